# Optimizing an MI355X kernel written in HIP

```python
import math
import jax
import jax.numpy as jnp
from jax import lax
import numpy as np

D_MODEL = 1024
BATCH = 8
SEQ = 2048
DEPTH = 4
DEC_BATCH = 8
DEC_SEQ = 8192
PAST_LEN = 128

N_MIXERS = 4
N_GROUPS = DEPTH // N_MIXERS
N_MOD = 6
NORM_EPS = 1e-6

HY_WIDTH = D_MODEL
HY_BANDS = 16
HY_EMB = 1 + 2 * HY_BANDS
HY_FILTER_ORDER = 64
HY_TARGET = 1e-2
HY_DECAY_SHORT = 0.3
HY_DECAY_LONG = 1.5

RET_HEADS = 4
RET_DK = D_MODEL // RET_HEADS
RET_DV = 2 * RET_DK
RET_CHUNK = 128
RET_SPLITS = [RET_HEADS * RET_DK, 2 * RET_HEADS * RET_DK, 2 * RET_HEADS * RET_DK + RET_HEADS * RET_DV]
RET_IN = 2 * RET_HEADS * RET_DK + 2 * RET_HEADS * RET_DV

SWA_HQ = 16
SWA_HKV = 4
SWA_GROUP = SWA_HQ // SWA_HKV
SWA_DH = 64
WINDOW = 128
ATTN_BLOCK = 128
ROPE_THETA = 10000.0
NEG_INF = -1e30
SWA_SPLITS = [SWA_HQ * SWA_DH, (SWA_HQ + SWA_HKV) * SWA_DH]
SWA_IN = (SWA_HQ + 2 * SWA_HKV) * SWA_DH

HG_HEADS = 8
HG_DK = 128
HG_DV = D_MODEL // HG_HEADS
HG_CHUNK = 64
HG_SPLITS = [HG_HEADS * HG_DK, HG_HEADS * (HG_DK + HG_DV), HG_HEADS * (2 * HG_DK + HG_DV), HG_HEADS * (3 * HG_DK + HG_DV)]
HG_IN = HG_HEADS * (3 * HG_DK + 2 * HG_DV)

D_FF = 2816

kernel_name = 'bidir_hybrid_encoder_two_groups'


def rms_norm(x, gain=None):
    xf = x.astype(jnp.float32)
    y = xf * lax.rsqrt(jnp.mean(xf * xf, axis=-1, keepdims=True) + NORM_EPS)
    if gain is not None:
        y = y * gain.astype(jnp.float32)
    return y.astype(x.dtype)


def dwconv3(x, w, b):
    xp = jnp.pad(x, ((0, 0), (1, 1), (0, 0)))
    return xp[:, :-2] * w[0] + xp[:, 1:-1] * w[1] + xp[:, 2:] * w[2] + b


def rope(x):
    L, dh = x.shape[1], x.shape[-1]
    inv = ROPE_THETA ** (-jnp.arange(0, dh, 2, dtype=jnp.float32) / dh)
    ang = jnp.arange(L, dtype=jnp.float32)[:, None] * inv[None, :]
    cos = jnp.cos(ang)[None, :, None, :]
    sin = jnp.sin(ang)[None, :, None, :]
    xf = x.astype(jnp.float32)
    x1, x2 = xf[..., : dh // 2], xf[..., dh // 2:]
    return jnp.concatenate([x1 * cos - x2 * sin, x1 * sin + x2 * cos], axis=-1).astype(x.dtype)


def chunk_recurrence(q, k, v, log_f, chunk):
    B, H, T, DK = q.shape
    DV = v.shape[-1]
    n = T // chunk
    q = q.astype(jnp.float32).reshape(B, H, n, chunk, DK)
    k = k.astype(jnp.float32).reshape(B, H, n, chunk, DK)
    v = v.astype(jnp.float32).reshape(B, H, n, chunk, DV)
    g = jnp.broadcast_to(log_f.astype(jnp.float32), (B, H, T, DK)).reshape(B, H, n, chunk, DK)
    b = jnp.cumsum(g, axis=3)
    b_last = b[:, :, :, -1:]
    q_dec = q * jnp.exp(b)
    k_inv = k * jnp.exp(-b)
    k_end = k * jnp.exp(b_last - b)
    causal = jnp.tril(jnp.ones((chunk, chunk), dtype=bool))
    scores = jnp.where(causal, jnp.einsum('bhntd,bhnsd->bhnts', q_dec, k_inv), 0.0)
    o_intra = jnp.einsum('bhnts,bhnse->bhnte', scores, v)

    def step(S, xs):
        qd, ke, vc, dl = xs
        o = jnp.einsum('bhtd,bhde->bhte', qd, S)
        S = dl[..., None] * S + jnp.einsum('bhtd,bhte->bhde', ke, vc)
        return S, o

    xs = (jnp.moveaxis(q_dec, 2, 0), jnp.moveaxis(k_end, 2, 0), jnp.moveaxis(v, 2, 0),
          jnp.moveaxis(jnp.exp(b_last[:, :, :, 0]), 2, 0))
    _, o_inter = lax.scan(step, jnp.zeros((B, H, DK, DV), jnp.float32), xs)
    return (o_intra + jnp.moveaxis(o_inter, 0, 2)).reshape(B, H, T, DV)


def bidir_recurrence(q, k_fwd, k_bwd, v, g_fwd, g_bwd, chunk):
    def flip(a):
        return jnp.flip(a, axis=2)
    fwd = chunk_recurrence(q, k_fwd, v, g_fwd, chunk)
    bwd = chunk_recurrence(flip(q), flip(k_bwd), flip(v), flip(g_bwd), chunk)
    return fwd + flip(bwd)


def hyena_filters(L, w1, b1, w2, b2, w3, freq, decay):
    t = jnp.linspace(0.0, 1.0, L, dtype=jnp.float32)[:, None]
    ang = (2.0 * math.pi / L) * jnp.arange(L, dtype=jnp.float32)[:, None]
    bands = jnp.linspace(1e-4, HY_BANDS - 1, HY_BANDS, dtype=jnp.float32)[None, :]
    z = jnp.concatenate([t, jnp.cos(bands * ang), -jnp.sin(bands * ang)], axis=-1)
    fr = freq.astype(jnp.float32)
    h = jnp.sin(fr * (z @ w1.astype(jnp.float32) + b1.astype(jnp.float32)))
    h = jnp.sin(fr * (h @ w2.astype(jnp.float32) + b2.astype(jnp.float32)))
    h = (h @ w3.astype(jnp.float32)).reshape(L, 2, HY_WIDTH)
    h = h * jnp.exp(-t[:, :, None] * jnp.abs(decay.astype(jnp.float32))[None])
    taps = jnp.concatenate([h[:, 0], jnp.zeros((1, HY_WIDTH), jnp.float32), h[:0:-1, 1]], axis=0)
    return taps / jnp.sum(jnp.abs(taps), axis=0, keepdims=True)


def long_conv(u, taps):
    L = u.shape[1]
    uf = jnp.fft.rfft(u.astype(jnp.float32), n=2 * L, axis=1)
    tf = jnp.fft.rfft(taps, axis=0)
    return jnp.fft.irfft(uf * tf[None], n=2 * L, axis=1)[:, :L]


def hyena_mixer(h, w_in, conv_w, conv_b, w1, b1, w2, b2, w3, freq, decay, skip, w_out):
    z = dwconv3(h @ w_in, conv_w, conv_b)
    x0, x1, v = jnp.split(z, 3, axis=-1)
    u = x1 * v
    taps = hyena_filters(h.shape[1], w1, b1, w2, b2, w3, freq, decay)
    y = long_conv(u, taps) + u.astype(jnp.float32) * skip.astype(jnp.float32)
    return (y.astype(h.dtype) * x0) @ w_out


def retention_mixer(h, w_in, decay_raw, w_out):
    B, L, _ = h.shape
    q, k, v, g = jnp.split(h @ w_in, RET_SPLITS, axis=-1)
    q = rope(q.reshape(B, L, RET_HEADS, RET_DK)).transpose(0, 2, 1, 3)
    k = (rope(k.reshape(B, L, RET_HEADS, RET_DK)) * (RET_DK ** -0.5)).transpose(0, 2, 1, 3)
    v = v.reshape(B, L, RET_HEADS, RET_DV).transpose(0, 2, 1, 3)
    log_gamma = -jnp.exp(decay_raw.astype(jnp.float32))
    o = bidir_recurrence(q, k, k, v, log_gamma[0].reshape(1, RET_HEADS, 1, 1),
                         log_gamma[1].reshape(1, RET_HEADS, 1, 1), RET_CHUNK)
    o = rms_norm(o.transpose(0, 2, 1, 3)).reshape(B, L, RET_HEADS * RET_DV).astype(h.dtype)
    return (o * jax.nn.silu(g)) @ w_out


def banded_window_attention(q, k, v, sink):
    B, L = q.shape[0], q.shape[1]
    nb = L // ATTN_BLOCK
    span = ATTN_BLOCK + 2 * WINDOW
    scale = SWA_DH ** -0.5
    kp = jnp.pad(k, ((0, 0), (WINDOW, WINDOW), (0, 0), (0, 0)))
    vp = jnp.pad(v, ((0, 0), (WINDOW, WINDOW), (0, 0), (0, 0)))
    qb = jnp.moveaxis(q.reshape(B, nb, ATTN_BLOCK, SWA_HKV, SWA_GROUP, SWA_DH), 1, 0)
    starts = jnp.arange(nb, dtype=jnp.int32) * ATTN_BLOCK
    rel = jnp.arange(ATTN_BLOCK)[:, None] - (jnp.arange(span)[None, :] - WINDOW)
    band = jnp.abs(rel) <= WINDOW
    sink_l = sink.astype(jnp.float32).reshape(1, SWA_HKV, SWA_GROUP, 1, 1)

    def block(args):
        qj, start = args
        kj = lax.dynamic_slice_in_dim(kp, start, span, axis=1)
        vj = lax.dynamic_slice_in_dim(vp, start, span, axis=1)
        kpos = start - WINDOW + jnp.arange(span)
        valid = band & ((kpos >= 0) & (kpos < L))[None, :]
        s = jnp.einsum('bqhgd,bkhd->bhgqk', qj.astype(jnp.float32), kj.astype(jnp.float32)) * scale
        s = jnp.where(valid, s, NEG_INF)
        sk = jnp.broadcast_to(sink_l, s.shape[:-1] + (1,))
        p = jax.nn.softmax(jnp.concatenate([s, sk], axis=-1), axis=-1)[..., :-1]
        return jnp.einsum('bhgqk,bkhd->bqhgd', p, vj.astype(jnp.float32))

    o = lax.map(block, (qb, starts))
    return jnp.moveaxis(o, 0, 1).reshape(B, L, SWA_HQ * SWA_DH)


def swa_mixer(h, w_in, q_gain, k_gain, sink, w_out):
    B, L, _ = h.shape
    q, k, v = jnp.split(h @ w_in, SWA_SPLITS, axis=-1)
    q = rope(rms_norm(q.reshape(B, L, SWA_HQ, SWA_DH), q_gain))
    k = rope(rms_norm(k.reshape(B, L, SWA_HKV, SWA_DH), k_gain))
    v = v.reshape(B, L, SWA_HKV, SWA_DH)
    o = banded_window_attention(q, k, v, sink).astype(h.dtype)
    return o @ w_out


def hgrn_mixer(h, w_in, lb_table, layer, gain, w_out):
    B, L, _ = h.shape
    q, i, ff, fb, gate = jnp.split(h @ w_in, HG_SPLITS, axis=-1)

    def heads(a):
        return a.reshape(B, L, HG_HEADS, -1).transpose(0, 2, 1, 3)

    sm = jax.nn.softmax(lb_table.astype(jnp.float32), axis=1)
    lb = (jnp.cumsum(sm, axis=1) - sm)[:, layer]
    f_f = lb[0] + (1.0 - lb[0]) * jax.nn.sigmoid(ff.astype(jnp.float32))
    f_b = lb[1] + (1.0 - lb[1]) * jax.nn.sigmoid(fb.astype(jnp.float32))
    o = bidir_recurrence(heads(jax.nn.silu(q)), heads(1.0 - f_f), heads(1.0 - f_b), heads(i),
                         heads(jnp.log(f_f)), heads(jnp.log(f_b)), HG_CHUNK)
    o = rms_norm(o.transpose(0, 2, 1, 3), gain).reshape(B, L, HG_HEADS * HG_DV).astype(h.dtype)
    return (o * jax.nn.silu(gate)) @ w_out


def conv_ffn(h, w_gate, w_val, conv_w, conv_b, w_down):
    a = dwconv3(h @ w_gate, conv_w, conv_b)
    return (jax.nn.silu(a) * (h @ w_val)) @ w_down


def setup_inputs(seed: int = 0) -> dict:
    key = jax.random.key(seed)
    keys = jax.random.split(key, 36)
    counter = iter(range(36))

    def nrm(shape, scale=1.0):
        return scale * jax.random.normal(keys[next(counter)], shape, jnp.float32)

    G, W, D = N_GROUPS, HY_WIDTH, D_MODEL
    hy_decay0 = jnp.linspace(math.log(HY_TARGET) / HY_DECAY_LONG, math.log(HY_TARGET) / HY_DECAY_SHORT, W, dtype=jnp.float32)
    ret_decay0 = jnp.log(-jnp.log(1.0 - 2.0 ** (-5.0 - jnp.arange(RET_HEADS, dtype=jnp.float32))))
    return {
        'x_prompt': nrm((BATCH, SEQ, D)),
        'x_sample': nrm((DEC_BATCH, DEC_SEQ, D)),
        'c_prompt': nrm((BATCH, D)),
        'c_sample': nrm((DEC_BATCH, D)),
        'ada_w': nrm((DEPTH, D, N_MOD * D), D ** -0.5),
        'ada_b': nrm((DEPTH, N_MOD * D), 0.02),
        'norm_g': 1.0 + nrm((DEPTH, 2, D), 0.02),
        'hy_w_in': nrm((G, D, 3 * W), D ** -0.5),
        'hy_conv_w': nrm((G, 3, 3 * W), 3 ** -0.5),
        'hy_conv_b': nrm((G, 3 * W), 0.02),
        'hy_w1': nrm((G, HY_EMB, HY_FILTER_ORDER), HY_EMB ** -0.5),
        'hy_b1': nrm((G, HY_FILTER_ORDER), 0.02),
        'hy_w2': nrm((G, HY_FILTER_ORDER, HY_FILTER_ORDER), HY_FILTER_ORDER ** -0.5),
        'hy_b2': nrm((G, HY_FILTER_ORDER), 0.02),
        'hy_w3': nrm((G, HY_FILTER_ORDER, 2 * W), HY_FILTER_ORDER ** -0.5),
        'hy_freq': 1.0 + nrm((G, HY_FILTER_ORDER), 0.01),
        'hy_decay': hy_decay0[None, None, :] + nrm((G, 2, W), 0.01),
        'hy_skip': nrm((G, W)),
        'hy_w_out': nrm((G, W, D), W ** -0.5),
        'ret_w_in': nrm((G, D, RET_IN), D ** -0.5),
        'ret_decay': ret_decay0[None, None, :] + nrm((G, 2, RET_HEADS), 0.01),
        'ret_w_out': nrm((G, RET_HEADS * RET_DV, D), (RET_HEADS * RET_DV) ** -0.5),
        'swa_w_in': nrm((G, D, SWA_IN), D ** -0.5),
        'swa_q_gain': 1.0 + nrm((G, SWA_DH), 0.02),
        'swa_k_gain': 1.0 + nrm((G, SWA_DH), 0.02),
        'swa_sink': nrm((G, SWA_HQ), 0.5),
        'swa_w_out': nrm((G, SWA_HQ * SWA_DH, D), (SWA_HQ * SWA_DH) ** -0.5),
        'hg_w_in': nrm((G, D, HG_IN), D ** -0.5),
        'hg_lb': nrm((2, DEPTH, HG_HEADS * HG_DK), 0.1),
        'hg_gain': 1.0 + nrm((G, HG_DV), 0.02),
        'hg_w_out': nrm((G, HG_HEADS * HG_DV, D), (HG_HEADS * HG_DV) ** -0.5),
        'ffn_w_gate': nrm((DEPTH, D, D_FF), D ** -0.5),
        'ffn_w_val': nrm((DEPTH, D, D_FF), D ** -0.5),
        'ffn_conv_w': nrm((DEPTH, 3, D_FF), 3 ** -0.5),
        'ffn_conv_b': nrm((DEPTH, D_FF), 0.02),
        'ffn_w_down': nrm((DEPTH, D_FF, D), D_FF ** -0.5),
    }


def reference(x_prompt, x_sample, c_prompt, c_sample, ada_w, ada_b, norm_g,
              hy_w_in, hy_conv_w, hy_conv_b, hy_w1, hy_b1, hy_w2, hy_b2, hy_w3, hy_freq, hy_decay, hy_skip, hy_w_out,
              ret_w_in, ret_decay, ret_w_out,
              swa_w_in, swa_q_gain, swa_k_gain, swa_sink, swa_w_out,
              hg_w_in, hg_lb, hg_gain, hg_w_out,
              ffn_w_gate, ffn_w_val, ffn_conv_w, ffn_conv_b, ffn_w_down):

    def trunk(x, c):
        cs = jax.nn.silu(c)
        for layer in range(DEPTH):
            kind, j = layer % N_MIXERS, layer // N_MIXERS
            mod = (cs @ ada_w[layer] + ada_b[layer])[:, None, :]
            sh1, sc1, g1, sh2, sc2, g2 = jnp.split(mod, N_MOD, axis=-1)
            h = rms_norm(x, norm_g[layer, 0]) * (1.0 + sc1) + sh1
            if kind == 0:
                m = hyena_mixer(h, hy_w_in[j], hy_conv_w[j], hy_conv_b[j], hy_w1[j], hy_b1[j], hy_w2[j], hy_b2[j],
                                hy_w3[j], hy_freq[j], hy_decay[j], hy_skip[j], hy_w_out[j])
            elif kind == 1:
                m = retention_mixer(h, ret_w_in[j], ret_decay[j], ret_w_out[j])
            elif kind == 2:
                m = swa_mixer(h, swa_w_in[j], swa_q_gain[j], swa_k_gain[j], swa_sink[j], swa_w_out[j])
            else:
                m = hgrn_mixer(h, hg_w_in[j], hg_lb, layer, hg_gain[j], hg_w_out[j])
            x = x + g1 * m
            h = rms_norm(x, norm_g[layer, 1]) * (1.0 + sc2) + sh2
            x = x + g2 * conv_ffn(h, ffn_w_gate[layer], ffn_w_val[layer], ffn_conv_w[layer], ffn_conv_b[layer], ffn_w_down[layer])
        return x

    y_prompt = trunk(x_prompt, c_prompt)
    y_sample = trunk(x_sample, c_sample)
    return (y_prompt, y_sample)
```

```cpp
#include <hip/hip_runtime.h>
#include <hip/hip_cooperative_groups.h>
#include <cstdio>
#include <cstdint>
#include <cstring>
namespace cg = cooperative_groups;

typedef unsigned short u16;
typedef __attribute__((ext_vector_type(8))) short bf16x8;
typedef __attribute__((ext_vector_type(4))) float f32x4;

#define NT 512
#ifndef ONE_LAUNCH
#define ONE_LAUNCH 1
#endif

constexpr int D = 1024, SLAB = 16384, DFF = 2816;
constexpr int LDSB = 131072;
constexpr int NPHASES = 2 + 5 * (10 + 12 + 10 + 12);

constexpr size_t SZW(size_t n, size_t k) { return n * k * 2; }
constexpr size_t O_WHYIN = 0;
constexpr size_t O_WHYOUT = O_WHYIN + SZW(3072, 1024);
constexpr size_t O_WRETIN = O_WHYOUT + SZW(1024, 1024);
constexpr size_t O_WRETOUT = O_WRETIN + SZW(6144, 1024);
constexpr size_t O_WSWAIN = O_WRETOUT + SZW(1024, 2048);
constexpr size_t O_WSWAOUT = O_WSWAIN + SZW(1536, 1024);
constexpr size_t O_WHGIN = O_WSWAOUT + SZW(1024, 1024);
constexpr size_t O_WHGOUT = O_WHGIN + SZW(5120, 1024);
constexpr size_t O_WFG = O_WHGOUT + SZW(1024, 1024);
constexpr size_t O_WFV = O_WFG + 4 * SZW(2816, 1024);
constexpr size_t O_WFD = O_WFV + 4 * SZW(2816, 1024);
constexpr size_t O_MOD = O_WFD + 4 * SZW(1024, 2816);
constexpr size_t O_TW = O_MOD + (size_t)4 * 16 * 6144 * 4;
constexpr size_t O_HIDS = O_TW + 8192 * 8;
constexpr size_t O_HIDP = O_HIDS + (size_t)8192 * 64 * 4;
constexpr size_t O_ROPER = O_HIDP + (size_t)2048 * 64 * 4;
constexpr size_t O_ROPES = O_ROPER + (size_t)8192 * 128 * 8;
constexpr size_t O_PROJ = O_ROPES + (size_t)8192 * 32 * 8;
constexpr size_t O_HBUF = O_PROJ + (size_t)SLAB * 6144 * 2;
constexpr size_t O_A2 = O_HBUF + (size_t)SLAB * 1024 * 2;
constexpr size_t O_C = O_A2 + (size_t)SLAB * 2048 * 2;
constexpr size_t O_GBUF = O_C;
constexpr size_t O_ACT = O_GBUF + (size_t)SLAB * DFF * 2;
constexpr size_t O_MODP = O_C;
constexpr size_t O_HSPS = O_ACT + (size_t)SLAB * DFF * 2;
constexpr size_t O_HSPP = O_HSPS + (size_t)1024 * 16384 * 8;
constexpr size_t O_UT = O_HSPP + (size_t)1024 * 4096 * 8;
constexpr size_t O_X0C = O_UT + (size_t)SLAB * 1024 * 4;
constexpr size_t END_HY = O_X0C + (size_t)SLAB * 1024 * 2;
constexpr size_t SZP = (size_t)SLAB * 1024 * 2;
constexpr size_t O_QDF = O_C, O_QDB = O_QDF + SZP, O_KIF = O_QDB + SZP, O_KIB = O_KIF + SZP, O_KEF = O_KIB + SZP, O_KEB = O_KEF + SZP;
constexpr size_t O_DLF = O_KEB + SZP;
constexpr size_t O_DLB = O_DLF + (size_t)256 * 1024 * 4;
constexpr size_t O_SC = O_DLB + (size_t)256 * 1024 * 4;
constexpr size_t O_STF = O_SC + (size_t)SLAB * 512 * 2;
constexpr size_t O_STB = O_STF + (size_t)134217728;
constexpr size_t O_OBUF = O_STB + (size_t)134217728;
constexpr size_t END_REC = O_OBUF + (size_t)SLAB * 2048 * 4;
constexpr size_t O_QN = O_C;
constexpr size_t O_KN = O_QN + SZP;
constexpr size_t O_PBUF = O_KN + (size_t)SLAB * 256 * 2;
constexpr size_t END_SWA = O_PBUF + (size_t)SLAB * 16 * 320 * 2;
constexpr size_t WS_END = END_REC > END_HY ? (END_REC > END_SWA ? END_REC : END_SWA) : (END_HY > END_SWA ? END_HY : END_SWA);
static_assert(WS_END <= ((size_t)1 << 30), "workspace exceeds 1 GiB");

struct Params {
  const float* in[36];
  float* out;
  unsigned char* ws;
  int p0, p1;
};

extern __shared__ __attribute__((aligned(16))) unsigned char smem[];

__device__ __forceinline__ int TID() { int t = threadIdx.x; asm volatile("" : "+v"(t)); return t; }
__device__ __forceinline__ int BID() { int b = blockIdx.x; asm volatile("" : "+s"(b)); return b; }
__device__ __forceinline__ unsigned char* WS(const Params& P) { unsigned char* w = P.ws; asm volatile("" : "+s"(w)); return w; }
__device__ __forceinline__ float* OUTP(const Params& P) { float* w = P.out; asm volatile("" : "+s"(w)); return w; }


__device__ __forceinline__ u16 f2bf(float f) {
  unsigned u = __float_as_uint(f);
  u += 0x7fffu + ((u >> 16) & 1u);
  return (u16)(u >> 16);
}
__device__ __forceinline__ float bf2f(u16 h) { return __uint_as_float(((unsigned)h) << 16); }
__device__ __forceinline__ unsigned pack2(float a, float b) { return (unsigned)f2bf(a) | ((unsigned)f2bf(b) << 16); }
__device__ __forceinline__ float silu_f(float x) { return x / (1.f + __expf(-x)); }
__device__ __forceinline__ float sigm(float x) { return 1.f / (1.f + __expf(-x)); }
__device__ __forceinline__ float wave_sum(float v) {
#pragma unroll
  for (int o = 32; o; o >>= 1) v += __shfl_xor(v, o);
  return v;
}
__device__ __forceinline__ int Lof(int slab) { return slab == 0 ? 2048 : 8192; }
__device__ __forceinline__ int gb_of(int slab, int r) { return slab == 0 ? (r >> 11) : (8 + (slab - 1) * 2 + (r >> 13)); }

constexpr int LDS_LD = 40;
template <int R, bool KC>
__device__ __forceinline__ uint4 ld_tile(const u16* __restrict__ base, long ld, int k0, int tid) {
  uint4 v = make_uint4(0, 0, 0, 0);
  if (tid < R * 4) {
    if (KC) {
      int r = tid >> 2, kc = tid & 3;
      v = *(const uint4*)(base + (long)r * ld + k0 + kc * 8);
    } else {
      int k = tid / (R / 8), mc = tid % (R / 8);
      v = *(const uint4*)(base + (long)(k0 + k) * ld + mc * 8);
    }
  }
  return v;
}
template <int R, bool KC>
__device__ __forceinline__ void st_tile(u16* s, uint4 v, int tid) {
  if (tid < R * 4) {
    if (KC) {
      int r = tid >> 2, kc = tid & 3;
      *(uint4*)(s + r * LDS_LD + kc * 8) = v;
    } else {
      int k = tid / (R / 8), mc = tid % (R / 8);
      u16* p = s + (mc * 8) * LDS_LD + k;
      p[0 * LDS_LD] = (u16)(v.x & 0xffff); p[1 * LDS_LD] = (u16)(v.x >> 16);
      p[2 * LDS_LD] = (u16)(v.y & 0xffff); p[3 * LDS_LD] = (u16)(v.y >> 16);
      p[4 * LDS_LD] = (u16)(v.z & 0xffff); p[5 * LDS_LD] = (u16)(v.z >> 16);
      p[6 * LDS_LD] = (u16)(v.w & 0xffff); p[7 * LDS_LD] = (u16)(v.w >> 16);
    }
  }
}

template <int TM, int TN, bool AKC, bool BKC>
__device__ __forceinline__ void gemm_acc(f32x4 (&acc)[TM / 32][TN / 64], const u16* __restrict__ A, long lda,
                                         const u16* __restrict__ B, long ldb, int K, u16* sm) {
  u16* As = sm;
  u16* Bs = sm + 128 * LDS_LD;
  const int tid = TID(), lane = tid & 63, wid = tid >> 6;
  const int wm = wid >> 2, wn = wid & 3, fr = lane & 15, fq = lane >> 4;
  constexpr int MI = TM / 32, NI = TN / 64;
  uint4 ra = ld_tile<TM, AKC>(A, lda, 0, tid), rb = ld_tile<TN, BKC>(B, ldb, 0, tid);
  for (int k0 = 0; k0 < K; k0 += 32) {
    __syncthreads();
    st_tile<TM, AKC>(As, ra, tid);
    st_tile<TN, BKC>(Bs, rb, tid);
    __syncthreads();
    if (k0 + 32 < K) {
      ra = ld_tile<TM, AKC>(A, lda, k0 + 32, tid);
      rb = ld_tile<TN, BKC>(B, ldb, k0 + 32, tid);
    }
    bf16x8 af[MI], bfr[NI];
#pragma unroll
    for (int mi = 0; mi < MI; ++mi) af[mi] = *(const bf16x8*)(As + (wm * (TM / 2) + mi * 16 + fr) * LDS_LD + fq * 8);
#pragma unroll
    for (int ni = 0; ni < NI; ++ni) bfr[ni] = *(const bf16x8*)(Bs + (wn * (TN / 4) + ni * 16 + fr) * LDS_LD + fq * 8);
#pragma unroll
    for (int mi = 0; mi < MI; ++mi)
#pragma unroll
      for (int ni = 0; ni < NI; ++ni)
        acc[mi][ni] = __builtin_amdgcn_mfma_f32_16x16x32_bf16(af[mi], bfr[ni], acc[mi][ni], 0, 0, 0);
  }
  __syncthreads();
}

template <int TM, int TN, class F>
__device__ __forceinline__ void epi_each(f32x4 (&acc)[TM / 32][TN / 64], F f) {
  const int tid = TID(), lane = tid & 63, wid = tid >> 6;
  const int wm = wid >> 2, wn = wid & 3, fr = lane & 15, fq = lane >> 4;
#pragma unroll
  for (int mi = 0; mi < TM / 32; ++mi)
#pragma unroll
    for (int ni = 0; ni < TN / 64; ++ni)
#pragma unroll
      for (int j = 0; j < 4; ++j) f(wm * (TM / 2) + mi * 16 + fq * 4 + j, wn * (TN / 4) + ni * 16 + fr, acc[mi][ni][j]);
}

template <class E>
__device__ __forceinline__ void phase_gemm(const u16* A, int lda, const u16* Bt, int K, int N, E e) {
  const int ntn = N / 128, nitems = (SLAB / 128) * ntn;
  for (int item = BID(); item < nitems; item += gridDim.x) {
    const int mt = item / ntn, nt = item % ntn;
    f32x4 acc[4][2] = {};
    gemm_acc<128, 128, true, true>(acc, A + (long)mt * 128 * lda, lda, Bt + (long)nt * 128 * K, K, K, (u16*)smem);
    epi_each<128, 128>(acc, [&](int r, int c, float v) { e(mt * 128 + r, nt * 128 + c, v); });
  }
}

__device__ __forceinline__ void fft_dif(float2* x, int N, const float2* __restrict__ tw) {
  const int tid = TID();
  for (int s = N >> 1; s >= 1; s >>= 1) {
    const int tws = 8192 / s;
    for (int i = tid; i < (N >> 1); i += NT) {
      const int j = i & (s - 1);
      const int p = ((i - j) << 1) + j;
      float2 a = x[p], b = x[p + s];
      float2 w = tw[j * tws];
      x[p] = make_float2(a.x + b.x, a.y + b.y);
      float dx = a.x - b.x, dy = a.y - b.y;
      x[p + s] = make_float2(dx * w.x - dy * w.y, dx * w.y + dy * w.x);
    }
    __syncthreads();
  }
}
__device__ __forceinline__ void ifft_dit(float2* x, int N, const float2* __restrict__ tw) {
  const int tid = TID();
  for (int s = 1; s < N; s <<= 1) {
    const int tws = 8192 / s;
    for (int i = tid; i < (N >> 1); i += NT) {
      const int j = i & (s - 1);
      const int p = ((i - j) << 1) + j;
      float2 a = x[p], b = x[p + s];
      float2 w = tw[j * tws];
      float bx = b.x * w.x + b.y * w.y, by = b.y * w.x - b.x * w.y;
      x[p] = make_float2(a.x + bx, a.y + by);
      x[p + s] = make_float2(a.x - bx, a.y - by);
    }
    __syncthreads();
  }
}

__device__ void transpose_w(const float* __restrict__ W, u16* __restrict__ Wt, int K, int N) {
  float* smf = (float*)smem;
  const int tk = K / 64, tn = N / 64, tid = TID();
  for (int item = BID(); item < tk * tn; item += gridDim.x) {
    const int k0 = (item / tn) * 64, n0 = (item % tn) * 64;
    __syncthreads();
    for (int i = tid; i < 4096; i += NT) {
      int kk = i >> 6, nn = i & 63;
      smf[kk * 65 + nn] = W[(long)(k0 + kk) * N + n0 + nn];
    }
    __syncthreads();
    for (int i = tid; i < 4096; i += NT) {
      int nn = i >> 6, kk = i & 63;
      Wt[(long)(n0 + nn) * K + k0 + kk] = f2bf(smf[kk * 65 + nn]);
    }
  }
  __syncthreads();
}

__device__ void phase_pre0(const Params& P) {
  const int tid = TID();
  const long gtid = (long)BID() * NT + tid, gsz = (long)gridDim.x * NT;
  {
    const float4* s0 = (const float4*)P.in[0];
    const float4* s1 = (const float4*)P.in[1];
    float4* o = (float4*)OUTP(P);
    const long n0 = (long)16384 * 1024 / 4, n1 = (long)65536 * 1024 / 4;
    for (long i = gtid; i < n0; i += gsz) o[i] = s0[i];
    for (long i = gtid; i < n1; i += gsz) o[n0 + i] = s1[i];
  }
  transpose_w(P.in[7], (u16*)(WS(P) + O_WHYIN), 1024, 3072);
  transpose_w(P.in[18], (u16*)(WS(P) + O_WHYOUT), 1024, 1024);
  transpose_w(P.in[19], (u16*)(WS(P) + O_WRETIN), 1024, 6144);
  transpose_w(P.in[21], (u16*)(WS(P) + O_WRETOUT), 2048, 1024);
  transpose_w(P.in[22], (u16*)(WS(P) + O_WSWAIN), 1024, 1536);
  transpose_w(P.in[26], (u16*)(WS(P) + O_WSWAOUT), 1024, 1024);
  transpose_w(P.in[27], (u16*)(WS(P) + O_WHGIN), 1024, 5120);
  transpose_w(P.in[30], (u16*)(WS(P) + O_WHGOUT), 1024, 1024);
  for (int l = 0; l < 4; ++l) {
    transpose_w(P.in[31] + (long)l * 1024 * DFF, (u16*)(WS(P) + O_WFG) + (long)l * DFF * 1024, 1024, DFF);
    transpose_w(P.in[32] + (long)l * 1024 * DFF, (u16*)(WS(P) + O_WFV) + (long)l * DFF * 1024, 1024, DFF);
    transpose_w(P.in[35] + (long)l * DFF * 1024, (u16*)(WS(P) + O_WFD) + (long)l * 1024 * DFF, DFF, 1024);
  }
  {
    float* cs = (float*)smem;
    float* modp = (float*)(WS(P) + O_MODP);
    for (int item = BID(); item < 4 * 8 * 12; item += gridDim.x) {
      const int nb = item % 12, ks = (item / 12) % 8, l = item / 96;
      __syncthreads();
      for (int i = tid; i < 2048; i += NT) {
        int b = i >> 7, k = i & 127;
        float c = (b < 8) ? P.in[2][b * 1024 + ks * 128 + k] : P.in[3][(b - 8) * 1024 + ks * 128 + k];
        cs[i] = c / (1.f + expf(-c));
      }
      __syncthreads();
      const int n = nb * 512 + tid;
      float a[16];
#pragma unroll
      for (int b = 0; b < 16; ++b) a[b] = 0.f;
      const float* w = P.in[4] + ((long)l * 1024 + ks * 128) * 6144 + n;
      for (int k = 0; k < 128; ++k) {
        float wv = w[(long)k * 6144];
#pragma unroll
        for (int b = 0; b < 16; ++b) a[b] += cs[b * 128 + k] * wv;
      }
#pragma unroll
      for (int b = 0; b < 16; ++b) modp[(((long)ks * 4 + l) * 16 + b) * 6144 + n] = a[b];
    }
    __syncthreads();
  }
  {
    float2* tw = (float2*)(WS(P) + O_TW);
    for (long i = gtid; i < 8192; i += gsz) {
      double s, c;
      sincospi(2.0 * (double)i / 16384.0, &s, &c);
      tw[i] = make_float2((float)c, (float)(-s));
    }
    float2* rr = (float2*)(WS(P) + O_ROPER);
    for (long i = gtid; i < (long)8192 * 128; i += gsz) {
      int pos = (int)(i >> 7), d = (int)(i & 127);
      double inv = pow(10000.0, -(double)d / 128.0);
      double s, c;
      sincos((double)pos * inv, &s, &c);
      rr[i] = make_float2((float)c, (float)s);
    }
    float2* rs = (float2*)(WS(P) + O_ROPES);
    for (long i = gtid; i < (long)8192 * 32; i += gsz) {
      int pos = (int)(i >> 5), d = (int)(i & 31);
      double inv = pow(10000.0, -(double)d / 32.0);
      double s, c;
      sincos((double)pos * inv, &s, &c);
      rs[i] = make_float2((float)c, (float)s);
    }
  }
  {
    float* zf = (float*)smem;
    float* h1 = zf + 8 * 36;
    const float* w1 = P.in[10]; const float* b1 = P.in[11]; const float* w2 = P.in[12]; const float* b2 = P.in[13];
    const float* fr = P.in[15];
    const int tl = tid >> 6, j = tid & 63;
    for (int item = BID(); item < 1280; item += gridDim.x) {
      const int sel = item >= 1024;
      const int L = sel ? 2048 : 8192;
      const int t = (sel ? item - 1024 : item) * 8 + tl;
      float* hid = (float*)(WS(P) + (sel ? O_HIDP : O_HIDS));
      __syncthreads();
      if (j < 33) {
        float v;
        if (j == 0) v = (float)t / (float)(L - 1);
        else {
          int i = (j - 1) & 15;
          float band = 1e-4f + (float)i * ((15.f - 1e-4f) / 15.f);
          float ang = (6.283185307179586f / (float)L) * (float)t;
          float a = band * ang;
          v = (j <= 16) ? cosf(a) : -sinf(a);
        }
        zf[tl * 36 + j] = v;
      }
      __syncthreads();
      float s = b1[j];
#pragma unroll 3
      for (int i = 0; i < 33; ++i) s += zf[tl * 36 + i] * w1[i * 64 + j];
      h1[tl * 64 + j] = sinf(fr[j] * s);
      __syncthreads();
      float s2 = b2[j];
#pragma unroll 4
      for (int i = 0; i < 64; ++i) s2 += h1[tl * 64 + i] * w2[i * 64 + j];
      hid[(long)t * 64 + j] = sinf(fr[j] * s2);
    }
    __syncthreads();
  }
}

__device__ void phase_pre1(const Params& P) {
  __shared__ float w3s[128];
  __shared__ float red[8];
  const int tid = TID(), lane = tid & 63, wid = tid >> 6;
  const long gtid = (long)BID() * NT + tid, gsz = (long)gridDim.x * NT;
  {
    const float* modp = (const float*)(WS(P) + O_MODP);
    float* mod = (float*)(WS(P) + O_MOD);
    for (long i = gtid; i < (long)4 * 16 * 6144; i += gsz) {
      int n = (int)(i % 6144);
      int l = (int)(i / (16 * 6144));
      float s = P.in[5][l * 6144 + n];
      for (int ks = 0; ks < 8; ++ks) s += modp[(long)ks * 4 * 16 * 6144 + i];
      mod[i] = s;
    }
  }
  float2* buf = (float2*)smem;
  const float2* tw = (const float2*)(WS(P) + O_TW);
  for (int item = BID(); item < 2048; item += gridDim.x) {
    const int sel = item >> 10, c = item & 1023;
    const int L = sel ? 2048 : 8192, N = 2 * L;
    const float* hid = (const float*)(WS(P) + (sel ? O_HIDP : O_HIDS));
    float2* hs = (float2*)(WS(P) + (sel ? O_HSPP : O_HSPS)) + (long)c * N;
    __syncthreads();
    if (tid < 128) {
      int dirn = tid >> 6, j = tid & 63;
      w3s[tid] = P.in[14][(long)j * 2048 + dirn * 1024 + c];
    }
    __syncthreads();
    const float dec0 = fabsf(P.in[16][c]), dec1 = fabsf(P.in[16][1024 + c]);
    const float invLm1 = 1.f / (float)(L - 1);
    float asum = 0.f;
    for (int n = tid; n < N; n += NT) {
      float val = 0.f;
      if (n != L) {
        const int dirn = n < L ? 0 : 1;
        const int t = n < L ? n : N - n;
        const float4* hr = (const float4*)(hid + (long)t * 64);
        const float* w = w3s + dirn * 64;
        float s = 0.f;
#pragma unroll
        for (int q = 0; q < 16; ++q) {
          float4 h4 = hr[q];
          s += h4.x * w[4 * q] + h4.y * w[4 * q + 1] + h4.z * w[4 * q + 2] + h4.w * w[4 * q + 3];
        }
        float tl = (float)t * invLm1;
        val = s * expf(-tl * (dirn ? dec1 : dec0));
      }
      buf[n] = make_float2(val, 0.f);
      asum += fabsf(val);
    }
    asum = wave_sum(asum);
    if (lane == 0) red[wid] = asum;
    __syncthreads();
    float tot = 0.f;
#pragma unroll
    for (int w = 0; w < 8; ++w) tot += red[w];
    const float scale = 1.f / (tot * (float)N);
    fft_dif(buf, N, tw);
    for (int p = tid; p < N; p += NT) {
      float2 a = buf[p];
      hs[p] = make_float2(a.x * scale, a.y * scale);
    }
  }
  __syncthreads();
}

__device__ void phase_norm(const Params& P, int layer, int slab, int which) {
  const float* x = OUTP(P) + (long)slab * SLAB * D;
  u16* h = (u16*)(WS(P) + O_HBUF);
  const float* gain = P.in[6] + (layer * 2 + which) * D;
  const float* mod = (const float*)(WS(P) + O_MOD) + (long)layer * 16 * 6144;
  const int shoff = which ? 3 * D : 0, scoff = which ? 4 * D : D;
  const int tid = TID(), lane = tid & 63, wid = tid >> 6;
  for (int item = BID(); item < SLAB / 8; item += gridDim.x) {
    const int r = item * 8 + wid;
    const float* xr = x + (long)r * D;
    float4 v[4];
    float ss = 0.f;
#pragma unroll
    for (int i = 0; i < 4; ++i) {
      v[i] = *(const float4*)(xr + i * 256 + lane * 4);
      ss += v[i].x * v[i].x + v[i].y * v[i].y + v[i].z * v[i].z + v[i].w * v[i].w;
    }
    ss = wave_sum(ss);
    const float rstd = rsqrtf(ss * (1.f / 1024.f) + 1e-6f);
    const float* m = mod + (long)gb_of(slab, r) * 6144;
#pragma unroll
    for (int i = 0; i < 4; ++i) {
      const int col = i * 256 + lane * 4;
      float4 g = *(const float4*)(gain + col);
      float4 sc = *(const float4*)(m + scoff + col);
      float4 sh = *(const float4*)(m + shoff + col);
      float y0 = v[i].x * rstd * g.x * (1.f + sc.x) + sh.x;
      float y1 = v[i].y * rstd * g.y * (1.f + sc.y) + sh.y;
      float y2 = v[i].z * rstd * g.z * (1.f + sc.z) + sh.z;
      float y3 = v[i].w * rstd * g.w * (1.f + sc.w) + sh.w;
      uint2 o = make_uint2(pack2(y0, y1), pack2(y2, y3));
      *(uint2*)(h + (long)r * D + col) = o;
    }
  }
}

__device__ void phase_proj(const Params& P, size_t woff, int N) {
  u16* o = (u16*)(WS(P) + O_PROJ);
  phase_gemm((const u16*)(WS(P) + O_HBUF), D, (const u16*)(WS(P) + woff), D, N,
             [&](int r, int c, float v) { o[(long)r * N + c] = f2bf(v); });
}
__device__ void phase_resid(const Params& P, int layer, int slab, const u16* A, int K, size_t woff, int goff) {
  float* x = OUTP(P) + (long)slab * SLAB * D;
  const float* mod = (const float*)(WS(P) + O_MOD) + (long)layer * 16 * 6144;
  phase_gemm(A, K, (const u16*)(WS(P) + woff), K, D, [&](int r, int c, float v) {
    float g = mod[(long)gb_of(slab, r) * 6144 + goff + c];
    x[(long)r * D + c] += g * v;
  });
}

__device__ void phase_ffn_gate(const Params& P, int layer) {
  u16* g = (u16*)(WS(P) + O_GBUF);
  phase_gemm((const u16*)(WS(P) + O_HBUF), D, (const u16*)(WS(P) + O_WFG) + (long)layer * DFF * D, D, DFF,
             [&](int r, int c, float v) { g[(long)r * DFF + c] = f2bf(v); });
}
__device__ void phase_ffn_val(const Params& P, int layer, int slab) {
  const u16* g = (const u16*)(WS(P) + O_GBUF);
  u16* act = (u16*)(WS(P) + O_ACT);
  const float* cw = P.in[33] + (long)layer * 3 * DFF;
  const float* cb = P.in[34] + (long)layer * DFF;
  const int L = Lof(slab);
  phase_gemm((const u16*)(WS(P) + O_HBUF), D, (const u16*)(WS(P) + O_WFV) + (long)layer * DFF * D, D, DFF,
             [&](int r, int c, float v) {
               const int pos = r & (L - 1);
               float a = bf2f(g[(long)r * DFF + c]) * cw[DFF + c] + cb[c];
               if (pos > 0) a += bf2f(g[(long)(r - 1) * DFF + c]) * cw[c];
               if (pos < L - 1) a += bf2f(g[(long)(r + 1) * DFF + c]) * cw[2 * DFF + c];
               act[(long)r * DFF + c] = f2bf(silu_f(a) * v);
             });
}

__device__ void phase_hy_conv(const Params& P, int slab) {
  const int L = Lof(slab), nseq = SLAB / L, tid = TID();
  const u16* z = (const u16*)(WS(P) + O_PROJ);
  float* uT = (float*)(WS(P) + O_UT);
  u16* x0c = (u16*)(WS(P) + O_X0C);
  const float* cw = P.in[8];
  const float* cb = P.in[9];
  float* tile = (float*)smem;
  const int ntt = L / 64;
  const int nitems = nseq * ntt * 16;
  for (int item = BID(); item < nitems; item += gridDim.x) {
    const int ct = item % 16, tt = (item / 16) % ntt, seq = item / (16 * ntt);
    __syncthreads();
    for (int i = tid; i < 4096; i += NT) {
      const int tl = i >> 6, cl = i & 63;
      const int t = tt * 64 + tl, c = ct * 64 + cl;
      const long row = (long)seq * L + t;
      float val[3];
#pragma unroll
      for (int q = 0; q < 3; ++q) {
        const int col = q * 1024 + c;
        float a = bf2f(z[row * 3072 + col]) * cw[3072 + col] + cb[col];
        if (t > 0) a += bf2f(z[(row - 1) * 3072 + col]) * cw[col];
        if (t < L - 1) a += bf2f(z[(row + 1) * 3072 + col]) * cw[2 * 3072 + col];
        val[q] = a;
      }
      x0c[row * 1024 + c] = f2bf(val[0]);
      tile[tl * 65 + cl] = val[1] * val[2];
    }
    __syncthreads();
    for (int i = tid; i < 4096; i += NT) {
      const int cl = i >> 6, tl = i & 63;
      uT[((long)seq * 1024 + ct * 64 + cl) * L + tt * 64 + tl] = tile[tl * 65 + cl];
    }
  }
  __syncthreads();
}

__device__ void phase_hy_fft(const Params& P, int slab) {
  const int L = Lof(slab), N = 2 * L, nseq = SLAB / L, tid = TID();
  float* uT = (float*)(WS(P) + O_UT);
  const float2* hsb = (const float2*)(WS(P) + (slab == 0 ? O_HSPP : O_HSPS));
  const float2* tw = (const float2*)(WS(P) + O_TW);
  const float* skip = P.in[17];
  float2* buf = (float2*)smem;
  const int nitems = (nseq / 2) * 1024;
  for (int item = BID(); item < nitems; item += gridDim.x) {
    const int pr = item >> 10, c = item & 1023;
    float* u0 = uT + ((long)(pr * 2) * 1024 + c) * L;
    float* u1 = u0 + (long)1024 * L;
    __syncthreads();
    for (int t = tid; t < L; t += NT) {
      buf[t] = make_float2(u0[t], u1[t]);
      buf[t + L] = make_float2(0.f, 0.f);
    }
    __syncthreads();
    fft_dif(buf, N, tw);
    const float2* h = hsb + (long)c * N;
    for (int p = tid; p < N; p += NT) {
      float2 a = buf[p], b = h[p];
      buf[p] = make_float2(a.x * b.x - a.y * b.y, a.x * b.y + a.y * b.x);
    }
    __syncthreads();
    ifft_dit(buf, N, tw);
    const float sk = skip[c];
    for (int t = tid; t < L; t += NT) {
      float2 y = buf[t];
      u0[t] = y.x + u0[t] * sk;
      u1[t] = y.y + u1[t] * sk;
    }
  }
  __syncthreads();
}

__device__ void phase_hy_tr(const Params& P, int slab) {
  const int L = Lof(slab), nseq = SLAB / L, tid = TID();
  const float* yT = (const float*)(WS(P) + O_UT);
  const u16* x0c = (const u16*)(WS(P) + O_X0C);
  u16* a2 = (u16*)(WS(P) + O_A2);
  float* tile = (float*)smem;
  const int ntt = L / 64;
  const int nitems = nseq * ntt * 16;
  for (int item = BID(); item < nitems; item += gridDim.x) {
    const int ct = item % 16, tt = (item / 16) % ntt, seq = item / (16 * ntt);
    __syncthreads();
    for (int i = tid; i < 4096; i += NT) {
      const int cl = i >> 6, tl = i & 63;
      tile[cl * 65 + tl] = yT[((long)seq * 1024 + ct * 64 + cl) * L + tt * 64 + tl];
    }
    __syncthreads();
    for (int i = tid; i < 4096; i += NT) {
      const int tl = i >> 6, cl = i & 63;
      const long row = (long)seq * L + tt * 64 + tl;
      const int c = ct * 64 + cl;
      a2[row * 1024 + c] = f2bf(tile[cl * 65 + tl] * bf2f(x0c[row * 1024 + c]));
    }
  }
  __syncthreads();
}

struct Rec {
  int H, DK, DV, C;
  int ldv, voff, goff;
};
__device__ __forceinline__ Rec rec_of(int kind) {
  Rec r;
  if (kind == 1) { r.H = 4; r.DK = 256; r.DV = 512; r.C = 128; r.ldv = 6144; r.voff = 2048; r.goff = 4096; }
  else { r.H = 8; r.DK = 128; r.DV = 128; r.C = 64; r.ldv = 5120; r.voff = 1024; r.goff = 4096; }
  return r;
}

__device__ void phase_ret_prep(const Params& P, int slab) {
  const int L = Lof(slab);
  const u16* pj = (const u16*)(WS(P) + O_PROJ);
  u16* qdf = (u16*)(WS(P) + O_QDF); u16* qdb = (u16*)(WS(P) + O_QDB);
  u16* kif = (u16*)(WS(P) + O_KIF); u16* kib = (u16*)(WS(P) + O_KIB);
  u16* kef = (u16*)(WS(P) + O_KEF); u16* keb = (u16*)(WS(P) + O_KEB);
  float* dlf = (float*)(WS(P) + O_DLF); float* dlb = (float*)(WS(P) + O_DLB);
  const float2* rope = (const float2*)(WS(P) + O_ROPER);
  const long gtid = (long)BID() * NT + TID(), gsz = (long)gridDim.x * NT;
  for (long idx = gtid; idx < (long)SLAB * 512; idx += gsz) {
    const int d = (int)(idx & 127), h = (int)((idx >> 7) & 3), t = (int)(idx >> 9);
    const int pos = t & (L - 1), r = t & 127;
    const float lgf = -expf(P.in[20][h]), lgb = -expf(P.in[20][4 + h]);
    const u16* row = pj + (long)t * 6144;
    const float q1 = bf2f(row[h * 256 + d]), q2 = bf2f(row[h * 256 + d + 128]);
    const float k1 = bf2f(row[1024 + h * 256 + d]), k2 = bf2f(row[1024 + h * 256 + d + 128]);
    const float2 cs = rope[(long)pos * 128 + d];
    const float qa = q1 * cs.x - q2 * cs.y, qb = q1 * cs.y + q2 * cs.x;
    const float ka = (k1 * cs.x - k2 * cs.y) * 0.0625f, kb = (k1 * cs.y + k2 * cs.x) * 0.0625f;
    const float bf = (float)(r + 1) * lgf, bb = (float)(128 - r) * lgb;
    const float ef = expf(bf), eif = expf(-bf), eef = expf((float)(127 - r) * lgf);
    const float eb = expf(bb), eib = expf(-bb), eeb = expf((float)r * lgb);
    const long o1 = (long)t * 1024 + h * 256 + d, o2 = o1 + 128;
    qdf[o1] = f2bf(qa * ef); qdf[o2] = f2bf(qb * ef);
    qdb[o1] = f2bf(qa * eb); qdb[o2] = f2bf(qb * eb);
    kif[o1] = f2bf(ka * eif); kif[o2] = f2bf(kb * eif);
    kib[o1] = f2bf(ka * eib); kib[o2] = f2bf(kb * eib);
    kef[o1] = f2bf(ka * eef); kef[o2] = f2bf(kb * eef);
    keb[o1] = f2bf(ka * eeb); keb[o2] = f2bf(kb * eeb);
    if (r == 0) {
      const long cgi = (long)(t >> 7) * 1024 + h * 256 + d;
      const float df = expf(128.f * lgf), db = expf(128.f * lgb);
      dlf[cgi] = df; dlf[cgi + 128] = df;
      dlb[cgi] = db; dlb[cgi + 128] = db;
    }
  }
}

__device__ void phase_hg_prep(const Params& P) {
  const u16* pj = (const u16*)(WS(P) + O_PROJ);
  u16* qdf = (u16*)(WS(P) + O_QDF); u16* qdb = (u16*)(WS(P) + O_QDB);
  u16* kif = (u16*)(WS(P) + O_KIF); u16* kib = (u16*)(WS(P) + O_KIB);
  u16* kef = (u16*)(WS(P) + O_KEF); u16* keb = (u16*)(WS(P) + O_KEB);
  float* dlf = (float*)(WS(P) + O_DLF); float* dlb = (float*)(WS(P) + O_DLB);
  const float* lbt = P.in[28];
  for (int item = BID(); item < 512; item += gridDim.x) {
    const int cgi = item >> 1, ch = (item & 1) * 512 + TID();
    float lb[2];
#pragma unroll
    for (int dr = 0; dr < 2; ++dr) {
      float a0 = lbt[(dr * 4 + 0) * 1024 + ch], a1 = lbt[(dr * 4 + 1) * 1024 + ch], a2 = lbt[(dr * 4 + 2) * 1024 + ch], a3 = lbt[(dr * 4 + 3) * 1024 + ch];
      float m = fmaxf(fmaxf(a0, a1), fmaxf(a2, a3));
      float e0 = expf(a0 - m), e1 = expf(a1 - m), e2 = expf(a2 - m), e3 = expf(a3 - m);
      lb[dr] = (e0 + e1 + e2) / (e0 + e1 + e2 + e3);
    }
    const long t0 = (long)cgi * 64;
    float totf = 0.f, totb = 0.f;
    for (int r = 0; r < 64; ++r) {
      const u16* row = pj + (t0 + r) * 5120;
      float xf = bf2f(row[2048 + ch]), xb = bf2f(row[3072 + ch]);
      totf += logf(lb[0] + (1.f - lb[0]) * sigm(xf));
      totb += logf(lb[1] + (1.f - lb[1]) * sigm(xb));
    }
    float b = 0.f;
    for (int r = 0; r < 64; ++r) {
      const u16* row = pj + (t0 + r) * 5120;
      const float q = silu_f(bf2f(row[ch]));
      const float xf = bf2f(row[2048 + ch]);
      b += logf(lb[0] + (1.f - lb[0]) * sigm(xf));
      const float k = (1.f - lb[0]) * sigm(-xf);
      const long o = (t0 + r) * 1024 + ch;
      qdf[o] = f2bf(q * expf(b));
      kif[o] = f2bf(k * expf(-b));
      kef[o] = f2bf(k * expf(totf - b));
    }
    b = 0.f;
    for (int r = 63; r >= 0; --r) {
      const u16* row = pj + (t0 + r) * 5120;
      const float q = silu_f(bf2f(row[ch]));
      const float xb = bf2f(row[3072 + ch]);
      b += logf(lb[1] + (1.f - lb[1]) * sigm(xb));
      const float k = (1.f - lb[1]) * sigm(-xb);
      const long o = (t0 + r) * 1024 + ch;
      qdb[o] = f2bf(q * expf(b));
      kib[o] = f2bf(k * expf(-b));
      keb[o] = f2bf(k * expf(totb - b));
    }
    dlf[(long)cgi * 1024 + ch] = expf(totf);
    dlb[(long)cgi * 1024 + ch] = expf(totb);
  }
}

template <int C>
__device__ __forceinline__ void rec_scores_item(const Params& P, const Rec& R, int cgi, int h) {
  const u16* qdf = (const u16*)(WS(P) + O_QDF); const u16* qdb = (const u16*)(WS(P) + O_QDB);
  const u16* kif = (const u16*)(WS(P) + O_KIF); const u16* kib = (const u16*)(WS(P) + O_KIB);
  u16* sc = (u16*)(WS(P) + O_SC) + ((long)cgi * R.H + h) * C * C;
  const long off = (long)cgi * C * 1024 + h * R.DK;
  f32x4 af[C / 32][C / 64] = {}, ab[C / 32][C / 64] = {};
  gemm_acc<C, C, true, true>(af, qdf + off, 1024, kif + off, 1024, R.DK, (u16*)smem);
  gemm_acc<C, C, true, true>(ab, qdb + off, 1024, kib + off, 1024, R.DK, (u16*)smem);
  const int tid = TID(), lane = tid & 63, wid = tid >> 6;
  const int wm = wid >> 2, wn = wid & 3, fr = lane & 15, fq = lane >> 4;
#pragma unroll
  for (int mi = 0; mi < C / 32; ++mi)
#pragma unroll
    for (int ni = 0; ni < C / 64; ++ni)
#pragma unroll
      for (int j = 0; j < 4; ++j) {
        const int r = wm * (C / 2) + mi * 16 + fq * 4 + j, c = wn * (C / 4) + ni * 16 + fr;
        float v = (c <= r ? af[mi][ni][j] : 0.f) + (c >= r ? ab[mi][ni][j] : 0.f);
        sc[r * C + c] = f2bf(v);
      }
}

template <int C>
__device__ void phase_rec_su(const Params& P, int kind) {
  const Rec R = rec_of(kind);
  const int nch = SLAB / C;
  const int n_sc = nch * R.H;
  const int mtn = R.DK / 128, ntn = R.DV / 128;
  const int n_u = nch * R.H * 2 * mtn * ntn;
  const u16* pj = (const u16*)(WS(P) + O_PROJ);
  for (int item = BID(); item < n_sc + n_u; item += gridDim.x) {
    if (item < n_sc) {
      rec_scores_item<C>(P, R, item / R.H, item % R.H);
    } else {
      int q = item - n_sc;
      const int nt = q % ntn; q /= ntn;
      const int mt = q % mtn; q /= mtn;
      const int dir = q & 1; q >>= 1;
      const int h = q % R.H, cgi = q / R.H;
      const u16* ke = (const u16*)(WS(P) + (dir ? O_KEB : O_KEF)) + (long)cgi * C * 1024 + h * R.DK + mt * 128;
      const u16* v = pj + (long)cgi * C * R.ldv + R.voff + h * R.DV + nt * 128;
      u16* st = (u16*)(WS(P) + (dir ? O_STB : O_STF)) + (((long)cgi * R.H + h) * R.DV + nt * 128) * R.DK + mt * 128;
      f32x4 acc[4][2] = {};
      gemm_acc<128, 128, false, false>(acc, ke, 1024, v, R.ldv, C, (u16*)smem);
      const int DK = R.DK;
      epi_each<128, 128>(acc, [&](int r, int c, float val) { st[(long)c * DK + r] = f2bf(val); });
    }
  }
}

__device__ void phase_rec_scan(const Params& P, int kind, int slab) {
  const Rec R = rec_of(kind);
  const int L = Lof(slab), nseq = SLAB / L, ncs = L / R.C;
  const int hdk = R.DK / 2;
  const long per = (long)R.H * R.DV * hdk;
  const long total = 2 * nseq * per;
  const long gtid = (long)BID() * NT + TID(), gsz = (long)gridDim.x * NT;
  for (long idx = gtid; idx < total; idx += gsz) {
    long q = idx;
    const int pd = (int)(q % hdk); q /= hdk;
    const int e = (int)(q % R.DV); q /= R.DV;
    const int h = (int)(q % R.H); q /= R.H;
    const int seq = (int)(q % nseq);
    const int dir = (int)(q / nseq);
    u16* st = (u16*)(WS(P) + (dir ? O_STB : O_STF));
    const float* dl = (const float*)(WS(P) + (dir ? O_DLB : O_DLF));
    float s0 = 0.f, s1 = 0.f;
    for (int i = 0; i < ncs; ++i) {
      const int n = dir ? (ncs - 1 - i) : i;
      const long cgi = (long)seq * ncs + n;
      unsigned* p = (unsigned*)(st + ((cgi * R.H + h) * R.DV + e) * R.DK + pd * 2);
      const unsigned u = *p;
      *p = pack2(s0, s1);
      const float2 dd = *(const float2*)(dl + cgi * 1024 + h * R.DK + pd * 2);
      s0 = dd.x * s0 + bf2f((u16)(u & 0xffff));
      s1 = dd.y * s1 + bf2f((u16)(u >> 16));
    }
  }
}

template <int C>
__device__ void phase_rec_out(const Params& P, int kind) {
  const Rec R = rec_of(kind);
  const int nch = SLAB / C, ntn = R.DV / 128;
  const u16* pj = (const u16*)(WS(P) + O_PROJ);
  float* ob = (float*)(WS(P) + O_OBUF);
  const int HDV = R.H * R.DV;
  for (int item = BID(); item < nch * R.H * ntn; item += gridDim.x) {
    const int nt = item % ntn, h = (item / ntn) % R.H, cgi = item / (ntn * R.H);
    f32x4 acc[C / 32][2] = {};
    const u16* sc = (const u16*)(WS(P) + O_SC) + ((long)cgi * R.H + h) * C * C;
    const u16* v = pj + (long)cgi * C * R.ldv + R.voff + h * R.DV + nt * 128;
    gemm_acc<C, 128, true, false>(acc, sc, C, v, R.ldv, C, (u16*)smem);
    const long qoff = (long)cgi * C * 1024 + h * R.DK;
    const long soff = (((long)cgi * R.H + h) * R.DV + nt * 128) * R.DK;
    gemm_acc<C, 128, true, true>(acc, (const u16*)(WS(P) + O_QDF) + qoff, 1024, (const u16*)(WS(P) + O_STF) + soff, R.DK, R.DK, (u16*)smem);
    gemm_acc<C, 128, true, true>(acc, (const u16*)(WS(P) + O_QDB) + qoff, 1024, (const u16*)(WS(P) + O_STB) + soff, R.DK, R.DK, (u16*)smem);
    float* o = ob + (long)cgi * C * HDV + h * R.DV + nt * 128;
    epi_each<C, 128>(acc, [&](int r, int c, float val) { o[(long)r * HDV + c] = val; });
  }
}

__device__ void phase_rec_ng(const Params& P, int kind) {
  const Rec R = rec_of(kind);
  const int HDV = R.H * R.DV;
  const float* ob = (const float*)(WS(P) + O_OBUF);
  const u16* pj = (const u16*)(WS(P) + O_PROJ);
  u16* a2 = (u16*)(WS(P) + O_A2);
  const float* gain = (kind == 3) ? P.in[29] : nullptr;
  const int tid = TID(), lane = tid & 63, wid = tid >> 6;
  const int nrows = SLAB * R.H;
  const int per = R.DV / 64;
  for (int item = BID(); item < nrows / 8; item += gridDim.x) {
    const int rh = item * 8 + wid;
    const int t = rh / R.H, h = rh % R.H;
    const float* o = ob + (long)t * HDV + h * R.DV + lane * per;
    float ss = 0.f;
    for (int i = 0; i < per; ++i) { float v = o[i]; ss += v * v; }
    ss = wave_sum(ss);
    const float rstd = rsqrtf(ss / (float)R.DV + 1e-6f);
    const u16* g = pj + (long)t * R.ldv + R.goff + h * R.DV + lane * per;
    u16* out = a2 + (long)t * HDV + h * R.DV + lane * per;
    for (int i = 0; i < per; ++i) {
      float y = o[i] * rstd;
      if (gain) y *= gain[lane * per + i];
      out[i] = f2bf(y * silu_f(bf2f(g[i])));
    }
  }
}

__device__ void phase_swa_prep(const Params& P, int slab) {
  const int L = Lof(slab);
  const u16* pj = (const u16*)(WS(P) + O_PROJ);
  u16* qn = (u16*)(WS(P) + O_QN);
  u16* kn = (u16*)(WS(P) + O_KN);
  const float2* rope = (const float2*)(WS(P) + O_ROPES);
  const long gtid = (long)BID() * NT + TID(), gsz = (long)gridDim.x * NT;
  for (long idx = gtid; idx < (long)SLAB * 640; idx += gsz) {
    const int d = (int)(idx & 31);
    const int hd = (int)((idx >> 5) % 20);
    const int t = (int)(idx / 640);
    const int col = hd < 16 ? hd * 64 : 1024 + (hd - 16) * 64;
    const float x1 = bf2f(pj[(long)t * 1536 + col + d]), x2 = bf2f(pj[(long)t * 1536 + col + d + 32]);
    float ss = x1 * x1 + x2 * x2;
#pragma unroll
    for (int o = 16; o; o >>= 1) ss += __shfl_xor(ss, o);
    const float rstd = rsqrtf(ss * (1.f / 64.f) + 1e-6f);
    const float* gn = hd < 16 ? P.in[23] : P.in[24];
    const float y1 = x1 * rstd * gn[d], y2 = x2 * rstd * gn[d + 32];
    const float2 cs = rope[(long)(t & (L - 1)) * 32 + d];
    float o1 = y1 * cs.x - y2 * cs.y, o2 = y1 * cs.y + y2 * cs.x;
    if (hd < 16) {
      qn[(long)t * 1024 + hd * 64 + d] = f2bf(o1 * 0.125f);
      qn[(long)t * 1024 + hd * 64 + d + 32] = f2bf(o2 * 0.125f);
    } else {
      kn[(long)t * 256 + (hd - 16) * 64 + d] = f2bf(o1);
      kn[(long)t * 256 + (hd - 16) * 64 + d + 32] = f2bf(o2);
    }
  }
}

constexpr int SLD = 324;
__device__ void phase_swa_att1(const Params& P, int slab) {
  const int L = Lof(slab), nqb = L / 64;
  const u16* qn = (const u16*)(WS(P) + O_QN);
  const u16* kn = (const u16*)(WS(P) + O_KN);
  u16* pb = (u16*)(WS(P) + O_PBUF);
  const float* sink = P.in[25];
  float* S = (float*)(smem + 24576);
  const int tid = TID();
  const int nitems = (SLAB / 64) * 16;
  for (int item = BID(); item < nitems; item += gridDim.x) {
    const int hq = item & 15, qbg = item >> 4;
    const int seq = qbg / nqb, qb = qbg % nqb;
    const int q0 = qb * 64;
    const long tok0 = (long)seq * L;
    const int hkv = hq >> 2;
    for (int kt = 0; kt < 5; ++kt) {
      const int kp0 = q0 - 128 + kt * 64;
      if (kp0 >= 0 && kp0 < L) {
        f32x4 acc[2][1] = {};
        gemm_acc<64, 64, true, true>(acc, qn + (tok0 + q0) * 1024 + hq * 64, 1024, kn + (tok0 + kp0) * 256 + hkv * 64, 256, 64, (u16*)smem);
        epi_each<64, 64>(acc, [&](int r, int c, float v) {
          const int dlt = (q0 + r) - (kp0 + c);
          S[r * SLD + kt * 64 + c] = (dlt <= 128 && dlt >= -128) ? v : -1e30f;
        });
      } else {
        for (int i = tid; i < 4096; i += NT) S[(i >> 6) * SLD + kt * 64 + (i & 63)] = -1e30f;
      }
    }
    __syncthreads();
    {
      const int r = tid >> 3, sub = tid & 7;
      const float sk = sink[hq];
      float m = sk;
      for (int c = sub; c < 320; c += 8) m = fmaxf(m, S[r * SLD + c]);
      m = fmaxf(m, __shfl_xor(m, 1)); m = fmaxf(m, __shfl_xor(m, 2)); m = fmaxf(m, __shfl_xor(m, 4));
      float den = 0.f;
      for (int c = sub; c < 320; c += 8) { float e = __expf(S[r * SLD + c] - m); S[r * SLD + c] = e; den += e; }
      den += __shfl_xor(den, 1); den += __shfl_xor(den, 2); den += __shfl_xor(den, 4);
      den += __expf(sk - m);
      const float inv = 1.f / den;
      u16* prow = pb + ((long)item * 64 + r) * 320;
      for (int c = sub; c < 320; c += 8) prow[c] = f2bf(S[r * SLD + c] * inv);
    }
    __syncthreads();
  }
}

__device__ void phase_swa_att2(const Params& P, int slab) {
  const int L = Lof(slab), nqb = L / 64;
  const u16* pj = (const u16*)(WS(P) + O_PROJ);
  const u16* pb = (const u16*)(WS(P) + O_PBUF);
  u16* a2 = (u16*)(WS(P) + O_A2);
  const int nitems = (SLAB / 64) * 16;
  for (int item = BID(); item < nitems; item += gridDim.x) {
    const int hq = item & 15, qbg = item >> 4;
    const int seq = qbg / nqb, qb = qbg % nqb;
    const int q0 = qb * 64;
    const long tok0 = (long)seq * L;
    const int hkv = hq >> 2;
    f32x4 acc[2][1] = {};
    for (int kt = 0; kt < 5; ++kt) {
      const int kp0 = q0 - 128 + kt * 64;
      if (kp0 >= 0 && kp0 < L)
        gemm_acc<64, 64, true, false>(acc, pb + (long)item * 64 * 320 + kt * 64, 320, pj + (tok0 + kp0) * 1536 + 1280 + hkv * 64, 1536, 64, (u16*)smem);
    }
    u16* o = a2 + (tok0 + q0) * 1024 + hq * 64;
    epi_each<64, 64>(acc, [&](int r, int c, float v) { o[(long)r * 1024 + c] = f2bf(v); });
  }
}

__device__ __forceinline__ int nsteps_of(int kind) { return (kind & 1) ? 12 : 10; }

__device__ void layer_step(const Params& P, int layer, int slab, int step) {
  const int kind = layer;
  const int nmix = nsteps_of(kind) - 4;
  if (step == 0) { phase_norm(P, layer, slab, 0); return; }
  if (step >= nmix) {
    const int f = step - nmix;
    if (f == 0) phase_norm(P, layer, slab, 1);
    else if (f == 1) phase_ffn_gate(P, layer);
    else if (f == 2) phase_ffn_val(P, layer, slab);
    else phase_resid(P, layer, slab, (const u16*)(WS(P) + O_ACT), DFF, O_WFD + (size_t)layer * SZW(1024, 2816), 5 * D);
    return;
  }
  if (kind == 0) {
    if (step == 1) phase_proj(P, O_WHYIN, 3072);
    else if (step == 2) phase_hy_conv(P, slab);
    else if (step == 3) phase_hy_fft(P, slab);
    else if (step == 4) phase_hy_tr(P, slab);
    else phase_resid(P, layer, slab, (const u16*)(WS(P) + O_A2), 1024, O_WHYOUT, 2 * D);
  } else if (kind == 1) {
    if (step == 1) phase_proj(P, O_WRETIN, 6144);
    else if (step == 2) phase_ret_prep(P, slab);
    else if (step == 3) phase_rec_su<128>(P, 1);
    else if (step == 4) phase_rec_scan(P, 1, slab);
    else if (step == 5) phase_rec_out<128>(P, 1);
    else if (step == 6) phase_rec_ng(P, 1);
    else phase_resid(P, layer, slab, (const u16*)(WS(P) + O_A2), 2048, O_WRETOUT, 2 * D);
  } else if (kind == 2) {
    if (step == 1) phase_proj(P, O_WSWAIN, 1536);
    else if (step == 2) phase_swa_prep(P, slab);
    else if (step == 3) phase_swa_att1(P, slab);
    else if (step == 4) phase_swa_att2(P, slab);
    else phase_resid(P, layer, slab, (const u16*)(WS(P) + O_A2), 1024, O_WSWAOUT, 2 * D);
  } else {
    if (step == 1) phase_proj(P, O_WHGIN, 5120);
    else if (step == 2) phase_hg_prep(P);
    else if (step == 3) phase_rec_su<64>(P, 3);
    else if (step == 4) phase_rec_scan(P, 3, slab);
    else if (step == 5) phase_rec_out<64>(P, 3);
    else if (step == 6) phase_rec_ng(P, 3);
    else phase_resid(P, layer, slab, (const u16*)(WS(P) + O_A2), 1024, O_WHGOUT, 2 * D);
  }
}

__global__ void __launch_bounds__(NT) fwd_megakernel(Params P) {
  cg::grid_group grid = cg::this_grid();
  for (int pid = P.p0; pid < P.p1; ++pid) {
    if (pid == 0) phase_pre0(P);
    else if (pid == 1) phase_pre1(P);
    else {
      int q = pid - 2, layer = 0;
      while (q >= 5 * nsteps_of(layer)) { q -= 5 * nsteps_of(layer); ++layer; }
      const int ns = nsteps_of(layer);
      layer_step(P, layer, q / ns, q % ns);
    }
    if (pid + 1 < P.p1) grid.sync();
  }
}

extern "C" void kernel_launch(void* const* d_in, const int* in_sizes, int n_in, void* d_out, int out_size, void* d_ws,
                              size_t ws_size, hipStream_t stream) {
  static int grid_blocks = 0;
  if (!grid_blocks) {
    int dev = 0, cus = 0, per_cu = 0;
    (void)hipGetDevice(&dev);
    (void)hipDeviceGetAttribute(&cus, hipDeviceAttributeMultiprocessorCount, dev);
    (void)hipFuncSetAttribute((const void*)fwd_megakernel, hipFuncAttributeMaxDynamicSharedMemorySize, LDSB);
    (void)hipOccupancyMaxActiveBlocksPerMultiprocessor(&per_cu, (const void*)fwd_megakernel, NT, LDSB);
    if (per_cu < 1) per_cu = 1;
    if (per_cu > 1) per_cu = 1;
    grid_blocks = cus * per_cu;
    if (ws_size < WS_END) fprintf(stderr, "kernel_launch: workspace too small: %zu < %zu\n", ws_size, (size_t)WS_END);
  }
  Params p;
  memset(&p, 0, sizeof(p));
  for (int i = 0; i < 36; ++i) p.in[i] = (const float*)d_in[i];
  p.out = (float*)d_out;
  p.ws = (unsigned char*)d_ws;
#if ONE_LAUNCH
  p.p0 = 0; p.p1 = NPHASES;
  void* args[] = {&p};
  hipError_t e = hipLaunchCooperativeKernel((const void*)fwd_megakernel, dim3(grid_blocks), dim3(NT), args, LDSB, stream);
  if (e != hipSuccess) fprintf(stderr, "cooperative launch failed: %s (grid %d)\n", hipGetErrorString(e), grid_blocks);
#else
  for (int ph = 0; ph < NPHASES; ++ph) {
    p.p0 = ph; p.p1 = ph + 1;
    hipLaunchKernelGGL(fwd_megakernel, dim3(grid_blocks), dim3(NT), LDSB, stream, p);
  }
#endif
}
```

```cpp
#include <hip/hip_runtime.h>
#include <hip/hip_cooperative_groups.h>
#include <cstdio>
#include <cstdint>
#include <cstring>
namespace cg = cooperative_groups;

typedef unsigned short u16;
typedef __attribute__((ext_vector_type(8))) short bf16x8;
typedef __attribute__((ext_vector_type(4))) float f32x4;

#define NT 512
#ifndef ONE_LAUNCH
#define ONE_LAUNCH 1
#endif

constexpr int D = 1024, SLAB = 16384, DFF = 2816;
constexpr int LDSB = 131072;
constexpr int NPHASES = 2 + 5 * (10 + 12 + 10 + 12);

constexpr size_t SZW(size_t n, size_t k) { return n * k * 2; }
constexpr size_t O_WHYIN = 0;
constexpr size_t O_WHYOUT = O_WHYIN + SZW(3072, 1024);
constexpr size_t O_WRETIN = O_WHYOUT + SZW(1024, 1024);
constexpr size_t O_WRETOUT = O_WRETIN + SZW(6144, 1024);
constexpr size_t O_WSWAIN = O_WRETOUT + SZW(1024, 2048);
constexpr size_t O_WSWAOUT = O_WSWAIN + SZW(1536, 1024);
constexpr size_t O_WHGIN = O_WSWAOUT + SZW(1024, 1024);
constexpr size_t O_WHGOUT = O_WHGIN + SZW(5120, 1024);
constexpr size_t O_WFG = O_WHGOUT + SZW(1024, 1024);
constexpr size_t O_WFV = O_WFG + 4 * SZW(2816, 1024);
constexpr size_t O_WFD = O_WFV + 4 * SZW(2816, 1024);
constexpr size_t O_MOD = O_WFD + 4 * SZW(1024, 2816);
constexpr size_t O_TW = O_MOD + (size_t)4 * 16 * 6144 * 4;
constexpr size_t O_HIDS = O_TW + 8192 * 8;
constexpr size_t O_HIDP = O_HIDS + (size_t)8192 * 64 * 4;
constexpr size_t O_ROPER = O_HIDP + (size_t)2048 * 64 * 4;
constexpr size_t O_ROPES = O_ROPER + (size_t)8192 * 128 * 8;
constexpr size_t O_PROJ = O_ROPES + (size_t)8192 * 32 * 8;
constexpr size_t O_HBUF = O_PROJ + (size_t)SLAB * 6144 * 2;
constexpr size_t O_A2 = O_HBUF + (size_t)SLAB * 1024 * 2;
constexpr size_t O_C = O_A2 + (size_t)SLAB * 2048 * 2;
constexpr size_t O_GBUF = O_C;
constexpr size_t O_ACT = O_GBUF + (size_t)SLAB * DFF * 2;
constexpr size_t O_MODP = O_C;
constexpr size_t O_HSPS = O_ACT + (size_t)SLAB * DFF * 2;
constexpr size_t O_HSPP = O_HSPS + (size_t)1024 * 16384 * 8;
constexpr size_t O_UT = O_HSPP + (size_t)1024 * 4096 * 8;
constexpr size_t O_X0C = O_UT + (size_t)SLAB * 1024 * 4;
constexpr size_t END_HY = O_X0C + (size_t)SLAB * 1024 * 2;
constexpr size_t SZP = (size_t)SLAB * 1024 * 2;
constexpr size_t O_QDF = O_C, O_QDB = O_QDF + SZP, O_KIF = O_QDB + SZP, O_KIB = O_KIF + SZP, O_KEF = O_KIB + SZP, O_KEB = O_KEF + SZP;
constexpr size_t O_DLF = O_KEB + SZP;
constexpr size_t O_DLB = O_DLF + (size_t)256 * 1024 * 4;
constexpr size_t O_SC = O_DLB + (size_t)256 * 1024 * 4;
constexpr size_t O_STF = O_SC + (size_t)SLAB * 512 * 2;
constexpr size_t O_STB = O_STF + (size_t)134217728;
constexpr size_t O_OBUF = O_STB + (size_t)134217728;
constexpr size_t END_REC = O_OBUF + (size_t)SLAB * 2048 * 4;
constexpr size_t O_QN = O_C;
constexpr size_t O_KN = O_QN + SZP;
constexpr size_t O_PBUF = O_KN + (size_t)SLAB * 256 * 2;
constexpr size_t END_SWA = O_PBUF + (size_t)SLAB * 16 * 320 * 2;
constexpr size_t WS_END = END_REC > END_HY ? (END_REC > END_SWA ? END_REC : END_SWA) : (END_HY > END_SWA ? END_HY : END_SWA);
static_assert(WS_END <= ((size_t)1 << 30), "workspace exceeds 1 GiB");

struct Params {
  const float* in[36];
  float* out;
  unsigned char* ws;
  int p0, p1;
};

extern __shared__ __attribute__((aligned(16))) unsigned char smem[];

__device__ __forceinline__ int TID() { int t = threadIdx.x; asm volatile("" : "+v"(t)); return t; }
__device__ __forceinline__ int BID() { int b = blockIdx.x; asm volatile("" : "+s"(b)); return b; }
__device__ __forceinline__ long ZOFF() { long z = 0; asm volatile("" : "+s"(z)); return z; }
__device__ __forceinline__ unsigned char* WS(const Params& P) { return P.ws + ZOFF(); }
__device__ __forceinline__ float* OUTP(const Params& P) { return P.out + ZOFF(); }

namespace pg8 {
#define PG8_LAS __attribute__((address_space(3)))
typedef unsigned short bf16_t;
typedef short bf16x8 __attribute__((ext_vector_type(8)));
typedef float f32x4 __attribute__((ext_vector_type(4)));
typedef unsigned u32x4 __attribute__((ext_vector_type(4)));
constexpr int BM = 256, BK = 64, HALF = 128, HTB = HALF * BK * 2  , STAGE_BYTES = 8 * HTB, NXCD = 8, WGM = 8;

__host__ __device__ __forceinline__ int lds_byte(int r, int c) { const int st = (r >> 4) * 2 + (c >> 5), rr = r & 15, cc = c & 31, ob = rr * 64 + cc * 2; return st * 1024 + (ob ^ (((ob >> 9) & 1) << 5)); }
__host__ __device__ __forceinline__ void stage_rc(int b, int& R, int& C) { const int st = b / 1024, sb = b % 1024, swz = sb ^ (((sb >> 9) & 1) << 5); R = (st >> 1) * 16 + swz / 64; C = (st & 1) * 32 + (swz % 64) / 2; }
__host__ __device__ __forceinline__ int perm32(int rho) { const int n = rho >> 4, i = rho & 15; return 8 * (i >> 2) + 4 * n + (i & 3); }

struct Unit { int pm, pn; };
struct Gemm { const bf16_t* A; const bf16_t* Bt; int M, N, K; };

struct StaticOrder {
    int nM, nN, nwg, G, c;
    __host__ __device__ void init(int M, int N, int G_, int c_) { nM = M / BM; nN = N / BM; nwg = nM * nN; G = G_; c = c_; }
    __host__ __device__ bool next(int i, Unit& u) const {
        const long L = (long)i * G + c; if (L >= nwg) return false;
        int wgid = (int)L; { const int q = nwg / NXCD, r = nwg % NXCD, xcd = wgid % NXCD, off = wgid / NXCD; wgid = (xcd < r ? xcd * (q + 1) : r * (q + 1) + (xcd - r) * q) + off; }
        const int nig = WGM * nN, gid = wgid / nig, fm = gid * WGM, gsz = (nM - fm) < WGM ? (nM - fm) : WGM;
        u.pm = fm + ((wgid % nig) % gsz); u.pn = (wgid % nig) / gsz; return true;
    }
    __device__ __forceinline__ void a_ready(const Unit&) const {}
    __device__ __forceinline__ void done(const Unit&) const {}
};

template <class Epi, class Sched, bool STAMP = false>
__device__ __forceinline__ void gemm_phase(PG8_LAS unsigned char* lds, const Gemm g, const Sched& S, const Epi& E, unsigned long long* stamps) {
    const int tid = TID(), wid = __builtin_amdgcn_readfirstlane(tid >> 6), lane = tid & 63, wr = wid >> 2, wc = wid & 3, fr = lane & 15, fq = lane >> 4;
    const int K = g.K, nt = K / BK;
    int ts_lo = 0, ts_hi = 0, nts = 0; const unsigned long long rt_entry = STAMP ? (unsigned long long)wall_clock64() : 0ull;
#define PG8_STAMP() do { if (STAMP && wid == 0 && nts < 64) { const unsigned long long _c = (unsigned long long)clock64(); \
        ts_lo = (lane == nts) ? (int)(unsigned)_c : ts_lo; ts_hi = (lane == nts) ? (int)(unsigned)(_c >> 32) : ts_hi; ++nts; } } while (0)
    PG8_STAMP();
    unsigned voffA[2], voffB[2];
#pragma unroll
    for (int i = 0; i < 2; ++i) { int R, C; stage_rc(tid * 16 + i * 8192, R, C); const int Rb = Epi::PERM ? ((R & ~31) + perm32(R & 31)) : R;
        voffA[i] = (unsigned)(R * K + C) * 2u; voffB[i] = (unsigned)(Rb * K + C) * 2u; }
    const size_t kstep = (size_t)(BK * 2);
    const size_t hstep = (size_t)HALF * K * 2;
    const size_t tstep = 2 * hstep;
    const unsigned ldsw = (unsigned)wid * 1024u;
    const int aoff = lds_byte(wr * 64 + fr, fq * 8), boff = lds_byte(wc * 32 + fr, fq * 8);
#define PG8_SA(b, h) (((b) * 2 + (h)) * HTB)
#define PG8_SB(b, h) ((4 + (b) * 2 + (h)) * HTB)
#define PG8_STAGE(bufoff, gbase, voff) do { _Pragma("unroll") for (int _i = 0; _i < 2; ++_i) \
        __builtin_amdgcn_global_load_lds((const unsigned*)((const char*)(gbase) + (voff)[_i]), (PG8_LAS unsigned*)(lds + (bufoff) + ldsw + _i * 8192), 16, 0, 0); } while (0)
#define PG8_LDA(dst, b, h) do { _Pragma("unroll") for (int m = 0; m < 4; ++m) _Pragma("unroll") for (int k = 0; k < 2; ++k) dst[m][k] = *(const PG8_LAS bf16x8*)(lds + PG8_SA(b, h) + aoff + m * 2048 + k * 1024); } while (0)
#define PG8_LDB(dst, b, h) do { _Pragma("unroll") for (int n = 0; n < 2; ++n) _Pragma("unroll") for (int k = 0; k < 2; ++k) dst[n][k] = *(const PG8_LAS bf16x8*)(lds + PG8_SB(b, h) + boff + n * 2048 + k * 1024); } while (0)
#define PG8_MMA(ai, bj, At, Bt) do { __builtin_amdgcn_s_setprio(1); _Pragma("unroll") for (int m = 0; m < 4; ++m) _Pragma("unroll") for (int n = 0; n < 2; ++n) _Pragma("unroll") for (int k = 0; k < 2; ++k) \
        acc[ai][bj][m][n] = __builtin_amdgcn_mfma_f32_16x16x32_bf16(Bt[n][k], At[m][k], acc[ai][bj][m][n], 0, 0, 0); __builtin_amdgcn_s_setprio(0); } while (0)
#define PG8_WAIT_V(n) asm volatile("s_waitcnt vmcnt(" #n ")" ::: "memory")
#define PG8_WAIT_L(n) asm volatile("s_waitcnt lgkmcnt(" #n ")" ::: "memory")
#define PG8_BAR __builtin_amdgcn_s_barrier()
#define PG8_SCHED __builtin_amdgcn_sched_barrier(0)
    Unit cur, nxt; int ui = 0;
    if (!S.next(0, cur)) return;
    f32x4 acc[2][2][4][2];
#pragma unroll
    for (int a = 0; a < 2; ++a)
#pragma unroll
        for (int b = 0; b < 2; ++b)
#pragma unroll
            for (int m = 0; m < 4; ++m)
#pragma unroll
                for (int n = 0; n < 2; ++n) acc[a][b][m][n] = (f32x4){0.f, 0.f, 0.f, 0.f};
    bf16x8 At[4][2], B0[2][2], B1[2][2];
    const char* cA = (const char*)g.A + (size_t)cur.pm * tstep; const char* cB = (const char*)g.Bt + (size_t)cur.pn * tstep;
    S.a_ready(cur);
    PG8_STAGE(PG8_SB(0, 0), cB, voffB); PG8_STAGE(PG8_SA(0, 0), cA, voffA); PG8_STAGE(PG8_SB(0, 1), cB + hstep, voffB); PG8_STAGE(PG8_SA(0, 1), cA + hstep, voffA);
    if (wr == 1) PG8_BAR;
    PG8_WAIT_V(4); PG8_BAR;
    PG8_STAGE(PG8_SB(1, 0), cB + kstep, voffB); PG8_STAGE(PG8_SA(1, 0), cA + kstep, voffA); PG8_STAGE(PG8_SB(1, 1), cB + hstep + kstep, voffB);
    PG8_WAIT_V(6); PG8_BAR;
    PG8_STAMP();
    for (;;) {
        const bool has_next = S.next(ui + 1, nxt);
        const char* nA = has_next ? (const char*)g.A + (size_t)nxt.pm * tstep : cA; const char* nB = has_next ? (const char*)g.Bt + (size_t)nxt.pn * tstep : cB;
        for (int t = 0; t < nt; t += 2) {
            const bool last = (t == nt - 2);
            const char* a1 = cA + (size_t)(t + 1) * kstep;
            const char* a2 = last ? nA : cA + (size_t)(t + 2) * kstep; const char* b2 = last ? nB : cB + (size_t)(t + 2) * kstep;
            const char* a3 = a2 + kstep; const char* b3 = b2 + kstep;
            if (last && has_next) S.a_ready(nxt);
            PG8_LDB(B0, 0, 0); PG8_SCHED; PG8_LDA(At, 0, 0); PG8_STAGE(PG8_SA(1, 1), a1 + hstep, voffA);
            PG8_WAIT_L(8); PG8_BAR; PG8_WAIT_L(0); PG8_MMA(0, 0, At, B0); PG8_BAR; PG8_SCHED;
            PG8_LDB(B1, 0, 1); PG8_STAGE(PG8_SB(0, 0), b2, voffB);
            PG8_BAR; PG8_WAIT_L(0); PG8_MMA(0, 1, At, B1); PG8_BAR;
            PG8_LDA(At, 0, 1); PG8_STAGE(PG8_SA(0, 0), a2, voffA);
            PG8_BAR; PG8_WAIT_L(0); PG8_MMA(1, 0, At, B0); PG8_BAR; PG8_SCHED;
            PG8_STAGE(PG8_SB(0, 1), b2 + hstep, voffB);
            PG8_WAIT_V(6); PG8_BAR; PG8_MMA(1, 1, At, B1); PG8_BAR;
            PG8_LDB(B0, 1, 0); PG8_SCHED; PG8_LDA(At, 1, 0); PG8_STAGE(PG8_SA(0, 1), a2 + hstep, voffA);
            PG8_WAIT_L(8); PG8_BAR; PG8_WAIT_L(0); PG8_MMA(0, 0, At, B0); PG8_BAR; PG8_SCHED;
            PG8_LDB(B1, 1, 1); PG8_STAGE(PG8_SB(1, 0), b3, voffB);
            PG8_BAR; PG8_WAIT_L(0); PG8_MMA(0, 1, At, B1); PG8_BAR;
            PG8_LDA(At, 1, 1); PG8_STAGE(PG8_SA(1, 0), a3, voffA);
            PG8_BAR; PG8_WAIT_L(0); PG8_MMA(1, 0, At, B0); PG8_BAR; PG8_SCHED;
            PG8_STAGE(PG8_SB(1, 1), b3 + hstep, voffB);
            PG8_WAIT_V(6); PG8_BAR; PG8_MMA(1, 1, At, B1); PG8_BAR;
        }
        PG8_STAMP();
        if constexpr (!Epi::AFTER_DRAIN) { E(acc, cur, wr, wc, fr, fq); S.done(cur); }
        PG8_STAMP();
        if (!has_next) break;
#pragma unroll
        for (int a = 0; a < 2; ++a)
#pragma unroll
            for (int b = 0; b < 2; ++b)
#pragma unroll
                for (int m = 0; m < 4; ++m)
#pragma unroll
                    for (int n = 0; n < 2; ++n) acc[a][b][m][n] = (f32x4){0.f, 0.f, 0.f, 0.f};
        cur = nxt; cA = nA; cB = nB; ++ui;
    }
    PG8_WAIT_V(0);
    if (wr == 0) PG8_BAR;
    PG8_BAR;
    if constexpr (Epi::AFTER_DRAIN) { E.fused(acc, cur, wr, wc, fr, fq, lds, wid, lane); S.done(cur); }
    PG8_STAMP();
    if (STAMP && wid == 0) { stamps[lane] = lane < nts ? (((unsigned long long)(unsigned)ts_hi << 32) | (unsigned)ts_lo) : 0ull;
        if (lane == 62) stamps[62] = rt_entry; if (lane == 63) stamps[63] = (unsigned long long)wall_clock64(); }
#undef PG8_STAMP
#undef PG8_SA
#undef PG8_SB
#undef PG8_STAGE
#undef PG8_LDA
#undef PG8_LDB
#undef PG8_MMA
#undef PG8_WAIT_V
#undef PG8_WAIT_L
#undef PG8_BAR
#undef PG8_SCHED
}
}


__device__ __forceinline__ u16 f2bf(float f) {
  unsigned u = __float_as_uint(f);
  u += 0x7fffu + ((u >> 16) & 1u);
  return (u16)(u >> 16);
}
__device__ __forceinline__ float bf2f(u16 h) { return __uint_as_float(((unsigned)h) << 16); }
__device__ __forceinline__ unsigned pack2(float a, float b) { return (unsigned)f2bf(a) | ((unsigned)f2bf(b) << 16); }
__device__ __forceinline__ float silu_f(float x) { return x / (1.f + __expf(-x)); }
__device__ __forceinline__ float sigm(float x) { return 1.f / (1.f + __expf(-x)); }
__device__ __forceinline__ float wave_sum(float v) {
#pragma unroll
  for (int o = 32; o; o >>= 1) v += __shfl_xor(v, o);
  return v;
}
__device__ __forceinline__ int Lof(int slab) { return slab == 0 ? 2048 : 8192; }
__device__ __forceinline__ int gb_of(int slab, int r) { return slab == 0 ? (r >> 11) : (8 + (slab - 1) * 2 + (r >> 13)); }

constexpr int LDS_LD = 40;
template <int R, bool KC>
__device__ __forceinline__ uint4 ld_tile(const u16* __restrict__ base, long ld, int k0, int tid) {
  uint4 v = make_uint4(0, 0, 0, 0);
  if (tid < R * 4) {
    if (KC) {
      int r = tid >> 2, kc = tid & 3;
      v = *(const uint4*)(base + (long)r * ld + k0 + kc * 8);
    } else {
      int k = tid / (R / 8), mc = tid % (R / 8);
      v = *(const uint4*)(base + (long)(k0 + k) * ld + mc * 8);
    }
  }
  return v;
}
template <int R, bool KC>
__device__ __forceinline__ void st_tile(u16* s, uint4 v, int tid) {
  if (tid < R * 4) {
    if (KC) {
      int r = tid >> 2, kc = tid & 3;
      *(uint4*)(s + r * LDS_LD + kc * 8) = v;
    } else {
      int k = tid / (R / 8), mc = tid % (R / 8);
      u16* p = s + (mc * 8) * LDS_LD + k;
      p[0 * LDS_LD] = (u16)(v.x & 0xffff); p[1 * LDS_LD] = (u16)(v.x >> 16);
      p[2 * LDS_LD] = (u16)(v.y & 0xffff); p[3 * LDS_LD] = (u16)(v.y >> 16);
      p[4 * LDS_LD] = (u16)(v.z & 0xffff); p[5 * LDS_LD] = (u16)(v.z >> 16);
      p[6 * LDS_LD] = (u16)(v.w & 0xffff); p[7 * LDS_LD] = (u16)(v.w >> 16);
    }
  }
}

template <int TM, int TN, bool AKC, bool BKC>
__device__ __forceinline__ void gemm_acc(f32x4 (&acc)[TM / 32][TN / 64], const u16* __restrict__ A, long lda,
                                         const u16* __restrict__ B, long ldb, int K, u16* sm) {
  u16* As = sm;
  u16* Bs = sm + 128 * LDS_LD;
  const int tid = TID(), lane = tid & 63, wid = tid >> 6;
  const int wm = wid >> 2, wn = wid & 3, fr = lane & 15, fq = lane >> 4;
  constexpr int MI = TM / 32, NI = TN / 64;
  uint4 ra = ld_tile<TM, AKC>(A, lda, 0, tid), rb = ld_tile<TN, BKC>(B, ldb, 0, tid);
  for (int k0 = 0; k0 < K; k0 += 32) {
    __syncthreads();
    st_tile<TM, AKC>(As, ra, tid);
    st_tile<TN, BKC>(Bs, rb, tid);
    __syncthreads();
    if (k0 + 32 < K) {
      ra = ld_tile<TM, AKC>(A, lda, k0 + 32, tid);
      rb = ld_tile<TN, BKC>(B, ldb, k0 + 32, tid);
    }
    bf16x8 af[MI], bfr[NI];
#pragma unroll
    for (int mi = 0; mi < MI; ++mi) af[mi] = *(const bf16x8*)(As + (wm * (TM / 2) + mi * 16 + fr) * LDS_LD + fq * 8);
#pragma unroll
    for (int ni = 0; ni < NI; ++ni) bfr[ni] = *(const bf16x8*)(Bs + (wn * (TN / 4) + ni * 16 + fr) * LDS_LD + fq * 8);
#pragma unroll
    for (int mi = 0; mi < MI; ++mi)
#pragma unroll
      for (int ni = 0; ni < NI; ++ni)
        acc[mi][ni] = __builtin_amdgcn_mfma_f32_16x16x32_bf16(af[mi], bfr[ni], acc[mi][ni], 0, 0, 0);
  }
  __syncthreads();
}

template <int TM, int TN, class F>
__device__ __forceinline__ void epi_each(f32x4 (&acc)[TM / 32][TN / 64], F f) {
  const int tid = TID(), lane = tid & 63, wid = tid >> 6;
  const int wm = wid >> 2, wn = wid & 3, fr = lane & 15, fq = lane >> 4;
#pragma unroll
  for (int mi = 0; mi < TM / 32; ++mi)
#pragma unroll
    for (int ni = 0; ni < TN / 64; ++ni)
#pragma unroll
      for (int j = 0; j < 4; ++j) f(wm * (TM / 2) + mi * 16 + fq * 4 + j, wn * (TN / 4) + ni * 16 + fr, acc[mi][ni][j]);
}


struct EpiStoreBf16 {
  static constexpr bool PERM = false, AFTER_DRAIN = false;
  u16* O; int ldc;
  __device__ __forceinline__ void operator()(const f32x4 (&acc)[2][2][4][2], const pg8::Unit& u, int wr, int wc, int fr, int fq) const {
    const int row0 = u.pm * 256 + wr * 64 + fr, col0 = u.pn * 256 + wc * 32 + 4 * fq;
#pragma unroll
    for (int ai = 0; ai < 2; ++ai)
#pragma unroll
      for (int m = 0; m < 4; ++m) {
        u16* rowp = O + (size_t)(row0 + ai * 128 + m * 16) * ldc + col0;
#pragma unroll
        for (int bj = 0; bj < 2; ++bj)
#pragma unroll
          for (int n = 0; n < 2; ++n) {
            const f32x4 v = acc[ai][bj][m][n];
            *(uint2*)(rowp + bj * 128 + n * 16) = make_uint2(pack2(v[0], v[1]), pack2(v[2], v[3]));
          }
      }
  }
};
struct EpiResid {
  static constexpr bool PERM = false, AFTER_DRAIN = false;
  float* X; const float* mod; int goff; int slab;
  __device__ __forceinline__ void operator()(const f32x4 (&acc)[2][2][4][2], const pg8::Unit& u, int wr, int wc, int fr, int fq) const {
    const int row0 = u.pm * 256 + wr * 64 + fr, col0 = u.pn * 256 + wc * 32 + 4 * fq;
#pragma unroll
    for (int ai = 0; ai < 2; ++ai)
#pragma unroll
      for (int m = 0; m < 4; ++m) {
        const int r = row0 + ai * 128 + m * 16;
        const float* g = mod + (size_t)gb_of(slab, r) * 6144 + goff + col0;
        float* xp = X + (size_t)r * D + col0;
#pragma unroll
        for (int bj = 0; bj < 2; ++bj)
#pragma unroll
          for (int n = 0; n < 2; ++n) {
            const f32x4 gv = *(const f32x4*)(g + bj * 128 + n * 16);
            f32x4 xv = *(const f32x4*)(xp + bj * 128 + n * 16);
            xv += gv * acc[ai][bj][m][n];
            *(f32x4*)(xp + bj * 128 + n * 16) = xv;
          }
      }
  }
};
struct EpiFfnVal {
  static constexpr bool PERM = false, AFTER_DRAIN = false;
  const u16* G; u16* ACT; const float* cw; const float* cb; int L;
  __device__ __forceinline__ void operator()(const f32x4 (&acc)[2][2][4][2], const pg8::Unit& u, int wr, int wc, int fr, int fq) const {
    const int row0 = u.pm * 256 + wr * 64 + fr, col0 = u.pn * 256 + wc * 32 + 4 * fq;
#pragma unroll
    for (int bj = 0; bj < 2; ++bj)
#pragma unroll
      for (int n = 0; n < 2; ++n) {
        const int c = col0 + bj * 128 + n * 16;
        const f32x4 w0 = *(const f32x4*)(cw + c), w1 = *(const f32x4*)(cw + DFF + c), w2 = *(const f32x4*)(cw + 2 * DFF + c), bb = *(const f32x4*)(cb + c);
#pragma unroll
        for (int ai = 0; ai < 2; ++ai)
#pragma unroll
          for (int m = 0; m < 4; ++m) {
            const int r = row0 + ai * 128 + m * 16;
            const int pos = r & (L - 1);
            const u16* gp = G + (size_t)r * DFF + c;
            const uint2 g1 = *(const uint2*)gp;
            uint2 g0 = make_uint2(0, 0), g2 = make_uint2(0, 0);
            if (pos > 0) g0 = *(const uint2*)(gp - DFF);
            if (pos < L - 1) g2 = *(const uint2*)(gp + DFF);
            f32x4 a;
            a[0] = bf2f((u16)(g0.x & 0xffff)) * w0[0] + bf2f((u16)(g1.x & 0xffff)) * w1[0] + bf2f((u16)(g2.x & 0xffff)) * w2[0] + bb[0];
            a[1] = bf2f((u16)(g0.x >> 16)) * w0[1] + bf2f((u16)(g1.x >> 16)) * w1[1] + bf2f((u16)(g2.x >> 16)) * w2[1] + bb[1];
            a[2] = bf2f((u16)(g0.y & 0xffff)) * w0[2] + bf2f((u16)(g1.y & 0xffff)) * w1[2] + bf2f((u16)(g2.y & 0xffff)) * w2[2] + bb[2];
            a[3] = bf2f((u16)(g0.y >> 16)) * w0[3] + bf2f((u16)(g1.y >> 16)) * w1[3] + bf2f((u16)(g2.y >> 16)) * w2[3] + bb[3];
            const f32x4 v = acc[ai][bj][m][n];
            *(uint2*)(ACT + (size_t)r * DFF + c) = make_uint2(pack2(silu_f(a[0]) * v[0], silu_f(a[1]) * v[1]), pack2(silu_f(a[2]) * v[2], silu_f(a[3]) * v[3]));
          }
      }
  }
};
template <class Epi>
__device__ __forceinline__ void run_gemm(const u16* A, const u16* Bt, int N, int K, const Epi& E) {
  pg8::Gemm g; g.A = A; g.Bt = Bt; g.M = SLAB; g.N = N; g.K = K;
  pg8::StaticOrder S; S.init(SLAB, N, gridDim.x, BID());
  __syncthreads();
  pg8::gemm_phase<Epi, pg8::StaticOrder, false>((PG8_LAS unsigned char*)smem, g, S, E, nullptr);
  __syncthreads();
}

__device__ __forceinline__ void fft_dif(float2* x, int N, const float2* __restrict__ tw) {
  const int tid = TID();
  for (int s = N >> 1; s >= 1; s >>= 1) {
    const int tws = 8192 / s;
    for (int i = tid; i < (N >> 1); i += NT) {
      const int j = i & (s - 1);
      const int p = ((i - j) << 1) + j;
      float2 a = x[p], b = x[p + s];
      float2 w = tw[j * tws];
      x[p] = make_float2(a.x + b.x, a.y + b.y);
      float dx = a.x - b.x, dy = a.y - b.y;
      x[p + s] = make_float2(dx * w.x - dy * w.y, dx * w.y + dy * w.x);
    }
    __syncthreads();
  }
}
__device__ __forceinline__ void ifft_dit(float2* x, int N, const float2* __restrict__ tw) {
  const int tid = TID();
  for (int s = 1; s < N; s <<= 1) {
    const int tws = 8192 / s;
    for (int i = tid; i < (N >> 1); i += NT) {
      const int j = i & (s - 1);
      const int p = ((i - j) << 1) + j;
      float2 a = x[p], b = x[p + s];
      float2 w = tw[j * tws];
      float bx = b.x * w.x + b.y * w.y, by = b.y * w.x - b.x * w.y;
      x[p] = make_float2(a.x + bx, a.y + by);
      x[p + s] = make_float2(a.x - bx, a.y - by);
    }
    __syncthreads();
  }
}

__device__ void transpose_w(const float* __restrict__ W, u16* __restrict__ Wt, int K, int N) {
  float* smf = (float*)smem;
  const int tk = K / 64, tn = N / 64, tid = TID();
  for (int item = BID(); item < tk * tn; item += gridDim.x) {
    const int k0 = (item / tn) * 64, n0 = (item % tn) * 64;
    __syncthreads();
    for (int i = tid; i < 4096; i += NT) {
      int kk = i >> 6, nn = i & 63;
      smf[kk * 65 + nn] = W[(long)(k0 + kk) * N + n0 + nn];
    }
    __syncthreads();
    for (int i = tid; i < 4096; i += NT) {
      int nn = i >> 6, kk = i & 63;
      Wt[(long)(n0 + nn) * K + k0 + kk] = f2bf(smf[kk * 65 + nn]);
    }
  }
  __syncthreads();
}

__device__ void phase_pre0(const Params& P) {
  const int tid = TID();
  const long gtid = (long)BID() * NT + tid, gsz = (long)gridDim.x * NT;
  {
    const float4* s0 = (const float4*)P.in[0];
    const float4* s1 = (const float4*)P.in[1];
    float4* o = (float4*)OUTP(P);
    const long n0 = (long)16384 * 1024 / 4, n1 = (long)65536 * 1024 / 4;
    for (long i = gtid; i < n0; i += gsz) o[i] = s0[i];
    for (long i = gtid; i < n1; i += gsz) o[n0 + i] = s1[i];
  }
  transpose_w(P.in[7], (u16*)(WS(P) + O_WHYIN), 1024, 3072);
  transpose_w(P.in[18], (u16*)(WS(P) + O_WHYOUT), 1024, 1024);
  transpose_w(P.in[19], (u16*)(WS(P) + O_WRETIN), 1024, 6144);
  transpose_w(P.in[21], (u16*)(WS(P) + O_WRETOUT), 2048, 1024);
  transpose_w(P.in[22], (u16*)(WS(P) + O_WSWAIN), 1024, 1536);
  transpose_w(P.in[26], (u16*)(WS(P) + O_WSWAOUT), 1024, 1024);
  transpose_w(P.in[27], (u16*)(WS(P) + O_WHGIN), 1024, 5120);
  transpose_w(P.in[30], (u16*)(WS(P) + O_WHGOUT), 1024, 1024);
  for (int l = 0; l < 4; ++l) {
    transpose_w(P.in[31] + (long)l * 1024 * DFF, (u16*)(WS(P) + O_WFG) + (long)l * DFF * 1024, 1024, DFF);
    transpose_w(P.in[32] + (long)l * 1024 * DFF, (u16*)(WS(P) + O_WFV) + (long)l * DFF * 1024, 1024, DFF);
    transpose_w(P.in[35] + (long)l * DFF * 1024, (u16*)(WS(P) + O_WFD) + (long)l * 1024 * DFF, DFF, 1024);
  }
  {
    float* cs = (float*)smem;
    float* modp = (float*)(WS(P) + O_MODP);
    for (int item = BID(); item < 4 * 8 * 12; item += gridDim.x) {
      const int nb = item % 12, ks = (item / 12) % 8, l = item / 96;
      __syncthreads();
      for (int i = tid; i < 2048; i += NT) {
        int b = i >> 7, k = i & 127;
        float c = (b < 8) ? P.in[2][b * 1024 + ks * 128 + k] : P.in[3][(b - 8) * 1024 + ks * 128 + k];
        cs[i] = c / (1.f + expf(-c));
      }
      __syncthreads();
      const int n = nb * 512 + tid;
      float a[16];
#pragma unroll
      for (int b = 0; b < 16; ++b) a[b] = 0.f;
      const float* w = P.in[4] + ((long)l * 1024 + ks * 128) * 6144 + n;
      for (int k = 0; k < 128; ++k) {
        float wv = w[(long)k * 6144];
#pragma unroll
        for (int b = 0; b < 16; ++b) a[b] += cs[b * 128 + k] * wv;
      }
#pragma unroll
      for (int b = 0; b < 16; ++b) modp[(((long)ks * 4 + l) * 16 + b) * 6144 + n] = a[b];
    }
    __syncthreads();
  }
  {
    float2* tw = (float2*)(WS(P) + O_TW);
    for (long i = gtid; i < 8192; i += gsz) {
      float s, c;
      sincospif((float)i * (1.f / 8192.f), &s, &c);
      tw[i] = make_float2(c, -s);
    }
    float2* rr = (float2*)(WS(P) + O_ROPER);
    for (long i = gtid; i < (long)8192 * 128; i += gsz) {
      int pos = (int)(i >> 7), d = (int)(i & 127);
      float inv = exp2f(-(float)d * (13.287712379549449f / 128.f));
      float s, c;
      sincosf((float)pos * inv, &s, &c);
      rr[i] = make_float2(c, s);
    }
    float2* rs = (float2*)(WS(P) + O_ROPES);
    for (long i = gtid; i < (long)8192 * 32; i += gsz) {
      int pos = (int)(i >> 5), d = (int)(i & 31);
      float inv = exp2f(-(float)d * (13.287712379549449f / 32.f));
      float s, c;
      sincosf((float)pos * inv, &s, &c);
      rs[i] = make_float2(c, s);
    }
  }
  {
    float* zf = (float*)smem;
    float* h1 = zf + 8 * 36;
    const float* w1 = P.in[10]; const float* b1 = P.in[11]; const float* w2 = P.in[12]; const float* b2 = P.in[13];
    const float* fr = P.in[15];
    const int tl = tid >> 6, j = tid & 63;
    for (int item = BID(); item < 1280; item += gridDim.x) {
      const int sel = item >= 1024;
      const int L = sel ? 2048 : 8192;
      const int t = (sel ? item - 1024 : item) * 8 + tl;
      float* hid = (float*)(WS(P) + (sel ? O_HIDP : O_HIDS));
      __syncthreads();
      if (j < 33) {
        float v;
        if (j == 0) v = (float)t / (float)(L - 1);
        else {
          int i = (j - 1) & 15;
          float band = 1e-4f + (float)i * ((15.f - 1e-4f) / 15.f);
          float ang = (6.283185307179586f / (float)L) * (float)t;
          float a = band * ang;
          v = (j <= 16) ? cosf(a) : -sinf(a);
        }
        zf[tl * 36 + j] = v;
      }
      __syncthreads();
      float s = b1[j];
#pragma unroll 3
      for (int i = 0; i < 33; ++i) s += zf[tl * 36 + i] * w1[i * 64 + j];
      h1[tl * 64 + j] = sinf(fr[j] * s);
      __syncthreads();
      float s2 = b2[j];
#pragma unroll 4
      for (int i = 0; i < 64; ++i) s2 += h1[tl * 64 + i] * w2[i * 64 + j];
      hid[(long)t * 64 + j] = sinf(fr[j] * s2);
    }
    __syncthreads();
  }
}

__device__ void phase_pre1(const Params& P) {
  __shared__ float w3s[128];
  __shared__ float red[8];
  const int tid = TID(), lane = tid & 63, wid = tid >> 6;
  const long gtid = (long)BID() * NT + tid, gsz = (long)gridDim.x * NT;
  {
    const float* modp = (const float*)(WS(P) + O_MODP);
    float* mod = (float*)(WS(P) + O_MOD);
    for (long i = gtid; i < (long)4 * 16 * 6144; i += gsz) {
      int n = (int)(i % 6144);
      int l = (int)(i / (16 * 6144));
      float s = P.in[5][l * 6144 + n];
      for (int ks = 0; ks < 8; ++ks) s += modp[(long)ks * 4 * 16 * 6144 + i];
      mod[i] = s;
    }
  }
  float2* buf = (float2*)smem;
  const float2* tw = (const float2*)(WS(P) + O_TW);
  for (int item = BID(); item < 2048; item += gridDim.x) {
    const int sel = item >> 10, c = item & 1023;
    const int L = sel ? 2048 : 8192, N = 2 * L;
    const float* hid = (const float*)(WS(P) + (sel ? O_HIDP : O_HIDS));
    float2* hs = (float2*)(WS(P) + (sel ? O_HSPP : O_HSPS)) + (long)c * N;
    __syncthreads();
    if (tid < 128) {
      int dirn = tid >> 6, j = tid & 63;
      w3s[tid] = P.in[14][(long)j * 2048 + dirn * 1024 + c];
    }
    __syncthreads();
    const float dec0 = fabsf(P.in[16][c]), dec1 = fabsf(P.in[16][1024 + c]);
    const float invLm1 = 1.f / (float)(L - 1);
    float asum = 0.f;
    for (int n = tid; n < N; n += NT) {
      float val = 0.f;
      if (n != L) {
        const int dirn = n < L ? 0 : 1;
        const int t = n < L ? n : N - n;
        const float4* hr = (const float4*)(hid + (long)t * 64);
        const float* w = w3s + dirn * 64;
        float s = 0.f;
#pragma unroll
        for (int q = 0; q < 16; ++q) {
          float4 h4 = hr[q];
          s += h4.x * w[4 * q] + h4.y * w[4 * q + 1] + h4.z * w[4 * q + 2] + h4.w * w[4 * q + 3];
        }
        float tl = (float)t * invLm1;
        val = s * expf(-tl * (dirn ? dec1 : dec0));
      }
      buf[n] = make_float2(val, 0.f);
      asum += fabsf(val);
    }
    asum = wave_sum(asum);
    if (lane == 0) red[wid] = asum;
    __syncthreads();
    float tot = 0.f;
#pragma unroll
    for (int w = 0; w < 8; ++w) tot += red[w];
    const float scale = 1.f / (tot * (float)N);
    fft_dif(buf, N, tw);
    for (int p = tid; p < N; p += NT) {
      float2 a = buf[p];
      hs[p] = make_float2(a.x * scale, a.y * scale);
    }
  }
  __syncthreads();
}

__device__ void phase_norm(const Params& P, int layer, int slab, int which) {
  const float* x = OUTP(P) + (long)slab * SLAB * D;
  u16* h = (u16*)(WS(P) + O_HBUF);
  const float* gain = P.in[6] + (layer * 2 + which) * D;
  const float* mod = (const float*)(WS(P) + O_MOD) + (long)layer * 16 * 6144;
  const int shoff = which ? 3 * D : 0, scoff = which ? 4 * D : D;
  const int tid = TID(), lane = tid & 63, wid = tid >> 6;
  for (int item = BID(); item < SLAB / 8; item += gridDim.x) {
    const int r = item * 8 + wid;
    const float* xr = x + (long)r * D;
    float4 v[4];
    float ss = 0.f;
#pragma unroll
    for (int i = 0; i < 4; ++i) {
      v[i] = *(const float4*)(xr + i * 256 + lane * 4);
      ss += v[i].x * v[i].x + v[i].y * v[i].y + v[i].z * v[i].z + v[i].w * v[i].w;
    }
    ss = wave_sum(ss);
    const float rstd = rsqrtf(ss * (1.f / 1024.f) + 1e-6f);
    const float* m = mod + (long)gb_of(slab, r) * 6144;
#pragma unroll
    for (int i = 0; i < 4; ++i) {
      const int col = i * 256 + lane * 4;
      float4 g = *(const float4*)(gain + col);
      float4 sc = *(const float4*)(m + scoff + col);
      float4 sh = *(const float4*)(m + shoff + col);
      float y0 = v[i].x * rstd * g.x * (1.f + sc.x) + sh.x;
      float y1 = v[i].y * rstd * g.y * (1.f + sc.y) + sh.y;
      float y2 = v[i].z * rstd * g.z * (1.f + sc.z) + sh.z;
      float y3 = v[i].w * rstd * g.w * (1.f + sc.w) + sh.w;
      uint2 o = make_uint2(pack2(y0, y1), pack2(y2, y3));
      *(uint2*)(h + (long)r * D + col) = o;
    }
  }
}

__device__ void phase_proj(const Params& P, size_t woff, int N) {
  EpiStoreBf16 E; E.O = (u16*)(WS(P) + O_PROJ); E.ldc = N;
  run_gemm((const u16*)(WS(P) + O_HBUF), (const u16*)(WS(P) + woff), N, D, E);
}
__device__ void phase_resid(const Params& P, int layer, int slab, const u16* A, int K, size_t woff, int goff) {
  EpiResid E; E.X = OUTP(P) + (long)slab * SLAB * D; E.mod = (const float*)(WS(P) + O_MOD) + (long)layer * 16 * 6144; E.goff = goff; E.slab = slab;
  run_gemm(A, (const u16*)(WS(P) + woff), D, K, E);
}

__device__ void phase_ffn_gate(const Params& P, int layer) {
  EpiStoreBf16 E; E.O = (u16*)(WS(P) + O_GBUF); E.ldc = DFF;
  run_gemm((const u16*)(WS(P) + O_HBUF), (const u16*)(WS(P) + O_WFG) + (long)layer * DFF * D, DFF, D, E);
}
__device__ void phase_ffn_val(const Params& P, int layer, int slab) {
  EpiFfnVal E; E.G = (const u16*)(WS(P) + O_GBUF); E.ACT = (u16*)(WS(P) + O_ACT);
  E.cw = P.in[33] + (long)layer * 3 * DFF; E.cb = P.in[34] + (long)layer * DFF; E.L = Lof(slab);
  run_gemm((const u16*)(WS(P) + O_HBUF), (const u16*)(WS(P) + O_WFV) + (long)layer * DFF * D, DFF, D, E);
}

__device__ void phase_hy_conv(const Params& P, int slab) {
  const int L = Lof(slab), nseq = SLAB / L, tid = TID();
  const u16* z = (const u16*)(WS(P) + O_PROJ);
  float* uT = (float*)(WS(P) + O_UT);
  u16* x0c = (u16*)(WS(P) + O_X0C);
  const float* cw = P.in[8];
  const float* cb = P.in[9];
  float* tile = (float*)smem;
  const int ntt = L / 64;
  const int nitems = nseq * ntt * 16;
  for (int item = BID(); item < nitems; item += gridDim.x) {
    const int ct = item % 16, tt = (item / 16) % ntt, seq = item / (16 * ntt);
    __syncthreads();
    for (int i = tid; i < 4096; i += NT) {
      const int tl = i >> 6, cl = i & 63;
      const int t = tt * 64 + tl, c = ct * 64 + cl;
      const long row = (long)seq * L + t;
      float val[3];
#pragma unroll
      for (int q = 0; q < 3; ++q) {
        const int col = q * 1024 + c;
        float a = bf2f(z[row * 3072 + col]) * cw[3072 + col] + cb[col];
        if (t > 0) a += bf2f(z[(row - 1) * 3072 + col]) * cw[col];
        if (t < L - 1) a += bf2f(z[(row + 1) * 3072 + col]) * cw[2 * 3072 + col];
        val[q] = a;
      }
      x0c[row * 1024 + c] = f2bf(val[0]);
      tile[tl * 65 + cl] = val[1] * val[2];
    }
    __syncthreads();
    for (int i = tid; i < 4096; i += NT) {
      const int cl = i >> 6, tl = i & 63;
      uT[((long)seq * 1024 + ct * 64 + cl) * L + tt * 64 + tl] = tile[tl * 65 + cl];
    }
  }
  __syncthreads();
}

__device__ void phase_hy_fft(const Params& P, int slab) {
  const int L = Lof(slab), N = 2 * L, nseq = SLAB / L, tid = TID();
  float* uT = (float*)(WS(P) + O_UT);
  const float2* hsb = (const float2*)(WS(P) + (slab == 0 ? O_HSPP : O_HSPS));
  const float2* tw = (const float2*)(WS(P) + O_TW);
  const float* skip = P.in[17];
  float2* buf = (float2*)smem;
  const int nitems = (nseq / 2) * 1024;
  for (int item = BID(); item < nitems; item += gridDim.x) {
    const int pr = item >> 10, c = item & 1023;
    float* u0 = uT + ((long)(pr * 2) * 1024 + c) * L;
    float* u1 = u0 + (long)1024 * L;
    __syncthreads();
    for (int t = tid; t < L; t += NT) {
      buf[t] = make_float2(u0[t], u1[t]);
      buf[t + L] = make_float2(0.f, 0.f);
    }
    __syncthreads();
    fft_dif(buf, N, tw);
    const float2* h = hsb + (long)c * N;
    for (int p = tid; p < N; p += NT) {
      float2 a = buf[p], b = h[p];
      buf[p] = make_float2(a.x * b.x - a.y * b.y, a.x * b.y + a.y * b.x);
    }
    __syncthreads();
    ifft_dit(buf, N, tw);
    const float sk = skip[c];
    for (int t = tid; t < L; t += NT) {
      float2 y = buf[t];
      u0[t] = y.x + u0[t] * sk;
      u1[t] = y.y + u1[t] * sk;
    }
  }
  __syncthreads();
}

__device__ void phase_hy_tr(const Params& P, int slab) {
  const int L = Lof(slab), nseq = SLAB / L, tid = TID();
  const float* yT = (const float*)(WS(P) + O_UT);
  const u16* x0c = (const u16*)(WS(P) + O_X0C);
  u16* a2 = (u16*)(WS(P) + O_A2);
  float* tile = (float*)smem;
  const int ntt = L / 64;
  const int nitems = nseq * ntt * 16;
  for (int item = BID(); item < nitems; item += gridDim.x) {
    const int ct = item % 16, tt = (item / 16) % ntt, seq = item / (16 * ntt);
    __syncthreads();
    for (int i = tid; i < 4096; i += NT) {
      const int cl = i >> 6, tl = i & 63;
      tile[cl * 65 + tl] = yT[((long)seq * 1024 + ct * 64 + cl) * L + tt * 64 + tl];
    }
    __syncthreads();
    for (int i = tid; i < 4096; i += NT) {
      const int tl = i >> 6, cl = i & 63;
      const long row = (long)seq * L + tt * 64 + tl;
      const int c = ct * 64 + cl;
      a2[row * 1024 + c] = f2bf(tile[cl * 65 + tl] * bf2f(x0c[row * 1024 + c]));
    }
  }
  __syncthreads();
}

struct Rec {
  int H, DK, DV, C;
  int ldv, voff, goff;
};
__device__ __forceinline__ Rec rec_of(int kind) {
  Rec r;
  if (kind == 1) { r.H = 4; r.DK = 256; r.DV = 512; r.C = 128; r.ldv = 6144; r.voff = 2048; r.goff = 4096; }
  else { r.H = 8; r.DK = 128; r.DV = 128; r.C = 64; r.ldv = 5120; r.voff = 1024; r.goff = 4096; }
  return r;
}

__device__ void phase_ret_prep(const Params& P, int slab) {
  const int L = Lof(slab);
  const u16* pj = (const u16*)(WS(P) + O_PROJ);
  u16* qdf = (u16*)(WS(P) + O_QDF); u16* qdb = (u16*)(WS(P) + O_QDB);
  u16* kif = (u16*)(WS(P) + O_KIF); u16* kib = (u16*)(WS(P) + O_KIB);
  u16* kef = (u16*)(WS(P) + O_KEF); u16* keb = (u16*)(WS(P) + O_KEB);
  float* dlf = (float*)(WS(P) + O_DLF); float* dlb = (float*)(WS(P) + O_DLB);
  const float2* rope = (const float2*)(WS(P) + O_ROPER);
  const long gtid = (long)BID() * NT + TID(), gsz = (long)gridDim.x * NT;
  for (long idx = gtid; idx < (long)SLAB * 512; idx += gsz) {
    const int d = (int)(idx & 127), h = (int)((idx >> 7) & 3), t = (int)(idx >> 9);
    const int pos = t & (L - 1), r = t & 127;
    const float lgf = -expf(P.in[20][h]), lgb = -expf(P.in[20][4 + h]);
    const u16* row = pj + (long)t * 6144;
    const float q1 = bf2f(row[h * 256 + d]), q2 = bf2f(row[h * 256 + d + 128]);
    const float k1 = bf2f(row[1024 + h * 256 + d]), k2 = bf2f(row[1024 + h * 256 + d + 128]);
    const float2 cs = rope[(long)pos * 128 + d];
    const float qa = q1 * cs.x - q2 * cs.y, qb = q1 * cs.y + q2 * cs.x;
    const float ka = (k1 * cs.x - k2 * cs.y) * 0.0625f, kb = (k1 * cs.y + k2 * cs.x) * 0.0625f;
    const float bf = (float)(r + 1) * lgf, bb = (float)(128 - r) * lgb;
    const float ef = expf(bf), eif = expf(-bf), eef = expf((float)(127 - r) * lgf);
    const float eb = expf(bb), eib = expf(-bb), eeb = expf((float)r * lgb);
    const long o1 = (long)t * 1024 + h * 256 + d, o2 = o1 + 128;
    qdf[o1] = f2bf(qa * ef); qdf[o2] = f2bf(qb * ef);
    qdb[o1] = f2bf(qa * eb); qdb[o2] = f2bf(qb * eb);
    kif[o1] = f2bf(ka * eif); kif[o2] = f2bf(kb * eif);
    kib[o1] = f2bf(ka * eib); kib[o2] = f2bf(kb * eib);
    kef[o1] = f2bf(ka * eef); kef[o2] = f2bf(kb * eef);
    keb[o1] = f2bf(ka * eeb); keb[o2] = f2bf(kb * eeb);
    if (r == 0) {
      const long cgi = (long)(t >> 7) * 1024 + h * 256 + d;
      const float df = expf(128.f * lgf), db = expf(128.f * lgb);
      dlf[cgi] = df; dlf[cgi + 128] = df;
      dlb[cgi] = db; dlb[cgi + 128] = db;
    }
  }
}

__device__ void phase_hg_prep(const Params& P) {
  const u16* pj = (const u16*)(WS(P) + O_PROJ);
  u16* qdf = (u16*)(WS(P) + O_QDF); u16* qdb = (u16*)(WS(P) + O_QDB);
  u16* kif = (u16*)(WS(P) + O_KIF); u16* kib = (u16*)(WS(P) + O_KIB);
  u16* kef = (u16*)(WS(P) + O_KEF); u16* keb = (u16*)(WS(P) + O_KEB);
  float* dlf = (float*)(WS(P) + O_DLF); float* dlb = (float*)(WS(P) + O_DLB);
  const float* lbt = P.in[28];
  for (int item = BID(); item < 512; item += gridDim.x) {
    const int cgi = item >> 1, ch = (item & 1) * 512 + TID();
    float lb[2];
#pragma unroll
    for (int dr = 0; dr < 2; ++dr) {
      float a0 = lbt[(dr * 4 + 0) * 1024 + ch], a1 = lbt[(dr * 4 + 1) * 1024 + ch], a2 = lbt[(dr * 4 + 2) * 1024 + ch], a3 = lbt[(dr * 4 + 3) * 1024 + ch];
      float m = fmaxf(fmaxf(a0, a1), fmaxf(a2, a3));
      float e0 = expf(a0 - m), e1 = expf(a1 - m), e2 = expf(a2 - m), e3 = expf(a3 - m);
      lb[dr] = (e0 + e1 + e2) / (e0 + e1 + e2 + e3);
    }
    const long t0 = (long)cgi * 64;
    float totf = 0.f, totb = 0.f;
    for (int r = 0; r < 64; ++r) {
      const u16* row = pj + (t0 + r) * 5120;
      float xf = bf2f(row[2048 + ch]), xb = bf2f(row[3072 + ch]);
      totf += logf(lb[0] + (1.f - lb[0]) * sigm(xf));
      totb += logf(lb[1] + (1.f - lb[1]) * sigm(xb));
    }
    float b = 0.f;
    for (int r = 0; r < 64; ++r) {
      const u16* row = pj + (t0 + r) * 5120;
      const float q = silu_f(bf2f(row[ch]));
      const float xf = bf2f(row[2048 + ch]);
      b += logf(lb[0] + (1.f - lb[0]) * sigm(xf));
      const float k = (1.f - lb[0]) * sigm(-xf);
      const long o = (t0 + r) * 1024 + ch;
      qdf[o] = f2bf(q * expf(b));
      kif[o] = f2bf(k * expf(-b));
      kef[o] = f2bf(k * expf(totf - b));
    }
    b = 0.f;
    for (int r = 63; r >= 0; --r) {
      const u16* row = pj + (t0 + r) * 5120;
      const float q = silu_f(bf2f(row[ch]));
      const float xb = bf2f(row[3072 + ch]);
      b += logf(lb[1] + (1.f - lb[1]) * sigm(xb));
      const float k = (1.f - lb[1]) * sigm(-xb);
      const long o = (t0 + r) * 1024 + ch;
      qdb[o] = f2bf(q * expf(b));
      kib[o] = f2bf(k * expf(-b));
      keb[o] = f2bf(k * expf(totb - b));
    }
    dlf[(long)cgi * 1024 + ch] = expf(totf);
    dlb[(long)cgi * 1024 + ch] = expf(totb);
  }
}

template <int C>
__device__ __forceinline__ void rec_scores_item(const Params& P, const Rec& R, int cgi, int h) {
  const u16* qdf = (const u16*)(WS(P) + O_QDF); const u16* qdb = (const u16*)(WS(P) + O_QDB);
  const u16* kif = (const u16*)(WS(P) + O_KIF); const u16* kib = (const u16*)(WS(P) + O_KIB);
  u16* sc = (u16*)(WS(P) + O_SC) + ((long)cgi * R.H + h) * C * C;
  const long off = (long)cgi * C * 1024 + h * R.DK;
  f32x4 af[C / 32][C / 64] = {}, ab[C / 32][C / 64] = {};
  gemm_acc<C, C, true, true>(af, qdf + off, 1024, kif + off, 1024, R.DK, (u16*)smem);
  gemm_acc<C, C, true, true>(ab, qdb + off, 1024, kib + off, 1024, R.DK, (u16*)smem);
  const int tid = TID(), lane = tid & 63, wid = tid >> 6;
  const int wm = wid >> 2, wn = wid & 3, fr = lane & 15, fq = lane >> 4;
#pragma unroll
  for (int mi = 0; mi < C / 32; ++mi)
#pragma unroll
    for (int ni = 0; ni < C / 64; ++ni)
#pragma unroll
      for (int j = 0; j < 4; ++j) {
        const int r = wm * (C / 2) + mi * 16 + fq * 4 + j, c = wn * (C / 4) + ni * 16 + fr;
        float v = (c <= r ? af[mi][ni][j] : 0.f) + (c >= r ? ab[mi][ni][j] : 0.f);
        sc[r * C + c] = f2bf(v);
      }
}

template <int C>
__device__ void phase_rec_su(const Params& P, int kind) {
  const Rec R = rec_of(kind);
  const int nch = SLAB / C;
  const int n_sc = nch * R.H;
  const int mtn = R.DK / 128, ntn = R.DV / 128;
  const int n_u = nch * R.H * 2 * mtn * ntn;
  const u16* pj = (const u16*)(WS(P) + O_PROJ);
  for (int item = BID(); item < n_sc + n_u; item += gridDim.x) {
    if (item < n_sc) {
      rec_scores_item<C>(P, R, item / R.H, item % R.H);
    } else {
      int q = item - n_sc;
      const int nt = q % ntn; q /= ntn;
      const int mt = q % mtn; q /= mtn;
      const int dir = q & 1; q >>= 1;
      const int h = q % R.H, cgi = q / R.H;
      const u16* ke = (const u16*)(WS(P) + (dir ? O_KEB : O_KEF)) + (long)cgi * C * 1024 + h * R.DK + mt * 128;
      const u16* v = pj + (long)cgi * C * R.ldv + R.voff + h * R.DV + nt * 128;
      u16* st = (u16*)(WS(P) + (dir ? O_STB : O_STF)) + (((long)cgi * R.H + h) * R.DV + nt * 128) * R.DK + mt * 128;
      f32x4 acc[4][2] = {};
      gemm_acc<128, 128, false, false>(acc, ke, 1024, v, R.ldv, C, (u16*)smem);
      const int DK = R.DK;
      epi_each<128, 128>(acc, [&](int r, int c, float val) { st[(long)c * DK + r] = f2bf(val); });
    }
  }
}

__device__ void phase_rec_scan(const Params& P, int kind, int slab) {
  const Rec R = rec_of(kind);
  const int L = Lof(slab), nseq = SLAB / L, ncs = L / R.C;
  const int hdk = R.DK / 2;
  const long per = (long)R.H * R.DV * hdk;
  const long total = 2 * nseq * per;
  const long gtid = (long)BID() * NT + TID(), gsz = (long)gridDim.x * NT;
  for (long idx = gtid; idx < total; idx += gsz) {
    long q = idx;
    const int pd = (int)(q % hdk); q /= hdk;
    const int e = (int)(q % R.DV); q /= R.DV;
    const int h = (int)(q % R.H); q /= R.H;
    const int seq = (int)(q % nseq);
    const int dir = (int)(q / nseq);
    u16* st = (u16*)(WS(P) + (dir ? O_STB : O_STF));
    const float* dl = (const float*)(WS(P) + (dir ? O_DLB : O_DLF));
    float s0 = 0.f, s1 = 0.f;
    for (int i = 0; i < ncs; ++i) {
      const int n = dir ? (ncs - 1 - i) : i;
      const long cgi = (long)seq * ncs + n;
      unsigned* p = (unsigned*)(st + ((cgi * R.H + h) * R.DV + e) * R.DK + pd * 2);
      const unsigned u = *p;
      *p = pack2(s0, s1);
      const float2 dd = *(const float2*)(dl + cgi * 1024 + h * R.DK + pd * 2);
      s0 = dd.x * s0 + bf2f((u16)(u & 0xffff));
      s1 = dd.y * s1 + bf2f((u16)(u >> 16));
    }
  }
}

template <int C>
__device__ void phase_rec_out(const Params& P, int kind) {
  const Rec R = rec_of(kind);
  const int nch = SLAB / C, ntn = R.DV / 128;
  const u16* pj = (const u16*)(WS(P) + O_PROJ);
  float* ob = (float*)(WS(P) + O_OBUF);
  const int HDV = R.H * R.DV;
  for (int item = BID(); item < nch * R.H * ntn; item += gridDim.x) {
    const int nt = item % ntn, h = (item / ntn) % R.H, cgi = item / (ntn * R.H);
    f32x4 acc[C / 32][2] = {};
    const u16* sc = (const u16*)(WS(P) + O_SC) + ((long)cgi * R.H + h) * C * C;
    const u16* v = pj + (long)cgi * C * R.ldv + R.voff + h * R.DV + nt * 128;
    gemm_acc<C, 128, true, false>(acc, sc, C, v, R.ldv, C, (u16*)smem);
    const long qoff = (long)cgi * C * 1024 + h * R.DK;
    const long soff = (((long)cgi * R.H + h) * R.DV + nt * 128) * R.DK;
    gemm_acc<C, 128, true, true>(acc, (const u16*)(WS(P) + O_QDF) + qoff, 1024, (const u16*)(WS(P) + O_STF) + soff, R.DK, R.DK, (u16*)smem);
    gemm_acc<C, 128, true, true>(acc, (const u16*)(WS(P) + O_QDB) + qoff, 1024, (const u16*)(WS(P) + O_STB) + soff, R.DK, R.DK, (u16*)smem);
    float* o = ob + (long)cgi * C * HDV + h * R.DV + nt * 128;
    epi_each<C, 128>(acc, [&](int r, int c, float val) { o[(long)r * HDV + c] = val; });
  }
}

__device__ void phase_rec_ng(const Params& P, int kind) {
  const Rec R = rec_of(kind);
  const int HDV = R.H * R.DV;
  const float* ob = (const float*)(WS(P) + O_OBUF);
  const u16* pj = (const u16*)(WS(P) + O_PROJ);
  u16* a2 = (u16*)(WS(P) + O_A2);
  const float* gain = (kind == 3) ? P.in[29] : nullptr;
  const int tid = TID(), lane = tid & 63, wid = tid >> 6;
  const int nrows = SLAB * R.H;
  const int per = R.DV / 64;
  for (int item = BID(); item < nrows / 8; item += gridDim.x) {
    const int rh = item * 8 + wid;
    const int t = rh / R.H, h = rh % R.H;
    const float* o = ob + (long)t * HDV + h * R.DV + lane * per;
    float ss = 0.f;
    for (int i = 0; i < per; ++i) { float v = o[i]; ss += v * v; }
    ss = wave_sum(ss);
    const float rstd = rsqrtf(ss / (float)R.DV + 1e-6f);
    const u16* g = pj + (long)t * R.ldv + R.goff + h * R.DV + lane * per;
    u16* out = a2 + (long)t * HDV + h * R.DV + lane * per;
    for (int i = 0; i < per; ++i) {
      float y = o[i] * rstd;
      if (gain) y *= gain[lane * per + i];
      out[i] = f2bf(y * silu_f(bf2f(g[i])));
    }
  }
}

__device__ void phase_swa_prep(const Params& P, int slab) {
  const int L = Lof(slab);
  const u16* pj = (const u16*)(WS(P) + O_PROJ);
  u16* qn = (u16*)(WS(P) + O_QN);
  u16* kn = (u16*)(WS(P) + O_KN);
  const float2* rope = (const float2*)(WS(P) + O_ROPES);
  const long gtid = (long)BID() * NT + TID(), gsz = (long)gridDim.x * NT;
  for (long idx = gtid; idx < (long)SLAB * 640; idx += gsz) {
    const int d = (int)(idx & 31);
    const int hd = (int)((idx >> 5) % 20);
    const int t = (int)(idx / 640);
    const int col = hd < 16 ? hd * 64 : 1024 + (hd - 16) * 64;
    const float x1 = bf2f(pj[(long)t * 1536 + col + d]), x2 = bf2f(pj[(long)t * 1536 + col + d + 32]);
    float ss = x1 * x1 + x2 * x2;
#pragma unroll
    for (int o = 16; o; o >>= 1) ss += __shfl_xor(ss, o);
    const float rstd = rsqrtf(ss * (1.f / 64.f) + 1e-6f);
    const float* gn = hd < 16 ? P.in[23] : P.in[24];
    const float y1 = x1 * rstd * gn[d], y2 = x2 * rstd * gn[d + 32];
    const float2 cs = rope[(long)(t & (L - 1)) * 32 + d];
    float o1 = y1 * cs.x - y2 * cs.y, o2 = y1 * cs.y + y2 * cs.x;
    if (hd < 16) {
      qn[(long)t * 1024 + hd * 64 + d] = f2bf(o1 * 0.125f);
      qn[(long)t * 1024 + hd * 64 + d + 32] = f2bf(o2 * 0.125f);
    } else {
      kn[(long)t * 256 + (hd - 16) * 64 + d] = f2bf(o1);
      kn[(long)t * 256 + (hd - 16) * 64 + d + 32] = f2bf(o2);
    }
  }
}

constexpr int SLD = 324;
__device__ void phase_swa_att1(const Params& P, int slab) {
  const int L = Lof(slab), nqb = L / 64;
  const u16* qn = (const u16*)(WS(P) + O_QN);
  const u16* kn = (const u16*)(WS(P) + O_KN);
  u16* pb = (u16*)(WS(P) + O_PBUF);
  const float* sink = P.in[25];
  float* S = (float*)(smem + 24576);
  const int tid = TID();
  const int nitems = (SLAB / 64) * 16;
  for (int item = BID(); item < nitems; item += gridDim.x) {
    const int hq = item & 15, qbg = item >> 4;
    const int seq = qbg / nqb, qb = qbg % nqb;
    const int q0 = qb * 64;
    const long tok0 = (long)seq * L;
    const int hkv = hq >> 2;
    for (int kt = 0; kt < 5; ++kt) {
      const int kp0 = q0 - 128 + kt * 64;
      if (kp0 >= 0 && kp0 < L) {
        f32x4 acc[2][1] = {};
        gemm_acc<64, 64, true, true>(acc, qn + (tok0 + q0) * 1024 + hq * 64, 1024, kn + (tok0 + kp0) * 256 + hkv * 64, 256, 64, (u16*)smem);
        epi_each<64, 64>(acc, [&](int r, int c, float v) {
          const int dlt = (q0 + r) - (kp0 + c);
          S[r * SLD + kt * 64 + c] = (dlt <= 128 && dlt >= -128) ? v : -1e30f;
        });
      } else {
        for (int i = tid; i < 4096; i += NT) S[(i >> 6) * SLD + kt * 64 + (i & 63)] = -1e30f;
      }
    }
    __syncthreads();
    {
      const int r = tid >> 3, sub = tid & 7;
      const float sk = sink[hq];
      float m = sk;
      for (int c = sub; c < 320; c += 8) m = fmaxf(m, S[r * SLD + c]);
      m = fmaxf(m, __shfl_xor(m, 1)); m = fmaxf(m, __shfl_xor(m, 2)); m = fmaxf(m, __shfl_xor(m, 4));
      float den = 0.f;
      for (int c = sub; c < 320; c += 8) { float e = __expf(S[r * SLD + c] - m); S[r * SLD + c] = e; den += e; }
      den += __shfl_xor(den, 1); den += __shfl_xor(den, 2); den += __shfl_xor(den, 4);
      den += __expf(sk - m);
      const float inv = 1.f / den;
      u16* prow = pb + ((long)item * 64 + r) * 320;
      for (int c = sub; c < 320; c += 8) prow[c] = f2bf(S[r * SLD + c] * inv);
    }
    __syncthreads();
  }
}

__device__ void phase_swa_att2(const Params& P, int slab) {
  const int L = Lof(slab), nqb = L / 64;
  const u16* pj = (const u16*)(WS(P) + O_PROJ);
  const u16* pb = (const u16*)(WS(P) + O_PBUF);
  u16* a2 = (u16*)(WS(P) + O_A2);
  const int nitems = (SLAB / 64) * 16;
  for (int item = BID(); item < nitems; item += gridDim.x) {
    const int hq = item & 15, qbg = item >> 4;
    const int seq = qbg / nqb, qb = qbg % nqb;
    const int q0 = qb * 64;
    const long tok0 = (long)seq * L;
    const int hkv = hq >> 2;
    f32x4 acc[2][1] = {};
    for (int kt = 0; kt < 5; ++kt) {
      const int kp0 = q0 - 128 + kt * 64;
      if (kp0 >= 0 && kp0 < L)
        gemm_acc<64, 64, true, false>(acc, pb + (long)item * 64 * 320 + kt * 64, 320, pj + (tok0 + kp0) * 1536 + 1280 + hkv * 64, 1536, 64, (u16*)smem);
    }
    u16* o = a2 + (tok0 + q0) * 1024 + hq * 64;
    epi_each<64, 64>(acc, [&](int r, int c, float v) { o[(long)r * 1024 + c] = f2bf(v); });
  }
}

__device__ __forceinline__ int nsteps_of(int kind) { return (kind & 1) ? 12 : 10; }

__device__ void layer_step(const Params& P, int layer, int slab, int step) {
  const int kind = layer;
  const int nmix = nsteps_of(kind) - 4;
  if (step == 0) { phase_norm(P, layer, slab, 0); return; }
  if (step >= nmix) {
    const int f = step - nmix;
    if (f == 0) phase_norm(P, layer, slab, 1);
    else if (f == 1) phase_ffn_gate(P, layer);
    else if (f == 2) phase_ffn_val(P, layer, slab);
    else phase_resid(P, layer, slab, (const u16*)(WS(P) + O_ACT), DFF, O_WFD + (size_t)layer * SZW(1024, 2816), 5 * D);
    return;
  }
  if (kind == 0) {
    if (step == 1) phase_proj(P, O_WHYIN, 3072);
    else if (step == 2) phase_hy_conv(P, slab);
    else if (step == 3) phase_hy_fft(P, slab);
    else if (step == 4) phase_hy_tr(P, slab);
    else phase_resid(P, layer, slab, (const u16*)(WS(P) + O_A2), 1024, O_WHYOUT, 2 * D);
  } else if (kind == 1) {
    if (step == 1) phase_proj(P, O_WRETIN, 6144);
    else if (step == 2) phase_ret_prep(P, slab);
    else if (step == 3) phase_rec_su<128>(P, 1);
    else if (step == 4) phase_rec_scan(P, 1, slab);
    else if (step == 5) phase_rec_out<128>(P, 1);
    else if (step == 6) phase_rec_ng(P, 1);
    else phase_resid(P, layer, slab, (const u16*)(WS(P) + O_A2), 2048, O_WRETOUT, 2 * D);
  } else if (kind == 2) {
    if (step == 1) phase_proj(P, O_WSWAIN, 1536);
    else if (step == 2) phase_swa_prep(P, slab);
    else if (step == 3) phase_swa_att1(P, slab);
    else if (step == 4) phase_swa_att2(P, slab);
    else phase_resid(P, layer, slab, (const u16*)(WS(P) + O_A2), 1024, O_WSWAOUT, 2 * D);
  } else {
    if (step == 1) phase_proj(P, O_WHGIN, 5120);
    else if (step == 2) phase_hg_prep(P);
    else if (step == 3) phase_rec_su<64>(P, 3);
    else if (step == 4) phase_rec_scan(P, 3, slab);
    else if (step == 5) phase_rec_out<64>(P, 3);
    else if (step == 6) phase_rec_ng(P, 3);
    else phase_resid(P, layer, slab, (const u16*)(WS(P) + O_A2), 1024, O_WHGOUT, 2 * D);
  }
}

__global__ void __launch_bounds__(NT) fwd_megakernel(Params P) {
  cg::grid_group grid = cg::this_grid();
  for (int pid = P.p0; pid < P.p1; ++pid) {
    if (pid == 0) phase_pre0(P);
    else if (pid == 1) phase_pre1(P);
    else {
      int q = pid - 2, layer = 0;
      while (q >= 5 * nsteps_of(layer)) { q -= 5 * nsteps_of(layer); ++layer; }
      const int ns = nsteps_of(layer);
      layer_step(P, layer, q / ns, q % ns);
    }
    if (pid + 1 < P.p1) grid.sync();
  }
}

extern "C" void kernel_launch(void* const* d_in, const int* in_sizes, int n_in, void* d_out, int out_size, void* d_ws,
                              size_t ws_size, hipStream_t stream) {
  static int grid_blocks = 0;
  if (!grid_blocks) {
    int dev = 0, cus = 0, per_cu = 0;
    (void)hipGetDevice(&dev);
    (void)hipDeviceGetAttribute(&cus, hipDeviceAttributeMultiprocessorCount, dev);
    (void)hipFuncSetAttribute((const void*)fwd_megakernel, hipFuncAttributeMaxDynamicSharedMemorySize, LDSB);
    (void)hipOccupancyMaxActiveBlocksPerMultiprocessor(&per_cu, (const void*)fwd_megakernel, NT, LDSB);
    if (per_cu < 1) per_cu = 1;
    if (per_cu > 1) per_cu = 1;
    grid_blocks = cus * per_cu;
    if (ws_size < WS_END) fprintf(stderr, "kernel_launch: workspace too small: %zu < %zu\n", ws_size, (size_t)WS_END);
  }
  Params p;
  memset(&p, 0, sizeof(p));
  for (int i = 0; i < 36; ++i) p.in[i] = (const float*)d_in[i];
  p.out = (float*)d_out;
  p.ws = (unsigned char*)d_ws;
#if ONE_LAUNCH
  p.p0 = 0; p.p1 = NPHASES;
  void* args[] = {&p};
  hipError_t e = hipLaunchCooperativeKernel((const void*)fwd_megakernel, dim3(grid_blocks), dim3(NT), args, LDSB, stream);
  if (e != hipSuccess) fprintf(stderr, "cooperative launch failed: %s (grid %d)\n", hipGetErrorString(e), grid_blocks);
#else
  for (int ph = 0; ph < NPHASES; ++ph) {
    p.p0 = ph; p.p1 = ph + 1;
    hipLaunchKernelGGL(fwd_megakernel, dim3(grid_blocks), dim3(NT), LDSB, stream, p);
  }
#endif
}
```

```cpp
#include <hip/hip_runtime.h>
#include <hip/hip_cooperative_groups.h>
#include <cstdio>
#include <cstdint>
#include <cstring>
namespace cg = cooperative_groups;

typedef unsigned short u16;
typedef __attribute__((ext_vector_type(8))) short bf16x8;
typedef __attribute__((ext_vector_type(4))) float f32x4;

#define NT 512
#ifndef ONE_LAUNCH
#define ONE_LAUNCH 1
#endif

constexpr int D = 1024, SLAB = 16384, DFF = 2816;
constexpr int LDSB = 131072;
constexpr int NPHASES = 2 + 5 * (10 + 12 + 10 + 12);

constexpr size_t SZW(size_t n, size_t k) { return n * k * 2; }
constexpr size_t O_WHYIN = 0;
constexpr size_t O_WHYOUT = O_WHYIN + SZW(3072, 1024);
constexpr size_t O_WRETIN = O_WHYOUT + SZW(1024, 1024);
constexpr size_t O_WRETOUT = O_WRETIN + SZW(6144, 1024);
constexpr size_t O_WSWAIN = O_WRETOUT + SZW(1024, 2048);
constexpr size_t O_WSWAOUT = O_WSWAIN + SZW(1536, 1024);
constexpr size_t O_WHGIN = O_WSWAOUT + SZW(1024, 1024);
constexpr size_t O_WHGOUT = O_WHGIN + SZW(5120, 1024);
constexpr size_t O_WFG = O_WHGOUT + SZW(1024, 1024);
constexpr size_t O_WFV = O_WFG + 4 * SZW(2816, 1024);
constexpr size_t O_WFD = O_WFV + 4 * SZW(2816, 1024);
constexpr size_t O_MOD = O_WFD + 4 * SZW(1024, 2816);
constexpr size_t O_TW = O_MOD + (size_t)4 * 16 * 6144 * 4;
constexpr size_t O_HIDS = O_TW + 8192 * 8;
constexpr size_t O_HIDP = O_HIDS + (size_t)8192 * 64 * 4;
constexpr size_t O_ROPER = O_HIDP + (size_t)2048 * 64 * 4;
constexpr size_t O_ROPES = O_ROPER + (size_t)8192 * 128 * 8;
constexpr size_t O_PROJ = O_ROPES + (size_t)8192 * 32 * 8;
constexpr size_t O_HBUF = O_PROJ + (size_t)SLAB * 6144 * 2;
constexpr size_t O_A2 = O_HBUF + (size_t)SLAB * 1024 * 2;
constexpr size_t O_C = O_A2 + (size_t)SLAB * 2048 * 2;
constexpr size_t O_GBUF = O_C;
constexpr size_t O_ACT = O_GBUF + (size_t)SLAB * DFF * 2;
constexpr size_t O_MODP = O_C;
constexpr size_t O_HSPS = O_ACT + (size_t)SLAB * DFF * 2;
constexpr size_t O_HSPP = O_HSPS + (size_t)1024 * 16384 * 8;
constexpr size_t O_UT = O_HSPP + (size_t)1024 * 4096 * 8;
constexpr size_t O_X0C = O_UT + (size_t)SLAB * 1024 * 4;
constexpr size_t END_HY = O_X0C + (size_t)SLAB * 1024 * 2;
constexpr size_t SZP = (size_t)SLAB * 1024 * 2;
constexpr size_t O_QDF = O_C, O_QDB = O_QDF + SZP, O_KIF = O_QDB + SZP, O_KIB = O_KIF + SZP, O_KEF = O_KIB + SZP, O_KEB = O_KEF + SZP;
constexpr size_t O_DLF = O_KEB + SZP;
constexpr size_t O_DLB = O_DLF + (size_t)256 * 1024 * 4;
constexpr size_t O_SC = O_DLB + (size_t)256 * 1024 * 4;
constexpr size_t O_STF = O_SC + (size_t)SLAB * 512 * 2;
constexpr size_t O_STB = O_STF + (size_t)134217728;
constexpr size_t O_OBUF = O_STB + (size_t)134217728;
constexpr size_t END_REC = O_OBUF + (size_t)SLAB * 2048 * 4;
constexpr size_t O_QN = O_C;
constexpr size_t O_KN = O_QN + SZP;
constexpr size_t O_PBUF = O_KN + (size_t)SLAB * 256 * 2;
constexpr size_t END_SWA = O_PBUF + (size_t)SLAB * 16 * 320 * 2;
constexpr size_t WS_END = END_REC > END_HY ? (END_REC > END_SWA ? END_REC : END_SWA) : (END_HY > END_SWA ? END_HY : END_SWA);
static_assert(WS_END <= ((size_t)1 << 30), "workspace exceeds 1 GiB");

struct Params {
  const float* in[36];
  float* out;
  unsigned char* ws;
  int p0, p1;
};

extern __shared__ __attribute__((aligned(16))) unsigned char smem[];

__device__ __forceinline__ int TID() { int t = threadIdx.x; asm volatile("" : "+v"(t)); return t; }
__device__ __forceinline__ int BID() { int b = blockIdx.x; asm volatile("" : "+s"(b)); return b; }
__device__ __forceinline__ long ZOFF() { long z = 0; asm volatile("" : "+s"(z)); return z; }
__device__ __forceinline__ unsigned char* WS(const Params& P) { return P.ws + ZOFF(); }
__device__ __forceinline__ float* OUTP(const Params& P) { return P.out + ZOFF(); }

namespace pg8 {
#define PG8_LAS __attribute__((address_space(3)))
typedef unsigned short bf16_t;
typedef short bf16x8 __attribute__((ext_vector_type(8)));
typedef float f32x4 __attribute__((ext_vector_type(4)));
typedef unsigned u32x4 __attribute__((ext_vector_type(4)));
constexpr int BM = 256, BK = 64, HALF = 128, HTB = HALF * BK * 2  , STAGE_BYTES = 8 * HTB, NXCD = 8, WGM = 8;

__host__ __device__ __forceinline__ int lds_byte(int r, int c) { const int st = (r >> 4) * 2 + (c >> 5), rr = r & 15, cc = c & 31, ob = rr * 64 + cc * 2; return st * 1024 + (ob ^ (((ob >> 9) & 1) << 5)); }
__host__ __device__ __forceinline__ void stage_rc(int b, int& R, int& C) { const int st = b / 1024, sb = b % 1024, swz = sb ^ (((sb >> 9) & 1) << 5); R = (st >> 1) * 16 + swz / 64; C = (st & 1) * 32 + (swz % 64) / 2; }
__host__ __device__ __forceinline__ int perm32(int rho) { const int n = rho >> 4, i = rho & 15; return 8 * (i >> 2) + 4 * n + (i & 3); }

struct Unit { int pm, pn; };
struct Gemm { const bf16_t* A; const bf16_t* Bt; int M, N, K; };

struct StaticOrder {
    int nM, nN, nwg, G, c;
    __host__ __device__ void init(int M, int N, int G_, int c_) { nM = M / BM; nN = N / BM; nwg = nM * nN; G = G_; c = c_; }
    __host__ __device__ bool next(int i, Unit& u) const {
        const long L = (long)i * G + c; if (L >= nwg) return false;
        int wgid = (int)L; { const int q = nwg / NXCD, r = nwg % NXCD, xcd = wgid % NXCD, off = wgid / NXCD; wgid = (xcd < r ? xcd * (q + 1) : r * (q + 1) + (xcd - r) * q) + off; }
        const int nig = WGM * nN, gid = wgid / nig, fm = gid * WGM, gsz = (nM - fm) < WGM ? (nM - fm) : WGM;
        u.pm = fm + ((wgid % nig) % gsz); u.pn = (wgid % nig) / gsz; return true;
    }
    __device__ __forceinline__ void a_ready(const Unit&) const {}
    __device__ __forceinline__ void done(const Unit&) const {}
};

template <class Epi, class Sched, bool STAMP = false>
__device__ __forceinline__ void gemm_phase(PG8_LAS unsigned char* lds, const Gemm g, const Sched& S, const Epi& E, unsigned long long* stamps) {
    const int tid = TID(), wid = __builtin_amdgcn_readfirstlane(tid >> 6), lane = tid & 63, wr = wid >> 2, wc = wid & 3, fr = lane & 15, fq = lane >> 4;
    const int K = g.K, nt = K / BK;
    int ts_lo = 0, ts_hi = 0, nts = 0; const unsigned long long rt_entry = STAMP ? (unsigned long long)wall_clock64() : 0ull;
#define PG8_STAMP() do { if (STAMP && wid == 0 && nts < 64) { const unsigned long long _c = (unsigned long long)clock64(); \
        ts_lo = (lane == nts) ? (int)(unsigned)_c : ts_lo; ts_hi = (lane == nts) ? (int)(unsigned)(_c >> 32) : ts_hi; ++nts; } } while (0)
    PG8_STAMP();
    unsigned voffA[2], voffB[2];
#pragma unroll
    for (int i = 0; i < 2; ++i) { int R, C; stage_rc(tid * 16 + i * 8192, R, C); const int Rb = Epi::PERM ? ((R & ~31) + perm32(R & 31)) : R;
        voffA[i] = (unsigned)(R * K + C) * 2u; voffB[i] = (unsigned)(Rb * K + C) * 2u; }
    const size_t kstep = (size_t)(BK * 2);
    const size_t hstep = (size_t)HALF * K * 2;
    const size_t tstep = 2 * hstep;
    const unsigned ldsw = (unsigned)wid * 1024u;
    const int aoff = lds_byte(wr * 64 + fr, fq * 8), boff = lds_byte(wc * 32 + fr, fq * 8);
#define PG8_SA(b, h) (((b) * 2 + (h)) * HTB)
#define PG8_SB(b, h) ((4 + (b) * 2 + (h)) * HTB)
#define PG8_STAGE(bufoff, gbase, voff) do { _Pragma("unroll") for (int _i = 0; _i < 2; ++_i) \
        __builtin_amdgcn_global_load_lds((const unsigned*)((const char*)(gbase) + (voff)[_i]), (PG8_LAS unsigned*)(lds + (bufoff) + ldsw + _i * 8192), 16, 0, 0); } while (0)
#define PG8_LDA(dst, b, h) do { _Pragma("unroll") for (int m = 0; m < 4; ++m) _Pragma("unroll") for (int k = 0; k < 2; ++k) dst[m][k] = *(const PG8_LAS bf16x8*)(lds + PG8_SA(b, h) + aoff + m * 2048 + k * 1024); } while (0)
#define PG8_LDB(dst, b, h) do { _Pragma("unroll") for (int n = 0; n < 2; ++n) _Pragma("unroll") for (int k = 0; k < 2; ++k) dst[n][k] = *(const PG8_LAS bf16x8*)(lds + PG8_SB(b, h) + boff + n * 2048 + k * 1024); } while (0)
#define PG8_MMA(ai, bj, At, Bt) do { __builtin_amdgcn_s_setprio(1); _Pragma("unroll") for (int m = 0; m < 4; ++m) _Pragma("unroll") for (int n = 0; n < 2; ++n) _Pragma("unroll") for (int k = 0; k < 2; ++k) \
        acc[ai][bj][m][n] = __builtin_amdgcn_mfma_f32_16x16x32_bf16(Bt[n][k], At[m][k], acc[ai][bj][m][n], 0, 0, 0); __builtin_amdgcn_s_setprio(0); } while (0)
#define PG8_WAIT_V(n) asm volatile("s_waitcnt vmcnt(" #n ")" ::: "memory")
#define PG8_WAIT_L(n) asm volatile("s_waitcnt lgkmcnt(" #n ")" ::: "memory")
#define PG8_BAR __builtin_amdgcn_s_barrier()
#define PG8_SCHED __builtin_amdgcn_sched_barrier(0)
    Unit cur, nxt; int ui = 0;
    if (!S.next(0, cur)) return;
    f32x4 acc[2][2][4][2];
#pragma unroll
    for (int a = 0; a < 2; ++a)
#pragma unroll
        for (int b = 0; b < 2; ++b)
#pragma unroll
            for (int m = 0; m < 4; ++m)
#pragma unroll
                for (int n = 0; n < 2; ++n) acc[a][b][m][n] = (f32x4){0.f, 0.f, 0.f, 0.f};
    bf16x8 At[4][2], B0[2][2], B1[2][2];
    const char* cA = (const char*)g.A + (size_t)cur.pm * tstep; const char* cB = (const char*)g.Bt + (size_t)cur.pn * tstep;
    S.a_ready(cur);
    PG8_STAGE(PG8_SB(0, 0), cB, voffB); PG8_STAGE(PG8_SA(0, 0), cA, voffA); PG8_STAGE(PG8_SB(0, 1), cB + hstep, voffB); PG8_STAGE(PG8_SA(0, 1), cA + hstep, voffA);
    if (wr == 1) PG8_BAR;
    PG8_WAIT_V(4); PG8_BAR;
    PG8_STAGE(PG8_SB(1, 0), cB + kstep, voffB); PG8_STAGE(PG8_SA(1, 0), cA + kstep, voffA); PG8_STAGE(PG8_SB(1, 1), cB + hstep + kstep, voffB);
    PG8_WAIT_V(6); PG8_BAR;
    PG8_STAMP();
    for (;;) {
        const bool has_next = S.next(ui + 1, nxt);
        const char* nA = has_next ? (const char*)g.A + (size_t)nxt.pm * tstep : cA; const char* nB = has_next ? (const char*)g.Bt + (size_t)nxt.pn * tstep : cB;
        for (int t = 0; t < nt; t += 2) {
            const bool last = (t == nt - 2);
            const char* a1 = cA + (size_t)(t + 1) * kstep;
            const char* a2 = last ? nA : cA + (size_t)(t + 2) * kstep; const char* b2 = last ? nB : cB + (size_t)(t + 2) * kstep;
            const char* a3 = a2 + kstep; const char* b3 = b2 + kstep;
            if (last && has_next) S.a_ready(nxt);
            PG8_LDB(B0, 0, 0); PG8_SCHED; PG8_LDA(At, 0, 0); PG8_STAGE(PG8_SA(1, 1), a1 + hstep, voffA);
            PG8_WAIT_L(8); PG8_BAR; PG8_WAIT_L(0); PG8_MMA(0, 0, At, B0); PG8_BAR; PG8_SCHED;
            PG8_LDB(B1, 0, 1); PG8_STAGE(PG8_SB(0, 0), b2, voffB);
            PG8_BAR; PG8_WAIT_L(0); PG8_MMA(0, 1, At, B1); PG8_BAR;
            PG8_LDA(At, 0, 1); PG8_STAGE(PG8_SA(0, 0), a2, voffA);
            PG8_BAR; PG8_WAIT_L(0); PG8_MMA(1, 0, At, B0); PG8_BAR; PG8_SCHED;
            PG8_STAGE(PG8_SB(0, 1), b2 + hstep, voffB);
            PG8_WAIT_V(6); PG8_BAR; PG8_MMA(1, 1, At, B1); PG8_BAR;
            PG8_LDB(B0, 1, 0); PG8_SCHED; PG8_LDA(At, 1, 0); PG8_STAGE(PG8_SA(0, 1), a2 + hstep, voffA);
            PG8_WAIT_L(8); PG8_BAR; PG8_WAIT_L(0); PG8_MMA(0, 0, At, B0); PG8_BAR; PG8_SCHED;
            PG8_LDB(B1, 1, 1); PG8_STAGE(PG8_SB(1, 0), b3, voffB);
            PG8_BAR; PG8_WAIT_L(0); PG8_MMA(0, 1, At, B1); PG8_BAR;
            PG8_LDA(At, 1, 1); PG8_STAGE(PG8_SA(1, 0), a3, voffA);
            PG8_BAR; PG8_WAIT_L(0); PG8_MMA(1, 0, At, B0); PG8_BAR; PG8_SCHED;
            PG8_STAGE(PG8_SB(1, 1), b3 + hstep, voffB);
            PG8_WAIT_V(6); PG8_BAR; PG8_MMA(1, 1, At, B1); PG8_BAR;
        }
        PG8_STAMP();
        if constexpr (!Epi::AFTER_DRAIN) { E(acc, cur, wr, wc, fr, fq); S.done(cur); }
        PG8_STAMP();
        if (!has_next) break;
#pragma unroll
        for (int a = 0; a < 2; ++a)
#pragma unroll
            for (int b = 0; b < 2; ++b)
#pragma unroll
                for (int m = 0; m < 4; ++m)
#pragma unroll
                    for (int n = 0; n < 2; ++n) acc[a][b][m][n] = (f32x4){0.f, 0.f, 0.f, 0.f};
        cur = nxt; cA = nA; cB = nB; ++ui;
    }
    PG8_WAIT_V(0);
    if (wr == 0) PG8_BAR;
    PG8_BAR;
    if constexpr (Epi::AFTER_DRAIN) { E.fused(acc, cur, wr, wc, fr, fq, lds, wid, lane); S.done(cur); }
    PG8_STAMP();
    if (STAMP && wid == 0) { stamps[lane] = lane < nts ? (((unsigned long long)(unsigned)ts_hi << 32) | (unsigned)ts_lo) : 0ull;
        if (lane == 62) stamps[62] = rt_entry; if (lane == 63) stamps[63] = (unsigned long long)wall_clock64(); }
#undef PG8_STAMP
#undef PG8_SA
#undef PG8_SB
#undef PG8_STAGE
#undef PG8_LDA
#undef PG8_LDB
#undef PG8_MMA
#undef PG8_WAIT_V
#undef PG8_WAIT_L
#undef PG8_BAR
#undef PG8_SCHED
}
}


__device__ __forceinline__ u16 f2bf(float f) {
  unsigned u = __float_as_uint(f);
  u += 0x7fffu + ((u >> 16) & 1u);
  return (u16)(u >> 16);
}
__device__ __forceinline__ float bf2f(u16 h) { return __uint_as_float(((unsigned)h) << 16); }
__device__ __forceinline__ unsigned pack2(float a, float b) { return (unsigned)f2bf(a) | ((unsigned)f2bf(b) << 16); }
__device__ __forceinline__ float silu_f(float x) { return x / (1.f + __expf(-x)); }
__device__ __forceinline__ float sigm(float x) { return 1.f / (1.f + __expf(-x)); }
__device__ __forceinline__ float wave_sum(float v) {
#pragma unroll
  for (int o = 32; o; o >>= 1) v += __shfl_xor(v, o);
  return v;
}
__device__ __forceinline__ int Lof(int slab) { return slab == 0 ? 2048 : 8192; }
__device__ __forceinline__ int gb_of(int slab, int r) { return slab == 0 ? (r >> 11) : (8 + (slab - 1) * 2 + (r >> 13)); }

typedef short v4s __attribute__((ext_vector_type(4)));
#define LDS_AS __attribute__((address_space(3)))
template <int R, bool KC>
__device__ __forceinline__ uint4 ld_chunk(const u16* __restrict__ base, long ld, int k0, int c) {
  if (KC) {
    const int r = c >> 3, kc = c & 7;
    return *(const uint4*)(base + (long)r * ld + k0 + kc * 8);
  } else {
    const int k = c / (R / 8), mc = c % (R / 8);
    return *(const uint4*)(base + (long)(k0 + k) * ld + mc * 8);
  }
}
template <int R, bool KC>
__device__ __forceinline__ void st_chunk(u16* s, uint4 v, int c) {
  if (KC) {
    const int r = c >> 3, kc = c & 7;
    *(uint4*)(s + r * 72 + kc * 8) = v;
  } else {
    const int k = c / (R / 8), mc = c % (R / 8);
    *(uint4*)(s + k * (R + 8) + mc * 8) = v;
  }
}
template <int R, bool KC>
__device__ __forceinline__ bf16x8 ld_frag(const u16* s, int x0, int ks, int fr, int fq) {
  if (KC) {
    return *(const bf16x8*)(s + (x0 + fr) * 72 + ks * 32 + fq * 8);
  } else {
    const int q4 = fr >> 2, p4 = fr & 3;
    const u16* p = s + (ks * 32 + 8 * fq + q4) * (R + 8) + x0 + 4 * p4;
    v4s lo = __builtin_amdgcn_ds_read_tr16_b64_v4i16((LDS_AS v4s*)p);
    v4s hi = __builtin_amdgcn_ds_read_tr16_b64_v4i16((LDS_AS v4s*)(p + 4 * (R + 8)));
    bf16x8 r;
    r[0] = lo[0]; r[1] = lo[1]; r[2] = lo[2]; r[3] = lo[3]; r[4] = hi[0]; r[5] = hi[1]; r[6] = hi[2]; r[7] = hi[3];
    return r;
  }
}

template <int TM, int TN, bool AKC, bool BKC, bool TR>
__device__ __forceinline__ void gemm_acc(f32x4 (&acc)[TM / 32][TN / 64], const u16* __restrict__ A, long lda,
                                         const u16* __restrict__ B, long ldb, int K, u16* sm) {
  u16* As = sm;
  u16* Bs = sm + 9216;
  const int tid = TID(), lane = tid & 63, wid = tid >> 6;
  const int wm = wid >> 2, wn = wid & 3, fr = lane & 15, fq = lane >> 4;
  constexpr int MI = TM / 32, NI = TN / 64;
  uint4 ra0 = ld_chunk<TM, AKC>(A, lda, 0, tid), rb0 = ld_chunk<TN, BKC>(B, ldb, 0, tid);
  uint4 ra1 = ra0, rb1 = rb0;
  if (TM == 128) ra1 = ld_chunk<TM, AKC>(A, lda, 0, tid + NT);
  if (TN == 128) rb1 = ld_chunk<TN, BKC>(B, ldb, 0, tid + NT);
  for (int k0 = 0; k0 < K; k0 += 64) {
    __syncthreads();
    st_chunk<TM, AKC>(As, ra0, tid);
    if (TM == 128) st_chunk<TM, AKC>(As, ra1, tid + NT);
    st_chunk<TN, BKC>(Bs, rb0, tid);
    if (TN == 128) st_chunk<TN, BKC>(Bs, rb1, tid + NT);
    __syncthreads();
    if (k0 + 64 < K) {
      ra0 = ld_chunk<TM, AKC>(A, lda, k0 + 64, tid);
      if (TM == 128) ra1 = ld_chunk<TM, AKC>(A, lda, k0 + 64, tid + NT);
      rb0 = ld_chunk<TN, BKC>(B, ldb, k0 + 64, tid);
      if (TN == 128) rb1 = ld_chunk<TN, BKC>(B, ldb, k0 + 64, tid + NT);
    }
#pragma unroll
    for (int ks = 0; ks < 2; ++ks) {
      bf16x8 af[MI], bfr[NI];
#pragma unroll
      for (int mi = 0; mi < MI; ++mi) af[mi] = ld_frag<TM, AKC>(As, wm * (TM / 2) + mi * 16, ks, fr, fq);
#pragma unroll
      for (int ni = 0; ni < NI; ++ni) bfr[ni] = ld_frag<TN, BKC>(Bs, wn * (TN / 4) + ni * 16, ks, fr, fq);
#pragma unroll
      for (int mi = 0; mi < MI; ++mi)
#pragma unroll
        for (int ni = 0; ni < NI; ++ni)
          acc[mi][ni] = TR ? __builtin_amdgcn_mfma_f32_16x16x32_bf16(bfr[ni], af[mi], acc[mi][ni], 0, 0, 0)
                           : __builtin_amdgcn_mfma_f32_16x16x32_bf16(af[mi], bfr[ni], acc[mi][ni], 0, 0, 0);
    }
  }
  __syncthreads();
}

template <int TM, int TN, bool TR, class F>
__device__ __forceinline__ void epi_each(f32x4 (&acc)[TM / 32][TN / 64], F f) {
  const int tid = TID(), lane = tid & 63, wid = tid >> 6;
  const int wm = wid >> 2, wn = wid & 3, fr = lane & 15, fq = lane >> 4;
#pragma unroll
  for (int mi = 0; mi < TM / 32; ++mi)
#pragma unroll
    for (int ni = 0; ni < TN / 64; ++ni) {
      const int r0 = wm * (TM / 2) + mi * 16, c0 = wn * (TN / 4) + ni * 16;
      if (TR) f(r0 + fr, c0 + fq * 4, acc[mi][ni]);
      else f(r0 + fq * 4, c0 + fr, acc[mi][ni]);
    }
}

struct EpiStoreBf16 {
  static constexpr bool PERM = false, AFTER_DRAIN = false;
  u16* O; int ldc;
  __device__ __forceinline__ void operator()(const f32x4 (&acc)[2][2][4][2], const pg8::Unit& u, int wr, int wc, int fr, int fq) const {
    const int row0 = u.pm * 256 + wr * 64 + fr, col0 = u.pn * 256 + wc * 32 + 4 * fq;
#pragma unroll
    for (int ai = 0; ai < 2; ++ai)
#pragma unroll
      for (int m = 0; m < 4; ++m) {
        u16* rowp = O + (size_t)(row0 + ai * 128 + m * 16) * ldc + col0;
#pragma unroll
        for (int bj = 0; bj < 2; ++bj)
#pragma unroll
          for (int n = 0; n < 2; ++n) {
            const f32x4 v = acc[ai][bj][m][n];
            *(uint2*)(rowp + bj * 128 + n * 16) = make_uint2(pack2(v[0], v[1]), pack2(v[2], v[3]));
          }
      }
  }
};
struct EpiResid {
  static constexpr bool PERM = false, AFTER_DRAIN = false;
  float* X; const float* mod; int goff; int slab;
  __device__ __forceinline__ void operator()(const f32x4 (&acc)[2][2][4][2], const pg8::Unit& u, int wr, int wc, int fr, int fq) const {
    const int row0 = u.pm * 256 + wr * 64 + fr, col0 = u.pn * 256 + wc * 32 + 4 * fq;
#pragma unroll
    for (int ai = 0; ai < 2; ++ai)
#pragma unroll
      for (int m = 0; m < 4; ++m) {
        const int r = row0 + ai * 128 + m * 16;
        const float* g = mod + (size_t)gb_of(slab, r) * 6144 + goff + col0;
        float* xp = X + (size_t)r * D + col0;
#pragma unroll
        for (int bj = 0; bj < 2; ++bj)
#pragma unroll
          for (int n = 0; n < 2; ++n) {
            const f32x4 gv = *(const f32x4*)(g + bj * 128 + n * 16);
            f32x4 xv = *(const f32x4*)(xp + bj * 128 + n * 16);
            xv += gv * acc[ai][bj][m][n];
            *(f32x4*)(xp + bj * 128 + n * 16) = xv;
          }
      }
  }
};
struct EpiFfnVal {
  static constexpr bool PERM = false, AFTER_DRAIN = false;
  const u16* G; u16* ACT; const float* cw; const float* cb; int L;
  __device__ __forceinline__ void operator()(const f32x4 (&acc)[2][2][4][2], const pg8::Unit& u, int wr, int wc, int fr, int fq) const {
    const int row0 = u.pm * 256 + wr * 64 + fr, col0 = u.pn * 256 + wc * 32 + 4 * fq;
#pragma unroll
    for (int bj = 0; bj < 2; ++bj)
#pragma unroll
      for (int n = 0; n < 2; ++n) {
        const int c = col0 + bj * 128 + n * 16;
        const f32x4 w0 = *(const f32x4*)(cw + c), w1 = *(const f32x4*)(cw + DFF + c), w2 = *(const f32x4*)(cw + 2 * DFF + c), bb = *(const f32x4*)(cb + c);
#pragma unroll
        for (int ai = 0; ai < 2; ++ai)
#pragma unroll
          for (int m = 0; m < 4; ++m) {
            const int r = row0 + ai * 128 + m * 16;
            const int pos = r & (L - 1);
            const u16* gp = G + (size_t)r * DFF + c;
            const uint2 g1 = *(const uint2*)gp;
            uint2 g0 = make_uint2(0, 0), g2 = make_uint2(0, 0);
            if (pos > 0) g0 = *(const uint2*)(gp - DFF);
            if (pos < L - 1) g2 = *(const uint2*)(gp + DFF);
            f32x4 a;
            a[0] = bf2f((u16)(g0.x & 0xffff)) * w0[0] + bf2f((u16)(g1.x & 0xffff)) * w1[0] + bf2f((u16)(g2.x & 0xffff)) * w2[0] + bb[0];
            a[1] = bf2f((u16)(g0.x >> 16)) * w0[1] + bf2f((u16)(g1.x >> 16)) * w1[1] + bf2f((u16)(g2.x >> 16)) * w2[1] + bb[1];
            a[2] = bf2f((u16)(g0.y & 0xffff)) * w0[2] + bf2f((u16)(g1.y & 0xffff)) * w1[2] + bf2f((u16)(g2.y & 0xffff)) * w2[2] + bb[2];
            a[3] = bf2f((u16)(g0.y >> 16)) * w0[3] + bf2f((u16)(g1.y >> 16)) * w1[3] + bf2f((u16)(g2.y >> 16)) * w2[3] + bb[3];
            const f32x4 v = acc[ai][bj][m][n];
            *(uint2*)(ACT + (size_t)r * DFF + c) = make_uint2(pack2(silu_f(a[0]) * v[0], silu_f(a[1]) * v[1]), pack2(silu_f(a[2]) * v[2], silu_f(a[3]) * v[3]));
          }
      }
  }
};
template <class Epi>
__device__ __forceinline__ void run_gemm(const u16* A, const u16* Bt, int N, int K, const Epi& E) {
  pg8::Gemm g; g.A = A; g.Bt = Bt; g.M = SLAB; g.N = N; g.K = K;
  pg8::StaticOrder S; S.init(SLAB, N, gridDim.x, BID());
  __syncthreads();
  pg8::gemm_phase<Epi, pg8::StaticOrder, false>((PG8_LAS unsigned char*)smem, g, S, E, nullptr);
  __syncthreads();
}

__device__ __forceinline__ void fft_dif(float2* x, int N, const float2* __restrict__ tw) {
  const int tid = TID();
  for (int s = N >> 1; s >= 1; s >>= 1) {
    const int tws = 8192 / s;
    for (int i = tid; i < (N >> 1); i += NT) {
      const int j = i & (s - 1);
      const int p = ((i - j) << 1) + j;
      float2 a = x[p], b = x[p + s];
      float2 w = tw[j * tws];
      x[p] = make_float2(a.x + b.x, a.y + b.y);
      float dx = a.x - b.x, dy = a.y - b.y;
      x[p + s] = make_float2(dx * w.x - dy * w.y, dx * w.y + dy * w.x);
    }
    __syncthreads();
  }
}
__device__ __forceinline__ void ifft_dit(float2* x, int N, const float2* __restrict__ tw) {
  const int tid = TID();
  for (int s = 1; s < N; s <<= 1) {
    const int tws = 8192 / s;
    for (int i = tid; i < (N >> 1); i += NT) {
      const int j = i & (s - 1);
      const int p = ((i - j) << 1) + j;
      float2 a = x[p], b = x[p + s];
      float2 w = tw[j * tws];
      float bx = b.x * w.x + b.y * w.y, by = b.y * w.x - b.x * w.y;
      x[p] = make_float2(a.x + bx, a.y + by);
      x[p + s] = make_float2(a.x - bx, a.y - by);
    }
    __syncthreads();
  }
}

__device__ void transpose_w(const float* __restrict__ W, u16* __restrict__ Wt, int K, int N) {
  float* smf = (float*)smem;
  const int tk = K / 64, tn = N / 64, tid = TID();
  for (int item = BID(); item < tk * tn; item += gridDim.x) {
    const int k0 = (item / tn) * 64, n0 = (item % tn) * 64;
    __syncthreads();
    for (int i = tid; i < 4096; i += NT) {
      int kk = i >> 6, nn = i & 63;
      smf[kk * 65 + nn] = W[(long)(k0 + kk) * N + n0 + nn];
    }
    __syncthreads();
    for (int i = tid; i < 4096; i += NT) {
      int nn = i >> 6, kk = i & 63;
      Wt[(long)(n0 + nn) * K + k0 + kk] = f2bf(smf[kk * 65 + nn]);
    }
  }
  __syncthreads();
}

__device__ void phase_pre0(const Params& P) {
  const int tid = TID();
  const long gtid = (long)BID() * NT + tid, gsz = (long)gridDim.x * NT;
  {
    const float4* s0 = (const float4*)P.in[0];
    const float4* s1 = (const float4*)P.in[1];
    float4* o = (float4*)OUTP(P);
    const long n0 = (long)16384 * 1024 / 4, n1 = (long)65536 * 1024 / 4;
    for (long i = gtid; i < n0; i += gsz) o[i] = s0[i];
    for (long i = gtid; i < n1; i += gsz) o[n0 + i] = s1[i];
  }
  transpose_w(P.in[7], (u16*)(WS(P) + O_WHYIN), 1024, 3072);
  transpose_w(P.in[18], (u16*)(WS(P) + O_WHYOUT), 1024, 1024);
  transpose_w(P.in[19], (u16*)(WS(P) + O_WRETIN), 1024, 6144);
  transpose_w(P.in[21], (u16*)(WS(P) + O_WRETOUT), 2048, 1024);
  transpose_w(P.in[22], (u16*)(WS(P) + O_WSWAIN), 1024, 1536);
  transpose_w(P.in[26], (u16*)(WS(P) + O_WSWAOUT), 1024, 1024);
  transpose_w(P.in[27], (u16*)(WS(P) + O_WHGIN), 1024, 5120);
  transpose_w(P.in[30], (u16*)(WS(P) + O_WHGOUT), 1024, 1024);
  for (int l = 0; l < 4; ++l) {
    transpose_w(P.in[31] + (long)l * 1024 * DFF, (u16*)(WS(P) + O_WFG) + (long)l * DFF * 1024, 1024, DFF);
    transpose_w(P.in[32] + (long)l * 1024 * DFF, (u16*)(WS(P) + O_WFV) + (long)l * DFF * 1024, 1024, DFF);
    transpose_w(P.in[35] + (long)l * DFF * 1024, (u16*)(WS(P) + O_WFD) + (long)l * 1024 * DFF, DFF, 1024);
  }
  {
    float* cs = (float*)smem;
    float* modp = (float*)(WS(P) + O_MODP);
    for (int item = BID(); item < 4 * 8 * 12; item += gridDim.x) {
      const int nb = item % 12, ks = (item / 12) % 8, l = item / 96;
      __syncthreads();
      for (int i = tid; i < 2048; i += NT) {
        int b = i >> 7, k = i & 127;
        float c = (b < 8) ? P.in[2][b * 1024 + ks * 128 + k] : P.in[3][(b - 8) * 1024 + ks * 128 + k];
        cs[i] = c / (1.f + expf(-c));
      }
      __syncthreads();
      const int n = nb * 512 + tid;
      float a[16];
#pragma unroll
      for (int b = 0; b < 16; ++b) a[b] = 0.f;
      const float* w = P.in[4] + ((long)l * 1024 + ks * 128) * 6144 + n;
      for (int k = 0; k < 128; ++k) {
        float wv = w[(long)k * 6144];
#pragma unroll
        for (int b = 0; b < 16; ++b) a[b] += cs[b * 128 + k] * wv;
      }
#pragma unroll
      for (int b = 0; b < 16; ++b) modp[(((long)ks * 4 + l) * 16 + b) * 6144 + n] = a[b];
    }
    __syncthreads();
  }
  {
    float2* tw = (float2*)(WS(P) + O_TW);
    for (long i = gtid; i < 8192; i += gsz) {
      float s, c;
      sincospif((float)i * (1.f / 8192.f), &s, &c);
      tw[i] = make_float2(c, -s);
    }
    float2* rr = (float2*)(WS(P) + O_ROPER);
    for (long i = gtid; i < (long)8192 * 128; i += gsz) {
      int pos = (int)(i >> 7), d = (int)(i & 127);
      float inv = exp2f(-(float)d * (13.287712379549449f / 128.f));
      float s, c;
      sincosf((float)pos * inv, &s, &c);
      rr[i] = make_float2(c, s);
    }
    float2* rs = (float2*)(WS(P) + O_ROPES);
    for (long i = gtid; i < (long)8192 * 32; i += gsz) {
      int pos = (int)(i >> 5), d = (int)(i & 31);
      float inv = exp2f(-(float)d * (13.287712379549449f / 32.f));
      float s, c;
      sincosf((float)pos * inv, &s, &c);
      rs[i] = make_float2(c, s);
    }
  }
  {
    float* zf = (float*)smem;
    float* h1 = zf + 8 * 36;
    const float* w1 = P.in[10]; const float* b1 = P.in[11]; const float* w2 = P.in[12]; const float* b2 = P.in[13];
    const float* fr = P.in[15];
    const int tl = tid >> 6, j = tid & 63;
    for (int item = BID(); item < 1280; item += gridDim.x) {
      const int sel = item >= 1024;
      const int L = sel ? 2048 : 8192;
      const int t = (sel ? item - 1024 : item) * 8 + tl;
      float* hid = (float*)(WS(P) + (sel ? O_HIDP : O_HIDS));
      __syncthreads();
      if (j < 33) {
        float v;
        if (j == 0) v = (float)t / (float)(L - 1);
        else {
          int i = (j - 1) & 15;
          float band = 1e-4f + (float)i * ((15.f - 1e-4f) / 15.f);
          float ang = (6.283185307179586f / (float)L) * (float)t;
          float a = band * ang;
          v = (j <= 16) ? cosf(a) : -sinf(a);
        }
        zf[tl * 36 + j] = v;
      }
      __syncthreads();
      float s = b1[j];
#pragma unroll 3
      for (int i = 0; i < 33; ++i) s += zf[tl * 36 + i] * w1[i * 64 + j];
      h1[tl * 64 + j] = sinf(fr[j] * s);
      __syncthreads();
      float s2 = b2[j];
#pragma unroll 4
      for (int i = 0; i < 64; ++i) s2 += h1[tl * 64 + i] * w2[i * 64 + j];
      hid[(long)t * 64 + j] = sinf(fr[j] * s2);
    }
    __syncthreads();
  }
}

__device__ void phase_pre1(const Params& P) {
  __shared__ float w3s[128];
  __shared__ float red[8];
  const int tid = TID(), lane = tid & 63, wid = tid >> 6;
  const long gtid = (long)BID() * NT + tid, gsz = (long)gridDim.x * NT;
  {
    const float* modp = (const float*)(WS(P) + O_MODP);
    float* mod = (float*)(WS(P) + O_MOD);
    for (long i = gtid; i < (long)4 * 16 * 6144; i += gsz) {
      int n = (int)(i % 6144);
      int l = (int)(i / (16 * 6144));
      float s = P.in[5][l * 6144 + n];
      for (int ks = 0; ks < 8; ++ks) s += modp[(long)ks * 4 * 16 * 6144 + i];
      mod[i] = s;
    }
  }
  float2* buf = (float2*)smem;
  const float2* tw = (const float2*)(WS(P) + O_TW);
  for (int item = BID(); item < 2048; item += gridDim.x) {
    const int sel = item >> 10, c = item & 1023;
    const int L = sel ? 2048 : 8192, N = 2 * L;
    const float* hid = (const float*)(WS(P) + (sel ? O_HIDP : O_HIDS));
    float2* hs = (float2*)(WS(P) + (sel ? O_HSPP : O_HSPS)) + (long)c * N;
    __syncthreads();
    if (tid < 128) {
      int dirn = tid >> 6, j = tid & 63;
      w3s[tid] = P.in[14][(long)j * 2048 + dirn * 1024 + c];
    }
    __syncthreads();
    const float dec0 = fabsf(P.in[16][c]), dec1 = fabsf(P.in[16][1024 + c]);
    const float invLm1 = 1.f / (float)(L - 1);
    float asum = 0.f;
    for (int n = tid; n < N; n += NT) {
      float val = 0.f;
      if (n != L) {
        const int dirn = n < L ? 0 : 1;
        const int t = n < L ? n : N - n;
        const float4* hr = (const float4*)(hid + (long)t * 64);
        const float* w = w3s + dirn * 64;
        float s = 0.f;
#pragma unroll
        for (int q = 0; q < 16; ++q) {
          float4 h4 = hr[q];
          s += h4.x * w[4 * q] + h4.y * w[4 * q + 1] + h4.z * w[4 * q + 2] + h4.w * w[4 * q + 3];
        }
        float tl = (float)t * invLm1;
        val = s * expf(-tl * (dirn ? dec1 : dec0));
      }
      buf[n] = make_float2(val, 0.f);
      asum += fabsf(val);
    }
    asum = wave_sum(asum);
    if (lane == 0) red[wid] = asum;
    __syncthreads();
    float tot = 0.f;
#pragma unroll
    for (int w = 0; w < 8; ++w) tot += red[w];
    const float scale = 1.f / (tot * (float)N);
    fft_dif(buf, N, tw);
    for (int p = tid; p < N; p += NT) {
      float2 a = buf[p];
      hs[p] = make_float2(a.x * scale, a.y * scale);
    }
  }
  __syncthreads();
}

__device__ void phase_norm(const Params& P, int layer, int slab, int which) {
  const float* x = OUTP(P) + (long)slab * SLAB * D;
  u16* h = (u16*)(WS(P) + O_HBUF);
  const float* gain = P.in[6] + (layer * 2 + which) * D;
  const float* mod = (const float*)(WS(P) + O_MOD) + (long)layer * 16 * 6144;
  const int shoff = which ? 3 * D : 0, scoff = which ? 4 * D : D;
  const int tid = TID(), lane = tid & 63, wid = tid >> 6;
  for (int item = BID(); item < SLAB / 8; item += gridDim.x) {
    const int r = item * 8 + wid;
    const float* xr = x + (long)r * D;
    float4 v[4];
    float ss = 0.f;
#pragma unroll
    for (int i = 0; i < 4; ++i) {
      v[i] = *(const float4*)(xr + i * 256 + lane * 4);
      ss += v[i].x * v[i].x + v[i].y * v[i].y + v[i].z * v[i].z + v[i].w * v[i].w;
    }
    ss = wave_sum(ss);
    const float rstd = rsqrtf(ss * (1.f / 1024.f) + 1e-6f);
    const float* m = mod + (long)gb_of(slab, r) * 6144;
#pragma unroll
    for (int i = 0; i < 4; ++i) {
      const int col = i * 256 + lane * 4;
      float4 g = *(const float4*)(gain + col);
      float4 sc = *(const float4*)(m + scoff + col);
      float4 sh = *(const float4*)(m + shoff + col);
      float y0 = v[i].x * rstd * g.x * (1.f + sc.x) + sh.x;
      float y1 = v[i].y * rstd * g.y * (1.f + sc.y) + sh.y;
      float y2 = v[i].z * rstd * g.z * (1.f + sc.z) + sh.z;
      float y3 = v[i].w * rstd * g.w * (1.f + sc.w) + sh.w;
      uint2 o = make_uint2(pack2(y0, y1), pack2(y2, y3));
      *(uint2*)(h + (long)r * D + col) = o;
    }
  }
}

__device__ void phase_proj(const Params& P, size_t woff, int N) {
  EpiStoreBf16 E; E.O = (u16*)(WS(P) + O_PROJ); E.ldc = N;
  run_gemm((const u16*)(WS(P) + O_HBUF), (const u16*)(WS(P) + woff), N, D, E);
}
__device__ void phase_resid(const Params& P, int layer, int slab, const u16* A, int K, size_t woff, int goff) {
  EpiResid E; E.X = OUTP(P) + (long)slab * SLAB * D; E.mod = (const float*)(WS(P) + O_MOD) + (long)layer * 16 * 6144; E.goff = goff; E.slab = slab;
  run_gemm(A, (const u16*)(WS(P) + woff), D, K, E);
}

__device__ void phase_ffn_gate(const Params& P, int layer) {
  EpiStoreBf16 E; E.O = (u16*)(WS(P) + O_GBUF); E.ldc = DFF;
  run_gemm((const u16*)(WS(P) + O_HBUF), (const u16*)(WS(P) + O_WFG) + (long)layer * DFF * D, DFF, D, E);
}
__device__ void phase_ffn_val(const Params& P, int layer, int slab) {
  EpiFfnVal E; E.G = (const u16*)(WS(P) + O_GBUF); E.ACT = (u16*)(WS(P) + O_ACT);
  E.cw = P.in[33] + (long)layer * 3 * DFF; E.cb = P.in[34] + (long)layer * DFF; E.L = Lof(slab);
  run_gemm((const u16*)(WS(P) + O_HBUF), (const u16*)(WS(P) + O_WFV) + (long)layer * DFF * D, DFF, D, E);
}

__device__ void phase_hy_conv(const Params& P, int slab) {
  const int L = Lof(slab), nseq = SLAB / L, tid = TID();
  const u16* z = (const u16*)(WS(P) + O_PROJ);
  float* uT = (float*)(WS(P) + O_UT);
  u16* x0c = (u16*)(WS(P) + O_X0C);
  const float* cw = P.in[8];
  const float* cb = P.in[9];
  float* tile = (float*)smem;
  const int ntt = L / 64;
  const int nitems = nseq * ntt * 16;
  for (int item = BID(); item < nitems; item += gridDim.x) {
    const int ct = item % 16, tt = (item / 16) % ntt, seq = item / (16 * ntt);
    __syncthreads();
    for (int i = tid; i < 4096; i += NT) {
      const int tl = i >> 6, cl = i & 63;
      const int t = tt * 64 + tl, c = ct * 64 + cl;
      const long row = (long)seq * L + t;
      float val[3];
#pragma unroll
      for (int q = 0; q < 3; ++q) {
        const int col = q * 1024 + c;
        float a = bf2f(z[row * 3072 + col]) * cw[3072 + col] + cb[col];
        if (t > 0) a += bf2f(z[(row - 1) * 3072 + col]) * cw[col];
        if (t < L - 1) a += bf2f(z[(row + 1) * 3072 + col]) * cw[2 * 3072 + col];
        val[q] = a;
      }
      x0c[row * 1024 + c] = f2bf(val[0]);
      tile[tl * 65 + cl] = val[1] * val[2];
    }
    __syncthreads();
    for (int i = tid; i < 4096; i += NT) {
      const int cl = i >> 6, tl = i & 63;
      uT[((long)seq * 1024 + ct * 64 + cl) * L + tt * 64 + tl] = tile[tl * 65 + cl];
    }
  }
  __syncthreads();
}

__device__ void phase_hy_fft(const Params& P, int slab) {
  const int L = Lof(slab), N = 2 * L, nseq = SLAB / L, tid = TID();
  float* uT = (float*)(WS(P) + O_UT);
  const float2* hsb = (const float2*)(WS(P) + (slab == 0 ? O_HSPP : O_HSPS));
  const float2* tw = (const float2*)(WS(P) + O_TW);
  const float* skip = P.in[17];
  float2* buf = (float2*)smem;
  const int nitems = (nseq / 2) * 1024;
  for (int item = BID(); item < nitems; item += gridDim.x) {
    const int pr = item >> 10, c = item & 1023;
    float* u0 = uT + ((long)(pr * 2) * 1024 + c) * L;
    float* u1 = u0 + (long)1024 * L;
    __syncthreads();
    for (int t = tid; t < L; t += NT) {
      buf[t] = make_float2(u0[t], u1[t]);
      buf[t + L] = make_float2(0.f, 0.f);
    }
    __syncthreads();
    fft_dif(buf, N, tw);
    const float2* h = hsb + (long)c * N;
    for (int p = tid; p < N; p += NT) {
      float2 a = buf[p], b = h[p];
      buf[p] = make_float2(a.x * b.x - a.y * b.y, a.x * b.y + a.y * b.x);
    }
    __syncthreads();
    ifft_dit(buf, N, tw);
    const float sk = skip[c];
    for (int t = tid; t < L; t += NT) {
      float2 y = buf[t];
      u0[t] = y.x + u0[t] * sk;
      u1[t] = y.y + u1[t] * sk;
    }
  }
  __syncthreads();
}

__device__ void phase_hy_tr(const Params& P, int slab) {
  const int L = Lof(slab), nseq = SLAB / L, tid = TID();
  const float* yT = (const float*)(WS(P) + O_UT);
  const u16* x0c = (const u16*)(WS(P) + O_X0C);
  u16* a2 = (u16*)(WS(P) + O_A2);
  float* tile = (float*)smem;
  const int ntt = L / 64;
  const int nitems = nseq * ntt * 16;
  for (int item = BID(); item < nitems; item += gridDim.x) {
    const int ct = item % 16, tt = (item / 16) % ntt, seq = item / (16 * ntt);
    __syncthreads();
    for (int i = tid; i < 4096; i += NT) {
      const int cl = i >> 6, tl = i & 63;
      tile[cl * 65 + tl] = yT[((long)seq * 1024 + ct * 64 + cl) * L + tt * 64 + tl];
    }
    __syncthreads();
    for (int i = tid; i < 4096; i += NT) {
      const int tl = i >> 6, cl = i & 63;
      const long row = (long)seq * L + tt * 64 + tl;
      const int c = ct * 64 + cl;
      a2[row * 1024 + c] = f2bf(tile[cl * 65 + tl] * bf2f(x0c[row * 1024 + c]));
    }
  }
  __syncthreads();
}

struct Rec {
  int H, DK, DV, C;
  int ldv, voff, goff;
};
__device__ __forceinline__ Rec rec_of(int kind) {
  Rec r;
  if (kind == 1) { r.H = 4; r.DK = 256; r.DV = 512; r.C = 128; r.ldv = 6144; r.voff = 2048; r.goff = 4096; }
  else { r.H = 8; r.DK = 128; r.DV = 128; r.C = 64; r.ldv = 5120; r.voff = 1024; r.goff = 4096; }
  return r;
}

__device__ void phase_ret_prep(const Params& P, int slab) {
  const int L = Lof(slab);
  const u16* pj = (const u16*)(WS(P) + O_PROJ);
  u16* qdf = (u16*)(WS(P) + O_QDF); u16* qdb = (u16*)(WS(P) + O_QDB);
  u16* kif = (u16*)(WS(P) + O_KIF); u16* kib = (u16*)(WS(P) + O_KIB);
  u16* kef = (u16*)(WS(P) + O_KEF); u16* keb = (u16*)(WS(P) + O_KEB);
  float* dlf = (float*)(WS(P) + O_DLF); float* dlb = (float*)(WS(P) + O_DLB);
  const float2* rope = (const float2*)(WS(P) + O_ROPER);
  const long gtid = (long)BID() * NT + TID(), gsz = (long)gridDim.x * NT;
  for (long idx = gtid; idx < (long)SLAB * 512; idx += gsz) {
    const int d = (int)(idx & 127), h = (int)((idx >> 7) & 3), t = (int)(idx >> 9);
    const int pos = t & (L - 1), r = t & 127;
    const float lgf = -expf(P.in[20][h]), lgb = -expf(P.in[20][4 + h]);
    const u16* row = pj + (long)t * 6144;
    const float q1 = bf2f(row[h * 256 + d]), q2 = bf2f(row[h * 256 + d + 128]);
    const float k1 = bf2f(row[1024 + h * 256 + d]), k2 = bf2f(row[1024 + h * 256 + d + 128]);
    const float2 cs = rope[(long)pos * 128 + d];
    const float qa = q1 * cs.x - q2 * cs.y, qb = q1 * cs.y + q2 * cs.x;
    const float ka = (k1 * cs.x - k2 * cs.y) * 0.0625f, kb = (k1 * cs.y + k2 * cs.x) * 0.0625f;
    const float bf = (float)(r + 1) * lgf, bb = (float)(128 - r) * lgb;
    const float ef = expf(bf), eif = expf(-bf), eef = expf((float)(127 - r) * lgf);
    const float eb = expf(bb), eib = expf(-bb), eeb = expf((float)r * lgb);
    const long o1 = (long)t * 1024 + h * 256 + d, o2 = o1 + 128;
    qdf[o1] = f2bf(qa * ef); qdf[o2] = f2bf(qb * ef);
    qdb[o1] = f2bf(qa * eb); qdb[o2] = f2bf(qb * eb);
    kif[o1] = f2bf(ka * eif); kif[o2] = f2bf(kb * eif);
    kib[o1] = f2bf(ka * eib); kib[o2] = f2bf(kb * eib);
    kef[o1] = f2bf(ka * eef); kef[o2] = f2bf(kb * eef);
    keb[o1] = f2bf(ka * eeb); keb[o2] = f2bf(kb * eeb);
    if (r == 0) {
      const long cgi = (long)(t >> 7) * 1024 + h * 256 + d;
      const float df = expf(128.f * lgf), db = expf(128.f * lgb);
      dlf[cgi] = df; dlf[cgi + 128] = df;
      dlb[cgi] = db; dlb[cgi + 128] = db;
    }
  }
}

__device__ void phase_hg_prep(const Params& P) {
  const u16* pj = (const u16*)(WS(P) + O_PROJ);
  u16* qdf = (u16*)(WS(P) + O_QDF); u16* qdb = (u16*)(WS(P) + O_QDB);
  u16* kif = (u16*)(WS(P) + O_KIF); u16* kib = (u16*)(WS(P) + O_KIB);
  u16* kef = (u16*)(WS(P) + O_KEF); u16* keb = (u16*)(WS(P) + O_KEB);
  float* dlf = (float*)(WS(P) + O_DLF); float* dlb = (float*)(WS(P) + O_DLB);
  const float* lbt = P.in[28];
  for (int item = BID(); item < 512; item += gridDim.x) {
    const int cgi = item >> 1, ch = (item & 1) * 512 + TID();
    float lb[2];
#pragma unroll
    for (int dr = 0; dr < 2; ++dr) {
      float a0 = lbt[(dr * 4 + 0) * 1024 + ch], a1 = lbt[(dr * 4 + 1) * 1024 + ch], a2 = lbt[(dr * 4 + 2) * 1024 + ch], a3 = lbt[(dr * 4 + 3) * 1024 + ch];
      float m = fmaxf(fmaxf(a0, a1), fmaxf(a2, a3));
      float e0 = expf(a0 - m), e1 = expf(a1 - m), e2 = expf(a2 - m), e3 = expf(a3 - m);
      lb[dr] = (e0 + e1 + e2) / (e0 + e1 + e2 + e3);
    }
    const long t0 = (long)cgi * 64;
    float totf = 0.f, totb = 0.f;
    for (int r = 0; r < 64; ++r) {
      const u16* row = pj + (t0 + r) * 5120;
      float xf = bf2f(row[2048 + ch]), xb = bf2f(row[3072 + ch]);
      totf += logf(lb[0] + (1.f - lb[0]) * sigm(xf));
      totb += logf(lb[1] + (1.f - lb[1]) * sigm(xb));
    }
    float b = 0.f;
    for (int r = 0; r < 64; ++r) {
      const u16* row = pj + (t0 + r) * 5120;
      const float q = silu_f(bf2f(row[ch]));
      const float xf = bf2f(row[2048 + ch]);
      b += logf(lb[0] + (1.f - lb[0]) * sigm(xf));
      const float k = (1.f - lb[0]) * sigm(-xf);
      const long o = (t0 + r) * 1024 + ch;
      qdf[o] = f2bf(q * expf(b));
      kif[o] = f2bf(k * expf(-b));
      kef[o] = f2bf(k * expf(totf - b));
    }
    b = 0.f;
    for (int r = 63; r >= 0; --r) {
      const u16* row = pj + (t0 + r) * 5120;
      const float q = silu_f(bf2f(row[ch]));
      const float xb = bf2f(row[3072 + ch]);
      b += logf(lb[1] + (1.f - lb[1]) * sigm(xb));
      const float k = (1.f - lb[1]) * sigm(-xb);
      const long o = (t0 + r) * 1024 + ch;
      qdb[o] = f2bf(q * expf(b));
      kib[o] = f2bf(k * expf(-b));
      keb[o] = f2bf(k * expf(totb - b));
    }
    dlf[(long)cgi * 1024 + ch] = expf(totf);
    dlb[(long)cgi * 1024 + ch] = expf(totb);
  }
}

template <int C>
__device__ __forceinline__ void rec_scores_item(const Params& P, const Rec& R, int cgi, int h) {
  const u16* qdf = (const u16*)(WS(P) + O_QDF); const u16* qdb = (const u16*)(WS(P) + O_QDB);
  const u16* kif = (const u16*)(WS(P) + O_KIF); const u16* kib = (const u16*)(WS(P) + O_KIB);
  u16* sc = (u16*)(WS(P) + O_SC) + ((long)cgi * R.H + h) * C * C;
  const long off = (long)cgi * C * 1024 + h * R.DK;
  f32x4 af[C / 32][C / 64] = {}, ab[C / 32][C / 64] = {};
  gemm_acc<C, C, true, true, true>(af, qdf + off, 1024, kif + off, 1024, R.DK, (u16*)smem);
  gemm_acc<C, C, true, true, true>(ab, qdb + off, 1024, kib + off, 1024, R.DK, (u16*)smem);
  const int tid = TID(), lane = tid & 63, wid = tid >> 6;
  const int wm = wid >> 2, wn = wid & 3, fr = lane & 15, fq = lane >> 4;
#pragma unroll
  for (int mi = 0; mi < C / 32; ++mi)
#pragma unroll
    for (int ni = 0; ni < C / 64; ++ni) {
      const int r = wm * (C / 2) + mi * 16 + fr, c0 = wn * (C / 4) + ni * 16 + fq * 4;
      float v[4];
#pragma unroll
      for (int j = 0; j < 4; ++j) {
        const int c = c0 + j;
        v[j] = (c <= r ? af[mi][ni][j] : 0.f) + (c >= r ? ab[mi][ni][j] : 0.f);
      }
      *(uint2*)(sc + r * C + c0) = make_uint2(pack2(v[0], v[1]), pack2(v[2], v[3]));
    }
}

template <int C>
__device__ void phase_rec_su(const Params& P, int kind) {
  const Rec R = rec_of(kind);
  const int nch = SLAB / C;
  const int n_sc = nch * R.H;
  const int mtn = R.DK / 128, ntn = R.DV / 128;
  const int n_u = nch * R.H * 2 * mtn * ntn;
  const u16* pj = (const u16*)(WS(P) + O_PROJ);
  for (int item = BID(); item < n_sc + n_u; item += gridDim.x) {
    if (item < n_sc) {
      rec_scores_item<C>(P, R, item / R.H, item % R.H);
    } else {
      int q = item - n_sc;
      const int nt = q % ntn; q /= ntn;
      const int mt = q % mtn; q /= mtn;
      const int dir = q & 1; q >>= 1;
      const int h = q % R.H, cgi = q / R.H;
      const u16* ke = (const u16*)(WS(P) + (dir ? O_KEB : O_KEF)) + (long)cgi * C * 1024 + h * R.DK + mt * 128;
      const u16* v = pj + (long)cgi * C * R.ldv + R.voff + h * R.DV + nt * 128;
      u16* st = (u16*)(WS(P) + (dir ? O_STB : O_STF)) + (((long)cgi * R.H + h) * R.DV + nt * 128) * R.DK + mt * 128;
      f32x4 acc[4][2] = {};
      gemm_acc<128, 128, false, false, false>(acc, ke, 1024, v, R.ldv, C, (u16*)smem);
      const int DK = R.DK;
      epi_each<128, 128, false>(acc, [&](int r, int c, f32x4 val) {
        *(uint2*)(st + (long)c * DK + r) = make_uint2(pack2(val[0], val[1]), pack2(val[2], val[3]));
      });
    }
  }
}

__device__ void phase_rec_scan(const Params& P, int kind, int slab) {
  const Rec R = rec_of(kind);
  const int L = Lof(slab), nseq = SLAB / L, ncs = L / R.C;
  const int hdk = R.DK / 2;
  const long per = (long)R.H * R.DV * hdk;
  const long total = 2 * nseq * per;
  const long gtid = (long)BID() * NT + TID(), gsz = (long)gridDim.x * NT;
  for (long idx = gtid; idx < total; idx += gsz) {
    long q = idx;
    const int pd = (int)(q % hdk); q /= hdk;
    const int e = (int)(q % R.DV); q /= R.DV;
    const int h = (int)(q % R.H); q /= R.H;
    const int seq = (int)(q % nseq);
    const int dir = (int)(q / nseq);
    u16* st = (u16*)(WS(P) + (dir ? O_STB : O_STF));
    const float* dl = (const float*)(WS(P) + (dir ? O_DLB : O_DLF));
    float s0 = 0.f, s1 = 0.f;
    const long ebase = ((long)h * R.DV + e) * R.DK + pd * 2;
    const long cstride = (long)R.H * R.DV * R.DK;
    const int dbase = h * R.DK + pd * 2;
    for (int i0 = 0; i0 < ncs; i0 += 8) {
      unsigned u[8];
      float2 dd[8];
#pragma unroll
      for (int j = 0; j < 8; ++j) {
        const int n = dir ? (ncs - 1 - i0 - j) : (i0 + j);
        const long cgi = (long)seq * ncs + n;
        u[j] = *(const unsigned*)(st + cgi * cstride + ebase);
        dd[j] = *(const float2*)(dl + cgi * 1024 + dbase);
      }
#pragma unroll
      for (int j = 0; j < 8; ++j) {
        const int n = dir ? (ncs - 1 - i0 - j) : (i0 + j);
        const long cgi = (long)seq * ncs + n;
        *(unsigned*)(st + cgi * cstride + ebase) = pack2(s0, s1);
        s0 = dd[j].x * s0 + bf2f((u16)(u[j] & 0xffff));
        s1 = dd[j].y * s1 + bf2f((u16)(u[j] >> 16));
      }
    }
  }
}

template <int C>
__device__ void phase_rec_out(const Params& P, int kind) {
  const Rec R = rec_of(kind);
  const int nch = SLAB / C, ntn = R.DV / 128;
  const u16* pj = (const u16*)(WS(P) + O_PROJ);
  float* ob = (float*)(WS(P) + O_OBUF);
  const int HDV = R.H * R.DV;
  for (int item = BID(); item < nch * R.H * ntn; item += gridDim.x) {
    const int nt = item % ntn, h = (item / ntn) % R.H, cgi = item / (ntn * R.H);
    f32x4 acc[C / 32][2] = {};
    const u16* sc = (const u16*)(WS(P) + O_SC) + ((long)cgi * R.H + h) * C * C;
    const u16* v = pj + (long)cgi * C * R.ldv + R.voff + h * R.DV + nt * 128;
    gemm_acc<C, 128, true, false, true>(acc, sc, C, v, R.ldv, C, (u16*)smem);
    const long qoff = (long)cgi * C * 1024 + h * R.DK;
    const long soff = (((long)cgi * R.H + h) * R.DV + nt * 128) * R.DK;
    gemm_acc<C, 128, true, true, true>(acc, (const u16*)(WS(P) + O_QDF) + qoff, 1024, (const u16*)(WS(P) + O_STF) + soff, R.DK, R.DK, (u16*)smem);
    gemm_acc<C, 128, true, true, true>(acc, (const u16*)(WS(P) + O_QDB) + qoff, 1024, (const u16*)(WS(P) + O_STB) + soff, R.DK, R.DK, (u16*)smem);
    float* o = ob + (long)cgi * C * HDV + h * R.DV + nt * 128;
    epi_each<C, 128, true>(acc, [&](int r, int c, f32x4 val) { *(f32x4*)(o + (long)r * HDV + c) = val; });
  }
}

__device__ void phase_rec_ng(const Params& P, int kind) {
  const Rec R = rec_of(kind);
  const int HDV = R.H * R.DV;
  const float* ob = (const float*)(WS(P) + O_OBUF);
  const u16* pj = (const u16*)(WS(P) + O_PROJ);
  u16* a2 = (u16*)(WS(P) + O_A2);
  const float* gain = (kind == 3) ? P.in[29] : nullptr;
  const int tid = TID(), lane = tid & 63, wid = tid >> 6;
  const int nrows = SLAB * R.H;
  const int per = R.DV / 64;
  for (int item = BID(); item < nrows / 8; item += gridDim.x) {
    const int rh = item * 8 + wid;
    const int t = rh / R.H, h = rh % R.H;
    const float* o = ob + (long)t * HDV + h * R.DV + lane * per;
    float ss = 0.f;
    for (int i = 0; i < per; ++i) { float v = o[i]; ss += v * v; }
    ss = wave_sum(ss);
    const float rstd = rsqrtf(ss / (float)R.DV + 1e-6f);
    const u16* g = pj + (long)t * R.ldv + R.goff + h * R.DV + lane * per;
    u16* out = a2 + (long)t * HDV + h * R.DV + lane * per;
    for (int i = 0; i < per; ++i) {
      float y = o[i] * rstd;
      if (gain) y *= gain[lane * per + i];
      out[i] = f2bf(y * silu_f(bf2f(g[i])));
    }
  }
}

__device__ void phase_swa_prep(const Params& P, int slab) {
  const int L = Lof(slab);
  const u16* pj = (const u16*)(WS(P) + O_PROJ);
  u16* qn = (u16*)(WS(P) + O_QN);
  u16* kn = (u16*)(WS(P) + O_KN);
  const float2* rope = (const float2*)(WS(P) + O_ROPES);
  const long gtid = (long)BID() * NT + TID(), gsz = (long)gridDim.x * NT;
  for (long idx = gtid; idx < (long)SLAB * 640; idx += gsz) {
    const int d = (int)(idx & 31);
    const int hd = (int)((idx >> 5) % 20);
    const int t = (int)(idx / 640);
    const int col = hd < 16 ? hd * 64 : 1024 + (hd - 16) * 64;
    const float x1 = bf2f(pj[(long)t * 1536 + col + d]), x2 = bf2f(pj[(long)t * 1536 + col + d + 32]);
    float ss = x1 * x1 + x2 * x2;
#pragma unroll
    for (int o = 16; o; o >>= 1) ss += __shfl_xor(ss, o);
    const float rstd = rsqrtf(ss * (1.f / 64.f) + 1e-6f);
    const float* gn = hd < 16 ? P.in[23] : P.in[24];
    const float y1 = x1 * rstd * gn[d], y2 = x2 * rstd * gn[d + 32];
    const float2 cs = rope[(long)(t & (L - 1)) * 32 + d];
    float o1 = y1 * cs.x - y2 * cs.y, o2 = y1 * cs.y + y2 * cs.x;
    if (hd < 16) {
      qn[(long)t * 1024 + hd * 64 + d] = f2bf(o1 * 0.125f);
      qn[(long)t * 1024 + hd * 64 + d + 32] = f2bf(o2 * 0.125f);
    } else {
      kn[(long)t * 256 + (hd - 16) * 64 + d] = f2bf(o1);
      kn[(long)t * 256 + (hd - 16) * 64 + d + 32] = f2bf(o2);
    }
  }
}

constexpr int SLD = 324;
__device__ void phase_swa_att1(const Params& P, int slab) {
  const int L = Lof(slab), nqb = L / 64;
  const u16* qn = (const u16*)(WS(P) + O_QN);
  const u16* kn = (const u16*)(WS(P) + O_KN);
  u16* pb = (u16*)(WS(P) + O_PBUF);
  const float* sink = P.in[25];
  float* S = (float*)(smem + 40960);
  const int tid = TID();
  const int nitems = (SLAB / 64) * 16;
  for (int item = BID(); item < nitems; item += gridDim.x) {
    const int hq = item & 15, qbg = item >> 4;
    const int seq = qbg / nqb, qb = qbg % nqb;
    const int q0 = qb * 64;
    const long tok0 = (long)seq * L;
    const int hkv = hq >> 2;
    for (int kt = 0; kt < 5; ++kt) {
      const int kp0 = q0 - 128 + kt * 64;
      if (kp0 >= 0 && kp0 < L) {
        f32x4 acc[2][1] = {};
        gemm_acc<64, 64, true, true, true>(acc, qn + (tok0 + q0) * 1024 + hq * 64, 1024, kn + (tok0 + kp0) * 256 + hkv * 64, 256, 64, (u16*)smem);
        epi_each<64, 64, true>(acc, [&](int r, int c, f32x4 v) {
          f32x4 o;
#pragma unroll
          for (int j = 0; j < 4; ++j) {
            const int dlt = (q0 + r) - (kp0 + c + j);
            o[j] = (dlt <= 128 && dlt >= -128) ? v[j] : -1e30f;
          }
          *(f32x4*)(S + r * SLD + kt * 64 + c) = o;
        });
      } else {
        for (int i = tid; i < 4096; i += NT) S[(i >> 6) * SLD + kt * 64 + (i & 63)] = -1e30f;
      }
    }
    __syncthreads();
    {
      const int r = tid >> 3, sub = tid & 7;
      const float sk = sink[hq];
      float m = sk;
      for (int c = sub; c < 320; c += 8) m = fmaxf(m, S[r * SLD + c]);
      m = fmaxf(m, __shfl_xor(m, 1)); m = fmaxf(m, __shfl_xor(m, 2)); m = fmaxf(m, __shfl_xor(m, 4));
      float den = 0.f;
      for (int c = sub; c < 320; c += 8) { float e = __expf(S[r * SLD + c] - m); S[r * SLD + c] = e; den += e; }
      den += __shfl_xor(den, 1); den += __shfl_xor(den, 2); den += __shfl_xor(den, 4);
      den += __expf(sk - m);
      const float inv = 1.f / den;
      u16* prow = pb + ((long)item * 64 + r) * 320;
      for (int c = sub; c < 320; c += 8) prow[c] = f2bf(S[r * SLD + c] * inv);
    }
    __syncthreads();
  }
}

__device__ void phase_swa_att2(const Params& P, int slab) {
  const int L = Lof(slab), nqb = L / 64;
  const u16* pj = (const u16*)(WS(P) + O_PROJ);
  const u16* pb = (const u16*)(WS(P) + O_PBUF);
  u16* a2 = (u16*)(WS(P) + O_A2);
  const int nitems = (SLAB / 64) * 16;
  for (int item = BID(); item < nitems; item += gridDim.x) {
    const int hq = item & 15, qbg = item >> 4;
    const int seq = qbg / nqb, qb = qbg % nqb;
    const int q0 = qb * 64;
    const long tok0 = (long)seq * L;
    const int hkv = hq >> 2;
    f32x4 acc[2][1] = {};
    for (int kt = 0; kt < 5; ++kt) {
      const int kp0 = q0 - 128 + kt * 64;
      if (kp0 >= 0 && kp0 < L)
        gemm_acc<64, 64, true, false, true>(acc, pb + (long)item * 64 * 320 + kt * 64, 320, pj + (tok0 + kp0) * 1536 + 1280 + hkv * 64, 1536, 64, (u16*)smem);
    }
    u16* o = a2 + (tok0 + q0) * 1024 + hq * 64;
    epi_each<64, 64, true>(acc, [&](int r, int c, f32x4 v) { *(uint2*)(o + (long)r * 1024 + c) = make_uint2(pack2(v[0], v[1]), pack2(v[2], v[3])); });
  }
}

__device__ __forceinline__ int nsteps_of(int kind) { return (kind & 1) ? 12 : 10; }

__device__ void layer_step(const Params& P, int layer, int slab, int step) {
  const int kind = layer;
  const int nmix = nsteps_of(kind) - 4;
  if (step == 0) { phase_norm(P, layer, slab, 0); return; }
  if (step >= nmix) {
    const int f = step - nmix;
    if (f == 0) phase_norm(P, layer, slab, 1);
    else if (f == 1) phase_ffn_gate(P, layer);
    else if (f == 2) phase_ffn_val(P, layer, slab);
    else phase_resid(P, layer, slab, (const u16*)(WS(P) + O_ACT), DFF, O_WFD + (size_t)layer * SZW(1024, 2816), 5 * D);
    return;
  }
  if (kind == 0) {
    if (step == 1) phase_proj(P, O_WHYIN, 3072);
    else if (step == 2) phase_hy_conv(P, slab);
    else if (step == 3) phase_hy_fft(P, slab);
    else if (step == 4) phase_hy_tr(P, slab);
    else phase_resid(P, layer, slab, (const u16*)(WS(P) + O_A2), 1024, O_WHYOUT, 2 * D);
  } else if (kind == 1) {
    if (step == 1) phase_proj(P, O_WRETIN, 6144);
    else if (step == 2) phase_ret_prep(P, slab);
    else if (step == 3) phase_rec_su<128>(P, 1);
    else if (step == 4) phase_rec_scan(P, 1, slab);
    else if (step == 5) phase_rec_out<128>(P, 1);
    else if (step == 6) phase_rec_ng(P, 1);
    else phase_resid(P, layer, slab, (const u16*)(WS(P) + O_A2), 2048, O_WRETOUT, 2 * D);
  } else if (kind == 2) {
    if (step == 1) phase_proj(P, O_WSWAIN, 1536);
    else if (step == 2) phase_swa_prep(P, slab);
    else if (step == 3) phase_swa_att1(P, slab);
    else if (step == 4) phase_swa_att2(P, slab);
    else phase_resid(P, layer, slab, (const u16*)(WS(P) + O_A2), 1024, O_WSWAOUT, 2 * D);
  } else {
    if (step == 1) phase_proj(P, O_WHGIN, 5120);
    else if (step == 2) phase_hg_prep(P);
    else if (step == 3) phase_rec_su<64>(P, 3);
    else if (step == 4) phase_rec_scan(P, 3, slab);
    else if (step == 5) phase_rec_out<64>(P, 3);
    else if (step == 6) phase_rec_ng(P, 3);
    else phase_resid(P, layer, slab, (const u16*)(WS(P) + O_A2), 1024, O_WHGOUT, 2 * D);
  }
}

__global__ void __launch_bounds__(NT) fwd_megakernel(Params P) {
  cg::grid_group grid = cg::this_grid();
  for (int pid = P.p0; pid < P.p1; ++pid) {
    if (pid == 0) phase_pre0(P);
    else if (pid == 1) phase_pre1(P);
    else {
      int q = pid - 2, layer = 0;
      while (q >= 5 * nsteps_of(layer)) { q -= 5 * nsteps_of(layer); ++layer; }
      const int ns = nsteps_of(layer);
      layer_step(P, layer, q / ns, q % ns);
    }
    if (pid + 1 < P.p1) grid.sync();
  }
}

extern "C" void kernel_launch(void* const* d_in, const int* in_sizes, int n_in, void* d_out, int out_size, void* d_ws,
                              size_t ws_size, hipStream_t stream) {
  static int grid_blocks = 0;
  if (!grid_blocks) {
    int dev = 0, cus = 0, per_cu = 0;
    (void)hipGetDevice(&dev);
    (void)hipDeviceGetAttribute(&cus, hipDeviceAttributeMultiprocessorCount, dev);
    (void)hipFuncSetAttribute((const void*)fwd_megakernel, hipFuncAttributeMaxDynamicSharedMemorySize, LDSB);
    (void)hipOccupancyMaxActiveBlocksPerMultiprocessor(&per_cu, (const void*)fwd_megakernel, NT, LDSB);
    if (per_cu < 1) per_cu = 1;
    if (per_cu > 1) per_cu = 1;
    grid_blocks = cus * per_cu;
    if (ws_size < WS_END) fprintf(stderr, "kernel_launch: workspace too small: %zu < %zu\n", ws_size, (size_t)WS_END);
  }
  Params p;
  memset(&p, 0, sizeof(p));
  for (int i = 0; i < 36; ++i) p.in[i] = (const float*)d_in[i];
  p.out = (float*)d_out;
  p.ws = (unsigned char*)d_ws;
#if ONE_LAUNCH
  p.p0 = 0; p.p1 = NPHASES;
  void* args[] = {&p};
  hipError_t e = hipLaunchCooperativeKernel((const void*)fwd_megakernel, dim3(grid_blocks), dim3(NT), args, LDSB, stream);
  if (e != hipSuccess) fprintf(stderr, "cooperative launch failed: %s (grid %d)\n", hipGetErrorString(e), grid_blocks);
#else
  for (int ph = 0; ph < NPHASES; ++ph) {
    p.p0 = ph; p.p1 = ph + 1;
    hipLaunchKernelGGL(fwd_megakernel, dim3(grid_blocks), dim3(NT), LDSB, stream, p);
  }
#endif
}
```

```cpp
#include <hip/hip_runtime.h>
#include <hip/hip_cooperative_groups.h>
#include <cstdio>
#include <cstdint>
#include <cstring>
namespace cg = cooperative_groups;

typedef unsigned short u16;
typedef __attribute__((ext_vector_type(8))) short bf16x8;
typedef __attribute__((ext_vector_type(4))) float f32x4;

#define NT 512
#ifndef ONE_LAUNCH
#define ONE_LAUNCH 1
#endif
#ifndef PROBE_MASK
#define PROBE_MASK 0
#endif
#define REP(cls) for (int rep_ = 0; rep_ < (((PROBE_MASK >> (cls)) & 1) ? 2 : 1); ++rep_)

constexpr int D = 1024, SLAB = 16384, DFF = 2816;
constexpr int LDSB = 131072;
constexpr int NPHASES = 2 + 5 * (10 + 12 + 10 + 12);

constexpr size_t SZW(size_t n, size_t k) { return n * k * 2; }
constexpr size_t O_WHYIN = 0;
constexpr size_t O_WHYOUT = O_WHYIN + SZW(3072, 1024);
constexpr size_t O_WRETIN = O_WHYOUT + SZW(1024, 1024);
constexpr size_t O_WRETOUT = O_WRETIN + SZW(6144, 1024);
constexpr size_t O_WSWAIN = O_WRETOUT + SZW(1024, 2048);
constexpr size_t O_WSWAOUT = O_WSWAIN + SZW(1536, 1024);
constexpr size_t O_WHGIN = O_WSWAOUT + SZW(1024, 1024);
constexpr size_t O_WHGOUT = O_WHGIN + SZW(5120, 1024);
constexpr size_t O_WFG = O_WHGOUT + SZW(1024, 1024);
constexpr size_t O_WFV = O_WFG + 4 * SZW(2816, 1024);
constexpr size_t O_WFD = O_WFV + 4 * SZW(2816, 1024);
constexpr size_t O_MOD = O_WFD + 4 * SZW(1024, 2816);
constexpr size_t O_TW = O_MOD + (size_t)4 * 16 * 6144 * 4;
constexpr size_t O_HIDS = O_TW + 8192 * 8;
constexpr size_t O_HIDP = O_HIDS + (size_t)8192 * 64 * 4;
constexpr size_t O_ROPER = O_HIDP + (size_t)2048 * 64 * 4;
constexpr size_t O_ROPES = O_ROPER + (size_t)8192 * 128 * 8;
constexpr size_t O_PROJ = O_ROPES + (size_t)8192 * 32 * 8;
constexpr size_t O_HBUF = O_PROJ + (size_t)SLAB * 6144 * 2;
constexpr size_t O_A2 = O_HBUF + (size_t)SLAB * 1024 * 2;
constexpr size_t O_C = O_A2 + (size_t)SLAB * 2048 * 2;
constexpr size_t O_GBUF = O_C;
constexpr size_t O_ACT = O_GBUF + (size_t)SLAB * DFF * 2;
constexpr size_t O_MODP = O_C;
constexpr size_t O_HSPS = O_ACT + (size_t)SLAB * DFF * 2;
constexpr size_t O_HSPP = O_HSPS + (size_t)1024 * 16384 * 8;
constexpr size_t O_UT = O_HSPP + (size_t)1024 * 4096 * 8;
constexpr size_t O_X0C = O_UT + (size_t)SLAB * 1024 * 4;
constexpr size_t END_HY = O_X0C + (size_t)SLAB * 1024 * 2;
constexpr size_t SZP = (size_t)SLAB * 1024 * 2;
constexpr size_t O_QDF = O_C, O_QDB = O_QDF + SZP, O_KIF = O_QDB + SZP, O_KIB = O_KIF + SZP, O_KEF = O_KIB + SZP, O_KEB = O_KEF + SZP;
constexpr size_t O_DLF = O_KEB + SZP;
constexpr size_t O_DLB = O_DLF + (size_t)256 * 1024 * 4;
constexpr size_t O_SC = O_DLB + (size_t)256 * 1024 * 4;
constexpr size_t O_STF = O_SC + (size_t)SLAB * 512 * 2;
constexpr size_t O_STB = O_STF + (size_t)134217728;
constexpr size_t O_OBUF = O_STB + (size_t)134217728;
constexpr size_t END_REC = O_OBUF + (size_t)SLAB * 2048 * 4;
constexpr size_t O_QN = O_C;
constexpr size_t O_KN = O_QN + SZP;
constexpr size_t O_PBUF = O_KN + (size_t)SLAB * 256 * 2;
constexpr size_t END_SWA = O_PBUF + (size_t)SLAB * 16 * 320 * 2;
constexpr size_t WS_END = END_REC > END_HY ? (END_REC > END_SWA ? END_REC : END_SWA) : (END_HY > END_SWA ? END_HY : END_SWA);
static_assert(WS_END <= ((size_t)1 << 30), "workspace exceeds 1 GiB");

struct Params {
  const float* in[36];
  float* out;
  unsigned char* ws;
  int p0, p1;
};

extern __shared__ __attribute__((aligned(16))) unsigned char smem[];

__device__ __forceinline__ int TID() { int t = threadIdx.x; asm volatile("" : "+v"(t)); return t; }
__device__ __forceinline__ int BID() { int b = blockIdx.x; asm volatile("" : "+s"(b)); return b; }
__device__ __forceinline__ long ZOFF() { long z = 0; asm volatile("" : "+s"(z)); return z; }
__device__ __forceinline__ unsigned char* WS(const Params& P) { return P.ws + ZOFF(); }
__device__ __forceinline__ float* OUTP(const Params& P) { return P.out + ZOFF(); }

namespace pg8 {
#define PG8_LAS __attribute__((address_space(3)))
typedef unsigned short bf16_t;
typedef short bf16x8 __attribute__((ext_vector_type(8)));
typedef float f32x4 __attribute__((ext_vector_type(4)));
typedef unsigned u32x4 __attribute__((ext_vector_type(4)));
constexpr int BM = 256, BK = 64, HALF = 128, HTB = HALF * BK * 2  , STAGE_BYTES = 8 * HTB, NXCD = 8, WGM = 8;

__host__ __device__ __forceinline__ int lds_byte(int r, int c) { const int st = (r >> 4) * 2 + (c >> 5), rr = r & 15, cc = c & 31, ob = rr * 64 + cc * 2; return st * 1024 + (ob ^ (((ob >> 9) & 1) << 5)); }
__host__ __device__ __forceinline__ void stage_rc(int b, int& R, int& C) { const int st = b / 1024, sb = b % 1024, swz = sb ^ (((sb >> 9) & 1) << 5); R = (st >> 1) * 16 + swz / 64; C = (st & 1) * 32 + (swz % 64) / 2; }
__host__ __device__ __forceinline__ int perm32(int rho) { const int n = rho >> 4, i = rho & 15; return 8 * (i >> 2) + 4 * n + (i & 3); }

struct Unit { int pm, pn; };
struct Gemm { const bf16_t* A; const bf16_t* Bt; int M, N, K; };

struct StaticOrder {
    int nM, nN, nwg, G, c;
    __host__ __device__ void init(int M, int N, int G_, int c_) { nM = M / BM; nN = N / BM; nwg = nM * nN; G = G_; c = c_; }
    __host__ __device__ bool next(int i, Unit& u) const {
        const long L = (long)i * G + c; if (L >= nwg) return false;
        int wgid = (int)L; { const int q = nwg / NXCD, r = nwg % NXCD, xcd = wgid % NXCD, off = wgid / NXCD; wgid = (xcd < r ? xcd * (q + 1) : r * (q + 1) + (xcd - r) * q) + off; }
        const int nig = WGM * nN, gid = wgid / nig, fm = gid * WGM, gsz = (nM - fm) < WGM ? (nM - fm) : WGM;
        u.pm = fm + ((wgid % nig) % gsz); u.pn = (wgid % nig) / gsz; return true;
    }
    __device__ __forceinline__ void a_ready(const Unit&) const {}
    __device__ __forceinline__ void done(const Unit&) const {}
};

template <class Epi, class Sched, bool STAMP = false>
__device__ __forceinline__ void gemm_phase(PG8_LAS unsigned char* lds, const Gemm g, const Sched& S, const Epi& E, unsigned long long* stamps) {
    const int tid = TID(), wid = __builtin_amdgcn_readfirstlane(tid >> 6), lane = tid & 63, wr = wid >> 2, wc = wid & 3, fr = lane & 15, fq = lane >> 4;
    const int K = g.K, nt = K / BK;
    int ts_lo = 0, ts_hi = 0, nts = 0; const unsigned long long rt_entry = STAMP ? (unsigned long long)wall_clock64() : 0ull;
#define PG8_STAMP() do { if (STAMP && wid == 0 && nts < 64) { const unsigned long long _c = (unsigned long long)clock64(); \
        ts_lo = (lane == nts) ? (int)(unsigned)_c : ts_lo; ts_hi = (lane == nts) ? (int)(unsigned)(_c >> 32) : ts_hi; ++nts; } } while (0)
    PG8_STAMP();
    unsigned voffA[2], voffB[2];
#pragma unroll
    for (int i = 0; i < 2; ++i) { int R, C; stage_rc(tid * 16 + i * 8192, R, C); const int Rb = Epi::PERM ? ((R & ~31) + perm32(R & 31)) : R;
        voffA[i] = (unsigned)(R * K + C) * 2u; voffB[i] = (unsigned)(Rb * K + C) * 2u; }
    const size_t kstep = (size_t)(BK * 2);
    const size_t hstep = (size_t)HALF * K * 2;
    const size_t tstep = 2 * hstep;
    const unsigned ldsw = (unsigned)wid * 1024u;
    const int aoff = lds_byte(wr * 64 + fr, fq * 8), boff = lds_byte(wc * 32 + fr, fq * 8);
#define PG8_SA(b, h) (((b) * 2 + (h)) * HTB)
#define PG8_SB(b, h) ((4 + (b) * 2 + (h)) * HTB)
#define PG8_STAGE(bufoff, gbase, voff) do { _Pragma("unroll") for (int _i = 0; _i < 2; ++_i) \
        __builtin_amdgcn_global_load_lds((const unsigned*)((const char*)(gbase) + (voff)[_i]), (PG8_LAS unsigned*)(lds + (bufoff) + ldsw + _i * 8192), 16, 0, 0); } while (0)
#define PG8_LDA(dst, b, h) do { _Pragma("unroll") for (int m = 0; m < 4; ++m) _Pragma("unroll") for (int k = 0; k < 2; ++k) dst[m][k] = *(const PG8_LAS bf16x8*)(lds + PG8_SA(b, h) + aoff + m * 2048 + k * 1024); } while (0)
#define PG8_LDB(dst, b, h) do { _Pragma("unroll") for (int n = 0; n < 2; ++n) _Pragma("unroll") for (int k = 0; k < 2; ++k) dst[n][k] = *(const PG8_LAS bf16x8*)(lds + PG8_SB(b, h) + boff + n * 2048 + k * 1024); } while (0)
#define PG8_MMA(ai, bj, At, Bt) do { __builtin_amdgcn_s_setprio(1); _Pragma("unroll") for (int m = 0; m < 4; ++m) _Pragma("unroll") for (int n = 0; n < 2; ++n) _Pragma("unroll") for (int k = 0; k < 2; ++k) \
        acc[ai][bj][m][n] = __builtin_amdgcn_mfma_f32_16x16x32_bf16(Bt[n][k], At[m][k], acc[ai][bj][m][n], 0, 0, 0); __builtin_amdgcn_s_setprio(0); } while (0)
#define PG8_WAIT_V(n) asm volatile("s_waitcnt vmcnt(" #n ")" ::: "memory")
#define PG8_WAIT_L(n) asm volatile("s_waitcnt lgkmcnt(" #n ")" ::: "memory")
#define PG8_BAR __builtin_amdgcn_s_barrier()
#define PG8_SCHED __builtin_amdgcn_sched_barrier(0)
    Unit cur, nxt; int ui = 0;
    if (!S.next(0, cur)) return;
    f32x4 acc[2][2][4][2];
#pragma unroll
    for (int a = 0; a < 2; ++a)
#pragma unroll
        for (int b = 0; b < 2; ++b)
#pragma unroll
            for (int m = 0; m < 4; ++m)
#pragma unroll
                for (int n = 0; n < 2; ++n) acc[a][b][m][n] = (f32x4){0.f, 0.f, 0.f, 0.f};
    bf16x8 At[4][2], B0[2][2], B1[2][2];
    const char* cA = (const char*)g.A + (size_t)cur.pm * tstep; const char* cB = (const char*)g.Bt + (size_t)cur.pn * tstep;
    S.a_ready(cur);
    PG8_STAGE(PG8_SB(0, 0), cB, voffB); PG8_STAGE(PG8_SA(0, 0), cA, voffA); PG8_STAGE(PG8_SB(0, 1), cB + hstep, voffB); PG8_STAGE(PG8_SA(0, 1), cA + hstep, voffA);
    if (wr == 1) PG8_BAR;
    PG8_WAIT_V(4); PG8_BAR;
    PG8_STAGE(PG8_SB(1, 0), cB + kstep, voffB); PG8_STAGE(PG8_SA(1, 0), cA + kstep, voffA); PG8_STAGE(PG8_SB(1, 1), cB + hstep + kstep, voffB);
    PG8_WAIT_V(6); PG8_BAR;
    PG8_STAMP();
    for (;;) {
        const bool has_next = S.next(ui + 1, nxt);
        const char* nA = has_next ? (const char*)g.A + (size_t)nxt.pm * tstep : cA; const char* nB = has_next ? (const char*)g.Bt + (size_t)nxt.pn * tstep : cB;
        for (int t = 0; t < nt; t += 2) {
            const bool last = (t == nt - 2);
            const char* a1 = cA + (size_t)(t + 1) * kstep;
            const char* a2 = last ? nA : cA + (size_t)(t + 2) * kstep; const char* b2 = last ? nB : cB + (size_t)(t + 2) * kstep;
            const char* a3 = a2 + kstep; const char* b3 = b2 + kstep;
            if (last && has_next) S.a_ready(nxt);
            PG8_LDB(B0, 0, 0); PG8_SCHED; PG8_LDA(At, 0, 0); PG8_STAGE(PG8_SA(1, 1), a1 + hstep, voffA);
            PG8_WAIT_L(8); PG8_BAR; PG8_WAIT_L(0); PG8_MMA(0, 0, At, B0); PG8_BAR; PG8_SCHED;
            PG8_LDB(B1, 0, 1); PG8_STAGE(PG8_SB(0, 0), b2, voffB);
            PG8_BAR; PG8_WAIT_L(0); PG8_MMA(0, 1, At, B1); PG8_BAR;
            PG8_LDA(At, 0, 1); PG8_STAGE(PG8_SA(0, 0), a2, voffA);
            PG8_BAR; PG8_WAIT_L(0); PG8_MMA(1, 0, At, B0); PG8_BAR; PG8_SCHED;
            PG8_STAGE(PG8_SB(0, 1), b2 + hstep, voffB);
            PG8_WAIT_V(6); PG8_BAR; PG8_MMA(1, 1, At, B1); PG8_BAR;
            PG8_LDB(B0, 1, 0); PG8_SCHED; PG8_LDA(At, 1, 0); PG8_STAGE(PG8_SA(0, 1), a2 + hstep, voffA);
            PG8_WAIT_L(8); PG8_BAR; PG8_WAIT_L(0); PG8_MMA(0, 0, At, B0); PG8_BAR; PG8_SCHED;
            PG8_LDB(B1, 1, 1); PG8_STAGE(PG8_SB(1, 0), b3, voffB);
            PG8_BAR; PG8_WAIT_L(0); PG8_MMA(0, 1, At, B1); PG8_BAR;
            PG8_LDA(At, 1, 1); PG8_STAGE(PG8_SA(1, 0), a3, voffA);
            PG8_BAR; PG8_WAIT_L(0); PG8_MMA(1, 0, At, B0); PG8_BAR; PG8_SCHED;
            PG8_STAGE(PG8_SB(1, 1), b3 + hstep, voffB);
            PG8_WAIT_V(6); PG8_BAR; PG8_MMA(1, 1, At, B1); PG8_BAR;
        }
        PG8_STAMP();
        if constexpr (!Epi::AFTER_DRAIN) { E(acc, cur, wr, wc, fr, fq); S.done(cur); }
        PG8_STAMP();
        if (!has_next) break;
#pragma unroll
        for (int a = 0; a < 2; ++a)
#pragma unroll
            for (int b = 0; b < 2; ++b)
#pragma unroll
                for (int m = 0; m < 4; ++m)
#pragma unroll
                    for (int n = 0; n < 2; ++n) acc[a][b][m][n] = (f32x4){0.f, 0.f, 0.f, 0.f};
        cur = nxt; cA = nA; cB = nB; ++ui;
    }
    PG8_WAIT_V(0);
    if (wr == 0) PG8_BAR;
    PG8_BAR;
    if constexpr (Epi::AFTER_DRAIN) { E.fused(acc, cur, wr, wc, fr, fq, lds, wid, lane); S.done(cur); }
    PG8_STAMP();
    if (STAMP && wid == 0) { stamps[lane] = lane < nts ? (((unsigned long long)(unsigned)ts_hi << 32) | (unsigned)ts_lo) : 0ull;
        if (lane == 62) stamps[62] = rt_entry; if (lane == 63) stamps[63] = (unsigned long long)wall_clock64(); }
#undef PG8_STAMP
#undef PG8_SA
#undef PG8_SB
#undef PG8_STAGE
#undef PG8_LDA
#undef PG8_LDB
#undef PG8_MMA
#undef PG8_WAIT_V
#undef PG8_WAIT_L
#undef PG8_BAR
#undef PG8_SCHED
}
}


__device__ __forceinline__ u16 f2bf(float f) {
  unsigned u = __float_as_uint(f);
  u += 0x7fffu + ((u >> 16) & 1u);
  return (u16)(u >> 16);
}
__device__ __forceinline__ float bf2f(u16 h) { return __uint_as_float(((unsigned)h) << 16); }
__device__ __forceinline__ unsigned pack2(float a, float b) { return (unsigned)f2bf(a) | ((unsigned)f2bf(b) << 16); }
__device__ __forceinline__ float silu_f(float x) { return x / (1.f + __expf(-x)); }
__device__ __forceinline__ float sigm(float x) { return 1.f / (1.f + __expf(-x)); }
__device__ __forceinline__ float wave_sum(float v) {
#pragma unroll
  for (int o = 32; o; o >>= 1) v += __shfl_xor(v, o);
  return v;
}
__device__ __forceinline__ int Lof(int slab) { return slab == 0 ? 2048 : 8192; }
__device__ __forceinline__ int gb_of(int slab, int r) { return slab == 0 ? (r >> 11) : (8 + (slab - 1) * 2 + (r >> 13)); }

typedef short v4s __attribute__((ext_vector_type(4)));
#define LDS_AS __attribute__((address_space(3)))
template <int R, bool KC>
__device__ __forceinline__ uint4 ld_chunk(const u16* __restrict__ base, long ld, int k0, int c) {
  if (KC) {
    const int r = c >> 3, kc = c & 7;
    return *(const uint4*)(base + (long)r * ld + k0 + kc * 8);
  } else {
    const int k = c / (R / 8), mc = c % (R / 8);
    return *(const uint4*)(base + (long)(k0 + k) * ld + mc * 8);
  }
}
template <int R, bool KC>
__device__ __forceinline__ void st_chunk(u16* s, uint4 v, int c) {
  if (KC) {
    const int r = c >> 3, kc = c & 7;
    *(uint4*)(s + r * 72 + kc * 8) = v;
  } else {
    const int k = c / (R / 8), mc = c % (R / 8);
    *(uint4*)(s + k * (R + 8) + mc * 8) = v;
  }
}
template <int R, bool KC>
__device__ __forceinline__ bf16x8 ld_frag(const u16* s, int x0, int ks, int fr, int fq) {
  if (KC) {
    return *(const bf16x8*)(s + (x0 + fr) * 72 + ks * 32 + fq * 8);
  } else {
    const int q4 = fr >> 2, p4 = fr & 3;
    const u16* p = s + (ks * 32 + 8 * fq + q4) * (R + 8) + x0 + 4 * p4;
    v4s lo = __builtin_amdgcn_ds_read_tr16_b64_v4i16((LDS_AS v4s*)p);
    v4s hi = __builtin_amdgcn_ds_read_tr16_b64_v4i16((LDS_AS v4s*)(p + 4 * (R + 8)));
    bf16x8 r;
    r[0] = lo[0]; r[1] = lo[1]; r[2] = lo[2]; r[3] = lo[3]; r[4] = hi[0]; r[5] = hi[1]; r[6] = hi[2]; r[7] = hi[3];
    return r;
  }
}

template <int TM, int TN, bool AKC, bool BKC, bool TR>
__device__ __forceinline__ void gemm_acc(f32x4 (&acc)[TM / 32][TN / 64], const u16* __restrict__ A, long lda,
                                         const u16* __restrict__ B, long ldb, int K, u16* sm) {
  u16* As = sm;
  u16* Bs = sm + 9216;
  const int tid = TID(), lane = tid & 63, wid = tid >> 6;
  const int wm = wid >> 2, wn = wid & 3, fr = lane & 15, fq = lane >> 4;
  constexpr int MI = TM / 32, NI = TN / 64;
  uint4 ra0 = ld_chunk<TM, AKC>(A, lda, 0, tid), rb0 = ld_chunk<TN, BKC>(B, ldb, 0, tid);
  uint4 ra1 = ra0, rb1 = rb0;
  if (TM == 128) ra1 = ld_chunk<TM, AKC>(A, lda, 0, tid + NT);
  if (TN == 128) rb1 = ld_chunk<TN, BKC>(B, ldb, 0, tid + NT);
  for (int k0 = 0; k0 < K; k0 += 64) {
    __syncthreads();
    st_chunk<TM, AKC>(As, ra0, tid);
    if (TM == 128) st_chunk<TM, AKC>(As, ra1, tid + NT);
    st_chunk<TN, BKC>(Bs, rb0, tid);
    if (TN == 128) st_chunk<TN, BKC>(Bs, rb1, tid + NT);
    __syncthreads();
    if (k0 + 64 < K) {
      ra0 = ld_chunk<TM, AKC>(A, lda, k0 + 64, tid);
      if (TM == 128) ra1 = ld_chunk<TM, AKC>(A, lda, k0 + 64, tid + NT);
      rb0 = ld_chunk<TN, BKC>(B, ldb, k0 + 64, tid);
      if (TN == 128) rb1 = ld_chunk<TN, BKC>(B, ldb, k0 + 64, tid + NT);
    }
#pragma unroll
    for (int ks = 0; ks < 2; ++ks) {
      bf16x8 af[MI], bfr[NI];
#pragma unroll
      for (int mi = 0; mi < MI; ++mi) af[mi] = ld_frag<TM, AKC>(As, wm * (TM / 2) + mi * 16, ks, fr, fq);
#pragma unroll
      for (int ni = 0; ni < NI; ++ni) bfr[ni] = ld_frag<TN, BKC>(Bs, wn * (TN / 4) + ni * 16, ks, fr, fq);
#pragma unroll
      for (int mi = 0; mi < MI; ++mi)
#pragma unroll
        for (int ni = 0; ni < NI; ++ni)
          acc[mi][ni] = TR ? __builtin_amdgcn_mfma_f32_16x16x32_bf16(bfr[ni], af[mi], acc[mi][ni], 0, 0, 0)
                           : __builtin_amdgcn_mfma_f32_16x16x32_bf16(af[mi], bfr[ni], acc[mi][ni], 0, 0, 0);
    }
  }
  __syncthreads();
}

template <int TM, int TN, bool TR, class F>
__device__ __forceinline__ void epi_each(f32x4 (&acc)[TM / 32][TN / 64], F f) {
  const int tid = TID(), lane = tid & 63, wid = tid >> 6;
  const int wm = wid >> 2, wn = wid & 3, fr = lane & 15, fq = lane >> 4;
#pragma unroll
  for (int mi = 0; mi < TM / 32; ++mi)
#pragma unroll
    for (int ni = 0; ni < TN / 64; ++ni) {
      const int r0 = wm * (TM / 2) + mi * 16, c0 = wn * (TN / 4) + ni * 16;
      if (TR) f(r0 + fr, c0 + fq * 4, acc[mi][ni]);
      else f(r0 + fq * 4, c0 + fr, acc[mi][ni]);
    }
}

struct EpiStoreBf16 {
  static constexpr bool PERM = false, AFTER_DRAIN = false;
  u16* O; int ldc;
  __device__ __forceinline__ void operator()(const f32x4 (&acc)[2][2][4][2], const pg8::Unit& u, int wr, int wc, int fr, int fq) const {
    const int row0 = u.pm * 256 + wr * 64 + fr, col0 = u.pn * 256 + wc * 32 + 4 * fq;
#pragma unroll
    for (int ai = 0; ai < 2; ++ai)
#pragma unroll
      for (int m = 0; m < 4; ++m) {
        u16* rowp = O + (size_t)(row0 + ai * 128 + m * 16) * ldc + col0;
#pragma unroll
        for (int bj = 0; bj < 2; ++bj)
#pragma unroll
          for (int n = 0; n < 2; ++n) {
            const f32x4 v = acc[ai][bj][m][n];
            *(uint2*)(rowp + bj * 128 + n * 16) = make_uint2(pack2(v[0], v[1]), pack2(v[2], v[3]));
          }
      }
  }
};
struct EpiResid {
  static constexpr bool PERM = false, AFTER_DRAIN = false;
  float* X; const float* mod; int goff; int slab;
  __device__ __forceinline__ void operator()(const f32x4 (&acc)[2][2][4][2], const pg8::Unit& u, int wr, int wc, int fr, int fq) const {
    const int row0 = u.pm * 256 + wr * 64 + fr, col0 = u.pn * 256 + wc * 32 + 4 * fq;
#pragma unroll
    for (int ai = 0; ai < 2; ++ai)
#pragma unroll
      for (int m = 0; m < 4; ++m) {
        const int r = row0 + ai * 128 + m * 16;
        const float* g = mod + (size_t)gb_of(slab, r) * 6144 + goff + col0;
        float* xp = X + (size_t)r * D + col0;
#pragma unroll
        for (int bj = 0; bj < 2; ++bj)
#pragma unroll
          for (int n = 0; n < 2; ++n) {
            const f32x4 gv = *(const f32x4*)(g + bj * 128 + n * 16);
            f32x4 xv = *(const f32x4*)(xp + bj * 128 + n * 16);
            xv += gv * acc[ai][bj][m][n];
            *(f32x4*)(xp + bj * 128 + n * 16) = xv;
          }
      }
  }
};
struct EpiFfnVal {
  static constexpr bool PERM = false, AFTER_DRAIN = false;
  const u16* G; u16* ACT; const float* cw; const float* cb; int L;
  __device__ __forceinline__ void operator()(const f32x4 (&acc)[2][2][4][2], const pg8::Unit& u, int wr, int wc, int fr, int fq) const {
    const int row0 = u.pm * 256 + wr * 64 + fr, col0 = u.pn * 256 + wc * 32 + 4 * fq;
#pragma unroll
    for (int bj = 0; bj < 2; ++bj)
#pragma unroll
      for (int n = 0; n < 2; ++n) {
        const int c = col0 + bj * 128 + n * 16;
        const f32x4 w0 = *(const f32x4*)(cw + c), w1 = *(const f32x4*)(cw + DFF + c), w2 = *(const f32x4*)(cw + 2 * DFF + c), bb = *(const f32x4*)(cb + c);
#pragma unroll
        for (int ai = 0; ai < 2; ++ai)
#pragma unroll
          for (int m = 0; m < 4; ++m) {
            const int r = row0 + ai * 128 + m * 16;
            const int pos = r & (L - 1);
            const u16* gp = G + (size_t)r * DFF + c;
            const uint2 g1 = *(const uint2*)gp;
            uint2 g0 = make_uint2(0, 0), g2 = make_uint2(0, 0);
            if (pos > 0) g0 = *(const uint2*)(gp - DFF);
            if (pos < L - 1) g2 = *(const uint2*)(gp + DFF);
            f32x4 a;
            a[0] = bf2f((u16)(g0.x & 0xffff)) * w0[0] + bf2f((u16)(g1.x & 0xffff)) * w1[0] + bf2f((u16)(g2.x & 0xffff)) * w2[0] + bb[0];
            a[1] = bf2f((u16)(g0.x >> 16)) * w0[1] + bf2f((u16)(g1.x >> 16)) * w1[1] + bf2f((u16)(g2.x >> 16)) * w2[1] + bb[1];
            a[2] = bf2f((u16)(g0.y & 0xffff)) * w0[2] + bf2f((u16)(g1.y & 0xffff)) * w1[2] + bf2f((u16)(g2.y & 0xffff)) * w2[2] + bb[2];
            a[3] = bf2f((u16)(g0.y >> 16)) * w0[3] + bf2f((u16)(g1.y >> 16)) * w1[3] + bf2f((u16)(g2.y >> 16)) * w2[3] + bb[3];
            const f32x4 v = acc[ai][bj][m][n];
            *(uint2*)(ACT + (size_t)r * DFF + c) = make_uint2(pack2(silu_f(a[0]) * v[0], silu_f(a[1]) * v[1]), pack2(silu_f(a[2]) * v[2], silu_f(a[3]) * v[3]));
          }
      }
  }
};
template <class Epi>
__device__ __forceinline__ void run_gemm(const u16* A, const u16* Bt, int N, int K, const Epi& E) {
  pg8::Gemm g; g.A = A; g.Bt = Bt; g.M = SLAB; g.N = N; g.K = K;
  pg8::StaticOrder S; S.init(SLAB, N, gridDim.x, BID());
  __syncthreads();
  pg8::gemm_phase<Epi, pg8::StaticOrder, false>((PG8_LAS unsigned char*)smem, g, S, E, nullptr);
  __syncthreads();
}

template <int N>
__device__ __forceinline__ void fft_dif_t(float2* x, const float2* __restrict__ tw) {
  const int tid = TID();
  constexpr int IT = N / 2 / NT;
#pragma unroll 1
  for (int s = N >> 1; s >= 1; s >>= 1) {
    const int tws = 8192 / s;
    const float2 w0 = tw[(tid & (s - 1)) * tws];
#pragma unroll
    for (int it = 0; it < IT; ++it) {
      const int i = tid + it * NT;
      const int j = i & (s - 1);
      const int p = ((i - j) << 1) + j;
      float2 w = w0;
      if (s >= 1024) {
        const float2 wu = tw[((it * NT) & (s - 1)) * tws];
        w = make_float2(w0.x * wu.x - w0.y * wu.y, w0.x * wu.y + w0.y * wu.x);
      }
      float2 a = x[p], b = x[p + s];
      x[p] = make_float2(a.x + b.x, a.y + b.y);
      float dx = a.x - b.x, dy = a.y - b.y;
      x[p + s] = make_float2(dx * w.x - dy * w.y, dx * w.y + dy * w.x);
    }
    __syncthreads();
  }
}
template <int N>
__device__ __forceinline__ void ifft_dit_t(float2* x, const float2* __restrict__ tw) {
  const int tid = TID();
  constexpr int IT = N / 2 / NT;
#pragma unroll 1
  for (int s = 1; s < N; s <<= 1) {
    const int tws = 8192 / s;
    const float2 w0 = tw[(tid & (s - 1)) * tws];
#pragma unroll
    for (int it = 0; it < IT; ++it) {
      const int i = tid + it * NT;
      const int j = i & (s - 1);
      const int p = ((i - j) << 1) + j;
      float2 w = w0;
      if (s >= 1024) {
        const float2 wu = tw[((it * NT) & (s - 1)) * tws];
        w = make_float2(w0.x * wu.x - w0.y * wu.y, w0.x * wu.y + w0.y * wu.x);
      }
      float2 a = x[p], b = x[p + s];
      float bx = b.x * w.x + b.y * w.y, by = b.y * w.x - b.x * w.y;
      x[p] = make_float2(a.x + bx, a.y + by);
      x[p + s] = make_float2(a.x - bx, a.y - by);
    }
    __syncthreads();
  }
}
__device__ __forceinline__ void fft_dif(float2* x, int N, const float2* __restrict__ tw) {
  if (N == 16384) fft_dif_t<16384>(x, tw); else fft_dif_t<4096>(x, tw);
}
__device__ __forceinline__ void ifft_dit(float2* x, int N, const float2* __restrict__ tw) {
  if (N == 16384) ifft_dit_t<16384>(x, tw); else ifft_dit_t<4096>(x, tw);
}

__device__ void transpose_w(const float* __restrict__ W, u16* __restrict__ Wt, int K, int N) {
  float* smf = (float*)smem;
  const int tk = K / 64, tn = N / 64, tid = TID();
  for (int item = BID(); item < tk * tn; item += gridDim.x) {
    const int k0 = (item / tn) * 64, n0 = (item % tn) * 64;
    __syncthreads();
    for (int i = tid; i < 4096; i += NT) {
      int kk = i >> 6, nn = i & 63;
      smf[kk * 65 + nn] = W[(long)(k0 + kk) * N + n0 + nn];
    }
    __syncthreads();
    for (int i = tid; i < 4096; i += NT) {
      int nn = i >> 6, kk = i & 63;
      Wt[(long)(n0 + nn) * K + k0 + kk] = f2bf(smf[kk * 65 + nn]);
    }
  }
  __syncthreads();
}

__device__ void phase_pre0(const Params& P) {
  const int tid = TID();
  const long gtid = (long)BID() * NT + tid, gsz = (long)gridDim.x * NT;
  {
    const float4* s0 = (const float4*)P.in[0];
    const float4* s1 = (const float4*)P.in[1];
    float4* o = (float4*)OUTP(P);
    const long n0 = (long)16384 * 1024 / 4, n1 = (long)65536 * 1024 / 4;
    for (long i = gtid; i < n0; i += gsz) o[i] = s0[i];
    for (long i = gtid; i < n1; i += gsz) o[n0 + i] = s1[i];
  }
  transpose_w(P.in[7], (u16*)(WS(P) + O_WHYIN), 1024, 3072);
  transpose_w(P.in[18], (u16*)(WS(P) + O_WHYOUT), 1024, 1024);
  transpose_w(P.in[19], (u16*)(WS(P) + O_WRETIN), 1024, 6144);
  transpose_w(P.in[21], (u16*)(WS(P) + O_WRETOUT), 2048, 1024);
  transpose_w(P.in[22], (u16*)(WS(P) + O_WSWAIN), 1024, 1536);
  transpose_w(P.in[26], (u16*)(WS(P) + O_WSWAOUT), 1024, 1024);
  transpose_w(P.in[27], (u16*)(WS(P) + O_WHGIN), 1024, 5120);
  transpose_w(P.in[30], (u16*)(WS(P) + O_WHGOUT), 1024, 1024);
  for (int l = 0; l < 4; ++l) {
    transpose_w(P.in[31] + (long)l * 1024 * DFF, (u16*)(WS(P) + O_WFG) + (long)l * DFF * 1024, 1024, DFF);
    transpose_w(P.in[32] + (long)l * 1024 * DFF, (u16*)(WS(P) + O_WFV) + (long)l * DFF * 1024, 1024, DFF);
    transpose_w(P.in[35] + (long)l * DFF * 1024, (u16*)(WS(P) + O_WFD) + (long)l * 1024 * DFF, DFF, 1024);
  }
  {
    float* cs = (float*)smem;
    float* modp = (float*)(WS(P) + O_MODP);
    for (int item = BID(); item < 4 * 8 * 12; item += gridDim.x) {
      const int nb = item % 12, ks = (item / 12) % 8, l = item / 96;
      __syncthreads();
      for (int i = tid; i < 2048; i += NT) {
        int b = i >> 7, k = i & 127;
        float c = (b < 8) ? P.in[2][b * 1024 + ks * 128 + k] : P.in[3][(b - 8) * 1024 + ks * 128 + k];
        cs[i] = c / (1.f + expf(-c));
      }
      __syncthreads();
      const int n = nb * 512 + tid;
      float a[16];
#pragma unroll
      for (int b = 0; b < 16; ++b) a[b] = 0.f;
      const float* w = P.in[4] + ((long)l * 1024 + ks * 128) * 6144 + n;
      for (int k = 0; k < 128; ++k) {
        float wv = w[(long)k * 6144];
#pragma unroll
        for (int b = 0; b < 16; ++b) a[b] += cs[b * 128 + k] * wv;
      }
#pragma unroll
      for (int b = 0; b < 16; ++b) modp[(((long)ks * 4 + l) * 16 + b) * 6144 + n] = a[b];
    }
    __syncthreads();
  }
  {
    float2* tw = (float2*)(WS(P) + O_TW);
    for (long i = gtid; i < 8192; i += gsz) {
      float s, c;
      sincospif((float)i * (1.f / 8192.f), &s, &c);
      tw[i] = make_float2(c, -s);
    }
    float2* rr = (float2*)(WS(P) + O_ROPER);
    for (long i = gtid; i < (long)8192 * 128; i += gsz) {
      int pos = (int)(i >> 7), d = (int)(i & 127);
      float inv = exp2f(-(float)d * (13.287712379549449f / 128.f));
      float s, c;
      sincosf((float)pos * inv, &s, &c);
      rr[i] = make_float2(c, s);
    }
    float2* rs = (float2*)(WS(P) + O_ROPES);
    for (long i = gtid; i < (long)8192 * 32; i += gsz) {
      int pos = (int)(i >> 5), d = (int)(i & 31);
      float inv = exp2f(-(float)d * (13.287712379549449f / 32.f));
      float s, c;
      sincosf((float)pos * inv, &s, &c);
      rs[i] = make_float2(c, s);
    }
  }
  {
    float* zf = (float*)smem;
    float* h1 = zf + 8 * 36;
    const float* w1 = P.in[10]; const float* b1 = P.in[11]; const float* w2 = P.in[12]; const float* b2 = P.in[13];
    const float* fr = P.in[15];
    const int tl = tid >> 6, j = tid & 63;
    for (int item = BID(); item < 1280; item += gridDim.x) {
      const int sel = item >= 1024;
      const int L = sel ? 2048 : 8192;
      const int t = (sel ? item - 1024 : item) * 8 + tl;
      float* hid = (float*)(WS(P) + (sel ? O_HIDP : O_HIDS));
      __syncthreads();
      if (j < 33) {
        float v;
        if (j == 0) v = (float)t / (float)(L - 1);
        else {
          int i = (j - 1) & 15;
          float band = 1e-4f + (float)i * ((15.f - 1e-4f) / 15.f);
          float ang = (6.283185307179586f / (float)L) * (float)t;
          float a = band * ang;
          v = (j <= 16) ? cosf(a) : -sinf(a);
        }
        zf[tl * 36 + j] = v;
      }
      __syncthreads();
      float s = b1[j];
#pragma unroll 3
      for (int i = 0; i < 33; ++i) s += zf[tl * 36 + i] * w1[i * 64 + j];
      h1[tl * 64 + j] = sinf(fr[j] * s);
      __syncthreads();
      float s2 = b2[j];
#pragma unroll 4
      for (int i = 0; i < 64; ++i) s2 += h1[tl * 64 + i] * w2[i * 64 + j];
      hid[(long)t * 64 + j] = sinf(fr[j] * s2);
    }
    __syncthreads();
  }
}

__device__ void phase_pre1(const Params& P) {
  __shared__ float w3s[128];
  __shared__ float red[8];
  const int tid = TID(), lane = tid & 63, wid = tid >> 6;
  const long gtid = (long)BID() * NT + tid, gsz = (long)gridDim.x * NT;
  {
    const float* modp = (const float*)(WS(P) + O_MODP);
    float* mod = (float*)(WS(P) + O_MOD);
    for (long i = gtid; i < (long)4 * 16 * 6144; i += gsz) {
      int n = (int)(i % 6144);
      int l = (int)(i / (16 * 6144));
      float s = P.in[5][l * 6144 + n];
      for (int ks = 0; ks < 8; ++ks) s += modp[(long)ks * 4 * 16 * 6144 + i];
      mod[i] = s;
    }
  }
  float2* buf = (float2*)smem;
  const float2* tw = (const float2*)(WS(P) + O_TW);
  for (int item = BID(); item < 2048; item += gridDim.x) {
    const int sel = item >> 10, c = item & 1023;
    const int L = sel ? 2048 : 8192, N = 2 * L;
    const float* hid = (const float*)(WS(P) + (sel ? O_HIDP : O_HIDS));
    float2* hs = (float2*)(WS(P) + (sel ? O_HSPP : O_HSPS)) + (long)c * N;
    __syncthreads();
    if (tid < 128) {
      int dirn = tid >> 6, j = tid & 63;
      w3s[tid] = P.in[14][(long)j * 2048 + dirn * 1024 + c];
    }
    __syncthreads();
    const float dec0 = fabsf(P.in[16][c]), dec1 = fabsf(P.in[16][1024 + c]);
    const float invLm1 = 1.f / (float)(L - 1);
    float asum = 0.f;
    for (int n = tid; n < N; n += NT) {
      float val = 0.f;
      if (n != L) {
        const int dirn = n < L ? 0 : 1;
        const int t = n < L ? n : N - n;
        const float4* hr = (const float4*)(hid + (long)t * 64);
        const float* w = w3s + dirn * 64;
        float s = 0.f;
#pragma unroll
        for (int q = 0; q < 16; ++q) {
          float4 h4 = hr[q];
          s += h4.x * w[4 * q] + h4.y * w[4 * q + 1] + h4.z * w[4 * q + 2] + h4.w * w[4 * q + 3];
        }
        float tl = (float)t * invLm1;
        val = s * expf(-tl * (dirn ? dec1 : dec0));
      }
      buf[n] = make_float2(val, 0.f);
      asum += fabsf(val);
    }
    asum = wave_sum(asum);
    if (lane == 0) red[wid] = asum;
    __syncthreads();
    float tot = 0.f;
#pragma unroll
    for (int w = 0; w < 8; ++w) tot += red[w];
    const float scale = 1.f / (tot * (float)N);
    fft_dif(buf, N, tw);
    for (int p = tid; p < N; p += NT) {
      float2 a = buf[p];
      hs[p] = make_float2(a.x * scale, a.y * scale);
    }
  }
  __syncthreads();
}

__device__ void phase_norm(const Params& P, int layer, int slab, int which) {
  const float* x = OUTP(P) + (long)slab * SLAB * D;
  u16* h = (u16*)(WS(P) + O_HBUF);
  const float* gain = P.in[6] + (layer * 2 + which) * D;
  const float* mod = (const float*)(WS(P) + O_MOD) + (long)layer * 16 * 6144;
  const int shoff = which ? 3 * D : 0, scoff = which ? 4 * D : D;
  const int tid = TID(), lane = tid & 63, wid = tid >> 6;
  for (int item = BID(); item < SLAB / 8; item += gridDim.x) {
    const int r = item * 8 + wid;
    const float* xr = x + (long)r * D;
    float4 v[4];
    float ss = 0.f;
#pragma unroll
    for (int i = 0; i < 4; ++i) {
      v[i] = *(const float4*)(xr + i * 256 + lane * 4);
      ss += v[i].x * v[i].x + v[i].y * v[i].y + v[i].z * v[i].z + v[i].w * v[i].w;
    }
    ss = wave_sum(ss);
    const float rstd = rsqrtf(ss * (1.f / 1024.f) + 1e-6f);
    const float* m = mod + (long)gb_of(slab, r) * 6144;
#pragma unroll
    for (int i = 0; i < 4; ++i) {
      const int col = i * 256 + lane * 4;
      float4 g = *(const float4*)(gain + col);
      float4 sc = *(const float4*)(m + scoff + col);
      float4 sh = *(const float4*)(m + shoff + col);
      float y0 = v[i].x * rstd * g.x * (1.f + sc.x) + sh.x;
      float y1 = v[i].y * rstd * g.y * (1.f + sc.y) + sh.y;
      float y2 = v[i].z * rstd * g.z * (1.f + sc.z) + sh.z;
      float y3 = v[i].w * rstd * g.w * (1.f + sc.w) + sh.w;
      uint2 o = make_uint2(pack2(y0, y1), pack2(y2, y3));
      *(uint2*)(h + (long)r * D + col) = o;
    }
  }
}

__device__ void phase_proj(const Params& P, size_t woff, int N) {
  EpiStoreBf16 E; E.O = (u16*)(WS(P) + O_PROJ); E.ldc = N;
  run_gemm((const u16*)(WS(P) + O_HBUF), (const u16*)(WS(P) + woff), N, D, E);
}
__device__ void phase_resid(const Params& P, int layer, int slab, const u16* A, int K, size_t woff, int goff) {
  EpiResid E; E.X = OUTP(P) + (long)slab * SLAB * D; E.mod = (const float*)(WS(P) + O_MOD) + (long)layer * 16 * 6144; E.goff = goff; E.slab = slab;
  run_gemm(A, (const u16*)(WS(P) + woff), D, K, E);
}

__device__ void phase_ffn_gate(const Params& P, int layer) {
  EpiStoreBf16 E; E.O = (u16*)(WS(P) + O_GBUF); E.ldc = DFF;
  run_gemm((const u16*)(WS(P) + O_HBUF), (const u16*)(WS(P) + O_WFG) + (long)layer * DFF * D, DFF, D, E);
}
__device__ void phase_ffn_val(const Params& P, int layer, int slab) {
  EpiFfnVal E; E.G = (const u16*)(WS(P) + O_GBUF); E.ACT = (u16*)(WS(P) + O_ACT);
  E.cw = P.in[33] + (long)layer * 3 * DFF; E.cb = P.in[34] + (long)layer * DFF; E.L = Lof(slab);
  run_gemm((const u16*)(WS(P) + O_HBUF), (const u16*)(WS(P) + O_WFV) + (long)layer * DFF * D, DFF, D, E);
}

__device__ void phase_hy_conv(const Params& P, int slab) {
  const int L = Lof(slab), nseq = SLAB / L, tid = TID();
  const u16* z = (const u16*)(WS(P) + O_PROJ);
  float* uT = (float*)(WS(P) + O_UT);
  u16* x0c = (u16*)(WS(P) + O_X0C);
  const float* cw = P.in[8];
  const float* cb = P.in[9];
  float* tile = (float*)smem;
  const int ntt = L / 64;
  const int nitems = nseq * ntt * 16;
  for (int item = BID(); item < nitems; item += gridDim.x) {
    const int ct = item % 16, tt = (item / 16) % ntt, seq = item / (16 * ntt);
    __syncthreads();
    for (int i = tid; i < 4096; i += NT) {
      const int tl = i >> 6, cl = i & 63;
      const int t = tt * 64 + tl, c = ct * 64 + cl;
      const long row = (long)seq * L + t;
      float val[3];
#pragma unroll
      for (int q = 0; q < 3; ++q) {
        const int col = q * 1024 + c;
        float a = bf2f(z[row * 3072 + col]) * cw[3072 + col] + cb[col];
        if (t > 0) a += bf2f(z[(row - 1) * 3072 + col]) * cw[col];
        if (t < L - 1) a += bf2f(z[(row + 1) * 3072 + col]) * cw[2 * 3072 + col];
        val[q] = a;
      }
      x0c[row * 1024 + c] = f2bf(val[0]);
      tile[tl * 65 + cl] = val[1] * val[2];
    }
    __syncthreads();
    for (int i = tid; i < 4096; i += NT) {
      const int cl = i >> 6, tl = i & 63;
      uT[((long)seq * 1024 + ct * 64 + cl) * L + tt * 64 + tl] = tile[tl * 65 + cl];
    }
  }
  __syncthreads();
}

__device__ void phase_hy_fft(const Params& P, int slab) {
  const int L = Lof(slab), N = 2 * L, nseq = SLAB / L, tid = TID();
  float* uT = (float*)(WS(P) + O_UT);
  const float2* hsb = (const float2*)(WS(P) + (slab == 0 ? O_HSPP : O_HSPS));
  const float2* tw = (const float2*)(WS(P) + O_TW);
  const float* skip = P.in[17];
  float2* buf = (float2*)smem;
  const int nitems = (nseq / 2) * 1024;
  for (int item = BID(); item < nitems; item += gridDim.x) {
    const int pr = item >> 10, c = item & 1023;
    float* u0 = uT + ((long)(pr * 2) * 1024 + c) * L;
    float* u1 = u0 + (long)1024 * L;
    __syncthreads();
    for (int t = tid; t < L; t += NT) {
      buf[t] = make_float2(u0[t], u1[t]);
      buf[t + L] = make_float2(0.f, 0.f);
    }
    __syncthreads();
    fft_dif(buf, N, tw);
    const float2* h = hsb + (long)c * N;
    for (int p = tid; p < N; p += NT) {
      float2 a = buf[p], b = h[p];
      buf[p] = make_float2(a.x * b.x - a.y * b.y, a.x * b.y + a.y * b.x);
    }
    __syncthreads();
    ifft_dit(buf, N, tw);
    const float sk = skip[c];
    for (int t = tid; t < L; t += NT) {
      float2 y = buf[t];
      u0[t] = y.x + u0[t] * sk;
      u1[t] = y.y + u1[t] * sk;
    }
  }
  __syncthreads();
}

__device__ void phase_hy_tr(const Params& P, int slab) {
  const int L = Lof(slab), nseq = SLAB / L, tid = TID();
  const float* yT = (const float*)(WS(P) + O_UT);
  const u16* x0c = (const u16*)(WS(P) + O_X0C);
  u16* a2 = (u16*)(WS(P) + O_A2);
  float* tile = (float*)smem;
  const int ntt = L / 64;
  const int nitems = nseq * ntt * 16;
  for (int item = BID(); item < nitems; item += gridDim.x) {
    const int ct = item % 16, tt = (item / 16) % ntt, seq = item / (16 * ntt);
    __syncthreads();
    for (int i = tid; i < 4096; i += NT) {
      const int cl = i >> 6, tl = i & 63;
      tile[cl * 65 + tl] = yT[((long)seq * 1024 + ct * 64 + cl) * L + tt * 64 + tl];
    }
    __syncthreads();
    for (int i = tid; i < 4096; i += NT) {
      const int tl = i >> 6, cl = i & 63;
      const long row = (long)seq * L + tt * 64 + tl;
      const int c = ct * 64 + cl;
      a2[row * 1024 + c] = f2bf(tile[cl * 65 + tl] * bf2f(x0c[row * 1024 + c]));
    }
  }
  __syncthreads();
}

struct Rec {
  int H, DK, DV, C;
  int ldv, voff, goff;
};
__device__ __forceinline__ Rec rec_of(int kind) {
  Rec r;
  if (kind == 1) { r.H = 4; r.DK = 256; r.DV = 512; r.C = 128; r.ldv = 6144; r.voff = 2048; r.goff = 4096; }
  else { r.H = 8; r.DK = 128; r.DV = 128; r.C = 64; r.ldv = 5120; r.voff = 1024; r.goff = 4096; }
  return r;
}

__device__ void phase_ret_prep(const Params& P, int slab) {
  const int L = Lof(slab);
  const u16* pj = (const u16*)(WS(P) + O_PROJ);
  u16* qdf = (u16*)(WS(P) + O_QDF); u16* qdb = (u16*)(WS(P) + O_QDB);
  u16* kif = (u16*)(WS(P) + O_KIF); u16* kib = (u16*)(WS(P) + O_KIB);
  u16* kef = (u16*)(WS(P) + O_KEF); u16* keb = (u16*)(WS(P) + O_KEB);
  float* dlf = (float*)(WS(P) + O_DLF); float* dlb = (float*)(WS(P) + O_DLB);
  const float2* rope = (const float2*)(WS(P) + O_ROPER);
  const long gtid = (long)BID() * NT + TID(), gsz = (long)gridDim.x * NT;
  for (long idx = gtid; idx < (long)SLAB * 512; idx += gsz) {
    const int d = (int)(idx & 127), h = (int)((idx >> 7) & 3), t = (int)(idx >> 9);
    const int pos = t & (L - 1), r = t & 127;
    const float lgf = -expf(P.in[20][h]), lgb = -expf(P.in[20][4 + h]);
    const u16* row = pj + (long)t * 6144;
    const float q1 = bf2f(row[h * 256 + d]), q2 = bf2f(row[h * 256 + d + 128]);
    const float k1 = bf2f(row[1024 + h * 256 + d]), k2 = bf2f(row[1024 + h * 256 + d + 128]);
    const float2 cs = rope[(long)pos * 128 + d];
    const float qa = q1 * cs.x - q2 * cs.y, qb = q1 * cs.y + q2 * cs.x;
    const float ka = (k1 * cs.x - k2 * cs.y) * 0.0625f, kb = (k1 * cs.y + k2 * cs.x) * 0.0625f;
    const float bf = (float)(r + 1) * lgf, bb = (float)(128 - r) * lgb;
    const float ef = expf(bf), eif = expf(-bf), eef = expf((float)(127 - r) * lgf);
    const float eb = expf(bb), eib = expf(-bb), eeb = expf((float)r * lgb);
    const long o1 = (long)t * 1024 + h * 256 + d, o2 = o1 + 128;
    qdf[o1] = f2bf(qa * ef); qdf[o2] = f2bf(qb * ef);
    qdb[o1] = f2bf(qa * eb); qdb[o2] = f2bf(qb * eb);
    kif[o1] = f2bf(ka * eif); kif[o2] = f2bf(kb * eif);
    kib[o1] = f2bf(ka * eib); kib[o2] = f2bf(kb * eib);
    kef[o1] = f2bf(ka * eef); kef[o2] = f2bf(kb * eef);
    keb[o1] = f2bf(ka * eeb); keb[o2] = f2bf(kb * eeb);
    if (r == 0) {
      const long cgi = (long)(t >> 7) * 1024 + h * 256 + d;
      const float df = expf(128.f * lgf), db = expf(128.f * lgb);
      dlf[cgi] = df; dlf[cgi + 128] = df;
      dlb[cgi] = db; dlb[cgi + 128] = db;
    }
  }
}

__device__ void phase_hg_prep(const Params& P) {
  const u16* pj = (const u16*)(WS(P) + O_PROJ);
  u16* qdf = (u16*)(WS(P) + O_QDF); u16* qdb = (u16*)(WS(P) + O_QDB);
  u16* kif = (u16*)(WS(P) + O_KIF); u16* kib = (u16*)(WS(P) + O_KIB);
  u16* kef = (u16*)(WS(P) + O_KEF); u16* keb = (u16*)(WS(P) + O_KEB);
  float* dlf = (float*)(WS(P) + O_DLF); float* dlb = (float*)(WS(P) + O_DLB);
  const float* lbt = P.in[28];
  float* totF = (float*)smem;
  float* totB = totF + 512;
  const int tid = TID(), lane = tid & 63, rg = tid >> 6;
  for (int item = BID(); item < 4096; item += gridDim.x) {
    const int cgi = item >> 4, ch = (item & 15) * 64 + lane;
    float lb0, lb1;
    {
      float a0 = lbt[0 * 1024 + ch], a1 = lbt[1 * 1024 + ch], a2 = lbt[2 * 1024 + ch], a3 = lbt[3 * 1024 + ch];
      float m = fmaxf(fmaxf(a0, a1), fmaxf(a2, a3));
      float e0 = expf(a0 - m), e1 = expf(a1 - m), e2 = expf(a2 - m), e3 = expf(a3 - m);
      lb0 = (e0 + e1 + e2) / (e0 + e1 + e2 + e3);
      a0 = lbt[4 * 1024 + ch]; a1 = lbt[5 * 1024 + ch]; a2 = lbt[6 * 1024 + ch]; a3 = lbt[7 * 1024 + ch];
      m = fmaxf(fmaxf(a0, a1), fmaxf(a2, a3));
      e0 = expf(a0 - m); e1 = expf(a1 - m); e2 = expf(a2 - m); e3 = expf(a3 - m);
      lb1 = (e0 + e1 + e2) / (e0 + e1 + e2 + e3);
    }
    const long t0 = (long)cgi * 64 + rg * 8;
    float xq[8], xf[8], xb[8];
#pragma unroll
    for (int i = 0; i < 8; ++i) {
      const u16* row = pj + (t0 + i) * 5120;
      xq[i] = bf2f(row[ch]); xf[i] = bf2f(row[2048 + ch]); xb[i] = bf2f(row[3072 + ch]);
    }
    float pf[8], sb[8];
    float accf = 0.f;
#pragma unroll
    for (int i = 0; i < 8; ++i) { accf += logf(lb0 + (1.f - lb0) * sigm(xf[i])); pf[i] = accf; }
    float accb = 0.f;
#pragma unroll
    for (int i = 7; i >= 0; --i) { accb += logf(lb1 + (1.f - lb1) * sigm(xb[i])); sb[i] = accb; }
    __syncthreads();
    totF[rg * 64 + lane] = accf;
    totB[rg * 64 + lane] = accb;
    __syncthreads();
    float offF = 0.f, offB = 0.f, totf = 0.f, totb = 0.f;
#pragma unroll
    for (int g = 0; g < 8; ++g) {
      const float f = totF[g * 64 + lane], bq = totB[g * 64 + lane];
      totf += f; totb += bq;
      if (g < rg) offF += f;
      if (g > rg) offB += bq;
    }
#pragma unroll
    for (int i = 0; i < 8; ++i) {
      const float q = silu_f(xq[i]);
      const float bf = offF + pf[i], bb = offB + sb[i];
      const float kf = (1.f - lb0) * sigm(-xf[i]), kb = (1.f - lb1) * sigm(-xb[i]);
      const long o = (t0 + i) * 1024 + ch;
      qdf[o] = f2bf(q * expf(bf));
      kif[o] = f2bf(kf * expf(-bf));
      kef[o] = f2bf(kf * expf(totf - bf));
      qdb[o] = f2bf(q * expf(bb));
      kib[o] = f2bf(kb * expf(-bb));
      keb[o] = f2bf(kb * expf(totb - bb));
    }
    if (rg == 0) {
      dlf[(long)cgi * 1024 + ch] = expf(totf);
      dlb[(long)cgi * 1024 + ch] = expf(totb);
    }
  }
  __syncthreads();
}

template <int C>
__device__ __forceinline__ void rec_scores_item(const Params& P, const Rec& R, int cgi, int h) {
  const u16* qdf = (const u16*)(WS(P) + O_QDF); const u16* qdb = (const u16*)(WS(P) + O_QDB);
  const u16* kif = (const u16*)(WS(P) + O_KIF); const u16* kib = (const u16*)(WS(P) + O_KIB);
  u16* sc = (u16*)(WS(P) + O_SC) + ((long)cgi * R.H + h) * C * C;
  const long off = (long)cgi * C * 1024 + h * R.DK;
  f32x4 af[C / 32][C / 64] = {}, ab[C / 32][C / 64] = {};
  gemm_acc<C, C, true, true, true>(af, qdf + off, 1024, kif + off, 1024, R.DK, (u16*)smem);
  gemm_acc<C, C, true, true, true>(ab, qdb + off, 1024, kib + off, 1024, R.DK, (u16*)smem);
  const int tid = TID(), lane = tid & 63, wid = tid >> 6;
  const int wm = wid >> 2, wn = wid & 3, fr = lane & 15, fq = lane >> 4;
#pragma unroll
  for (int mi = 0; mi < C / 32; ++mi)
#pragma unroll
    for (int ni = 0; ni < C / 64; ++ni) {
      const int r = wm * (C / 2) + mi * 16 + fr, c0 = wn * (C / 4) + ni * 16 + fq * 4;
      float v[4];
#pragma unroll
      for (int j = 0; j < 4; ++j) {
        const int c = c0 + j;
        v[j] = (c <= r ? af[mi][ni][j] : 0.f) + (c >= r ? ab[mi][ni][j] : 0.f);
      }
      *(uint2*)(sc + r * C + c0) = make_uint2(pack2(v[0], v[1]), pack2(v[2], v[3]));
    }
}

template <int C>
__device__ void phase_rec_su(const Params& P, int kind) {
  const Rec R = rec_of(kind);
  const int nch = SLAB / C;
  const int n_sc = nch * R.H;
  const int mtn = R.DK / 128, ntn = R.DV / 128;
  const int n_u = nch * R.H * 2 * mtn * ntn;
  const u16* pj = (const u16*)(WS(P) + O_PROJ);
  for (int item = BID(); item < n_sc + n_u; item += gridDim.x) {
    if (item < n_sc) {
      rec_scores_item<C>(P, R, item / R.H, item % R.H);
    } else {
      int q = item - n_sc;
      const int nt = q % ntn; q /= ntn;
      const int mt = q % mtn; q /= mtn;
      const int dir = q & 1; q >>= 1;
      const int h = q % R.H, cgi = q / R.H;
      const u16* ke = (const u16*)(WS(P) + (dir ? O_KEB : O_KEF)) + (long)cgi * C * 1024 + h * R.DK + mt * 128;
      const u16* v = pj + (long)cgi * C * R.ldv + R.voff + h * R.DV + nt * 128;
      u16* st = (u16*)(WS(P) + (dir ? O_STB : O_STF)) + (((long)cgi * R.H + h) * R.DV + nt * 128) * R.DK + mt * 128;
      f32x4 acc[4][2] = {};
      gemm_acc<128, 128, false, false, false>(acc, ke, 1024, v, R.ldv, C, (u16*)smem);
      const int DK = R.DK;
      epi_each<128, 128, false>(acc, [&](int r, int c, f32x4 val) {
        *(uint2*)(st + (long)c * DK + r) = make_uint2(pack2(val[0], val[1]), pack2(val[2], val[3]));
      });
    }
  }
}

__device__ void phase_rec_scan(const Params& P, int kind, int slab) {
  const Rec R = rec_of(kind);
  const int L = Lof(slab), nseq = SLAB / L, ncs = L / R.C;
  const int hdk = R.DK / 2;
  const long per = (long)R.H * R.DV * hdk;
  const long total = 2 * nseq * per;
  const long gtid = (long)BID() * NT + TID(), gsz = (long)gridDim.x * NT;
  for (long idx = gtid; idx < total; idx += gsz) {
    long q = idx;
    const int pd = (int)(q % hdk); q /= hdk;
    const int e = (int)(q % R.DV); q /= R.DV;
    const int h = (int)(q % R.H); q /= R.H;
    const int seq = (int)(q % nseq);
    const int dir = (int)(q / nseq);
    u16* st = (u16*)(WS(P) + (dir ? O_STB : O_STF));
    const float* dl = (const float*)(WS(P) + (dir ? O_DLB : O_DLF));
    float s0 = 0.f, s1 = 0.f;
    const long ebase = ((long)h * R.DV + e) * R.DK + pd * 2;
    const long cstride = (long)R.H * R.DV * R.DK;
    const int dbase = h * R.DK + pd * 2;
    for (int i0 = 0; i0 < ncs; i0 += 8) {
      unsigned u[8];
      float2 dd[8];
#pragma unroll
      for (int j = 0; j < 8; ++j) {
        const int n = dir ? (ncs - 1 - i0 - j) : (i0 + j);
        const long cgi = (long)seq * ncs + n;
        u[j] = *(const unsigned*)(st + cgi * cstride + ebase);
        dd[j] = *(const float2*)(dl + cgi * 1024 + dbase);
      }
#pragma unroll
      for (int j = 0; j < 8; ++j) {
        const int n = dir ? (ncs - 1 - i0 - j) : (i0 + j);
        const long cgi = (long)seq * ncs + n;
        *(unsigned*)(st + cgi * cstride + ebase) = pack2(s0, s1);
        s0 = dd[j].x * s0 + bf2f((u16)(u[j] & 0xffff));
        s1 = dd[j].y * s1 + bf2f((u16)(u[j] >> 16));
      }
    }
  }
}

template <int C>
__device__ void phase_rec_out(const Params& P, int kind) {
  const Rec R = rec_of(kind);
  const int nch = SLAB / C, ntn = R.DV / 128;
  const u16* pj = (const u16*)(WS(P) + O_PROJ);
  float* ob = (float*)(WS(P) + O_OBUF);
  const int HDV = R.H * R.DV;
  for (int item = BID(); item < nch * R.H * ntn; item += gridDim.x) {
    const int nt = item % ntn, h = (item / ntn) % R.H, cgi = item / (ntn * R.H);
    f32x4 acc[C / 32][2] = {};
    const u16* sc = (const u16*)(WS(P) + O_SC) + ((long)cgi * R.H + h) * C * C;
    const u16* v = pj + (long)cgi * C * R.ldv + R.voff + h * R.DV + nt * 128;
    gemm_acc<C, 128, true, false, true>(acc, sc, C, v, R.ldv, C, (u16*)smem);
    const long qoff = (long)cgi * C * 1024 + h * R.DK;
    const long soff = (((long)cgi * R.H + h) * R.DV + nt * 128) * R.DK;
    gemm_acc<C, 128, true, true, true>(acc, (const u16*)(WS(P) + O_QDF) + qoff, 1024, (const u16*)(WS(P) + O_STF) + soff, R.DK, R.DK, (u16*)smem);
    gemm_acc<C, 128, true, true, true>(acc, (const u16*)(WS(P) + O_QDB) + qoff, 1024, (const u16*)(WS(P) + O_STB) + soff, R.DK, R.DK, (u16*)smem);
    float* o = ob + (long)cgi * C * HDV + h * R.DV + nt * 128;
    epi_each<C, 128, true>(acc, [&](int r, int c, f32x4 val) { *(f32x4*)(o + (long)r * HDV + c) = val; });
  }
}

__device__ void phase_rec_ng(const Params& P, int kind) {
  const Rec R = rec_of(kind);
  const int HDV = R.H * R.DV;
  const float* ob = (const float*)(WS(P) + O_OBUF);
  const u16* pj = (const u16*)(WS(P) + O_PROJ);
  u16* a2 = (u16*)(WS(P) + O_A2);
  const float* gain = (kind == 3) ? P.in[29] : nullptr;
  const int tid = TID(), lane = tid & 63, wid = tid >> 6;
  const int nrows = SLAB * R.H;
  const int per = R.DV / 64;
  for (int item = BID(); item < nrows / 32; item += gridDim.x) {
    float ss[4];
#pragma unroll
    for (int u = 0; u < 4; ++u) {
      const int rh = item * 32 + wid * 4 + u;
      const int t = rh / R.H, h = rh % R.H;
      const float* o = ob + (long)t * HDV + h * R.DV + lane * per;
      float a = 0.f;
      for (int i = 0; i < per; ++i) { float v = o[i]; a += v * v; }
      ss[u] = a;
    }
#pragma unroll
    for (int u = 0; u < 4; ++u) ss[u] = wave_sum(ss[u]);
#pragma unroll
    for (int u = 0; u < 4; ++u) {
      const int rh = item * 32 + wid * 4 + u;
      const int t = rh / R.H, h = rh % R.H;
      const float* o = ob + (long)t * HDV + h * R.DV + lane * per;
      const float rstd = rsqrtf(ss[u] / (float)R.DV + 1e-6f);
      const u16* g = pj + (long)t * R.ldv + R.goff + h * R.DV + lane * per;
      u16* out = a2 + (long)t * HDV + h * R.DV + lane * per;
      for (int i = 0; i < per; ++i) {
        float y = o[i] * rstd;
        if (gain) y *= gain[lane * per + i];
        out[i] = f2bf(y * silu_f(bf2f(g[i])));
      }
    }
  }
}

__device__ void phase_swa_prep(const Params& P, int slab) {
  const int L = Lof(slab);
  const u16* pj = (const u16*)(WS(P) + O_PROJ);
  u16* qn = (u16*)(WS(P) + O_QN);
  u16* kn = (u16*)(WS(P) + O_KN);
  const float2* rope = (const float2*)(WS(P) + O_ROPES);
  const long gtid = (long)BID() * NT + TID(), gsz = (long)gridDim.x * NT;
  for (long idx = gtid; idx < (long)SLAB * 640; idx += gsz) {
    const int d = (int)(idx & 31);
    const int hd = (int)((idx >> 5) % 20);
    const int t = (int)(idx / 640);
    const int col = hd < 16 ? hd * 64 : 1024 + (hd - 16) * 64;
    const float x1 = bf2f(pj[(long)t * 1536 + col + d]), x2 = bf2f(pj[(long)t * 1536 + col + d + 32]);
    float ss = x1 * x1 + x2 * x2;
#pragma unroll
    for (int o = 16; o; o >>= 1) ss += __shfl_xor(ss, o);
    const float rstd = rsqrtf(ss * (1.f / 64.f) + 1e-6f);
    const float* gn = hd < 16 ? P.in[23] : P.in[24];
    const float y1 = x1 * rstd * gn[d], y2 = x2 * rstd * gn[d + 32];
    const float2 cs = rope[(long)(t & (L - 1)) * 32 + d];
    float o1 = y1 * cs.x - y2 * cs.y, o2 = y1 * cs.y + y2 * cs.x;
    if (hd < 16) {
      qn[(long)t * 1024 + hd * 64 + d] = f2bf(o1 * 0.125f);
      qn[(long)t * 1024 + hd * 64 + d + 32] = f2bf(o2 * 0.125f);
    } else {
      kn[(long)t * 256 + (hd - 16) * 64 + d] = f2bf(o1);
      kn[(long)t * 256 + (hd - 16) * 64 + d + 32] = f2bf(o2);
    }
  }
}

constexpr int SLD = 324;
__device__ void phase_swa_att1(const Params& P, int slab) {
  const int L = Lof(slab), nqb = L / 64;
  const u16* qn = (const u16*)(WS(P) + O_QN);
  const u16* kn = (const u16*)(WS(P) + O_KN);
  u16* pb = (u16*)(WS(P) + O_PBUF);
  const float* sink = P.in[25];
  float* S = (float*)(smem + 40960);
  const int tid = TID();
  const int nitems = (SLAB / 64) * 16;
  for (int item = BID(); item < nitems; item += gridDim.x) {
    const int hq = item & 15, qbg = item >> 4;
    const int seq = qbg / nqb, qb = qbg % nqb;
    const int q0 = qb * 64;
    const long tok0 = (long)seq * L;
    const int hkv = hq >> 2;
    for (int kt = 0; kt < 5; ++kt) {
      const int kp0 = q0 - 128 + kt * 64;
      if (kp0 >= 0 && kp0 < L) {
        f32x4 acc[2][1] = {};
        gemm_acc<64, 64, true, true, true>(acc, qn + (tok0 + q0) * 1024 + hq * 64, 1024, kn + (tok0 + kp0) * 256 + hkv * 64, 256, 64, (u16*)smem);
        epi_each<64, 64, true>(acc, [&](int r, int c, f32x4 v) {
          f32x4 o;
#pragma unroll
          for (int j = 0; j < 4; ++j) {
            const int dlt = (q0 + r) - (kp0 + c + j);
            o[j] = (dlt <= 128 && dlt >= -128) ? v[j] : -1e30f;
          }
          *(f32x4*)(S + r * SLD + kt * 64 + c) = o;
        });
      } else {
        for (int i = tid; i < 4096; i += NT) S[(i >> 6) * SLD + kt * 64 + (i & 63)] = -1e30f;
      }
    }
    __syncthreads();
    {
      const int r = tid >> 3, sub = tid & 7;
      const float sk = sink[hq];
      float m = sk;
      for (int c = sub; c < 320; c += 8) m = fmaxf(m, S[r * SLD + c]);
      m = fmaxf(m, __shfl_xor(m, 1)); m = fmaxf(m, __shfl_xor(m, 2)); m = fmaxf(m, __shfl_xor(m, 4));
      float den = 0.f;
      for (int c = sub; c < 320; c += 8) { float e = __expf(S[r * SLD + c] - m); S[r * SLD + c] = e; den += e; }
      den += __shfl_xor(den, 1); den += __shfl_xor(den, 2); den += __shfl_xor(den, 4);
      den += __expf(sk - m);
      const float inv = 1.f / den;
      u16* prow = pb + ((long)item * 64 + r) * 320;
      for (int c = sub; c < 320; c += 8) prow[c] = f2bf(S[r * SLD + c] * inv);
    }
    __syncthreads();
  }
}

__device__ void phase_swa_att2(const Params& P, int slab) {
  const int L = Lof(slab), nqb = L / 64;
  const u16* pj = (const u16*)(WS(P) + O_PROJ);
  const u16* pb = (const u16*)(WS(P) + O_PBUF);
  u16* a2 = (u16*)(WS(P) + O_A2);
  const int nitems = (SLAB / 64) * 16;
  for (int item = BID(); item < nitems; item += gridDim.x) {
    const int hq = item & 15, qbg = item >> 4;
    const int seq = qbg / nqb, qb = qbg % nqb;
    const int q0 = qb * 64;
    const long tok0 = (long)seq * L;
    const int hkv = hq >> 2;
    f32x4 acc[2][1] = {};
    for (int kt = 0; kt < 5; ++kt) {
      const int kp0 = q0 - 128 + kt * 64;
      if (kp0 >= 0 && kp0 < L)
        gemm_acc<64, 64, true, false, true>(acc, pb + (long)item * 64 * 320 + kt * 64, 320, pj + (tok0 + kp0) * 1536 + 1280 + hkv * 64, 1536, 64, (u16*)smem);
    }
    u16* o = a2 + (tok0 + q0) * 1024 + hq * 64;
    epi_each<64, 64, true>(acc, [&](int r, int c, f32x4 v) { *(uint2*)(o + (long)r * 1024 + c) = make_uint2(pack2(v[0], v[1]), pack2(v[2], v[3])); });
  }
}

__device__ __forceinline__ int nsteps_of(int kind) { return (kind & 1) ? 12 : 10; }

__device__ void layer_step(const Params& P, int layer, int slab, int step) {
  const int kind = layer;
  const int nmix = nsteps_of(kind) - 4;
  if (step == 0) { REP(4) phase_norm(P, layer, slab, 0); return; }
  if (step >= nmix) {
    const int f = step - nmix;
    if (f == 0) { REP(4) phase_norm(P, layer, slab, 1); }
    else if (f == 1) { REP(0) phase_ffn_gate(P, layer); }
    else if (f == 2) { REP(0) phase_ffn_val(P, layer, slab); }
    else phase_resid(P, layer, slab, (const u16*)(WS(P) + O_ACT), DFF, O_WFD + (size_t)layer * SZW(1024, 2816), 5 * D);
    return;
  }
  if (kind == 0) {
    if (step == 1) { REP(0) phase_proj(P, O_WHYIN, 3072); }
    else if (step == 2) { REP(3) phase_hy_conv(P, slab); }
    else if (step == 3) phase_hy_fft(P, slab);
    else if (step == 4) { REP(3) phase_hy_tr(P, slab); }
    else phase_resid(P, layer, slab, (const u16*)(WS(P) + O_A2), 1024, O_WHYOUT, 2 * D);
  } else if (kind == 1) {
    if (step == 1) { REP(0) phase_proj(P, O_WRETIN, 6144); }
    else if (step == 2) { REP(1) phase_ret_prep(P, slab); }
    else if (step == 3) { REP(1) phase_rec_su<128>(P, 1); }
    else if (step == 4) phase_rec_scan(P, 1, slab);
    else if (step == 5) { REP(1) phase_rec_out<128>(P, 1); }
    else if (step == 6) { REP(1) phase_rec_ng(P, 1); }
    else phase_resid(P, layer, slab, (const u16*)(WS(P) + O_A2), 2048, O_WRETOUT, 2 * D);
  } else if (kind == 2) {
    if (step == 1) { REP(0) phase_proj(P, O_WSWAIN, 1536); }
    else if (step == 2) { REP(2) phase_swa_prep(P, slab); }
    else if (step == 3) { REP(2) phase_swa_att1(P, slab); }
    else if (step == 4) { REP(2) phase_swa_att2(P, slab); }
    else phase_resid(P, layer, slab, (const u16*)(WS(P) + O_A2), 1024, O_WSWAOUT, 2 * D);
  } else {
    if (step == 1) { REP(0) phase_proj(P, O_WHGIN, 5120); }
    else if (step == 2) { REP(1) phase_hg_prep(P); }
    else if (step == 3) { REP(1) phase_rec_su<64>(P, 3); }
    else if (step == 4) phase_rec_scan(P, 3, slab);
    else if (step == 5) { REP(1) phase_rec_out<64>(P, 3); }
    else if (step == 6) { REP(1) phase_rec_ng(P, 3); }
    else phase_resid(P, layer, slab, (const u16*)(WS(P) + O_A2), 1024, O_WHGOUT, 2 * D);
  }
}

__global__ void __launch_bounds__(NT) fwd_megakernel(Params P) {
  cg::grid_group grid = cg::this_grid();
  for (int pid = P.p0; pid < P.p1; ++pid) {
    if (pid == 0) { REP(5) phase_pre0(P); }
    else if (pid == 1) { REP(5) phase_pre1(P); }
    else {
      int q = pid - 2, layer = 0;
      while (q >= 5 * nsteps_of(layer)) { q -= 5 * nsteps_of(layer); ++layer; }
      const int ns = nsteps_of(layer);
      layer_step(P, layer, q / ns, q % ns);
    }
    if (pid + 1 < P.p1) grid.sync();
  }
}

extern "C" void kernel_launch(void* const* d_in, const int* in_sizes, int n_in, void* d_out, int out_size, void* d_ws,
                              size_t ws_size, hipStream_t stream) {
  static int grid_blocks = 0;
  if (!grid_blocks) {
    int dev = 0, cus = 0, per_cu = 0;
    (void)hipGetDevice(&dev);
    (void)hipDeviceGetAttribute(&cus, hipDeviceAttributeMultiprocessorCount, dev);
    (void)hipFuncSetAttribute((const void*)fwd_megakernel, hipFuncAttributeMaxDynamicSharedMemorySize, LDSB);
    (void)hipOccupancyMaxActiveBlocksPerMultiprocessor(&per_cu, (const void*)fwd_megakernel, NT, LDSB);
    if (per_cu < 1) per_cu = 1;
    if (per_cu > 1) per_cu = 1;
    grid_blocks = cus * per_cu;
    if (ws_size < WS_END) fprintf(stderr, "kernel_launch: workspace too small: %zu < %zu\n", ws_size, (size_t)WS_END);
  }
  Params p;
  memset(&p, 0, sizeof(p));
  for (int i = 0; i < 36; ++i) p.in[i] = (const float*)d_in[i];
  p.out = (float*)d_out;
  p.ws = (unsigned char*)d_ws;
#if ONE_LAUNCH
  p.p0 = 0; p.p1 = NPHASES;
  void* args[] = {&p};
  hipError_t e = hipLaunchCooperativeKernel((const void*)fwd_megakernel, dim3(grid_blocks), dim3(NT), args, LDSB, stream);
  if (e != hipSuccess) fprintf(stderr, "cooperative launch failed: %s (grid %d)\n", hipGetErrorString(e), grid_blocks);
#else
  for (int ph = 0; ph < NPHASES; ++ph) {
    p.p0 = ph; p.p1 = ph + 1;
    hipLaunchKernelGGL(fwd_megakernel, dim3(grid_blocks), dim3(NT), LDSB, stream, p);
  }
#endif
}
```

```cpp
#include <hip/hip_runtime.h>
#include <hip/hip_cooperative_groups.h>
#include <cstdio>
#include <cstdint>
#include <cstring>
namespace cg = cooperative_groups;

typedef unsigned short u16;
typedef __attribute__((ext_vector_type(8))) short bf16x8;
typedef __attribute__((ext_vector_type(4))) float f32x4;

#define NT 512
#ifndef ONE_LAUNCH
#define ONE_LAUNCH 1
#endif
#ifndef PROBE_MASK
#define PROBE_MASK 0
#endif
#define REP(cls) for (int rep_ = 0; rep_ < (((PROBE_MASK >> (cls)) & 1) ? 2 : 1); ++rep_)

constexpr int D = 1024, SLAB = 16384, DFF = 2816;
constexpr int LDSB = 131072;
constexpr int NPHASES = 2 + 5 * (10 + 12 + 10 + 12);

constexpr size_t SZW(size_t n, size_t k) { return n * k * 2; }
constexpr size_t O_WHYIN = 0;
constexpr size_t O_WHYOUT = O_WHYIN + SZW(3072, 1024);
constexpr size_t O_WRETIN = O_WHYOUT + SZW(1024, 1024);
constexpr size_t O_WRETOUT = O_WRETIN + SZW(6144, 1024);
constexpr size_t O_WSWAIN = O_WRETOUT + SZW(1024, 2048);
constexpr size_t O_WSWAOUT = O_WSWAIN + SZW(1536, 1024);
constexpr size_t O_WHGIN = O_WSWAOUT + SZW(1024, 1024);
constexpr size_t O_WHGOUT = O_WHGIN + SZW(5120, 1024);
constexpr size_t O_WFG = O_WHGOUT + SZW(1024, 1024);
constexpr size_t O_WFV = O_WFG + 4 * SZW(2816, 1024);
constexpr size_t O_WFD = O_WFV + 4 * SZW(2816, 1024);
constexpr size_t O_MOD = O_WFD + 4 * SZW(1024, 2816);
constexpr size_t O_TW = O_MOD + (size_t)4 * 16 * 6144 * 4;
constexpr size_t O_HIDS = O_TW + 8192 * 8;
constexpr size_t O_HIDP = O_HIDS + (size_t)8192 * 64 * 4;
constexpr size_t O_ROPER = O_HIDP + (size_t)2048 * 64 * 4;
constexpr size_t O_ROPES = O_ROPER + (size_t)8192 * 128 * 8;
constexpr size_t O_PROJ = O_ROPES + (size_t)8192 * 32 * 8;
constexpr size_t O_HBUF = O_PROJ + (size_t)SLAB * 6144 * 2;
constexpr size_t O_A2 = O_HBUF + (size_t)SLAB * 1024 * 2;
constexpr size_t O_C = O_A2 + (size_t)SLAB * 2048 * 2;
constexpr size_t O_GBUF = O_C;
constexpr size_t O_ACT = O_GBUF + (size_t)SLAB * DFF * 2;
constexpr size_t O_MODP = O_C;
constexpr size_t O_HSPS = O_ACT + (size_t)SLAB * DFF * 2;
constexpr size_t O_HSPP = O_HSPS + (size_t)1024 * 16384 * 8;
constexpr size_t O_UT = O_HSPP + (size_t)1024 * 4096 * 8;
constexpr size_t O_X0C = O_UT + (size_t)SLAB * 1024 * 4;
constexpr size_t END_HY = O_X0C + (size_t)SLAB * 1024 * 2;
constexpr size_t SZP = (size_t)SLAB * 1024 * 2;
constexpr size_t O_QDF = O_C, O_QDB = O_QDF + SZP, O_KIF = O_QDB + SZP, O_KIB = O_KIF + SZP, O_KEF = O_KIB + SZP, O_KEB = O_KEF + SZP;
constexpr size_t O_DLF = O_KEB + SZP;
constexpr size_t O_DLB = O_DLF + (size_t)256 * 1024 * 4;
constexpr size_t O_SC = O_DLB + (size_t)256 * 1024 * 4;
constexpr size_t O_STF = O_SC + (size_t)SLAB * 512 * 2;
constexpr size_t O_STB = O_STF + (size_t)134217728;
constexpr size_t O_OBUF = O_STB + (size_t)134217728;
constexpr size_t END_REC = O_OBUF + (size_t)SLAB * 2048 * 4;
constexpr size_t O_QN = O_C;
constexpr size_t O_KN = O_QN + SZP;
constexpr size_t O_PBUF = O_KN + (size_t)SLAB * 256 * 2;
constexpr size_t END_SWA = O_PBUF + (size_t)SLAB * 16 * 320 * 2;
constexpr size_t WS_END = END_REC > END_HY ? (END_REC > END_SWA ? END_REC : END_SWA) : (END_HY > END_SWA ? END_HY : END_SWA);
constexpr size_t O_BAR = ((size_t)1 << 30) - 16384;
static_assert(WS_END <= O_BAR, "workspace exceeds 1 GiB");

struct Params {
  const float* in[36];
  float* out;
  unsigned char* ws;
  int p0, p1;
};

extern __shared__ __attribute__((aligned(16))) unsigned char smem[];

__device__ __forceinline__ int TID() { int t = threadIdx.x; asm volatile("" : "+v"(t)); return t; }
__device__ __forceinline__ int BID() { int b = blockIdx.x; asm volatile("" : "+s"(b)); return b; }
__device__ __forceinline__ long ZOFF() { long z = 0; asm volatile("" : "+s"(z)); return z; }
__device__ __forceinline__ unsigned char* WS(const Params& P) { return P.ws + ZOFF(); }
__device__ __forceinline__ float* OUTP(const Params& P) { return P.out + ZOFF(); }

namespace pg8 {
#define PG8_LAS __attribute__((address_space(3)))
typedef unsigned short bf16_t;
typedef short bf16x8 __attribute__((ext_vector_type(8)));
typedef float f32x4 __attribute__((ext_vector_type(4)));
typedef unsigned u32x4 __attribute__((ext_vector_type(4)));
constexpr int BM = 256, BK = 64, HALF = 128, HTB = HALF * BK * 2  , STAGE_BYTES = 8 * HTB, NXCD = 8, WGM = 8;

__host__ __device__ __forceinline__ int lds_byte(int r, int c) { const int st = (r >> 4) * 2 + (c >> 5), rr = r & 15, cc = c & 31, ob = rr * 64 + cc * 2; return st * 1024 + (ob ^ (((ob >> 9) & 1) << 5)); }
__host__ __device__ __forceinline__ void stage_rc(int b, int& R, int& C) { const int st = b / 1024, sb = b % 1024, swz = sb ^ (((sb >> 9) & 1) << 5); R = (st >> 1) * 16 + swz / 64; C = (st & 1) * 32 + (swz % 64) / 2; }
__host__ __device__ __forceinline__ int perm32(int rho) { const int n = rho >> 4, i = rho & 15; return 8 * (i >> 2) + 4 * n + (i & 3); }

struct Unit { int pm, pn; };
struct Gemm { const bf16_t* A; const bf16_t* Bt; int M, N, K; };

struct StaticOrder {
    int nM, nN, nwg, G, c;
    __host__ __device__ void init(int M, int N, int G_, int c_) { nM = M / BM; nN = N / BM; nwg = nM * nN; G = G_; c = c_; }
    __host__ __device__ bool next(int i, Unit& u) const {
        const long L = (long)i * G + c; if (L >= nwg) return false;
        int wgid = (int)L; { const int q = nwg / NXCD, r = nwg % NXCD, xcd = wgid % NXCD, off = wgid / NXCD; wgid = (xcd < r ? xcd * (q + 1) : r * (q + 1) + (xcd - r) * q) + off; }
        const int nig = WGM * nN, gid = wgid / nig, fm = gid * WGM, gsz = (nM - fm) < WGM ? (nM - fm) : WGM;
        u.pm = fm + ((wgid % nig) % gsz); u.pn = (wgid % nig) / gsz; return true;
    }
    __device__ __forceinline__ void a_ready(const Unit&) const {}
    __device__ __forceinline__ void done(const Unit&) const {}
};

template <class Epi, class Sched, bool STAMP = false>
__device__ __forceinline__ void gemm_phase(PG8_LAS unsigned char* lds, const Gemm g, const Sched& S, const Epi& E, unsigned long long* stamps) {
    const int tid = TID(), wid = __builtin_amdgcn_readfirstlane(tid >> 6), lane = tid & 63, wr = wid >> 2, wc = wid & 3, fr = lane & 15, fq = lane >> 4;
    const int K = g.K, nt = K / BK;
    int ts_lo = 0, ts_hi = 0, nts = 0; const unsigned long long rt_entry = STAMP ? (unsigned long long)wall_clock64() : 0ull;
#define PG8_STAMP() do { if (STAMP && wid == 0 && nts < 64) { const unsigned long long _c = (unsigned long long)clock64(); \
        ts_lo = (lane == nts) ? (int)(unsigned)_c : ts_lo; ts_hi = (lane == nts) ? (int)(unsigned)(_c >> 32) : ts_hi; ++nts; } } while (0)
    PG8_STAMP();
    unsigned voffA[2], voffB[2];
#pragma unroll
    for (int i = 0; i < 2; ++i) { int R, C; stage_rc(tid * 16 + i * 8192, R, C); const int Rb = Epi::PERM ? ((R & ~31) + perm32(R & 31)) : R;
        voffA[i] = (unsigned)(R * K + C) * 2u; voffB[i] = (unsigned)(Rb * K + C) * 2u; }
    const size_t kstep = (size_t)(BK * 2);
    const size_t hstep = (size_t)HALF * K * 2;
    const size_t tstep = 2 * hstep;
    const unsigned ldsw = (unsigned)wid * 1024u;
    const int aoff = lds_byte(wr * 64 + fr, fq * 8), boff = lds_byte(wc * 32 + fr, fq * 8);
#define PG8_SA(b, h) (((b) * 2 + (h)) * HTB)
#define PG8_SB(b, h) ((4 + (b) * 2 + (h)) * HTB)
#define PG8_STAGE(bufoff, gbase, voff) do { _Pragma("unroll") for (int _i = 0; _i < 2; ++_i) \
        __builtin_amdgcn_global_load_lds((const unsigned*)((const char*)(gbase) + (voff)[_i]), (PG8_LAS unsigned*)(lds + (bufoff) + ldsw + _i * 8192), 16, 0, 0); } while (0)
#define PG8_LDA(dst, b, h) do { _Pragma("unroll") for (int m = 0; m < 4; ++m) _Pragma("unroll") for (int k = 0; k < 2; ++k) dst[m][k] = *(const PG8_LAS bf16x8*)(lds + PG8_SA(b, h) + aoff + m * 2048 + k * 1024); } while (0)
#define PG8_LDB(dst, b, h) do { _Pragma("unroll") for (int n = 0; n < 2; ++n) _Pragma("unroll") for (int k = 0; k < 2; ++k) dst[n][k] = *(const PG8_LAS bf16x8*)(lds + PG8_SB(b, h) + boff + n * 2048 + k * 1024); } while (0)
#define PG8_MMA(ai, bj, At, Bt) do { __builtin_amdgcn_s_setprio(1); _Pragma("unroll") for (int m = 0; m < 4; ++m) _Pragma("unroll") for (int n = 0; n < 2; ++n) _Pragma("unroll") for (int k = 0; k < 2; ++k) \
        acc[ai][bj][m][n] = __builtin_amdgcn_mfma_f32_16x16x32_bf16(Bt[n][k], At[m][k], acc[ai][bj][m][n], 0, 0, 0); __builtin_amdgcn_s_setprio(0); } while (0)
#define PG8_WAIT_V(n) asm volatile("s_waitcnt vmcnt(" #n ")" ::: "memory")
#define PG8_WAIT_L(n) asm volatile("s_waitcnt lgkmcnt(" #n ")" ::: "memory")
#define PG8_BAR __builtin_amdgcn_s_barrier()
#define PG8_SCHED __builtin_amdgcn_sched_barrier(0)
    Unit cur, nxt; int ui = 0;
    if (!S.next(0, cur)) return;
    f32x4 acc[2][2][4][2];
#pragma unroll
    for (int a = 0; a < 2; ++a)
#pragma unroll
        for (int b = 0; b < 2; ++b)
#pragma unroll
            for (int m = 0; m < 4; ++m)
#pragma unroll
                for (int n = 0; n < 2; ++n) acc[a][b][m][n] = (f32x4){0.f, 0.f, 0.f, 0.f};
    bf16x8 At[4][2], B0[2][2], B1[2][2];
    const char* cA = (const char*)g.A + (size_t)cur.pm * tstep; const char* cB = (const char*)g.Bt + (size_t)cur.pn * tstep;
    S.a_ready(cur);
    PG8_STAGE(PG8_SB(0, 0), cB, voffB); PG8_STAGE(PG8_SA(0, 0), cA, voffA); PG8_STAGE(PG8_SB(0, 1), cB + hstep, voffB); PG8_STAGE(PG8_SA(0, 1), cA + hstep, voffA);
    if (wr == 1) PG8_BAR;
    PG8_WAIT_V(4); PG8_BAR;
    PG8_STAGE(PG8_SB(1, 0), cB + kstep, voffB); PG8_STAGE(PG8_SA(1, 0), cA + kstep, voffA); PG8_STAGE(PG8_SB(1, 1), cB + hstep + kstep, voffB);
    PG8_WAIT_V(6); PG8_BAR;
    PG8_STAMP();
    for (;;) {
        const bool has_next = S.next(ui + 1, nxt);
        const char* nA = has_next ? (const char*)g.A + (size_t)nxt.pm * tstep : cA; const char* nB = has_next ? (const char*)g.Bt + (size_t)nxt.pn * tstep : cB;
        for (int t = 0; t < nt; t += 2) {
            const bool last = (t == nt - 2);
            const char* a1 = cA + (size_t)(t + 1) * kstep;
            const char* a2 = last ? nA : cA + (size_t)(t + 2) * kstep; const char* b2 = last ? nB : cB + (size_t)(t + 2) * kstep;
            const char* a3 = a2 + kstep; const char* b3 = b2 + kstep;
            if (last && has_next) S.a_ready(nxt);
            PG8_LDB(B0, 0, 0); PG8_SCHED; PG8_LDA(At, 0, 0); PG8_STAGE(PG8_SA(1, 1), a1 + hstep, voffA);
            PG8_WAIT_L(8); PG8_BAR; PG8_WAIT_L(0); PG8_MMA(0, 0, At, B0); PG8_BAR; PG8_SCHED;
            PG8_LDB(B1, 0, 1); PG8_STAGE(PG8_SB(0, 0), b2, voffB);
            PG8_BAR; PG8_WAIT_L(0); PG8_MMA(0, 1, At, B1); PG8_BAR;
            PG8_LDA(At, 0, 1); PG8_STAGE(PG8_SA(0, 0), a2, voffA);
            PG8_BAR; PG8_WAIT_L(0); PG8_MMA(1, 0, At, B0); PG8_BAR; PG8_SCHED;
            PG8_STAGE(PG8_SB(0, 1), b2 + hstep, voffB);
            PG8_WAIT_V(6); PG8_BAR; PG8_MMA(1, 1, At, B1); PG8_BAR;
            PG8_LDB(B0, 1, 0); PG8_SCHED; PG8_LDA(At, 1, 0); PG8_STAGE(PG8_SA(0, 1), a2 + hstep, voffA);
            PG8_WAIT_L(8); PG8_BAR; PG8_WAIT_L(0); PG8_MMA(0, 0, At, B0); PG8_BAR; PG8_SCHED;
            PG8_LDB(B1, 1, 1); PG8_STAGE(PG8_SB(1, 0), b3, voffB);
            PG8_BAR; PG8_WAIT_L(0); PG8_MMA(0, 1, At, B1); PG8_BAR;
            PG8_LDA(At, 1, 1); PG8_STAGE(PG8_SA(1, 0), a3, voffA);
            PG8_BAR; PG8_WAIT_L(0); PG8_MMA(1, 0, At, B0); PG8_BAR; PG8_SCHED;
            PG8_STAGE(PG8_SB(1, 1), b3 + hstep, voffB);
            PG8_WAIT_V(6); PG8_BAR; PG8_MMA(1, 1, At, B1); PG8_BAR;
        }
        PG8_STAMP();
        if constexpr (!Epi::AFTER_DRAIN) { E(acc, cur, wr, wc, fr, fq); S.done(cur); }
        PG8_STAMP();
        if (!has_next) break;
#pragma unroll
        for (int a = 0; a < 2; ++a)
#pragma unroll
            for (int b = 0; b < 2; ++b)
#pragma unroll
                for (int m = 0; m < 4; ++m)
#pragma unroll
                    for (int n = 0; n < 2; ++n) acc[a][b][m][n] = (f32x4){0.f, 0.f, 0.f, 0.f};
        cur = nxt; cA = nA; cB = nB; ++ui;
    }
    PG8_WAIT_V(0);
    if (wr == 0) PG8_BAR;
    PG8_BAR;
    if constexpr (Epi::AFTER_DRAIN) { E.fused(acc, cur, wr, wc, fr, fq, lds, wid, lane); S.done(cur); }
    PG8_STAMP();
    if (STAMP && wid == 0) { stamps[lane] = lane < nts ? (((unsigned long long)(unsigned)ts_hi << 32) | (unsigned)ts_lo) : 0ull;
        if (lane == 62) stamps[62] = rt_entry; if (lane == 63) stamps[63] = (unsigned long long)wall_clock64(); }
#undef PG8_STAMP
#undef PG8_SA
#undef PG8_SB
#undef PG8_STAGE
#undef PG8_LDA
#undef PG8_LDB
#undef PG8_MMA
#undef PG8_WAIT_V
#undef PG8_WAIT_L
#undef PG8_BAR
#undef PG8_SCHED
}
}


__device__ __forceinline__ u16 f2bf(float f) {
  unsigned u = __float_as_uint(f);
  u += 0x7fffu + ((u >> 16) & 1u);
  return (u16)(u >> 16);
}
__device__ __forceinline__ float bf2f(u16 h) { return __uint_as_float(((unsigned)h) << 16); }
__device__ __forceinline__ unsigned pack2(float a, float b) { return (unsigned)f2bf(a) | ((unsigned)f2bf(b) << 16); }
__device__ __forceinline__ float silu_f(float x) { return x / (1.f + __expf(-x)); }
__device__ __forceinline__ float sigm(float x) { return 1.f / (1.f + __expf(-x)); }
__device__ __forceinline__ float wave_sum(float v) {
#pragma unroll
  for (int o = 32; o; o >>= 1) v += __shfl_xor(v, o);
  return v;
}
__device__ __forceinline__ int Lof(int slab) { return slab == 0 ? 2048 : 8192; }
__device__ __forceinline__ int gb_of(int slab, int r) { return slab == 0 ? (r >> 11) : (8 + (slab - 1) * 2 + (r >> 13)); }

typedef short v4s __attribute__((ext_vector_type(4)));
#define LDS_AS __attribute__((address_space(3)))
template <int R, bool KC>
__device__ __forceinline__ uint4 ld_chunk(const u16* __restrict__ base, long ld, int k0, int c) {
  if (KC) {
    const int r = c >> 3, kc = c & 7;
    return *(const uint4*)(base + (long)r * ld + k0 + kc * 8);
  } else {
    const int k = c / (R / 8), mc = c % (R / 8);
    return *(const uint4*)(base + (long)(k0 + k) * ld + mc * 8);
  }
}
template <int R, bool KC>
__device__ __forceinline__ void st_chunk(u16* s, uint4 v, int c) {
  if (KC) {
    const int r = c >> 3, kc = c & 7;
    *(uint4*)(s + r * 72 + kc * 8) = v;
  } else {
    const int k = c / (R / 8), mc = c % (R / 8);
    *(uint4*)(s + k * (R + 8) + mc * 8) = v;
  }
}
template <int R, bool KC>
__device__ __forceinline__ bf16x8 ld_frag(const u16* s, int x0, int ks, int fr, int fq) {
  if (KC) {
    return *(const bf16x8*)(s + (x0 + fr) * 72 + ks * 32 + fq * 8);
  } else {
    const int q4 = fr >> 2, p4 = fr & 3;
    const u16* p = s + (ks * 32 + 8 * fq + q4) * (R + 8) + x0 + 4 * p4;
    v4s lo = __builtin_amdgcn_ds_read_tr16_b64_v4i16((LDS_AS v4s*)p);
    v4s hi = __builtin_amdgcn_ds_read_tr16_b64_v4i16((LDS_AS v4s*)(p + 4 * (R + 8)));
    bf16x8 r;
    r[0] = lo[0]; r[1] = lo[1]; r[2] = lo[2]; r[3] = lo[3]; r[4] = hi[0]; r[5] = hi[1]; r[6] = hi[2]; r[7] = hi[3];
    return r;
  }
}

template <int TM, int TN, bool AKC, bool BKC, bool TR>
__device__ __forceinline__ void gemm_acc(f32x4 (&acc)[TM / 32][TN / 64], const u16* __restrict__ A, long lda,
                                         const u16* __restrict__ B, long ldb, int K, u16* sm) {
  u16* As = sm;
  u16* Bs = sm + 9216;
  const int tid = TID(), lane = tid & 63, wid = tid >> 6;
  const int wm = wid >> 2, wn = wid & 3, fr = lane & 15, fq = lane >> 4;
  constexpr int MI = TM / 32, NI = TN / 64;
  uint4 ra0 = ld_chunk<TM, AKC>(A, lda, 0, tid), rb0 = ld_chunk<TN, BKC>(B, ldb, 0, tid);
  uint4 ra1 = ra0, rb1 = rb0;
  if (TM == 128) ra1 = ld_chunk<TM, AKC>(A, lda, 0, tid + NT);
  if (TN == 128) rb1 = ld_chunk<TN, BKC>(B, ldb, 0, tid + NT);
  for (int k0 = 0; k0 < K; k0 += 64) {
    __syncthreads();
    st_chunk<TM, AKC>(As, ra0, tid);
    if (TM == 128) st_chunk<TM, AKC>(As, ra1, tid + NT);
    st_chunk<TN, BKC>(Bs, rb0, tid);
    if (TN == 128) st_chunk<TN, BKC>(Bs, rb1, tid + NT);
    __syncthreads();
    if (k0 + 64 < K) {
      ra0 = ld_chunk<TM, AKC>(A, lda, k0 + 64, tid);
      if (TM == 128) ra1 = ld_chunk<TM, AKC>(A, lda, k0 + 64, tid + NT);
      rb0 = ld_chunk<TN, BKC>(B, ldb, k0 + 64, tid);
      if (TN == 128) rb1 = ld_chunk<TN, BKC>(B, ldb, k0 + 64, tid + NT);
    }
#pragma unroll
    for (int ks = 0; ks < 2; ++ks) {
      bf16x8 af[MI], bfr[NI];
#pragma unroll
      for (int mi = 0; mi < MI; ++mi) af[mi] = ld_frag<TM, AKC>(As, wm * (TM / 2) + mi * 16, ks, fr, fq);
#pragma unroll
      for (int ni = 0; ni < NI; ++ni) bfr[ni] = ld_frag<TN, BKC>(Bs, wn * (TN / 4) + ni * 16, ks, fr, fq);
#pragma unroll
      for (int mi = 0; mi < MI; ++mi)
#pragma unroll
        for (int ni = 0; ni < NI; ++ni)
          acc[mi][ni] = TR ? __builtin_amdgcn_mfma_f32_16x16x32_bf16(bfr[ni], af[mi], acc[mi][ni], 0, 0, 0)
                           : __builtin_amdgcn_mfma_f32_16x16x32_bf16(af[mi], bfr[ni], acc[mi][ni], 0, 0, 0);
    }
  }
  __syncthreads();
}

template <int TM, int TN, bool TR, class F>
__device__ __forceinline__ void epi_each(f32x4 (&acc)[TM / 32][TN / 64], F f) {
  const int tid = TID(), lane = tid & 63, wid = tid >> 6;
  const int wm = wid >> 2, wn = wid & 3, fr = lane & 15, fq = lane >> 4;
#pragma unroll
  for (int mi = 0; mi < TM / 32; ++mi)
#pragma unroll
    for (int ni = 0; ni < TN / 64; ++ni) {
      const int r0 = wm * (TM / 2) + mi * 16, c0 = wn * (TN / 4) + ni * 16;
      if (TR) f(r0 + fr, c0 + fq * 4, acc[mi][ni]);
      else f(r0 + fq * 4, c0 + fr, acc[mi][ni]);
    }
}

struct EpiStoreBf16 {
  static constexpr bool PERM = false, AFTER_DRAIN = false;
  u16* O; int ldc;
  __device__ __forceinline__ void operator()(const f32x4 (&acc)[2][2][4][2], const pg8::Unit& u, int wr, int wc, int fr, int fq) const {
    const int row0 = u.pm * 256 + wr * 64 + fr, col0 = u.pn * 256 + wc * 32 + 4 * fq;
#pragma unroll
    for (int ai = 0; ai < 2; ++ai)
#pragma unroll
      for (int m = 0; m < 4; ++m) {
        u16* rowp = O + (size_t)(row0 + ai * 128 + m * 16) * ldc + col0;
#pragma unroll
        for (int bj = 0; bj < 2; ++bj)
#pragma unroll
          for (int n = 0; n < 2; ++n) {
            const f32x4 v = acc[ai][bj][m][n];
            *(uint2*)(rowp + bj * 128 + n * 16) = make_uint2(pack2(v[0], v[1]), pack2(v[2], v[3]));
          }
      }
  }
};
struct EpiResid {
  static constexpr bool PERM = false, AFTER_DRAIN = false;
  float* X; const float* mod; int goff; int slab;
  __device__ __forceinline__ void operator()(const f32x4 (&acc)[2][2][4][2], const pg8::Unit& u, int wr, int wc, int fr, int fq) const {
    const int row0 = u.pm * 256 + wr * 64 + fr, col0 = u.pn * 256 + wc * 32 + 4 * fq;
#pragma unroll
    for (int ai = 0; ai < 2; ++ai)
#pragma unroll
      for (int m = 0; m < 4; ++m) {
        const int r = row0 + ai * 128 + m * 16;
        const float* g = mod + (size_t)gb_of(slab, r) * 6144 + goff + col0;
        float* xp = X + (size_t)r * D + col0;
#pragma unroll
        for (int bj = 0; bj < 2; ++bj)
#pragma unroll
          for (int n = 0; n < 2; ++n) {
            const f32x4 gv = *(const f32x4*)(g + bj * 128 + n * 16);
            f32x4 xv = *(const f32x4*)(xp + bj * 128 + n * 16);
            xv += gv * acc[ai][bj][m][n];
            *(f32x4*)(xp + bj * 128 + n * 16) = xv;
          }
      }
  }
};
struct EpiFfnVal {
  static constexpr bool PERM = false, AFTER_DRAIN = false;
  const u16* G; u16* ACT; const float* cw; const float* cb; int L;
  __device__ __forceinline__ void operator()(const f32x4 (&acc)[2][2][4][2], const pg8::Unit& u, int wr, int wc, int fr, int fq) const {
    const int row0 = u.pm * 256 + wr * 64 + fr, col0 = u.pn * 256 + wc * 32 + 4 * fq;
#pragma unroll
    for (int bj = 0; bj < 2; ++bj)
#pragma unroll
      for (int n = 0; n < 2; ++n) {
        const int c = col0 + bj * 128 + n * 16;
        const f32x4 w0 = *(const f32x4*)(cw + c), w1 = *(const f32x4*)(cw + DFF + c), w2 = *(const f32x4*)(cw + 2 * DFF + c), bb = *(const f32x4*)(cb + c);
#pragma unroll
        for (int ai = 0; ai < 2; ++ai)
#pragma unroll
          for (int m = 0; m < 4; ++m) {
            const int r = row0 + ai * 128 + m * 16;
            const int pos = r & (L - 1);
            const u16* gp = G + (size_t)r * DFF + c;
            const uint2 g1 = *(const uint2*)gp;
            uint2 g0 = make_uint2(0, 0), g2 = make_uint2(0, 0);
            if (pos > 0) g0 = *(const uint2*)(gp - DFF);
            if (pos < L - 1) g2 = *(const uint2*)(gp + DFF);
            f32x4 a;
            a[0] = bf2f((u16)(g0.x & 0xffff)) * w0[0] + bf2f((u16)(g1.x & 0xffff)) * w1[0] + bf2f((u16)(g2.x & 0xffff)) * w2[0] + bb[0];
            a[1] = bf2f((u16)(g0.x >> 16)) * w0[1] + bf2f((u16)(g1.x >> 16)) * w1[1] + bf2f((u16)(g2.x >> 16)) * w2[1] + bb[1];
            a[2] = bf2f((u16)(g0.y & 0xffff)) * w0[2] + bf2f((u16)(g1.y & 0xffff)) * w1[2] + bf2f((u16)(g2.y & 0xffff)) * w2[2] + bb[2];
            a[3] = bf2f((u16)(g0.y >> 16)) * w0[3] + bf2f((u16)(g1.y >> 16)) * w1[3] + bf2f((u16)(g2.y >> 16)) * w2[3] + bb[3];
            const f32x4 v = acc[ai][bj][m][n];
            *(uint2*)(ACT + (size_t)r * DFF + c) = make_uint2(pack2(silu_f(a[0]) * v[0], silu_f(a[1]) * v[1]), pack2(silu_f(a[2]) * v[2], silu_f(a[3]) * v[3]));
          }
      }
  }
};
template <class Epi>
__device__ __forceinline__ void run_gemm(const u16* A, const u16* Bt, int N, int K, const Epi& E) {
  pg8::Gemm g; g.A = A; g.Bt = Bt; g.M = SLAB; g.N = N; g.K = K;
  pg8::StaticOrder S; S.init(SLAB, N, gridDim.x, BID());
  __syncthreads();
  pg8::gemm_phase<Epi, pg8::StaticOrder, false>((PG8_LAS unsigned char*)smem, g, S, E, nullptr);
  __syncthreads();
}

template <int N>
__device__ __forceinline__ void fft_dif_t(float2* x, const float2* __restrict__ tw) {
  const int tid = TID();
  constexpr int IT = N / 2 / NT;
#pragma unroll 1
  for (int s = N >> 1; s >= 1; s >>= 1) {
    const int tws = 8192 / s;
    const float2 w0 = tw[(tid & (s - 1)) * tws];
#pragma unroll
    for (int it = 0; it < IT; ++it) {
      const int i = tid + it * NT;
      const int j = i & (s - 1);
      const int p = ((i - j) << 1) + j;
      float2 w = w0;
      if (s >= 1024) {
        const float2 wu = tw[((it * NT) & (s - 1)) * tws];
        w = make_float2(w0.x * wu.x - w0.y * wu.y, w0.x * wu.y + w0.y * wu.x);
      }
      float2 a = x[p], b = x[p + s];
      x[p] = make_float2(a.x + b.x, a.y + b.y);
      float dx = a.x - b.x, dy = a.y - b.y;
      x[p + s] = make_float2(dx * w.x - dy * w.y, dx * w.y + dy * w.x);
    }
    __syncthreads();
  }
}
template <int N>
__device__ __forceinline__ void ifft_dit_t(float2* x, const float2* __restrict__ tw) {
  const int tid = TID();
  constexpr int IT = N / 2 / NT;
#pragma unroll 1
  for (int s = 1; s < N; s <<= 1) {
    const int tws = 8192 / s;
    const float2 w0 = tw[(tid & (s - 1)) * tws];
#pragma unroll
    for (int it = 0; it < IT; ++it) {
      const int i = tid + it * NT;
      const int j = i & (s - 1);
      const int p = ((i - j) << 1) + j;
      float2 w = w0;
      if (s >= 1024) {
        const float2 wu = tw[((it * NT) & (s - 1)) * tws];
        w = make_float2(w0.x * wu.x - w0.y * wu.y, w0.x * wu.y + w0.y * wu.x);
      }
      float2 a = x[p], b = x[p + s];
      float bx = b.x * w.x + b.y * w.y, by = b.y * w.x - b.x * w.y;
      x[p] = make_float2(a.x + bx, a.y + by);
      x[p + s] = make_float2(a.x - bx, a.y - by);
    }
    __syncthreads();
  }
}
__device__ __forceinline__ void fft_dif(float2* x, int N, const float2* __restrict__ tw) {
  if (N == 16384) fft_dif_t<16384>(x, tw); else fft_dif_t<4096>(x, tw);
}
__device__ __forceinline__ void ifft_dit(float2* x, int N, const float2* __restrict__ tw) {
  if (N == 16384) ifft_dit_t<16384>(x, tw); else ifft_dit_t<4096>(x, tw);
}

__device__ void transpose_w(const float* __restrict__ W, u16* __restrict__ Wt, int K, int N) {
  float* smf = (float*)smem;
  const int tk = K / 64, tn = N / 64, tid = TID();
  for (int item = BID(); item < tk * tn; item += gridDim.x) {
    const int k0 = (item / tn) * 64, n0 = (item % tn) * 64;
    __syncthreads();
    for (int i = tid; i < 4096; i += NT) {
      int kk = i >> 6, nn = i & 63;
      smf[kk * 65 + nn] = W[(long)(k0 + kk) * N + n0 + nn];
    }
    __syncthreads();
    for (int i = tid; i < 4096; i += NT) {
      int nn = i >> 6, kk = i & 63;
      Wt[(long)(n0 + nn) * K + k0 + kk] = f2bf(smf[kk * 65 + nn]);
    }
  }
  __syncthreads();
}

__device__ void phase_pre0(const Params& P) {
  const int tid = TID();
  const long gtid = (long)BID() * NT + tid, gsz = (long)gridDim.x * NT;
  {
    const float4* s0 = (const float4*)P.in[0];
    const float4* s1 = (const float4*)P.in[1];
    float4* o = (float4*)OUTP(P);
    const long n0 = (long)16384 * 1024 / 4, n1 = (long)65536 * 1024 / 4;
    for (long i = gtid; i < n0; i += gsz) o[i] = s0[i];
    for (long i = gtid; i < n1; i += gsz) o[n0 + i] = s1[i];
  }
  transpose_w(P.in[7], (u16*)(WS(P) + O_WHYIN), 1024, 3072);
  transpose_w(P.in[18], (u16*)(WS(P) + O_WHYOUT), 1024, 1024);
  transpose_w(P.in[19], (u16*)(WS(P) + O_WRETIN), 1024, 6144);
  transpose_w(P.in[21], (u16*)(WS(P) + O_WRETOUT), 2048, 1024);
  transpose_w(P.in[22], (u16*)(WS(P) + O_WSWAIN), 1024, 1536);
  transpose_w(P.in[26], (u16*)(WS(P) + O_WSWAOUT), 1024, 1024);
  transpose_w(P.in[27], (u16*)(WS(P) + O_WHGIN), 1024, 5120);
  transpose_w(P.in[30], (u16*)(WS(P) + O_WHGOUT), 1024, 1024);
  for (int l = 0; l < 4; ++l) {
    transpose_w(P.in[31] + (long)l * 1024 * DFF, (u16*)(WS(P) + O_WFG) + (long)l * DFF * 1024, 1024, DFF);
    transpose_w(P.in[32] + (long)l * 1024 * DFF, (u16*)(WS(P) + O_WFV) + (long)l * DFF * 1024, 1024, DFF);
    transpose_w(P.in[35] + (long)l * DFF * 1024, (u16*)(WS(P) + O_WFD) + (long)l * 1024 * DFF, DFF, 1024);
  }
  {
    float* cs = (float*)smem;
    float* modp = (float*)(WS(P) + O_MODP);
    for (int item = BID(); item < 4 * 8 * 12; item += gridDim.x) {
      const int nb = item % 12, ks = (item / 12) % 8, l = item / 96;
      __syncthreads();
      for (int i = tid; i < 2048; i += NT) {
        int b = i >> 7, k = i & 127;
        float c = (b < 8) ? P.in[2][b * 1024 + ks * 128 + k] : P.in[3][(b - 8) * 1024 + ks * 128 + k];
        cs[i] = c / (1.f + expf(-c));
      }
      __syncthreads();
      const int n = nb * 512 + tid;
      float a[16];
#pragma unroll
      for (int b = 0; b < 16; ++b) a[b] = 0.f;
      const float* w = P.in[4] + ((long)l * 1024 + ks * 128) * 6144 + n;
      for (int k = 0; k < 128; ++k) {
        float wv = w[(long)k * 6144];
#pragma unroll
        for (int b = 0; b < 16; ++b) a[b] += cs[b * 128 + k] * wv;
      }
#pragma unroll
      for (int b = 0; b < 16; ++b) modp[(((long)ks * 4 + l) * 16 + b) * 6144 + n] = a[b];
    }
    __syncthreads();
  }
  {
    float2* tw = (float2*)(WS(P) + O_TW);
    for (long i = gtid; i < 8192; i += gsz) {
      float s, c;
      sincospif((float)i * (1.f / 8192.f), &s, &c);
      tw[i] = make_float2(c, -s);
    }
    float2* rr = (float2*)(WS(P) + O_ROPER);
    for (long i = gtid; i < (long)8192 * 128; i += gsz) {
      int pos = (int)(i >> 7), d = (int)(i & 127);
      float inv = exp2f(-(float)d * (13.287712379549449f / 128.f));
      float s, c;
      sincosf((float)pos * inv, &s, &c);
      rr[i] = make_float2(c, s);
    }
    float2* rs = (float2*)(WS(P) + O_ROPES);
    for (long i = gtid; i < (long)8192 * 32; i += gsz) {
      int pos = (int)(i >> 5), d = (int)(i & 31);
      float inv = exp2f(-(float)d * (13.287712379549449f / 32.f));
      float s, c;
      sincosf((float)pos * inv, &s, &c);
      rs[i] = make_float2(c, s);
    }
  }
  {
    float* zf = (float*)smem;
    float* h1 = zf + 8 * 36;
    const float* w1 = P.in[10]; const float* b1 = P.in[11]; const float* w2 = P.in[12]; const float* b2 = P.in[13];
    const float* fr = P.in[15];
    const int tl = tid >> 6, j = tid & 63;
    for (int item = BID(); item < 1280; item += gridDim.x) {
      const int sel = item >= 1024;
      const int L = sel ? 2048 : 8192;
      const int t = (sel ? item - 1024 : item) * 8 + tl;
      float* hid = (float*)(WS(P) + (sel ? O_HIDP : O_HIDS));
      __syncthreads();
      if (j < 33) {
        float v;
        if (j == 0) v = (float)t / (float)(L - 1);
        else {
          int i = (j - 1) & 15;
          float band = 1e-4f + (float)i * ((15.f - 1e-4f) / 15.f);
          float ang = (6.283185307179586f / (float)L) * (float)t;
          float a = band * ang;
          v = (j <= 16) ? cosf(a) : -sinf(a);
        }
        zf[tl * 36 + j] = v;
      }
      __syncthreads();
      float s = b1[j];
#pragma unroll 3
      for (int i = 0; i < 33; ++i) s += zf[tl * 36 + i] * w1[i * 64 + j];
      h1[tl * 64 + j] = sinf(fr[j] * s);
      __syncthreads();
      float s2 = b2[j];
#pragma unroll 4
      for (int i = 0; i < 64; ++i) s2 += h1[tl * 64 + i] * w2[i * 64 + j];
      hid[(long)t * 64 + j] = sinf(fr[j] * s2);
    }
    __syncthreads();
  }
}

__device__ void phase_pre1(const Params& P) {
  __shared__ float w3s[128];
  __shared__ float red[8];
  const int tid = TID(), lane = tid & 63, wid = tid >> 6;
  const long gtid = (long)BID() * NT + tid, gsz = (long)gridDim.x * NT;
  {
    const float* modp = (const float*)(WS(P) + O_MODP);
    float* mod = (float*)(WS(P) + O_MOD);
    for (long i = gtid; i < (long)4 * 16 * 6144; i += gsz) {
      int n = (int)(i % 6144);
      int l = (int)(i / (16 * 6144));
      float s = P.in[5][l * 6144 + n];
      for (int ks = 0; ks < 8; ++ks) s += modp[(long)ks * 4 * 16 * 6144 + i];
      mod[i] = s;
    }
  }
  float2* buf = (float2*)smem;
  const float2* tw = (const float2*)(WS(P) + O_TW);
  for (int item = BID(); item < 2048; item += gridDim.x) {
    const int sel = item >> 10, c = item & 1023;
    const int L = sel ? 2048 : 8192, N = 2 * L;
    const float* hid = (const float*)(WS(P) + (sel ? O_HIDP : O_HIDS));
    float2* hs = (float2*)(WS(P) + (sel ? O_HSPP : O_HSPS)) + (long)c * N;
    __syncthreads();
    if (tid < 128) {
      int dirn = tid >> 6, j = tid & 63;
      w3s[tid] = P.in[14][(long)j * 2048 + dirn * 1024 + c];
    }
    __syncthreads();
    const float dec0 = fabsf(P.in[16][c]), dec1 = fabsf(P.in[16][1024 + c]);
    const float invLm1 = 1.f / (float)(L - 1);
    float asum = 0.f;
    for (int n = tid; n < N; n += NT) {
      float val = 0.f;
      if (n != L) {
        const int dirn = n < L ? 0 : 1;
        const int t = n < L ? n : N - n;
        const float4* hr = (const float4*)(hid + (long)t * 64);
        const float* w = w3s + dirn * 64;
        float s = 0.f;
#pragma unroll
        for (int q = 0; q < 16; ++q) {
          float4 h4 = hr[q];
          s += h4.x * w[4 * q] + h4.y * w[4 * q + 1] + h4.z * w[4 * q + 2] + h4.w * w[4 * q + 3];
        }
        float tl = (float)t * invLm1;
        val = s * expf(-tl * (dirn ? dec1 : dec0));
      }
      buf[n] = make_float2(val, 0.f);
      asum += fabsf(val);
    }
    asum = wave_sum(asum);
    if (lane == 0) red[wid] = asum;
    __syncthreads();
    float tot = 0.f;
#pragma unroll
    for (int w = 0; w < 8; ++w) tot += red[w];
    const float scale = 1.f / (tot * (float)N);
    fft_dif(buf, N, tw);
    for (int p = tid; p < N; p += NT) {
      float2 a = buf[p];
      hs[p] = make_float2(a.x * scale, a.y * scale);
    }
  }
  __syncthreads();
}

__device__ void phase_norm(const Params& P, int layer, int slab, int which) {
  const float* x = OUTP(P) + (long)slab * SLAB * D;
  u16* h = (u16*)(WS(P) + O_HBUF);
  const float* gain = P.in[6] + (layer * 2 + which) * D;
  const float* mod = (const float*)(WS(P) + O_MOD) + (long)layer * 16 * 6144;
  const int shoff = which ? 3 * D : 0, scoff = which ? 4 * D : D;
  const int tid = TID(), lane = tid & 63, wid = tid >> 6;
  for (int item = BID(); item < SLAB / 8; item += gridDim.x) {
    const int r = item * 8 + wid;
    const float* xr = x + (long)r * D;
    float4 v[4];
    float ss = 0.f;
#pragma unroll
    for (int i = 0; i < 4; ++i) {
      v[i] = *(const float4*)(xr + i * 256 + lane * 4);
      ss += v[i].x * v[i].x + v[i].y * v[i].y + v[i].z * v[i].z + v[i].w * v[i].w;
    }
    ss = wave_sum(ss);
    const float rstd = rsqrtf(ss * (1.f / 1024.f) + 1e-6f);
    const float* m = mod + (long)gb_of(slab, r) * 6144;
#pragma unroll
    for (int i = 0; i < 4; ++i) {
      const int col = i * 256 + lane * 4;
      float4 g = *(const float4*)(gain + col);
      float4 sc = *(const float4*)(m + scoff + col);
      float4 sh = *(const float4*)(m + shoff + col);
      float y0 = v[i].x * rstd * g.x * (1.f + sc.x) + sh.x;
      float y1 = v[i].y * rstd * g.y * (1.f + sc.y) + sh.y;
      float y2 = v[i].z * rstd * g.z * (1.f + sc.z) + sh.z;
      float y3 = v[i].w * rstd * g.w * (1.f + sc.w) + sh.w;
      uint2 o = make_uint2(pack2(y0, y1), pack2(y2, y3));
      *(uint2*)(h + (long)r * D + col) = o;
    }
  }
}

__device__ void phase_proj(const Params& P, size_t woff, int N) {
  EpiStoreBf16 E; E.O = (u16*)(WS(P) + O_PROJ); E.ldc = N;
  run_gemm((const u16*)(WS(P) + O_HBUF), (const u16*)(WS(P) + woff), N, D, E);
}
__device__ void phase_resid(const Params& P, int layer, int slab, const u16* A, int K, size_t woff, int goff) {
  EpiResid E; E.X = OUTP(P) + (long)slab * SLAB * D; E.mod = (const float*)(WS(P) + O_MOD) + (long)layer * 16 * 6144; E.goff = goff; E.slab = slab;
  run_gemm(A, (const u16*)(WS(P) + woff), D, K, E);
}

__device__ void phase_ffn_gate(const Params& P, int layer) {
  EpiStoreBf16 E; E.O = (u16*)(WS(P) + O_GBUF); E.ldc = DFF;
  run_gemm((const u16*)(WS(P) + O_HBUF), (const u16*)(WS(P) + O_WFG) + (long)layer * DFF * D, DFF, D, E);
}
__device__ void phase_ffn_val(const Params& P, int layer, int slab) {
  EpiFfnVal E; E.G = (const u16*)(WS(P) + O_GBUF); E.ACT = (u16*)(WS(P) + O_ACT);
  E.cw = P.in[33] + (long)layer * 3 * DFF; E.cb = P.in[34] + (long)layer * DFF; E.L = Lof(slab);
  run_gemm((const u16*)(WS(P) + O_HBUF), (const u16*)(WS(P) + O_WFV) + (long)layer * DFF * D, DFF, D, E);
}

__device__ void phase_hy_conv(const Params& P, int slab) {
  const int L = Lof(slab), nseq = SLAB / L, tid = TID();
  const u16* z = (const u16*)(WS(P) + O_PROJ);
  float* uT = (float*)(WS(P) + O_UT);
  u16* x0c = (u16*)(WS(P) + O_X0C);
  const float* cw = P.in[8];
  const float* cb = P.in[9];
  float* tile = (float*)smem;
  const int ntt = L / 64;
  const int nitems = nseq * ntt * 16;
  for (int item = BID(); item < nitems; item += gridDim.x) {
    const int ct = item % 16, tt = (item / 16) % ntt, seq = item / (16 * ntt);
    __syncthreads();
    for (int i = tid; i < 4096; i += NT) {
      const int tl = i >> 6, cl = i & 63;
      const int t = tt * 64 + tl, c = ct * 64 + cl;
      const long row = (long)seq * L + t;
      float val[3];
#pragma unroll
      for (int q = 0; q < 3; ++q) {
        const int col = q * 1024 + c;
        float a = bf2f(z[row * 3072 + col]) * cw[3072 + col] + cb[col];
        if (t > 0) a += bf2f(z[(row - 1) * 3072 + col]) * cw[col];
        if (t < L - 1) a += bf2f(z[(row + 1) * 3072 + col]) * cw[2 * 3072 + col];
        val[q] = a;
      }
      x0c[row * 1024 + c] = f2bf(val[0]);
      tile[tl * 65 + cl] = val[1] * val[2];
    }
    __syncthreads();
    for (int i = tid; i < 4096; i += NT) {
      const int cl = i >> 6, tl = i & 63;
      uT[((long)seq * 1024 + ct * 64 + cl) * L + tt * 64 + tl] = tile[tl * 65 + cl];
    }
  }
  __syncthreads();
}

__device__ void phase_hy_fft(const Params& P, int slab) {
  const int L = Lof(slab), N = 2 * L, nseq = SLAB / L, tid = TID();
  float* uT = (float*)(WS(P) + O_UT);
  const float2* hsb = (const float2*)(WS(P) + (slab == 0 ? O_HSPP : O_HSPS));
  const float2* tw = (const float2*)(WS(P) + O_TW);
  const float* skip = P.in[17];
  float2* buf = (float2*)smem;
  const int nitems = (nseq / 2) * 1024;
  for (int item = BID(); item < nitems; item += gridDim.x) {
    const int pr = item >> 10, c = item & 1023;
    float* u0 = uT + ((long)(pr * 2) * 1024 + c) * L;
    float* u1 = u0 + (long)1024 * L;
    __syncthreads();
    for (int t = tid; t < L; t += NT) {
      buf[t] = make_float2(u0[t], u1[t]);
      buf[t + L] = make_float2(0.f, 0.f);
    }
    __syncthreads();
    fft_dif(buf, N, tw);
    const float2* h = hsb + (long)c * N;
    for (int p = tid; p < N; p += NT) {
      float2 a = buf[p], b = h[p];
      buf[p] = make_float2(a.x * b.x - a.y * b.y, a.x * b.y + a.y * b.x);
    }
    __syncthreads();
    ifft_dit(buf, N, tw);
    const float sk = skip[c];
    for (int t = tid; t < L; t += NT) {
      float2 y = buf[t];
      u0[t] = y.x + u0[t] * sk;
      u1[t] = y.y + u1[t] * sk;
    }
  }
  __syncthreads();
}

__device__ void phase_hy_tr(const Params& P, int slab) {
  const int L = Lof(slab), nseq = SLAB / L, tid = TID();
  const float* yT = (const float*)(WS(P) + O_UT);
  const u16* x0c = (const u16*)(WS(P) + O_X0C);
  u16* a2 = (u16*)(WS(P) + O_A2);
  float* tile = (float*)smem;
  const int ntt = L / 64;
  const int nitems = nseq * ntt * 16;
  for (int item = BID(); item < nitems; item += gridDim.x) {
    const int ct = item % 16, tt = (item / 16) % ntt, seq = item / (16 * ntt);
    __syncthreads();
    for (int i = tid; i < 4096; i += NT) {
      const int cl = i >> 6, tl = i & 63;
      tile[cl * 65 + tl] = yT[((long)seq * 1024 + ct * 64 + cl) * L + tt * 64 + tl];
    }
    __syncthreads();
    for (int i = tid; i < 4096; i += NT) {
      const int tl = i >> 6, cl = i & 63;
      const long row = (long)seq * L + tt * 64 + tl;
      const int c = ct * 64 + cl;
      a2[row * 1024 + c] = f2bf(tile[cl * 65 + tl] * bf2f(x0c[row * 1024 + c]));
    }
  }
  __syncthreads();
}

struct Rec {
  int H, DK, DV, C;
  int ldv, voff, goff;
};
__device__ __forceinline__ Rec rec_of(int kind) {
  Rec r;
  if (kind == 1) { r.H = 4; r.DK = 256; r.DV = 512; r.C = 128; r.ldv = 6144; r.voff = 2048; r.goff = 4096; }
  else { r.H = 8; r.DK = 128; r.DV = 128; r.C = 64; r.ldv = 5120; r.voff = 1024; r.goff = 4096; }
  return r;
}

__device__ void phase_ret_prep(const Params& P, int slab) {
  const int L = Lof(slab);
  const u16* pj = (const u16*)(WS(P) + O_PROJ);
  u16* qdf = (u16*)(WS(P) + O_QDF); u16* qdb = (u16*)(WS(P) + O_QDB);
  u16* kif = (u16*)(WS(P) + O_KIF); u16* kib = (u16*)(WS(P) + O_KIB);
  u16* kef = (u16*)(WS(P) + O_KEF); u16* keb = (u16*)(WS(P) + O_KEB);
  float* dlf = (float*)(WS(P) + O_DLF); float* dlb = (float*)(WS(P) + O_DLB);
  const float2* rope = (const float2*)(WS(P) + O_ROPER);
  const long gtid = (long)BID() * NT + TID(), gsz = (long)gridDim.x * NT;
  for (long idx = gtid; idx < (long)SLAB * 512; idx += gsz) {
    const int d = (int)(idx & 127), h = (int)((idx >> 7) & 3), t = (int)(idx >> 9);
    const int pos = t & (L - 1), r = t & 127;
    const float lgf = -expf(P.in[20][h]), lgb = -expf(P.in[20][4 + h]);
    const u16* row = pj + (long)t * 6144;
    const float q1 = bf2f(row[h * 256 + d]), q2 = bf2f(row[h * 256 + d + 128]);
    const float k1 = bf2f(row[1024 + h * 256 + d]), k2 = bf2f(row[1024 + h * 256 + d + 128]);
    const float2 cs = rope[(long)pos * 128 + d];
    const float qa = q1 * cs.x - q2 * cs.y, qb = q1 * cs.y + q2 * cs.x;
    const float ka = (k1 * cs.x - k2 * cs.y) * 0.0625f, kb = (k1 * cs.y + k2 * cs.x) * 0.0625f;
    const float bf = (float)(r + 1) * lgf, bb = (float)(128 - r) * lgb;
    const float ef = expf(bf), eif = expf(-bf), eef = expf((float)(127 - r) * lgf);
    const float eb = expf(bb), eib = expf(-bb), eeb = expf((float)r * lgb);
    const long o1 = (long)t * 1024 + h * 256 + d, o2 = o1 + 128;
    qdf[o1] = f2bf(qa * ef); qdf[o2] = f2bf(qb * ef);
    qdb[o1] = f2bf(qa * eb); qdb[o2] = f2bf(qb * eb);
    kif[o1] = f2bf(ka * eif); kif[o2] = f2bf(kb * eif);
    kib[o1] = f2bf(ka * eib); kib[o2] = f2bf(kb * eib);
    kef[o1] = f2bf(ka * eef); kef[o2] = f2bf(kb * eef);
    keb[o1] = f2bf(ka * eeb); keb[o2] = f2bf(kb * eeb);
    if (r == 0) {
      const long cgi = (long)(t >> 7) * 1024 + h * 256 + d;
      const float df = expf(128.f * lgf), db = expf(128.f * lgb);
      dlf[cgi] = df; dlf[cgi + 128] = df;
      dlb[cgi] = db; dlb[cgi + 128] = db;
    }
  }
}

__device__ void phase_hg_prep(const Params& P) {
  const u16* pj = (const u16*)(WS(P) + O_PROJ);
  u16* qdf = (u16*)(WS(P) + O_QDF); u16* qdb = (u16*)(WS(P) + O_QDB);
  u16* kif = (u16*)(WS(P) + O_KIF); u16* kib = (u16*)(WS(P) + O_KIB);
  u16* kef = (u16*)(WS(P) + O_KEF); u16* keb = (u16*)(WS(P) + O_KEB);
  float* dlf = (float*)(WS(P) + O_DLF); float* dlb = (float*)(WS(P) + O_DLB);
  const float* lbt = P.in[28];
  float* totF = (float*)smem;
  float* totB = totF + 512;
  const int tid = TID(), lane = tid & 63, rg = tid >> 6;
  for (int item = BID(); item < 4096; item += gridDim.x) {
    const int cgi = item >> 4, ch = (item & 15) * 64 + lane;
    float lb0, lb1;
    {
      float a0 = lbt[0 * 1024 + ch], a1 = lbt[1 * 1024 + ch], a2 = lbt[2 * 1024 + ch], a3 = lbt[3 * 1024 + ch];
      float m = fmaxf(fmaxf(a0, a1), fmaxf(a2, a3));
      float e0 = expf(a0 - m), e1 = expf(a1 - m), e2 = expf(a2 - m), e3 = expf(a3 - m);
      lb0 = (e0 + e1 + e2) / (e0 + e1 + e2 + e3);
      a0 = lbt[4 * 1024 + ch]; a1 = lbt[5 * 1024 + ch]; a2 = lbt[6 * 1024 + ch]; a3 = lbt[7 * 1024 + ch];
      m = fmaxf(fmaxf(a0, a1), fmaxf(a2, a3));
      e0 = expf(a0 - m); e1 = expf(a1 - m); e2 = expf(a2 - m); e3 = expf(a3 - m);
      lb1 = (e0 + e1 + e2) / (e0 + e1 + e2 + e3);
    }
    const long t0 = (long)cgi * 64 + rg * 8;
    float xq[8], xf[8], xb[8];
#pragma unroll
    for (int i = 0; i < 8; ++i) {
      const u16* row = pj + (t0 + i) * 5120;
      xq[i] = bf2f(row[ch]); xf[i] = bf2f(row[2048 + ch]); xb[i] = bf2f(row[3072 + ch]);
    }
    float pf[8], sb[8];
    float accf = 0.f;
#pragma unroll
    for (int i = 0; i < 8; ++i) { accf += logf(lb0 + (1.f - lb0) * sigm(xf[i])); pf[i] = accf; }
    float accb = 0.f;
#pragma unroll
    for (int i = 7; i >= 0; --i) { accb += logf(lb1 + (1.f - lb1) * sigm(xb[i])); sb[i] = accb; }
    __syncthreads();
    totF[rg * 64 + lane] = accf;
    totB[rg * 64 + lane] = accb;
    __syncthreads();
    float offF = 0.f, offB = 0.f, totf = 0.f, totb = 0.f;
#pragma unroll
    for (int g = 0; g < 8; ++g) {
      const float f = totF[g * 64 + lane], bq = totB[g * 64 + lane];
      totf += f; totb += bq;
      if (g < rg) offF += f;
      if (g > rg) offB += bq;
    }
#pragma unroll
    for (int i = 0; i < 8; ++i) {
      const float q = silu_f(xq[i]);
      const float bf = offF + pf[i], bb = offB + sb[i];
      const float kf = (1.f - lb0) * sigm(-xf[i]), kb = (1.f - lb1) * sigm(-xb[i]);
      const long o = (t0 + i) * 1024 + ch;
      qdf[o] = f2bf(q * expf(bf));
      kif[o] = f2bf(kf * expf(-bf));
      kef[o] = f2bf(kf * expf(totf - bf));
      qdb[o] = f2bf(q * expf(bb));
      kib[o] = f2bf(kb * expf(-bb));
      keb[o] = f2bf(kb * expf(totb - bb));
    }
    if (rg == 0) {
      dlf[(long)cgi * 1024 + ch] = expf(totf);
      dlb[(long)cgi * 1024 + ch] = expf(totb);
    }
  }
  __syncthreads();
}

template <int C>
__device__ __forceinline__ void rec_scores_item(const Params& P, const Rec& R, int cgi, int h) {
  const u16* qdf = (const u16*)(WS(P) + O_QDF); const u16* qdb = (const u16*)(WS(P) + O_QDB);
  const u16* kif = (const u16*)(WS(P) + O_KIF); const u16* kib = (const u16*)(WS(P) + O_KIB);
  u16* sc = (u16*)(WS(P) + O_SC) + ((long)cgi * R.H + h) * C * C;
  const long off = (long)cgi * C * 1024 + h * R.DK;
  f32x4 af[C / 32][C / 64] = {}, ab[C / 32][C / 64] = {};
  gemm_acc<C, C, true, true, true>(af, qdf + off, 1024, kif + off, 1024, R.DK, (u16*)smem);
  gemm_acc<C, C, true, true, true>(ab, qdb + off, 1024, kib + off, 1024, R.DK, (u16*)smem);
  const int tid = TID(), lane = tid & 63, wid = tid >> 6;
  const int wm = wid >> 2, wn = wid & 3, fr = lane & 15, fq = lane >> 4;
#pragma unroll
  for (int mi = 0; mi < C / 32; ++mi)
#pragma unroll
    for (int ni = 0; ni < C / 64; ++ni) {
      const int r = wm * (C / 2) + mi * 16 + fr, c0 = wn * (C / 4) + ni * 16 + fq * 4;
      float v[4];
#pragma unroll
      for (int j = 0; j < 4; ++j) {
        const int c = c0 + j;
        v[j] = (c <= r ? af[mi][ni][j] : 0.f) + (c >= r ? ab[mi][ni][j] : 0.f);
      }
      *(uint2*)(sc + r * C + c0) = make_uint2(pack2(v[0], v[1]), pack2(v[2], v[3]));
    }
}

template <int C>
__device__ void phase_rec_su(const Params& P, int kind) {
  const Rec R = rec_of(kind);
  const int nch = SLAB / C;
  const int n_sc = nch * R.H;
  const int mtn = R.DK / 128, ntn = R.DV / 128;
  const int n_u = nch * R.H * 2 * mtn * ntn;
  const u16* pj = (const u16*)(WS(P) + O_PROJ);
  for (int item = BID(); item < n_sc + n_u; item += gridDim.x) {
    if (item < n_sc) {
      rec_scores_item<C>(P, R, item / R.H, item % R.H);
    } else {
      int q = item - n_sc;
      const int nt = q % ntn; q /= ntn;
      const int mt = q % mtn; q /= mtn;
      const int dir = q & 1; q >>= 1;
      const int h = q % R.H, cgi = q / R.H;
      const u16* ke = (const u16*)(WS(P) + (dir ? O_KEB : O_KEF)) + (long)cgi * C * 1024 + h * R.DK + mt * 128;
      const u16* v = pj + (long)cgi * C * R.ldv + R.voff + h * R.DV + nt * 128;
      u16* st = (u16*)(WS(P) + (dir ? O_STB : O_STF)) + (((long)cgi * R.H + h) * R.DV + nt * 128) * R.DK + mt * 128;
      f32x4 acc[4][2] = {};
      gemm_acc<128, 128, false, false, false>(acc, ke, 1024, v, R.ldv, C, (u16*)smem);
      const int DK = R.DK;
      epi_each<128, 128, false>(acc, [&](int r, int c, f32x4 val) {
        *(uint2*)(st + (long)c * DK + r) = make_uint2(pack2(val[0], val[1]), pack2(val[2], val[3]));
      });
    }
  }
}

__device__ void phase_rec_scan(const Params& P, int kind, int slab) {
  const Rec R = rec_of(kind);
  const int L = Lof(slab), nseq = SLAB / L, ncs = L / R.C;
  const int hdk = R.DK / 2;
  const long per = (long)R.H * R.DV * hdk;
  const long total = 2 * nseq * per;
  const long gtid = (long)BID() * NT + TID(), gsz = (long)gridDim.x * NT;
  for (long idx = gtid; idx < total; idx += gsz) {
    long q = idx;
    const int pd = (int)(q % hdk); q /= hdk;
    const int e = (int)(q % R.DV); q /= R.DV;
    const int h = (int)(q % R.H); q /= R.H;
    const int seq = (int)(q % nseq);
    const int dir = (int)(q / nseq);
    u16* st = (u16*)(WS(P) + (dir ? O_STB : O_STF));
    const float* dl = (const float*)(WS(P) + (dir ? O_DLB : O_DLF));
    float s0 = 0.f, s1 = 0.f;
    const long ebase = ((long)h * R.DV + e) * R.DK + pd * 2;
    const long cstride = (long)R.H * R.DV * R.DK;
    const int dbase = h * R.DK + pd * 2;
    for (int i0 = 0; i0 < ncs; i0 += 8) {
      unsigned u[8];
      float2 dd[8];
#pragma unroll
      for (int j = 0; j < 8; ++j) {
        const int n = dir ? (ncs - 1 - i0 - j) : (i0 + j);
        const long cgi = (long)seq * ncs + n;
        u[j] = *(const unsigned*)(st + cgi * cstride + ebase);
        dd[j] = *(const float2*)(dl + cgi * 1024 + dbase);
      }
#pragma unroll
      for (int j = 0; j < 8; ++j) {
        const int n = dir ? (ncs - 1 - i0 - j) : (i0 + j);
        const long cgi = (long)seq * ncs + n;
        *(unsigned*)(st + cgi * cstride + ebase) = pack2(s0, s1);
        s0 = dd[j].x * s0 + bf2f((u16)(u[j] & 0xffff));
        s1 = dd[j].y * s1 + bf2f((u16)(u[j] >> 16));
      }
    }
  }
}

template <int C>
__device__ void phase_rec_out(const Params& P, int kind) {
  const Rec R = rec_of(kind);
  const int nch = SLAB / C, ntn = R.DV / 128;
  const u16* pj = (const u16*)(WS(P) + O_PROJ);
  float* ob = (float*)(WS(P) + O_OBUF);
  const int HDV = R.H * R.DV;
  for (int item = BID(); item < nch * R.H * ntn; item += gridDim.x) {
    const int nt = item % ntn, h = (item / ntn) % R.H, cgi = item / (ntn * R.H);
    f32x4 acc[C / 32][2] = {};
    const u16* sc = (const u16*)(WS(P) + O_SC) + ((long)cgi * R.H + h) * C * C;
    const u16* v = pj + (long)cgi * C * R.ldv + R.voff + h * R.DV + nt * 128;
    gemm_acc<C, 128, true, false, true>(acc, sc, C, v, R.ldv, C, (u16*)smem);
    const long qoff = (long)cgi * C * 1024 + h * R.DK;
    const long soff = (((long)cgi * R.H + h) * R.DV + nt * 128) * R.DK;
    gemm_acc<C, 128, true, true, true>(acc, (const u16*)(WS(P) + O_QDF) + qoff, 1024, (const u16*)(WS(P) + O_STF) + soff, R.DK, R.DK, (u16*)smem);
    gemm_acc<C, 128, true, true, true>(acc, (const u16*)(WS(P) + O_QDB) + qoff, 1024, (const u16*)(WS(P) + O_STB) + soff, R.DK, R.DK, (u16*)smem);
    float* o = ob + (long)cgi * C * HDV + h * R.DV + nt * 128;
    epi_each<C, 128, true>(acc, [&](int r, int c, f32x4 val) { *(f32x4*)(o + (long)r * HDV + c) = val; });
  }
}

__device__ void phase_rec_ng(const Params& P, int kind) {
  const Rec R = rec_of(kind);
  const int HDV = R.H * R.DV;
  const float* ob = (const float*)(WS(P) + O_OBUF);
  const u16* pj = (const u16*)(WS(P) + O_PROJ);
  u16* a2 = (u16*)(WS(P) + O_A2);
  const float* gain = (kind == 3) ? P.in[29] : nullptr;
  const int tid = TID(), lane = tid & 63, wid = tid >> 6;
  const int nrows = SLAB * R.H;
  const int per = R.DV / 64;
  for (int item = BID(); item < nrows / 32; item += gridDim.x) {
    float ss[4];
#pragma unroll
    for (int u = 0; u < 4; ++u) {
      const int rh = item * 32 + wid * 4 + u;
      const int t = rh / R.H, h = rh % R.H;
      const float* o = ob + (long)t * HDV + h * R.DV + lane * per;
      float a = 0.f;
      for (int i = 0; i < per; ++i) { float v = o[i]; a += v * v; }
      ss[u] = a;
    }
#pragma unroll
    for (int u = 0; u < 4; ++u) ss[u] = wave_sum(ss[u]);
#pragma unroll
    for (int u = 0; u < 4; ++u) {
      const int rh = item * 32 + wid * 4 + u;
      const int t = rh / R.H, h = rh % R.H;
      const float* o = ob + (long)t * HDV + h * R.DV + lane * per;
      const float rstd = rsqrtf(ss[u] / (float)R.DV + 1e-6f);
      const u16* g = pj + (long)t * R.ldv + R.goff + h * R.DV + lane * per;
      u16* out = a2 + (long)t * HDV + h * R.DV + lane * per;
      for (int i = 0; i < per; ++i) {
        float y = o[i] * rstd;
        if (gain) y *= gain[lane * per + i];
        out[i] = f2bf(y * silu_f(bf2f(g[i])));
      }
    }
  }
}

__device__ void phase_swa_prep(const Params& P, int slab) {
  const int L = Lof(slab);
  const u16* pj = (const u16*)(WS(P) + O_PROJ);
  u16* qn = (u16*)(WS(P) + O_QN);
  u16* kn = (u16*)(WS(P) + O_KN);
  const float2* rope = (const float2*)(WS(P) + O_ROPES);
  const long gtid = (long)BID() * NT + TID(), gsz = (long)gridDim.x * NT;
  for (long idx = gtid; idx < (long)SLAB * 640; idx += gsz) {
    const int d = (int)(idx & 31);
    const int hd = (int)((idx >> 5) % 20);
    const int t = (int)(idx / 640);
    const int col = hd < 16 ? hd * 64 : 1024 + (hd - 16) * 64;
    const float x1 = bf2f(pj[(long)t * 1536 + col + d]), x2 = bf2f(pj[(long)t * 1536 + col + d + 32]);
    float ss = x1 * x1 + x2 * x2;
#pragma unroll
    for (int o = 16; o; o >>= 1) ss += __shfl_xor(ss, o);
    const float rstd = rsqrtf(ss * (1.f / 64.f) + 1e-6f);
    const float* gn = hd < 16 ? P.in[23] : P.in[24];
    const float y1 = x1 * rstd * gn[d], y2 = x2 * rstd * gn[d + 32];
    const float2 cs = rope[(long)(t & (L - 1)) * 32 + d];
    float o1 = y1 * cs.x - y2 * cs.y, o2 = y1 * cs.y + y2 * cs.x;
    if (hd < 16) {
      qn[(long)t * 1024 + hd * 64 + d] = f2bf(o1 * 0.125f);
      qn[(long)t * 1024 + hd * 64 + d + 32] = f2bf(o2 * 0.125f);
    } else {
      kn[(long)t * 256 + (hd - 16) * 64 + d] = f2bf(o1);
      kn[(long)t * 256 + (hd - 16) * 64 + d + 32] = f2bf(o2);
    }
  }
}

constexpr int SLD = 324;
__device__ void phase_swa_att1(const Params& P, int slab) {
  const int L = Lof(slab), nqb = L / 64;
  const u16* qn = (const u16*)(WS(P) + O_QN);
  const u16* kn = (const u16*)(WS(P) + O_KN);
  u16* pb = (u16*)(WS(P) + O_PBUF);
  const float* sink = P.in[25];
  float* S = (float*)(smem + 40960);
  const int tid = TID();
  const int nitems = (SLAB / 64) * 16;
  for (int item = BID(); item < nitems; item += gridDim.x) {
    const int hq = item & 15, qbg = item >> 4;
    const int seq = qbg / nqb, qb = qbg % nqb;
    const int q0 = qb * 64;
    const long tok0 = (long)seq * L;
    const int hkv = hq >> 2;
    for (int kt = 0; kt < 5; ++kt) {
      const int kp0 = q0 - 128 + kt * 64;
      if (kp0 >= 0 && kp0 < L) {
        f32x4 acc[2][1] = {};
        gemm_acc<64, 64, true, true, true>(acc, qn + (tok0 + q0) * 1024 + hq * 64, 1024, kn + (tok0 + kp0) * 256 + hkv * 64, 256, 64, (u16*)smem);
        epi_each<64, 64, true>(acc, [&](int r, int c, f32x4 v) {
          f32x4 o;
#pragma unroll
          for (int j = 0; j < 4; ++j) {
            const int dlt = (q0 + r) - (kp0 + c + j);
            o[j] = (dlt <= 128 && dlt >= -128) ? v[j] : -1e30f;
          }
          *(f32x4*)(S + r * SLD + kt * 64 + c) = o;
        });
      } else {
        for (int i = tid; i < 4096; i += NT) S[(i >> 6) * SLD + kt * 64 + (i & 63)] = -1e30f;
      }
    }
    __syncthreads();
    {
      const int r = tid >> 3, sub = tid & 7;
      const float sk = sink[hq];
      float m = sk;
      for (int c = sub; c < 320; c += 8) m = fmaxf(m, S[r * SLD + c]);
      m = fmaxf(m, __shfl_xor(m, 1)); m = fmaxf(m, __shfl_xor(m, 2)); m = fmaxf(m, __shfl_xor(m, 4));
      float den = 0.f;
      for (int c = sub; c < 320; c += 8) { float e = __expf(S[r * SLD + c] - m); S[r * SLD + c] = e; den += e; }
      den += __shfl_xor(den, 1); den += __shfl_xor(den, 2); den += __shfl_xor(den, 4);
      den += __expf(sk - m);
      const float inv = 1.f / den;
      u16* prow = pb + ((long)item * 64 + r) * 320;
      for (int c = sub; c < 320; c += 8) prow[c] = f2bf(S[r * SLD + c] * inv);
    }
    __syncthreads();
  }
}

__device__ void phase_swa_att2(const Params& P, int slab) {
  const int L = Lof(slab), nqb = L / 64;
  const u16* pj = (const u16*)(WS(P) + O_PROJ);
  const u16* pb = (const u16*)(WS(P) + O_PBUF);
  u16* a2 = (u16*)(WS(P) + O_A2);
  const int nitems = (SLAB / 64) * 16;
  for (int item = BID(); item < nitems; item += gridDim.x) {
    const int hq = item & 15, qbg = item >> 4;
    const int seq = qbg / nqb, qb = qbg % nqb;
    const int q0 = qb * 64;
    const long tok0 = (long)seq * L;
    const int hkv = hq >> 2;
    f32x4 acc[2][1] = {};
    for (int kt = 0; kt < 5; ++kt) {
      const int kp0 = q0 - 128 + kt * 64;
      if (kp0 >= 0 && kp0 < L)
        gemm_acc<64, 64, true, false, true>(acc, pb + (long)item * 64 * 320 + kt * 64, 320, pj + (tok0 + kp0) * 1536 + 1280 + hkv * 64, 1536, 64, (u16*)smem);
    }
    u16* o = a2 + (tok0 + q0) * 1024 + hq * 64;
    epi_each<64, 64, true>(acc, [&](int r, int c, f32x4 v) { *(uint2*)(o + (long)r * 1024 + c) = make_uint2(pack2(v[0], v[1]), pack2(v[2], v[3])); });
  }
}


#define XB_TMO      128
#define XB_XCNT(j)  (256  + 64 * (j))
#define XB_XSUB(j)  (1280 + 64 * (j))
#define XB_XGEN(j)  (2304 + 64 * (j))
#define XB_TOP      3328
#define XB_TOPGEN   3392
#define XCD_BAR_WORDS 3456
#define XB_SPIN_CAP (1u << 18)
__device__ __forceinline__ unsigned xb_ld(unsigned* p)              { return __hip_atomic_load(p, __ATOMIC_RELAXED, __HIP_MEMORY_SCOPE_AGENT); }
__device__ __forceinline__ unsigned xb_add(unsigned* p, unsigned v) { return __hip_atomic_fetch_add(p, v, __ATOMIC_RELAXED, __HIP_MEMORY_SCOPE_AGENT); }
__device__ __forceinline__ unsigned xb_xcc_id() { return (unsigned)__builtin_amdgcn_s_getreg((3 << 11) | 20) & 0xFu; }
#define XB_SPIN(cond, bar) do { unsigned _sp = 0; while (cond) { __builtin_amdgcn_s_sleep(1); \
    if ((++_sp & 255u) == 0u) { if (xb_ld(&(bar)[XB_TMO])) break; if (_sp > XB_SPIN_CAP) { atomicAdd(&(bar)[XB_TMO], 1u); break; } } } } while (0)
struct XcdBarrier { unsigned* bar; unsigned x; volatile LDS_AS unsigned* st; };
__device__ __forceinline__ XcdBarrier xcd_barrier_post(unsigned* bar, volatile LDS_AS unsigned* st) {
    XcdBarrier b; b.bar = bar; b.x = xb_xcc_id(); b.st = st;
    if (threadIdx.x == 0) (void)xb_add(&bar[XB_XCNT(b.x)], 1u);
    return b;
}
__device__ __forceinline__ void xcd_barrier_complete(unsigned* bar, unsigned x, unsigned& nloc, unsigned& nx) {
    const unsigned G = gridDim.x * gridDim.y * gridDim.z;
    unsigned sum, cnt, mine, sp = 0u;
    for (;;) {
        sum = 0u; cnt = 0u; mine = 0u;
#pragma unroll
        for (unsigned j = 0; j < 16; ++j) { const unsigned c = xb_ld(&bar[XB_XCNT(j)]); sum += c; cnt += (c > 0u) ? 1u : 0u; mine = (j == x) ? c : mine; }
        if (sum == G) break;
        __builtin_amdgcn_s_sleep(1);
        if ((++sp & 255u) == 0u) { if (xb_ld(&bar[XB_TMO])) break; if (sp > XB_SPIN_CAP) { atomicAdd(&bar[XB_TMO], 1u); break; } }
    }
    nloc = mine > 0u ? mine : 1u; nx = cnt > 0u ? cnt : 1u;
}
__device__ __forceinline__ void xcd_barrier(const XcdBarrier& b) {
    asm volatile("s_waitcnt vmcnt(0)" ::: "memory");
    __syncthreads();
    if (threadIdx.x == 0) {
        unsigned* bar = b.bar;
        __builtin_amdgcn_s_waitcnt(0);
        unsigned nloc = b.st[0], nx = b.st[1];
        if (nloc == 0u) { xcd_barrier_complete(bar, b.x, nloc, nx); b.st[0] = nloc; b.st[1] = nx; }
        const unsigned old = xb_add(&bar[XB_XSUB(b.x)], 1u);
        const unsigned gen = old / nloc;
        if (old + 1u == (gen + 1u) * nloc) {
            __builtin_amdgcn_fence(__ATOMIC_RELEASE, "agent");
            asm volatile("s_waitcnt vmcnt(0)" ::: "memory");
            const unsigned og = xb_add(&bar[XB_TOP], 1u);
            const unsigned tg = og / nx;
            if (og + 1u == (tg + 1u) * nx) xb_add(&bar[XB_TOPGEN], 1u);
            else XB_SPIN(xb_ld(&bar[XB_TOPGEN]) == tg, bar);
            __builtin_amdgcn_fence(__ATOMIC_ACQUIRE, "agent");
            xb_add(&bar[XB_XGEN(b.x)], 1u);
            asm volatile("s_waitcnt vmcnt(0)" ::: "memory");
        } else {
            XB_SPIN(xb_ld(&bar[XB_XGEN(b.x)]) == gen, bar);
            __builtin_amdgcn_fence(__ATOMIC_ACQUIRE, "agent");
            asm volatile("s_waitcnt vmcnt(0)" ::: "memory");
        }
    }
    __syncthreads();
}

__device__ __forceinline__ int nsteps_of(int kind) { return (kind & 1) ? 12 : 10; }

__device__ void layer_step(const Params& P, int layer, int slab, int step) {
  const int kind = layer;
  const int nmix = nsteps_of(kind) - 4;
  if (step == 0) { REP(4) phase_norm(P, layer, slab, 0); return; }
  if (step >= nmix) {
    const int f = step - nmix;
    if (f == 0) { REP(4) phase_norm(P, layer, slab, 1); }
    else if (f == 1) { REP(0) phase_ffn_gate(P, layer); }
    else if (f == 2) { REP(0) phase_ffn_val(P, layer, slab); }
    else phase_resid(P, layer, slab, (const u16*)(WS(P) + O_ACT), DFF, O_WFD + (size_t)layer * SZW(1024, 2816), 5 * D);
    return;
  }
  if (kind == 0) {
    if (step == 1) { REP(0) phase_proj(P, O_WHYIN, 3072); }
    else if (step == 2) { REP(3) phase_hy_conv(P, slab); }
    else if (step == 3) phase_hy_fft(P, slab);
    else if (step == 4) { REP(3) phase_hy_tr(P, slab); }
    else phase_resid(P, layer, slab, (const u16*)(WS(P) + O_A2), 1024, O_WHYOUT, 2 * D);
  } else if (kind == 1) {
    if (step == 1) { REP(0) phase_proj(P, O_WRETIN, 6144); }
    else if (step == 2) { REP(1) phase_ret_prep(P, slab); }
    else if (step == 3) { REP(1) phase_rec_su<128>(P, 1); }
    else if (step == 4) phase_rec_scan(P, 1, slab);
    else if (step == 5) { REP(1) phase_rec_out<128>(P, 1); }
    else if (step == 6) { REP(1) phase_rec_ng(P, 1); }
    else phase_resid(P, layer, slab, (const u16*)(WS(P) + O_A2), 2048, O_WRETOUT, 2 * D);
  } else if (kind == 2) {
    if (step == 1) { REP(0) phase_proj(P, O_WSWAIN, 1536); }
    else if (step == 2) { REP(2) phase_swa_prep(P, slab); }
    else if (step == 3) { REP(2) phase_swa_att1(P, slab); }
    else if (step == 4) { REP(2) phase_swa_att2(P, slab); }
    else phase_resid(P, layer, slab, (const u16*)(WS(P) + O_A2), 1024, O_WSWAOUT, 2 * D);
  } else {
    if (step == 1) { REP(0) phase_proj(P, O_WHGIN, 5120); }
    else if (step == 2) { REP(1) phase_hg_prep(P); }
    else if (step == 3) { REP(1) phase_rec_su<64>(P, 3); }
    else if (step == 4) phase_rec_scan(P, 3, slab);
    else if (step == 5) { REP(1) phase_rec_out<64>(P, 3); }
    else if (step == 6) { REP(1) phase_rec_ng(P, 3); }
    else phase_resid(P, layer, slab, (const u16*)(WS(P) + O_A2), 1024, O_WHGOUT, 2 * D);
  }
}

__global__ void __launch_bounds__(NT) fwd_megakernel(Params P) {
  cg::grid_group grid = cg::this_grid();
  __shared__ uint4 xb_words;
  if (threadIdx.x == 0) xb_words = make_uint4(0u, 0u, 0u, 0u);
  __syncthreads();
  XcdBarrier xb = xcd_barrier_post((unsigned*)(P.ws + O_BAR), (volatile LDS_AS unsigned*)&xb_words);
  for (int pid = P.p0; pid < P.p1; ++pid) {
    if (pid == 0) { REP(5) phase_pre0(P); }
    else if (pid == 1) { REP(5) phase_pre1(P); }
    else {
      int q = pid - 2, layer = 0;
      while (q >= 5 * nsteps_of(layer)) { q -= 5 * nsteps_of(layer); ++layer; }
      const int ns = nsteps_of(layer);
      layer_step(P, layer, q / ns, q % ns);
    }
    if (pid + 1 < P.p1) {
      if (pid == 0) grid.sync();
      else xcd_barrier(xb);
      if ((PROBE_MASK >> 8) & 1) xcd_barrier(xb);
    }
  }
}

extern "C" void kernel_launch(void* const* d_in, const int* in_sizes, int n_in, void* d_out, int out_size, void* d_ws,
                              size_t ws_size, hipStream_t stream) {
  static int grid_blocks = 0;
  if (!grid_blocks) {
    int dev = 0, cus = 0, per_cu = 0;
    (void)hipGetDevice(&dev);
    (void)hipDeviceGetAttribute(&cus, hipDeviceAttributeMultiprocessorCount, dev);
    (void)hipFuncSetAttribute((const void*)fwd_megakernel, hipFuncAttributeMaxDynamicSharedMemorySize, LDSB);
    (void)hipOccupancyMaxActiveBlocksPerMultiprocessor(&per_cu, (const void*)fwd_megakernel, NT, LDSB);
    if (per_cu < 1) per_cu = 1;
    if (per_cu > 1) per_cu = 1;
    grid_blocks = cus * per_cu;
    if (ws_size < WS_END) fprintf(stderr, "kernel_launch: workspace too small: %zu < %zu\n", ws_size, (size_t)WS_END);
  }
  Params p;
  memset(&p, 0, sizeof(p));
  for (int i = 0; i < 36; ++i) p.in[i] = (const float*)d_in[i];
  p.out = (float*)d_out;
  p.ws = (unsigned char*)d_ws;
  (void)hipMemsetAsync((unsigned char*)d_ws + O_BAR, 0, XCD_BAR_WORDS * 4, stream);
#if ONE_LAUNCH
  p.p0 = 0; p.p1 = NPHASES;
  void* args[] = {&p};
  hipError_t e = hipLaunchCooperativeKernel((const void*)fwd_megakernel, dim3(grid_blocks), dim3(NT), args, LDSB, stream);
  if (e != hipSuccess) fprintf(stderr, "cooperative launch failed: %s (grid %d)\n", hipGetErrorString(e), grid_blocks);
#else
  for (int ph = 0; ph < NPHASES; ++ph) {
    p.p0 = ph; p.p1 = ph + 1;
    hipLaunchKernelGGL(fwd_megakernel, dim3(grid_blocks), dim3(NT), LDSB, stream, p);
  }
#endif
}
```

```cpp
#include <hip/hip_runtime.h>
#include <hip/hip_cooperative_groups.h>
#include <cstdio>
#include <cstdint>
#include <cstring>
namespace cg = cooperative_groups;

typedef unsigned short u16;
typedef __attribute__((ext_vector_type(8))) short bf16x8;
typedef __attribute__((ext_vector_type(4))) float f32x4;

#define NT 512
#ifndef ONE_LAUNCH
#define ONE_LAUNCH 1
#endif
#ifndef PROBE_MASK
#define PROBE_MASK 0
#endif
#define REP(cls) for (int rep_ = 0; rep_ < (((PROBE_MASK >> (cls)) & 1) ? 2 : 1); ++rep_)

constexpr int D = 1024, SLAB = 16384, DFF = 2816;
constexpr int LDSB = 131072;
constexpr int NPHASES = 2 + 5 * (10 + 12 + 10 + 12);

constexpr size_t SZW(size_t n, size_t k) { return n * k * 2; }
constexpr size_t O_WHYIN = 0;
constexpr size_t O_WHYOUT = O_WHYIN + SZW(3072, 1024);
constexpr size_t O_WRETIN = O_WHYOUT + SZW(1024, 1024);
constexpr size_t O_WRETOUT = O_WRETIN + SZW(6144, 1024);
constexpr size_t O_WSWAIN = O_WRETOUT + SZW(1024, 2048);
constexpr size_t O_WSWAOUT = O_WSWAIN + SZW(1536, 1024);
constexpr size_t O_WHGIN = O_WSWAOUT + SZW(1024, 1024);
constexpr size_t O_WHGOUT = O_WHGIN + SZW(5120, 1024);
constexpr size_t O_WFG = O_WHGOUT + SZW(1024, 1024);
constexpr size_t O_WFV = O_WFG + 4 * SZW(2816, 1024);
constexpr size_t O_WFD = O_WFV + 4 * SZW(2816, 1024);
constexpr size_t O_MOD = O_WFD + 4 * SZW(1024, 2816);
constexpr size_t O_TW = O_MOD + (size_t)4 * 16 * 6144 * 4;
constexpr size_t O_HIDS = O_TW + 8192 * 8;
constexpr size_t O_HIDP = O_HIDS + (size_t)8192 * 64 * 4;
constexpr size_t O_ROPER = O_HIDP + (size_t)2048 * 64 * 4;
constexpr size_t O_ROPES = O_ROPER + (size_t)8192 * 128 * 8;
constexpr size_t O_PROJ = O_ROPES + (size_t)8192 * 32 * 8;
constexpr size_t O_HBUF = O_PROJ + (size_t)SLAB * 6144 * 2;
constexpr size_t O_A2 = O_HBUF + (size_t)SLAB * 1024 * 2;
constexpr size_t O_C = O_A2 + (size_t)SLAB * 2048 * 2;
constexpr size_t O_GBUF = O_C;
constexpr size_t O_ACT = O_GBUF + (size_t)SLAB * DFF * 2;
constexpr size_t O_MODP = O_C;
constexpr size_t O_HSPS = O_ACT + (size_t)SLAB * DFF * 2;
constexpr size_t O_HSPP = O_HSPS + (size_t)1024 * 16384 * 8;
constexpr size_t O_UT = O_HSPP + (size_t)1024 * 4096 * 8;
constexpr size_t O_X0C = O_UT + (size_t)SLAB * 1024 * 4;
constexpr size_t END_HY = O_X0C + (size_t)SLAB * 1024 * 2;
constexpr size_t SZP = (size_t)SLAB * 1024 * 2;
constexpr size_t O_QDF = O_C, O_QDB = O_QDF + SZP, O_KIF = O_QDB + SZP, O_KIB = O_KIF + SZP, O_KEF = O_KIB + SZP, O_KEB = O_KEF + SZP;
constexpr size_t O_DLF = O_KEB + SZP;
constexpr size_t O_DLB = O_DLF + (size_t)256 * 1024 * 4;
constexpr size_t O_SC = O_DLB + (size_t)256 * 1024 * 4;
constexpr size_t O_STF = O_SC + (size_t)SLAB * 512 * 2;
constexpr size_t O_STB = O_STF + (size_t)134217728;
constexpr size_t O_OBUF = O_STB + (size_t)134217728;
constexpr size_t END_REC = O_OBUF + (size_t)SLAB * 2048 * 4;
constexpr size_t O_QN = O_C;
constexpr size_t O_KN = O_QN + SZP;
constexpr size_t O_PBUF = O_KN + (size_t)SLAB * 256 * 2;
constexpr size_t END_SWA = O_PBUF + (size_t)SLAB * 16 * 320 * 2;
constexpr size_t WS_END = END_REC > END_HY ? (END_REC > END_SWA ? END_REC : END_SWA) : (END_HY > END_SWA ? END_HY : END_SWA);
constexpr size_t O_BAR = ((size_t)1 << 30) - 16384;
static_assert(WS_END <= O_BAR, "workspace exceeds 1 GiB");

struct Params {
  const float* in[36];
  float* out;
  unsigned char* ws;
  int p0, p1;
};

extern __shared__ __attribute__((aligned(16))) unsigned char smem[];

__device__ __forceinline__ int TID() { int t = threadIdx.x; asm volatile("" : "+v"(t)); return t; }
__device__ __forceinline__ int BID() { int b = blockIdx.x; asm volatile("" : "+s"(b)); return b; }
__device__ __forceinline__ long ZOFF() { long z = 0; asm volatile("" : "+s"(z)); return z; }
__device__ __forceinline__ unsigned char* WS(const Params& P) { return P.ws + ZOFF(); }
__device__ __forceinline__ float* OUTP(const Params& P) { return P.out + ZOFF(); }

namespace pg8 {
#define PG8_LAS __attribute__((address_space(3)))
typedef unsigned short bf16_t;
typedef short bf16x8 __attribute__((ext_vector_type(8)));
typedef float f32x4 __attribute__((ext_vector_type(4)));
typedef unsigned u32x4 __attribute__((ext_vector_type(4)));
constexpr int BM = 256, BK = 64, HALF = 128, HTB = HALF * BK * 2  , STAGE_BYTES = 8 * HTB, NXCD = 8, WGM = 8;

__host__ __device__ __forceinline__ int lds_byte(int r, int c) { const int st = (r >> 4) * 2 + (c >> 5), rr = r & 15, cc = c & 31, ob = rr * 64 + cc * 2; return st * 1024 + (ob ^ (((ob >> 9) & 1) << 5)); }
__host__ __device__ __forceinline__ void stage_rc(int b, int& R, int& C) { const int st = b / 1024, sb = b % 1024, swz = sb ^ (((sb >> 9) & 1) << 5); R = (st >> 1) * 16 + swz / 64; C = (st & 1) * 32 + (swz % 64) / 2; }
__host__ __device__ __forceinline__ int perm32(int rho) { const int n = rho >> 4, i = rho & 15; return 8 * (i >> 2) + 4 * n + (i & 3); }

struct Unit { int pm, pn; };
struct Gemm { const bf16_t* A; const bf16_t* Bt; int M, N, K; };

struct StaticOrder {
    int nM, nN, nwg, G, c;
    __host__ __device__ void init(int M, int N, int G_, int c_) { nM = M / BM; nN = N / BM; nwg = nM * nN; G = G_; c = c_; }
    __host__ __device__ bool next(int i, Unit& u) const {
        const long L = (long)i * G + c; if (L >= nwg) return false;
        int wgid = (int)L; { const int q = nwg / NXCD, r = nwg % NXCD, xcd = wgid % NXCD, off = wgid / NXCD; wgid = (xcd < r ? xcd * (q + 1) : r * (q + 1) + (xcd - r) * q) + off; }
        const int nig = WGM * nN, gid = wgid / nig, fm = gid * WGM, gsz = (nM - fm) < WGM ? (nM - fm) : WGM;
        u.pm = fm + ((wgid % nig) % gsz); u.pn = (wgid % nig) / gsz; return true;
    }
    __device__ __forceinline__ void a_ready(const Unit&) const {}
    __device__ __forceinline__ void done(const Unit&) const {}
};

template <class Epi, class Sched, bool STAMP = false>
__device__ __forceinline__ void gemm_phase(PG8_LAS unsigned char* lds, const Gemm g, const Sched& S, const Epi& E, unsigned long long* stamps) {
    const int tid = TID(), wid = __builtin_amdgcn_readfirstlane(tid >> 6), lane = tid & 63, wr = wid >> 2, wc = wid & 3, fr = lane & 15, fq = lane >> 4;
    const int K = g.K, nt = K / BK;
    int ts_lo = 0, ts_hi = 0, nts = 0; const unsigned long long rt_entry = STAMP ? (unsigned long long)wall_clock64() : 0ull;
#define PG8_STAMP() do { if (STAMP && wid == 0 && nts < 64) { const unsigned long long _c = (unsigned long long)clock64(); \
        ts_lo = (lane == nts) ? (int)(unsigned)_c : ts_lo; ts_hi = (lane == nts) ? (int)(unsigned)(_c >> 32) : ts_hi; ++nts; } } while (0)
    PG8_STAMP();
    unsigned voffA[2], voffB[2];
#pragma unroll
    for (int i = 0; i < 2; ++i) { int R, C; stage_rc(tid * 16 + i * 8192, R, C); const int Rb = Epi::PERM ? ((R & ~31) + perm32(R & 31)) : R;
        voffA[i] = (unsigned)(R * K + C) * 2u; voffB[i] = (unsigned)(Rb * K + C) * 2u; }
    const size_t kstep = (size_t)(BK * 2);
    const size_t hstep = (size_t)HALF * K * 2;
    const size_t tstep = 2 * hstep;
    const unsigned ldsw = (unsigned)wid * 1024u;
    const int aoff = lds_byte(wr * 64 + fr, fq * 8), boff = lds_byte(wc * 32 + fr, fq * 8);
#define PG8_SA(b, h) (((b) * 2 + (h)) * HTB)
#define PG8_SB(b, h) ((4 + (b) * 2 + (h)) * HTB)
#define PG8_STAGE(bufoff, gbase, voff) do { _Pragma("unroll") for (int _i = 0; _i < 2; ++_i) \
        __builtin_amdgcn_global_load_lds((const unsigned*)((const char*)(gbase) + (voff)[_i]), (PG8_LAS unsigned*)(lds + (bufoff) + ldsw + _i * 8192), 16, 0, 0); } while (0)
#define PG8_LDA(dst, b, h) do { _Pragma("unroll") for (int m = 0; m < 4; ++m) _Pragma("unroll") for (int k = 0; k < 2; ++k) dst[m][k] = *(const PG8_LAS bf16x8*)(lds + PG8_SA(b, h) + aoff + m * 2048 + k * 1024); } while (0)
#define PG8_LDB(dst, b, h) do { _Pragma("unroll") for (int n = 0; n < 2; ++n) _Pragma("unroll") for (int k = 0; k < 2; ++k) dst[n][k] = *(const PG8_LAS bf16x8*)(lds + PG8_SB(b, h) + boff + n * 2048 + k * 1024); } while (0)
#define PG8_MMA(ai, bj, At, Bt) do { __builtin_amdgcn_s_setprio(1); _Pragma("unroll") for (int m = 0; m < 4; ++m) _Pragma("unroll") for (int n = 0; n < 2; ++n) _Pragma("unroll") for (int k = 0; k < 2; ++k) \
        acc[ai][bj][m][n] = __builtin_amdgcn_mfma_f32_16x16x32_bf16(Bt[n][k], At[m][k], acc[ai][bj][m][n], 0, 0, 0); __builtin_amdgcn_s_setprio(0); } while (0)
#define PG8_WAIT_V(n) asm volatile("s_waitcnt vmcnt(" #n ")" ::: "memory")
#define PG8_WAIT_L(n) asm volatile("s_waitcnt lgkmcnt(" #n ")" ::: "memory")
#define PG8_BAR __builtin_amdgcn_s_barrier()
#define PG8_SCHED __builtin_amdgcn_sched_barrier(0)
    Unit cur, nxt; int ui = 0;
    if (!S.next(0, cur)) return;
    f32x4 acc[2][2][4][2];
#pragma unroll
    for (int a = 0; a < 2; ++a)
#pragma unroll
        for (int b = 0; b < 2; ++b)
#pragma unroll
            for (int m = 0; m < 4; ++m)
#pragma unroll
                for (int n = 0; n < 2; ++n) acc[a][b][m][n] = (f32x4){0.f, 0.f, 0.f, 0.f};
    bf16x8 At[4][2], B0[2][2], B1[2][2];
    const char* cA = (const char*)g.A + (size_t)cur.pm * tstep; const char* cB = (const char*)g.Bt + (size_t)cur.pn * tstep;
    S.a_ready(cur);
    PG8_STAGE(PG8_SB(0, 0), cB, voffB); PG8_STAGE(PG8_SA(0, 0), cA, voffA); PG8_STAGE(PG8_SB(0, 1), cB + hstep, voffB); PG8_STAGE(PG8_SA(0, 1), cA + hstep, voffA);
    if (wr == 1) PG8_BAR;
    PG8_WAIT_V(4); PG8_BAR;
    PG8_STAGE(PG8_SB(1, 0), cB + kstep, voffB); PG8_STAGE(PG8_SA(1, 0), cA + kstep, voffA); PG8_STAGE(PG8_SB(1, 1), cB + hstep + kstep, voffB);
    PG8_WAIT_V(6); PG8_BAR;
    PG8_STAMP();
    for (;;) {
        const bool has_next = S.next(ui + 1, nxt);
        const char* nA = has_next ? (const char*)g.A + (size_t)nxt.pm * tstep : cA; const char* nB = has_next ? (const char*)g.Bt + (size_t)nxt.pn * tstep : cB;
        for (int t = 0; t < nt; t += 2) {
            const bool last = (t == nt - 2);
            const char* a1 = cA + (size_t)(t + 1) * kstep;
            const char* a2 = last ? nA : cA + (size_t)(t + 2) * kstep; const char* b2 = last ? nB : cB + (size_t)(t + 2) * kstep;
            const char* a3 = a2 + kstep; const char* b3 = b2 + kstep;
            if (last && has_next) S.a_ready(nxt);
            PG8_LDB(B0, 0, 0); PG8_SCHED; PG8_LDA(At, 0, 0); PG8_STAGE(PG8_SA(1, 1), a1 + hstep, voffA);
            PG8_WAIT_L(8); PG8_BAR; PG8_WAIT_L(0); PG8_MMA(0, 0, At, B0); PG8_BAR; PG8_SCHED;
            PG8_LDB(B1, 0, 1); PG8_STAGE(PG8_SB(0, 0), b2, voffB);
            PG8_BAR; PG8_WAIT_L(0); PG8_MMA(0, 1, At, B1); PG8_BAR;
            PG8_LDA(At, 0, 1); PG8_STAGE(PG8_SA(0, 0), a2, voffA);
            PG8_BAR; PG8_WAIT_L(0); PG8_MMA(1, 0, At, B0); PG8_BAR; PG8_SCHED;
            PG8_STAGE(PG8_SB(0, 1), b2 + hstep, voffB);
            PG8_WAIT_V(6); PG8_BAR; PG8_MMA(1, 1, At, B1); PG8_BAR;
            PG8_LDB(B0, 1, 0); PG8_SCHED; PG8_LDA(At, 1, 0); PG8_STAGE(PG8_SA(0, 1), a2 + hstep, voffA);
            PG8_WAIT_L(8); PG8_BAR; PG8_WAIT_L(0); PG8_MMA(0, 0, At, B0); PG8_BAR; PG8_SCHED;
            PG8_LDB(B1, 1, 1); PG8_STAGE(PG8_SB(1, 0), b3, voffB);
            PG8_BAR; PG8_WAIT_L(0); PG8_MMA(0, 1, At, B1); PG8_BAR;
            PG8_LDA(At, 1, 1); PG8_STAGE(PG8_SA(1, 0), a3, voffA);
            PG8_BAR; PG8_WAIT_L(0); PG8_MMA(1, 0, At, B0); PG8_BAR; PG8_SCHED;
            PG8_STAGE(PG8_SB(1, 1), b3 + hstep, voffB);
            PG8_WAIT_V(6); PG8_BAR; PG8_MMA(1, 1, At, B1); PG8_BAR;
        }
        PG8_STAMP();
        if constexpr (!Epi::AFTER_DRAIN) { E(acc, cur, wr, wc, fr, fq); S.done(cur); }
        PG8_STAMP();
        if (!has_next) break;
#pragma unroll
        for (int a = 0; a < 2; ++a)
#pragma unroll
            for (int b = 0; b < 2; ++b)
#pragma unroll
                for (int m = 0; m < 4; ++m)
#pragma unroll
                    for (int n = 0; n < 2; ++n) acc[a][b][m][n] = (f32x4){0.f, 0.f, 0.f, 0.f};
        cur = nxt; cA = nA; cB = nB; ++ui;
    }
    PG8_WAIT_V(0);
    if (wr == 0) PG8_BAR;
    PG8_BAR;
    if constexpr (Epi::AFTER_DRAIN) { E.fused(acc, cur, wr, wc, fr, fq, lds, wid, lane); S.done(cur); }
    PG8_STAMP();
    if (STAMP && wid == 0) { stamps[lane] = lane < nts ? (((unsigned long long)(unsigned)ts_hi << 32) | (unsigned)ts_lo) : 0ull;
        if (lane == 62) stamps[62] = rt_entry; if (lane == 63) stamps[63] = (unsigned long long)wall_clock64(); }
#undef PG8_STAMP
#undef PG8_SA
#undef PG8_SB
#undef PG8_STAGE
#undef PG8_LDA
#undef PG8_LDB
#undef PG8_MMA
#undef PG8_WAIT_V
#undef PG8_WAIT_L
#undef PG8_BAR
#undef PG8_SCHED
}
}


__device__ __forceinline__ u16 f2bf(float f) {
  unsigned u = __float_as_uint(f);
  u += 0x7fffu + ((u >> 16) & 1u);
  return (u16)(u >> 16);
}
__device__ __forceinline__ float bf2f(u16 h) { return __uint_as_float(((unsigned)h) << 16); }
__device__ __forceinline__ unsigned pack2(float a, float b) { return (unsigned)f2bf(a) | ((unsigned)f2bf(b) << 16); }
__device__ __forceinline__ float silu_f(float x) { return x / (1.f + __expf(-x)); }
__device__ __forceinline__ float sigm(float x) { return 1.f / (1.f + __expf(-x)); }
__device__ __forceinline__ float wave_sum(float v) {
#pragma unroll
  for (int o = 32; o; o >>= 1) v += __shfl_xor(v, o);
  return v;
}
__device__ __forceinline__ int Lof(int slab) { return slab == 0 ? 2048 : 8192; }
__device__ __forceinline__ int gb_of(int slab, int r) { return slab == 0 ? (r >> 11) : (8 + (slab - 1) * 2 + (r >> 13)); }

typedef short v4s __attribute__((ext_vector_type(4)));
#define LDS_AS __attribute__((address_space(3)))
template <int R, bool KC>
__device__ __forceinline__ uint4 ld_chunk(const u16* __restrict__ base, long ld, int k0, int c) {
  if (KC) {
    const int r = c >> 3, kc = c & 7;
    return *(const uint4*)(base + (long)r * ld + k0 + kc * 8);
  } else {
    const int k = c / (R / 8), mc = c % (R / 8);
    return *(const uint4*)(base + (long)(k0 + k) * ld + mc * 8);
  }
}
template <int R, bool KC>
__device__ __forceinline__ void st_chunk(u16* s, uint4 v, int c) {
  if (KC) {
    const int r = c >> 3, kc = c & 7;
    *(uint4*)(s + r * 72 + kc * 8) = v;
  } else {
    const int k = c / (R / 8), mc = c % (R / 8);
    *(uint4*)(s + k * (R + 8) + mc * 8) = v;
  }
}
template <int R, bool KC>
__device__ __forceinline__ bf16x8 ld_frag(const u16* s, int x0, int ks, int fr, int fq) {
  if (KC) {
    return *(const bf16x8*)(s + (x0 + fr) * 72 + ks * 32 + fq * 8);
  } else {
    const int q4 = fr >> 2, p4 = fr & 3;
    const u16* p = s + (ks * 32 + 8 * fq + q4) * (R + 8) + x0 + 4 * p4;
    v4s lo = __builtin_amdgcn_ds_read_tr16_b64_v4i16((LDS_AS v4s*)p);
    v4s hi = __builtin_amdgcn_ds_read_tr16_b64_v4i16((LDS_AS v4s*)(p + 4 * (R + 8)));
    bf16x8 r;
    r[0] = lo[0]; r[1] = lo[1]; r[2] = lo[2]; r[3] = lo[3]; r[4] = hi[0]; r[5] = hi[1]; r[6] = hi[2]; r[7] = hi[3];
    return r;
  }
}

template <int TM, int TN, bool AKC, bool BKC, bool TR>
__device__ __forceinline__ void gemm_acc(f32x4 (&acc)[TM / 32][TN / 64], const u16* __restrict__ A, long lda,
                                         const u16* __restrict__ B, long ldb, int K, u16* sm) {
  u16* As = sm;
  u16* Bs = sm + 9216;
  const int tid = TID(), lane = tid & 63, wid = tid >> 6;
  const int wm = wid >> 2, wn = wid & 3, fr = lane & 15, fq = lane >> 4;
  constexpr int MI = TM / 32, NI = TN / 64;
  uint4 ra0 = ld_chunk<TM, AKC>(A, lda, 0, tid), rb0 = ld_chunk<TN, BKC>(B, ldb, 0, tid);
  uint4 ra1 = ra0, rb1 = rb0;
  if (TM == 128) ra1 = ld_chunk<TM, AKC>(A, lda, 0, tid + NT);
  if (TN == 128) rb1 = ld_chunk<TN, BKC>(B, ldb, 0, tid + NT);
  for (int k0 = 0; k0 < K; k0 += 64) {
    __syncthreads();
    st_chunk<TM, AKC>(As, ra0, tid);
    if (TM == 128) st_chunk<TM, AKC>(As, ra1, tid + NT);
    st_chunk<TN, BKC>(Bs, rb0, tid);
    if (TN == 128) st_chunk<TN, BKC>(Bs, rb1, tid + NT);
    __syncthreads();
    if (k0 + 64 < K) {
      ra0 = ld_chunk<TM, AKC>(A, lda, k0 + 64, tid);
      if (TM == 128) ra1 = ld_chunk<TM, AKC>(A, lda, k0 + 64, tid + NT);
      rb0 = ld_chunk<TN, BKC>(B, ldb, k0 + 64, tid);
      if (TN == 128) rb1 = ld_chunk<TN, BKC>(B, ldb, k0 + 64, tid + NT);
    }
#pragma unroll
    for (int ks = 0; ks < 2; ++ks) {
      bf16x8 af[MI], bfr[NI];
#pragma unroll
      for (int mi = 0; mi < MI; ++mi) af[mi] = ld_frag<TM, AKC>(As, wm * (TM / 2) + mi * 16, ks, fr, fq);
#pragma unroll
      for (int ni = 0; ni < NI; ++ni) bfr[ni] = ld_frag<TN, BKC>(Bs, wn * (TN / 4) + ni * 16, ks, fr, fq);
#pragma unroll
      for (int mi = 0; mi < MI; ++mi)
#pragma unroll
        for (int ni = 0; ni < NI; ++ni)
          acc[mi][ni] = TR ? __builtin_amdgcn_mfma_f32_16x16x32_bf16(bfr[ni], af[mi], acc[mi][ni], 0, 0, 0)
                           : __builtin_amdgcn_mfma_f32_16x16x32_bf16(af[mi], bfr[ni], acc[mi][ni], 0, 0, 0);
    }
  }
  __syncthreads();
}

template <int TM, int TN, bool TR, class F>
__device__ __forceinline__ void epi_each(f32x4 (&acc)[TM / 32][TN / 64], F f) {
  const int tid = TID(), lane = tid & 63, wid = tid >> 6;
  const int wm = wid >> 2, wn = wid & 3, fr = lane & 15, fq = lane >> 4;
#pragma unroll
  for (int mi = 0; mi < TM / 32; ++mi)
#pragma unroll
    for (int ni = 0; ni < TN / 64; ++ni) {
      const int r0 = wm * (TM / 2) + mi * 16, c0 = wn * (TN / 4) + ni * 16;
      if (TR) f(r0 + fr, c0 + fq * 4, acc[mi][ni]);
      else f(r0 + fq * 4, c0 + fr, acc[mi][ni]);
    }
}

struct EpiStoreBf16 {
  static constexpr bool PERM = false, AFTER_DRAIN = false;
  u16* O; int ldc;
  __device__ __forceinline__ void operator()(const f32x4 (&acc)[2][2][4][2], const pg8::Unit& u, int wr, int wc, int fr, int fq) const {
    const int row0 = u.pm * 256 + wr * 64 + fr, col0 = u.pn * 256 + wc * 32 + 4 * fq;
#pragma unroll
    for (int ai = 0; ai < 2; ++ai)
#pragma unroll
      for (int m = 0; m < 4; ++m) {
        u16* rowp = O + (size_t)(row0 + ai * 128 + m * 16) * ldc + col0;
#pragma unroll
        for (int bj = 0; bj < 2; ++bj)
#pragma unroll
          for (int n = 0; n < 2; ++n) {
            const f32x4 v = acc[ai][bj][m][n];
            *(uint2*)(rowp + bj * 128 + n * 16) = make_uint2(pack2(v[0], v[1]), pack2(v[2], v[3]));
          }
      }
  }
};
struct EpiResid {
  static constexpr bool PERM = false, AFTER_DRAIN = false;
  float* X; const float* mod; int goff; int slab;
  __device__ __forceinline__ void operator()(const f32x4 (&acc)[2][2][4][2], const pg8::Unit& u, int wr, int wc, int fr, int fq) const {
    const int row0 = u.pm * 256 + wr * 64 + fr, col0 = u.pn * 256 + wc * 32 + 4 * fq;
    const float* g = mod + (size_t)gb_of(slab, u.pm * 256) * 6144 + goff + col0;
    f32x4 gv[2][2];
#pragma unroll
    for (int bj = 0; bj < 2; ++bj)
#pragma unroll
      for (int n = 0; n < 2; ++n) gv[bj][n] = *(const f32x4*)(g + bj * 128 + n * 16);
#pragma unroll
    for (int am = 0; am < 4; ++am) {
      f32x4 xv[2][2][2];
#pragma unroll
      for (int mm = 0; mm < 2; ++mm)
#pragma unroll
        for (int bj = 0; bj < 2; ++bj)
#pragma unroll
          for (int n = 0; n < 2; ++n) xv[mm][bj][n] = *(const f32x4*)(X + (size_t)(row0 + (am >> 1) * 128 + ((am & 1) * 2 + mm) * 16) * D + col0 + bj * 128 + n * 16);
#pragma unroll
      for (int mm = 0; mm < 2; ++mm)
#pragma unroll
        for (int bj = 0; bj < 2; ++bj)
#pragma unroll
          for (int n = 0; n < 2; ++n)
            *(f32x4*)(X + (size_t)(row0 + (am >> 1) * 128 + ((am & 1) * 2 + mm) * 16) * D + col0 + bj * 128 + n * 16) = xv[mm][bj][n] + gv[bj][n] * acc[am >> 1][bj][(am & 1) * 2 + mm][n];
    }
  }
};
struct EpiFfnVal {
  static constexpr bool PERM = false, AFTER_DRAIN = false;
  const u16* G; u16* ACT; const float* cw; const float* cb; int L;
  __device__ __forceinline__ void operator()(const f32x4 (&acc)[2][2][4][2], const pg8::Unit& u, int wr, int wc, int fr, int fq) const {
    const int row0 = u.pm * 256 + wr * 64 + fr, col0 = u.pn * 256 + wc * 32 + 4 * fq;
#pragma unroll
    for (int bj = 0; bj < 2; ++bj)
#pragma unroll
      for (int n = 0; n < 2; ++n) {
        const int c = col0 + bj * 128 + n * 16;
        const f32x4 w0 = *(const f32x4*)(cw + c), w1 = *(const f32x4*)(cw + DFF + c), w2 = *(const f32x4*)(cw + 2 * DFF + c), bb = *(const f32x4*)(cb + c);
#pragma unroll
        for (int ai = 0; ai < 2; ++ai) {
          uint2 g0[4], g1[4], g2[4];
#pragma unroll
          for (int m = 0; m < 4; ++m) {
            const int r = row0 + ai * 128 + m * 16;
            const int pos = r & (L - 1);
            const u16* gp = G + (size_t)r * DFF + c;
            g1[m] = *(const uint2*)gp;
            g0[m] = *(const uint2*)(gp - (pos > 0 ? DFF : 0));
            g2[m] = *(const uint2*)(gp + (pos < L - 1 ? DFF : 0));
          }
#pragma unroll
          for (int m = 0; m < 4; ++m) {
            const int r = row0 + ai * 128 + m * 16;
            const int pos = r & (L - 1);
            const float m0 = pos > 0 ? 1.f : 0.f, m2 = pos < L - 1 ? 1.f : 0.f;
            const uint2 a0 = g0[m], a1 = g1[m], a2 = g2[m];
            f32x4 a;
            a[0] = m0 * bf2f((u16)(a0.x & 0xffff)) * w0[0] + bf2f((u16)(a1.x & 0xffff)) * w1[0] + m2 * bf2f((u16)(a2.x & 0xffff)) * w2[0] + bb[0];
            a[1] = m0 * bf2f((u16)(a0.x >> 16)) * w0[1] + bf2f((u16)(a1.x >> 16)) * w1[1] + m2 * bf2f((u16)(a2.x >> 16)) * w2[1] + bb[1];
            a[2] = m0 * bf2f((u16)(a0.y & 0xffff)) * w0[2] + bf2f((u16)(a1.y & 0xffff)) * w1[2] + m2 * bf2f((u16)(a2.y & 0xffff)) * w2[2] + bb[2];
            a[3] = m0 * bf2f((u16)(a0.y >> 16)) * w0[3] + bf2f((u16)(a1.y >> 16)) * w1[3] + m2 * bf2f((u16)(a2.y >> 16)) * w2[3] + bb[3];
            const f32x4 v = acc[ai][bj][m][n];
            *(uint2*)(ACT + (size_t)r * DFF + c) = make_uint2(pack2(silu_f(a[0]) * v[0], silu_f(a[1]) * v[1]), pack2(silu_f(a[2]) * v[2], silu_f(a[3]) * v[3]));
          }
        }
      }
  }
};
template <class Epi>
__device__ __forceinline__ void run_gemm(const u16* A, const u16* Bt, int N, int K, const Epi& E) {
  pg8::Gemm g; g.A = A; g.Bt = Bt; g.M = SLAB; g.N = N; g.K = K;
  pg8::StaticOrder S; S.init(SLAB, N, gridDim.x, BID());
  __syncthreads();
  pg8::gemm_phase<Epi, pg8::StaticOrder, false>((PG8_LAS unsigned char*)smem, g, S, E, nullptr);
  __syncthreads();
}

template <int N>
__device__ __forceinline__ void fft_dif_t(float2* x, const float2* __restrict__ tw) {
  const int tid = TID();
  constexpr int IT = N / 2 / NT;
#pragma unroll 1
  for (int s = N >> 1; s >= 1; s >>= 1) {
    const int tws = 8192 / s;
    const float2 w0 = tw[(tid & (s - 1)) * tws];
#pragma unroll
    for (int it = 0; it < IT; ++it) {
      const int i = tid + it * NT;
      const int j = i & (s - 1);
      const int p = ((i - j) << 1) + j;
      float2 w = w0;
      if (s >= 1024) {
        const float2 wu = tw[((it * NT) & (s - 1)) * tws];
        w = make_float2(w0.x * wu.x - w0.y * wu.y, w0.x * wu.y + w0.y * wu.x);
      }
      float2 a = x[p], b = x[p + s];
      x[p] = make_float2(a.x + b.x, a.y + b.y);
      float dx = a.x - b.x, dy = a.y - b.y;
      x[p + s] = make_float2(dx * w.x - dy * w.y, dx * w.y + dy * w.x);
    }
    __syncthreads();
  }
}
template <int N>
__device__ __forceinline__ void ifft_dit_t(float2* x, const float2* __restrict__ tw) {
  const int tid = TID();
  constexpr int IT = N / 2 / NT;
#pragma unroll 1
  for (int s = 1; s < N; s <<= 1) {
    const int tws = 8192 / s;
    const float2 w0 = tw[(tid & (s - 1)) * tws];
#pragma unroll
    for (int it = 0; it < IT; ++it) {
      const int i = tid + it * NT;
      const int j = i & (s - 1);
      const int p = ((i - j) << 1) + j;
      float2 w = w0;
      if (s >= 1024) {
        const float2 wu = tw[((it * NT) & (s - 1)) * tws];
        w = make_float2(w0.x * wu.x - w0.y * wu.y, w0.x * wu.y + w0.y * wu.x);
      }
      float2 a = x[p], b = x[p + s];
      float bx = b.x * w.x + b.y * w.y, by = b.y * w.x - b.x * w.y;
      x[p] = make_float2(a.x + bx, a.y + by);
      x[p + s] = make_float2(a.x - bx, a.y - by);
    }
    __syncthreads();
  }
}
__device__ __forceinline__ void fft_dif(float2* x, int N, const float2* __restrict__ tw) {
  if (N == 16384) fft_dif_t<16384>(x, tw); else fft_dif_t<4096>(x, tw);
}
__device__ __forceinline__ void ifft_dit(float2* x, int N, const float2* __restrict__ tw) {
  if (N == 16384) ifft_dit_t<16384>(x, tw); else ifft_dit_t<4096>(x, tw);
}

__device__ void transpose_w(const float* __restrict__ W, u16* __restrict__ Wt, int K, int N) {
  float* smf = (float*)smem;
  const int tk = K / 64, tn = N / 64, tid = TID();
  for (int item = BID(); item < tk * tn; item += gridDim.x) {
    const int k0 = (item / tn) * 64, n0 = (item % tn) * 64;
    __syncthreads();
    for (int i = tid; i < 4096; i += NT) {
      int kk = i >> 6, nn = i & 63;
      smf[kk * 65 + nn] = W[(long)(k0 + kk) * N + n0 + nn];
    }
    __syncthreads();
    for (int i = tid; i < 4096; i += NT) {
      int nn = i >> 6, kk = i & 63;
      Wt[(long)(n0 + nn) * K + k0 + kk] = f2bf(smf[kk * 65 + nn]);
    }
  }
  __syncthreads();
}

__device__ void phase_pre0(const Params& P) {
  const int tid = TID();
  const long gtid = (long)BID() * NT + tid, gsz = (long)gridDim.x * NT;
  {
    const float4* s0 = (const float4*)P.in[0];
    const float4* s1 = (const float4*)P.in[1];
    float4* o = (float4*)OUTP(P);
    const long n0 = (long)16384 * 1024 / 4, n1 = (long)65536 * 1024 / 4;
    for (long i = gtid; i < n0; i += gsz) o[i] = s0[i];
    for (long i = gtid; i < n1; i += gsz) o[n0 + i] = s1[i];
  }
  transpose_w(P.in[7], (u16*)(WS(P) + O_WHYIN), 1024, 3072);
  transpose_w(P.in[18], (u16*)(WS(P) + O_WHYOUT), 1024, 1024);
  transpose_w(P.in[19], (u16*)(WS(P) + O_WRETIN), 1024, 6144);
  transpose_w(P.in[21], (u16*)(WS(P) + O_WRETOUT), 2048, 1024);
  transpose_w(P.in[22], (u16*)(WS(P) + O_WSWAIN), 1024, 1536);
  transpose_w(P.in[26], (u16*)(WS(P) + O_WSWAOUT), 1024, 1024);
  transpose_w(P.in[27], (u16*)(WS(P) + O_WHGIN), 1024, 5120);
  transpose_w(P.in[30], (u16*)(WS(P) + O_WHGOUT), 1024, 1024);
  for (int l = 0; l < 4; ++l) {
    transpose_w(P.in[31] + (long)l * 1024 * DFF, (u16*)(WS(P) + O_WFG) + (long)l * DFF * 1024, 1024, DFF);
    transpose_w(P.in[32] + (long)l * 1024 * DFF, (u16*)(WS(P) + O_WFV) + (long)l * DFF * 1024, 1024, DFF);
    transpose_w(P.in[35] + (long)l * DFF * 1024, (u16*)(WS(P) + O_WFD) + (long)l * 1024 * DFF, DFF, 1024);
  }
  {
    float* cs = (float*)smem;
    float* modp = (float*)(WS(P) + O_MODP);
    for (int item = BID(); item < 4 * 8 * 12; item += gridDim.x) {
      const int nb = item % 12, ks = (item / 12) % 8, l = item / 96;
      __syncthreads();
      for (int i = tid; i < 2048; i += NT) {
        int b = i >> 7, k = i & 127;
        float c = (b < 8) ? P.in[2][b * 1024 + ks * 128 + k] : P.in[3][(b - 8) * 1024 + ks * 128 + k];
        cs[i] = c / (1.f + expf(-c));
      }
      __syncthreads();
      const int n = nb * 512 + tid;
      float a[16];
#pragma unroll
      for (int b = 0; b < 16; ++b) a[b] = 0.f;
      const float* w = P.in[4] + ((long)l * 1024 + ks * 128) * 6144 + n;
      for (int k = 0; k < 128; ++k) {
        float wv = w[(long)k * 6144];
#pragma unroll
        for (int b = 0; b < 16; ++b) a[b] += cs[b * 128 + k] * wv;
      }
#pragma unroll
      for (int b = 0; b < 16; ++b) modp[(((long)ks * 4 + l) * 16 + b) * 6144 + n] = a[b];
    }
    __syncthreads();
  }
  {
    float2* tw = (float2*)(WS(P) + O_TW);
    for (long i = gtid; i < 8192; i += gsz) {
      float s, c;
      sincospif((float)i * (1.f / 8192.f), &s, &c);
      tw[i] = make_float2(c, -s);
    }
    float2* rr = (float2*)(WS(P) + O_ROPER);
    for (long i = gtid; i < (long)8192 * 128; i += gsz) {
      int pos = (int)(i >> 7), d = (int)(i & 127);
      float inv = exp2f(-(float)d * (13.287712379549449f / 128.f));
      float s, c;
      sincosf((float)pos * inv, &s, &c);
      rr[i] = make_float2(c, s);
    }
    float2* rs = (float2*)(WS(P) + O_ROPES);
    for (long i = gtid; i < (long)8192 * 32; i += gsz) {
      int pos = (int)(i >> 5), d = (int)(i & 31);
      float inv = exp2f(-(float)d * (13.287712379549449f / 32.f));
      float s, c;
      sincosf((float)pos * inv, &s, &c);
      rs[i] = make_float2(c, s);
    }
  }
  {
    float* zf = (float*)smem;
    float* h1 = zf + 8 * 36;
    const float* w1 = P.in[10]; const float* b1 = P.in[11]; const float* w2 = P.in[12]; const float* b2 = P.in[13];
    const float* fr = P.in[15];
    const int tl = tid >> 6, j = tid & 63;
    for (int item = BID(); item < 1280; item += gridDim.x) {
      const int sel = item >= 1024;
      const int L = sel ? 2048 : 8192;
      const int t = (sel ? item - 1024 : item) * 8 + tl;
      float* hid = (float*)(WS(P) + (sel ? O_HIDP : O_HIDS));
      __syncthreads();
      if (j < 33) {
        float v;
        if (j == 0) v = (float)t / (float)(L - 1);
        else {
          int i = (j - 1) & 15;
          float band = 1e-4f + (float)i * ((15.f - 1e-4f) / 15.f);
          float ang = (6.283185307179586f / (float)L) * (float)t;
          float a = band * ang;
          v = (j <= 16) ? cosf(a) : -sinf(a);
        }
        zf[tl * 36 + j] = v;
      }
      __syncthreads();
      float s = b1[j];
#pragma unroll 3
      for (int i = 0; i < 33; ++i) s += zf[tl * 36 + i] * w1[i * 64 + j];
      h1[tl * 64 + j] = sinf(fr[j] * s);
      __syncthreads();
      float s2 = b2[j];
#pragma unroll 4
      for (int i = 0; i < 64; ++i) s2 += h1[tl * 64 + i] * w2[i * 64 + j];
      hid[(long)t * 64 + j] = sinf(fr[j] * s2);
    }
    __syncthreads();
  }
}

__device__ void phase_pre1(const Params& P) {
  __shared__ float w3s[128];
  __shared__ float red[8];
  const int tid = TID(), lane = tid & 63, wid = tid >> 6;
  const long gtid = (long)BID() * NT + tid, gsz = (long)gridDim.x * NT;
  {
    const float* modp = (const float*)(WS(P) + O_MODP);
    float* mod = (float*)(WS(P) + O_MOD);
    for (long i = gtid; i < (long)4 * 16 * 6144; i += gsz) {
      int n = (int)(i % 6144);
      int l = (int)(i / (16 * 6144));
      float s = P.in[5][l * 6144 + n];
      for (int ks = 0; ks < 8; ++ks) s += modp[(long)ks * 4 * 16 * 6144 + i];
      mod[i] = s;
    }
  }
  float2* buf = (float2*)smem;
  const float2* tw = (const float2*)(WS(P) + O_TW);
  for (int item = BID(); item < 2048; item += gridDim.x) {
    const int sel = item >> 10, c = item & 1023;
    const int L = sel ? 2048 : 8192, N = 2 * L;
    const float* hid = (const float*)(WS(P) + (sel ? O_HIDP : O_HIDS));
    float2* hs = (float2*)(WS(P) + (sel ? O_HSPP : O_HSPS)) + (long)c * N;
    __syncthreads();
    if (tid < 128) {
      int dirn = tid >> 6, j = tid & 63;
      w3s[tid] = P.in[14][(long)j * 2048 + dirn * 1024 + c];
    }
    __syncthreads();
    const float dec0 = fabsf(P.in[16][c]), dec1 = fabsf(P.in[16][1024 + c]);
    const float invLm1 = 1.f / (float)(L - 1);
    float asum = 0.f;
    for (int n = tid; n < N; n += NT) {
      float val = 0.f;
      if (n != L) {
        const int dirn = n < L ? 0 : 1;
        const int t = n < L ? n : N - n;
        const float4* hr = (const float4*)(hid + (long)t * 64);
        const float* w = w3s + dirn * 64;
        float s = 0.f;
#pragma unroll
        for (int q = 0; q < 16; ++q) {
          float4 h4 = hr[q];
          s += h4.x * w[4 * q] + h4.y * w[4 * q + 1] + h4.z * w[4 * q + 2] + h4.w * w[4 * q + 3];
        }
        float tl = (float)t * invLm1;
        val = s * expf(-tl * (dirn ? dec1 : dec0));
      }
      buf[n] = make_float2(val, 0.f);
      asum += fabsf(val);
    }
    asum = wave_sum(asum);
    if (lane == 0) red[wid] = asum;
    __syncthreads();
    float tot = 0.f;
#pragma unroll
    for (int w = 0; w < 8; ++w) tot += red[w];
    const float scale = 1.f / (tot * (float)N);
    fft_dif(buf, N, tw);
    for (int p = tid; p < N; p += NT) {
      float2 a = buf[p];
      hs[p] = make_float2(a.x * scale, a.y * scale);
    }
  }
  __syncthreads();
}

__device__ void phase_norm(const Params& P, int layer, int slab, int which) {
  const float* x = OUTP(P) + (long)slab * SLAB * D;
  u16* h = (u16*)(WS(P) + O_HBUF);
  const float* gain = P.in[6] + (layer * 2 + which) * D;
  const float* mod = (const float*)(WS(P) + O_MOD) + (long)layer * 16 * 6144;
  const int shoff = which ? 3 * D : 0, scoff = which ? 4 * D : D;
  const int tid = TID(), lane = tid & 63, wid = tid >> 6;
  for (int item = BID(); item < SLAB / 8; item += gridDim.x) {
    const int r = item * 8 + wid;
    const float* xr = x + (long)r * D;
    float4 v[4];
    float ss = 0.f;
#pragma unroll
    for (int i = 0; i < 4; ++i) {
      v[i] = *(const float4*)(xr + i * 256 + lane * 4);
      ss += v[i].x * v[i].x + v[i].y * v[i].y + v[i].z * v[i].z + v[i].w * v[i].w;
    }
    ss = wave_sum(ss);
    const float rstd = rsqrtf(ss * (1.f / 1024.f) + 1e-6f);
    const float* m = mod + (long)gb_of(slab, r) * 6144;
#pragma unroll
    for (int i = 0; i < 4; ++i) {
      const int col = i * 256 + lane * 4;
      float4 g = *(const float4*)(gain + col);
      float4 sc = *(const float4*)(m + scoff + col);
      float4 sh = *(const float4*)(m + shoff + col);
      float y0 = v[i].x * rstd * g.x * (1.f + sc.x) + sh.x;
      float y1 = v[i].y * rstd * g.y * (1.f + sc.y) + sh.y;
      float y2 = v[i].z * rstd * g.z * (1.f + sc.z) + sh.z;
      float y3 = v[i].w * rstd * g.w * (1.f + sc.w) + sh.w;
      uint2 o = make_uint2(pack2(y0, y1), pack2(y2, y3));
      *(uint2*)(h + (long)r * D + col) = o;
    }
  }
}

__device__ void phase_proj(const Params& P, size_t woff, int N) {
  EpiStoreBf16 E; E.O = (u16*)(WS(P) + O_PROJ); E.ldc = N;
  run_gemm((const u16*)(WS(P) + O_HBUF), (const u16*)(WS(P) + woff), N, D, E);
}
__device__ void phase_resid(const Params& P, int layer, int slab, const u16* A, int K, size_t woff, int goff) {
  EpiResid E; E.X = OUTP(P) + (long)slab * SLAB * D; E.mod = (const float*)(WS(P) + O_MOD) + (long)layer * 16 * 6144; E.goff = goff; E.slab = slab;
  run_gemm(A, (const u16*)(WS(P) + woff), D, K, E);
}

__device__ void phase_ffn_gate(const Params& P, int layer) {
  EpiStoreBf16 E; E.O = (u16*)(WS(P) + O_GBUF); E.ldc = DFF;
  run_gemm((const u16*)(WS(P) + O_HBUF), (const u16*)(WS(P) + O_WFG) + (long)layer * DFF * D, DFF, D, E);
}
__device__ void phase_ffn_val(const Params& P, int layer, int slab) {
  EpiFfnVal E; E.G = (const u16*)(WS(P) + O_GBUF); E.ACT = (u16*)(WS(P) + O_ACT);
  E.cw = P.in[33] + (long)layer * 3 * DFF; E.cb = P.in[34] + (long)layer * DFF; E.L = Lof(slab);
  run_gemm((const u16*)(WS(P) + O_HBUF), (const u16*)(WS(P) + O_WFV) + (long)layer * DFF * D, DFF, D, E);
}

__device__ void phase_hy_conv(const Params& P, int slab) {
  const int L = Lof(slab), nseq = SLAB / L, tid = TID();
  const u16* z = (const u16*)(WS(P) + O_PROJ);
  float* uT = (float*)(WS(P) + O_UT);
  u16* x0c = (u16*)(WS(P) + O_X0C);
  const float* cw = P.in[8];
  const float* cb = P.in[9];
  float* tile = (float*)smem;
  const int ntt = L / 64;
  const int nitems = nseq * ntt * 16;
  for (int item = BID(); item < nitems; item += gridDim.x) {
    const int ct = item % 16, tt = (item / 16) % ntt, seq = item / (16 * ntt);
    __syncthreads();
    for (int i = tid; i < 4096; i += NT) {
      const int tl = i >> 6, cl = i & 63;
      const int t = tt * 64 + tl, c = ct * 64 + cl;
      const long row = (long)seq * L + t;
      float val[3];
#pragma unroll
      for (int q = 0; q < 3; ++q) {
        const int col = q * 1024 + c;
        float a = bf2f(z[row * 3072 + col]) * cw[3072 + col] + cb[col];
        if (t > 0) a += bf2f(z[(row - 1) * 3072 + col]) * cw[col];
        if (t < L - 1) a += bf2f(z[(row + 1) * 3072 + col]) * cw[2 * 3072 + col];
        val[q] = a;
      }
      x0c[row * 1024 + c] = f2bf(val[0]);
      tile[tl * 65 + cl] = val[1] * val[2];
    }
    __syncthreads();
    for (int i = tid; i < 4096; i += NT) {
      const int cl = i >> 6, tl = i & 63;
      uT[((long)seq * 1024 + ct * 64 + cl) * L + tt * 64 + tl] = tile[tl * 65 + cl];
    }
  }
  __syncthreads();
}

__device__ void phase_hy_fft(const Params& P, int slab, bool dry = false) {
  const int L = Lof(slab), N = 2 * L, nseq = SLAB / L, tid = TID();
  float* uT = (float*)(WS(P) + O_UT);
  const float2* hsb = (const float2*)(WS(P) + (slab == 0 ? O_HSPP : O_HSPS));
  const float2* tw = (const float2*)(WS(P) + O_TW);
  const float* skip = P.in[17];
  float2* buf = (float2*)smem;
  const int nitems = (nseq / 2) * 1024;
  for (int item = BID(); item < nitems; item += gridDim.x) {
    const int pr = item >> 10, c = item & 1023;
    float* u0 = uT + ((long)(pr * 2) * 1024 + c) * L;
    float* u1 = u0 + (long)1024 * L;
    __syncthreads();
    for (int t = tid; t < L; t += NT) {
      buf[t] = make_float2(u0[t], u1[t]);
      buf[t + L] = make_float2(0.f, 0.f);
    }
    __syncthreads();
    fft_dif(buf, N, tw);
    const float2* h = hsb + (long)c * N;
    for (int p = tid; p < N; p += NT) {
      float2 a = buf[p], b = h[p];
      buf[p] = make_float2(a.x * b.x - a.y * b.y, a.x * b.y + a.y * b.x);
    }
    __syncthreads();
    ifft_dit(buf, N, tw);
    const float sk = skip[c];
    for (int t = tid; t < L; t += NT) {
      float2 y = buf[t];
      const long doff = dry ? (long)(END_HY - O_UT) / 4 : 0;
      u0[t + doff] = y.x + u0[t] * sk;
      u1[t + doff] = y.y + u1[t] * sk;
    }
  }
  __syncthreads();
}

__device__ void phase_hy_tr(const Params& P, int slab) {
  const int L = Lof(slab), nseq = SLAB / L, tid = TID();
  const float* yT = (const float*)(WS(P) + O_UT);
  const u16* x0c = (const u16*)(WS(P) + O_X0C);
  u16* a2 = (u16*)(WS(P) + O_A2);
  float* tile = (float*)smem;
  const int ntt = L / 64;
  const int nitems = nseq * ntt * 16;
  for (int item = BID(); item < nitems; item += gridDim.x) {
    const int ct = item % 16, tt = (item / 16) % ntt, seq = item / (16 * ntt);
    __syncthreads();
    for (int i = tid; i < 4096; i += NT) {
      const int cl = i >> 6, tl = i & 63;
      tile[cl * 65 + tl] = yT[((long)seq * 1024 + ct * 64 + cl) * L + tt * 64 + tl];
    }
    __syncthreads();
    for (int i = tid; i < 4096; i += NT) {
      const int tl = i >> 6, cl = i & 63;
      const long row = (long)seq * L + tt * 64 + tl;
      const int c = ct * 64 + cl;
      a2[row * 1024 + c] = f2bf(tile[cl * 65 + tl] * bf2f(x0c[row * 1024 + c]));
    }
  }
  __syncthreads();
}

struct Rec {
  int H, DK, DV, C;
  int ldv, voff, goff;
};
__device__ __forceinline__ Rec rec_of(int kind) {
  Rec r;
  if (kind == 1) { r.H = 4; r.DK = 256; r.DV = 512; r.C = 128; r.ldv = 6144; r.voff = 2048; r.goff = 4096; }
  else { r.H = 8; r.DK = 128; r.DV = 128; r.C = 64; r.ldv = 5120; r.voff = 1024; r.goff = 4096; }
  return r;
}

__device__ void phase_ret_prep(const Params& P, int slab) {
  const int L = Lof(slab);
  const u16* pj = (const u16*)(WS(P) + O_PROJ);
  u16* qdf = (u16*)(WS(P) + O_QDF); u16* qdb = (u16*)(WS(P) + O_QDB);
  u16* kif = (u16*)(WS(P) + O_KIF); u16* kib = (u16*)(WS(P) + O_KIB);
  u16* kef = (u16*)(WS(P) + O_KEF); u16* keb = (u16*)(WS(P) + O_KEB);
  float* dlf = (float*)(WS(P) + O_DLF); float* dlb = (float*)(WS(P) + O_DLB);
  const float2* rope = (const float2*)(WS(P) + O_ROPER);
  const long gtid = (long)BID() * NT + TID(), gsz = (long)gridDim.x * NT;
  for (long idx = gtid; idx < (long)SLAB * 512; idx += gsz) {
    const int d = (int)(idx & 127), h = (int)((idx >> 7) & 3), t = (int)(idx >> 9);
    const int pos = t & (L - 1), r = t & 127;
    const float lgf = -expf(P.in[20][h]), lgb = -expf(P.in[20][4 + h]);
    const u16* row = pj + (long)t * 6144;
    const float q1 = bf2f(row[h * 256 + d]), q2 = bf2f(row[h * 256 + d + 128]);
    const float k1 = bf2f(row[1024 + h * 256 + d]), k2 = bf2f(row[1024 + h * 256 + d + 128]);
    const float2 cs = rope[(long)pos * 128 + d];
    const float qa = q1 * cs.x - q2 * cs.y, qb = q1 * cs.y + q2 * cs.x;
    const float ka = (k1 * cs.x - k2 * cs.y) * 0.0625f, kb = (k1 * cs.y + k2 * cs.x) * 0.0625f;
    const float bf = (float)(r + 1) * lgf, bb = (float)(128 - r) * lgb;
    const float ef = expf(bf), eif = expf(-bf), eef = expf((float)(127 - r) * lgf);
    const float eb = expf(bb), eib = expf(-bb), eeb = expf((float)r * lgb);
    const long o1 = (long)t * 1024 + h * 256 + d, o2 = o1 + 128;
    qdf[o1] = f2bf(qa * ef); qdf[o2] = f2bf(qb * ef);
    qdb[o1] = f2bf(qa * eb); qdb[o2] = f2bf(qb * eb);
    kif[o1] = f2bf(ka * eif); kif[o2] = f2bf(kb * eif);
    kib[o1] = f2bf(ka * eib); kib[o2] = f2bf(kb * eib);
    kef[o1] = f2bf(ka * eef); kef[o2] = f2bf(kb * eef);
    keb[o1] = f2bf(ka * eeb); keb[o2] = f2bf(kb * eeb);
    if (r == 0) {
      const long cgi = (long)(t >> 7) * 1024 + h * 256 + d;
      const float df = expf(128.f * lgf), db = expf(128.f * lgb);
      dlf[cgi] = df; dlf[cgi + 128] = df;
      dlb[cgi] = db; dlb[cgi + 128] = db;
    }
  }
}

__device__ void phase_hg_prep(const Params& P) {
  const u16* pj = (const u16*)(WS(P) + O_PROJ);
  u16* qdf = (u16*)(WS(P) + O_QDF); u16* qdb = (u16*)(WS(P) + O_QDB);
  u16* kif = (u16*)(WS(P) + O_KIF); u16* kib = (u16*)(WS(P) + O_KIB);
  u16* kef = (u16*)(WS(P) + O_KEF); u16* keb = (u16*)(WS(P) + O_KEB);
  float* dlf = (float*)(WS(P) + O_DLF); float* dlb = (float*)(WS(P) + O_DLB);
  const float* lbt = P.in[28];
  float* totF = (float*)smem;
  float* totB = totF + 512;
  const int tid = TID(), lane = tid & 63, rg = tid >> 6;
  for (int item = BID(); item < 4096; item += gridDim.x) {
    const int cgi = item >> 4, ch = (item & 15) * 64 + lane;
    float lb0, lb1;
    {
      float a0 = lbt[0 * 1024 + ch], a1 = lbt[1 * 1024 + ch], a2 = lbt[2 * 1024 + ch], a3 = lbt[3 * 1024 + ch];
      float m = fmaxf(fmaxf(a0, a1), fmaxf(a2, a3));
      float e0 = expf(a0 - m), e1 = expf(a1 - m), e2 = expf(a2 - m), e3 = expf(a3 - m);
      lb0 = (e0 + e1 + e2) / (e0 + e1 + e2 + e3);
      a0 = lbt[4 * 1024 + ch]; a1 = lbt[5 * 1024 + ch]; a2 = lbt[6 * 1024 + ch]; a3 = lbt[7 * 1024 + ch];
      m = fmaxf(fmaxf(a0, a1), fmaxf(a2, a3));
      e0 = expf(a0 - m); e1 = expf(a1 - m); e2 = expf(a2 - m); e3 = expf(a3 - m);
      lb1 = (e0 + e1 + e2) / (e0 + e1 + e2 + e3);
    }
    const long t0 = (long)cgi * 64 + rg * 8;
    float xq[8], xf[8], xb[8];
#pragma unroll
    for (int i = 0; i < 8; ++i) {
      const u16* row = pj + (t0 + i) * 5120;
      xq[i] = bf2f(row[ch]); xf[i] = bf2f(row[2048 + ch]); xb[i] = bf2f(row[3072 + ch]);
    }
    float pf[8], sb[8];
    float accf = 0.f;
#pragma unroll
    for (int i = 0; i < 8; ++i) { accf += logf(lb0 + (1.f - lb0) * sigm(xf[i])); pf[i] = accf; }
    float accb = 0.f;
#pragma unroll
    for (int i = 7; i >= 0; --i) { accb += logf(lb1 + (1.f - lb1) * sigm(xb[i])); sb[i] = accb; }
    __syncthreads();
    totF[rg * 64 + lane] = accf;
    totB[rg * 64 + lane] = accb;
    __syncthreads();
    float offF = 0.f, offB = 0.f, totf = 0.f, totb = 0.f;
#pragma unroll
    for (int g = 0; g < 8; ++g) {
      const float f = totF[g * 64 + lane], bq = totB[g * 64 + lane];
      totf += f; totb += bq;
      if (g < rg) offF += f;
      if (g > rg) offB += bq;
    }
#pragma unroll
    for (int i = 0; i < 8; ++i) {
      const float q = silu_f(xq[i]);
      const float bf = offF + pf[i], bb = offB + sb[i];
      const float kf = (1.f - lb0) * sigm(-xf[i]), kb = (1.f - lb1) * sigm(-xb[i]);
      const long o = (t0 + i) * 1024 + ch;
      qdf[o] = f2bf(q * expf(bf));
      kif[o] = f2bf(kf * expf(-bf));
      kef[o] = f2bf(kf * expf(totf - bf));
      qdb[o] = f2bf(q * expf(bb));
      kib[o] = f2bf(kb * expf(-bb));
      keb[o] = f2bf(kb * expf(totb - bb));
    }
    if (rg == 0) {
      dlf[(long)cgi * 1024 + ch] = expf(totf);
      dlb[(long)cgi * 1024 + ch] = expf(totb);
    }
  }
  __syncthreads();
}

template <int C>
__device__ __forceinline__ void rec_scores_item(const Params& P, const Rec& R, int cgi, int h) {
  const u16* qdf = (const u16*)(WS(P) + O_QDF); const u16* qdb = (const u16*)(WS(P) + O_QDB);
  const u16* kif = (const u16*)(WS(P) + O_KIF); const u16* kib = (const u16*)(WS(P) + O_KIB);
  u16* sc = (u16*)(WS(P) + O_SC) + ((long)cgi * R.H + h) * C * C;
  const long off = (long)cgi * C * 1024 + h * R.DK;
  f32x4 af[C / 32][C / 64] = {}, ab[C / 32][C / 64] = {};
  gemm_acc<C, C, true, true, true>(af, qdf + off, 1024, kif + off, 1024, R.DK, (u16*)smem);
  gemm_acc<C, C, true, true, true>(ab, qdb + off, 1024, kib + off, 1024, R.DK, (u16*)smem);
  const int tid = TID(), lane = tid & 63, wid = tid >> 6;
  const int wm = wid >> 2, wn = wid & 3, fr = lane & 15, fq = lane >> 4;
#pragma unroll
  for (int mi = 0; mi < C / 32; ++mi)
#pragma unroll
    for (int ni = 0; ni < C / 64; ++ni) {
      const int r = wm * (C / 2) + mi * 16 + fr, c0 = wn * (C / 4) + ni * 16 + fq * 4;
      float v[4];
#pragma unroll
      for (int j = 0; j < 4; ++j) {
        const int c = c0 + j;
        v[j] = (c <= r ? af[mi][ni][j] : 0.f) + (c >= r ? ab[mi][ni][j] : 0.f);
      }
      *(uint2*)(sc + r * C + c0) = make_uint2(pack2(v[0], v[1]), pack2(v[2], v[3]));
    }
}

template <int C>
__device__ void phase_rec_su(const Params& P, int kind) {
  const Rec R = rec_of(kind);
  const int nch = SLAB / C;
  const int n_sc = nch * R.H;
  const int mtn = R.DK / 128, ntn = R.DV / 128;
  const int n_u = nch * R.H * 2 * mtn * ntn;
  const u16* pj = (const u16*)(WS(P) + O_PROJ);
  for (int item = BID(); item < n_sc + n_u; item += gridDim.x) {
    if (item < n_sc) {
      rec_scores_item<C>(P, R, item / R.H, item % R.H);
    } else {
      int q = item - n_sc;
      const int nt = q % ntn; q /= ntn;
      const int mt = q % mtn; q /= mtn;
      const int dir = q & 1; q >>= 1;
      const int h = q % R.H, cgi = q / R.H;
      const u16* ke = (const u16*)(WS(P) + (dir ? O_KEB : O_KEF)) + (long)cgi * C * 1024 + h * R.DK + mt * 128;
      const u16* v = pj + (long)cgi * C * R.ldv + R.voff + h * R.DV + nt * 128;
      u16* st = (u16*)(WS(P) + (dir ? O_STB : O_STF)) + (((long)cgi * R.H + h) * R.DV + nt * 128) * R.DK + mt * 128;
      f32x4 acc[4][2] = {};
      gemm_acc<128, 128, false, false, false>(acc, ke, 1024, v, R.ldv, C, (u16*)smem);
      const int DK = R.DK;
      epi_each<128, 128, false>(acc, [&](int r, int c, f32x4 val) {
        *(uint2*)(st + (long)c * DK + r) = make_uint2(pack2(val[0], val[1]), pack2(val[2], val[3]));
      });
    }
  }
}

__device__ void phase_rec_scan(const Params& P, int kind, int slab, bool dry = false) {
  const Rec R = rec_of(kind);
  const int L = Lof(slab), nseq = SLAB / L, ncs = L / R.C;
  const int hdk = R.DK / 2;
  const long per = (long)R.H * R.DV * hdk;
  const long total = 2 * nseq * per;
  const long gtid = (long)BID() * NT + TID(), gsz = (long)gridDim.x * NT;
  for (long idx = gtid; idx < total; idx += gsz) {
    long q = idx;
    const int pd = (int)(q % hdk); q /= hdk;
    const int e = (int)(q % R.DV); q /= R.DV;
    const int h = (int)(q % R.H); q /= R.H;
    const int seq = (int)(q % nseq);
    const int dir = (int)(q / nseq);
    u16* st = (u16*)(WS(P) + (dir ? O_STB : O_STF));
    u16* stw = dry ? (u16*)(WS(P) + O_OBUF) : st;
    const float* dl = (const float*)(WS(P) + (dir ? O_DLB : O_DLF));
    float s0 = 0.f, s1 = 0.f;
    const long ebase = ((long)h * R.DV + e) * R.DK + pd * 2;
    const long cstride = (long)R.H * R.DV * R.DK;
    const int dbase = h * R.DK + pd * 2;
    for (int i0 = 0; i0 < ncs; i0 += 8) {
      unsigned u[8];
      float2 dd[8];
#pragma unroll
      for (int j = 0; j < 8; ++j) {
        const int n = dir ? (ncs - 1 - i0 - j) : (i0 + j);
        const long cgi = (long)seq * ncs + n;
        u[j] = *(const unsigned*)(st + cgi * cstride + ebase);
        dd[j] = *(const float2*)(dl + cgi * 1024 + dbase);
      }
#pragma unroll
      for (int j = 0; j < 8; ++j) {
        const int n = dir ? (ncs - 1 - i0 - j) : (i0 + j);
        const long cgi = (long)seq * ncs + n;
        *(unsigned*)(stw + cgi * cstride + ebase) = pack2(s0, s1);
        s0 = dd[j].x * s0 + bf2f((u16)(u[j] & 0xffff));
        s1 = dd[j].y * s1 + bf2f((u16)(u[j] >> 16));
      }
    }
  }
}

template <int C>
__device__ void phase_rec_out(const Params& P, int kind) {
  const Rec R = rec_of(kind);
  const int nch = SLAB / C, ntn = R.DV / 128;
  const u16* pj = (const u16*)(WS(P) + O_PROJ);
  float* ob = (float*)(WS(P) + O_OBUF);
  const int HDV = R.H * R.DV;
  for (int item = BID(); item < nch * R.H * ntn; item += gridDim.x) {
    const int nt = item % ntn, h = (item / ntn) % R.H, cgi = item / (ntn * R.H);
    f32x4 acc[C / 32][2] = {};
    const u16* sc = (const u16*)(WS(P) + O_SC) + ((long)cgi * R.H + h) * C * C;
    const u16* v = pj + (long)cgi * C * R.ldv + R.voff + h * R.DV + nt * 128;
    gemm_acc<C, 128, true, false, true>(acc, sc, C, v, R.ldv, C, (u16*)smem);
    const long qoff = (long)cgi * C * 1024 + h * R.DK;
    const long soff = (((long)cgi * R.H + h) * R.DV + nt * 128) * R.DK;
    gemm_acc<C, 128, true, true, true>(acc, (const u16*)(WS(P) + O_QDF) + qoff, 1024, (const u16*)(WS(P) + O_STF) + soff, R.DK, R.DK, (u16*)smem);
    gemm_acc<C, 128, true, true, true>(acc, (const u16*)(WS(P) + O_QDB) + qoff, 1024, (const u16*)(WS(P) + O_STB) + soff, R.DK, R.DK, (u16*)smem);
    float* o = ob + (long)cgi * C * HDV + h * R.DV + nt * 128;
    epi_each<C, 128, true>(acc, [&](int r, int c, f32x4 val) { *(f32x4*)(o + (long)r * HDV + c) = val; });
  }
}

__device__ void phase_rec_ng(const Params& P, int kind) {
  const Rec R = rec_of(kind);
  const int HDV = R.H * R.DV;
  const float* ob = (const float*)(WS(P) + O_OBUF);
  const u16* pj = (const u16*)(WS(P) + O_PROJ);
  u16* a2 = (u16*)(WS(P) + O_A2);
  const float* gain = (kind == 3) ? P.in[29] : nullptr;
  const int tid = TID(), lane = tid & 63, wid = tid >> 6;
  const int nrows = SLAB * R.H;
  const int per = R.DV / 64;
  for (int item = BID(); item < nrows / 32; item += gridDim.x) {
    float ss[4];
#pragma unroll
    for (int u = 0; u < 4; ++u) {
      const int rh = item * 32 + wid * 4 + u;
      const int t = rh / R.H, h = rh % R.H;
      const float* o = ob + (long)t * HDV + h * R.DV + lane * per;
      float a = 0.f;
      for (int i = 0; i < per; ++i) { float v = o[i]; a += v * v; }
      ss[u] = a;
    }
#pragma unroll
    for (int u = 0; u < 4; ++u) ss[u] = wave_sum(ss[u]);
#pragma unroll
    for (int u = 0; u < 4; ++u) {
      const int rh = item * 32 + wid * 4 + u;
      const int t = rh / R.H, h = rh % R.H;
      const float* o = ob + (long)t * HDV + h * R.DV + lane * per;
      const float rstd = rsqrtf(ss[u] / (float)R.DV + 1e-6f);
      const u16* g = pj + (long)t * R.ldv + R.goff + h * R.DV + lane * per;
      u16* out = a2 + (long)t * HDV + h * R.DV + lane * per;
      for (int i = 0; i < per; ++i) {
        float y = o[i] * rstd;
        if (gain) y *= gain[lane * per + i];
        out[i] = f2bf(y * silu_f(bf2f(g[i])));
      }
    }
  }
}

__device__ void phase_swa_prep(const Params& P, int slab) {
  const int L = Lof(slab);
  const u16* pj = (const u16*)(WS(P) + O_PROJ);
  u16* qn = (u16*)(WS(P) + O_QN);
  u16* kn = (u16*)(WS(P) + O_KN);
  const float2* rope = (const float2*)(WS(P) + O_ROPES);
  const long gtid = (long)BID() * NT + TID(), gsz = (long)gridDim.x * NT;
  for (long idx = gtid; idx < (long)SLAB * 640; idx += gsz) {
    const int d = (int)(idx & 31);
    const int hd = (int)((idx >> 5) % 20);
    const int t = (int)(idx / 640);
    const int col = hd < 16 ? hd * 64 : 1024 + (hd - 16) * 64;
    const float x1 = bf2f(pj[(long)t * 1536 + col + d]), x2 = bf2f(pj[(long)t * 1536 + col + d + 32]);
    float ss = x1 * x1 + x2 * x2;
#pragma unroll
    for (int o = 16; o; o >>= 1) ss += __shfl_xor(ss, o);
    const float rstd = rsqrtf(ss * (1.f / 64.f) + 1e-6f);
    const float* gn = hd < 16 ? P.in[23] : P.in[24];
    const float y1 = x1 * rstd * gn[d], y2 = x2 * rstd * gn[d + 32];
    const float2 cs = rope[(long)(t & (L - 1)) * 32 + d];
    float o1 = y1 * cs.x - y2 * cs.y, o2 = y1 * cs.y + y2 * cs.x;
    if (hd < 16) {
      qn[(long)t * 1024 + hd * 64 + d] = f2bf(o1 * 0.125f);
      qn[(long)t * 1024 + hd * 64 + d + 32] = f2bf(o2 * 0.125f);
    } else {
      kn[(long)t * 256 + (hd - 16) * 64 + d] = f2bf(o1);
      kn[(long)t * 256 + (hd - 16) * 64 + d + 32] = f2bf(o2);
    }
  }
}

constexpr int SLD = 324;
__device__ void phase_swa_att1(const Params& P, int slab) {
  const int L = Lof(slab), nqb = L / 64;
  const u16* qn = (const u16*)(WS(P) + O_QN);
  const u16* kn = (const u16*)(WS(P) + O_KN);
  u16* pb = (u16*)(WS(P) + O_PBUF);
  const float* sink = P.in[25];
  float* S = (float*)(smem + 40960);
  const int tid = TID();
  const int nitems = (SLAB / 64) * 16;
  for (int item = BID(); item < nitems; item += gridDim.x) {
    const int hq = item & 15, qbg = item >> 4;
    const int seq = qbg / nqb, qb = qbg % nqb;
    const int q0 = qb * 64;
    const long tok0 = (long)seq * L;
    const int hkv = hq >> 2;
    for (int kt = 0; kt < 5; ++kt) {
      const int kp0 = q0 - 128 + kt * 64;
      if (kp0 >= 0 && kp0 < L) {
        f32x4 acc[2][1] = {};
        gemm_acc<64, 64, true, true, true>(acc, qn + (tok0 + q0) * 1024 + hq * 64, 1024, kn + (tok0 + kp0) * 256 + hkv * 64, 256, 64, (u16*)smem);
        epi_each<64, 64, true>(acc, [&](int r, int c, f32x4 v) {
          f32x4 o;
#pragma unroll
          for (int j = 0; j < 4; ++j) {
            const int dlt = (q0 + r) - (kp0 + c + j);
            o[j] = (dlt <= 128 && dlt >= -128) ? v[j] : -1e30f;
          }
          *(f32x4*)(S + r * SLD + kt * 64 + c) = o;
        });
      } else {
        for (int i = tid; i < 4096; i += NT) S[(i >> 6) * SLD + kt * 64 + (i & 63)] = -1e30f;
      }
    }
    __syncthreads();
    {
      const int r = tid >> 3, sub = tid & 7;
      const float sk = sink[hq];
      float m = sk;
      for (int c = sub; c < 320; c += 8) m = fmaxf(m, S[r * SLD + c]);
      m = fmaxf(m, __shfl_xor(m, 1)); m = fmaxf(m, __shfl_xor(m, 2)); m = fmaxf(m, __shfl_xor(m, 4));
      float den = 0.f;
      for (int c = sub; c < 320; c += 8) { float e = __expf(S[r * SLD + c] - m); S[r * SLD + c] = e; den += e; }
      den += __shfl_xor(den, 1); den += __shfl_xor(den, 2); den += __shfl_xor(den, 4);
      den += __expf(sk - m);
      const float inv = 1.f / den;
      u16* prow = pb + ((long)item * 64 + r) * 320;
      for (int c = sub; c < 320; c += 8) prow[c] = f2bf(S[r * SLD + c] * inv);
    }
    __syncthreads();
  }
}

__device__ void phase_swa_att2(const Params& P, int slab) {
  const int L = Lof(slab), nqb = L / 64;
  const u16* pj = (const u16*)(WS(P) + O_PROJ);
  const u16* pb = (const u16*)(WS(P) + O_PBUF);
  u16* a2 = (u16*)(WS(P) + O_A2);
  const int nitems = (SLAB / 64) * 16;
  for (int item = BID(); item < nitems; item += gridDim.x) {
    const int hq = item & 15, qbg = item >> 4;
    const int seq = qbg / nqb, qb = qbg % nqb;
    const int q0 = qb * 64;
    const long tok0 = (long)seq * L;
    const int hkv = hq >> 2;
    f32x4 acc[2][1] = {};
    for (int kt = 0; kt < 5; ++kt) {
      const int kp0 = q0 - 128 + kt * 64;
      if (kp0 >= 0 && kp0 < L)
        gemm_acc<64, 64, true, false, true>(acc, pb + (long)item * 64 * 320 + kt * 64, 320, pj + (tok0 + kp0) * 1536 + 1280 + hkv * 64, 1536, 64, (u16*)smem);
    }
    u16* o = a2 + (tok0 + q0) * 1024 + hq * 64;
    epi_each<64, 64, true>(acc, [&](int r, int c, f32x4 v) { *(uint2*)(o + (long)r * 1024 + c) = make_uint2(pack2(v[0], v[1]), pack2(v[2], v[3])); });
  }
}


#define XB_TMO      128
#define XB_XCNT(j)  (256  + 64 * (j))
#define XB_XSUB(j)  (1280 + 64 * (j))
#define XB_XGEN(j)  (2304 + 64 * (j))
#define XB_TOP      3328
#define XB_TOPGEN   3392
#define XCD_BAR_WORDS 3456
#define XB_SPIN_CAP (1u << 18)
__device__ __forceinline__ unsigned xb_ld(unsigned* p)              { return __hip_atomic_load(p, __ATOMIC_RELAXED, __HIP_MEMORY_SCOPE_AGENT); }
__device__ __forceinline__ unsigned xb_add(unsigned* p, unsigned v) { return __hip_atomic_fetch_add(p, v, __ATOMIC_RELAXED, __HIP_MEMORY_SCOPE_AGENT); }
__device__ __forceinline__ unsigned xb_xcc_id() { return (unsigned)__builtin_amdgcn_s_getreg((3 << 11) | 20) & 0xFu; }
#define XB_SPIN(cond, bar) do { unsigned _sp = 0; while (cond) { __builtin_amdgcn_s_sleep(1); \
    if ((++_sp & 255u) == 0u) { if (xb_ld(&(bar)[XB_TMO])) break; if (_sp > XB_SPIN_CAP) { atomicAdd(&(bar)[XB_TMO], 1u); break; } } } } while (0)
struct XcdBarrier { unsigned* bar; unsigned x; volatile LDS_AS unsigned* st; };
__device__ __forceinline__ XcdBarrier xcd_barrier_post(unsigned* bar, volatile LDS_AS unsigned* st) {
    XcdBarrier b; b.bar = bar; b.x = xb_xcc_id(); b.st = st;
    if (threadIdx.x == 0) (void)xb_add(&bar[XB_XCNT(b.x)], 1u);
    return b;
}
__device__ __forceinline__ void xcd_barrier_complete(unsigned* bar, unsigned x, unsigned& nloc, unsigned& nx) {
    const unsigned G = gridDim.x * gridDim.y * gridDim.z;
    unsigned sum, cnt, mine, sp = 0u;
    for (;;) {
        sum = 0u; cnt = 0u; mine = 0u;
#pragma unroll
        for (unsigned j = 0; j < 16; ++j) { const unsigned c = xb_ld(&bar[XB_XCNT(j)]); sum += c; cnt += (c > 0u) ? 1u : 0u; mine = (j == x) ? c : mine; }
        if (sum == G) break;
        __builtin_amdgcn_s_sleep(1);
        if ((++sp & 255u) == 0u) { if (xb_ld(&bar[XB_TMO])) break; if (sp > XB_SPIN_CAP) { atomicAdd(&bar[XB_TMO], 1u); break; } }
    }
    nloc = mine > 0u ? mine : 1u; nx = cnt > 0u ? cnt : 1u;
}
__device__ __forceinline__ void xcd_barrier(const XcdBarrier& b) {
    asm volatile("s_waitcnt vmcnt(0)" ::: "memory");
    __syncthreads();
    if (threadIdx.x == 0) {
        unsigned* bar = b.bar;
        __builtin_amdgcn_s_waitcnt(0);
        unsigned nloc = b.st[0], nx = b.st[1];
        if (nloc == 0u) { xcd_barrier_complete(bar, b.x, nloc, nx); b.st[0] = nloc; b.st[1] = nx; }
        const unsigned old = xb_add(&bar[XB_XSUB(b.x)], 1u);
        const unsigned gen = old / nloc;
        if (old + 1u == (gen + 1u) * nloc) {
            __builtin_amdgcn_fence(__ATOMIC_RELEASE, "agent");
            asm volatile("s_waitcnt vmcnt(0)" ::: "memory");
            const unsigned og = xb_add(&bar[XB_TOP], 1u);
            const unsigned tg = og / nx;
            if (og + 1u == (tg + 1u) * nx) xb_add(&bar[XB_TOPGEN], 1u);
            else XB_SPIN(xb_ld(&bar[XB_TOPGEN]) == tg, bar);
            __builtin_amdgcn_fence(__ATOMIC_ACQUIRE, "agent");
            xb_add(&bar[XB_XGEN(b.x)], 1u);
            asm volatile("s_waitcnt vmcnt(0)" ::: "memory");
        } else {
            XB_SPIN(xb_ld(&bar[XB_XGEN(b.x)]) == gen, bar);
            __builtin_amdgcn_fence(__ATOMIC_ACQUIRE, "agent");
            asm volatile("s_waitcnt vmcnt(0)" ::: "memory");
        }
    }
    __syncthreads();
}

__device__ __forceinline__ int nsteps_of(int kind) { return (kind & 1) ? 12 : 10; }

__device__ void layer_step(const Params& P, int layer, int slab, int step) {
  const int kind = layer;
  const int nmix = nsteps_of(kind) - 4;
  if (step == 0) { REP(4) phase_norm(P, layer, slab, 0); return; }
  if (step >= nmix) {
    const int f = step - nmix;
    if (f == 0) { REP(4) phase_norm(P, layer, slab, 1); }
    else if (f == 1) { REP(0) phase_ffn_gate(P, layer); }
    else if (f == 2) { REP(0) phase_ffn_val(P, layer, slab); }
    else phase_resid(P, layer, slab, (const u16*)(WS(P) + O_ACT), DFF, O_WFD + (size_t)layer * SZW(1024, 2816), 5 * D);
    return;
  }
  if (kind == 0) {
    if (step == 1) { REP(0) phase_proj(P, O_WHYIN, 3072); }
    else if (step == 2) { REP(3) phase_hy_conv(P, slab); }
    else if (step == 3) { if ((PROBE_MASK >> 7) & 1) phase_hy_fft(P, slab, true); phase_hy_fft(P, slab); }
    else if (step == 4) { REP(3) phase_hy_tr(P, slab); }
    else phase_resid(P, layer, slab, (const u16*)(WS(P) + O_A2), 1024, O_WHYOUT, 2 * D);
  } else if (kind == 1) {
    if (step == 1) { REP(0) phase_proj(P, O_WRETIN, 6144); }
    else if (step == 2) { REP(1) phase_ret_prep(P, slab); }
    else if (step == 3) { REP(1) phase_rec_su<128>(P, 1); }
    else if (step == 4) { if ((PROBE_MASK >> 6) & 1) phase_rec_scan(P, 1, slab, true); phase_rec_scan(P, 1, slab); }
    else if (step == 5) { REP(1) phase_rec_out<128>(P, 1); }
    else if (step == 6) { REP(1) phase_rec_ng(P, 1); }
    else phase_resid(P, layer, slab, (const u16*)(WS(P) + O_A2), 2048, O_WRETOUT, 2 * D);
  } else if (kind == 2) {
    if (step == 1) { REP(0) phase_proj(P, O_WSWAIN, 1536); }
    else if (step == 2) { REP(2) phase_swa_prep(P, slab); }
    else if (step == 3) { REP(2) phase_swa_att1(P, slab); }
    else if (step == 4) { REP(2) phase_swa_att2(P, slab); }
    else phase_resid(P, layer, slab, (const u16*)(WS(P) + O_A2), 1024, O_WSWAOUT, 2 * D);
  } else {
    if (step == 1) { REP(0) phase_proj(P, O_WHGIN, 5120); }
    else if (step == 2) { REP(1) phase_hg_prep(P); }
    else if (step == 3) { REP(1) phase_rec_su<64>(P, 3); }
    else if (step == 4) { if ((PROBE_MASK >> 6) & 1) phase_rec_scan(P, 3, slab, true); phase_rec_scan(P, 3, slab); }
    else if (step == 5) { REP(1) phase_rec_out<64>(P, 3); }
    else if (step == 6) { REP(1) phase_rec_ng(P, 3); }
    else phase_resid(P, layer, slab, (const u16*)(WS(P) + O_A2), 1024, O_WHGOUT, 2 * D);
  }
}

__global__ void __launch_bounds__(NT) fwd_megakernel(Params P) {
  cg::grid_group grid = cg::this_grid();
  __shared__ uint4 xb_words;
  if (threadIdx.x == 0) xb_words = make_uint4(0u, 0u, 0u, 0u);
  __syncthreads();
  XcdBarrier xb = xcd_barrier_post((unsigned*)(P.ws + O_BAR), (volatile LDS_AS unsigned*)&xb_words);
  for (int pid = P.p0; pid < P.p1; ++pid) {
    if (pid == 0) { REP(5) phase_pre0(P); }
    else if (pid == 1) { REP(5) phase_pre1(P); }
    else {
      int q = pid - 2, layer = 0;
      while (q >= 5 * nsteps_of(layer)) { q -= 5 * nsteps_of(layer); ++layer; }
      const int ns = nsteps_of(layer);
      layer_step(P, layer, q / ns, q % ns);
    }
    if (pid + 1 < P.p1) {
      if (pid == 0) grid.sync();
      else xcd_barrier(xb);
      if ((PROBE_MASK >> 8) & 1) xcd_barrier(xb);
    }
  }
}

extern "C" void kernel_launch(void* const* d_in, const int* in_sizes, int n_in, void* d_out, int out_size, void* d_ws,
                              size_t ws_size, hipStream_t stream) {
  static int grid_blocks = 0;
  if (!grid_blocks) {
    int dev = 0, cus = 0, per_cu = 0;
    (void)hipGetDevice(&dev);
    (void)hipDeviceGetAttribute(&cus, hipDeviceAttributeMultiprocessorCount, dev);
    (void)hipFuncSetAttribute((const void*)fwd_megakernel, hipFuncAttributeMaxDynamicSharedMemorySize, LDSB);
    (void)hipOccupancyMaxActiveBlocksPerMultiprocessor(&per_cu, (const void*)fwd_megakernel, NT, LDSB);
    if (per_cu < 1) per_cu = 1;
    if (per_cu > 1) per_cu = 1;
    grid_blocks = cus * per_cu;
    if (ws_size < WS_END) fprintf(stderr, "kernel_launch: workspace too small: %zu < %zu\n", ws_size, (size_t)WS_END);
  }
  Params p;
  memset(&p, 0, sizeof(p));
  for (int i = 0; i < 36; ++i) p.in[i] = (const float*)d_in[i];
  p.out = (float*)d_out;
  p.ws = (unsigned char*)d_ws;
  (void)hipMemsetAsync((unsigned char*)d_ws + O_BAR, 0, XCD_BAR_WORDS * 4, stream);
#if ONE_LAUNCH
  p.p0 = 0; p.p1 = NPHASES;
  void* args[] = {&p};
  hipError_t e = hipLaunchCooperativeKernel((const void*)fwd_megakernel, dim3(grid_blocks), dim3(NT), args, LDSB, stream);
  if (e != hipSuccess) fprintf(stderr, "cooperative launch failed: %s (grid %d)\n", hipGetErrorString(e), grid_blocks);
#else
  for (int ph = 0; ph < NPHASES; ++ph) {
    p.p0 = ph; p.p1 = ph + 1;
    hipLaunchKernelGGL(fwd_megakernel, dim3(grid_blocks), dim3(NT), LDSB, stream, p);
  }
#endif
}
```

```cpp
#include <hip/hip_runtime.h>
#include <hip/hip_cooperative_groups.h>
#include <cstdio>
#include <cstdint>
#include <cstring>
namespace cg = cooperative_groups;

typedef unsigned short u16;
typedef __attribute__((ext_vector_type(8))) short bf16x8;
typedef __attribute__((ext_vector_type(4))) float f32x4;

#define NT 512
#ifndef ONE_LAUNCH
#define ONE_LAUNCH 1
#endif
#ifndef PROBE_MASK
#define PROBE_MASK 0
#endif
#define REP(cls) for (int rep_##cls = 0; rep_##cls < (((PROBE_MASK >> (cls)) & 1) ? 2 : 1); ++rep_##cls)

constexpr int D = 1024, SLAB = 16384, DFF = 2816;
constexpr int LDSB = 131072;
constexpr int NPHASES = 2 + 5 * (10 + 12 + 10 + 12);

constexpr size_t SZW(size_t n, size_t k) { return n * k * 2; }
constexpr size_t O_WHYIN = 0;
constexpr size_t O_WHYOUT = O_WHYIN + SZW(3072, 1024);
constexpr size_t O_WRETIN = O_WHYOUT + SZW(1024, 1024);
constexpr size_t O_WRETOUT = O_WRETIN + SZW(6144, 1024);
constexpr size_t O_WSWAIN = O_WRETOUT + SZW(1024, 2048);
constexpr size_t O_WSWAOUT = O_WSWAIN + SZW(1536, 1024);
constexpr size_t O_WHGIN = O_WSWAOUT + SZW(1024, 1024);
constexpr size_t O_WHGOUT = O_WHGIN + SZW(5120, 1024);
constexpr size_t O_WFG = O_WHGOUT + SZW(1024, 1024);
constexpr size_t O_WFV = O_WFG + 4 * SZW(2816, 1024);
constexpr size_t O_WFD = O_WFV + 4 * SZW(2816, 1024);
constexpr size_t O_MOD = O_WFD + 4 * SZW(1024, 2816);
constexpr size_t O_TW = O_MOD + (size_t)4 * 16 * 6144 * 4;
constexpr size_t O_HIDS = O_TW + 8192 * 8;
constexpr size_t O_HIDP = O_HIDS + (size_t)8192 * 64 * 4;
constexpr size_t O_ROPER = O_HIDP + (size_t)2048 * 64 * 4;
constexpr size_t O_ROPES = O_ROPER + (size_t)8192 * 128 * 8;
constexpr size_t O_PROJ = O_ROPES + (size_t)8192 * 32 * 8;
constexpr size_t O_HBUF = O_PROJ + (size_t)SLAB * 6144 * 2;
constexpr size_t O_A2 = O_HBUF + (size_t)SLAB * 1024 * 2;
constexpr size_t O_C = O_A2 + (size_t)SLAB * 2048 * 2;
constexpr size_t O_GBUF = O_C;
constexpr size_t O_ACT = O_GBUF + (size_t)SLAB * DFF * 2;
constexpr size_t O_MODP = O_C;
constexpr size_t O_HSPS = O_ACT + (size_t)SLAB * DFF * 2;
constexpr size_t O_HSPP = O_HSPS + (size_t)1024 * 16384 * 8;
constexpr size_t O_UT = O_HSPP + (size_t)1024 * 4096 * 8;
constexpr size_t O_X0C = O_UT + (size_t)SLAB * 1024 * 4;
constexpr size_t END_HY = O_X0C + (size_t)SLAB * 1024 * 2;
constexpr size_t SZP = (size_t)SLAB * 1024 * 2;
constexpr size_t O_QDF = O_C, O_QDB = O_QDF + SZP, O_KIF = O_QDB + SZP, O_KIB = O_KIF + SZP, O_KEF = O_KIB + SZP, O_KEB = O_KEF + SZP;
constexpr size_t O_DLF = O_KEB + SZP;
constexpr size_t O_DLB = O_DLF + (size_t)256 * 1024 * 4;
constexpr size_t O_SC = O_DLB + (size_t)256 * 1024 * 4;
constexpr size_t O_STF = O_SC + (size_t)SLAB * 512 * 2;
constexpr size_t O_STB = O_STF + (size_t)134217728;
constexpr size_t O_OBUF = O_STB + (size_t)134217728;
constexpr size_t END_REC = O_OBUF + (size_t)SLAB * 2048 * 4;
constexpr size_t O_QN = O_C;
constexpr size_t O_KN = O_QN + SZP;
constexpr size_t O_PBUF = O_KN + (size_t)SLAB * 256 * 2;
constexpr size_t END_SWA = O_PBUF + (size_t)SLAB * 16 * 320 * 2;
constexpr size_t WS_END = END_REC > END_HY ? (END_REC > END_SWA ? END_REC : END_SWA) : (END_HY > END_SWA ? END_HY : END_SWA);
constexpr size_t O_BAR = ((size_t)1 << 30) - 16384;
static_assert(WS_END <= O_BAR, "workspace exceeds 1 GiB");

struct Params {
  const float* in[36];
  float* out;
  unsigned char* ws;
  int p0, p1;
};

extern __shared__ __attribute__((aligned(16))) unsigned char smem[];

__device__ __forceinline__ int TID() { int t = threadIdx.x; asm volatile("" : "+v"(t)); return t; }
__device__ __forceinline__ int BID() { int b = blockIdx.x; asm volatile("" : "+s"(b)); return b; }
__device__ __forceinline__ long ZOFF() { long z = 0; asm volatile("" : "+s"(z)); return z; }
__device__ __forceinline__ unsigned char* WS(const Params& P) { return P.ws + ZOFF(); }
__device__ __forceinline__ float* OUTP(const Params& P) { return P.out + ZOFF(); }

namespace pg8 {
#define PG8_LAS __attribute__((address_space(3)))
typedef unsigned short bf16_t;
typedef short bf16x8 __attribute__((ext_vector_type(8)));
typedef float f32x4 __attribute__((ext_vector_type(4)));
typedef unsigned u32x4 __attribute__((ext_vector_type(4)));
constexpr int BM = 256, BK = 64, HALF = 128, HTB = HALF * BK * 2  , STAGE_BYTES = 8 * HTB, NXCD = 8, WGM = 8;

__host__ __device__ __forceinline__ int lds_byte(int r, int c) { const int st = (r >> 4) * 2 + (c >> 5), rr = r & 15, cc = c & 31, ob = rr * 64 + cc * 2; return st * 1024 + (ob ^ (((ob >> 9) & 1) << 5)); }
__host__ __device__ __forceinline__ void stage_rc(int b, int& R, int& C) { const int st = b / 1024, sb = b % 1024, swz = sb ^ (((sb >> 9) & 1) << 5); R = (st >> 1) * 16 + swz / 64; C = (st & 1) * 32 + (swz % 64) / 2; }
__host__ __device__ __forceinline__ int perm32(int rho) { const int n = rho >> 4, i = rho & 15; return 8 * (i >> 2) + 4 * n + (i & 3); }

struct Unit { int pm, pn; };
struct Gemm { const bf16_t* A; const bf16_t* Bt; int M, N, K; };

struct StaticOrder {
    int nM, nN, nwg, G, c;
    __host__ __device__ void init(int M, int N, int G_, int c_) { nM = M / BM; nN = N / BM; nwg = nM * nN; G = G_; c = c_; }
    __host__ __device__ bool next(int i, Unit& u) const {
        const long L = (long)i * G + c; if (L >= nwg) return false;
        int wgid = (int)L; { const int q = nwg / NXCD, r = nwg % NXCD, xcd = wgid % NXCD, off = wgid / NXCD; wgid = (xcd < r ? xcd * (q + 1) : r * (q + 1) + (xcd - r) * q) + off; }
        const int nig = WGM * nN, gid = wgid / nig, fm = gid * WGM, gsz = (nM - fm) < WGM ? (nM - fm) : WGM;
        u.pm = fm + ((wgid % nig) % gsz); u.pn = (wgid % nig) / gsz; return true;
    }
    __device__ __forceinline__ void a_ready(const Unit&) const {}
    __device__ __forceinline__ void done(const Unit&) const {}
};

template <class Epi, class Sched, bool STAMP = false>
__device__ __forceinline__ void gemm_phase(PG8_LAS unsigned char* lds, const Gemm g, const Sched& S, const Epi& E, unsigned long long* stamps) {
    const int tid = TID(), wid = __builtin_amdgcn_readfirstlane(tid >> 6), lane = tid & 63, wr = wid >> 2, wc = wid & 3, fr = lane & 15, fq = lane >> 4;
    const int K = g.K, nt = K / BK;
    int ts_lo = 0, ts_hi = 0, nts = 0; const unsigned long long rt_entry = STAMP ? (unsigned long long)wall_clock64() : 0ull;
#define PG8_STAMP() do { if (STAMP && wid == 0 && nts < 64) { const unsigned long long _c = (unsigned long long)clock64(); \
        ts_lo = (lane == nts) ? (int)(unsigned)_c : ts_lo; ts_hi = (lane == nts) ? (int)(unsigned)(_c >> 32) : ts_hi; ++nts; } } while (0)
    PG8_STAMP();
    unsigned voffA[2], voffB[2];
#pragma unroll
    for (int i = 0; i < 2; ++i) { int R, C; stage_rc(tid * 16 + i * 8192, R, C); const int Rb = Epi::PERM ? ((R & ~31) + perm32(R & 31)) : R;
        voffA[i] = (unsigned)(R * K + C) * 2u; voffB[i] = (unsigned)(Rb * K + C) * 2u; }
    const size_t kstep = (size_t)(BK * 2);
    const size_t hstep = (size_t)HALF * K * 2;
    const size_t tstep = 2 * hstep;
    const unsigned ldsw = (unsigned)wid * 1024u;
    const int aoff = lds_byte(wr * 64 + fr, fq * 8), boff = lds_byte(wc * 32 + fr, fq * 8);
#define PG8_SA(b, h) (((b) * 2 + (h)) * HTB)
#define PG8_SB(b, h) ((4 + (b) * 2 + (h)) * HTB)
#define PG8_STAGE(bufoff, gbase, voff) do { _Pragma("unroll") for (int _i = 0; _i < 2; ++_i) \
        __builtin_amdgcn_global_load_lds((const unsigned*)((const char*)(gbase) + (voff)[_i]), (PG8_LAS unsigned*)(lds + (bufoff) + ldsw + _i * 8192), 16, 0, 0); } while (0)
#define PG8_LDA(dst, b, h) do { _Pragma("unroll") for (int m = 0; m < 4; ++m) _Pragma("unroll") for (int k = 0; k < 2; ++k) dst[m][k] = *(const PG8_LAS bf16x8*)(lds + PG8_SA(b, h) + aoff + m * 2048 + k * 1024); } while (0)
#define PG8_LDB(dst, b, h) do { _Pragma("unroll") for (int n = 0; n < 2; ++n) _Pragma("unroll") for (int k = 0; k < 2; ++k) dst[n][k] = *(const PG8_LAS bf16x8*)(lds + PG8_SB(b, h) + boff + n * 2048 + k * 1024); } while (0)
#define PG8_MMA(ai, bj, At, Bt) do { __builtin_amdgcn_s_setprio(1); _Pragma("unroll") for (int m = 0; m < 4; ++m) _Pragma("unroll") for (int n = 0; n < 2; ++n) _Pragma("unroll") for (int k = 0; k < 2; ++k) \
        acc[ai][bj][m][n] = __builtin_amdgcn_mfma_f32_16x16x32_bf16(Bt[n][k], At[m][k], acc[ai][bj][m][n], 0, 0, 0); __builtin_amdgcn_s_setprio(0); } while (0)
#define PG8_WAIT_V(n) asm volatile("s_waitcnt vmcnt(" #n ")" ::: "memory")
#define PG8_WAIT_L(n) asm volatile("s_waitcnt lgkmcnt(" #n ")" ::: "memory")
#define PG8_BAR __builtin_amdgcn_s_barrier()
#define PG8_SCHED __builtin_amdgcn_sched_barrier(0)
    Unit cur, nxt; int ui = 0;
    if (!S.next(0, cur)) return;
    f32x4 acc[2][2][4][2];
#pragma unroll
    for (int a = 0; a < 2; ++a)
#pragma unroll
        for (int b = 0; b < 2; ++b)
#pragma unroll
            for (int m = 0; m < 4; ++m)
#pragma unroll
                for (int n = 0; n < 2; ++n) acc[a][b][m][n] = (f32x4){0.f, 0.f, 0.f, 0.f};
    bf16x8 At[4][2], B0[2][2], B1[2][2];
    const char* cA = (const char*)g.A + (size_t)cur.pm * tstep; const char* cB = (const char*)g.Bt + (size_t)cur.pn * tstep;
    S.a_ready(cur);
    PG8_STAGE(PG8_SB(0, 0), cB, voffB); PG8_STAGE(PG8_SA(0, 0), cA, voffA); PG8_STAGE(PG8_SB(0, 1), cB + hstep, voffB); PG8_STAGE(PG8_SA(0, 1), cA + hstep, voffA);
    if (wr == 1) PG8_BAR;
    PG8_WAIT_V(4); PG8_BAR;
    PG8_STAGE(PG8_SB(1, 0), cB + kstep, voffB); PG8_STAGE(PG8_SA(1, 0), cA + kstep, voffA); PG8_STAGE(PG8_SB(1, 1), cB + hstep + kstep, voffB);
    PG8_WAIT_V(6); PG8_BAR;
    PG8_STAMP();
    for (;;) {
        const bool has_next = S.next(ui + 1, nxt);
        const char* nA = has_next ? (const char*)g.A + (size_t)nxt.pm * tstep : cA; const char* nB = has_next ? (const char*)g.Bt + (size_t)nxt.pn * tstep : cB;
        for (int t = 0; t < nt; t += 2) {
            const bool last = (t == nt - 2);
            const char* a1 = cA + (size_t)(t + 1) * kstep;
            const char* a2 = last ? nA : cA + (size_t)(t + 2) * kstep; const char* b2 = last ? nB : cB + (size_t)(t + 2) * kstep;
            const char* a3 = a2 + kstep; const char* b3 = b2 + kstep;
            if (last && has_next) S.a_ready(nxt);
            PG8_LDB(B0, 0, 0); PG8_SCHED; PG8_LDA(At, 0, 0); PG8_STAGE(PG8_SA(1, 1), a1 + hstep, voffA);
            PG8_WAIT_L(8); PG8_BAR; PG8_WAIT_L(0); PG8_MMA(0, 0, At, B0); PG8_BAR; PG8_SCHED;
            PG8_LDB(B1, 0, 1); PG8_STAGE(PG8_SB(0, 0), b2, voffB);
            PG8_BAR; PG8_WAIT_L(0); PG8_MMA(0, 1, At, B1); PG8_BAR;
            PG8_LDA(At, 0, 1); PG8_STAGE(PG8_SA(0, 0), a2, voffA);
            PG8_BAR; PG8_WAIT_L(0); PG8_MMA(1, 0, At, B0); PG8_BAR; PG8_SCHED;
            PG8_STAGE(PG8_SB(0, 1), b2 + hstep, voffB);
            PG8_WAIT_V(6); PG8_BAR; PG8_MMA(1, 1, At, B1); PG8_BAR;
            PG8_LDB(B0, 1, 0); PG8_SCHED; PG8_LDA(At, 1, 0); PG8_STAGE(PG8_SA(0, 1), a2 + hstep, voffA);
            PG8_WAIT_L(8); PG8_BAR; PG8_WAIT_L(0); PG8_MMA(0, 0, At, B0); PG8_BAR; PG8_SCHED;
            PG8_LDB(B1, 1, 1); PG8_STAGE(PG8_SB(1, 0), b3, voffB);
            PG8_BAR; PG8_WAIT_L(0); PG8_MMA(0, 1, At, B1); PG8_BAR;
            PG8_LDA(At, 1, 1); PG8_STAGE(PG8_SA(1, 0), a3, voffA);
            PG8_BAR; PG8_WAIT_L(0); PG8_MMA(1, 0, At, B0); PG8_BAR; PG8_SCHED;
            PG8_STAGE(PG8_SB(1, 1), b3 + hstep, voffB);
            PG8_WAIT_V(6); PG8_BAR; PG8_MMA(1, 1, At, B1); PG8_BAR;
        }
        PG8_STAMP();
        if constexpr (!Epi::AFTER_DRAIN) { E(acc, cur, wr, wc, fr, fq); S.done(cur); }
        PG8_STAMP();
        if (!has_next) break;
#pragma unroll
        for (int a = 0; a < 2; ++a)
#pragma unroll
            for (int b = 0; b < 2; ++b)
#pragma unroll
                for (int m = 0; m < 4; ++m)
#pragma unroll
                    for (int n = 0; n < 2; ++n) acc[a][b][m][n] = (f32x4){0.f, 0.f, 0.f, 0.f};
        cur = nxt; cA = nA; cB = nB; ++ui;
    }
    PG8_WAIT_V(0);
    if (wr == 0) PG8_BAR;
    PG8_BAR;
    if constexpr (Epi::AFTER_DRAIN) { E.fused(acc, cur, wr, wc, fr, fq, lds, wid, lane); S.done(cur); }
    PG8_STAMP();
    if (STAMP && wid == 0) { stamps[lane] = lane < nts ? (((unsigned long long)(unsigned)ts_hi << 32) | (unsigned)ts_lo) : 0ull;
        if (lane == 62) stamps[62] = rt_entry; if (lane == 63) stamps[63] = (unsigned long long)wall_clock64(); }
#undef PG8_STAMP
#undef PG8_SA
#undef PG8_SB
#undef PG8_STAGE
#undef PG8_LDA
#undef PG8_LDB
#undef PG8_MMA
#undef PG8_WAIT_V
#undef PG8_WAIT_L
#undef PG8_BAR
#undef PG8_SCHED
}
}


__device__ __forceinline__ u16 f2bf(float f) {
  unsigned u = __float_as_uint(f);
  u += 0x7fffu + ((u >> 16) & 1u);
  return (u16)(u >> 16);
}
__device__ __forceinline__ float bf2f(u16 h) { return __uint_as_float(((unsigned)h) << 16); }
__device__ __forceinline__ unsigned pack2(float a, float b) { return (unsigned)f2bf(a) | ((unsigned)f2bf(b) << 16); }
__device__ __forceinline__ float silu_f(float x) { return x / (1.f + __expf(-x)); }
__device__ __forceinline__ float sigm(float x) { return 1.f / (1.f + __expf(-x)); }
__device__ __forceinline__ float wave_sum(float v) {
#pragma unroll
  for (int o = 32; o; o >>= 1) v += __shfl_xor(v, o);
  return v;
}
__device__ __forceinline__ int Lof(int slab) { return slab == 0 ? 2048 : 8192; }
__device__ __forceinline__ int gb_of(int slab, int r) { return slab == 0 ? (r >> 11) : (8 + (slab - 1) * 2 + (r >> 13)); }

typedef short v4s __attribute__((ext_vector_type(4)));
#define LDS_AS __attribute__((address_space(3)))
template <int R, bool KC>
__device__ __forceinline__ uint4 ld_chunk(const u16* __restrict__ base, long ld, int k0, int c) {
  if (KC) {
    const int r = c >> 3, kc = c & 7;
    return *(const uint4*)(base + (long)r * ld + k0 + kc * 8);
  } else {
    const int k = c / (R / 8), mc = c % (R / 8);
    return *(const uint4*)(base + (long)(k0 + k) * ld + mc * 8);
  }
}
template <int R, bool KC>
__device__ __forceinline__ void st_chunk(u16* s, uint4 v, int c) {
  if (KC) {
    const int r = c >> 3, kc = c & 7;
    *(uint4*)(s + r * 72 + kc * 8) = v;
  } else {
    const int k = c / (R / 8), mc = c % (R / 8);
    *(uint4*)(s + k * (R + 8) + mc * 8) = v;
  }
}
template <int R, bool KC>
__device__ __forceinline__ bf16x8 ld_frag(const u16* s, int x0, int ks, int fr, int fq) {
  if (KC) {
    return *(const bf16x8*)(s + (x0 + fr) * 72 + ks * 32 + fq * 8);
  } else {
    const int q4 = fr >> 2, p4 = fr & 3;
    const u16* p = s + (ks * 32 + 8 * fq + q4) * (R + 8) + x0 + 4 * p4;
    v4s lo = __builtin_amdgcn_ds_read_tr16_b64_v4i16((LDS_AS v4s*)p);
    v4s hi = __builtin_amdgcn_ds_read_tr16_b64_v4i16((LDS_AS v4s*)(p + 4 * (R + 8)));
    bf16x8 r;
    r[0] = lo[0]; r[1] = lo[1]; r[2] = lo[2]; r[3] = lo[3]; r[4] = hi[0]; r[5] = hi[1]; r[6] = hi[2]; r[7] = hi[3];
    return r;
  }
}

template <int TM, int TN, bool AKC, bool BKC, bool TR, int KT>
__device__ __forceinline__ void gemm_acc(f32x4 (&acc)[TM / 32][TN / 64], const u16* __restrict__ A, long lda,
                                         const u16* __restrict__ B, long ldb, u16* sm) {
  u16* As = sm;
  u16* Bs = sm + 9216;
  const int tid = TID(), lane = tid & 63, wid = tid >> 6;
  const int wm = wid >> 2, wn = wid & 3, fr = lane & 15, fq = lane >> 4;
  constexpr int MI = TM / 32, NI = TN / 64;
  uint4 ra0[KT], ra1[KT], rb0[KT], rb1[KT];
#pragma unroll
  for (int kt = 0; kt < KT; ++kt) {
    ra0[kt] = ld_chunk<TM, AKC>(A, lda, kt * 64, tid);
    ra1[kt] = ra0[kt];
    if (TM == 128) ra1[kt] = ld_chunk<TM, AKC>(A, lda, kt * 64, tid + NT);
    rb0[kt] = ld_chunk<TN, BKC>(B, ldb, kt * 64, tid);
    rb1[kt] = rb0[kt];
    if (TN == 128) rb1[kt] = ld_chunk<TN, BKC>(B, ldb, kt * 64, tid + NT);
  }
#pragma unroll
  for (int kt = 0; kt < KT; ++kt) {
    __syncthreads();
    st_chunk<TM, AKC>(As, ra0[kt], tid);
    if (TM == 128) st_chunk<TM, AKC>(As, ra1[kt], tid + NT);
    st_chunk<TN, BKC>(Bs, rb0[kt], tid);
    if (TN == 128) st_chunk<TN, BKC>(Bs, rb1[kt], tid + NT);
    __syncthreads();
#pragma unroll
    for (int ks = 0; ks < 2; ++ks) {
      bf16x8 af[MI], bfr[NI];
#pragma unroll
      for (int mi = 0; mi < MI; ++mi) af[mi] = ld_frag<TM, AKC>(As, wm * (TM / 2) + mi * 16, ks, fr, fq);
#pragma unroll
      for (int ni = 0; ni < NI; ++ni) bfr[ni] = ld_frag<TN, BKC>(Bs, wn * (TN / 4) + ni * 16, ks, fr, fq);
#pragma unroll
      for (int mi = 0; mi < MI; ++mi)
#pragma unroll
        for (int ni = 0; ni < NI; ++ni)
          acc[mi][ni] = TR ? __builtin_amdgcn_mfma_f32_16x16x32_bf16(bfr[ni], af[mi], acc[mi][ni], 0, 0, 0)
                           : __builtin_amdgcn_mfma_f32_16x16x32_bf16(af[mi], bfr[ni], acc[mi][ni], 0, 0, 0);
    }
  }
  __syncthreads();
}

template <int TM, int TN, bool TR, class F>
__device__ __forceinline__ void epi_each(f32x4 (&acc)[TM / 32][TN / 64], F f) {
  const int tid = TID(), lane = tid & 63, wid = tid >> 6;
  const int wm = wid >> 2, wn = wid & 3, fr = lane & 15, fq = lane >> 4;
#pragma unroll
  for (int mi = 0; mi < TM / 32; ++mi)
#pragma unroll
    for (int ni = 0; ni < TN / 64; ++ni) {
      const int r0 = wm * (TM / 2) + mi * 16, c0 = wn * (TN / 4) + ni * 16;
      if (TR) f(r0 + fr, c0 + fq * 4, acc[mi][ni]);
      else f(r0 + fq * 4, c0 + fr, acc[mi][ni]);
    }
}

struct EpiStoreBf16 {
  static constexpr bool PERM = false, AFTER_DRAIN = false;
  u16* O; int ldc;
  __device__ __forceinline__ void operator()(const f32x4 (&acc)[2][2][4][2], const pg8::Unit& u, int wr, int wc, int fr, int fq) const {
    const int row0 = u.pm * 256 + wr * 64 + fr, col0 = u.pn * 256 + wc * 32 + 4 * fq;
#pragma unroll
    for (int ai = 0; ai < 2; ++ai)
#pragma unroll
      for (int m = 0; m < 4; ++m) {
        u16* rowp = O + (size_t)(row0 + ai * 128 + m * 16) * ldc + col0;
#pragma unroll
        for (int bj = 0; bj < 2; ++bj)
#pragma unroll
          for (int n = 0; n < 2; ++n) {
            const f32x4 v = acc[ai][bj][m][n];
            *(uint2*)(rowp + bj * 128 + n * 16) = make_uint2(pack2(v[0], v[1]), pack2(v[2], v[3]));
          }
      }
  }
};
struct EpiResid {
  static constexpr bool PERM = false, AFTER_DRAIN = false;
  float* X; const float* mod; int goff; int slab;
  __device__ __forceinline__ void operator()(const f32x4 (&acc)[2][2][4][2], const pg8::Unit& u, int wr, int wc, int fr, int fq) const {
    const int row0 = u.pm * 256 + wr * 64 + fr, col0 = u.pn * 256 + wc * 32 + 4 * fq;
    const float* g = mod + (size_t)gb_of(slab, u.pm * 256) * 6144 + goff + col0;
    f32x4 gv[2][2];
#pragma unroll
    for (int bj = 0; bj < 2; ++bj)
#pragma unroll
      for (int n = 0; n < 2; ++n) gv[bj][n] = *(const f32x4*)(g + bj * 128 + n * 16);
#pragma unroll
    for (int am = 0; am < 4; ++am) {
      f32x4 xv[2][2][2];
#pragma unroll
      for (int mm = 0; mm < 2; ++mm)
#pragma unroll
        for (int bj = 0; bj < 2; ++bj)
#pragma unroll
          for (int n = 0; n < 2; ++n) xv[mm][bj][n] = *(const f32x4*)(X + (size_t)(row0 + (am >> 1) * 128 + ((am & 1) * 2 + mm) * 16) * D + col0 + bj * 128 + n * 16);
#pragma unroll
      for (int mm = 0; mm < 2; ++mm)
#pragma unroll
        for (int bj = 0; bj < 2; ++bj)
#pragma unroll
          for (int n = 0; n < 2; ++n)
            *(f32x4*)(X + (size_t)(row0 + (am >> 1) * 128 + ((am & 1) * 2 + mm) * 16) * D + col0 + bj * 128 + n * 16) = xv[mm][bj][n] + gv[bj][n] * acc[am >> 1][bj][(am & 1) * 2 + mm][n];
    }
  }
};
struct EpiFfnVal {
  static constexpr bool PERM = false, AFTER_DRAIN = false;
  const u16* G; u16* ACT; const float* cw; const float* cb; int L;
  __device__ __forceinline__ void operator()(const f32x4 (&acc)[2][2][4][2], const pg8::Unit& u, int wr, int wc, int fr, int fq) const {
    const int row0 = u.pm * 256 + wr * 64 + fr, col0 = u.pn * 256 + wc * 32 + 4 * fq;
#pragma unroll
    for (int bj = 0; bj < 2; ++bj)
#pragma unroll
      for (int n = 0; n < 2; ++n) {
        const int c = col0 + bj * 128 + n * 16;
        const f32x4 w0 = *(const f32x4*)(cw + c), w1 = *(const f32x4*)(cw + DFF + c), w2 = *(const f32x4*)(cw + 2 * DFF + c), bb = *(const f32x4*)(cb + c);
#pragma unroll
        for (int ai = 0; ai < 2; ++ai) {
          uint2 g0[4], g1[4], g2[4];
#pragma unroll
          for (int m = 0; m < 4; ++m) {
            const int r = row0 + ai * 128 + m * 16;
            const int pos = r & (L - 1);
            const u16* gp = G + (size_t)r * DFF + c;
            g1[m] = *(const uint2*)gp;
            g0[m] = *(const uint2*)(gp - (pos > 0 ? DFF : 0));
            g2[m] = *(const uint2*)(gp + (pos < L - 1 ? DFF : 0));
          }
#pragma unroll
          for (int m = 0; m < 4; ++m) {
            const int r = row0 + ai * 128 + m * 16;
            const int pos = r & (L - 1);
            const float m0 = pos > 0 ? 1.f : 0.f, m2 = pos < L - 1 ? 1.f : 0.f;
            const uint2 a0 = g0[m], a1 = g1[m], a2 = g2[m];
            f32x4 a;
            a[0] = m0 * bf2f((u16)(a0.x & 0xffff)) * w0[0] + bf2f((u16)(a1.x & 0xffff)) * w1[0] + m2 * bf2f((u16)(a2.x & 0xffff)) * w2[0] + bb[0];
            a[1] = m0 * bf2f((u16)(a0.x >> 16)) * w0[1] + bf2f((u16)(a1.x >> 16)) * w1[1] + m2 * bf2f((u16)(a2.x >> 16)) * w2[1] + bb[1];
            a[2] = m0 * bf2f((u16)(a0.y & 0xffff)) * w0[2] + bf2f((u16)(a1.y & 0xffff)) * w1[2] + m2 * bf2f((u16)(a2.y & 0xffff)) * w2[2] + bb[2];
            a[3] = m0 * bf2f((u16)(a0.y >> 16)) * w0[3] + bf2f((u16)(a1.y >> 16)) * w1[3] + m2 * bf2f((u16)(a2.y >> 16)) * w2[3] + bb[3];
            const f32x4 v = acc[ai][bj][m][n];
            *(uint2*)(ACT + (size_t)r * DFF + c) = make_uint2(pack2(silu_f(a[0]) * v[0], silu_f(a[1]) * v[1]), pack2(silu_f(a[2]) * v[2], silu_f(a[3]) * v[3]));
          }
        }
      }
  }
};
template <class Epi>
__device__ __forceinline__ void run_gemm(const u16* A, const u16* Bt, int N, int K, const Epi& E) {
  pg8::Gemm g; g.A = A; g.Bt = Bt; g.M = SLAB; g.N = N; g.K = K;
  pg8::StaticOrder S; S.init(SLAB, N, gridDim.x, BID());
  __syncthreads();
  pg8::gemm_phase<Epi, pg8::StaticOrder, false>((PG8_LAS unsigned char*)smem, g, S, E, nullptr);
  __syncthreads();
}

template <int N>
__device__ __forceinline__ void fft_dif_t(float2* x, const float2* __restrict__ tw) {
  const int tid = TID();
  constexpr int IT = N / 2 / NT;
#pragma unroll 1
  for (int s = N >> 1; s >= 1; s >>= 1) {
    const int tws = 8192 / s;
    const float2 w0 = tw[(tid & (s - 1)) * tws];
#pragma unroll
    for (int it = 0; it < IT; ++it) {
      const int i = tid + it * NT;
      const int j = i & (s - 1);
      const int p = ((i - j) << 1) + j;
      float2 w = w0;
      if (s >= 1024) {
        const float2 wu = tw[((it * NT) & (s - 1)) * tws];
        w = make_float2(w0.x * wu.x - w0.y * wu.y, w0.x * wu.y + w0.y * wu.x);
      }
      float2 a = x[p], b = x[p + s];
      x[p] = make_float2(a.x + b.x, a.y + b.y);
      float dx = a.x - b.x, dy = a.y - b.y;
      x[p + s] = make_float2(dx * w.x - dy * w.y, dx * w.y + dy * w.x);
    }
    __syncthreads();
  }
}
template <int N>
__device__ __forceinline__ void ifft_dit_t(float2* x, const float2* __restrict__ tw) {
  const int tid = TID();
  constexpr int IT = N / 2 / NT;
#pragma unroll 1
  for (int s = 1; s < N; s <<= 1) {
    const int tws = 8192 / s;
    const float2 w0 = tw[(tid & (s - 1)) * tws];
#pragma unroll
    for (int it = 0; it < IT; ++it) {
      const int i = tid + it * NT;
      const int j = i & (s - 1);
      const int p = ((i - j) << 1) + j;
      float2 w = w0;
      if (s >= 1024) {
        const float2 wu = tw[((it * NT) & (s - 1)) * tws];
        w = make_float2(w0.x * wu.x - w0.y * wu.y, w0.x * wu.y + w0.y * wu.x);
      }
      float2 a = x[p], b = x[p + s];
      float bx = b.x * w.x + b.y * w.y, by = b.y * w.x - b.x * w.y;
      x[p] = make_float2(a.x + bx, a.y + by);
      x[p + s] = make_float2(a.x - bx, a.y - by);
    }
    __syncthreads();
  }
}
__device__ __forceinline__ void fft_dif(float2* x, int N, const float2* __restrict__ tw) {
  if (N == 16384) fft_dif_t<16384>(x, tw); else fft_dif_t<4096>(x, tw);
}
__device__ __forceinline__ void ifft_dit(float2* x, int N, const float2* __restrict__ tw) {
  if (N == 16384) ifft_dit_t<16384>(x, tw); else ifft_dit_t<4096>(x, tw);
}

__device__ void transpose_w(const float* __restrict__ W, u16* __restrict__ Wt, int K, int N) {
  float* smf = (float*)smem;
  const int tk = K / 64, tn = N / 64, tid = TID();
  for (int item = BID(); item < tk * tn; item += gridDim.x) {
    const int k0 = (item / tn) * 64, n0 = (item % tn) * 64;
    __syncthreads();
    for (int i = tid; i < 4096; i += NT) {
      int kk = i >> 6, nn = i & 63;
      smf[kk * 65 + nn] = W[(long)(k0 + kk) * N + n0 + nn];
    }
    __syncthreads();
    for (int i = tid; i < 4096; i += NT) {
      int nn = i >> 6, kk = i & 63;
      Wt[(long)(n0 + nn) * K + k0 + kk] = f2bf(smf[kk * 65 + nn]);
    }
  }
  __syncthreads();
}

__device__ void phase_pre0(const Params& P) {
  const int tid = TID();
  const long gtid = (long)BID() * NT + tid, gsz = (long)gridDim.x * NT;
  {
    const float4* s0 = (const float4*)P.in[0];
    const float4* s1 = (const float4*)P.in[1];
    float4* o = (float4*)OUTP(P);
    const long n0 = (long)16384 * 1024 / 4, n1 = (long)65536 * 1024 / 4;
    for (long i = gtid; i < n0; i += gsz) o[i] = s0[i];
    for (long i = gtid; i < n1; i += gsz) o[n0 + i] = s1[i];
  }
  transpose_w(P.in[7], (u16*)(WS(P) + O_WHYIN), 1024, 3072);
  transpose_w(P.in[18], (u16*)(WS(P) + O_WHYOUT), 1024, 1024);
  transpose_w(P.in[19], (u16*)(WS(P) + O_WRETIN), 1024, 6144);
  transpose_w(P.in[21], (u16*)(WS(P) + O_WRETOUT), 2048, 1024);
  transpose_w(P.in[22], (u16*)(WS(P) + O_WSWAIN), 1024, 1536);
  transpose_w(P.in[26], (u16*)(WS(P) + O_WSWAOUT), 1024, 1024);
  transpose_w(P.in[27], (u16*)(WS(P) + O_WHGIN), 1024, 5120);
  transpose_w(P.in[30], (u16*)(WS(P) + O_WHGOUT), 1024, 1024);
  for (int l = 0; l < 4; ++l) {
    transpose_w(P.in[31] + (long)l * 1024 * DFF, (u16*)(WS(P) + O_WFG) + (long)l * DFF * 1024, 1024, DFF);
    transpose_w(P.in[32] + (long)l * 1024 * DFF, (u16*)(WS(P) + O_WFV) + (long)l * DFF * 1024, 1024, DFF);
    transpose_w(P.in[35] + (long)l * DFF * 1024, (u16*)(WS(P) + O_WFD) + (long)l * 1024 * DFF, DFF, 1024);
  }
  {
    float* cs = (float*)smem;
    float* modp = (float*)(WS(P) + O_MODP);
    for (int item = BID(); item < 4 * 8 * 12; item += gridDim.x) {
      const int nb = item % 12, ks = (item / 12) % 8, l = item / 96;
      __syncthreads();
      for (int i = tid; i < 2048; i += NT) {
        int b = i >> 7, k = i & 127;
        float c = (b < 8) ? P.in[2][b * 1024 + ks * 128 + k] : P.in[3][(b - 8) * 1024 + ks * 128 + k];
        cs[i] = c / (1.f + expf(-c));
      }
      __syncthreads();
      const int n = nb * 512 + tid;
      float a[16];
#pragma unroll
      for (int b = 0; b < 16; ++b) a[b] = 0.f;
      const float* w = P.in[4] + ((long)l * 1024 + ks * 128) * 6144 + n;
      for (int k = 0; k < 128; ++k) {
        float wv = w[(long)k * 6144];
#pragma unroll
        for (int b = 0; b < 16; ++b) a[b] += cs[b * 128 + k] * wv;
      }
#pragma unroll
      for (int b = 0; b < 16; ++b) modp[(((long)ks * 4 + l) * 16 + b) * 6144 + n] = a[b];
    }
    __syncthreads();
  }
  {
    float2* tw = (float2*)(WS(P) + O_TW);
    for (long i = gtid; i < 8192; i += gsz) {
      float s, c;
      sincospif((float)i * (1.f / 8192.f), &s, &c);
      tw[i] = make_float2(c, -s);
    }
    float2* rr = (float2*)(WS(P) + O_ROPER);
    for (long i = gtid; i < (long)8192 * 128; i += gsz) {
      int pos = (int)(i >> 7), d = (int)(i & 127);
      float inv = exp2f(-(float)d * (13.287712379549449f / 128.f));
      float s, c;
      sincosf((float)pos * inv, &s, &c);
      rr[i] = make_float2(c, s);
    }
    float2* rs = (float2*)(WS(P) + O_ROPES);
    for (long i = gtid; i < (long)8192 * 32; i += gsz) {
      int pos = (int)(i >> 5), d = (int)(i & 31);
      float inv = exp2f(-(float)d * (13.287712379549449f / 32.f));
      float s, c;
      sincosf((float)pos * inv, &s, &c);
      rs[i] = make_float2(c, s);
    }
  }
  {
    float* zf = (float*)smem;
    float* h1 = zf + 8 * 36;
    const float* w1 = P.in[10]; const float* b1 = P.in[11]; const float* w2 = P.in[12]; const float* b2 = P.in[13];
    const float* fr = P.in[15];
    const int tl = tid >> 6, j = tid & 63;
    for (int item = BID(); item < 1280; item += gridDim.x) {
      const int sel = item >= 1024;
      const int L = sel ? 2048 : 8192;
      const int t = (sel ? item - 1024 : item) * 8 + tl;
      float* hid = (float*)(WS(P) + (sel ? O_HIDP : O_HIDS));
      __syncthreads();
      if (j < 33) {
        float v;
        if (j == 0) v = (float)t / (float)(L - 1);
        else {
          int i = (j - 1) & 15;
          float band = 1e-4f + (float)i * ((15.f - 1e-4f) / 15.f);
          float ang = (6.283185307179586f / (float)L) * (float)t;
          float a = band * ang;
          v = (j <= 16) ? cosf(a) : -sinf(a);
        }
        zf[tl * 36 + j] = v;
      }
      __syncthreads();
      float s = b1[j];
#pragma unroll 3
      for (int i = 0; i < 33; ++i) s += zf[tl * 36 + i] * w1[i * 64 + j];
      h1[tl * 64 + j] = sinf(fr[j] * s);
      __syncthreads();
      float s2 = b2[j];
#pragma unroll 4
      for (int i = 0; i < 64; ++i) s2 += h1[tl * 64 + i] * w2[i * 64 + j];
      hid[(long)t * 64 + j] = sinf(fr[j] * s2);
    }
    __syncthreads();
  }
}

__device__ void phase_pre1(const Params& P) {
  __shared__ float w3s[128];
  __shared__ float red[8];
  const int tid = TID(), lane = tid & 63, wid = tid >> 6;
  const long gtid = (long)BID() * NT + tid, gsz = (long)gridDim.x * NT;
  {
    const float* modp = (const float*)(WS(P) + O_MODP);
    float* mod = (float*)(WS(P) + O_MOD);
    for (long i = gtid; i < (long)4 * 16 * 6144; i += gsz) {
      int n = (int)(i % 6144);
      int l = (int)(i / (16 * 6144));
      float s = P.in[5][l * 6144 + n];
      for (int ks = 0; ks < 8; ++ks) s += modp[(long)ks * 4 * 16 * 6144 + i];
      mod[i] = s;
    }
  }
  float2* buf = (float2*)smem;
  const float2* tw = (const float2*)(WS(P) + O_TW);
  for (int item = BID(); item < 2048; item += gridDim.x) {
    const int sel = item >> 10, c = item & 1023;
    const int L = sel ? 2048 : 8192, N = 2 * L;
    const float* hid = (const float*)(WS(P) + (sel ? O_HIDP : O_HIDS));
    float2* hs = (float2*)(WS(P) + (sel ? O_HSPP : O_HSPS)) + (long)c * N;
    __syncthreads();
    if (tid < 128) {
      int dirn = tid >> 6, j = tid & 63;
      w3s[tid] = P.in[14][(long)j * 2048 + dirn * 1024 + c];
    }
    __syncthreads();
    const float dec0 = fabsf(P.in[16][c]), dec1 = fabsf(P.in[16][1024 + c]);
    const float invLm1 = 1.f / (float)(L - 1);
    float asum = 0.f;
    for (int n = tid; n < N; n += NT) {
      float val = 0.f;
      if (n != L) {
        const int dirn = n < L ? 0 : 1;
        const int t = n < L ? n : N - n;
        const float4* hr = (const float4*)(hid + (long)t * 64);
        const float* w = w3s + dirn * 64;
        float s = 0.f;
#pragma unroll
        for (int q = 0; q < 16; ++q) {
          float4 h4 = hr[q];
          s += h4.x * w[4 * q] + h4.y * w[4 * q + 1] + h4.z * w[4 * q + 2] + h4.w * w[4 * q + 3];
        }
        float tl = (float)t * invLm1;
        val = s * expf(-tl * (dirn ? dec1 : dec0));
      }
      buf[n] = make_float2(val, 0.f);
      asum += fabsf(val);
    }
    asum = wave_sum(asum);
    if (lane == 0) red[wid] = asum;
    __syncthreads();
    float tot = 0.f;
#pragma unroll
    for (int w = 0; w < 8; ++w) tot += red[w];
    const float scale = 1.f / (tot * (float)N);
    fft_dif(buf, N, tw);
    for (int p = tid; p < N; p += NT) {
      float2 a = buf[p];
      hs[p] = make_float2(a.x * scale, a.y * scale);
    }
  }
  __syncthreads();
}

__device__ void phase_norm(const Params& P, int layer, int slab, int which) {
  const float* x = OUTP(P) + (long)slab * SLAB * D;
  u16* h = (u16*)(WS(P) + O_HBUF);
  const float* gain = P.in[6] + (layer * 2 + which) * D;
  const float* mod = (const float*)(WS(P) + O_MOD) + (long)layer * 16 * 6144;
  const int shoff = which ? 3 * D : 0, scoff = which ? 4 * D : D;
  const int tid = TID(), lane = tid & 63, wid = tid >> 6;
  for (int item = BID(); item < SLAB / 8; item += gridDim.x) {
    const int r = item * 8 + wid;
    const float* xr = x + (long)r * D;
    float4 v[4];
    float ss = 0.f;
#pragma unroll
    for (int i = 0; i < 4; ++i) {
      v[i] = *(const float4*)(xr + i * 256 + lane * 4);
      ss += v[i].x * v[i].x + v[i].y * v[i].y + v[i].z * v[i].z + v[i].w * v[i].w;
    }
    ss = wave_sum(ss);
    const float rstd = rsqrtf(ss * (1.f / 1024.f) + 1e-6f);
    const float* m = mod + (long)gb_of(slab, r) * 6144;
#pragma unroll
    for (int i = 0; i < 4; ++i) {
      const int col = i * 256 + lane * 4;
      float4 g = *(const float4*)(gain + col);
      float4 sc = *(const float4*)(m + scoff + col);
      float4 sh = *(const float4*)(m + shoff + col);
      float y0 = v[i].x * rstd * g.x * (1.f + sc.x) + sh.x;
      float y1 = v[i].y * rstd * g.y * (1.f + sc.y) + sh.y;
      float y2 = v[i].z * rstd * g.z * (1.f + sc.z) + sh.z;
      float y3 = v[i].w * rstd * g.w * (1.f + sc.w) + sh.w;
      uint2 o = make_uint2(pack2(y0, y1), pack2(y2, y3));
      *(uint2*)(h + (long)r * D + col) = o;
    }
  }
}

__device__ void phase_proj(const Params& P, size_t woff, int N) {
  EpiStoreBf16 E; E.O = (u16*)(WS(P) + O_PROJ); E.ldc = N;
  run_gemm((const u16*)(WS(P) + O_HBUF), (const u16*)(WS(P) + woff), N, D, E);
}
__device__ void phase_resid(const Params& P, int layer, int slab, const u16* A, int K, size_t woff, int goff) {
  EpiResid E; E.X = OUTP(P) + (long)slab * SLAB * D; E.mod = (const float*)(WS(P) + O_MOD) + (long)layer * 16 * 6144; E.goff = goff; E.slab = slab;
  run_gemm(A, (const u16*)(WS(P) + woff), D, K, E);
}

__device__ void phase_ffn_gate(const Params& P, int layer) {
  EpiStoreBf16 E; E.O = (u16*)(WS(P) + O_GBUF); E.ldc = DFF;
  run_gemm((const u16*)(WS(P) + O_HBUF), (const u16*)(WS(P) + O_WFG) + (long)layer * DFF * D, DFF, D, E);
}
__device__ void phase_ffn_val(const Params& P, int layer, int slab) {
  EpiFfnVal E; E.G = (const u16*)(WS(P) + O_GBUF); E.ACT = (u16*)(WS(P) + O_ACT);
  E.cw = P.in[33] + (long)layer * 3 * DFF; E.cb = P.in[34] + (long)layer * DFF; E.L = Lof(slab);
  run_gemm((const u16*)(WS(P) + O_HBUF), (const u16*)(WS(P) + O_WFV) + (long)layer * DFF * D, DFF, D, E);
}

__device__ void phase_hy_conv(const Params& P, int slab) {
  const int L = Lof(slab), nseq = SLAB / L, tid = TID();
  const u16* z = (const u16*)(WS(P) + O_PROJ);
  float* uT = (float*)(WS(P) + O_UT);
  u16* x0c = (u16*)(WS(P) + O_X0C);
  const float* cw = P.in[8];
  const float* cb = P.in[9];
  float* tile = (float*)smem;
  const int ntt = L / 64;
  const int nitems = nseq * ntt * 16;
  for (int item = BID(); item < nitems; item += gridDim.x) {
    const int ct = item % 16, tt = (item / 16) % ntt, seq = item / (16 * ntt);
    __syncthreads();
    for (int i = tid; i < 4096; i += NT) {
      const int tl = i >> 6, cl = i & 63;
      const int t = tt * 64 + tl, c = ct * 64 + cl;
      const long row = (long)seq * L + t;
      float val[3];
#pragma unroll
      for (int q = 0; q < 3; ++q) {
        const int col = q * 1024 + c;
        float a = bf2f(z[row * 3072 + col]) * cw[3072 + col] + cb[col];
        if (t > 0) a += bf2f(z[(row - 1) * 3072 + col]) * cw[col];
        if (t < L - 1) a += bf2f(z[(row + 1) * 3072 + col]) * cw[2 * 3072 + col];
        val[q] = a;
      }
      x0c[row * 1024 + c] = f2bf(val[0]);
      tile[tl * 65 + cl] = val[1] * val[2];
    }
    __syncthreads();
    for (int i = tid; i < 4096; i += NT) {
      const int cl = i >> 6, tl = i & 63;
      uT[((long)seq * 1024 + ct * 64 + cl) * L + tt * 64 + tl] = tile[tl * 65 + cl];
    }
  }
  __syncthreads();
}

__device__ void phase_hy_fft(const Params& P, int slab, bool dry = false) {
  const int L = Lof(slab), N = 2 * L, nseq = SLAB / L, tid = TID();
  float* uT = (float*)(WS(P) + O_UT);
  const float2* hsb = (const float2*)(WS(P) + (slab == 0 ? O_HSPP : O_HSPS));
  const float2* tw = (const float2*)(WS(P) + O_TW);
  const float* skip = P.in[17];
  float2* buf = (float2*)smem;
  const int nitems = (nseq / 2) * 1024;
  for (int item = BID(); item < nitems; item += gridDim.x) {
    const int pr = item >> 10, c = item & 1023;
    float* u0 = uT + ((long)(pr * 2) * 1024 + c) * L;
    float* u1 = u0 + (long)1024 * L;
    __syncthreads();
    for (int t = tid; t < L; t += NT) {
      buf[t] = make_float2(u0[t], u1[t]);
      buf[t + L] = make_float2(0.f, 0.f);
    }
    __syncthreads();
    fft_dif(buf, N, tw);
    const float2* h = hsb + (long)c * N;
    for (int p = tid; p < N; p += NT) {
      float2 a = buf[p], b = h[p];
      buf[p] = make_float2(a.x * b.x - a.y * b.y, a.x * b.y + a.y * b.x);
    }
    __syncthreads();
    ifft_dit(buf, N, tw);
    const float sk = skip[c];
    for (int t = tid; t < L; t += NT) {
      float2 y = buf[t];
      const long doff = dry ? (long)(END_HY - O_UT) / 4 : 0;
      u0[t + doff] = y.x + u0[t] * sk;
      u1[t + doff] = y.y + u1[t] * sk;
    }
  }
  __syncthreads();
}

__device__ void phase_hy_tr(const Params& P, int slab) {
  const int L = Lof(slab), nseq = SLAB / L, tid = TID();
  const float* yT = (const float*)(WS(P) + O_UT);
  const u16* x0c = (const u16*)(WS(P) + O_X0C);
  u16* a2 = (u16*)(WS(P) + O_A2);
  float* tile = (float*)smem;
  const int ntt = L / 64;
  const int nitems = nseq * ntt * 16;
  for (int item = BID(); item < nitems; item += gridDim.x) {
    const int ct = item % 16, tt = (item / 16) % ntt, seq = item / (16 * ntt);
    __syncthreads();
    for (int i = tid; i < 4096; i += NT) {
      const int cl = i >> 6, tl = i & 63;
      tile[cl * 65 + tl] = yT[((long)seq * 1024 + ct * 64 + cl) * L + tt * 64 + tl];
    }
    __syncthreads();
    for (int i = tid; i < 4096; i += NT) {
      const int tl = i >> 6, cl = i & 63;
      const long row = (long)seq * L + tt * 64 + tl;
      const int c = ct * 64 + cl;
      a2[row * 1024 + c] = f2bf(tile[cl * 65 + tl] * bf2f(x0c[row * 1024 + c]));
    }
  }
  __syncthreads();
}

struct Rec {
  int H, DK, DV, C;
  int ldv, voff, goff;
};
__device__ __forceinline__ Rec rec_of(int kind) {
  Rec r;
  if (kind == 1) { r.H = 4; r.DK = 256; r.DV = 512; r.C = 128; r.ldv = 6144; r.voff = 2048; r.goff = 4096; }
  else { r.H = 8; r.DK = 128; r.DV = 128; r.C = 64; r.ldv = 5120; r.voff = 1024; r.goff = 4096; }
  return r;
}

__device__ __forceinline__ void unpack8(const uint4 v, float (&f)[8]) {
  f[0] = bf2f((u16)(v.x & 0xffff)); f[1] = bf2f((u16)(v.x >> 16)); f[2] = bf2f((u16)(v.y & 0xffff)); f[3] = bf2f((u16)(v.y >> 16));
  f[4] = bf2f((u16)(v.z & 0xffff)); f[5] = bf2f((u16)(v.z >> 16)); f[6] = bf2f((u16)(v.w & 0xffff)); f[7] = bf2f((u16)(v.w >> 16));
}
__device__ __forceinline__ uint4 pack8s(const float (&f)[8], float sc) {
  return make_uint4(pack2(f[0] * sc, f[1] * sc), pack2(f[2] * sc, f[3] * sc), pack2(f[4] * sc, f[5] * sc), pack2(f[6] * sc, f[7] * sc));
}
__device__ void phase_ret_prep(const Params& P, int slab) {
  const int L = Lof(slab);
  const u16* __restrict__ pj = (const u16*)(WS(P) + O_PROJ);
  u16* __restrict__ qdf = (u16*)(WS(P) + O_QDF); u16* __restrict__ qdb = (u16*)(WS(P) + O_QDB);
  u16* __restrict__ kif = (u16*)(WS(P) + O_KIF); u16* __restrict__ kib = (u16*)(WS(P) + O_KIB);
  u16* __restrict__ kef = (u16*)(WS(P) + O_KEF); u16* __restrict__ keb = (u16*)(WS(P) + O_KEB);
  float* dlf = (float*)(WS(P) + O_DLF); float* dlb = (float*)(WS(P) + O_DLB);
  const float2* __restrict__ rope = (const float2*)(WS(P) + O_ROPER);
  const long gtid = (long)BID() * NT + TID(), gsz = (long)gridDim.x * NT;
  for (long idx = gtid; idx < (long)SLAB * 64; idx += gsz) {
    const int d0 = (int)(idx & 15) * 8, h = (int)((idx >> 4) & 3), t = (int)(idx >> 6);
    const int pos = t & (L - 1), r = t & 127;
    const float lgf = -expf(P.in[20][h]), lgb = -expf(P.in[20][4 + h]);
    const u16* row = pj + (long)t * 6144 + h * 256 + d0;
    const uint4 vq1 = *(const uint4*)row, vq2 = *(const uint4*)(row + 128);
    const uint4 vk1 = *(const uint4*)(row + 1024), vk2 = *(const uint4*)(row + 1024 + 128);
    const float4* rp = (const float4*)(rope + (long)pos * 128 + d0);
    const float4 c01 = rp[0], c23 = rp[1], c45 = rp[2], c67 = rp[3];
    float q1[8], q2[8], k1[8], k2[8];
    unpack8(vq1, q1); unpack8(vq2, q2); unpack8(vk1, k1); unpack8(vk2, k2);
    const float cs[8] = {c01.x, c01.z, c23.x, c23.z, c45.x, c45.z, c67.x, c67.z};
    const float sn[8] = {c01.y, c01.w, c23.y, c23.w, c45.y, c45.w, c67.y, c67.w};
    float qa[8], qb[8], ka[8], kb[8];
#pragma unroll
    for (int i = 0; i < 8; ++i) {
      qa[i] = q1[i] * cs[i] - q2[i] * sn[i]; qb[i] = q1[i] * sn[i] + q2[i] * cs[i];
      ka[i] = (k1[i] * cs[i] - k2[i] * sn[i]) * 0.0625f; kb[i] = (k1[i] * sn[i] + k2[i] * cs[i]) * 0.0625f;
    }
    const float bf = (float)(r + 1) * lgf, bb = (float)(128 - r) * lgb;
    const float ef = expf(bf), eif = expf(-bf), eef = expf((float)(127 - r) * lgf);
    const float eb = expf(bb), eib = expf(-bb), eeb = expf((float)r * lgb);
    const long o1 = (long)t * 1024 + h * 256 + d0, o2 = o1 + 128;
    *(uint4*)(qdf + o1) = pack8s(qa, ef); *(uint4*)(qdf + o2) = pack8s(qb, ef);
    *(uint4*)(qdb + o1) = pack8s(qa, eb); *(uint4*)(qdb + o2) = pack8s(qb, eb);
    *(uint4*)(kif + o1) = pack8s(ka, eif); *(uint4*)(kif + o2) = pack8s(kb, eif);
    *(uint4*)(kib + o1) = pack8s(ka, eib); *(uint4*)(kib + o2) = pack8s(kb, eib);
    *(uint4*)(kef + o1) = pack8s(ka, eef); *(uint4*)(kef + o2) = pack8s(kb, eef);
    *(uint4*)(keb + o1) = pack8s(ka, eeb); *(uint4*)(keb + o2) = pack8s(kb, eeb);
    if (r == 0) {
      const long cgi = (long)(t >> 7) * 1024 + h * 256 + d0;
      const float df = expf(128.f * lgf), db = expf(128.f * lgb);
#pragma unroll
      for (int i = 0; i < 8; ++i) { dlf[cgi + i] = df; dlf[cgi + 128 + i] = df; dlb[cgi + i] = db; dlb[cgi + 128 + i] = db; }
    }
  }
}

__device__ __forceinline__ float lb_of(const float* lbt, int dr, int ch) {
  const float a0 = lbt[(dr * 4 + 0) * 1024 + ch], a1 = lbt[(dr * 4 + 1) * 1024 + ch], a2 = lbt[(dr * 4 + 2) * 1024 + ch], a3 = lbt[(dr * 4 + 3) * 1024 + ch];
  const float m = fmaxf(fmaxf(a0, a1), fmaxf(a2, a3));
  const float e0 = expf(a0 - m), e1 = expf(a1 - m), e2 = expf(a2 - m), e3 = expf(a3 - m);
  return (e0 + e1 + e2) / (e0 + e1 + e2 + e3);
}
__device__ void phase_hg_prep(const Params& P) {
  const u16* __restrict__ pj = (const u16*)(WS(P) + O_PROJ);
  u16* __restrict__ qdf = (u16*)(WS(P) + O_QDF); u16* __restrict__ qdb = (u16*)(WS(P) + O_QDB);
  u16* __restrict__ kif = (u16*)(WS(P) + O_KIF); u16* __restrict__ kib = (u16*)(WS(P) + O_KIB);
  u16* __restrict__ kef = (u16*)(WS(P) + O_KEF); u16* __restrict__ keb = (u16*)(WS(P) + O_KEB);
  float* dlf = (float*)(WS(P) + O_DLF); float* dlb = (float*)(WS(P) + O_DLB);
  const float* lbt = P.in[28];
  float* totF = (float*)smem;
  float* totB = totF + 1024;
  const int tid = TID(), lane = tid & 63, rg = tid >> 6;
  for (int item = BID(); item < 2048; item += gridDim.x) {
    const int cgi = item >> 3, ch = (item & 7) * 128 + lane * 2;
    const long t0 = (long)cgi * 64 + rg * 8;
    unsigned wq[8], wf[8], wb[8];
#pragma unroll
    for (int i = 0; i < 8; ++i) {
      const u16* row = pj + (t0 + i) * 5120 + ch;
      wq[i] = *(const unsigned*)row; wf[i] = *(const unsigned*)(row + 2048); wb[i] = *(const unsigned*)(row + 3072);
    }
    float lb0[2], lb1[2];
    lb0[0] = lb_of(lbt, 0, ch); lb0[1] = lb_of(lbt, 0, ch + 1);
    lb1[0] = lb_of(lbt, 1, ch); lb1[1] = lb_of(lbt, 1, ch + 1);
    float pf[2][8], sb[2][8], accf[2], accb[2];
#pragma unroll
    for (int c = 0; c < 2; ++c) {
      float a = 0.f;
#pragma unroll
      for (int i = 0; i < 8; ++i) {
        const float x = bf2f((u16)(c ? (wf[i] >> 16) : (wf[i] & 0xffff)));
        a += logf(lb0[c] + (1.f - lb0[c]) * sigm(x)); pf[c][i] = a;
      }
      accf[c] = a;
      a = 0.f;
#pragma unroll
      for (int i = 7; i >= 0; --i) {
        const float x = bf2f((u16)(c ? (wb[i] >> 16) : (wb[i] & 0xffff)));
        a += logf(lb1[c] + (1.f - lb1[c]) * sigm(x)); sb[c][i] = a;
      }
      accb[c] = a;
    }
    __syncthreads();
    *(float2*)(totF + rg * 128 + lane * 2) = make_float2(accf[0], accf[1]);
    *(float2*)(totB + rg * 128 + lane * 2) = make_float2(accb[0], accb[1]);
    __syncthreads();
    float offF[2] = {0.f, 0.f}, offB[2] = {0.f, 0.f}, totf[2] = {0.f, 0.f}, totb[2] = {0.f, 0.f};
#pragma unroll
    for (int g = 0; g < 8; ++g) {
      const float2 f = *(const float2*)(totF + g * 128 + lane * 2), bq = *(const float2*)(totB + g * 128 + lane * 2);
      totf[0] += f.x; totf[1] += f.y; totb[0] += bq.x; totb[1] += bq.y;
      if (g < rg) { offF[0] += f.x; offF[1] += f.y; }
      if (g > rg) { offB[0] += bq.x; offB[1] += bq.y; }
    }
#pragma unroll
    for (int i = 0; i < 8; ++i) {
      float o[6][2];
#pragma unroll
      for (int c = 0; c < 2; ++c) {
        const float xq = bf2f((u16)(c ? (wq[i] >> 16) : (wq[i] & 0xffff)));
        const float xf = bf2f((u16)(c ? (wf[i] >> 16) : (wf[i] & 0xffff)));
        const float xb = bf2f((u16)(c ? (wb[i] >> 16) : (wb[i] & 0xffff)));
        const float q = silu_f(xq);
        const float bf = offF[c] + pf[c][i], bb = offB[c] + sb[c][i];
        const float kf = (1.f - lb0[c]) * sigm(-xf), kb = (1.f - lb1[c]) * sigm(-xb);
        o[0][c] = q * expf(bf); o[1][c] = kf * expf(-bf); o[2][c] = kf * expf(totf[c] - bf);
        o[3][c] = q * expf(bb); o[4][c] = kb * expf(-bb); o[5][c] = kb * expf(totb[c] - bb);
      }
      const long oo = (t0 + i) * 1024 + ch;
      *(unsigned*)(qdf + oo) = pack2(o[0][0], o[0][1]);
      *(unsigned*)(kif + oo) = pack2(o[1][0], o[1][1]);
      *(unsigned*)(kef + oo) = pack2(o[2][0], o[2][1]);
      *(unsigned*)(qdb + oo) = pack2(o[3][0], o[3][1]);
      *(unsigned*)(kib + oo) = pack2(o[4][0], o[4][1]);
      *(unsigned*)(keb + oo) = pack2(o[5][0], o[5][1]);
    }
    if (rg == 0) {
      *(float2*)(dlf + (long)cgi * 1024 + ch) = make_float2(expf(totf[0]), expf(totf[1]));
      *(float2*)(dlb + (long)cgi * 1024 + ch) = make_float2(expf(totb[0]), expf(totb[1]));
    }
  }
  __syncthreads();
}

template <int C>
__device__ __forceinline__ void rec_scores_item(const Params& P, const Rec& R, int cgi, int h) {
  const u16* qdf = (const u16*)(WS(P) + O_QDF); const u16* qdb = (const u16*)(WS(P) + O_QDB);
  const u16* kif = (const u16*)(WS(P) + O_KIF); const u16* kib = (const u16*)(WS(P) + O_KIB);
  u16* sc = (u16*)(WS(P) + O_SC) + ((long)cgi * R.H + h) * C * C;
  const long off = (long)cgi * C * 1024 + h * R.DK;
  f32x4 af[C / 32][C / 64] = {}, ab[C / 32][C / 64] = {};
  gemm_acc<C, C, true, true, true, (C == 128 ? 4 : 2)>(af, qdf + off, 1024, kif + off, 1024, (u16*)smem);
  gemm_acc<C, C, true, true, true, (C == 128 ? 4 : 2)>(ab, qdb + off, 1024, kib + off, 1024, (u16*)smem);
  const int tid = TID(), lane = tid & 63, wid = tid >> 6;
  const int wm = wid >> 2, wn = wid & 3, fr = lane & 15, fq = lane >> 4;
#pragma unroll
  for (int mi = 0; mi < C / 32; ++mi)
#pragma unroll
    for (int ni = 0; ni < C / 64; ++ni) {
      const int r = wm * (C / 2) + mi * 16 + fr, c0 = wn * (C / 4) + ni * 16 + fq * 4;
      float v[4];
#pragma unroll
      for (int j = 0; j < 4; ++j) {
        const int c = c0 + j;
        v[j] = (c <= r ? af[mi][ni][j] : 0.f) + (c >= r ? ab[mi][ni][j] : 0.f);
      }
      *(uint2*)(sc + r * C + c0) = make_uint2(pack2(v[0], v[1]), pack2(v[2], v[3]));
    }
}

template <int C>
__device__ void phase_rec_su(const Params& P, int kind) {
  const Rec R = rec_of(kind);
  const int nch = SLAB / C;
  const int n_sc = nch * R.H;
  const int mtn = R.DK / 128, ntn = R.DV / 128;
  const int n_u = nch * R.H * 2 * mtn * ntn;
  const u16* pj = (const u16*)(WS(P) + O_PROJ);
  for (int item = BID(); item < n_sc + n_u; item += gridDim.x) {
    if (item < n_sc) {
      rec_scores_item<C>(P, R, item / R.H, item % R.H);
    } else {
      int q = item - n_sc;
      const int nt = q % ntn; q /= ntn;
      const int mt = q % mtn; q /= mtn;
      const int dir = q & 1; q >>= 1;
      const int h = q % R.H, cgi = q / R.H;
      const u16* ke = (const u16*)(WS(P) + (dir ? O_KEB : O_KEF)) + (long)cgi * C * 1024 + h * R.DK + mt * 128;
      const u16* v = pj + (long)cgi * C * R.ldv + R.voff + h * R.DV + nt * 128;
      u16* st = (u16*)(WS(P) + (dir ? O_STB : O_STF)) + (((long)cgi * R.H + h) * R.DV + nt * 128) * R.DK + mt * 128;
      f32x4 acc[4][2] = {};
      gemm_acc<128, 128, false, false, false, C / 64>(acc, ke, 1024, v, R.ldv, (u16*)smem);
      const int DK = R.DK;
      epi_each<128, 128, false>(acc, [&](int r, int c, f32x4 val) {
        *(uint2*)(st + (long)c * DK + r) = make_uint2(pack2(val[0], val[1]), pack2(val[2], val[3]));
      });
    }
  }
}

__device__ void phase_rec_scan(const Params& P, int kind, int slab, bool dry = false) {
  const Rec R = rec_of(kind);
  const int L = Lof(slab), nseq = SLAB / L, ncs = L / R.C;
  const int hdk = R.DK / 2;
  const long per = (long)R.H * R.DV * hdk;
  const long total = 2 * nseq * per;
  const long gtid = (long)BID() * NT + TID(), gsz = (long)gridDim.x * NT;
  for (long idx = gtid; idx < total; idx += gsz) {
    long q = idx;
    const int pd = (int)(q % hdk); q /= hdk;
    const int e = (int)(q % R.DV); q /= R.DV;
    const int h = (int)(q % R.H); q /= R.H;
    const int seq = (int)(q % nseq);
    const int dir = (int)(q / nseq);
    u16* st = (u16*)(WS(P) + (dir ? O_STB : O_STF));
    u16* stw = dry ? (u16*)(WS(P) + O_OBUF) : st;
    const float* dl = (const float*)(WS(P) + (dir ? O_DLB : O_DLF));
    float s0 = 0.f, s1 = 0.f;
    const long ebase = ((long)h * R.DV + e) * R.DK + pd * 2;
    const long cstride = (long)R.H * R.DV * R.DK;
    const int dbase = h * R.DK + pd * 2;
    for (int i0 = 0; i0 < ncs; i0 += 8) {
      unsigned u[8];
      float2 dd[8];
#pragma unroll
      for (int j = 0; j < 8; ++j) {
        const int n = dir ? (ncs - 1 - i0 - j) : (i0 + j);
        const long cgi = (long)seq * ncs + n;
        u[j] = *(const unsigned*)(st + cgi * cstride + ebase);
        dd[j] = *(const float2*)(dl + cgi * 1024 + dbase);
      }
#pragma unroll
      for (int j = 0; j < 8; ++j) {
        const int n = dir ? (ncs - 1 - i0 - j) : (i0 + j);
        const long cgi = (long)seq * ncs + n;
        *(unsigned*)(stw + cgi * cstride + ebase) = pack2(s0, s1);
        s0 = dd[j].x * s0 + bf2f((u16)(u[j] & 0xffff));
        s1 = dd[j].y * s1 + bf2f((u16)(u[j] >> 16));
      }
    }
  }
}

template <int C>
__device__ void phase_rec_out(const Params& P, int kind) {
  const Rec R = rec_of(kind);
  const int nch = SLAB / C, ntn = R.DV / 128;
  const u16* pj = (const u16*)(WS(P) + O_PROJ);
  float* ob = (float*)(WS(P) + O_OBUF);
  const int HDV = R.H * R.DV;
  for (int item = BID(); item < nch * R.H * ntn; item += gridDim.x) {
    const int nt = item % ntn, h = (item / ntn) % R.H, cgi = item / (ntn * R.H);
    f32x4 acc[C / 32][2] = {};
    const u16* sc = (const u16*)(WS(P) + O_SC) + ((long)cgi * R.H + h) * C * C;
    const u16* v = pj + (long)cgi * C * R.ldv + R.voff + h * R.DV + nt * 128;
    gemm_acc<C, 128, true, false, true, C / 64>(acc, sc, C, v, R.ldv, (u16*)smem);
    const long qoff = (long)cgi * C * 1024 + h * R.DK;
    const long soff = (((long)cgi * R.H + h) * R.DV + nt * 128) * R.DK;
    gemm_acc<C, 128, true, true, true, (C == 128 ? 4 : 2)>(acc, (const u16*)(WS(P) + O_QDF) + qoff, 1024, (const u16*)(WS(P) + O_STF) + soff, R.DK, (u16*)smem);
    gemm_acc<C, 128, true, true, true, (C == 128 ? 4 : 2)>(acc, (const u16*)(WS(P) + O_QDB) + qoff, 1024, (const u16*)(WS(P) + O_STB) + soff, R.DK, (u16*)smem);
    float* o = ob + (long)cgi * C * HDV + h * R.DV + nt * 128;
    epi_each<C, 128, true>(acc, [&](int r, int c, f32x4 val) { *(f32x4*)(o + (long)r * HDV + c) = val; });
  }
}

template <int KIND>
__device__ void phase_rec_ng_t(const Params& P) {
  const Rec R = rec_of(KIND);
  constexpr int DV = (KIND == 1) ? 512 : 128, H = (KIND == 1) ? 4 : 8, PER = DV / 64, HDV = H * DV;
  const float* __restrict__ ob = (const float*)(WS(P) + O_OBUF);
  const u16* __restrict__ pj = (const u16*)(WS(P) + O_PROJ);
  u16* __restrict__ a2 = (u16*)(WS(P) + O_A2);
  const float* gain = P.in[29];
  const int tid = TID(), lane = tid & 63, wid = tid >> 6;
  constexpr int nrows = SLAB * H;
  for (int item = BID(); item < nrows / 32; item += gridDim.x) {
    float v[4][PER];
    float ss[4];
#pragma unroll
    for (int u = 0; u < 4; ++u) {
      const int rh = item * 32 + wid * 4 + u;
      const int t = rh / H, h = rh % H;
      const float* o = ob + (long)t * HDV + h * DV + lane * PER;
      if (PER == 8) {
        const float4 a = *(const float4*)o, b = *(const float4*)(o + 4);
        v[u][0] = a.x; v[u][1] = a.y; v[u][2] = a.z; v[u][3] = a.w; v[u][4 % PER] = b.x; v[u][5 % PER] = b.y; v[u][6 % PER] = b.z; v[u][7 % PER] = b.w;
      } else {
        const float2 a = *(const float2*)o;
        v[u][0] = a.x; v[u][1] = a.y;
      }
      float a = 0.f;
#pragma unroll
      for (int i = 0; i < PER; ++i) a += v[u][i] * v[u][i];
      ss[u] = a;
    }
#pragma unroll
    for (int u = 0; u < 4; ++u) ss[u] = wave_sum(ss[u]);
#pragma unroll
    for (int u = 0; u < 4; ++u) {
      const int rh = item * 32 + wid * 4 + u;
      const int t = rh / H, h = rh % H;
      const float rstd = rsqrtf(ss[u] / (float)DV + 1e-6f);
      const u16* g = pj + (long)t * R.ldv + R.goff + h * DV + lane * PER;
      u16* out = a2 + (long)t * HDV + h * DV + lane * PER;
      float y[PER];
#pragma unroll
      for (int i = 0; i < PER; ++i) {
        y[i] = v[u][i] * rstd;
        if (KIND == 3) y[i] *= gain[lane * PER + i];
      }
      if (PER == 8) {
        const uint4 gw = *(const uint4*)g;
        float gf[8];
        unpack8(gw, gf);
        float r8[8];
#pragma unroll
        for (int i = 0; i < 8; ++i) r8[i] = y[i % PER] * silu_f(gf[i]);
        *(uint4*)out = pack8s(r8, 1.f);
      } else {
        const unsigned gw = *(const unsigned*)g;
        *(unsigned*)out = pack2(y[0] * silu_f(bf2f((u16)(gw & 0xffff))), y[1 % PER] * silu_f(bf2f((u16)(gw >> 16))));
      }
    }
  }
}
__device__ void phase_rec_ng(const Params& P, int kind) {
  if (kind == 1) phase_rec_ng_t<1>(P); else phase_rec_ng_t<3>(P);
}

__device__ void phase_swa_prep(const Params& P, int slab) {
  const int L = Lof(slab);
  const u16* pj = (const u16*)(WS(P) + O_PROJ);
  u16* qn = (u16*)(WS(P) + O_QN);
  u16* kn = (u16*)(WS(P) + O_KN);
  const float2* rope = (const float2*)(WS(P) + O_ROPES);
  const long gtid = (long)BID() * NT + TID(), gsz = (long)gridDim.x * NT;
  for (long idx = gtid; idx < (long)SLAB * 640; idx += gsz) {
    const int d = (int)(idx & 31);
    const int hd = (int)((idx >> 5) % 20);
    const int t = (int)(idx / 640);
    const int col = hd < 16 ? hd * 64 : 1024 + (hd - 16) * 64;
    const float x1 = bf2f(pj[(long)t * 1536 + col + d]), x2 = bf2f(pj[(long)t * 1536 + col + d + 32]);
    float ss = x1 * x1 + x2 * x2;
#pragma unroll
    for (int o = 16; o; o >>= 1) ss += __shfl_xor(ss, o);
    const float rstd = rsqrtf(ss * (1.f / 64.f) + 1e-6f);
    const float* gn = hd < 16 ? P.in[23] : P.in[24];
    const float y1 = x1 * rstd * gn[d], y2 = x2 * rstd * gn[d + 32];
    const float2 cs = rope[(long)(t & (L - 1)) * 32 + d];
    float o1 = y1 * cs.x - y2 * cs.y, o2 = y1 * cs.y + y2 * cs.x;
    if (hd < 16) {
      qn[(long)t * 1024 + hd * 64 + d] = f2bf(o1 * 0.125f);
      qn[(long)t * 1024 + hd * 64 + d + 32] = f2bf(o2 * 0.125f);
    } else {
      kn[(long)t * 256 + (hd - 16) * 64 + d] = f2bf(o1);
      kn[(long)t * 256 + (hd - 16) * 64 + d + 32] = f2bf(o2);
    }
  }
}

constexpr int SLD = 324;
__device__ void phase_swa_att1(const Params& P, int slab) {
  const int L = Lof(slab), nqb = L / 64;
  const u16* qn = (const u16*)(WS(P) + O_QN);
  const u16* kn = (const u16*)(WS(P) + O_KN);
  u16* pb = (u16*)(WS(P) + O_PBUF);
  const float* sink = P.in[25];
  float* S = (float*)(smem + 40960);
  const int tid = TID();
  const int nitems = (SLAB / 64) * 16;
  for (int item = BID(); item < nitems; item += gridDim.x) {
    const int hq = item & 15, qbg = item >> 4;
    const int seq = qbg / nqb, qb = qbg % nqb;
    const int q0 = qb * 64;
    const long tok0 = (long)seq * L;
    const int hkv = hq >> 2;
    for (int kt = 0; kt < 5; ++kt) {
      const int kp0 = q0 - 128 + kt * 64;
      if (kp0 >= 0 && kp0 < L) {
        f32x4 acc[2][1] = {};
        gemm_acc<64, 64, true, true, true, 1>(acc, qn + (tok0 + q0) * 1024 + hq * 64, 1024, kn + (tok0 + kp0) * 256 + hkv * 64, 256, (u16*)smem);
        epi_each<64, 64, true>(acc, [&](int r, int c, f32x4 v) {
          f32x4 o;
#pragma unroll
          for (int j = 0; j < 4; ++j) {
            const int dlt = (q0 + r) - (kp0 + c + j);
            o[j] = (dlt <= 128 && dlt >= -128) ? v[j] : -1e30f;
          }
          *(f32x4*)(S + r * SLD + kt * 64 + c) = o;
        });
      } else {
        for (int i = tid; i < 4096; i += NT) S[(i >> 6) * SLD + kt * 64 + (i & 63)] = -1e30f;
      }
    }
    __syncthreads();
    {
      const int r = tid >> 3, sub = tid & 7;
      const float sk = sink[hq];
      float m = sk;
      for (int c = sub; c < 320; c += 8) m = fmaxf(m, S[r * SLD + c]);
      m = fmaxf(m, __shfl_xor(m, 1)); m = fmaxf(m, __shfl_xor(m, 2)); m = fmaxf(m, __shfl_xor(m, 4));
      float den = 0.f;
      for (int c = sub; c < 320; c += 8) { float e = __expf(S[r * SLD + c] - m); S[r * SLD + c] = e; den += e; }
      den += __shfl_xor(den, 1); den += __shfl_xor(den, 2); den += __shfl_xor(den, 4);
      den += __expf(sk - m);
      const float inv = 1.f / den;
      u16* prow = pb + ((long)item * 64 + r) * 320;
      for (int c = sub; c < 320; c += 8) prow[c] = f2bf(S[r * SLD + c] * inv);
    }
    __syncthreads();
  }
}

__device__ void phase_swa_att2(const Params& P, int slab) {
  const int L = Lof(slab), nqb = L / 64;
  const u16* pj = (const u16*)(WS(P) + O_PROJ);
  const u16* pb = (const u16*)(WS(P) + O_PBUF);
  u16* a2 = (u16*)(WS(P) + O_A2);
  const int nitems = (SLAB / 64) * 16;
  for (int item = BID(); item < nitems; item += gridDim.x) {
    const int hq = item & 15, qbg = item >> 4;
    const int seq = qbg / nqb, qb = qbg % nqb;
    const int q0 = qb * 64;
    const long tok0 = (long)seq * L;
    const int hkv = hq >> 2;
    f32x4 acc[2][1] = {};
    for (int kt = 0; kt < 5; ++kt) {
      const int kp0 = q0 - 128 + kt * 64;
      if (kp0 >= 0 && kp0 < L)
        gemm_acc<64, 64, true, false, true, 1>(acc, pb + (long)item * 64 * 320 + kt * 64, 320, pj + (tok0 + kp0) * 1536 + 1280 + hkv * 64, 1536, (u16*)smem);
    }
    u16* o = a2 + (tok0 + q0) * 1024 + hq * 64;
    epi_each<64, 64, true>(acc, [&](int r, int c, f32x4 v) { *(uint2*)(o + (long)r * 1024 + c) = make_uint2(pack2(v[0], v[1]), pack2(v[2], v[3])); });
  }
}


#define XB_TMO      128
#define XB_XCNT(j)  (256  + 64 * (j))
#define XB_XSUB(j)  (1280 + 64 * (j))
#define XB_XGEN(j)  (2304 + 64 * (j))
#define XB_TOP      3328
#define XB_TOPGEN   3392
#define XCD_BAR_WORDS 3456
#define XB_SPIN_CAP (1u << 18)
__device__ __forceinline__ unsigned xb_ld(unsigned* p)              { return __hip_atomic_load(p, __ATOMIC_RELAXED, __HIP_MEMORY_SCOPE_AGENT); }
__device__ __forceinline__ unsigned xb_add(unsigned* p, unsigned v) { return __hip_atomic_fetch_add(p, v, __ATOMIC_RELAXED, __HIP_MEMORY_SCOPE_AGENT); }
__device__ __forceinline__ unsigned xb_xcc_id() { return (unsigned)__builtin_amdgcn_s_getreg((3 << 11) | 20) & 0xFu; }
#define XB_SPIN(cond, bar) do { unsigned _sp = 0; while (cond) { __builtin_amdgcn_s_sleep(1); \
    if ((++_sp & 255u) == 0u) { if (xb_ld(&(bar)[XB_TMO])) break; if (_sp > XB_SPIN_CAP) { atomicAdd(&(bar)[XB_TMO], 1u); break; } } } } while (0)
struct XcdBarrier { unsigned* bar; unsigned x; volatile LDS_AS unsigned* st; };
__device__ __forceinline__ XcdBarrier xcd_barrier_post(unsigned* bar, volatile LDS_AS unsigned* st) {
    XcdBarrier b; b.bar = bar; b.x = xb_xcc_id(); b.st = st;
    if (threadIdx.x == 0) (void)xb_add(&bar[XB_XCNT(b.x)], 1u);
    return b;
}
__device__ __forceinline__ void xcd_barrier_complete(unsigned* bar, unsigned x, unsigned& nloc, unsigned& nx) {
    const unsigned G = gridDim.x * gridDim.y * gridDim.z;
    unsigned sum, cnt, mine, sp = 0u;
    for (;;) {
        sum = 0u; cnt = 0u; mine = 0u;
#pragma unroll
        for (unsigned j = 0; j < 16; ++j) { const unsigned c = xb_ld(&bar[XB_XCNT(j)]); sum += c; cnt += (c > 0u) ? 1u : 0u; mine = (j == x) ? c : mine; }
        if (sum == G) break;
        __builtin_amdgcn_s_sleep(1);
        if ((++sp & 255u) == 0u) { if (xb_ld(&bar[XB_TMO])) break; if (sp > XB_SPIN_CAP) { atomicAdd(&bar[XB_TMO], 1u); break; } }
    }
    nloc = mine > 0u ? mine : 1u; nx = cnt > 0u ? cnt : 1u;
}
__device__ __forceinline__ void xcd_barrier(const XcdBarrier& b) {
    asm volatile("s_waitcnt vmcnt(0)" ::: "memory");
    __syncthreads();
    if (threadIdx.x == 0) {
        unsigned* bar = b.bar;
        __builtin_amdgcn_s_waitcnt(0);
        unsigned nloc = b.st[0], nx = b.st[1];
        if (nloc == 0u) { xcd_barrier_complete(bar, b.x, nloc, nx); b.st[0] = nloc; b.st[1] = nx; }
        const unsigned old = xb_add(&bar[XB_XSUB(b.x)], 1u);
        const unsigned gen = old / nloc;
        if (old + 1u == (gen + 1u) * nloc) {
            __builtin_amdgcn_fence(__ATOMIC_RELEASE, "agent");
            asm volatile("s_waitcnt vmcnt(0)" ::: "memory");
            const unsigned og = xb_add(&bar[XB_TOP], 1u);
            const unsigned tg = og / nx;
            if (og + 1u == (tg + 1u) * nx) xb_add(&bar[XB_TOPGEN], 1u);
            else XB_SPIN(xb_ld(&bar[XB_TOPGEN]) == tg, bar);
            __builtin_amdgcn_fence(__ATOMIC_ACQUIRE, "agent");
            xb_add(&bar[XB_XGEN(b.x)], 1u);
            asm volatile("s_waitcnt vmcnt(0)" ::: "memory");
        } else {
            XB_SPIN(xb_ld(&bar[XB_XGEN(b.x)]) == gen, bar);
            __builtin_amdgcn_fence(__ATOMIC_ACQUIRE, "agent");
            asm volatile("s_waitcnt vmcnt(0)" ::: "memory");
        }
    }
    __syncthreads();
}

__device__ __forceinline__ int nsteps_of(int kind) { return (kind & 1) ? 12 : 10; }

__device__ void layer_step(const Params& P, int layer, int slab, int step) {
  const int kind = layer;
  const int nmix = nsteps_of(kind) - 4;
  if (step == 0) { REP(4) phase_norm(P, layer, slab, 0); return; }
  if (step >= nmix) {
    const int f = step - nmix;
    if (f == 0) { REP(4) phase_norm(P, layer, slab, 1); }
    else if (f == 1) { REP(0) phase_ffn_gate(P, layer); }
    else if (f == 2) { REP(0) phase_ffn_val(P, layer, slab); }
    else phase_resid(P, layer, slab, (const u16*)(WS(P) + O_ACT), DFF, O_WFD + (size_t)layer * SZW(1024, 2816), 5 * D);
    return;
  }
  if (kind == 0) {
    if (step == 1) { REP(0) phase_proj(P, O_WHYIN, 3072); }
    else if (step == 2) { REP(3) phase_hy_conv(P, slab); }
    else if (step == 3) { if ((PROBE_MASK >> 7) & 1) phase_hy_fft(P, slab, true); phase_hy_fft(P, slab); }
    else if (step == 4) { REP(3) phase_hy_tr(P, slab); }
    else phase_resid(P, layer, slab, (const u16*)(WS(P) + O_A2), 1024, O_WHYOUT, 2 * D);
  } else if (kind == 1) {
    if (step == 1) { REP(0) phase_proj(P, O_WRETIN, 6144); }
    else if (step == 2) { REP(1) REP(9) phase_ret_prep(P, slab); }
    else if (step == 3) { REP(1) REP(11) phase_rec_su<128>(P, 1); }
    else if (step == 4) { if ((PROBE_MASK >> 6) & 1) phase_rec_scan(P, 1, slab, true); phase_rec_scan(P, 1, slab); }
    else if (step == 5) { REP(1) REP(12) phase_rec_out<128>(P, 1); }
    else if (step == 6) { REP(1) REP(9) phase_rec_ng(P, 1); }
    else phase_resid(P, layer, slab, (const u16*)(WS(P) + O_A2), 2048, O_WRETOUT, 2 * D);
  } else if (kind == 2) {
    if (step == 1) { REP(0) phase_proj(P, O_WSWAIN, 1536); }
    else if (step == 2) { REP(2) REP(14) phase_swa_prep(P, slab); }
    else if (step == 3) { REP(2) REP(15) phase_swa_att1(P, slab); }
    else if (step == 4) { REP(2) REP(16) phase_swa_att2(P, slab); }
    else phase_resid(P, layer, slab, (const u16*)(WS(P) + O_A2), 1024, O_WSWAOUT, 2 * D);
  } else {
    if (step == 1) { REP(0) phase_proj(P, O_WHGIN, 5120); }
    else if (step == 2) { REP(1) REP(9) phase_hg_prep(P); }
    else if (step == 3) { REP(1) REP(11) phase_rec_su<64>(P, 3); }
    else if (step == 4) { if ((PROBE_MASK >> 6) & 1) phase_rec_scan(P, 3, slab, true); phase_rec_scan(P, 3, slab); }
    else if (step == 5) { REP(1) REP(12) phase_rec_out<64>(P, 3); }
    else if (step == 6) { REP(1) REP(9) phase_rec_ng(P, 3); }
    else phase_resid(P, layer, slab, (const u16*)(WS(P) + O_A2), 1024, O_WHGOUT, 2 * D);
  }
}

__global__ void __launch_bounds__(NT) fwd_megakernel(Params P) {
  cg::grid_group grid = cg::this_grid();
  __shared__ uint4 xb_words;
  if (threadIdx.x == 0) xb_words = make_uint4(0u, 0u, 0u, 0u);
  __syncthreads();
  XcdBarrier xb = xcd_barrier_post((unsigned*)(P.ws + O_BAR), (volatile LDS_AS unsigned*)&xb_words);
  for (int pid = P.p0; pid < P.p1; ++pid) {
    if (pid == 0) { REP(5) phase_pre0(P); }
    else if (pid == 1) { REP(5) phase_pre1(P); }
    else {
      int q = pid - 2, layer = 0;
      while (q >= 5 * nsteps_of(layer)) { q -= 5 * nsteps_of(layer); ++layer; }
      const int ns = nsteps_of(layer);
      layer_step(P, layer, q / ns, q % ns);
    }
    if (pid + 1 < P.p1) {
      if (pid == 0) grid.sync();
      else xcd_barrier(xb);
      if ((PROBE_MASK >> 8) & 1) xcd_barrier(xb);
    }
  }
}

extern "C" void kernel_launch(void* const* d_in, const int* in_sizes, int n_in, void* d_out, int out_size, void* d_ws,
                              size_t ws_size, hipStream_t stream) {
  static int grid_blocks = 0;
  if (!grid_blocks) {
    int dev = 0, cus = 0, per_cu = 0;
    (void)hipGetDevice(&dev);
    (void)hipDeviceGetAttribute(&cus, hipDeviceAttributeMultiprocessorCount, dev);
    (void)hipFuncSetAttribute((const void*)fwd_megakernel, hipFuncAttributeMaxDynamicSharedMemorySize, LDSB);
    (void)hipOccupancyMaxActiveBlocksPerMultiprocessor(&per_cu, (const void*)fwd_megakernel, NT, LDSB);
    if (per_cu < 1) per_cu = 1;
    if (per_cu > 1) per_cu = 1;
    grid_blocks = cus * per_cu;
    if (ws_size < WS_END) fprintf(stderr, "kernel_launch: workspace too small: %zu < %zu\n", ws_size, (size_t)WS_END);
  }
  Params p;
  memset(&p, 0, sizeof(p));
  for (int i = 0; i < 36; ++i) p.in[i] = (const float*)d_in[i];
  p.out = (float*)d_out;
  p.ws = (unsigned char*)d_ws;
  (void)hipMemsetAsync((unsigned char*)d_ws + O_BAR, 0, XCD_BAR_WORDS * 4, stream);
#if ONE_LAUNCH
  p.p0 = 0; p.p1 = NPHASES;
  void* args[] = {&p};
  hipError_t e = hipLaunchCooperativeKernel((const void*)fwd_megakernel, dim3(grid_blocks), dim3(NT), args, LDSB, stream);
  if (e != hipSuccess) fprintf(stderr, "cooperative launch failed: %s (grid %d)\n", hipGetErrorString(e), grid_blocks);
#else
  for (int ph = 0; ph < NPHASES; ++ph) {
    p.p0 = ph; p.p1 = ph + 1;
    hipLaunchKernelGGL(fwd_megakernel, dim3(grid_blocks), dim3(NT), LDSB, stream, p);
  }
#endif
}
```

```cpp
#include <hip/hip_runtime.h>
#include <hip/hip_cooperative_groups.h>
#include <cstdio>
#include <cstdint>
#include <cstring>
namespace cg = cooperative_groups;

typedef unsigned short u16;
typedef __attribute__((ext_vector_type(8))) short bf16x8;
typedef __attribute__((ext_vector_type(4))) float f32x4;

#define NT 512
#ifndef ONE_LAUNCH
#define ONE_LAUNCH 1
#endif
#ifndef PROBE_MASK
#define PROBE_MASK 0
#endif
#define REP(cls) for (int rep_##cls = 0; rep_##cls < (((PROBE_MASK >> (cls)) & 1) ? 2 : 1); ++rep_##cls)

constexpr int D = 1024, SLAB = 16384, DFF = 2816;
constexpr int LDSB = 131072;
constexpr int NPHASES = 2 + 5 * (10 + 12 + 10 + 12);

constexpr size_t SZW(size_t n, size_t k) { return n * k * 2; }
constexpr size_t O_WHYIN = 0;
constexpr size_t O_WHYOUT = O_WHYIN + SZW(3072, 1024);
constexpr size_t O_WRETIN = O_WHYOUT + SZW(1024, 1024);
constexpr size_t O_WRETOUT = O_WRETIN + SZW(6144, 1024);
constexpr size_t O_WSWAIN = O_WRETOUT + SZW(1024, 2048);
constexpr size_t O_WSWAOUT = O_WSWAIN + SZW(1536, 1024);
constexpr size_t O_WHGIN = O_WSWAOUT + SZW(1024, 1024);
constexpr size_t O_WHGOUT = O_WHGIN + SZW(5120, 1024);
constexpr size_t O_WFG = O_WHGOUT + SZW(1024, 1024);
constexpr size_t O_WFV = O_WFG + 4 * SZW(2816, 1024);
constexpr size_t O_WFD = O_WFV + 4 * SZW(2816, 1024);
constexpr size_t O_MOD = O_WFD + 4 * SZW(1024, 2816);
constexpr size_t O_TW = O_MOD + (size_t)4 * 16 * 6144 * 4;
constexpr size_t O_HIDS = O_TW + 8192 * 8;
constexpr size_t O_HIDP = O_HIDS + (size_t)8192 * 64 * 4;
constexpr size_t O_ROPER = O_HIDP + (size_t)2048 * 64 * 4;
constexpr size_t O_ROPES = O_ROPER + (size_t)8192 * 128 * 8;
constexpr size_t O_PROJ = O_ROPES + (size_t)8192 * 32 * 8;
constexpr size_t O_HBUF = O_PROJ + (size_t)SLAB * 6144 * 2;
constexpr size_t O_A2 = O_HBUF + (size_t)SLAB * 1024 * 2;
constexpr size_t O_C = O_A2 + (size_t)SLAB * 2048 * 2;
constexpr size_t O_GBUF = O_C;
constexpr size_t O_ACT = O_GBUF + (size_t)SLAB * DFF * 2;
constexpr size_t O_MODP = O_C;
constexpr size_t O_HSPS = O_ACT + (size_t)SLAB * DFF * 2;
constexpr size_t O_HSPP = O_HSPS + (size_t)1024 * 16384 * 8;
constexpr size_t O_UT = O_HSPP + (size_t)1024 * 4096 * 8;
constexpr size_t O_X0C = O_UT + (size_t)SLAB * 1024 * 4;
constexpr size_t END_HY = O_X0C + (size_t)SLAB * 1024 * 2;
constexpr size_t SZP = (size_t)SLAB * 1024 * 2;
constexpr size_t O_QDF = O_C, O_QDB = O_QDF + SZP, O_KIF = O_QDB + SZP, O_KIB = O_KIF + SZP, O_KEF = O_KIB + SZP, O_KEB = O_KEF + SZP;
constexpr size_t O_DLF = O_KEB + SZP;
constexpr size_t O_DLB = O_DLF + (size_t)256 * 1024 * 4;
constexpr size_t O_SC = O_DLB + (size_t)256 * 1024 * 4;
constexpr size_t O_STF = O_SC + (size_t)SLAB * 512 * 2;
constexpr size_t O_STB = O_STF + (size_t)134217728;
constexpr size_t O_OBUF = O_STB + (size_t)134217728;
constexpr size_t END_REC = O_OBUF + (size_t)SLAB * 2048 * 4;
constexpr size_t O_QN = O_C;
constexpr size_t O_KN = O_QN + SZP;
constexpr size_t O_PBUF = O_KN + (size_t)SLAB * 256 * 2;
constexpr size_t END_SWA = O_PBUF + (size_t)SLAB * 16 * 320 * 2;
constexpr size_t WS_END = END_REC > END_HY ? (END_REC > END_SWA ? END_REC : END_SWA) : (END_HY > END_SWA ? END_HY : END_SWA);
constexpr size_t O_BAR = ((size_t)1 << 30) - 16384;
static_assert(WS_END <= O_BAR, "workspace exceeds 1 GiB");

struct Params {
  const float* in[36];
  float* out;
  unsigned char* ws;
  int p0, p1;
};

extern __shared__ __attribute__((aligned(16))) unsigned char smem[];

__device__ __forceinline__ int TID() { int t = threadIdx.x; asm volatile("" : "+v"(t)); return t; }
__device__ __forceinline__ int BID() { int b = blockIdx.x; asm volatile("" : "+s"(b)); return b; }
__device__ __forceinline__ long ZOFF() { long z = 0; asm volatile("" : "+s"(z)); return z; }
__device__ __forceinline__ unsigned char* WS(const Params& P) { return P.ws + ZOFF(); }
__device__ __forceinline__ float* OUTP(const Params& P) { return P.out + ZOFF(); }

namespace pg8 {
#define PG8_LAS __attribute__((address_space(3)))
typedef unsigned short bf16_t;
typedef short bf16x8 __attribute__((ext_vector_type(8)));
typedef float f32x4 __attribute__((ext_vector_type(4)));
typedef unsigned u32x4 __attribute__((ext_vector_type(4)));
constexpr int BM = 256, BK = 64, HALF = 128, HTB = HALF * BK * 2  , STAGE_BYTES = 8 * HTB, NXCD = 8, WGM = 8;

__host__ __device__ __forceinline__ int lds_byte(int r, int c) { const int st = (r >> 4) * 2 + (c >> 5), rr = r & 15, cc = c & 31, ob = rr * 64 + cc * 2; return st * 1024 + (ob ^ (((ob >> 9) & 1) << 5)); }
__host__ __device__ __forceinline__ void stage_rc(int b, int& R, int& C) { const int st = b / 1024, sb = b % 1024, swz = sb ^ (((sb >> 9) & 1) << 5); R = (st >> 1) * 16 + swz / 64; C = (st & 1) * 32 + (swz % 64) / 2; }
__host__ __device__ __forceinline__ int perm32(int rho) { const int n = rho >> 4, i = rho & 15; return 8 * (i >> 2) + 4 * n + (i & 3); }

struct Unit { int pm, pn; };
struct Gemm { const bf16_t* A; const bf16_t* Bt; int M, N, K; };

struct StaticOrder {
    int nM, nN, nwg, G, c;
    __host__ __device__ void init(int M, int N, int G_, int c_) { nM = M / BM; nN = N / BM; nwg = nM * nN; G = G_; c = c_; }
    __host__ __device__ bool next(int i, Unit& u) const {
        const long L = (long)i * G + c; if (L >= nwg) return false;
        int wgid = (int)L; { const int q = nwg / NXCD, r = nwg % NXCD, xcd = wgid % NXCD, off = wgid / NXCD; wgid = (xcd < r ? xcd * (q + 1) : r * (q + 1) + (xcd - r) * q) + off; }
        const int nig = WGM * nN, gid = wgid / nig, fm = gid * WGM, gsz = (nM - fm) < WGM ? (nM - fm) : WGM;
        u.pm = fm + ((wgid % nig) % gsz); u.pn = (wgid % nig) / gsz; return true;
    }
    __device__ __forceinline__ void a_ready(const Unit&) const {}
    __device__ __forceinline__ void done(const Unit&) const {}
};

template <class Epi, class Sched, bool STAMP = false>
__device__ __forceinline__ void gemm_phase(PG8_LAS unsigned char* lds, const Gemm g, const Sched& S, const Epi& E, unsigned long long* stamps) {
    const int tid = TID(), wid = __builtin_amdgcn_readfirstlane(tid >> 6), lane = tid & 63, wr = wid >> 2, wc = wid & 3, fr = lane & 15, fq = lane >> 4;
    const int K = g.K, nt = K / BK;
    int ts_lo = 0, ts_hi = 0, nts = 0; const unsigned long long rt_entry = STAMP ? (unsigned long long)wall_clock64() : 0ull;
#define PG8_STAMP() do { if (STAMP && wid == 0 && nts < 64) { const unsigned long long _c = (unsigned long long)clock64(); \
        ts_lo = (lane == nts) ? (int)(unsigned)_c : ts_lo; ts_hi = (lane == nts) ? (int)(unsigned)(_c >> 32) : ts_hi; ++nts; } } while (0)
    PG8_STAMP();
    unsigned voffA[2], voffB[2];
#pragma unroll
    for (int i = 0; i < 2; ++i) { int R, C; stage_rc(tid * 16 + i * 8192, R, C); const int Rb = Epi::PERM ? ((R & ~31) + perm32(R & 31)) : R;
        voffA[i] = (unsigned)(R * K + C) * 2u; voffB[i] = (unsigned)(Rb * K + C) * 2u; }
    const size_t kstep = (size_t)(BK * 2);
    const size_t hstep = (size_t)HALF * K * 2;
    const size_t tstep = 2 * hstep;
    const unsigned ldsw = (unsigned)wid * 1024u;
    const int aoff = lds_byte(wr * 64 + fr, fq * 8), boff = lds_byte(wc * 32 + fr, fq * 8);
#define PG8_SA(b, h) (((b) * 2 + (h)) * HTB)
#define PG8_SB(b, h) ((4 + (b) * 2 + (h)) * HTB)
#define PG8_STAGE(bufoff, gbase, voff) do { _Pragma("unroll") for (int _i = 0; _i < 2; ++_i) \
        __builtin_amdgcn_global_load_lds((const unsigned*)((const char*)(gbase) + (voff)[_i]), (PG8_LAS unsigned*)(lds + (bufoff) + ldsw + _i * 8192), 16, 0, 0); } while (0)
#define PG8_LDA(dst, b, h) do { _Pragma("unroll") for (int m = 0; m < 4; ++m) _Pragma("unroll") for (int k = 0; k < 2; ++k) dst[m][k] = *(const PG8_LAS bf16x8*)(lds + PG8_SA(b, h) + aoff + m * 2048 + k * 1024); } while (0)
#define PG8_LDB(dst, b, h) do { _Pragma("unroll") for (int n = 0; n < 2; ++n) _Pragma("unroll") for (int k = 0; k < 2; ++k) dst[n][k] = *(const PG8_LAS bf16x8*)(lds + PG8_SB(b, h) + boff + n * 2048 + k * 1024); } while (0)
#define PG8_MMA(ai, bj, At, Bt) do { __builtin_amdgcn_s_setprio(1); _Pragma("unroll") for (int m = 0; m < 4; ++m) _Pragma("unroll") for (int n = 0; n < 2; ++n) _Pragma("unroll") for (int k = 0; k < 2; ++k) \
        acc[ai][bj][m][n] = __builtin_amdgcn_mfma_f32_16x16x32_bf16(Bt[n][k], At[m][k], acc[ai][bj][m][n], 0, 0, 0); __builtin_amdgcn_s_setprio(0); } while (0)
#define PG8_WAIT_V(n) asm volatile("s_waitcnt vmcnt(" #n ")" ::: "memory")
#define PG8_WAIT_L(n) asm volatile("s_waitcnt lgkmcnt(" #n ")" ::: "memory")
#define PG8_BAR __builtin_amdgcn_s_barrier()
#define PG8_SCHED __builtin_amdgcn_sched_barrier(0)
    Unit cur, nxt; int ui = 0;
    if (!S.next(0, cur)) return;
    f32x4 acc[2][2][4][2];
#pragma unroll
    for (int a = 0; a < 2; ++a)
#pragma unroll
        for (int b = 0; b < 2; ++b)
#pragma unroll
            for (int m = 0; m < 4; ++m)
#pragma unroll
                for (int n = 0; n < 2; ++n) acc[a][b][m][n] = (f32x4){0.f, 0.f, 0.f, 0.f};
    bf16x8 At[4][2], B0[2][2], B1[2][2];
    const char* cA = (const char*)g.A + (size_t)cur.pm * tstep; const char* cB = (const char*)g.Bt + (size_t)cur.pn * tstep;
    S.a_ready(cur);
    PG8_STAGE(PG8_SB(0, 0), cB, voffB); PG8_STAGE(PG8_SA(0, 0), cA, voffA); PG8_STAGE(PG8_SB(0, 1), cB + hstep, voffB); PG8_STAGE(PG8_SA(0, 1), cA + hstep, voffA);
    if (wr == 1) PG8_BAR;
    PG8_WAIT_V(4); PG8_BAR;
    PG8_STAGE(PG8_SB(1, 0), cB + kstep, voffB); PG8_STAGE(PG8_SA(1, 0), cA + kstep, voffA); PG8_STAGE(PG8_SB(1, 1), cB + hstep + kstep, voffB);
    PG8_WAIT_V(6); PG8_BAR;
    PG8_STAMP();
    for (;;) {
        const bool has_next = S.next(ui + 1, nxt);
        const char* nA = has_next ? (const char*)g.A + (size_t)nxt.pm * tstep : cA; const char* nB = has_next ? (const char*)g.Bt + (size_t)nxt.pn * tstep : cB;
        for (int t = 0; t < nt; t += 2) {
            const bool last = (t == nt - 2);
            const char* a1 = cA + (size_t)(t + 1) * kstep;
            const char* a2 = last ? nA : cA + (size_t)(t + 2) * kstep; const char* b2 = last ? nB : cB + (size_t)(t + 2) * kstep;
            const char* a3 = a2 + kstep; const char* b3 = b2 + kstep;
            if (last && has_next) S.a_ready(nxt);
            PG8_LDB(B0, 0, 0); PG8_SCHED; PG8_LDA(At, 0, 0); PG8_STAGE(PG8_SA(1, 1), a1 + hstep, voffA);
            PG8_WAIT_L(8); PG8_BAR; PG8_WAIT_L(0); PG8_MMA(0, 0, At, B0); PG8_BAR; PG8_SCHED;
            PG8_LDB(B1, 0, 1); PG8_STAGE(PG8_SB(0, 0), b2, voffB);
            PG8_BAR; PG8_WAIT_L(0); PG8_MMA(0, 1, At, B1); PG8_BAR;
            PG8_LDA(At, 0, 1); PG8_STAGE(PG8_SA(0, 0), a2, voffA);
            PG8_BAR; PG8_WAIT_L(0); PG8_MMA(1, 0, At, B0); PG8_BAR; PG8_SCHED;
            PG8_STAGE(PG8_SB(0, 1), b2 + hstep, voffB);
            PG8_WAIT_V(6); PG8_BAR; PG8_MMA(1, 1, At, B1); PG8_BAR;
            PG8_LDB(B0, 1, 0); PG8_SCHED; PG8_LDA(At, 1, 0); PG8_STAGE(PG8_SA(0, 1), a2 + hstep, voffA);
            PG8_WAIT_L(8); PG8_BAR; PG8_WAIT_L(0); PG8_MMA(0, 0, At, B0); PG8_BAR; PG8_SCHED;
            PG8_LDB(B1, 1, 1); PG8_STAGE(PG8_SB(1, 0), b3, voffB);
            PG8_BAR; PG8_WAIT_L(0); PG8_MMA(0, 1, At, B1); PG8_BAR;
            PG8_LDA(At, 1, 1); PG8_STAGE(PG8_SA(1, 0), a3, voffA);
            PG8_BAR; PG8_WAIT_L(0); PG8_MMA(1, 0, At, B0); PG8_BAR; PG8_SCHED;
            PG8_STAGE(PG8_SB(1, 1), b3 + hstep, voffB);
            PG8_WAIT_V(6); PG8_BAR; PG8_MMA(1, 1, At, B1); PG8_BAR;
        }
        PG8_STAMP();
        if constexpr (!Epi::AFTER_DRAIN) { E(acc, cur, wr, wc, fr, fq); S.done(cur); }
        PG8_STAMP();
        if (!has_next) break;
#pragma unroll
        for (int a = 0; a < 2; ++a)
#pragma unroll
            for (int b = 0; b < 2; ++b)
#pragma unroll
                for (int m = 0; m < 4; ++m)
#pragma unroll
                    for (int n = 0; n < 2; ++n) acc[a][b][m][n] = (f32x4){0.f, 0.f, 0.f, 0.f};
        cur = nxt; cA = nA; cB = nB; ++ui;
    }
    PG8_WAIT_V(0);
    if (wr == 0) PG8_BAR;
    PG8_BAR;
    if constexpr (Epi::AFTER_DRAIN) { E.fused(acc, cur, wr, wc, fr, fq, lds, wid, lane); S.done(cur); }
    PG8_STAMP();
    if (STAMP && wid == 0) { stamps[lane] = lane < nts ? (((unsigned long long)(unsigned)ts_hi << 32) | (unsigned)ts_lo) : 0ull;
        if (lane == 62) stamps[62] = rt_entry; if (lane == 63) stamps[63] = (unsigned long long)wall_clock64(); }
#undef PG8_STAMP
#undef PG8_SA
#undef PG8_SB
#undef PG8_STAGE
#undef PG8_LDA
#undef PG8_LDB
#undef PG8_MMA
#undef PG8_WAIT_V
#undef PG8_WAIT_L
#undef PG8_BAR
#undef PG8_SCHED
}
}


__device__ __forceinline__ u16 f2bf(float f) {
  unsigned u = __float_as_uint(f);
  u += 0x7fffu + ((u >> 16) & 1u);
  return (u16)(u >> 16);
}
__device__ __forceinline__ float bf2f(u16 h) { return __uint_as_float(((unsigned)h) << 16); }
__device__ __forceinline__ unsigned pack2(float a, float b) { return (unsigned)f2bf(a) | ((unsigned)f2bf(b) << 16); }
__device__ __forceinline__ float silu_f(float x) { return x / (1.f + __expf(-x)); }
__device__ __forceinline__ float sigm(float x) { return 1.f / (1.f + __expf(-x)); }
__device__ __forceinline__ float wave_sum(float v) {
#pragma unroll
  for (int o = 32; o; o >>= 1) v += __shfl_xor(v, o);
  return v;
}
__device__ __forceinline__ const float* xin_of(const Params& P, int slab) { return slab == 0 ? P.in[0] : P.in[1] + (long)(slab - 1) * SLAB * D; }
__device__ __forceinline__ int Lof(int slab) { return slab == 0 ? 2048 : 8192; }
__device__ __forceinline__ int gb_of(int slab, int r) { return slab == 0 ? (r >> 11) : (8 + (slab - 1) * 2 + (r >> 13)); }

typedef short v4s __attribute__((ext_vector_type(4)));
#define LDS_AS __attribute__((address_space(3)))
template <int R, bool KC>
__device__ __forceinline__ uint4 ld_chunk(const u16* __restrict__ base, long ld, int k0, int c) {
  if (KC) {
    const int r = c >> 3, kc = c & 7;
    return *(const uint4*)(base + (long)r * ld + k0 + kc * 8);
  } else {
    const int k = c / (R / 8), mc = c % (R / 8);
    return *(const uint4*)(base + (long)(k0 + k) * ld + mc * 8);
  }
}
template <int R, bool KC>
__device__ __forceinline__ void st_chunk(u16* s, uint4 v, int c) {
  if (KC) {
    const int r = c >> 3, kc = c & 7;
    *(uint4*)(s + r * 72 + kc * 8) = v;
  } else {
    const int k = c / (R / 8), mc = c % (R / 8);
    *(uint4*)(s + k * (R + 8) + mc * 8) = v;
  }
}
template <int R, bool KC>
__device__ __forceinline__ bf16x8 ld_frag(const u16* s, int x0, int ks, int fr, int fq) {
  if (KC) {
    return *(const bf16x8*)(s + (x0 + fr) * 72 + ks * 32 + fq * 8);
  } else {
    const int q4 = fr >> 2, p4 = fr & 3;
    const u16* p = s + (ks * 32 + 8 * fq + q4) * (R + 8) + x0 + 4 * p4;
    v4s lo = __builtin_amdgcn_ds_read_tr16_b64_v4i16((LDS_AS v4s*)p);
    v4s hi = __builtin_amdgcn_ds_read_tr16_b64_v4i16((LDS_AS v4s*)(p + 4 * (R + 8)));
    bf16x8 r;
    r[0] = lo[0]; r[1] = lo[1]; r[2] = lo[2]; r[3] = lo[3]; r[4] = hi[0]; r[5] = hi[1]; r[6] = hi[2]; r[7] = hi[3];
    return r;
  }
}

template <int TM, int TN, bool AKC, bool BKC, bool TR, int KT>
__device__ __forceinline__ void gemm_acc(f32x4 (&acc)[TM / 32][TN / 64], const u16* __restrict__ A, long lda,
                                         const u16* __restrict__ B, long ldb, u16* sm) {
  u16* As = sm;
  u16* Bs = sm + 9216;
  const int tid = TID(), lane = tid & 63, wid = tid >> 6;
  const int wm = wid >> 2, wn = wid & 3, fr = lane & 15, fq = lane >> 4;
  constexpr int MI = TM / 32, NI = TN / 64;
  uint4 ra0[KT], ra1[KT], rb0[KT], rb1[KT];
#pragma unroll
  for (int kt = 0; kt < KT; ++kt) {
    ra0[kt] = ld_chunk<TM, AKC>(A, lda, kt * 64, tid);
    ra1[kt] = ra0[kt];
    if (TM == 128) ra1[kt] = ld_chunk<TM, AKC>(A, lda, kt * 64, tid + NT);
    rb0[kt] = ld_chunk<TN, BKC>(B, ldb, kt * 64, tid);
    rb1[kt] = rb0[kt];
    if (TN == 128) rb1[kt] = ld_chunk<TN, BKC>(B, ldb, kt * 64, tid + NT);
  }
#pragma unroll
  for (int kt = 0; kt < KT; ++kt) {
    __syncthreads();
    st_chunk<TM, AKC>(As, ra0[kt], tid);
    if (TM == 128) st_chunk<TM, AKC>(As, ra1[kt], tid + NT);
    st_chunk<TN, BKC>(Bs, rb0[kt], tid);
    if (TN == 128) st_chunk<TN, BKC>(Bs, rb1[kt], tid + NT);
    __syncthreads();
#pragma unroll
    for (int ks = 0; ks < 2; ++ks) {
      bf16x8 af[MI], bfr[NI];
#pragma unroll
      for (int mi = 0; mi < MI; ++mi) af[mi] = ld_frag<TM, AKC>(As, wm * (TM / 2) + mi * 16, ks, fr, fq);
#pragma unroll
      for (int ni = 0; ni < NI; ++ni) bfr[ni] = ld_frag<TN, BKC>(Bs, wn * (TN / 4) + ni * 16, ks, fr, fq);
#pragma unroll
      for (int mi = 0; mi < MI; ++mi)
#pragma unroll
        for (int ni = 0; ni < NI; ++ni)
          acc[mi][ni] = TR ? __builtin_amdgcn_mfma_f32_16x16x32_bf16(bfr[ni], af[mi], acc[mi][ni], 0, 0, 0)
                           : __builtin_amdgcn_mfma_f32_16x16x32_bf16(af[mi], bfr[ni], acc[mi][ni], 0, 0, 0);
    }
  }
  __syncthreads();
}

template <int TM, int TN, bool TR, class F>
__device__ __forceinline__ void epi_each(f32x4 (&acc)[TM / 32][TN / 64], F f) {
  const int tid = TID(), lane = tid & 63, wid = tid >> 6;
  const int wm = wid >> 2, wn = wid & 3, fr = lane & 15, fq = lane >> 4;
#pragma unroll
  for (int mi = 0; mi < TM / 32; ++mi)
#pragma unroll
    for (int ni = 0; ni < TN / 64; ++ni) {
      const int r0 = wm * (TM / 2) + mi * 16, c0 = wn * (TN / 4) + ni * 16;
      if (TR) f(r0 + fr, c0 + fq * 4, acc[mi][ni]);
      else f(r0 + fq * 4, c0 + fr, acc[mi][ni]);
    }
}

struct EpiStoreBf16 {
  static constexpr bool PERM = false, AFTER_DRAIN = false;
  u16* O; int ldc;
  __device__ __forceinline__ void operator()(const f32x4 (&acc)[2][2][4][2], const pg8::Unit& u, int wr, int wc, int fr, int fq) const {
    const int row0 = u.pm * 256 + wr * 64 + fr, col0 = u.pn * 256 + wc * 32 + 4 * fq;
#pragma unroll
    for (int ai = 0; ai < 2; ++ai)
#pragma unroll
      for (int m = 0; m < 4; ++m) {
        u16* rowp = O + (size_t)(row0 + ai * 128 + m * 16) * ldc + col0;
#pragma unroll
        for (int bj = 0; bj < 2; ++bj)
#pragma unroll
          for (int n = 0; n < 2; ++n) {
            const f32x4 v = acc[ai][bj][m][n];
            *(uint2*)(rowp + bj * 128 + n * 16) = make_uint2(pack2(v[0], v[1]), pack2(v[2], v[3]));
          }
      }
  }
};
struct EpiResid {
  static constexpr bool PERM = false, AFTER_DRAIN = false;
  float* X; const float* XS; const float* mod; int goff; int slab;
  __device__ __forceinline__ void operator()(const f32x4 (&acc)[2][2][4][2], const pg8::Unit& u, int wr, int wc, int fr, int fq) const {
    const int row0 = u.pm * 256 + wr * 64 + fr, col0 = u.pn * 256 + wc * 32 + 4 * fq;
    const float* g = mod + (size_t)gb_of(slab, u.pm * 256) * 6144 + goff + col0;
    f32x4 gv[2][2];
#pragma unroll
    for (int bj = 0; bj < 2; ++bj)
#pragma unroll
      for (int n = 0; n < 2; ++n) gv[bj][n] = *(const f32x4*)(g + bj * 128 + n * 16);
#pragma unroll
    for (int am = 0; am < 4; ++am) {
      f32x4 xv[2][2][2];
#pragma unroll
      for (int mm = 0; mm < 2; ++mm)
#pragma unroll
        for (int bj = 0; bj < 2; ++bj)
#pragma unroll
          for (int n = 0; n < 2; ++n) xv[mm][bj][n] = *(const f32x4*)(XS + (size_t)(row0 + (am >> 1) * 128 + ((am & 1) * 2 + mm) * 16) * D + col0 + bj * 128 + n * 16);
#pragma unroll
      for (int mm = 0; mm < 2; ++mm)
#pragma unroll
        for (int bj = 0; bj < 2; ++bj)
#pragma unroll
          for (int n = 0; n < 2; ++n)
            *(f32x4*)(X + (size_t)(row0 + (am >> 1) * 128 + ((am & 1) * 2 + mm) * 16) * D + col0 + bj * 128 + n * 16) = xv[mm][bj][n] + gv[bj][n] * acc[am >> 1][bj][(am & 1) * 2 + mm][n];
    }
  }
};
struct EpiFfnVal {
  static constexpr bool PERM = false, AFTER_DRAIN = false;
  const u16* G; u16* ACT; const float* cw; const float* cb; int L;
  __device__ __forceinline__ void operator()(const f32x4 (&acc)[2][2][4][2], const pg8::Unit& u, int wr, int wc, int fr, int fq) const {
    const int row0 = u.pm * 256 + wr * 64 + fr, col0 = u.pn * 256 + wc * 32 + 4 * fq;
#pragma unroll
    for (int bj = 0; bj < 2; ++bj)
#pragma unroll
      for (int n = 0; n < 2; ++n) {
        const int c = col0 + bj * 128 + n * 16;
        const f32x4 w0 = *(const f32x4*)(cw + c), w1 = *(const f32x4*)(cw + DFF + c), w2 = *(const f32x4*)(cw + 2 * DFF + c), bb = *(const f32x4*)(cb + c);
#pragma unroll
        for (int ai = 0; ai < 2; ++ai) {
          uint2 g0[4], g1[4], g2[4];
#pragma unroll
          for (int m = 0; m < 4; ++m) {
            const int r = row0 + ai * 128 + m * 16;
            const int pos = r & (L - 1);
            const u16* gp = G + (size_t)r * DFF + c;
            g1[m] = *(const uint2*)gp;
            g0[m] = *(const uint2*)(gp - (pos > 0 ? DFF : 0));
            g2[m] = *(const uint2*)(gp + (pos < L - 1 ? DFF : 0));
          }
#pragma unroll
          for (int m = 0; m < 4; ++m) {
            const int r = row0 + ai * 128 + m * 16;
            const int pos = r & (L - 1);
            const float m0 = pos > 0 ? 1.f : 0.f, m2 = pos < L - 1 ? 1.f : 0.f;
            const uint2 a0 = g0[m], a1 = g1[m], a2 = g2[m];
            f32x4 a;
            a[0] = m0 * bf2f((u16)(a0.x & 0xffff)) * w0[0] + bf2f((u16)(a1.x & 0xffff)) * w1[0] + m2 * bf2f((u16)(a2.x & 0xffff)) * w2[0] + bb[0];
            a[1] = m0 * bf2f((u16)(a0.x >> 16)) * w0[1] + bf2f((u16)(a1.x >> 16)) * w1[1] + m2 * bf2f((u16)(a2.x >> 16)) * w2[1] + bb[1];
            a[2] = m0 * bf2f((u16)(a0.y & 0xffff)) * w0[2] + bf2f((u16)(a1.y & 0xffff)) * w1[2] + m2 * bf2f((u16)(a2.y & 0xffff)) * w2[2] + bb[2];
            a[3] = m0 * bf2f((u16)(a0.y >> 16)) * w0[3] + bf2f((u16)(a1.y >> 16)) * w1[3] + m2 * bf2f((u16)(a2.y >> 16)) * w2[3] + bb[3];
            const f32x4 v = acc[ai][bj][m][n];
            *(uint2*)(ACT + (size_t)r * DFF + c) = make_uint2(pack2(silu_f(a[0]) * v[0], silu_f(a[1]) * v[1]), pack2(silu_f(a[2]) * v[2], silu_f(a[3]) * v[3]));
          }
        }
      }
  }
};
template <class Epi>
__device__ __forceinline__ void run_gemm(const u16* A, const u16* Bt, int N, int K, const Epi& E) {
  pg8::Gemm g; g.A = A; g.Bt = Bt; g.M = SLAB; g.N = N; g.K = K;
  pg8::StaticOrder S; S.init(SLAB, N, gridDim.x, BID());
  __syncthreads();
  pg8::gemm_phase<Epi, pg8::StaticOrder, false>((PG8_LAS unsigned char*)smem, g, S, E, nullptr);
  __syncthreads();
}

template <int N>
__device__ __forceinline__ void fft_dif_t(float2* x, const float2* __restrict__ tw) {
  const int tid = TID();
  constexpr int IT = N / 2 / NT;
#pragma unroll 1
  for (int s = N >> 1; s >= 1; s >>= 1) {
    const int tws = 8192 / s;
    const float2 w0 = tw[(tid & (s - 1)) * tws];
#pragma unroll
    for (int it = 0; it < IT; ++it) {
      const int i = tid + it * NT;
      const int j = i & (s - 1);
      const int p = ((i - j) << 1) + j;
      float2 w = w0;
      if (s >= 1024) {
        const float2 wu = tw[((it * NT) & (s - 1)) * tws];
        w = make_float2(w0.x * wu.x - w0.y * wu.y, w0.x * wu.y + w0.y * wu.x);
      }
      float2 a = x[p], b = x[p + s];
      x[p] = make_float2(a.x + b.x, a.y + b.y);
      float dx = a.x - b.x, dy = a.y - b.y;
      x[p + s] = make_float2(dx * w.x - dy * w.y, dx * w.y + dy * w.x);
    }
    __syncthreads();
  }
}
template <int N>
__device__ __forceinline__ void ifft_dit_t(float2* x, const float2* __restrict__ tw) {
  const int tid = TID();
  constexpr int IT = N / 2 / NT;
#pragma unroll 1
  for (int s = 1; s < N; s <<= 1) {
    const int tws = 8192 / s;
    const float2 w0 = tw[(tid & (s - 1)) * tws];
#pragma unroll
    for (int it = 0; it < IT; ++it) {
      const int i = tid + it * NT;
      const int j = i & (s - 1);
      const int p = ((i - j) << 1) + j;
      float2 w = w0;
      if (s >= 1024) {
        const float2 wu = tw[((it * NT) & (s - 1)) * tws];
        w = make_float2(w0.x * wu.x - w0.y * wu.y, w0.x * wu.y + w0.y * wu.x);
      }
      float2 a = x[p], b = x[p + s];
      float bx = b.x * w.x + b.y * w.y, by = b.y * w.x - b.x * w.y;
      x[p] = make_float2(a.x + bx, a.y + by);
      x[p + s] = make_float2(a.x - bx, a.y - by);
    }
    __syncthreads();
  }
}
__device__ __forceinline__ void fft_dif(float2* x, int N, const float2* __restrict__ tw) {
  if (N == 16384) fft_dif_t<16384>(x, tw); else fft_dif_t<4096>(x, tw);
}
__device__ __forceinline__ void ifft_dit(float2* x, int N, const float2* __restrict__ tw) {
  if (N == 16384) ifft_dit_t<16384>(x, tw); else ifft_dit_t<4096>(x, tw);
}

__device__ void transpose_w(const float* __restrict__ W, u16* __restrict__ Wt, int K, int N) {
  float* smf = (float*)smem;
  const int tk = K / 64, tn = N / 64, tid = TID();
  for (int item = BID(); item < tk * tn; item += gridDim.x) {
    const int k0 = (item / tn) * 64, n0 = (item % tn) * 64;
    __syncthreads();
    for (int i = tid; i < 4096; i += NT) {
      int kk = i >> 6, nn = i & 63;
      smf[kk * 65 + nn] = W[(long)(k0 + kk) * N + n0 + nn];
    }
    __syncthreads();
    for (int i = tid; i < 4096; i += NT) {
      int nn = i >> 6, kk = i & 63;
      Wt[(long)(n0 + nn) * K + k0 + kk] = f2bf(smf[kk * 65 + nn]);
    }
  }
  __syncthreads();
}

__device__ void phase_pre0(const Params& P) {
  const int tid = TID();
  const long gtid = (long)BID() * NT + tid, gsz = (long)gridDim.x * NT;
  transpose_w(P.in[7], (u16*)(WS(P) + O_WHYIN), 1024, 3072);
  transpose_w(P.in[18], (u16*)(WS(P) + O_WHYOUT), 1024, 1024);
  transpose_w(P.in[19], (u16*)(WS(P) + O_WRETIN), 1024, 6144);
  transpose_w(P.in[21], (u16*)(WS(P) + O_WRETOUT), 2048, 1024);
  transpose_w(P.in[22], (u16*)(WS(P) + O_WSWAIN), 1024, 1536);
  transpose_w(P.in[26], (u16*)(WS(P) + O_WSWAOUT), 1024, 1024);
  transpose_w(P.in[27], (u16*)(WS(P) + O_WHGIN), 1024, 5120);
  transpose_w(P.in[30], (u16*)(WS(P) + O_WHGOUT), 1024, 1024);
  for (int l = 0; l < 4; ++l) {
    transpose_w(P.in[31] + (long)l * 1024 * DFF, (u16*)(WS(P) + O_WFG) + (long)l * DFF * 1024, 1024, DFF);
    transpose_w(P.in[32] + (long)l * 1024 * DFF, (u16*)(WS(P) + O_WFV) + (long)l * DFF * 1024, 1024, DFF);
    transpose_w(P.in[35] + (long)l * DFF * 1024, (u16*)(WS(P) + O_WFD) + (long)l * 1024 * DFF, DFF, 1024);
  }
  {
    float* cs = (float*)smem;
    float* modp = (float*)(WS(P) + O_MODP);
    for (int item = BID(); item < 4 * 8 * 12; item += gridDim.x) {
      const int nb = item % 12, ks = (item / 12) % 8, l = item / 96;
      __syncthreads();
      for (int i = tid; i < 2048; i += NT) {
        int b = i >> 7, k = i & 127;
        float c = (b < 8) ? P.in[2][b * 1024 + ks * 128 + k] : P.in[3][(b - 8) * 1024 + ks * 128 + k];
        cs[i] = c / (1.f + expf(-c));
      }
      __syncthreads();
      const int n = nb * 512 + tid;
      float a[16];
#pragma unroll
      for (int b = 0; b < 16; ++b) a[b] = 0.f;
      const float* w = P.in[4] + ((long)l * 1024 + ks * 128) * 6144 + n;
      for (int k = 0; k < 128; ++k) {
        float wv = w[(long)k * 6144];
#pragma unroll
        for (int b = 0; b < 16; ++b) a[b] += cs[b * 128 + k] * wv;
      }
#pragma unroll
      for (int b = 0; b < 16; ++b) modp[(((long)ks * 4 + l) * 16 + b) * 6144 + n] = a[b];
    }
    __syncthreads();
  }
  {
    float2* tw = (float2*)(WS(P) + O_TW);
    for (long i = gtid; i < 8192; i += gsz) {
      float s, c;
      sincospif((float)i * (1.f / 8192.f), &s, &c);
      tw[i] = make_float2(c, -s);
    }
    float2* rr = (float2*)(WS(P) + O_ROPER);
    for (long i = gtid; i < (long)8192 * 128; i += gsz) {
      int pos = (int)(i >> 7), d = (int)(i & 127);
      float inv = exp2f(-(float)d * (13.287712379549449f / 128.f));
      float s, c;
      sincosf((float)pos * inv, &s, &c);
      rr[i] = make_float2(c, s);
    }
    float2* rs = (float2*)(WS(P) + O_ROPES);
    for (long i = gtid; i < (long)8192 * 32; i += gsz) {
      int pos = (int)(i >> 5), d = (int)(i & 31);
      float inv = exp2f(-(float)d * (13.287712379549449f / 32.f));
      float s, c;
      sincosf((float)pos * inv, &s, &c);
      rs[i] = make_float2(c, s);
    }
  }
  {
    float* zf = (float*)smem;
    float* h1 = zf + 8 * 36;
    const float* w1 = P.in[10]; const float* b1 = P.in[11]; const float* w2 = P.in[12]; const float* b2 = P.in[13];
    const float* fr = P.in[15];
    const int tl = tid >> 6, j = tid & 63;
    for (int item = BID(); item < 1280; item += gridDim.x) {
      const int sel = item >= 1024;
      const int L = sel ? 2048 : 8192;
      const int t = (sel ? item - 1024 : item) * 8 + tl;
      float* hid = (float*)(WS(P) + (sel ? O_HIDP : O_HIDS));
      __syncthreads();
      if (j < 33) {
        float v;
        if (j == 0) v = (float)t / (float)(L - 1);
        else {
          int i = (j - 1) & 15;
          float band = 1e-4f + (float)i * ((15.f - 1e-4f) / 15.f);
          float ang = (6.283185307179586f / (float)L) * (float)t;
          float a = band * ang;
          v = (j <= 16) ? cosf(a) : -sinf(a);
        }
        zf[tl * 36 + j] = v;
      }
      __syncthreads();
      float s = b1[j];
#pragma unroll 3
      for (int i = 0; i < 33; ++i) s += zf[tl * 36 + i] * w1[i * 64 + j];
      h1[tl * 64 + j] = sinf(fr[j] * s);
      __syncthreads();
      float s2 = b2[j];
#pragma unroll 4
      for (int i = 0; i < 64; ++i) s2 += h1[tl * 64 + i] * w2[i * 64 + j];
      hid[(long)t * 64 + j] = sinf(fr[j] * s2);
    }
    __syncthreads();
  }
}

__device__ void phase_pre1(const Params& P) {
  __shared__ float w3s[128];
  __shared__ float red[8];
  const int tid = TID(), lane = tid & 63, wid = tid >> 6;
  const long gtid = (long)BID() * NT + tid, gsz = (long)gridDim.x * NT;
  {
    const float* modp = (const float*)(WS(P) + O_MODP);
    float* mod = (float*)(WS(P) + O_MOD);
    for (long i = gtid; i < (long)4 * 16 * 6144; i += gsz) {
      int n = (int)(i % 6144);
      int l = (int)(i / (16 * 6144));
      float s = P.in[5][l * 6144 + n];
      for (int ks = 0; ks < 8; ++ks) s += modp[(long)ks * 4 * 16 * 6144 + i];
      mod[i] = s;
    }
  }
  float2* buf = (float2*)smem;
  const float2* tw = (const float2*)(WS(P) + O_TW);
  for (int item = BID(); item < 2048; item += gridDim.x) {
    const int sel = item >> 10, c = item & 1023;
    const int L = sel ? 2048 : 8192, N = 2 * L;
    const float* hid = (const float*)(WS(P) + (sel ? O_HIDP : O_HIDS));
    float2* hs = (float2*)(WS(P) + (sel ? O_HSPP : O_HSPS)) + (long)c * N;
    __syncthreads();
    if (tid < 128) {
      int dirn = tid >> 6, j = tid & 63;
      w3s[tid] = P.in[14][(long)j * 2048 + dirn * 1024 + c];
    }
    __syncthreads();
    const float dec0 = fabsf(P.in[16][c]), dec1 = fabsf(P.in[16][1024 + c]);
    const float invLm1 = 1.f / (float)(L - 1);
    float asum = 0.f;
    for (int n = tid; n < N; n += NT) {
      float val = 0.f;
      if (n != L) {
        const int dirn = n < L ? 0 : 1;
        const int t = n < L ? n : N - n;
        const float4* hr = (const float4*)(hid + (long)t * 64);
        const float* w = w3s + dirn * 64;
        float s = 0.f;
#pragma unroll
        for (int q = 0; q < 16; ++q) {
          float4 h4 = hr[q];
          s += h4.x * w[4 * q] + h4.y * w[4 * q + 1] + h4.z * w[4 * q + 2] + h4.w * w[4 * q + 3];
        }
        float tl = (float)t * invLm1;
        val = s * expf(-tl * (dirn ? dec1 : dec0));
      }
      buf[n] = make_float2(val, 0.f);
      asum += fabsf(val);
    }
    asum = wave_sum(asum);
    if (lane == 0) red[wid] = asum;
    __syncthreads();
    float tot = 0.f;
#pragma unroll
    for (int w = 0; w < 8; ++w) tot += red[w];
    const float scale = 1.f / (tot * (float)N);
    fft_dif(buf, N, tw);
    for (int p = tid; p < N; p += NT) {
      float2 a = buf[p];
      hs[p] = make_float2(a.x * scale, a.y * scale);
    }
  }
  __syncthreads();
}

__device__ void phase_norm(const Params& P, int layer, int slab, int which) {
  const float* __restrict__ x = (layer == 0 && which == 0) ? xin_of(P, slab) : (const float*)(OUTP(P) + (long)slab * SLAB * D);
  u16* __restrict__ h = (u16*)(WS(P) + O_HBUF);
  const float* gain = P.in[6] + (layer * 2 + which) * D;
  const float* mod = (const float*)(WS(P) + O_MOD) + (long)layer * 16 * 6144;
  const int shoff = which ? 3 * D : 0, scoff = which ? 4 * D : D;
  const int tid = TID(), lane = tid & 63, wid = tid >> 6;
  for (int item = BID(); item < SLAB / 32; item += gridDim.x) {
    const int r0 = item * 32 + wid * 4;
    float4 v[4][4];
    float ss[4];
#pragma unroll
    for (int u = 0; u < 4; ++u) {
      const float* xr = x + (long)(r0 + u) * D;
      float a = 0.f;
#pragma unroll
      for (int i = 0; i < 4; ++i) {
        v[u][i] = *(const float4*)(xr + i * 256 + lane * 4);
        a += v[u][i].x * v[u][i].x + v[u][i].y * v[u][i].y + v[u][i].z * v[u][i].z + v[u][i].w * v[u][i].w;
      }
      ss[u] = a;
    }
    const float* m = mod + (long)gb_of(slab, r0) * 6144;
#pragma unroll
    for (int u = 0; u < 4; ++u) ss[u] = wave_sum(ss[u]);
#pragma unroll
    for (int i = 0; i < 4; ++i) {
      const int col = i * 256 + lane * 4;
      const float4 g = *(const float4*)(gain + col);
      const float4 sc = *(const float4*)(m + scoff + col);
      const float4 sh = *(const float4*)(m + shoff + col);
      const float a0 = g.x * (1.f + sc.x), a1 = g.y * (1.f + sc.y), a2 = g.z * (1.f + sc.z), a3 = g.w * (1.f + sc.w);
#pragma unroll
      for (int u = 0; u < 4; ++u) {
        const float rstd = rsqrtf(ss[u] * (1.f / 1024.f) + 1e-6f);
        const float y0 = v[u][i].x * rstd * a0 + sh.x, y1 = v[u][i].y * rstd * a1 + sh.y;
        const float y2 = v[u][i].z * rstd * a2 + sh.z, y3 = v[u][i].w * rstd * a3 + sh.w;
        *(uint2*)(h + (long)(r0 + u) * D + col) = make_uint2(pack2(y0, y1), pack2(y2, y3));
      }
    }
  }
}

__device__ void phase_proj(const Params& P, size_t woff, int N) {
  EpiStoreBf16 E; E.O = (u16*)(WS(P) + O_PROJ); E.ldc = N;
  run_gemm((const u16*)(WS(P) + O_HBUF), (const u16*)(WS(P) + woff), N, D, E);
}
__device__ void phase_resid(const Params& P, int layer, int slab, const u16* A, int K, size_t woff, int goff) {
  EpiResid E; E.X = OUTP(P) + (long)slab * SLAB * D; E.XS = (layer == 0 && goff == 2 * D) ? xin_of(P, slab) : (const float*)E.X; E.mod = (const float*)(WS(P) + O_MOD) + (long)layer * 16 * 6144; E.goff = goff; E.slab = slab;
  run_gemm(A, (const u16*)(WS(P) + woff), D, K, E);
}

__device__ void phase_ffn_gate(const Params& P, int layer) {
  EpiStoreBf16 E; E.O = (u16*)(WS(P) + O_GBUF); E.ldc = DFF;
  run_gemm((const u16*)(WS(P) + O_HBUF), (const u16*)(WS(P) + O_WFG) + (long)layer * DFF * D, DFF, D, E);
}
__device__ void phase_ffn_val(const Params& P, int layer, int slab) {
  EpiFfnVal E; E.G = (const u16*)(WS(P) + O_GBUF); E.ACT = (u16*)(WS(P) + O_ACT);
  E.cw = P.in[33] + (long)layer * 3 * DFF; E.cb = P.in[34] + (long)layer * DFF; E.L = Lof(slab);
  run_gemm((const u16*)(WS(P) + O_HBUF), (const u16*)(WS(P) + O_WFV) + (long)layer * DFF * D, DFF, D, E);
}

__device__ void phase_hy_conv(const Params& P, int slab) {
  const int L = Lof(slab), nseq = SLAB / L, tid = TID();
  const u16* z = (const u16*)(WS(P) + O_PROJ);
  float* uT = (float*)(WS(P) + O_UT);
  u16* x0c = (u16*)(WS(P) + O_X0C);
  const float* cw = P.in[8];
  const float* cb = P.in[9];
  float* tile = (float*)smem;
  const int ntt = L / 64;
  const int nitems = nseq * ntt * 16;
  for (int item = BID(); item < nitems; item += gridDim.x) {
    const int ct = item % 16, tt = (item / 16) % ntt, seq = item / (16 * ntt);
    __syncthreads();
    for (int i = tid; i < 4096; i += NT) {
      const int tl = i >> 6, cl = i & 63;
      const int t = tt * 64 + tl, c = ct * 64 + cl;
      const long row = (long)seq * L + t;
      float val[3];
#pragma unroll
      for (int q = 0; q < 3; ++q) {
        const int col = q * 1024 + c;
        float a = bf2f(z[row * 3072 + col]) * cw[3072 + col] + cb[col];
        if (t > 0) a += bf2f(z[(row - 1) * 3072 + col]) * cw[col];
        if (t < L - 1) a += bf2f(z[(row + 1) * 3072 + col]) * cw[2 * 3072 + col];
        val[q] = a;
      }
      x0c[row * 1024 + c] = f2bf(val[0]);
      tile[tl * 65 + cl] = val[1] * val[2];
    }
    __syncthreads();
    for (int i = tid; i < 4096; i += NT) {
      const int cl = i >> 6, tl = i & 63;
      uT[((long)seq * 1024 + ct * 64 + cl) * L + tt * 64 + tl] = tile[tl * 65 + cl];
    }
  }
  __syncthreads();
}

__device__ void phase_hy_fft(const Params& P, int slab, bool dry = false) {
  const int L = Lof(slab), N = 2 * L, nseq = SLAB / L, tid = TID();
  float* uT = (float*)(WS(P) + O_UT);
  const float2* hsb = (const float2*)(WS(P) + (slab == 0 ? O_HSPP : O_HSPS));
  const float2* tw = (const float2*)(WS(P) + O_TW);
  const float* skip = P.in[17];
  float2* buf = (float2*)smem;
  const int nitems = (nseq / 2) * 1024;
  for (int item = BID(); item < nitems; item += gridDim.x) {
    const int pr = item >> 10, c = item & 1023;
    float* u0 = uT + ((long)(pr * 2) * 1024 + c) * L;
    float* u1 = u0 + (long)1024 * L;
    __syncthreads();
    for (int t = tid; t < L; t += NT) {
      buf[t] = make_float2(u0[t], u1[t]);
      buf[t + L] = make_float2(0.f, 0.f);
    }
    __syncthreads();
    fft_dif(buf, N, tw);
    const float2* h = hsb + (long)c * N;
    for (int p = tid; p < N; p += NT) {
      float2 a = buf[p], b = h[p];
      buf[p] = make_float2(a.x * b.x - a.y * b.y, a.x * b.y + a.y * b.x);
    }
    __syncthreads();
    ifft_dit(buf, N, tw);
    const float sk = skip[c];
    for (int t = tid; t < L; t += NT) {
      float2 y = buf[t];
      const long doff = dry ? (long)(END_HY - O_UT) / 4 : 0;
      u0[t + doff] = y.x + u0[t] * sk;
      u1[t + doff] = y.y + u1[t] * sk;
    }
  }
  __syncthreads();
}

__device__ void phase_hy_tr(const Params& P, int slab) {
  const int L = Lof(slab), nseq = SLAB / L, tid = TID();
  const float* yT = (const float*)(WS(P) + O_UT);
  const u16* x0c = (const u16*)(WS(P) + O_X0C);
  u16* a2 = (u16*)(WS(P) + O_A2);
  float* tile = (float*)smem;
  const int ntt = L / 64;
  const int nitems = nseq * ntt * 16;
  for (int item = BID(); item < nitems; item += gridDim.x) {
    const int ct = item % 16, tt = (item / 16) % ntt, seq = item / (16 * ntt);
    __syncthreads();
    for (int i = tid; i < 4096; i += NT) {
      const int cl = i >> 6, tl = i & 63;
      tile[cl * 65 + tl] = yT[((long)seq * 1024 + ct * 64 + cl) * L + tt * 64 + tl];
    }
    __syncthreads();
    for (int i = tid; i < 4096; i += NT) {
      const int tl = i >> 6, cl = i & 63;
      const long row = (long)seq * L + tt * 64 + tl;
      const int c = ct * 64 + cl;
      a2[row * 1024 + c] = f2bf(tile[cl * 65 + tl] * bf2f(x0c[row * 1024 + c]));
    }
  }
  __syncthreads();
}

struct Rec {
  int H, DK, DV, C;
  int ldv, voff, goff;
};
__device__ __forceinline__ Rec rec_of(int kind) {
  Rec r;
  if (kind == 1) { r.H = 4; r.DK = 256; r.DV = 512; r.C = 128; r.ldv = 6144; r.voff = 2048; r.goff = 4096; }
  else { r.H = 8; r.DK = 128; r.DV = 128; r.C = 64; r.ldv = 5120; r.voff = 1024; r.goff = 4096; }
  return r;
}

__device__ __forceinline__ void unpack8(const uint4 v, float (&f)[8]) {
  f[0] = bf2f((u16)(v.x & 0xffff)); f[1] = bf2f((u16)(v.x >> 16)); f[2] = bf2f((u16)(v.y & 0xffff)); f[3] = bf2f((u16)(v.y >> 16));
  f[4] = bf2f((u16)(v.z & 0xffff)); f[5] = bf2f((u16)(v.z >> 16)); f[6] = bf2f((u16)(v.w & 0xffff)); f[7] = bf2f((u16)(v.w >> 16));
}
__device__ __forceinline__ uint4 pack8s(const float (&f)[8], float sc) {
  return make_uint4(pack2(f[0] * sc, f[1] * sc), pack2(f[2] * sc, f[3] * sc), pack2(f[4] * sc, f[5] * sc), pack2(f[6] * sc, f[7] * sc));
}
__device__ void phase_ret_prep(const Params& P, int slab) {
  const int L = Lof(slab);
  const u16* __restrict__ pj = (const u16*)(WS(P) + O_PROJ);
  u16* __restrict__ qdf = (u16*)(WS(P) + O_QDF); u16* __restrict__ qdb = (u16*)(WS(P) + O_QDB);
  u16* __restrict__ kif = (u16*)(WS(P) + O_KIF); u16* __restrict__ kib = (u16*)(WS(P) + O_KIB);
  u16* __restrict__ kef = (u16*)(WS(P) + O_KEF); u16* __restrict__ keb = (u16*)(WS(P) + O_KEB);
  float* dlf = (float*)(WS(P) + O_DLF); float* dlb = (float*)(WS(P) + O_DLB);
  const float2* __restrict__ rope = (const float2*)(WS(P) + O_ROPER);
  const long gtid = (long)BID() * NT + TID(), gsz = (long)gridDim.x * NT;
  for (long idx = gtid; idx < (long)SLAB * 64; idx += gsz) {
    const int d0 = (int)(idx & 15) * 8, h = (int)((idx >> 4) & 3), t = (int)(idx >> 6);
    const int pos = t & (L - 1), r = t & 127;
    const float lgf = -expf(P.in[20][h]), lgb = -expf(P.in[20][4 + h]);
    const u16* row = pj + (long)t * 6144 + h * 256 + d0;
    const uint4 vq1 = *(const uint4*)row, vq2 = *(const uint4*)(row + 128);
    const uint4 vk1 = *(const uint4*)(row + 1024), vk2 = *(const uint4*)(row + 1024 + 128);
    const float4* rp = (const float4*)(rope + (long)pos * 128 + d0);
    const float4 c01 = rp[0], c23 = rp[1], c45 = rp[2], c67 = rp[3];
    float q1[8], q2[8], k1[8], k2[8];
    unpack8(vq1, q1); unpack8(vq2, q2); unpack8(vk1, k1); unpack8(vk2, k2);
    const float cs[8] = {c01.x, c01.z, c23.x, c23.z, c45.x, c45.z, c67.x, c67.z};
    const float sn[8] = {c01.y, c01.w, c23.y, c23.w, c45.y, c45.w, c67.y, c67.w};
    float qa[8], qb[8], ka[8], kb[8];
#pragma unroll
    for (int i = 0; i < 8; ++i) {
      qa[i] = q1[i] * cs[i] - q2[i] * sn[i]; qb[i] = q1[i] * sn[i] + q2[i] * cs[i];
      ka[i] = (k1[i] * cs[i] - k2[i] * sn[i]) * 0.0625f; kb[i] = (k1[i] * sn[i] + k2[i] * cs[i]) * 0.0625f;
    }
    const float bf = (float)(r + 1) * lgf, bb = (float)(128 - r) * lgb;
    const float ef = expf(bf), eif = expf(-bf), eef = expf((float)(127 - r) * lgf);
    const float eb = expf(bb), eib = expf(-bb), eeb = expf((float)r * lgb);
    const long o1 = (long)t * 1024 + h * 256 + d0, o2 = o1 + 128;
    *(uint4*)(qdf + o1) = pack8s(qa, ef); *(uint4*)(qdf + o2) = pack8s(qb, ef);
    *(uint4*)(qdb + o1) = pack8s(qa, eb); *(uint4*)(qdb + o2) = pack8s(qb, eb);
    *(uint4*)(kif + o1) = pack8s(ka, eif); *(uint4*)(kif + o2) = pack8s(kb, eif);
    *(uint4*)(kib + o1) = pack8s(ka, eib); *(uint4*)(kib + o2) = pack8s(kb, eib);
    *(uint4*)(kef + o1) = pack8s(ka, eef); *(uint4*)(kef + o2) = pack8s(kb, eef);
    *(uint4*)(keb + o1) = pack8s(ka, eeb); *(uint4*)(keb + o2) = pack8s(kb, eeb);
    if (r == 0) {
      const long cgi = (long)(t >> 7) * 1024 + h * 256 + d0;
      const float df = expf(128.f * lgf), db = expf(128.f * lgb);
#pragma unroll
      for (int i = 0; i < 8; ++i) { dlf[cgi + i] = df; dlf[cgi + 128 + i] = df; dlb[cgi + i] = db; dlb[cgi + 128 + i] = db; }
    }
  }
}

__device__ __forceinline__ float lb_of(const float* lbt, int dr, int ch) {
  const float a0 = lbt[(dr * 4 + 0) * 1024 + ch], a1 = lbt[(dr * 4 + 1) * 1024 + ch], a2 = lbt[(dr * 4 + 2) * 1024 + ch], a3 = lbt[(dr * 4 + 3) * 1024 + ch];
  const float m = fmaxf(fmaxf(a0, a1), fmaxf(a2, a3));
  const float e0 = expf(a0 - m), e1 = expf(a1 - m), e2 = expf(a2 - m), e3 = expf(a3 - m);
  return (e0 + e1 + e2) / (e0 + e1 + e2 + e3);
}
__device__ void phase_hg_prep(const Params& P) {
  const u16* __restrict__ pj = (const u16*)(WS(P) + O_PROJ);
  u16* __restrict__ qdf = (u16*)(WS(P) + O_QDF); u16* __restrict__ qdb = (u16*)(WS(P) + O_QDB);
  u16* __restrict__ kif = (u16*)(WS(P) + O_KIF); u16* __restrict__ kib = (u16*)(WS(P) + O_KIB);
  u16* __restrict__ kef = (u16*)(WS(P) + O_KEF); u16* __restrict__ keb = (u16*)(WS(P) + O_KEB);
  float* dlf = (float*)(WS(P) + O_DLF); float* dlb = (float*)(WS(P) + O_DLB);
  const float* lbt = P.in[28];
  float* totF = (float*)smem;
  float* totB = totF + 1024;
  const int tid = TID(), lane = tid & 63, rg = tid >> 6;
  for (int item = BID(); item < 2048; item += gridDim.x) {
    const int cgi = item >> 3, ch = (item & 7) * 128 + lane * 2;
    const long t0 = (long)cgi * 64 + rg * 8;
    unsigned wq[8], wf[8], wb[8];
#pragma unroll
    for (int i = 0; i < 8; ++i) {
      const u16* row = pj + (t0 + i) * 5120 + ch;
      wq[i] = *(const unsigned*)row; wf[i] = *(const unsigned*)(row + 2048); wb[i] = *(const unsigned*)(row + 3072);
    }
    float lb0[2], lb1[2];
    lb0[0] = lb_of(lbt, 0, ch); lb0[1] = lb_of(lbt, 0, ch + 1);
    lb1[0] = lb_of(lbt, 1, ch); lb1[1] = lb_of(lbt, 1, ch + 1);
    float pf[2][8], sb[2][8], accf[2], accb[2];
#pragma unroll
    for (int c = 0; c < 2; ++c) {
      float a = 0.f;
#pragma unroll
      for (int i = 0; i < 8; ++i) {
        const float x = bf2f((u16)(c ? (wf[i] >> 16) : (wf[i] & 0xffff)));
        a += logf(lb0[c] + (1.f - lb0[c]) * sigm(x)); pf[c][i] = a;
      }
      accf[c] = a;
      a = 0.f;
#pragma unroll
      for (int i = 7; i >= 0; --i) {
        const float x = bf2f((u16)(c ? (wb[i] >> 16) : (wb[i] & 0xffff)));
        a += logf(lb1[c] + (1.f - lb1[c]) * sigm(x)); sb[c][i] = a;
      }
      accb[c] = a;
    }
    __syncthreads();
    *(float2*)(totF + rg * 128 + lane * 2) = make_float2(accf[0], accf[1]);
    *(float2*)(totB + rg * 128 + lane * 2) = make_float2(accb[0], accb[1]);
    __syncthreads();
    float offF[2] = {0.f, 0.f}, offB[2] = {0.f, 0.f}, totf[2] = {0.f, 0.f}, totb[2] = {0.f, 0.f};
#pragma unroll
    for (int g = 0; g < 8; ++g) {
      const float2 f = *(const float2*)(totF + g * 128 + lane * 2), bq = *(const float2*)(totB + g * 128 + lane * 2);
      totf[0] += f.x; totf[1] += f.y; totb[0] += bq.x; totb[1] += bq.y;
      if (g < rg) { offF[0] += f.x; offF[1] += f.y; }
      if (g > rg) { offB[0] += bq.x; offB[1] += bq.y; }
    }
#pragma unroll
    for (int i = 0; i < 8; ++i) {
      float o[6][2];
#pragma unroll
      for (int c = 0; c < 2; ++c) {
        const float xq = bf2f((u16)(c ? (wq[i] >> 16) : (wq[i] & 0xffff)));
        const float xf = bf2f((u16)(c ? (wf[i] >> 16) : (wf[i] & 0xffff)));
        const float xb = bf2f((u16)(c ? (wb[i] >> 16) : (wb[i] & 0xffff)));
        const float q = silu_f(xq);
        const float bf = offF[c] + pf[c][i], bb = offB[c] + sb[c][i];
        const float kf = (1.f - lb0[c]) * sigm(-xf), kb = (1.f - lb1[c]) * sigm(-xb);
        o[0][c] = q * expf(bf); o[1][c] = kf * expf(-bf); o[2][c] = kf * expf(totf[c] - bf);
        o[3][c] = q * expf(bb); o[4][c] = kb * expf(-bb); o[5][c] = kb * expf(totb[c] - bb);
      }
      const long oo = (t0 + i) * 1024 + ch;
      *(unsigned*)(qdf + oo) = pack2(o[0][0], o[0][1]);
      *(unsigned*)(kif + oo) = pack2(o[1][0], o[1][1]);
      *(unsigned*)(kef + oo) = pack2(o[2][0], o[2][1]);
      *(unsigned*)(qdb + oo) = pack2(o[3][0], o[3][1]);
      *(unsigned*)(kib + oo) = pack2(o[4][0], o[4][1]);
      *(unsigned*)(keb + oo) = pack2(o[5][0], o[5][1]);
    }
    if (rg == 0) {
      *(float2*)(dlf + (long)cgi * 1024 + ch) = make_float2(expf(totf[0]), expf(totf[1]));
      *(float2*)(dlb + (long)cgi * 1024 + ch) = make_float2(expf(totb[0]), expf(totb[1]));
    }
  }
  __syncthreads();
}

template <int C>
__device__ __forceinline__ void rec_scores_item(const Params& P, const Rec& R, int cgi, int h) {
  const u16* qdf = (const u16*)(WS(P) + O_QDF); const u16* qdb = (const u16*)(WS(P) + O_QDB);
  const u16* kif = (const u16*)(WS(P) + O_KIF); const u16* kib = (const u16*)(WS(P) + O_KIB);
  u16* sc = (u16*)(WS(P) + O_SC) + ((long)cgi * R.H + h) * C * C;
  const long off = (long)cgi * C * 1024 + h * R.DK;
  f32x4 af[C / 32][C / 64] = {}, ab[C / 32][C / 64] = {};
  gemm_acc<C, C, true, true, true, (C == 128 ? 4 : 2)>(af, qdf + off, 1024, kif + off, 1024, (u16*)smem);
  gemm_acc<C, C, true, true, true, (C == 128 ? 4 : 2)>(ab, qdb + off, 1024, kib + off, 1024, (u16*)smem);
  const int tid = TID(), lane = tid & 63, wid = tid >> 6;
  const int wm = wid >> 2, wn = wid & 3, fr = lane & 15, fq = lane >> 4;
#pragma unroll
  for (int mi = 0; mi < C / 32; ++mi)
#pragma unroll
    for (int ni = 0; ni < C / 64; ++ni) {
      const int r = wm * (C / 2) + mi * 16 + fr, c0 = wn * (C / 4) + ni * 16 + fq * 4;
      float v[4];
#pragma unroll
      for (int j = 0; j < 4; ++j) {
        const int c = c0 + j;
        v[j] = (c <= r ? af[mi][ni][j] : 0.f) + (c >= r ? ab[mi][ni][j] : 0.f);
      }
      *(uint2*)(sc + r * C + c0) = make_uint2(pack2(v[0], v[1]), pack2(v[2], v[3]));
    }
}

template <int C>
__device__ void phase_rec_su(const Params& P, int kind) {
  const Rec R = rec_of(kind);
  const int nch = SLAB / C;
  const int n_sc = nch * R.H;
  const int mtn = R.DK / 128, ntn = R.DV / 128;
  const int n_u = nch * R.H * 2 * mtn * ntn;
  const u16* pj = (const u16*)(WS(P) + O_PROJ);
  for (int item = BID(); item < n_sc + n_u; item += gridDim.x) {
    if (item < n_sc) {
      rec_scores_item<C>(P, R, item / R.H, item % R.H);
    } else {
      int q = item - n_sc;
      const int nt = q % ntn; q /= ntn;
      const int mt = q % mtn; q /= mtn;
      const int dir = q & 1; q >>= 1;
      const int h = q % R.H, cgi = q / R.H;
      const u16* ke = (const u16*)(WS(P) + (dir ? O_KEB : O_KEF)) + (long)cgi * C * 1024 + h * R.DK + mt * 128;
      const u16* v = pj + (long)cgi * C * R.ldv + R.voff + h * R.DV + nt * 128;
      u16* st = (u16*)(WS(P) + (dir ? O_STB : O_STF)) + (((long)cgi * R.H + h) * R.DV + nt * 128) * R.DK + mt * 128;
      f32x4 acc[4][2] = {};
      gemm_acc<128, 128, false, false, false, C / 64>(acc, ke, 1024, v, R.ldv, (u16*)smem);
      const int DK = R.DK;
      epi_each<128, 128, false>(acc, [&](int r, int c, f32x4 val) {
        *(uint2*)(st + (long)c * DK + r) = make_uint2(pack2(val[0], val[1]), pack2(val[2], val[3]));
      });
    }
  }
}

__device__ void phase_rec_scan(const Params& P, int kind, int slab, bool dry = false) {
  const Rec R = rec_of(kind);
  const int L = Lof(slab), nseq = SLAB / L, ncs = L / R.C;
  const int qdk = R.DK / 4;
  const long per = (long)R.H * R.DV * qdk;
  const long total = 2 * nseq * per;
  const long gtid = (long)BID() * NT + TID(), gsz = (long)gridDim.x * NT;
  for (long idx = gtid; idx < total; idx += gsz) {
    long q = idx;
    const int pd = (int)(q % qdk); q /= qdk;
    const int e = (int)(q % R.DV); q /= R.DV;
    const int h = (int)(q % R.H); q /= R.H;
    const int seq = (int)(q % nseq);
    const int dir = (int)(q / nseq);
    u16* st = (u16*)(WS(P) + (dir ? O_STB : O_STF));
    u16* stw = dry ? (u16*)(WS(P) + O_OBUF) : st;
    const float* dl = (const float*)(WS(P) + (dir ? O_DLB : O_DLF));
    float s0 = 0.f, s1 = 0.f, s2 = 0.f, s3 = 0.f;
    const long ebase = ((long)h * R.DV + e) * R.DK + pd * 4;
    const long cstride = (long)R.H * R.DV * R.DK;
    const int dbase = h * R.DK + pd * 4;
    for (int i0 = 0; i0 < ncs; i0 += 8) {
      uint2 u[8];
      float4 dd[8];
#pragma unroll
      for (int j = 0; j < 8; ++j) {
        const int n = dir ? (ncs - 1 - i0 - j) : (i0 + j);
        const long cgi = (long)seq * ncs + n;
        u[j] = *(const uint2*)(st + cgi * cstride + ebase);
        dd[j] = *(const float4*)(dl + cgi * 1024 + dbase);
      }
#pragma unroll
      for (int j = 0; j < 8; ++j) {
        const int n = dir ? (ncs - 1 - i0 - j) : (i0 + j);
        const long cgi = (long)seq * ncs + n;
        *(uint2*)(stw + cgi * cstride + ebase) = make_uint2(pack2(s0, s1), pack2(s2, s3));
        s0 = dd[j].x * s0 + bf2f((u16)(u[j].x & 0xffff));
        s1 = dd[j].y * s1 + bf2f((u16)(u[j].x >> 16));
        s2 = dd[j].z * s2 + bf2f((u16)(u[j].y & 0xffff));
        s3 = dd[j].w * s3 + bf2f((u16)(u[j].y >> 16));
      }
    }
  }
}

template <int C>
__device__ void phase_rec_out(const Params& P, int kind) {
  const Rec R = rec_of(kind);
  const int nch = SLAB / C, ntn = R.DV / 128;
  const u16* pj = (const u16*)(WS(P) + O_PROJ);
  float* ob = (float*)(WS(P) + O_OBUF);
  const int HDV = R.H * R.DV;
  for (int item = BID(); item < nch * R.H * ntn; item += gridDim.x) {
    const int nt = item % ntn, h = (item / ntn) % R.H, cgi = item / (ntn * R.H);
    f32x4 acc[C / 32][2] = {};
    const u16* sc = (const u16*)(WS(P) + O_SC) + ((long)cgi * R.H + h) * C * C;
    const u16* v = pj + (long)cgi * C * R.ldv + R.voff + h * R.DV + nt * 128;
    gemm_acc<C, 128, true, false, true, C / 64>(acc, sc, C, v, R.ldv, (u16*)smem);
    const long qoff = (long)cgi * C * 1024 + h * R.DK;
    const long soff = (((long)cgi * R.H + h) * R.DV + nt * 128) * R.DK;
    gemm_acc<C, 128, true, true, true, (C == 128 ? 4 : 2)>(acc, (const u16*)(WS(P) + O_QDF) + qoff, 1024, (const u16*)(WS(P) + O_STF) + soff, R.DK, (u16*)smem);
    gemm_acc<C, 128, true, true, true, (C == 128 ? 4 : 2)>(acc, (const u16*)(WS(P) + O_QDB) + qoff, 1024, (const u16*)(WS(P) + O_STB) + soff, R.DK, (u16*)smem);
    float* o = ob + (long)cgi * C * HDV + h * R.DV + nt * 128;
    epi_each<C, 128, true>(acc, [&](int r, int c, f32x4 val) { *(f32x4*)(o + (long)r * HDV + c) = val; });
  }
}

template <int KIND>
__device__ void phase_rec_ng_t(const Params& P) {
  const Rec R = rec_of(KIND);
  constexpr int DV = (KIND == 1) ? 512 : 128, H = (KIND == 1) ? 4 : 8, PER = DV / 64, HDV = H * DV;
  const float* __restrict__ ob = (const float*)(WS(P) + O_OBUF);
  const u16* __restrict__ pj = (const u16*)(WS(P) + O_PROJ);
  u16* __restrict__ a2 = (u16*)(WS(P) + O_A2);
  const float* gain = P.in[29];
  const int tid = TID(), lane = tid & 63, wid = tid >> 6;
  constexpr int nrows = SLAB * H;
  for (int item = BID(); item < nrows / 32; item += gridDim.x) {
    float v[4][PER];
    float ss[4];
#pragma unroll
    for (int u = 0; u < 4; ++u) {
      const int rh = item * 32 + wid * 4 + u;
      const int t = rh / H, h = rh % H;
      const float* o = ob + (long)t * HDV + h * DV + lane * PER;
      if (PER == 8) {
        const float4 a = *(const float4*)o, b = *(const float4*)(o + 4);
        v[u][0] = a.x; v[u][1] = a.y; v[u][2] = a.z; v[u][3] = a.w; v[u][4 % PER] = b.x; v[u][5 % PER] = b.y; v[u][6 % PER] = b.z; v[u][7 % PER] = b.w;
      } else {
        const float2 a = *(const float2*)o;
        v[u][0] = a.x; v[u][1] = a.y;
      }
      float a = 0.f;
#pragma unroll
      for (int i = 0; i < PER; ++i) a += v[u][i] * v[u][i];
      ss[u] = a;
    }
#pragma unroll
    for (int u = 0; u < 4; ++u) ss[u] = wave_sum(ss[u]);
#pragma unroll
    for (int u = 0; u < 4; ++u) {
      const int rh = item * 32 + wid * 4 + u;
      const int t = rh / H, h = rh % H;
      const float rstd = rsqrtf(ss[u] / (float)DV + 1e-6f);
      const u16* g = pj + (long)t * R.ldv + R.goff + h * DV + lane * PER;
      u16* out = a2 + (long)t * HDV + h * DV + lane * PER;
      float y[PER];
#pragma unroll
      for (int i = 0; i < PER; ++i) {
        y[i] = v[u][i] * rstd;
        if (KIND == 3) y[i] *= gain[lane * PER + i];
      }
      if (PER == 8) {
        const uint4 gw = *(const uint4*)g;
        float gf[8];
        unpack8(gw, gf);
        float r8[8];
#pragma unroll
        for (int i = 0; i < 8; ++i) r8[i] = y[i % PER] * silu_f(gf[i]);
        *(uint4*)out = pack8s(r8, 1.f);
      } else {
        const unsigned gw = *(const unsigned*)g;
        *(unsigned*)out = pack2(y[0] * silu_f(bf2f((u16)(gw & 0xffff))), y[1 % PER] * silu_f(bf2f((u16)(gw >> 16))));
      }
    }
  }
}
__device__ void phase_rec_ng(const Params& P, int kind) {
  if (kind == 1) phase_rec_ng_t<1>(P); else phase_rec_ng_t<3>(P);
}

__device__ void phase_swa_prep(const Params& P, int slab) {
  const int L = Lof(slab);
  const u16* pj = (const u16*)(WS(P) + O_PROJ);
  u16* qn = (u16*)(WS(P) + O_QN);
  u16* kn = (u16*)(WS(P) + O_KN);
  const float2* rope = (const float2*)(WS(P) + O_ROPES);
  const long gtid = (long)BID() * NT + TID(), gsz = (long)gridDim.x * NT;
  for (long idx = gtid; idx < (long)SLAB * 640; idx += gsz) {
    const int d = (int)(idx & 31);
    const int hd = (int)((idx >> 5) % 20);
    const int t = (int)(idx / 640);
    const int col = hd < 16 ? hd * 64 : 1024 + (hd - 16) * 64;
    const float x1 = bf2f(pj[(long)t * 1536 + col + d]), x2 = bf2f(pj[(long)t * 1536 + col + d + 32]);
    float ss = x1 * x1 + x2 * x2;
#pragma unroll
    for (int o = 16; o; o >>= 1) ss += __shfl_xor(ss, o);
    const float rstd = rsqrtf(ss * (1.f / 64.f) + 1e-6f);
    const float* gn = hd < 16 ? P.in[23] : P.in[24];
    const float y1 = x1 * rstd * gn[d], y2 = x2 * rstd * gn[d + 32];
    const float2 cs = rope[(long)(t & (L - 1)) * 32 + d];
    float o1 = y1 * cs.x - y2 * cs.y, o2 = y1 * cs.y + y2 * cs.x;
    if (hd < 16) {
      qn[(long)t * 1024 + hd * 64 + d] = f2bf(o1 * 0.125f);
      qn[(long)t * 1024 + hd * 64 + d + 32] = f2bf(o2 * 0.125f);
    } else {
      kn[(long)t * 256 + (hd - 16) * 64 + d] = f2bf(o1);
      kn[(long)t * 256 + (hd - 16) * 64 + d + 32] = f2bf(o2);
    }
  }
}

constexpr int SLD = 324;
__device__ void phase_swa_att1(const Params& P, int slab) {
  const int L = Lof(slab), nqb = L / 64;
  const u16* qn = (const u16*)(WS(P) + O_QN);
  const u16* kn = (const u16*)(WS(P) + O_KN);
  u16* pb = (u16*)(WS(P) + O_PBUF);
  const float* sink = P.in[25];
  float* S = (float*)(smem + 40960);
  const int tid = TID();
  const int nitems = (SLAB / 64) * 16;
  for (int item = BID(); item < nitems; item += gridDim.x) {
    const int hq = item & 15, qbg = item >> 4;
    const int seq = qbg / nqb, qb = qbg % nqb;
    const int q0 = qb * 64;
    const long tok0 = (long)seq * L;
    const int hkv = hq >> 2;
    for (int kt = 0; kt < 5; ++kt) {
      const int kp0 = q0 - 128 + kt * 64;
      if (kp0 >= 0 && kp0 < L) {
        f32x4 acc[2][1] = {};
        gemm_acc<64, 64, true, true, true, 1>(acc, qn + (tok0 + q0) * 1024 + hq * 64, 1024, kn + (tok0 + kp0) * 256 + hkv * 64, 256, (u16*)smem);
        epi_each<64, 64, true>(acc, [&](int r, int c, f32x4 v) {
          f32x4 o;
#pragma unroll
          for (int j = 0; j < 4; ++j) {
            const int dlt = (q0 + r) - (kp0 + c + j);
            o[j] = (dlt <= 128 && dlt >= -128) ? v[j] : -1e30f;
          }
          *(f32x4*)(S + r * SLD + kt * 64 + c) = o;
        });
      } else {
        for (int i = tid; i < 4096; i += NT) S[(i >> 6) * SLD + kt * 64 + (i & 63)] = -1e30f;
      }
    }
    __syncthreads();
    {
      const int r = tid >> 3, sub = tid & 7;
      const float sk = sink[hq];
      float m = sk;
      for (int c = sub; c < 320; c += 8) m = fmaxf(m, S[r * SLD + c]);
      m = fmaxf(m, __shfl_xor(m, 1)); m = fmaxf(m, __shfl_xor(m, 2)); m = fmaxf(m, __shfl_xor(m, 4));
      float den = 0.f;
      for (int c = sub; c < 320; c += 8) { float e = __expf(S[r * SLD + c] - m); S[r * SLD + c] = e; den += e; }
      den += __shfl_xor(den, 1); den += __shfl_xor(den, 2); den += __shfl_xor(den, 4);
      den += __expf(sk - m);
      const float inv = 1.f / den;
      u16* prow = pb + ((long)item * 64 + r) * 320;
      for (int c = sub; c < 320; c += 8) prow[c] = f2bf(S[r * SLD + c] * inv);
    }
    __syncthreads();
  }
}

__device__ void phase_swa_att2(const Params& P, int slab) {
  const int L = Lof(slab), nqb = L / 64;
  const u16* pj = (const u16*)(WS(P) + O_PROJ);
  const u16* pb = (const u16*)(WS(P) + O_PBUF);
  u16* a2 = (u16*)(WS(P) + O_A2);
  const int nitems = (SLAB / 64) * 16;
  for (int item = BID(); item < nitems; item += gridDim.x) {
    const int hq = item & 15, qbg = item >> 4;
    const int seq = qbg / nqb, qb = qbg % nqb;
    const int q0 = qb * 64;
    const long tok0 = (long)seq * L;
    const int hkv = hq >> 2;
    f32x4 acc[2][1] = {};
    for (int kt = 0; kt < 5; ++kt) {
      const int kp0 = q0 - 128 + kt * 64;
      if (kp0 >= 0 && kp0 < L)
        gemm_acc<64, 64, true, false, true, 1>(acc, pb + (long)item * 64 * 320 + kt * 64, 320, pj + (tok0 + kp0) * 1536 + 1280 + hkv * 64, 1536, (u16*)smem);
    }
    u16* o = a2 + (tok0 + q0) * 1024 + hq * 64;
    epi_each<64, 64, true>(acc, [&](int r, int c, f32x4 v) { *(uint2*)(o + (long)r * 1024 + c) = make_uint2(pack2(v[0], v[1]), pack2(v[2], v[3])); });
  }
}


#define XB_TMO      128
#define XB_XCNT(j)  (256  + 64 * (j))
#define XB_XSUB(j)  (1280 + 64 * (j))
#define XB_XGEN(j)  (2304 + 64 * (j))
#define XB_TOP      3328
#define XB_TOPGEN   3392
#define XCD_BAR_WORDS 3456
#define XB_SPIN_CAP (1u << 18)
__device__ __forceinline__ unsigned xb_ld(unsigned* p)              { return __hip_atomic_load(p, __ATOMIC_RELAXED, __HIP_MEMORY_SCOPE_AGENT); }
__device__ __forceinline__ unsigned xb_add(unsigned* p, unsigned v) { return __hip_atomic_fetch_add(p, v, __ATOMIC_RELAXED, __HIP_MEMORY_SCOPE_AGENT); }
__device__ __forceinline__ unsigned xb_xcc_id() { return (unsigned)__builtin_amdgcn_s_getreg((3 << 11) | 20) & 0xFu; }
#define XB_SPIN(cond, bar) do { unsigned _sp = 0; while (cond) { __builtin_amdgcn_s_sleep(1); \
    if ((++_sp & 255u) == 0u) { if (xb_ld(&(bar)[XB_TMO])) break; if (_sp > XB_SPIN_CAP) { atomicAdd(&(bar)[XB_TMO], 1u); break; } } } } while (0)
struct XcdBarrier { unsigned* bar; unsigned x; volatile LDS_AS unsigned* st; };
__device__ __forceinline__ XcdBarrier xcd_barrier_post(unsigned* bar, volatile LDS_AS unsigned* st) {
    XcdBarrier b; b.bar = bar; b.x = xb_xcc_id(); b.st = st;
    if (threadIdx.x == 0) (void)xb_add(&bar[XB_XCNT(b.x)], 1u);
    return b;
}
__device__ __forceinline__ void xcd_barrier_complete(unsigned* bar, unsigned x, unsigned& nloc, unsigned& nx) {
    const unsigned G = gridDim.x * gridDim.y * gridDim.z;
    unsigned sum, cnt, mine, sp = 0u;
    for (;;) {
        sum = 0u; cnt = 0u; mine = 0u;
#pragma unroll
        for (unsigned j = 0; j < 16; ++j) { const unsigned c = xb_ld(&bar[XB_XCNT(j)]); sum += c; cnt += (c > 0u) ? 1u : 0u; mine = (j == x) ? c : mine; }
        if (sum == G) break;
        __builtin_amdgcn_s_sleep(1);
        if ((++sp & 255u) == 0u) { if (xb_ld(&bar[XB_TMO])) break; if (sp > XB_SPIN_CAP) { atomicAdd(&bar[XB_TMO], 1u); break; } }
    }
    nloc = mine > 0u ? mine : 1u; nx = cnt > 0u ? cnt : 1u;
}
__device__ __forceinline__ void xcd_barrier(const XcdBarrier& b) {
    asm volatile("s_waitcnt vmcnt(0)" ::: "memory");
    __syncthreads();
    if (threadIdx.x == 0) {
        unsigned* bar = b.bar;
        __builtin_amdgcn_s_waitcnt(0);
        unsigned nloc = b.st[0], nx = b.st[1];
        if (nloc == 0u) { xcd_barrier_complete(bar, b.x, nloc, nx); b.st[0] = nloc; b.st[1] = nx; }
        const unsigned old = xb_add(&bar[XB_XSUB(b.x)], 1u);
        const unsigned gen = old / nloc;
        if (old + 1u == (gen + 1u) * nloc) {
            __builtin_amdgcn_fence(__ATOMIC_RELEASE, "agent");
            asm volatile("s_waitcnt vmcnt(0)" ::: "memory");
            const unsigned og = xb_add(&bar[XB_TOP], 1u);
            const unsigned tg = og / nx;
            if (og + 1u == (tg + 1u) * nx) xb_add(&bar[XB_TOPGEN], 1u);
            else XB_SPIN(xb_ld(&bar[XB_TOPGEN]) == tg, bar);
            __builtin_amdgcn_fence(__ATOMIC_ACQUIRE, "agent");
            xb_add(&bar[XB_XGEN(b.x)], 1u);
            asm volatile("s_waitcnt vmcnt(0)" ::: "memory");
        } else {
            XB_SPIN(xb_ld(&bar[XB_XGEN(b.x)]) == gen, bar);
            __builtin_amdgcn_fence(__ATOMIC_ACQUIRE, "agent");
            asm volatile("s_waitcnt vmcnt(0)" ::: "memory");
        }
    }
    __syncthreads();
}

__device__ __forceinline__ int nsteps_of(int kind) { return (kind & 1) ? 12 : 10; }

__device__ void layer_step(const Params& P, int layer, int slab, int step) {
  const int kind = layer;
  const int nmix = nsteps_of(kind) - 4;
  if (step == 0) { REP(4) phase_norm(P, layer, slab, 0); return; }
  if (step >= nmix) {
    const int f = step - nmix;
    if (f == 0) { REP(4) phase_norm(P, layer, slab, 1); }
    else if (f == 1) { REP(0) phase_ffn_gate(P, layer); }
    else if (f == 2) { REP(0) phase_ffn_val(P, layer, slab); }
    else phase_resid(P, layer, slab, (const u16*)(WS(P) + O_ACT), DFF, O_WFD + (size_t)layer * SZW(1024, 2816), 5 * D);
    return;
  }
  if (kind == 0) {
    if (step == 1) { REP(0) phase_proj(P, O_WHYIN, 3072); }
    else if (step == 2) { REP(3) phase_hy_conv(P, slab); }
    else if (step == 3) { if ((PROBE_MASK >> 7) & 1) phase_hy_fft(P, slab, true); phase_hy_fft(P, slab); }
    else if (step == 4) { REP(3) phase_hy_tr(P, slab); }
    else phase_resid(P, layer, slab, (const u16*)(WS(P) + O_A2), 1024, O_WHYOUT, 2 * D);
  } else if (kind == 1) {
    if (step == 1) { REP(0) phase_proj(P, O_WRETIN, 6144); }
    else if (step == 2) { REP(1) REP(9) phase_ret_prep(P, slab); }
    else if (step == 3) { REP(1) REP(11) phase_rec_su<128>(P, 1); }
    else if (step == 4) { if ((PROBE_MASK >> 6) & 1) phase_rec_scan(P, 1, slab, true); phase_rec_scan(P, 1, slab); }
    else if (step == 5) { REP(1) REP(12) phase_rec_out<128>(P, 1); }
    else if (step == 6) { REP(1) REP(9) phase_rec_ng(P, 1); }
    else phase_resid(P, layer, slab, (const u16*)(WS(P) + O_A2), 2048, O_WRETOUT, 2 * D);
  } else if (kind == 2) {
    if (step == 1) { REP(0) phase_proj(P, O_WSWAIN, 1536); }
    else if (step == 2) { REP(2) REP(14) phase_swa_prep(P, slab); }
    else if (step == 3) { REP(2) REP(15) phase_swa_att1(P, slab); }
    else if (step == 4) { REP(2) REP(16) phase_swa_att2(P, slab); }
    else phase_resid(P, layer, slab, (const u16*)(WS(P) + O_A2), 1024, O_WSWAOUT, 2 * D);
  } else {
    if (step == 1) { REP(0) phase_proj(P, O_WHGIN, 5120); }
    else if (step == 2) { REP(1) REP(9) phase_hg_prep(P); }
    else if (step == 3) { REP(1) REP(11) phase_rec_su<64>(P, 3); }
    else if (step == 4) { if ((PROBE_MASK >> 6) & 1) phase_rec_scan(P, 3, slab, true); phase_rec_scan(P, 3, slab); }
    else if (step == 5) { REP(1) REP(12) phase_rec_out<64>(P, 3); }
    else if (step == 6) { REP(1) REP(9) phase_rec_ng(P, 3); }
    else phase_resid(P, layer, slab, (const u16*)(WS(P) + O_A2), 1024, O_WHGOUT, 2 * D);
  }
}

__global__ void __launch_bounds__(NT) fwd_megakernel(Params P) {
  cg::grid_group grid = cg::this_grid();
  __shared__ uint4 xb_words;
  if (threadIdx.x == 0) xb_words = make_uint4(0u, 0u, 0u, 0u);
  __syncthreads();
  XcdBarrier xb = xcd_barrier_post((unsigned*)(P.ws + O_BAR), (volatile LDS_AS unsigned*)&xb_words);
  for (int pid = P.p0; pid < P.p1; ++pid) {
    if (pid == 0) { REP(5) phase_pre0(P); }
    else if (pid == 1) { REP(5) phase_pre1(P); }
    else {
      int q = pid - 2, layer = 0;
      while (q >= 5 * nsteps_of(layer)) { q -= 5 * nsteps_of(layer); ++layer; }
      const int ns = nsteps_of(layer);
      layer_step(P, layer, q / ns, q % ns);
    }
    if (pid + 1 < P.p1) {
      if (pid == 0) grid.sync();
      else xcd_barrier(xb);
      if ((PROBE_MASK >> 8) & 1) xcd_barrier(xb);
    }
  }
}

extern "C" void kernel_launch(void* const* d_in, const int* in_sizes, int n_in, void* d_out, int out_size, void* d_ws,
                              size_t ws_size, hipStream_t stream) {
  static int grid_blocks = 0;
  if (!grid_blocks) {
    int dev = 0, cus = 0, per_cu = 0;
    (void)hipGetDevice(&dev);
    (void)hipDeviceGetAttribute(&cus, hipDeviceAttributeMultiprocessorCount, dev);
    (void)hipFuncSetAttribute((const void*)fwd_megakernel, hipFuncAttributeMaxDynamicSharedMemorySize, LDSB);
    (void)hipOccupancyMaxActiveBlocksPerMultiprocessor(&per_cu, (const void*)fwd_megakernel, NT, LDSB);
    if (per_cu < 1) per_cu = 1;
    if (per_cu > 1) per_cu = 1;
    grid_blocks = cus * per_cu;
    if (ws_size < WS_END) fprintf(stderr, "kernel_launch: workspace too small: %zu < %zu\n", ws_size, (size_t)WS_END);
  }
  Params p;
  memset(&p, 0, sizeof(p));
  for (int i = 0; i < 36; ++i) p.in[i] = (const float*)d_in[i];
  p.out = (float*)d_out;
  p.ws = (unsigned char*)d_ws;
  (void)hipMemsetAsync((unsigned char*)d_ws + O_BAR, 0, XCD_BAR_WORDS * 4, stream);
#if ONE_LAUNCH
  p.p0 = 0; p.p1 = NPHASES;
  void* args[] = {&p};
  hipError_t e = hipLaunchCooperativeKernel((const void*)fwd_megakernel, dim3(grid_blocks), dim3(NT), args, LDSB, stream);
  if (e != hipSuccess) fprintf(stderr, "cooperative launch failed: %s (grid %d)\n", hipGetErrorString(e), grid_blocks);
#else
  for (int ph = 0; ph < NPHASES; ++ph) {
    p.p0 = ph; p.p1 = ph + 1;
    hipLaunchKernelGGL(fwd_megakernel, dim3(grid_blocks), dim3(NT), LDSB, stream, p);
  }
#endif
}
```

```cpp
#include <hip/hip_runtime.h>
#include <hip/hip_cooperative_groups.h>
#include <cstdio>
#include <cstdint>
#include <cstring>
namespace cg = cooperative_groups;

typedef unsigned short u16;
typedef __attribute__((ext_vector_type(8))) short bf16x8;
typedef __attribute__((ext_vector_type(4))) float f32x4;

#define NT 512
#ifndef ONE_LAUNCH
#define ONE_LAUNCH 1
#endif
#ifndef PROBE_MASK
#define PROBE_MASK 0
#endif
#define REP(cls) for (int rep_##cls = 0; rep_##cls < (((PROBE_MASK >> (cls)) & 1) ? 2 : 1); ++rep_##cls)

constexpr int D = 1024, SLAB = 16384, DFF = 2816;
constexpr int LDSB = 131072;
constexpr int NPHASES = 2 + 5 * (10 + 12 + 10 + 12);

constexpr size_t SZW(size_t n, size_t k) { return n * k * 2; }
constexpr size_t O_WHYIN = 0;
constexpr size_t O_WHYOUT = O_WHYIN + SZW(3072, 1024);
constexpr size_t O_WRETIN = O_WHYOUT + SZW(1024, 1024);
constexpr size_t O_WRETOUT = O_WRETIN + SZW(6144, 1024);
constexpr size_t O_WSWAIN = O_WRETOUT + SZW(1024, 2048);
constexpr size_t O_WSWAOUT = O_WSWAIN + SZW(1536, 1024);
constexpr size_t O_WHGIN = O_WSWAOUT + SZW(1024, 1024);
constexpr size_t O_WHGOUT = O_WHGIN + SZW(5120, 1024);
constexpr size_t O_WFG = O_WHGOUT + SZW(1024, 1024);
constexpr size_t O_WFV = O_WFG + 4 * SZW(2816, 1024);
constexpr size_t O_WFD = O_WFV + 4 * SZW(2816, 1024);
constexpr size_t O_MOD = O_WFD + 4 * SZW(1024, 2816);
constexpr size_t O_TW = O_MOD + (size_t)4 * 16 * 6144 * 4;
constexpr size_t O_HIDS = O_TW + 8192 * 8;
constexpr size_t O_HIDP = O_HIDS + (size_t)8192 * 64 * 4;
constexpr size_t O_ROPER = O_HIDP + (size_t)2048 * 64 * 4;
constexpr size_t O_ROPES = O_ROPER + (size_t)8192 * 128 * 8;
constexpr size_t O_PROJ = O_ROPES + (size_t)8192 * 32 * 8;
constexpr size_t O_HBUF = O_PROJ + (size_t)SLAB * 6144 * 2;
constexpr size_t O_A2 = O_HBUF + (size_t)SLAB * 1024 * 2;
constexpr size_t O_C = O_A2 + (size_t)SLAB * 2048 * 2;
constexpr size_t O_GBUF = O_C;
constexpr size_t O_ACT = O_GBUF + (size_t)SLAB * DFF * 2;
constexpr size_t O_MODP = O_C;
constexpr size_t O_HSPS = O_ACT + (size_t)SLAB * DFF * 2;
constexpr size_t O_HSPP = O_HSPS + (size_t)1024 * 16384 * 8;
constexpr size_t O_UT = O_HSPP + (size_t)1024 * 4096 * 8;
constexpr size_t O_X0C = O_UT + (size_t)SLAB * 1024 * 4;
constexpr size_t END_HY = O_X0C + (size_t)SLAB * 1024 * 2;
constexpr size_t SZP = (size_t)SLAB * 1024 * 2;
constexpr size_t O_QDF = O_C, O_QDB = O_QDF + SZP, O_KIF = O_QDB + SZP, O_KIB = O_KIF + SZP, O_KEF = O_KIB + SZP, O_KEB = O_KEF + SZP;
constexpr size_t O_DLF = O_KEB + SZP;
constexpr size_t O_DLB = O_DLF + (size_t)256 * 1024 * 4;
constexpr size_t O_SC = O_DLB + (size_t)256 * 1024 * 4;
constexpr size_t O_STF = O_SC + (size_t)SLAB * 512 * 2;
constexpr size_t O_STB = O_STF + (size_t)134217728;
constexpr size_t O_OBUF = O_STB + (size_t)134217728;
constexpr size_t END_REC = O_OBUF + (size_t)SLAB * 2048 * 4;
constexpr size_t O_QN = O_C;
constexpr size_t O_KN = O_QN + SZP;
constexpr size_t O_PBUF = O_KN + (size_t)SLAB * 256 * 2;
constexpr size_t END_SWA = O_PBUF + (size_t)SLAB * 16 * 320 * 2;
constexpr size_t WS_END = END_REC > END_HY ? (END_REC > END_SWA ? END_REC : END_SWA) : (END_HY > END_SWA ? END_HY : END_SWA);
constexpr size_t O_BAR = ((size_t)1 << 30) - 16384;
static_assert(WS_END <= O_BAR, "workspace exceeds 1 GiB");

struct Params {
  const float* in[36];
  float* out;
  unsigned char* ws;
  int p0, p1;
};

extern __shared__ __attribute__((aligned(16))) unsigned char smem[];

__device__ __forceinline__ int TID() { int t = threadIdx.x; asm volatile("" : "+v"(t)); return t; }
__device__ __forceinline__ int BID() { int b = blockIdx.x; asm volatile("" : "+s"(b)); return b; }
__device__ __forceinline__ long ZOFF() { long z = 0; asm volatile("" : "+s"(z)); return z; }
__device__ __forceinline__ unsigned char* WS(const Params& P) { return P.ws + ZOFF(); }
__device__ __forceinline__ float* OUTP(const Params& P) { return P.out + ZOFF(); }

namespace pg8 {
#define PG8_LAS __attribute__((address_space(3)))
typedef unsigned short bf16_t;
typedef short bf16x8 __attribute__((ext_vector_type(8)));
typedef float f32x4 __attribute__((ext_vector_type(4)));
typedef unsigned u32x4 __attribute__((ext_vector_type(4)));
constexpr int BM = 256, BK = 64, HALF = 128, HTB = HALF * BK * 2  , STAGE_BYTES = 8 * HTB, NXCD = 8, WGM = 8;

__host__ __device__ __forceinline__ int lds_byte(int r, int c) { const int st = (r >> 4) * 2 + (c >> 5), rr = r & 15, cc = c & 31, ob = rr * 64 + cc * 2; return st * 1024 + (ob ^ (((ob >> 9) & 1) << 5)); }
__host__ __device__ __forceinline__ void stage_rc(int b, int& R, int& C) { const int st = b / 1024, sb = b % 1024, swz = sb ^ (((sb >> 9) & 1) << 5); R = (st >> 1) * 16 + swz / 64; C = (st & 1) * 32 + (swz % 64) / 2; }
__host__ __device__ __forceinline__ int perm32(int rho) { const int n = rho >> 4, i = rho & 15; return 8 * (i >> 2) + 4 * n + (i & 3); }

struct Unit { int pm, pn; };
struct Gemm { const bf16_t* A; const bf16_t* Bt; int M, N, K; };

struct StaticOrder {
    int nM, nN, nwg, G, c;
    __host__ __device__ void init(int M, int N, int G_, int c_) { nM = M / BM; nN = N / BM; nwg = nM * nN; G = G_; c = c_; }
    __host__ __device__ bool next(int i, Unit& u) const {
        const long L = (long)i * G + c; if (L >= nwg) return false;
        int wgid = (int)L; { const int q = nwg / NXCD, r = nwg % NXCD, xcd = wgid % NXCD, off = wgid / NXCD; wgid = (xcd < r ? xcd * (q + 1) : r * (q + 1) + (xcd - r) * q) + off; }
        const int nig = WGM * nN, gid = wgid / nig, fm = gid * WGM, gsz = (nM - fm) < WGM ? (nM - fm) : WGM;
        u.pm = fm + ((wgid % nig) % gsz); u.pn = (wgid % nig) / gsz; return true;
    }
    __device__ __forceinline__ void a_ready(const Unit&) const {}
    __device__ __forceinline__ void done(const Unit&) const {}
};

template <class Epi, class Sched, bool STAMP = false>
__device__ __forceinline__ void gemm_phase(PG8_LAS unsigned char* lds, const Gemm g, const Sched& S, const Epi& E, unsigned long long* stamps) {
    const int tid = TID(), wid = __builtin_amdgcn_readfirstlane(tid >> 6), lane = tid & 63, wr = wid >> 2, wc = wid & 3, fr = lane & 15, fq = lane >> 4;
    const int K = g.K, nt = K / BK;
    int ts_lo = 0, ts_hi = 0, nts = 0; const unsigned long long rt_entry = STAMP ? (unsigned long long)wall_clock64() : 0ull;
#define PG8_STAMP() do { if (STAMP && wid == 0 && nts < 64) { const unsigned long long _c = (unsigned long long)clock64(); \
        ts_lo = (lane == nts) ? (int)(unsigned)_c : ts_lo; ts_hi = (lane == nts) ? (int)(unsigned)(_c >> 32) : ts_hi; ++nts; } } while (0)
    PG8_STAMP();
    unsigned voffA[2], voffB[2];
#pragma unroll
    for (int i = 0; i < 2; ++i) { int R, C; stage_rc(tid * 16 + i * 8192, R, C); const int Rb = Epi::PERM ? ((R & ~31) + perm32(R & 31)) : R;
        voffA[i] = (unsigned)(R * K + C) * 2u; voffB[i] = (unsigned)(Rb * K + C) * 2u; }
    const size_t kstep = (size_t)(BK * 2);
    const size_t hstep = (size_t)HALF * K * 2;
    const size_t tstep = 2 * hstep;
    const unsigned ldsw = (unsigned)wid * 1024u;
    const int aoff = lds_byte(wr * 64 + fr, fq * 8), boff = lds_byte(wc * 32 + fr, fq * 8);
#define PG8_SA(b, h) (((b) * 2 + (h)) * HTB)
#define PG8_SB(b, h) ((4 + (b) * 2 + (h)) * HTB)
#define PG8_STAGE(bufoff, gbase, voff) do { _Pragma("unroll") for (int _i = 0; _i < 2; ++_i) \
        __builtin_amdgcn_global_load_lds((const unsigned*)((const char*)(gbase) + (voff)[_i]), (PG8_LAS unsigned*)(lds + (bufoff) + ldsw + _i * 8192), 16, 0, 0); } while (0)
#define PG8_LDA(dst, b, h) do { _Pragma("unroll") for (int m = 0; m < 4; ++m) _Pragma("unroll") for (int k = 0; k < 2; ++k) dst[m][k] = *(const PG8_LAS bf16x8*)(lds + PG8_SA(b, h) + aoff + m * 2048 + k * 1024); } while (0)
#define PG8_LDB(dst, b, h) do { _Pragma("unroll") for (int n = 0; n < 2; ++n) _Pragma("unroll") for (int k = 0; k < 2; ++k) dst[n][k] = *(const PG8_LAS bf16x8*)(lds + PG8_SB(b, h) + boff + n * 2048 + k * 1024); } while (0)
#define PG8_MMA(ai, bj, At, Bt) do { __builtin_amdgcn_s_setprio(1); _Pragma("unroll") for (int m = 0; m < 4; ++m) _Pragma("unroll") for (int n = 0; n < 2; ++n) _Pragma("unroll") for (int k = 0; k < 2; ++k) \
        acc[ai][bj][m][n] = __builtin_amdgcn_mfma_f32_16x16x32_bf16(Bt[n][k], At[m][k], acc[ai][bj][m][n], 0, 0, 0); __builtin_amdgcn_s_setprio(0); } while (0)
#define PG8_WAIT_V(n) asm volatile("s_waitcnt vmcnt(" #n ")" ::: "memory")
#define PG8_WAIT_L(n) asm volatile("s_waitcnt lgkmcnt(" #n ")" ::: "memory")
#define PG8_BAR __builtin_amdgcn_s_barrier()
#define PG8_SCHED __builtin_amdgcn_sched_barrier(0)
    Unit cur, nxt; int ui = 0;
    if (!S.next(0, cur)) return;
    f32x4 acc[2][2][4][2];
#pragma unroll
    for (int a = 0; a < 2; ++a)
#pragma unroll
        for (int b = 0; b < 2; ++b)
#pragma unroll
            for (int m = 0; m < 4; ++m)
#pragma unroll
                for (int n = 0; n < 2; ++n) acc[a][b][m][n] = (f32x4){0.f, 0.f, 0.f, 0.f};
    bf16x8 At[4][2], B0[2][2], B1[2][2];
    const char* cA = (const char*)g.A + (size_t)cur.pm * tstep; const char* cB = (const char*)g.Bt + (size_t)cur.pn * tstep;
    S.a_ready(cur);
    PG8_STAGE(PG8_SB(0, 0), cB, voffB); PG8_STAGE(PG8_SA(0, 0), cA, voffA); PG8_STAGE(PG8_SB(0, 1), cB + hstep, voffB); PG8_STAGE(PG8_SA(0, 1), cA + hstep, voffA);
    if (wr == 1) PG8_BAR;
    PG8_WAIT_V(4); PG8_BAR;
    PG8_STAGE(PG8_SB(1, 0), cB + kstep, voffB); PG8_STAGE(PG8_SA(1, 0), cA + kstep, voffA); PG8_STAGE(PG8_SB(1, 1), cB + hstep + kstep, voffB);
    PG8_WAIT_V(6); PG8_BAR;
    PG8_STAMP();
    for (;;) {
        const bool has_next = S.next(ui + 1, nxt);
        const char* nA = has_next ? (const char*)g.A + (size_t)nxt.pm * tstep : cA; const char* nB = has_next ? (const char*)g.Bt + (size_t)nxt.pn * tstep : cB;
        for (int t = 0; t < nt; t += 2) {
            const bool last = (t == nt - 2);
            const char* a1 = cA + (size_t)(t + 1) * kstep;
            const char* a2 = last ? nA : cA + (size_t)(t + 2) * kstep; const char* b2 = last ? nB : cB + (size_t)(t + 2) * kstep;
            const char* a3 = a2 + kstep; const char* b3 = b2 + kstep;
            if (last && has_next) S.a_ready(nxt);
            PG8_LDB(B0, 0, 0); PG8_SCHED; PG8_LDA(At, 0, 0); PG8_STAGE(PG8_SA(1, 1), a1 + hstep, voffA);
            PG8_WAIT_L(8); PG8_BAR; PG8_WAIT_L(0); PG8_MMA(0, 0, At, B0); PG8_BAR; PG8_SCHED;
            PG8_LDB(B1, 0, 1); PG8_STAGE(PG8_SB(0, 0), b2, voffB);
            PG8_BAR; PG8_WAIT_L(0); PG8_MMA(0, 1, At, B1); PG8_BAR;
            PG8_LDA(At, 0, 1); PG8_STAGE(PG8_SA(0, 0), a2, voffA);
            PG8_BAR; PG8_WAIT_L(0); PG8_MMA(1, 0, At, B0); PG8_BAR; PG8_SCHED;
            PG8_STAGE(PG8_SB(0, 1), b2 + hstep, voffB);
            PG8_WAIT_V(6); PG8_BAR; PG8_MMA(1, 1, At, B1); PG8_BAR;
            PG8_LDB(B0, 1, 0); PG8_SCHED; PG8_LDA(At, 1, 0); PG8_STAGE(PG8_SA(0, 1), a2 + hstep, voffA);
            PG8_WAIT_L(8); PG8_BAR; PG8_WAIT_L(0); PG8_MMA(0, 0, At, B0); PG8_BAR; PG8_SCHED;
            PG8_LDB(B1, 1, 1); PG8_STAGE(PG8_SB(1, 0), b3, voffB);
            PG8_BAR; PG8_WAIT_L(0); PG8_MMA(0, 1, At, B1); PG8_BAR;
            PG8_LDA(At, 1, 1); PG8_STAGE(PG8_SA(1, 0), a3, voffA);
            PG8_BAR; PG8_WAIT_L(0); PG8_MMA(1, 0, At, B0); PG8_BAR; PG8_SCHED;
            PG8_STAGE(PG8_SB(1, 1), b3 + hstep, voffB);
            PG8_WAIT_V(6); PG8_BAR; PG8_MMA(1, 1, At, B1); PG8_BAR;
        }
        PG8_STAMP();
        if constexpr (!Epi::AFTER_DRAIN) { E(acc, cur, wr, wc, fr, fq); S.done(cur); }
        PG8_STAMP();
        if (!has_next) break;
#pragma unroll
        for (int a = 0; a < 2; ++a)
#pragma unroll
            for (int b = 0; b < 2; ++b)
#pragma unroll
                for (int m = 0; m < 4; ++m)
#pragma unroll
                    for (int n = 0; n < 2; ++n) acc[a][b][m][n] = (f32x4){0.f, 0.f, 0.f, 0.f};
        cur = nxt; cA = nA; cB = nB; ++ui;
    }
    PG8_WAIT_V(0);
    if (wr == 0) PG8_BAR;
    PG8_BAR;
    if constexpr (Epi::AFTER_DRAIN) { E.fused(acc, cur, wr, wc, fr, fq, lds, wid, lane); S.done(cur); }
    PG8_STAMP();
    if (STAMP && wid == 0) { stamps[lane] = lane < nts ? (((unsigned long long)(unsigned)ts_hi << 32) | (unsigned)ts_lo) : 0ull;
        if (lane == 62) stamps[62] = rt_entry; if (lane == 63) stamps[63] = (unsigned long long)wall_clock64(); }
#undef PG8_STAMP
#undef PG8_SA
#undef PG8_SB
#undef PG8_STAGE
#undef PG8_LDA
#undef PG8_LDB
#undef PG8_MMA
#undef PG8_WAIT_V
#undef PG8_WAIT_L
#undef PG8_BAR
#undef PG8_SCHED
}
}


__device__ __forceinline__ u16 f2bf(float f) {
  unsigned u = __float_as_uint(f);
  u += 0x7fffu + ((u >> 16) & 1u);
  return (u16)(u >> 16);
}
__device__ __forceinline__ float bf2f(u16 h) { return __uint_as_float(((unsigned)h) << 16); }
__device__ __forceinline__ unsigned pack2(float a, float b) { return (unsigned)f2bf(a) | ((unsigned)f2bf(b) << 16); }
__device__ __forceinline__ float silu_f(float x) { return x / (1.f + __expf(-x)); }
__device__ __forceinline__ float sigm(float x) { return 1.f / (1.f + __expf(-x)); }
__device__ __forceinline__ float wave_sum(float v) {
#pragma unroll
  for (int o = 32; o; o >>= 1) v += __shfl_xor(v, o);
  return v;
}
__device__ __forceinline__ const float* xin_of(const Params& P, int slab) { return slab == 0 ? P.in[0] : P.in[1] + (long)(slab - 1) * SLAB * D; }
__device__ __forceinline__ int Lof(int slab) { return slab == 0 ? 2048 : 8192; }
__device__ __forceinline__ int gb_of(int slab, int r) { return slab == 0 ? (r >> 11) : (8 + (slab - 1) * 2 + (r >> 13)); }

typedef short v4s __attribute__((ext_vector_type(4)));
#define LDS_AS __attribute__((address_space(3)))
template <int R, bool KC>
__device__ __forceinline__ uint4 ld_chunk(const u16* __restrict__ base, long ld, int k0, int c) {
  if (KC) {
    const int r = c >> 3, kc = c & 7;
    return *(const uint4*)(base + (long)r * ld + k0 + kc * 8);
  } else {
    const int k = c / (R / 8), mc = c % (R / 8);
    return *(const uint4*)(base + (long)(k0 + k) * ld + mc * 8);
  }
}
template <int R, bool KC>
__device__ __forceinline__ void st_chunk(u16* s, uint4 v, int c) {
  if (KC) {
    const int r = c >> 3, kc = c & 7;
    *(uint4*)(s + r * 72 + kc * 8) = v;
  } else {
    const int k = c / (R / 8), mc = c % (R / 8);
    *(uint4*)(s + k * (R + 8) + mc * 8) = v;
  }
}
template <int R, bool KC>
__device__ __forceinline__ bf16x8 ld_frag(const u16* s, int x0, int ks, int fr, int fq) {
  if (KC) {
    return *(const bf16x8*)(s + (x0 + fr) * 72 + ks * 32 + fq * 8);
  } else {
    const int q4 = fr >> 2, p4 = fr & 3;
    const u16* p = s + (ks * 32 + 8 * fq + q4) * (R + 8) + x0 + 4 * p4;
    v4s lo = __builtin_amdgcn_ds_read_tr16_b64_v4i16((LDS_AS v4s*)p);
    v4s hi = __builtin_amdgcn_ds_read_tr16_b64_v4i16((LDS_AS v4s*)(p + 4 * (R + 8)));
    bf16x8 r;
    r[0] = lo[0]; r[1] = lo[1]; r[2] = lo[2]; r[3] = lo[3]; r[4] = hi[0]; r[5] = hi[1]; r[6] = hi[2]; r[7] = hi[3];
    return r;
  }
}

template <int TM, int TN, bool AKC, bool BKC, bool TR, int KT>
__device__ __forceinline__ void gemm_acc(f32x4 (&acc)[TM / 32][TN / 64], const u16* __restrict__ A, long lda,
                                         const u16* __restrict__ B, long ldb, u16* sm) {
  u16* As = sm;
  u16* Bs = sm + 9216;
  const int tid = TID(), lane = tid & 63, wid = tid >> 6;
  const int wm = wid >> 2, wn = wid & 3, fr = lane & 15, fq = lane >> 4;
  constexpr int MI = TM / 32, NI = TN / 64;
  uint4 ra0[KT], ra1[KT], rb0[KT], rb1[KT];
#pragma unroll
  for (int kt = 0; kt < KT; ++kt) {
    ra0[kt] = ld_chunk<TM, AKC>(A, lda, kt * 64, tid);
    ra1[kt] = ra0[kt];
    if (TM == 128) ra1[kt] = ld_chunk<TM, AKC>(A, lda, kt * 64, tid + NT);
    rb0[kt] = ld_chunk<TN, BKC>(B, ldb, kt * 64, tid);
    rb1[kt] = rb0[kt];
    if (TN == 128) rb1[kt] = ld_chunk<TN, BKC>(B, ldb, kt * 64, tid + NT);
  }
#pragma unroll
  for (int kt = 0; kt < KT; ++kt) {
    __syncthreads();
    st_chunk<TM, AKC>(As, ra0[kt], tid);
    if (TM == 128) st_chunk<TM, AKC>(As, ra1[kt], tid + NT);
    st_chunk<TN, BKC>(Bs, rb0[kt], tid);
    if (TN == 128) st_chunk<TN, BKC>(Bs, rb1[kt], tid + NT);
    __syncthreads();
#pragma unroll
    for (int ks = 0; ks < 2; ++ks) {
      bf16x8 af[MI], bfr[NI];
#pragma unroll
      for (int mi = 0; mi < MI; ++mi) af[mi] = ld_frag<TM, AKC>(As, wm * (TM / 2) + mi * 16, ks, fr, fq);
#pragma unroll
      for (int ni = 0; ni < NI; ++ni) bfr[ni] = ld_frag<TN, BKC>(Bs, wn * (TN / 4) + ni * 16, ks, fr, fq);
#pragma unroll
      for (int mi = 0; mi < MI; ++mi)
#pragma unroll
        for (int ni = 0; ni < NI; ++ni)
          acc[mi][ni] = TR ? __builtin_amdgcn_mfma_f32_16x16x32_bf16(bfr[ni], af[mi], acc[mi][ni], 0, 0, 0)
                           : __builtin_amdgcn_mfma_f32_16x16x32_bf16(af[mi], bfr[ni], acc[mi][ni], 0, 0, 0);
    }
  }
  __syncthreads();
}

template <int TM, int TN, bool TR, class F>
__device__ __forceinline__ void epi_each(f32x4 (&acc)[TM / 32][TN / 64], F f) {
  const int tid = TID(), lane = tid & 63, wid = tid >> 6;
  const int wm = wid >> 2, wn = wid & 3, fr = lane & 15, fq = lane >> 4;
#pragma unroll
  for (int mi = 0; mi < TM / 32; ++mi)
#pragma unroll
    for (int ni = 0; ni < TN / 64; ++ni) {
      const int r0 = wm * (TM / 2) + mi * 16, c0 = wn * (TN / 4) + ni * 16;
      if (TR) f(r0 + fr, c0 + fq * 4, acc[mi][ni]);
      else f(r0 + fq * 4, c0 + fr, acc[mi][ni]);
    }
}

struct EpiStoreBf16 {
  static constexpr bool PERM = false, AFTER_DRAIN = false;
  u16* O; int ldc;
  __device__ __forceinline__ void operator()(const f32x4 (&acc)[2][2][4][2], const pg8::Unit& u, int wr, int wc, int fr, int fq) const {
    const int row0 = u.pm * 256 + wr * 64 + fr, col0 = u.pn * 256 + wc * 32 + 4 * fq;
#pragma unroll
    for (int ai = 0; ai < 2; ++ai)
#pragma unroll
      for (int m = 0; m < 4; ++m) {
        u16* rowp = O + (size_t)(row0 + ai * 128 + m * 16) * ldc + col0;
#pragma unroll
        for (int bj = 0; bj < 2; ++bj)
#pragma unroll
          for (int n = 0; n < 2; ++n) {
            const f32x4 v = acc[ai][bj][m][n];
            *(uint2*)(rowp + bj * 128 + n * 16) = make_uint2(pack2(v[0], v[1]), pack2(v[2], v[3]));
          }
      }
  }
};
struct EpiResid {
  static constexpr bool PERM = false, AFTER_DRAIN = false;
  float* X; const float* XS; const float* mod; int goff; int slab;
  __device__ __forceinline__ void operator()(const f32x4 (&acc)[2][2][4][2], const pg8::Unit& u, int wr, int wc, int fr, int fq) const {
    const int row0 = u.pm * 256 + wr * 64 + fr, col0 = u.pn * 256 + wc * 32 + 4 * fq;
    const float* g = mod + (size_t)gb_of(slab, u.pm * 256) * 6144 + goff + col0;
    f32x4 gv[2][2];
#pragma unroll
    for (int bj = 0; bj < 2; ++bj)
#pragma unroll
      for (int n = 0; n < 2; ++n) gv[bj][n] = *(const f32x4*)(g + bj * 128 + n * 16);
#pragma unroll
    for (int am = 0; am < 4; ++am) {
      f32x4 xv[2][2][2];
#pragma unroll
      for (int mm = 0; mm < 2; ++mm)
#pragma unroll
        for (int bj = 0; bj < 2; ++bj)
#pragma unroll
          for (int n = 0; n < 2; ++n) xv[mm][bj][n] = *(const f32x4*)(XS + (size_t)(row0 + (am >> 1) * 128 + ((am & 1) * 2 + mm) * 16) * D + col0 + bj * 128 + n * 16);
#pragma unroll
      for (int mm = 0; mm < 2; ++mm)
#pragma unroll
        for (int bj = 0; bj < 2; ++bj)
#pragma unroll
          for (int n = 0; n < 2; ++n)
            *(f32x4*)(X + (size_t)(row0 + (am >> 1) * 128 + ((am & 1) * 2 + mm) * 16) * D + col0 + bj * 128 + n * 16) = xv[mm][bj][n] + gv[bj][n] * acc[am >> 1][bj][(am & 1) * 2 + mm][n];
    }
  }
};
struct EpiFfnVal {
  static constexpr bool PERM = false, AFTER_DRAIN = false;
  const u16* G; u16* ACT; const float* cw; const float* cb; int L;
  __device__ __forceinline__ void operator()(const f32x4 (&acc)[2][2][4][2], const pg8::Unit& u, int wr, int wc, int fr, int fq) const {
    const int row0 = u.pm * 256 + wr * 64 + fr, col0 = u.pn * 256 + wc * 32 + 4 * fq;
#pragma unroll
    for (int bj = 0; bj < 2; ++bj)
#pragma unroll
      for (int n = 0; n < 2; ++n) {
        const int c = col0 + bj * 128 + n * 16;
        const f32x4 w0 = *(const f32x4*)(cw + c), w1 = *(const f32x4*)(cw + DFF + c), w2 = *(const f32x4*)(cw + 2 * DFF + c), bb = *(const f32x4*)(cb + c);
#pragma unroll
        for (int ai = 0; ai < 2; ++ai) {
          uint2 g0[4], g1[4], g2[4];
#pragma unroll
          for (int m = 0; m < 4; ++m) {
            const int r = row0 + ai * 128 + m * 16;
            const int pos = r & (L - 1);
            const u16* gp = G + (size_t)r * DFF + c;
            g1[m] = *(const uint2*)gp;
            g0[m] = *(const uint2*)(gp - (pos > 0 ? DFF : 0));
            g2[m] = *(const uint2*)(gp + (pos < L - 1 ? DFF : 0));
          }
#pragma unroll
          for (int m = 0; m < 4; ++m) {
            const int r = row0 + ai * 128 + m * 16;
            const int pos = r & (L - 1);
            const float m0 = pos > 0 ? 1.f : 0.f, m2 = pos < L - 1 ? 1.f : 0.f;
            const uint2 a0 = g0[m], a1 = g1[m], a2 = g2[m];
            f32x4 a;
            a[0] = m0 * bf2f((u16)(a0.x & 0xffff)) * w0[0] + bf2f((u16)(a1.x & 0xffff)) * w1[0] + m2 * bf2f((u16)(a2.x & 0xffff)) * w2[0] + bb[0];
            a[1] = m0 * bf2f((u16)(a0.x >> 16)) * w0[1] + bf2f((u16)(a1.x >> 16)) * w1[1] + m2 * bf2f((u16)(a2.x >> 16)) * w2[1] + bb[1];
            a[2] = m0 * bf2f((u16)(a0.y & 0xffff)) * w0[2] + bf2f((u16)(a1.y & 0xffff)) * w1[2] + m2 * bf2f((u16)(a2.y & 0xffff)) * w2[2] + bb[2];
            a[3] = m0 * bf2f((u16)(a0.y >> 16)) * w0[3] + bf2f((u16)(a1.y >> 16)) * w1[3] + m2 * bf2f((u16)(a2.y >> 16)) * w2[3] + bb[3];
            const f32x4 v = acc[ai][bj][m][n];
            *(uint2*)(ACT + (size_t)r * DFF + c) = make_uint2(pack2(silu_f(a[0]) * v[0], silu_f(a[1]) * v[1]), pack2(silu_f(a[2]) * v[2], silu_f(a[3]) * v[3]));
          }
        }
      }
  }
};
template <class Epi>
__device__ __forceinline__ void run_gemm(const u16* A, const u16* Bt, int N, int K, const Epi& E) {
  pg8::Gemm g; g.A = A; g.Bt = Bt; g.M = SLAB; g.N = N; g.K = K;
  pg8::StaticOrder S; S.init(SLAB, N, gridDim.x, BID());
  __syncthreads();
  pg8::gemm_phase<Epi, pg8::StaticOrder, false>((PG8_LAS unsigned char*)smem, g, S, E, nullptr);
  __syncthreads();
}

template <int N>
__device__ __forceinline__ void fft_dif_t(float2* x, const float2* __restrict__ tw) {
  const int tid = TID();
  constexpr int IT = N / 2 / NT;
#pragma unroll 1
  for (int s = N >> 1; s >= 1; s >>= 1) {
    const int tws = 8192 / s;
    const float2 w0 = tw[(tid & (s - 1)) * tws];
#pragma unroll
    for (int it = 0; it < IT; ++it) {
      const int i = tid + it * NT;
      const int j = i & (s - 1);
      const int p = ((i - j) << 1) + j;
      float2 w = w0;
      if (s >= 1024) {
        const float2 wu = tw[((it * NT) & (s - 1)) * tws];
        w = make_float2(w0.x * wu.x - w0.y * wu.y, w0.x * wu.y + w0.y * wu.x);
      }
      float2 a = x[p], b = x[p + s];
      x[p] = make_float2(a.x + b.x, a.y + b.y);
      float dx = a.x - b.x, dy = a.y - b.y;
      x[p + s] = make_float2(dx * w.x - dy * w.y, dx * w.y + dy * w.x);
    }
    __syncthreads();
  }
}
template <int N>
__device__ __forceinline__ void ifft_dit_t(float2* x, const float2* __restrict__ tw) {
  const int tid = TID();
  constexpr int IT = N / 2 / NT;
#pragma unroll 1
  for (int s = 1; s < N; s <<= 1) {
    const int tws = 8192 / s;
    const float2 w0 = tw[(tid & (s - 1)) * tws];
#pragma unroll
    for (int it = 0; it < IT; ++it) {
      const int i = tid + it * NT;
      const int j = i & (s - 1);
      const int p = ((i - j) << 1) + j;
      float2 w = w0;
      if (s >= 1024) {
        const float2 wu = tw[((it * NT) & (s - 1)) * tws];
        w = make_float2(w0.x * wu.x - w0.y * wu.y, w0.x * wu.y + w0.y * wu.x);
      }
      float2 a = x[p], b = x[p + s];
      float bx = b.x * w.x + b.y * w.y, by = b.y * w.x - b.x * w.y;
      x[p] = make_float2(a.x + bx, a.y + by);
      x[p + s] = make_float2(a.x - bx, a.y - by);
    }
    __syncthreads();
  }
}
__device__ __forceinline__ void fft_dif(float2* x, int N, const float2* __restrict__ tw) {
  if (N == 16384) fft_dif_t<16384>(x, tw); else fft_dif_t<4096>(x, tw);
}
__device__ __forceinline__ void ifft_dit(float2* x, int N, const float2* __restrict__ tw) {
  if (N == 16384) ifft_dit_t<16384>(x, tw); else ifft_dit_t<4096>(x, tw);
}

__device__ __forceinline__ void unpack8(const uint4 v, float (&f)[8]) {
  f[0] = bf2f((u16)(v.x & 0xffff)); f[1] = bf2f((u16)(v.x >> 16)); f[2] = bf2f((u16)(v.y & 0xffff)); f[3] = bf2f((u16)(v.y >> 16));
  f[4] = bf2f((u16)(v.z & 0xffff)); f[5] = bf2f((u16)(v.z >> 16)); f[6] = bf2f((u16)(v.w & 0xffff)); f[7] = bf2f((u16)(v.w >> 16));
}
__device__ __forceinline__ uint4 pack8s(const float (&f)[8], float sc) {
  return make_uint4(pack2(f[0] * sc, f[1] * sc), pack2(f[2] * sc, f[3] * sc), pack2(f[4] * sc, f[5] * sc), pack2(f[6] * sc, f[7] * sc));
}
__device__ void transpose_w(const float* __restrict__ W, u16* __restrict__ Wt, int K, int N) {
  float* smf = (float*)smem;
  const int tk = K / 64, tn = N / 64, tid = TID();
  for (int item = BID(); item < tk * tn; item += gridDim.x) {
    const int k0 = (item / tn) * 64, n0 = (item % tn) * 64;
    float4 v[2];
#pragma unroll
    for (int j = 0; j < 2; ++j) {
      const int idx = tid + j * NT, kk = idx >> 4, n4 = idx & 15;
      v[j] = *(const float4*)(W + (long)(k0 + kk) * N + n0 + n4 * 4);
    }
    __syncthreads();
#pragma unroll
    for (int j = 0; j < 2; ++j) {
      const int idx = tid + j * NT, kk = idx >> 4, n4 = idx & 15;
      float* p = smf + kk * 65 + n4 * 4;
      p[0] = v[j].x; p[1] = v[j].y; p[2] = v[j].z; p[3] = v[j].w;
    }
    __syncthreads();
    const int nn = tid >> 3, k8 = tid & 7;
    float f[8];
#pragma unroll
    for (int i = 0; i < 8; ++i) f[i] = smf[(k8 * 8 + i) * 65 + nn];
    *(uint4*)(Wt + (long)(n0 + nn) * K + k0 + k8 * 8) = pack8s(f, 1.f);
  }
  __syncthreads();
}

__device__ void phase_pre0(const Params& P) {
  const int tid = TID();
  const long gtid = (long)BID() * NT + tid, gsz = (long)gridDim.x * NT;
  transpose_w(P.in[7], (u16*)(WS(P) + O_WHYIN), 1024, 3072);
  transpose_w(P.in[18], (u16*)(WS(P) + O_WHYOUT), 1024, 1024);
  transpose_w(P.in[19], (u16*)(WS(P) + O_WRETIN), 1024, 6144);
  transpose_w(P.in[21], (u16*)(WS(P) + O_WRETOUT), 2048, 1024);
  transpose_w(P.in[22], (u16*)(WS(P) + O_WSWAIN), 1024, 1536);
  transpose_w(P.in[26], (u16*)(WS(P) + O_WSWAOUT), 1024, 1024);
  transpose_w(P.in[27], (u16*)(WS(P) + O_WHGIN), 1024, 5120);
  transpose_w(P.in[30], (u16*)(WS(P) + O_WHGOUT), 1024, 1024);
  for (int l = 0; l < 4; ++l) {
    transpose_w(P.in[31] + (long)l * 1024 * DFF, (u16*)(WS(P) + O_WFG) + (long)l * DFF * 1024, 1024, DFF);
    transpose_w(P.in[32] + (long)l * 1024 * DFF, (u16*)(WS(P) + O_WFV) + (long)l * DFF * 1024, 1024, DFF);
    transpose_w(P.in[35] + (long)l * DFF * 1024, (u16*)(WS(P) + O_WFD) + (long)l * 1024 * DFF, DFF, 1024);
  }
  {
    float* cs = (float*)smem;
    float* modp = (float*)(WS(P) + O_MODP);
    for (int item = BID(); item < 4 * 8 * 12; item += gridDim.x) {
      const int nb = item % 12, ks = (item / 12) % 8, l = item / 96;
      __syncthreads();
      for (int i = tid; i < 2048; i += NT) {
        int b = i >> 7, k = i & 127;
        float c = (b < 8) ? P.in[2][b * 1024 + ks * 128 + k] : P.in[3][(b - 8) * 1024 + ks * 128 + k];
        cs[i] = c / (1.f + expf(-c));
      }
      __syncthreads();
      const int n = nb * 512 + tid;
      float a[16];
#pragma unroll
      for (int b = 0; b < 16; ++b) a[b] = 0.f;
      const float* w = P.in[4] + ((long)l * 1024 + ks * 128) * 6144 + n;
      for (int k = 0; k < 128; ++k) {
        float wv = w[(long)k * 6144];
#pragma unroll
        for (int b = 0; b < 16; ++b) a[b] += cs[b * 128 + k] * wv;
      }
#pragma unroll
      for (int b = 0; b < 16; ++b) modp[(((long)ks * 4 + l) * 16 + b) * 6144 + n] = a[b];
    }
    __syncthreads();
  }
  {
    float2* tw = (float2*)(WS(P) + O_TW);
    for (long i = gtid; i < 8192; i += gsz) {
      float s, c;
      sincospif((float)i * (1.f / 8192.f), &s, &c);
      tw[i] = make_float2(c, -s);
    }
    float2* rr = (float2*)(WS(P) + O_ROPER);
    for (long i = gtid; i < (long)8192 * 128; i += gsz) {
      int pos = (int)(i >> 7), d = (int)(i & 127);
      float inv = exp2f(-(float)d * (13.287712379549449f / 128.f));
      float s, c;
      sincosf((float)pos * inv, &s, &c);
      rr[i] = make_float2(c, s);
    }
    float2* rs = (float2*)(WS(P) + O_ROPES);
    for (long i = gtid; i < (long)8192 * 32; i += gsz) {
      int pos = (int)(i >> 5), d = (int)(i & 31);
      float inv = exp2f(-(float)d * (13.287712379549449f / 32.f));
      float s, c;
      sincosf((float)pos * inv, &s, &c);
      rs[i] = make_float2(c, s);
    }
  }
  {
    float* zf = (float*)smem;
    float* h1 = zf + 8 * 36;
    const float* w1 = P.in[10]; const float* b1 = P.in[11]; const float* w2 = P.in[12]; const float* b2 = P.in[13];
    const float* fr = P.in[15];
    const int tl = tid >> 6, j = tid & 63;
    for (int item = BID(); item < 1280; item += gridDim.x) {
      const int sel = item >= 1024;
      const int L = sel ? 2048 : 8192;
      const int t = (sel ? item - 1024 : item) * 8 + tl;
      float* hid = (float*)(WS(P) + (sel ? O_HIDP : O_HIDS));
      __syncthreads();
      if (j < 33) {
        float v;
        if (j == 0) v = (float)t / (float)(L - 1);
        else {
          int i = (j - 1) & 15;
          float band = 1e-4f + (float)i * ((15.f - 1e-4f) / 15.f);
          float ang = (6.283185307179586f / (float)L) * (float)t;
          float a = band * ang;
          v = (j <= 16) ? cosf(a) : -sinf(a);
        }
        zf[tl * 36 + j] = v;
      }
      __syncthreads();
      float s = b1[j];
#pragma unroll 3
      for (int i = 0; i < 33; ++i) s += zf[tl * 36 + i] * w1[i * 64 + j];
      h1[tl * 64 + j] = sinf(fr[j] * s);
      __syncthreads();
      float s2 = b2[j];
#pragma unroll 4
      for (int i = 0; i < 64; ++i) s2 += h1[tl * 64 + i] * w2[i * 64 + j];
      hid[(long)t * 64 + j] = sinf(fr[j] * s2);
    }
    __syncthreads();
  }
}

__device__ void phase_pre1(const Params& P) {
  __shared__ float w3s[128];
  __shared__ float red[8];
  const int tid = TID(), lane = tid & 63, wid = tid >> 6;
  const long gtid = (long)BID() * NT + tid, gsz = (long)gridDim.x * NT;
  {
    const float* modp = (const float*)(WS(P) + O_MODP);
    float* mod = (float*)(WS(P) + O_MOD);
    for (long i = gtid; i < (long)4 * 16 * 6144; i += gsz) {
      int n = (int)(i % 6144);
      int l = (int)(i / (16 * 6144));
      float s = P.in[5][l * 6144 + n];
      for (int ks = 0; ks < 8; ++ks) s += modp[(long)ks * 4 * 16 * 6144 + i];
      mod[i] = s;
    }
  }
  float2* buf = (float2*)smem;
  const float2* tw = (const float2*)(WS(P) + O_TW);
  for (int item = BID(); item < 2048; item += gridDim.x) {
    const int sel = item >> 10, c = item & 1023;
    const int L = sel ? 2048 : 8192, N = 2 * L;
    const float* hid = (const float*)(WS(P) + (sel ? O_HIDP : O_HIDS));
    float2* hs = (float2*)(WS(P) + (sel ? O_HSPP : O_HSPS)) + (long)c * N;
    __syncthreads();
    if (tid < 128) {
      int dirn = tid >> 6, j = tid & 63;
      w3s[tid] = P.in[14][(long)j * 2048 + dirn * 1024 + c];
    }
    __syncthreads();
    const float dec0 = fabsf(P.in[16][c]), dec1 = fabsf(P.in[16][1024 + c]);
    const float invLm1 = 1.f / (float)(L - 1);
    float asum = 0.f;
    for (int n = tid; n < N; n += NT) {
      float val = 0.f;
      if (n != L) {
        const int dirn = n < L ? 0 : 1;
        const int t = n < L ? n : N - n;
        const float4* hr = (const float4*)(hid + (long)t * 64);
        const float* w = w3s + dirn * 64;
        float s = 0.f;
#pragma unroll
        for (int q = 0; q < 16; ++q) {
          float4 h4 = hr[q];
          s += h4.x * w[4 * q] + h4.y * w[4 * q + 1] + h4.z * w[4 * q + 2] + h4.w * w[4 * q + 3];
        }
        float tl = (float)t * invLm1;
        val = s * expf(-tl * (dirn ? dec1 : dec0));
      }
      buf[n] = make_float2(val, 0.f);
      asum += fabsf(val);
    }
    asum = wave_sum(asum);
    if (lane == 0) red[wid] = asum;
    __syncthreads();
    float tot = 0.f;
#pragma unroll
    for (int w = 0; w < 8; ++w) tot += red[w];
    const float scale = 1.f / (tot * (float)N);
    fft_dif(buf, N, tw);
    for (int p = tid; p < N; p += NT) {
      float2 a = buf[p];
      hs[p] = make_float2(a.x * scale, a.y * scale);
    }
  }
  __syncthreads();
}

__device__ void phase_norm(const Params& P, int layer, int slab, int which) {
  const float* __restrict__ x = (layer == 0 && which == 0) ? xin_of(P, slab) : (const float*)(OUTP(P) + (long)slab * SLAB * D);
  u16* __restrict__ h = (u16*)(WS(P) + O_HBUF);
  const float* gain = P.in[6] + (layer * 2 + which) * D;
  const float* mod = (const float*)(WS(P) + O_MOD) + (long)layer * 16 * 6144;
  const int shoff = which ? 3 * D : 0, scoff = which ? 4 * D : D;
  const int tid = TID(), lane = tid & 63, wid = tid >> 6;
  for (int item = BID(); item < SLAB / 32; item += gridDim.x) {
    const int r0 = item * 32 + wid * 4;
    float4 v[4][4];
    float ss[4];
#pragma unroll
    for (int u = 0; u < 4; ++u) {
      const float* xr = x + (long)(r0 + u) * D;
      float a = 0.f;
#pragma unroll
      for (int i = 0; i < 4; ++i) {
        v[u][i] = *(const float4*)(xr + i * 256 + lane * 4);
        a += v[u][i].x * v[u][i].x + v[u][i].y * v[u][i].y + v[u][i].z * v[u][i].z + v[u][i].w * v[u][i].w;
      }
      ss[u] = a;
    }
    const float* m = mod + (long)gb_of(slab, r0) * 6144;
#pragma unroll
    for (int u = 0; u < 4; ++u) ss[u] = wave_sum(ss[u]);
#pragma unroll
    for (int i = 0; i < 4; ++i) {
      const int col = i * 256 + lane * 4;
      const float4 g = *(const float4*)(gain + col);
      const float4 sc = *(const float4*)(m + scoff + col);
      const float4 sh = *(const float4*)(m + shoff + col);
      const float a0 = g.x * (1.f + sc.x), a1 = g.y * (1.f + sc.y), a2 = g.z * (1.f + sc.z), a3 = g.w * (1.f + sc.w);
#pragma unroll
      for (int u = 0; u < 4; ++u) {
        const float rstd = rsqrtf(ss[u] * (1.f / 1024.f) + 1e-6f);
        const float y0 = v[u][i].x * rstd * a0 + sh.x, y1 = v[u][i].y * rstd * a1 + sh.y;
        const float y2 = v[u][i].z * rstd * a2 + sh.z, y3 = v[u][i].w * rstd * a3 + sh.w;
        *(uint2*)(h + (long)(r0 + u) * D + col) = make_uint2(pack2(y0, y1), pack2(y2, y3));
      }
    }
  }
}

__device__ void phase_proj(const Params& P, size_t woff, int N) {
  EpiStoreBf16 E; E.O = (u16*)(WS(P) + O_PROJ); E.ldc = N;
  run_gemm((const u16*)(WS(P) + O_HBUF), (const u16*)(WS(P) + woff), N, D, E);
}
__device__ void phase_resid(const Params& P, int layer, int slab, const u16* A, int K, size_t woff, int goff) {
  EpiResid E; E.X = OUTP(P) + (long)slab * SLAB * D; E.XS = (layer == 0 && goff == 2 * D) ? xin_of(P, slab) : (const float*)E.X; E.mod = (const float*)(WS(P) + O_MOD) + (long)layer * 16 * 6144; E.goff = goff; E.slab = slab;
  run_gemm(A, (const u16*)(WS(P) + woff), D, K, E);
}

__device__ void phase_ffn_gate(const Params& P, int layer) {
  EpiStoreBf16 E; E.O = (u16*)(WS(P) + O_GBUF); E.ldc = DFF;
  run_gemm((const u16*)(WS(P) + O_HBUF), (const u16*)(WS(P) + O_WFG) + (long)layer * DFF * D, DFF, D, E);
}
__device__ void phase_ffn_val(const Params& P, int layer, int slab) {
  EpiFfnVal E; E.G = (const u16*)(WS(P) + O_GBUF); E.ACT = (u16*)(WS(P) + O_ACT);
  E.cw = P.in[33] + (long)layer * 3 * DFF; E.cb = P.in[34] + (long)layer * DFF; E.L = Lof(slab);
  run_gemm((const u16*)(WS(P) + O_HBUF), (const u16*)(WS(P) + O_WFV) + (long)layer * DFF * D, DFF, D, E);
}

__device__ void phase_hy_conv(const Params& P, int slab) {
  const int L = Lof(slab), nseq = SLAB / L, tid = TID();
  const u16* __restrict__ z = (const u16*)(WS(P) + O_PROJ);
  float* __restrict__ uT = (float*)(WS(P) + O_UT);
  u16* __restrict__ x0c = (u16*)(WS(P) + O_X0C);
  const float* cw = P.in[8];
  const float* cb = P.in[9];
  float* tile = (float*)smem;
  const int ntt = L / 64;
  const int nitems = nseq * ntt * 16;
  const int tl = tid >> 3, cg = tid & 7;
  for (int item = BID(); item < nitems; item += gridDim.x) {
    const int ct = item % 16, tt = (item / 16) % ntt, seq = item / (16 * ntt);
    const int t = tt * 64 + tl, c0 = ct * 64 + cg * 8;
    const long row = (long)seq * L + t;
    const float mp = t > 0 ? 1.f : 0.f, mn = t < L - 1 ? 1.f : 0.f;
    const long rp = t > 0 ? row - 1 : row, rn = t < L - 1 ? row + 1 : row;
    float val[3][8];
#pragma unroll
    for (int q = 0; q < 3; ++q) {
      const int col = q * 1024 + c0;
      float a[8], b[8], c[8];
      unpack8(*(const uint4*)(z + rp * 3072 + col), a);
      unpack8(*(const uint4*)(z + row * 3072 + col), b);
      unpack8(*(const uint4*)(z + rn * 3072 + col), c);
      const float4 w0a = *(const float4*)(cw + col), w0b = *(const float4*)(cw + col + 4);
      const float4 w1a = *(const float4*)(cw + 3072 + col), w1b = *(const float4*)(cw + 3072 + col + 4);
      const float4 w2a = *(const float4*)(cw + 6144 + col), w2b = *(const float4*)(cw + 6144 + col + 4);
      const float4 ba = *(const float4*)(cb + col), bb = *(const float4*)(cb + col + 4);
      const float w0[8] = {w0a.x, w0a.y, w0a.z, w0a.w, w0b.x, w0b.y, w0b.z, w0b.w};
      const float w1[8] = {w1a.x, w1a.y, w1a.z, w1a.w, w1b.x, w1b.y, w1b.z, w1b.w};
      const float w2[8] = {w2a.x, w2a.y, w2a.z, w2a.w, w2b.x, w2b.y, w2b.z, w2b.w};
      const float bs[8] = {ba.x, ba.y, ba.z, ba.w, bb.x, bb.y, bb.z, bb.w};
#pragma unroll
      for (int i = 0; i < 8; ++i) val[q][i] = mp * a[i] * w0[i] + b[i] * w1[i] + mn * c[i] * w2[i] + bs[i];
    }
    *(uint4*)(x0c + row * 1024 + c0) = pack8s(val[0], 1.f);
    __syncthreads();
#pragma unroll
    for (int i = 0; i < 8; ++i) tile[tl * 65 + cg * 8 + i] = val[1][i] * val[2][i];
    __syncthreads();
    {
      const int cl = tid >> 3, tq = tid & 7;
      float* dst = uT + ((long)seq * 1024 + ct * 64 + cl) * L + tt * 64 + tq * 8;
      float4 o0, o1;
      o0.x = tile[(tq * 8 + 0) * 65 + cl]; o0.y = tile[(tq * 8 + 1) * 65 + cl]; o0.z = tile[(tq * 8 + 2) * 65 + cl]; o0.w = tile[(tq * 8 + 3) * 65 + cl];
      o1.x = tile[(tq * 8 + 4) * 65 + cl]; o1.y = tile[(tq * 8 + 5) * 65 + cl]; o1.z = tile[(tq * 8 + 6) * 65 + cl]; o1.w = tile[(tq * 8 + 7) * 65 + cl];
      *(float4*)dst = o0; *(float4*)(dst + 4) = o1;
    }
  }
  __syncthreads();
}

__device__ void phase_hy_fft(const Params& P, int slab, bool dry = false) {
  const int L = Lof(slab), N = 2 * L, nseq = SLAB / L, tid = TID();
  float* uT = (float*)(WS(P) + O_UT);
  const float2* hsb = (const float2*)(WS(P) + (slab == 0 ? O_HSPP : O_HSPS));
  const float2* tw = (const float2*)(WS(P) + O_TW);
  const float* skip = P.in[17];
  float2* buf = (float2*)smem;
  const int nitems = (nseq / 2) * 1024;
  for (int item = BID(); item < nitems; item += gridDim.x) {
    const int pr = item >> 10, c = item & 1023;
    float* u0 = uT + ((long)(pr * 2) * 1024 + c) * L;
    float* u1 = u0 + (long)1024 * L;
    __syncthreads();
    for (int t = tid; t < L; t += NT) {
      buf[t] = make_float2(u0[t], u1[t]);
      buf[t + L] = make_float2(0.f, 0.f);
    }
    __syncthreads();
    fft_dif(buf, N, tw);
    const float2* h = hsb + (long)c * N;
    for (int p = tid; p < N; p += NT) {
      float2 a = buf[p], b = h[p];
      buf[p] = make_float2(a.x * b.x - a.y * b.y, a.x * b.y + a.y * b.x);
    }
    __syncthreads();
    ifft_dit(buf, N, tw);
    const float sk = skip[c];
    for (int t = tid; t < L; t += NT) {
      float2 y = buf[t];
      const long doff = dry ? (long)(END_HY - O_UT) / 4 : 0;
      u0[t + doff] = y.x + u0[t] * sk;
      u1[t + doff] = y.y + u1[t] * sk;
    }
  }
  __syncthreads();
}

__device__ void phase_hy_tr(const Params& P, int slab) {
  const int L = Lof(slab), nseq = SLAB / L, tid = TID();
  const float* __restrict__ yT = (const float*)(WS(P) + O_UT);
  const u16* __restrict__ x0c = (const u16*)(WS(P) + O_X0C);
  u16* __restrict__ a2 = (u16*)(WS(P) + O_A2);
  float* tile = (float*)smem;
  const int ntt = L / 64;
  const int nitems = nseq * ntt * 16;
  for (int item = BID(); item < nitems; item += gridDim.x) {
    const int ct = item % 16, tt = (item / 16) % ntt, seq = item / (16 * ntt);
    const int cl = tid >> 3, tq = tid & 7;
    const float* src = yT + ((long)seq * 1024 + ct * 64 + cl) * L + tt * 64 + tq * 8;
    const float4 i0 = *(const float4*)src, i1 = *(const float4*)(src + 4);
    const int tl = tid >> 3, cg = tid & 7;
    const long row = (long)seq * L + tt * 64 + tl;
    const int c0 = ct * 64 + cg * 8;
    float xg[8];
    unpack8(*(const uint4*)(x0c + row * 1024 + c0), xg);
    __syncthreads();
    float* p = tile + cl * 65 + tq * 8;
    p[0] = i0.x; p[1] = i0.y; p[2] = i0.z; p[3] = i0.w; p[4] = i1.x; p[5] = i1.y; p[6] = i1.z; p[7] = i1.w;
    __syncthreads();
    float o[8];
#pragma unroll
    for (int i = 0; i < 8; ++i) o[i] = tile[(cg * 8 + i) * 65 + tl] * xg[i];
    *(uint4*)(a2 + row * 1024 + c0) = pack8s(o, 1.f);
  }
  __syncthreads();
}

struct Rec {
  int H, DK, DV, C;
  int ldv, voff, goff;
};
__device__ __forceinline__ Rec rec_of(int kind) {
  Rec r;
  if (kind == 1) { r.H = 4; r.DK = 256; r.DV = 512; r.C = 128; r.ldv = 6144; r.voff = 2048; r.goff = 4096; }
  else { r.H = 8; r.DK = 128; r.DV = 128; r.C = 64; r.ldv = 5120; r.voff = 1024; r.goff = 4096; }
  return r;
}

__device__ void phase_ret_prep(const Params& P, int slab) {
  const int L = Lof(slab);
  const u16* __restrict__ pj = (const u16*)(WS(P) + O_PROJ);
  u16* __restrict__ qdf = (u16*)(WS(P) + O_QDF); u16* __restrict__ qdb = (u16*)(WS(P) + O_QDB);
  u16* __restrict__ kif = (u16*)(WS(P) + O_KIF); u16* __restrict__ kib = (u16*)(WS(P) + O_KIB);
  u16* __restrict__ kef = (u16*)(WS(P) + O_KEF); u16* __restrict__ keb = (u16*)(WS(P) + O_KEB);
  float* dlf = (float*)(WS(P) + O_DLF); float* dlb = (float*)(WS(P) + O_DLB);
  const float2* __restrict__ rope = (const float2*)(WS(P) + O_ROPER);
  const long gtid = (long)BID() * NT + TID(), gsz = (long)gridDim.x * NT;
  for (long idx = gtid; idx < (long)SLAB * 64; idx += gsz) {
    const int d0 = (int)(idx & 15) * 8, h = (int)((idx >> 4) & 3), t = (int)(idx >> 6);
    const int pos = t & (L - 1), r = t & 127;
    const float lgf = -expf(P.in[20][h]), lgb = -expf(P.in[20][4 + h]);
    const u16* row = pj + (long)t * 6144 + h * 256 + d0;
    const uint4 vq1 = *(const uint4*)row, vq2 = *(const uint4*)(row + 128);
    const uint4 vk1 = *(const uint4*)(row + 1024), vk2 = *(const uint4*)(row + 1024 + 128);
    const float4* rp = (const float4*)(rope + (long)pos * 128 + d0);
    const float4 c01 = rp[0], c23 = rp[1], c45 = rp[2], c67 = rp[3];
    float q1[8], q2[8], k1[8], k2[8];
    unpack8(vq1, q1); unpack8(vq2, q2); unpack8(vk1, k1); unpack8(vk2, k2);
    const float cs[8] = {c01.x, c01.z, c23.x, c23.z, c45.x, c45.z, c67.x, c67.z};
    const float sn[8] = {c01.y, c01.w, c23.y, c23.w, c45.y, c45.w, c67.y, c67.w};
    float qa[8], qb[8], ka[8], kb[8];
#pragma unroll
    for (int i = 0; i < 8; ++i) {
      qa[i] = q1[i] * cs[i] - q2[i] * sn[i]; qb[i] = q1[i] * sn[i] + q2[i] * cs[i];
      ka[i] = (k1[i] * cs[i] - k2[i] * sn[i]) * 0.0625f; kb[i] = (k1[i] * sn[i] + k2[i] * cs[i]) * 0.0625f;
    }
    const float bf = (float)(r + 1) * lgf, bb = (float)(128 - r) * lgb;
    const float ef = expf(bf), eif = expf(-bf), eef = expf((float)(127 - r) * lgf);
    const float eb = expf(bb), eib = expf(-bb), eeb = expf((float)r * lgb);
    const long o1 = (long)t * 1024 + h * 256 + d0, o2 = o1 + 128;
    *(uint4*)(qdf + o1) = pack8s(qa, ef); *(uint4*)(qdf + o2) = pack8s(qb, ef);
    *(uint4*)(qdb + o1) = pack8s(qa, eb); *(uint4*)(qdb + o2) = pack8s(qb, eb);
    *(uint4*)(kif + o1) = pack8s(ka, eif); *(uint4*)(kif + o2) = pack8s(kb, eif);
    *(uint4*)(kib + o1) = pack8s(ka, eib); *(uint4*)(kib + o2) = pack8s(kb, eib);
    *(uint4*)(kef + o1) = pack8s(ka, eef); *(uint4*)(kef + o2) = pack8s(kb, eef);
    *(uint4*)(keb + o1) = pack8s(ka, eeb); *(uint4*)(keb + o2) = pack8s(kb, eeb);
    if (r == 0) {
      const long cgi = (long)(t >> 7) * 1024 + h * 256 + d0;
      const float df = expf(128.f * lgf), db = expf(128.f * lgb);
#pragma unroll
      for (int i = 0; i < 8; ++i) { dlf[cgi + i] = df; dlf[cgi + 128 + i] = df; dlb[cgi + i] = db; dlb[cgi + 128 + i] = db; }
    }
  }
}

__device__ __forceinline__ float lb_of(const float* lbt, int dr, int ch) {
  const float a0 = lbt[(dr * 4 + 0) * 1024 + ch], a1 = lbt[(dr * 4 + 1) * 1024 + ch], a2 = lbt[(dr * 4 + 2) * 1024 + ch], a3 = lbt[(dr * 4 + 3) * 1024 + ch];
  const float m = fmaxf(fmaxf(a0, a1), fmaxf(a2, a3));
  const float e0 = expf(a0 - m), e1 = expf(a1 - m), e2 = expf(a2 - m), e3 = expf(a3 - m);
  return (e0 + e1 + e2) / (e0 + e1 + e2 + e3);
}
__device__ void phase_hg_prep(const Params& P) {
  const u16* __restrict__ pj = (const u16*)(WS(P) + O_PROJ);
  u16* __restrict__ qdf = (u16*)(WS(P) + O_QDF); u16* __restrict__ qdb = (u16*)(WS(P) + O_QDB);
  u16* __restrict__ kif = (u16*)(WS(P) + O_KIF); u16* __restrict__ kib = (u16*)(WS(P) + O_KIB);
  u16* __restrict__ kef = (u16*)(WS(P) + O_KEF); u16* __restrict__ keb = (u16*)(WS(P) + O_KEB);
  float* dlf = (float*)(WS(P) + O_DLF); float* dlb = (float*)(WS(P) + O_DLB);
  const float* lbt = P.in[28];
  float* totF = (float*)smem;
  float* totB = totF + 1024;
  const int tid = TID(), lane = tid & 63, rg = tid >> 6;
  for (int item = BID(); item < 2048; item += gridDim.x) {
    const int cgi = item >> 3, ch = (item & 7) * 128 + lane * 2;
    const long t0 = (long)cgi * 64 + rg * 8;
    unsigned wq[8], wf[8], wb[8];
#pragma unroll
    for (int i = 0; i < 8; ++i) {
      const u16* row = pj + (t0 + i) * 5120 + ch;
      wq[i] = *(const unsigned*)row; wf[i] = *(const unsigned*)(row + 2048); wb[i] = *(const unsigned*)(row + 3072);
    }
    float lb0[2], lb1[2];
    lb0[0] = lb_of(lbt, 0, ch); lb0[1] = lb_of(lbt, 0, ch + 1);
    lb1[0] = lb_of(lbt, 1, ch); lb1[1] = lb_of(lbt, 1, ch + 1);
    float pf[2][8], sb[2][8], accf[2], accb[2];
#pragma unroll
    for (int c = 0; c < 2; ++c) {
      float a = 0.f;
#pragma unroll
      for (int i = 0; i < 8; ++i) {
        const float x = bf2f((u16)(c ? (wf[i] >> 16) : (wf[i] & 0xffff)));
        a += logf(lb0[c] + (1.f - lb0[c]) * sigm(x)); pf[c][i] = a;
      }
      accf[c] = a;
      a = 0.f;
#pragma unroll
      for (int i = 7; i >= 0; --i) {
        const float x = bf2f((u16)(c ? (wb[i] >> 16) : (wb[i] & 0xffff)));
        a += logf(lb1[c] + (1.f - lb1[c]) * sigm(x)); sb[c][i] = a;
      }
      accb[c] = a;
    }
    __syncthreads();
    *(float2*)(totF + rg * 128 + lane * 2) = make_float2(accf[0], accf[1]);
    *(float2*)(totB + rg * 128 + lane * 2) = make_float2(accb[0], accb[1]);
    __syncthreads();
    float offF[2] = {0.f, 0.f}, offB[2] = {0.f, 0.f}, totf[2] = {0.f, 0.f}, totb[2] = {0.f, 0.f};
#pragma unroll
    for (int g = 0; g < 8; ++g) {
      const float2 f = *(const float2*)(totF + g * 128 + lane * 2), bq = *(const float2*)(totB + g * 128 + lane * 2);
      totf[0] += f.x; totf[1] += f.y; totb[0] += bq.x; totb[1] += bq.y;
      if (g < rg) { offF[0] += f.x; offF[1] += f.y; }
      if (g > rg) { offB[0] += bq.x; offB[1] += bq.y; }
    }
#pragma unroll
    for (int i = 0; i < 8; ++i) {
      float o[6][2];
#pragma unroll
      for (int c = 0; c < 2; ++c) {
        const float xq = bf2f((u16)(c ? (wq[i] >> 16) : (wq[i] & 0xffff)));
        const float xf = bf2f((u16)(c ? (wf[i] >> 16) : (wf[i] & 0xffff)));
        const float xb = bf2f((u16)(c ? (wb[i] >> 16) : (wb[i] & 0xffff)));
        const float q = silu_f(xq);
        const float bf = offF[c] + pf[c][i], bb = offB[c] + sb[c][i];
        const float kf = (1.f - lb0[c]) * sigm(-xf), kb = (1.f - lb1[c]) * sigm(-xb);
        o[0][c] = q * expf(bf); o[1][c] = kf * expf(-bf); o[2][c] = kf * expf(totf[c] - bf);
        o[3][c] = q * expf(bb); o[4][c] = kb * expf(-bb); o[5][c] = kb * expf(totb[c] - bb);
      }
      const long oo = (t0 + i) * 1024 + ch;
      *(unsigned*)(qdf + oo) = pack2(o[0][0], o[0][1]);
      *(unsigned*)(kif + oo) = pack2(o[1][0], o[1][1]);
      *(unsigned*)(kef + oo) = pack2(o[2][0], o[2][1]);
      *(unsigned*)(qdb + oo) = pack2(o[3][0], o[3][1]);
      *(unsigned*)(kib + oo) = pack2(o[4][0], o[4][1]);
      *(unsigned*)(keb + oo) = pack2(o[5][0], o[5][1]);
    }
    if (rg == 0) {
      *(float2*)(dlf + (long)cgi * 1024 + ch) = make_float2(expf(totf[0]), expf(totf[1]));
      *(float2*)(dlb + (long)cgi * 1024 + ch) = make_float2(expf(totb[0]), expf(totb[1]));
    }
  }
  __syncthreads();
}

template <int C>
__device__ __forceinline__ void rec_scores_item(const Params& P, const Rec& R, int cgi, int h) {
  const u16* qdf = (const u16*)(WS(P) + O_QDF); const u16* qdb = (const u16*)(WS(P) + O_QDB);
  const u16* kif = (const u16*)(WS(P) + O_KIF); const u16* kib = (const u16*)(WS(P) + O_KIB);
  u16* sc = (u16*)(WS(P) + O_SC) + ((long)cgi * R.H + h) * C * C;
  const long off = (long)cgi * C * 1024 + h * R.DK;
  f32x4 af[C / 32][C / 64] = {}, ab[C / 32][C / 64] = {};
  gemm_acc<C, C, true, true, true, (C == 128 ? 4 : 2)>(af, qdf + off, 1024, kif + off, 1024, (u16*)smem);
  gemm_acc<C, C, true, true, true, (C == 128 ? 4 : 2)>(ab, qdb + off, 1024, kib + off, 1024, (u16*)smem);
  const int tid = TID(), lane = tid & 63, wid = tid >> 6;
  const int wm = wid >> 2, wn = wid & 3, fr = lane & 15, fq = lane >> 4;
#pragma unroll
  for (int mi = 0; mi < C / 32; ++mi)
#pragma unroll
    for (int ni = 0; ni < C / 64; ++ni) {
      const int r = wm * (C / 2) + mi * 16 + fr, c0 = wn * (C / 4) + ni * 16 + fq * 4;
      float v[4];
#pragma unroll
      for (int j = 0; j < 4; ++j) {
        const int c = c0 + j;
        v[j] = (c <= r ? af[mi][ni][j] : 0.f) + (c >= r ? ab[mi][ni][j] : 0.f);
      }
      *(uint2*)(sc + r * C + c0) = make_uint2(pack2(v[0], v[1]), pack2(v[2], v[3]));
    }
}

template <int C>
__device__ void phase_rec_su(const Params& P, int kind) {
  const Rec R = rec_of(kind);
  const int nch = SLAB / C;
  const int n_sc = nch * R.H;
  const int mtn = R.DK / 128, ntn = R.DV / 128;
  const int n_u = nch * R.H * 2 * mtn * ntn;
  const u16* pj = (const u16*)(WS(P) + O_PROJ);
  for (int item = BID(); item < n_sc + n_u; item += gridDim.x) {
    if (item < n_sc) {
      rec_scores_item<C>(P, R, item / R.H, item % R.H);
    } else {
      int q = item - n_sc;
      const int nt = q % ntn; q /= ntn;
      const int mt = q % mtn; q /= mtn;
      const int dir = q & 1; q >>= 1;
      const int h = q % R.H, cgi = q / R.H;
      const u16* ke = (const u16*)(WS(P) + (dir ? O_KEB : O_KEF)) + (long)cgi * C * 1024 + h * R.DK + mt * 128;
      const u16* v = pj + (long)cgi * C * R.ldv + R.voff + h * R.DV + nt * 128;
      u16* st = (u16*)(WS(P) + (dir ? O_STB : O_STF)) + (((long)cgi * R.H + h) * R.DV + nt * 128) * R.DK + mt * 128;
      f32x4 acc[4][2] = {};
      gemm_acc<128, 128, false, false, false, C / 64>(acc, ke, 1024, v, R.ldv, (u16*)smem);
      const int DK = R.DK;
      epi_each<128, 128, false>(acc, [&](int r, int c, f32x4 val) {
        *(uint2*)(st + (long)c * DK + r) = make_uint2(pack2(val[0], val[1]), pack2(val[2], val[3]));
      });
    }
  }
}

__device__ void phase_rec_scan(const Params& P, int kind, int slab, bool dry = false) {
  const Rec R = rec_of(kind);
  const int L = Lof(slab), nseq = SLAB / L, ncs = L / R.C;
  const int qdk = R.DK / 4;
  const long per = (long)R.H * R.DV * qdk;
  const long total = 2 * nseq * per;
  const long gtid = (long)BID() * NT + TID(), gsz = (long)gridDim.x * NT;
  for (long idx = gtid; idx < total; idx += gsz) {
    long q = idx;
    const int pd = (int)(q % qdk); q /= qdk;
    const int e = (int)(q % R.DV); q /= R.DV;
    const int h = (int)(q % R.H); q /= R.H;
    const int seq = (int)(q % nseq);
    const int dir = (int)(q / nseq);
    u16* st = (u16*)(WS(P) + (dir ? O_STB : O_STF));
    u16* stw = dry ? (u16*)(WS(P) + O_OBUF) : st;
    const float* dl = (const float*)(WS(P) + (dir ? O_DLB : O_DLF));
    float s0 = 0.f, s1 = 0.f, s2 = 0.f, s3 = 0.f;
    const long ebase = ((long)h * R.DV + e) * R.DK + pd * 4;
    const long cstride = (long)R.H * R.DV * R.DK;
    const int dbase = h * R.DK + pd * 4;
    for (int i0 = 0; i0 < ncs; i0 += 8) {
      uint2 u[8];
      float4 dd[8];
#pragma unroll
      for (int j = 0; j < 8; ++j) {
        const int n = dir ? (ncs - 1 - i0 - j) : (i0 + j);
        const long cgi = (long)seq * ncs + n;
        u[j] = *(const uint2*)(st + cgi * cstride + ebase);
        dd[j] = *(const float4*)(dl + cgi * 1024 + dbase);
      }
#pragma unroll
      for (int j = 0; j < 8; ++j) {
        const int n = dir ? (ncs - 1 - i0 - j) : (i0 + j);
        const long cgi = (long)seq * ncs + n;
        *(uint2*)(stw + cgi * cstride + ebase) = make_uint2(pack2(s0, s1), pack2(s2, s3));
        s0 = dd[j].x * s0 + bf2f((u16)(u[j].x & 0xffff));
        s1 = dd[j].y * s1 + bf2f((u16)(u[j].x >> 16));
        s2 = dd[j].z * s2 + bf2f((u16)(u[j].y & 0xffff));
        s3 = dd[j].w * s3 + bf2f((u16)(u[j].y >> 16));
      }
    }
  }
}

template <int C>
__device__ void phase_rec_out(const Params& P, int kind) {
  const Rec R = rec_of(kind);
  const int nch = SLAB / C, ntn = R.DV / 128;
  const u16* pj = (const u16*)(WS(P) + O_PROJ);
  float* ob = (float*)(WS(P) + O_OBUF);
  const int HDV = R.H * R.DV;
  for (int item = BID(); item < nch * R.H * ntn; item += gridDim.x) {
    const int nt = item % ntn, h = (item / ntn) % R.H, cgi = item / (ntn * R.H);
    f32x4 acc[C / 32][2] = {};
    const u16* sc = (const u16*)(WS(P) + O_SC) + ((long)cgi * R.H + h) * C * C;
    const u16* v = pj + (long)cgi * C * R.ldv + R.voff + h * R.DV + nt * 128;
    gemm_acc<C, 128, true, false, true, C / 64>(acc, sc, C, v, R.ldv, (u16*)smem);
    const long qoff = (long)cgi * C * 1024 + h * R.DK;
    const long soff = (((long)cgi * R.H + h) * R.DV + nt * 128) * R.DK;
    gemm_acc<C, 128, true, true, true, (C == 128 ? 4 : 2)>(acc, (const u16*)(WS(P) + O_QDF) + qoff, 1024, (const u16*)(WS(P) + O_STF) + soff, R.DK, (u16*)smem);
    gemm_acc<C, 128, true, true, true, (C == 128 ? 4 : 2)>(acc, (const u16*)(WS(P) + O_QDB) + qoff, 1024, (const u16*)(WS(P) + O_STB) + soff, R.DK, (u16*)smem);
    float* o = ob + (long)cgi * C * HDV + h * R.DV + nt * 128;
    epi_each<C, 128, true>(acc, [&](int r, int c, f32x4 val) { *(f32x4*)(o + (long)r * HDV + c) = val; });
  }
}

template <int KIND>
__device__ void phase_rec_ng_t(const Params& P) {
  const Rec R = rec_of(KIND);
  constexpr int DV = (KIND == 1) ? 512 : 128, H = (KIND == 1) ? 4 : 8, PER = DV / 64, HDV = H * DV;
  const float* __restrict__ ob = (const float*)(WS(P) + O_OBUF);
  const u16* __restrict__ pj = (const u16*)(WS(P) + O_PROJ);
  u16* __restrict__ a2 = (u16*)(WS(P) + O_A2);
  const float* gain = P.in[29];
  const int tid = TID(), lane = tid & 63, wid = tid >> 6;
  constexpr int nrows = SLAB * H;
  for (int item = BID(); item < nrows / 32; item += gridDim.x) {
    float v[4][PER];
    float ss[4];
#pragma unroll
    for (int u = 0; u < 4; ++u) {
      const int rh = item * 32 + wid * 4 + u;
      const int t = rh / H, h = rh % H;
      const float* o = ob + (long)t * HDV + h * DV + lane * PER;
      if (PER == 8) {
        const float4 a = *(const float4*)o, b = *(const float4*)(o + 4);
        v[u][0] = a.x; v[u][1] = a.y; v[u][2] = a.z; v[u][3] = a.w; v[u][4 % PER] = b.x; v[u][5 % PER] = b.y; v[u][6 % PER] = b.z; v[u][7 % PER] = b.w;
      } else {
        const float2 a = *(const float2*)o;
        v[u][0] = a.x; v[u][1] = a.y;
      }
      float a = 0.f;
#pragma unroll
      for (int i = 0; i < PER; ++i) a += v[u][i] * v[u][i];
      ss[u] = a;
    }
#pragma unroll
    for (int u = 0; u < 4; ++u) ss[u] = wave_sum(ss[u]);
#pragma unroll
    for (int u = 0; u < 4; ++u) {
      const int rh = item * 32 + wid * 4 + u;
      const int t = rh / H, h = rh % H;
      const float rstd = rsqrtf(ss[u] / (float)DV + 1e-6f);
      const u16* g = pj + (long)t * R.ldv + R.goff + h * DV + lane * PER;
      u16* out = a2 + (long)t * HDV + h * DV + lane * PER;
      float y[PER];
#pragma unroll
      for (int i = 0; i < PER; ++i) {
        y[i] = v[u][i] * rstd;
        if (KIND == 3) y[i] *= gain[lane * PER + i];
      }
      if (PER == 8) {
        const uint4 gw = *(const uint4*)g;
        float gf[8];
        unpack8(gw, gf);
        float r8[8];
#pragma unroll
        for (int i = 0; i < 8; ++i) r8[i] = y[i % PER] * silu_f(gf[i]);
        *(uint4*)out = pack8s(r8, 1.f);
      } else {
        const unsigned gw = *(const unsigned*)g;
        *(unsigned*)out = pack2(y[0] * silu_f(bf2f((u16)(gw & 0xffff))), y[1 % PER] * silu_f(bf2f((u16)(gw >> 16))));
      }
    }
  }
}
__device__ void phase_rec_ng(const Params& P, int kind) {
  if (kind == 1) phase_rec_ng_t<1>(P); else phase_rec_ng_t<3>(P);
}

__device__ void phase_swa_prep(const Params& P, int slab) {
  const int L = Lof(slab);
  const u16* pj = (const u16*)(WS(P) + O_PROJ);
  u16* qn = (u16*)(WS(P) + O_QN);
  u16* kn = (u16*)(WS(P) + O_KN);
  const float2* rope = (const float2*)(WS(P) + O_ROPES);
  const long gtid = (long)BID() * NT + TID(), gsz = (long)gridDim.x * NT;
  for (long idx = gtid; idx < (long)SLAB * 640; idx += gsz) {
    const int d = (int)(idx & 31);
    const int hd = (int)((idx >> 5) % 20);
    const int t = (int)(idx / 640);
    const int col = hd < 16 ? hd * 64 : 1024 + (hd - 16) * 64;
    const float x1 = bf2f(pj[(long)t * 1536 + col + d]), x2 = bf2f(pj[(long)t * 1536 + col + d + 32]);
    float ss = x1 * x1 + x2 * x2;
#pragma unroll
    for (int o = 16; o; o >>= 1) ss += __shfl_xor(ss, o);
    const float rstd = rsqrtf(ss * (1.f / 64.f) + 1e-6f);
    const float* gn = hd < 16 ? P.in[23] : P.in[24];
    const float y1 = x1 * rstd * gn[d], y2 = x2 * rstd * gn[d + 32];
    const float2 cs = rope[(long)(t & (L - 1)) * 32 + d];
    float o1 = y1 * cs.x - y2 * cs.y, o2 = y1 * cs.y + y2 * cs.x;
    if (hd < 16) {
      qn[(long)t * 1024 + hd * 64 + d] = f2bf(o1 * 0.125f);
      qn[(long)t * 1024 + hd * 64 + d + 32] = f2bf(o2 * 0.125f);
    } else {
      kn[(long)t * 256 + (hd - 16) * 64 + d] = f2bf(o1);
      kn[(long)t * 256 + (hd - 16) * 64 + d + 32] = f2bf(o2);
    }
  }
}

constexpr int SLD = 324;
__device__ void phase_swa_att1(const Params& P, int slab) {
  const int L = Lof(slab), nqb = L / 64;
  const u16* qn = (const u16*)(WS(P) + O_QN);
  const u16* kn = (const u16*)(WS(P) + O_KN);
  u16* pb = (u16*)(WS(P) + O_PBUF);
  const float* sink = P.in[25];
  float* S = (float*)(smem + 40960);
  const int tid = TID();
  const int nitems = (SLAB / 64) * 16;
  for (int item = BID(); item < nitems; item += gridDim.x) {
    const int hq = item & 15, qbg = item >> 4;
    const int seq = qbg / nqb, qb = qbg % nqb;
    const int q0 = qb * 64;
    const long tok0 = (long)seq * L;
    const int hkv = hq >> 2;
    for (int kt = 0; kt < 5; ++kt) {
      const int kp0 = q0 - 128 + kt * 64;
      if (kp0 >= 0 && kp0 < L) {
        f32x4 acc[2][1] = {};
        gemm_acc<64, 64, true, true, true, 1>(acc, qn + (tok0 + q0) * 1024 + hq * 64, 1024, kn + (tok0 + kp0) * 256 + hkv * 64, 256, (u16*)smem);
        epi_each<64, 64, true>(acc, [&](int r, int c, f32x4 v) {
          f32x4 o;
#pragma unroll
          for (int j = 0; j < 4; ++j) {
            const int dlt = (q0 + r) - (kp0 + c + j);
            o[j] = (dlt <= 128 && dlt >= -128) ? v[j] : -1e30f;
          }
          *(f32x4*)(S + r * SLD + kt * 64 + c) = o;
        });
      } else {
        for (int i = tid; i < 4096; i += NT) S[(i >> 6) * SLD + kt * 64 + (i & 63)] = -1e30f;
      }
    }
    __syncthreads();
    {
      const int r = tid >> 3, sub = tid & 7;
      const float sk = sink[hq];
      float m = sk;
      for (int c = sub; c < 320; c += 8) m = fmaxf(m, S[r * SLD + c]);
      m = fmaxf(m, __shfl_xor(m, 1)); m = fmaxf(m, __shfl_xor(m, 2)); m = fmaxf(m, __shfl_xor(m, 4));
      float den = 0.f;
      for (int c = sub; c < 320; c += 8) { float e = __expf(S[r * SLD + c] - m); S[r * SLD + c] = e; den += e; }
      den += __shfl_xor(den, 1); den += __shfl_xor(den, 2); den += __shfl_xor(den, 4);
      den += __expf(sk - m);
      const float inv = 1.f / den;
      u16* prow = pb + ((long)item * 64 + r) * 320;
      for (int c = sub; c < 320; c += 8) prow[c] = f2bf(S[r * SLD + c] * inv);
    }
    __syncthreads();
  }
}

__device__ void phase_swa_att2(const Params& P, int slab) {
  const int L = Lof(slab), nqb = L / 64;
  const u16* pj = (const u16*)(WS(P) + O_PROJ);
  const u16* pb = (const u16*)(WS(P) + O_PBUF);
  u16* a2 = (u16*)(WS(P) + O_A2);
  const int nitems = (SLAB / 64) * 16;
  for (int item = BID(); item < nitems; item += gridDim.x) {
    const int hq = item & 15, qbg = item >> 4;
    const int seq = qbg / nqb, qb = qbg % nqb;
    const int q0 = qb * 64;
    const long tok0 = (long)seq * L;
    const int hkv = hq >> 2;
    f32x4 acc[2][1] = {};
    for (int kt = 0; kt < 5; ++kt) {
      const int kp0 = q0 - 128 + kt * 64;
      if (kp0 >= 0 && kp0 < L)
        gemm_acc<64, 64, true, false, true, 1>(acc, pb + (long)item * 64 * 320 + kt * 64, 320, pj + (tok0 + kp0) * 1536 + 1280 + hkv * 64, 1536, (u16*)smem);
    }
    u16* o = a2 + (tok0 + q0) * 1024 + hq * 64;
    epi_each<64, 64, true>(acc, [&](int r, int c, f32x4 v) { *(uint2*)(o + (long)r * 1024 + c) = make_uint2(pack2(v[0], v[1]), pack2(v[2], v[3])); });
  }
}


#define XB_TMO      128
#define XB_XCNT(j)  (256  + 64 * (j))
#define XB_XSUB(j)  (1280 + 64 * (j))
#define XB_XGEN(j)  (2304 + 64 * (j))
#define XB_TOP      3328
#define XB_TOPGEN   3392
#define XCD_BAR_WORDS 3456
#define XB_SPIN_CAP (1u << 18)
__device__ __forceinline__ unsigned xb_ld(unsigned* p)              { return __hip_atomic_load(p, __ATOMIC_RELAXED, __HIP_MEMORY_SCOPE_AGENT); }
__device__ __forceinline__ unsigned xb_add(unsigned* p, unsigned v) { return __hip_atomic_fetch_add(p, v, __ATOMIC_RELAXED, __HIP_MEMORY_SCOPE_AGENT); }
__device__ __forceinline__ unsigned xb_xcc_id() { return (unsigned)__builtin_amdgcn_s_getreg((3 << 11) | 20) & 0xFu; }
#define XB_SPIN(cond, bar) do { unsigned _sp = 0; while (cond) { __builtin_amdgcn_s_sleep(1); \
    if ((++_sp & 255u) == 0u) { if (xb_ld(&(bar)[XB_TMO])) break; if (_sp > XB_SPIN_CAP) { atomicAdd(&(bar)[XB_TMO], 1u); break; } } } } while (0)
struct XcdBarrier { unsigned* bar; unsigned x; volatile LDS_AS unsigned* st; };
__device__ __forceinline__ XcdBarrier xcd_barrier_post(unsigned* bar, volatile LDS_AS unsigned* st) {
    XcdBarrier b; b.bar = bar; b.x = xb_xcc_id(); b.st = st;
    if (threadIdx.x == 0) (void)xb_add(&bar[XB_XCNT(b.x)], 1u);
    return b;
}
__device__ __forceinline__ void xcd_barrier_complete(unsigned* bar, unsigned x, unsigned& nloc, unsigned& nx) {
    const unsigned G = gridDim.x * gridDim.y * gridDim.z;
    unsigned sum, cnt, mine, sp = 0u;
    for (;;) {
        sum = 0u; cnt = 0u; mine = 0u;
#pragma unroll
        for (unsigned j = 0; j < 16; ++j) { const unsigned c = xb_ld(&bar[XB_XCNT(j)]); sum += c; cnt += (c > 0u) ? 1u : 0u; mine = (j == x) ? c : mine; }
        if (sum == G) break;
        __builtin_amdgcn_s_sleep(1);
        if ((++sp & 255u) == 0u) { if (xb_ld(&bar[XB_TMO])) break; if (sp > XB_SPIN_CAP) { atomicAdd(&bar[XB_TMO], 1u); break; } }
    }
    nloc = mine > 0u ? mine : 1u; nx = cnt > 0u ? cnt : 1u;
}
__device__ __forceinline__ void xcd_barrier(const XcdBarrier& b) {
    asm volatile("s_waitcnt vmcnt(0)" ::: "memory");
    __syncthreads();
    if (threadIdx.x == 0) {
        unsigned* bar = b.bar;
        __builtin_amdgcn_s_waitcnt(0);
        unsigned nloc = b.st[0], nx = b.st[1];
        if (nloc == 0u) { xcd_barrier_complete(bar, b.x, nloc, nx); b.st[0] = nloc; b.st[1] = nx; }
        const unsigned old = xb_add(&bar[XB_XSUB(b.x)], 1u);
        const unsigned gen = old / nloc;
        if (old + 1u == (gen + 1u) * nloc) {
            __builtin_amdgcn_fence(__ATOMIC_RELEASE, "agent");
            asm volatile("s_waitcnt vmcnt(0)" ::: "memory");
            const unsigned og = xb_add(&bar[XB_TOP], 1u);
            const unsigned tg = og / nx;
            if (og + 1u == (tg + 1u) * nx) xb_add(&bar[XB_TOPGEN], 1u);
            else XB_SPIN(xb_ld(&bar[XB_TOPGEN]) == tg, bar);
            __builtin_amdgcn_fence(__ATOMIC_ACQUIRE, "agent");
            xb_add(&bar[XB_XGEN(b.x)], 1u);
            asm volatile("s_waitcnt vmcnt(0)" ::: "memory");
        } else {
            XB_SPIN(xb_ld(&bar[XB_XGEN(b.x)]) == gen, bar);
            __builtin_amdgcn_fence(__ATOMIC_ACQUIRE, "agent");
            asm volatile("s_waitcnt vmcnt(0)" ::: "memory");
        }
    }
    __syncthreads();
}

__device__ __forceinline__ int nsteps_of(int kind) { return (kind & 1) ? 12 : 10; }

__device__ void layer_step(const Params& P, int layer, int slab, int step) {
  const int kind = layer;
  const int nmix = nsteps_of(kind) - 4;
  if (step == 0) { REP(4) phase_norm(P, layer, slab, 0); return; }
  if (step >= nmix) {
    const int f = step - nmix;
    if (f == 0) { REP(4) phase_norm(P, layer, slab, 1); }
    else if (f == 1) { REP(0) phase_ffn_gate(P, layer); }
    else if (f == 2) { REP(0) phase_ffn_val(P, layer, slab); }
    else phase_resid(P, layer, slab, (const u16*)(WS(P) + O_ACT), DFF, O_WFD + (size_t)layer * SZW(1024, 2816), 5 * D);
    return;
  }
  if (kind == 0) {
    if (step == 1) { REP(0) phase_proj(P, O_WHYIN, 3072); }
    else if (step == 2) { REP(3) phase_hy_conv(P, slab); }
    else if (step == 3) { if ((PROBE_MASK >> 7) & 1) phase_hy_fft(P, slab, true); phase_hy_fft(P, slab); }
    else if (step == 4) { REP(3) phase_hy_tr(P, slab); }
    else phase_resid(P, layer, slab, (const u16*)(WS(P) + O_A2), 1024, O_WHYOUT, 2 * D);
  } else if (kind == 1) {
    if (step == 1) { REP(0) phase_proj(P, O_WRETIN, 6144); }
    else if (step == 2) { REP(1) REP(9) phase_ret_prep(P, slab); }
    else if (step == 3) { REP(1) REP(11) phase_rec_su<128>(P, 1); }
    else if (step == 4) { if ((PROBE_MASK >> 6) & 1) phase_rec_scan(P, 1, slab, true); phase_rec_scan(P, 1, slab); }
    else if (step == 5) { REP(1) REP(12) phase_rec_out<128>(P, 1); }
    else if (step == 6) { REP(1) REP(9) phase_rec_ng(P, 1); }
    else phase_resid(P, layer, slab, (const u16*)(WS(P) + O_A2), 2048, O_WRETOUT, 2 * D);
  } else if (kind == 2) {
    if (step == 1) { REP(0) phase_proj(P, O_WSWAIN, 1536); }
    else if (step == 2) { REP(2) REP(14) phase_swa_prep(P, slab); }
    else if (step == 3) { REP(2) REP(15) phase_swa_att1(P, slab); }
    else if (step == 4) { REP(2) REP(16) phase_swa_att2(P, slab); }
    else phase_resid(P, layer, slab, (const u16*)(WS(P) + O_A2), 1024, O_WSWAOUT, 2 * D);
  } else {
    if (step == 1) { REP(0) phase_proj(P, O_WHGIN, 5120); }
    else if (step == 2) { REP(1) REP(9) phase_hg_prep(P); }
    else if (step == 3) { REP(1) REP(11) phase_rec_su<64>(P, 3); }
    else if (step == 4) { if ((PROBE_MASK >> 6) & 1) phase_rec_scan(P, 3, slab, true); phase_rec_scan(P, 3, slab); }
    else if (step == 5) { REP(1) REP(12) phase_rec_out<64>(P, 3); }
    else if (step == 6) { REP(1) REP(9) phase_rec_ng(P, 3); }
    else phase_resid(P, layer, slab, (const u16*)(WS(P) + O_A2), 1024, O_WHGOUT, 2 * D);
  }
}

__global__ void __launch_bounds__(NT) fwd_megakernel(Params P) {
  cg::grid_group grid = cg::this_grid();
  __shared__ uint4 xb_words;
  if (threadIdx.x == 0) xb_words = make_uint4(0u, 0u, 0u, 0u);
  __syncthreads();
  XcdBarrier xb = xcd_barrier_post((unsigned*)(P.ws + O_BAR), (volatile LDS_AS unsigned*)&xb_words);
  for (int pid = P.p0; pid < P.p1; ++pid) {
    if (pid == 0) { REP(5) phase_pre0(P); }
    else if (pid == 1) { REP(5) phase_pre1(P); }
    else {
      int q = pid - 2, layer = 0;
      while (q >= 5 * nsteps_of(layer)) { q -= 5 * nsteps_of(layer); ++layer; }
      const int ns = nsteps_of(layer);
      layer_step(P, layer, q / ns, q % ns);
    }
    if (pid + 1 < P.p1) {
      if (pid == 0) grid.sync();
      else xcd_barrier(xb);
      if ((PROBE_MASK >> 8) & 1) xcd_barrier(xb);
    }
  }
}

extern "C" void kernel_launch(void* const* d_in, const int* in_sizes, int n_in, void* d_out, int out_size, void* d_ws,
                              size_t ws_size, hipStream_t stream) {
  static int grid_blocks = 0;
  if (!grid_blocks) {
    int dev = 0, cus = 0, per_cu = 0;
    (void)hipGetDevice(&dev);
    (void)hipDeviceGetAttribute(&cus, hipDeviceAttributeMultiprocessorCount, dev);
    (void)hipFuncSetAttribute((const void*)fwd_megakernel, hipFuncAttributeMaxDynamicSharedMemorySize, LDSB);
    (void)hipOccupancyMaxActiveBlocksPerMultiprocessor(&per_cu, (const void*)fwd_megakernel, NT, LDSB);
    if (per_cu < 1) per_cu = 1;
    if (per_cu > 1) per_cu = 1;
    grid_blocks = cus * per_cu;
    if (ws_size < WS_END) fprintf(stderr, "kernel_launch: workspace too small: %zu < %zu\n", ws_size, (size_t)WS_END);
  }
  Params p;
  memset(&p, 0, sizeof(p));
  for (int i = 0; i < 36; ++i) p.in[i] = (const float*)d_in[i];
  p.out = (float*)d_out;
  p.ws = (unsigned char*)d_ws;
  (void)hipMemsetAsync((unsigned char*)d_ws + O_BAR, 0, XCD_BAR_WORDS * 4, stream);
#if ONE_LAUNCH
  p.p0 = 0; p.p1 = NPHASES;
  void* args[] = {&p};
  hipError_t e = hipLaunchCooperativeKernel((const void*)fwd_megakernel, dim3(grid_blocks), dim3(NT), args, LDSB, stream);
  if (e != hipSuccess) fprintf(stderr, "cooperative launch failed: %s (grid %d)\n", hipGetErrorString(e), grid_blocks);
#else
  for (int ph = 0; ph < NPHASES; ++ph) {
    p.p0 = ph; p.p1 = ph + 1;
    hipLaunchKernelGGL(fwd_megakernel, dim3(grid_blocks), dim3(NT), LDSB, stream, p);
  }
#endif
}
```

```cpp
#include <hip/hip_runtime.h>
#include <hip/hip_cooperative_groups.h>
#include <cstdio>
#include <cstdint>
#include <cstring>
namespace cg = cooperative_groups;

typedef unsigned short u16;
typedef __attribute__((ext_vector_type(8))) short bf16x8;
typedef __attribute__((ext_vector_type(4))) float f32x4;

#define NT 512
#ifndef ONE_LAUNCH
#define ONE_LAUNCH 1
#endif
#ifndef PROBE_MASK
#define PROBE_MASK 0
#endif
#define REP(cls) for (int rep_##cls = 0; rep_##cls < (((PROBE_MASK >> (cls)) & 1) ? 2 : 1); ++rep_##cls)

constexpr int D = 1024, SLAB = 16384, DFF = 2816;
constexpr int LDSB = 139264;
constexpr int NPHASES = 2 + 5 * (10 + 12 + 10 + 12);

constexpr size_t SZW(size_t n, size_t k) { return n * k * 2; }
constexpr size_t O_WHYIN = 0;
constexpr size_t O_WHYOUT = O_WHYIN + SZW(3072, 1024);
constexpr size_t O_WRETIN = O_WHYOUT + SZW(1024, 1024);
constexpr size_t O_WRETOUT = O_WRETIN + SZW(6144, 1024);
constexpr size_t O_WSWAIN = O_WRETOUT + SZW(1024, 2048);
constexpr size_t O_WSWAOUT = O_WSWAIN + SZW(1536, 1024);
constexpr size_t O_WHGIN = O_WSWAOUT + SZW(1024, 1024);
constexpr size_t O_WHGOUT = O_WHGIN + SZW(5120, 1024);
constexpr size_t O_WFG = O_WHGOUT + SZW(1024, 1024);
constexpr size_t O_WFV = O_WFG + 4 * SZW(2816, 1024);
constexpr size_t O_WFD = O_WFV + 4 * SZW(2816, 1024);
constexpr size_t O_MOD = O_WFD + 4 * SZW(1024, 2816);
constexpr size_t O_TW = O_MOD + (size_t)4 * 16 * 6144 * 4;
constexpr size_t O_HIDS = O_TW + 8192 * 8;
constexpr size_t O_HIDP = O_HIDS + (size_t)8192 * 64 * 4;
constexpr size_t O_ROPER = O_HIDP + (size_t)2048 * 64 * 4;
constexpr size_t O_ROPES = O_ROPER + (size_t)8192 * 128 * 8;
constexpr size_t O_PROJ = O_ROPES + (size_t)8192 * 32 * 8;
constexpr size_t O_HBUF = O_PROJ + (size_t)SLAB * 6144 * 2;
constexpr size_t O_A2 = O_HBUF + (size_t)SLAB * 1024 * 2;
constexpr size_t O_C = O_A2 + (size_t)SLAB * 2048 * 2;
constexpr size_t O_GBUF = O_C;
constexpr size_t O_ACT = O_GBUF + (size_t)SLAB * DFF * 2;
constexpr size_t O_MODP = O_C;
constexpr size_t O_HSPS = O_ACT + (size_t)SLAB * DFF * 2;
constexpr size_t O_HSPP = O_HSPS + (size_t)1024 * 16384 * 8;
constexpr size_t O_UT = O_HSPP + (size_t)1024 * 4096 * 8;
constexpr size_t O_X0C = O_UT + (size_t)SLAB * 1024 * 4;
constexpr size_t END_HY = O_X0C + (size_t)SLAB * 1024 * 2;
constexpr size_t SZP = (size_t)SLAB * 1024 * 2;
constexpr size_t O_QDF = O_C, O_QDB = O_QDF + SZP, O_KIF = O_QDB + SZP, O_KIB = O_KIF + SZP, O_KEF = O_KIB + SZP, O_KEB = O_KEF + SZP;
constexpr size_t O_DLF = O_KEB + SZP;
constexpr size_t O_DLB = O_DLF + (size_t)256 * 1024 * 4;
constexpr size_t O_SC = O_DLB + (size_t)256 * 1024 * 4;
constexpr size_t O_STF = O_SC + (size_t)SLAB * 512 * 2;
constexpr size_t O_STB = O_STF + (size_t)134217728;
constexpr size_t O_OBUF = O_STB + (size_t)134217728;
constexpr size_t END_REC = O_OBUF + (size_t)SLAB * 2048 * 4;
constexpr size_t O_QN = O_C;
constexpr size_t O_KN = O_QN + SZP;
constexpr size_t O_PBUF = O_KN + (size_t)SLAB * 256 * 2;
constexpr size_t END_SWA = O_PBUF + (size_t)SLAB * 16 * 320 * 2;
constexpr size_t WS_END = END_REC > END_HY ? (END_REC > END_SWA ? END_REC : END_SWA) : (END_HY > END_SWA ? END_HY : END_SWA);
constexpr size_t O_BAR = ((size_t)1 << 30) - 16384;
static_assert(WS_END <= O_BAR, "workspace exceeds 1 GiB");

struct Params {
  const float* in[36];
  float* out;
  unsigned char* ws;
  int p0, p1;
};

extern __shared__ __attribute__((aligned(16))) unsigned char smem[];

__device__ __forceinline__ int TID() { int t = threadIdx.x; asm volatile("" : "+v"(t)); return t; }
__device__ __forceinline__ int BID() { int b = blockIdx.x; asm volatile("" : "+s"(b)); return b; }
__device__ __forceinline__ long ZOFF() { long z = 0; asm volatile("" : "+s"(z)); return z; }
__device__ __forceinline__ unsigned char* WS(const Params& P) { return P.ws + ZOFF(); }
__device__ __forceinline__ float* OUTP(const Params& P) { return P.out + ZOFF(); }

namespace pg8 {
#define PG8_LAS __attribute__((address_space(3)))
typedef unsigned short bf16_t;
typedef short bf16x8 __attribute__((ext_vector_type(8)));
typedef float f32x4 __attribute__((ext_vector_type(4)));
typedef unsigned u32x4 __attribute__((ext_vector_type(4)));
constexpr int BM = 256, BK = 64, HALF = 128, HTB = HALF * BK * 2  , STAGE_BYTES = 8 * HTB, NXCD = 8, WGM = 8;

__host__ __device__ __forceinline__ int lds_byte(int r, int c) { const int st = (r >> 4) * 2 + (c >> 5), rr = r & 15, cc = c & 31, ob = rr * 64 + cc * 2; return st * 1024 + (ob ^ (((ob >> 9) & 1) << 5)); }
__host__ __device__ __forceinline__ void stage_rc(int b, int& R, int& C) { const int st = b / 1024, sb = b % 1024, swz = sb ^ (((sb >> 9) & 1) << 5); R = (st >> 1) * 16 + swz / 64; C = (st & 1) * 32 + (swz % 64) / 2; }
__host__ __device__ __forceinline__ int perm32(int rho) { const int n = rho >> 4, i = rho & 15; return 8 * (i >> 2) + 4 * n + (i & 3); }

struct Unit { int pm, pn; };
struct Gemm { const bf16_t* A; const bf16_t* Bt; int M, N, K; };

struct StaticOrder {
    int nM, nN, nwg, G, c;
    __host__ __device__ void init(int M, int N, int G_, int c_) { nM = M / BM; nN = N / BM; nwg = nM * nN; G = G_; c = c_; }
    __host__ __device__ bool next(int i, Unit& u) const {
        const long L = (long)i * G + c; if (L >= nwg) return false;
        int wgid = (int)L; { const int q = nwg / NXCD, r = nwg % NXCD, xcd = wgid % NXCD, off = wgid / NXCD; wgid = (xcd < r ? xcd * (q + 1) : r * (q + 1) + (xcd - r) * q) + off; }
        const int nig = WGM * nN, gid = wgid / nig, fm = gid * WGM, gsz = (nM - fm) < WGM ? (nM - fm) : WGM;
        u.pm = fm + ((wgid % nig) % gsz); u.pn = (wgid % nig) / gsz; return true;
    }
    __device__ __forceinline__ void a_ready(const Unit&) const {}
    __device__ __forceinline__ void done(const Unit&) const {}
};

template <class Epi, class Sched, bool STAMP = false>
__device__ __forceinline__ void gemm_phase(PG8_LAS unsigned char* lds, const Gemm g, const Sched& S, const Epi& E, unsigned long long* stamps) {
    const int tid = TID(), wid = __builtin_amdgcn_readfirstlane(tid >> 6), lane = tid & 63, wr = wid >> 2, wc = wid & 3, fr = lane & 15, fq = lane >> 4;
    const int K = g.K, nt = K / BK;
    int ts_lo = 0, ts_hi = 0, nts = 0; const unsigned long long rt_entry = STAMP ? (unsigned long long)wall_clock64() : 0ull;
#define PG8_STAMP() do { if (STAMP && wid == 0 && nts < 64) { const unsigned long long _c = (unsigned long long)clock64(); \
        ts_lo = (lane == nts) ? (int)(unsigned)_c : ts_lo; ts_hi = (lane == nts) ? (int)(unsigned)(_c >> 32) : ts_hi; ++nts; } } while (0)
    PG8_STAMP();
    unsigned voffA[2], voffB[2];
#pragma unroll
    for (int i = 0; i < 2; ++i) { int R, C; stage_rc(tid * 16 + i * 8192, R, C); const int Rb = Epi::PERM ? ((R & ~31) + perm32(R & 31)) : R;
        voffA[i] = (unsigned)(R * K + C) * 2u; voffB[i] = (unsigned)(Rb * K + C) * 2u; }
    const size_t kstep = (size_t)(BK * 2);
    const size_t hstep = (size_t)HALF * K * 2;
    const size_t tstep = 2 * hstep;
    const unsigned ldsw = (unsigned)wid * 1024u;
    const int aoff = lds_byte(wr * 64 + fr, fq * 8), boff = lds_byte(wc * 32 + fr, fq * 8);
#define PG8_SA(b, h) (((b) * 2 + (h)) * HTB)
#define PG8_SB(b, h) ((4 + (b) * 2 + (h)) * HTB)
#define PG8_STAGE(bufoff, gbase, voff) do { _Pragma("unroll") for (int _i = 0; _i < 2; ++_i) \
        __builtin_amdgcn_global_load_lds((const unsigned*)((const char*)(gbase) + (voff)[_i]), (PG8_LAS unsigned*)(lds + (bufoff) + ldsw + _i * 8192), 16, 0, 0); } while (0)
#define PG8_LDA(dst, b, h) do { _Pragma("unroll") for (int m = 0; m < 4; ++m) _Pragma("unroll") for (int k = 0; k < 2; ++k) dst[m][k] = *(const PG8_LAS bf16x8*)(lds + PG8_SA(b, h) + aoff + m * 2048 + k * 1024); } while (0)
#define PG8_LDB(dst, b, h) do { _Pragma("unroll") for (int n = 0; n < 2; ++n) _Pragma("unroll") for (int k = 0; k < 2; ++k) dst[n][k] = *(const PG8_LAS bf16x8*)(lds + PG8_SB(b, h) + boff + n * 2048 + k * 1024); } while (0)
#define PG8_MMA(ai, bj, At, Bt) do { __builtin_amdgcn_s_setprio(1); _Pragma("unroll") for (int m = 0; m < 4; ++m) _Pragma("unroll") for (int n = 0; n < 2; ++n) _Pragma("unroll") for (int k = 0; k < 2; ++k) \
        acc[ai][bj][m][n] = __builtin_amdgcn_mfma_f32_16x16x32_bf16(Bt[n][k], At[m][k], acc[ai][bj][m][n], 0, 0, 0); __builtin_amdgcn_s_setprio(0); } while (0)
#define PG8_WAIT_V(n) asm volatile("s_waitcnt vmcnt(" #n ")" ::: "memory")
#define PG8_WAIT_L(n) asm volatile("s_waitcnt lgkmcnt(" #n ")" ::: "memory")
#define PG8_BAR __builtin_amdgcn_s_barrier()
#define PG8_SCHED __builtin_amdgcn_sched_barrier(0)
    Unit cur, nxt; int ui = 0;
    if (!S.next(0, cur)) return;
    f32x4 acc[2][2][4][2];
#pragma unroll
    for (int a = 0; a < 2; ++a)
#pragma unroll
        for (int b = 0; b < 2; ++b)
#pragma unroll
            for (int m = 0; m < 4; ++m)
#pragma unroll
                for (int n = 0; n < 2; ++n) acc[a][b][m][n] = (f32x4){0.f, 0.f, 0.f, 0.f};
    bf16x8 At[4][2], B0[2][2], B1[2][2];
    const char* cA = (const char*)g.A + (size_t)cur.pm * tstep; const char* cB = (const char*)g.Bt + (size_t)cur.pn * tstep;
    S.a_ready(cur);
    PG8_STAGE(PG8_SB(0, 0), cB, voffB); PG8_STAGE(PG8_SA(0, 0), cA, voffA); PG8_STAGE(PG8_SB(0, 1), cB + hstep, voffB); PG8_STAGE(PG8_SA(0, 1), cA + hstep, voffA);
    if (wr == 1) PG8_BAR;
    PG8_WAIT_V(4); PG8_BAR;
    PG8_STAGE(PG8_SB(1, 0), cB + kstep, voffB); PG8_STAGE(PG8_SA(1, 0), cA + kstep, voffA); PG8_STAGE(PG8_SB(1, 1), cB + hstep + kstep, voffB);
    PG8_WAIT_V(6); PG8_BAR;
    PG8_STAMP();
    for (;;) {
        const bool has_next = S.next(ui + 1, nxt);
        const char* nA = has_next ? (const char*)g.A + (size_t)nxt.pm * tstep : cA; const char* nB = has_next ? (const char*)g.Bt + (size_t)nxt.pn * tstep : cB;
        for (int t = 0; t < nt; t += 2) {
            const bool last = (t == nt - 2);
            const char* a1 = cA + (size_t)(t + 1) * kstep;
            const char* a2 = last ? nA : cA + (size_t)(t + 2) * kstep; const char* b2 = last ? nB : cB + (size_t)(t + 2) * kstep;
            const char* a3 = a2 + kstep; const char* b3 = b2 + kstep;
            if (last && has_next) S.a_ready(nxt);
            PG8_LDB(B0, 0, 0); PG8_SCHED; PG8_LDA(At, 0, 0); PG8_STAGE(PG8_SA(1, 1), a1 + hstep, voffA);
            PG8_WAIT_L(8); PG8_BAR; PG8_WAIT_L(0); PG8_MMA(0, 0, At, B0); PG8_BAR; PG8_SCHED;
            PG8_LDB(B1, 0, 1); PG8_STAGE(PG8_SB(0, 0), b2, voffB);
            PG8_BAR; PG8_WAIT_L(0); PG8_MMA(0, 1, At, B1); PG8_BAR;
            PG8_LDA(At, 0, 1); PG8_STAGE(PG8_SA(0, 0), a2, voffA);
            PG8_BAR; PG8_WAIT_L(0); PG8_MMA(1, 0, At, B0); PG8_BAR; PG8_SCHED;
            PG8_STAGE(PG8_SB(0, 1), b2 + hstep, voffB);
            PG8_WAIT_V(6); PG8_BAR; PG8_MMA(1, 1, At, B1); PG8_BAR;
            PG8_LDB(B0, 1, 0); PG8_SCHED; PG8_LDA(At, 1, 0); PG8_STAGE(PG8_SA(0, 1), a2 + hstep, voffA);
            PG8_WAIT_L(8); PG8_BAR; PG8_WAIT_L(0); PG8_MMA(0, 0, At, B0); PG8_BAR; PG8_SCHED;
            PG8_LDB(B1, 1, 1); PG8_STAGE(PG8_SB(1, 0), b3, voffB);
            PG8_BAR; PG8_WAIT_L(0); PG8_MMA(0, 1, At, B1); PG8_BAR;
            PG8_LDA(At, 1, 1); PG8_STAGE(PG8_SA(1, 0), a3, voffA);
            PG8_BAR; PG8_WAIT_L(0); PG8_MMA(1, 0, At, B0); PG8_BAR; PG8_SCHED;
            PG8_STAGE(PG8_SB(1, 1), b3 + hstep, voffB);
            PG8_WAIT_V(6); PG8_BAR; PG8_MMA(1, 1, At, B1); PG8_BAR;
        }
        PG8_STAMP();
        if constexpr (!Epi::AFTER_DRAIN) { E(acc, cur, wr, wc, fr, fq); S.done(cur); }
        PG8_STAMP();
        if (!has_next) break;
#pragma unroll
        for (int a = 0; a < 2; ++a)
#pragma unroll
            for (int b = 0; b < 2; ++b)
#pragma unroll
                for (int m = 0; m < 4; ++m)
#pragma unroll
                    for (int n = 0; n < 2; ++n) acc[a][b][m][n] = (f32x4){0.f, 0.f, 0.f, 0.f};
        cur = nxt; cA = nA; cB = nB; ++ui;
    }
    PG8_WAIT_V(0);
    if (wr == 0) PG8_BAR;
    PG8_BAR;
    if constexpr (Epi::AFTER_DRAIN) { E.fused(acc, cur, wr, wc, fr, fq, lds, wid, lane); S.done(cur); }
    PG8_STAMP();
    if (STAMP && wid == 0) { stamps[lane] = lane < nts ? (((unsigned long long)(unsigned)ts_hi << 32) | (unsigned)ts_lo) : 0ull;
        if (lane == 62) stamps[62] = rt_entry; if (lane == 63) stamps[63] = (unsigned long long)wall_clock64(); }
#undef PG8_STAMP
#undef PG8_SA
#undef PG8_SB
#undef PG8_STAGE
#undef PG8_LDA
#undef PG8_LDB
#undef PG8_MMA
#undef PG8_WAIT_V
#undef PG8_WAIT_L
#undef PG8_BAR
#undef PG8_SCHED
}
}


__device__ __forceinline__ u16 f2bf(float f) {
  unsigned u = __float_as_uint(f);
  u += 0x7fffu + ((u >> 16) & 1u);
  return (u16)(u >> 16);
}
__device__ __forceinline__ float bf2f(u16 h) { return __uint_as_float(((unsigned)h) << 16); }
__device__ __forceinline__ unsigned pack2(float a, float b) { return (unsigned)f2bf(a) | ((unsigned)f2bf(b) << 16); }
__device__ __forceinline__ float silu_f(float x) { return x / (1.f + __expf(-x)); }
__device__ __forceinline__ float sigm(float x) { return 1.f / (1.f + __expf(-x)); }
__device__ __forceinline__ float wave_sum(float v) {
#pragma unroll
  for (int o = 32; o; o >>= 1) v += __shfl_xor(v, o);
  return v;
}
__device__ __forceinline__ const float* xin_of(const Params& P, int slab) { return slab == 0 ? P.in[0] : P.in[1] + (long)(slab - 1) * SLAB * D; }
__device__ __forceinline__ int Lof(int slab) { return slab == 0 ? 2048 : 8192; }
__device__ __forceinline__ int gb_of(int slab, int r) { return slab == 0 ? (r >> 11) : (8 + (slab - 1) * 2 + (r >> 13)); }

typedef short v4s __attribute__((ext_vector_type(4)));
#define LBAR() asm volatile("s_waitcnt lgkmcnt(0)\n\ts_barrier" ::: "memory")
#define LDS_AS __attribute__((address_space(3)))
template <int R, bool KC>
__device__ __forceinline__ uint4 ld_chunk(const u16* __restrict__ base, long ld, int k0, int c) {
  if (KC) {
    const int r = c >> 3, kc = c & 7;
    return *(const uint4*)(base + (long)r * ld + k0 + kc * 8);
  } else {
    const int k = c / (R / 8), mc = c % (R / 8);
    return *(const uint4*)(base + (long)(k0 + k) * ld + mc * 8);
  }
}
template <int R, bool KC>
__device__ __forceinline__ void st_chunk(u16* s, uint4 v, int c) {
  if (KC) {
    const int r = c >> 3, kc = c & 7;
    *(uint4*)(s + r * 72 + kc * 8) = v;
  } else {
    const int k = c / (R / 8), mc = c % (R / 8);
    *(uint4*)(s + k * (R + 8) + mc * 8) = v;
  }
}
template <int R, bool KC>
__device__ __forceinline__ bf16x8 ld_frag(const u16* s, int x0, int ks, int fr, int fq) {
  if (KC) {
    return *(const bf16x8*)(s + (x0 + fr) * 72 + ks * 32 + fq * 8);
  } else {
    const int q4 = fr >> 2, p4 = fr & 3;
    const u16* p = s + (ks * 32 + 8 * fq + q4) * (R + 8) + x0 + 4 * p4;
    v4s lo = __builtin_amdgcn_ds_read_tr16_b64_v4i16((LDS_AS v4s*)p);
    v4s hi = __builtin_amdgcn_ds_read_tr16_b64_v4i16((LDS_AS v4s*)(p + 4 * (R + 8)));
    bf16x8 r;
    r[0] = lo[0]; r[1] = lo[1]; r[2] = lo[2]; r[3] = lo[3]; r[4] = hi[0]; r[5] = hi[1]; r[6] = hi[2]; r[7] = hi[3];
    return r;
  }
}

template <int TM, int TN, bool AKC, bool BKC, bool TR, int KT>
__device__ __forceinline__ void gemm_acc(f32x4 (&acc)[TM / 32][TN / 64], const u16* __restrict__ A, long lda,
                                         const u16* __restrict__ B, long ldb, u16* sm) {
  u16* As = sm;
  u16* Bs = sm + 9216;
  const int tid = TID(), lane = tid & 63, wid = tid >> 6;
  const int wm = wid >> 2, wn = wid & 3, fr = lane & 15, fq = lane >> 4;
  constexpr int MI = TM / 32, NI = TN / 64;
  uint4 ra0[KT], ra1[KT], rb0[KT], rb1[KT];
#pragma unroll
  for (int kt = 0; kt < KT; ++kt) {
    ra0[kt] = ld_chunk<TM, AKC>(A, lda, kt * 64, tid);
    ra1[kt] = ra0[kt];
    if (TM == 128) ra1[kt] = ld_chunk<TM, AKC>(A, lda, kt * 64, tid + NT);
    rb0[kt] = ld_chunk<TN, BKC>(B, ldb, kt * 64, tid);
    rb1[kt] = rb0[kt];
    if (TN == 128) rb1[kt] = ld_chunk<TN, BKC>(B, ldb, kt * 64, tid + NT);
  }
#pragma unroll
  for (int kt = 0; kt < KT; ++kt) {
    __syncthreads();
    st_chunk<TM, AKC>(As, ra0[kt], tid);
    if (TM == 128) st_chunk<TM, AKC>(As, ra1[kt], tid + NT);
    st_chunk<TN, BKC>(Bs, rb0[kt], tid);
    if (TN == 128) st_chunk<TN, BKC>(Bs, rb1[kt], tid + NT);
    __syncthreads();
#pragma unroll
    for (int ks = 0; ks < 2; ++ks) {
      bf16x8 af[MI], bfr[NI];
#pragma unroll
      for (int mi = 0; mi < MI; ++mi) af[mi] = ld_frag<TM, AKC>(As, wm * (TM / 2) + mi * 16, ks, fr, fq);
#pragma unroll
      for (int ni = 0; ni < NI; ++ni) bfr[ni] = ld_frag<TN, BKC>(Bs, wn * (TN / 4) + ni * 16, ks, fr, fq);
#pragma unroll
      for (int mi = 0; mi < MI; ++mi)
#pragma unroll
        for (int ni = 0; ni < NI; ++ni)
          acc[mi][ni] = TR ? __builtin_amdgcn_mfma_f32_16x16x32_bf16(bfr[ni], af[mi], acc[mi][ni], 0, 0, 0)
                           : __builtin_amdgcn_mfma_f32_16x16x32_bf16(af[mi], bfr[ni], acc[mi][ni], 0, 0, 0);
    }
  }
  __syncthreads();
}

template <int KT> struct Tiles { uint4 a0[KT], a1[KT], b0[KT], b1[KT]; };
template <int TM, int TN, bool AKC, bool BKC, int KT>
__device__ __forceinline__ void tiles_issue(Tiles<KT>& t, const u16* __restrict__ A, long lda, const u16* __restrict__ B, long ldb) {
  const int tid = TID();
#pragma unroll
  for (int kt = 0; kt < KT; ++kt) {
    t.a0[kt] = ld_chunk<TM, AKC>(A, lda, kt * 64, tid);
    t.a1[kt] = t.a0[kt];
    if (TM == 128) t.a1[kt] = ld_chunk<TM, AKC>(A, lda, kt * 64, tid + NT);
    t.b0[kt] = ld_chunk<TN, BKC>(B, ldb, kt * 64, tid);
    t.b1[kt] = t.b0[kt];
    if (TN == 128) t.b1[kt] = ld_chunk<TN, BKC>(B, ldb, kt * 64, tid + NT);
  }
}
template <int TM, int TN, bool AKC, bool BKC, bool TR, int KT>
__device__ __forceinline__ void gemm_run(f32x4 (&acc)[TM / 32][TN / 64], const Tiles<KT>& t, u16* sm) {
  u16* As = sm;
  u16* Bs = sm + 9216;
  const int tid = TID(), lane = tid & 63, wid = tid >> 6;
  const int wm = wid >> 2, wn = wid & 3, fr = lane & 15, fq = lane >> 4;
  constexpr int MI = TM / 32, NI = TN / 64;
#pragma unroll
  for (int kt = 0; kt < KT; ++kt) {
    __syncthreads();
    st_chunk<TM, AKC>(As, t.a0[kt], tid);
    if (TM == 128) st_chunk<TM, AKC>(As, t.a1[kt], tid + NT);
    st_chunk<TN, BKC>(Bs, t.b0[kt], tid);
    if (TN == 128) st_chunk<TN, BKC>(Bs, t.b1[kt], tid + NT);
    __syncthreads();
#pragma unroll
    for (int ks = 0; ks < 2; ++ks) {
      bf16x8 af[MI], bfr[NI];
#pragma unroll
      for (int mi = 0; mi < MI; ++mi) af[mi] = ld_frag<TM, AKC>(As, wm * (TM / 2) + mi * 16, ks, fr, fq);
#pragma unroll
      for (int ni = 0; ni < NI; ++ni) bfr[ni] = ld_frag<TN, BKC>(Bs, wn * (TN / 4) + ni * 16, ks, fr, fq);
#pragma unroll
      for (int mi = 0; mi < MI; ++mi)
#pragma unroll
        for (int ni = 0; ni < NI; ++ni)
          acc[mi][ni] = TR ? __builtin_amdgcn_mfma_f32_16x16x32_bf16(bfr[ni], af[mi], acc[mi][ni], 0, 0, 0)
                           : __builtin_amdgcn_mfma_f32_16x16x32_bf16(af[mi], bfr[ni], acc[mi][ni], 0, 0, 0);
    }
  }
}

template <int TM, int TN, bool TR, class F>
__device__ __forceinline__ void epi_each(f32x4 (&acc)[TM / 32][TN / 64], F f) {
  const int tid = TID(), lane = tid & 63, wid = tid >> 6;
  const int wm = wid >> 2, wn = wid & 3, fr = lane & 15, fq = lane >> 4;
#pragma unroll
  for (int mi = 0; mi < TM / 32; ++mi)
#pragma unroll
    for (int ni = 0; ni < TN / 64; ++ni) {
      const int r0 = wm * (TM / 2) + mi * 16, c0 = wn * (TN / 4) + ni * 16;
      if (TR) f(r0 + fr, c0 + fq * 4, acc[mi][ni]);
      else f(r0 + fq * 4, c0 + fr, acc[mi][ni]);
    }
}

struct EpiStoreBf16 {
  static constexpr bool PERM = false, AFTER_DRAIN = false;
  u16* O; int ldc;
  __device__ __forceinline__ void operator()(const f32x4 (&acc)[2][2][4][2], const pg8::Unit& u, int wr, int wc, int fr, int fq) const {
    const int row0 = u.pm * 256 + wr * 64 + fr, col0 = u.pn * 256 + wc * 32 + 4 * fq;
#pragma unroll
    for (int ai = 0; ai < 2; ++ai)
#pragma unroll
      for (int m = 0; m < 4; ++m) {
        u16* rowp = O + (size_t)(row0 + ai * 128 + m * 16) * ldc + col0;
#pragma unroll
        for (int bj = 0; bj < 2; ++bj)
#pragma unroll
          for (int n = 0; n < 2; ++n) {
            const f32x4 v = acc[ai][bj][m][n];
            *(uint2*)(rowp + bj * 128 + n * 16) = make_uint2(pack2(v[0], v[1]), pack2(v[2], v[3]));
          }
      }
  }
};
struct EpiResid {
  static constexpr bool PERM = false, AFTER_DRAIN = false;
  float* X; const float* XS; const float* mod; int goff; int slab;
  __device__ __forceinline__ void operator()(const f32x4 (&acc)[2][2][4][2], const pg8::Unit& u, int wr, int wc, int fr, int fq) const {
    const int row0 = u.pm * 256 + wr * 64 + fr, col0 = u.pn * 256 + wc * 32 + 4 * fq;
    const float* g = mod + (size_t)gb_of(slab, u.pm * 256) * 6144 + goff + col0;
    f32x4 gv[2][2];
#pragma unroll
    for (int bj = 0; bj < 2; ++bj)
#pragma unroll
      for (int n = 0; n < 2; ++n) gv[bj][n] = *(const f32x4*)(g + bj * 128 + n * 16);
#pragma unroll
    for (int am = 0; am < 4; ++am) {
      f32x4 xv[2][2][2];
#pragma unroll
      for (int mm = 0; mm < 2; ++mm)
#pragma unroll
        for (int bj = 0; bj < 2; ++bj)
#pragma unroll
          for (int n = 0; n < 2; ++n) xv[mm][bj][n] = *(const f32x4*)(XS + (size_t)(row0 + (am >> 1) * 128 + ((am & 1) * 2 + mm) * 16) * D + col0 + bj * 128 + n * 16);
#pragma unroll
      for (int mm = 0; mm < 2; ++mm)
#pragma unroll
        for (int bj = 0; bj < 2; ++bj)
#pragma unroll
          for (int n = 0; n < 2; ++n)
            *(f32x4*)(X + (size_t)(row0 + (am >> 1) * 128 + ((am & 1) * 2 + mm) * 16) * D + col0 + bj * 128 + n * 16) = xv[mm][bj][n] + gv[bj][n] * acc[am >> 1][bj][(am & 1) * 2 + mm][n];
    }
  }
};
struct EpiFfnVal {
  static constexpr bool PERM = false, AFTER_DRAIN = false;
  const u16* G; u16* ACT; const float* cw; const float* cb; int L;
  __device__ __forceinline__ void operator()(const f32x4 (&acc)[2][2][4][2], const pg8::Unit& u, int wr, int wc, int fr, int fq) const {
    const int row0 = u.pm * 256 + wr * 64 + fr, col0 = u.pn * 256 + wc * 32 + 4 * fq;
#pragma unroll
    for (int bj = 0; bj < 2; ++bj)
#pragma unroll
      for (int n = 0; n < 2; ++n) {
        const int c = col0 + bj * 128 + n * 16;
        const f32x4 w0 = *(const f32x4*)(cw + c), w1 = *(const f32x4*)(cw + DFF + c), w2 = *(const f32x4*)(cw + 2 * DFF + c), bb = *(const f32x4*)(cb + c);
#pragma unroll
        for (int ai = 0; ai < 2; ++ai) {
          uint2 g0[4], g1[4], g2[4];
#pragma unroll
          for (int m = 0; m < 4; ++m) {
            const int r = row0 + ai * 128 + m * 16;
            const int pos = r & (L - 1);
            const u16* gp = G + (size_t)r * DFF + c;
            g1[m] = *(const uint2*)gp;
            g0[m] = *(const uint2*)(gp - (pos > 0 ? DFF : 0));
            g2[m] = *(const uint2*)(gp + (pos < L - 1 ? DFF : 0));
          }
#pragma unroll
          for (int m = 0; m < 4; ++m) {
            const int r = row0 + ai * 128 + m * 16;
            const int pos = r & (L - 1);
            const float m0 = pos > 0 ? 1.f : 0.f, m2 = pos < L - 1 ? 1.f : 0.f;
            const uint2 a0 = g0[m], a1 = g1[m], a2 = g2[m];
            f32x4 a;
            a[0] = m0 * bf2f((u16)(a0.x & 0xffff)) * w0[0] + bf2f((u16)(a1.x & 0xffff)) * w1[0] + m2 * bf2f((u16)(a2.x & 0xffff)) * w2[0] + bb[0];
            a[1] = m0 * bf2f((u16)(a0.x >> 16)) * w0[1] + bf2f((u16)(a1.x >> 16)) * w1[1] + m2 * bf2f((u16)(a2.x >> 16)) * w2[1] + bb[1];
            a[2] = m0 * bf2f((u16)(a0.y & 0xffff)) * w0[2] + bf2f((u16)(a1.y & 0xffff)) * w1[2] + m2 * bf2f((u16)(a2.y & 0xffff)) * w2[2] + bb[2];
            a[3] = m0 * bf2f((u16)(a0.y >> 16)) * w0[3] + bf2f((u16)(a1.y >> 16)) * w1[3] + m2 * bf2f((u16)(a2.y >> 16)) * w2[3] + bb[3];
            const f32x4 v = acc[ai][bj][m][n];
            *(uint2*)(ACT + (size_t)r * DFF + c) = make_uint2(pack2(silu_f(a[0]) * v[0], silu_f(a[1]) * v[1]), pack2(silu_f(a[2]) * v[2], silu_f(a[3]) * v[3]));
          }
        }
      }
  }
};
template <class Epi>
__device__ __forceinline__ void run_gemm(const u16* A, const u16* Bt, int N, int K, const Epi& E) {
  pg8::Gemm g; g.A = A; g.Bt = Bt; g.M = SLAB; g.N = N; g.K = K;
  pg8::StaticOrder S; S.init(SLAB, N, gridDim.x, BID());
  __syncthreads();
  pg8::gemm_phase<Epi, pg8::StaticOrder, false>((PG8_LAS unsigned char*)smem, g, S, E, nullptr);
  __syncthreads();
}

__device__ __forceinline__ int fidx(int p) { return p + ((p >> 6) << 2); }
__device__ __forceinline__ float2 cmulf(float2 a, float2 b) { return make_float2(a.x * b.x - a.y * b.y, a.x * b.y + a.y * b.x); }
__device__ __forceinline__ float2 cmulcf(float2 a, float2 b) { return make_float2(a.x * b.x + a.y * b.y, a.y * b.x - a.x * b.y); }
#define R16C(q) ((q) == 0 ? 1.f : (q) == 1 ? 0.9238795325f : (q) == 2 ? 0.7071067812f : (q) == 3 ? 0.3826834324f : (q) == 4 ? 0.f : (q) == 5 ? -0.3826834324f : (q) == 6 ? -0.7071067812f : -0.9238795325f)
#define R16S(q) ((q) == 0 ? 0.f : (q) == 1 ? -0.3826834324f : (q) == 2 ? -0.7071067812f : (q) == 3 ? -0.9238795325f : (q) == 4 ? -1.f : (q) == 5 ? -0.9238795325f : (q) == 6 ? -0.7071067812f : -0.3826834324f)
template <int N, int RS, bool INV>
__device__ __forceinline__ void fft_pass(float2* x, const float2* __restrict__ tw, const int S, const int tid) {
  constexpr int R = 1 << RS;
  const int E = S >> (RS - 1);
#pragma unroll 1
  for (int g = tid; g < N / R; g += NT) {
    const int blo = g & (E - 1);
    const int base = ((g - blo) << RS) + blo;
    float2 e[R];
#pragma unroll
    for (int k = 0; k < R; ++k) e[k] = x[fidx(base + k * E)];
    float2 wb[RS];
#pragma unroll
    for (int st = 0; st < RS; ++st) wb[st] = tw[blo * (8192 / (S >> st))];
#pragma unroll
    for (int sq = 0; sq < RS; ++sq) {
      const int st = INV ? (RS - 1 - sq) : sq;
      const int h = (R / 2) >> st;
#pragma unroll
      for (int k = 0; k < R; ++k) {
        if ((k & h) == 0) {
          const int m = k & (h - 1);
          const int q = m * (8 / h);
          float2 w = wb[st];
          if (q != 0) w = cmulf(w, make_float2(R16C(q), R16S(q)));
          if (!INV) {
            const float2 a = e[k], b = e[k + h];
            e[k] = make_float2(a.x + b.x, a.y + b.y);
            e[k + h] = cmulf(make_float2(a.x - b.x, a.y - b.y), w);
          } else {
            const float2 a = e[k], b = cmulcf(e[k + h], w);
            e[k] = make_float2(a.x + b.x, a.y + b.y);
            e[k + h] = make_float2(a.x - b.x, a.y - b.y);
          }
        }
      }
    }
#pragma unroll
    for (int k = 0; k < R; ++k) x[fidx(base + k * E)] = e[k];
  }
  __syncthreads();
}
template <int N>
__device__ __forceinline__ void fft_dif_t(float2* x, const float2* __restrict__ tw) {
  const int tid = TID();
  if (N == 16384) {
    fft_pass<N, 4, false>(x, tw, 8192, tid); fft_pass<N, 4, false>(x, tw, 512, tid);
    fft_pass<N, 4, false>(x, tw, 32, tid); fft_pass<N, 2, false>(x, tw, 2, tid);
  } else {
    fft_pass<N, 4, false>(x, tw, 2048, tid); fft_pass<N, 4, false>(x, tw, 128, tid); fft_pass<N, 4, false>(x, tw, 8, tid);
  }
}
template <int N>
__device__ __forceinline__ void ifft_dit_t(float2* x, const float2* __restrict__ tw) {
  const int tid = TID();
  if (N == 16384) {
    fft_pass<N, 2, true>(x, tw, 2, tid); fft_pass<N, 4, true>(x, tw, 32, tid);
    fft_pass<N, 4, true>(x, tw, 512, tid); fft_pass<N, 4, true>(x, tw, 8192, tid);
  } else {
    fft_pass<N, 4, true>(x, tw, 8, tid); fft_pass<N, 4, true>(x, tw, 128, tid); fft_pass<N, 4, true>(x, tw, 2048, tid);
  }
}
__device__ __forceinline__ void fft_dif(float2* x, int N, const float2* __restrict__ tw) {
  if (N == 16384) fft_dif_t<16384>(x, tw); else fft_dif_t<4096>(x, tw);
}
__device__ __forceinline__ void ifft_dit(float2* x, int N, const float2* __restrict__ tw) {
  if (N == 16384) ifft_dit_t<16384>(x, tw); else ifft_dit_t<4096>(x, tw);
}

__device__ __forceinline__ void unpack8(const uint4 v, float (&f)[8]) {
  f[0] = bf2f((u16)(v.x & 0xffff)); f[1] = bf2f((u16)(v.x >> 16)); f[2] = bf2f((u16)(v.y & 0xffff)); f[3] = bf2f((u16)(v.y >> 16));
  f[4] = bf2f((u16)(v.z & 0xffff)); f[5] = bf2f((u16)(v.z >> 16)); f[6] = bf2f((u16)(v.w & 0xffff)); f[7] = bf2f((u16)(v.w >> 16));
}
__device__ __forceinline__ uint4 pack8s(const float (&f)[8], float sc) {
  return make_uint4(pack2(f[0] * sc, f[1] * sc), pack2(f[2] * sc, f[3] * sc), pack2(f[4] * sc, f[5] * sc), pack2(f[6] * sc, f[7] * sc));
}
__device__ void transpose_w(const float* __restrict__ W, u16* __restrict__ Wt, int K, int N) {
  float* smf = (float*)smem;
  const int tk = K / 64, tn = N / 64, tid = TID();
  for (int item = BID(); item < tk * tn; item += gridDim.x) {
    const int k0 = (item / tn) * 64, n0 = (item % tn) * 64;
    float4 v[2];
#pragma unroll
    for (int j = 0; j < 2; ++j) {
      const int idx = tid + j * NT, kk = idx >> 4, n4 = idx & 15;
      v[j] = *(const float4*)(W + (long)(k0 + kk) * N + n0 + n4 * 4);
    }
    __syncthreads();
#pragma unroll
    for (int j = 0; j < 2; ++j) {
      const int idx = tid + j * NT, kk = idx >> 4, n4 = idx & 15;
      float* p = smf + kk * 65 + n4 * 4;
      p[0] = v[j].x; p[1] = v[j].y; p[2] = v[j].z; p[3] = v[j].w;
    }
    __syncthreads();
    const int nn = tid >> 3, k8 = tid & 7;
    float f[8];
#pragma unroll
    for (int i = 0; i < 8; ++i) f[i] = smf[(k8 * 8 + i) * 65 + nn];
    *(uint4*)(Wt + (long)(n0 + nn) * K + k0 + k8 * 8) = pack8s(f, 1.f);
  }
  __syncthreads();
}

__device__ void phase_pre0(const Params& P) {
  const int tid = TID();
  const long gtid = (long)BID() * NT + tid, gsz = (long)gridDim.x * NT;
  transpose_w(P.in[7], (u16*)(WS(P) + O_WHYIN), 1024, 3072);
  transpose_w(P.in[18], (u16*)(WS(P) + O_WHYOUT), 1024, 1024);
  transpose_w(P.in[19], (u16*)(WS(P) + O_WRETIN), 1024, 6144);
  transpose_w(P.in[21], (u16*)(WS(P) + O_WRETOUT), 2048, 1024);
  transpose_w(P.in[22], (u16*)(WS(P) + O_WSWAIN), 1024, 1536);
  transpose_w(P.in[26], (u16*)(WS(P) + O_WSWAOUT), 1024, 1024);
  transpose_w(P.in[27], (u16*)(WS(P) + O_WHGIN), 1024, 5120);
  transpose_w(P.in[30], (u16*)(WS(P) + O_WHGOUT), 1024, 1024);
  for (int l = 0; l < 4; ++l) {
    transpose_w(P.in[31] + (long)l * 1024 * DFF, (u16*)(WS(P) + O_WFG) + (long)l * DFF * 1024, 1024, DFF);
    transpose_w(P.in[32] + (long)l * 1024 * DFF, (u16*)(WS(P) + O_WFV) + (long)l * DFF * 1024, 1024, DFF);
    transpose_w(P.in[35] + (long)l * DFF * 1024, (u16*)(WS(P) + O_WFD) + (long)l * 1024 * DFF, DFF, 1024);
  }
  {
    float* cs = (float*)smem;
    float* modp = (float*)(WS(P) + O_MODP);
    for (int item = BID(); item < 4 * 8 * 12; item += gridDim.x) {
      const int nb = item % 12, ks = (item / 12) % 8, l = item / 96;
      __syncthreads();
      for (int i = tid; i < 2048; i += NT) {
        int b = i >> 7, k = i & 127;
        float c = (b < 8) ? P.in[2][b * 1024 + ks * 128 + k] : P.in[3][(b - 8) * 1024 + ks * 128 + k];
        cs[i] = c / (1.f + expf(-c));
      }
      __syncthreads();
      const int n = nb * 512 + tid;
      float a[16];
#pragma unroll
      for (int b = 0; b < 16; ++b) a[b] = 0.f;
      const float* w = P.in[4] + ((long)l * 1024 + ks * 128) * 6144 + n;
      for (int k = 0; k < 128; ++k) {
        float wv = w[(long)k * 6144];
#pragma unroll
        for (int b = 0; b < 16; ++b) a[b] += cs[b * 128 + k] * wv;
      }
#pragma unroll
      for (int b = 0; b < 16; ++b) modp[(((long)ks * 4 + l) * 16 + b) * 6144 + n] = a[b];
    }
    __syncthreads();
  }
  {
    float2* tw = (float2*)(WS(P) + O_TW);
    for (long i = gtid; i < 8192; i += gsz) {
      float s, c;
      sincospif((float)i * (1.f / 8192.f), &s, &c);
      tw[i] = make_float2(c, -s);
    }
    float2* rr = (float2*)(WS(P) + O_ROPER);
    for (long i = gtid; i < (long)8192 * 128; i += gsz) {
      int pos = (int)(i >> 7), d = (int)(i & 127);
      float inv = exp2f(-(float)d * (13.287712379549449f / 128.f));
      float s, c;
      sincosf((float)pos * inv, &s, &c);
      rr[i] = make_float2(c, s);
    }
    float2* rs = (float2*)(WS(P) + O_ROPES);
    for (long i = gtid; i < (long)8192 * 32; i += gsz) {
      int pos = (int)(i >> 5), d = (int)(i & 31);
      float inv = exp2f(-(float)d * (13.287712379549449f / 32.f));
      float s, c;
      sincosf((float)pos * inv, &s, &c);
      rs[i] = make_float2(c, s);
    }
  }
  {
    float* zf = (float*)smem;
    float* h1 = zf + 8 * 36;
    const float* w1 = P.in[10]; const float* b1 = P.in[11]; const float* w2 = P.in[12]; const float* b2 = P.in[13];
    const float* fr = P.in[15];
    const int tl = tid >> 6, j = tid & 63;
    for (int item = BID(); item < 1280; item += gridDim.x) {
      const int sel = item >= 1024;
      const int L = sel ? 2048 : 8192;
      const int t = (sel ? item - 1024 : item) * 8 + tl;
      float* hid = (float*)(WS(P) + (sel ? O_HIDP : O_HIDS));
      __syncthreads();
      if (j < 33) {
        float v;
        if (j == 0) v = (float)t / (float)(L - 1);
        else {
          int i = (j - 1) & 15;
          float band = 1e-4f + (float)i * ((15.f - 1e-4f) / 15.f);
          float ang = (6.283185307179586f / (float)L) * (float)t;
          float a = band * ang;
          v = (j <= 16) ? cosf(a) : -sinf(a);
        }
        zf[tl * 36 + j] = v;
      }
      __syncthreads();
      float s = b1[j];
#pragma unroll 3
      for (int i = 0; i < 33; ++i) s += zf[tl * 36 + i] * w1[i * 64 + j];
      h1[tl * 64 + j] = sinf(fr[j] * s);
      __syncthreads();
      float s2 = b2[j];
#pragma unroll 4
      for (int i = 0; i < 64; ++i) s2 += h1[tl * 64 + i] * w2[i * 64 + j];
      hid[(long)t * 64 + j] = sinf(fr[j] * s2);
    }
    __syncthreads();
  }
}

__device__ void phase_pre1(const Params& P) {
  __shared__ float w3s[128];
  __shared__ float red[8];
  const int tid = TID(), lane = tid & 63, wid = tid >> 6;
  const long gtid = (long)BID() * NT + tid, gsz = (long)gridDim.x * NT;
  {
    const float* modp = (const float*)(WS(P) + O_MODP);
    float* mod = (float*)(WS(P) + O_MOD);
    for (long i = gtid; i < (long)4 * 16 * 6144; i += gsz) {
      int n = (int)(i % 6144);
      int l = (int)(i / (16 * 6144));
      float s = P.in[5][l * 6144 + n];
      for (int ks = 0; ks < 8; ++ks) s += modp[(long)ks * 4 * 16 * 6144 + i];
      mod[i] = s;
    }
  }
  float2* buf = (float2*)smem;
  const float2* tw = (const float2*)(WS(P) + O_TW);
  for (int item = BID(); item < 2048; item += gridDim.x) {
    const int sel = item >> 10, c = item & 1023;
    const int L = sel ? 2048 : 8192, N = 2 * L;
    const float* hid = (const float*)(WS(P) + (sel ? O_HIDP : O_HIDS));
    float2* hs = (float2*)(WS(P) + (sel ? O_HSPP : O_HSPS)) + (long)c * N;
    __syncthreads();
    if (tid < 128) {
      int dirn = tid >> 6, j = tid & 63;
      w3s[tid] = P.in[14][(long)j * 2048 + dirn * 1024 + c];
    }
    __syncthreads();
    const float dec0 = fabsf(P.in[16][c]), dec1 = fabsf(P.in[16][1024 + c]);
    const float invLm1 = 1.f / (float)(L - 1);
    float asum = 0.f;
    for (int n = tid; n < N; n += NT) {
      float val = 0.f;
      if (n != L) {
        const int dirn = n < L ? 0 : 1;
        const int t = n < L ? n : N - n;
        const float4* hr = (const float4*)(hid + (long)t * 64);
        const float* w = w3s + dirn * 64;
        float s = 0.f;
#pragma unroll
        for (int q = 0; q < 16; ++q) {
          float4 h4 = hr[q];
          s += h4.x * w[4 * q] + h4.y * w[4 * q + 1] + h4.z * w[4 * q + 2] + h4.w * w[4 * q + 3];
        }
        float tl = (float)t * invLm1;
        val = s * expf(-tl * (dirn ? dec1 : dec0));
      }
      buf[fidx(n)] = make_float2(val, 0.f);
      asum += fabsf(val);
    }
    asum = wave_sum(asum);
    if (lane == 0) red[wid] = asum;
    __syncthreads();
    float tot = 0.f;
#pragma unroll
    for (int w = 0; w < 8; ++w) tot += red[w];
    const float scale = 1.f / (tot * (float)N);
    fft_dif(buf, N, tw);
    for (int p = tid; p < N; p += NT) {
      float2 a = buf[fidx(p)];
      hs[p] = make_float2(a.x * scale, a.y * scale);
    }
  }
  __syncthreads();
}

__device__ void phase_norm(const Params& P, int layer, int slab, int which) {
  const float* __restrict__ x = (layer == 0 && which == 0) ? xin_of(P, slab) : (const float*)(OUTP(P) + (long)slab * SLAB * D);
  u16* __restrict__ h = (u16*)(WS(P) + O_HBUF);
  const float* gain = P.in[6] + (layer * 2 + which) * D;
  const float* mod = (const float*)(WS(P) + O_MOD) + (long)layer * 16 * 6144;
  const int shoff = which ? 3 * D : 0, scoff = which ? 4 * D : D;
  const int tid = TID(), lane = tid & 63, wid = tid >> 6;
  for (int item = BID(); item < SLAB / 32; item += gridDim.x) {
    const int r0 = item * 32 + wid * 4;
    float4 v[4][4];
    float ss[4];
#pragma unroll
    for (int u = 0; u < 4; ++u) {
      const float* xr = x + (long)(r0 + u) * D;
      float a = 0.f;
#pragma unroll
      for (int i = 0; i < 4; ++i) {
        v[u][i] = *(const float4*)(xr + i * 256 + lane * 4);
        a += v[u][i].x * v[u][i].x + v[u][i].y * v[u][i].y + v[u][i].z * v[u][i].z + v[u][i].w * v[u][i].w;
      }
      ss[u] = a;
    }
    const float* m = mod + (long)gb_of(slab, r0) * 6144;
#pragma unroll
    for (int u = 0; u < 4; ++u) ss[u] = wave_sum(ss[u]);
#pragma unroll
    for (int i = 0; i < 4; ++i) {
      const int col = i * 256 + lane * 4;
      const float4 g = *(const float4*)(gain + col);
      const float4 sc = *(const float4*)(m + scoff + col);
      const float4 sh = *(const float4*)(m + shoff + col);
      const float a0 = g.x * (1.f + sc.x), a1 = g.y * (1.f + sc.y), a2 = g.z * (1.f + sc.z), a3 = g.w * (1.f + sc.w);
#pragma unroll
      for (int u = 0; u < 4; ++u) {
        const float rstd = rsqrtf(ss[u] * (1.f / 1024.f) + 1e-6f);
        const float y0 = v[u][i].x * rstd * a0 + sh.x, y1 = v[u][i].y * rstd * a1 + sh.y;
        const float y2 = v[u][i].z * rstd * a2 + sh.z, y3 = v[u][i].w * rstd * a3 + sh.w;
        *(uint2*)(h + (long)(r0 + u) * D + col) = make_uint2(pack2(y0, y1), pack2(y2, y3));
      }
    }
  }
}

__device__ void phase_proj(const Params& P, size_t woff, int N) {
  EpiStoreBf16 E; E.O = (u16*)(WS(P) + O_PROJ); E.ldc = N;
  run_gemm((const u16*)(WS(P) + O_HBUF), (const u16*)(WS(P) + woff), N, D, E);
}
__device__ void phase_resid(const Params& P, int layer, int slab, const u16* A, int K, size_t woff, int goff) {
  EpiResid E; E.X = OUTP(P) + (long)slab * SLAB * D; E.XS = (layer == 0 && goff == 2 * D) ? xin_of(P, slab) : (const float*)E.X; E.mod = (const float*)(WS(P) + O_MOD) + (long)layer * 16 * 6144; E.goff = goff; E.slab = slab;
  run_gemm(A, (const u16*)(WS(P) + woff), D, K, E);
}

__device__ void phase_ffn_gate(const Params& P, int layer) {
  EpiStoreBf16 E; E.O = (u16*)(WS(P) + O_GBUF); E.ldc = DFF;
  run_gemm((const u16*)(WS(P) + O_HBUF), (const u16*)(WS(P) + O_WFG) + (long)layer * DFF * D, DFF, D, E);
}
__device__ void phase_ffn_val(const Params& P, int layer, int slab) {
  EpiFfnVal E; E.G = (const u16*)(WS(P) + O_GBUF); E.ACT = (u16*)(WS(P) + O_ACT);
  E.cw = P.in[33] + (long)layer * 3 * DFF; E.cb = P.in[34] + (long)layer * DFF; E.L = Lof(slab);
  run_gemm((const u16*)(WS(P) + O_HBUF), (const u16*)(WS(P) + O_WFV) + (long)layer * DFF * D, DFF, D, E);
}

__device__ void phase_hy_conv(const Params& P, int slab) {
  const int L = Lof(slab), nseq = SLAB / L, tid = TID();
  const u16* __restrict__ z = (const u16*)(WS(P) + O_PROJ);
  float* __restrict__ uT = (float*)(WS(P) + O_UT);
  u16* __restrict__ x0c = (u16*)(WS(P) + O_X0C);
  const float* cw = P.in[8];
  const float* cb = P.in[9];
  float* tile = (float*)smem;
  const int ntt = L / 64;
  const int nitems = nseq * ntt * 16;
  const int tl = tid >> 3, cg = tid & 7;
  for (int item = BID(); item < nitems; item += gridDim.x) {
    const int ct = item % 16, tt = (item / 16) % ntt, seq = item / (16 * ntt);
    const int t = tt * 64 + tl, c0 = ct * 64 + cg * 8;
    const long row = (long)seq * L + t;
    const float mp = t > 0 ? 1.f : 0.f, mn = t < L - 1 ? 1.f : 0.f;
    const long rp = t > 0 ? row - 1 : row, rn = t < L - 1 ? row + 1 : row;
    float val[3][8];
#pragma unroll
    for (int q = 0; q < 3; ++q) {
      const int col = q * 1024 + c0;
      float a[8], b[8], c[8];
      unpack8(*(const uint4*)(z + rp * 3072 + col), a);
      unpack8(*(const uint4*)(z + row * 3072 + col), b);
      unpack8(*(const uint4*)(z + rn * 3072 + col), c);
      const float4 w0a = *(const float4*)(cw + col), w0b = *(const float4*)(cw + col + 4);
      const float4 w1a = *(const float4*)(cw + 3072 + col), w1b = *(const float4*)(cw + 3072 + col + 4);
      const float4 w2a = *(const float4*)(cw + 6144 + col), w2b = *(const float4*)(cw + 6144 + col + 4);
      const float4 ba = *(const float4*)(cb + col), bb = *(const float4*)(cb + col + 4);
      const float w0[8] = {w0a.x, w0a.y, w0a.z, w0a.w, w0b.x, w0b.y, w0b.z, w0b.w};
      const float w1[8] = {w1a.x, w1a.y, w1a.z, w1a.w, w1b.x, w1b.y, w1b.z, w1b.w};
      const float w2[8] = {w2a.x, w2a.y, w2a.z, w2a.w, w2b.x, w2b.y, w2b.z, w2b.w};
      const float bs[8] = {ba.x, ba.y, ba.z, ba.w, bb.x, bb.y, bb.z, bb.w};
#pragma unroll
      for (int i = 0; i < 8; ++i) val[q][i] = mp * a[i] * w0[i] + b[i] * w1[i] + mn * c[i] * w2[i] + bs[i];
    }
    *(uint4*)(x0c + row * 1024 + c0) = pack8s(val[0], 1.f);
    __syncthreads();
#pragma unroll
    for (int i = 0; i < 8; ++i) tile[tl * 65 + cg * 8 + i] = val[1][i] * val[2][i];
    __syncthreads();
    {
      const int cl = tid >> 3, tq = tid & 7;
      float* dst = uT + ((long)seq * 1024 + ct * 64 + cl) * L + tt * 64 + tq * 8;
      float4 o0, o1;
      o0.x = tile[(tq * 8 + 0) * 65 + cl]; o0.y = tile[(tq * 8 + 1) * 65 + cl]; o0.z = tile[(tq * 8 + 2) * 65 + cl]; o0.w = tile[(tq * 8 + 3) * 65 + cl];
      o1.x = tile[(tq * 8 + 4) * 65 + cl]; o1.y = tile[(tq * 8 + 5) * 65 + cl]; o1.z = tile[(tq * 8 + 6) * 65 + cl]; o1.w = tile[(tq * 8 + 7) * 65 + cl];
      *(float4*)dst = o0; *(float4*)(dst + 4) = o1;
    }
  }
  __syncthreads();
}

__device__ void phase_hy_fft(const Params& P, int slab, bool dry = false) {
  const int L = Lof(slab), N = 2 * L, nseq = SLAB / L, tid = TID();
  float* uT = (float*)(WS(P) + O_UT);
  const float2* hsb = (const float2*)(WS(P) + (slab == 0 ? O_HSPP : O_HSPS));
  const float2* tw = (const float2*)(WS(P) + O_TW);
  const float* skip = P.in[17];
  float2* buf = (float2*)smem;
  const int nitems = (nseq / 2) * 1024;
  for (int item = BID(); item < nitems; item += gridDim.x) {
    const int pr = item >> 10, c = item & 1023;
    float* u0 = uT + ((long)(pr * 2) * 1024 + c) * L;
    float* u1 = u0 + (long)1024 * L;
    __syncthreads();
    for (int t = tid; t < L; t += NT) {
      buf[fidx(t)] = make_float2(u0[t], u1[t]);
      buf[fidx(t + L)] = make_float2(0.f, 0.f);
    }
    __syncthreads();
    fft_dif(buf, N, tw);
    const float2* h = hsb + (long)c * N;
    for (int p = tid; p < N; p += NT) {
      float2 a = buf[fidx(p)], b = h[p];
      buf[fidx(p)] = make_float2(a.x * b.x - a.y * b.y, a.x * b.y + a.y * b.x);
    }
    __syncthreads();
    ifft_dit(buf, N, tw);
    const float sk = skip[c];
    for (int t = tid; t < L; t += NT) {
      float2 y = buf[fidx(t)];
      const long doff = dry ? (long)(END_HY - O_UT) / 4 : 0;
      u0[t + doff] = y.x + u0[t] * sk;
      u1[t + doff] = y.y + u1[t] * sk;
    }
  }
  __syncthreads();
}

__device__ void phase_hy_tr(const Params& P, int slab) {
  const int L = Lof(slab), nseq = SLAB / L, tid = TID();
  const float* __restrict__ yT = (const float*)(WS(P) + O_UT);
  const u16* __restrict__ x0c = (const u16*)(WS(P) + O_X0C);
  u16* __restrict__ a2 = (u16*)(WS(P) + O_A2);
  float* tile = (float*)smem;
  const int ntt = L / 64;
  const int nitems = nseq * ntt * 16;
  for (int item = BID(); item < nitems; item += gridDim.x) {
    const int ct = item % 16, tt = (item / 16) % ntt, seq = item / (16 * ntt);
    const int cl = tid >> 3, tq = tid & 7;
    const float* src = yT + ((long)seq * 1024 + ct * 64 + cl) * L + tt * 64 + tq * 8;
    const float4 i0 = *(const float4*)src, i1 = *(const float4*)(src + 4);
    const int tl = tid >> 3, cg = tid & 7;
    const long row = (long)seq * L + tt * 64 + tl;
    const int c0 = ct * 64 + cg * 8;
    float xg[8];
    unpack8(*(const uint4*)(x0c + row * 1024 + c0), xg);
    __syncthreads();
    float* p = tile + cl * 65 + tq * 8;
    p[0] = i0.x; p[1] = i0.y; p[2] = i0.z; p[3] = i0.w; p[4] = i1.x; p[5] = i1.y; p[6] = i1.z; p[7] = i1.w;
    __syncthreads();
    float o[8];
#pragma unroll
    for (int i = 0; i < 8; ++i) o[i] = tile[(cg * 8 + i) * 65 + tl] * xg[i];
    *(uint4*)(a2 + row * 1024 + c0) = pack8s(o, 1.f);
  }
  __syncthreads();
}

struct Rec {
  int H, DK, DV, C;
  int ldv, voff, goff;
};
__device__ __forceinline__ Rec rec_of(int kind) {
  Rec r;
  if (kind == 1) { r.H = 4; r.DK = 256; r.DV = 512; r.C = 128; r.ldv = 6144; r.voff = 2048; r.goff = 4096; }
  else { r.H = 8; r.DK = 128; r.DV = 128; r.C = 64; r.ldv = 5120; r.voff = 1024; r.goff = 4096; }
  return r;
}

__device__ void phase_ret_prep(const Params& P, int slab) {
  const int L = Lof(slab);
  const u16* __restrict__ pj = (const u16*)(WS(P) + O_PROJ);
  u16* __restrict__ qdf = (u16*)(WS(P) + O_QDF); u16* __restrict__ qdb = (u16*)(WS(P) + O_QDB);
  u16* __restrict__ kif = (u16*)(WS(P) + O_KIF); u16* __restrict__ kib = (u16*)(WS(P) + O_KIB);
  u16* __restrict__ kef = (u16*)(WS(P) + O_KEF); u16* __restrict__ keb = (u16*)(WS(P) + O_KEB);
  float* dlf = (float*)(WS(P) + O_DLF); float* dlb = (float*)(WS(P) + O_DLB);
  const float2* __restrict__ rope = (const float2*)(WS(P) + O_ROPER);
  const long gtid = (long)BID() * NT + TID(), gsz = (long)gridDim.x * NT;
  for (long idx = gtid; idx < (long)SLAB * 64; idx += gsz) {
    const int d0 = (int)(idx & 15) * 8, h = (int)((idx >> 4) & 3), t = (int)(idx >> 6);
    const int pos = t & (L - 1), r = t & 127;
    const float lgf = -expf(P.in[20][h]), lgb = -expf(P.in[20][4 + h]);
    const u16* row = pj + (long)t * 6144 + h * 256 + d0;
    const uint4 vq1 = *(const uint4*)row, vq2 = *(const uint4*)(row + 128);
    const uint4 vk1 = *(const uint4*)(row + 1024), vk2 = *(const uint4*)(row + 1024 + 128);
    const float4* rp = (const float4*)(rope + (long)pos * 128 + d0);
    const float4 c01 = rp[0], c23 = rp[1], c45 = rp[2], c67 = rp[3];
    float q1[8], q2[8], k1[8], k2[8];
    unpack8(vq1, q1); unpack8(vq2, q2); unpack8(vk1, k1); unpack8(vk2, k2);
    const float cs[8] = {c01.x, c01.z, c23.x, c23.z, c45.x, c45.z, c67.x, c67.z};
    const float sn[8] = {c01.y, c01.w, c23.y, c23.w, c45.y, c45.w, c67.y, c67.w};
    float qa[8], qb[8], ka[8], kb[8];
#pragma unroll
    for (int i = 0; i < 8; ++i) {
      qa[i] = q1[i] * cs[i] - q2[i] * sn[i]; qb[i] = q1[i] * sn[i] + q2[i] * cs[i];
      ka[i] = (k1[i] * cs[i] - k2[i] * sn[i]) * 0.0625f; kb[i] = (k1[i] * sn[i] + k2[i] * cs[i]) * 0.0625f;
    }
    const float bf = (float)(r + 1) * lgf, bb = (float)(128 - r) * lgb;
    const float ef = expf(bf), eif = expf(-bf), eef = expf((float)(127 - r) * lgf);
    const float eb = expf(bb), eib = expf(-bb), eeb = expf((float)r * lgb);
    const long o1 = (long)t * 1024 + h * 256 + d0, o2 = o1 + 128;
    *(uint4*)(qdf + o1) = pack8s(qa, ef); *(uint4*)(qdf + o2) = pack8s(qb, ef);
    *(uint4*)(qdb + o1) = pack8s(qa, eb); *(uint4*)(qdb + o2) = pack8s(qb, eb);
    *(uint4*)(kif + o1) = pack8s(ka, eif); *(uint4*)(kif + o2) = pack8s(kb, eif);
    *(uint4*)(kib + o1) = pack8s(ka, eib); *(uint4*)(kib + o2) = pack8s(kb, eib);
    *(uint4*)(kef + o1) = pack8s(ka, eef); *(uint4*)(kef + o2) = pack8s(kb, eef);
    *(uint4*)(keb + o1) = pack8s(ka, eeb); *(uint4*)(keb + o2) = pack8s(kb, eeb);
    if (r == 0) {
      const long cgi = (long)(t >> 7) * 1024 + h * 256 + d0;
      const float df = expf(128.f * lgf), db = expf(128.f * lgb);
#pragma unroll
      for (int i = 0; i < 8; ++i) { dlf[cgi + i] = df; dlf[cgi + 128 + i] = df; dlb[cgi + i] = db; dlb[cgi + 128 + i] = db; }
    }
  }
}

__device__ __forceinline__ float lb_of(const float* lbt, int dr, int ch) {
  const float a0 = lbt[(dr * 4 + 0) * 1024 + ch], a1 = lbt[(dr * 4 + 1) * 1024 + ch], a2 = lbt[(dr * 4 + 2) * 1024 + ch], a3 = lbt[(dr * 4 + 3) * 1024 + ch];
  const float m = fmaxf(fmaxf(a0, a1), fmaxf(a2, a3));
  const float e0 = expf(a0 - m), e1 = expf(a1 - m), e2 = expf(a2 - m), e3 = expf(a3 - m);
  return (e0 + e1 + e2) / (e0 + e1 + e2 + e3);
}
__device__ void phase_hg_prep(const Params& P) {
  const u16* __restrict__ pj = (const u16*)(WS(P) + O_PROJ);
  u16* __restrict__ qdf = (u16*)(WS(P) + O_QDF); u16* __restrict__ qdb = (u16*)(WS(P) + O_QDB);
  u16* __restrict__ kif = (u16*)(WS(P) + O_KIF); u16* __restrict__ kib = (u16*)(WS(P) + O_KIB);
  u16* __restrict__ kef = (u16*)(WS(P) + O_KEF); u16* __restrict__ keb = (u16*)(WS(P) + O_KEB);
  float* dlf = (float*)(WS(P) + O_DLF); float* dlb = (float*)(WS(P) + O_DLB);
  const float* lbt = P.in[28];
  float* totF = (float*)smem;
  float* totB = totF + 1024;
  const int tid = TID(), lane = tid & 63, rg = tid >> 6;
  for (int item = BID(); item < 2048; item += gridDim.x) {
    const int cgi = item >> 3, ch = (item & 7) * 128 + lane * 2;
    const long t0 = (long)cgi * 64 + rg * 8;
    unsigned wq[8], wf[8], wb[8];
#pragma unroll
    for (int i = 0; i < 8; ++i) {
      const u16* row = pj + (t0 + i) * 5120 + ch;
      wq[i] = *(const unsigned*)row; wf[i] = *(const unsigned*)(row + 2048); wb[i] = *(const unsigned*)(row + 3072);
    }
    float lb0[2], lb1[2];
    lb0[0] = lb_of(lbt, 0, ch); lb0[1] = lb_of(lbt, 0, ch + 1);
    lb1[0] = lb_of(lbt, 1, ch); lb1[1] = lb_of(lbt, 1, ch + 1);
    float pf[2][8], sb[2][8], accf[2], accb[2];
#pragma unroll
    for (int c = 0; c < 2; ++c) {
      float a = 0.f;
#pragma unroll
      for (int i = 0; i < 8; ++i) {
        const float x = bf2f((u16)(c ? (wf[i] >> 16) : (wf[i] & 0xffff)));
        a += logf(lb0[c] + (1.f - lb0[c]) * sigm(x)); pf[c][i] = a;
      }
      accf[c] = a;
      a = 0.f;
#pragma unroll
      for (int i = 7; i >= 0; --i) {
        const float x = bf2f((u16)(c ? (wb[i] >> 16) : (wb[i] & 0xffff)));
        a += logf(lb1[c] + (1.f - lb1[c]) * sigm(x)); sb[c][i] = a;
      }
      accb[c] = a;
    }
    __syncthreads();
    *(float2*)(totF + rg * 128 + lane * 2) = make_float2(accf[0], accf[1]);
    *(float2*)(totB + rg * 128 + lane * 2) = make_float2(accb[0], accb[1]);
    __syncthreads();
    float offF[2] = {0.f, 0.f}, offB[2] = {0.f, 0.f}, totf[2] = {0.f, 0.f}, totb[2] = {0.f, 0.f};
#pragma unroll
    for (int g = 0; g < 8; ++g) {
      const float2 f = *(const float2*)(totF + g * 128 + lane * 2), bq = *(const float2*)(totB + g * 128 + lane * 2);
      totf[0] += f.x; totf[1] += f.y; totb[0] += bq.x; totb[1] += bq.y;
      if (g < rg) { offF[0] += f.x; offF[1] += f.y; }
      if (g > rg) { offB[0] += bq.x; offB[1] += bq.y; }
    }
#pragma unroll
    for (int i = 0; i < 8; ++i) {
      float o[6][2];
#pragma unroll
      for (int c = 0; c < 2; ++c) {
        const float xq = bf2f((u16)(c ? (wq[i] >> 16) : (wq[i] & 0xffff)));
        const float xf = bf2f((u16)(c ? (wf[i] >> 16) : (wf[i] & 0xffff)));
        const float xb = bf2f((u16)(c ? (wb[i] >> 16) : (wb[i] & 0xffff)));
        const float q = silu_f(xq);
        const float bf = offF[c] + pf[c][i], bb = offB[c] + sb[c][i];
        const float kf = (1.f - lb0[c]) * sigm(-xf), kb = (1.f - lb1[c]) * sigm(-xb);
        o[0][c] = q * expf(bf); o[1][c] = kf * expf(-bf); o[2][c] = kf * expf(totf[c] - bf);
        o[3][c] = q * expf(bb); o[4][c] = kb * expf(-bb); o[5][c] = kb * expf(totb[c] - bb);
      }
      const long oo = (t0 + i) * 1024 + ch;
      *(unsigned*)(qdf + oo) = pack2(o[0][0], o[0][1]);
      *(unsigned*)(kif + oo) = pack2(o[1][0], o[1][1]);
      *(unsigned*)(kef + oo) = pack2(o[2][0], o[2][1]);
      *(unsigned*)(qdb + oo) = pack2(o[3][0], o[3][1]);
      *(unsigned*)(kib + oo) = pack2(o[4][0], o[4][1]);
      *(unsigned*)(keb + oo) = pack2(o[5][0], o[5][1]);
    }
    if (rg == 0) {
      *(float2*)(dlf + (long)cgi * 1024 + ch) = make_float2(expf(totf[0]), expf(totf[1]));
      *(float2*)(dlb + (long)cgi * 1024 + ch) = make_float2(expf(totb[0]), expf(totb[1]));
    }
  }
  __syncthreads();
}

template <int C>
__device__ __forceinline__ void rec_scores_item(const Params& P, const Rec& R, int cgi, int h) {
  const u16* qdf = (const u16*)(WS(P) + O_QDF); const u16* qdb = (const u16*)(WS(P) + O_QDB);
  const u16* kif = (const u16*)(WS(P) + O_KIF); const u16* kib = (const u16*)(WS(P) + O_KIB);
  u16* sc = (u16*)(WS(P) + O_SC) + ((long)cgi * R.H + h) * C * C;
  const long off = (long)cgi * C * 1024 + h * R.DK;
  f32x4 af[C / 32][C / 64] = {}, ab[C / 32][C / 64] = {};
  gemm_acc<C, C, true, true, true, (C == 128 ? 4 : 2)>(af, qdf + off, 1024, kif + off, 1024, (u16*)smem);
  gemm_acc<C, C, true, true, true, (C == 128 ? 4 : 2)>(ab, qdb + off, 1024, kib + off, 1024, (u16*)smem);
  const int tid = TID(), lane = tid & 63, wid = tid >> 6;
  const int wm = wid >> 2, wn = wid & 3, fr = lane & 15, fq = lane >> 4;
#pragma unroll
  for (int mi = 0; mi < C / 32; ++mi)
#pragma unroll
    for (int ni = 0; ni < C / 64; ++ni) {
      const int r = wm * (C / 2) + mi * 16 + fr, c0 = wn * (C / 4) + ni * 16 + fq * 4;
      float v[4];
#pragma unroll
      for (int j = 0; j < 4; ++j) {
        const int c = c0 + j;
        v[j] = (c <= r ? af[mi][ni][j] : 0.f) + (c >= r ? ab[mi][ni][j] : 0.f);
      }
      *(uint2*)(sc + r * C + c0) = make_uint2(pack2(v[0], v[1]), pack2(v[2], v[3]));
    }
}

template <int C>
__device__ void phase_rec_su(const Params& P, int kind) {
  const Rec R = rec_of(kind);
  constexpr int KTU = C / 64;
  const int nch = SLAB / C;
  const int n_sc = nch * R.H;
  const int mtn = R.DK / 128, ntn = R.DV / 128;
  const int n_u = nch * R.H * 2 * mtn * ntn, G = gridDim.x;
  const u16* pj = (const u16*)(WS(P) + O_PROJ);
  for (int item = BID(); item < n_sc; item += G) rec_scores_item<C>(P, R, item / R.H, item % R.H);
  const u16* kef = (const u16*)(WS(P) + O_KEF); const u16* keb = (const u16*)(WS(P) + O_KEB);
  u16* stfb = (u16*)(WS(P) + O_STF); u16* stbb = (u16*)(WS(P) + O_STB);
  Tiles<KTU> ta, tb;
#define U_DECODE(q_, nt_, mt_, dir_, h_, cgi_) int nt_, mt_, dir_, h_, cgi_; { int qq = (q_); nt_ = qq % ntn; qq /= ntn; mt_ = qq % mtn; qq /= mtn; dir_ = qq & 1; qq >>= 1; h_ = qq % R.H; cgi_ = qq / R.H; }
#define U_ISSUE(T_, nt_, mt_, dir_, h_, cgi_) tiles_issue<128, 128, false, false, KTU>(T_, (dir_ ? keb : kef) + (long)cgi_ * C * 1024 + h_ * R.DK + mt_ * 128, 1024, pj + (long)cgi_ * C * R.ldv + R.voff + h_ * R.DV + nt_ * 128, R.ldv)
#define U_RUN(T_, nt_, mt_, dir_, h_, cgi_) { f32x4 acc[4][2] = {}; gemm_run<128, 128, false, false, false, KTU>(acc, T_, (u16*)smem); \
    u16* st = (dir_ ? stbb : stfb) + (((long)cgi_ * R.H + h_) * R.DV + nt_ * 128) * R.DK + mt_ * 128; const int DK = R.DK; \
    epi_each<128, 128, false>(acc, [&](int r, int c, f32x4 val) { *(uint2*)(st + (long)c * DK + r) = make_uint2(pack2(val[0], val[1]), pack2(val[2], val[3])); }); }
  int q = BID();
  if (q < n_u) { U_DECODE(q, nt, mt, dir, h, cgi); U_ISSUE(ta, nt, mt, dir, h, cgi); }
  for (; q < n_u; q += 2 * G) {
    U_DECODE(q, nt, mt, dir, h, cgi);
    const int q2 = q + G;
    if (q2 < n_u) { U_DECODE(q2, nt2, mt2, dir2, h2, cgi2); U_ISSUE(tb, nt2, mt2, dir2, h2, cgi2); }
    U_RUN(ta, nt, mt, dir, h, cgi);
    const int q3 = q + 2 * G;
    if (q3 < n_u) { U_DECODE(q3, nt3, mt3, dir3, h3, cgi3); U_ISSUE(ta, nt3, mt3, dir3, h3, cgi3); }
    if (q2 < n_u) { U_DECODE(q2, nt2, mt2, dir2, h2, cgi2); U_RUN(tb, nt2, mt2, dir2, h2, cgi2); }
  }
#undef U_DECODE
#undef U_ISSUE
#undef U_RUN
  __syncthreads();
}

__device__ void phase_rec_scan(const Params& P, int kind, int slab, bool dry = false) {
  const Rec R = rec_of(kind);
  const int L = Lof(slab), nseq = SLAB / L, ncs = L / R.C;
  const int qdk = R.DK / 4;
  const long per = (long)R.H * R.DV * qdk;
  const long total = 2 * nseq * per;
  const long gtid = (long)BID() * NT + TID(), gsz = (long)gridDim.x * NT;
  for (long idx = gtid; idx < total; idx += gsz) {
    long q = idx;
    const int pd = (int)(q % qdk); q /= qdk;
    const int e = (int)(q % R.DV); q /= R.DV;
    const int h = (int)(q % R.H); q /= R.H;
    const int seq = (int)(q % nseq);
    const int dir = (int)(q / nseq);
    u16* st = (u16*)(WS(P) + (dir ? O_STB : O_STF));
    u16* stw = dry ? (u16*)(WS(P) + O_OBUF) : st;
    const float* dl = (const float*)(WS(P) + (dir ? O_DLB : O_DLF));
    float s0 = 0.f, s1 = 0.f, s2 = 0.f, s3 = 0.f;
    const long ebase = ((long)h * R.DV + e) * R.DK + pd * 4;
    const long cstride = (long)R.H * R.DV * R.DK;
    const int dbase = h * R.DK + pd * 4;
    for (int i0 = 0; i0 < ncs; i0 += 8) {
      uint2 u[8];
      float4 dd[8];
#pragma unroll
      for (int j = 0; j < 8; ++j) {
        const int n = dir ? (ncs - 1 - i0 - j) : (i0 + j);
        const long cgi = (long)seq * ncs + n;
        u[j] = *(const uint2*)(st + cgi * cstride + ebase);
        dd[j] = *(const float4*)(dl + cgi * 1024 + dbase);
      }
#pragma unroll
      for (int j = 0; j < 8; ++j) {
        const int n = dir ? (ncs - 1 - i0 - j) : (i0 + j);
        const long cgi = (long)seq * ncs + n;
        *(uint2*)(stw + cgi * cstride + ebase) = make_uint2(pack2(s0, s1), pack2(s2, s3));
        s0 = dd[j].x * s0 + bf2f((u16)(u[j].x & 0xffff));
        s1 = dd[j].y * s1 + bf2f((u16)(u[j].x >> 16));
        s2 = dd[j].z * s2 + bf2f((u16)(u[j].y & 0xffff));
        s3 = dd[j].w * s3 + bf2f((u16)(u[j].y >> 16));
      }
    }
  }
}

template <int C>
__device__ void phase_rec_out(const Params& P, int kind) {
  const Rec R = rec_of(kind);
  constexpr int KT1 = C / 64, KT2 = (C == 128 ? 4 : 2);
  const int nch = SLAB / C, ntn = R.DV / 128;
  const u16* pj = (const u16*)(WS(P) + O_PROJ);
  const u16* scb = (const u16*)(WS(P) + O_SC);
  const u16* qdf = (const u16*)(WS(P) + O_QDF); const u16* qdb = (const u16*)(WS(P) + O_QDB);
  const u16* stf = (const u16*)(WS(P) + O_STF); const u16* stb = (const u16*)(WS(P) + O_STB);
  float* ob = (float*)(WS(P) + O_OBUF);
  const int HDV = R.H * R.DV;
  const int nitems = nch * R.H * ntn, G = gridDim.x;
  Tiles<KT1> t1; Tiles<KT2> t2; Tiles<KT2> t3;
  int item = BID();
  if (item < nitems) {
    const int nt = item % ntn, h = (item / ntn) % R.H, cgi = item / (ntn * R.H);
    tiles_issue<C, 128, true, false, KT1>(t1, scb + ((long)cgi * R.H + h) * C * C, C, pj + (long)cgi * C * R.ldv + R.voff + h * R.DV + nt * 128, R.ldv);
  }
  for (; item < nitems; item += G) {
    const int nt = item % ntn, h = (item / ntn) % R.H, cgi = item / (ntn * R.H);
    const long qoff = (long)cgi * C * 1024 + h * R.DK;
    const long soff = (((long)cgi * R.H + h) * R.DV + nt * 128) * R.DK;
    f32x4 acc[C / 32][2] = {};
    tiles_issue<C, 128, true, true, KT2>(t2, qdf + qoff, 1024, stf + soff, R.DK);
    gemm_run<C, 128, true, false, true, KT1>(acc, t1, (u16*)smem);
    tiles_issue<C, 128, true, true, KT2>(t3, qdb + qoff, 1024, stb + soff, R.DK);
    gemm_run<C, 128, true, true, true, KT2>(acc, t2, (u16*)smem);
    const int nx = item + G;
    if (nx < nitems) {
      const int nt2 = nx % ntn, h2 = (nx / ntn) % R.H, cg2 = nx / (ntn * R.H);
      tiles_issue<C, 128, true, false, KT1>(t1, scb + ((long)cg2 * R.H + h2) * C * C, C, pj + (long)cg2 * C * R.ldv + R.voff + h2 * R.DV + nt2 * 128, R.ldv);
    }
    gemm_run<C, 128, true, true, true, KT2>(acc, t3, (u16*)smem);
    float* o = ob + (long)cgi * C * HDV + h * R.DV + nt * 128;
    epi_each<C, 128, true>(acc, [&](int r, int c, f32x4 val) { *(f32x4*)(o + (long)r * HDV + c) = val; });
  }
  __syncthreads();
}

template <int KIND>
__device__ void phase_rec_ng_t(const Params& P) {
  const Rec R = rec_of(KIND);
  constexpr int DV = (KIND == 1) ? 512 : 128, H = (KIND == 1) ? 4 : 8, PER = DV / 64, HDV = H * DV;
  const float* __restrict__ ob = (const float*)(WS(P) + O_OBUF);
  const u16* __restrict__ pj = (const u16*)(WS(P) + O_PROJ);
  u16* __restrict__ a2 = (u16*)(WS(P) + O_A2);
  const float* gain = P.in[29];
  const int tid = TID(), lane = tid & 63, wid = tid >> 6;
  constexpr int nrows = SLAB * H;
  for (int item = BID(); item < nrows / 32; item += gridDim.x) {
    float v[4][PER];
    float ss[4];
#pragma unroll
    for (int u = 0; u < 4; ++u) {
      const int rh = item * 32 + wid * 4 + u;
      const int t = rh / H, h = rh % H;
      const float* o = ob + (long)t * HDV + h * DV + lane * PER;
      if (PER == 8) {
        const float4 a = *(const float4*)o, b = *(const float4*)(o + 4);
        v[u][0] = a.x; v[u][1] = a.y; v[u][2] = a.z; v[u][3] = a.w; v[u][4 % PER] = b.x; v[u][5 % PER] = b.y; v[u][6 % PER] = b.z; v[u][7 % PER] = b.w;
      } else {
        const float2 a = *(const float2*)o;
        v[u][0] = a.x; v[u][1] = a.y;
      }
      float a = 0.f;
#pragma unroll
      for (int i = 0; i < PER; ++i) a += v[u][i] * v[u][i];
      ss[u] = a;
    }
#pragma unroll
    for (int u = 0; u < 4; ++u) ss[u] = wave_sum(ss[u]);
#pragma unroll
    for (int u = 0; u < 4; ++u) {
      const int rh = item * 32 + wid * 4 + u;
      const int t = rh / H, h = rh % H;
      const float rstd = rsqrtf(ss[u] / (float)DV + 1e-6f);
      const u16* g = pj + (long)t * R.ldv + R.goff + h * DV + lane * PER;
      u16* out = a2 + (long)t * HDV + h * DV + lane * PER;
      float y[PER];
#pragma unroll
      for (int i = 0; i < PER; ++i) {
        y[i] = v[u][i] * rstd;
        if (KIND == 3) y[i] *= gain[lane * PER + i];
      }
      if (PER == 8) {
        const uint4 gw = *(const uint4*)g;
        float gf[8];
        unpack8(gw, gf);
        float r8[8];
#pragma unroll
        for (int i = 0; i < 8; ++i) r8[i] = y[i % PER] * silu_f(gf[i]);
        *(uint4*)out = pack8s(r8, 1.f);
      } else {
        const unsigned gw = *(const unsigned*)g;
        *(unsigned*)out = pack2(y[0] * silu_f(bf2f((u16)(gw & 0xffff))), y[1 % PER] * silu_f(bf2f((u16)(gw >> 16))));
      }
    }
  }
}
__device__ void phase_rec_ng(const Params& P, int kind) {
  if (kind == 1) phase_rec_ng_t<1>(P); else phase_rec_ng_t<3>(P);
}

__device__ void phase_swa_prep(const Params& P, int slab) {
  const int L = Lof(slab);
  const u16* pj = (const u16*)(WS(P) + O_PROJ);
  u16* qn = (u16*)(WS(P) + O_QN);
  u16* kn = (u16*)(WS(P) + O_KN);
  const float2* rope = (const float2*)(WS(P) + O_ROPES);
  const long gtid = (long)BID() * NT + TID(), gsz = (long)gridDim.x * NT;
  for (long idx = gtid; idx < (long)SLAB * 640; idx += gsz) {
    const int d = (int)(idx & 31);
    const int hd = (int)((idx >> 5) % 20);
    const int t = (int)(idx / 640);
    const int col = hd < 16 ? hd * 64 : 1024 + (hd - 16) * 64;
    const float x1 = bf2f(pj[(long)t * 1536 + col + d]), x2 = bf2f(pj[(long)t * 1536 + col + d + 32]);
    float ss = x1 * x1 + x2 * x2;
#pragma unroll
    for (int o = 16; o; o >>= 1) ss += __shfl_xor(ss, o);
    const float rstd = rsqrtf(ss * (1.f / 64.f) + 1e-6f);
    const float* gn = hd < 16 ? P.in[23] : P.in[24];
    const float y1 = x1 * rstd * gn[d], y2 = x2 * rstd * gn[d + 32];
    const float2 cs = rope[(long)(t & (L - 1)) * 32 + d];
    float o1 = y1 * cs.x - y2 * cs.y, o2 = y1 * cs.y + y2 * cs.x;
    if (hd < 16) {
      qn[(long)t * 1024 + hd * 64 + d] = f2bf(o1 * 0.125f);
      qn[(long)t * 1024 + hd * 64 + d + 32] = f2bf(o2 * 0.125f);
    } else {
      kn[(long)t * 256 + (hd - 16) * 64 + d] = f2bf(o1);
      kn[(long)t * 256 + (hd - 16) * 64 + d + 32] = f2bf(o2);
    }
  }
}

constexpr int SLD = 324;
__device__ void phase_swa_att1(const Params& P, int slab) {
  const int L = Lof(slab), nqb = L / 64;
  const u16* qn = (const u16*)(WS(P) + O_QN);
  const u16* kn = (const u16*)(WS(P) + O_KN);
  u16* pb = (u16*)(WS(P) + O_PBUF);
  const float* sink = P.in[25];
  float* S = (float*)(smem + 40960);
  const int tid = TID();
  const int nitems = (SLAB / 64) * 16;
  for (int item = BID(); item < nitems; item += gridDim.x) {
    const int hq = item & 15, qbg = item >> 4;
    const int seq = qbg / nqb, qb = qbg % nqb;
    const int q0 = qb * 64;
    const long tok0 = (long)seq * L;
    const int hkv = hq >> 2;
    for (int kt = 0; kt < 5; ++kt) {
      const int kp0 = q0 - 128 + kt * 64;
      if (kp0 >= 0 && kp0 < L) {
        f32x4 acc[2][1] = {};
        gemm_acc<64, 64, true, true, true, 1>(acc, qn + (tok0 + q0) * 1024 + hq * 64, 1024, kn + (tok0 + kp0) * 256 + hkv * 64, 256, (u16*)smem);
        epi_each<64, 64, true>(acc, [&](int r, int c, f32x4 v) {
          f32x4 o;
#pragma unroll
          for (int j = 0; j < 4; ++j) {
            const int dlt = (q0 + r) - (kp0 + c + j);
            o[j] = (dlt <= 128 && dlt >= -128) ? v[j] : -1e30f;
          }
          *(f32x4*)(S + r * SLD + kt * 64 + c) = o;
        });
      } else {
        for (int i = tid; i < 4096; i += NT) S[(i >> 6) * SLD + kt * 64 + (i & 63)] = -1e30f;
      }
    }
    __syncthreads();
    {
      const int r = tid >> 3, sub = tid & 7;
      const float sk = sink[hq];
      float m = sk;
      for (int c = sub; c < 320; c += 8) m = fmaxf(m, S[r * SLD + c]);
      m = fmaxf(m, __shfl_xor(m, 1)); m = fmaxf(m, __shfl_xor(m, 2)); m = fmaxf(m, __shfl_xor(m, 4));
      float den = 0.f;
      for (int c = sub; c < 320; c += 8) { float e = __expf(S[r * SLD + c] - m); S[r * SLD + c] = e; den += e; }
      den += __shfl_xor(den, 1); den += __shfl_xor(den, 2); den += __shfl_xor(den, 4);
      den += __expf(sk - m);
      const float inv = 1.f / den;
      u16* prow = pb + ((long)item * 64 + r) * 320;
      for (int c = sub; c < 320; c += 8) prow[c] = f2bf(S[r * SLD + c] * inv);
    }
    __syncthreads();
  }
}

__device__ void phase_swa_att2(const Params& P, int slab) {
  const int L = Lof(slab), nqb = L / 64;
  const u16* pj = (const u16*)(WS(P) + O_PROJ);
  const u16* pb = (const u16*)(WS(P) + O_PBUF);
  u16* a2 = (u16*)(WS(P) + O_A2);
  const int nitems = (SLAB / 64) * 16;
  for (int item = BID(); item < nitems; item += gridDim.x) {
    const int hq = item & 15, qbg = item >> 4;
    const int seq = qbg / nqb, qb = qbg % nqb;
    const int q0 = qb * 64;
    const long tok0 = (long)seq * L;
    const int hkv = hq >> 2;
    f32x4 acc[2][1] = {};
    for (int kt = 0; kt < 5; ++kt) {
      const int kp0 = q0 - 128 + kt * 64;
      if (kp0 >= 0 && kp0 < L)
        gemm_acc<64, 64, true, false, true, 1>(acc, pb + (long)item * 64 * 320 + kt * 64, 320, pj + (tok0 + kp0) * 1536 + 1280 + hkv * 64, 1536, (u16*)smem);
    }
    u16* o = a2 + (tok0 + q0) * 1024 + hq * 64;
    epi_each<64, 64, true>(acc, [&](int r, int c, f32x4 v) { *(uint2*)(o + (long)r * 1024 + c) = make_uint2(pack2(v[0], v[1]), pack2(v[2], v[3])); });
  }
}


#define XB_TMO      128
#define XB_XCNT(j)  (256  + 64 * (j))
#define XB_XSUB(j)  (1280 + 64 * (j))
#define XB_XGEN(j)  (2304 + 64 * (j))
#define XB_TOP      3328
#define XB_TOPGEN   3392
#define XCD_BAR_WORDS 3456
#define XB_SPIN_CAP (1u << 18)
__device__ __forceinline__ unsigned xb_ld(unsigned* p)              { return __hip_atomic_load(p, __ATOMIC_RELAXED, __HIP_MEMORY_SCOPE_AGENT); }
__device__ __forceinline__ unsigned xb_add(unsigned* p, unsigned v) { return __hip_atomic_fetch_add(p, v, __ATOMIC_RELAXED, __HIP_MEMORY_SCOPE_AGENT); }
__device__ __forceinline__ unsigned xb_xcc_id() { return (unsigned)__builtin_amdgcn_s_getreg((3 << 11) | 20) & 0xFu; }
#define XB_SPIN(cond, bar) do { unsigned _sp = 0; while (cond) { __builtin_amdgcn_s_sleep(1); \
    if ((++_sp & 255u) == 0u) { if (xb_ld(&(bar)[XB_TMO])) break; if (_sp > XB_SPIN_CAP) { atomicAdd(&(bar)[XB_TMO], 1u); break; } } } } while (0)
struct XcdBarrier { unsigned* bar; unsigned x; volatile LDS_AS unsigned* st; };
__device__ __forceinline__ XcdBarrier xcd_barrier_post(unsigned* bar, volatile LDS_AS unsigned* st) {
    XcdBarrier b; b.bar = bar; b.x = xb_xcc_id(); b.st = st;
    if (threadIdx.x == 0) (void)xb_add(&bar[XB_XCNT(b.x)], 1u);
    return b;
}
__device__ __forceinline__ void xcd_barrier_complete(unsigned* bar, unsigned x, unsigned& nloc, unsigned& nx) {
    const unsigned G = gridDim.x * gridDim.y * gridDim.z;
    unsigned sum, cnt, mine, sp = 0u;
    for (;;) {
        sum = 0u; cnt = 0u; mine = 0u;
#pragma unroll
        for (unsigned j = 0; j < 16; ++j) { const unsigned c = xb_ld(&bar[XB_XCNT(j)]); sum += c; cnt += (c > 0u) ? 1u : 0u; mine = (j == x) ? c : mine; }
        if (sum == G) break;
        __builtin_amdgcn_s_sleep(1);
        if ((++sp & 255u) == 0u) { if (xb_ld(&bar[XB_TMO])) break; if (sp > XB_SPIN_CAP) { atomicAdd(&bar[XB_TMO], 1u); break; } }
    }
    nloc = mine > 0u ? mine : 1u; nx = cnt > 0u ? cnt : 1u;
}
__device__ __forceinline__ void xcd_barrier(const XcdBarrier& b) {
    asm volatile("s_waitcnt vmcnt(0)" ::: "memory");
    __syncthreads();
    if (threadIdx.x == 0) {
        unsigned* bar = b.bar;
        __builtin_amdgcn_s_waitcnt(0);
        unsigned nloc = b.st[0], nx = b.st[1];
        if (nloc == 0u) { xcd_barrier_complete(bar, b.x, nloc, nx); b.st[0] = nloc; b.st[1] = nx; }
        const unsigned old = xb_add(&bar[XB_XSUB(b.x)], 1u);
        const unsigned gen = old / nloc;
        if (old + 1u == (gen + 1u) * nloc) {
            __builtin_amdgcn_fence(__ATOMIC_RELEASE, "agent");
            asm volatile("s_waitcnt vmcnt(0)" ::: "memory");
            const unsigned og = xb_add(&bar[XB_TOP], 1u);
            const unsigned tg = og / nx;
            if (og + 1u == (tg + 1u) * nx) xb_add(&bar[XB_TOPGEN], 1u);
            else XB_SPIN(xb_ld(&bar[XB_TOPGEN]) == tg, bar);
            __builtin_amdgcn_fence(__ATOMIC_ACQUIRE, "agent");
            xb_add(&bar[XB_XGEN(b.x)], 1u);
            asm volatile("s_waitcnt vmcnt(0)" ::: "memory");
        } else {
            XB_SPIN(xb_ld(&bar[XB_XGEN(b.x)]) == gen, bar);
            __builtin_amdgcn_fence(__ATOMIC_ACQUIRE, "agent");
            asm volatile("s_waitcnt vmcnt(0)" ::: "memory");
        }
    }
    __syncthreads();
}

__device__ __forceinline__ int nsteps_of(int kind) { return (kind & 1) ? 12 : 10; }

__device__ void layer_step(const Params& P, int layer, int slab, int step) {
  const int kind = layer;
  const int nmix = nsteps_of(kind) - 4;
  if (step == 0) { REP(4) phase_norm(P, layer, slab, 0); return; }
  if (step >= nmix) {
    const int f = step - nmix;
    if (f == 0) { REP(4) phase_norm(P, layer, slab, 1); }
    else if (f == 1) { REP(0) phase_ffn_gate(P, layer); }
    else if (f == 2) { REP(0) phase_ffn_val(P, layer, slab); }
    else phase_resid(P, layer, slab, (const u16*)(WS(P) + O_ACT), DFF, O_WFD + (size_t)layer * SZW(1024, 2816), 5 * D);
    return;
  }
  if (kind == 0) {
    if (step == 1) { REP(0) phase_proj(P, O_WHYIN, 3072); }
    else if (step == 2) { REP(3) phase_hy_conv(P, slab); }
    else if (step == 3) { if ((PROBE_MASK >> 7) & 1) phase_hy_fft(P, slab, true); phase_hy_fft(P, slab); }
    else if (step == 4) { REP(3) phase_hy_tr(P, slab); }
    else phase_resid(P, layer, slab, (const u16*)(WS(P) + O_A2), 1024, O_WHYOUT, 2 * D);
  } else if (kind == 1) {
    if (step == 1) { REP(0) phase_proj(P, O_WRETIN, 6144); }
    else if (step == 2) { REP(1) REP(9) phase_ret_prep(P, slab); }
    else if (step == 3) { REP(1) REP(11) phase_rec_su<128>(P, 1); }
    else if (step == 4) { if ((PROBE_MASK >> 6) & 1) phase_rec_scan(P, 1, slab, true); phase_rec_scan(P, 1, slab); }
    else if (step == 5) { REP(1) REP(12) phase_rec_out<128>(P, 1); }
    else if (step == 6) { REP(1) REP(9) phase_rec_ng(P, 1); }
    else phase_resid(P, layer, slab, (const u16*)(WS(P) + O_A2), 2048, O_WRETOUT, 2 * D);
  } else if (kind == 2) {
    if (step == 1) { REP(0) phase_proj(P, O_WSWAIN, 1536); }
    else if (step == 2) { REP(2) REP(14) phase_swa_prep(P, slab); }
    else if (step == 3) { REP(2) REP(15) phase_swa_att1(P, slab); }
    else if (step == 4) { REP(2) REP(16) phase_swa_att2(P, slab); }
    else phase_resid(P, layer, slab, (const u16*)(WS(P) + O_A2), 1024, O_WSWAOUT, 2 * D);
  } else {
    if (step == 1) { REP(0) phase_proj(P, O_WHGIN, 5120); }
    else if (step == 2) { REP(1) REP(9) phase_hg_prep(P); }
    else if (step == 3) { REP(1) REP(11) phase_rec_su<64>(P, 3); }
    else if (step == 4) { if ((PROBE_MASK >> 6) & 1) phase_rec_scan(P, 3, slab, true); phase_rec_scan(P, 3, slab); }
    else if (step == 5) { REP(1) REP(12) phase_rec_out<64>(P, 3); }
    else if (step == 6) { REP(1) REP(9) phase_rec_ng(P, 3); }
    else phase_resid(P, layer, slab, (const u16*)(WS(P) + O_A2), 1024, O_WHGOUT, 2 * D);
  }
}

__global__ void __launch_bounds__(NT) fwd_megakernel(Params P) {
  cg::grid_group grid = cg::this_grid();
  __shared__ uint4 xb_words;
  if (threadIdx.x == 0) xb_words = make_uint4(0u, 0u, 0u, 0u);
  __syncthreads();
  XcdBarrier xb = xcd_barrier_post((unsigned*)(P.ws + O_BAR), (volatile LDS_AS unsigned*)&xb_words);
  for (int pid = P.p0; pid < P.p1; ++pid) {
    if (pid == 0) { REP(5) phase_pre0(P); }
    else if (pid == 1) { REP(5) phase_pre1(P); }
    else {
      int q = pid - 2, layer = 0;
      while (q >= 5 * nsteps_of(layer)) { q -= 5 * nsteps_of(layer); ++layer; }
      const int ns = nsteps_of(layer);
      layer_step(P, layer, q / ns, q % ns);
    }
    if (pid + 1 < P.p1) {
      if (pid == 0) grid.sync();
      else xcd_barrier(xb);
      if ((PROBE_MASK >> 8) & 1) xcd_barrier(xb);
    }
  }
}

extern "C" void kernel_launch(void* const* d_in, const int* in_sizes, int n_in, void* d_out, int out_size, void* d_ws,
                              size_t ws_size, hipStream_t stream) {
  static int grid_blocks = 0;
  if (!grid_blocks) {
    int dev = 0, cus = 0, per_cu = 0;
    (void)hipGetDevice(&dev);
    (void)hipDeviceGetAttribute(&cus, hipDeviceAttributeMultiprocessorCount, dev);
    (void)hipFuncSetAttribute((const void*)fwd_megakernel, hipFuncAttributeMaxDynamicSharedMemorySize, LDSB);
    (void)hipOccupancyMaxActiveBlocksPerMultiprocessor(&per_cu, (const void*)fwd_megakernel, NT, LDSB);
    if (per_cu < 1) per_cu = 1;
    if (per_cu > 1) per_cu = 1;
    grid_blocks = cus * per_cu;
    if (ws_size < WS_END) fprintf(stderr, "kernel_launch: workspace too small: %zu < %zu\n", ws_size, (size_t)WS_END);
  }
  Params p;
  memset(&p, 0, sizeof(p));
  for (int i = 0; i < 36; ++i) p.in[i] = (const float*)d_in[i];
  p.out = (float*)d_out;
  p.ws = (unsigned char*)d_ws;
  (void)hipMemsetAsync((unsigned char*)d_ws + O_BAR, 0, XCD_BAR_WORDS * 4, stream);
#if ONE_LAUNCH
  p.p0 = 0; p.p1 = NPHASES;
  void* args[] = {&p};
  hipError_t e = hipLaunchCooperativeKernel((const void*)fwd_megakernel, dim3(grid_blocks), dim3(NT), args, LDSB, stream);
  if (e != hipSuccess) fprintf(stderr, "cooperative launch failed: %s (grid %d)\n", hipGetErrorString(e), grid_blocks);
#else
  for (int ph = 0; ph < NPHASES; ++ph) {
    p.p0 = ph; p.p1 = ph + 1;
    hipLaunchKernelGGL(fwd_megakernel, dim3(grid_blocks), dim3(NT), LDSB, stream, p);
  }
#endif
}
```

```cpp
#include <hip/hip_runtime.h>
#include <hip/hip_cooperative_groups.h>
#include <cstdio>
#include <cstdint>
#include <cstring>
namespace cg = cooperative_groups;

typedef unsigned short u16;
typedef __attribute__((ext_vector_type(8))) short bf16x8;
typedef __attribute__((ext_vector_type(4))) float f32x4;

#define NT 512
#ifndef ONE_LAUNCH
#define ONE_LAUNCH 1
#endif
#ifndef PROBE_MASK
#define PROBE_MASK 0
#endif
#define REP(cls) for (int rep_##cls = 0; rep_##cls < (((PROBE_MASK >> (cls)) & 1) ? 2 : 1); ++rep_##cls)

constexpr int D = 1024, SLAB = 16384, DFF = 2816;
constexpr int LDSB = 139264;
constexpr int FSLAB = 40960, NTOK = 81920;
constexpr int NPHASES = 2 + 5 * (6 + 8 + 6 + 8) + 4 * 7;

constexpr size_t SZW(size_t n, size_t k) { return n * k * 2; }
constexpr size_t O_WHYIN = 0;
constexpr size_t O_WHYOUT = O_WHYIN + SZW(3072, 1024);
constexpr size_t O_WRETIN = O_WHYOUT + SZW(1024, 1024);
constexpr size_t O_WRETOUT = O_WRETIN + SZW(6144, 1024);
constexpr size_t O_WSWAIN = O_WRETOUT + SZW(1024, 2048);
constexpr size_t O_WSWAOUT = O_WSWAIN + SZW(1536, 1024);
constexpr size_t O_WHGIN = O_WSWAOUT + SZW(1024, 1024);
constexpr size_t O_WHGOUT = O_WHGIN + SZW(5120, 1024);
constexpr size_t O_WFG = O_WHGOUT + SZW(1024, 1024);
constexpr size_t O_WFV = O_WFG + 4 * SZW(2816, 1024);
constexpr size_t O_WFD = O_WFV + 4 * SZW(2816, 1024);
constexpr size_t O_MOD = O_WFD + 4 * SZW(1024, 2816);
constexpr size_t O_TW = O_MOD + (size_t)4 * 16 * 6144 * 4;
constexpr size_t O_HIDS = O_TW + 8192 * 8;
constexpr size_t O_HIDP = O_HIDS + (size_t)8192 * 64 * 4;
constexpr size_t O_ROPER = O_HIDP + (size_t)2048 * 64 * 4;
constexpr size_t O_ROPES = O_ROPER + (size_t)8192 * 128 * 8;
constexpr size_t O_PROJ = O_ROPES + (size_t)8192 * 32 * 8;
constexpr size_t O_HBUF = O_PROJ + (size_t)SLAB * 6144 * 2;
constexpr size_t O_A2 = O_HBUF + (size_t)SLAB * 1024 * 2;
constexpr size_t O_C = O_A2 + (size_t)SLAB * 2048 * 2;
constexpr size_t O_FHBUF = O_PROJ;
constexpr size_t O_FGBUF = O_FHBUF + (size_t)FSLAB * 1024 * 2;
constexpr size_t O_FACT = O_FGBUF + (size_t)FSLAB * DFF * 2;
constexpr size_t END_F = O_FACT + (size_t)NTOK * DFF * 2;
constexpr size_t O_MODP = O_C;
constexpr size_t O_BAR = ((size_t)1 << 30) - 16384;
constexpr size_t O_HSPS = O_BAR - (size_t)1024 * 16384 * 8 - (size_t)1024 * 4096 * 8;
constexpr size_t O_HSPP = O_HSPS + (size_t)1024 * 16384 * 8;
constexpr size_t O_UT = O_C;
constexpr size_t O_X0C = O_UT + (size_t)SLAB * 1024 * 4;
constexpr size_t END_HY = O_X0C + (size_t)SLAB * 1024 * 2;
static_assert(END_F <= O_HSPS && END_HY <= O_HSPS, "layer-0 buffers overlap the filter spectra");
constexpr size_t SZP = (size_t)SLAB * 1024 * 2;
constexpr size_t O_QDF = O_C, O_QDB = O_QDF + SZP, O_KIF = O_QDB + SZP, O_KIB = O_KIF + SZP, O_KEF = O_KIB + SZP, O_KEB = O_KEF + SZP;
constexpr size_t O_DLF = O_KEB + SZP;
constexpr size_t O_DLB = O_DLF + (size_t)256 * 1024 * 4;
constexpr size_t O_SC = O_DLB + (size_t)256 * 1024 * 4;
constexpr size_t O_STF = O_SC + (size_t)SLAB * 512 * 2;
constexpr size_t O_STB = O_STF + (size_t)134217728;
constexpr size_t O_OBUF = O_STB + (size_t)134217728;
constexpr size_t END_REC = O_OBUF + (size_t)SLAB * 2048 * 4;
constexpr size_t O_QN = O_C;
constexpr size_t O_KN = O_QN + SZP;
constexpr size_t O_PBUF = O_KN + (size_t)SLAB * 256 * 2;
constexpr size_t END_SWA = O_PBUF + (size_t)SLAB * 16 * 320 * 2;
constexpr size_t WS_END = END_REC > END_HY ? (END_REC > END_SWA ? END_REC : END_SWA) : (END_HY > END_SWA ? END_HY : END_SWA);
static_assert(WS_END <= O_BAR, "workspace exceeds 1 GiB");

struct Params {
  const float* in[36];
  float* out;
  unsigned char* ws;
  int p0, p1;
};

extern __shared__ __attribute__((aligned(16))) unsigned char smem[];

__device__ __forceinline__ int TID() { int t = threadIdx.x; asm volatile("" : "+v"(t)); return t; }
__device__ __forceinline__ int BID() { int b = blockIdx.x; asm volatile("" : "+s"(b)); return b; }
__device__ __forceinline__ long ZOFF() { long z = 0; asm volatile("" : "+s"(z)); return z; }
__device__ __forceinline__ unsigned char* WS(const Params& P) { return P.ws + ZOFF(); }
__device__ __forceinline__ float* OUTP(const Params& P) { return P.out + ZOFF(); }

namespace pg8 {
#define PG8_LAS __attribute__((address_space(3)))
typedef unsigned short bf16_t;
typedef short bf16x8 __attribute__((ext_vector_type(8)));
typedef float f32x4 __attribute__((ext_vector_type(4)));
typedef unsigned u32x4 __attribute__((ext_vector_type(4)));
constexpr int BM = 256, BK = 64, HALF = 128, HTB = HALF * BK * 2  , STAGE_BYTES = 8 * HTB, NXCD = 8, WGM = 8;

__host__ __device__ __forceinline__ int lds_byte(int r, int c) { const int st = (r >> 4) * 2 + (c >> 5), rr = r & 15, cc = c & 31, ob = rr * 64 + cc * 2; return st * 1024 + (ob ^ (((ob >> 9) & 1) << 5)); }
__host__ __device__ __forceinline__ void stage_rc(int b, int& R, int& C) { const int st = b / 1024, sb = b % 1024, swz = sb ^ (((sb >> 9) & 1) << 5); R = (st >> 1) * 16 + swz / 64; C = (st & 1) * 32 + (swz % 64) / 2; }
__host__ __device__ __forceinline__ int perm32(int rho) { const int n = rho >> 4, i = rho & 15; return 8 * (i >> 2) + 4 * n + (i & 3); }

struct Unit { int pm, pn; };
struct Gemm { const bf16_t* A; const bf16_t* Bt; int M, N, K; };

struct StaticOrder {
    int nM, nN, nwg, G, c;
    __host__ __device__ void init(int M, int N, int G_, int c_) { nM = M / BM; nN = N / BM; nwg = nM * nN; G = G_; c = c_; }
    __host__ __device__ bool next(int i, Unit& u) const {
        const long L = (long)i * G + c; if (L >= nwg) return false;
        int wgid = (int)L; { const int q = nwg / NXCD, r = nwg % NXCD, xcd = wgid % NXCD, off = wgid / NXCD; wgid = (xcd < r ? xcd * (q + 1) : r * (q + 1) + (xcd - r) * q) + off; }
        const int nig = WGM * nN, gid = wgid / nig, fm = gid * WGM, gsz = (nM - fm) < WGM ? (nM - fm) : WGM;
        u.pm = fm + ((wgid % nig) % gsz); u.pn = (wgid % nig) / gsz; return true;
    }
    __device__ __forceinline__ void a_ready(const Unit&) const {}
    __device__ __forceinline__ void done(const Unit&) const {}
};

template <class Epi, class Sched, bool STAMP = false>
__device__ __forceinline__ void gemm_phase(PG8_LAS unsigned char* lds, const Gemm g, const Sched& S, const Epi& E, unsigned long long* stamps) {
    const int tid = TID(), wid = __builtin_amdgcn_readfirstlane(tid >> 6), lane = tid & 63, wr = wid >> 2, wc = wid & 3, fr = lane & 15, fq = lane >> 4;
    const int K = g.K, nt = K / BK;
    int ts_lo = 0, ts_hi = 0, nts = 0; const unsigned long long rt_entry = STAMP ? (unsigned long long)wall_clock64() : 0ull;
#define PG8_STAMP() do { if (STAMP && wid == 0 && nts < 64) { const unsigned long long _c = (unsigned long long)clock64(); \
        ts_lo = (lane == nts) ? (int)(unsigned)_c : ts_lo; ts_hi = (lane == nts) ? (int)(unsigned)(_c >> 32) : ts_hi; ++nts; } } while (0)
    PG8_STAMP();
    unsigned voffA[2], voffB[2];
#pragma unroll
    for (int i = 0; i < 2; ++i) { int R, C; stage_rc(tid * 16 + i * 8192, R, C); const int Rb = Epi::PERM ? ((R & ~31) + perm32(R & 31)) : R;
        voffA[i] = (unsigned)(R * K + C) * 2u; voffB[i] = (unsigned)(Rb * K + C) * 2u; }
    const size_t kstep = (size_t)(BK * 2);
    const size_t hstep = (size_t)HALF * K * 2;
    const size_t tstep = 2 * hstep;
    const unsigned ldsw = (unsigned)wid * 1024u;
    const int aoff = lds_byte(wr * 64 + fr, fq * 8), boff = lds_byte(wc * 32 + fr, fq * 8);
#define PG8_SA(b, h) (((b) * 2 + (h)) * HTB)
#define PG8_SB(b, h) ((4 + (b) * 2 + (h)) * HTB)
#define PG8_STAGE(bufoff, gbase, voff) do { _Pragma("unroll") for (int _i = 0; _i < 2; ++_i) \
        __builtin_amdgcn_global_load_lds((const unsigned*)((const char*)(gbase) + (voff)[_i]), (PG8_LAS unsigned*)(lds + (bufoff) + ldsw + _i * 8192), 16, 0, 0); } while (0)
#define PG8_LDA(dst, b, h) do { _Pragma("unroll") for (int m = 0; m < 4; ++m) _Pragma("unroll") for (int k = 0; k < 2; ++k) dst[m][k] = *(const PG8_LAS bf16x8*)(lds + PG8_SA(b, h) + aoff + m * 2048 + k * 1024); } while (0)
#define PG8_LDB(dst, b, h) do { _Pragma("unroll") for (int n = 0; n < 2; ++n) _Pragma("unroll") for (int k = 0; k < 2; ++k) dst[n][k] = *(const PG8_LAS bf16x8*)(lds + PG8_SB(b, h) + boff + n * 2048 + k * 1024); } while (0)
#define PG8_MMA(ai, bj, At, Bt) do { __builtin_amdgcn_s_setprio(1); _Pragma("unroll") for (int m = 0; m < 4; ++m) _Pragma("unroll") for (int n = 0; n < 2; ++n) _Pragma("unroll") for (int k = 0; k < 2; ++k) \
        acc[ai][bj][m][n] = __builtin_amdgcn_mfma_f32_16x16x32_bf16(Bt[n][k], At[m][k], acc[ai][bj][m][n], 0, 0, 0); __builtin_amdgcn_s_setprio(0); } while (0)
#define PG8_WAIT_V(n) asm volatile("s_waitcnt vmcnt(" #n ")" ::: "memory")
#define PG8_WAIT_L(n) asm volatile("s_waitcnt lgkmcnt(" #n ")" ::: "memory")
#define PG8_BAR __builtin_amdgcn_s_barrier()
#define PG8_SCHED __builtin_amdgcn_sched_barrier(0)
    Unit cur, nxt; int ui = 0;
    if (!S.next(0, cur)) return;
    f32x4 acc[2][2][4][2];
#pragma unroll
    for (int a = 0; a < 2; ++a)
#pragma unroll
        for (int b = 0; b < 2; ++b)
#pragma unroll
            for (int m = 0; m < 4; ++m)
#pragma unroll
                for (int n = 0; n < 2; ++n) acc[a][b][m][n] = (f32x4){0.f, 0.f, 0.f, 0.f};
    bf16x8 At[4][2], B0[2][2], B1[2][2];
    const char* cA = (const char*)g.A + (size_t)cur.pm * tstep; const char* cB = (const char*)g.Bt + (size_t)cur.pn * tstep;
    S.a_ready(cur);
    PG8_STAGE(PG8_SB(0, 0), cB, voffB); PG8_STAGE(PG8_SA(0, 0), cA, voffA); PG8_STAGE(PG8_SB(0, 1), cB + hstep, voffB); PG8_STAGE(PG8_SA(0, 1), cA + hstep, voffA);
    if (wr == 1) PG8_BAR;
    PG8_WAIT_V(4); PG8_BAR;
    PG8_STAGE(PG8_SB(1, 0), cB + kstep, voffB); PG8_STAGE(PG8_SA(1, 0), cA + kstep, voffA); PG8_STAGE(PG8_SB(1, 1), cB + hstep + kstep, voffB);
    PG8_WAIT_V(6); PG8_BAR;
    PG8_STAMP();
    for (;;) {
        const bool has_next = S.next(ui + 1, nxt);
        const char* nA = has_next ? (const char*)g.A + (size_t)nxt.pm * tstep : cA; const char* nB = has_next ? (const char*)g.Bt + (size_t)nxt.pn * tstep : cB;
        for (int t = 0; t < nt; t += 2) {
            const bool last = (t == nt - 2);
            const char* a1 = cA + (size_t)(t + 1) * kstep;
            const char* a2 = last ? nA : cA + (size_t)(t + 2) * kstep; const char* b2 = last ? nB : cB + (size_t)(t + 2) * kstep;
            const char* a3 = a2 + kstep; const char* b3 = b2 + kstep;
            if (last && has_next) S.a_ready(nxt);
            PG8_LDB(B0, 0, 0); PG8_SCHED; PG8_LDA(At, 0, 0); PG8_STAGE(PG8_SA(1, 1), a1 + hstep, voffA);
            PG8_WAIT_L(8); PG8_BAR; PG8_WAIT_L(0); PG8_MMA(0, 0, At, B0); PG8_BAR; PG8_SCHED;
            PG8_LDB(B1, 0, 1); PG8_STAGE(PG8_SB(0, 0), b2, voffB);
            PG8_BAR; PG8_WAIT_L(0); PG8_MMA(0, 1, At, B1); PG8_BAR;
            PG8_LDA(At, 0, 1); PG8_STAGE(PG8_SA(0, 0), a2, voffA);
            PG8_BAR; PG8_WAIT_L(0); PG8_MMA(1, 0, At, B0); PG8_BAR; PG8_SCHED;
            PG8_STAGE(PG8_SB(0, 1), b2 + hstep, voffB);
            PG8_WAIT_V(6); PG8_BAR; PG8_MMA(1, 1, At, B1); PG8_BAR;
            PG8_LDB(B0, 1, 0); PG8_SCHED; PG8_LDA(At, 1, 0); PG8_STAGE(PG8_SA(0, 1), a2 + hstep, voffA);
            PG8_WAIT_L(8); PG8_BAR; PG8_WAIT_L(0); PG8_MMA(0, 0, At, B0); PG8_BAR; PG8_SCHED;
            PG8_LDB(B1, 1, 1); PG8_STAGE(PG8_SB(1, 0), b3, voffB);
            PG8_BAR; PG8_WAIT_L(0); PG8_MMA(0, 1, At, B1); PG8_BAR;
            PG8_LDA(At, 1, 1); PG8_STAGE(PG8_SA(1, 0), a3, voffA);
            PG8_BAR; PG8_WAIT_L(0); PG8_MMA(1, 0, At, B0); PG8_BAR; PG8_SCHED;
            PG8_STAGE(PG8_SB(1, 1), b3 + hstep, voffB);
            PG8_WAIT_V(6); PG8_BAR; PG8_MMA(1, 1, At, B1); PG8_BAR;
        }
        PG8_STAMP();
        if constexpr (!Epi::AFTER_DRAIN) { E(acc, cur, wr, wc, fr, fq); S.done(cur); }
        PG8_STAMP();
        if (!has_next) break;
#pragma unroll
        for (int a = 0; a < 2; ++a)
#pragma unroll
            for (int b = 0; b < 2; ++b)
#pragma unroll
                for (int m = 0; m < 4; ++m)
#pragma unroll
                    for (int n = 0; n < 2; ++n) acc[a][b][m][n] = (f32x4){0.f, 0.f, 0.f, 0.f};
        cur = nxt; cA = nA; cB = nB; ++ui;
    }
    PG8_WAIT_V(0);
    if (wr == 0) PG8_BAR;
    PG8_BAR;
    if constexpr (Epi::AFTER_DRAIN) { E.fused(acc, cur, wr, wc, fr, fq, lds, wid, lane); S.done(cur); }
    PG8_STAMP();
    if (STAMP && wid == 0) { stamps[lane] = lane < nts ? (((unsigned long long)(unsigned)ts_hi << 32) | (unsigned)ts_lo) : 0ull;
        if (lane == 62) stamps[62] = rt_entry; if (lane == 63) stamps[63] = (unsigned long long)wall_clock64(); }
#undef PG8_STAMP
#undef PG8_SA
#undef PG8_SB
#undef PG8_STAGE
#undef PG8_LDA
#undef PG8_LDB
#undef PG8_MMA
#undef PG8_WAIT_V
#undef PG8_WAIT_L
#undef PG8_BAR
#undef PG8_SCHED
}
}


__device__ __forceinline__ u16 f2bf(float f) {
  unsigned u = __float_as_uint(f);
  u += 0x7fffu + ((u >> 16) & 1u);
  return (u16)(u >> 16);
}
__device__ __forceinline__ float bf2f(u16 h) { return __uint_as_float(((unsigned)h) << 16); }
__device__ __forceinline__ unsigned pack2(float a, float b) { return (unsigned)f2bf(a) | ((unsigned)f2bf(b) << 16); }
__device__ __forceinline__ float silu_f(float x) { return x / (1.f + __expf(-x)); }
__device__ __forceinline__ float sigm(float x) { return 1.f / (1.f + __expf(-x)); }
__device__ __forceinline__ float wave_sum(float v) {
#pragma unroll
  for (int o = 32; o; o >>= 1) v += __shfl_xor(v, o);
  return v;
}
__device__ __forceinline__ const float* xin_of(const Params& P, int slab) { return slab == 0 ? P.in[0] : P.in[1] + (long)(slab - 1) * SLAB * D; }
__device__ __forceinline__ int Lof(int slab) { return slab == 0 ? 2048 : 8192; }
__device__ __forceinline__ int gb_row(int gr) { return gr < 16384 ? (gr >> 11) : (8 + ((gr - 16384) >> 13)); }
__device__ __forceinline__ int gb_of(int slab, int r) { return slab == 0 ? (r >> 11) : (8 + (slab - 1) * 2 + (r >> 13)); }

typedef short v4s __attribute__((ext_vector_type(4)));
#define LBAR() asm volatile("s_waitcnt lgkmcnt(0)\n\ts_barrier" ::: "memory")
#define LDS_AS __attribute__((address_space(3)))
template <int R, bool KC>
__device__ __forceinline__ uint4 ld_chunk(const u16* __restrict__ base, long ld, int k0, int c) {
  if (KC) {
    const int r = c >> 3, kc = c & 7;
    return *(const uint4*)(base + (long)r * ld + k0 + kc * 8);
  } else {
    const int k = c / (R / 8), mc = c % (R / 8);
    return *(const uint4*)(base + (long)(k0 + k) * ld + mc * 8);
  }
}
template <int R, bool KC>
__device__ __forceinline__ void st_chunk(u16* s, uint4 v, int c) {
  if (KC) {
    const int r = c >> 3, kc = c & 7;
    *(uint4*)(s + r * 72 + kc * 8) = v;
  } else {
    const int k = c / (R / 8), mc = c % (R / 8);
    *(uint4*)(s + k * (R + 8) + mc * 8) = v;
  }
}
template <int R, bool KC>
__device__ __forceinline__ bf16x8 ld_frag(const u16* s, int x0, int ks, int fr, int fq) {
  if (KC) {
    return *(const bf16x8*)(s + (x0 + fr) * 72 + ks * 32 + fq * 8);
  } else {
    const int q4 = fr >> 2, p4 = fr & 3;
    const u16* p = s + (ks * 32 + 8 * fq + q4) * (R + 8) + x0 + 4 * p4;
    v4s lo = __builtin_amdgcn_ds_read_tr16_b64_v4i16((LDS_AS v4s*)p);
    v4s hi = __builtin_amdgcn_ds_read_tr16_b64_v4i16((LDS_AS v4s*)(p + 4 * (R + 8)));
    bf16x8 r;
    r[0] = lo[0]; r[1] = lo[1]; r[2] = lo[2]; r[3] = lo[3]; r[4] = hi[0]; r[5] = hi[1]; r[6] = hi[2]; r[7] = hi[3];
    return r;
  }
}

template <int TM, int TN, bool AKC, bool BKC, bool TR, int KT>
__device__ __forceinline__ void gemm_acc(f32x4 (&acc)[TM / 32][TN / 64], const u16* __restrict__ A, long lda,
                                         const u16* __restrict__ B, long ldb, u16* sm) {
  u16* As = sm;
  u16* Bs = sm + 9216;
  const int tid = TID(), lane = tid & 63, wid = tid >> 6;
  const int wm = wid >> 2, wn = wid & 3, fr = lane & 15, fq = lane >> 4;
  constexpr int MI = TM / 32, NI = TN / 64;
  uint4 ra0[KT], ra1[KT], rb0[KT], rb1[KT];
#pragma unroll
  for (int kt = 0; kt < KT; ++kt) {
    ra0[kt] = ld_chunk<TM, AKC>(A, lda, kt * 64, tid);
    ra1[kt] = ra0[kt];
    if (TM == 128) ra1[kt] = ld_chunk<TM, AKC>(A, lda, kt * 64, tid + NT);
    rb0[kt] = ld_chunk<TN, BKC>(B, ldb, kt * 64, tid);
    rb1[kt] = rb0[kt];
    if (TN == 128) rb1[kt] = ld_chunk<TN, BKC>(B, ldb, kt * 64, tid + NT);
  }
#pragma unroll
  for (int kt = 0; kt < KT; ++kt) {
    __syncthreads();
    st_chunk<TM, AKC>(As, ra0[kt], tid);
    if (TM == 128) st_chunk<TM, AKC>(As, ra1[kt], tid + NT);
    st_chunk<TN, BKC>(Bs, rb0[kt], tid);
    if (TN == 128) st_chunk<TN, BKC>(Bs, rb1[kt], tid + NT);
    __syncthreads();
#pragma unroll
    for (int ks = 0; ks < 2; ++ks) {
      bf16x8 af[MI], bfr[NI];
#pragma unroll
      for (int mi = 0; mi < MI; ++mi) af[mi] = ld_frag<TM, AKC>(As, wm * (TM / 2) + mi * 16, ks, fr, fq);
#pragma unroll
      for (int ni = 0; ni < NI; ++ni) bfr[ni] = ld_frag<TN, BKC>(Bs, wn * (TN / 4) + ni * 16, ks, fr, fq);
#pragma unroll
      for (int mi = 0; mi < MI; ++mi)
#pragma unroll
        for (int ni = 0; ni < NI; ++ni)
          acc[mi][ni] = TR ? __builtin_amdgcn_mfma_f32_16x16x32_bf16(bfr[ni], af[mi], acc[mi][ni], 0, 0, 0)
                           : __builtin_amdgcn_mfma_f32_16x16x32_bf16(af[mi], bfr[ni], acc[mi][ni], 0, 0, 0);
    }
  }
  __syncthreads();
}

template <int KT> struct Tiles { uint4 a0[KT], a1[KT], b0[KT], b1[KT]; };
template <int TM, int TN, bool AKC, bool BKC, int KT>
__device__ __forceinline__ void tiles_issue(Tiles<KT>& t, const u16* __restrict__ A, long lda, const u16* __restrict__ B, long ldb) {
  const int tid = TID();
#pragma unroll
  for (int kt = 0; kt < KT; ++kt) {
    t.a0[kt] = ld_chunk<TM, AKC>(A, lda, kt * 64, tid);
    t.a1[kt] = t.a0[kt];
    if (TM == 128) t.a1[kt] = ld_chunk<TM, AKC>(A, lda, kt * 64, tid + NT);
    t.b0[kt] = ld_chunk<TN, BKC>(B, ldb, kt * 64, tid);
    t.b1[kt] = t.b0[kt];
    if (TN == 128) t.b1[kt] = ld_chunk<TN, BKC>(B, ldb, kt * 64, tid + NT);
  }
}
template <int TM, int TN, bool AKC, bool BKC, bool TR, int KT>
__device__ __forceinline__ void gemm_run(f32x4 (&acc)[TM / 32][TN / 64], const Tiles<KT>& t, u16* sm) {
  u16* As = sm;
  u16* Bs = sm + 9216;
  const int tid = TID(), lane = tid & 63, wid = tid >> 6;
  const int wm = wid >> 2, wn = wid & 3, fr = lane & 15, fq = lane >> 4;
  constexpr int MI = TM / 32, NI = TN / 64;
#pragma unroll
  for (int kt = 0; kt < KT; ++kt) {
    __syncthreads();
    st_chunk<TM, AKC>(As, t.a0[kt], tid);
    if (TM == 128) st_chunk<TM, AKC>(As, t.a1[kt], tid + NT);
    st_chunk<TN, BKC>(Bs, t.b0[kt], tid);
    if (TN == 128) st_chunk<TN, BKC>(Bs, t.b1[kt], tid + NT);
    __syncthreads();
#pragma unroll
    for (int ks = 0; ks < 2; ++ks) {
      bf16x8 af[MI], bfr[NI];
#pragma unroll
      for (int mi = 0; mi < MI; ++mi) af[mi] = ld_frag<TM, AKC>(As, wm * (TM / 2) + mi * 16, ks, fr, fq);
#pragma unroll
      for (int ni = 0; ni < NI; ++ni) bfr[ni] = ld_frag<TN, BKC>(Bs, wn * (TN / 4) + ni * 16, ks, fr, fq);
#pragma unroll
      for (int mi = 0; mi < MI; ++mi)
#pragma unroll
        for (int ni = 0; ni < NI; ++ni)
          acc[mi][ni] = TR ? __builtin_amdgcn_mfma_f32_16x16x32_bf16(bfr[ni], af[mi], acc[mi][ni], 0, 0, 0)
                           : __builtin_amdgcn_mfma_f32_16x16x32_bf16(af[mi], bfr[ni], acc[mi][ni], 0, 0, 0);
    }
  }
}

template <int TM, int TN, bool TR, class F>
__device__ __forceinline__ void epi_each(f32x4 (&acc)[TM / 32][TN / 64], F f) {
  const int tid = TID(), lane = tid & 63, wid = tid >> 6;
  const int wm = wid >> 2, wn = wid & 3, fr = lane & 15, fq = lane >> 4;
#pragma unroll
  for (int mi = 0; mi < TM / 32; ++mi)
#pragma unroll
    for (int ni = 0; ni < TN / 64; ++ni) {
      const int r0 = wm * (TM / 2) + mi * 16, c0 = wn * (TN / 4) + ni * 16;
      if (TR) f(r0 + fr, c0 + fq * 4, acc[mi][ni]);
      else f(r0 + fq * 4, c0 + fr, acc[mi][ni]);
    }
}

struct EpiStoreBf16 {
  static constexpr bool PERM = false, AFTER_DRAIN = false;
  u16* O; int ldc;
  __device__ __forceinline__ void operator()(const f32x4 (&acc)[2][2][4][2], const pg8::Unit& u, int wr, int wc, int fr, int fq) const {
    const int row0 = u.pm * 256 + wr * 64 + fr, col0 = u.pn * 256 + wc * 32 + 4 * fq;
#pragma unroll
    for (int ai = 0; ai < 2; ++ai)
#pragma unroll
      for (int m = 0; m < 4; ++m) {
        u16* rowp = O + (size_t)(row0 + ai * 128 + m * 16) * ldc + col0;
#pragma unroll
        for (int bj = 0; bj < 2; ++bj)
#pragma unroll
          for (int n = 0; n < 2; ++n) {
            const f32x4 v = acc[ai][bj][m][n];
            *(uint2*)(rowp + bj * 128 + n * 16) = make_uint2(pack2(v[0], v[1]), pack2(v[2], v[3]));
          }
      }
  }
};
struct EpiResid {
  static constexpr bool PERM = false, AFTER_DRAIN = false;
  float* X; const float* XS; const float* mod; int goff; int grow0;
  __device__ __forceinline__ void operator()(const f32x4 (&acc)[2][2][4][2], const pg8::Unit& u, int wr, int wc, int fr, int fq) const {
    const int row0 = u.pm * 256 + wr * 64 + fr, col0 = u.pn * 256 + wc * 32 + 4 * fq;
    const float* g = mod + (size_t)gb_row(grow0 + u.pm * 256) * 6144 + goff + col0;
    f32x4 gv[2][2];
#pragma unroll
    for (int bj = 0; bj < 2; ++bj)
#pragma unroll
      for (int n = 0; n < 2; ++n) gv[bj][n] = *(const f32x4*)(g + bj * 128 + n * 16);
#pragma unroll
    for (int am = 0; am < 4; ++am) {
      f32x4 xv[2][2][2];
#pragma unroll
      for (int mm = 0; mm < 2; ++mm)
#pragma unroll
        for (int bj = 0; bj < 2; ++bj)
#pragma unroll
          for (int n = 0; n < 2; ++n) xv[mm][bj][n] = *(const f32x4*)(XS + (size_t)(row0 + (am >> 1) * 128 + ((am & 1) * 2 + mm) * 16) * D + col0 + bj * 128 + n * 16);
#pragma unroll
      for (int mm = 0; mm < 2; ++mm)
#pragma unroll
        for (int bj = 0; bj < 2; ++bj)
#pragma unroll
          for (int n = 0; n < 2; ++n)
            *(f32x4*)(X + (size_t)(row0 + (am >> 1) * 128 + ((am & 1) * 2 + mm) * 16) * D + col0 + bj * 128 + n * 16) = xv[mm][bj][n] + gv[bj][n] * acc[am >> 1][bj][(am & 1) * 2 + mm][n];
    }
  }
};
struct EpiFfnVal {
  static constexpr bool PERM = false, AFTER_DRAIN = false;
  const u16* G; u16* ACT; const float* cw; const float* cb; int grow0;
  __device__ __forceinline__ void operator()(const f32x4 (&acc)[2][2][4][2], const pg8::Unit& u, int wr, int wc, int fr, int fq) const {
    const int row0 = u.pm * 256 + wr * 64 + fr, col0 = u.pn * 256 + wc * 32 + 4 * fq;
#pragma unroll
    for (int bj = 0; bj < 2; ++bj)
#pragma unroll
      for (int n = 0; n < 2; ++n) {
        const int c = col0 + bj * 128 + n * 16;
        const f32x4 w0 = *(const f32x4*)(cw + c), w1 = *(const f32x4*)(cw + DFF + c), w2 = *(const f32x4*)(cw + 2 * DFF + c), bb = *(const f32x4*)(cb + c);
#pragma unroll
        for (int ai = 0; ai < 2; ++ai) {
          uint2 g0[4], g1[4], g2[4];
#pragma unroll
          for (int m = 0; m < 4; ++m) {
            const int r = row0 + ai * 128 + m * 16;
            const int L = (grow0 + r) < 16384 ? 2048 : 8192;
            const int pos = (grow0 + r) & (L - 1);
            const u16* gp = G + (size_t)r * DFF + c;
            g1[m] = *(const uint2*)gp;
            g0[m] = *(const uint2*)(gp - (pos > 0 ? DFF : 0));
            g2[m] = *(const uint2*)(gp + (pos < L - 1 ? DFF : 0));
          }
#pragma unroll
          for (int m = 0; m < 4; ++m) {
            const int r = row0 + ai * 128 + m * 16;
            const int L = (grow0 + r) < 16384 ? 2048 : 8192;
            const int pos = (grow0 + r) & (L - 1);
            const float m0 = pos > 0 ? 1.f : 0.f, m2 = pos < L - 1 ? 1.f : 0.f;
            const uint2 a0 = g0[m], a1 = g1[m], a2 = g2[m];
            f32x4 a;
            a[0] = m0 * bf2f((u16)(a0.x & 0xffff)) * w0[0] + bf2f((u16)(a1.x & 0xffff)) * w1[0] + m2 * bf2f((u16)(a2.x & 0xffff)) * w2[0] + bb[0];
            a[1] = m0 * bf2f((u16)(a0.x >> 16)) * w0[1] + bf2f((u16)(a1.x >> 16)) * w1[1] + m2 * bf2f((u16)(a2.x >> 16)) * w2[1] + bb[1];
            a[2] = m0 * bf2f((u16)(a0.y & 0xffff)) * w0[2] + bf2f((u16)(a1.y & 0xffff)) * w1[2] + m2 * bf2f((u16)(a2.y & 0xffff)) * w2[2] + bb[2];
            a[3] = m0 * bf2f((u16)(a0.y >> 16)) * w0[3] + bf2f((u16)(a1.y >> 16)) * w1[3] + m2 * bf2f((u16)(a2.y >> 16)) * w2[3] + bb[3];
            const f32x4 v = acc[ai][bj][m][n];
            *(uint2*)(ACT + (size_t)r * DFF + c) = make_uint2(pack2(silu_f(a[0]) * v[0], silu_f(a[1]) * v[1]), pack2(silu_f(a[2]) * v[2], silu_f(a[3]) * v[3]));
          }
        }
      }
  }
};
template <class Epi>
__device__ __forceinline__ void run_gemm(const u16* A, const u16* Bt, int M, int N, int K, const Epi& E) {
  pg8::Gemm g; g.A = A; g.Bt = Bt; g.M = M; g.N = N; g.K = K;
  pg8::StaticOrder S; S.init(M, N, gridDim.x, BID());
  __syncthreads();
  pg8::gemm_phase<Epi, pg8::StaticOrder, false>((PG8_LAS unsigned char*)smem, g, S, E, nullptr);
  __syncthreads();
}

__device__ __forceinline__ int fidx(int p) { return p + ((p >> 6) << 2); }
__device__ __forceinline__ float2 cmulf(float2 a, float2 b) { return make_float2(a.x * b.x - a.y * b.y, a.x * b.y + a.y * b.x); }
__device__ __forceinline__ float2 cmulcf(float2 a, float2 b) { return make_float2(a.x * b.x + a.y * b.y, a.y * b.x - a.x * b.y); }
#define R16C(q) ((q) == 0 ? 1.f : (q) == 1 ? 0.9238795325f : (q) == 2 ? 0.7071067812f : (q) == 3 ? 0.3826834324f : (q) == 4 ? 0.f : (q) == 5 ? -0.3826834324f : (q) == 6 ? -0.7071067812f : -0.9238795325f)
#define R16S(q) ((q) == 0 ? 0.f : (q) == 1 ? -0.3826834324f : (q) == 2 ? -0.7071067812f : (q) == 3 ? -0.9238795325f : (q) == 4 ? -1.f : (q) == 5 ? -0.9238795325f : (q) == 6 ? -0.7071067812f : -0.3826834324f)
template <int N, int RS, bool INV>
__device__ __forceinline__ void fft_pass(float2* x, const float2* __restrict__ tw, const int S, const int tid) {
  constexpr int R = 1 << RS;
  const int E = S >> (RS - 1);
#pragma unroll 1
  for (int g = tid; g < N / R; g += NT) {
    const int blo = g & (E - 1);
    const int base = ((g - blo) << RS) + blo;
    float2 e[R];
#pragma unroll
    for (int k = 0; k < R; ++k) e[k] = x[fidx(base + k * E)];
    float2 wb[RS];
#pragma unroll
    for (int st = 0; st < RS; ++st) wb[st] = tw[blo * (8192 / (S >> st))];
#pragma unroll
    for (int sq = 0; sq < RS; ++sq) {
      const int st = INV ? (RS - 1 - sq) : sq;
      const int h = (R / 2) >> st;
#pragma unroll
      for (int k = 0; k < R; ++k) {
        if ((k & h) == 0) {
          const int m = k & (h - 1);
          const int q = m * (8 / h);
          float2 w = wb[st];
          if (q != 0) w = cmulf(w, make_float2(R16C(q), R16S(q)));
          if (!INV) {
            const float2 a = e[k], b = e[k + h];
            e[k] = make_float2(a.x + b.x, a.y + b.y);
            e[k + h] = cmulf(make_float2(a.x - b.x, a.y - b.y), w);
          } else {
            const float2 a = e[k], b = cmulcf(e[k + h], w);
            e[k] = make_float2(a.x + b.x, a.y + b.y);
            e[k + h] = make_float2(a.x - b.x, a.y - b.y);
          }
        }
      }
    }
#pragma unroll
    for (int k = 0; k < R; ++k) x[fidx(base + k * E)] = e[k];
  }
  __syncthreads();
}
template <int N>
__device__ __forceinline__ void fft_dif_t(float2* x, const float2* __restrict__ tw) {
  const int tid = TID();
  if (N == 16384) {
    fft_pass<N, 4, false>(x, tw, 8192, tid); fft_pass<N, 4, false>(x, tw, 512, tid);
    fft_pass<N, 4, false>(x, tw, 32, tid); fft_pass<N, 2, false>(x, tw, 2, tid);
  } else {
    fft_pass<N, 4, false>(x, tw, 2048, tid); fft_pass<N, 4, false>(x, tw, 128, tid); fft_pass<N, 4, false>(x, tw, 8, tid);
  }
}
template <int N>
__device__ __forceinline__ void ifft_dit_t(float2* x, const float2* __restrict__ tw) {
  const int tid = TID();
  if (N == 16384) {
    fft_pass<N, 2, true>(x, tw, 2, tid); fft_pass<N, 4, true>(x, tw, 32, tid);
    fft_pass<N, 4, true>(x, tw, 512, tid); fft_pass<N, 4, true>(x, tw, 8192, tid);
  } else {
    fft_pass<N, 4, true>(x, tw, 8, tid); fft_pass<N, 4, true>(x, tw, 128, tid); fft_pass<N, 4, true>(x, tw, 2048, tid);
  }
}
__device__ __forceinline__ void fft_dif(float2* x, int N, const float2* __restrict__ tw) {
  if (N == 16384) fft_dif_t<16384>(x, tw); else fft_dif_t<4096>(x, tw);
}
__device__ __forceinline__ void ifft_dit(float2* x, int N, const float2* __restrict__ tw) {
  if (N == 16384) ifft_dit_t<16384>(x, tw); else ifft_dit_t<4096>(x, tw);
}

__device__ __forceinline__ void unpack8(const uint4 v, float (&f)[8]) {
  f[0] = bf2f((u16)(v.x & 0xffff)); f[1] = bf2f((u16)(v.x >> 16)); f[2] = bf2f((u16)(v.y & 0xffff)); f[3] = bf2f((u16)(v.y >> 16));
  f[4] = bf2f((u16)(v.z & 0xffff)); f[5] = bf2f((u16)(v.z >> 16)); f[6] = bf2f((u16)(v.w & 0xffff)); f[7] = bf2f((u16)(v.w >> 16));
}
__device__ __forceinline__ uint4 pack8s(const float (&f)[8], float sc) {
  return make_uint4(pack2(f[0] * sc, f[1] * sc), pack2(f[2] * sc, f[3] * sc), pack2(f[4] * sc, f[5] * sc), pack2(f[6] * sc, f[7] * sc));
}
__device__ void transpose_w(const float* __restrict__ W, u16* __restrict__ Wt, int K, int N) {
  float* smf = (float*)smem;
  const int tk = K / 64, tn = N / 64, tid = TID();
  for (int item = BID(); item < tk * tn; item += gridDim.x) {
    const int k0 = (item / tn) * 64, n0 = (item % tn) * 64;
    float4 v[2];
#pragma unroll
    for (int j = 0; j < 2; ++j) {
      const int idx = tid + j * NT, kk = idx >> 4, n4 = idx & 15;
      v[j] = *(const float4*)(W + (long)(k0 + kk) * N + n0 + n4 * 4);
    }
    __syncthreads();
#pragma unroll
    for (int j = 0; j < 2; ++j) {
      const int idx = tid + j * NT, kk = idx >> 4, n4 = idx & 15;
      float* p = smf + kk * 65 + n4 * 4;
      p[0] = v[j].x; p[1] = v[j].y; p[2] = v[j].z; p[3] = v[j].w;
    }
    __syncthreads();
    const int nn = tid >> 3, k8 = tid & 7;
    float f[8];
#pragma unroll
    for (int i = 0; i < 8; ++i) f[i] = smf[(k8 * 8 + i) * 65 + nn];
    *(uint4*)(Wt + (long)(n0 + nn) * K + k0 + k8 * 8) = pack8s(f, 1.f);
  }
  __syncthreads();
}

__device__ void phase_pre0(const Params& P) {
  const int tid = TID();
  const long gtid = (long)BID() * NT + tid, gsz = (long)gridDim.x * NT;
  transpose_w(P.in[7], (u16*)(WS(P) + O_WHYIN), 1024, 3072);
  transpose_w(P.in[18], (u16*)(WS(P) + O_WHYOUT), 1024, 1024);
  transpose_w(P.in[19], (u16*)(WS(P) + O_WRETIN), 1024, 6144);
  transpose_w(P.in[21], (u16*)(WS(P) + O_WRETOUT), 2048, 1024);
  transpose_w(P.in[22], (u16*)(WS(P) + O_WSWAIN), 1024, 1536);
  transpose_w(P.in[26], (u16*)(WS(P) + O_WSWAOUT), 1024, 1024);
  transpose_w(P.in[27], (u16*)(WS(P) + O_WHGIN), 1024, 5120);
  transpose_w(P.in[30], (u16*)(WS(P) + O_WHGOUT), 1024, 1024);
  for (int l = 0; l < 4; ++l) {
    transpose_w(P.in[31] + (long)l * 1024 * DFF, (u16*)(WS(P) + O_WFG) + (long)l * DFF * 1024, 1024, DFF);
    transpose_w(P.in[32] + (long)l * 1024 * DFF, (u16*)(WS(P) + O_WFV) + (long)l * DFF * 1024, 1024, DFF);
    transpose_w(P.in[35] + (long)l * DFF * 1024, (u16*)(WS(P) + O_WFD) + (long)l * 1024 * DFF, DFF, 1024);
  }
  {
    float* cs = (float*)smem;
    float* modp = (float*)(WS(P) + O_MODP);
    for (int item = BID(); item < 4 * 8 * 12; item += gridDim.x) {
      const int nb = item % 12, ks = (item / 12) % 8, l = item / 96;
      __syncthreads();
      for (int i = tid; i < 2048; i += NT) {
        int b = i >> 7, k = i & 127;
        float c = (b < 8) ? P.in[2][b * 1024 + ks * 128 + k] : P.in[3][(b - 8) * 1024 + ks * 128 + k];
        cs[i] = c / (1.f + expf(-c));
      }
      __syncthreads();
      const int n = nb * 512 + tid;
      float a[16];
#pragma unroll
      for (int b = 0; b < 16; ++b) a[b] = 0.f;
      const float* w = P.in[4] + ((long)l * 1024 + ks * 128) * 6144 + n;
      for (int k = 0; k < 128; ++k) {
        float wv = w[(long)k * 6144];
#pragma unroll
        for (int b = 0; b < 16; ++b) a[b] += cs[b * 128 + k] * wv;
      }
#pragma unroll
      for (int b = 0; b < 16; ++b) modp[(((long)ks * 4 + l) * 16 + b) * 6144 + n] = a[b];
    }
    __syncthreads();
  }
  {
    float2* tw = (float2*)(WS(P) + O_TW);
    for (long i = gtid; i < 8192; i += gsz) {
      float s, c;
      sincospif((float)i * (1.f / 8192.f), &s, &c);
      tw[i] = make_float2(c, -s);
    }
    float2* rr = (float2*)(WS(P) + O_ROPER);
    for (long i = gtid; i < (long)8192 * 128; i += gsz) {
      int pos = (int)(i >> 7), d = (int)(i & 127);
      float inv = exp2f(-(float)d * (13.287712379549449f / 128.f));
      float s, c;
      sincosf((float)pos * inv, &s, &c);
      rr[i] = make_float2(c, s);
    }
    float2* rs = (float2*)(WS(P) + O_ROPES);
    for (long i = gtid; i < (long)8192 * 32; i += gsz) {
      int pos = (int)(i >> 5), d = (int)(i & 31);
      float inv = exp2f(-(float)d * (13.287712379549449f / 32.f));
      float s, c;
      sincosf((float)pos * inv, &s, &c);
      rs[i] = make_float2(c, s);
    }
  }
  {
    float* zf = (float*)smem;
    float* h1 = zf + 8 * 36;
    const float* w1 = P.in[10]; const float* b1 = P.in[11]; const float* w2 = P.in[12]; const float* b2 = P.in[13];
    const float* fr = P.in[15];
    const int tl = tid >> 6, j = tid & 63;
    for (int item = BID(); item < 1280; item += gridDim.x) {
      const int sel = item >= 1024;
      const int L = sel ? 2048 : 8192;
      const int t = (sel ? item - 1024 : item) * 8 + tl;
      float* hid = (float*)(WS(P) + (sel ? O_HIDP : O_HIDS));
      __syncthreads();
      if (j < 33) {
        float v;
        if (j == 0) v = (float)t / (float)(L - 1);
        else {
          int i = (j - 1) & 15;
          float band = 1e-4f + (float)i * ((15.f - 1e-4f) / 15.f);
          float ang = (6.283185307179586f / (float)L) * (float)t;
          float a = band * ang;
          v = (j <= 16) ? cosf(a) : -sinf(a);
        }
        zf[tl * 36 + j] = v;
      }
      __syncthreads();
      float s = b1[j];
#pragma unroll 3
      for (int i = 0; i < 33; ++i) s += zf[tl * 36 + i] * w1[i * 64 + j];
      h1[tl * 64 + j] = sinf(fr[j] * s);
      __syncthreads();
      float s2 = b2[j];
#pragma unroll 4
      for (int i = 0; i < 64; ++i) s2 += h1[tl * 64 + i] * w2[i * 64 + j];
      hid[(long)t * 64 + j] = sinf(fr[j] * s2);
    }
    __syncthreads();
  }
}

__device__ void phase_pre1(const Params& P) {
  __shared__ float w3s[128];
  __shared__ float red[8];
  const int tid = TID(), lane = tid & 63, wid = tid >> 6;
  const long gtid = (long)BID() * NT + tid, gsz = (long)gridDim.x * NT;
  {
    const float* modp = (const float*)(WS(P) + O_MODP);
    float* mod = (float*)(WS(P) + O_MOD);
    for (long i = gtid; i < (long)4 * 16 * 6144; i += gsz) {
      int n = (int)(i % 6144);
      int l = (int)(i / (16 * 6144));
      float s = P.in[5][l * 6144 + n];
      for (int ks = 0; ks < 8; ++ks) s += modp[(long)ks * 4 * 16 * 6144 + i];
      mod[i] = s;
    }
  }
  float2* buf = (float2*)smem;
  const float2* tw = (const float2*)(WS(P) + O_TW);
  for (int item = BID(); item < 2048; item += gridDim.x) {
    const int sel = item >> 10, c = item & 1023;
    const int L = sel ? 2048 : 8192, N = 2 * L;
    const float* hid = (const float*)(WS(P) + (sel ? O_HIDP : O_HIDS));
    float2* hs = (float2*)(WS(P) + (sel ? O_HSPP : O_HSPS)) + (long)c * N;
    __syncthreads();
    if (tid < 128) {
      int dirn = tid >> 6, j = tid & 63;
      w3s[tid] = P.in[14][(long)j * 2048 + dirn * 1024 + c];
    }
    __syncthreads();
    const float dec0 = fabsf(P.in[16][c]), dec1 = fabsf(P.in[16][1024 + c]);
    const float invLm1 = 1.f / (float)(L - 1);
    float asum = 0.f;
    for (int n = tid; n < N; n += NT) {
      float val = 0.f;
      if (n != L) {
        const int dirn = n < L ? 0 : 1;
        const int t = n < L ? n : N - n;
        const float4* hr = (const float4*)(hid + (long)t * 64);
        const float* w = w3s + dirn * 64;
        float s = 0.f;
#pragma unroll
        for (int q = 0; q < 16; ++q) {
          float4 h4 = hr[q];
          s += h4.x * w[4 * q] + h4.y * w[4 * q + 1] + h4.z * w[4 * q + 2] + h4.w * w[4 * q + 3];
        }
        float tl = (float)t * invLm1;
        val = s * expf(-tl * (dirn ? dec1 : dec0));
      }
      buf[fidx(n)] = make_float2(val, 0.f);
      asum += fabsf(val);
    }
    asum = wave_sum(asum);
    if (lane == 0) red[wid] = asum;
    __syncthreads();
    float tot = 0.f;
#pragma unroll
    for (int w = 0; w < 8; ++w) tot += red[w];
    const float scale = 1.f / (tot * (float)N);
    fft_dif(buf, N, tw);
    for (int p = tid; p < N; p += NT) {
      float2 a = buf[fidx(p)];
      hs[p] = make_float2(a.x * scale, a.y * scale);
    }
  }
  __syncthreads();
}

__device__ void phase_norm(const Params& P, int layer, int sl, int which) {
  const int grow0 = which ? sl * FSLAB : sl * SLAB, nrows = which ? FSLAB : SLAB;
  const float* __restrict__ x = (layer == 0 && which == 0) ? xin_of(P, sl) : (const float*)(OUTP(P) + (long)grow0 * D);
  u16* __restrict__ h = (u16*)(WS(P) + (which ? O_FHBUF : O_HBUF));
  const float* gain = P.in[6] + (layer * 2 + which) * D;
  const float* mod = (const float*)(WS(P) + O_MOD) + (long)layer * 16 * 6144;
  const int shoff = which ? 3 * D : 0, scoff = which ? 4 * D : D;
  const int tid = TID(), lane = tid & 63, wid = tid >> 6;
  for (int item = BID(); item < nrows / 32; item += gridDim.x) {
    const int r0 = item * 32 + wid * 4;
    float4 v[4][4];
    float ss[4];
#pragma unroll
    for (int u = 0; u < 4; ++u) {
      const float* xr = x + (long)(r0 + u) * D;
      float a = 0.f;
#pragma unroll
      for (int i = 0; i < 4; ++i) {
        v[u][i] = *(const float4*)(xr + i * 256 + lane * 4);
        a += v[u][i].x * v[u][i].x + v[u][i].y * v[u][i].y + v[u][i].z * v[u][i].z + v[u][i].w * v[u][i].w;
      }
      ss[u] = a;
    }
    const float* m = mod + (long)gb_row(grow0 + r0) * 6144;
#pragma unroll
    for (int u = 0; u < 4; ++u) ss[u] = wave_sum(ss[u]);
#pragma unroll
    for (int i = 0; i < 4; ++i) {
      const int col = i * 256 + lane * 4;
      const float4 g = *(const float4*)(gain + col);
      const float4 sc = *(const float4*)(m + scoff + col);
      const float4 sh = *(const float4*)(m + shoff + col);
      const float a0 = g.x * (1.f + sc.x), a1 = g.y * (1.f + sc.y), a2 = g.z * (1.f + sc.z), a3 = g.w * (1.f + sc.w);
#pragma unroll
      for (int u = 0; u < 4; ++u) {
        const float rstd = rsqrtf(ss[u] * (1.f / 1024.f) + 1e-6f);
        const float y0 = v[u][i].x * rstd * a0 + sh.x, y1 = v[u][i].y * rstd * a1 + sh.y;
        const float y2 = v[u][i].z * rstd * a2 + sh.z, y3 = v[u][i].w * rstd * a3 + sh.w;
        *(uint2*)(h + (long)(r0 + u) * D + col) = make_uint2(pack2(y0, y1), pack2(y2, y3));
      }
    }
  }
}

__device__ void phase_proj(const Params& P, size_t woff, int N) {
  EpiStoreBf16 E; E.O = (u16*)(WS(P) + O_PROJ); E.ldc = N;
  run_gemm((const u16*)(WS(P) + O_HBUF), (const u16*)(WS(P) + woff), SLAB, N, D, E);
}
__device__ void phase_resid(const Params& P, int layer, int slab, const u16* A, int K, size_t woff, int goff) {
  EpiResid E; E.X = OUTP(P) + (long)slab * SLAB * D; E.XS = (layer == 0) ? xin_of(P, slab) : (const float*)E.X; E.mod = (const float*)(WS(P) + O_MOD) + (long)layer * 16 * 6144; E.goff = goff; E.grow0 = slab * SLAB;
  run_gemm(A, (const u16*)(WS(P) + woff), SLAB, D, K, E);
}

__device__ void phase_ffn_gate(const Params& P, int layer) {
  EpiStoreBf16 E; E.O = (u16*)(WS(P) + O_FGBUF); E.ldc = DFF;
  run_gemm((const u16*)(WS(P) + O_FHBUF), (const u16*)(WS(P) + O_WFG) + (long)layer * DFF * D, FSLAB, DFF, D, E);
}
__device__ void phase_ffn_val(const Params& P, int layer, int fs) {
  EpiFfnVal E; E.G = (const u16*)(WS(P) + O_FGBUF); E.ACT = (u16*)(WS(P) + O_FACT) + (long)fs * FSLAB * DFF;
  E.cw = P.in[33] + (long)layer * 3 * DFF; E.cb = P.in[34] + (long)layer * DFF; E.grow0 = fs * FSLAB;
  run_gemm((const u16*)(WS(P) + O_FHBUF), (const u16*)(WS(P) + O_WFV) + (long)layer * DFF * D, FSLAB, DFF, D, E);
}
__device__ void phase_ffn_down(const Params& P, int layer) {
  EpiResid E; E.X = OUTP(P); E.XS = E.X; E.mod = (const float*)(WS(P) + O_MOD) + (long)layer * 16 * 6144; E.goff = 5 * D; E.grow0 = 0;
  run_gemm((const u16*)(WS(P) + O_FACT), (const u16*)(WS(P) + O_WFD) + (long)layer * D * DFF, NTOK, D, DFF, E);
}

__device__ void phase_hy_conv(const Params& P, int slab) {
  const int L = Lof(slab), nseq = SLAB / L, tid = TID();
  const u16* __restrict__ z = (const u16*)(WS(P) + O_PROJ);
  float* __restrict__ uT = (float*)(WS(P) + O_UT);
  u16* __restrict__ x0c = (u16*)(WS(P) + O_X0C);
  const float* cw = P.in[8];
  const float* cb = P.in[9];
  float* tile = (float*)smem;
  const int ntt = L / 64;
  const int nitems = nseq * ntt * 16;
  const int tl = tid >> 3, cg = tid & 7;
  for (int item = BID(); item < nitems; item += gridDim.x) {
    const int ct = item % 16, tt = (item / 16) % ntt, seq = item / (16 * ntt);
    const int t = tt * 64 + tl, c0 = ct * 64 + cg * 8;
    const long row = (long)seq * L + t;
    const float mp = t > 0 ? 1.f : 0.f, mn = t < L - 1 ? 1.f : 0.f;
    const long rp = t > 0 ? row - 1 : row, rn = t < L - 1 ? row + 1 : row;
    float val[3][8];
#pragma unroll
    for (int q = 0; q < 3; ++q) {
      const int col = q * 1024 + c0;
      float a[8], b[8], c[8];
      unpack8(*(const uint4*)(z + rp * 3072 + col), a);
      unpack8(*(const uint4*)(z + row * 3072 + col), b);
      unpack8(*(const uint4*)(z + rn * 3072 + col), c);
      const float4 w0a = *(const float4*)(cw + col), w0b = *(const float4*)(cw + col + 4);
      const float4 w1a = *(const float4*)(cw + 3072 + col), w1b = *(const float4*)(cw + 3072 + col + 4);
      const float4 w2a = *(const float4*)(cw + 6144 + col), w2b = *(const float4*)(cw + 6144 + col + 4);
      const float4 ba = *(const float4*)(cb + col), bb = *(const float4*)(cb + col + 4);
      const float w0[8] = {w0a.x, w0a.y, w0a.z, w0a.w, w0b.x, w0b.y, w0b.z, w0b.w};
      const float w1[8] = {w1a.x, w1a.y, w1a.z, w1a.w, w1b.x, w1b.y, w1b.z, w1b.w};
      const float w2[8] = {w2a.x, w2a.y, w2a.z, w2a.w, w2b.x, w2b.y, w2b.z, w2b.w};
      const float bs[8] = {ba.x, ba.y, ba.z, ba.w, bb.x, bb.y, bb.z, bb.w};
#pragma unroll
      for (int i = 0; i < 8; ++i) val[q][i] = mp * a[i] * w0[i] + b[i] * w1[i] + mn * c[i] * w2[i] + bs[i];
    }
    *(uint4*)(x0c + row * 1024 + c0) = pack8s(val[0], 1.f);
    __syncthreads();
#pragma unroll
    for (int i = 0; i < 8; ++i) tile[tl * 65 + cg * 8 + i] = val[1][i] * val[2][i];
    __syncthreads();
    {
      const int cl = tid >> 3, tq = tid & 7;
      float* dst = uT + ((long)seq * 1024 + ct * 64 + cl) * L + tt * 64 + tq * 8;
      float4 o0, o1;
      o0.x = tile[(tq * 8 + 0) * 65 + cl]; o0.y = tile[(tq * 8 + 1) * 65 + cl]; o0.z = tile[(tq * 8 + 2) * 65 + cl]; o0.w = tile[(tq * 8 + 3) * 65 + cl];
      o1.x = tile[(tq * 8 + 4) * 65 + cl]; o1.y = tile[(tq * 8 + 5) * 65 + cl]; o1.z = tile[(tq * 8 + 6) * 65 + cl]; o1.w = tile[(tq * 8 + 7) * 65 + cl];
      *(float4*)dst = o0; *(float4*)(dst + 4) = o1;
    }
  }
  __syncthreads();
}

__device__ void phase_hy_fft(const Params& P, int slab, bool dry = false) {
  const int L = Lof(slab), N = 2 * L, nseq = SLAB / L, tid = TID();
  float* uT = (float*)(WS(P) + O_UT);
  const float2* hsb = (const float2*)(WS(P) + (slab == 0 ? O_HSPP : O_HSPS));
  const float2* tw = (const float2*)(WS(P) + O_TW);
  const float* skip = P.in[17];
  float2* buf = (float2*)smem;
  const int nitems = (nseq / 2) * 1024;
  for (int item = BID(); item < nitems; item += gridDim.x) {
    const int pr = item >> 10, c = item & 1023;
    float* u0 = uT + ((long)(pr * 2) * 1024 + c) * L;
    float* u1 = u0 + (long)1024 * L;
    __syncthreads();
    for (int t = tid; t < L; t += NT) {
      buf[fidx(t)] = make_float2(u0[t], u1[t]);
      buf[fidx(t + L)] = make_float2(0.f, 0.f);
    }
    __syncthreads();
    fft_dif(buf, N, tw);
    const float2* h = hsb + (long)c * N;
    for (int p = tid; p < N; p += NT) {
      float2 a = buf[fidx(p)], b = h[p];
      buf[fidx(p)] = make_float2(a.x * b.x - a.y * b.y, a.x * b.y + a.y * b.x);
    }
    __syncthreads();
    ifft_dit(buf, N, tw);
    const float sk = skip[c];
    for (int t = tid; t < L; t += NT) {
      float2 y = buf[fidx(t)];
      const long doff = dry ? (long)(END_HY - O_UT) / 4 : 0;
      u0[t + doff] = y.x + u0[t] * sk;
      u1[t + doff] = y.y + u1[t] * sk;
    }
  }
  __syncthreads();
}

__device__ void phase_hy_tr(const Params& P, int slab) {
  const int L = Lof(slab), nseq = SLAB / L, tid = TID();
  const float* __restrict__ yT = (const float*)(WS(P) + O_UT);
  const u16* __restrict__ x0c = (const u16*)(WS(P) + O_X0C);
  u16* __restrict__ a2 = (u16*)(WS(P) + O_A2);
  float* tile = (float*)smem;
  const int ntt = L / 64;
  const int nitems = nseq * ntt * 16;
  for (int item = BID(); item < nitems; item += gridDim.x) {
    const int ct = item % 16, tt = (item / 16) % ntt, seq = item / (16 * ntt);
    const int cl = tid >> 3, tq = tid & 7;
    const float* src = yT + ((long)seq * 1024 + ct * 64 + cl) * L + tt * 64 + tq * 8;
    const float4 i0 = *(const float4*)src, i1 = *(const float4*)(src + 4);
    const int tl = tid >> 3, cg = tid & 7;
    const long row = (long)seq * L + tt * 64 + tl;
    const int c0 = ct * 64 + cg * 8;
    float xg[8];
    unpack8(*(const uint4*)(x0c + row * 1024 + c0), xg);
    __syncthreads();
    float* p = tile + cl * 65 + tq * 8;
    p[0] = i0.x; p[1] = i0.y; p[2] = i0.z; p[3] = i0.w; p[4] = i1.x; p[5] = i1.y; p[6] = i1.z; p[7] = i1.w;
    __syncthreads();
    float o[8];
#pragma unroll
    for (int i = 0; i < 8; ++i) o[i] = tile[(cg * 8 + i) * 65 + tl] * xg[i];
    *(uint4*)(a2 + row * 1024 + c0) = pack8s(o, 1.f);
  }
  __syncthreads();
}

struct Rec {
  int H, DK, DV, C;
  int ldv, voff, goff;
};
__device__ __forceinline__ Rec rec_of(int kind) {
  Rec r;
  if (kind == 1) { r.H = 4; r.DK = 256; r.DV = 512; r.C = 128; r.ldv = 6144; r.voff = 2048; r.goff = 4096; }
  else { r.H = 8; r.DK = 128; r.DV = 128; r.C = 64; r.ldv = 5120; r.voff = 1024; r.goff = 4096; }
  return r;
}

__device__ void phase_ret_prep(const Params& P, int slab) {
  const int L = Lof(slab);
  const u16* __restrict__ pj = (const u16*)(WS(P) + O_PROJ);
  u16* __restrict__ qdf = (u16*)(WS(P) + O_QDF); u16* __restrict__ qdb = (u16*)(WS(P) + O_QDB);
  u16* __restrict__ kif = (u16*)(WS(P) + O_KIF); u16* __restrict__ kib = (u16*)(WS(P) + O_KIB);
  u16* __restrict__ kef = (u16*)(WS(P) + O_KEF); u16* __restrict__ keb = (u16*)(WS(P) + O_KEB);
  float* dlf = (float*)(WS(P) + O_DLF); float* dlb = (float*)(WS(P) + O_DLB);
  const float2* __restrict__ rope = (const float2*)(WS(P) + O_ROPER);
  const long gtid = (long)BID() * NT + TID(), gsz = (long)gridDim.x * NT;
  for (long idx = gtid; idx < (long)SLAB * 64; idx += gsz) {
    const int d0 = (int)(idx & 15) * 8, h = (int)((idx >> 4) & 3), t = (int)(idx >> 6);
    const int pos = t & (L - 1), r = t & 127;
    const float lgf = -expf(P.in[20][h]), lgb = -expf(P.in[20][4 + h]);
    const u16* row = pj + (long)t * 6144 + h * 256 + d0;
    const uint4 vq1 = *(const uint4*)row, vq2 = *(const uint4*)(row + 128);
    const uint4 vk1 = *(const uint4*)(row + 1024), vk2 = *(const uint4*)(row + 1024 + 128);
    const float4* rp = (const float4*)(rope + (long)pos * 128 + d0);
    const float4 c01 = rp[0], c23 = rp[1], c45 = rp[2], c67 = rp[3];
    float q1[8], q2[8], k1[8], k2[8];
    unpack8(vq1, q1); unpack8(vq2, q2); unpack8(vk1, k1); unpack8(vk2, k2);
    const float cs[8] = {c01.x, c01.z, c23.x, c23.z, c45.x, c45.z, c67.x, c67.z};
    const float sn[8] = {c01.y, c01.w, c23.y, c23.w, c45.y, c45.w, c67.y, c67.w};
    float qa[8], qb[8], ka[8], kb[8];
#pragma unroll
    for (int i = 0; i < 8; ++i) {
      qa[i] = q1[i] * cs[i] - q2[i] * sn[i]; qb[i] = q1[i] * sn[i] + q2[i] * cs[i];
      ka[i] = (k1[i] * cs[i] - k2[i] * sn[i]) * 0.0625f; kb[i] = (k1[i] * sn[i] + k2[i] * cs[i]) * 0.0625f;
    }
    const float bf = (float)(r + 1) * lgf, bb = (float)(128 - r) * lgb;
    const float ef = expf(bf), eif = expf(-bf), eef = expf((float)(127 - r) * lgf);
    const float eb = expf(bb), eib = expf(-bb), eeb = expf((float)r * lgb);
    const long o1 = (long)t * 1024 + h * 256 + d0, o2 = o1 + 128;
    *(uint4*)(qdf + o1) = pack8s(qa, ef); *(uint4*)(qdf + o2) = pack8s(qb, ef);
    *(uint4*)(qdb + o1) = pack8s(qa, eb); *(uint4*)(qdb + o2) = pack8s(qb, eb);
    *(uint4*)(kif + o1) = pack8s(ka, eif); *(uint4*)(kif + o2) = pack8s(kb, eif);
    *(uint4*)(kib + o1) = pack8s(ka, eib); *(uint4*)(kib + o2) = pack8s(kb, eib);
    *(uint4*)(kef + o1) = pack8s(ka, eef); *(uint4*)(kef + o2) = pack8s(kb, eef);
    *(uint4*)(keb + o1) = pack8s(ka, eeb); *(uint4*)(keb + o2) = pack8s(kb, eeb);
    if (r == 0) {
      const long cgi = (long)(t >> 7) * 1024 + h * 256 + d0;
      const float df = expf(128.f * lgf), db = expf(128.f * lgb);
#pragma unroll
      for (int i = 0; i < 8; ++i) { dlf[cgi + i] = df; dlf[cgi + 128 + i] = df; dlb[cgi + i] = db; dlb[cgi + 128 + i] = db; }
    }
  }
}

__device__ __forceinline__ float lb_of(const float* lbt, int dr, int ch) {
  const float a0 = lbt[(dr * 4 + 0) * 1024 + ch], a1 = lbt[(dr * 4 + 1) * 1024 + ch], a2 = lbt[(dr * 4 + 2) * 1024 + ch], a3 = lbt[(dr * 4 + 3) * 1024 + ch];
  const float m = fmaxf(fmaxf(a0, a1), fmaxf(a2, a3));
  const float e0 = expf(a0 - m), e1 = expf(a1 - m), e2 = expf(a2 - m), e3 = expf(a3 - m);
  return (e0 + e1 + e2) / (e0 + e1 + e2 + e3);
}
__device__ void phase_hg_prep(const Params& P) {
  const u16* __restrict__ pj = (const u16*)(WS(P) + O_PROJ);
  u16* __restrict__ qdf = (u16*)(WS(P) + O_QDF); u16* __restrict__ qdb = (u16*)(WS(P) + O_QDB);
  u16* __restrict__ kif = (u16*)(WS(P) + O_KIF); u16* __restrict__ kib = (u16*)(WS(P) + O_KIB);
  u16* __restrict__ kef = (u16*)(WS(P) + O_KEF); u16* __restrict__ keb = (u16*)(WS(P) + O_KEB);
  float* dlf = (float*)(WS(P) + O_DLF); float* dlb = (float*)(WS(P) + O_DLB);
  const float* lbt = P.in[28];
  float* totF = (float*)smem;
  float* totB = totF + 1024;
  const int tid = TID(), lane = tid & 63, rg = tid >> 6;
  for (int item = BID(); item < 2048; item += gridDim.x) {
    const int cgi = item >> 3, ch = (item & 7) * 128 + lane * 2;
    const long t0 = (long)cgi * 64 + rg * 8;
    unsigned wq[8], wf[8], wb[8];
#pragma unroll
    for (int i = 0; i < 8; ++i) {
      const u16* row = pj + (t0 + i) * 5120 + ch;
      wq[i] = *(const unsigned*)row; wf[i] = *(const unsigned*)(row + 2048); wb[i] = *(const unsigned*)(row + 3072);
    }
    float lb0[2], lb1[2];
    lb0[0] = lb_of(lbt, 0, ch); lb0[1] = lb_of(lbt, 0, ch + 1);
    lb1[0] = lb_of(lbt, 1, ch); lb1[1] = lb_of(lbt, 1, ch + 1);
    float pf[2][8], sb[2][8], accf[2], accb[2];
#pragma unroll
    for (int c = 0; c < 2; ++c) {
      float a = 0.f;
#pragma unroll
      for (int i = 0; i < 8; ++i) {
        const float x = bf2f((u16)(c ? (wf[i] >> 16) : (wf[i] & 0xffff)));
        a += logf(lb0[c] + (1.f - lb0[c]) * sigm(x)); pf[c][i] = a;
      }
      accf[c] = a;
      a = 0.f;
#pragma unroll
      for (int i = 7; i >= 0; --i) {
        const float x = bf2f((u16)(c ? (wb[i] >> 16) : (wb[i] & 0xffff)));
        a += logf(lb1[c] + (1.f - lb1[c]) * sigm(x)); sb[c][i] = a;
      }
      accb[c] = a;
    }
    __syncthreads();
    *(float2*)(totF + rg * 128 + lane * 2) = make_float2(accf[0], accf[1]);
    *(float2*)(totB + rg * 128 + lane * 2) = make_float2(accb[0], accb[1]);
    __syncthreads();
    float offF[2] = {0.f, 0.f}, offB[2] = {0.f, 0.f}, totf[2] = {0.f, 0.f}, totb[2] = {0.f, 0.f};
#pragma unroll
    for (int g = 0; g < 8; ++g) {
      const float2 f = *(const float2*)(totF + g * 128 + lane * 2), bq = *(const float2*)(totB + g * 128 + lane * 2);
      totf[0] += f.x; totf[1] += f.y; totb[0] += bq.x; totb[1] += bq.y;
      if (g < rg) { offF[0] += f.x; offF[1] += f.y; }
      if (g > rg) { offB[0] += bq.x; offB[1] += bq.y; }
    }
#pragma unroll
    for (int i = 0; i < 8; ++i) {
      float o[6][2];
#pragma unroll
      for (int c = 0; c < 2; ++c) {
        const float xq = bf2f((u16)(c ? (wq[i] >> 16) : (wq[i] & 0xffff)));
        const float xf = bf2f((u16)(c ? (wf[i] >> 16) : (wf[i] & 0xffff)));
        const float xb = bf2f((u16)(c ? (wb[i] >> 16) : (wb[i] & 0xffff)));
        const float q = silu_f(xq);
        const float bf = offF[c] + pf[c][i], bb = offB[c] + sb[c][i];
        const float kf = (1.f - lb0[c]) * sigm(-xf), kb = (1.f - lb1[c]) * sigm(-xb);
        o[0][c] = q * expf(bf); o[1][c] = kf * expf(-bf); o[2][c] = kf * expf(totf[c] - bf);
        o[3][c] = q * expf(bb); o[4][c] = kb * expf(-bb); o[5][c] = kb * expf(totb[c] - bb);
      }
      const long oo = (t0 + i) * 1024 + ch;
      *(unsigned*)(qdf + oo) = pack2(o[0][0], o[0][1]);
      *(unsigned*)(kif + oo) = pack2(o[1][0], o[1][1]);
      *(unsigned*)(kef + oo) = pack2(o[2][0], o[2][1]);
      *(unsigned*)(qdb + oo) = pack2(o[3][0], o[3][1]);
      *(unsigned*)(kib + oo) = pack2(o[4][0], o[4][1]);
      *(unsigned*)(keb + oo) = pack2(o[5][0], o[5][1]);
    }
    if (rg == 0) {
      *(float2*)(dlf + (long)cgi * 1024 + ch) = make_float2(expf(totf[0]), expf(totf[1]));
      *(float2*)(dlb + (long)cgi * 1024 + ch) = make_float2(expf(totb[0]), expf(totb[1]));
    }
  }
  __syncthreads();
}

template <int C>
__device__ __forceinline__ void rec_scores_item(const Params& P, const Rec& R, int cgi, int h) {
  const u16* qdf = (const u16*)(WS(P) + O_QDF); const u16* qdb = (const u16*)(WS(P) + O_QDB);
  const u16* kif = (const u16*)(WS(P) + O_KIF); const u16* kib = (const u16*)(WS(P) + O_KIB);
  u16* sc = (u16*)(WS(P) + O_SC) + ((long)cgi * R.H + h) * C * C;
  const long off = (long)cgi * C * 1024 + h * R.DK;
  f32x4 af[C / 32][C / 64] = {}, ab[C / 32][C / 64] = {};
  gemm_acc<C, C, true, true, true, (C == 128 ? 4 : 2)>(af, qdf + off, 1024, kif + off, 1024, (u16*)smem);
  gemm_acc<C, C, true, true, true, (C == 128 ? 4 : 2)>(ab, qdb + off, 1024, kib + off, 1024, (u16*)smem);
  const int tid = TID(), lane = tid & 63, wid = tid >> 6;
  const int wm = wid >> 2, wn = wid & 3, fr = lane & 15, fq = lane >> 4;
#pragma unroll
  for (int mi = 0; mi < C / 32; ++mi)
#pragma unroll
    for (int ni = 0; ni < C / 64; ++ni) {
      const int r = wm * (C / 2) + mi * 16 + fr, c0 = wn * (C / 4) + ni * 16 + fq * 4;
      float v[4];
#pragma unroll
      for (int j = 0; j < 4; ++j) {
        const int c = c0 + j;
        v[j] = (c <= r ? af[mi][ni][j] : 0.f) + (c >= r ? ab[mi][ni][j] : 0.f);
      }
      *(uint2*)(sc + r * C + c0) = make_uint2(pack2(v[0], v[1]), pack2(v[2], v[3]));
    }
}

template <int C>
__device__ void phase_rec_su(const Params& P, int kind) {
  const Rec R = rec_of(kind);
  constexpr int KTU = C / 64;
  const int nch = SLAB / C;
  const int n_sc = nch * R.H;
  const int mtn = R.DK / 128, ntn = R.DV / 128;
  const int n_u = nch * R.H * 2 * mtn * ntn, G = gridDim.x;
  const u16* pj = (const u16*)(WS(P) + O_PROJ);
  for (int item = BID(); item < n_sc; item += G) rec_scores_item<C>(P, R, item / R.H, item % R.H);
  const u16* kef = (const u16*)(WS(P) + O_KEF); const u16* keb = (const u16*)(WS(P) + O_KEB);
  u16* stfb = (u16*)(WS(P) + O_STF); u16* stbb = (u16*)(WS(P) + O_STB);
  Tiles<KTU> ta, tb;
#define U_DECODE(q_, nt_, mt_, dir_, h_, cgi_) int nt_, mt_, dir_, h_, cgi_; { int qq = (q_); nt_ = qq % ntn; qq /= ntn; mt_ = qq % mtn; qq /= mtn; dir_ = qq & 1; qq >>= 1; h_ = qq % R.H; cgi_ = qq / R.H; }
#define U_ISSUE(T_, nt_, mt_, dir_, h_, cgi_) tiles_issue<128, 128, false, false, KTU>(T_, (dir_ ? keb : kef) + (long)cgi_ * C * 1024 + h_ * R.DK + mt_ * 128, 1024, pj + (long)cgi_ * C * R.ldv + R.voff + h_ * R.DV + nt_ * 128, R.ldv)
#define U_RUN(T_, nt_, mt_, dir_, h_, cgi_) { f32x4 acc[4][2] = {}; gemm_run<128, 128, false, false, false, KTU>(acc, T_, (u16*)smem); \
    u16* st = (dir_ ? stbb : stfb) + (((long)cgi_ * R.H + h_) * R.DV + nt_ * 128) * R.DK + mt_ * 128; const int DK = R.DK; \
    epi_each<128, 128, false>(acc, [&](int r, int c, f32x4 val) { *(uint2*)(st + (long)c * DK + r) = make_uint2(pack2(val[0], val[1]), pack2(val[2], val[3])); }); }
  int q = BID();
  if (q < n_u) { U_DECODE(q, nt, mt, dir, h, cgi); U_ISSUE(ta, nt, mt, dir, h, cgi); }
  for (; q < n_u; q += 2 * G) {
    U_DECODE(q, nt, mt, dir, h, cgi);
    const int q2 = q + G;
    if (q2 < n_u) { U_DECODE(q2, nt2, mt2, dir2, h2, cgi2); U_ISSUE(tb, nt2, mt2, dir2, h2, cgi2); }
    U_RUN(ta, nt, mt, dir, h, cgi);
    const int q3 = q + 2 * G;
    if (q3 < n_u) { U_DECODE(q3, nt3, mt3, dir3, h3, cgi3); U_ISSUE(ta, nt3, mt3, dir3, h3, cgi3); }
    if (q2 < n_u) { U_DECODE(q2, nt2, mt2, dir2, h2, cgi2); U_RUN(tb, nt2, mt2, dir2, h2, cgi2); }
  }
#undef U_DECODE
#undef U_ISSUE
#undef U_RUN
  __syncthreads();
}

__device__ void phase_rec_scan(const Params& P, int kind, int slab, bool dry = false) {
  const Rec R = rec_of(kind);
  const int L = Lof(slab), nseq = SLAB / L, ncs = L / R.C;
  const int qdk = R.DK / 4;
  const long per = (long)R.H * R.DV * qdk;
  const long total = 2 * nseq * per;
  const long gtid = (long)BID() * NT + TID(), gsz = (long)gridDim.x * NT;
  for (long idx = gtid; idx < total; idx += gsz) {
    long q = idx;
    const int pd = (int)(q % qdk); q /= qdk;
    const int e = (int)(q % R.DV); q /= R.DV;
    const int h = (int)(q % R.H); q /= R.H;
    const int seq = (int)(q % nseq);
    const int dir = (int)(q / nseq);
    u16* st = (u16*)(WS(P) + (dir ? O_STB : O_STF));
    u16* stw = dry ? (u16*)(WS(P) + O_OBUF) : st;
    const float* dl = (const float*)(WS(P) + (dir ? O_DLB : O_DLF));
    float s0 = 0.f, s1 = 0.f, s2 = 0.f, s3 = 0.f;
    const long ebase = ((long)h * R.DV + e) * R.DK + pd * 4;
    const long cstride = (long)R.H * R.DV * R.DK;
    const int dbase = h * R.DK + pd * 4;
    for (int i0 = 0; i0 < ncs; i0 += 8) {
      uint2 u[8];
      float4 dd[8];
#pragma unroll
      for (int j = 0; j < 8; ++j) {
        const int n = dir ? (ncs - 1 - i0 - j) : (i0 + j);
        const long cgi = (long)seq * ncs + n;
        u[j] = *(const uint2*)(st + cgi * cstride + ebase);
        dd[j] = *(const float4*)(dl + cgi * 1024 + dbase);
      }
#pragma unroll
      for (int j = 0; j < 8; ++j) {
        const int n = dir ? (ncs - 1 - i0 - j) : (i0 + j);
        const long cgi = (long)seq * ncs + n;
        *(uint2*)(stw + cgi * cstride + ebase) = make_uint2(pack2(s0, s1), pack2(s2, s3));
        s0 = dd[j].x * s0 + bf2f((u16)(u[j].x & 0xffff));
        s1 = dd[j].y * s1 + bf2f((u16)(u[j].x >> 16));
        s2 = dd[j].z * s2 + bf2f((u16)(u[j].y & 0xffff));
        s3 = dd[j].w * s3 + bf2f((u16)(u[j].y >> 16));
      }
    }
  }
}

template <int C>
__device__ void phase_rec_out(const Params& P, int kind) {
  const Rec R = rec_of(kind);
  constexpr int KT1 = C / 64, KT2 = (C == 128 ? 4 : 2);
  const int nch = SLAB / C, ntn = R.DV / 128;
  const u16* pj = (const u16*)(WS(P) + O_PROJ);
  const u16* scb = (const u16*)(WS(P) + O_SC);
  const u16* qdf = (const u16*)(WS(P) + O_QDF); const u16* qdb = (const u16*)(WS(P) + O_QDB);
  const u16* stf = (const u16*)(WS(P) + O_STF); const u16* stb = (const u16*)(WS(P) + O_STB);
  float* ob = (float*)(WS(P) + O_OBUF);
  const int HDV = R.H * R.DV;
  const int nitems = nch * R.H * ntn, G = gridDim.x;
  Tiles<KT1> t1; Tiles<KT2> t2; Tiles<KT2> t3;
  int item = BID();
  if (item < nitems) {
    const int nt = item % ntn, h = (item / ntn) % R.H, cgi = item / (ntn * R.H);
    tiles_issue<C, 128, true, false, KT1>(t1, scb + ((long)cgi * R.H + h) * C * C, C, pj + (long)cgi * C * R.ldv + R.voff + h * R.DV + nt * 128, R.ldv);
  }
  for (; item < nitems; item += G) {
    const int nt = item % ntn, h = (item / ntn) % R.H, cgi = item / (ntn * R.H);
    const long qoff = (long)cgi * C * 1024 + h * R.DK;
    const long soff = (((long)cgi * R.H + h) * R.DV + nt * 128) * R.DK;
    f32x4 acc[C / 32][2] = {};
    tiles_issue<C, 128, true, true, KT2>(t2, qdf + qoff, 1024, stf + soff, R.DK);
    gemm_run<C, 128, true, false, true, KT1>(acc, t1, (u16*)smem);
    tiles_issue<C, 128, true, true, KT2>(t3, qdb + qoff, 1024, stb + soff, R.DK);
    gemm_run<C, 128, true, true, true, KT2>(acc, t2, (u16*)smem);
    const int nx = item + G;
    if (nx < nitems) {
      const int nt2 = nx % ntn, h2 = (nx / ntn) % R.H, cg2 = nx / (ntn * R.H);
      tiles_issue<C, 128, true, false, KT1>(t1, scb + ((long)cg2 * R.H + h2) * C * C, C, pj + (long)cg2 * C * R.ldv + R.voff + h2 * R.DV + nt2 * 128, R.ldv);
    }
    gemm_run<C, 128, true, true, true, KT2>(acc, t3, (u16*)smem);
    float* o = ob + (long)cgi * C * HDV + h * R.DV + nt * 128;
    epi_each<C, 128, true>(acc, [&](int r, int c, f32x4 val) { *(f32x4*)(o + (long)r * HDV + c) = val; });
  }
  __syncthreads();
}

template <int KIND>
__device__ void phase_rec_ng_t(const Params& P) {
  const Rec R = rec_of(KIND);
  constexpr int DV = (KIND == 1) ? 512 : 128, H = (KIND == 1) ? 4 : 8, PER = DV / 64, HDV = H * DV;
  const float* __restrict__ ob = (const float*)(WS(P) + O_OBUF);
  const u16* __restrict__ pj = (const u16*)(WS(P) + O_PROJ);
  u16* __restrict__ a2 = (u16*)(WS(P) + O_A2);
  const float* gain = P.in[29];
  const int tid = TID(), lane = tid & 63, wid = tid >> 6;
  constexpr int nrows = SLAB * H;
  for (int item = BID(); item < nrows / 32; item += gridDim.x) {
    float v[4][PER];
    float ss[4];
#pragma unroll
    for (int u = 0; u < 4; ++u) {
      const int rh = item * 32 + wid * 4 + u;
      const int t = rh / H, h = rh % H;
      const float* o = ob + (long)t * HDV + h * DV + lane * PER;
      if (PER == 8) {
        const float4 a = *(const float4*)o, b = *(const float4*)(o + 4);
        v[u][0] = a.x; v[u][1] = a.y; v[u][2] = a.z; v[u][3] = a.w; v[u][4 % PER] = b.x; v[u][5 % PER] = b.y; v[u][6 % PER] = b.z; v[u][7 % PER] = b.w;
      } else {
        const float2 a = *(const float2*)o;
        v[u][0] = a.x; v[u][1] = a.y;
      }
      float a = 0.f;
#pragma unroll
      for (int i = 0; i < PER; ++i) a += v[u][i] * v[u][i];
      ss[u] = a;
    }
#pragma unroll
    for (int u = 0; u < 4; ++u) ss[u] = wave_sum(ss[u]);
#pragma unroll
    for (int u = 0; u < 4; ++u) {
      const int rh = item * 32 + wid * 4 + u;
      const int t = rh / H, h = rh % H;
      const float rstd = rsqrtf(ss[u] / (float)DV + 1e-6f);
      const u16* g = pj + (long)t * R.ldv + R.goff + h * DV + lane * PER;
      u16* out = a2 + (long)t * HDV + h * DV + lane * PER;
      float y[PER];
#pragma unroll
      for (int i = 0; i < PER; ++i) {
        y[i] = v[u][i] * rstd;
        if (KIND == 3) y[i] *= gain[lane * PER + i];
      }
      if (PER == 8) {
        const uint4 gw = *(const uint4*)g;
        float gf[8];
        unpack8(gw, gf);
        float r8[8];
#pragma unroll
        for (int i = 0; i < 8; ++i) r8[i] = y[i % PER] * silu_f(gf[i]);
        *(uint4*)out = pack8s(r8, 1.f);
      } else {
        const unsigned gw = *(const unsigned*)g;
        *(unsigned*)out = pack2(y[0] * silu_f(bf2f((u16)(gw & 0xffff))), y[1 % PER] * silu_f(bf2f((u16)(gw >> 16))));
      }
    }
  }
}
__device__ void phase_rec_ng(const Params& P, int kind) {
  if (kind == 1) phase_rec_ng_t<1>(P); else phase_rec_ng_t<3>(P);
}

__device__ void phase_swa_prep(const Params& P, int slab) {
  const int L = Lof(slab);
  const u16* pj = (const u16*)(WS(P) + O_PROJ);
  u16* qn = (u16*)(WS(P) + O_QN);
  u16* kn = (u16*)(WS(P) + O_KN);
  const float2* rope = (const float2*)(WS(P) + O_ROPES);
  const long gtid = (long)BID() * NT + TID(), gsz = (long)gridDim.x * NT;
  for (long idx = gtid; idx < (long)SLAB * 640; idx += gsz) {
    const int d = (int)(idx & 31);
    const int hd = (int)((idx >> 5) % 20);
    const int t = (int)(idx / 640);
    const int col = hd < 16 ? hd * 64 : 1024 + (hd - 16) * 64;
    const float x1 = bf2f(pj[(long)t * 1536 + col + d]), x2 = bf2f(pj[(long)t * 1536 + col + d + 32]);
    float ss = x1 * x1 + x2 * x2;
#pragma unroll
    for (int o = 16; o; o >>= 1) ss += __shfl_xor(ss, o);
    const float rstd = rsqrtf(ss * (1.f / 64.f) + 1e-6f);
    const float* gn = hd < 16 ? P.in[23] : P.in[24];
    const float y1 = x1 * rstd * gn[d], y2 = x2 * rstd * gn[d + 32];
    const float2 cs = rope[(long)(t & (L - 1)) * 32 + d];
    float o1 = y1 * cs.x - y2 * cs.y, o2 = y1 * cs.y + y2 * cs.x;
    if (hd < 16) {
      qn[(long)t * 1024 + hd * 64 + d] = f2bf(o1 * 0.125f);
      qn[(long)t * 1024 + hd * 64 + d + 32] = f2bf(o2 * 0.125f);
    } else {
      kn[(long)t * 256 + (hd - 16) * 64 + d] = f2bf(o1);
      kn[(long)t * 256 + (hd - 16) * 64 + d + 32] = f2bf(o2);
    }
  }
}

constexpr int SLD = 324;
__device__ void phase_swa_att1(const Params& P, int slab) {
  const int L = Lof(slab), nqb = L / 64;
  const u16* qn = (const u16*)(WS(P) + O_QN);
  const u16* kn = (const u16*)(WS(P) + O_KN);
  u16* pb = (u16*)(WS(P) + O_PBUF);
  const float* sink = P.in[25];
  float* S = (float*)(smem + 40960);
  const int tid = TID();
  const int nitems = (SLAB / 64) * 16;
  for (int item = BID(); item < nitems; item += gridDim.x) {
    const int hq = item & 15, qbg = item >> 4;
    const int seq = qbg / nqb, qb = qbg % nqb;
    const int q0 = qb * 64;
    const long tok0 = (long)seq * L;
    const int hkv = hq >> 2;
    for (int kt = 0; kt < 5; ++kt) {
      const int kp0 = q0 - 128 + kt * 64;
      if (kp0 >= 0 && kp0 < L) {
        f32x4 acc[2][1] = {};
        gemm_acc<64, 64, true, true, true, 1>(acc, qn + (tok0 + q0) * 1024 + hq * 64, 1024, kn + (tok0 + kp0) * 256 + hkv * 64, 256, (u16*)smem);
        epi_each<64, 64, true>(acc, [&](int r, int c, f32x4 v) {
          f32x4 o;
#pragma unroll
          for (int j = 0; j < 4; ++j) {
            const int dlt = (q0 + r) - (kp0 + c + j);
            o[j] = (dlt <= 128 && dlt >= -128) ? v[j] : -1e30f;
          }
          *(f32x4*)(S + r * SLD + kt * 64 + c) = o;
        });
      } else {
        for (int i = tid; i < 4096; i += NT) S[(i >> 6) * SLD + kt * 64 + (i & 63)] = -1e30f;
      }
    }
    __syncthreads();
    {
      const int r = tid >> 3, sub = tid & 7;
      const float sk = sink[hq];
      float m = sk;
      for (int c = sub; c < 320; c += 8) m = fmaxf(m, S[r * SLD + c]);
      m = fmaxf(m, __shfl_xor(m, 1)); m = fmaxf(m, __shfl_xor(m, 2)); m = fmaxf(m, __shfl_xor(m, 4));
      float den = 0.f;
      for (int c = sub; c < 320; c += 8) { float e = __expf(S[r * SLD + c] - m); S[r * SLD + c] = e; den += e; }
      den += __shfl_xor(den, 1); den += __shfl_xor(den, 2); den += __shfl_xor(den, 4);
      den += __expf(sk - m);
      const float inv = 1.f / den;
      u16* prow = pb + ((long)item * 64 + r) * 320;
      for (int c = sub; c < 320; c += 8) prow[c] = f2bf(S[r * SLD + c] * inv);
    }
    __syncthreads();
  }
}

__device__ void phase_swa_att2(const Params& P, int slab) {
  const int L = Lof(slab), nqb = L / 64;
  const u16* pj = (const u16*)(WS(P) + O_PROJ);
  const u16* pb = (const u16*)(WS(P) + O_PBUF);
  u16* a2 = (u16*)(WS(P) + O_A2);
  const int nitems = (SLAB / 64) * 16;
  for (int item = BID(); item < nitems; item += gridDim.x) {
    const int hq = item & 15, qbg = item >> 4;
    const int seq = qbg / nqb, qb = qbg % nqb;
    const int q0 = qb * 64;
    const long tok0 = (long)seq * L;
    const int hkv = hq >> 2;
    f32x4 acc[2][1] = {};
    for (int kt = 0; kt < 5; ++kt) {
      const int kp0 = q0 - 128 + kt * 64;
      if (kp0 >= 0 && kp0 < L)
        gemm_acc<64, 64, true, false, true, 1>(acc, pb + (long)item * 64 * 320 + kt * 64, 320, pj + (tok0 + kp0) * 1536 + 1280 + hkv * 64, 1536, (u16*)smem);
    }
    u16* o = a2 + (tok0 + q0) * 1024 + hq * 64;
    epi_each<64, 64, true>(acc, [&](int r, int c, f32x4 v) { *(uint2*)(o + (long)r * 1024 + c) = make_uint2(pack2(v[0], v[1]), pack2(v[2], v[3])); });
  }
}


#define XB_TMO      128
#define XB_XCNT(j)  (256  + 64 * (j))
#define XB_XSUB(j)  (1280 + 64 * (j))
#define XB_XGEN(j)  (2304 + 64 * (j))
#define XB_TOP      3328
#define XB_TOPGEN   3392
#define XCD_BAR_WORDS 3456
#define XB_SPIN_CAP (1u << 18)
__device__ __forceinline__ unsigned xb_ld(unsigned* p)              { return __hip_atomic_load(p, __ATOMIC_RELAXED, __HIP_MEMORY_SCOPE_AGENT); }
__device__ __forceinline__ unsigned xb_add(unsigned* p, unsigned v) { return __hip_atomic_fetch_add(p, v, __ATOMIC_RELAXED, __HIP_MEMORY_SCOPE_AGENT); }
__device__ __forceinline__ unsigned xb_xcc_id() { return (unsigned)__builtin_amdgcn_s_getreg((3 << 11) | 20) & 0xFu; }
#define XB_SPIN(cond, bar) do { unsigned _sp = 0; while (cond) { __builtin_amdgcn_s_sleep(1); \
    if ((++_sp & 255u) == 0u) { if (xb_ld(&(bar)[XB_TMO])) break; if (_sp > XB_SPIN_CAP) { atomicAdd(&(bar)[XB_TMO], 1u); break; } } } } while (0)
struct XcdBarrier { unsigned* bar; unsigned x; volatile LDS_AS unsigned* st; };
__device__ __forceinline__ XcdBarrier xcd_barrier_post(unsigned* bar, volatile LDS_AS unsigned* st) {
    XcdBarrier b; b.bar = bar; b.x = xb_xcc_id(); b.st = st;
    if (threadIdx.x == 0) (void)xb_add(&bar[XB_XCNT(b.x)], 1u);
    return b;
}
__device__ __forceinline__ void xcd_barrier_complete(unsigned* bar, unsigned x, unsigned& nloc, unsigned& nx) {
    const unsigned G = gridDim.x * gridDim.y * gridDim.z;
    unsigned sum, cnt, mine, sp = 0u;
    for (;;) {
        sum = 0u; cnt = 0u; mine = 0u;
#pragma unroll
        for (unsigned j = 0; j < 16; ++j) { const unsigned c = xb_ld(&bar[XB_XCNT(j)]); sum += c; cnt += (c > 0u) ? 1u : 0u; mine = (j == x) ? c : mine; }
        if (sum == G) break;
        __builtin_amdgcn_s_sleep(1);
        if ((++sp & 255u) == 0u) { if (xb_ld(&bar[XB_TMO])) break; if (sp > XB_SPIN_CAP) { atomicAdd(&bar[XB_TMO], 1u); break; } }
    }
    nloc = mine > 0u ? mine : 1u; nx = cnt > 0u ? cnt : 1u;
}
__device__ __forceinline__ void xcd_barrier(const XcdBarrier& b) {
    asm volatile("s_waitcnt vmcnt(0)" ::: "memory");
    __syncthreads();
    if (threadIdx.x == 0) {
        unsigned* bar = b.bar;
        __builtin_amdgcn_s_waitcnt(0);
        unsigned nloc = b.st[0], nx = b.st[1];
        if (nloc == 0u) { xcd_barrier_complete(bar, b.x, nloc, nx); b.st[0] = nloc; b.st[1] = nx; }
        const unsigned old = xb_add(&bar[XB_XSUB(b.x)], 1u);
        const unsigned gen = old / nloc;
        if (old + 1u == (gen + 1u) * nloc) {
            __builtin_amdgcn_fence(__ATOMIC_RELEASE, "agent");
            asm volatile("s_waitcnt vmcnt(0)" ::: "memory");
            const unsigned og = xb_add(&bar[XB_TOP], 1u);
            const unsigned tg = og / nx;
            if (og + 1u == (tg + 1u) * nx) xb_add(&bar[XB_TOPGEN], 1u);
            else XB_SPIN(xb_ld(&bar[XB_TOPGEN]) == tg, bar);
            __builtin_amdgcn_fence(__ATOMIC_ACQUIRE, "agent");
            xb_add(&bar[XB_XGEN(b.x)], 1u);
            asm volatile("s_waitcnt vmcnt(0)" ::: "memory");
        } else {
            XB_SPIN(xb_ld(&bar[XB_XGEN(b.x)]) == gen, bar);
            __builtin_amdgcn_fence(__ATOMIC_ACQUIRE, "agent");
            asm volatile("s_waitcnt vmcnt(0)" ::: "memory");
        }
    }
    __syncthreads();
}

__device__ __forceinline__ int nmix_of(int kind) { return (kind & 1) ? 8 : 6; }

__device__ void ffn_step(const Params& P, int layer, int f) {
  if (f == 6) { phase_ffn_down(P, layer); return; }
  const int fs = f / 3, st = f % 3;
  if (st == 0) { REP(4) phase_norm(P, layer, fs, 1); }
  else if (st == 1) { REP(0) phase_ffn_gate(P, layer); }
  else { REP(0) phase_ffn_val(P, layer, fs); }
}
__device__ void layer_step(const Params& P, int layer, int slab, int step) {
  const int kind = layer;
  if (step == 0) { REP(4) phase_norm(P, layer, slab, 0); return; }
  if (kind == 0) {
    if (step == 1) { REP(0) phase_proj(P, O_WHYIN, 3072); }
    else if (step == 2) { REP(3) phase_hy_conv(P, slab); }
    else if (step == 3) { if ((PROBE_MASK >> 7) & 1) phase_hy_fft(P, slab, true); phase_hy_fft(P, slab); }
    else if (step == 4) { REP(3) phase_hy_tr(P, slab); }
    else phase_resid(P, layer, slab, (const u16*)(WS(P) + O_A2), 1024, O_WHYOUT, 2 * D);
  } else if (kind == 1) {
    if (step == 1) { REP(0) phase_proj(P, O_WRETIN, 6144); }
    else if (step == 2) { REP(1) REP(9) phase_ret_prep(P, slab); }
    else if (step == 3) { REP(1) REP(11) phase_rec_su<128>(P, 1); }
    else if (step == 4) { if ((PROBE_MASK >> 6) & 1) phase_rec_scan(P, 1, slab, true); phase_rec_scan(P, 1, slab); }
    else if (step == 5) { REP(1) REP(12) phase_rec_out<128>(P, 1); }
    else if (step == 6) { REP(1) REP(9) phase_rec_ng(P, 1); }
    else phase_resid(P, layer, slab, (const u16*)(WS(P) + O_A2), 2048, O_WRETOUT, 2 * D);
  } else if (kind == 2) {
    if (step == 1) { REP(0) phase_proj(P, O_WSWAIN, 1536); }
    else if (step == 2) { REP(2) REP(14) phase_swa_prep(P, slab); }
    else if (step == 3) { REP(2) REP(15) phase_swa_att1(P, slab); }
    else if (step == 4) { REP(2) REP(16) phase_swa_att2(P, slab); }
    else phase_resid(P, layer, slab, (const u16*)(WS(P) + O_A2), 1024, O_WSWAOUT, 2 * D);
  } else {
    if (step == 1) { REP(0) phase_proj(P, O_WHGIN, 5120); }
    else if (step == 2) { REP(1) REP(9) phase_hg_prep(P); }
    else if (step == 3) { REP(1) REP(11) phase_rec_su<64>(P, 3); }
    else if (step == 4) { if ((PROBE_MASK >> 6) & 1) phase_rec_scan(P, 3, slab, true); phase_rec_scan(P, 3, slab); }
    else if (step == 5) { REP(1) REP(12) phase_rec_out<64>(P, 3); }
    else if (step == 6) { REP(1) REP(9) phase_rec_ng(P, 3); }
    else phase_resid(P, layer, slab, (const u16*)(WS(P) + O_A2), 1024, O_WHGOUT, 2 * D);
  }
}

__global__ void __launch_bounds__(NT) fwd_megakernel(Params P) {
  cg::grid_group grid = cg::this_grid();
  __shared__ uint4 xb_words;
  if (threadIdx.x == 0) xb_words = make_uint4(0u, 0u, 0u, 0u);
  __syncthreads();
  XcdBarrier xb = xcd_barrier_post((unsigned*)(P.ws + O_BAR), (volatile LDS_AS unsigned*)&xb_words);
  for (int pid = P.p0; pid < P.p1; ++pid) {
    if (pid == 0) { REP(5) phase_pre0(P); }
    else if (pid == 1) { REP(5) phase_pre1(P); }
    else {
      int q = pid - 2, layer = 0;
      while (q >= 5 * nmix_of(layer) + 7) { q -= 5 * nmix_of(layer) + 7; ++layer; }
      const int nm = nmix_of(layer);
      if (q < 5 * nm) layer_step(P, layer, q / nm, q % nm);
      else ffn_step(P, layer, q - 5 * nm);
    }
    if (pid + 1 < P.p1) {
      if (pid == 0) grid.sync();
      else xcd_barrier(xb);
      if ((PROBE_MASK >> 8) & 1) xcd_barrier(xb);
    }
  }
}

extern "C" void kernel_launch(void* const* d_in, const int* in_sizes, int n_in, void* d_out, int out_size, void* d_ws,
                              size_t ws_size, hipStream_t stream) {
  static int grid_blocks = 0;
  if (!grid_blocks) {
    int dev = 0, cus = 0, per_cu = 0;
    (void)hipGetDevice(&dev);
    (void)hipDeviceGetAttribute(&cus, hipDeviceAttributeMultiprocessorCount, dev);
    (void)hipFuncSetAttribute((const void*)fwd_megakernel, hipFuncAttributeMaxDynamicSharedMemorySize, LDSB);
    (void)hipOccupancyMaxActiveBlocksPerMultiprocessor(&per_cu, (const void*)fwd_megakernel, NT, LDSB);
    if (per_cu < 1) per_cu = 1;
    if (per_cu > 1) per_cu = 1;
    grid_blocks = cus * per_cu;
    if (ws_size < WS_END) fprintf(stderr, "kernel_launch: workspace too small: %zu < %zu\n", ws_size, (size_t)WS_END);
  }
  Params p;
  memset(&p, 0, sizeof(p));
  for (int i = 0; i < 36; ++i) p.in[i] = (const float*)d_in[i];
  p.out = (float*)d_out;
  p.ws = (unsigned char*)d_ws;
  (void)hipMemsetAsync((unsigned char*)d_ws + O_BAR, 0, XCD_BAR_WORDS * 4, stream);
#if ONE_LAUNCH
  p.p0 = 0; p.p1 = NPHASES;
  void* args[] = {&p};
  hipError_t e = hipLaunchCooperativeKernel((const void*)fwd_megakernel, dim3(grid_blocks), dim3(NT), args, LDSB, stream);
  if (e != hipSuccess) fprintf(stderr, "cooperative launch failed: %s (grid %d)\n", hipGetErrorString(e), grid_blocks);
#else
  for (int ph = 0; ph < NPHASES; ++ph) {
    p.p0 = ph; p.p1 = ph + 1;
    hipLaunchKernelGGL(fwd_megakernel, dim3(grid_blocks), dim3(NT), LDSB, stream, p);
  }
#endif
}
```

```cpp
#include <hip/hip_runtime.h>
#include <hip/hip_cooperative_groups.h>
#include <cstdio>
#include <cstdint>
#include <cstring>
namespace cg = cooperative_groups;

typedef unsigned short u16;
typedef __attribute__((ext_vector_type(8))) short bf16x8;
typedef __attribute__((ext_vector_type(4))) float f32x4;

#define NT 512
#ifndef ONE_LAUNCH
#define ONE_LAUNCH 1
#endif
#ifndef PROBE_MASK
#define PROBE_MASK 0
#endif
#define REP(cls) for (int rep_##cls = 0; rep_##cls < (((PROBE_MASK >> (cls)) & 1) ? 2 : 1); ++rep_##cls)

constexpr int D = 1024, SLAB = 16384, DFF = 2816;
constexpr int LDSB = 139264;
constexpr int FSLAB = 40960, NTOK = 81920;
constexpr int NPHASES = 2 + 5 * (6 + 8 + 6 + 8) + 4 * 7;

constexpr size_t SZW(size_t n, size_t k) { return n * k * 2; }
constexpr size_t O_WHYIN = 0;
constexpr size_t O_WHYOUT = O_WHYIN + SZW(3072, 1024);
constexpr size_t O_WRETIN = O_WHYOUT + SZW(1024, 1024);
constexpr size_t O_WRETOUT = O_WRETIN + SZW(6144, 1024);
constexpr size_t O_WSWAIN = O_WRETOUT + SZW(1024, 2048);
constexpr size_t O_WSWAOUT = O_WSWAIN + SZW(1536, 1024);
constexpr size_t O_WHGIN = O_WSWAOUT + SZW(1024, 1024);
constexpr size_t O_WHGOUT = O_WHGIN + SZW(5120, 1024);
constexpr size_t O_WFG = O_WHGOUT + SZW(1024, 1024);
constexpr size_t O_WFV = O_WFG + 4 * SZW(2816, 1024);
constexpr size_t O_WFD = O_WFV + 4 * SZW(2816, 1024);
constexpr size_t O_MOD = O_WFD + 4 * SZW(1024, 2816);
constexpr size_t O_TW = O_MOD + (size_t)4 * 16 * 6144 * 4;
constexpr size_t O_HIDS = O_TW + 8192 * 8;
constexpr size_t O_HIDP = O_HIDS + (size_t)8192 * 64 * 4;
constexpr size_t O_ROPER = O_HIDP + (size_t)2048 * 64 * 4;
constexpr size_t O_ROPES = O_ROPER + (size_t)8192 * 128 * 8;
constexpr size_t O_PROJ = O_ROPES + (size_t)8192 * 32 * 8;
constexpr size_t O_HBUF = O_PROJ + (size_t)SLAB * 6144 * 2;
constexpr size_t O_A2 = O_HBUF + (size_t)SLAB * 1024 * 2;
constexpr size_t O_C = O_A2 + (size_t)SLAB * 2048 * 2;
constexpr size_t O_FHBUF = O_PROJ;
constexpr size_t O_FGBUF = O_FHBUF + (size_t)FSLAB * 1024 * 2;
constexpr size_t O_FACT = O_FGBUF + (size_t)FSLAB * DFF * 2;
constexpr size_t END_F = O_FACT + (size_t)NTOK * DFF * 2;
constexpr size_t O_MODP = O_C;
constexpr size_t O_BAR = ((size_t)1 << 30) - 16384;
constexpr size_t O_HSPS = O_BAR - (size_t)1024 * 16384 * 8 - (size_t)1024 * 4096 * 8;
constexpr size_t O_HSPP = O_HSPS + (size_t)1024 * 16384 * 8;
constexpr size_t O_UT = O_C;
constexpr size_t O_X0C = O_UT + (size_t)SLAB * 1024 * 4;
constexpr size_t END_HY = O_X0C + (size_t)SLAB * 1024 * 2;
static_assert(END_F <= O_HSPS && END_HY <= O_HSPS, "layer-0 buffers overlap the filter spectra");
constexpr size_t SZP = (size_t)SLAB * 1024 * 2;
constexpr size_t O_QDF = O_C, O_QDB = O_QDF + SZP, O_KIF = O_QDB + SZP, O_KIB = O_KIF + SZP, O_KEF = O_KIB + SZP, O_KEB = O_KEF + SZP;
constexpr size_t O_DLF = O_KEB + SZP;
constexpr size_t O_DLB = O_DLF + (size_t)256 * 1024 * 4;
constexpr size_t O_SC = O_DLB + (size_t)256 * 1024 * 4;
constexpr size_t O_STF = O_SC + (size_t)SLAB * 512 * 2;
constexpr size_t O_STB = O_STF + (size_t)134217728;
constexpr size_t O_OBUF = O_STB + (size_t)134217728;
constexpr size_t END_REC = O_OBUF + (size_t)SLAB * 2048 * 4;
constexpr size_t O_QN = O_C;
constexpr size_t O_KN = O_QN + SZP;
constexpr size_t O_PBUF = O_KN + (size_t)SLAB * 256 * 2;
constexpr size_t END_SWA = O_PBUF + (size_t)SLAB * 16 * 320 * 2;
constexpr size_t WS_END = END_REC > END_HY ? (END_REC > END_SWA ? END_REC : END_SWA) : (END_HY > END_SWA ? END_HY : END_SWA);
static_assert(WS_END <= O_BAR, "workspace exceeds 1 GiB");

struct Params {
  const float* in[36];
  float* out;
  unsigned char* ws;
  int p0, p1;
};

extern __shared__ __attribute__((aligned(16))) unsigned char smem[];

__device__ __forceinline__ int TID() { int t = threadIdx.x; asm volatile("" : "+v"(t)); return t; }
__device__ __forceinline__ int BID() { int b = blockIdx.x; asm volatile("" : "+s"(b)); return b; }
__device__ __forceinline__ long ZOFF() { long z = 0; asm volatile("" : "+s"(z)); return z; }
__device__ __forceinline__ unsigned char* WS(const Params& P) { return P.ws + ZOFF(); }
__device__ __forceinline__ float* OUTP(const Params& P) { return P.out + ZOFF(); }

namespace pg8 {
#define PG8_LAS __attribute__((address_space(3)))
typedef unsigned short bf16_t;
typedef short bf16x8 __attribute__((ext_vector_type(8)));
typedef float f32x4 __attribute__((ext_vector_type(4)));
typedef unsigned u32x4 __attribute__((ext_vector_type(4)));
constexpr int BM = 256, BK = 64, HALF = 128, HTB = HALF * BK * 2  , STAGE_BYTES = 8 * HTB, NXCD = 8, WGM = 8;

__host__ __device__ __forceinline__ int lds_byte(int r, int c) { const int st = (r >> 4) * 2 + (c >> 5), rr = r & 15, cc = c & 31, ob = rr * 64 + cc * 2; return st * 1024 + (ob ^ (((ob >> 9) & 1) << 5)); }
__host__ __device__ __forceinline__ void stage_rc(int b, int& R, int& C) { const int st = b / 1024, sb = b % 1024, swz = sb ^ (((sb >> 9) & 1) << 5); R = (st >> 1) * 16 + swz / 64; C = (st & 1) * 32 + (swz % 64) / 2; }
__host__ __device__ __forceinline__ int perm32(int rho) { const int n = rho >> 4, i = rho & 15; return 8 * (i >> 2) + 4 * n + (i & 3); }

struct Unit { int pm, pn; };
struct Gemm { const bf16_t* A; const bf16_t* Bt; int M, N, K; };

struct StaticOrder {
    int nM, nN, nwg, G, c;
    __host__ __device__ void init(int M, int N, int G_, int c_) { nM = M / BM; nN = N / BM; nwg = nM * nN; G = G_; c = c_; }
    __host__ __device__ bool next(int i, Unit& u) const {
        const long L = (long)i * G + c; if (L >= nwg) return false;
        int wgid = (int)L; { const int q = nwg / NXCD, r = nwg % NXCD, xcd = wgid % NXCD, off = wgid / NXCD; wgid = (xcd < r ? xcd * (q + 1) : r * (q + 1) + (xcd - r) * q) + off; }
        const int nig = WGM * nN, gid = wgid / nig, fm = gid * WGM, gsz = (nM - fm) < WGM ? (nM - fm) : WGM;
        u.pm = fm + ((wgid % nig) % gsz); u.pn = (wgid % nig) / gsz; return true;
    }
    __device__ __forceinline__ void a_ready(const Unit&) const {}
    __device__ __forceinline__ void done(const Unit&) const {}
};

template <class Epi, class Sched, bool STAMP = false>
__device__ __forceinline__ void gemm_phase(PG8_LAS unsigned char* lds, const Gemm g, const Sched& S, const Epi& E, unsigned long long* stamps) {
    const int tid = TID(), wid = __builtin_amdgcn_readfirstlane(tid >> 6), lane = tid & 63, wr = wid >> 2, wc = wid & 3, fr = lane & 15, fq = lane >> 4;
    const int K = g.K, nt = K / BK;
    int ts_lo = 0, ts_hi = 0, nts = 0; const unsigned long long rt_entry = STAMP ? (unsigned long long)wall_clock64() : 0ull;
#define PG8_STAMP() do { if (STAMP && wid == 0 && nts < 64) { const unsigned long long _c = (unsigned long long)clock64(); \
        ts_lo = (lane == nts) ? (int)(unsigned)_c : ts_lo; ts_hi = (lane == nts) ? (int)(unsigned)(_c >> 32) : ts_hi; ++nts; } } while (0)
    PG8_STAMP();
    unsigned voffA[2], voffB[2];
#pragma unroll
    for (int i = 0; i < 2; ++i) { int R, C; stage_rc(tid * 16 + i * 8192, R, C); const int Rb = Epi::PERM ? ((R & ~31) + perm32(R & 31)) : R;
        voffA[i] = (unsigned)(R * K + C) * 2u; voffB[i] = (unsigned)(Rb * K + C) * 2u; }
    const size_t kstep = (size_t)(BK * 2);
    const size_t hstep = (size_t)HALF * K * 2;
    const size_t tstep = 2 * hstep;
    const unsigned ldsw = (unsigned)wid * 1024u;
    const int aoff = lds_byte(wr * 64 + fr, fq * 8), boff = lds_byte(wc * 32 + fr, fq * 8);
#define PG8_SA(b, h) (((b) * 2 + (h)) * HTB)
#define PG8_SB(b, h) ((4 + (b) * 2 + (h)) * HTB)
#define PG8_STAGE(bufoff, gbase, voff) do { _Pragma("unroll") for (int _i = 0; _i < 2; ++_i) \
        __builtin_amdgcn_global_load_lds((const unsigned*)((const char*)(gbase) + (voff)[_i]), (PG8_LAS unsigned*)(lds + (bufoff) + ldsw + _i * 8192), 16, 0, 0); } while (0)
#define PG8_LDA(dst, b, h) do { _Pragma("unroll") for (int m = 0; m < 4; ++m) _Pragma("unroll") for (int k = 0; k < 2; ++k) dst[m][k] = *(const PG8_LAS bf16x8*)(lds + PG8_SA(b, h) + aoff + m * 2048 + k * 1024); } while (0)
#define PG8_LDB(dst, b, h) do { _Pragma("unroll") for (int n = 0; n < 2; ++n) _Pragma("unroll") for (int k = 0; k < 2; ++k) dst[n][k] = *(const PG8_LAS bf16x8*)(lds + PG8_SB(b, h) + boff + n * 2048 + k * 1024); } while (0)
#define PG8_MMA(ai, bj, At, Bt) do { __builtin_amdgcn_s_setprio(1); _Pragma("unroll") for (int m = 0; m < 4; ++m) _Pragma("unroll") for (int n = 0; n < 2; ++n) _Pragma("unroll") for (int k = 0; k < 2; ++k) \
        acc[ai][bj][m][n] = __builtin_amdgcn_mfma_f32_16x16x32_bf16(Bt[n][k], At[m][k], acc[ai][bj][m][n], 0, 0, 0); __builtin_amdgcn_s_setprio(0); } while (0)
#define PG8_WAIT_V(n) asm volatile("s_waitcnt vmcnt(" #n ")" ::: "memory")
#define PG8_WAIT_L(n) asm volatile("s_waitcnt lgkmcnt(" #n ")" ::: "memory")
#define PG8_BAR __builtin_amdgcn_s_barrier()
#define PG8_SCHED __builtin_amdgcn_sched_barrier(0)
    Unit cur, nxt; int ui = 0;
    if (!S.next(0, cur)) return;
    f32x4 acc[2][2][4][2];
#pragma unroll
    for (int a = 0; a < 2; ++a)
#pragma unroll
        for (int b = 0; b < 2; ++b)
#pragma unroll
            for (int m = 0; m < 4; ++m)
#pragma unroll
                for (int n = 0; n < 2; ++n) acc[a][b][m][n] = (f32x4){0.f, 0.f, 0.f, 0.f};
    bf16x8 At[4][2], B0[2][2], B1[2][2];
    const char* cA = (const char*)g.A + (size_t)cur.pm * tstep; const char* cB = (const char*)g.Bt + (size_t)cur.pn * tstep;
    S.a_ready(cur);
    PG8_STAGE(PG8_SB(0, 0), cB, voffB); PG8_STAGE(PG8_SA(0, 0), cA, voffA); PG8_STAGE(PG8_SB(0, 1), cB + hstep, voffB); PG8_STAGE(PG8_SA(0, 1), cA + hstep, voffA);
    if (wr == 1) PG8_BAR;
    PG8_WAIT_V(4); PG8_BAR;
    PG8_STAGE(PG8_SB(1, 0), cB + kstep, voffB); PG8_STAGE(PG8_SA(1, 0), cA + kstep, voffA); PG8_STAGE(PG8_SB(1, 1), cB + hstep + kstep, voffB);
    PG8_WAIT_V(6); PG8_BAR;
    PG8_STAMP();
    for (;;) {
        const bool has_next = S.next(ui + 1, nxt);
        const char* nA = has_next ? (const char*)g.A + (size_t)nxt.pm * tstep : cA; const char* nB = has_next ? (const char*)g.Bt + (size_t)nxt.pn * tstep : cB;
        for (int t = 0; t < nt; t += 2) {
            const bool last = (t == nt - 2);
            const char* a1 = cA + (size_t)(t + 1) * kstep;
            const char* a2 = last ? nA : cA + (size_t)(t + 2) * kstep; const char* b2 = last ? nB : cB + (size_t)(t + 2) * kstep;
            const char* a3 = a2 + kstep; const char* b3 = b2 + kstep;
            if (last && has_next) S.a_ready(nxt);
            PG8_LDB(B0, 0, 0); PG8_SCHED; PG8_LDA(At, 0, 0); PG8_STAGE(PG8_SA(1, 1), a1 + hstep, voffA);
            PG8_WAIT_L(8); PG8_BAR; PG8_WAIT_L(0); PG8_MMA(0, 0, At, B0); PG8_BAR; PG8_SCHED;
            PG8_LDB(B1, 0, 1); PG8_STAGE(PG8_SB(0, 0), b2, voffB);
            PG8_BAR; PG8_WAIT_L(0); PG8_MMA(0, 1, At, B1); PG8_BAR;
            PG8_LDA(At, 0, 1); PG8_STAGE(PG8_SA(0, 0), a2, voffA);
            PG8_BAR; PG8_WAIT_L(0); PG8_MMA(1, 0, At, B0); PG8_BAR; PG8_SCHED;
            PG8_STAGE(PG8_SB(0, 1), b2 + hstep, voffB);
            PG8_WAIT_V(6); PG8_BAR; PG8_MMA(1, 1, At, B1); PG8_BAR;
            PG8_LDB(B0, 1, 0); PG8_SCHED; PG8_LDA(At, 1, 0); PG8_STAGE(PG8_SA(0, 1), a2 + hstep, voffA);
            PG8_WAIT_L(8); PG8_BAR; PG8_WAIT_L(0); PG8_MMA(0, 0, At, B0); PG8_BAR; PG8_SCHED;
            PG8_LDB(B1, 1, 1); PG8_STAGE(PG8_SB(1, 0), b3, voffB);
            PG8_BAR; PG8_WAIT_L(0); PG8_MMA(0, 1, At, B1); PG8_BAR;
            PG8_LDA(At, 1, 1); PG8_STAGE(PG8_SA(1, 0), a3, voffA);
            PG8_BAR; PG8_WAIT_L(0); PG8_MMA(1, 0, At, B0); PG8_BAR; PG8_SCHED;
            PG8_STAGE(PG8_SB(1, 1), b3 + hstep, voffB);
            PG8_WAIT_V(6); PG8_BAR; PG8_MMA(1, 1, At, B1); PG8_BAR;
        }
        PG8_STAMP();
        if constexpr (!Epi::AFTER_DRAIN) { E(acc, cur, wr, wc, fr, fq); S.done(cur); }
        PG8_STAMP();
        if (!has_next) break;
#pragma unroll
        for (int a = 0; a < 2; ++a)
#pragma unroll
            for (int b = 0; b < 2; ++b)
#pragma unroll
                for (int m = 0; m < 4; ++m)
#pragma unroll
                    for (int n = 0; n < 2; ++n) acc[a][b][m][n] = (f32x4){0.f, 0.f, 0.f, 0.f};
        cur = nxt; cA = nA; cB = nB; ++ui;
    }
    PG8_WAIT_V(0);
    if (wr == 0) PG8_BAR;
    PG8_BAR;
    if constexpr (Epi::AFTER_DRAIN) { E.fused(acc, cur, wr, wc, fr, fq, lds, wid, lane); S.done(cur); }
    PG8_STAMP();
    if (STAMP && wid == 0) { stamps[lane] = lane < nts ? (((unsigned long long)(unsigned)ts_hi << 32) | (unsigned)ts_lo) : 0ull;
        if (lane == 62) stamps[62] = rt_entry; if (lane == 63) stamps[63] = (unsigned long long)wall_clock64(); }
#undef PG8_STAMP
#undef PG8_SA
#undef PG8_SB
#undef PG8_STAGE
#undef PG8_LDA
#undef PG8_LDB
#undef PG8_MMA
#undef PG8_WAIT_V
#undef PG8_WAIT_L
#undef PG8_BAR
#undef PG8_SCHED
}
}


__device__ __forceinline__ u16 f2bf(float f) {
  unsigned u = __float_as_uint(f);
  u += 0x7fffu + ((u >> 16) & 1u);
  return (u16)(u >> 16);
}
__device__ __forceinline__ float bf2f(u16 h) { return __uint_as_float(((unsigned)h) << 16); }
__device__ __forceinline__ unsigned pack2(float a, float b) { return (unsigned)f2bf(a) | ((unsigned)f2bf(b) << 16); }
__device__ __forceinline__ void unpack8(const uint4 v, float (&f)[8]) {
  f[0] = bf2f((u16)(v.x & 0xffff)); f[1] = bf2f((u16)(v.x >> 16)); f[2] = bf2f((u16)(v.y & 0xffff)); f[3] = bf2f((u16)(v.y >> 16));
  f[4] = bf2f((u16)(v.z & 0xffff)); f[5] = bf2f((u16)(v.z >> 16)); f[6] = bf2f((u16)(v.w & 0xffff)); f[7] = bf2f((u16)(v.w >> 16));
}
__device__ __forceinline__ uint4 pack8s(const float (&f)[8], float sc) {
  return make_uint4(pack2(f[0] * sc, f[1] * sc), pack2(f[2] * sc, f[3] * sc), pack2(f[4] * sc, f[5] * sc), pack2(f[6] * sc, f[7] * sc));
}
__device__ __forceinline__ float silu_f(float x) { return x / (1.f + __expf(-x)); }
__device__ __forceinline__ float sigm(float x) { return 1.f / (1.f + __expf(-x)); }
__device__ __forceinline__ float wave_sum(float v) {
#pragma unroll
  for (int o = 32; o; o >>= 1) v += __shfl_xor(v, o);
  return v;
}
__device__ __forceinline__ const float* xin_of(const Params& P, int slab) { return slab == 0 ? P.in[0] : P.in[1] + (long)(slab - 1) * SLAB * D; }
__device__ __forceinline__ int Lof(int slab) { return slab == 0 ? 2048 : 8192; }
__device__ __forceinline__ int gb_row(int gr) { return gr < 16384 ? (gr >> 11) : (8 + ((gr - 16384) >> 13)); }
__device__ __forceinline__ int gb_of(int slab, int r) { return slab == 0 ? (r >> 11) : (8 + (slab - 1) * 2 + (r >> 13)); }

typedef short v4s __attribute__((ext_vector_type(4)));
#define LBAR() asm volatile("s_waitcnt lgkmcnt(0)\n\ts_barrier" ::: "memory")
#define LDS_AS __attribute__((address_space(3)))
template <int R, bool KC>
__device__ __forceinline__ uint4 ld_chunk(const u16* __restrict__ base, long ld, int k0, int c) {
  if (KC) {
    const int r = c >> 3, kc = c & 7;
    return *(const uint4*)(base + (long)r * ld + k0 + kc * 8);
  } else {
    const int k = c / (R / 8), mc = c % (R / 8);
    return *(const uint4*)(base + (long)(k0 + k) * ld + mc * 8);
  }
}
template <int R, bool KC>
__device__ __forceinline__ void st_chunk(u16* s, uint4 v, int c) {
  if (KC) {
    const int r = c >> 3, kc = c & 7;
    *(uint4*)(s + r * 72 + kc * 8) = v;
  } else {
    const int k = c / (R / 8), mc = c % (R / 8);
    *(uint4*)(s + k * (R + 8) + mc * 8) = v;
  }
}
template <int R, bool KC>
__device__ __forceinline__ bf16x8 ld_frag(const u16* s, int x0, int ks, int fr, int fq) {
  if (KC) {
    return *(const bf16x8*)(s + (x0 + fr) * 72 + ks * 32 + fq * 8);
  } else {
    const int q4 = fr >> 2, p4 = fr & 3;
    const u16* p = s + (ks * 32 + 8 * fq + q4) * (R + 8) + x0 + 4 * p4;
    v4s lo = __builtin_amdgcn_ds_read_tr16_b64_v4i16((LDS_AS v4s*)p);
    v4s hi = __builtin_amdgcn_ds_read_tr16_b64_v4i16((LDS_AS v4s*)(p + 4 * (R + 8)));
    bf16x8 r;
    r[0] = lo[0]; r[1] = lo[1]; r[2] = lo[2]; r[3] = lo[3]; r[4] = hi[0]; r[5] = hi[1]; r[6] = hi[2]; r[7] = hi[3];
    return r;
  }
}

template <int TM, int TN, bool AKC, bool BKC, bool TR, int KT>
__device__ __forceinline__ void gemm_acc(f32x4 (&acc)[TM / 32][TN / 64], const u16* __restrict__ A, long lda,
                                         const u16* __restrict__ B, long ldb, u16* sm) {
  u16* As = sm;
  u16* Bs = sm + 9216;
  const int tid = TID(), lane = tid & 63, wid = tid >> 6;
  const int wm = wid >> 2, wn = wid & 3, fr = lane & 15, fq = lane >> 4;
  constexpr int MI = TM / 32, NI = TN / 64;
  uint4 ra0[KT], ra1[KT], rb0[KT], rb1[KT];
#pragma unroll
  for (int kt = 0; kt < KT; ++kt) {
    ra0[kt] = ld_chunk<TM, AKC>(A, lda, kt * 64, tid);
    ra1[kt] = ra0[kt];
    if (TM == 128) ra1[kt] = ld_chunk<TM, AKC>(A, lda, kt * 64, tid + NT);
    rb0[kt] = ld_chunk<TN, BKC>(B, ldb, kt * 64, tid);
    rb1[kt] = rb0[kt];
    if (TN == 128) rb1[kt] = ld_chunk<TN, BKC>(B, ldb, kt * 64, tid + NT);
  }
#pragma unroll
  for (int kt = 0; kt < KT; ++kt) {
    __syncthreads();
    st_chunk<TM, AKC>(As, ra0[kt], tid);
    if (TM == 128) st_chunk<TM, AKC>(As, ra1[kt], tid + NT);
    st_chunk<TN, BKC>(Bs, rb0[kt], tid);
    if (TN == 128) st_chunk<TN, BKC>(Bs, rb1[kt], tid + NT);
    __syncthreads();
#pragma unroll
    for (int ks = 0; ks < 2; ++ks) {
      bf16x8 af[MI], bfr[NI];
#pragma unroll
      for (int mi = 0; mi < MI; ++mi) af[mi] = ld_frag<TM, AKC>(As, wm * (TM / 2) + mi * 16, ks, fr, fq);
#pragma unroll
      for (int ni = 0; ni < NI; ++ni) bfr[ni] = ld_frag<TN, BKC>(Bs, wn * (TN / 4) + ni * 16, ks, fr, fq);
#pragma unroll
      for (int mi = 0; mi < MI; ++mi)
#pragma unroll
        for (int ni = 0; ni < NI; ++ni)
          acc[mi][ni] = TR ? __builtin_amdgcn_mfma_f32_16x16x32_bf16(bfr[ni], af[mi], acc[mi][ni], 0, 0, 0)
                           : __builtin_amdgcn_mfma_f32_16x16x32_bf16(af[mi], bfr[ni], acc[mi][ni], 0, 0, 0);
    }
  }
  __syncthreads();
}

template <int KT> struct Tiles { uint4 a0[KT], a1[KT], b0[KT], b1[KT]; };
template <int TM, int TN, bool AKC, bool BKC, int KT>
__device__ __forceinline__ void tiles_issue(Tiles<KT>& t, const u16* __restrict__ A, long lda, const u16* __restrict__ B, long ldb) {
  const int tid = TID();
#pragma unroll
  for (int kt = 0; kt < KT; ++kt) {
    t.a0[kt] = ld_chunk<TM, AKC>(A, lda, kt * 64, tid);
    t.a1[kt] = t.a0[kt];
    if (TM == 128) t.a1[kt] = ld_chunk<TM, AKC>(A, lda, kt * 64, tid + NT);
    t.b0[kt] = ld_chunk<TN, BKC>(B, ldb, kt * 64, tid);
    t.b1[kt] = t.b0[kt];
    if (TN == 128) t.b1[kt] = ld_chunk<TN, BKC>(B, ldb, kt * 64, tid + NT);
  }
}
template <int TM, int TN, bool AKC, bool BKC, bool TR, int KT>
__device__ __forceinline__ void gemm_run(f32x4 (&acc)[TM / 32][TN / 64], const Tiles<KT>& t, u16* sm) {
  u16* As = sm;
  u16* Bs = sm + 9216;
  const int tid = TID(), lane = tid & 63, wid = tid >> 6;
  const int wm = wid >> 2, wn = wid & 3, fr = lane & 15, fq = lane >> 4;
  constexpr int MI = TM / 32, NI = TN / 64;
#pragma unroll
  for (int kt = 0; kt < KT; ++kt) {
    __syncthreads();
    st_chunk<TM, AKC>(As, t.a0[kt], tid);
    if (TM == 128) st_chunk<TM, AKC>(As, t.a1[kt], tid + NT);
    st_chunk<TN, BKC>(Bs, t.b0[kt], tid);
    if (TN == 128) st_chunk<TN, BKC>(Bs, t.b1[kt], tid + NT);
    __syncthreads();
#pragma unroll
    for (int ks = 0; ks < 2; ++ks) {
      bf16x8 af[MI], bfr[NI];
#pragma unroll
      for (int mi = 0; mi < MI; ++mi) af[mi] = ld_frag<TM, AKC>(As, wm * (TM / 2) + mi * 16, ks, fr, fq);
#pragma unroll
      for (int ni = 0; ni < NI; ++ni) bfr[ni] = ld_frag<TN, BKC>(Bs, wn * (TN / 4) + ni * 16, ks, fr, fq);
#pragma unroll
      for (int mi = 0; mi < MI; ++mi)
#pragma unroll
        for (int ni = 0; ni < NI; ++ni)
          acc[mi][ni] = TR ? __builtin_amdgcn_mfma_f32_16x16x32_bf16(bfr[ni], af[mi], acc[mi][ni], 0, 0, 0)
                           : __builtin_amdgcn_mfma_f32_16x16x32_bf16(af[mi], bfr[ni], acc[mi][ni], 0, 0, 0);
    }
  }
}

template <int TM, int TN, bool TR, class F>
__device__ __forceinline__ void epi_each(f32x4 (&acc)[TM / 32][TN / 64], F f) {
  const int tid = TID(), lane = tid & 63, wid = tid >> 6;
  const int wm = wid >> 2, wn = wid & 3, fr = lane & 15, fq = lane >> 4;
#pragma unroll
  for (int mi = 0; mi < TM / 32; ++mi)
#pragma unroll
    for (int ni = 0; ni < TN / 64; ++ni) {
      const int r0 = wm * (TM / 2) + mi * 16, c0 = wn * (TN / 4) + ni * 16;
      if (TR) f(r0 + fr, c0 + fq * 4, acc[mi][ni]);
      else f(r0 + fq * 4, c0 + fr, acc[mi][ni]);
    }
}

struct EpiStoreBf16 {
  static constexpr bool PERM = true, AFTER_DRAIN = false;
  u16* O; int ldc;
  __device__ __forceinline__ void operator()(const f32x4 (&acc)[2][2][4][2], const pg8::Unit& u, int wr, int wc, int fr, int fq) const {
    const int row0 = u.pm * 256 + wr * 64 + fr, col0 = u.pn * 256 + wc * 32 + 8 * fq;
#pragma unroll
    for (int ai = 0; ai < 2; ++ai)
#pragma unroll
      for (int m = 0; m < 4; ++m) {
        u16* rowp = O + (size_t)(row0 + ai * 128 + m * 16) * ldc + col0;
#pragma unroll
        for (int bj = 0; bj < 2; ++bj) {
          const f32x4 v0 = acc[ai][bj][m][0], v1 = acc[ai][bj][m][1];
          *(uint4*)(rowp + bj * 128) = make_uint4(pack2(v0[0], v0[1]), pack2(v0[2], v0[3]), pack2(v1[0], v1[1]), pack2(v1[2], v1[3]));
        }
      }
  }
};
struct EpiResid {
  static constexpr bool PERM = false, AFTER_DRAIN = false;
  float* X; const float* XS; const float* mod; int goff; int grow0;
  __device__ __forceinline__ void operator()(const f32x4 (&acc)[2][2][4][2], const pg8::Unit& u, int wr, int wc, int fr, int fq) const {
    const int row0 = u.pm * 256 + wr * 64 + fr, col0 = u.pn * 256 + wc * 32 + 4 * fq;
    const float* g = mod + (size_t)gb_row(grow0 + u.pm * 256) * 6144 + goff + col0;
    f32x4 gv[2][2];
#pragma unroll
    for (int bj = 0; bj < 2; ++bj)
#pragma unroll
      for (int n = 0; n < 2; ++n) gv[bj][n] = *(const f32x4*)(g + bj * 128 + n * 16);
#pragma unroll
    for (int am = 0; am < 4; ++am) {
      f32x4 xv[2][2][2];
#pragma unroll
      for (int mm = 0; mm < 2; ++mm)
#pragma unroll
        for (int bj = 0; bj < 2; ++bj)
#pragma unroll
          for (int n = 0; n < 2; ++n) xv[mm][bj][n] = *(const f32x4*)(XS + (size_t)(row0 + (am >> 1) * 128 + ((am & 1) * 2 + mm) * 16) * D + col0 + bj * 128 + n * 16);
#pragma unroll
      for (int mm = 0; mm < 2; ++mm)
#pragma unroll
        for (int bj = 0; bj < 2; ++bj)
#pragma unroll
          for (int n = 0; n < 2; ++n)
            *(f32x4*)(X + (size_t)(row0 + (am >> 1) * 128 + ((am & 1) * 2 + mm) * 16) * D + col0 + bj * 128 + n * 16) = xv[mm][bj][n] + gv[bj][n] * acc[am >> 1][bj][(am & 1) * 2 + mm][n];
    }
  }
};
struct EpiFfnVal {
  static constexpr bool PERM = false, AFTER_DRAIN = false;
  const u16* G; u16* ACT; const float* cw; const float* cb; int grow0;
  __device__ __forceinline__ void operator()(const f32x4 (&acc)[2][2][4][2], const pg8::Unit& u, int wr, int wc, int fr, int fq) const {
    const int row0 = u.pm * 256 + wr * 64 + fr, col0 = u.pn * 256 + wc * 32 + 4 * fq;
#pragma unroll
    for (int bj = 0; bj < 2; ++bj)
#pragma unroll
      for (int n = 0; n < 2; ++n) {
        const int c = col0 + bj * 128 + n * 16;
        const f32x4 w0 = *(const f32x4*)(cw + c), w1 = *(const f32x4*)(cw + DFF + c), w2 = *(const f32x4*)(cw + 2 * DFF + c), bb = *(const f32x4*)(cb + c);
#pragma unroll
        for (int ai = 0; ai < 2; ++ai) {
          uint2 g0[4], g1[4], g2[4];
#pragma unroll
          for (int m = 0; m < 4; ++m) {
            const int r = row0 + ai * 128 + m * 16;
            const int L = (grow0 + r) < 16384 ? 2048 : 8192;
            const int pos = (grow0 + r) & (L - 1);
            const u16* gp = G + (size_t)r * DFF + c;
            g1[m] = *(const uint2*)gp;
            g0[m] = *(const uint2*)(gp - (pos > 0 ? DFF : 0));
            g2[m] = *(const uint2*)(gp + (pos < L - 1 ? DFF : 0));
          }
#pragma unroll
          for (int m = 0; m < 4; ++m) {
            const int r = row0 + ai * 128 + m * 16;
            const int L = (grow0 + r) < 16384 ? 2048 : 8192;
            const int pos = (grow0 + r) & (L - 1);
            const float m0 = pos > 0 ? 1.f : 0.f, m2 = pos < L - 1 ? 1.f : 0.f;
            const uint2 a0 = g0[m], a1 = g1[m], a2 = g2[m];
            f32x4 a;
            a[0] = m0 * bf2f((u16)(a0.x & 0xffff)) * w0[0] + bf2f((u16)(a1.x & 0xffff)) * w1[0] + m2 * bf2f((u16)(a2.x & 0xffff)) * w2[0] + bb[0];
            a[1] = m0 * bf2f((u16)(a0.x >> 16)) * w0[1] + bf2f((u16)(a1.x >> 16)) * w1[1] + m2 * bf2f((u16)(a2.x >> 16)) * w2[1] + bb[1];
            a[2] = m0 * bf2f((u16)(a0.y & 0xffff)) * w0[2] + bf2f((u16)(a1.y & 0xffff)) * w1[2] + m2 * bf2f((u16)(a2.y & 0xffff)) * w2[2] + bb[2];
            a[3] = m0 * bf2f((u16)(a0.y >> 16)) * w0[3] + bf2f((u16)(a1.y >> 16)) * w1[3] + m2 * bf2f((u16)(a2.y >> 16)) * w2[3] + bb[3];
            const f32x4 v = acc[ai][bj][m][n];
            *(uint2*)(ACT + (size_t)r * DFF + c) = make_uint2(pack2(silu_f(a[0]) * v[0], silu_f(a[1]) * v[1]), pack2(silu_f(a[2]) * v[2], silu_f(a[3]) * v[3]));
          }
        }
      }
  }
};
template <class Epi>
__device__ __forceinline__ void run_gemm(const u16* A, const u16* Bt, int M, int N, int K, const Epi& E) {
  pg8::Gemm g; g.A = A; g.Bt = Bt; g.M = M; g.N = N; g.K = K;
  pg8::StaticOrder S; S.init(M, N, gridDim.x, BID());
  __syncthreads();
  pg8::gemm_phase<Epi, pg8::StaticOrder, false>((PG8_LAS unsigned char*)smem, g, S, E, nullptr);
  __syncthreads();
}

__device__ __forceinline__ int fidx(int p) { return p + ((p >> 6) << 2); }
__device__ __forceinline__ float2 cmulf(float2 a, float2 b) { return make_float2(a.x * b.x - a.y * b.y, a.x * b.y + a.y * b.x); }
__device__ __forceinline__ float2 cmulcf(float2 a, float2 b) { return make_float2(a.x * b.x + a.y * b.y, a.y * b.x - a.x * b.y); }
#define R16C(q) ((q) == 0 ? 1.f : (q) == 1 ? 0.9238795325f : (q) == 2 ? 0.7071067812f : (q) == 3 ? 0.3826834324f : (q) == 4 ? 0.f : (q) == 5 ? -0.3826834324f : (q) == 6 ? -0.7071067812f : -0.9238795325f)
#define R16S(q) ((q) == 0 ? 0.f : (q) == 1 ? -0.3826834324f : (q) == 2 ? -0.7071067812f : (q) == 3 ? -0.9238795325f : (q) == 4 ? -1.f : (q) == 5 ? -0.9238795325f : (q) == 6 ? -0.7071067812f : -0.3826834324f)
template <int N, int RS, bool INV>
__device__ __forceinline__ void fft_pass(float2* x, const float2* __restrict__ tw, const int S, const int tid) {
  constexpr int R = 1 << RS;
  const int E = S >> (RS - 1);
#pragma unroll 1
  for (int g = tid; g < N / R; g += NT) {
    const int blo = g & (E - 1);
    const int base = ((g - blo) << RS) + blo;
    float2 e[R];
#pragma unroll
    for (int k = 0; k < R; ++k) e[k] = x[fidx(base + k * E)];
    float2 wb[RS];
#pragma unroll
    for (int st = 0; st < RS; ++st) wb[st] = tw[blo * (8192 / (S >> st))];
#pragma unroll
    for (int sq = 0; sq < RS; ++sq) {
      const int st = INV ? (RS - 1 - sq) : sq;
      const int h = (R / 2) >> st;
#pragma unroll
      for (int k = 0; k < R; ++k) {
        if ((k & h) == 0) {
          const int m = k & (h - 1);
          const int q = m * (8 / h);
          float2 w = wb[st];
          if (q != 0) w = cmulf(w, make_float2(R16C(q), R16S(q)));
          if (!INV) {
            const float2 a = e[k], b = e[k + h];
            e[k] = make_float2(a.x + b.x, a.y + b.y);
            e[k + h] = cmulf(make_float2(a.x - b.x, a.y - b.y), w);
          } else {
            const float2 a = e[k], b = cmulcf(e[k + h], w);
            e[k] = make_float2(a.x + b.x, a.y + b.y);
            e[k + h] = make_float2(a.x - b.x, a.y - b.y);
          }
        }
      }
    }
#pragma unroll
    for (int k = 0; k < R; ++k) x[fidx(base + k * E)] = e[k];
  }
  __syncthreads();
}
template <int N>
__device__ __forceinline__ void fft_dif_t(float2* x, const float2* __restrict__ tw) {
  const int tid = TID();
  if (N == 16384) {
    fft_pass<N, 4, false>(x, tw, 8192, tid); fft_pass<N, 4, false>(x, tw, 512, tid);
    fft_pass<N, 4, false>(x, tw, 32, tid); fft_pass<N, 2, false>(x, tw, 2, tid);
  } else {
    fft_pass<N, 4, false>(x, tw, 2048, tid); fft_pass<N, 4, false>(x, tw, 128, tid); fft_pass<N, 4, false>(x, tw, 8, tid);
  }
}
template <int N>
__device__ __forceinline__ void ifft_dit_t(float2* x, const float2* __restrict__ tw) {
  const int tid = TID();
  if (N == 16384) {
    fft_pass<N, 2, true>(x, tw, 2, tid); fft_pass<N, 4, true>(x, tw, 32, tid);
    fft_pass<N, 4, true>(x, tw, 512, tid); fft_pass<N, 4, true>(x, tw, 8192, tid);
  } else {
    fft_pass<N, 4, true>(x, tw, 8, tid); fft_pass<N, 4, true>(x, tw, 128, tid); fft_pass<N, 4, true>(x, tw, 2048, tid);
  }
}
__device__ __forceinline__ void fft_dif(float2* x, int N, const float2* __restrict__ tw) {
  if (N == 16384) fft_dif_t<16384>(x, tw); else fft_dif_t<4096>(x, tw);
}
__device__ __forceinline__ void ifft_dit(float2* x, int N, const float2* __restrict__ tw) {
  if (N == 16384) ifft_dit_t<16384>(x, tw); else ifft_dit_t<4096>(x, tw);
}

__device__ void transpose_w(const float* __restrict__ W, u16* __restrict__ Wt, int K, int N) {
  float* smf = (float*)smem;
  const int tk = K / 64, tn = N / 64, tid = TID();
  for (int item = BID(); item < tk * tn; item += gridDim.x) {
    const int k0 = (item / tn) * 64, n0 = (item % tn) * 64;
    float4 v[2];
#pragma unroll
    for (int j = 0; j < 2; ++j) {
      const int idx = tid + j * NT, kk = idx >> 4, n4 = idx & 15;
      v[j] = *(const float4*)(W + (long)(k0 + kk) * N + n0 + n4 * 4);
    }
    __syncthreads();
#pragma unroll
    for (int j = 0; j < 2; ++j) {
      const int idx = tid + j * NT, kk = idx >> 4, n4 = idx & 15;
      float* p = smf + kk * 65 + n4 * 4;
      p[0] = v[j].x; p[1] = v[j].y; p[2] = v[j].z; p[3] = v[j].w;
    }
    __syncthreads();
    const int nn = tid >> 3, k8 = tid & 7;
    float f[8];
#pragma unroll
    for (int i = 0; i < 8; ++i) f[i] = smf[(k8 * 8 + i) * 65 + nn];
    *(uint4*)(Wt + (long)(n0 + nn) * K + k0 + k8 * 8) = pack8s(f, 1.f);
  }
  __syncthreads();
}

__device__ void phase_pre0(const Params& P) {
  const int tid = TID();
  const long gtid = (long)BID() * NT + tid, gsz = (long)gridDim.x * NT;
  transpose_w(P.in[7], (u16*)(WS(P) + O_WHYIN), 1024, 3072);
  transpose_w(P.in[18], (u16*)(WS(P) + O_WHYOUT), 1024, 1024);
  transpose_w(P.in[19], (u16*)(WS(P) + O_WRETIN), 1024, 6144);
  transpose_w(P.in[21], (u16*)(WS(P) + O_WRETOUT), 2048, 1024);
  transpose_w(P.in[22], (u16*)(WS(P) + O_WSWAIN), 1024, 1536);
  transpose_w(P.in[26], (u16*)(WS(P) + O_WSWAOUT), 1024, 1024);
  transpose_w(P.in[27], (u16*)(WS(P) + O_WHGIN), 1024, 5120);
  transpose_w(P.in[30], (u16*)(WS(P) + O_WHGOUT), 1024, 1024);
  for (int l = 0; l < 4; ++l) {
    transpose_w(P.in[31] + (long)l * 1024 * DFF, (u16*)(WS(P) + O_WFG) + (long)l * DFF * 1024, 1024, DFF);
    transpose_w(P.in[32] + (long)l * 1024 * DFF, (u16*)(WS(P) + O_WFV) + (long)l * DFF * 1024, 1024, DFF);
    transpose_w(P.in[35] + (long)l * DFF * 1024, (u16*)(WS(P) + O_WFD) + (long)l * 1024 * DFF, DFF, 1024);
  }
  {
    float* cs = (float*)smem;
    float* modp = (float*)(WS(P) + O_MODP);
    for (int item = BID(); item < 4 * 8 * 12; item += gridDim.x) {
      const int nb = item % 12, ks = (item / 12) % 8, l = item / 96;
      __syncthreads();
      for (int i = tid; i < 2048; i += NT) {
        int b = i >> 7, k = i & 127;
        float c = (b < 8) ? P.in[2][b * 1024 + ks * 128 + k] : P.in[3][(b - 8) * 1024 + ks * 128 + k];
        cs[i] = c / (1.f + expf(-c));
      }
      __syncthreads();
      const int n = nb * 512 + tid;
      float a[16];
#pragma unroll
      for (int b = 0; b < 16; ++b) a[b] = 0.f;
      const float* w = P.in[4] + ((long)l * 1024 + ks * 128) * 6144 + n;
      for (int k = 0; k < 128; ++k) {
        float wv = w[(long)k * 6144];
#pragma unroll
        for (int b = 0; b < 16; ++b) a[b] += cs[b * 128 + k] * wv;
      }
#pragma unroll
      for (int b = 0; b < 16; ++b) modp[(((long)ks * 4 + l) * 16 + b) * 6144 + n] = a[b];
    }
    __syncthreads();
  }
  {
    float2* tw = (float2*)(WS(P) + O_TW);
    for (long i = gtid; i < 8192; i += gsz) {
      float s, c;
      sincospif((float)i * (1.f / 8192.f), &s, &c);
      tw[i] = make_float2(c, -s);
    }
    float2* rr = (float2*)(WS(P) + O_ROPER);
    for (long i = gtid; i < (long)8192 * 128; i += gsz) {
      int pos = (int)(i >> 7), d = (int)(i & 127);
      float inv = exp2f(-(float)d * (13.287712379549449f / 128.f));
      float s, c;
      sincosf((float)pos * inv, &s, &c);
      rr[i] = make_float2(c, s);
    }
    float2* rs = (float2*)(WS(P) + O_ROPES);
    for (long i = gtid; i < (long)8192 * 32; i += gsz) {
      int pos = (int)(i >> 5), d = (int)(i & 31);
      float inv = exp2f(-(float)d * (13.287712379549449f / 32.f));
      float s, c;
      sincosf((float)pos * inv, &s, &c);
      rs[i] = make_float2(c, s);
    }
  }
  {
    float* zf = (float*)smem;
    float* h1 = zf + 8 * 36;
    const float* w1 = P.in[10]; const float* b1 = P.in[11]; const float* w2 = P.in[12]; const float* b2 = P.in[13];
    const float* fr = P.in[15];
    const int tl = tid >> 6, j = tid & 63;
    for (int item = BID(); item < 1280; item += gridDim.x) {
      const int sel = item >= 1024;
      const int L = sel ? 2048 : 8192;
      const int t = (sel ? item - 1024 : item) * 8 + tl;
      float* hid = (float*)(WS(P) + (sel ? O_HIDP : O_HIDS));
      __syncthreads();
      if (j < 33) {
        float v;
        if (j == 0) v = (float)t / (float)(L - 1);
        else {
          int i = (j - 1) & 15;
          float band = 1e-4f + (float)i * ((15.f - 1e-4f) / 15.f);
          float ang = (6.283185307179586f / (float)L) * (float)t;
          float a = band * ang;
          v = (j <= 16) ? cosf(a) : -sinf(a);
        }
        zf[tl * 36 + j] = v;
      }
      __syncthreads();
      float s = b1[j];
#pragma unroll 3
      for (int i = 0; i < 33; ++i) s += zf[tl * 36 + i] * w1[i * 64 + j];
      h1[tl * 64 + j] = sinf(fr[j] * s);
      __syncthreads();
      float s2 = b2[j];
#pragma unroll 4
      for (int i = 0; i < 64; ++i) s2 += h1[tl * 64 + i] * w2[i * 64 + j];
      hid[(long)t * 64 + j] = sinf(fr[j] * s2);
    }
    __syncthreads();
  }
}

__device__ void phase_pre1(const Params& P) {
  __shared__ float w3s[128];
  __shared__ float red[8];
  const int tid = TID(), lane = tid & 63, wid = tid >> 6;
  const long gtid = (long)BID() * NT + tid, gsz = (long)gridDim.x * NT;
  {
    const float* modp = (const float*)(WS(P) + O_MODP);
    float* mod = (float*)(WS(P) + O_MOD);
    for (long i = gtid; i < (long)4 * 16 * 6144; i += gsz) {
      int n = (int)(i % 6144);
      int l = (int)(i / (16 * 6144));
      float s = P.in[5][l * 6144 + n];
      for (int ks = 0; ks < 8; ++ks) s += modp[(long)ks * 4 * 16 * 6144 + i];
      mod[i] = s;
    }
  }
  float2* buf = (float2*)smem;
  const float2* tw = (const float2*)(WS(P) + O_TW);
  for (int item = BID(); item < 2048; item += gridDim.x) {
    const int sel = item >> 10, c = item & 1023;
    const int L = sel ? 2048 : 8192, N = 2 * L;
    const float* hid = (const float*)(WS(P) + (sel ? O_HIDP : O_HIDS));
    float2* hs = (float2*)(WS(P) + (sel ? O_HSPP : O_HSPS)) + (long)c * N;
    __syncthreads();
    if (tid < 128) {
      int dirn = tid >> 6, j = tid & 63;
      w3s[tid] = P.in[14][(long)j * 2048 + dirn * 1024 + c];
    }
    __syncthreads();
    const float dec0 = fabsf(P.in[16][c]), dec1 = fabsf(P.in[16][1024 + c]);
    const float invLm1 = 1.f / (float)(L - 1);
    float asum = 0.f;
    for (int n = tid; n < N; n += NT) {
      float val = 0.f;
      if (n != L) {
        const int dirn = n < L ? 0 : 1;
        const int t = n < L ? n : N - n;
        const float4* hr = (const float4*)(hid + (long)t * 64);
        const float* w = w3s + dirn * 64;
        float s = 0.f;
#pragma unroll
        for (int q = 0; q < 16; ++q) {
          float4 h4 = hr[q];
          s += h4.x * w[4 * q] + h4.y * w[4 * q + 1] + h4.z * w[4 * q + 2] + h4.w * w[4 * q + 3];
        }
        float tl = (float)t * invLm1;
        val = s * expf(-tl * (dirn ? dec1 : dec0));
      }
      buf[fidx(n)] = make_float2(val, 0.f);
      asum += fabsf(val);
    }
    asum = wave_sum(asum);
    if (lane == 0) red[wid] = asum;
    __syncthreads();
    float tot = 0.f;
#pragma unroll
    for (int w = 0; w < 8; ++w) tot += red[w];
    const float scale = 1.f / (tot * (float)N);
    fft_dif(buf, N, tw);
    for (int p = tid; p < N; p += NT) {
      float2 a = buf[fidx(p)];
      hs[p] = make_float2(a.x * scale, a.y * scale);
    }
  }
  __syncthreads();
}

__device__ void phase_norm(const Params& P, int layer, int sl, int which) {
  const int grow0 = which ? sl * FSLAB : sl * SLAB, nrows = which ? FSLAB : SLAB;
  const float* __restrict__ x = (layer == 0 && which == 0) ? xin_of(P, sl) : (const float*)(OUTP(P) + (long)grow0 * D);
  u16* __restrict__ h = (u16*)(WS(P) + (which ? O_FHBUF : O_HBUF));
  const float* gain = P.in[6] + (layer * 2 + which) * D;
  const float* mod = (const float*)(WS(P) + O_MOD) + (long)layer * 16 * 6144;
  const int shoff = which ? 3 * D : 0, scoff = which ? 4 * D : D;
  const int tid = TID(), lane = tid & 63, wid = tid >> 6;
  for (int item = BID(); item < nrows / 32; item += gridDim.x) {
    const int r0 = item * 32 + wid * 4;
    float4 v[4][4];
    float ss[4];
#pragma unroll
    for (int u = 0; u < 4; ++u) {
      const float* xr = x + (long)(r0 + u) * D;
      float a = 0.f;
#pragma unroll
      for (int i = 0; i < 4; ++i) {
        v[u][i] = *(const float4*)(xr + i * 256 + lane * 4);
        a += v[u][i].x * v[u][i].x + v[u][i].y * v[u][i].y + v[u][i].z * v[u][i].z + v[u][i].w * v[u][i].w;
      }
      ss[u] = a;
    }
    const float* m = mod + (long)gb_row(grow0 + r0) * 6144;
#pragma unroll
    for (int u = 0; u < 4; ++u) ss[u] = wave_sum(ss[u]);
#pragma unroll
    for (int i = 0; i < 4; ++i) {
      const int col = i * 256 + lane * 4;
      const float4 g = *(const float4*)(gain + col);
      const float4 sc = *(const float4*)(m + scoff + col);
      const float4 sh = *(const float4*)(m + shoff + col);
      const float a0 = g.x * (1.f + sc.x), a1 = g.y * (1.f + sc.y), a2 = g.z * (1.f + sc.z), a3 = g.w * (1.f + sc.w);
#pragma unroll
      for (int u = 0; u < 4; ++u) {
        const float rstd = rsqrtf(ss[u] * (1.f / 1024.f) + 1e-6f);
        const float y0 = v[u][i].x * rstd * a0 + sh.x, y1 = v[u][i].y * rstd * a1 + sh.y;
        const float y2 = v[u][i].z * rstd * a2 + sh.z, y3 = v[u][i].w * rstd * a3 + sh.w;
        *(uint2*)(h + (long)(r0 + u) * D + col) = make_uint2(pack2(y0, y1), pack2(y2, y3));
      }
    }
  }
}

__device__ void phase_proj(const Params& P, size_t woff, int N) {
  EpiStoreBf16 E; E.O = (u16*)(WS(P) + O_PROJ); E.ldc = N;
  run_gemm((const u16*)(WS(P) + O_HBUF), (const u16*)(WS(P) + woff), SLAB, N, D, E);
}
__device__ void phase_resid(const Params& P, int layer, int slab, const u16* A, int K, size_t woff, int goff) {
  EpiResid E; E.X = OUTP(P) + (long)slab * SLAB * D; E.XS = (layer == 0) ? xin_of(P, slab) : (const float*)E.X; E.mod = (const float*)(WS(P) + O_MOD) + (long)layer * 16 * 6144; E.goff = goff; E.grow0 = slab * SLAB;
  run_gemm(A, (const u16*)(WS(P) + woff), SLAB, D, K, E);
}

__device__ void phase_ffn_gate(const Params& P, int layer) {
  EpiStoreBf16 E; E.O = (u16*)(WS(P) + O_FGBUF); E.ldc = DFF;
  run_gemm((const u16*)(WS(P) + O_FHBUF), (const u16*)(WS(P) + O_WFG) + (long)layer * DFF * D, FSLAB, DFF, D, E);
}
__device__ void phase_ffn_val(const Params& P, int layer, int fs) {
  EpiFfnVal E; E.G = (const u16*)(WS(P) + O_FGBUF); E.ACT = (u16*)(WS(P) + O_FACT) + (long)fs * FSLAB * DFF;
  E.cw = P.in[33] + (long)layer * 3 * DFF; E.cb = P.in[34] + (long)layer * DFF; E.grow0 = fs * FSLAB;
  run_gemm((const u16*)(WS(P) + O_FHBUF), (const u16*)(WS(P) + O_WFV) + (long)layer * DFF * D, FSLAB, DFF, D, E);
}
__device__ void phase_ffn_down(const Params& P, int layer) {
  EpiResid E; E.X = OUTP(P); E.XS = E.X; E.mod = (const float*)(WS(P) + O_MOD) + (long)layer * 16 * 6144; E.goff = 5 * D; E.grow0 = 0;
  run_gemm((const u16*)(WS(P) + O_FACT), (const u16*)(WS(P) + O_WFD) + (long)layer * D * DFF, NTOK, D, DFF, E);
}

__device__ void phase_hy_conv(const Params& P, int slab) {
  const int L = Lof(slab), nseq = SLAB / L, tid = TID();
  const u16* __restrict__ z = (const u16*)(WS(P) + O_PROJ);
  float* __restrict__ uT = (float*)(WS(P) + O_UT);
  u16* __restrict__ x0c = (u16*)(WS(P) + O_X0C);
  const float* cw = P.in[8];
  const float* cb = P.in[9];
  float* tile = (float*)smem;
  const int ntt = L / 64;
  const int nitems = nseq * ntt * 16;
  const int tl = tid >> 3, cg = tid & 7;
  for (int item = BID(); item < nitems; item += gridDim.x) {
    const int ct = item % 16, tt = (item / 16) % ntt, seq = item / (16 * ntt);
    const int t = tt * 64 + tl, c0 = ct * 64 + cg * 8;
    const long row = (long)seq * L + t;
    const float mp = t > 0 ? 1.f : 0.f, mn = t < L - 1 ? 1.f : 0.f;
    const long rp = t > 0 ? row - 1 : row, rn = t < L - 1 ? row + 1 : row;
    float val[3][8];
#pragma unroll
    for (int q = 0; q < 3; ++q) {
      const int col = q * 1024 + c0;
      float a[8], b[8], c[8];
      unpack8(*(const uint4*)(z + rp * 3072 + col), a);
      unpack8(*(const uint4*)(z + row * 3072 + col), b);
      unpack8(*(const uint4*)(z + rn * 3072 + col), c);
      const float4 w0a = *(const float4*)(cw + col), w0b = *(const float4*)(cw + col + 4);
      const float4 w1a = *(const float4*)(cw + 3072 + col), w1b = *(const float4*)(cw + 3072 + col + 4);
      const float4 w2a = *(const float4*)(cw + 6144 + col), w2b = *(const float4*)(cw + 6144 + col + 4);
      const float4 ba = *(const float4*)(cb + col), bb = *(const float4*)(cb + col + 4);
      const float w0[8] = {w0a.x, w0a.y, w0a.z, w0a.w, w0b.x, w0b.y, w0b.z, w0b.w};
      const float w1[8] = {w1a.x, w1a.y, w1a.z, w1a.w, w1b.x, w1b.y, w1b.z, w1b.w};
      const float w2[8] = {w2a.x, w2a.y, w2a.z, w2a.w, w2b.x, w2b.y, w2b.z, w2b.w};
      const float bs[8] = {ba.x, ba.y, ba.z, ba.w, bb.x, bb.y, bb.z, bb.w};
#pragma unroll
      for (int i = 0; i < 8; ++i) val[q][i] = mp * a[i] * w0[i] + b[i] * w1[i] + mn * c[i] * w2[i] + bs[i];
    }
    *(uint4*)(x0c + row * 1024 + c0) = pack8s(val[0], 1.f);
    __syncthreads();
#pragma unroll
    for (int i = 0; i < 8; ++i) tile[tl * 65 + cg * 8 + i] = val[1][i] * val[2][i];
    __syncthreads();
    {
      const int cl = tid >> 3, tq = tid & 7;
      float* dst = uT + ((long)seq * 1024 + ct * 64 + cl) * L + tt * 64 + tq * 8;
      float4 o0, o1;
      o0.x = tile[(tq * 8 + 0) * 65 + cl]; o0.y = tile[(tq * 8 + 1) * 65 + cl]; o0.z = tile[(tq * 8 + 2) * 65 + cl]; o0.w = tile[(tq * 8 + 3) * 65 + cl];
      o1.x = tile[(tq * 8 + 4) * 65 + cl]; o1.y = tile[(tq * 8 + 5) * 65 + cl]; o1.z = tile[(tq * 8 + 6) * 65 + cl]; o1.w = tile[(tq * 8 + 7) * 65 + cl];
      *(float4*)dst = o0; *(float4*)(dst + 4) = o1;
    }
  }
  __syncthreads();
}

__device__ void phase_hy_fft(const Params& P, int slab, bool dry = false) {
  const int L = Lof(slab), N = 2 * L, nseq = SLAB / L, tid = TID();
  float* uT = (float*)(WS(P) + O_UT);
  const float2* hsb = (const float2*)(WS(P) + (slab == 0 ? O_HSPP : O_HSPS));
  const float2* tw = (const float2*)(WS(P) + O_TW);
  const float* skip = P.in[17];
  float2* buf = (float2*)smem;
  const int nitems = (nseq / 2) * 1024;
  for (int item = BID(); item < nitems; item += gridDim.x) {
    const int pr = item >> 10, c = item & 1023;
    float* u0 = uT + ((long)(pr * 2) * 1024 + c) * L;
    float* u1 = u0 + (long)1024 * L;
    __syncthreads();
    for (int t = tid; t < L; t += NT) {
      buf[fidx(t)] = make_float2(u0[t], u1[t]);
      buf[fidx(t + L)] = make_float2(0.f, 0.f);
    }
    __syncthreads();
    fft_dif(buf, N, tw);
    const float2* h = hsb + (long)c * N;
    for (int p = tid; p < N; p += NT) {
      float2 a = buf[fidx(p)], b = h[p];
      buf[fidx(p)] = make_float2(a.x * b.x - a.y * b.y, a.x * b.y + a.y * b.x);
    }
    __syncthreads();
    ifft_dit(buf, N, tw);
    const float sk = skip[c];
    for (int t = tid; t < L; t += NT) {
      float2 y = buf[fidx(t)];
      const long doff = dry ? (long)(END_HY - O_UT) / 4 : 0;
      u0[t + doff] = y.x + u0[t] * sk;
      u1[t + doff] = y.y + u1[t] * sk;
    }
  }
  __syncthreads();
}

__device__ void phase_hy_tr(const Params& P, int slab) {
  const int L = Lof(slab), nseq = SLAB / L, tid = TID();
  const float* __restrict__ yT = (const float*)(WS(P) + O_UT);
  const u16* __restrict__ x0c = (const u16*)(WS(P) + O_X0C);
  u16* __restrict__ a2 = (u16*)(WS(P) + O_A2);
  float* tile = (float*)smem;
  const int ntt = L / 64;
  const int nitems = nseq * ntt * 16;
  for (int item = BID(); item < nitems; item += gridDim.x) {
    const int ct = item % 16, tt = (item / 16) % ntt, seq = item / (16 * ntt);
    const int cl = tid >> 3, tq = tid & 7;
    const float* src = yT + ((long)seq * 1024 + ct * 64 + cl) * L + tt * 64 + tq * 8;
    const float4 i0 = *(const float4*)src, i1 = *(const float4*)(src + 4);
    const int tl = tid >> 3, cg = tid & 7;
    const long row = (long)seq * L + tt * 64 + tl;
    const int c0 = ct * 64 + cg * 8;
    float xg[8];
    unpack8(*(const uint4*)(x0c + row * 1024 + c0), xg);
    __syncthreads();
    float* p = tile + cl * 65 + tq * 8;
    p[0] = i0.x; p[1] = i0.y; p[2] = i0.z; p[3] = i0.w; p[4] = i1.x; p[5] = i1.y; p[6] = i1.z; p[7] = i1.w;
    __syncthreads();
    float o[8];
#pragma unroll
    for (int i = 0; i < 8; ++i) o[i] = tile[(cg * 8 + i) * 65 + tl] * xg[i];
    *(uint4*)(a2 + row * 1024 + c0) = pack8s(o, 1.f);
  }
  __syncthreads();
}

struct Rec {
  int H, DK, DV, C;
  int ldv, voff, goff;
};
__device__ __forceinline__ Rec rec_of(int kind) {
  Rec r;
  if (kind == 1) { r.H = 4; r.DK = 256; r.DV = 512; r.C = 128; r.ldv = 6144; r.voff = 2048; r.goff = 4096; }
  else { r.H = 8; r.DK = 128; r.DV = 128; r.C = 64; r.ldv = 5120; r.voff = 1024; r.goff = 4096; }
  return r;
}

__device__ void phase_ret_prep(const Params& P, int slab) {
  const int L = Lof(slab);
  const u16* __restrict__ pj = (const u16*)(WS(P) + O_PROJ);
  u16* __restrict__ qdf = (u16*)(WS(P) + O_QDF); u16* __restrict__ qdb = (u16*)(WS(P) + O_QDB);
  u16* __restrict__ kif = (u16*)(WS(P) + O_KIF); u16* __restrict__ kib = (u16*)(WS(P) + O_KIB);
  u16* __restrict__ kef = (u16*)(WS(P) + O_KEF); u16* __restrict__ keb = (u16*)(WS(P) + O_KEB);
  float* dlf = (float*)(WS(P) + O_DLF); float* dlb = (float*)(WS(P) + O_DLB);
  const float2* __restrict__ rope = (const float2*)(WS(P) + O_ROPER);
  const long gtid = (long)BID() * NT + TID(), gsz = (long)gridDim.x * NT;
  for (long idx = gtid; idx < (long)SLAB * 64; idx += gsz) {
    const int d0 = (int)(idx & 15) * 8, h = (int)((idx >> 4) & 3), t = (int)(idx >> 6);
    const int pos = t & (L - 1), r = t & 127;
    const float lgf = -expf(P.in[20][h]), lgb = -expf(P.in[20][4 + h]);
    const u16* row = pj + (long)t * 6144 + h * 256 + d0;
    const uint4 vq1 = *(const uint4*)row, vq2 = *(const uint4*)(row + 128);
    const uint4 vk1 = *(const uint4*)(row + 1024), vk2 = *(const uint4*)(row + 1024 + 128);
    const float4* rp = (const float4*)(rope + (long)pos * 128 + d0);
    const float4 c01 = rp[0], c23 = rp[1], c45 = rp[2], c67 = rp[3];
    float q1[8], q2[8], k1[8], k2[8];
    unpack8(vq1, q1); unpack8(vq2, q2); unpack8(vk1, k1); unpack8(vk2, k2);
    const float cs[8] = {c01.x, c01.z, c23.x, c23.z, c45.x, c45.z, c67.x, c67.z};
    const float sn[8] = {c01.y, c01.w, c23.y, c23.w, c45.y, c45.w, c67.y, c67.w};
    float qa[8], qb[8], ka[8], kb[8];
#pragma unroll
    for (int i = 0; i < 8; ++i) {
      qa[i] = q1[i] * cs[i] - q2[i] * sn[i]; qb[i] = q1[i] * sn[i] + q2[i] * cs[i];
      ka[i] = (k1[i] * cs[i] - k2[i] * sn[i]) * 0.0625f; kb[i] = (k1[i] * sn[i] + k2[i] * cs[i]) * 0.0625f;
    }
    const float bf = (float)(r + 1) * lgf, bb = (float)(128 - r) * lgb;
    const float ef = expf(bf), eif = expf(-bf), eef = expf((float)(127 - r) * lgf);
    const float eb = expf(bb), eib = expf(-bb), eeb = expf((float)r * lgb);
    const long o1 = (long)t * 1024 + h * 256 + d0, o2 = o1 + 128;
    *(uint4*)(qdf + o1) = pack8s(qa, ef); *(uint4*)(qdf + o2) = pack8s(qb, ef);
    *(uint4*)(qdb + o1) = pack8s(qa, eb); *(uint4*)(qdb + o2) = pack8s(qb, eb);
    *(uint4*)(kif + o1) = pack8s(ka, eif); *(uint4*)(kif + o2) = pack8s(kb, eif);
    *(uint4*)(kib + o1) = pack8s(ka, eib); *(uint4*)(kib + o2) = pack8s(kb, eib);
    *(uint4*)(kef + o1) = pack8s(ka, eef); *(uint4*)(kef + o2) = pack8s(kb, eef);
    *(uint4*)(keb + o1) = pack8s(ka, eeb); *(uint4*)(keb + o2) = pack8s(kb, eeb);
    if (r == 0) {
      const long cgi = (long)(t >> 7) * 1024 + h * 256 + d0;
      const float df = expf(128.f * lgf), db = expf(128.f * lgb);
#pragma unroll
      for (int i = 0; i < 8; ++i) { dlf[cgi + i] = df; dlf[cgi + 128 + i] = df; dlb[cgi + i] = db; dlb[cgi + 128 + i] = db; }
    }
  }
}

__device__ __forceinline__ float lb_of(const float* lbt, int dr, int ch) {
  const float a0 = lbt[(dr * 4 + 0) * 1024 + ch], a1 = lbt[(dr * 4 + 1) * 1024 + ch], a2 = lbt[(dr * 4 + 2) * 1024 + ch], a3 = lbt[(dr * 4 + 3) * 1024 + ch];
  const float m = fmaxf(fmaxf(a0, a1), fmaxf(a2, a3));
  const float e0 = expf(a0 - m), e1 = expf(a1 - m), e2 = expf(a2 - m), e3 = expf(a3 - m);
  return (e0 + e1 + e2) / (e0 + e1 + e2 + e3);
}
__device__ void phase_hg_prep(const Params& P) {
  const u16* __restrict__ pj = (const u16*)(WS(P) + O_PROJ);
  u16* __restrict__ qdf = (u16*)(WS(P) + O_QDF); u16* __restrict__ qdb = (u16*)(WS(P) + O_QDB);
  u16* __restrict__ kif = (u16*)(WS(P) + O_KIF); u16* __restrict__ kib = (u16*)(WS(P) + O_KIB);
  u16* __restrict__ kef = (u16*)(WS(P) + O_KEF); u16* __restrict__ keb = (u16*)(WS(P) + O_KEB);
  float* dlf = (float*)(WS(P) + O_DLF); float* dlb = (float*)(WS(P) + O_DLB);
  const float* lbt = P.in[28];
  float* totF = (float*)smem;
  float* totB = totF + 1024;
  const int tid = TID(), lane = tid & 63, rg = tid >> 6;
  for (int item = BID(); item < 2048; item += gridDim.x) {
    const int cgi = item >> 3, ch = (item & 7) * 128 + lane * 2;
    const long t0 = (long)cgi * 64 + rg * 8;
    unsigned wq[8], wf[8], wb[8];
#pragma unroll
    for (int i = 0; i < 8; ++i) {
      const u16* row = pj + (t0 + i) * 5120 + ch;
      wq[i] = *(const unsigned*)row; wf[i] = *(const unsigned*)(row + 2048); wb[i] = *(const unsigned*)(row + 3072);
    }
    float lb0[2], lb1[2];
    lb0[0] = lb_of(lbt, 0, ch); lb0[1] = lb_of(lbt, 0, ch + 1);
    lb1[0] = lb_of(lbt, 1, ch); lb1[1] = lb_of(lbt, 1, ch + 1);
    float pf[2][8], sb[2][8], accf[2], accb[2];
#pragma unroll
    for (int c = 0; c < 2; ++c) {
      float a = 0.f;
#pragma unroll
      for (int i = 0; i < 8; ++i) {
        const float x = bf2f((u16)(c ? (wf[i] >> 16) : (wf[i] & 0xffff)));
        a += logf(lb0[c] + (1.f - lb0[c]) * sigm(x)); pf[c][i] = a;
      }
      accf[c] = a;
      a = 0.f;
#pragma unroll
      for (int i = 7; i >= 0; --i) {
        const float x = bf2f((u16)(c ? (wb[i] >> 16) : (wb[i] & 0xffff)));
        a += logf(lb1[c] + (1.f - lb1[c]) * sigm(x)); sb[c][i] = a;
      }
      accb[c] = a;
    }
    __syncthreads();
    *(float2*)(totF + rg * 128 + lane * 2) = make_float2(accf[0], accf[1]);
    *(float2*)(totB + rg * 128 + lane * 2) = make_float2(accb[0], accb[1]);
    __syncthreads();
    float offF[2] = {0.f, 0.f}, offB[2] = {0.f, 0.f}, totf[2] = {0.f, 0.f}, totb[2] = {0.f, 0.f};
#pragma unroll
    for (int g = 0; g < 8; ++g) {
      const float2 f = *(const float2*)(totF + g * 128 + lane * 2), bq = *(const float2*)(totB + g * 128 + lane * 2);
      totf[0] += f.x; totf[1] += f.y; totb[0] += bq.x; totb[1] += bq.y;
      if (g < rg) { offF[0] += f.x; offF[1] += f.y; }
      if (g > rg) { offB[0] += bq.x; offB[1] += bq.y; }
    }
#pragma unroll
    for (int i = 0; i < 8; ++i) {
      float o[6][2];
#pragma unroll
      for (int c = 0; c < 2; ++c) {
        const float xq = bf2f((u16)(c ? (wq[i] >> 16) : (wq[i] & 0xffff)));
        const float xf = bf2f((u16)(c ? (wf[i] >> 16) : (wf[i] & 0xffff)));
        const float xb = bf2f((u16)(c ? (wb[i] >> 16) : (wb[i] & 0xffff)));
        const float q = silu_f(xq);
        const float bf = offF[c] + pf[c][i], bb = offB[c] + sb[c][i];
        const float kf = (1.f - lb0[c]) * sigm(-xf), kb = (1.f - lb1[c]) * sigm(-xb);
        o[0][c] = q * expf(bf); o[1][c] = kf * expf(-bf); o[2][c] = kf * expf(totf[c] - bf);
        o[3][c] = q * expf(bb); o[4][c] = kb * expf(-bb); o[5][c] = kb * expf(totb[c] - bb);
      }
      const long oo = (t0 + i) * 1024 + ch;
      *(unsigned*)(qdf + oo) = pack2(o[0][0], o[0][1]);
      *(unsigned*)(kif + oo) = pack2(o[1][0], o[1][1]);
      *(unsigned*)(kef + oo) = pack2(o[2][0], o[2][1]);
      *(unsigned*)(qdb + oo) = pack2(o[3][0], o[3][1]);
      *(unsigned*)(kib + oo) = pack2(o[4][0], o[4][1]);
      *(unsigned*)(keb + oo) = pack2(o[5][0], o[5][1]);
    }
    if (rg == 0) {
      *(float2*)(dlf + (long)cgi * 1024 + ch) = make_float2(expf(totf[0]), expf(totf[1]));
      *(float2*)(dlb + (long)cgi * 1024 + ch) = make_float2(expf(totb[0]), expf(totb[1]));
    }
  }
  __syncthreads();
}

template <int C>
__device__ __forceinline__ void rec_scores_item(const Params& P, const Rec& R, int cgi, int h) {
  const u16* qdf = (const u16*)(WS(P) + O_QDF); const u16* qdb = (const u16*)(WS(P) + O_QDB);
  const u16* kif = (const u16*)(WS(P) + O_KIF); const u16* kib = (const u16*)(WS(P) + O_KIB);
  u16* sc = (u16*)(WS(P) + O_SC) + ((long)cgi * R.H + h) * C * C;
  const long off = (long)cgi * C * 1024 + h * R.DK;
  f32x4 af[C / 32][C / 64] = {}, ab[C / 32][C / 64] = {};
  gemm_acc<C, C, true, true, true, (C == 128 ? 4 : 2)>(af, qdf + off, 1024, kif + off, 1024, (u16*)smem);
  gemm_acc<C, C, true, true, true, (C == 128 ? 4 : 2)>(ab, qdb + off, 1024, kib + off, 1024, (u16*)smem);
  const int tid = TID(), lane = tid & 63, wid = tid >> 6;
  const int wm = wid >> 2, wn = wid & 3, fr = lane & 15, fq = lane >> 4;
#pragma unroll
  for (int mi = 0; mi < C / 32; ++mi)
#pragma unroll
    for (int ni = 0; ni < C / 64; ++ni) {
      const int r = wm * (C / 2) + mi * 16 + fr, c0 = wn * (C / 4) + ni * 16 + fq * 4;
      float v[4];
#pragma unroll
      for (int j = 0; j < 4; ++j) {
        const int c = c0 + j;
        v[j] = (c <= r ? af[mi][ni][j] : 0.f) + (c >= r ? ab[mi][ni][j] : 0.f);
      }
      *(uint2*)(sc + r * C + c0) = make_uint2(pack2(v[0], v[1]), pack2(v[2], v[3]));
    }
}

template <int C>
__device__ void phase_rec_su(const Params& P, int kind) {
  const Rec R = rec_of(kind);
  constexpr int KTU = C / 64;
  const int nch = SLAB / C;
  const int n_sc = nch * R.H;
  const int mtn = R.DK / 128, ntn = R.DV / 128;
  const int n_u = nch * R.H * 2 * mtn * ntn, G = gridDim.x;
  const u16* pj = (const u16*)(WS(P) + O_PROJ);
  for (int item = BID(); item < n_sc; item += G) rec_scores_item<C>(P, R, item / R.H, item % R.H);
  const u16* kef = (const u16*)(WS(P) + O_KEF); const u16* keb = (const u16*)(WS(P) + O_KEB);
  u16* stfb = (u16*)(WS(P) + O_STF); u16* stbb = (u16*)(WS(P) + O_STB);
  Tiles<KTU> ta, tb;
#define U_DECODE(q_, nt_, mt_, dir_, h_, cgi_) int nt_, mt_, dir_, h_, cgi_; { int qq = (q_); nt_ = qq % ntn; qq /= ntn; mt_ = qq % mtn; qq /= mtn; dir_ = qq & 1; qq >>= 1; h_ = qq % R.H; cgi_ = qq / R.H; }
#define U_ISSUE(T_, nt_, mt_, dir_, h_, cgi_) tiles_issue<128, 128, false, false, KTU>(T_, (dir_ ? keb : kef) + (long)cgi_ * C * 1024 + h_ * R.DK + mt_ * 128, 1024, pj + (long)cgi_ * C * R.ldv + R.voff + h_ * R.DV + nt_ * 128, R.ldv)
#define U_RUN(T_, nt_, mt_, dir_, h_, cgi_) { f32x4 acc[4][2] = {}; gemm_run<128, 128, false, false, false, KTU>(acc, T_, (u16*)smem); \
    u16* st = (dir_ ? stbb : stfb) + (((long)cgi_ * R.H + h_) * R.DV + nt_ * 128) * R.DK + mt_ * 128; const int DK = R.DK; \
    epi_each<128, 128, false>(acc, [&](int r, int c, f32x4 val) { *(uint2*)(st + (long)c * DK + r) = make_uint2(pack2(val[0], val[1]), pack2(val[2], val[3])); }); }
  int q = BID();
  if (q < n_u) { U_DECODE(q, nt, mt, dir, h, cgi); U_ISSUE(ta, nt, mt, dir, h, cgi); }
  for (; q < n_u; q += 2 * G) {
    U_DECODE(q, nt, mt, dir, h, cgi);
    const int q2 = q + G;
    if (q2 < n_u) { U_DECODE(q2, nt2, mt2, dir2, h2, cgi2); U_ISSUE(tb, nt2, mt2, dir2, h2, cgi2); }
    U_RUN(ta, nt, mt, dir, h, cgi);
    const int q3 = q + 2 * G;
    if (q3 < n_u) { U_DECODE(q3, nt3, mt3, dir3, h3, cgi3); U_ISSUE(ta, nt3, mt3, dir3, h3, cgi3); }
    if (q2 < n_u) { U_DECODE(q2, nt2, mt2, dir2, h2, cgi2); U_RUN(tb, nt2, mt2, dir2, h2, cgi2); }
  }
#undef U_DECODE
#undef U_ISSUE
#undef U_RUN
  __syncthreads();
}

__device__ void phase_rec_scan(const Params& P, int kind, int slab, bool dry = false) {
  const Rec R = rec_of(kind);
  const int L = Lof(slab), nseq = SLAB / L, ncs = L / R.C;
  const int qdk = R.DK / 4;
  const long per = (long)R.H * R.DV * qdk;
  const long total = 2 * nseq * per;
  const long gtid = (long)BID() * NT + TID(), gsz = (long)gridDim.x * NT;
  for (long idx = gtid; idx < total; idx += gsz) {
    long q = idx;
    const int pd = (int)(q % qdk); q /= qdk;
    const int e = (int)(q % R.DV); q /= R.DV;
    const int h = (int)(q % R.H); q /= R.H;
    const int seq = (int)(q % nseq);
    const int dir = (int)(q / nseq);
    u16* st = (u16*)(WS(P) + (dir ? O_STB : O_STF));
    u16* stw = dry ? (u16*)(WS(P) + O_OBUF) : st;
    const float* dl = (const float*)(WS(P) + (dir ? O_DLB : O_DLF));
    float s0 = 0.f, s1 = 0.f, s2 = 0.f, s3 = 0.f;
    const long ebase = ((long)h * R.DV + e) * R.DK + pd * 4;
    const long cstride = (long)R.H * R.DV * R.DK;
    const int dbase = h * R.DK + pd * 4;
    for (int i0 = 0; i0 < ncs; i0 += 8) {
      uint2 u[8];
      float4 dd[8];
#pragma unroll
      for (int j = 0; j < 8; ++j) {
        const int n = dir ? (ncs - 1 - i0 - j) : (i0 + j);
        const long cgi = (long)seq * ncs + n;
        u[j] = *(const uint2*)(st + cgi * cstride + ebase);
        dd[j] = *(const float4*)(dl + cgi * 1024 + dbase);
      }
#pragma unroll
      for (int j = 0; j < 8; ++j) {
        const int n = dir ? (ncs - 1 - i0 - j) : (i0 + j);
        const long cgi = (long)seq * ncs + n;
        *(uint2*)(stw + cgi * cstride + ebase) = make_uint2(pack2(s0, s1), pack2(s2, s3));
        s0 = dd[j].x * s0 + bf2f((u16)(u[j].x & 0xffff));
        s1 = dd[j].y * s1 + bf2f((u16)(u[j].x >> 16));
        s2 = dd[j].z * s2 + bf2f((u16)(u[j].y & 0xffff));
        s3 = dd[j].w * s3 + bf2f((u16)(u[j].y >> 16));
      }
    }
  }
}

template <int C>
__device__ void phase_rec_out(const Params& P, int kind) {
  const Rec R = rec_of(kind);
  constexpr int KT1 = C / 64, KT2 = (C == 128 ? 4 : 2);
  const int nch = SLAB / C, ntn = R.DV / 128;
  const u16* pj = (const u16*)(WS(P) + O_PROJ);
  const u16* scb = (const u16*)(WS(P) + O_SC);
  const u16* qdf = (const u16*)(WS(P) + O_QDF); const u16* qdb = (const u16*)(WS(P) + O_QDB);
  const u16* stf = (const u16*)(WS(P) + O_STF); const u16* stb = (const u16*)(WS(P) + O_STB);
  u16* ob = (u16*)(WS(P) + O_OBUF);
  const int HDV = R.H * R.DV;
  const int nitems = nch * R.H * ntn, G = gridDim.x;
  Tiles<KT1> t1; Tiles<KT2> t2; Tiles<KT2> t3;
  int item = BID();
  if (item < nitems) {
    const int nt = item % ntn, h = (item / ntn) % R.H, cgi = item / (ntn * R.H);
    tiles_issue<C, 128, true, false, KT1>(t1, scb + ((long)cgi * R.H + h) * C * C, C, pj + (long)cgi * C * R.ldv + R.voff + h * R.DV + nt * 128, R.ldv);
  }
  for (; item < nitems; item += G) {
    const int nt = item % ntn, h = (item / ntn) % R.H, cgi = item / (ntn * R.H);
    const long qoff = (long)cgi * C * 1024 + h * R.DK;
    const long soff = (((long)cgi * R.H + h) * R.DV + nt * 128) * R.DK;
    f32x4 acc[C / 32][2] = {};
    tiles_issue<C, 128, true, true, KT2>(t2, qdf + qoff, 1024, stf + soff, R.DK);
    gemm_run<C, 128, true, false, true, KT1>(acc, t1, (u16*)smem);
    tiles_issue<C, 128, true, true, KT2>(t3, qdb + qoff, 1024, stb + soff, R.DK);
    gemm_run<C, 128, true, true, true, KT2>(acc, t2, (u16*)smem);
    const int nx = item + G;
    if (nx < nitems) {
      const int nt2 = nx % ntn, h2 = (nx / ntn) % R.H, cg2 = nx / (ntn * R.H);
      tiles_issue<C, 128, true, false, KT1>(t1, scb + ((long)cg2 * R.H + h2) * C * C, C, pj + (long)cg2 * C * R.ldv + R.voff + h2 * R.DV + nt2 * 128, R.ldv);
    }
    gemm_run<C, 128, true, true, true, KT2>(acc, t3, (u16*)smem);
    u16* o = ob + (long)cgi * C * HDV + h * R.DV + nt * 128;
    epi_each<C, 128, true>(acc, [&](int r, int c, f32x4 val) { *(uint2*)(o + (long)r * HDV + c) = make_uint2(pack2(val[0], val[1]), pack2(val[2], val[3])); });
  }
  __syncthreads();
}

template <int KIND>
__device__ void phase_rec_ng_t(const Params& P) {
  const Rec R = rec_of(KIND);
  constexpr int DV = (KIND == 1) ? 512 : 128, H = (KIND == 1) ? 4 : 8, PER = DV / 64, HDV = H * DV;
  const u16* __restrict__ ob = (const u16*)(WS(P) + O_OBUF);
  const u16* __restrict__ pj = (const u16*)(WS(P) + O_PROJ);
  u16* __restrict__ a2 = (u16*)(WS(P) + O_A2);
  const float* gain = P.in[29];
  const int tid = TID(), lane = tid & 63, wid = tid >> 6;
  constexpr int nrows = SLAB * H;
  for (int item = BID(); item < nrows / 32; item += gridDim.x) {
    float v[4][PER];
    float ss[4];
#pragma unroll
    for (int u = 0; u < 4; ++u) {
      const int rh = item * 32 + wid * 4 + u;
      const int t = rh / H, h = rh % H;
      const u16* o = ob + (long)t * HDV + h * DV + lane * PER;
      if (PER == 8) {
        float f8[8];
        unpack8(*(const uint4*)o, f8);
#pragma unroll
        for (int i = 0; i < 8; ++i) v[u][i % PER] = f8[i];
      } else {
        const unsigned w = *(const unsigned*)o;
        v[u][0] = bf2f((u16)(w & 0xffff)); v[u][1 % PER] = bf2f((u16)(w >> 16));
      }
      float a = 0.f;
#pragma unroll
      for (int i = 0; i < PER; ++i) a += v[u][i] * v[u][i];
      ss[u] = a;
    }
#pragma unroll
    for (int u = 0; u < 4; ++u) ss[u] = wave_sum(ss[u]);
#pragma unroll
    for (int u = 0; u < 4; ++u) {
      const int rh = item * 32 + wid * 4 + u;
      const int t = rh / H, h = rh % H;
      const float rstd = rsqrtf(ss[u] / (float)DV + 1e-6f);
      const u16* g = pj + (long)t * R.ldv + R.goff + h * DV + lane * PER;
      u16* out = a2 + (long)t * HDV + h * DV + lane * PER;
      float y[PER];
#pragma unroll
      for (int i = 0; i < PER; ++i) {
        y[i] = v[u][i] * rstd;
        if (KIND == 3) y[i] *= gain[lane * PER + i];
      }
      if (PER == 8) {
        const uint4 gw = *(const uint4*)g;
        float gf[8];
        unpack8(gw, gf);
        float r8[8];
#pragma unroll
        for (int i = 0; i < 8; ++i) r8[i] = y[i % PER] * silu_f(gf[i]);
        *(uint4*)out = pack8s(r8, 1.f);
      } else {
        const unsigned gw = *(const unsigned*)g;
        *(unsigned*)out = pack2(y[0] * silu_f(bf2f((u16)(gw & 0xffff))), y[1 % PER] * silu_f(bf2f((u16)(gw >> 16))));
      }
    }
  }
}
__device__ void phase_rec_ng(const Params& P, int kind) {
  if (kind == 1) phase_rec_ng_t<1>(P); else phase_rec_ng_t<3>(P);
}

__device__ void phase_swa_prep(const Params& P, int slab) {
  const int L = Lof(slab);
  const u16* pj = (const u16*)(WS(P) + O_PROJ);
  u16* qn = (u16*)(WS(P) + O_QN);
  u16* kn = (u16*)(WS(P) + O_KN);
  const float2* rope = (const float2*)(WS(P) + O_ROPES);
  const long gtid = (long)BID() * NT + TID(), gsz = (long)gridDim.x * NT;
  for (long idx = gtid; idx < (long)SLAB * 640; idx += gsz) {
    const int d = (int)(idx & 31);
    const int hd = (int)((idx >> 5) % 20);
    const int t = (int)(idx / 640);
    const int col = hd < 16 ? hd * 64 : 1024 + (hd - 16) * 64;
    const float x1 = bf2f(pj[(long)t * 1536 + col + d]), x2 = bf2f(pj[(long)t * 1536 + col + d + 32]);
    float ss = x1 * x1 + x2 * x2;
#pragma unroll
    for (int o = 16; o; o >>= 1) ss += __shfl_xor(ss, o);
    const float rstd = rsqrtf(ss * (1.f / 64.f) + 1e-6f);
    const float* gn = hd < 16 ? P.in[23] : P.in[24];
    const float y1 = x1 * rstd * gn[d], y2 = x2 * rstd * gn[d + 32];
    const float2 cs = rope[(long)(t & (L - 1)) * 32 + d];
    float o1 = y1 * cs.x - y2 * cs.y, o2 = y1 * cs.y + y2 * cs.x;
    if (hd < 16) {
      qn[(long)t * 1024 + hd * 64 + d] = f2bf(o1 * 0.125f);
      qn[(long)t * 1024 + hd * 64 + d + 32] = f2bf(o2 * 0.125f);
    } else {
      kn[(long)t * 256 + (hd - 16) * 64 + d] = f2bf(o1);
      kn[(long)t * 256 + (hd - 16) * 64 + d + 32] = f2bf(o2);
    }
  }
}

constexpr int SLD = 324;
__device__ void phase_swa_att1(const Params& P, int slab) {
  const int L = Lof(slab), nqb = L / 64;
  const u16* qn = (const u16*)(WS(P) + O_QN);
  const u16* kn = (const u16*)(WS(P) + O_KN);
  u16* pb = (u16*)(WS(P) + O_PBUF);
  const float* sink = P.in[25];
  float* S = (float*)(smem + 40960);
  const int tid = TID();
  const int nitems = (SLAB / 64) * 16;
  for (int item = BID(); item < nitems; item += gridDim.x) {
    const int hq = item & 15, qbg = item >> 4;
    const int seq = qbg / nqb, qb = qbg % nqb;
    const int q0 = qb * 64;
    const long tok0 = (long)seq * L;
    const int hkv = hq >> 2;
    for (int kt = 0; kt < 5; ++kt) {
      const int kp0 = q0 - 128 + kt * 64;
      if (kp0 >= 0 && kp0 < L) {
        f32x4 acc[2][1] = {};
        gemm_acc<64, 64, true, true, true, 1>(acc, qn + (tok0 + q0) * 1024 + hq * 64, 1024, kn + (tok0 + kp0) * 256 + hkv * 64, 256, (u16*)smem);
        epi_each<64, 64, true>(acc, [&](int r, int c, f32x4 v) {
          f32x4 o;
#pragma unroll
          for (int j = 0; j < 4; ++j) {
            const int dlt = (q0 + r) - (kp0 + c + j);
            o[j] = (dlt <= 128 && dlt >= -128) ? v[j] : -1e30f;
          }
          *(f32x4*)(S + r * SLD + kt * 64 + c) = o;
        });
      } else {
        for (int i = tid; i < 4096; i += NT) S[(i >> 6) * SLD + kt * 64 + (i & 63)] = -1e30f;
      }
    }
    __syncthreads();
    {
      const int r = tid >> 3, sub = tid & 7;
      const float sk = sink[hq];
      float m = sk;
      for (int c = sub; c < 320; c += 8) m = fmaxf(m, S[r * SLD + c]);
      m = fmaxf(m, __shfl_xor(m, 1)); m = fmaxf(m, __shfl_xor(m, 2)); m = fmaxf(m, __shfl_xor(m, 4));
      float den = 0.f;
      for (int c = sub; c < 320; c += 8) { float e = __expf(S[r * SLD + c] - m); S[r * SLD + c] = e; den += e; }
      den += __shfl_xor(den, 1); den += __shfl_xor(den, 2); den += __shfl_xor(den, 4);
      den += __expf(sk - m);
      const float inv = 1.f / den;
      u16* prow = pb + ((long)item * 64 + r) * 320;
      for (int c = sub; c < 320; c += 8) prow[c] = f2bf(S[r * SLD + c] * inv);
    }
    __syncthreads();
  }
}

__device__ void phase_swa_att2(const Params& P, int slab) {
  const int L = Lof(slab), nqb = L / 64;
  const u16* pj = (const u16*)(WS(P) + O_PROJ);
  const u16* pb = (const u16*)(WS(P) + O_PBUF);
  u16* a2 = (u16*)(WS(P) + O_A2);
  const int nitems = (SLAB / 64) * 16;
  for (int item = BID(); item < nitems; item += gridDim.x) {
    const int hq = item & 15, qbg = item >> 4;
    const int seq = qbg / nqb, qb = qbg % nqb;
    const int q0 = qb * 64;
    const long tok0 = (long)seq * L;
    const int hkv = hq >> 2;
    f32x4 acc[2][1] = {};
    for (int kt = 0; kt < 5; ++kt) {
      const int kp0 = q0 - 128 + kt * 64;
      if (kp0 >= 0 && kp0 < L)
        gemm_acc<64, 64, true, false, true, 1>(acc, pb + (long)item * 64 * 320 + kt * 64, 320, pj + (tok0 + kp0) * 1536 + 1280 + hkv * 64, 1536, (u16*)smem);
    }
    u16* o = a2 + (tok0 + q0) * 1024 + hq * 64;
    epi_each<64, 64, true>(acc, [&](int r, int c, f32x4 v) { *(uint2*)(o + (long)r * 1024 + c) = make_uint2(pack2(v[0], v[1]), pack2(v[2], v[3])); });
  }
}


#define XB_TMO      128
#define XB_XCNT(j)  (256  + 64 * (j))
#define XB_XSUB(j)  (1280 + 64 * (j))
#define XB_XGEN(j)  (2304 + 64 * (j))
#define XB_TOP      3328
#define XB_TOPGEN   3392
#define XCD_BAR_WORDS 3456
#define XB_SPIN_CAP (1u << 18)
__device__ __forceinline__ unsigned xb_ld(unsigned* p)              { return __hip_atomic_load(p, __ATOMIC_RELAXED, __HIP_MEMORY_SCOPE_AGENT); }
__device__ __forceinline__ unsigned xb_add(unsigned* p, unsigned v) { return __hip_atomic_fetch_add(p, v, __ATOMIC_RELAXED, __HIP_MEMORY_SCOPE_AGENT); }
__device__ __forceinline__ unsigned xb_xcc_id() { return (unsigned)__builtin_amdgcn_s_getreg((3 << 11) | 20) & 0xFu; }
#define XB_SPIN(cond, bar) do { unsigned _sp = 0; while (cond) { __builtin_amdgcn_s_sleep(1); \
    if ((++_sp & 255u) == 0u) { if (xb_ld(&(bar)[XB_TMO])) break; if (_sp > XB_SPIN_CAP) { atomicAdd(&(bar)[XB_TMO], 1u); break; } } } } while (0)
struct XcdBarrier { unsigned* bar; unsigned x; volatile LDS_AS unsigned* st; };
__device__ __forceinline__ XcdBarrier xcd_barrier_post(unsigned* bar, volatile LDS_AS unsigned* st) {
    XcdBarrier b; b.bar = bar; b.x = xb_xcc_id(); b.st = st;
    if (threadIdx.x == 0) (void)xb_add(&bar[XB_XCNT(b.x)], 1u);
    return b;
}
__device__ __forceinline__ void xcd_barrier_complete(unsigned* bar, unsigned x, unsigned& nloc, unsigned& nx) {
    const unsigned G = gridDim.x * gridDim.y * gridDim.z;
    unsigned sum, cnt, mine, sp = 0u;
    for (;;) {
        sum = 0u; cnt = 0u; mine = 0u;
#pragma unroll
        for (unsigned j = 0; j < 16; ++j) { const unsigned c = xb_ld(&bar[XB_XCNT(j)]); sum += c; cnt += (c > 0u) ? 1u : 0u; mine = (j == x) ? c : mine; }
        if (sum == G) break;
        __builtin_amdgcn_s_sleep(1);
        if ((++sp & 255u) == 0u) { if (xb_ld(&bar[XB_TMO])) break; if (sp > XB_SPIN_CAP) { atomicAdd(&bar[XB_TMO], 1u); break; } }
    }
    nloc = mine > 0u ? mine : 1u; nx = cnt > 0u ? cnt : 1u;
}
__device__ __forceinline__ void xcd_barrier(const XcdBarrier& b) {
    asm volatile("s_waitcnt vmcnt(0)" ::: "memory");
    __syncthreads();
    if (threadIdx.x == 0) {
        unsigned* bar = b.bar;
        __builtin_amdgcn_s_waitcnt(0);
        unsigned nloc = b.st[0], nx = b.st[1];
        if (nloc == 0u) { xcd_barrier_complete(bar, b.x, nloc, nx); b.st[0] = nloc; b.st[1] = nx; }
        const unsigned old = xb_add(&bar[XB_XSUB(b.x)], 1u);
        const unsigned gen = old / nloc;
        if (old + 1u == (gen + 1u) * nloc) {
            __builtin_amdgcn_fence(__ATOMIC_RELEASE, "agent");
            asm volatile("s_waitcnt vmcnt(0)" ::: "memory");
            const unsigned og = xb_add(&bar[XB_TOP], 1u);
            const unsigned tg = og / nx;
            if (og + 1u == (tg + 1u) * nx) xb_add(&bar[XB_TOPGEN], 1u);
            else XB_SPIN(xb_ld(&bar[XB_TOPGEN]) == tg, bar);
            __builtin_amdgcn_fence(__ATOMIC_ACQUIRE, "agent");
            xb_add(&bar[XB_XGEN(b.x)], 1u);
            asm volatile("s_waitcnt vmcnt(0)" ::: "memory");
        } else {
            XB_SPIN(xb_ld(&bar[XB_XGEN(b.x)]) == gen, bar);
            __builtin_amdgcn_fence(__ATOMIC_ACQUIRE, "agent");
            asm volatile("s_waitcnt vmcnt(0)" ::: "memory");
        }
    }
    __syncthreads();
}

__device__ __forceinline__ int nmix_of(int kind) { return (kind & 1) ? 8 : 6; }

__device__ void ffn_step(const Params& P, int layer, int f) {
  if (f == 6) { phase_ffn_down(P, layer); return; }
  const int fs = f / 3, st = f % 3;
  if (st == 0) { REP(4) phase_norm(P, layer, fs, 1); }
  else if (st == 1) { REP(0) phase_ffn_gate(P, layer); }
  else { REP(0) phase_ffn_val(P, layer, fs); }
}
__device__ void layer_step(const Params& P, int layer, int slab, int step) {
  const int kind = layer;
  if (step == 0) { REP(4) phase_norm(P, layer, slab, 0); return; }
  if (kind == 0) {
    if (step == 1) { REP(0) phase_proj(P, O_WHYIN, 3072); }
    else if (step == 2) { REP(3) phase_hy_conv(P, slab); }
    else if (step == 3) { if ((PROBE_MASK >> 7) & 1) phase_hy_fft(P, slab, true); phase_hy_fft(P, slab); }
    else if (step == 4) { REP(3) phase_hy_tr(P, slab); }
    else phase_resid(P, layer, slab, (const u16*)(WS(P) + O_A2), 1024, O_WHYOUT, 2 * D);
  } else if (kind == 1) {
    if (step == 1) { REP(0) phase_proj(P, O_WRETIN, 6144); }
    else if (step == 2) { REP(1) REP(9) phase_ret_prep(P, slab); }
    else if (step == 3) { REP(1) REP(11) phase_rec_su<128>(P, 1); }
    else if (step == 4) { if ((PROBE_MASK >> 6) & 1) phase_rec_scan(P, 1, slab, true); phase_rec_scan(P, 1, slab); }
    else if (step == 5) { REP(1) REP(12) phase_rec_out<128>(P, 1); }
    else if (step == 6) { REP(1) REP(9) phase_rec_ng(P, 1); }
    else phase_resid(P, layer, slab, (const u16*)(WS(P) + O_A2), 2048, O_WRETOUT, 2 * D);
  } else if (kind == 2) {
    if (step == 1) { REP(0) phase_proj(P, O_WSWAIN, 1536); }
    else if (step == 2) { REP(2) REP(14) phase_swa_prep(P, slab); }
    else if (step == 3) { REP(2) REP(15) phase_swa_att1(P, slab); }
    else if (step == 4) { REP(2) REP(16) phase_swa_att2(P, slab); }
    else phase_resid(P, layer, slab, (const u16*)(WS(P) + O_A2), 1024, O_WSWAOUT, 2 * D);
  } else {
    if (step == 1) { REP(0) phase_proj(P, O_WHGIN, 5120); }
    else if (step == 2) { REP(1) REP(9) phase_hg_prep(P); }
    else if (step == 3) { REP(1) REP(11) phase_rec_su<64>(P, 3); }
    else if (step == 4) { if ((PROBE_MASK >> 6) & 1) phase_rec_scan(P, 3, slab, true); phase_rec_scan(P, 3, slab); }
    else if (step == 5) { REP(1) REP(12) phase_rec_out<64>(P, 3); }
    else if (step == 6) { REP(1) REP(9) phase_rec_ng(P, 3); }
    else phase_resid(P, layer, slab, (const u16*)(WS(P) + O_A2), 1024, O_WHGOUT, 2 * D);
  }
}

__global__ void __launch_bounds__(NT) fwd_megakernel(Params P) {
  cg::grid_group grid = cg::this_grid();
  __shared__ uint4 xb_words;
  if (threadIdx.x == 0) xb_words = make_uint4(0u, 0u, 0u, 0u);
  __syncthreads();
  XcdBarrier xb = xcd_barrier_post((unsigned*)(P.ws + O_BAR), (volatile LDS_AS unsigned*)&xb_words);
  for (int pid = P.p0; pid < P.p1; ++pid) {
    if (pid == 0) { REP(5) phase_pre0(P); }
    else if (pid == 1) { REP(5) phase_pre1(P); }
    else {
      int q = pid - 2, layer = 0;
      while (q >= 5 * nmix_of(layer) + 7) { q -= 5 * nmix_of(layer) + 7; ++layer; }
      const int nm = nmix_of(layer);
      if (q < 5 * nm) layer_step(P, layer, q / nm, q % nm);
      else ffn_step(P, layer, q - 5 * nm);
    }
    if (pid + 1 < P.p1) {
      if (pid == 0) grid.sync();
      else xcd_barrier(xb);
      if ((PROBE_MASK >> 8) & 1) xcd_barrier(xb);
    }
  }
}

extern "C" void kernel_launch(void* const* d_in, const int* in_sizes, int n_in, void* d_out, int out_size, void* d_ws,
                              size_t ws_size, hipStream_t stream) {
  static int grid_blocks = 0;
  if (!grid_blocks) {
    int dev = 0, cus = 0, per_cu = 0;
    (void)hipGetDevice(&dev);
    (void)hipDeviceGetAttribute(&cus, hipDeviceAttributeMultiprocessorCount, dev);
    (void)hipFuncSetAttribute((const void*)fwd_megakernel, hipFuncAttributeMaxDynamicSharedMemorySize, LDSB);
    (void)hipOccupancyMaxActiveBlocksPerMultiprocessor(&per_cu, (const void*)fwd_megakernel, NT, LDSB);
    if (per_cu < 1) per_cu = 1;
    if (per_cu > 1) per_cu = 1;
    grid_blocks = cus * per_cu;
    if (ws_size < WS_END) fprintf(stderr, "kernel_launch: workspace too small: %zu < %zu\n", ws_size, (size_t)WS_END);
  }
  Params p;
  memset(&p, 0, sizeof(p));
  for (int i = 0; i < 36; ++i) p.in[i] = (const float*)d_in[i];
  p.out = (float*)d_out;
  p.ws = (unsigned char*)d_ws;
  (void)hipMemsetAsync((unsigned char*)d_ws + O_BAR, 0, XCD_BAR_WORDS * 4, stream);
#if ONE_LAUNCH
  p.p0 = 0; p.p1 = NPHASES;
  void* args[] = {&p};
  hipError_t e = hipLaunchCooperativeKernel((const void*)fwd_megakernel, dim3(grid_blocks), dim3(NT), args, LDSB, stream);
  if (e != hipSuccess) fprintf(stderr, "cooperative launch failed: %s (grid %d)\n", hipGetErrorString(e), grid_blocks);
#else
  for (int ph = 0; ph < NPHASES; ++ph) {
    p.p0 = ph; p.p1 = ph + 1;
    hipLaunchKernelGGL(fwd_megakernel, dim3(grid_blocks), dim3(NT), LDSB, stream, p);
  }
#endif
}
```

```cpp
#include <hip/hip_runtime.h>
#include <hip/hip_cooperative_groups.h>
#include <cstdio>
#include <cstdint>
#include <cstring>
namespace cg = cooperative_groups;

typedef unsigned short u16;
typedef __attribute__((ext_vector_type(8))) short bf16x8;
typedef __attribute__((ext_vector_type(4))) float f32x4;

#define NT 512
#ifndef ONE_LAUNCH
#define ONE_LAUNCH 1
#endif
#ifndef PROBE_MASK
#define PROBE_MASK 0
#endif
#define REP(cls) for (int rep_##cls = 0; rep_##cls < (((PROBE_MASK >> (cls)) & 1) ? 2 : 1); ++rep_##cls)

constexpr int D = 1024, SLAB = 16384, DFF = 2816;
constexpr int LDSB = 139264;
constexpr int FSLAB = 40960, NTOK = 81920;
constexpr int NPHASES = 2 + 5 * (6 + 8 + 5 + 8) + 4 * 7;

constexpr size_t SZW(size_t n, size_t k) { return n * k * 2; }
constexpr size_t O_WHYIN = 0;
constexpr size_t O_WHYOUT = O_WHYIN + SZW(3072, 1024);
constexpr size_t O_WRETIN = O_WHYOUT + SZW(1024, 1024);
constexpr size_t O_WRETOUT = O_WRETIN + SZW(6144, 1024);
constexpr size_t O_WSWAIN = O_WRETOUT + SZW(1024, 2048);
constexpr size_t O_WSWAOUT = O_WSWAIN + SZW(1536, 1024);
constexpr size_t O_WHGIN = O_WSWAOUT + SZW(1024, 1024);
constexpr size_t O_WHGOUT = O_WHGIN + SZW(5120, 1024);
constexpr size_t O_WFG = O_WHGOUT + SZW(1024, 1024);
constexpr size_t O_WFV = O_WFG + 4 * SZW(2816, 1024);
constexpr size_t O_WFD = O_WFV + 4 * SZW(2816, 1024);
constexpr size_t O_MOD = O_WFD + 4 * SZW(1024, 2816);
constexpr size_t O_TW = O_MOD + (size_t)4 * 16 * 6144 * 4;
constexpr size_t O_HIDS = O_TW + 8192 * 8;
constexpr size_t O_HIDP = O_HIDS + (size_t)8192 * 64 * 4;
constexpr size_t O_ROPER = O_HIDP + (size_t)2048 * 64 * 4;
constexpr size_t O_ROPES = O_ROPER + (size_t)8192 * 128 * 8;
constexpr size_t O_PROJ = O_ROPES + (size_t)8192 * 32 * 8;
constexpr size_t O_HBUF = O_PROJ + (size_t)SLAB * 6144 * 2;
constexpr size_t O_A2 = O_HBUF + (size_t)SLAB * 1024 * 2;
constexpr size_t O_C = O_A2 + (size_t)SLAB * 2048 * 2;
constexpr size_t O_FHBUF = O_PROJ;
constexpr size_t O_FGBUF = O_FHBUF + (size_t)FSLAB * 1024 * 2;
constexpr size_t O_FACT = O_FGBUF + (size_t)FSLAB * DFF * 2;
constexpr size_t END_F = O_FACT + (size_t)NTOK * DFF * 2;
constexpr size_t O_MODP = O_C;
constexpr size_t O_BAR = ((size_t)1 << 30) - 16384;
constexpr size_t O_HSPS = O_BAR - (size_t)1024 * 16384 * 8 - (size_t)1024 * 4096 * 8;
constexpr size_t O_HSPP = O_HSPS + (size_t)1024 * 16384 * 8;
constexpr size_t O_UT = O_C;
constexpr size_t O_X0C = O_UT + (size_t)SLAB * 1024 * 4;
constexpr size_t END_HY = O_X0C + (size_t)SLAB * 1024 * 2;
static_assert(END_F <= O_HSPS && END_HY <= O_HSPS, "layer-0 buffers overlap the filter spectra");
constexpr size_t SZP = (size_t)SLAB * 1024 * 2;
constexpr size_t O_QDF = O_C, O_QDB = O_QDF + SZP, O_KIF = O_QDB + SZP, O_KIB = O_KIF + SZP, O_KEF = O_KIB + SZP, O_KEB = O_KEF + SZP;
constexpr size_t O_DLF = O_KEB + SZP;
constexpr size_t O_DLB = O_DLF + (size_t)256 * 1024 * 4;
constexpr size_t O_SC = O_DLB + (size_t)256 * 1024 * 4;
constexpr size_t O_STF = O_SC + (size_t)SLAB * 512 * 2;
constexpr size_t O_STB = O_STF + (size_t)134217728;
constexpr size_t O_OBUF = O_STB + (size_t)134217728;
constexpr size_t END_REC = O_OBUF + (size_t)SLAB * 2048 * 4;
constexpr size_t O_QN = O_C;
constexpr size_t O_KN = O_QN + SZP;
constexpr size_t O_PBUF = O_KN + (size_t)SLAB * 256 * 2;
constexpr size_t END_SWA = O_PBUF + (size_t)SLAB * 16 * 320 * 2;
constexpr size_t WS_END = END_REC > END_HY ? (END_REC > END_SWA ? END_REC : END_SWA) : (END_HY > END_SWA ? END_HY : END_SWA);
static_assert(WS_END <= O_BAR, "workspace exceeds 1 GiB");

struct Params {
  const float* in[36];
  float* out;
  unsigned char* ws;
  int p0, p1;
};

extern __shared__ __attribute__((aligned(16))) unsigned char smem[];

__device__ __forceinline__ int TID() { int t = threadIdx.x; asm volatile("" : "+v"(t)); return t; }
__device__ __forceinline__ int BID() { int b = blockIdx.x; asm volatile("" : "+s"(b)); return b; }
__device__ __forceinline__ long ZOFF() { long z = 0; asm volatile("" : "+s"(z)); return z; }
__device__ __forceinline__ unsigned char* WS(const Params& P) { return P.ws + ZOFF(); }
__device__ __forceinline__ float* OUTP(const Params& P) { return P.out + ZOFF(); }

namespace pg8 {
#define PG8_LAS __attribute__((address_space(3)))
typedef unsigned short bf16_t;
typedef short bf16x8 __attribute__((ext_vector_type(8)));
typedef float f32x4 __attribute__((ext_vector_type(4)));
typedef unsigned u32x4 __attribute__((ext_vector_type(4)));
constexpr int BM = 256, BK = 64, HALF = 128, HTB = HALF * BK * 2  , STAGE_BYTES = 8 * HTB, NXCD = 8, WGM = 8;

__host__ __device__ __forceinline__ int lds_byte(int r, int c) { const int st = (r >> 4) * 2 + (c >> 5), rr = r & 15, cc = c & 31, ob = rr * 64 + cc * 2; return st * 1024 + (ob ^ (((ob >> 9) & 1) << 5)); }
__host__ __device__ __forceinline__ void stage_rc(int b, int& R, int& C) { const int st = b / 1024, sb = b % 1024, swz = sb ^ (((sb >> 9) & 1) << 5); R = (st >> 1) * 16 + swz / 64; C = (st & 1) * 32 + (swz % 64) / 2; }
__host__ __device__ __forceinline__ int perm32(int rho) { const int n = rho >> 4, i = rho & 15; return 8 * (i >> 2) + 4 * n + (i & 3); }

struct Unit { int pm, pn; };
struct Gemm { const bf16_t* A; const bf16_t* Bt; int M, N, K; };

struct StaticOrder {
    int nM, nN, nwg, G, c;
    __host__ __device__ void init(int M, int N, int G_, int c_) { nM = M / BM; nN = N / BM; nwg = nM * nN; G = G_; c = c_; }
    __host__ __device__ bool next(int i, Unit& u) const {
        const long L = (long)i * G + c; if (L >= nwg) return false;
        int wgid = (int)L; { const int q = nwg / NXCD, r = nwg % NXCD, xcd = wgid % NXCD, off = wgid / NXCD; wgid = (xcd < r ? xcd * (q + 1) : r * (q + 1) + (xcd - r) * q) + off; }
        const int nig = WGM * nN, gid = wgid / nig, fm = gid * WGM, gsz = (nM - fm) < WGM ? (nM - fm) : WGM;
        u.pm = fm + ((wgid % nig) % gsz); u.pn = (wgid % nig) / gsz; return true;
    }
    __device__ __forceinline__ void a_ready(const Unit&) const {}
    __device__ __forceinline__ void done(const Unit&) const {}
};

template <class Epi, class Sched, bool STAMP = false>
__device__ __forceinline__ void gemm_phase(PG8_LAS unsigned char* lds, const Gemm g, const Sched& S, const Epi& E, unsigned long long* stamps) {
    const int tid = TID(), wid = __builtin_amdgcn_readfirstlane(tid >> 6), lane = tid & 63, wr = wid >> 2, wc = wid & 3, fr = lane & 15, fq = lane >> 4;
    const int K = g.K, nt = K / BK;
    int ts_lo = 0, ts_hi = 0, nts = 0; const unsigned long long rt_entry = STAMP ? (unsigned long long)wall_clock64() : 0ull;
#define PG8_STAMP() do { if (STAMP && wid == 0 && nts < 64) { const unsigned long long _c = (unsigned long long)clock64(); \
        ts_lo = (lane == nts) ? (int)(unsigned)_c : ts_lo; ts_hi = (lane == nts) ? (int)(unsigned)(_c >> 32) : ts_hi; ++nts; } } while (0)
    PG8_STAMP();
    unsigned voffA[2], voffB[2];
#pragma unroll
    for (int i = 0; i < 2; ++i) { int R, C; stage_rc(tid * 16 + i * 8192, R, C); const int Rb = Epi::PERM ? ((R & ~31) + perm32(R & 31)) : R;
        voffA[i] = (unsigned)(R * K + C) * 2u; voffB[i] = (unsigned)(Rb * K + C) * 2u; }
    const size_t kstep = (size_t)(BK * 2);
    const size_t hstep = (size_t)HALF * K * 2;
    const size_t tstep = 2 * hstep;
    const unsigned ldsw = (unsigned)wid * 1024u;
    const int aoff = lds_byte(wr * 64 + fr, fq * 8), boff = lds_byte(wc * 32 + fr, fq * 8);
#define PG8_SA(b, h) (((b) * 2 + (h)) * HTB)
#define PG8_SB(b, h) ((4 + (b) * 2 + (h)) * HTB)
#define PG8_STAGE(bufoff, gbase, voff) do { _Pragma("unroll") for (int _i = 0; _i < 2; ++_i) \
        __builtin_amdgcn_global_load_lds((const unsigned*)((const char*)(gbase) + (voff)[_i]), (PG8_LAS unsigned*)(lds + (bufoff) + ldsw + _i * 8192), 16, 0, 0); } while (0)
#define PG8_LDA(dst, b, h) do { _Pragma("unroll") for (int m = 0; m < 4; ++m) _Pragma("unroll") for (int k = 0; k < 2; ++k) dst[m][k] = *(const PG8_LAS bf16x8*)(lds + PG8_SA(b, h) + aoff + m * 2048 + k * 1024); } while (0)
#define PG8_LDB(dst, b, h) do { _Pragma("unroll") for (int n = 0; n < 2; ++n) _Pragma("unroll") for (int k = 0; k < 2; ++k) dst[n][k] = *(const PG8_LAS bf16x8*)(lds + PG8_SB(b, h) + boff + n * 2048 + k * 1024); } while (0)
#define PG8_MMA(ai, bj, At, Bt) do { __builtin_amdgcn_s_setprio(1); _Pragma("unroll") for (int m = 0; m < 4; ++m) _Pragma("unroll") for (int n = 0; n < 2; ++n) _Pragma("unroll") for (int k = 0; k < 2; ++k) \
        acc[ai][bj][m][n] = __builtin_amdgcn_mfma_f32_16x16x32_bf16(Bt[n][k], At[m][k], acc[ai][bj][m][n], 0, 0, 0); __builtin_amdgcn_s_setprio(0); } while (0)
#define PG8_WAIT_V(n) asm volatile("s_waitcnt vmcnt(" #n ")" ::: "memory")
#define PG8_WAIT_L(n) asm volatile("s_waitcnt lgkmcnt(" #n ")" ::: "memory")
#define PG8_BAR __builtin_amdgcn_s_barrier()
#define PG8_SCHED __builtin_amdgcn_sched_barrier(0)
    Unit cur, nxt; int ui = 0;
    if (!S.next(0, cur)) return;
    f32x4 acc[2][2][4][2];
#pragma unroll
    for (int a = 0; a < 2; ++a)
#pragma unroll
        for (int b = 0; b < 2; ++b)
#pragma unroll
            for (int m = 0; m < 4; ++m)
#pragma unroll
                for (int n = 0; n < 2; ++n) acc[a][b][m][n] = (f32x4){0.f, 0.f, 0.f, 0.f};
    bf16x8 At[4][2], B0[2][2], B1[2][2];
    const char* cA = (const char*)g.A + (size_t)cur.pm * tstep; const char* cB = (const char*)g.Bt + (size_t)cur.pn * tstep;
    S.a_ready(cur);
    PG8_STAGE(PG8_SB(0, 0), cB, voffB); PG8_STAGE(PG8_SA(0, 0), cA, voffA); PG8_STAGE(PG8_SB(0, 1), cB + hstep, voffB); PG8_STAGE(PG8_SA(0, 1), cA + hstep, voffA);
    if (wr == 1) PG8_BAR;
    PG8_WAIT_V(4); PG8_BAR;
    PG8_STAGE(PG8_SB(1, 0), cB + kstep, voffB); PG8_STAGE(PG8_SA(1, 0), cA + kstep, voffA); PG8_STAGE(PG8_SB(1, 1), cB + hstep + kstep, voffB);
    PG8_WAIT_V(6); PG8_BAR;
    PG8_STAMP();
    for (;;) {
        const bool has_next = S.next(ui + 1, nxt);
        const char* nA = has_next ? (const char*)g.A + (size_t)nxt.pm * tstep : cA; const char* nB = has_next ? (const char*)g.Bt + (size_t)nxt.pn * tstep : cB;
        for (int t = 0; t < nt; t += 2) {
            const bool last = (t == nt - 2);
            const char* a1 = cA + (size_t)(t + 1) * kstep;
            const char* a2 = last ? nA : cA + (size_t)(t + 2) * kstep; const char* b2 = last ? nB : cB + (size_t)(t + 2) * kstep;
            const char* a3 = a2 + kstep; const char* b3 = b2 + kstep;
            if (last && has_next) S.a_ready(nxt);
            PG8_LDB(B0, 0, 0); PG8_SCHED; PG8_LDA(At, 0, 0); PG8_STAGE(PG8_SA(1, 1), a1 + hstep, voffA);
            PG8_WAIT_L(8); PG8_BAR; PG8_WAIT_L(0); PG8_MMA(0, 0, At, B0); PG8_BAR; PG8_SCHED;
            PG8_LDB(B1, 0, 1); PG8_STAGE(PG8_SB(0, 0), b2, voffB);
            PG8_BAR; PG8_WAIT_L(0); PG8_MMA(0, 1, At, B1); PG8_BAR;
            PG8_LDA(At, 0, 1); PG8_STAGE(PG8_SA(0, 0), a2, voffA);
            PG8_BAR; PG8_WAIT_L(0); PG8_MMA(1, 0, At, B0); PG8_BAR; PG8_SCHED;
            PG8_STAGE(PG8_SB(0, 1), b2 + hstep, voffB);
            PG8_WAIT_V(6); PG8_BAR; PG8_MMA(1, 1, At, B1); PG8_BAR;
            PG8_LDB(B0, 1, 0); PG8_SCHED; PG8_LDA(At, 1, 0); PG8_STAGE(PG8_SA(0, 1), a2 + hstep, voffA);
            PG8_WAIT_L(8); PG8_BAR; PG8_WAIT_L(0); PG8_MMA(0, 0, At, B0); PG8_BAR; PG8_SCHED;
            PG8_LDB(B1, 1, 1); PG8_STAGE(PG8_SB(1, 0), b3, voffB);
            PG8_BAR; PG8_WAIT_L(0); PG8_MMA(0, 1, At, B1); PG8_BAR;
            PG8_LDA(At, 1, 1); PG8_STAGE(PG8_SA(1, 0), a3, voffA);
            PG8_BAR; PG8_WAIT_L(0); PG8_MMA(1, 0, At, B0); PG8_BAR; PG8_SCHED;
            PG8_STAGE(PG8_SB(1, 1), b3 + hstep, voffB);
            PG8_WAIT_V(6); PG8_BAR; PG8_MMA(1, 1, At, B1); PG8_BAR;
        }
        PG8_STAMP();
        if constexpr (!Epi::AFTER_DRAIN) { E(acc, cur, wr, wc, fr, fq); S.done(cur); }
        PG8_STAMP();
        if (!has_next) break;
#pragma unroll
        for (int a = 0; a < 2; ++a)
#pragma unroll
            for (int b = 0; b < 2; ++b)
#pragma unroll
                for (int m = 0; m < 4; ++m)
#pragma unroll
                    for (int n = 0; n < 2; ++n) acc[a][b][m][n] = (f32x4){0.f, 0.f, 0.f, 0.f};
        cur = nxt; cA = nA; cB = nB; ++ui;
    }
    PG8_WAIT_V(0);
    if (wr == 0) PG8_BAR;
    PG8_BAR;
    if constexpr (Epi::AFTER_DRAIN) { E.fused(acc, cur, wr, wc, fr, fq, lds, wid, lane); S.done(cur); }
    PG8_STAMP();
    if (STAMP && wid == 0) { stamps[lane] = lane < nts ? (((unsigned long long)(unsigned)ts_hi << 32) | (unsigned)ts_lo) : 0ull;
        if (lane == 62) stamps[62] = rt_entry; if (lane == 63) stamps[63] = (unsigned long long)wall_clock64(); }
#undef PG8_STAMP
#undef PG8_SA
#undef PG8_SB
#undef PG8_STAGE
#undef PG8_LDA
#undef PG8_LDB
#undef PG8_MMA
#undef PG8_WAIT_V
#undef PG8_WAIT_L
#undef PG8_BAR
#undef PG8_SCHED
}
}


__device__ __forceinline__ u16 f2bf(float f) {
  unsigned u = __float_as_uint(f);
  u += 0x7fffu + ((u >> 16) & 1u);
  return (u16)(u >> 16);
}
__device__ __forceinline__ float bf2f(u16 h) { return __uint_as_float(((unsigned)h) << 16); }
__device__ __forceinline__ unsigned pack2(float a, float b) { return (unsigned)f2bf(a) | ((unsigned)f2bf(b) << 16); }
__device__ __forceinline__ void unpack8(const uint4 v, float (&f)[8]) {
  f[0] = bf2f((u16)(v.x & 0xffff)); f[1] = bf2f((u16)(v.x >> 16)); f[2] = bf2f((u16)(v.y & 0xffff)); f[3] = bf2f((u16)(v.y >> 16));
  f[4] = bf2f((u16)(v.z & 0xffff)); f[5] = bf2f((u16)(v.z >> 16)); f[6] = bf2f((u16)(v.w & 0xffff)); f[7] = bf2f((u16)(v.w >> 16));
}
__device__ __forceinline__ uint4 pack8s(const float (&f)[8], float sc) {
  return make_uint4(pack2(f[0] * sc, f[1] * sc), pack2(f[2] * sc, f[3] * sc), pack2(f[4] * sc, f[5] * sc), pack2(f[6] * sc, f[7] * sc));
}
__device__ __forceinline__ float silu_f(float x) { return x / (1.f + __expf(-x)); }
__device__ __forceinline__ float sigm(float x) { return 1.f / (1.f + __expf(-x)); }
__device__ __forceinline__ float wave_sum(float v) {
#pragma unroll
  for (int o = 32; o; o >>= 1) v += __shfl_xor(v, o);
  return v;
}
__device__ __forceinline__ const float* xin_of(const Params& P, int slab) { return slab == 0 ? P.in[0] : P.in[1] + (long)(slab - 1) * SLAB * D; }
__device__ __forceinline__ int Lof(int slab) { return slab == 0 ? 2048 : 8192; }
__device__ __forceinline__ int gb_row(int gr) { return gr < 16384 ? (gr >> 11) : (8 + ((gr - 16384) >> 13)); }
__device__ __forceinline__ int gb_of(int slab, int r) { return slab == 0 ? (r >> 11) : (8 + (slab - 1) * 2 + (r >> 13)); }

typedef short v4s __attribute__((ext_vector_type(4)));
#define LBAR() asm volatile("s_waitcnt lgkmcnt(0)\n\ts_barrier" ::: "memory")
#define LDS_AS __attribute__((address_space(3)))
template <int R, bool KC>
__device__ __forceinline__ uint4 ld_chunk(const u16* __restrict__ base, long ld, int k0, int c) {
  if (KC) {
    const int r = c >> 3, kc = c & 7;
    return *(const uint4*)(base + (long)r * ld + k0 + kc * 8);
  } else {
    const int k = c / (R / 8), mc = c % (R / 8);
    return *(const uint4*)(base + (long)(k0 + k) * ld + mc * 8);
  }
}
template <int R, bool KC>
__device__ __forceinline__ void st_chunk(u16* s, uint4 v, int c) {
  if (KC) {
    const int r = c >> 3, kc = c & 7;
    *(uint4*)(s + r * 72 + kc * 8) = v;
  } else {
    const int k = c / (R / 8), mc = c % (R / 8);
    *(uint4*)(s + k * (R + 8) + mc * 8) = v;
  }
}
template <int R, bool KC>
__device__ __forceinline__ bf16x8 ld_frag(const u16* s, int x0, int ks, int fr, int fq) {
  if (KC) {
    return *(const bf16x8*)(s + (x0 + fr) * 72 + ks * 32 + fq * 8);
  } else {
    const int q4 = fr >> 2, p4 = fr & 3;
    const u16* p = s + (ks * 32 + 8 * fq + q4) * (R + 8) + x0 + 4 * p4;
    v4s lo = __builtin_amdgcn_ds_read_tr16_b64_v4i16((LDS_AS v4s*)p);
    v4s hi = __builtin_amdgcn_ds_read_tr16_b64_v4i16((LDS_AS v4s*)(p + 4 * (R + 8)));
    bf16x8 r;
    r[0] = lo[0]; r[1] = lo[1]; r[2] = lo[2]; r[3] = lo[3]; r[4] = hi[0]; r[5] = hi[1]; r[6] = hi[2]; r[7] = hi[3];
    return r;
  }
}

template <int TM, int TN, bool AKC, bool BKC, bool TR, int KT>
__device__ __forceinline__ void gemm_acc(f32x4 (&acc)[TM / 32][TN / 64], const u16* __restrict__ A, long lda,
                                         const u16* __restrict__ B, long ldb, u16* sm) {
  u16* As = sm;
  u16* Bs = sm + 9216;
  const int tid = TID(), lane = tid & 63, wid = tid >> 6;
  const int wm = wid >> 2, wn = wid & 3, fr = lane & 15, fq = lane >> 4;
  constexpr int MI = TM / 32, NI = TN / 64;
  uint4 ra0[KT], ra1[KT], rb0[KT], rb1[KT];
#pragma unroll
  for (int kt = 0; kt < KT; ++kt) {
    ra0[kt] = ld_chunk<TM, AKC>(A, lda, kt * 64, tid);
    ra1[kt] = ra0[kt];
    if (TM == 128) ra1[kt] = ld_chunk<TM, AKC>(A, lda, kt * 64, tid + NT);
    rb0[kt] = ld_chunk<TN, BKC>(B, ldb, kt * 64, tid);
    rb1[kt] = rb0[kt];
    if (TN == 128) rb1[kt] = ld_chunk<TN, BKC>(B, ldb, kt * 64, tid + NT);
  }
#pragma unroll
  for (int kt = 0; kt < KT; ++kt) {
    __syncthreads();
    st_chunk<TM, AKC>(As, ra0[kt], tid);
    if (TM == 128) st_chunk<TM, AKC>(As, ra1[kt], tid + NT);
    st_chunk<TN, BKC>(Bs, rb0[kt], tid);
    if (TN == 128) st_chunk<TN, BKC>(Bs, rb1[kt], tid + NT);
    __syncthreads();
#pragma unroll
    for (int ks = 0; ks < 2; ++ks) {
      bf16x8 af[MI], bfr[NI];
#pragma unroll
      for (int mi = 0; mi < MI; ++mi) af[mi] = ld_frag<TM, AKC>(As, wm * (TM / 2) + mi * 16, ks, fr, fq);
#pragma unroll
      for (int ni = 0; ni < NI; ++ni) bfr[ni] = ld_frag<TN, BKC>(Bs, wn * (TN / 4) + ni * 16, ks, fr, fq);
#pragma unroll
      for (int mi = 0; mi < MI; ++mi)
#pragma unroll
        for (int ni = 0; ni < NI; ++ni)
          acc[mi][ni] = TR ? __builtin_amdgcn_mfma_f32_16x16x32_bf16(bfr[ni], af[mi], acc[mi][ni], 0, 0, 0)
                           : __builtin_amdgcn_mfma_f32_16x16x32_bf16(af[mi], bfr[ni], acc[mi][ni], 0, 0, 0);
    }
  }
  __syncthreads();
}

template <int KT> struct Tiles { uint4 a0[KT], a1[KT], b0[KT], b1[KT]; };
template <int TM, int TN, bool AKC, bool BKC, int KT>
__device__ __forceinline__ void tiles_issue(Tiles<KT>& t, const u16* __restrict__ A, long lda, const u16* __restrict__ B, long ldb) {
  const int tid = TID();
#pragma unroll
  for (int kt = 0; kt < KT; ++kt) {
    t.a0[kt] = ld_chunk<TM, AKC>(A, lda, kt * 64, tid);
    t.a1[kt] = t.a0[kt];
    if (TM == 128) t.a1[kt] = ld_chunk<TM, AKC>(A, lda, kt * 64, tid + NT);
    t.b0[kt] = ld_chunk<TN, BKC>(B, ldb, kt * 64, tid);
    t.b1[kt] = t.b0[kt];
    if (TN == 128) t.b1[kt] = ld_chunk<TN, BKC>(B, ldb, kt * 64, tid + NT);
  }
}
template <int TM, int TN, bool AKC, bool BKC, bool TR, int KT>
__device__ __forceinline__ void gemm_run(f32x4 (&acc)[TM / 32][TN / 64], const Tiles<KT>& t, u16* sm) {
  u16* As = sm;
  u16* Bs = sm + 9216;
  const int tid = TID(), lane = tid & 63, wid = tid >> 6;
  const int wm = wid >> 2, wn = wid & 3, fr = lane & 15, fq = lane >> 4;
  constexpr int MI = TM / 32, NI = TN / 64;
#pragma unroll
  for (int kt = 0; kt < KT; ++kt) {
    __syncthreads();
    st_chunk<TM, AKC>(As, t.a0[kt], tid);
    if (TM == 128) st_chunk<TM, AKC>(As, t.a1[kt], tid + NT);
    st_chunk<TN, BKC>(Bs, t.b0[kt], tid);
    if (TN == 128) st_chunk<TN, BKC>(Bs, t.b1[kt], tid + NT);
    __syncthreads();
#pragma unroll
    for (int ks = 0; ks < 2; ++ks) {
      bf16x8 af[MI], bfr[NI];
#pragma unroll
      for (int mi = 0; mi < MI; ++mi) af[mi] = ld_frag<TM, AKC>(As, wm * (TM / 2) + mi * 16, ks, fr, fq);
#pragma unroll
      for (int ni = 0; ni < NI; ++ni) bfr[ni] = ld_frag<TN, BKC>(Bs, wn * (TN / 4) + ni * 16, ks, fr, fq);
#pragma unroll
      for (int mi = 0; mi < MI; ++mi)
#pragma unroll
        for (int ni = 0; ni < NI; ++ni)
          acc[mi][ni] = TR ? __builtin_amdgcn_mfma_f32_16x16x32_bf16(bfr[ni], af[mi], acc[mi][ni], 0, 0, 0)
                           : __builtin_amdgcn_mfma_f32_16x16x32_bf16(af[mi], bfr[ni], acc[mi][ni], 0, 0, 0);
    }
  }
}

template <int TM, int TN, bool TR, class F>
__device__ __forceinline__ void epi_each(f32x4 (&acc)[TM / 32][TN / 64], F f) {
  const int tid = TID(), lane = tid & 63, wid = tid >> 6;
  const int wm = wid >> 2, wn = wid & 3, fr = lane & 15, fq = lane >> 4;
#pragma unroll
  for (int mi = 0; mi < TM / 32; ++mi)
#pragma unroll
    for (int ni = 0; ni < TN / 64; ++ni) {
      const int r0 = wm * (TM / 2) + mi * 16, c0 = wn * (TN / 4) + ni * 16;
      if (TR) f(r0 + fr, c0 + fq * 4, acc[mi][ni]);
      else f(r0 + fq * 4, c0 + fr, acc[mi][ni]);
    }
}

struct EpiStoreBf16 {
  static constexpr bool PERM = true, AFTER_DRAIN = false;
  u16* O; int ldc;
  __device__ __forceinline__ void operator()(const f32x4 (&acc)[2][2][4][2], const pg8::Unit& u, int wr, int wc, int fr, int fq) const {
    const int row0 = u.pm * 256 + wr * 64 + fr, col0 = u.pn * 256 + wc * 32 + 8 * fq;
#pragma unroll
    for (int ai = 0; ai < 2; ++ai)
#pragma unroll
      for (int m = 0; m < 4; ++m) {
        u16* rowp = O + (size_t)(row0 + ai * 128 + m * 16) * ldc + col0;
#pragma unroll
        for (int bj = 0; bj < 2; ++bj) {
          const f32x4 v0 = acc[ai][bj][m][0], v1 = acc[ai][bj][m][1];
          *(uint4*)(rowp + bj * 128) = make_uint4(pack2(v0[0], v0[1]), pack2(v0[2], v0[3]), pack2(v1[0], v1[1]), pack2(v1[2], v1[3]));
        }
      }
  }
};
struct EpiResid {
  static constexpr bool PERM = false, AFTER_DRAIN = false;
  float* X; const float* XS; const float* mod; int goff; int grow0;
  __device__ __forceinline__ void operator()(const f32x4 (&acc)[2][2][4][2], const pg8::Unit& u, int wr, int wc, int fr, int fq) const {
    const int row0 = u.pm * 256 + wr * 64 + fr, col0 = u.pn * 256 + wc * 32 + 4 * fq;
    const float* g = mod + (size_t)gb_row(grow0 + u.pm * 256) * 6144 + goff + col0;
    f32x4 gv[2][2];
#pragma unroll
    for (int bj = 0; bj < 2; ++bj)
#pragma unroll
      for (int n = 0; n < 2; ++n) gv[bj][n] = *(const f32x4*)(g + bj * 128 + n * 16);
#pragma unroll
    for (int am = 0; am < 4; ++am) {
      f32x4 xv[2][2][2];
#pragma unroll
      for (int mm = 0; mm < 2; ++mm)
#pragma unroll
        for (int bj = 0; bj < 2; ++bj)
#pragma unroll
          for (int n = 0; n < 2; ++n) xv[mm][bj][n] = *(const f32x4*)(XS + (size_t)(row0 + (am >> 1) * 128 + ((am & 1) * 2 + mm) * 16) * D + col0 + bj * 128 + n * 16);
#pragma unroll
      for (int mm = 0; mm < 2; ++mm)
#pragma unroll
        for (int bj = 0; bj < 2; ++bj)
#pragma unroll
          for (int n = 0; n < 2; ++n)
            *(f32x4*)(X + (size_t)(row0 + (am >> 1) * 128 + ((am & 1) * 2 + mm) * 16) * D + col0 + bj * 128 + n * 16) = xv[mm][bj][n] + gv[bj][n] * acc[am >> 1][bj][(am & 1) * 2 + mm][n];
    }
  }
};
struct EpiFfnVal {
  static constexpr bool PERM = false, AFTER_DRAIN = false;
  const u16* G; u16* ACT; const float* cw; const float* cb; int grow0;
  __device__ __forceinline__ void operator()(const f32x4 (&acc)[2][2][4][2], const pg8::Unit& u, int wr, int wc, int fr, int fq) const {
    const int row0 = u.pm * 256 + wr * 64 + fr, col0 = u.pn * 256 + wc * 32 + 4 * fq;
#pragma unroll
    for (int bj = 0; bj < 2; ++bj)
#pragma unroll
      for (int n = 0; n < 2; ++n) {
        const int c = col0 + bj * 128 + n * 16;
        const f32x4 w0 = *(const f32x4*)(cw + c), w1 = *(const f32x4*)(cw + DFF + c), w2 = *(const f32x4*)(cw + 2 * DFF + c), bb = *(const f32x4*)(cb + c);
#pragma unroll
        for (int ai = 0; ai < 2; ++ai) {
          uint2 g0[4], g1[4], g2[4];
#pragma unroll
          for (int m = 0; m < 4; ++m) {
            const int r = row0 + ai * 128 + m * 16;
            const int L = (grow0 + r) < 16384 ? 2048 : 8192;
            const int pos = (grow0 + r) & (L - 1);
            const u16* gp = G + (size_t)r * DFF + c;
            g1[m] = *(const uint2*)gp;
            g0[m] = *(const uint2*)(gp - (pos > 0 ? DFF : 0));
            g2[m] = *(const uint2*)(gp + (pos < L - 1 ? DFF : 0));
          }
#pragma unroll
          for (int m = 0; m < 4; ++m) {
            const int r = row0 + ai * 128 + m * 16;
            const int L = (grow0 + r) < 16384 ? 2048 : 8192;
            const int pos = (grow0 + r) & (L - 1);
            const float m0 = pos > 0 ? 1.f : 0.f, m2 = pos < L - 1 ? 1.f : 0.f;
            const uint2 a0 = g0[m], a1 = g1[m], a2 = g2[m];
            f32x4 a;
            a[0] = m0 * bf2f((u16)(a0.x & 0xffff)) * w0[0] + bf2f((u16)(a1.x & 0xffff)) * w1[0] + m2 * bf2f((u16)(a2.x & 0xffff)) * w2[0] + bb[0];
            a[1] = m0 * bf2f((u16)(a0.x >> 16)) * w0[1] + bf2f((u16)(a1.x >> 16)) * w1[1] + m2 * bf2f((u16)(a2.x >> 16)) * w2[1] + bb[1];
            a[2] = m0 * bf2f((u16)(a0.y & 0xffff)) * w0[2] + bf2f((u16)(a1.y & 0xffff)) * w1[2] + m2 * bf2f((u16)(a2.y & 0xffff)) * w2[2] + bb[2];
            a[3] = m0 * bf2f((u16)(a0.y >> 16)) * w0[3] + bf2f((u16)(a1.y >> 16)) * w1[3] + m2 * bf2f((u16)(a2.y >> 16)) * w2[3] + bb[3];
            const f32x4 v = acc[ai][bj][m][n];
            *(uint2*)(ACT + (size_t)r * DFF + c) = make_uint2(pack2(silu_f(a[0]) * v[0], silu_f(a[1]) * v[1]), pack2(silu_f(a[2]) * v[2], silu_f(a[3]) * v[3]));
          }
        }
      }
  }
};
template <class Epi>
__device__ __forceinline__ void run_gemm(const u16* A, const u16* Bt, int M, int N, int K, const Epi& E) {
  pg8::Gemm g; g.A = A; g.Bt = Bt; g.M = M; g.N = N; g.K = K;
  pg8::StaticOrder S; S.init(M, N, gridDim.x, BID());
  __syncthreads();
  pg8::gemm_phase<Epi, pg8::StaticOrder, false>((PG8_LAS unsigned char*)smem, g, S, E, nullptr);
  __syncthreads();
}

__device__ __forceinline__ int fidx(int p) { return p + ((p >> 6) << 2); }
__device__ __forceinline__ float2 cmulf(float2 a, float2 b) { return make_float2(a.x * b.x - a.y * b.y, a.x * b.y + a.y * b.x); }
__device__ __forceinline__ float2 cmulcf(float2 a, float2 b) { return make_float2(a.x * b.x + a.y * b.y, a.y * b.x - a.x * b.y); }
#define R16C(q) ((q) == 0 ? 1.f : (q) == 1 ? 0.9238795325f : (q) == 2 ? 0.7071067812f : (q) == 3 ? 0.3826834324f : (q) == 4 ? 0.f : (q) == 5 ? -0.3826834324f : (q) == 6 ? -0.7071067812f : -0.9238795325f)
#define R16S(q) ((q) == 0 ? 0.f : (q) == 1 ? -0.3826834324f : (q) == 2 ? -0.7071067812f : (q) == 3 ? -0.9238795325f : (q) == 4 ? -1.f : (q) == 5 ? -0.9238795325f : (q) == 6 ? -0.7071067812f : -0.3826834324f)
template <int N, int RS, bool INV>
__device__ __forceinline__ void fft_pass(float2* x, const float2* __restrict__ tw, const int S, const int tid) {
  constexpr int R = 1 << RS;
  const int E = S >> (RS - 1);
#pragma unroll 1
  for (int g = tid; g < N / R; g += NT) {
    const int blo = g & (E - 1);
    const int base = ((g - blo) << RS) + blo;
    float2 e[R];
#pragma unroll
    for (int k = 0; k < R; ++k) e[k] = x[fidx(base + k * E)];
    float2 wb[RS];
#pragma unroll
    for (int st = 0; st < RS; ++st) wb[st] = tw[blo * (8192 / (S >> st))];
#pragma unroll
    for (int sq = 0; sq < RS; ++sq) {
      const int st = INV ? (RS - 1 - sq) : sq;
      const int h = (R / 2) >> st;
#pragma unroll
      for (int k = 0; k < R; ++k) {
        if ((k & h) == 0) {
          const int m = k & (h - 1);
          const int q = m * (8 / h);
          float2 w = wb[st];
          if (q != 0) w = cmulf(w, make_float2(R16C(q), R16S(q)));
          if (!INV) {
            const float2 a = e[k], b = e[k + h];
            e[k] = make_float2(a.x + b.x, a.y + b.y);
            e[k + h] = cmulf(make_float2(a.x - b.x, a.y - b.y), w);
          } else {
            const float2 a = e[k], b = cmulcf(e[k + h], w);
            e[k] = make_float2(a.x + b.x, a.y + b.y);
            e[k + h] = make_float2(a.x - b.x, a.y - b.y);
          }
        }
      }
    }
#pragma unroll
    for (int k = 0; k < R; ++k) x[fidx(base + k * E)] = e[k];
  }
  __syncthreads();
}
template <int N>
__device__ __forceinline__ void fft_dif_t(float2* x, const float2* __restrict__ tw) {
  const int tid = TID();
  if (N == 16384) {
    fft_pass<N, 4, false>(x, tw, 8192, tid); fft_pass<N, 4, false>(x, tw, 512, tid);
    fft_pass<N, 4, false>(x, tw, 32, tid); fft_pass<N, 2, false>(x, tw, 2, tid);
  } else {
    fft_pass<N, 4, false>(x, tw, 2048, tid); fft_pass<N, 4, false>(x, tw, 128, tid); fft_pass<N, 4, false>(x, tw, 8, tid);
  }
}
template <int N>
__device__ __forceinline__ void ifft_dit_t(float2* x, const float2* __restrict__ tw) {
  const int tid = TID();
  if (N == 16384) {
    fft_pass<N, 2, true>(x, tw, 2, tid); fft_pass<N, 4, true>(x, tw, 32, tid);
    fft_pass<N, 4, true>(x, tw, 512, tid); fft_pass<N, 4, true>(x, tw, 8192, tid);
  } else {
    fft_pass<N, 4, true>(x, tw, 8, tid); fft_pass<N, 4, true>(x, tw, 128, tid); fft_pass<N, 4, true>(x, tw, 2048, tid);
  }
}
__device__ __forceinline__ void fft_dif(float2* x, int N, const float2* __restrict__ tw) {
  if (N == 16384) fft_dif_t<16384>(x, tw); else fft_dif_t<4096>(x, tw);
}
__device__ __forceinline__ void ifft_dit(float2* x, int N, const float2* __restrict__ tw) {
  if (N == 16384) ifft_dit_t<16384>(x, tw); else ifft_dit_t<4096>(x, tw);
}

__device__ void transpose_w(const float* __restrict__ W, u16* __restrict__ Wt, int K, int N) {
  float* smf = (float*)smem;
  const int tk = K / 64, tn = N / 64, tid = TID();
  for (int item = BID(); item < tk * tn; item += gridDim.x) {
    const int k0 = (item / tn) * 64, n0 = (item % tn) * 64;
    float4 v[2];
#pragma unroll
    for (int j = 0; j < 2; ++j) {
      const int idx = tid + j * NT, kk = idx >> 4, n4 = idx & 15;
      v[j] = *(const float4*)(W + (long)(k0 + kk) * N + n0 + n4 * 4);
    }
    __syncthreads();
#pragma unroll
    for (int j = 0; j < 2; ++j) {
      const int idx = tid + j * NT, kk = idx >> 4, n4 = idx & 15;
      float* p = smf + kk * 65 + n4 * 4;
      p[0] = v[j].x; p[1] = v[j].y; p[2] = v[j].z; p[3] = v[j].w;
    }
    __syncthreads();
    const int nn = tid >> 3, k8 = tid & 7;
    float f[8];
#pragma unroll
    for (int i = 0; i < 8; ++i) f[i] = smf[(k8 * 8 + i) * 65 + nn];
    *(uint4*)(Wt + (long)(n0 + nn) * K + k0 + k8 * 8) = pack8s(f, 1.f);
  }
  __syncthreads();
}

__device__ void phase_pre0(const Params& P) {
  const int tid = TID();
  const long gtid = (long)BID() * NT + tid, gsz = (long)gridDim.x * NT;
  transpose_w(P.in[7], (u16*)(WS(P) + O_WHYIN), 1024, 3072);
  transpose_w(P.in[18], (u16*)(WS(P) + O_WHYOUT), 1024, 1024);
  transpose_w(P.in[19], (u16*)(WS(P) + O_WRETIN), 1024, 6144);
  transpose_w(P.in[21], (u16*)(WS(P) + O_WRETOUT), 2048, 1024);
  transpose_w(P.in[22], (u16*)(WS(P) + O_WSWAIN), 1024, 1536);
  transpose_w(P.in[26], (u16*)(WS(P) + O_WSWAOUT), 1024, 1024);
  transpose_w(P.in[27], (u16*)(WS(P) + O_WHGIN), 1024, 5120);
  transpose_w(P.in[30], (u16*)(WS(P) + O_WHGOUT), 1024, 1024);
  for (int l = 0; l < 4; ++l) {
    transpose_w(P.in[31] + (long)l * 1024 * DFF, (u16*)(WS(P) + O_WFG) + (long)l * DFF * 1024, 1024, DFF);
    transpose_w(P.in[32] + (long)l * 1024 * DFF, (u16*)(WS(P) + O_WFV) + (long)l * DFF * 1024, 1024, DFF);
    transpose_w(P.in[35] + (long)l * DFF * 1024, (u16*)(WS(P) + O_WFD) + (long)l * 1024 * DFF, DFF, 1024);
  }
  {
    float* cs = (float*)smem;
    float* modp = (float*)(WS(P) + O_MODP);
    for (int item = BID(); item < 4 * 8 * 12; item += gridDim.x) {
      const int nb = item % 12, ks = (item / 12) % 8, l = item / 96;
      __syncthreads();
      for (int i = tid; i < 2048; i += NT) {
        int b = i >> 7, k = i & 127;
        float c = (b < 8) ? P.in[2][b * 1024 + ks * 128 + k] : P.in[3][(b - 8) * 1024 + ks * 128 + k];
        cs[i] = c / (1.f + expf(-c));
      }
      __syncthreads();
      const int n = nb * 512 + tid;
      float a[16];
#pragma unroll
      for (int b = 0; b < 16; ++b) a[b] = 0.f;
      const float* w = P.in[4] + ((long)l * 1024 + ks * 128) * 6144 + n;
      for (int k = 0; k < 128; ++k) {
        float wv = w[(long)k * 6144];
#pragma unroll
        for (int b = 0; b < 16; ++b) a[b] += cs[b * 128 + k] * wv;
      }
#pragma unroll
      for (int b = 0; b < 16; ++b) modp[(((long)ks * 4 + l) * 16 + b) * 6144 + n] = a[b];
    }
    __syncthreads();
  }
  {
    float2* tw = (float2*)(WS(P) + O_TW);
    for (long i = gtid; i < 8192; i += gsz) {
      float s, c;
      sincospif((float)i * (1.f / 8192.f), &s, &c);
      tw[i] = make_float2(c, -s);
    }
    float2* rr = (float2*)(WS(P) + O_ROPER);
    for (long i = gtid; i < (long)8192 * 128; i += gsz) {
      int pos = (int)(i >> 7), d = (int)(i & 127);
      float inv = exp2f(-(float)d * (13.287712379549449f / 128.f));
      float s, c;
      sincosf((float)pos * inv, &s, &c);
      rr[i] = make_float2(c, s);
    }
    float2* rs = (float2*)(WS(P) + O_ROPES);
    for (long i = gtid; i < (long)8192 * 32; i += gsz) {
      int pos = (int)(i >> 5), d = (int)(i & 31);
      float inv = exp2f(-(float)d * (13.287712379549449f / 32.f));
      float s, c;
      sincosf((float)pos * inv, &s, &c);
      rs[i] = make_float2(c, s);
    }
  }
  {
    float* zf = (float*)smem;
    float* h1 = zf + 8 * 36;
    const float* w1 = P.in[10]; const float* b1 = P.in[11]; const float* w2 = P.in[12]; const float* b2 = P.in[13];
    const float* fr = P.in[15];
    const int tl = tid >> 6, j = tid & 63;
    for (int item = BID(); item < 1280; item += gridDim.x) {
      const int sel = item >= 1024;
      const int L = sel ? 2048 : 8192;
      const int t = (sel ? item - 1024 : item) * 8 + tl;
      float* hid = (float*)(WS(P) + (sel ? O_HIDP : O_HIDS));
      __syncthreads();
      if (j < 33) {
        float v;
        if (j == 0) v = (float)t / (float)(L - 1);
        else {
          int i = (j - 1) & 15;
          float band = 1e-4f + (float)i * ((15.f - 1e-4f) / 15.f);
          float ang = (6.283185307179586f / (float)L) * (float)t;
          float a = band * ang;
          v = (j <= 16) ? cosf(a) : -sinf(a);
        }
        zf[tl * 36 + j] = v;
      }
      __syncthreads();
      float s = b1[j];
#pragma unroll 3
      for (int i = 0; i < 33; ++i) s += zf[tl * 36 + i] * w1[i * 64 + j];
      h1[tl * 64 + j] = sinf(fr[j] * s);
      __syncthreads();
      float s2 = b2[j];
#pragma unroll 4
      for (int i = 0; i < 64; ++i) s2 += h1[tl * 64 + i] * w2[i * 64 + j];
      hid[(long)t * 64 + j] = sinf(fr[j] * s2);
    }
    __syncthreads();
  }
}

__device__ void phase_pre1(const Params& P) {
  __shared__ float w3s[128];
  __shared__ float red[8];
  const int tid = TID(), lane = tid & 63, wid = tid >> 6;
  const long gtid = (long)BID() * NT + tid, gsz = (long)gridDim.x * NT;
  {
    const float* modp = (const float*)(WS(P) + O_MODP);
    float* mod = (float*)(WS(P) + O_MOD);
    for (long i = gtid; i < (long)4 * 16 * 6144; i += gsz) {
      int n = (int)(i % 6144);
      int l = (int)(i / (16 * 6144));
      float s = P.in[5][l * 6144 + n];
      for (int ks = 0; ks < 8; ++ks) s += modp[(long)ks * 4 * 16 * 6144 + i];
      mod[i] = s;
    }
  }
  float2* buf = (float2*)smem;
  const float2* tw = (const float2*)(WS(P) + O_TW);
  for (int item = BID(); item < 2048; item += gridDim.x) {
    const int sel = item >> 10, c = item & 1023;
    const int L = sel ? 2048 : 8192, N = 2 * L;
    const float* hid = (const float*)(WS(P) + (sel ? O_HIDP : O_HIDS));
    float2* hs = (float2*)(WS(P) + (sel ? O_HSPP : O_HSPS)) + (long)c * N;
    __syncthreads();
    if (tid < 128) {
      int dirn = tid >> 6, j = tid & 63;
      w3s[tid] = P.in[14][(long)j * 2048 + dirn * 1024 + c];
    }
    __syncthreads();
    const float dec0 = fabsf(P.in[16][c]), dec1 = fabsf(P.in[16][1024 + c]);
    const float invLm1 = 1.f / (float)(L - 1);
    float asum = 0.f;
    for (int n = tid; n < N; n += NT) {
      float val = 0.f;
      if (n != L) {
        const int dirn = n < L ? 0 : 1;
        const int t = n < L ? n : N - n;
        const float4* hr = (const float4*)(hid + (long)t * 64);
        const float* w = w3s + dirn * 64;
        float s = 0.f;
#pragma unroll
        for (int q = 0; q < 16; ++q) {
          float4 h4 = hr[q];
          s += h4.x * w[4 * q] + h4.y * w[4 * q + 1] + h4.z * w[4 * q + 2] + h4.w * w[4 * q + 3];
        }
        float tl = (float)t * invLm1;
        val = s * expf(-tl * (dirn ? dec1 : dec0));
      }
      buf[fidx(n)] = make_float2(val, 0.f);
      asum += fabsf(val);
    }
    asum = wave_sum(asum);
    if (lane == 0) red[wid] = asum;
    __syncthreads();
    float tot = 0.f;
#pragma unroll
    for (int w = 0; w < 8; ++w) tot += red[w];
    const float scale = 1.f / (tot * (float)N);
    fft_dif(buf, N, tw);
    for (int p = tid; p < N; p += NT) {
      float2 a = buf[fidx(p)];
      hs[p] = make_float2(a.x * scale, a.y * scale);
    }
  }
  __syncthreads();
}

__device__ void phase_norm(const Params& P, int layer, int sl, int which) {
  const int grow0 = which ? sl * FSLAB : sl * SLAB, nrows = which ? FSLAB : SLAB;
  const float* __restrict__ x = (layer == 0 && which == 0) ? xin_of(P, sl) : (const float*)(OUTP(P) + (long)grow0 * D);
  u16* __restrict__ h = (u16*)(WS(P) + (which ? O_FHBUF : O_HBUF));
  const float* gain = P.in[6] + (layer * 2 + which) * D;
  const float* mod = (const float*)(WS(P) + O_MOD) + (long)layer * 16 * 6144;
  const int shoff = which ? 3 * D : 0, scoff = which ? 4 * D : D;
  const int tid = TID(), lane = tid & 63, wid = tid >> 6;
  for (int item = BID(); item < nrows / 32; item += gridDim.x) {
    const int r0 = item * 32 + wid * 4;
    float4 v[4][4];
    float ss[4];
#pragma unroll
    for (int u = 0; u < 4; ++u) {
      const float* xr = x + (long)(r0 + u) * D;
      float a = 0.f;
#pragma unroll
      for (int i = 0; i < 4; ++i) {
        v[u][i] = *(const float4*)(xr + i * 256 + lane * 4);
        a += v[u][i].x * v[u][i].x + v[u][i].y * v[u][i].y + v[u][i].z * v[u][i].z + v[u][i].w * v[u][i].w;
      }
      ss[u] = a;
    }
    const float* m = mod + (long)gb_row(grow0 + r0) * 6144;
#pragma unroll
    for (int u = 0; u < 4; ++u) ss[u] = wave_sum(ss[u]);
#pragma unroll
    for (int i = 0; i < 4; ++i) {
      const int col = i * 256 + lane * 4;
      const float4 g = *(const float4*)(gain + col);
      const float4 sc = *(const float4*)(m + scoff + col);
      const float4 sh = *(const float4*)(m + shoff + col);
      const float a0 = g.x * (1.f + sc.x), a1 = g.y * (1.f + sc.y), a2 = g.z * (1.f + sc.z), a3 = g.w * (1.f + sc.w);
#pragma unroll
      for (int u = 0; u < 4; ++u) {
        const float rstd = rsqrtf(ss[u] * (1.f / 1024.f) + 1e-6f);
        const float y0 = v[u][i].x * rstd * a0 + sh.x, y1 = v[u][i].y * rstd * a1 + sh.y;
        const float y2 = v[u][i].z * rstd * a2 + sh.z, y3 = v[u][i].w * rstd * a3 + sh.w;
        *(uint2*)(h + (long)(r0 + u) * D + col) = make_uint2(pack2(y0, y1), pack2(y2, y3));
      }
    }
  }
}

__device__ void phase_proj(const Params& P, size_t woff, int N) {
  EpiStoreBf16 E; E.O = (u16*)(WS(P) + O_PROJ); E.ldc = N;
  run_gemm((const u16*)(WS(P) + O_HBUF), (const u16*)(WS(P) + woff), SLAB, N, D, E);
}
__device__ void phase_resid(const Params& P, int layer, int slab, const u16* A, int K, size_t woff, int goff) {
  EpiResid E; E.X = OUTP(P) + (long)slab * SLAB * D; E.XS = (layer == 0) ? xin_of(P, slab) : (const float*)E.X; E.mod = (const float*)(WS(P) + O_MOD) + (long)layer * 16 * 6144; E.goff = goff; E.grow0 = slab * SLAB;
  run_gemm(A, (const u16*)(WS(P) + woff), SLAB, D, K, E);
}

__device__ void phase_ffn_gate(const Params& P, int layer) {
  EpiStoreBf16 E; E.O = (u16*)(WS(P) + O_FGBUF); E.ldc = DFF;
  run_gemm((const u16*)(WS(P) + O_FHBUF), (const u16*)(WS(P) + O_WFG) + (long)layer * DFF * D, FSLAB, DFF, D, E);
}
__device__ void phase_ffn_val(const Params& P, int layer, int fs) {
  EpiFfnVal E; E.G = (const u16*)(WS(P) + O_FGBUF); E.ACT = (u16*)(WS(P) + O_FACT) + (long)fs * FSLAB * DFF;
  E.cw = P.in[33] + (long)layer * 3 * DFF; E.cb = P.in[34] + (long)layer * DFF; E.grow0 = fs * FSLAB;
  run_gemm((const u16*)(WS(P) + O_FHBUF), (const u16*)(WS(P) + O_WFV) + (long)layer * DFF * D, FSLAB, DFF, D, E);
}
__device__ void phase_ffn_down(const Params& P, int layer) {
  EpiResid E; E.X = OUTP(P); E.XS = E.X; E.mod = (const float*)(WS(P) + O_MOD) + (long)layer * 16 * 6144; E.goff = 5 * D; E.grow0 = 0;
  run_gemm((const u16*)(WS(P) + O_FACT), (const u16*)(WS(P) + O_WFD) + (long)layer * D * DFF, NTOK, D, DFF, E);
}

__device__ void phase_hy_conv(const Params& P, int slab) {
  const int L = Lof(slab), nseq = SLAB / L, tid = TID();
  const u16* __restrict__ z = (const u16*)(WS(P) + O_PROJ);
  float* __restrict__ uT = (float*)(WS(P) + O_UT);
  u16* __restrict__ x0c = (u16*)(WS(P) + O_X0C);
  const float* cw = P.in[8];
  const float* cb = P.in[9];
  float* tile = (float*)smem;
  const int ntt = L / 64;
  const int nitems = nseq * ntt * 16;
  const int tl = tid >> 3, cg = tid & 7;
  for (int item = BID(); item < nitems; item += gridDim.x) {
    const int ct = item % 16, tt = (item / 16) % ntt, seq = item / (16 * ntt);
    const int t = tt * 64 + tl, c0 = ct * 64 + cg * 8;
    const long row = (long)seq * L + t;
    const float mp = t > 0 ? 1.f : 0.f, mn = t < L - 1 ? 1.f : 0.f;
    const long rp = t > 0 ? row - 1 : row, rn = t < L - 1 ? row + 1 : row;
    float val[3][8];
#pragma unroll
    for (int q = 0; q < 3; ++q) {
      const int col = q * 1024 + c0;
      float a[8], b[8], c[8];
      unpack8(*(const uint4*)(z + rp * 3072 + col), a);
      unpack8(*(const uint4*)(z + row * 3072 + col), b);
      unpack8(*(const uint4*)(z + rn * 3072 + col), c);
      const float4 w0a = *(const float4*)(cw + col), w0b = *(const float4*)(cw + col + 4);
      const float4 w1a = *(const float4*)(cw + 3072 + col), w1b = *(const float4*)(cw + 3072 + col + 4);
      const float4 w2a = *(const float4*)(cw + 6144 + col), w2b = *(const float4*)(cw + 6144 + col + 4);
      const float4 ba = *(const float4*)(cb + col), bb = *(const float4*)(cb + col + 4);
      const float w0[8] = {w0a.x, w0a.y, w0a.z, w0a.w, w0b.x, w0b.y, w0b.z, w0b.w};
      const float w1[8] = {w1a.x, w1a.y, w1a.z, w1a.w, w1b.x, w1b.y, w1b.z, w1b.w};
      const float w2[8] = {w2a.x, w2a.y, w2a.z, w2a.w, w2b.x, w2b.y, w2b.z, w2b.w};
      const float bs[8] = {ba.x, ba.y, ba.z, ba.w, bb.x, bb.y, bb.z, bb.w};
#pragma unroll
      for (int i = 0; i < 8; ++i) val[q][i] = mp * a[i] * w0[i] + b[i] * w1[i] + mn * c[i] * w2[i] + bs[i];
    }
    *(uint4*)(x0c + row * 1024 + c0) = pack8s(val[0], 1.f);
    __syncthreads();
#pragma unroll
    for (int i = 0; i < 8; ++i) tile[tl * 65 + cg * 8 + i] = val[1][i] * val[2][i];
    __syncthreads();
    {
      const int cl = tid >> 3, tq = tid & 7;
      float* dst = uT + ((long)seq * 1024 + ct * 64 + cl) * L + tt * 64 + tq * 8;
      float4 o0, o1;
      o0.x = tile[(tq * 8 + 0) * 65 + cl]; o0.y = tile[(tq * 8 + 1) * 65 + cl]; o0.z = tile[(tq * 8 + 2) * 65 + cl]; o0.w = tile[(tq * 8 + 3) * 65 + cl];
      o1.x = tile[(tq * 8 + 4) * 65 + cl]; o1.y = tile[(tq * 8 + 5) * 65 + cl]; o1.z = tile[(tq * 8 + 6) * 65 + cl]; o1.w = tile[(tq * 8 + 7) * 65 + cl];
      *(float4*)dst = o0; *(float4*)(dst + 4) = o1;
    }
  }
  __syncthreads();
}

__device__ void phase_hy_fft(const Params& P, int slab, bool dry = false) {
  const int L = Lof(slab), N = 2 * L, nseq = SLAB / L, tid = TID();
  float* uT = (float*)(WS(P) + O_UT);
  const float2* hsb = (const float2*)(WS(P) + (slab == 0 ? O_HSPP : O_HSPS));
  const float2* tw = (const float2*)(WS(P) + O_TW);
  const float* skip = P.in[17];
  float2* buf = (float2*)smem;
  const int nitems = (nseq / 2) * 1024;
  for (int item = BID(); item < nitems; item += gridDim.x) {
    const int pr = item >> 10, c = item & 1023;
    float* u0 = uT + ((long)(pr * 2) * 1024 + c) * L;
    float* u1 = u0 + (long)1024 * L;
    __syncthreads();
    for (int t = tid; t < L; t += NT) {
      buf[fidx(t)] = make_float2(u0[t], u1[t]);
      buf[fidx(t + L)] = make_float2(0.f, 0.f);
    }
    __syncthreads();
    fft_dif(buf, N, tw);
    const float2* h = hsb + (long)c * N;
    for (int p = tid; p < N; p += NT) {
      float2 a = buf[fidx(p)], b = h[p];
      buf[fidx(p)] = make_float2(a.x * b.x - a.y * b.y, a.x * b.y + a.y * b.x);
    }
    __syncthreads();
    ifft_dit(buf, N, tw);
    const float sk = skip[c];
    for (int t = tid; t < L; t += NT) {
      float2 y = buf[fidx(t)];
      const long doff = dry ? (long)(END_HY - O_UT) / 4 : 0;
      u0[t + doff] = y.x + u0[t] * sk;
      u1[t + doff] = y.y + u1[t] * sk;
    }
  }
  __syncthreads();
}

__device__ void phase_hy_tr(const Params& P, int slab) {
  const int L = Lof(slab), nseq = SLAB / L, tid = TID();
  const float* __restrict__ yT = (const float*)(WS(P) + O_UT);
  const u16* __restrict__ x0c = (const u16*)(WS(P) + O_X0C);
  u16* __restrict__ a2 = (u16*)(WS(P) + O_A2);
  float* tile = (float*)smem;
  const int ntt = L / 64;
  const int nitems = nseq * ntt * 16;
  for (int item = BID(); item < nitems; item += gridDim.x) {
    const int ct = item % 16, tt = (item / 16) % ntt, seq = item / (16 * ntt);
    const int cl = tid >> 3, tq = tid & 7;
    const float* src = yT + ((long)seq * 1024 + ct * 64 + cl) * L + tt * 64 + tq * 8;
    const float4 i0 = *(const float4*)src, i1 = *(const float4*)(src + 4);
    const int tl = tid >> 3, cg = tid & 7;
    const long row = (long)seq * L + tt * 64 + tl;
    const int c0 = ct * 64 + cg * 8;
    float xg[8];
    unpack8(*(const uint4*)(x0c + row * 1024 + c0), xg);
    __syncthreads();
    float* p = tile + cl * 65 + tq * 8;
    p[0] = i0.x; p[1] = i0.y; p[2] = i0.z; p[3] = i0.w; p[4] = i1.x; p[5] = i1.y; p[6] = i1.z; p[7] = i1.w;
    __syncthreads();
    float o[8];
#pragma unroll
    for (int i = 0; i < 8; ++i) o[i] = tile[(cg * 8 + i) * 65 + tl] * xg[i];
    *(uint4*)(a2 + row * 1024 + c0) = pack8s(o, 1.f);
  }
  __syncthreads();
}

struct Rec {
  int H, DK, DV, C;
  int ldv, voff, goff;
};
__device__ __forceinline__ Rec rec_of(int kind) {
  Rec r;
  if (kind == 1) { r.H = 4; r.DK = 256; r.DV = 512; r.C = 128; r.ldv = 6144; r.voff = 2048; r.goff = 4096; }
  else { r.H = 8; r.DK = 128; r.DV = 128; r.C = 64; r.ldv = 5120; r.voff = 1024; r.goff = 4096; }
  return r;
}

__device__ void phase_ret_prep(const Params& P, int slab) {
  const int L = Lof(slab);
  const u16* __restrict__ pj = (const u16*)(WS(P) + O_PROJ);
  u16* __restrict__ qdf = (u16*)(WS(P) + O_QDF); u16* __restrict__ qdb = (u16*)(WS(P) + O_QDB);
  u16* __restrict__ kif = (u16*)(WS(P) + O_KIF); u16* __restrict__ kib = (u16*)(WS(P) + O_KIB);
  u16* __restrict__ kef = (u16*)(WS(P) + O_KEF); u16* __restrict__ keb = (u16*)(WS(P) + O_KEB);
  float* dlf = (float*)(WS(P) + O_DLF); float* dlb = (float*)(WS(P) + O_DLB);
  const float2* __restrict__ rope = (const float2*)(WS(P) + O_ROPER);
  const long gtid = (long)BID() * NT + TID(), gsz = (long)gridDim.x * NT;
  for (long idx = gtid; idx < (long)SLAB * 64; idx += gsz) {
    const int d0 = (int)(idx & 15) * 8, h = (int)((idx >> 4) & 3), t = (int)(idx >> 6);
    const int pos = t & (L - 1), r = t & 127;
    const float lgf = -expf(P.in[20][h]), lgb = -expf(P.in[20][4 + h]);
    const u16* row = pj + (long)t * 6144 + h * 256 + d0;
    const uint4 vq1 = *(const uint4*)row, vq2 = *(const uint4*)(row + 128);
    const uint4 vk1 = *(const uint4*)(row + 1024), vk2 = *(const uint4*)(row + 1024 + 128);
    const float4* rp = (const float4*)(rope + (long)pos * 128 + d0);
    const float4 c01 = rp[0], c23 = rp[1], c45 = rp[2], c67 = rp[3];
    float q1[8], q2[8], k1[8], k2[8];
    unpack8(vq1, q1); unpack8(vq2, q2); unpack8(vk1, k1); unpack8(vk2, k2);
    const float cs[8] = {c01.x, c01.z, c23.x, c23.z, c45.x, c45.z, c67.x, c67.z};
    const float sn[8] = {c01.y, c01.w, c23.y, c23.w, c45.y, c45.w, c67.y, c67.w};
    float qa[8], qb[8], ka[8], kb[8];
#pragma unroll
    for (int i = 0; i < 8; ++i) {
      qa[i] = q1[i] * cs[i] - q2[i] * sn[i]; qb[i] = q1[i] * sn[i] + q2[i] * cs[i];
      ka[i] = (k1[i] * cs[i] - k2[i] * sn[i]) * 0.0625f; kb[i] = (k1[i] * sn[i] + k2[i] * cs[i]) * 0.0625f;
    }
    const float bf = (float)(r + 1) * lgf, bb = (float)(128 - r) * lgb;
    const float ef = expf(bf), eif = expf(-bf), eef = expf((float)(127 - r) * lgf);
    const float eb = expf(bb), eib = expf(-bb), eeb = expf((float)r * lgb);
    const long o1 = (long)t * 1024 + h * 256 + d0, o2 = o1 + 128;
    *(uint4*)(qdf + o1) = pack8s(qa, ef); *(uint4*)(qdf + o2) = pack8s(qb, ef);
    *(uint4*)(qdb + o1) = pack8s(qa, eb); *(uint4*)(qdb + o2) = pack8s(qb, eb);
    *(uint4*)(kif + o1) = pack8s(ka, eif); *(uint4*)(kif + o2) = pack8s(kb, eif);
    *(uint4*)(kib + o1) = pack8s(ka, eib); *(uint4*)(kib + o2) = pack8s(kb, eib);
    *(uint4*)(kef + o1) = pack8s(ka, eef); *(uint4*)(kef + o2) = pack8s(kb, eef);
    *(uint4*)(keb + o1) = pack8s(ka, eeb); *(uint4*)(keb + o2) = pack8s(kb, eeb);
    if (r == 0) {
      const long cgi = (long)(t >> 7) * 1024 + h * 256 + d0;
      const float df = expf(128.f * lgf), db = expf(128.f * lgb);
#pragma unroll
      for (int i = 0; i < 8; ++i) { dlf[cgi + i] = df; dlf[cgi + 128 + i] = df; dlb[cgi + i] = db; dlb[cgi + 128 + i] = db; }
    }
  }
}

__device__ __forceinline__ float lb_of(const float* lbt, int dr, int ch) {
  const float a0 = lbt[(dr * 4 + 0) * 1024 + ch], a1 = lbt[(dr * 4 + 1) * 1024 + ch], a2 = lbt[(dr * 4 + 2) * 1024 + ch], a3 = lbt[(dr * 4 + 3) * 1024 + ch];
  const float m = fmaxf(fmaxf(a0, a1), fmaxf(a2, a3));
  const float e0 = expf(a0 - m), e1 = expf(a1 - m), e2 = expf(a2 - m), e3 = expf(a3 - m);
  return (e0 + e1 + e2) / (e0 + e1 + e2 + e3);
}
__device__ void phase_hg_prep(const Params& P) {
  const u16* __restrict__ pj = (const u16*)(WS(P) + O_PROJ);
  u16* __restrict__ qdf = (u16*)(WS(P) + O_QDF); u16* __restrict__ qdb = (u16*)(WS(P) + O_QDB);
  u16* __restrict__ kif = (u16*)(WS(P) + O_KIF); u16* __restrict__ kib = (u16*)(WS(P) + O_KIB);
  u16* __restrict__ kef = (u16*)(WS(P) + O_KEF); u16* __restrict__ keb = (u16*)(WS(P) + O_KEB);
  float* dlf = (float*)(WS(P) + O_DLF); float* dlb = (float*)(WS(P) + O_DLB);
  const float* lbt = P.in[28];
  float* totF = (float*)smem;
  float* totB = totF + 1024;
  const int tid = TID(), lane = tid & 63, rg = tid >> 6;
  for (int item = BID(); item < 2048; item += gridDim.x) {
    const int cgi = item >> 3, ch = (item & 7) * 128 + lane * 2;
    const long t0 = (long)cgi * 64 + rg * 8;
    unsigned wq[8], wf[8], wb[8];
#pragma unroll
    for (int i = 0; i < 8; ++i) {
      const u16* row = pj + (t0 + i) * 5120 + ch;
      wq[i] = *(const unsigned*)row; wf[i] = *(const unsigned*)(row + 2048); wb[i] = *(const unsigned*)(row + 3072);
    }
    float lb0[2], lb1[2];
    lb0[0] = lb_of(lbt, 0, ch); lb0[1] = lb_of(lbt, 0, ch + 1);
    lb1[0] = lb_of(lbt, 1, ch); lb1[1] = lb_of(lbt, 1, ch + 1);
    float pf[2][8], sb[2][8], accf[2], accb[2];
#pragma unroll
    for (int c = 0; c < 2; ++c) {
      float a = 0.f;
#pragma unroll
      for (int i = 0; i < 8; ++i) {
        const float x = bf2f((u16)(c ? (wf[i] >> 16) : (wf[i] & 0xffff)));
        a += logf(lb0[c] + (1.f - lb0[c]) * sigm(x)); pf[c][i] = a;
      }
      accf[c] = a;
      a = 0.f;
#pragma unroll
      for (int i = 7; i >= 0; --i) {
        const float x = bf2f((u16)(c ? (wb[i] >> 16) : (wb[i] & 0xffff)));
        a += logf(lb1[c] + (1.f - lb1[c]) * sigm(x)); sb[c][i] = a;
      }
      accb[c] = a;
    }
    __syncthreads();
    *(float2*)(totF + rg * 128 + lane * 2) = make_float2(accf[0], accf[1]);
    *(float2*)(totB + rg * 128 + lane * 2) = make_float2(accb[0], accb[1]);
    __syncthreads();
    float offF[2] = {0.f, 0.f}, offB[2] = {0.f, 0.f}, totf[2] = {0.f, 0.f}, totb[2] = {0.f, 0.f};
#pragma unroll
    for (int g = 0; g < 8; ++g) {
      const float2 f = *(const float2*)(totF + g * 128 + lane * 2), bq = *(const float2*)(totB + g * 128 + lane * 2);
      totf[0] += f.x; totf[1] += f.y; totb[0] += bq.x; totb[1] += bq.y;
      if (g < rg) { offF[0] += f.x; offF[1] += f.y; }
      if (g > rg) { offB[0] += bq.x; offB[1] += bq.y; }
    }
#pragma unroll
    for (int i = 0; i < 8; ++i) {
      float o[6][2];
#pragma unroll
      for (int c = 0; c < 2; ++c) {
        const float xq = bf2f((u16)(c ? (wq[i] >> 16) : (wq[i] & 0xffff)));
        const float xf = bf2f((u16)(c ? (wf[i] >> 16) : (wf[i] & 0xffff)));
        const float xb = bf2f((u16)(c ? (wb[i] >> 16) : (wb[i] & 0xffff)));
        const float q = silu_f(xq);
        const float bf = offF[c] + pf[c][i], bb = offB[c] + sb[c][i];
        const float kf = (1.f - lb0[c]) * sigm(-xf), kb = (1.f - lb1[c]) * sigm(-xb);
        o[0][c] = q * expf(bf); o[1][c] = kf * expf(-bf); o[2][c] = kf * expf(totf[c] - bf);
        o[3][c] = q * expf(bb); o[4][c] = kb * expf(-bb); o[5][c] = kb * expf(totb[c] - bb);
      }
      const long oo = (t0 + i) * 1024 + ch;
      *(unsigned*)(qdf + oo) = pack2(o[0][0], o[0][1]);
      *(unsigned*)(kif + oo) = pack2(o[1][0], o[1][1]);
      *(unsigned*)(kef + oo) = pack2(o[2][0], o[2][1]);
      *(unsigned*)(qdb + oo) = pack2(o[3][0], o[3][1]);
      *(unsigned*)(kib + oo) = pack2(o[4][0], o[4][1]);
      *(unsigned*)(keb + oo) = pack2(o[5][0], o[5][1]);
    }
    if (rg == 0) {
      *(float2*)(dlf + (long)cgi * 1024 + ch) = make_float2(expf(totf[0]), expf(totf[1]));
      *(float2*)(dlb + (long)cgi * 1024 + ch) = make_float2(expf(totb[0]), expf(totb[1]));
    }
  }
  __syncthreads();
}

template <int C>
__device__ __forceinline__ void rec_scores_item(const Params& P, const Rec& R, int cgi, int h) {
  const u16* qdf = (const u16*)(WS(P) + O_QDF); const u16* qdb = (const u16*)(WS(P) + O_QDB);
  const u16* kif = (const u16*)(WS(P) + O_KIF); const u16* kib = (const u16*)(WS(P) + O_KIB);
  u16* sc = (u16*)(WS(P) + O_SC) + ((long)cgi * R.H + h) * C * C;
  const long off = (long)cgi * C * 1024 + h * R.DK;
  f32x4 af[C / 32][C / 64] = {}, ab[C / 32][C / 64] = {};
  gemm_acc<C, C, true, true, true, (C == 128 ? 4 : 2)>(af, qdf + off, 1024, kif + off, 1024, (u16*)smem);
  gemm_acc<C, C, true, true, true, (C == 128 ? 4 : 2)>(ab, qdb + off, 1024, kib + off, 1024, (u16*)smem);
  const int tid = TID(), lane = tid & 63, wid = tid >> 6;
  const int wm = wid >> 2, wn = wid & 3, fr = lane & 15, fq = lane >> 4;
#pragma unroll
  for (int mi = 0; mi < C / 32; ++mi)
#pragma unroll
    for (int ni = 0; ni < C / 64; ++ni) {
      const int r = wm * (C / 2) + mi * 16 + fr, c0 = wn * (C / 4) + ni * 16 + fq * 4;
      float v[4];
#pragma unroll
      for (int j = 0; j < 4; ++j) {
        const int c = c0 + j;
        v[j] = (c <= r ? af[mi][ni][j] : 0.f) + (c >= r ? ab[mi][ni][j] : 0.f);
      }
      *(uint2*)(sc + r * C + c0) = make_uint2(pack2(v[0], v[1]), pack2(v[2], v[3]));
    }
}

template <int C>
__device__ void phase_rec_su(const Params& P, int kind) {
  const Rec R = rec_of(kind);
  constexpr int KTU = C / 64;
  const int nch = SLAB / C;
  const int n_sc = nch * R.H;
  const int mtn = R.DK / 128, ntn = R.DV / 128;
  const int n_u = nch * R.H * 2 * mtn * ntn, G = gridDim.x;
  const u16* pj = (const u16*)(WS(P) + O_PROJ);
  for (int item = BID(); item < n_sc; item += G) rec_scores_item<C>(P, R, item / R.H, item % R.H);
  const u16* kef = (const u16*)(WS(P) + O_KEF); const u16* keb = (const u16*)(WS(P) + O_KEB);
  u16* stfb = (u16*)(WS(P) + O_STF); u16* stbb = (u16*)(WS(P) + O_STB);
  Tiles<KTU> ta, tb;
#define U_DECODE(q_, nt_, mt_, dir_, h_, cgi_) int nt_, mt_, dir_, h_, cgi_; { int qq = (q_); nt_ = qq % ntn; qq /= ntn; mt_ = qq % mtn; qq /= mtn; dir_ = qq & 1; qq >>= 1; h_ = qq % R.H; cgi_ = qq / R.H; }
#define U_ISSUE(T_, nt_, mt_, dir_, h_, cgi_) tiles_issue<128, 128, false, false, KTU>(T_, (dir_ ? keb : kef) + (long)cgi_ * C * 1024 + h_ * R.DK + mt_ * 128, 1024, pj + (long)cgi_ * C * R.ldv + R.voff + h_ * R.DV + nt_ * 128, R.ldv)
#define U_RUN(T_, nt_, mt_, dir_, h_, cgi_) { f32x4 acc[4][2] = {}; gemm_run<128, 128, false, false, false, KTU>(acc, T_, (u16*)smem); \
    u16* st = (dir_ ? stbb : stfb) + (((long)cgi_ * R.H + h_) * R.DV + nt_ * 128) * R.DK + mt_ * 128; const int DK = R.DK; \
    epi_each<128, 128, false>(acc, [&](int r, int c, f32x4 val) { *(uint2*)(st + (long)c * DK + r) = make_uint2(pack2(val[0], val[1]), pack2(val[2], val[3])); }); }
  int q = BID();
  if (q < n_u) { U_DECODE(q, nt, mt, dir, h, cgi); U_ISSUE(ta, nt, mt, dir, h, cgi); }
  for (; q < n_u; q += 2 * G) {
    U_DECODE(q, nt, mt, dir, h, cgi);
    const int q2 = q + G;
    if (q2 < n_u) { U_DECODE(q2, nt2, mt2, dir2, h2, cgi2); U_ISSUE(tb, nt2, mt2, dir2, h2, cgi2); }
    U_RUN(ta, nt, mt, dir, h, cgi);
    const int q3 = q + 2 * G;
    if (q3 < n_u) { U_DECODE(q3, nt3, mt3, dir3, h3, cgi3); U_ISSUE(ta, nt3, mt3, dir3, h3, cgi3); }
    if (q2 < n_u) { U_DECODE(q2, nt2, mt2, dir2, h2, cgi2); U_RUN(tb, nt2, mt2, dir2, h2, cgi2); }
  }
#undef U_DECODE
#undef U_ISSUE
#undef U_RUN
  __syncthreads();
}

__device__ void phase_rec_scan(const Params& P, int kind, int slab, bool dry = false) {
  const Rec R = rec_of(kind);
  const int L = Lof(slab), nseq = SLAB / L, ncs = L / R.C;
  const int qdk = R.DK / 4;
  const long per = (long)R.H * R.DV * qdk;
  const long total = 2 * nseq * per;
  const long gtid = (long)BID() * NT + TID(), gsz = (long)gridDim.x * NT;
  for (long idx = gtid; idx < total; idx += gsz) {
    long q = idx;
    const int pd = (int)(q % qdk); q /= qdk;
    const int e = (int)(q % R.DV); q /= R.DV;
    const int h = (int)(q % R.H); q /= R.H;
    const int seq = (int)(q % nseq);
    const int dir = (int)(q / nseq);
    u16* st = (u16*)(WS(P) + (dir ? O_STB : O_STF));
    u16* stw = dry ? (u16*)(WS(P) + O_OBUF) : st;
    const float* dl = (const float*)(WS(P) + (dir ? O_DLB : O_DLF));
    float s0 = 0.f, s1 = 0.f, s2 = 0.f, s3 = 0.f;
    const long ebase = ((long)h * R.DV + e) * R.DK + pd * 4;
    const long cstride = (long)R.H * R.DV * R.DK;
    const int dbase = h * R.DK + pd * 4;
    for (int i0 = 0; i0 < ncs; i0 += 8) {
      uint2 u[8];
      float4 dd[8];
#pragma unroll
      for (int j = 0; j < 8; ++j) {
        const int n = dir ? (ncs - 1 - i0 - j) : (i0 + j);
        const long cgi = (long)seq * ncs + n;
        u[j] = *(const uint2*)(st + cgi * cstride + ebase);
        dd[j] = *(const float4*)(dl + cgi * 1024 + dbase);
      }
#pragma unroll
      for (int j = 0; j < 8; ++j) {
        const int n = dir ? (ncs - 1 - i0 - j) : (i0 + j);
        const long cgi = (long)seq * ncs + n;
        *(uint2*)(stw + cgi * cstride + ebase) = make_uint2(pack2(s0, s1), pack2(s2, s3));
        s0 = dd[j].x * s0 + bf2f((u16)(u[j].x & 0xffff));
        s1 = dd[j].y * s1 + bf2f((u16)(u[j].x >> 16));
        s2 = dd[j].z * s2 + bf2f((u16)(u[j].y & 0xffff));
        s3 = dd[j].w * s3 + bf2f((u16)(u[j].y >> 16));
      }
    }
  }
}

template <int C>
__device__ void phase_rec_out(const Params& P, int kind) {
  const Rec R = rec_of(kind);
  constexpr int KT1 = C / 64, KT2 = (C == 128 ? 4 : 2);
  const int nch = SLAB / C, ntn = R.DV / 128;
  const u16* pj = (const u16*)(WS(P) + O_PROJ);
  const u16* scb = (const u16*)(WS(P) + O_SC);
  const u16* qdf = (const u16*)(WS(P) + O_QDF); const u16* qdb = (const u16*)(WS(P) + O_QDB);
  const u16* stf = (const u16*)(WS(P) + O_STF); const u16* stb = (const u16*)(WS(P) + O_STB);
  u16* ob = (u16*)(WS(P) + O_OBUF);
  const int HDV = R.H * R.DV;
  const int nitems = nch * R.H * ntn, G = gridDim.x;
  Tiles<KT1> t1; Tiles<KT2> t2; Tiles<KT2> t3;
  int item = BID();
  if (item < nitems) {
    const int nt = item % ntn, h = (item / ntn) % R.H, cgi = item / (ntn * R.H);
    tiles_issue<C, 128, true, false, KT1>(t1, scb + ((long)cgi * R.H + h) * C * C, C, pj + (long)cgi * C * R.ldv + R.voff + h * R.DV + nt * 128, R.ldv);
  }
  for (; item < nitems; item += G) {
    const int nt = item % ntn, h = (item / ntn) % R.H, cgi = item / (ntn * R.H);
    const long qoff = (long)cgi * C * 1024 + h * R.DK;
    const long soff = (((long)cgi * R.H + h) * R.DV + nt * 128) * R.DK;
    f32x4 acc[C / 32][2] = {};
    tiles_issue<C, 128, true, true, KT2>(t2, qdf + qoff, 1024, stf + soff, R.DK);
    gemm_run<C, 128, true, false, true, KT1>(acc, t1, (u16*)smem);
    tiles_issue<C, 128, true, true, KT2>(t3, qdb + qoff, 1024, stb + soff, R.DK);
    gemm_run<C, 128, true, true, true, KT2>(acc, t2, (u16*)smem);
    const int nx = item + G;
    if (nx < nitems) {
      const int nt2 = nx % ntn, h2 = (nx / ntn) % R.H, cg2 = nx / (ntn * R.H);
      tiles_issue<C, 128, true, false, KT1>(t1, scb + ((long)cg2 * R.H + h2) * C * C, C, pj + (long)cg2 * C * R.ldv + R.voff + h2 * R.DV + nt2 * 128, R.ldv);
    }
    gemm_run<C, 128, true, true, true, KT2>(acc, t3, (u16*)smem);
    u16* o = ob + (long)cgi * C * HDV + h * R.DV + nt * 128;
    epi_each<C, 128, true>(acc, [&](int r, int c, f32x4 val) { *(uint2*)(o + (long)r * HDV + c) = make_uint2(pack2(val[0], val[1]), pack2(val[2], val[3])); });
  }
  __syncthreads();
}

template <int KIND>
__device__ void phase_rec_ng_t(const Params& P) {
  const Rec R = rec_of(KIND);
  constexpr int DV = (KIND == 1) ? 512 : 128, H = (KIND == 1) ? 4 : 8, PER = DV / 64, HDV = H * DV;
  const u16* __restrict__ ob = (const u16*)(WS(P) + O_OBUF);
  const u16* __restrict__ pj = (const u16*)(WS(P) + O_PROJ);
  u16* __restrict__ a2 = (u16*)(WS(P) + O_A2);
  const float* gain = P.in[29];
  const int tid = TID(), lane = tid & 63, wid = tid >> 6;
  constexpr int nrows = SLAB * H;
  for (int item = BID(); item < nrows / 32; item += gridDim.x) {
    float v[4][PER];
    float ss[4];
#pragma unroll
    for (int u = 0; u < 4; ++u) {
      const int rh = item * 32 + wid * 4 + u;
      const int t = rh / H, h = rh % H;
      const u16* o = ob + (long)t * HDV + h * DV + lane * PER;
      if (PER == 8) {
        float f8[8];
        unpack8(*(const uint4*)o, f8);
#pragma unroll
        for (int i = 0; i < 8; ++i) v[u][i % PER] = f8[i];
      } else {
        const unsigned w = *(const unsigned*)o;
        v[u][0] = bf2f((u16)(w & 0xffff)); v[u][1 % PER] = bf2f((u16)(w >> 16));
      }
      float a = 0.f;
#pragma unroll
      for (int i = 0; i < PER; ++i) a += v[u][i] * v[u][i];
      ss[u] = a;
    }
#pragma unroll
    for (int u = 0; u < 4; ++u) ss[u] = wave_sum(ss[u]);
#pragma unroll
    for (int u = 0; u < 4; ++u) {
      const int rh = item * 32 + wid * 4 + u;
      const int t = rh / H, h = rh % H;
      const float rstd = rsqrtf(ss[u] / (float)DV + 1e-6f);
      const u16* g = pj + (long)t * R.ldv + R.goff + h * DV + lane * PER;
      u16* out = a2 + (long)t * HDV + h * DV + lane * PER;
      float y[PER];
#pragma unroll
      for (int i = 0; i < PER; ++i) {
        y[i] = v[u][i] * rstd;
        if (KIND == 3) y[i] *= gain[lane * PER + i];
      }
      if (PER == 8) {
        const uint4 gw = *(const uint4*)g;
        float gf[8];
        unpack8(gw, gf);
        float r8[8];
#pragma unroll
        for (int i = 0; i < 8; ++i) r8[i] = y[i % PER] * silu_f(gf[i]);
        *(uint4*)out = pack8s(r8, 1.f);
      } else {
        const unsigned gw = *(const unsigned*)g;
        *(unsigned*)out = pack2(y[0] * silu_f(bf2f((u16)(gw & 0xffff))), y[1 % PER] * silu_f(bf2f((u16)(gw >> 16))));
      }
    }
  }
}
__device__ void phase_rec_ng(const Params& P, int kind) {
  if (kind == 1) phase_rec_ng_t<1>(P); else phase_rec_ng_t<3>(P);
}

__device__ void phase_swa_prep(const Params& P, int slab) {
  const int L = Lof(slab);
  const u16* pj = (const u16*)(WS(P) + O_PROJ);
  u16* qn = (u16*)(WS(P) + O_QN);
  u16* kn = (u16*)(WS(P) + O_KN);
  const float2* rope = (const float2*)(WS(P) + O_ROPES);
  const long gtid = (long)BID() * NT + TID(), gsz = (long)gridDim.x * NT;
  for (long idx = gtid; idx < (long)SLAB * 640; idx += gsz) {
    const int d = (int)(idx & 31);
    const int hd = (int)((idx >> 5) % 20);
    const int t = (int)(idx / 640);
    const int col = hd < 16 ? hd * 64 : 1024 + (hd - 16) * 64;
    const float x1 = bf2f(pj[(long)t * 1536 + col + d]), x2 = bf2f(pj[(long)t * 1536 + col + d + 32]);
    float ss = x1 * x1 + x2 * x2;
#pragma unroll
    for (int o = 16; o; o >>= 1) ss += __shfl_xor(ss, o);
    const float rstd = rsqrtf(ss * (1.f / 64.f) + 1e-6f);
    const float* gn = hd < 16 ? P.in[23] : P.in[24];
    const float y1 = x1 * rstd * gn[d], y2 = x2 * rstd * gn[d + 32];
    const float2 cs = rope[(long)(t & (L - 1)) * 32 + d];
    float o1 = y1 * cs.x - y2 * cs.y, o2 = y1 * cs.y + y2 * cs.x;
    if (hd < 16) {
      qn[(long)t * 1024 + hd * 64 + d] = f2bf(o1 * 0.125f);
      qn[(long)t * 1024 + hd * 64 + d + 32] = f2bf(o2 * 0.125f);
    } else {
      kn[(long)t * 256 + (hd - 16) * 64 + d] = f2bf(o1);
      kn[(long)t * 256 + (hd - 16) * 64 + d + 32] = f2bf(o2);
    }
  }
}

constexpr int SLD = 324;
__device__ void phase_swa_att(const Params& P, int slab) {
  const int L = Lof(slab), nqb = L / 64;
  const u16* qn = (const u16*)(WS(P) + O_QN);
  const u16* kn = (const u16*)(WS(P) + O_KN);
  const u16* pj = (const u16*)(WS(P) + O_PROJ);
  u16* a2 = (u16*)(WS(P) + O_A2);
  const float* sink = P.in[25];
  float* S = (float*)(smem + 40960);
  u16* Bs = (u16*)smem + 9216;
  const int tid = TID(), lane = tid & 63, wid = tid >> 6;
  const int wm = wid >> 2, wn = wid & 3, fr = lane & 15, fq = lane >> 4;
  const int nitems = (SLAB / 64) * 16;
  for (int item = BID(); item < nitems; item += gridDim.x) {
    const int hq = item & 15, qbg = item >> 4;
    const int seq = qbg / nqb, qb = qbg % nqb;
    const int q0 = qb * 64;
    const long tok0 = (long)seq * L;
    const int hkv = hq >> 2;
    uint4 vt[5];
#pragma unroll
    for (int kt = 0; kt < 5; ++kt) {
      const int kp0 = q0 - 128 + kt * 64;
      vt[kt] = make_uint4(0, 0, 0, 0);
      if (kp0 >= 0 && kp0 < L) vt[kt] = ld_chunk<64, false>(pj + (tok0 + kp0) * 1536 + 1280 + hkv * 64, 1536, 0, tid);
    }
    for (int kt = 0; kt < 5; ++kt) {
      const int kp0 = q0 - 128 + kt * 64;
      if (kp0 >= 0 && kp0 < L) {
        f32x4 acc[2][1] = {};
        gemm_acc<64, 64, true, true, true, 1>(acc, qn + (tok0 + q0) * 1024 + hq * 64, 1024, kn + (tok0 + kp0) * 256 + hkv * 64, 256, (u16*)smem);
        epi_each<64, 64, true>(acc, [&](int r, int c, f32x4 v) {
          f32x4 o;
#pragma unroll
          for (int j = 0; j < 4; ++j) {
            const int dlt = (q0 + r) - (kp0 + c + j);
            o[j] = (dlt <= 128 && dlt >= -128) ? v[j] : -1e30f;
          }
          *(f32x4*)(S + r * SLD + kt * 64 + c) = o;
        });
      } else {
        for (int i = tid; i < 4096; i += NT) S[(i >> 6) * SLD + kt * 64 + (i & 63)] = -1e30f;
      }
    }
    __syncthreads();
    {
      const int r = tid >> 3, sub = tid & 7;
      const float sk = sink[hq];
      float e[40];
      float m = sk;
#pragma unroll
      for (int i = 0; i < 40; ++i) { e[i] = S[r * SLD + sub + 8 * i]; m = fmaxf(m, e[i]); }
      m = fmaxf(m, __shfl_xor(m, 1)); m = fmaxf(m, __shfl_xor(m, 2)); m = fmaxf(m, __shfl_xor(m, 4));
      float den = 0.f;
#pragma unroll
      for (int i = 0; i < 40; ++i) { e[i] = __expf(e[i] - m); den += e[i]; }
      den += __shfl_xor(den, 1); den += __shfl_xor(den, 2); den += __shfl_xor(den, 4);
      den += __expf(sk - m);
      const float inv = 1.f / den;
      u16* prow = (u16*)(S + r * SLD);
#pragma unroll
      for (int i = 0; i < 40; ++i) prow[sub + 8 * i] = f2bf(e[i] * inv);
    }
    __syncthreads();
    f32x4 acc[2][1] = {};
#pragma unroll
    for (int kt = 0; kt < 5; ++kt) {
      const int kp0 = q0 - 128 + kt * 64;
      if (kp0 >= 0 && kp0 < L) {
        __syncthreads();
        st_chunk<64, false>(Bs, vt[kt], tid);
        __syncthreads();
#pragma unroll
        for (int ks = 0; ks < 2; ++ks) {
          bf16x8 af[2];
#pragma unroll
          for (int mi = 0; mi < 2; ++mi) af[mi] = *(const bf16x8*)((const u16*)(S + (wm * 32 + mi * 16 + fr) * SLD) + kt * 64 + ks * 32 + fq * 8);
          const bf16x8 bfr = ld_frag<64, false>(Bs, wn * 16, ks, fr, fq);
#pragma unroll
          for (int mi = 0; mi < 2; ++mi) acc[mi][0] = __builtin_amdgcn_mfma_f32_16x16x32_bf16(bfr, af[mi], acc[mi][0], 0, 0, 0);
        }
      }
    }
    u16* o = a2 + (tok0 + q0) * 1024 + hq * 64;
    epi_each<64, 64, true>(acc, [&](int r, int c, f32x4 v) { *(uint2*)(o + (long)r * 1024 + c) = make_uint2(pack2(v[0], v[1]), pack2(v[2], v[3])); });
    __syncthreads();
  }
}

#define XB_TMO      128
#define XB_XCNT(j)  (256  + 64 * (j))
#define XB_XSUB(j)  (1280 + 64 * (j))
#define XB_XGEN(j)  (2304 + 64 * (j))
#define XB_TOP      3328
#define XB_TOPGEN   3392
#define XCD_BAR_WORDS 3456
#define XB_SPIN_CAP (1u << 18)
__device__ __forceinline__ unsigned xb_ld(unsigned* p)              { return __hip_atomic_load(p, __ATOMIC_RELAXED, __HIP_MEMORY_SCOPE_AGENT); }
__device__ __forceinline__ unsigned xb_add(unsigned* p, unsigned v) { return __hip_atomic_fetch_add(p, v, __ATOMIC_RELAXED, __HIP_MEMORY_SCOPE_AGENT); }
__device__ __forceinline__ unsigned xb_xcc_id() { return (unsigned)__builtin_amdgcn_s_getreg((3 << 11) | 20) & 0xFu; }
#define XB_SPIN(cond, bar) do { unsigned _sp = 0; while (cond) { __builtin_amdgcn_s_sleep(1); \
    if ((++_sp & 255u) == 0u) { if (xb_ld(&(bar)[XB_TMO])) break; if (_sp > XB_SPIN_CAP) { atomicAdd(&(bar)[XB_TMO], 1u); break; } } } } while (0)
struct XcdBarrier { unsigned* bar; unsigned x; volatile LDS_AS unsigned* st; };
__device__ __forceinline__ XcdBarrier xcd_barrier_post(unsigned* bar, volatile LDS_AS unsigned* st) {
    XcdBarrier b; b.bar = bar; b.x = xb_xcc_id(); b.st = st;
    if (threadIdx.x == 0) (void)xb_add(&bar[XB_XCNT(b.x)], 1u);
    return b;
}
__device__ __forceinline__ void xcd_barrier_complete(unsigned* bar, unsigned x, unsigned& nloc, unsigned& nx) {
    const unsigned G = gridDim.x * gridDim.y * gridDim.z;
    unsigned sum, cnt, mine, sp = 0u;
    for (;;) {
        sum = 0u; cnt = 0u; mine = 0u;
#pragma unroll
        for (unsigned j = 0; j < 16; ++j) { const unsigned c = xb_ld(&bar[XB_XCNT(j)]); sum += c; cnt += (c > 0u) ? 1u : 0u; mine = (j == x) ? c : mine; }
        if (sum == G) break;
        __builtin_amdgcn_s_sleep(1);
        if ((++sp & 255u) == 0u) { if (xb_ld(&bar[XB_TMO])) break; if (sp > XB_SPIN_CAP) { atomicAdd(&bar[XB_TMO], 1u); break; } }
    }
    nloc = mine > 0u ? mine : 1u; nx = cnt > 0u ? cnt : 1u;
}
__device__ __forceinline__ void xcd_barrier(const XcdBarrier& b) {
    asm volatile("s_waitcnt vmcnt(0)" ::: "memory");
    __syncthreads();
    if (threadIdx.x == 0) {
        unsigned* bar = b.bar;
        __builtin_amdgcn_s_waitcnt(0);
        unsigned nloc = b.st[0], nx = b.st[1];
        if (nloc == 0u) { xcd_barrier_complete(bar, b.x, nloc, nx); b.st[0] = nloc; b.st[1] = nx; }
        const unsigned old = xb_add(&bar[XB_XSUB(b.x)], 1u);
        const unsigned gen = old / nloc;
        if (old + 1u == (gen + 1u) * nloc) {
            __builtin_amdgcn_fence(__ATOMIC_RELEASE, "agent");
            asm volatile("s_waitcnt vmcnt(0)" ::: "memory");
            const unsigned og = xb_add(&bar[XB_TOP], 1u);
            const unsigned tg = og / nx;
            if (og + 1u == (tg + 1u) * nx) xb_add(&bar[XB_TOPGEN], 1u);
            else XB_SPIN(xb_ld(&bar[XB_TOPGEN]) == tg, bar);
            __builtin_amdgcn_fence(__ATOMIC_ACQUIRE, "agent");
            xb_add(&bar[XB_XGEN(b.x)], 1u);
            asm volatile("s_waitcnt vmcnt(0)" ::: "memory");
        } else {
            XB_SPIN(xb_ld(&bar[XB_XGEN(b.x)]) == gen, bar);
            __builtin_amdgcn_fence(__ATOMIC_ACQUIRE, "agent");
            asm volatile("s_waitcnt vmcnt(0)" ::: "memory");
        }
    }
    __syncthreads();
}

__device__ __forceinline__ int nmix_of(int kind) { return (kind & 1) ? 8 : (kind == 2 ? 5 : 6); }

__device__ void ffn_step(const Params& P, int layer, int f) {
  if (f == 6) { phase_ffn_down(P, layer); return; }
  const int fs = f / 3, st = f % 3;
  if (st == 0) { REP(4) phase_norm(P, layer, fs, 1); }
  else if (st == 1) { REP(0) phase_ffn_gate(P, layer); }
  else { REP(0) phase_ffn_val(P, layer, fs); }
}
__device__ void layer_step(const Params& P, int layer, int slab, int step) {
  const int kind = layer;
  if (step == 0) { REP(4) phase_norm(P, layer, slab, 0); return; }
  if (kind == 0) {
    if (step == 1) { REP(0) phase_proj(P, O_WHYIN, 3072); }
    else if (step == 2) { REP(3) phase_hy_conv(P, slab); }
    else if (step == 3) { if ((PROBE_MASK >> 7) & 1) phase_hy_fft(P, slab, true); phase_hy_fft(P, slab); }
    else if (step == 4) { REP(3) phase_hy_tr(P, slab); }
    else phase_resid(P, layer, slab, (const u16*)(WS(P) + O_A2), 1024, O_WHYOUT, 2 * D);
  } else if (kind == 1) {
    if (step == 1) { REP(0) phase_proj(P, O_WRETIN, 6144); }
    else if (step == 2) { REP(1) REP(9) phase_ret_prep(P, slab); }
    else if (step == 3) { REP(1) REP(11) phase_rec_su<128>(P, 1); }
    else if (step == 4) { if ((PROBE_MASK >> 6) & 1) phase_rec_scan(P, 1, slab, true); phase_rec_scan(P, 1, slab); }
    else if (step == 5) { REP(1) REP(12) phase_rec_out<128>(P, 1); }
    else if (step == 6) { REP(1) REP(9) phase_rec_ng(P, 1); }
    else phase_resid(P, layer, slab, (const u16*)(WS(P) + O_A2), 2048, O_WRETOUT, 2 * D);
  } else if (kind == 2) {
    if (step == 1) { REP(0) phase_proj(P, O_WSWAIN, 1536); }
    else if (step == 2) { REP(2) REP(14) phase_swa_prep(P, slab); }
    else if (step == 3) { REP(2) REP(15) phase_swa_att(P, slab); }
    else phase_resid(P, layer, slab, (const u16*)(WS(P) + O_A2), 1024, O_WSWAOUT, 2 * D);
  } else {
    if (step == 1) { REP(0) phase_proj(P, O_WHGIN, 5120); }
    else if (step == 2) { REP(1) REP(9) phase_hg_prep(P); }
    else if (step == 3) { REP(1) REP(11) phase_rec_su<64>(P, 3); }
    else if (step == 4) { if ((PROBE_MASK >> 6) & 1) phase_rec_scan(P, 3, slab, true); phase_rec_scan(P, 3, slab); }
    else if (step == 5) { REP(1) REP(12) phase_rec_out<64>(P, 3); }
    else if (step == 6) { REP(1) REP(9) phase_rec_ng(P, 3); }
    else phase_resid(P, layer, slab, (const u16*)(WS(P) + O_A2), 1024, O_WHGOUT, 2 * D);
  }
}

__global__ void __launch_bounds__(NT) fwd_megakernel(Params P) {
  cg::grid_group grid = cg::this_grid();
  __shared__ uint4 xb_words;
  if (threadIdx.x == 0) xb_words = make_uint4(0u, 0u, 0u, 0u);
  __syncthreads();
  XcdBarrier xb = xcd_barrier_post((unsigned*)(P.ws + O_BAR), (volatile LDS_AS unsigned*)&xb_words);
  for (int pid = P.p0; pid < P.p1; ++pid) {
    if (pid == 0) { REP(5) phase_pre0(P); }
    else if (pid == 1) { REP(5) phase_pre1(P); }
    else {
      int q = pid - 2, layer = 0;
      while (q >= 5 * nmix_of(layer) + 7) { q -= 5 * nmix_of(layer) + 7; ++layer; }
      const int nm = nmix_of(layer);
      if (q < 5 * nm) layer_step(P, layer, q / nm, q % nm);
      else ffn_step(P, layer, q - 5 * nm);
    }
    if (pid + 1 < P.p1) {
      if (pid == 0) grid.sync();
      else xcd_barrier(xb);
      if ((PROBE_MASK >> 8) & 1) xcd_barrier(xb);
    }
  }
}

extern "C" void kernel_launch(void* const* d_in, const int* in_sizes, int n_in, void* d_out, int out_size, void* d_ws,
                              size_t ws_size, hipStream_t stream) {
  static int grid_blocks = 0;
  if (!grid_blocks) {
    int dev = 0, cus = 0, per_cu = 0;
    (void)hipGetDevice(&dev);
    (void)hipDeviceGetAttribute(&cus, hipDeviceAttributeMultiprocessorCount, dev);
    (void)hipFuncSetAttribute((const void*)fwd_megakernel, hipFuncAttributeMaxDynamicSharedMemorySize, LDSB);
    (void)hipOccupancyMaxActiveBlocksPerMultiprocessor(&per_cu, (const void*)fwd_megakernel, NT, LDSB);
    if (per_cu < 1) per_cu = 1;
    if (per_cu > 1) per_cu = 1;
    grid_blocks = cus * per_cu;
    if (ws_size < WS_END) fprintf(stderr, "kernel_launch: workspace too small: %zu < %zu\n", ws_size, (size_t)WS_END);
  }
  Params p;
  memset(&p, 0, sizeof(p));
  for (int i = 0; i < 36; ++i) p.in[i] = (const float*)d_in[i];
  p.out = (float*)d_out;
  p.ws = (unsigned char*)d_ws;
  (void)hipMemsetAsync((unsigned char*)d_ws + O_BAR, 0, XCD_BAR_WORDS * 4, stream);
#if ONE_LAUNCH
  p.p0 = 0; p.p1 = NPHASES;
  void* args[] = {&p};
  hipError_t e = hipLaunchCooperativeKernel((const void*)fwd_megakernel, dim3(grid_blocks), dim3(NT), args, LDSB, stream);
  if (e != hipSuccess) fprintf(stderr, "cooperative launch failed: %s (grid %d)\n", hipGetErrorString(e), grid_blocks);
#else
  for (int ph = 0; ph < NPHASES; ++ph) {
    p.p0 = ph; p.p1 = ph + 1;
    hipLaunchKernelGGL(fwd_megakernel, dim3(grid_blocks), dim3(NT), LDSB, stream, p);
  }
#endif
}
```

```cpp
#include <hip/hip_runtime.h>
#include <hip/hip_cooperative_groups.h>
#include <cstdio>
#include <cstdint>
#include <cstring>
namespace cg = cooperative_groups;

typedef unsigned short u16;
typedef __attribute__((ext_vector_type(8))) short bf16x8;
typedef __attribute__((ext_vector_type(4))) float f32x4;

#define NT 512
#ifndef ONE_LAUNCH
#define ONE_LAUNCH 1
#endif
#ifndef PROBE_MASK
#define PROBE_MASK 0
#endif
#define REP(cls) for (int rep_##cls = 0; rep_##cls < (((PROBE_MASK >> (cls)) & 1) ? 2 : 1); ++rep_##cls)

constexpr int D = 1024, SLAB = 16384, DFF = 2816;
constexpr int LDSB = 139264;
constexpr int FSLAB = 40960, NTOK = 81920;
constexpr int NPHASES = 2 + 5 * (6 + 8 + 5 + 8) + 4 * 7;

constexpr size_t SZW(size_t n, size_t k) { return n * k * 2; }
constexpr size_t O_WHYIN = 0;
constexpr size_t O_WHYOUT = O_WHYIN + SZW(3072, 1024);
constexpr size_t O_WRETIN = O_WHYOUT + SZW(1024, 1024);
constexpr size_t O_WRETOUT = O_WRETIN + SZW(6144, 1024);
constexpr size_t O_WSWAIN = O_WRETOUT + SZW(1024, 2048);
constexpr size_t O_WSWAOUT = O_WSWAIN + SZW(1536, 1024);
constexpr size_t O_WHGIN = O_WSWAOUT + SZW(1024, 1024);
constexpr size_t O_WHGOUT = O_WHGIN + SZW(5120, 1024);
constexpr size_t O_WFG = O_WHGOUT + SZW(1024, 1024);
constexpr size_t O_WFV = O_WFG + 4 * SZW(2816, 1024);
constexpr size_t O_WFD = O_WFV + 4 * SZW(2816, 1024);
constexpr size_t O_MOD = O_WFD + 4 * SZW(1024, 2816);
constexpr size_t O_TW = O_MOD + (size_t)4 * 16 * 6144 * 4;
constexpr size_t O_HIDS = O_TW + 8192 * 8;
constexpr size_t O_HIDP = O_HIDS + (size_t)8192 * 64 * 4;
constexpr size_t O_ROPER = O_HIDP + (size_t)2048 * 64 * 4;
constexpr size_t O_ROPES = O_ROPER + (size_t)8192 * 128 * 8;
constexpr size_t O_PROJ = O_ROPES + (size_t)8192 * 32 * 8;
constexpr size_t O_HBUF = O_PROJ + (size_t)SLAB * 6144 * 2;
constexpr size_t O_A2 = O_HBUF + (size_t)SLAB * 1024 * 2;
constexpr size_t O_C = O_A2 + (size_t)SLAB * 2048 * 2;
constexpr size_t O_FHBUF = O_PROJ;
constexpr size_t O_FGBUF = O_FHBUF + (size_t)FSLAB * 1024 * 2;
constexpr size_t O_FACT = O_FGBUF + (size_t)FSLAB * DFF * 2;
constexpr size_t END_F = O_FACT + (size_t)NTOK * DFF * 2;
constexpr size_t O_MODP = O_C;
constexpr size_t O_BAR = ((size_t)1 << 30) - 16384;
constexpr size_t O_HSPS = O_BAR - (size_t)1024 * 16384 * 8 - (size_t)1024 * 4096 * 8;
constexpr size_t O_HSPP = O_HSPS + (size_t)1024 * 16384 * 8;
constexpr size_t O_UT = O_C;
constexpr size_t O_X0C = O_UT + (size_t)SLAB * 1024 * 4;
constexpr size_t END_HY = O_X0C + (size_t)SLAB * 1024 * 2;
static_assert(END_F <= O_HSPS && END_HY <= O_HSPS, "layer-0 buffers overlap the filter spectra");
constexpr size_t SZP = (size_t)SLAB * 1024 * 2;
constexpr size_t O_QDF = O_C, O_QDB = O_QDF + SZP, O_KIF = O_QDB + SZP, O_KIB = O_KIF + SZP, O_KEF = O_KIB + SZP, O_KEB = O_KEF + SZP;
constexpr size_t O_DLF = O_KEB + SZP;
constexpr size_t O_DLB = O_DLF + (size_t)256 * 1024 * 4;
constexpr size_t O_SC = O_DLB + (size_t)256 * 1024 * 4;
constexpr size_t O_STF = O_SC + (size_t)SLAB * 1024 * 2;
constexpr size_t O_STB = O_STF + (size_t)134217728;
constexpr size_t O_OBUF = O_STB + (size_t)134217728;
constexpr size_t END_REC = O_OBUF + (size_t)SLAB * 2048 * 4;
constexpr size_t O_QN = O_C;
constexpr size_t O_KN = O_QN + SZP;
constexpr size_t O_PBUF = O_KN + (size_t)SLAB * 256 * 2;
constexpr size_t END_SWA = O_PBUF + (size_t)SLAB * 16 * 320 * 2;
constexpr size_t WS_END = END_REC > END_HY ? (END_REC > END_SWA ? END_REC : END_SWA) : (END_HY > END_SWA ? END_HY : END_SWA);
static_assert(WS_END <= O_BAR, "workspace exceeds 1 GiB");

struct Params {
  const float* in[36];
  float* out;
  unsigned char* ws;
  int p0, p1;
};

extern __shared__ __attribute__((aligned(16))) unsigned char smem[];

__device__ __forceinline__ int TID() { int t = threadIdx.x; asm volatile("" : "+v"(t)); return t; }
__device__ __forceinline__ int BID() { int b = blockIdx.x; asm volatile("" : "+s"(b)); return b; }
__device__ __forceinline__ long ZOFF() { long z = 0; asm volatile("" : "+s"(z)); return z; }
__device__ __forceinline__ unsigned char* WS(const Params& P) { return P.ws + ZOFF(); }
__device__ __forceinline__ float* OUTP(const Params& P) { return P.out + ZOFF(); }

namespace pg8 {
#define PG8_LAS __attribute__((address_space(3)))
typedef unsigned short bf16_t;
typedef short bf16x8 __attribute__((ext_vector_type(8)));
typedef float f32x4 __attribute__((ext_vector_type(4)));
typedef unsigned u32x4 __attribute__((ext_vector_type(4)));
constexpr int BM = 256, BK = 64, HALF = 128, HTB = HALF * BK * 2  , STAGE_BYTES = 8 * HTB, NXCD = 8, WGM = 8;

__host__ __device__ __forceinline__ int lds_byte(int r, int c) { const int st = (r >> 4) * 2 + (c >> 5), rr = r & 15, cc = c & 31, ob = rr * 64 + cc * 2; return st * 1024 + (ob ^ (((ob >> 9) & 1) << 5)); }
__host__ __device__ __forceinline__ void stage_rc(int b, int& R, int& C) { const int st = b / 1024, sb = b % 1024, swz = sb ^ (((sb >> 9) & 1) << 5); R = (st >> 1) * 16 + swz / 64; C = (st & 1) * 32 + (swz % 64) / 2; }
__host__ __device__ __forceinline__ int perm32(int rho) { const int n = rho >> 4, i = rho & 15; return 8 * (i >> 2) + 4 * n + (i & 3); }

struct Unit { int pm, pn; };
struct Gemm { const bf16_t* A; const bf16_t* Bt; int M, N, K; };

struct StaticOrder {
    int nM, nN, nwg, G, c;
    __host__ __device__ void init(int M, int N, int G_, int c_) { nM = M / BM; nN = N / BM; nwg = nM * nN; G = G_; c = c_; }
    __host__ __device__ bool next(int i, Unit& u) const {
        const long L = (long)i * G + c; if (L >= nwg) return false;
        int wgid = (int)L; { const int q = nwg / NXCD, r = nwg % NXCD, xcd = wgid % NXCD, off = wgid / NXCD; wgid = (xcd < r ? xcd * (q + 1) : r * (q + 1) + (xcd - r) * q) + off; }
        const int nig = WGM * nN, gid = wgid / nig, fm = gid * WGM, gsz = (nM - fm) < WGM ? (nM - fm) : WGM;
        u.pm = fm + ((wgid % nig) % gsz); u.pn = (wgid % nig) / gsz; return true;
    }
    __device__ __forceinline__ void a_ready(const Unit&) const {}
    __device__ __forceinline__ void done(const Unit&) const {}
};

template <class Epi, class Sched, bool STAMP = false>
__device__ __forceinline__ void gemm_phase(PG8_LAS unsigned char* lds, const Gemm g, const Sched& S, const Epi& E, unsigned long long* stamps) {
    const int tid = TID(), wid = __builtin_amdgcn_readfirstlane(tid >> 6), lane = tid & 63, wr = wid >> 2, wc = wid & 3, fr = lane & 15, fq = lane >> 4;
    const int K = g.K, nt = K / BK;
    int ts_lo = 0, ts_hi = 0, nts = 0; const unsigned long long rt_entry = STAMP ? (unsigned long long)wall_clock64() : 0ull;
#define PG8_STAMP() do { if (STAMP && wid == 0 && nts < 64) { const unsigned long long _c = (unsigned long long)clock64(); \
        ts_lo = (lane == nts) ? (int)(unsigned)_c : ts_lo; ts_hi = (lane == nts) ? (int)(unsigned)(_c >> 32) : ts_hi; ++nts; } } while (0)
    PG8_STAMP();
    unsigned voffA[2], voffB[2];
#pragma unroll
    for (int i = 0; i < 2; ++i) { int R, C; stage_rc(tid * 16 + i * 8192, R, C); const int Rb = Epi::PERM ? ((R & ~31) + perm32(R & 31)) : R;
        voffA[i] = (unsigned)(R * K + C) * 2u; voffB[i] = (unsigned)(Rb * K + C) * 2u; }
    const size_t kstep = (size_t)(BK * 2);
    const size_t hstep = (size_t)HALF * K * 2;
    const size_t tstep = 2 * hstep;
    const unsigned ldsw = (unsigned)wid * 1024u;
    const int aoff = lds_byte(wr * 64 + fr, fq * 8), boff = lds_byte(wc * 32 + fr, fq * 8);
#define PG8_SA(b, h) (((b) * 2 + (h)) * HTB)
#define PG8_SB(b, h) ((4 + (b) * 2 + (h)) * HTB)
#define PG8_STAGE(bufoff, gbase, voff) do { _Pragma("unroll") for (int _i = 0; _i < 2; ++_i) \
        __builtin_amdgcn_global_load_lds((const unsigned*)((const char*)(gbase) + (voff)[_i]), (PG8_LAS unsigned*)(lds + (bufoff) + ldsw + _i * 8192), 16, 0, 0); } while (0)
#define PG8_LDA(dst, b, h) do { _Pragma("unroll") for (int m = 0; m < 4; ++m) _Pragma("unroll") for (int k = 0; k < 2; ++k) dst[m][k] = *(const PG8_LAS bf16x8*)(lds + PG8_SA(b, h) + aoff + m * 2048 + k * 1024); } while (0)
#define PG8_LDB(dst, b, h) do { _Pragma("unroll") for (int n = 0; n < 2; ++n) _Pragma("unroll") for (int k = 0; k < 2; ++k) dst[n][k] = *(const PG8_LAS bf16x8*)(lds + PG8_SB(b, h) + boff + n * 2048 + k * 1024); } while (0)
#define PG8_MMA(ai, bj, At, Bt) do { __builtin_amdgcn_s_setprio(1); _Pragma("unroll") for (int m = 0; m < 4; ++m) _Pragma("unroll") for (int n = 0; n < 2; ++n) _Pragma("unroll") for (int k = 0; k < 2; ++k) \
        acc[ai][bj][m][n] = __builtin_amdgcn_mfma_f32_16x16x32_bf16(Bt[n][k], At[m][k], acc[ai][bj][m][n], 0, 0, 0); __builtin_amdgcn_s_setprio(0); } while (0)
#define PG8_WAIT_V(n) asm volatile("s_waitcnt vmcnt(" #n ")" ::: "memory")
#define PG8_WAIT_L(n) asm volatile("s_waitcnt lgkmcnt(" #n ")" ::: "memory")
#define PG8_BAR __builtin_amdgcn_s_barrier()
#define PG8_SCHED __builtin_amdgcn_sched_barrier(0)
    Unit cur, nxt; int ui = 0;
    if (!S.next(0, cur)) return;
    f32x4 acc[2][2][4][2];
#pragma unroll
    for (int a = 0; a < 2; ++a)
#pragma unroll
        for (int b = 0; b < 2; ++b)
#pragma unroll
            for (int m = 0; m < 4; ++m)
#pragma unroll
                for (int n = 0; n < 2; ++n) acc[a][b][m][n] = (f32x4){0.f, 0.f, 0.f, 0.f};
    bf16x8 At[4][2], B0[2][2], B1[2][2];
    const char* cA = (const char*)g.A + (size_t)cur.pm * tstep; const char* cB = (const char*)g.Bt + (size_t)cur.pn * tstep;
    S.a_ready(cur);
    PG8_STAGE(PG8_SB(0, 0), cB, voffB); PG8_STAGE(PG8_SA(0, 0), cA, voffA); PG8_STAGE(PG8_SB(0, 1), cB + hstep, voffB); PG8_STAGE(PG8_SA(0, 1), cA + hstep, voffA);
    if (wr == 1) PG8_BAR;
    PG8_WAIT_V(4); PG8_BAR;
    PG8_STAGE(PG8_SB(1, 0), cB + kstep, voffB); PG8_STAGE(PG8_SA(1, 0), cA + kstep, voffA); PG8_STAGE(PG8_SB(1, 1), cB + hstep + kstep, voffB);
    PG8_WAIT_V(6); PG8_BAR;
    PG8_STAMP();
    for (;;) {
        const bool has_next = S.next(ui + 1, nxt);
        const char* nA = has_next ? (const char*)g.A + (size_t)nxt.pm * tstep : cA; const char* nB = has_next ? (const char*)g.Bt + (size_t)nxt.pn * tstep : cB;
        for (int t = 0; t < nt; t += 2) {
            const bool last = (t == nt - 2);
            const char* a1 = cA + (size_t)(t + 1) * kstep;
            const char* a2 = last ? nA : cA + (size_t)(t + 2) * kstep; const char* b2 = last ? nB : cB + (size_t)(t + 2) * kstep;
            const char* a3 = a2 + kstep; const char* b3 = b2 + kstep;
            if (last && has_next) S.a_ready(nxt);
            PG8_LDB(B0, 0, 0); PG8_SCHED; PG8_LDA(At, 0, 0); PG8_STAGE(PG8_SA(1, 1), a1 + hstep, voffA);
            PG8_WAIT_L(8); PG8_BAR; PG8_WAIT_L(0); PG8_MMA(0, 0, At, B0); PG8_BAR; PG8_SCHED;
            PG8_LDB(B1, 0, 1); PG8_STAGE(PG8_SB(0, 0), b2, voffB);
            PG8_BAR; PG8_WAIT_L(0); PG8_MMA(0, 1, At, B1); PG8_BAR;
            PG8_LDA(At, 0, 1); PG8_STAGE(PG8_SA(0, 0), a2, voffA);
            PG8_BAR; PG8_WAIT_L(0); PG8_MMA(1, 0, At, B0); PG8_BAR; PG8_SCHED;
            PG8_STAGE(PG8_SB(0, 1), b2 + hstep, voffB);
            PG8_WAIT_V(6); PG8_BAR; PG8_MMA(1, 1, At, B1); PG8_BAR;
            PG8_LDB(B0, 1, 0); PG8_SCHED; PG8_LDA(At, 1, 0); PG8_STAGE(PG8_SA(0, 1), a2 + hstep, voffA);
            PG8_WAIT_L(8); PG8_BAR; PG8_WAIT_L(0); PG8_MMA(0, 0, At, B0); PG8_BAR; PG8_SCHED;
            PG8_LDB(B1, 1, 1); PG8_STAGE(PG8_SB(1, 0), b3, voffB);
            PG8_BAR; PG8_WAIT_L(0); PG8_MMA(0, 1, At, B1); PG8_BAR;
            PG8_LDA(At, 1, 1); PG8_STAGE(PG8_SA(1, 0), a3, voffA);
            PG8_BAR; PG8_WAIT_L(0); PG8_MMA(1, 0, At, B0); PG8_BAR; PG8_SCHED;
            PG8_STAGE(PG8_SB(1, 1), b3 + hstep, voffB);
            PG8_WAIT_V(6); PG8_BAR; PG8_MMA(1, 1, At, B1); PG8_BAR;
        }
        PG8_STAMP();
        if constexpr (!Epi::AFTER_DRAIN) { E(acc, cur, wr, wc, fr, fq); S.done(cur); }
        PG8_STAMP();
        if (!has_next) break;
#pragma unroll
        for (int a = 0; a < 2; ++a)
#pragma unroll
            for (int b = 0; b < 2; ++b)
#pragma unroll
                for (int m = 0; m < 4; ++m)
#pragma unroll
                    for (int n = 0; n < 2; ++n) acc[a][b][m][n] = (f32x4){0.f, 0.f, 0.f, 0.f};
        cur = nxt; cA = nA; cB = nB; ++ui;
    }
    PG8_WAIT_V(0);
    if (wr == 0) PG8_BAR;
    PG8_BAR;
    if constexpr (Epi::AFTER_DRAIN) { E.fused(acc, cur, wr, wc, fr, fq, lds, wid, lane); S.done(cur); }
    PG8_STAMP();
    if (STAMP && wid == 0) { stamps[lane] = lane < nts ? (((unsigned long long)(unsigned)ts_hi << 32) | (unsigned)ts_lo) : 0ull;
        if (lane == 62) stamps[62] = rt_entry; if (lane == 63) stamps[63] = (unsigned long long)wall_clock64(); }
#undef PG8_STAMP
#undef PG8_SA
#undef PG8_SB
#undef PG8_STAGE
#undef PG8_LDA
#undef PG8_LDB
#undef PG8_MMA
#undef PG8_WAIT_V
#undef PG8_WAIT_L
#undef PG8_BAR
#undef PG8_SCHED
}
}


__device__ __forceinline__ u16 f2bf(float f) {
  unsigned u = __float_as_uint(f);
  u += 0x7fffu + ((u >> 16) & 1u);
  return (u16)(u >> 16);
}
__device__ __forceinline__ float bf2f(u16 h) { return __uint_as_float(((unsigned)h) << 16); }
__device__ __forceinline__ unsigned pack2(float a, float b) { return (unsigned)f2bf(a) | ((unsigned)f2bf(b) << 16); }
__device__ __forceinline__ void unpack8(const uint4 v, float (&f)[8]) {
  f[0] = bf2f((u16)(v.x & 0xffff)); f[1] = bf2f((u16)(v.x >> 16)); f[2] = bf2f((u16)(v.y & 0xffff)); f[3] = bf2f((u16)(v.y >> 16));
  f[4] = bf2f((u16)(v.z & 0xffff)); f[5] = bf2f((u16)(v.z >> 16)); f[6] = bf2f((u16)(v.w & 0xffff)); f[7] = bf2f((u16)(v.w >> 16));
}
__device__ __forceinline__ uint4 pack8s(const float (&f)[8], float sc) {
  return make_uint4(pack2(f[0] * sc, f[1] * sc), pack2(f[2] * sc, f[3] * sc), pack2(f[4] * sc, f[5] * sc), pack2(f[6] * sc, f[7] * sc));
}
__device__ __forceinline__ float silu_f(float x) { return x / (1.f + __expf(-x)); }
__device__ __forceinline__ float sigm(float x) { return 1.f / (1.f + __expf(-x)); }
__device__ __forceinline__ float wave_sum(float v) {
#pragma unroll
  for (int o = 32; o; o >>= 1) v += __shfl_xor(v, o);
  return v;
}
__device__ __forceinline__ const float* xin_of(const Params& P, int slab) { return slab == 0 ? P.in[0] : P.in[1] + (long)(slab - 1) * SLAB * D; }
__device__ __forceinline__ int Lof(int slab) { return slab == 0 ? 2048 : 8192; }
__device__ __forceinline__ int gb_row(int gr) { return gr < 16384 ? (gr >> 11) : (8 + ((gr - 16384) >> 13)); }
__device__ __forceinline__ int gb_of(int slab, int r) { return slab == 0 ? (r >> 11) : (8 + (slab - 1) * 2 + (r >> 13)); }

typedef short v4s __attribute__((ext_vector_type(4)));
#define LBAR() asm volatile("s_waitcnt lgkmcnt(0)\n\ts_barrier" ::: "memory")
#define LDS_AS __attribute__((address_space(3)))
template <int R, bool KC>
__device__ __forceinline__ uint4 ld_chunk(const u16* __restrict__ base, long ld, int k0, int c) {
  if (KC) {
    const int r = c >> 3, kc = c & 7;
    return *(const uint4*)(base + (long)r * ld + k0 + kc * 8);
  } else {
    const int k = c / (R / 8), mc = c % (R / 8);
    return *(const uint4*)(base + (long)(k0 + k) * ld + mc * 8);
  }
}
template <int R, bool KC>
__device__ __forceinline__ void st_chunk(u16* s, uint4 v, int c) {
  if (KC) {
    const int r = c >> 3, kc = c & 7;
    *(uint4*)(s + r * 72 + kc * 8) = v;
  } else {
    const int k = c / (R / 8), mc = c % (R / 8);
    *(uint4*)(s + k * (R + 8) + mc * 8) = v;
  }
}
template <int R, bool KC>
__device__ __forceinline__ bf16x8 ld_frag(const u16* s, int x0, int ks, int fr, int fq) {
  if (KC) {
    return *(const bf16x8*)(s + (x0 + fr) * 72 + ks * 32 + fq * 8);
  } else {
    const int q4 = fr >> 2, p4 = fr & 3;
    const u16* p = s + (ks * 32 + 8 * fq + q4) * (R + 8) + x0 + 4 * p4;
    v4s lo = __builtin_amdgcn_ds_read_tr16_b64_v4i16((LDS_AS v4s*)p);
    v4s hi = __builtin_amdgcn_ds_read_tr16_b64_v4i16((LDS_AS v4s*)(p + 4 * (R + 8)));
    bf16x8 r;
    r[0] = lo[0]; r[1] = lo[1]; r[2] = lo[2]; r[3] = lo[3]; r[4] = hi[0]; r[5] = hi[1]; r[6] = hi[2]; r[7] = hi[3];
    return r;
  }
}

template <int TM, int TN, bool AKC, bool BKC, bool TR, int KT>
__device__ __forceinline__ void gemm_acc(f32x4 (&acc)[TM / 32][TN / 64], const u16* __restrict__ A, long lda,
                                         const u16* __restrict__ B, long ldb, u16* sm) {
  u16* As = sm;
  u16* Bs = sm + 9216;
  const int tid = TID(), lane = tid & 63, wid = tid >> 6;
  const int wm = wid >> 2, wn = wid & 3, fr = lane & 15, fq = lane >> 4;
  constexpr int MI = TM / 32, NI = TN / 64;
  uint4 ra0[KT], ra1[KT], rb0[KT], rb1[KT];
#pragma unroll
  for (int kt = 0; kt < KT; ++kt) {
    ra0[kt] = ld_chunk<TM, AKC>(A, lda, kt * 64, tid);
    ra1[kt] = ra0[kt];
    if (TM == 128) ra1[kt] = ld_chunk<TM, AKC>(A, lda, kt * 64, tid + NT);
    rb0[kt] = ld_chunk<TN, BKC>(B, ldb, kt * 64, tid);
    rb1[kt] = rb0[kt];
    if (TN == 128) rb1[kt] = ld_chunk<TN, BKC>(B, ldb, kt * 64, tid + NT);
  }
#pragma unroll
  for (int kt = 0; kt < KT; ++kt) {
    __syncthreads();
    st_chunk<TM, AKC>(As, ra0[kt], tid);
    if (TM == 128) st_chunk<TM, AKC>(As, ra1[kt], tid + NT);
    st_chunk<TN, BKC>(Bs, rb0[kt], tid);
    if (TN == 128) st_chunk<TN, BKC>(Bs, rb1[kt], tid + NT);
    __syncthreads();
#pragma unroll
    for (int ks = 0; ks < 2; ++ks) {
      bf16x8 af[MI], bfr[NI];
#pragma unroll
      for (int mi = 0; mi < MI; ++mi) af[mi] = ld_frag<TM, AKC>(As, wm * (TM / 2) + mi * 16, ks, fr, fq);
#pragma unroll
      for (int ni = 0; ni < NI; ++ni) bfr[ni] = ld_frag<TN, BKC>(Bs, wn * (TN / 4) + ni * 16, ks, fr, fq);
#pragma unroll
      for (int mi = 0; mi < MI; ++mi)
#pragma unroll
        for (int ni = 0; ni < NI; ++ni)
          acc[mi][ni] = TR ? __builtin_amdgcn_mfma_f32_16x16x32_bf16(bfr[ni], af[mi], acc[mi][ni], 0, 0, 0)
                           : __builtin_amdgcn_mfma_f32_16x16x32_bf16(af[mi], bfr[ni], acc[mi][ni], 0, 0, 0);
    }
  }
  __syncthreads();
}

template <int KT> struct Tiles { uint4 a0[KT], a1[KT], b0[KT], b1[KT]; };
template <int TM, int TN, bool AKC, bool BKC, int KT>
__device__ __forceinline__ void tiles_issue(Tiles<KT>& t, const u16* __restrict__ A, long lda, const u16* __restrict__ B, long ldb) {
  const int tid = TID();
#pragma unroll
  for (int kt = 0; kt < KT; ++kt) {
    t.a0[kt] = ld_chunk<TM, AKC>(A, lda, kt * 64, tid);
    t.a1[kt] = t.a0[kt];
    if (TM == 128) t.a1[kt] = ld_chunk<TM, AKC>(A, lda, kt * 64, tid + NT);
    t.b0[kt] = ld_chunk<TN, BKC>(B, ldb, kt * 64, tid);
    t.b1[kt] = t.b0[kt];
    if (TN == 128) t.b1[kt] = ld_chunk<TN, BKC>(B, ldb, kt * 64, tid + NT);
  }
}
template <int TM, int TN, bool AKC, bool BKC, bool TR, int KT>
__device__ __forceinline__ void gemm_run(f32x4 (&acc)[TM / 32][TN / 64], const Tiles<KT>& t, u16* sm) {
  u16* As = sm;
  u16* Bs = sm + 9216;
  const int tid = TID(), lane = tid & 63, wid = tid >> 6;
  const int wm = wid >> 2, wn = wid & 3, fr = lane & 15, fq = lane >> 4;
  constexpr int MI = TM / 32, NI = TN / 64;
#pragma unroll
  for (int kt = 0; kt < KT; ++kt) {
    __syncthreads();
    st_chunk<TM, AKC>(As, t.a0[kt], tid);
    if (TM == 128) st_chunk<TM, AKC>(As, t.a1[kt], tid + NT);
    st_chunk<TN, BKC>(Bs, t.b0[kt], tid);
    if (TN == 128) st_chunk<TN, BKC>(Bs, t.b1[kt], tid + NT);
    __syncthreads();
#pragma unroll
    for (int ks = 0; ks < 2; ++ks) {
      bf16x8 af[MI], bfr[NI];
#pragma unroll
      for (int mi = 0; mi < MI; ++mi) af[mi] = ld_frag<TM, AKC>(As, wm * (TM / 2) + mi * 16, ks, fr, fq);
#pragma unroll
      for (int ni = 0; ni < NI; ++ni) bfr[ni] = ld_frag<TN, BKC>(Bs, wn * (TN / 4) + ni * 16, ks, fr, fq);
#pragma unroll
      for (int mi = 0; mi < MI; ++mi)
#pragma unroll
        for (int ni = 0; ni < NI; ++ni)
          acc[mi][ni] = TR ? __builtin_amdgcn_mfma_f32_16x16x32_bf16(bfr[ni], af[mi], acc[mi][ni], 0, 0, 0)
                           : __builtin_amdgcn_mfma_f32_16x16x32_bf16(af[mi], bfr[ni], acc[mi][ni], 0, 0, 0);
    }
  }
}

template <int TM, int TN, bool TR, class F>
__device__ __forceinline__ void epi_each(f32x4 (&acc)[TM / 32][TN / 64], F f) {
  const int tid = TID(), lane = tid & 63, wid = tid >> 6;
  const int wm = wid >> 2, wn = wid & 3, fr = lane & 15, fq = lane >> 4;
#pragma unroll
  for (int mi = 0; mi < TM / 32; ++mi)
#pragma unroll
    for (int ni = 0; ni < TN / 64; ++ni) {
      const int r0 = wm * (TM / 2) + mi * 16, c0 = wn * (TN / 4) + ni * 16;
      if (TR) f(r0 + fr, c0 + fq * 4, acc[mi][ni]);
      else f(r0 + fq * 4, c0 + fr, acc[mi][ni]);
    }
}

struct EpiStoreBf16 {
  static constexpr bool PERM = true, AFTER_DRAIN = false;
  u16* O; int ldc;
  __device__ __forceinline__ void operator()(const f32x4 (&acc)[2][2][4][2], const pg8::Unit& u, int wr, int wc, int fr, int fq) const {
    const int row0 = u.pm * 256 + wr * 64 + fr, col0 = u.pn * 256 + wc * 32 + 8 * fq;
#pragma unroll
    for (int ai = 0; ai < 2; ++ai)
#pragma unroll
      for (int m = 0; m < 4; ++m) {
        u16* rowp = O + (size_t)(row0 + ai * 128 + m * 16) * ldc + col0;
#pragma unroll
        for (int bj = 0; bj < 2; ++bj) {
          const f32x4 v0 = acc[ai][bj][m][0], v1 = acc[ai][bj][m][1];
          *(uint4*)(rowp + bj * 128) = make_uint4(pack2(v0[0], v0[1]), pack2(v0[2], v0[3]), pack2(v1[0], v1[1]), pack2(v1[2], v1[3]));
        }
      }
  }
};
struct EpiResid {
  static constexpr bool PERM = false, AFTER_DRAIN = false;
  float* X; const float* XS; const float* mod; int goff; int grow0;
  __device__ __forceinline__ void operator()(const f32x4 (&acc)[2][2][4][2], const pg8::Unit& u, int wr, int wc, int fr, int fq) const {
    const int row0 = u.pm * 256 + wr * 64 + fr, col0 = u.pn * 256 + wc * 32 + 4 * fq;
    const float* g = mod + (size_t)gb_row(grow0 + u.pm * 256) * 6144 + goff + col0;
    f32x4 gv[2][2];
#pragma unroll
    for (int bj = 0; bj < 2; ++bj)
#pragma unroll
      for (int n = 0; n < 2; ++n) gv[bj][n] = *(const f32x4*)(g + bj * 128 + n * 16);
#pragma unroll
    for (int am = 0; am < 4; ++am) {
      f32x4 xv[2][2][2];
#pragma unroll
      for (int mm = 0; mm < 2; ++mm)
#pragma unroll
        for (int bj = 0; bj < 2; ++bj)
#pragma unroll
          for (int n = 0; n < 2; ++n) xv[mm][bj][n] = *(const f32x4*)(XS + (size_t)(row0 + (am >> 1) * 128 + ((am & 1) * 2 + mm) * 16) * D + col0 + bj * 128 + n * 16);
#pragma unroll
      for (int mm = 0; mm < 2; ++mm)
#pragma unroll
        for (int bj = 0; bj < 2; ++bj)
#pragma unroll
          for (int n = 0; n < 2; ++n)
            *(f32x4*)(X + (size_t)(row0 + (am >> 1) * 128 + ((am & 1) * 2 + mm) * 16) * D + col0 + bj * 128 + n * 16) = xv[mm][bj][n] + gv[bj][n] * acc[am >> 1][bj][(am & 1) * 2 + mm][n];
    }
  }
};
struct EpiFfnVal {
  static constexpr bool PERM = false, AFTER_DRAIN = false;
  const u16* G; u16* ACT; const float* cw; const float* cb; int grow0;
  __device__ __forceinline__ void operator()(const f32x4 (&acc)[2][2][4][2], const pg8::Unit& u, int wr, int wc, int fr, int fq) const {
    const int row0 = u.pm * 256 + wr * 64 + fr, col0 = u.pn * 256 + wc * 32 + 4 * fq;
#pragma unroll
    for (int bj = 0; bj < 2; ++bj)
#pragma unroll
      for (int n = 0; n < 2; ++n) {
        const int c = col0 + bj * 128 + n * 16;
        const f32x4 w0 = *(const f32x4*)(cw + c), w1 = *(const f32x4*)(cw + DFF + c), w2 = *(const f32x4*)(cw + 2 * DFF + c), bb = *(const f32x4*)(cb + c);
#pragma unroll
        for (int ai = 0; ai < 2; ++ai) {
          uint2 g0[4], g1[4], g2[4];
#pragma unroll
          for (int m = 0; m < 4; ++m) {
            const int r = row0 + ai * 128 + m * 16;
            const int L = (grow0 + r) < 16384 ? 2048 : 8192;
            const int pos = (grow0 + r) & (L - 1);
            const u16* gp = G + (size_t)r * DFF + c;
            g1[m] = *(const uint2*)gp;
            g0[m] = *(const uint2*)(gp - (pos > 0 ? DFF : 0));
            g2[m] = *(const uint2*)(gp + (pos < L - 1 ? DFF : 0));
          }
#pragma unroll
          for (int m = 0; m < 4; ++m) {
            const int r = row0 + ai * 128 + m * 16;
            const int L = (grow0 + r) < 16384 ? 2048 : 8192;
            const int pos = (grow0 + r) & (L - 1);
            const float m0 = pos > 0 ? 1.f : 0.f, m2 = pos < L - 1 ? 1.f : 0.f;
            const uint2 a0 = g0[m], a1 = g1[m], a2 = g2[m];
            f32x4 a;
            a[0] = m0 * bf2f((u16)(a0.x & 0xffff)) * w0[0] + bf2f((u16)(a1.x & 0xffff)) * w1[0] + m2 * bf2f((u16)(a2.x & 0xffff)) * w2[0] + bb[0];
            a[1] = m0 * bf2f((u16)(a0.x >> 16)) * w0[1] + bf2f((u16)(a1.x >> 16)) * w1[1] + m2 * bf2f((u16)(a2.x >> 16)) * w2[1] + bb[1];
            a[2] = m0 * bf2f((u16)(a0.y & 0xffff)) * w0[2] + bf2f((u16)(a1.y & 0xffff)) * w1[2] + m2 * bf2f((u16)(a2.y & 0xffff)) * w2[2] + bb[2];
            a[3] = m0 * bf2f((u16)(a0.y >> 16)) * w0[3] + bf2f((u16)(a1.y >> 16)) * w1[3] + m2 * bf2f((u16)(a2.y >> 16)) * w2[3] + bb[3];
            const f32x4 v = acc[ai][bj][m][n];
            *(uint2*)(ACT + (size_t)r * DFF + c) = make_uint2(pack2(silu_f(a[0]) * v[0], silu_f(a[1]) * v[1]), pack2(silu_f(a[2]) * v[2], silu_f(a[3]) * v[3]));
          }
        }
      }
  }
};
template <class Epi>
__device__ __forceinline__ void run_gemm(const u16* A, const u16* Bt, int M, int N, int K, const Epi& E) {
  pg8::Gemm g; g.A = A; g.Bt = Bt; g.M = M; g.N = N; g.K = K;
  pg8::StaticOrder S; S.init(M, N, gridDim.x, BID());
  __syncthreads();
  pg8::gemm_phase<Epi, pg8::StaticOrder, false>((PG8_LAS unsigned char*)smem, g, S, E, nullptr);
  __syncthreads();
}

__device__ __forceinline__ int fidx(int p) { return p + ((p >> 6) << 2); }
__device__ __forceinline__ float2 cmulf(float2 a, float2 b) { return make_float2(a.x * b.x - a.y * b.y, a.x * b.y + a.y * b.x); }
__device__ __forceinline__ float2 cmulcf(float2 a, float2 b) { return make_float2(a.x * b.x + a.y * b.y, a.y * b.x - a.x * b.y); }
#define R16C(q) ((q) == 0 ? 1.f : (q) == 1 ? 0.9238795325f : (q) == 2 ? 0.7071067812f : (q) == 3 ? 0.3826834324f : (q) == 4 ? 0.f : (q) == 5 ? -0.3826834324f : (q) == 6 ? -0.7071067812f : -0.9238795325f)
#define R16S(q) ((q) == 0 ? 0.f : (q) == 1 ? -0.3826834324f : (q) == 2 ? -0.7071067812f : (q) == 3 ? -0.9238795325f : (q) == 4 ? -1.f : (q) == 5 ? -0.9238795325f : (q) == 6 ? -0.7071067812f : -0.3826834324f)
template <int N, int RS, bool INV>
__device__ __forceinline__ void fft_pass(float2* x, const float2* __restrict__ tw, const int S, const int tid) {
  constexpr int R = 1 << RS;
  const int E = S >> (RS - 1);
#pragma unroll 1
  for (int g = tid; g < N / R; g += NT) {
    const int blo = g & (E - 1);
    const int base = ((g - blo) << RS) + blo;
    float2 e[R];
#pragma unroll
    for (int k = 0; k < R; ++k) e[k] = x[fidx(base + k * E)];
    float2 wb[RS];
#pragma unroll
    for (int st = 0; st < RS; ++st) wb[st] = tw[blo * (8192 / (S >> st))];
#pragma unroll
    for (int sq = 0; sq < RS; ++sq) {
      const int st = INV ? (RS - 1 - sq) : sq;
      const int h = (R / 2) >> st;
#pragma unroll
      for (int k = 0; k < R; ++k) {
        if ((k & h) == 0) {
          const int m = k & (h - 1);
          const int q = m * (8 / h);
          float2 w = wb[st];
          if (q != 0) w = cmulf(w, make_float2(R16C(q), R16S(q)));
          if (!INV) {
            const float2 a = e[k], b = e[k + h];
            e[k] = make_float2(a.x + b.x, a.y + b.y);
            e[k + h] = cmulf(make_float2(a.x - b.x, a.y - b.y), w);
          } else {
            const float2 a = e[k], b = cmulcf(e[k + h], w);
            e[k] = make_float2(a.x + b.x, a.y + b.y);
            e[k + h] = make_float2(a.x - b.x, a.y - b.y);
          }
        }
      }
    }
#pragma unroll
    for (int k = 0; k < R; ++k) x[fidx(base + k * E)] = e[k];
  }
  __syncthreads();
}
template <int N>
__device__ __forceinline__ void fft_dif_t(float2* x, const float2* __restrict__ tw) {
  const int tid = TID();
  if (N == 16384) {
    fft_pass<N, 4, false>(x, tw, 8192, tid); fft_pass<N, 4, false>(x, tw, 512, tid);
    fft_pass<N, 4, false>(x, tw, 32, tid); fft_pass<N, 2, false>(x, tw, 2, tid);
  } else {
    fft_pass<N, 4, false>(x, tw, 2048, tid); fft_pass<N, 4, false>(x, tw, 128, tid); fft_pass<N, 4, false>(x, tw, 8, tid);
  }
}
template <int N>
__device__ __forceinline__ void ifft_dit_t(float2* x, const float2* __restrict__ tw) {
  const int tid = TID();
  if (N == 16384) {
    fft_pass<N, 2, true>(x, tw, 2, tid); fft_pass<N, 4, true>(x, tw, 32, tid);
    fft_pass<N, 4, true>(x, tw, 512, tid); fft_pass<N, 4, true>(x, tw, 8192, tid);
  } else {
    fft_pass<N, 4, true>(x, tw, 8, tid); fft_pass<N, 4, true>(x, tw, 128, tid); fft_pass<N, 4, true>(x, tw, 2048, tid);
  }
}
__device__ __forceinline__ void fft_dif(float2* x, int N, const float2* __restrict__ tw) {
  if (N == 16384) fft_dif_t<16384>(x, tw); else fft_dif_t<4096>(x, tw);
}
__device__ __forceinline__ void ifft_dit(float2* x, int N, const float2* __restrict__ tw) {
  if (N == 16384) ifft_dit_t<16384>(x, tw); else ifft_dit_t<4096>(x, tw);
}

__device__ void transpose_w(const float* __restrict__ W, u16* __restrict__ Wt, int K, int N) {
  float* smf = (float*)smem;
  const int tk = K / 64, tn = N / 64, tid = TID();
  for (int item = BID(); item < tk * tn; item += gridDim.x) {
    const int k0 = (item / tn) * 64, n0 = (item % tn) * 64;
    float4 v[2];
#pragma unroll
    for (int j = 0; j < 2; ++j) {
      const int idx = tid + j * NT, kk = idx >> 4, n4 = idx & 15;
      v[j] = *(const float4*)(W + (long)(k0 + kk) * N + n0 + n4 * 4);
    }
    __syncthreads();
#pragma unroll
    for (int j = 0; j < 2; ++j) {
      const int idx = tid + j * NT, kk = idx >> 4, n4 = idx & 15;
      float* p = smf + kk * 65 + n4 * 4;
      p[0] = v[j].x; p[1] = v[j].y; p[2] = v[j].z; p[3] = v[j].w;
    }
    __syncthreads();
    const int nn = tid >> 3, k8 = tid & 7;
    float f[8];
#pragma unroll
    for (int i = 0; i < 8; ++i) f[i] = smf[(k8 * 8 + i) * 65 + nn];
    *(uint4*)(Wt + (long)(n0 + nn) * K + k0 + k8 * 8) = pack8s(f, 1.f);
  }
  __syncthreads();
}

__device__ void phase_pre0(const Params& P) {
  const int tid = TID();
  const long gtid = (long)BID() * NT + tid, gsz = (long)gridDim.x * NT;
  transpose_w(P.in[7], (u16*)(WS(P) + O_WHYIN), 1024, 3072);
  transpose_w(P.in[18], (u16*)(WS(P) + O_WHYOUT), 1024, 1024);
  transpose_w(P.in[19], (u16*)(WS(P) + O_WRETIN), 1024, 6144);
  transpose_w(P.in[21], (u16*)(WS(P) + O_WRETOUT), 2048, 1024);
  transpose_w(P.in[22], (u16*)(WS(P) + O_WSWAIN), 1024, 1536);
  transpose_w(P.in[26], (u16*)(WS(P) + O_WSWAOUT), 1024, 1024);
  transpose_w(P.in[27], (u16*)(WS(P) + O_WHGIN), 1024, 5120);
  transpose_w(P.in[30], (u16*)(WS(P) + O_WHGOUT), 1024, 1024);
  for (int l = 0; l < 4; ++l) {
    transpose_w(P.in[31] + (long)l * 1024 * DFF, (u16*)(WS(P) + O_WFG) + (long)l * DFF * 1024, 1024, DFF);
    transpose_w(P.in[32] + (long)l * 1024 * DFF, (u16*)(WS(P) + O_WFV) + (long)l * DFF * 1024, 1024, DFF);
    transpose_w(P.in[35] + (long)l * DFF * 1024, (u16*)(WS(P) + O_WFD) + (long)l * 1024 * DFF, DFF, 1024);
  }
  {
    float* cs = (float*)smem;
    float* modp = (float*)(WS(P) + O_MODP);
    for (int item = BID(); item < 4 * 8 * 12; item += gridDim.x) {
      const int nb = item % 12, ks = (item / 12) % 8, l = item / 96;
      __syncthreads();
      for (int i = tid; i < 2048; i += NT) {
        int b = i >> 7, k = i & 127;
        float c = (b < 8) ? P.in[2][b * 1024 + ks * 128 + k] : P.in[3][(b - 8) * 1024 + ks * 128 + k];
        cs[i] = c / (1.f + expf(-c));
      }
      __syncthreads();
      const int n = nb * 512 + tid;
      float a[16];
#pragma unroll
      for (int b = 0; b < 16; ++b) a[b] = 0.f;
      const float* w = P.in[4] + ((long)l * 1024 + ks * 128) * 6144 + n;
      for (int k = 0; k < 128; ++k) {
        float wv = w[(long)k * 6144];
#pragma unroll
        for (int b = 0; b < 16; ++b) a[b] += cs[b * 128 + k] * wv;
      }
#pragma unroll
      for (int b = 0; b < 16; ++b) modp[(((long)ks * 4 + l) * 16 + b) * 6144 + n] = a[b];
    }
    __syncthreads();
  }
  {
    float2* tw = (float2*)(WS(P) + O_TW);
    for (long i = gtid; i < 8192; i += gsz) {
      float s, c;
      sincospif((float)i * (1.f / 8192.f), &s, &c);
      tw[i] = make_float2(c, -s);
    }
    float2* rr = (float2*)(WS(P) + O_ROPER);
    for (long i = gtid; i < (long)8192 * 128; i += gsz) {
      int pos = (int)(i >> 7), d = (int)(i & 127);
      float inv = exp2f(-(float)d * (13.287712379549449f / 128.f));
      float s, c;
      sincosf((float)pos * inv, &s, &c);
      rr[i] = make_float2(c, s);
    }
    float2* rs = (float2*)(WS(P) + O_ROPES);
    for (long i = gtid; i < (long)8192 * 32; i += gsz) {
      int pos = (int)(i >> 5), d = (int)(i & 31);
      float inv = exp2f(-(float)d * (13.287712379549449f / 32.f));
      float s, c;
      sincosf((float)pos * inv, &s, &c);
      rs[i] = make_float2(c, s);
    }
  }
  {
    float* zf = (float*)smem;
    float* h1 = zf + 8 * 36;
    const float* w1 = P.in[10]; const float* b1 = P.in[11]; const float* w2 = P.in[12]; const float* b2 = P.in[13];
    const float* fr = P.in[15];
    const int tl = tid >> 6, j = tid & 63;
    for (int item = BID(); item < 1280; item += gridDim.x) {
      const int sel = item >= 1024;
      const int L = sel ? 2048 : 8192;
      const int t = (sel ? item - 1024 : item) * 8 + tl;
      float* hid = (float*)(WS(P) + (sel ? O_HIDP : O_HIDS));
      __syncthreads();
      if (j < 33) {
        float v;
        if (j == 0) v = (float)t / (float)(L - 1);
        else {
          int i = (j - 1) & 15;
          float band = 1e-4f + (float)i * ((15.f - 1e-4f) / 15.f);
          float ang = (6.283185307179586f / (float)L) * (float)t;
          float a = band * ang;
          v = (j <= 16) ? cosf(a) : -sinf(a);
        }
        zf[tl * 36 + j] = v;
      }
      __syncthreads();
      float s = b1[j];
#pragma unroll 3
      for (int i = 0; i < 33; ++i) s += zf[tl * 36 + i] * w1[i * 64 + j];
      h1[tl * 64 + j] = sinf(fr[j] * s);
      __syncthreads();
      float s2 = b2[j];
#pragma unroll 4
      for (int i = 0; i < 64; ++i) s2 += h1[tl * 64 + i] * w2[i * 64 + j];
      hid[(long)t * 64 + j] = sinf(fr[j] * s2);
    }
    __syncthreads();
  }
}

__device__ void phase_pre1(const Params& P) {
  __shared__ float w3s[128];
  __shared__ float red[8];
  const int tid = TID(), lane = tid & 63, wid = tid >> 6;
  const long gtid = (long)BID() * NT + tid, gsz = (long)gridDim.x * NT;
  {
    const float* modp = (const float*)(WS(P) + O_MODP);
    float* mod = (float*)(WS(P) + O_MOD);
    for (long i = gtid; i < (long)4 * 16 * 6144; i += gsz) {
      int n = (int)(i % 6144);
      int l = (int)(i / (16 * 6144));
      float s = P.in[5][l * 6144 + n];
      for (int ks = 0; ks < 8; ++ks) s += modp[(long)ks * 4 * 16 * 6144 + i];
      mod[i] = s;
    }
  }
  float2* buf = (float2*)smem;
  const float2* tw = (const float2*)(WS(P) + O_TW);
  for (int item = BID(); item < 2048; item += gridDim.x) {
    const int sel = item >> 10, c = item & 1023;
    const int L = sel ? 2048 : 8192, N = 2 * L;
    const float* hid = (const float*)(WS(P) + (sel ? O_HIDP : O_HIDS));
    float2* hs = (float2*)(WS(P) + (sel ? O_HSPP : O_HSPS)) + (long)c * N;
    __syncthreads();
    if (tid < 128) {
      int dirn = tid >> 6, j = tid & 63;
      w3s[tid] = P.in[14][(long)j * 2048 + dirn * 1024 + c];
    }
    __syncthreads();
    const float dec0 = fabsf(P.in[16][c]), dec1 = fabsf(P.in[16][1024 + c]);
    const float invLm1 = 1.f / (float)(L - 1);
    float asum = 0.f;
    for (int n = tid; n < N; n += NT) {
      float val = 0.f;
      if (n != L) {
        const int dirn = n < L ? 0 : 1;
        const int t = n < L ? n : N - n;
        const float4* hr = (const float4*)(hid + (long)t * 64);
        const float* w = w3s + dirn * 64;
        float s = 0.f;
#pragma unroll
        for (int q = 0; q < 16; ++q) {
          float4 h4 = hr[q];
          s += h4.x * w[4 * q] + h4.y * w[4 * q + 1] + h4.z * w[4 * q + 2] + h4.w * w[4 * q + 3];
        }
        float tl = (float)t * invLm1;
        val = s * expf(-tl * (dirn ? dec1 : dec0));
      }
      buf[fidx(n)] = make_float2(val, 0.f);
      asum += fabsf(val);
    }
    asum = wave_sum(asum);
    if (lane == 0) red[wid] = asum;
    __syncthreads();
    float tot = 0.f;
#pragma unroll
    for (int w = 0; w < 8; ++w) tot += red[w];
    const float scale = 1.f / (tot * (float)N);
    fft_dif(buf, N, tw);
    for (int p = tid; p < N; p += NT) {
      float2 a = buf[fidx(p)];
      hs[p] = make_float2(a.x * scale, a.y * scale);
    }
  }
  __syncthreads();
}

__device__ void phase_norm(const Params& P, int layer, int sl, int which) {
  const int grow0 = which ? sl * FSLAB : sl * SLAB, nrows = which ? FSLAB : SLAB;
  const float* __restrict__ x = (layer == 0 && which == 0) ? xin_of(P, sl) : (const float*)(OUTP(P) + (long)grow0 * D);
  u16* __restrict__ h = (u16*)(WS(P) + (which ? O_FHBUF : O_HBUF));
  const float* gain = P.in[6] + (layer * 2 + which) * D;
  const float* mod = (const float*)(WS(P) + O_MOD) + (long)layer * 16 * 6144;
  const int shoff = which ? 3 * D : 0, scoff = which ? 4 * D : D;
  const int tid = TID(), lane = tid & 63, wid = tid >> 6;
  for (int item = BID(); item < nrows / 32; item += gridDim.x) {
    const int r0 = item * 32 + wid * 4;
    float4 v[4][4];
    float ss[4];
#pragma unroll
    for (int u = 0; u < 4; ++u) {
      const float* xr = x + (long)(r0 + u) * D;
      float a = 0.f;
#pragma unroll
      for (int i = 0; i < 4; ++i) {
        v[u][i] = *(const float4*)(xr + i * 256 + lane * 4);
        a += v[u][i].x * v[u][i].x + v[u][i].y * v[u][i].y + v[u][i].z * v[u][i].z + v[u][i].w * v[u][i].w;
      }
      ss[u] = a;
    }
    const float* m = mod + (long)gb_row(grow0 + r0) * 6144;
#pragma unroll
    for (int u = 0; u < 4; ++u) ss[u] = wave_sum(ss[u]);
#pragma unroll
    for (int i = 0; i < 4; ++i) {
      const int col = i * 256 + lane * 4;
      const float4 g = *(const float4*)(gain + col);
      const float4 sc = *(const float4*)(m + scoff + col);
      const float4 sh = *(const float4*)(m + shoff + col);
      const float a0 = g.x * (1.f + sc.x), a1 = g.y * (1.f + sc.y), a2 = g.z * (1.f + sc.z), a3 = g.w * (1.f + sc.w);
#pragma unroll
      for (int u = 0; u < 4; ++u) {
        const float rstd = rsqrtf(ss[u] * (1.f / 1024.f) + 1e-6f);
        const float y0 = v[u][i].x * rstd * a0 + sh.x, y1 = v[u][i].y * rstd * a1 + sh.y;
        const float y2 = v[u][i].z * rstd * a2 + sh.z, y3 = v[u][i].w * rstd * a3 + sh.w;
        *(uint2*)(h + (long)(r0 + u) * D + col) = make_uint2(pack2(y0, y1), pack2(y2, y3));
      }
    }
  }
}

__device__ void phase_proj(const Params& P, size_t woff, int N) {
  EpiStoreBf16 E; E.O = (u16*)(WS(P) + O_PROJ); E.ldc = N;
  run_gemm((const u16*)(WS(P) + O_HBUF), (const u16*)(WS(P) + woff), SLAB, N, D, E);
}
__device__ void phase_resid(const Params& P, int layer, int slab, const u16* A, int K, size_t woff, int goff) {
  EpiResid E; E.X = OUTP(P) + (long)slab * SLAB * D; E.XS = (layer == 0) ? xin_of(P, slab) : (const float*)E.X; E.mod = (const float*)(WS(P) + O_MOD) + (long)layer * 16 * 6144; E.goff = goff; E.grow0 = slab * SLAB;
  run_gemm(A, (const u16*)(WS(P) + woff), SLAB, D, K, E);
}

__device__ void phase_ffn_gate(const Params& P, int layer) {
  EpiStoreBf16 E; E.O = (u16*)(WS(P) + O_FGBUF); E.ldc = DFF;
  run_gemm((const u16*)(WS(P) + O_FHBUF), (const u16*)(WS(P) + O_WFG) + (long)layer * DFF * D, FSLAB, DFF, D, E);
}
__device__ void phase_ffn_val(const Params& P, int layer, int fs) {
  EpiFfnVal E; E.G = (const u16*)(WS(P) + O_FGBUF); E.ACT = (u16*)(WS(P) + O_FACT) + (long)fs * FSLAB * DFF;
  E.cw = P.in[33] + (long)layer * 3 * DFF; E.cb = P.in[34] + (long)layer * DFF; E.grow0 = fs * FSLAB;
  run_gemm((const u16*)(WS(P) + O_FHBUF), (const u16*)(WS(P) + O_WFV) + (long)layer * DFF * D, FSLAB, DFF, D, E);
}
__device__ void phase_ffn_down(const Params& P, int layer) {
  EpiResid E; E.X = OUTP(P); E.XS = E.X; E.mod = (const float*)(WS(P) + O_MOD) + (long)layer * 16 * 6144; E.goff = 5 * D; E.grow0 = 0;
  run_gemm((const u16*)(WS(P) + O_FACT), (const u16*)(WS(P) + O_WFD) + (long)layer * D * DFF, NTOK, D, DFF, E);
}

__device__ void phase_hy_conv(const Params& P, int slab) {
  const int L = Lof(slab), nseq = SLAB / L, tid = TID();
  const u16* __restrict__ z = (const u16*)(WS(P) + O_PROJ);
  float* __restrict__ uT = (float*)(WS(P) + O_UT);
  u16* __restrict__ x0c = (u16*)(WS(P) + O_X0C);
  const float* cw = P.in[8];
  const float* cb = P.in[9];
  float* tile = (float*)smem;
  const int ntt = L / 64;
  const int nitems = nseq * ntt * 16;
  const int tl = tid >> 3, cg = tid & 7;
  for (int item = BID(); item < nitems; item += gridDim.x) {
    const int ct = item % 16, tt = (item / 16) % ntt, seq = item / (16 * ntt);
    const int t = tt * 64 + tl, c0 = ct * 64 + cg * 8;
    const long row = (long)seq * L + t;
    const float mp = t > 0 ? 1.f : 0.f, mn = t < L - 1 ? 1.f : 0.f;
    const long rp = t > 0 ? row - 1 : row, rn = t < L - 1 ? row + 1 : row;
    float val[3][8];
#pragma unroll
    for (int q = 0; q < 3; ++q) {
      const int col = q * 1024 + c0;
      float a[8], b[8], c[8];
      unpack8(*(const uint4*)(z + rp * 3072 + col), a);
      unpack8(*(const uint4*)(z + row * 3072 + col), b);
      unpack8(*(const uint4*)(z + rn * 3072 + col), c);
      const float4 w0a = *(const float4*)(cw + col), w0b = *(const float4*)(cw + col + 4);
      const float4 w1a = *(const float4*)(cw + 3072 + col), w1b = *(const float4*)(cw + 3072 + col + 4);
      const float4 w2a = *(const float4*)(cw + 6144 + col), w2b = *(const float4*)(cw + 6144 + col + 4);
      const float4 ba = *(const float4*)(cb + col), bb = *(const float4*)(cb + col + 4);
      const float w0[8] = {w0a.x, w0a.y, w0a.z, w0a.w, w0b.x, w0b.y, w0b.z, w0b.w};
      const float w1[8] = {w1a.x, w1a.y, w1a.z, w1a.w, w1b.x, w1b.y, w1b.z, w1b.w};
      const float w2[8] = {w2a.x, w2a.y, w2a.z, w2a.w, w2b.x, w2b.y, w2b.z, w2b.w};
      const float bs[8] = {ba.x, ba.y, ba.z, ba.w, bb.x, bb.y, bb.z, bb.w};
#pragma unroll
      for (int i = 0; i < 8; ++i) val[q][i] = mp * a[i] * w0[i] + b[i] * w1[i] + mn * c[i] * w2[i] + bs[i];
    }
    *(uint4*)(x0c + row * 1024 + c0) = pack8s(val[0], 1.f);
    __syncthreads();
#pragma unroll
    for (int i = 0; i < 8; ++i) tile[tl * 65 + cg * 8 + i] = val[1][i] * val[2][i];
    __syncthreads();
    {
      const int cl = tid >> 3, tq = tid & 7;
      float* dst = uT + ((long)seq * 1024 + ct * 64 + cl) * L + tt * 64 + tq * 8;
      float4 o0, o1;
      o0.x = tile[(tq * 8 + 0) * 65 + cl]; o0.y = tile[(tq * 8 + 1) * 65 + cl]; o0.z = tile[(tq * 8 + 2) * 65 + cl]; o0.w = tile[(tq * 8 + 3) * 65 + cl];
      o1.x = tile[(tq * 8 + 4) * 65 + cl]; o1.y = tile[(tq * 8 + 5) * 65 + cl]; o1.z = tile[(tq * 8 + 6) * 65 + cl]; o1.w = tile[(tq * 8 + 7) * 65 + cl];
      *(float4*)dst = o0; *(float4*)(dst + 4) = o1;
    }
  }
  __syncthreads();
}

__device__ void phase_hy_fft(const Params& P, int slab, bool dry = false) {
  const int L = Lof(slab), N = 2 * L, nseq = SLAB / L, tid = TID();
  float* uT = (float*)(WS(P) + O_UT);
  const float2* hsb = (const float2*)(WS(P) + (slab == 0 ? O_HSPP : O_HSPS));
  const float2* tw = (const float2*)(WS(P) + O_TW);
  const float* skip = P.in[17];
  float2* buf = (float2*)smem;
  const int nitems = (nseq / 2) * 1024;
  for (int item = BID(); item < nitems; item += gridDim.x) {
    const int pr = item >> 10, c = item & 1023;
    float* u0 = uT + ((long)(pr * 2) * 1024 + c) * L;
    float* u1 = u0 + (long)1024 * L;
    __syncthreads();
    for (int t = tid; t < L; t += NT) {
      buf[fidx(t)] = make_float2(u0[t], u1[t]);
      buf[fidx(t + L)] = make_float2(0.f, 0.f);
    }
    __syncthreads();
    fft_dif(buf, N, tw);
    const float2* h = hsb + (long)c * N;
    for (int p = tid; p < N; p += NT) {
      float2 a = buf[fidx(p)], b = h[p];
      buf[fidx(p)] = make_float2(a.x * b.x - a.y * b.y, a.x * b.y + a.y * b.x);
    }
    __syncthreads();
    ifft_dit(buf, N, tw);
    const float sk = skip[c];
    for (int t = tid; t < L; t += NT) {
      float2 y = buf[fidx(t)];
      const long doff = dry ? (long)(END_HY - O_UT) / 4 : 0;
      u0[t + doff] = y.x + u0[t] * sk;
      u1[t + doff] = y.y + u1[t] * sk;
    }
  }
  __syncthreads();
}

__device__ void phase_hy_tr(const Params& P, int slab) {
  const int L = Lof(slab), nseq = SLAB / L, tid = TID();
  const float* __restrict__ yT = (const float*)(WS(P) + O_UT);
  const u16* __restrict__ x0c = (const u16*)(WS(P) + O_X0C);
  u16* __restrict__ a2 = (u16*)(WS(P) + O_A2);
  float* tile = (float*)smem;
  const int ntt = L / 64;
  const int nitems = nseq * ntt * 16;
  for (int item = BID(); item < nitems; item += gridDim.x) {
    const int ct = item % 16, tt = (item / 16) % ntt, seq = item / (16 * ntt);
    const int cl = tid >> 3, tq = tid & 7;
    const float* src = yT + ((long)seq * 1024 + ct * 64 + cl) * L + tt * 64 + tq * 8;
    const float4 i0 = *(const float4*)src, i1 = *(const float4*)(src + 4);
    const int tl = tid >> 3, cg = tid & 7;
    const long row = (long)seq * L + tt * 64 + tl;
    const int c0 = ct * 64 + cg * 8;
    float xg[8];
    unpack8(*(const uint4*)(x0c + row * 1024 + c0), xg);
    __syncthreads();
    float* p = tile + cl * 65 + tq * 8;
    p[0] = i0.x; p[1] = i0.y; p[2] = i0.z; p[3] = i0.w; p[4] = i1.x; p[5] = i1.y; p[6] = i1.z; p[7] = i1.w;
    __syncthreads();
    float o[8];
#pragma unroll
    for (int i = 0; i < 8; ++i) o[i] = tile[(cg * 8 + i) * 65 + tl] * xg[i];
    *(uint4*)(a2 + row * 1024 + c0) = pack8s(o, 1.f);
  }
  __syncthreads();
}

struct Rec {
  int H, DK, DV, C;
  int ldv, voff, goff;
};
__device__ __forceinline__ Rec rec_of(int kind) {
  Rec r;
  if (kind == 1) { r.H = 4; r.DK = 256; r.DV = 512; r.C = 256; r.ldv = 6144; r.voff = 2048; r.goff = 4096; }
  else { r.H = 8; r.DK = 128; r.DV = 128; r.C = 64; r.ldv = 5120; r.voff = 1024; r.goff = 4096; }
  return r;
}

__device__ void phase_ret_prep(const Params& P, int slab) {
  const int L = Lof(slab);
  const u16* __restrict__ pj = (const u16*)(WS(P) + O_PROJ);
  u16* __restrict__ qdf = (u16*)(WS(P) + O_QDF); u16* __restrict__ qdb = (u16*)(WS(P) + O_QDB);
  u16* __restrict__ kif = (u16*)(WS(P) + O_KIF); u16* __restrict__ kib = (u16*)(WS(P) + O_KIB);
  u16* __restrict__ kef = (u16*)(WS(P) + O_KEF); u16* __restrict__ keb = (u16*)(WS(P) + O_KEB);
  float* dlf = (float*)(WS(P) + O_DLF); float* dlb = (float*)(WS(P) + O_DLB);
  const float2* __restrict__ rope = (const float2*)(WS(P) + O_ROPER);
  const long gtid = (long)BID() * NT + TID(), gsz = (long)gridDim.x * NT;
  for (long idx = gtid; idx < (long)SLAB * 64; idx += gsz) {
    const int d0 = (int)(idx & 15) * 8, h = (int)((idx >> 4) & 3), t = (int)(idx >> 6);
    const int pos = t & (L - 1), r = t & 255;
    const float lgf = -expf(P.in[20][h]), lgb = -expf(P.in[20][4 + h]);
    const u16* row = pj + (long)t * 6144 + h * 256 + d0;
    const uint4 vq1 = *(const uint4*)row, vq2 = *(const uint4*)(row + 128);
    const uint4 vk1 = *(const uint4*)(row + 1024), vk2 = *(const uint4*)(row + 1024 + 128);
    const float4* rp = (const float4*)(rope + (long)pos * 128 + d0);
    const float4 c01 = rp[0], c23 = rp[1], c45 = rp[2], c67 = rp[3];
    float q1[8], q2[8], k1[8], k2[8];
    unpack8(vq1, q1); unpack8(vq2, q2); unpack8(vk1, k1); unpack8(vk2, k2);
    const float cs[8] = {c01.x, c01.z, c23.x, c23.z, c45.x, c45.z, c67.x, c67.z};
    const float sn[8] = {c01.y, c01.w, c23.y, c23.w, c45.y, c45.w, c67.y, c67.w};
    float qa[8], qb[8], ka[8], kb[8];
#pragma unroll
    for (int i = 0; i < 8; ++i) {
      qa[i] = q1[i] * cs[i] - q2[i] * sn[i]; qb[i] = q1[i] * sn[i] + q2[i] * cs[i];
      ka[i] = (k1[i] * cs[i] - k2[i] * sn[i]) * 0.0625f; kb[i] = (k1[i] * sn[i] + k2[i] * cs[i]) * 0.0625f;
    }
    const float bf = (float)(r + 1) * lgf, bb = (float)(256 - r) * lgb;
    const float ef = expf(bf), eif = expf(-bf), eef = expf((float)(255 - r) * lgf);
    const float eb = expf(bb), eib = expf(-bb), eeb = expf((float)r * lgb);
    const long o1 = (long)t * 1024 + h * 256 + d0, o2 = o1 + 128;
    *(uint4*)(qdf + o1) = pack8s(qa, ef); *(uint4*)(qdf + o2) = pack8s(qb, ef);
    *(uint4*)(qdb + o1) = pack8s(qa, eb); *(uint4*)(qdb + o2) = pack8s(qb, eb);
    *(uint4*)(kif + o1) = pack8s(ka, eif); *(uint4*)(kif + o2) = pack8s(kb, eif);
    *(uint4*)(kib + o1) = pack8s(ka, eib); *(uint4*)(kib + o2) = pack8s(kb, eib);
    *(uint4*)(kef + o1) = pack8s(ka, eef); *(uint4*)(kef + o2) = pack8s(kb, eef);
    *(uint4*)(keb + o1) = pack8s(ka, eeb); *(uint4*)(keb + o2) = pack8s(kb, eeb);
    if (r == 0) {
      const long cgi = (long)(t >> 8) * 1024 + h * 256 + d0;
      const float df = expf(256.f * lgf), db = expf(256.f * lgb);
#pragma unroll
      for (int i = 0; i < 8; ++i) { dlf[cgi + i] = df; dlf[cgi + 128 + i] = df; dlb[cgi + i] = db; dlb[cgi + 128 + i] = db; }
    }
  }
}

__device__ __forceinline__ float lb_of(const float* lbt, int dr, int ch) {
  const float a0 = lbt[(dr * 4 + 0) * 1024 + ch], a1 = lbt[(dr * 4 + 1) * 1024 + ch], a2 = lbt[(dr * 4 + 2) * 1024 + ch], a3 = lbt[(dr * 4 + 3) * 1024 + ch];
  const float m = fmaxf(fmaxf(a0, a1), fmaxf(a2, a3));
  const float e0 = expf(a0 - m), e1 = expf(a1 - m), e2 = expf(a2 - m), e3 = expf(a3 - m);
  return (e0 + e1 + e2) / (e0 + e1 + e2 + e3);
}
__device__ void phase_hg_prep(const Params& P) {
  const u16* __restrict__ pj = (const u16*)(WS(P) + O_PROJ);
  u16* __restrict__ qdf = (u16*)(WS(P) + O_QDF); u16* __restrict__ qdb = (u16*)(WS(P) + O_QDB);
  u16* __restrict__ kif = (u16*)(WS(P) + O_KIF); u16* __restrict__ kib = (u16*)(WS(P) + O_KIB);
  u16* __restrict__ kef = (u16*)(WS(P) + O_KEF); u16* __restrict__ keb = (u16*)(WS(P) + O_KEB);
  float* dlf = (float*)(WS(P) + O_DLF); float* dlb = (float*)(WS(P) + O_DLB);
  const float* lbt = P.in[28];
  float* totF = (float*)smem;
  float* totB = totF + 1024;
  const int tid = TID(), lane = tid & 63, rg = tid >> 6;
  for (int item = BID(); item < 2048; item += gridDim.x) {
    const int cgi = item >> 3, ch = (item & 7) * 128 + lane * 2;
    const long t0 = (long)cgi * 64 + rg * 8;
    unsigned wq[8], wf[8], wb[8];
#pragma unroll
    for (int i = 0; i < 8; ++i) {
      const u16* row = pj + (t0 + i) * 5120 + ch;
      wq[i] = *(const unsigned*)row; wf[i] = *(const unsigned*)(row + 2048); wb[i] = *(const unsigned*)(row + 3072);
    }
    float lb0[2], lb1[2];
    lb0[0] = lb_of(lbt, 0, ch); lb0[1] = lb_of(lbt, 0, ch + 1);
    lb1[0] = lb_of(lbt, 1, ch); lb1[1] = lb_of(lbt, 1, ch + 1);
    float pf[2][8], sb[2][8], accf[2], accb[2];
#pragma unroll
    for (int c = 0; c < 2; ++c) {
      float a = 0.f;
#pragma unroll
      for (int i = 0; i < 8; ++i) {
        const float x = bf2f((u16)(c ? (wf[i] >> 16) : (wf[i] & 0xffff)));
        a += logf(lb0[c] + (1.f - lb0[c]) * sigm(x)); pf[c][i] = a;
      }
      accf[c] = a;
      a = 0.f;
#pragma unroll
      for (int i = 7; i >= 0; --i) {
        const float x = bf2f((u16)(c ? (wb[i] >> 16) : (wb[i] & 0xffff)));
        a += logf(lb1[c] + (1.f - lb1[c]) * sigm(x)); sb[c][i] = a;
      }
      accb[c] = a;
    }
    __syncthreads();
    *(float2*)(totF + rg * 128 + lane * 2) = make_float2(accf[0], accf[1]);
    *(float2*)(totB + rg * 128 + lane * 2) = make_float2(accb[0], accb[1]);
    __syncthreads();
    float offF[2] = {0.f, 0.f}, offB[2] = {0.f, 0.f}, totf[2] = {0.f, 0.f}, totb[2] = {0.f, 0.f};
#pragma unroll
    for (int g = 0; g < 8; ++g) {
      const float2 f = *(const float2*)(totF + g * 128 + lane * 2), bq = *(const float2*)(totB + g * 128 + lane * 2);
      totf[0] += f.x; totf[1] += f.y; totb[0] += bq.x; totb[1] += bq.y;
      if (g < rg) { offF[0] += f.x; offF[1] += f.y; }
      if (g > rg) { offB[0] += bq.x; offB[1] += bq.y; }
    }
#pragma unroll
    for (int i = 0; i < 8; ++i) {
      float o[6][2];
#pragma unroll
      for (int c = 0; c < 2; ++c) {
        const float xq = bf2f((u16)(c ? (wq[i] >> 16) : (wq[i] & 0xffff)));
        const float xf = bf2f((u16)(c ? (wf[i] >> 16) : (wf[i] & 0xffff)));
        const float xb = bf2f((u16)(c ? (wb[i] >> 16) : (wb[i] & 0xffff)));
        const float q = silu_f(xq);
        const float bf = offF[c] + pf[c][i], bb = offB[c] + sb[c][i];
        const float kf = (1.f - lb0[c]) * sigm(-xf), kb = (1.f - lb1[c]) * sigm(-xb);
        o[0][c] = q * expf(bf); o[1][c] = kf * expf(-bf); o[2][c] = kf * expf(totf[c] - bf);
        o[3][c] = q * expf(bb); o[4][c] = kb * expf(-bb); o[5][c] = kb * expf(totb[c] - bb);
      }
      const long oo = (t0 + i) * 1024 + ch;
      *(unsigned*)(qdf + oo) = pack2(o[0][0], o[0][1]);
      *(unsigned*)(kif + oo) = pack2(o[1][0], o[1][1]);
      *(unsigned*)(kef + oo) = pack2(o[2][0], o[2][1]);
      *(unsigned*)(qdb + oo) = pack2(o[3][0], o[3][1]);
      *(unsigned*)(kib + oo) = pack2(o[4][0], o[4][1]);
      *(unsigned*)(keb + oo) = pack2(o[5][0], o[5][1]);
    }
    if (rg == 0) {
      *(float2*)(dlf + (long)cgi * 1024 + ch) = make_float2(expf(totf[0]), expf(totf[1]));
      *(float2*)(dlb + (long)cgi * 1024 + ch) = make_float2(expf(totb[0]), expf(totb[1]));
    }
  }
  __syncthreads();
}

template <int C>
__device__ __forceinline__ void rec_scores_item(const Params& P, const Rec& R, int cgi, int h, int ti, int tj) {
  constexpr int T = C > 128 ? 128 : C, KTS = (C >= 128 ? 4 : 2);
  const u16* qdf = (const u16*)(WS(P) + O_QDF); const u16* qdb = (const u16*)(WS(P) + O_QDB);
  const u16* kif = (const u16*)(WS(P) + O_KIF); const u16* kib = (const u16*)(WS(P) + O_KIB);
  u16* sc = (u16*)(WS(P) + O_SC) + (((long)cgi * R.H + h) * C + ti * T) * C + tj * T;
  const long offA = ((long)cgi * C + ti * T) * 1024 + h * R.DK, offB = ((long)cgi * C + tj * T) * 1024 + h * R.DK;
  f32x4 af[T / 32][T / 64] = {}, ab[T / 32][T / 64] = {};
  if (ti >= tj) gemm_acc<T, T, true, true, true, KTS>(af, qdf + offA, 1024, kif + offB, 1024, (u16*)smem);
  if (ti <= tj) gemm_acc<T, T, true, true, true, KTS>(ab, qdb + offA, 1024, kib + offB, 1024, (u16*)smem);
  const int tid = TID(), lane = tid & 63, wid = tid >> 6;
  const int wm = wid >> 2, wn = wid & 3, fr = lane & 15, fq = lane >> 4;
#pragma unroll
  for (int mi = 0; mi < T / 32; ++mi)
#pragma unroll
    for (int ni = 0; ni < T / 64; ++ni) {
      const int r = wm * (T / 2) + mi * 16 + fr, c0 = wn * (T / 4) + ni * 16 + fq * 4;
      const int gr = ti * T + r;
      float v[4];
#pragma unroll
      for (int j = 0; j < 4; ++j) {
        const int gc = tj * T + c0 + j;
        v[j] = (gc <= gr ? af[mi][ni][j] : 0.f) + (gc >= gr ? ab[mi][ni][j] : 0.f);
      }
      *(uint2*)(sc + r * C + c0) = make_uint2(pack2(v[0], v[1]), pack2(v[2], v[3]));
    }
}

template <int C>
__device__ void phase_rec_su(const Params& P, int kind) {
  const Rec R = rec_of(kind);
  constexpr int KTU = C / 64;
  const int nch = SLAB / C;
  constexpr int NT1 = (C > 128 ? C / 128 : 1), NTT = NT1 * NT1;
  const int n_sc = nch * R.H * NTT;
  const int mtn = R.DK / 128, ntn = R.DV / 128;
  const int n_u = nch * R.H * 2 * mtn * ntn, G = gridDim.x;
  const u16* pj = (const u16*)(WS(P) + O_PROJ);
  for (int item = BID(); item < n_sc; item += G) { const int tl = item % NTT, hh = (item / NTT) % R.H, cg = item / (NTT * R.H); rec_scores_item<C>(P, R, cg, hh, tl / NT1, tl % NT1); }
  const u16* kef = (const u16*)(WS(P) + O_KEF); const u16* keb = (const u16*)(WS(P) + O_KEB);
  u16* stfb = (u16*)(WS(P) + O_STF); u16* stbb = (u16*)(WS(P) + O_STB);
  Tiles<KTU> ta, tb;
#define U_DECODE(q_, nt_, mt_, dir_, h_, cgi_) int nt_, mt_, dir_, h_, cgi_; { int qq = (q_); nt_ = qq % ntn; qq /= ntn; mt_ = qq % mtn; qq /= mtn; dir_ = qq & 1; qq >>= 1; h_ = qq % R.H; cgi_ = qq / R.H; }
#define U_ISSUE(T_, nt_, mt_, dir_, h_, cgi_) tiles_issue<128, 128, false, false, KTU>(T_, (dir_ ? keb : kef) + (long)cgi_ * C * 1024 + h_ * R.DK + mt_ * 128, 1024, pj + (long)cgi_ * C * R.ldv + R.voff + h_ * R.DV + nt_ * 128, R.ldv)
#define U_RUN(T_, nt_, mt_, dir_, h_, cgi_) { f32x4 acc[4][2] = {}; gemm_run<128, 128, false, false, false, KTU>(acc, T_, (u16*)smem); \
    u16* st = (dir_ ? stbb : stfb) + (((long)cgi_ * R.H + h_) * R.DV + nt_ * 128) * R.DK + mt_ * 128; const int DK = R.DK; \
    epi_each<128, 128, false>(acc, [&](int r, int c, f32x4 val) { *(uint2*)(st + (long)c * DK + r) = make_uint2(pack2(val[0], val[1]), pack2(val[2], val[3])); }); }
  int q = BID();
  if (q < n_u) { U_DECODE(q, nt, mt, dir, h, cgi); U_ISSUE(ta, nt, mt, dir, h, cgi); }
  for (; q < n_u; q += 2 * G) {
    U_DECODE(q, nt, mt, dir, h, cgi);
    const int q2 = q + G;
    if (q2 < n_u) { U_DECODE(q2, nt2, mt2, dir2, h2, cgi2); U_ISSUE(tb, nt2, mt2, dir2, h2, cgi2); }
    U_RUN(ta, nt, mt, dir, h, cgi);
    const int q3 = q + 2 * G;
    if (q3 < n_u) { U_DECODE(q3, nt3, mt3, dir3, h3, cgi3); U_ISSUE(ta, nt3, mt3, dir3, h3, cgi3); }
    if (q2 < n_u) { U_DECODE(q2, nt2, mt2, dir2, h2, cgi2); U_RUN(tb, nt2, mt2, dir2, h2, cgi2); }
  }
#undef U_DECODE
#undef U_ISSUE
#undef U_RUN
  __syncthreads();
}

__device__ void phase_rec_scan(const Params& P, int kind, int slab, bool dry = false) {
  const Rec R = rec_of(kind);
  const int L = Lof(slab), nseq = SLAB / L, ncs = L / R.C;
  const int qdk = R.DK / 4;
  const long per = (long)R.H * R.DV * qdk;
  const long total = 2 * nseq * per;
  const long gtid = (long)BID() * NT + TID(), gsz = (long)gridDim.x * NT;
  for (long idx = gtid; idx < total; idx += gsz) {
    long q = idx;
    const int pd = (int)(q % qdk); q /= qdk;
    const int e = (int)(q % R.DV); q /= R.DV;
    const int h = (int)(q % R.H); q /= R.H;
    const int seq = (int)(q % nseq);
    const int dir = (int)(q / nseq);
    u16* st = (u16*)(WS(P) + (dir ? O_STB : O_STF));
    u16* stw = dry ? (u16*)(WS(P) + O_OBUF) : st;
    const float* dl = (const float*)(WS(P) + (dir ? O_DLB : O_DLF));
    float s0 = 0.f, s1 = 0.f, s2 = 0.f, s3 = 0.f;
    const long ebase = ((long)h * R.DV + e) * R.DK + pd * 4;
    const long cstride = (long)R.H * R.DV * R.DK;
    const int dbase = h * R.DK + pd * 4;
    for (int i0 = 0; i0 < ncs; i0 += 8) {
      uint2 u[8];
      float4 dd[8];
#pragma unroll
      for (int j = 0; j < 8; ++j) {
        const int n = dir ? (ncs - 1 - i0 - j) : (i0 + j);
        const long cgi = (long)seq * ncs + n;
        u[j] = *(const uint2*)(st + cgi * cstride + ebase);
        dd[j] = *(const float4*)(dl + cgi * 1024 + dbase);
      }
#pragma unroll
      for (int j = 0; j < 8; ++j) {
        const int n = dir ? (ncs - 1 - i0 - j) : (i0 + j);
        const long cgi = (long)seq * ncs + n;
        *(uint2*)(stw + cgi * cstride + ebase) = make_uint2(pack2(s0, s1), pack2(s2, s3));
        s0 = dd[j].x * s0 + bf2f((u16)(u[j].x & 0xffff));
        s1 = dd[j].y * s1 + bf2f((u16)(u[j].x >> 16));
        s2 = dd[j].z * s2 + bf2f((u16)(u[j].y & 0xffff));
        s3 = dd[j].w * s3 + bf2f((u16)(u[j].y >> 16));
      }
    }
  }
}

template <int C>
__device__ void phase_rec_out(const Params& P, int kind) {
  const Rec R = rec_of(kind);
  constexpr int T = C > 128 ? 128 : C, NRT = C / T;
  constexpr int KT1 = C / 64, KT2 = (C >= 128 ? 4 : 2);
  const int nch = SLAB / C, ntn = R.DV / 128;
  const u16* pj = (const u16*)(WS(P) + O_PROJ);
  const u16* scb = (const u16*)(WS(P) + O_SC);
  const u16* qdf = (const u16*)(WS(P) + O_QDF); const u16* qdb = (const u16*)(WS(P) + O_QDB);
  const u16* stf = (const u16*)(WS(P) + O_STF); const u16* stb = (const u16*)(WS(P) + O_STB);
  u16* ob = (u16*)(WS(P) + O_OBUF);
  const int HDV = R.H * R.DV;
  const int nitems = nch * R.H * NRT * ntn, G = gridDim.x;
  Tiles<KT1> t1; Tiles<KT2> t2; Tiles<KT2> t3;
  int item = BID();
  if (item < nitems) {
    const int nt = item % ntn, rt = (item / ntn) % NRT, h = (item / (ntn * NRT)) % R.H, cgi = item / (ntn * NRT * R.H);
    tiles_issue<T, 128, true, false, KT1>(t1, scb + (((long)cgi * R.H + h) * C + rt * T) * C, C, pj + (long)cgi * C * R.ldv + R.voff + h * R.DV + nt * 128, R.ldv);
  }
  for (; item < nitems; item += G) {
    const int nt = item % ntn, rt = (item / ntn) % NRT, h = (item / (ntn * NRT)) % R.H, cgi = item / (ntn * NRT * R.H);
    const long qoff = ((long)cgi * C + rt * T) * 1024 + h * R.DK;
    const long soff = (((long)cgi * R.H + h) * R.DV + nt * 128) * R.DK;
    f32x4 acc[T / 32][2] = {};
    tiles_issue<T, 128, true, true, KT2>(t2, qdf + qoff, 1024, stf + soff, R.DK);
    gemm_run<T, 128, true, false, true, KT1>(acc, t1, (u16*)smem);
    tiles_issue<T, 128, true, true, KT2>(t3, qdb + qoff, 1024, stb + soff, R.DK);
    gemm_run<T, 128, true, true, true, KT2>(acc, t2, (u16*)smem);
    const int nx = item + G;
    if (nx < nitems) {
      const int nt2 = nx % ntn, rt2 = (nx / ntn) % NRT, h2 = (nx / (ntn * NRT)) % R.H, cg2 = nx / (ntn * NRT * R.H);
      tiles_issue<T, 128, true, false, KT1>(t1, scb + (((long)cg2 * R.H + h2) * C + rt2 * T) * C, C, pj + (long)cg2 * C * R.ldv + R.voff + h2 * R.DV + nt2 * 128, R.ldv);
    }
    gemm_run<T, 128, true, true, true, KT2>(acc, t3, (u16*)smem);
    u16* o = ob + ((long)cgi * C + rt * T) * HDV + h * R.DV + nt * 128;
    epi_each<T, 128, true>(acc, [&](int r, int c, f32x4 val) { *(uint2*)(o + (long)r * HDV + c) = make_uint2(pack2(val[0], val[1]), pack2(val[2], val[3])); });
  }
  __syncthreads();
}

template <int KIND>
__device__ void phase_rec_ng_t(const Params& P) {
  const Rec R = rec_of(KIND);
  constexpr int DV = (KIND == 1) ? 512 : 128, H = (KIND == 1) ? 4 : 8, PER = DV / 64, HDV = H * DV;
  const u16* __restrict__ ob = (const u16*)(WS(P) + O_OBUF);
  const u16* __restrict__ pj = (const u16*)(WS(P) + O_PROJ);
  u16* __restrict__ a2 = (u16*)(WS(P) + O_A2);
  const float* gain = P.in[29];
  const int tid = TID(), lane = tid & 63, wid = tid >> 6;
  constexpr int nrows = SLAB * H;
  for (int item = BID(); item < nrows / 32; item += gridDim.x) {
    float v[4][PER];
    float ss[4];
#pragma unroll
    for (int u = 0; u < 4; ++u) {
      const int rh = item * 32 + wid * 4 + u;
      const int t = rh / H, h = rh % H;
      const u16* o = ob + (long)t * HDV + h * DV + lane * PER;
      if (PER == 8) {
        float f8[8];
        unpack8(*(const uint4*)o, f8);
#pragma unroll
        for (int i = 0; i < 8; ++i) v[u][i % PER] = f8[i];
      } else {
        const unsigned w = *(const unsigned*)o;
        v[u][0] = bf2f((u16)(w & 0xffff)); v[u][1 % PER] = bf2f((u16)(w >> 16));
      }
      float a = 0.f;
#pragma unroll
      for (int i = 0; i < PER; ++i) a += v[u][i] * v[u][i];
      ss[u] = a;
    }
#pragma unroll
    for (int u = 0; u < 4; ++u) ss[u] = wave_sum(ss[u]);
#pragma unroll
    for (int u = 0; u < 4; ++u) {
      const int rh = item * 32 + wid * 4 + u;
      const int t = rh / H, h = rh % H;
      const float rstd = rsqrtf(ss[u] / (float)DV + 1e-6f);
      const u16* g = pj + (long)t * R.ldv + R.goff + h * DV + lane * PER;
      u16* out = a2 + (long)t * HDV + h * DV + lane * PER;
      float y[PER];
#pragma unroll
      for (int i = 0; i < PER; ++i) {
        y[i] = v[u][i] * rstd;
        if (KIND == 3) y[i] *= gain[lane * PER + i];
      }
      if (PER == 8) {
        const uint4 gw = *(const uint4*)g;
        float gf[8];
        unpack8(gw, gf);
        float r8[8];
#pragma unroll
        for (int i = 0; i < 8; ++i) r8[i] = y[i % PER] * silu_f(gf[i]);
        *(uint4*)out = pack8s(r8, 1.f);
      } else {
        const unsigned gw = *(const unsigned*)g;
        *(unsigned*)out = pack2(y[0] * silu_f(bf2f((u16)(gw & 0xffff))), y[1 % PER] * silu_f(bf2f((u16)(gw >> 16))));
      }
    }
  }
}
__device__ void phase_rec_ng(const Params& P, int kind) {
  if (kind == 1) phase_rec_ng_t<1>(P); else phase_rec_ng_t<3>(P);
}

__device__ void phase_swa_prep(const Params& P, int slab) {
  const int L = Lof(slab);
  const u16* pj = (const u16*)(WS(P) + O_PROJ);
  u16* qn = (u16*)(WS(P) + O_QN);
  u16* kn = (u16*)(WS(P) + O_KN);
  const float2* rope = (const float2*)(WS(P) + O_ROPES);
  const long gtid = (long)BID() * NT + TID(), gsz = (long)gridDim.x * NT;
  for (long idx = gtid; idx < (long)SLAB * 640; idx += gsz) {
    const int d = (int)(idx & 31);
    const int hd = (int)((idx >> 5) % 20);
    const int t = (int)(idx / 640);
    const int col = hd < 16 ? hd * 64 : 1024 + (hd - 16) * 64;
    const float x1 = bf2f(pj[(long)t * 1536 + col + d]), x2 = bf2f(pj[(long)t * 1536 + col + d + 32]);
    float ss = x1 * x1 + x2 * x2;
#pragma unroll
    for (int o = 16; o; o >>= 1) ss += __shfl_xor(ss, o);
    const float rstd = rsqrtf(ss * (1.f / 64.f) + 1e-6f);
    const float* gn = hd < 16 ? P.in[23] : P.in[24];
    const float y1 = x1 * rstd * gn[d], y2 = x2 * rstd * gn[d + 32];
    const float2 cs = rope[(long)(t & (L - 1)) * 32 + d];
    float o1 = y1 * cs.x - y2 * cs.y, o2 = y1 * cs.y + y2 * cs.x;
    if (hd < 16) {
      qn[(long)t * 1024 + hd * 64 + d] = f2bf(o1 * 0.125f);
      qn[(long)t * 1024 + hd * 64 + d + 32] = f2bf(o2 * 0.125f);
    } else {
      kn[(long)t * 256 + (hd - 16) * 64 + d] = f2bf(o1);
      kn[(long)t * 256 + (hd - 16) * 64 + d + 32] = f2bf(o2);
    }
  }
}

constexpr int SLD = 324;
__device__ void phase_swa_att(const Params& P, int slab) {
  const int L = Lof(slab), nqb = L / 64;
  const u16* qn = (const u16*)(WS(P) + O_QN);
  const u16* kn = (const u16*)(WS(P) + O_KN);
  const u16* pj = (const u16*)(WS(P) + O_PROJ);
  u16* a2 = (u16*)(WS(P) + O_A2);
  const float* sink = P.in[25];
  float* S = (float*)(smem + 40960);
  u16* Bs = (u16*)smem + 9216;
  const int tid = TID(), lane = tid & 63, wid = tid >> 6;
  const int wm = wid >> 2, wn = wid & 3, fr = lane & 15, fq = lane >> 4;
  const int nitems = (SLAB / 64) * 16;
  for (int item = BID(); item < nitems; item += gridDim.x) {
    const int hq = item & 15, qbg = item >> 4;
    const int seq = qbg / nqb, qb = qbg % nqb;
    const int q0 = qb * 64;
    const long tok0 = (long)seq * L;
    const int hkv = hq >> 2;
    uint4 vt[5];
#pragma unroll
    for (int kt = 0; kt < 5; ++kt) {
      const int kp0 = q0 - 128 + kt * 64;
      vt[kt] = make_uint4(0, 0, 0, 0);
      if (kp0 >= 0 && kp0 < L) vt[kt] = ld_chunk<64, false>(pj + (tok0 + kp0) * 1536 + 1280 + hkv * 64, 1536, 0, tid);
    }
    for (int kt = 0; kt < 5; ++kt) {
      const int kp0 = q0 - 128 + kt * 64;
      if (kp0 >= 0 && kp0 < L) {
        f32x4 acc[2][1] = {};
        gemm_acc<64, 64, true, true, true, 1>(acc, qn + (tok0 + q0) * 1024 + hq * 64, 1024, kn + (tok0 + kp0) * 256 + hkv * 64, 256, (u16*)smem);
        epi_each<64, 64, true>(acc, [&](int r, int c, f32x4 v) {
          f32x4 o;
#pragma unroll
          for (int j = 0; j < 4; ++j) {
            const int dlt = (q0 + r) - (kp0 + c + j);
            o[j] = (dlt <= 128 && dlt >= -128) ? v[j] : -1e30f;
          }
          *(f32x4*)(S + r * SLD + kt * 64 + c) = o;
        });
      } else {
        for (int i = tid; i < 4096; i += NT) S[(i >> 6) * SLD + kt * 64 + (i & 63)] = -1e30f;
      }
    }
    __syncthreads();
    {
      const int r = tid >> 3, sub = tid & 7;
      const float sk = sink[hq];
      float e[40];
      float m = sk;
#pragma unroll
      for (int i = 0; i < 40; ++i) { e[i] = S[r * SLD + sub + 8 * i]; m = fmaxf(m, e[i]); }
      m = fmaxf(m, __shfl_xor(m, 1)); m = fmaxf(m, __shfl_xor(m, 2)); m = fmaxf(m, __shfl_xor(m, 4));
      float den = 0.f;
#pragma unroll
      for (int i = 0; i < 40; ++i) { e[i] = __expf(e[i] - m); den += e[i]; }
      den += __shfl_xor(den, 1); den += __shfl_xor(den, 2); den += __shfl_xor(den, 4);
      den += __expf(sk - m);
      const float inv = 1.f / den;
      u16* prow = (u16*)(S + r * SLD);
#pragma unroll
      for (int i = 0; i < 40; ++i) prow[sub + 8 * i] = f2bf(e[i] * inv);
    }
    __syncthreads();
    f32x4 acc[2][1] = {};
#pragma unroll
    for (int kt = 0; kt < 5; ++kt) {
      const int kp0 = q0 - 128 + kt * 64;
      if (kp0 >= 0 && kp0 < L) {
        __syncthreads();
        st_chunk<64, false>(Bs, vt[kt], tid);
        __syncthreads();
#pragma unroll
        for (int ks = 0; ks < 2; ++ks) {
          bf16x8 af[2];
#pragma unroll
          for (int mi = 0; mi < 2; ++mi) af[mi] = *(const bf16x8*)((const u16*)(S + (wm * 32 + mi * 16 + fr) * SLD) + kt * 64 + ks * 32 + fq * 8);
          const bf16x8 bfr = ld_frag<64, false>(Bs, wn * 16, ks, fr, fq);
#pragma unroll
          for (int mi = 0; mi < 2; ++mi) acc[mi][0] = __builtin_amdgcn_mfma_f32_16x16x32_bf16(bfr, af[mi], acc[mi][0], 0, 0, 0);
        }
      }
    }
    u16* o = a2 + (tok0 + q0) * 1024 + hq * 64;
    epi_each<64, 64, true>(acc, [&](int r, int c, f32x4 v) { *(uint2*)(o + (long)r * 1024 + c) = make_uint2(pack2(v[0], v[1]), pack2(v[2], v[3])); });
    __syncthreads();
  }
}

#define XB_TMO      128
#define XB_XCNT(j)  (256  + 64 * (j))
#define XB_XSUB(j)  (1280 + 64 * (j))
#define XB_XGEN(j)  (2304 + 64 * (j))
#define XB_TOP      3328
#define XB_TOPGEN   3392
#define XCD_BAR_WORDS 3456
#define XB_SPIN_CAP (1u << 18)
__device__ __forceinline__ unsigned xb_ld(unsigned* p)              { return __hip_atomic_load(p, __ATOMIC_RELAXED, __HIP_MEMORY_SCOPE_AGENT); }
__device__ __forceinline__ unsigned xb_add(unsigned* p, unsigned v) { return __hip_atomic_fetch_add(p, v, __ATOMIC_RELAXED, __HIP_MEMORY_SCOPE_AGENT); }
__device__ __forceinline__ unsigned xb_xcc_id() { return (unsigned)__builtin_amdgcn_s_getreg((3 << 11) | 20) & 0xFu; }
#define XB_SPIN(cond, bar) do { unsigned _sp = 0; while (cond) { __builtin_amdgcn_s_sleep(1); \
    if ((++_sp & 255u) == 0u) { if (xb_ld(&(bar)[XB_TMO])) break; if (_sp > XB_SPIN_CAP) { atomicAdd(&(bar)[XB_TMO], 1u); break; } } } } while (0)
struct XcdBarrier { unsigned* bar; unsigned x; volatile LDS_AS unsigned* st; };
__device__ __forceinline__ XcdBarrier xcd_barrier_post(unsigned* bar, volatile LDS_AS unsigned* st) {
    XcdBarrier b; b.bar = bar; b.x = xb_xcc_id(); b.st = st;
    if (threadIdx.x == 0) (void)xb_add(&bar[XB_XCNT(b.x)], 1u);
    return b;
}
__device__ __forceinline__ void xcd_barrier_complete(unsigned* bar, unsigned x, unsigned& nloc, unsigned& nx) {
    const unsigned G = gridDim.x * gridDim.y * gridDim.z;
    unsigned sum, cnt, mine, sp = 0u;
    for (;;) {
        sum = 0u; cnt = 0u; mine = 0u;
#pragma unroll
        for (unsigned j = 0; j < 16; ++j) { const unsigned c = xb_ld(&bar[XB_XCNT(j)]); sum += c; cnt += (c > 0u) ? 1u : 0u; mine = (j == x) ? c : mine; }
        if (sum == G) break;
        __builtin_amdgcn_s_sleep(1);
        if ((++sp & 255u) == 0u) { if (xb_ld(&bar[XB_TMO])) break; if (sp > XB_SPIN_CAP) { atomicAdd(&bar[XB_TMO], 1u); break; } }
    }
    nloc = mine > 0u ? mine : 1u; nx = cnt > 0u ? cnt : 1u;
}
__device__ __forceinline__ void xcd_barrier(const XcdBarrier& b) {
    asm volatile("s_waitcnt vmcnt(0)" ::: "memory");
    __syncthreads();
    if (threadIdx.x == 0) {
        unsigned* bar = b.bar;
        __builtin_amdgcn_s_waitcnt(0);
        unsigned nloc = b.st[0], nx = b.st[1];
        if (nloc == 0u) { xcd_barrier_complete(bar, b.x, nloc, nx); b.st[0] = nloc; b.st[1] = nx; }
        const unsigned old = xb_add(&bar[XB_XSUB(b.x)], 1u);
        const unsigned gen = old / nloc;
        if (old + 1u == (gen + 1u) * nloc) {
            __builtin_amdgcn_fence(__ATOMIC_RELEASE, "agent");
            asm volatile("s_waitcnt vmcnt(0)" ::: "memory");
            const unsigned og = xb_add(&bar[XB_TOP], 1u);
            const unsigned tg = og / nx;
            if (og + 1u == (tg + 1u) * nx) xb_add(&bar[XB_TOPGEN], 1u);
            else XB_SPIN(xb_ld(&bar[XB_TOPGEN]) == tg, bar);
            __builtin_amdgcn_fence(__ATOMIC_ACQUIRE, "agent");
            xb_add(&bar[XB_XGEN(b.x)], 1u);
            asm volatile("s_waitcnt vmcnt(0)" ::: "memory");
        } else {
            XB_SPIN(xb_ld(&bar[XB_XGEN(b.x)]) == gen, bar);
            __builtin_amdgcn_fence(__ATOMIC_ACQUIRE, "agent");
            asm volatile("s_waitcnt vmcnt(0)" ::: "memory");
        }
    }
    __syncthreads();
}

__device__ __forceinline__ int nmix_of(int kind) { return (kind & 1) ? 8 : (kind == 2 ? 5 : 6); }

__device__ void ffn_step(const Params& P, int layer, int f) {
  if (f == 6) { phase_ffn_down(P, layer); return; }
  const int fs = f / 3, st = f % 3;
  if (st == 0) { REP(4) phase_norm(P, layer, fs, 1); }
  else if (st == 1) { REP(0) phase_ffn_gate(P, layer); }
  else { REP(0) phase_ffn_val(P, layer, fs); }
}
__device__ void layer_step(const Params& P, int layer, int slab, int step) {
  const int kind = layer;
  if (step == 0) { REP(4) phase_norm(P, layer, slab, 0); return; }
  if (kind == 0) {
    if (step == 1) { REP(0) phase_proj(P, O_WHYIN, 3072); }
    else if (step == 2) { REP(3) phase_hy_conv(P, slab); }
    else if (step == 3) { if ((PROBE_MASK >> 7) & 1) phase_hy_fft(P, slab, true); phase_hy_fft(P, slab); }
    else if (step == 4) { REP(3) phase_hy_tr(P, slab); }
    else phase_resid(P, layer, slab, (const u16*)(WS(P) + O_A2), 1024, O_WHYOUT, 2 * D);
  } else if (kind == 1) {
    if (step == 1) { REP(0) phase_proj(P, O_WRETIN, 6144); }
    else if (step == 2) { REP(1) REP(9) phase_ret_prep(P, slab); }
    else if (step == 3) { REP(1) REP(11) phase_rec_su<256>(P, 1); }
    else if (step == 4) { if ((PROBE_MASK >> 6) & 1) phase_rec_scan(P, 1, slab, true); phase_rec_scan(P, 1, slab); }
    else if (step == 5) { REP(1) REP(12) phase_rec_out<256>(P, 1); }
    else if (step == 6) { REP(1) REP(9) phase_rec_ng(P, 1); }
    else phase_resid(P, layer, slab, (const u16*)(WS(P) + O_A2), 2048, O_WRETOUT, 2 * D);
  } else if (kind == 2) {
    if (step == 1) { REP(0) phase_proj(P, O_WSWAIN, 1536); }
    else if (step == 2) { REP(2) REP(14) phase_swa_prep(P, slab); }
    else if (step == 3) { REP(2) REP(15) phase_swa_att(P, slab); }
    else phase_resid(P, layer, slab, (const u16*)(WS(P) + O_A2), 1024, O_WSWAOUT, 2 * D);
  } else {
    if (step == 1) { REP(0) phase_proj(P, O_WHGIN, 5120); }
    else if (step == 2) { REP(1) REP(9) phase_hg_prep(P); }
    else if (step == 3) { REP(1) REP(11) phase_rec_su<64>(P, 3); }
    else if (step == 4) { if ((PROBE_MASK >> 6) & 1) phase_rec_scan(P, 3, slab, true); phase_rec_scan(P, 3, slab); }
    else if (step == 5) { REP(1) REP(12) phase_rec_out<64>(P, 3); }
    else if (step == 6) { REP(1) REP(9) phase_rec_ng(P, 3); }
    else phase_resid(P, layer, slab, (const u16*)(WS(P) + O_A2), 1024, O_WHGOUT, 2 * D);
  }
}

__global__ void __launch_bounds__(NT) fwd_megakernel(Params P) {
  cg::grid_group grid = cg::this_grid();
  __shared__ uint4 xb_words;
  if (threadIdx.x == 0) xb_words = make_uint4(0u, 0u, 0u, 0u);
  __syncthreads();
  XcdBarrier xb = xcd_barrier_post((unsigned*)(P.ws + O_BAR), (volatile LDS_AS unsigned*)&xb_words);
  for (int pid = P.p0; pid < P.p1; ++pid) {
    if (pid == 0) { REP(5) phase_pre0(P); }
    else if (pid == 1) { REP(5) phase_pre1(P); }
    else {
      int q = pid - 2, layer = 0;
      while (q >= 5 * nmix_of(layer) + 7) { q -= 5 * nmix_of(layer) + 7; ++layer; }
      const int nm = nmix_of(layer);
      if (q < 5 * nm) layer_step(P, layer, q / nm, q % nm);
      else ffn_step(P, layer, q - 5 * nm);
    }
    if (pid + 1 < P.p1) {
      if (pid == 0) grid.sync();
      else xcd_barrier(xb);
      if ((PROBE_MASK >> 8) & 1) xcd_barrier(xb);
    }
  }
}

extern "C" void kernel_launch(void* const* d_in, const int* in_sizes, int n_in, void* d_out, int out_size, void* d_ws,
                              size_t ws_size, hipStream_t stream) {
  static int grid_blocks = 0;
  if (!grid_blocks) {
    int dev = 0, cus = 0, per_cu = 0;
    (void)hipGetDevice(&dev);
    (void)hipDeviceGetAttribute(&cus, hipDeviceAttributeMultiprocessorCount, dev);
    (void)hipFuncSetAttribute((const void*)fwd_megakernel, hipFuncAttributeMaxDynamicSharedMemorySize, LDSB);
    (void)hipOccupancyMaxActiveBlocksPerMultiprocessor(&per_cu, (const void*)fwd_megakernel, NT, LDSB);
    if (per_cu < 1) per_cu = 1;
    if (per_cu > 1) per_cu = 1;
    grid_blocks = cus * per_cu;
    if (ws_size < WS_END) fprintf(stderr, "kernel_launch: workspace too small: %zu < %zu\n", ws_size, (size_t)WS_END);
  }
  Params p;
  memset(&p, 0, sizeof(p));
  for (int i = 0; i < 36; ++i) p.in[i] = (const float*)d_in[i];
  p.out = (float*)d_out;
  p.ws = (unsigned char*)d_ws;
  (void)hipMemsetAsync((unsigned char*)d_ws + O_BAR, 0, XCD_BAR_WORDS * 4, stream);
#if ONE_LAUNCH
  p.p0 = 0; p.p1 = NPHASES;
  void* args[] = {&p};
  hipError_t e = hipLaunchCooperativeKernel((const void*)fwd_megakernel, dim3(grid_blocks), dim3(NT), args, LDSB, stream);
  if (e != hipSuccess) fprintf(stderr, "cooperative launch failed: %s (grid %d)\n", hipGetErrorString(e), grid_blocks);
#else
  for (int ph = 0; ph < NPHASES; ++ph) {
    p.p0 = ph; p.p1 = ph + 1;
    hipLaunchKernelGGL(fwd_megakernel, dim3(grid_blocks), dim3(NT), LDSB, stream, p);
  }
#endif
}
```

```cpp
#include <hip/hip_runtime.h>
#include <hip/hip_cooperative_groups.h>
#include <cstdio>
#include <cstdint>
#include <cstring>
namespace cg = cooperative_groups;

typedef unsigned short u16;
typedef __attribute__((ext_vector_type(8))) short bf16x8;
typedef __attribute__((ext_vector_type(4))) float f32x4;

#define NT 512
#ifndef ONE_LAUNCH
#define ONE_LAUNCH 1
#endif
#ifndef PROBE_MASK
#define PROBE_MASK 0
#endif
#define REP(cls) for (int rep_##cls = 0; rep_##cls < (((PROBE_MASK >> (cls)) & 1) ? 2 : 1); ++rep_##cls)

constexpr int D = 1024, SLAB = 16384, DFF = 2816;
constexpr int LDSB = 139264;
constexpr int FSLAB = 40960, NTOK = 81920;
constexpr int NPHASES = 2 + 5 * (6 + 8 + 5 + 8) + 4 * 7;

constexpr size_t SZW(size_t n, size_t k) { return n * k * 2; }
constexpr size_t O_WHYIN = 0;
constexpr size_t O_WHYOUT = O_WHYIN + SZW(3072, 1024);
constexpr size_t O_WRETIN = O_WHYOUT + SZW(1024, 1024);
constexpr size_t O_WRETOUT = O_WRETIN + SZW(6144, 1024);
constexpr size_t O_WSWAIN = O_WRETOUT + SZW(1024, 2048);
constexpr size_t O_WSWAOUT = O_WSWAIN + SZW(1536, 1024);
constexpr size_t O_WHGIN = O_WSWAOUT + SZW(1024, 1024);
constexpr size_t O_WHGOUT = O_WHGIN + SZW(5120, 1024);
constexpr size_t O_WFG = O_WHGOUT + SZW(1024, 1024);
constexpr size_t O_WFV = O_WFG + 4 * SZW(2816, 1024);
constexpr size_t O_WFD = O_WFV + 4 * SZW(2816, 1024);
constexpr size_t O_MOD = O_WFD + 4 * SZW(1024, 2816);
constexpr size_t O_TW = O_MOD + (size_t)4 * 16 * 6144 * 4;
constexpr size_t O_HIDS = O_TW + 8192 * 8;
constexpr size_t O_HIDP = O_HIDS + (size_t)8192 * 64 * 4;
constexpr size_t O_ROPER = O_HIDP + (size_t)2048 * 64 * 4;
constexpr size_t O_ROPES = O_ROPER + (size_t)8192 * 128 * 8;
constexpr size_t O_PROJ = O_ROPES + (size_t)8192 * 32 * 8;
constexpr size_t O_HBUF = O_PROJ + (size_t)SLAB * 6144 * 2;
constexpr size_t O_A2 = O_HBUF + (size_t)SLAB * 1024 * 2;
constexpr size_t O_C = O_A2 + (size_t)SLAB * 2048 * 2;
constexpr size_t O_FHBUF = O_PROJ;
constexpr size_t O_FGBUF = O_FHBUF + (size_t)FSLAB * 1024 * 2;
constexpr size_t O_FACT = O_FGBUF + (size_t)FSLAB * DFF * 2;
constexpr size_t END_F = O_FACT + (size_t)NTOK * DFF * 2;
constexpr size_t O_MODP = O_C;
constexpr size_t O_BAR = ((size_t)1 << 30) - 16384;
constexpr size_t O_HSPS = O_BAR - (size_t)1024 * 16384 * 8 - (size_t)1024 * 4096 * 8;
constexpr size_t O_HSPP = O_HSPS + (size_t)1024 * 16384 * 8;
constexpr size_t O_UT = O_C;
constexpr size_t O_X0C = O_UT + (size_t)SLAB * 1024 * 4;
constexpr size_t END_HY = O_X0C + (size_t)SLAB * 1024 * 2;
static_assert(END_F <= O_HSPS && END_HY <= O_HSPS, "layer-0 buffers overlap the filter spectra");
constexpr size_t SZP = (size_t)SLAB * 1024 * 2;
constexpr size_t O_QDF = O_C, O_QDB = O_QDF + SZP, O_KIF = O_QDB + SZP, O_KIB = O_KIF + SZP, O_KEF = O_KIB + SZP, O_KEB = O_KEF + SZP;
constexpr size_t O_DLF = O_KEB + SZP;
constexpr size_t O_DLB = O_DLF + (size_t)256 * 1024 * 4;
constexpr size_t O_SC = O_DLB + (size_t)256 * 1024 * 4;
constexpr size_t O_STF = O_SC + (size_t)SLAB * 1024 * 2;
constexpr size_t O_STB = O_STF + (size_t)134217728;
constexpr size_t O_OBUF = O_STB + (size_t)134217728;
constexpr size_t END_REC = O_OBUF + (size_t)SLAB * 2048 * 4;
constexpr size_t O_QN = O_C;
constexpr size_t O_KN = O_QN + SZP;
constexpr size_t O_PBUF = O_KN + (size_t)SLAB * 256 * 2;
constexpr size_t END_SWA = O_PBUF + (size_t)SLAB * 16 * 320 * 2;
constexpr size_t WS_END = END_REC > END_HY ? (END_REC > END_SWA ? END_REC : END_SWA) : (END_HY > END_SWA ? END_HY : END_SWA);
static_assert(WS_END <= O_BAR, "workspace exceeds 1 GiB");

struct Params {
  const float* in[36];
  float* out;
  unsigned char* ws;
  int p0, p1;
};

extern __shared__ __attribute__((aligned(16))) unsigned char smem[];

__device__ __forceinline__ int TID() { int t = threadIdx.x; asm volatile("" : "+v"(t)); return t; }
__device__ __forceinline__ int BID() { int b = blockIdx.x; asm volatile("" : "+s"(b)); return b; }
__device__ __forceinline__ long ZOFF() { long z = 0; asm volatile("" : "+s"(z)); return z; }
__device__ __forceinline__ unsigned char* WS(const Params& P) { return P.ws + ZOFF(); }
__device__ __forceinline__ float* OUTP(const Params& P) { return P.out + ZOFF(); }

namespace pg8 {
#define PG8_LAS __attribute__((address_space(3)))
typedef unsigned short bf16_t;
typedef short bf16x8 __attribute__((ext_vector_type(8)));
typedef float f32x4 __attribute__((ext_vector_type(4)));
typedef unsigned u32x4 __attribute__((ext_vector_type(4)));
constexpr int BM = 256, BK = 64, HALF = 128, HTB = HALF * BK * 2  , STAGE_BYTES = 8 * HTB, NXCD = 8, WGM = 8;

__host__ __device__ __forceinline__ int lds_byte(int r, int c) { const int st = (r >> 4) * 2 + (c >> 5), rr = r & 15, cc = c & 31, ob = rr * 64 + cc * 2; return st * 1024 + (ob ^ (((ob >> 9) & 1) << 5)); }
__host__ __device__ __forceinline__ void stage_rc(int b, int& R, int& C) { const int st = b / 1024, sb = b % 1024, swz = sb ^ (((sb >> 9) & 1) << 5); R = (st >> 1) * 16 + swz / 64; C = (st & 1) * 32 + (swz % 64) / 2; }
__host__ __device__ __forceinline__ int perm32(int rho) { const int n = rho >> 4, i = rho & 15; return 8 * (i >> 2) + 4 * n + (i & 3); }

struct Unit { int pm, pn; };
struct Gemm { const bf16_t* A; const bf16_t* Bt; int M, N, K; };

struct StaticOrder {
    int nM, nN, nwg, G, c;
    __host__ __device__ void init(int M, int N, int G_, int c_) { nM = M / BM; nN = N / BM; nwg = nM * nN; G = G_; c = c_; }
    __host__ __device__ bool next(int i, Unit& u) const {
        const long L = (long)i * G + c; if (L >= nwg) return false;
        int wgid = (int)L; { const int q = nwg / NXCD, r = nwg % NXCD, xcd = wgid % NXCD, off = wgid / NXCD; wgid = (xcd < r ? xcd * (q + 1) : r * (q + 1) + (xcd - r) * q) + off; }
        const int nig = WGM * nN, gid = wgid / nig, fm = gid * WGM, gsz = (nM - fm) < WGM ? (nM - fm) : WGM;
        u.pm = fm + ((wgid % nig) % gsz); u.pn = (wgid % nig) / gsz; return true;
    }
    __device__ __forceinline__ void a_ready(const Unit&) const {}
    __device__ __forceinline__ void done(const Unit&) const {}
};

template <class Epi, class Sched, bool STAMP = false>
__device__ __forceinline__ void gemm_phase(PG8_LAS unsigned char* lds, const Gemm g, const Sched& S, const Epi& E, unsigned long long* stamps) {
    const int tid = TID(), wid = __builtin_amdgcn_readfirstlane(tid >> 6), lane = tid & 63, wr = wid >> 2, wc = wid & 3, fr = lane & 15, fq = lane >> 4;
    const int K = g.K, nt = K / BK;
    int ts_lo = 0, ts_hi = 0, nts = 0; const unsigned long long rt_entry = STAMP ? (unsigned long long)wall_clock64() : 0ull;
#define PG8_STAMP() do { if (STAMP && wid == 0 && nts < 64) { const unsigned long long _c = (unsigned long long)clock64(); \
        ts_lo = (lane == nts) ? (int)(unsigned)_c : ts_lo; ts_hi = (lane == nts) ? (int)(unsigned)(_c >> 32) : ts_hi; ++nts; } } while (0)
    PG8_STAMP();
    unsigned voffA[2], voffB[2];
#pragma unroll
    for (int i = 0; i < 2; ++i) { int R, C; stage_rc(tid * 16 + i * 8192, R, C); const int Rb = Epi::PERM ? ((R & ~31) + perm32(R & 31)) : R;
        voffA[i] = (unsigned)(R * K + C) * 2u; voffB[i] = (unsigned)(Rb * K + C) * 2u; }
    const size_t kstep = (size_t)(BK * 2);
    const size_t hstep = (size_t)HALF * K * 2;
    const size_t tstep = 2 * hstep;
    const unsigned ldsw = (unsigned)wid * 1024u;
    const int aoff = lds_byte(wr * 64 + fr, fq * 8), boff = lds_byte(wc * 32 + fr, fq * 8);
#define PG8_SA(b, h) (((b) * 2 + (h)) * HTB)
#define PG8_SB(b, h) ((4 + (b) * 2 + (h)) * HTB)
#define PG8_STAGE(bufoff, gbase, voff) do { _Pragma("unroll") for (int _i = 0; _i < 2; ++_i) \
        __builtin_amdgcn_global_load_lds((const unsigned*)((const char*)(gbase) + (voff)[_i]), (PG8_LAS unsigned*)(lds + (bufoff) + ldsw + _i * 8192), 16, 0, 0); } while (0)
#define PG8_LDA(dst, b, h) do { _Pragma("unroll") for (int m = 0; m < 4; ++m) _Pragma("unroll") for (int k = 0; k < 2; ++k) dst[m][k] = *(const PG8_LAS bf16x8*)(lds + PG8_SA(b, h) + aoff + m * 2048 + k * 1024); } while (0)
#define PG8_LDB(dst, b, h) do { _Pragma("unroll") for (int n = 0; n < 2; ++n) _Pragma("unroll") for (int k = 0; k < 2; ++k) dst[n][k] = *(const PG8_LAS bf16x8*)(lds + PG8_SB(b, h) + boff + n * 2048 + k * 1024); } while (0)
#define PG8_MMA(ai, bj, At, Bt) do { __builtin_amdgcn_s_setprio(1); _Pragma("unroll") for (int m = 0; m < 4; ++m) _Pragma("unroll") for (int n = 0; n < 2; ++n) _Pragma("unroll") for (int k = 0; k < 2; ++k) \
        acc[ai][bj][m][n] = __builtin_amdgcn_mfma_f32_16x16x32_bf16(Bt[n][k], At[m][k], acc[ai][bj][m][n], 0, 0, 0); __builtin_amdgcn_s_setprio(0); } while (0)
#define PG8_WAIT_V(n) asm volatile("s_waitcnt vmcnt(" #n ")" ::: "memory")
#define PG8_WAIT_L(n) asm volatile("s_waitcnt lgkmcnt(" #n ")" ::: "memory")
#define PG8_BAR __builtin_amdgcn_s_barrier()
#define PG8_SCHED __builtin_amdgcn_sched_barrier(0)
    Unit cur, nxt; int ui = 0;
    if (!S.next(0, cur)) return;
    f32x4 acc[2][2][4][2];
#pragma unroll
    for (int a = 0; a < 2; ++a)
#pragma unroll
        for (int b = 0; b < 2; ++b)
#pragma unroll
            for (int m = 0; m < 4; ++m)
#pragma unroll
                for (int n = 0; n < 2; ++n) acc[a][b][m][n] = (f32x4){0.f, 0.f, 0.f, 0.f};
    bf16x8 At[4][2], B0[2][2], B1[2][2];
    const char* cA = (const char*)g.A + (size_t)cur.pm * tstep; const char* cB = (const char*)g.Bt + (size_t)cur.pn * tstep;
    S.a_ready(cur);
    PG8_STAGE(PG8_SB(0, 0), cB, voffB); PG8_STAGE(PG8_SA(0, 0), cA, voffA); PG8_STAGE(PG8_SB(0, 1), cB + hstep, voffB); PG8_STAGE(PG8_SA(0, 1), cA + hstep, voffA);
    if (wr == 1) PG8_BAR;
    PG8_WAIT_V(4); PG8_BAR;
    PG8_STAGE(PG8_SB(1, 0), cB + kstep, voffB); PG8_STAGE(PG8_SA(1, 0), cA + kstep, voffA); PG8_STAGE(PG8_SB(1, 1), cB + hstep + kstep, voffB);
    PG8_WAIT_V(6); PG8_BAR;
    PG8_STAMP();
    for (;;) {
        const bool has_next = S.next(ui + 1, nxt);
        const char* nA = has_next ? (const char*)g.A + (size_t)nxt.pm * tstep : cA; const char* nB = has_next ? (const char*)g.Bt + (size_t)nxt.pn * tstep : cB;
        for (int t = 0; t < nt; t += 2) {
            const bool last = (t == nt - 2);
            const char* a1 = cA + (size_t)(t + 1) * kstep;
            const char* a2 = last ? nA : cA + (size_t)(t + 2) * kstep; const char* b2 = last ? nB : cB + (size_t)(t + 2) * kstep;
            const char* a3 = a2 + kstep; const char* b3 = b2 + kstep;
            if (last && has_next) S.a_ready(nxt);
            PG8_LDB(B0, 0, 0); PG8_SCHED; PG8_LDA(At, 0, 0); PG8_STAGE(PG8_SA(1, 1), a1 + hstep, voffA);
            PG8_WAIT_L(8); PG8_BAR; PG8_WAIT_L(0); PG8_MMA(0, 0, At, B0); PG8_BAR; PG8_SCHED;
            PG8_LDB(B1, 0, 1); PG8_STAGE(PG8_SB(0, 0), b2, voffB);
            PG8_BAR; PG8_WAIT_L(0); PG8_MMA(0, 1, At, B1); PG8_BAR;
            PG8_LDA(At, 0, 1); PG8_STAGE(PG8_SA(0, 0), a2, voffA);
            PG8_BAR; PG8_WAIT_L(0); PG8_MMA(1, 0, At, B0); PG8_BAR; PG8_SCHED;
            PG8_STAGE(PG8_SB(0, 1), b2 + hstep, voffB);
            PG8_WAIT_V(6); PG8_BAR; PG8_MMA(1, 1, At, B1); PG8_BAR;
            PG8_LDB(B0, 1, 0); PG8_SCHED; PG8_LDA(At, 1, 0); PG8_STAGE(PG8_SA(0, 1), a2 + hstep, voffA);
            PG8_WAIT_L(8); PG8_BAR; PG8_WAIT_L(0); PG8_MMA(0, 0, At, B0); PG8_BAR; PG8_SCHED;
            PG8_LDB(B1, 1, 1); PG8_STAGE(PG8_SB(1, 0), b3, voffB);
            PG8_BAR; PG8_WAIT_L(0); PG8_MMA(0, 1, At, B1); PG8_BAR;
            PG8_LDA(At, 1, 1); PG8_STAGE(PG8_SA(1, 0), a3, voffA);
            PG8_BAR; PG8_WAIT_L(0); PG8_MMA(1, 0, At, B0); PG8_BAR; PG8_SCHED;
            PG8_STAGE(PG8_SB(1, 1), b3 + hstep, voffB);
            PG8_WAIT_V(6); PG8_BAR; PG8_MMA(1, 1, At, B1); PG8_BAR;
        }
        PG8_STAMP();
        if constexpr (!Epi::AFTER_DRAIN) { E(acc, cur, wr, wc, fr, fq); S.done(cur); }
        PG8_STAMP();
        if (!has_next) break;
#pragma unroll
        for (int a = 0; a < 2; ++a)
#pragma unroll
            for (int b = 0; b < 2; ++b)
#pragma unroll
                for (int m = 0; m < 4; ++m)
#pragma unroll
                    for (int n = 0; n < 2; ++n) acc[a][b][m][n] = (f32x4){0.f, 0.f, 0.f, 0.f};
        cur = nxt; cA = nA; cB = nB; ++ui;
    }
    PG8_WAIT_V(0);
    if (wr == 0) PG8_BAR;
    PG8_BAR;
    if constexpr (Epi::AFTER_DRAIN) { E.fused(acc, cur, wr, wc, fr, fq, lds, wid, lane); S.done(cur); }
    PG8_STAMP();
    if (STAMP && wid == 0) { stamps[lane] = lane < nts ? (((unsigned long long)(unsigned)ts_hi << 32) | (unsigned)ts_lo) : 0ull;
        if (lane == 62) stamps[62] = rt_entry; if (lane == 63) stamps[63] = (unsigned long long)wall_clock64(); }
#undef PG8_STAMP
#undef PG8_SA
#undef PG8_SB
#undef PG8_STAGE
#undef PG8_LDA
#undef PG8_LDB
#undef PG8_MMA
#undef PG8_WAIT_V
#undef PG8_WAIT_L
#undef PG8_BAR
#undef PG8_SCHED
}
}


__device__ __forceinline__ u16 f2bf(float f) {
  unsigned u = __float_as_uint(f);
  u += 0x7fffu + ((u >> 16) & 1u);
  return (u16)(u >> 16);
}
__device__ __forceinline__ float bf2f(u16 h) { return __uint_as_float(((unsigned)h) << 16); }
__device__ __forceinline__ unsigned pack2(float a, float b) { return (unsigned)f2bf(a) | ((unsigned)f2bf(b) << 16); }
__device__ __forceinline__ void unpack8(const uint4 v, float (&f)[8]) {
  f[0] = bf2f((u16)(v.x & 0xffff)); f[1] = bf2f((u16)(v.x >> 16)); f[2] = bf2f((u16)(v.y & 0xffff)); f[3] = bf2f((u16)(v.y >> 16));
  f[4] = bf2f((u16)(v.z & 0xffff)); f[5] = bf2f((u16)(v.z >> 16)); f[6] = bf2f((u16)(v.w & 0xffff)); f[7] = bf2f((u16)(v.w >> 16));
}
__device__ __forceinline__ uint4 pack8s(const float (&f)[8], float sc) {
  return make_uint4(pack2(f[0] * sc, f[1] * sc), pack2(f[2] * sc, f[3] * sc), pack2(f[4] * sc, f[5] * sc), pack2(f[6] * sc, f[7] * sc));
}
__device__ __forceinline__ float silu_f(float x) { return x / (1.f + __expf(-x)); }
__device__ __forceinline__ float sigm(float x) { return 1.f / (1.f + __expf(-x)); }
__device__ __forceinline__ float wave_sum(float v) {
#pragma unroll
  for (int o = 32; o; o >>= 1) v += __shfl_xor(v, o);
  return v;
}
__device__ __forceinline__ const float* xin_of(const Params& P, int slab) { return slab == 0 ? P.in[0] : P.in[1] + (long)(slab - 1) * SLAB * D; }
__device__ __forceinline__ int Lof(int slab) { return slab == 0 ? 2048 : 8192; }
__device__ __forceinline__ int gb_row(int gr) { return gr < 16384 ? (gr >> 11) : (8 + ((gr - 16384) >> 13)); }
__device__ __forceinline__ int gb_of(int slab, int r) { return slab == 0 ? (r >> 11) : (8 + (slab - 1) * 2 + (r >> 13)); }

typedef short v4s __attribute__((ext_vector_type(4)));
#define LBAR() asm volatile("s_waitcnt lgkmcnt(0)\n\ts_barrier" ::: "memory")
#define LDS_AS __attribute__((address_space(3)))
template <int R, bool KC>
__device__ __forceinline__ uint4 ld_chunk(const u16* __restrict__ base, long ld, int k0, int c) {
  if (KC) {
    const int r = c >> 3, kc = c & 7;
    return *(const uint4*)(base + (long)r * ld + k0 + kc * 8);
  } else {
    const int k = c / (R / 8), mc = c % (R / 8);
    return *(const uint4*)(base + (long)(k0 + k) * ld + mc * 8);
  }
}
template <int R, bool KC>
__device__ __forceinline__ void st_chunk(u16* s, uint4 v, int c) {
  if (KC) {
    const int r = c >> 3, kc = c & 7;
    *(uint4*)(s + r * 72 + kc * 8) = v;
  } else {
    const int k = c / (R / 8), mc = c % (R / 8);
    *(uint4*)(s + k * (R + 8) + mc * 8) = v;
  }
}
template <int R, bool KC>
__device__ __forceinline__ bf16x8 ld_frag(const u16* s, int x0, int ks, int fr, int fq) {
  if (KC) {
    return *(const bf16x8*)(s + (x0 + fr) * 72 + ks * 32 + fq * 8);
  } else {
    const int q4 = fr >> 2, p4 = fr & 3;
    const u16* p = s + (ks * 32 + 8 * fq + q4) * (R + 8) + x0 + 4 * p4;
    v4s lo = __builtin_amdgcn_ds_read_tr16_b64_v4i16((LDS_AS v4s*)p);
    v4s hi = __builtin_amdgcn_ds_read_tr16_b64_v4i16((LDS_AS v4s*)(p + 4 * (R + 8)));
    bf16x8 r;
    r[0] = lo[0]; r[1] = lo[1]; r[2] = lo[2]; r[3] = lo[3]; r[4] = hi[0]; r[5] = hi[1]; r[6] = hi[2]; r[7] = hi[3];
    return r;
  }
}

template <int TM, int TN, bool AKC, bool BKC, bool TR, int KT>
__device__ __forceinline__ void gemm_acc(f32x4 (&acc)[TM / 32][TN / 64], const u16* __restrict__ A, long lda,
                                         const u16* __restrict__ B, long ldb, u16* sm) {
  u16* As = sm;
  u16* Bs = sm + 9216;
  const int tid = TID(), lane = tid & 63, wid = tid >> 6;
  const int wm = wid >> 2, wn = wid & 3, fr = lane & 15, fq = lane >> 4;
  constexpr int MI = TM / 32, NI = TN / 64;
  uint4 ra0[KT], ra1[KT], rb0[KT], rb1[KT];
#pragma unroll
  for (int kt = 0; kt < KT; ++kt) {
    ra0[kt] = ld_chunk<TM, AKC>(A, lda, kt * 64, tid);
    ra1[kt] = ra0[kt];
    if (TM == 128) ra1[kt] = ld_chunk<TM, AKC>(A, lda, kt * 64, tid + NT);
    rb0[kt] = ld_chunk<TN, BKC>(B, ldb, kt * 64, tid);
    rb1[kt] = rb0[kt];
    if (TN == 128) rb1[kt] = ld_chunk<TN, BKC>(B, ldb, kt * 64, tid + NT);
  }
#pragma unroll
  for (int kt = 0; kt < KT; ++kt) {
    __syncthreads();
    st_chunk<TM, AKC>(As, ra0[kt], tid);
    if (TM == 128) st_chunk<TM, AKC>(As, ra1[kt], tid + NT);
    st_chunk<TN, BKC>(Bs, rb0[kt], tid);
    if (TN == 128) st_chunk<TN, BKC>(Bs, rb1[kt], tid + NT);
    __syncthreads();
#pragma unroll
    for (int ks = 0; ks < 2; ++ks) {
      bf16x8 af[MI], bfr[NI];
#pragma unroll
      for (int mi = 0; mi < MI; ++mi) af[mi] = ld_frag<TM, AKC>(As, wm * (TM / 2) + mi * 16, ks, fr, fq);
#pragma unroll
      for (int ni = 0; ni < NI; ++ni) bfr[ni] = ld_frag<TN, BKC>(Bs, wn * (TN / 4) + ni * 16, ks, fr, fq);
#pragma unroll
      for (int mi = 0; mi < MI; ++mi)
#pragma unroll
        for (int ni = 0; ni < NI; ++ni)
          acc[mi][ni] = TR ? __builtin_amdgcn_mfma_f32_16x16x32_bf16(bfr[ni], af[mi], acc[mi][ni], 0, 0, 0)
                           : __builtin_amdgcn_mfma_f32_16x16x32_bf16(af[mi], bfr[ni], acc[mi][ni], 0, 0, 0);
    }
  }
  __syncthreads();
}

template <int KT> struct Tiles { uint4 a0[KT], a1[KT], b0[KT], b1[KT]; };
template <int TM, int TN, bool AKC, bool BKC, int KT>
__device__ __forceinline__ void tiles_issue(Tiles<KT>& t, const u16* __restrict__ A, long lda, const u16* __restrict__ B, long ldb) {
  const int tid = TID();
#pragma unroll
  for (int kt = 0; kt < KT; ++kt) {
    t.a0[kt] = ld_chunk<TM, AKC>(A, lda, kt * 64, tid);
    t.a1[kt] = t.a0[kt];
    if (TM == 128) t.a1[kt] = ld_chunk<TM, AKC>(A, lda, kt * 64, tid + NT);
    t.b0[kt] = ld_chunk<TN, BKC>(B, ldb, kt * 64, tid);
    t.b1[kt] = t.b0[kt];
    if (TN == 128) t.b1[kt] = ld_chunk<TN, BKC>(B, ldb, kt * 64, tid + NT);
  }
}
template <int TM, int TN, bool AKC, bool BKC, bool TR, int KT>
__device__ __forceinline__ void gemm_run(f32x4 (&acc)[TM / 32][TN / 64], const Tiles<KT>& t, u16* sm) {
  u16* As = sm;
  u16* Bs = sm + 9216;
  const int tid = TID(), lane = tid & 63, wid = tid >> 6;
  const int wm = wid >> 2, wn = wid & 3, fr = lane & 15, fq = lane >> 4;
  constexpr int MI = TM / 32, NI = TN / 64;
#pragma unroll
  for (int kt = 0; kt < KT; ++kt) {
    __syncthreads();
    st_chunk<TM, AKC>(As, t.a0[kt], tid);
    if (TM == 128) st_chunk<TM, AKC>(As, t.a1[kt], tid + NT);
    st_chunk<TN, BKC>(Bs, t.b0[kt], tid);
    if (TN == 128) st_chunk<TN, BKC>(Bs, t.b1[kt], tid + NT);
    __syncthreads();
#pragma unroll
    for (int ks = 0; ks < 2; ++ks) {
      bf16x8 af[MI], bfr[NI];
#pragma unroll
      for (int mi = 0; mi < MI; ++mi) af[mi] = ld_frag<TM, AKC>(As, wm * (TM / 2) + mi * 16, ks, fr, fq);
#pragma unroll
      for (int ni = 0; ni < NI; ++ni) bfr[ni] = ld_frag<TN, BKC>(Bs, wn * (TN / 4) + ni * 16, ks, fr, fq);
#pragma unroll
      for (int mi = 0; mi < MI; ++mi)
#pragma unroll
        for (int ni = 0; ni < NI; ++ni)
          acc[mi][ni] = TR ? __builtin_amdgcn_mfma_f32_16x16x32_bf16(bfr[ni], af[mi], acc[mi][ni], 0, 0, 0)
                           : __builtin_amdgcn_mfma_f32_16x16x32_bf16(af[mi], bfr[ni], acc[mi][ni], 0, 0, 0);
    }
  }
}

template <int TM, int TN, bool TR, class F>
__device__ __forceinline__ void epi_each(f32x4 (&acc)[TM / 32][TN / 64], F f) {
  const int tid = TID(), lane = tid & 63, wid = tid >> 6;
  const int wm = wid >> 2, wn = wid & 3, fr = lane & 15, fq = lane >> 4;
#pragma unroll
  for (int mi = 0; mi < TM / 32; ++mi)
#pragma unroll
    for (int ni = 0; ni < TN / 64; ++ni) {
      const int r0 = wm * (TM / 2) + mi * 16, c0 = wn * (TN / 4) + ni * 16;
      if (TR) f(r0 + fr, c0 + fq * 4, acc[mi][ni]);
      else f(r0 + fq * 4, c0 + fr, acc[mi][ni]);
    }
}

struct EpiStoreBf16 {
  static constexpr bool PERM = true, AFTER_DRAIN = false;
  u16* O; int ldc;
  __device__ __forceinline__ void operator()(const f32x4 (&acc)[2][2][4][2], const pg8::Unit& u, int wr, int wc, int fr, int fq) const {
    const int row0 = u.pm * 256 + wr * 64 + fr, col0 = u.pn * 256 + wc * 32 + 8 * fq;
#pragma unroll
    for (int ai = 0; ai < 2; ++ai)
#pragma unroll
      for (int m = 0; m < 4; ++m) {
        u16* rowp = O + (size_t)(row0 + ai * 128 + m * 16) * ldc + col0;
#pragma unroll
        for (int bj = 0; bj < 2; ++bj) {
          const f32x4 v0 = acc[ai][bj][m][0], v1 = acc[ai][bj][m][1];
          *(uint4*)(rowp + bj * 128) = make_uint4(pack2(v0[0], v0[1]), pack2(v0[2], v0[3]), pack2(v1[0], v1[1]), pack2(v1[2], v1[3]));
        }
      }
  }
};
struct EpiResid {
  static constexpr bool PERM = false, AFTER_DRAIN = false;
  float* X; const float* XS; const float* mod; int goff; int grow0;
  __device__ __forceinline__ void operator()(const f32x4 (&acc)[2][2][4][2], const pg8::Unit& u, int wr, int wc, int fr, int fq) const {
    const int row0 = u.pm * 256 + wr * 64 + fr, col0 = u.pn * 256 + wc * 32 + 4 * fq;
    const float* g = mod + (size_t)gb_row(grow0 + u.pm * 256) * 6144 + goff + col0;
    f32x4 gv[2][2];
#pragma unroll
    for (int bj = 0; bj < 2; ++bj)
#pragma unroll
      for (int n = 0; n < 2; ++n) gv[bj][n] = *(const f32x4*)(g + bj * 128 + n * 16);
#pragma unroll
    for (int am = 0; am < 4; ++am) {
      f32x4 xv[2][2][2];
#pragma unroll
      for (int mm = 0; mm < 2; ++mm)
#pragma unroll
        for (int bj = 0; bj < 2; ++bj)
#pragma unroll
          for (int n = 0; n < 2; ++n) xv[mm][bj][n] = *(const f32x4*)(XS + (size_t)(row0 + (am >> 1) * 128 + ((am & 1) * 2 + mm) * 16) * D + col0 + bj * 128 + n * 16);
#pragma unroll
      for (int mm = 0; mm < 2; ++mm)
#pragma unroll
        for (int bj = 0; bj < 2; ++bj)
#pragma unroll
          for (int n = 0; n < 2; ++n)
            *(f32x4*)(X + (size_t)(row0 + (am >> 1) * 128 + ((am & 1) * 2 + mm) * 16) * D + col0 + bj * 128 + n * 16) = xv[mm][bj][n] + gv[bj][n] * acc[am >> 1][bj][(am & 1) * 2 + mm][n];
    }
  }
};
struct EpiFfnVal {
  static constexpr bool PERM = false, AFTER_DRAIN = false;
  const u16* G; u16* ACT; const float* cw; const float* cb; int grow0;
  __device__ __forceinline__ void operator()(const f32x4 (&acc)[2][2][4][2], const pg8::Unit& u, int wr, int wc, int fr, int fq) const {
    const int row0 = u.pm * 256 + wr * 64 + fr, col0 = u.pn * 256 + wc * 32 + 4 * fq;
#pragma unroll
    for (int bj = 0; bj < 2; ++bj)
#pragma unroll
      for (int n = 0; n < 2; ++n) {
        const int c = col0 + bj * 128 + n * 16;
        const f32x4 w0 = *(const f32x4*)(cw + c), w1 = *(const f32x4*)(cw + DFF + c), w2 = *(const f32x4*)(cw + 2 * DFF + c), bb = *(const f32x4*)(cb + c);
#pragma unroll
        for (int ai = 0; ai < 2; ++ai) {
          uint2 g0[4], g1[4], g2[4];
#pragma unroll
          for (int m = 0; m < 4; ++m) {
            const int r = row0 + ai * 128 + m * 16;
            const int L = (grow0 + r) < 16384 ? 2048 : 8192;
            const int pos = (grow0 + r) & (L - 1);
            const u16* gp = G + (size_t)r * DFF + c;
            g1[m] = *(const uint2*)gp;
            g0[m] = *(const uint2*)(gp - (pos > 0 ? DFF : 0));
            g2[m] = *(const uint2*)(gp + (pos < L - 1 ? DFF : 0));
          }
#pragma unroll
          for (int m = 0; m < 4; ++m) {
            const int r = row0 + ai * 128 + m * 16;
            const int L = (grow0 + r) < 16384 ? 2048 : 8192;
            const int pos = (grow0 + r) & (L - 1);
            const float m0 = pos > 0 ? 1.f : 0.f, m2 = pos < L - 1 ? 1.f : 0.f;
            const uint2 a0 = g0[m], a1 = g1[m], a2 = g2[m];
            f32x4 a;
            a[0] = m0 * bf2f((u16)(a0.x & 0xffff)) * w0[0] + bf2f((u16)(a1.x & 0xffff)) * w1[0] + m2 * bf2f((u16)(a2.x & 0xffff)) * w2[0] + bb[0];
            a[1] = m0 * bf2f((u16)(a0.x >> 16)) * w0[1] + bf2f((u16)(a1.x >> 16)) * w1[1] + m2 * bf2f((u16)(a2.x >> 16)) * w2[1] + bb[1];
            a[2] = m0 * bf2f((u16)(a0.y & 0xffff)) * w0[2] + bf2f((u16)(a1.y & 0xffff)) * w1[2] + m2 * bf2f((u16)(a2.y & 0xffff)) * w2[2] + bb[2];
            a[3] = m0 * bf2f((u16)(a0.y >> 16)) * w0[3] + bf2f((u16)(a1.y >> 16)) * w1[3] + m2 * bf2f((u16)(a2.y >> 16)) * w2[3] + bb[3];
            const f32x4 v = acc[ai][bj][m][n];
            *(uint2*)(ACT + (size_t)r * DFF + c) = make_uint2(pack2(silu_f(a[0]) * v[0], silu_f(a[1]) * v[1]), pack2(silu_f(a[2]) * v[2], silu_f(a[3]) * v[3]));
          }
        }
      }
  }
};
template <class Epi>
__device__ __forceinline__ void run_gemm(const u16* A, const u16* Bt, int M, int N, int K, const Epi& E) {
  pg8::Gemm g; g.A = A; g.Bt = Bt; g.M = M; g.N = N; g.K = K;
  pg8::StaticOrder S; S.init(M, N, gridDim.x, BID());
  __syncthreads();
  pg8::gemm_phase<Epi, pg8::StaticOrder, false>((PG8_LAS unsigned char*)smem, g, S, E, nullptr);
  __syncthreads();
}

__device__ __forceinline__ int fidx(int p) { return p + ((p >> 6) << 2); }
__device__ __forceinline__ float2 cmulf(float2 a, float2 b) { return make_float2(a.x * b.x - a.y * b.y, a.x * b.y + a.y * b.x); }
__device__ __forceinline__ float2 cmulcf(float2 a, float2 b) { return make_float2(a.x * b.x + a.y * b.y, a.y * b.x - a.x * b.y); }
#define R16C(q) ((q) == 0 ? 1.f : (q) == 1 ? 0.9238795325f : (q) == 2 ? 0.7071067812f : (q) == 3 ? 0.3826834324f : (q) == 4 ? 0.f : (q) == 5 ? -0.3826834324f : (q) == 6 ? -0.7071067812f : -0.9238795325f)
#define R16S(q) ((q) == 0 ? 0.f : (q) == 1 ? -0.3826834324f : (q) == 2 ? -0.7071067812f : (q) == 3 ? -0.9238795325f : (q) == 4 ? -1.f : (q) == 5 ? -0.9238795325f : (q) == 6 ? -0.7071067812f : -0.3826834324f)
template <int N, int RS, bool INV>
__device__ __forceinline__ void fft_pass(float2* x, const float2* __restrict__ tw, const int S, const int tid) {
  constexpr int R = 1 << RS;
  const int E = S >> (RS - 1);
#pragma unroll 1
  for (int g = tid; g < N / R; g += NT) {
    const int blo = g & (E - 1);
    const int base = ((g - blo) << RS) + blo;
    float2 e[R];
#pragma unroll
    for (int k = 0; k < R; ++k) e[k] = x[fidx(base + k * E)];
    float2 wb[RS];
#pragma unroll
    for (int st = 0; st < RS; ++st) wb[st] = tw[blo * (8192 / (S >> st))];
#pragma unroll
    for (int sq = 0; sq < RS; ++sq) {
      const int st = INV ? (RS - 1 - sq) : sq;
      const int h = (R / 2) >> st;
#pragma unroll
      for (int k = 0; k < R; ++k) {
        if ((k & h) == 0) {
          const int m = k & (h - 1);
          const int q = m * (8 / h);
          float2 w = wb[st];
          if (q != 0) w = cmulf(w, make_float2(R16C(q), R16S(q)));
          if (!INV) {
            const float2 a = e[k], b = e[k + h];
            e[k] = make_float2(a.x + b.x, a.y + b.y);
            e[k + h] = cmulf(make_float2(a.x - b.x, a.y - b.y), w);
          } else {
            const float2 a = e[k], b = cmulcf(e[k + h], w);
            e[k] = make_float2(a.x + b.x, a.y + b.y);
            e[k + h] = make_float2(a.x - b.x, a.y - b.y);
          }
        }
      }
    }
#pragma unroll
    for (int k = 0; k < R; ++k) x[fidx(base + k * E)] = e[k];
  }
  __syncthreads();
}
template <int N>
__device__ __forceinline__ void fft_dif_t(float2* x, const float2* __restrict__ tw) {
  const int tid = TID();
  if (N == 16384) {
    fft_pass<N, 4, false>(x, tw, 8192, tid); fft_pass<N, 4, false>(x, tw, 512, tid);
    fft_pass<N, 4, false>(x, tw, 32, tid); fft_pass<N, 2, false>(x, tw, 2, tid);
  } else {
    fft_pass<N, 4, false>(x, tw, 2048, tid); fft_pass<N, 4, false>(x, tw, 128, tid); fft_pass<N, 4, false>(x, tw, 8, tid);
  }
}
template <int N>
__device__ __forceinline__ void ifft_dit_t(float2* x, const float2* __restrict__ tw) {
  const int tid = TID();
  if (N == 16384) {
    fft_pass<N, 2, true>(x, tw, 2, tid); fft_pass<N, 4, true>(x, tw, 32, tid);
    fft_pass<N, 4, true>(x, tw, 512, tid); fft_pass<N, 4, true>(x, tw, 8192, tid);
  } else {
    fft_pass<N, 4, true>(x, tw, 8, tid); fft_pass<N, 4, true>(x, tw, 128, tid); fft_pass<N, 4, true>(x, tw, 2048, tid);
  }
}
__device__ __forceinline__ void fft_dif(float2* x, int N, const float2* __restrict__ tw) {
  if (N == 16384) fft_dif_t<16384>(x, tw); else fft_dif_t<4096>(x, tw);
}
__device__ __forceinline__ void ifft_dit(float2* x, int N, const float2* __restrict__ tw) {
  if (N == 16384) ifft_dit_t<16384>(x, tw); else ifft_dit_t<4096>(x, tw);
}

__device__ void transpose_w(const float* __restrict__ W, u16* __restrict__ Wt, int K, int N) {
  float* smf = (float*)smem;
  const int tk = K / 64, tn = N / 64, tid = TID();
  for (int item = BID(); item < tk * tn; item += gridDim.x) {
    const int k0 = (item / tn) * 64, n0 = (item % tn) * 64;
    float4 v[2];
#pragma unroll
    for (int j = 0; j < 2; ++j) {
      const int idx = tid + j * NT, kk = idx >> 4, n4 = idx & 15;
      v[j] = *(const float4*)(W + (long)(k0 + kk) * N + n0 + n4 * 4);
    }
    __syncthreads();
#pragma unroll
    for (int j = 0; j < 2; ++j) {
      const int idx = tid + j * NT, kk = idx >> 4, n4 = idx & 15;
      float* p = smf + kk * 65 + n4 * 4;
      p[0] = v[j].x; p[1] = v[j].y; p[2] = v[j].z; p[3] = v[j].w;
    }
    __syncthreads();
    const int nn = tid >> 3, k8 = tid & 7;
    float f[8];
#pragma unroll
    for (int i = 0; i < 8; ++i) f[i] = smf[(k8 * 8 + i) * 65 + nn];
    *(uint4*)(Wt + (long)(n0 + nn) * K + k0 + k8 * 8) = pack8s(f, 1.f);
  }
  __syncthreads();
}

__device__ void phase_pre0(const Params& P) {
  const int tid = TID();
  const long gtid = (long)BID() * NT + tid, gsz = (long)gridDim.x * NT;
  transpose_w(P.in[7], (u16*)(WS(P) + O_WHYIN), 1024, 3072);
  transpose_w(P.in[18], (u16*)(WS(P) + O_WHYOUT), 1024, 1024);
  transpose_w(P.in[19], (u16*)(WS(P) + O_WRETIN), 1024, 6144);
  transpose_w(P.in[21], (u16*)(WS(P) + O_WRETOUT), 2048, 1024);
  transpose_w(P.in[22], (u16*)(WS(P) + O_WSWAIN), 1024, 1536);
  transpose_w(P.in[26], (u16*)(WS(P) + O_WSWAOUT), 1024, 1024);
  transpose_w(P.in[27], (u16*)(WS(P) + O_WHGIN), 1024, 5120);
  transpose_w(P.in[30], (u16*)(WS(P) + O_WHGOUT), 1024, 1024);
  for (int l = 0; l < 4; ++l) {
    transpose_w(P.in[31] + (long)l * 1024 * DFF, (u16*)(WS(P) + O_WFG) + (long)l * DFF * 1024, 1024, DFF);
    transpose_w(P.in[32] + (long)l * 1024 * DFF, (u16*)(WS(P) + O_WFV) + (long)l * DFF * 1024, 1024, DFF);
    transpose_w(P.in[35] + (long)l * DFF * 1024, (u16*)(WS(P) + O_WFD) + (long)l * 1024 * DFF, DFF, 1024);
  }
  {
    float* cs = (float*)smem;
    float* modp = (float*)(WS(P) + O_MODP);
    for (int item = BID(); item < 4 * 8 * 12; item += gridDim.x) {
      const int nb = item % 12, ks = (item / 12) % 8, l = item / 96;
      __syncthreads();
      for (int i = tid; i < 2048; i += NT) {
        int b = i >> 7, k = i & 127;
        float c = (b < 8) ? P.in[2][b * 1024 + ks * 128 + k] : P.in[3][(b - 8) * 1024 + ks * 128 + k];
        cs[i] = c / (1.f + expf(-c));
      }
      __syncthreads();
      const int n = nb * 512 + tid;
      float a[16];
#pragma unroll
      for (int b = 0; b < 16; ++b) a[b] = 0.f;
      const float* w = P.in[4] + ((long)l * 1024 + ks * 128) * 6144 + n;
      for (int k = 0; k < 128; ++k) {
        float wv = w[(long)k * 6144];
#pragma unroll
        for (int b = 0; b < 16; ++b) a[b] += cs[b * 128 + k] * wv;
      }
#pragma unroll
      for (int b = 0; b < 16; ++b) modp[(((long)ks * 4 + l) * 16 + b) * 6144 + n] = a[b];
    }
    __syncthreads();
  }
  {
    float2* tw = (float2*)(WS(P) + O_TW);
    for (long i = gtid; i < 8192; i += gsz) {
      float s, c;
      sincospif((float)i * (1.f / 8192.f), &s, &c);
      tw[i] = make_float2(c, -s);
    }
    float2* rr = (float2*)(WS(P) + O_ROPER);
    for (long i = gtid; i < (long)8192 * 128; i += gsz) {
      int pos = (int)(i >> 7), d = (int)(i & 127);
      float inv = exp2f(-(float)d * (13.287712379549449f / 128.f));
      float s, c;
      sincosf((float)pos * inv, &s, &c);
      rr[i] = make_float2(c, s);
    }
    float2* rs = (float2*)(WS(P) + O_ROPES);
    for (long i = gtid; i < (long)8192 * 32; i += gsz) {
      int pos = (int)(i >> 5), d = (int)(i & 31);
      float inv = exp2f(-(float)d * (13.287712379549449f / 32.f));
      float s, c;
      sincosf((float)pos * inv, &s, &c);
      rs[i] = make_float2(c, s);
    }
  }
  {
    float* zf = (float*)smem;
    float* h1 = zf + 8 * 36;
    const float* w1 = P.in[10]; const float* b1 = P.in[11]; const float* w2 = P.in[12]; const float* b2 = P.in[13];
    const float* fr = P.in[15];
    const int tl = tid >> 6, j = tid & 63;
    for (int item = BID(); item < 1280; item += gridDim.x) {
      const int sel = item >= 1024;
      const int L = sel ? 2048 : 8192;
      const int t = (sel ? item - 1024 : item) * 8 + tl;
      float* hid = (float*)(WS(P) + (sel ? O_HIDP : O_HIDS));
      __syncthreads();
      if (j < 33) {
        float v;
        if (j == 0) v = (float)t / (float)(L - 1);
        else {
          int i = (j - 1) & 15;
          float band = 1e-4f + (float)i * ((15.f - 1e-4f) / 15.f);
          float ang = (6.283185307179586f / (float)L) * (float)t;
          float a = band * ang;
          v = (j <= 16) ? cosf(a) : -sinf(a);
        }
        zf[tl * 36 + j] = v;
      }
      __syncthreads();
      float s = b1[j];
#pragma unroll 3
      for (int i = 0; i < 33; ++i) s += zf[tl * 36 + i] * w1[i * 64 + j];
      h1[tl * 64 + j] = sinf(fr[j] * s);
      __syncthreads();
      float s2 = b2[j];
#pragma unroll 4
      for (int i = 0; i < 64; ++i) s2 += h1[tl * 64 + i] * w2[i * 64 + j];
      hid[(long)t * 64 + j] = sinf(fr[j] * s2);
    }
    __syncthreads();
  }
}

__device__ void phase_pre1(const Params& P) {
  __shared__ float w3s[128];
  __shared__ float red[8];
  const int tid = TID(), lane = tid & 63, wid = tid >> 6;
  const long gtid = (long)BID() * NT + tid, gsz = (long)gridDim.x * NT;
  {
    const float* modp = (const float*)(WS(P) + O_MODP);
    float* mod = (float*)(WS(P) + O_MOD);
    for (long i = gtid; i < (long)4 * 16 * 6144; i += gsz) {
      int n = (int)(i % 6144);
      int l = (int)(i / (16 * 6144));
      float s = P.in[5][l * 6144 + n];
      for (int ks = 0; ks < 8; ++ks) s += modp[(long)ks * 4 * 16 * 6144 + i];
      mod[i] = s;
    }
  }
  float2* buf = (float2*)smem;
  const float2* tw = (const float2*)(WS(P) + O_TW);
  for (int item = BID(); item < 2048; item += gridDim.x) {
    const int sel = item >> 10, c = item & 1023;
    const int L = sel ? 2048 : 8192, N = 2 * L;
    const float* hid = (const float*)(WS(P) + (sel ? O_HIDP : O_HIDS));
    float2* hs = (float2*)(WS(P) + (sel ? O_HSPP : O_HSPS)) + (long)c * N;
    __syncthreads();
    if (tid < 128) {
      int dirn = tid >> 6, j = tid & 63;
      w3s[tid] = P.in[14][(long)j * 2048 + dirn * 1024 + c];
    }
    __syncthreads();
    const float dec0 = fabsf(P.in[16][c]), dec1 = fabsf(P.in[16][1024 + c]);
    const float invLm1 = 1.f / (float)(L - 1);
    float asum = 0.f;
    for (int n = tid; n < N; n += NT) {
      float val = 0.f;
      if (n != L) {
        const int dirn = n < L ? 0 : 1;
        const int t = n < L ? n : N - n;
        const float4* hr = (const float4*)(hid + (long)t * 64);
        const float* w = w3s + dirn * 64;
        float s = 0.f;
#pragma unroll
        for (int q = 0; q < 16; ++q) {
          float4 h4 = hr[q];
          s += h4.x * w[4 * q] + h4.y * w[4 * q + 1] + h4.z * w[4 * q + 2] + h4.w * w[4 * q + 3];
        }
        float tl = (float)t * invLm1;
        val = s * expf(-tl * (dirn ? dec1 : dec0));
      }
      buf[fidx(n)] = make_float2(val, 0.f);
      asum += fabsf(val);
    }
    asum = wave_sum(asum);
    if (lane == 0) red[wid] = asum;
    __syncthreads();
    float tot = 0.f;
#pragma unroll
    for (int w = 0; w < 8; ++w) tot += red[w];
    const float scale = 1.f / (tot * (float)N);
    fft_dif(buf, N, tw);
    for (int p = tid; p < N; p += NT) {
      float2 a = buf[fidx(p)];
      hs[p] = make_float2(a.x * scale, a.y * scale);
    }
  }
  __syncthreads();
}

__device__ void phase_norm(const Params& P, int layer, int sl, int which) {
  const int grow0 = which ? sl * FSLAB : sl * SLAB, nrows = which ? FSLAB : SLAB;
  const float* __restrict__ x = (layer == 0 && which == 0) ? xin_of(P, sl) : (const float*)(OUTP(P) + (long)grow0 * D);
  u16* __restrict__ h = (u16*)(WS(P) + (which ? O_FHBUF : O_HBUF));
  const float* gain = P.in[6] + (layer * 2 + which) * D;
  const float* mod = (const float*)(WS(P) + O_MOD) + (long)layer * 16 * 6144;
  const int shoff = which ? 3 * D : 0, scoff = which ? 4 * D : D;
  const int tid = TID(), lane = tid & 63, wid = tid >> 6;
  for (int item = BID(); item < nrows / 32; item += gridDim.x) {
    const int r0 = item * 32 + wid * 4;
    float4 v[4][4];
    float ss[4];
#pragma unroll
    for (int u = 0; u < 4; ++u) {
      const float* xr = x + (long)(r0 + u) * D;
      float a = 0.f;
#pragma unroll
      for (int i = 0; i < 4; ++i) {
        v[u][i] = *(const float4*)(xr + i * 256 + lane * 4);
        a += v[u][i].x * v[u][i].x + v[u][i].y * v[u][i].y + v[u][i].z * v[u][i].z + v[u][i].w * v[u][i].w;
      }
      ss[u] = a;
    }
    const float* m = mod + (long)gb_row(grow0 + r0) * 6144;
#pragma unroll
    for (int u = 0; u < 4; ++u) ss[u] = wave_sum(ss[u]);
#pragma unroll
    for (int i = 0; i < 4; ++i) {
      const int col = i * 256 + lane * 4;
      const float4 g = *(const float4*)(gain + col);
      const float4 sc = *(const float4*)(m + scoff + col);
      const float4 sh = *(const float4*)(m + shoff + col);
      const float a0 = g.x * (1.f + sc.x), a1 = g.y * (1.f + sc.y), a2 = g.z * (1.f + sc.z), a3 = g.w * (1.f + sc.w);
#pragma unroll
      for (int u = 0; u < 4; ++u) {
        const float rstd = rsqrtf(ss[u] * (1.f / 1024.f) + 1e-6f);
        const float y0 = v[u][i].x * rstd * a0 + sh.x, y1 = v[u][i].y * rstd * a1 + sh.y;
        const float y2 = v[u][i].z * rstd * a2 + sh.z, y3 = v[u][i].w * rstd * a3 + sh.w;
        *(uint2*)(h + (long)(r0 + u) * D + col) = make_uint2(pack2(y0, y1), pack2(y2, y3));
      }
    }
  }
}

__device__ void phase_proj(const Params& P, size_t woff, int N) {
  EpiStoreBf16 E; E.O = (u16*)(WS(P) + O_PROJ); E.ldc = N;
  run_gemm((const u16*)(WS(P) + O_HBUF), (const u16*)(WS(P) + woff), SLAB, N, D, E);
}
__device__ void phase_resid(const Params& P, int layer, int slab, const u16* A, int K, size_t woff, int goff) {
  EpiResid E; E.X = OUTP(P) + (long)slab * SLAB * D; E.XS = (layer == 0) ? xin_of(P, slab) : (const float*)E.X; E.mod = (const float*)(WS(P) + O_MOD) + (long)layer * 16 * 6144; E.goff = goff; E.grow0 = slab * SLAB;
  run_gemm(A, (const u16*)(WS(P) + woff), SLAB, D, K, E);
}

__device__ void phase_ffn_gate(const Params& P, int layer) {
  EpiStoreBf16 E; E.O = (u16*)(WS(P) + O_FGBUF); E.ldc = DFF;
  run_gemm((const u16*)(WS(P) + O_FHBUF), (const u16*)(WS(P) + O_WFG) + (long)layer * DFF * D, FSLAB, DFF, D, E);
}
__device__ void phase_ffn_val(const Params& P, int layer, int fs) {
  EpiFfnVal E; E.G = (const u16*)(WS(P) + O_FGBUF); E.ACT = (u16*)(WS(P) + O_FACT) + (long)fs * FSLAB * DFF;
  E.cw = P.in[33] + (long)layer * 3 * DFF; E.cb = P.in[34] + (long)layer * DFF; E.grow0 = fs * FSLAB;
  run_gemm((const u16*)(WS(P) + O_FHBUF), (const u16*)(WS(P) + O_WFV) + (long)layer * DFF * D, FSLAB, DFF, D, E);
}
__device__ void phase_ffn_down(const Params& P, int layer) {
  EpiResid E; E.X = OUTP(P); E.XS = E.X; E.mod = (const float*)(WS(P) + O_MOD) + (long)layer * 16 * 6144; E.goff = 5 * D; E.grow0 = 0;
  run_gemm((const u16*)(WS(P) + O_FACT), (const u16*)(WS(P) + O_WFD) + (long)layer * D * DFF, NTOK, D, DFF, E);
}

__device__ void phase_hy_conv(const Params& P, int slab) {
  const int L = Lof(slab), nseq = SLAB / L, tid = TID();
  const u16* __restrict__ z = (const u16*)(WS(P) + O_PROJ);
  float* __restrict__ uT = (float*)(WS(P) + O_UT);
  u16* __restrict__ x0c = (u16*)(WS(P) + O_X0C);
  const float* cw = P.in[8];
  const float* cb = P.in[9];
  float* tile = (float*)smem;
  const int ntt = L / 64;
  const int nitems = nseq * ntt * 16;
  const int tl = tid >> 3, cg = tid & 7;
  for (int item = BID(); item < nitems; item += gridDim.x) {
    const int ct = item % 16, tt = (item / 16) % ntt, seq = item / (16 * ntt);
    const int t = tt * 64 + tl, c0 = ct * 64 + cg * 8;
    const long row = (long)seq * L + t;
    const float mp = t > 0 ? 1.f : 0.f, mn = t < L - 1 ? 1.f : 0.f;
    const long rp = t > 0 ? row - 1 : row, rn = t < L - 1 ? row + 1 : row;
    float val[3][8];
#pragma unroll
    for (int q = 0; q < 3; ++q) {
      const int col = q * 1024 + c0;
      float a[8], b[8], c[8];
      unpack8(*(const uint4*)(z + rp * 3072 + col), a);
      unpack8(*(const uint4*)(z + row * 3072 + col), b);
      unpack8(*(const uint4*)(z + rn * 3072 + col), c);
      const float4 w0a = *(const float4*)(cw + col), w0b = *(const float4*)(cw + col + 4);
      const float4 w1a = *(const float4*)(cw + 3072 + col), w1b = *(const float4*)(cw + 3072 + col + 4);
      const float4 w2a = *(const float4*)(cw + 6144 + col), w2b = *(const float4*)(cw + 6144 + col + 4);
      const float4 ba = *(const float4*)(cb + col), bb = *(const float4*)(cb + col + 4);
      const float w0[8] = {w0a.x, w0a.y, w0a.z, w0a.w, w0b.x, w0b.y, w0b.z, w0b.w};
      const float w1[8] = {w1a.x, w1a.y, w1a.z, w1a.w, w1b.x, w1b.y, w1b.z, w1b.w};
      const float w2[8] = {w2a.x, w2a.y, w2a.z, w2a.w, w2b.x, w2b.y, w2b.z, w2b.w};
      const float bs[8] = {ba.x, ba.y, ba.z, ba.w, bb.x, bb.y, bb.z, bb.w};
#pragma unroll
      for (int i = 0; i < 8; ++i) val[q][i] = mp * a[i] * w0[i] + b[i] * w1[i] + mn * c[i] * w2[i] + bs[i];
    }
    *(uint4*)(x0c + row * 1024 + c0) = pack8s(val[0], 1.f);
    __syncthreads();
#pragma unroll
    for (int i = 0; i < 8; ++i) tile[tl * 65 + cg * 8 + i] = val[1][i] * val[2][i];
    __syncthreads();
    {
      const int cl = tid >> 3, tq = tid & 7;
      float* dst = uT + ((long)seq * 1024 + ct * 64 + cl) * L + tt * 64 + tq * 8;
      float4 o0, o1;
      o0.x = tile[(tq * 8 + 0) * 65 + cl]; o0.y = tile[(tq * 8 + 1) * 65 + cl]; o0.z = tile[(tq * 8 + 2) * 65 + cl]; o0.w = tile[(tq * 8 + 3) * 65 + cl];
      o1.x = tile[(tq * 8 + 4) * 65 + cl]; o1.y = tile[(tq * 8 + 5) * 65 + cl]; o1.z = tile[(tq * 8 + 6) * 65 + cl]; o1.w = tile[(tq * 8 + 7) * 65 + cl];
      *(float4*)dst = o0; *(float4*)(dst + 4) = o1;
    }
  }
  __syncthreads();
}

__device__ void phase_hy_fft(const Params& P, int slab, bool dry = false) {
  const int L = Lof(slab), N = 2 * L, nseq = SLAB / L, tid = TID();
  float* uT = (float*)(WS(P) + O_UT);
  const float2* hsb = (const float2*)(WS(P) + (slab == 0 ? O_HSPP : O_HSPS));
  const float2* tw = (const float2*)(WS(P) + O_TW);
  const float* skip = P.in[17];
  float2* buf = (float2*)smem;
  const int nitems = (nseq / 2) * 1024;
  for (int item = BID(); item < nitems; item += gridDim.x) {
    const int pr = item >> 10, c = item & 1023;
    float* u0 = uT + ((long)(pr * 2) * 1024 + c) * L;
    float* u1 = u0 + (long)1024 * L;
    __syncthreads();
    for (int t = tid; t < L; t += NT) {
      buf[fidx(t)] = make_float2(u0[t], u1[t]);
      buf[fidx(t + L)] = make_float2(0.f, 0.f);
    }
    __syncthreads();
    fft_dif(buf, N, tw);
    const float2* h = hsb + (long)c * N;
    for (int p = tid; p < N; p += NT) {
      float2 a = buf[fidx(p)], b = h[p];
      buf[fidx(p)] = make_float2(a.x * b.x - a.y * b.y, a.x * b.y + a.y * b.x);
    }
    __syncthreads();
    ifft_dit(buf, N, tw);
    const float sk = skip[c];
    for (int t = tid; t < L; t += NT) {
      float2 y = buf[fidx(t)];
      const long doff = dry ? (long)(END_HY - O_UT) / 4 : 0;
      u0[t + doff] = y.x + u0[t] * sk;
      u1[t + doff] = y.y + u1[t] * sk;
    }
  }
  __syncthreads();
}

__device__ void phase_hy_tr(const Params& P, int slab) {
  const int L = Lof(slab), nseq = SLAB / L, tid = TID();
  const float* __restrict__ yT = (const float*)(WS(P) + O_UT);
  const u16* __restrict__ x0c = (const u16*)(WS(P) + O_X0C);
  u16* __restrict__ a2 = (u16*)(WS(P) + O_A2);
  float* tile = (float*)smem;
  const int ntt = L / 64;
  const int nitems = nseq * ntt * 16;
  for (int item = BID(); item < nitems; item += gridDim.x) {
    const int ct = item % 16, tt = (item / 16) % ntt, seq = item / (16 * ntt);
    const int cl = tid >> 3, tq = tid & 7;
    const float* src = yT + ((long)seq * 1024 + ct * 64 + cl) * L + tt * 64 + tq * 8;
    const float4 i0 = *(const float4*)src, i1 = *(const float4*)(src + 4);
    const int tl = tid >> 3, cg = tid & 7;
    const long row = (long)seq * L + tt * 64 + tl;
    const int c0 = ct * 64 + cg * 8;
    float xg[8];
    unpack8(*(const uint4*)(x0c + row * 1024 + c0), xg);
    __syncthreads();
    float* p = tile + cl * 65 + tq * 8;
    p[0] = i0.x; p[1] = i0.y; p[2] = i0.z; p[3] = i0.w; p[4] = i1.x; p[5] = i1.y; p[6] = i1.z; p[7] = i1.w;
    __syncthreads();
    float o[8];
#pragma unroll
    for (int i = 0; i < 8; ++i) o[i] = tile[(cg * 8 + i) * 65 + tl] * xg[i];
    *(uint4*)(a2 + row * 1024 + c0) = pack8s(o, 1.f);
  }
  __syncthreads();
}

struct Rec {
  int H, DK, DV, C;
  int ldv, voff, goff;
};
__device__ __forceinline__ Rec rec_of(int kind) {
  Rec r;
  if (kind == 1) { r.H = 4; r.DK = 256; r.DV = 512; r.C = 256; r.ldv = 6144; r.voff = 2048; r.goff = 4096; }
  else { r.H = 8; r.DK = 128; r.DV = 128; r.C = 128; r.ldv = 5120; r.voff = 1024; r.goff = 4096; }
  return r;
}

__device__ void phase_ret_prep(const Params& P, int slab) {
  const int L = Lof(slab);
  const u16* __restrict__ pj = (const u16*)(WS(P) + O_PROJ);
  u16* __restrict__ qdf = (u16*)(WS(P) + O_QDF); u16* __restrict__ qdb = (u16*)(WS(P) + O_QDB);
  u16* __restrict__ kif = (u16*)(WS(P) + O_KIF); u16* __restrict__ kib = (u16*)(WS(P) + O_KIB);
  u16* __restrict__ kef = (u16*)(WS(P) + O_KEF); u16* __restrict__ keb = (u16*)(WS(P) + O_KEB);
  float* dlf = (float*)(WS(P) + O_DLF); float* dlb = (float*)(WS(P) + O_DLB);
  const float2* __restrict__ rope = (const float2*)(WS(P) + O_ROPER);
  const long gtid = (long)BID() * NT + TID(), gsz = (long)gridDim.x * NT;
  for (long idx = gtid; idx < (long)SLAB * 64; idx += gsz) {
    const int d0 = (int)(idx & 15) * 8, h = (int)((idx >> 4) & 3), t = (int)(idx >> 6);
    const int pos = t & (L - 1), r = t & 255;
    const float lgf = -expf(P.in[20][h]), lgb = -expf(P.in[20][4 + h]);
    const u16* row = pj + (long)t * 6144 + h * 256 + d0;
    const uint4 vq1 = *(const uint4*)row, vq2 = *(const uint4*)(row + 128);
    const uint4 vk1 = *(const uint4*)(row + 1024), vk2 = *(const uint4*)(row + 1024 + 128);
    const float4* rp = (const float4*)(rope + (long)pos * 128 + d0);
    const float4 c01 = rp[0], c23 = rp[1], c45 = rp[2], c67 = rp[3];
    float q1[8], q2[8], k1[8], k2[8];
    unpack8(vq1, q1); unpack8(vq2, q2); unpack8(vk1, k1); unpack8(vk2, k2);
    const float cs[8] = {c01.x, c01.z, c23.x, c23.z, c45.x, c45.z, c67.x, c67.z};
    const float sn[8] = {c01.y, c01.w, c23.y, c23.w, c45.y, c45.w, c67.y, c67.w};
    float qa[8], qb[8], ka[8], kb[8];
#pragma unroll
    for (int i = 0; i < 8; ++i) {
      qa[i] = q1[i] * cs[i] - q2[i] * sn[i]; qb[i] = q1[i] * sn[i] + q2[i] * cs[i];
      ka[i] = (k1[i] * cs[i] - k2[i] * sn[i]) * 0.0625f; kb[i] = (k1[i] * sn[i] + k2[i] * cs[i]) * 0.0625f;
    }
    const float bf = (float)(r + 1) * lgf, bb = (float)(256 - r) * lgb;
    const float ef = expf(bf), eif = expf(-bf), eef = expf((float)(255 - r) * lgf);
    const float eb = expf(bb), eib = expf(-bb), eeb = expf((float)r * lgb);
    const long o1 = (long)t * 1024 + h * 256 + d0, o2 = o1 + 128;
    *(uint4*)(qdf + o1) = pack8s(qa, ef); *(uint4*)(qdf + o2) = pack8s(qb, ef);
    *(uint4*)(qdb + o1) = pack8s(qa, eb); *(uint4*)(qdb + o2) = pack8s(qb, eb);
    *(uint4*)(kif + o1) = pack8s(ka, eif); *(uint4*)(kif + o2) = pack8s(kb, eif);
    *(uint4*)(kib + o1) = pack8s(ka, eib); *(uint4*)(kib + o2) = pack8s(kb, eib);
    *(uint4*)(kef + o1) = pack8s(ka, eef); *(uint4*)(kef + o2) = pack8s(kb, eef);
    *(uint4*)(keb + o1) = pack8s(ka, eeb); *(uint4*)(keb + o2) = pack8s(kb, eeb);
    if (r == 0) {
      const long cgi = (long)(t >> 8) * 1024 + h * 256 + d0;
      const float df = expf(256.f * lgf), db = expf(256.f * lgb);
#pragma unroll
      for (int i = 0; i < 8; ++i) { dlf[cgi + i] = df; dlf[cgi + 128 + i] = df; dlb[cgi + i] = db; dlb[cgi + 128 + i] = db; }
    }
  }
}

__device__ __forceinline__ float lb_of(const float* lbt, int dr, int ch) {
  const float a0 = lbt[(dr * 4 + 0) * 1024 + ch], a1 = lbt[(dr * 4 + 1) * 1024 + ch], a2 = lbt[(dr * 4 + 2) * 1024 + ch], a3 = lbt[(dr * 4 + 3) * 1024 + ch];
  const float m = fmaxf(fmaxf(a0, a1), fmaxf(a2, a3));
  const float e0 = expf(a0 - m), e1 = expf(a1 - m), e2 = expf(a2 - m), e3 = expf(a3 - m);
  return (e0 + e1 + e2) / (e0 + e1 + e2 + e3);
}
__device__ void phase_hg_prep(const Params& P) {
  const u16* __restrict__ pj = (const u16*)(WS(P) + O_PROJ);
  u16* __restrict__ qdf = (u16*)(WS(P) + O_QDF); u16* __restrict__ qdb = (u16*)(WS(P) + O_QDB);
  u16* __restrict__ kif = (u16*)(WS(P) + O_KIF); u16* __restrict__ kib = (u16*)(WS(P) + O_KIB);
  u16* __restrict__ kef = (u16*)(WS(P) + O_KEF); u16* __restrict__ keb = (u16*)(WS(P) + O_KEB);
  float* dlf = (float*)(WS(P) + O_DLF); float* dlb = (float*)(WS(P) + O_DLB);
  const float* lbt = P.in[28];
  float* totF = (float*)smem;
  float* totB = totF + 1024;
  const int tid = TID(), lane = tid & 63, rg = tid >> 6;
  constexpr int RPT = 16;
  for (int item = BID(); item < 1024; item += gridDim.x) {
    const int cgi = item >> 3, ch = (item & 7) * 128 + lane * 2;
    const long t0 = (long)cgi * 128 + rg * RPT;
    unsigned wq[RPT], wf[RPT], wb[RPT];
#pragma unroll
    for (int i = 0; i < RPT; ++i) {
      const u16* row = pj + (t0 + i) * 5120 + ch;
      wq[i] = *(const unsigned*)row; wf[i] = *(const unsigned*)(row + 2048); wb[i] = *(const unsigned*)(row + 3072);
    }
    float lb0[2], lb1[2];
    lb0[0] = lb_of(lbt, 0, ch); lb0[1] = lb_of(lbt, 0, ch + 1);
    lb1[0] = lb_of(lbt, 1, ch); lb1[1] = lb_of(lbt, 1, ch + 1);
    float pf[2][RPT], sb[2][RPT], accf[2], accb[2];
#pragma unroll
    for (int c = 0; c < 2; ++c) {
      float a = 0.f;
#pragma unroll
      for (int i = 0; i < RPT; ++i) {
        const float x = bf2f((u16)(c ? (wf[i] >> 16) : (wf[i] & 0xffff)));
        a += logf(lb0[c] + (1.f - lb0[c]) * sigm(x)); pf[c][i] = a;
      }
      accf[c] = a;
      a = 0.f;
#pragma unroll
      for (int i = RPT - 1; i >= 0; --i) {
        const float x = bf2f((u16)(c ? (wb[i] >> 16) : (wb[i] & 0xffff)));
        a += logf(lb1[c] + (1.f - lb1[c]) * sigm(x)); sb[c][i] = a;
      }
      accb[c] = a;
    }
    __syncthreads();
    *(float2*)(totF + rg * 128 + lane * 2) = make_float2(accf[0], accf[1]);
    *(float2*)(totB + rg * 128 + lane * 2) = make_float2(accb[0], accb[1]);
    __syncthreads();
    float offF[2] = {0.f, 0.f}, offB[2] = {0.f, 0.f}, totf[2] = {0.f, 0.f}, totb[2] = {0.f, 0.f};
#pragma unroll
    for (int g = 0; g < 8; ++g) {
      const float2 f = *(const float2*)(totF + g * 128 + lane * 2), bq = *(const float2*)(totB + g * 128 + lane * 2);
      totf[0] += f.x; totf[1] += f.y; totb[0] += bq.x; totb[1] += bq.y;
      if (g < rg) { offF[0] += f.x; offF[1] += f.y; }
      if (g > rg) { offB[0] += bq.x; offB[1] += bq.y; }
    }
#pragma unroll
    for (int i = 0; i < RPT; ++i) {
      float o[6][2];
#pragma unroll
      for (int c = 0; c < 2; ++c) {
        const float xq = bf2f((u16)(c ? (wq[i] >> 16) : (wq[i] & 0xffff)));
        const float xf = bf2f((u16)(c ? (wf[i] >> 16) : (wf[i] & 0xffff)));
        const float xb = bf2f((u16)(c ? (wb[i] >> 16) : (wb[i] & 0xffff)));
        const float q = silu_f(xq);
        const float bf = offF[c] + pf[c][i], bb = offB[c] + sb[c][i];
        const float kf = (1.f - lb0[c]) * sigm(-xf), kb = (1.f - lb1[c]) * sigm(-xb);
        o[0][c] = q * expf(bf); o[1][c] = kf * expf(-bf); o[2][c] = kf * expf(totf[c] - bf);
        o[3][c] = q * expf(bb); o[4][c] = kb * expf(-bb); o[5][c] = kb * expf(totb[c] - bb);
      }
      const long oo = (t0 + i) * 1024 + ch;
      *(unsigned*)(qdf + oo) = pack2(o[0][0], o[0][1]);
      *(unsigned*)(kif + oo) = pack2(o[1][0], o[1][1]);
      *(unsigned*)(kef + oo) = pack2(o[2][0], o[2][1]);
      *(unsigned*)(qdb + oo) = pack2(o[3][0], o[3][1]);
      *(unsigned*)(kib + oo) = pack2(o[4][0], o[4][1]);
      *(unsigned*)(keb + oo) = pack2(o[5][0], o[5][1]);
    }
    if (rg == 0) {
      *(float2*)(dlf + (long)cgi * 1024 + ch) = make_float2(expf(totf[0]), expf(totf[1]));
      *(float2*)(dlb + (long)cgi * 1024 + ch) = make_float2(expf(totb[0]), expf(totb[1]));
    }
  }
  __syncthreads();
}

template <int C, int DKT>
__device__ __forceinline__ void rec_scores_item(const Params& P, const Rec& R, int cgi, int h, int ti, int tj) {
  constexpr int T = C > 128 ? 128 : C, KTS = DKT;
  const u16* qdf = (const u16*)(WS(P) + O_QDF); const u16* qdb = (const u16*)(WS(P) + O_QDB);
  const u16* kif = (const u16*)(WS(P) + O_KIF); const u16* kib = (const u16*)(WS(P) + O_KIB);
  u16* sc = (u16*)(WS(P) + O_SC) + (((long)cgi * R.H + h) * C + ti * T) * C + tj * T;
  const long offA = ((long)cgi * C + ti * T) * 1024 + h * R.DK, offB = ((long)cgi * C + tj * T) * 1024 + h * R.DK;
  f32x4 af[T / 32][T / 64] = {}, ab[T / 32][T / 64] = {};
  if (ti >= tj) gemm_acc<T, T, true, true, true, KTS>(af, qdf + offA, 1024, kif + offB, 1024, (u16*)smem);
  if (ti <= tj) gemm_acc<T, T, true, true, true, KTS>(ab, qdb + offA, 1024, kib + offB, 1024, (u16*)smem);
  const int tid = TID(), lane = tid & 63, wid = tid >> 6;
  const int wm = wid >> 2, wn = wid & 3, fr = lane & 15, fq = lane >> 4;
#pragma unroll
  for (int mi = 0; mi < T / 32; ++mi)
#pragma unroll
    for (int ni = 0; ni < T / 64; ++ni) {
      const int r = wm * (T / 2) + mi * 16 + fr, c0 = wn * (T / 4) + ni * 16 + fq * 4;
      const int gr = ti * T + r;
      float v[4];
#pragma unroll
      for (int j = 0; j < 4; ++j) {
        const int gc = tj * T + c0 + j;
        v[j] = (gc <= gr ? af[mi][ni][j] : 0.f) + (gc >= gr ? ab[mi][ni][j] : 0.f);
      }
      *(uint2*)(sc + r * C + c0) = make_uint2(pack2(v[0], v[1]), pack2(v[2], v[3]));
    }
}

template <int C, int DKT>
__device__ void phase_rec_su(const Params& P, int kind) {
  const Rec R = rec_of(kind);
  constexpr int KTU = C / 64;
  const int nch = SLAB / C;
  constexpr int NT1 = (C > 128 ? C / 128 : 1), NTT = NT1 * NT1;
  const int n_sc = nch * R.H * NTT;
  const int mtn = R.DK / 128, ntn = R.DV / 128;
  const int n_u = nch * R.H * 2 * mtn * ntn, G = gridDim.x;
  const u16* pj = (const u16*)(WS(P) + O_PROJ);
  for (int item = BID(); item < n_sc; item += G) { const int tl = item % NTT, hh = (item / NTT) % R.H, cg = item / (NTT * R.H); rec_scores_item<C, DKT>(P, R, cg, hh, tl / NT1, tl % NT1); }
  const u16* kef = (const u16*)(WS(P) + O_KEF); const u16* keb = (const u16*)(WS(P) + O_KEB);
  u16* stfb = (u16*)(WS(P) + O_STF); u16* stbb = (u16*)(WS(P) + O_STB);
  Tiles<KTU> ta, tb;
#define U_DECODE(q_, nt_, mt_, dir_, h_, cgi_) int nt_, mt_, dir_, h_, cgi_; { int qq = (q_); nt_ = qq % ntn; qq /= ntn; mt_ = qq % mtn; qq /= mtn; dir_ = qq & 1; qq >>= 1; h_ = qq % R.H; cgi_ = qq / R.H; }
#define U_ISSUE(T_, nt_, mt_, dir_, h_, cgi_) tiles_issue<128, 128, false, false, KTU>(T_, (dir_ ? keb : kef) + (long)cgi_ * C * 1024 + h_ * R.DK + mt_ * 128, 1024, pj + (long)cgi_ * C * R.ldv + R.voff + h_ * R.DV + nt_ * 128, R.ldv)
#define U_RUN(T_, nt_, mt_, dir_, h_, cgi_) { f32x4 acc[4][2] = {}; gemm_run<128, 128, false, false, false, KTU>(acc, T_, (u16*)smem); \
    u16* st = (dir_ ? stbb : stfb) + (((long)cgi_ * R.H + h_) * R.DV + nt_ * 128) * R.DK + mt_ * 128; const int DK = R.DK; \
    epi_each<128, 128, false>(acc, [&](int r, int c, f32x4 val) { *(uint2*)(st + (long)c * DK + r) = make_uint2(pack2(val[0], val[1]), pack2(val[2], val[3])); }); }
  int q = BID();
  if (q < n_u) { U_DECODE(q, nt, mt, dir, h, cgi); U_ISSUE(ta, nt, mt, dir, h, cgi); }
  for (; q < n_u; q += 2 * G) {
    U_DECODE(q, nt, mt, dir, h, cgi);
    const int q2 = q + G;
    if (q2 < n_u) { U_DECODE(q2, nt2, mt2, dir2, h2, cgi2); U_ISSUE(tb, nt2, mt2, dir2, h2, cgi2); }
    U_RUN(ta, nt, mt, dir, h, cgi);
    const int q3 = q + 2 * G;
    if (q3 < n_u) { U_DECODE(q3, nt3, mt3, dir3, h3, cgi3); U_ISSUE(ta, nt3, mt3, dir3, h3, cgi3); }
    if (q2 < n_u) { U_DECODE(q2, nt2, mt2, dir2, h2, cgi2); U_RUN(tb, nt2, mt2, dir2, h2, cgi2); }
  }
#undef U_DECODE
#undef U_ISSUE
#undef U_RUN
  __syncthreads();
}

__device__ void phase_rec_scan(const Params& P, int kind, int slab, bool dry = false) {
  const Rec R = rec_of(kind);
  const int L = Lof(slab), nseq = SLAB / L, ncs = L / R.C;
  const int qdk = R.DK / 4;
  const long per = (long)R.H * R.DV * qdk;
  const long total = 2 * nseq * per;
  const long gtid = (long)BID() * NT + TID(), gsz = (long)gridDim.x * NT;
  for (long idx = gtid; idx < total; idx += gsz) {
    long q = idx;
    const int pd = (int)(q % qdk); q /= qdk;
    const int e = (int)(q % R.DV); q /= R.DV;
    const int h = (int)(q % R.H); q /= R.H;
    const int seq = (int)(q % nseq);
    const int dir = (int)(q / nseq);
    u16* st = (u16*)(WS(P) + (dir ? O_STB : O_STF));
    u16* stw = dry ? (u16*)(WS(P) + O_OBUF) : st;
    const float* dl = (const float*)(WS(P) + (dir ? O_DLB : O_DLF));
    float s0 = 0.f, s1 = 0.f, s2 = 0.f, s3 = 0.f;
    const long ebase = ((long)h * R.DV + e) * R.DK + pd * 4;
    const long cstride = (long)R.H * R.DV * R.DK;
    const int dbase = h * R.DK + pd * 4;
    for (int i0 = 0; i0 < ncs; i0 += 8) {
      uint2 u[8];
      float4 dd[8];
#pragma unroll
      for (int j = 0; j < 8; ++j) {
        const int n = dir ? (ncs - 1 - i0 - j) : (i0 + j);
        const long cgi = (long)seq * ncs + n;
        u[j] = *(const uint2*)(st + cgi * cstride + ebase);
        dd[j] = *(const float4*)(dl + cgi * 1024 + dbase);
      }
#pragma unroll
      for (int j = 0; j < 8; ++j) {
        const int n = dir ? (ncs - 1 - i0 - j) : (i0 + j);
        const long cgi = (long)seq * ncs + n;
        *(uint2*)(stw + cgi * cstride + ebase) = make_uint2(pack2(s0, s1), pack2(s2, s3));
        s0 = dd[j].x * s0 + bf2f((u16)(u[j].x & 0xffff));
        s1 = dd[j].y * s1 + bf2f((u16)(u[j].x >> 16));
        s2 = dd[j].z * s2 + bf2f((u16)(u[j].y & 0xffff));
        s3 = dd[j].w * s3 + bf2f((u16)(u[j].y >> 16));
      }
    }
  }
}

template <int C, int DKT>
__device__ void phase_rec_out(const Params& P, int kind) {
  const Rec R = rec_of(kind);
  constexpr int T = C > 128 ? 128 : C, NRT = C / T;
  constexpr int KT1 = C / 64, KT2 = DKT;
  const int nch = SLAB / C, ntn = R.DV / 128;
  const u16* pj = (const u16*)(WS(P) + O_PROJ);
  const u16* scb = (const u16*)(WS(P) + O_SC);
  const u16* qdf = (const u16*)(WS(P) + O_QDF); const u16* qdb = (const u16*)(WS(P) + O_QDB);
  const u16* stf = (const u16*)(WS(P) + O_STF); const u16* stb = (const u16*)(WS(P) + O_STB);
  u16* ob = (u16*)(WS(P) + O_OBUF);
  const int HDV = R.H * R.DV;
  const int nitems = nch * R.H * NRT * ntn, G = gridDim.x;
  Tiles<KT1> t1; Tiles<KT2> t2; Tiles<KT2> t3;
  int item = BID();
  if (item < nitems) {
    const int nt = item % ntn, rt = (item / ntn) % NRT, h = (item / (ntn * NRT)) % R.H, cgi = item / (ntn * NRT * R.H);
    tiles_issue<T, 128, true, false, KT1>(t1, scb + (((long)cgi * R.H + h) * C + rt * T) * C, C, pj + (long)cgi * C * R.ldv + R.voff + h * R.DV + nt * 128, R.ldv);
  }
  for (; item < nitems; item += G) {
    const int nt = item % ntn, rt = (item / ntn) % NRT, h = (item / (ntn * NRT)) % R.H, cgi = item / (ntn * NRT * R.H);
    const long qoff = ((long)cgi * C + rt * T) * 1024 + h * R.DK;
    const long soff = (((long)cgi * R.H + h) * R.DV + nt * 128) * R.DK;
    f32x4 acc[T / 32][2] = {};
    tiles_issue<T, 128, true, true, KT2>(t2, qdf + qoff, 1024, stf + soff, R.DK);
    gemm_run<T, 128, true, false, true, KT1>(acc, t1, (u16*)smem);
    tiles_issue<T, 128, true, true, KT2>(t3, qdb + qoff, 1024, stb + soff, R.DK);
    gemm_run<T, 128, true, true, true, KT2>(acc, t2, (u16*)smem);
    const int nx = item + G;
    if (nx < nitems) {
      const int nt2 = nx % ntn, rt2 = (nx / ntn) % NRT, h2 = (nx / (ntn * NRT)) % R.H, cg2 = nx / (ntn * NRT * R.H);
      tiles_issue<T, 128, true, false, KT1>(t1, scb + (((long)cg2 * R.H + h2) * C + rt2 * T) * C, C, pj + (long)cg2 * C * R.ldv + R.voff + h2 * R.DV + nt2 * 128, R.ldv);
    }
    gemm_run<T, 128, true, true, true, KT2>(acc, t3, (u16*)smem);
    u16* o = ob + ((long)cgi * C + rt * T) * HDV + h * R.DV + nt * 128;
    epi_each<T, 128, true>(acc, [&](int r, int c, f32x4 val) { *(uint2*)(o + (long)r * HDV + c) = make_uint2(pack2(val[0], val[1]), pack2(val[2], val[3])); });
  }
  __syncthreads();
}

template <int KIND>
__device__ void phase_rec_ng_t(const Params& P) {
  const Rec R = rec_of(KIND);
  constexpr int DV = (KIND == 1) ? 512 : 128, H = (KIND == 1) ? 4 : 8, PER = DV / 64, HDV = H * DV;
  const u16* __restrict__ ob = (const u16*)(WS(P) + O_OBUF);
  const u16* __restrict__ pj = (const u16*)(WS(P) + O_PROJ);
  u16* __restrict__ a2 = (u16*)(WS(P) + O_A2);
  const float* gain = P.in[29];
  const int tid = TID(), lane = tid & 63, wid = tid >> 6;
  constexpr int nrows = SLAB * H;
  for (int item = BID(); item < nrows / 32; item += gridDim.x) {
    float v[4][PER];
    float ss[4];
#pragma unroll
    for (int u = 0; u < 4; ++u) {
      const int rh = item * 32 + wid * 4 + u;
      const int t = rh / H, h = rh % H;
      const u16* o = ob + (long)t * HDV + h * DV + lane * PER;
      if (PER == 8) {
        float f8[8];
        unpack8(*(const uint4*)o, f8);
#pragma unroll
        for (int i = 0; i < 8; ++i) v[u][i % PER] = f8[i];
      } else {
        const unsigned w = *(const unsigned*)o;
        v[u][0] = bf2f((u16)(w & 0xffff)); v[u][1 % PER] = bf2f((u16)(w >> 16));
      }
      float a = 0.f;
#pragma unroll
      for (int i = 0; i < PER; ++i) a += v[u][i] * v[u][i];
      ss[u] = a;
    }
#pragma unroll
    for (int u = 0; u < 4; ++u) ss[u] = wave_sum(ss[u]);
#pragma unroll
    for (int u = 0; u < 4; ++u) {
      const int rh = item * 32 + wid * 4 + u;
      const int t = rh / H, h = rh % H;
      const float rstd = rsqrtf(ss[u] / (float)DV + 1e-6f);
      const u16* g = pj + (long)t * R.ldv + R.goff + h * DV + lane * PER;
      u16* out = a2 + (long)t * HDV + h * DV + lane * PER;
      float y[PER];
#pragma unroll
      for (int i = 0; i < PER; ++i) {
        y[i] = v[u][i] * rstd;
        if (KIND == 3) y[i] *= gain[lane * PER + i];
      }
      if (PER == 8) {
        const uint4 gw = *(const uint4*)g;
        float gf[8];
        unpack8(gw, gf);
        float r8[8];
#pragma unroll
        for (int i = 0; i < 8; ++i) r8[i] = y[i % PER] * silu_f(gf[i]);
        *(uint4*)out = pack8s(r8, 1.f);
      } else {
        const unsigned gw = *(const unsigned*)g;
        *(unsigned*)out = pack2(y[0] * silu_f(bf2f((u16)(gw & 0xffff))), y[1 % PER] * silu_f(bf2f((u16)(gw >> 16))));
      }
    }
  }
}
__device__ void phase_rec_ng(const Params& P, int kind) {
  if (kind == 1) phase_rec_ng_t<1>(P); else phase_rec_ng_t<3>(P);
}

__device__ void phase_swa_prep(const Params& P, int slab) {
  const int L = Lof(slab);
  const u16* pj = (const u16*)(WS(P) + O_PROJ);
  u16* qn = (u16*)(WS(P) + O_QN);
  u16* kn = (u16*)(WS(P) + O_KN);
  const float2* rope = (const float2*)(WS(P) + O_ROPES);
  const long gtid = (long)BID() * NT + TID(), gsz = (long)gridDim.x * NT;
  for (long idx = gtid; idx < (long)SLAB * 640; idx += gsz) {
    const int d = (int)(idx & 31);
    const int hd = (int)((idx >> 5) % 20);
    const int t = (int)(idx / 640);
    const int col = hd < 16 ? hd * 64 : 1024 + (hd - 16) * 64;
    const float x1 = bf2f(pj[(long)t * 1536 + col + d]), x2 = bf2f(pj[(long)t * 1536 + col + d + 32]);
    float ss = x1 * x1 + x2 * x2;
#pragma unroll
    for (int o = 16; o; o >>= 1) ss += __shfl_xor(ss, o);
    const float rstd = rsqrtf(ss * (1.f / 64.f) + 1e-6f);
    const float* gn = hd < 16 ? P.in[23] : P.in[24];
    const float y1 = x1 * rstd * gn[d], y2 = x2 * rstd * gn[d + 32];
    const float2 cs = rope[(long)(t & (L - 1)) * 32 + d];
    float o1 = y1 * cs.x - y2 * cs.y, o2 = y1 * cs.y + y2 * cs.x;
    if (hd < 16) {
      qn[(long)t * 1024 + hd * 64 + d] = f2bf(o1 * 0.125f);
      qn[(long)t * 1024 + hd * 64 + d + 32] = f2bf(o2 * 0.125f);
    } else {
      kn[(long)t * 256 + (hd - 16) * 64 + d] = f2bf(o1);
      kn[(long)t * 256 + (hd - 16) * 64 + d + 32] = f2bf(o2);
    }
  }
}

constexpr int SLD = 324;
__device__ void phase_swa_att(const Params& P, int slab) {
  const int L = Lof(slab), nqb = L / 64;
  const u16* qn = (const u16*)(WS(P) + O_QN);
  const u16* kn = (const u16*)(WS(P) + O_KN);
  const u16* pj = (const u16*)(WS(P) + O_PROJ);
  u16* a2 = (u16*)(WS(P) + O_A2);
  const float* sink = P.in[25];
  float* S = (float*)(smem + 40960);
  u16* Bs = (u16*)smem + 9216;
  const int tid = TID(), lane = tid & 63, wid = tid >> 6;
  const int wm = wid >> 2, wn = wid & 3, fr = lane & 15, fq = lane >> 4;
  const int nitems = (SLAB / 64) * 16;
  for (int item = BID(); item < nitems; item += gridDim.x) {
    const int hq = item & 15, qbg = item >> 4;
    const int seq = qbg / nqb, qb = qbg % nqb;
    const int q0 = qb * 64;
    const long tok0 = (long)seq * L;
    const int hkv = hq >> 2;
    uint4 vt[5];
#pragma unroll
    for (int kt = 0; kt < 5; ++kt) {
      const int kp0 = q0 - 128 + kt * 64;
      vt[kt] = make_uint4(0, 0, 0, 0);
      if (kp0 >= 0 && kp0 < L) vt[kt] = ld_chunk<64, false>(pj + (tok0 + kp0) * 1536 + 1280 + hkv * 64, 1536, 0, tid);
    }
    for (int kt = 0; kt < 5; ++kt) {
      const int kp0 = q0 - 128 + kt * 64;
      if (kp0 >= 0 && kp0 < L) {
        f32x4 acc[2][1] = {};
        gemm_acc<64, 64, true, true, true, 1>(acc, qn + (tok0 + q0) * 1024 + hq * 64, 1024, kn + (tok0 + kp0) * 256 + hkv * 64, 256, (u16*)smem);
        epi_each<64, 64, true>(acc, [&](int r, int c, f32x4 v) {
          f32x4 o;
#pragma unroll
          for (int j = 0; j < 4; ++j) {
            const int dlt = (q0 + r) - (kp0 + c + j);
            o[j] = (dlt <= 128 && dlt >= -128) ? v[j] : -1e30f;
          }
          *(f32x4*)(S + r * SLD + kt * 64 + c) = o;
        });
      } else {
        for (int i = tid; i < 4096; i += NT) S[(i >> 6) * SLD + kt * 64 + (i & 63)] = -1e30f;
      }
    }
    __syncthreads();
    {
      const int r = tid >> 3, sub = tid & 7;
      const float sk = sink[hq];
      float e[40];
      float m = sk;
#pragma unroll
      for (int i = 0; i < 40; ++i) { e[i] = S[r * SLD + sub + 8 * i]; m = fmaxf(m, e[i]); }
      m = fmaxf(m, __shfl_xor(m, 1)); m = fmaxf(m, __shfl_xor(m, 2)); m = fmaxf(m, __shfl_xor(m, 4));
      float den = 0.f;
#pragma unroll
      for (int i = 0; i < 40; ++i) { e[i] = __expf(e[i] - m); den += e[i]; }
      den += __shfl_xor(den, 1); den += __shfl_xor(den, 2); den += __shfl_xor(den, 4);
      den += __expf(sk - m);
      const float inv = 1.f / den;
      u16* prow = (u16*)(S + r * SLD);
#pragma unroll
      for (int i = 0; i < 40; ++i) prow[sub + 8 * i] = f2bf(e[i] * inv);
    }
    __syncthreads();
    f32x4 acc[2][1] = {};
#pragma unroll
    for (int kt = 0; kt < 5; ++kt) {
      const int kp0 = q0 - 128 + kt * 64;
      if (kp0 >= 0 && kp0 < L) {
        __syncthreads();
        st_chunk<64, false>(Bs, vt[kt], tid);
        __syncthreads();
#pragma unroll
        for (int ks = 0; ks < 2; ++ks) {
          bf16x8 af[2];
#pragma unroll
          for (int mi = 0; mi < 2; ++mi) af[mi] = *(const bf16x8*)((const u16*)(S + (wm * 32 + mi * 16 + fr) * SLD) + kt * 64 + ks * 32 + fq * 8);
          const bf16x8 bfr = ld_frag<64, false>(Bs, wn * 16, ks, fr, fq);
#pragma unroll
          for (int mi = 0; mi < 2; ++mi) acc[mi][0] = __builtin_amdgcn_mfma_f32_16x16x32_bf16(bfr, af[mi], acc[mi][0], 0, 0, 0);
        }
      }
    }
    u16* o = a2 + (tok0 + q0) * 1024 + hq * 64;
    epi_each<64, 64, true>(acc, [&](int r, int c, f32x4 v) { *(uint2*)(o + (long)r * 1024 + c) = make_uint2(pack2(v[0], v[1]), pack2(v[2], v[3])); });
    __syncthreads();
  }
}

#define XB_TMO      128
#define XB_XCNT(j)  (256  + 64 * (j))
#define XB_XSUB(j)  (1280 + 64 * (j))
#define XB_XGEN(j)  (2304 + 64 * (j))
#define XB_TOP      3328
#define XB_TOPGEN   3392
#define XCD_BAR_WORDS 3456
#define XB_SPIN_CAP (1u << 18)
__device__ __forceinline__ unsigned xb_ld(unsigned* p)              { return __hip_atomic_load(p, __ATOMIC_RELAXED, __HIP_MEMORY_SCOPE_AGENT); }
__device__ __forceinline__ unsigned xb_add(unsigned* p, unsigned v) { return __hip_atomic_fetch_add(p, v, __ATOMIC_RELAXED, __HIP_MEMORY_SCOPE_AGENT); }
__device__ __forceinline__ unsigned xb_xcc_id() { return (unsigned)__builtin_amdgcn_s_getreg((3 << 11) | 20) & 0xFu; }
#define XB_SPIN(cond, bar) do { unsigned _sp = 0; while (cond) { __builtin_amdgcn_s_sleep(1); \
    if ((++_sp & 255u) == 0u) { if (xb_ld(&(bar)[XB_TMO])) break; if (_sp > XB_SPIN_CAP) { atomicAdd(&(bar)[XB_TMO], 1u); break; } } } } while (0)
struct XcdBarrier { unsigned* bar; unsigned x; volatile LDS_AS unsigned* st; };
__device__ __forceinline__ XcdBarrier xcd_barrier_post(unsigned* bar, volatile LDS_AS unsigned* st) {
    XcdBarrier b; b.bar = bar; b.x = xb_xcc_id(); b.st = st;
    if (threadIdx.x == 0) (void)xb_add(&bar[XB_XCNT(b.x)], 1u);
    return b;
}
__device__ __forceinline__ void xcd_barrier_complete(unsigned* bar, unsigned x, unsigned& nloc, unsigned& nx) {
    const unsigned G = gridDim.x * gridDim.y * gridDim.z;
    unsigned sum, cnt, mine, sp = 0u;
    for (;;) {
        sum = 0u; cnt = 0u; mine = 0u;
#pragma unroll
        for (unsigned j = 0; j < 16; ++j) { const unsigned c = xb_ld(&bar[XB_XCNT(j)]); sum += c; cnt += (c > 0u) ? 1u : 0u; mine = (j == x) ? c : mine; }
        if (sum == G) break;
        __builtin_amdgcn_s_sleep(1);
        if ((++sp & 255u) == 0u) { if (xb_ld(&bar[XB_TMO])) break; if (sp > XB_SPIN_CAP) { atomicAdd(&bar[XB_TMO], 1u); break; } }
    }
    nloc = mine > 0u ? mine : 1u; nx = cnt > 0u ? cnt : 1u;
}
__device__ __forceinline__ void xcd_barrier(const XcdBarrier& b) {
    asm volatile("s_waitcnt vmcnt(0)" ::: "memory");
    __syncthreads();
    if (threadIdx.x == 0) {
        unsigned* bar = b.bar;
        __builtin_amdgcn_s_waitcnt(0);
        unsigned nloc = b.st[0], nx = b.st[1];
        if (nloc == 0u) { xcd_barrier_complete(bar, b.x, nloc, nx); b.st[0] = nloc; b.st[1] = nx; }
        const unsigned old = xb_add(&bar[XB_XSUB(b.x)], 1u);
        const unsigned gen = old / nloc;
        if (old + 1u == (gen + 1u) * nloc) {
            __builtin_amdgcn_fence(__ATOMIC_RELEASE, "agent");
            asm volatile("s_waitcnt vmcnt(0)" ::: "memory");
            const unsigned og = xb_add(&bar[XB_TOP], 1u);
            const unsigned tg = og / nx;
            if (og + 1u == (tg + 1u) * nx) xb_add(&bar[XB_TOPGEN], 1u);
            else XB_SPIN(xb_ld(&bar[XB_TOPGEN]) == tg, bar);
            __builtin_amdgcn_fence(__ATOMIC_ACQUIRE, "agent");
            xb_add(&bar[XB_XGEN(b.x)], 1u);
            asm volatile("s_waitcnt vmcnt(0)" ::: "memory");
        } else {
            XB_SPIN(xb_ld(&bar[XB_XGEN(b.x)]) == gen, bar);
            __builtin_amdgcn_fence(__ATOMIC_ACQUIRE, "agent");
            asm volatile("s_waitcnt vmcnt(0)" ::: "memory");
        }
    }
    __syncthreads();
}

__device__ __forceinline__ int nmix_of(int kind) { return (kind & 1) ? 8 : (kind == 2 ? 5 : 6); }

__device__ void ffn_step(const Params& P, int layer, int f) {
  if (f == 6) { phase_ffn_down(P, layer); return; }
  const int fs = f / 3, st = f % 3;
  if (st == 0) { REP(4) phase_norm(P, layer, fs, 1); }
  else if (st == 1) { REP(0) phase_ffn_gate(P, layer); }
  else { REP(0) phase_ffn_val(P, layer, fs); }
}
__device__ void layer_step(const Params& P, int layer, int slab, int step) {
  const int kind = layer;
  if (step == 0) { REP(4) phase_norm(P, layer, slab, 0); return; }
  if (kind == 0) {
    if (step == 1) { REP(0) phase_proj(P, O_WHYIN, 3072); }
    else if (step == 2) { REP(3) phase_hy_conv(P, slab); }
    else if (step == 3) { if ((PROBE_MASK >> 7) & 1) phase_hy_fft(P, slab, true); phase_hy_fft(P, slab); }
    else if (step == 4) { REP(3) phase_hy_tr(P, slab); }
    else phase_resid(P, layer, slab, (const u16*)(WS(P) + O_A2), 1024, O_WHYOUT, 2 * D);
  } else if (kind == 1) {
    if (step == 1) { REP(0) phase_proj(P, O_WRETIN, 6144); }
    else if (step == 2) { REP(1) REP(9) phase_ret_prep(P, slab); }
    else if (step == 3) { REP(1) REP(11) phase_rec_su<256, 4>(P, 1); }
    else if (step == 4) { if ((PROBE_MASK >> 6) & 1) phase_rec_scan(P, 1, slab, true); phase_rec_scan(P, 1, slab); }
    else if (step == 5) { REP(1) REP(12) phase_rec_out<256, 4>(P, 1); }
    else if (step == 6) { REP(1) REP(9) phase_rec_ng(P, 1); }
    else phase_resid(P, layer, slab, (const u16*)(WS(P) + O_A2), 2048, O_WRETOUT, 2 * D);
  } else if (kind == 2) {
    if (step == 1) { REP(0) phase_proj(P, O_WSWAIN, 1536); }
    else if (step == 2) { REP(2) REP(14) phase_swa_prep(P, slab); }
    else if (step == 3) { REP(2) REP(15) phase_swa_att(P, slab); }
    else phase_resid(P, layer, slab, (const u16*)(WS(P) + O_A2), 1024, O_WSWAOUT, 2 * D);
  } else {
    if (step == 1) { REP(0) phase_proj(P, O_WHGIN, 5120); }
    else if (step == 2) { REP(1) REP(9) phase_hg_prep(P); }
    else if (step == 3) { REP(1) REP(11) phase_rec_su<128, 2>(P, 3); }
    else if (step == 4) { if ((PROBE_MASK >> 6) & 1) phase_rec_scan(P, 3, slab, true); phase_rec_scan(P, 3, slab); }
    else if (step == 5) { REP(1) REP(12) phase_rec_out<128, 2>(P, 3); }
    else if (step == 6) { REP(1) REP(9) phase_rec_ng(P, 3); }
    else phase_resid(P, layer, slab, (const u16*)(WS(P) + O_A2), 1024, O_WHGOUT, 2 * D);
  }
}

__global__ void __launch_bounds__(NT) fwd_megakernel(Params P) {
  cg::grid_group grid = cg::this_grid();
  __shared__ uint4 xb_words;
  if (threadIdx.x == 0) xb_words = make_uint4(0u, 0u, 0u, 0u);
  __syncthreads();
  XcdBarrier xb = xcd_barrier_post((unsigned*)(P.ws + O_BAR), (volatile LDS_AS unsigned*)&xb_words);
  for (int pid = P.p0; pid < P.p1; ++pid) {
    if (pid == 0) { REP(5) phase_pre0(P); }
    else if (pid == 1) { REP(5) phase_pre1(P); }
    else {
      int q = pid - 2, layer = 0;
      while (q >= 5 * nmix_of(layer) + 7) { q -= 5 * nmix_of(layer) + 7; ++layer; }
      const int nm = nmix_of(layer);
      if (q < 5 * nm) layer_step(P, layer, q / nm, q % nm);
      else ffn_step(P, layer, q - 5 * nm);
    }
    if (pid + 1 < P.p1) {
      if (pid == 0) grid.sync();
      else xcd_barrier(xb);
      if ((PROBE_MASK >> 8) & 1) xcd_barrier(xb);
    }
  }
}

extern "C" void kernel_launch(void* const* d_in, const int* in_sizes, int n_in, void* d_out, int out_size, void* d_ws,
                              size_t ws_size, hipStream_t stream) {
  static int grid_blocks = 0;
  if (!grid_blocks) {
    int dev = 0, cus = 0, per_cu = 0;
    (void)hipGetDevice(&dev);
    (void)hipDeviceGetAttribute(&cus, hipDeviceAttributeMultiprocessorCount, dev);
    (void)hipFuncSetAttribute((const void*)fwd_megakernel, hipFuncAttributeMaxDynamicSharedMemorySize, LDSB);
    (void)hipOccupancyMaxActiveBlocksPerMultiprocessor(&per_cu, (const void*)fwd_megakernel, NT, LDSB);
    if (per_cu < 1) per_cu = 1;
    if (per_cu > 1) per_cu = 1;
    grid_blocks = cus * per_cu;
    if (ws_size < WS_END) fprintf(stderr, "kernel_launch: workspace too small: %zu < %zu\n", ws_size, (size_t)WS_END);
  }
  Params p;
  memset(&p, 0, sizeof(p));
  for (int i = 0; i < 36; ++i) p.in[i] = (const float*)d_in[i];
  p.out = (float*)d_out;
  p.ws = (unsigned char*)d_ws;
  (void)hipMemsetAsync((unsigned char*)d_ws + O_BAR, 0, XCD_BAR_WORDS * 4, stream);
#if ONE_LAUNCH
  p.p0 = 0; p.p1 = NPHASES;
  void* args[] = {&p};
  hipError_t e = hipLaunchCooperativeKernel((const void*)fwd_megakernel, dim3(grid_blocks), dim3(NT), args, LDSB, stream);
  if (e != hipSuccess) fprintf(stderr, "cooperative launch failed: %s (grid %d)\n", hipGetErrorString(e), grid_blocks);
#else
  for (int ph = 0; ph < NPHASES; ++ph) {
    p.p0 = ph; p.p1 = ph + 1;
    hipLaunchKernelGGL(fwd_megakernel, dim3(grid_blocks), dim3(NT), LDSB, stream, p);
  }
#endif
}
```

```cpp
#include <hip/hip_runtime.h>
#include <hip/hip_cooperative_groups.h>
#include <cstdio>
#include <cstdint>
#include <cstring>
namespace cg = cooperative_groups;

typedef unsigned short u16;
typedef __attribute__((ext_vector_type(8))) short bf16x8;
typedef __attribute__((ext_vector_type(4))) float f32x4;

#define NT 512
#ifndef ONE_LAUNCH
#define ONE_LAUNCH 1
#endif
#ifndef PROBE_MASK
#define PROBE_MASK 0
#endif
#define REP(cls) for (int rep_##cls = 0; rep_##cls < (((PROBE_MASK >> (cls)) & 1) ? 2 : 1); ++rep_##cls)

constexpr int D = 1024, SLAB = 16384, DFF = 2816;
constexpr int LDSB = 139264;
constexpr int FSLAB = 40960, NTOK = 81920;
constexpr int NPHASES = 2 + 5 * (6 + 8 + 5 + 8) + 4 * 7;

constexpr size_t SZW(size_t n, size_t k) { return n * k * 2; }
constexpr size_t O_WHYIN = 0;
constexpr size_t O_WHYOUT = O_WHYIN + SZW(3072, 1024);
constexpr size_t O_WRETIN = O_WHYOUT + SZW(1024, 1024);
constexpr size_t O_WRETOUT = O_WRETIN + SZW(6144, 1024);
constexpr size_t O_WSWAIN = O_WRETOUT + SZW(1024, 2048);
constexpr size_t O_WSWAOUT = O_WSWAIN + SZW(1536, 1024);
constexpr size_t O_WHGIN = O_WSWAOUT + SZW(1024, 1024);
constexpr size_t O_WHGOUT = O_WHGIN + SZW(5120, 1024);
constexpr size_t O_WFG = O_WHGOUT + SZW(1024, 1024);
constexpr size_t O_WFV = O_WFG + 4 * SZW(2816, 1024);
constexpr size_t O_WFD = O_WFV + 4 * SZW(2816, 1024);
constexpr size_t O_MOD = O_WFD + 4 * SZW(1024, 2816);
constexpr size_t O_TW = O_MOD + (size_t)4 * 16 * 6144 * 4;
constexpr size_t O_HIDS = O_TW + 8192 * 8;
constexpr size_t O_HIDP = O_HIDS + (size_t)8192 * 64 * 4;
constexpr size_t O_ROPER = O_HIDP + (size_t)2048 * 64 * 4;
constexpr size_t O_ROPES = O_ROPER + (size_t)8192 * 128 * 8;
constexpr size_t O_PROJ = O_ROPES + (size_t)8192 * 32 * 8;
constexpr size_t O_HBUF = O_PROJ + (size_t)SLAB * 6144 * 2;
constexpr size_t O_A2 = O_HBUF + (size_t)SLAB * 1024 * 2;
constexpr size_t O_C = O_A2 + (size_t)SLAB * 2048 * 2;
constexpr size_t O_FHBUF = O_PROJ;
constexpr size_t O_FGBUF = O_FHBUF + (size_t)FSLAB * 1024 * 2;
constexpr size_t O_FACT = O_FGBUF + (size_t)FSLAB * DFF * 2;
constexpr size_t END_F = O_FACT + (size_t)NTOK * DFF * 2;
constexpr size_t O_MODP = O_C;
constexpr size_t O_BAR = ((size_t)1 << 30) - 16384;
constexpr size_t O_HSPS = O_BAR - (size_t)1024 * 16384 * 8 - (size_t)1024 * 4096 * 8;
constexpr size_t O_HSPP = O_HSPS + (size_t)1024 * 16384 * 8;
constexpr size_t O_UT = O_C;
constexpr size_t O_X0C = O_UT + (size_t)SLAB * 1024 * 4;
constexpr size_t END_HY = O_X0C + (size_t)SLAB * 1024 * 2;
static_assert(END_F <= O_HSPS && END_HY <= O_HSPS, "layer-0 buffers overlap the filter spectra");
constexpr size_t SZP = (size_t)SLAB * 1024 * 2;
constexpr size_t O_QDF = O_C, O_QDB = O_QDF + SZP, O_KIF = O_QDB + SZP, O_KIB = O_KIF + SZP, O_KEF = O_KIB + SZP, O_KEB = O_KEF + SZP;
constexpr size_t O_DLF = O_KEB + SZP;
constexpr size_t O_DLB = O_DLF + (size_t)256 * 1024 * 4;
constexpr size_t O_SC = O_DLB + (size_t)256 * 1024 * 4;
constexpr size_t O_STF = O_SC + (size_t)SLAB * 1024 * 2;
constexpr size_t O_STB = O_STF + (size_t)134217728;
constexpr size_t O_OBUF = O_STB + (size_t)134217728;
constexpr size_t END_REC = O_OBUF + (size_t)SLAB * 2048 * 4;
constexpr size_t O_QN = O_C;
constexpr size_t O_KN = O_QN + SZP;
constexpr size_t O_PBUF = O_KN + (size_t)SLAB * 256 * 2;
constexpr size_t END_SWA = O_PBUF + (size_t)SLAB * 16 * 320 * 2;
constexpr size_t WS_END = END_REC > END_HY ? (END_REC > END_SWA ? END_REC : END_SWA) : (END_HY > END_SWA ? END_HY : END_SWA);
static_assert(WS_END <= O_BAR, "workspace exceeds 1 GiB");

struct Params {
  const float* in[36];
  float* out;
  unsigned char* ws;
  int p0, p1;
};

extern __shared__ __attribute__((aligned(16))) unsigned char smem[];

__device__ __forceinline__ int TID() { int t = threadIdx.x; asm volatile("" : "+v"(t)); return t; }
__device__ __forceinline__ int BID() { int b = blockIdx.x; asm volatile("" : "+s"(b)); return b; }
__device__ __forceinline__ long ZOFF() { long z = 0; asm volatile("" : "+s"(z)); return z; }
__device__ __forceinline__ unsigned char* WS(const Params& P) { return P.ws + ZOFF(); }
__device__ __forceinline__ float* OUTP(const Params& P) { return P.out + ZOFF(); }

namespace pg8 {
#define PG8_LAS __attribute__((address_space(3)))
typedef unsigned short bf16_t;
typedef short bf16x8 __attribute__((ext_vector_type(8)));
typedef float f32x4 __attribute__((ext_vector_type(4)));
typedef unsigned u32x4 __attribute__((ext_vector_type(4)));
constexpr int BM = 256, BK = 64, HALF = 128, HTB = HALF * BK * 2  , STAGE_BYTES = 8 * HTB, NXCD = 8, WGM = 8;

__host__ __device__ __forceinline__ int lds_byte(int r, int c) { const int st = (r >> 4) * 2 + (c >> 5), rr = r & 15, cc = c & 31, ob = rr * 64 + cc * 2; return st * 1024 + (ob ^ (((ob >> 9) & 1) << 5)); }
__host__ __device__ __forceinline__ void stage_rc(int b, int& R, int& C) { const int st = b / 1024, sb = b % 1024, swz = sb ^ (((sb >> 9) & 1) << 5); R = (st >> 1) * 16 + swz / 64; C = (st & 1) * 32 + (swz % 64) / 2; }
__host__ __device__ __forceinline__ int perm32(int rho) { const int n = rho >> 4, i = rho & 15; return 8 * (i >> 2) + 4 * n + (i & 3); }

struct Unit { int pm, pn; };
struct Gemm { const bf16_t* A; const bf16_t* Bt; int M, N, K; };

struct StaticOrder {
    int nM, nN, nwg, G, c;
    __host__ __device__ void init(int M, int N, int G_, int c_) { nM = M / BM; nN = N / BM; nwg = nM * nN; G = G_; c = c_; }
    __host__ __device__ bool next(int i, Unit& u) const {
        const long L = (long)i * G + c; if (L >= nwg) return false;
        int wgid = (int)L; { const int q = nwg / NXCD, r = nwg % NXCD, xcd = wgid % NXCD, off = wgid / NXCD; wgid = (xcd < r ? xcd * (q + 1) : r * (q + 1) + (xcd - r) * q) + off; }
        const int nig = WGM * nN, gid = wgid / nig, fm = gid * WGM, gsz = (nM - fm) < WGM ? (nM - fm) : WGM;
        u.pm = fm + ((wgid % nig) % gsz); u.pn = (wgid % nig) / gsz; return true;
    }
    __device__ __forceinline__ void a_ready(const Unit&) const {}
    __device__ __forceinline__ void done(const Unit&) const {}
};

template <class Epi, class Sched, bool STAMP = false>
__device__ __forceinline__ void gemm_phase(PG8_LAS unsigned char* lds, const Gemm g, const Sched& S, const Epi& E, unsigned long long* stamps) {
    const int tid = TID(), wid = __builtin_amdgcn_readfirstlane(tid >> 6), lane = tid & 63, wr = wid >> 2, wc = wid & 3, fr = lane & 15, fq = lane >> 4;
    const int K = g.K, nt = K / BK;
    int ts_lo = 0, ts_hi = 0, nts = 0; const unsigned long long rt_entry = STAMP ? (unsigned long long)wall_clock64() : 0ull;
#define PG8_STAMP() do { if (STAMP && wid == 0 && nts < 64) { const unsigned long long _c = (unsigned long long)clock64(); \
        ts_lo = (lane == nts) ? (int)(unsigned)_c : ts_lo; ts_hi = (lane == nts) ? (int)(unsigned)(_c >> 32) : ts_hi; ++nts; } } while (0)
    PG8_STAMP();
    unsigned voffA[2], voffB[2];
#pragma unroll
    for (int i = 0; i < 2; ++i) { int R, C; stage_rc(tid * 16 + i * 8192, R, C); const int Rb = Epi::PERM ? ((R & ~31) + perm32(R & 31)) : R;
        voffA[i] = (unsigned)(R * K + C) * 2u; voffB[i] = (unsigned)(Rb * K + C) * 2u; }
    const size_t kstep = (size_t)(BK * 2);
    const size_t hstep = (size_t)HALF * K * 2;
    const size_t tstep = 2 * hstep;
    const unsigned ldsw = (unsigned)wid * 1024u;
    const int aoff = lds_byte(wr * 64 + fr, fq * 8), boff = lds_byte(wc * 32 + fr, fq * 8);
#define PG8_SA(b, h) (((b) * 2 + (h)) * HTB)
#define PG8_SB(b, h) ((4 + (b) * 2 + (h)) * HTB)
#define PG8_STAGE(bufoff, gbase, voff) do { _Pragma("unroll") for (int _i = 0; _i < 2; ++_i) \
        __builtin_amdgcn_global_load_lds((const unsigned*)((const char*)(gbase) + (voff)[_i]), (PG8_LAS unsigned*)(lds + (bufoff) + ldsw + _i * 8192), 16, 0, 0); } while (0)
#define PG8_LDA(dst, b, h) do { _Pragma("unroll") for (int m = 0; m < 4; ++m) _Pragma("unroll") for (int k = 0; k < 2; ++k) dst[m][k] = *(const PG8_LAS bf16x8*)(lds + PG8_SA(b, h) + aoff + m * 2048 + k * 1024); } while (0)
#define PG8_LDB(dst, b, h) do { _Pragma("unroll") for (int n = 0; n < 2; ++n) _Pragma("unroll") for (int k = 0; k < 2; ++k) dst[n][k] = *(const PG8_LAS bf16x8*)(lds + PG8_SB(b, h) + boff + n * 2048 + k * 1024); } while (0)
#define PG8_MMA(ai, bj, At, Bt) do { __builtin_amdgcn_s_setprio(1); _Pragma("unroll") for (int m = 0; m < 4; ++m) _Pragma("unroll") for (int n = 0; n < 2; ++n) _Pragma("unroll") for (int k = 0; k < 2; ++k) \
        acc[ai][bj][m][n] = __builtin_amdgcn_mfma_f32_16x16x32_bf16(Bt[n][k], At[m][k], acc[ai][bj][m][n], 0, 0, 0); __builtin_amdgcn_s_setprio(0); } while (0)
#define PG8_WAIT_V(n) asm volatile("s_waitcnt vmcnt(" #n ")" ::: "memory")
#define PG8_WAIT_L(n) asm volatile("s_waitcnt lgkmcnt(" #n ")" ::: "memory")
#define PG8_BAR __builtin_amdgcn_s_barrier()
#define PG8_SCHED __builtin_amdgcn_sched_barrier(0)
    Unit cur, nxt; int ui = 0;
    if (!S.next(0, cur)) return;
    f32x4 acc[2][2][4][2];
#pragma unroll
    for (int a = 0; a < 2; ++a)
#pragma unroll
        for (int b = 0; b < 2; ++b)
#pragma unroll
            for (int m = 0; m < 4; ++m)
#pragma unroll
                for (int n = 0; n < 2; ++n) acc[a][b][m][n] = (f32x4){0.f, 0.f, 0.f, 0.f};
    bf16x8 At[4][2], B0[2][2], B1[2][2];
    const char* cA = (const char*)g.A + (size_t)cur.pm * tstep; const char* cB = (const char*)g.Bt + (size_t)cur.pn * tstep;
    S.a_ready(cur);
    PG8_STAGE(PG8_SB(0, 0), cB, voffB); PG8_STAGE(PG8_SA(0, 0), cA, voffA); PG8_STAGE(PG8_SB(0, 1), cB + hstep, voffB); PG8_STAGE(PG8_SA(0, 1), cA + hstep, voffA);
    if (wr == 1) PG8_BAR;
    PG8_WAIT_V(4); PG8_BAR;
    PG8_STAGE(PG8_SB(1, 0), cB + kstep, voffB); PG8_STAGE(PG8_SA(1, 0), cA + kstep, voffA); PG8_STAGE(PG8_SB(1, 1), cB + hstep + kstep, voffB);
    PG8_WAIT_V(6); PG8_BAR;
    PG8_STAMP();
    for (;;) {
        const bool has_next = S.next(ui + 1, nxt);
        const char* nA = has_next ? (const char*)g.A + (size_t)nxt.pm * tstep : cA; const char* nB = has_next ? (const char*)g.Bt + (size_t)nxt.pn * tstep : cB;
        for (int t = 0; t < nt; t += 2) {
            const bool last = (t == nt - 2);
            const char* a1 = cA + (size_t)(t + 1) * kstep;
            const char* a2 = last ? nA : cA + (size_t)(t + 2) * kstep; const char* b2 = last ? nB : cB + (size_t)(t + 2) * kstep;
            const char* a3 = a2 + kstep; const char* b3 = b2 + kstep;
            if (last && has_next) S.a_ready(nxt);
            PG8_LDB(B0, 0, 0); PG8_SCHED; PG8_LDA(At, 0, 0); PG8_STAGE(PG8_SA(1, 1), a1 + hstep, voffA);
            PG8_WAIT_L(8); PG8_BAR; PG8_WAIT_L(0); PG8_MMA(0, 0, At, B0); PG8_BAR; PG8_SCHED;
            PG8_LDB(B1, 0, 1); PG8_STAGE(PG8_SB(0, 0), b2, voffB);
            PG8_BAR; PG8_WAIT_L(0); PG8_MMA(0, 1, At, B1); PG8_BAR;
            PG8_LDA(At, 0, 1); PG8_STAGE(PG8_SA(0, 0), a2, voffA);
            PG8_BAR; PG8_WAIT_L(0); PG8_MMA(1, 0, At, B0); PG8_BAR; PG8_SCHED;
            PG8_STAGE(PG8_SB(0, 1), b2 + hstep, voffB);
            PG8_WAIT_V(6); PG8_BAR; PG8_MMA(1, 1, At, B1); PG8_BAR;
            PG8_LDB(B0, 1, 0); PG8_SCHED; PG8_LDA(At, 1, 0); PG8_STAGE(PG8_SA(0, 1), a2 + hstep, voffA);
            PG8_WAIT_L(8); PG8_BAR; PG8_WAIT_L(0); PG8_MMA(0, 0, At, B0); PG8_BAR; PG8_SCHED;
            PG8_LDB(B1, 1, 1); PG8_STAGE(PG8_SB(1, 0), b3, voffB);
            PG8_BAR; PG8_WAIT_L(0); PG8_MMA(0, 1, At, B1); PG8_BAR;
            PG8_LDA(At, 1, 1); PG8_STAGE(PG8_SA(1, 0), a3, voffA);
            PG8_BAR; PG8_WAIT_L(0); PG8_MMA(1, 0, At, B0); PG8_BAR; PG8_SCHED;
            PG8_STAGE(PG8_SB(1, 1), b3 + hstep, voffB);
            PG8_WAIT_V(6); PG8_BAR; PG8_MMA(1, 1, At, B1); PG8_BAR;
        }
        PG8_STAMP();
        if constexpr (!Epi::AFTER_DRAIN) { E(acc, cur, wr, wc, fr, fq); S.done(cur); }
        PG8_STAMP();
        if (!has_next) break;
#pragma unroll
        for (int a = 0; a < 2; ++a)
#pragma unroll
            for (int b = 0; b < 2; ++b)
#pragma unroll
                for (int m = 0; m < 4; ++m)
#pragma unroll
                    for (int n = 0; n < 2; ++n) acc[a][b][m][n] = (f32x4){0.f, 0.f, 0.f, 0.f};
        cur = nxt; cA = nA; cB = nB; ++ui;
    }
    PG8_WAIT_V(0);
    if (wr == 0) PG8_BAR;
    PG8_BAR;
    if constexpr (Epi::AFTER_DRAIN) { E.fused(acc, cur, wr, wc, fr, fq, lds, wid, lane); S.done(cur); }
    PG8_STAMP();
    if (STAMP && wid == 0) { stamps[lane] = lane < nts ? (((unsigned long long)(unsigned)ts_hi << 32) | (unsigned)ts_lo) : 0ull;
        if (lane == 62) stamps[62] = rt_entry; if (lane == 63) stamps[63] = (unsigned long long)wall_clock64(); }
#undef PG8_STAMP
#undef PG8_SA
#undef PG8_SB
#undef PG8_STAGE
#undef PG8_LDA
#undef PG8_LDB
#undef PG8_MMA
#undef PG8_WAIT_V
#undef PG8_WAIT_L
#undef PG8_BAR
#undef PG8_SCHED
}
}


__device__ __forceinline__ u16 f2bf(float f) {
  unsigned u = __float_as_uint(f);
  u += 0x7fffu + ((u >> 16) & 1u);
  return (u16)(u >> 16);
}
__device__ __forceinline__ float bf2f(u16 h) { return __uint_as_float(((unsigned)h) << 16); }
__device__ __forceinline__ unsigned pack2(float a, float b) { return (unsigned)f2bf(a) | ((unsigned)f2bf(b) << 16); }
__device__ __forceinline__ void unpack8(const uint4 v, float (&f)[8]) {
  f[0] = bf2f((u16)(v.x & 0xffff)); f[1] = bf2f((u16)(v.x >> 16)); f[2] = bf2f((u16)(v.y & 0xffff)); f[3] = bf2f((u16)(v.y >> 16));
  f[4] = bf2f((u16)(v.z & 0xffff)); f[5] = bf2f((u16)(v.z >> 16)); f[6] = bf2f((u16)(v.w & 0xffff)); f[7] = bf2f((u16)(v.w >> 16));
}
__device__ __forceinline__ uint4 pack8s(const float (&f)[8], float sc) {
  return make_uint4(pack2(f[0] * sc, f[1] * sc), pack2(f[2] * sc, f[3] * sc), pack2(f[4] * sc, f[5] * sc), pack2(f[6] * sc, f[7] * sc));
}
__device__ __forceinline__ float silu_f(float x) { return x / (1.f + __expf(-x)); }
__device__ __forceinline__ float sigm(float x) { return 1.f / (1.f + __expf(-x)); }
__device__ __forceinline__ float wave_sum(float v) {
#pragma unroll
  for (int o = 32; o; o >>= 1) v += __shfl_xor(v, o);
  return v;
}
__device__ __forceinline__ const float* xin_of(const Params& P, int slab) { return slab == 0 ? P.in[0] : P.in[1] + (long)(slab - 1) * SLAB * D; }
__device__ __forceinline__ int Lof(int slab) { return slab == 0 ? 2048 : 8192; }
__device__ __forceinline__ int gb_row(int gr) { return gr < 16384 ? (gr >> 11) : (8 + ((gr - 16384) >> 13)); }
__device__ __forceinline__ int gb_of(int slab, int r) { return slab == 0 ? (r >> 11) : (8 + (slab - 1) * 2 + (r >> 13)); }

typedef short v4s __attribute__((ext_vector_type(4)));
#define LBAR() asm volatile("s_waitcnt lgkmcnt(0)\n\ts_barrier" ::: "memory")
#define LDS_AS __attribute__((address_space(3)))
template <int R, bool KC>
__device__ __forceinline__ uint4 ld_chunk(const u16* __restrict__ base, long ld, int k0, int c) {
  if (KC) {
    const int r = c >> 3, kc = c & 7;
    return *(const uint4*)(base + (long)r * ld + k0 + kc * 8);
  } else {
    const int k = c / (R / 8), mc = c % (R / 8);
    return *(const uint4*)(base + (long)(k0 + k) * ld + mc * 8);
  }
}
template <int R, bool KC>
__device__ __forceinline__ void st_chunk(u16* s, uint4 v, int c) {
  if (KC) {
    const int r = c >> 3, kc = c & 7;
    *(uint4*)(s + r * 72 + kc * 8) = v;
  } else {
    const int k = c / (R / 8), mc = c % (R / 8);
    *(uint4*)(s + k * (R + 8) + mc * 8) = v;
  }
}
template <int R, bool KC>
__device__ __forceinline__ bf16x8 ld_frag(const u16* s, int x0, int ks, int fr, int fq) {
  if (KC) {
    return *(const bf16x8*)(s + (x0 + fr) * 72 + ks * 32 + fq * 8);
  } else {
    const int q4 = fr >> 2, p4 = fr & 3;
    const u16* p = s + (ks * 32 + 8 * fq + q4) * (R + 8) + x0 + 4 * p4;
    v4s lo = __builtin_amdgcn_ds_read_tr16_b64_v4i16((LDS_AS v4s*)p);
    v4s hi = __builtin_amdgcn_ds_read_tr16_b64_v4i16((LDS_AS v4s*)(p + 4 * (R + 8)));
    bf16x8 r;
    r[0] = lo[0]; r[1] = lo[1]; r[2] = lo[2]; r[3] = lo[3]; r[4] = hi[0]; r[5] = hi[1]; r[6] = hi[2]; r[7] = hi[3];
    return r;
  }
}

template <int TM, int TN, bool AKC, bool BKC, bool TR, int KT>
__device__ __forceinline__ void gemm_acc(f32x4 (&acc)[TM / 32][TN / 64], const u16* __restrict__ A, long lda,
                                         const u16* __restrict__ B, long ldb, u16* sm) {
  u16* As = sm;
  u16* Bs = sm + 9216;
  const int tid = TID(), lane = tid & 63, wid = tid >> 6;
  const int wm = wid >> 2, wn = wid & 3, fr = lane & 15, fq = lane >> 4;
  constexpr int MI = TM / 32, NI = TN / 64;
  uint4 ra0[KT], ra1[KT], rb0[KT], rb1[KT];
#pragma unroll
  for (int kt = 0; kt < KT; ++kt) {
    ra0[kt] = ld_chunk<TM, AKC>(A, lda, kt * 64, tid);
    ra1[kt] = ra0[kt];
    if (TM == 128) ra1[kt] = ld_chunk<TM, AKC>(A, lda, kt * 64, tid + NT);
    rb0[kt] = ld_chunk<TN, BKC>(B, ldb, kt * 64, tid);
    rb1[kt] = rb0[kt];
    if (TN == 128) rb1[kt] = ld_chunk<TN, BKC>(B, ldb, kt * 64, tid + NT);
  }
#pragma unroll
  for (int kt = 0; kt < KT; ++kt) {
    __syncthreads();
    st_chunk<TM, AKC>(As, ra0[kt], tid);
    if (TM == 128) st_chunk<TM, AKC>(As, ra1[kt], tid + NT);
    st_chunk<TN, BKC>(Bs, rb0[kt], tid);
    if (TN == 128) st_chunk<TN, BKC>(Bs, rb1[kt], tid + NT);
    __syncthreads();
#pragma unroll
    for (int ks = 0; ks < 2; ++ks) {
      bf16x8 af[MI], bfr[NI];
#pragma unroll
      for (int mi = 0; mi < MI; ++mi) af[mi] = ld_frag<TM, AKC>(As, wm * (TM / 2) + mi * 16, ks, fr, fq);
#pragma unroll
      for (int ni = 0; ni < NI; ++ni) bfr[ni] = ld_frag<TN, BKC>(Bs, wn * (TN / 4) + ni * 16, ks, fr, fq);
#pragma unroll
      for (int mi = 0; mi < MI; ++mi)
#pragma unroll
        for (int ni = 0; ni < NI; ++ni)
          acc[mi][ni] = TR ? __builtin_amdgcn_mfma_f32_16x16x32_bf16(bfr[ni], af[mi], acc[mi][ni], 0, 0, 0)
                           : __builtin_amdgcn_mfma_f32_16x16x32_bf16(af[mi], bfr[ni], acc[mi][ni], 0, 0, 0);
    }
  }
  __syncthreads();
}

template <int KT> struct Tiles { uint4 a0[KT], a1[KT], b0[KT], b1[KT]; };
template <int TM, int TN, bool AKC, bool BKC, int KT>
__device__ __forceinline__ void tiles_issue(Tiles<KT>& t, const u16* __restrict__ A, long lda, const u16* __restrict__ B, long ldb) {
  const int tid = TID();
#pragma unroll
  for (int kt = 0; kt < KT; ++kt) {
    t.a0[kt] = ld_chunk<TM, AKC>(A, lda, kt * 64, tid);
    t.a1[kt] = t.a0[kt];
    if (TM == 128) t.a1[kt] = ld_chunk<TM, AKC>(A, lda, kt * 64, tid + NT);
    t.b0[kt] = ld_chunk<TN, BKC>(B, ldb, kt * 64, tid);
    t.b1[kt] = t.b0[kt];
    if (TN == 128) t.b1[kt] = ld_chunk<TN, BKC>(B, ldb, kt * 64, tid + NT);
  }
}
template <int TM, int TN, bool AKC, bool BKC, bool TR, int KT>
__device__ __forceinline__ void gemm_run(f32x4 (&acc)[TM / 32][TN / 64], const Tiles<KT>& t, u16* sm) {
  u16* As = sm;
  u16* Bs = sm + 9216;
  const int tid = TID(), lane = tid & 63, wid = tid >> 6;
  const int wm = wid >> 2, wn = wid & 3, fr = lane & 15, fq = lane >> 4;
  constexpr int MI = TM / 32, NI = TN / 64;
#pragma unroll
  for (int kt = 0; kt < KT; ++kt) {
    __syncthreads();
    st_chunk<TM, AKC>(As, t.a0[kt], tid);
    if (TM == 128) st_chunk<TM, AKC>(As, t.a1[kt], tid + NT);
    st_chunk<TN, BKC>(Bs, t.b0[kt], tid);
    if (TN == 128) st_chunk<TN, BKC>(Bs, t.b1[kt], tid + NT);
    __syncthreads();
#pragma unroll
    for (int ks = 0; ks < 2; ++ks) {
      bf16x8 af[MI], bfr[NI];
#pragma unroll
      for (int mi = 0; mi < MI; ++mi) af[mi] = ld_frag<TM, AKC>(As, wm * (TM / 2) + mi * 16, ks, fr, fq);
#pragma unroll
      for (int ni = 0; ni < NI; ++ni) bfr[ni] = ld_frag<TN, BKC>(Bs, wn * (TN / 4) + ni * 16, ks, fr, fq);
#pragma unroll
      for (int mi = 0; mi < MI; ++mi)
#pragma unroll
        for (int ni = 0; ni < NI; ++ni)
          acc[mi][ni] = TR ? __builtin_amdgcn_mfma_f32_16x16x32_bf16(bfr[ni], af[mi], acc[mi][ni], 0, 0, 0)
                           : __builtin_amdgcn_mfma_f32_16x16x32_bf16(af[mi], bfr[ni], acc[mi][ni], 0, 0, 0);
    }
  }
}

template <int TM, int TN, bool TR, class F>
__device__ __forceinline__ void epi_each(f32x4 (&acc)[TM / 32][TN / 64], F f) {
  const int tid = TID(), lane = tid & 63, wid = tid >> 6;
  const int wm = wid >> 2, wn = wid & 3, fr = lane & 15, fq = lane >> 4;
#pragma unroll
  for (int mi = 0; mi < TM / 32; ++mi)
#pragma unroll
    for (int ni = 0; ni < TN / 64; ++ni) {
      const int r0 = wm * (TM / 2) + mi * 16, c0 = wn * (TN / 4) + ni * 16;
      if (TR) f(r0 + fr, c0 + fq * 4, acc[mi][ni]);
      else f(r0 + fq * 4, c0 + fr, acc[mi][ni]);
    }
}

struct EpiStoreBf16 {
  static constexpr bool PERM = true, AFTER_DRAIN = false;
  u16* O; int ldc;
  __device__ __forceinline__ void operator()(const f32x4 (&acc)[2][2][4][2], const pg8::Unit& u, int wr, int wc, int fr, int fq) const {
    const int row0 = u.pm * 256 + wr * 64 + fr, col0 = u.pn * 256 + wc * 32 + 8 * fq;
#pragma unroll
    for (int ai = 0; ai < 2; ++ai)
#pragma unroll
      for (int m = 0; m < 4; ++m) {
        u16* rowp = O + (size_t)(row0 + ai * 128 + m * 16) * ldc + col0;
#pragma unroll
        for (int bj = 0; bj < 2; ++bj) {
          const f32x4 v0 = acc[ai][bj][m][0], v1 = acc[ai][bj][m][1];
          *(uint4*)(rowp + bj * 128) = make_uint4(pack2(v0[0], v0[1]), pack2(v0[2], v0[3]), pack2(v1[0], v1[1]), pack2(v1[2], v1[3]));
        }
      }
  }
};
struct EpiResid {
  static constexpr bool PERM = false, AFTER_DRAIN = false;
  float* X; const float* XS; const float* mod; int goff; int grow0;
  __device__ __forceinline__ void operator()(const f32x4 (&acc)[2][2][4][2], const pg8::Unit& u, int wr, int wc, int fr, int fq) const {
    const int row0 = u.pm * 256 + wr * 64 + fr, col0 = u.pn * 256 + wc * 32 + 4 * fq;
    const float* g = mod + (size_t)gb_row(grow0 + u.pm * 256) * 6144 + goff + col0;
    f32x4 gv[2][2];
#pragma unroll
    for (int bj = 0; bj < 2; ++bj)
#pragma unroll
      for (int n = 0; n < 2; ++n) gv[bj][n] = *(const f32x4*)(g + bj * 128 + n * 16);
#pragma unroll
    for (int am = 0; am < 4; ++am) {
      f32x4 xv[2][2][2];
#pragma unroll
      for (int mm = 0; mm < 2; ++mm)
#pragma unroll
        for (int bj = 0; bj < 2; ++bj)
#pragma unroll
          for (int n = 0; n < 2; ++n) xv[mm][bj][n] = *(const f32x4*)(XS + (size_t)(row0 + (am >> 1) * 128 + ((am & 1) * 2 + mm) * 16) * D + col0 + bj * 128 + n * 16);
#pragma unroll
      for (int mm = 0; mm < 2; ++mm)
#pragma unroll
        for (int bj = 0; bj < 2; ++bj)
#pragma unroll
          for (int n = 0; n < 2; ++n)
            *(f32x4*)(X + (size_t)(row0 + (am >> 1) * 128 + ((am & 1) * 2 + mm) * 16) * D + col0 + bj * 128 + n * 16) = xv[mm][bj][n] + gv[bj][n] * acc[am >> 1][bj][(am & 1) * 2 + mm][n];
    }
  }
};
struct EpiFfnVal {
  static constexpr bool PERM = false, AFTER_DRAIN = false;
  const u16* G; u16* ACT; const float* cw; const float* cb; int grow0;
  __device__ __forceinline__ void operator()(const f32x4 (&acc)[2][2][4][2], const pg8::Unit& u, int wr, int wc, int fr, int fq) const {
    const int row0 = u.pm * 256 + wr * 64 + fr, col0 = u.pn * 256 + wc * 32 + 4 * fq;
#pragma unroll
    for (int bj = 0; bj < 2; ++bj)
#pragma unroll
      for (int n = 0; n < 2; ++n) {
        const int c = col0 + bj * 128 + n * 16;
        const f32x4 w0 = *(const f32x4*)(cw + c), w1 = *(const f32x4*)(cw + DFF + c), w2 = *(const f32x4*)(cw + 2 * DFF + c), bb = *(const f32x4*)(cb + c);
#pragma unroll
        for (int ai = 0; ai < 2; ++ai) {
          uint2 g0[4], g1[4], g2[4];
#pragma unroll
          for (int m = 0; m < 4; ++m) {
            const int r = row0 + ai * 128 + m * 16;
            const int L = (grow0 + r) < 16384 ? 2048 : 8192;
            const int pos = (grow0 + r) & (L - 1);
            const u16* gp = G + (size_t)r * DFF + c;
            g1[m] = *(const uint2*)gp;
            g0[m] = *(const uint2*)(gp - (pos > 0 ? DFF : 0));
            g2[m] = *(const uint2*)(gp + (pos < L - 1 ? DFF : 0));
          }
#pragma unroll
          for (int m = 0; m < 4; ++m) {
            const int r = row0 + ai * 128 + m * 16;
            const int L = (grow0 + r) < 16384 ? 2048 : 8192;
            const int pos = (grow0 + r) & (L - 1);
            const float m0 = pos > 0 ? 1.f : 0.f, m2 = pos < L - 1 ? 1.f : 0.f;
            const uint2 a0 = g0[m], a1 = g1[m], a2 = g2[m];
            f32x4 a;
            a[0] = m0 * bf2f((u16)(a0.x & 0xffff)) * w0[0] + bf2f((u16)(a1.x & 0xffff)) * w1[0] + m2 * bf2f((u16)(a2.x & 0xffff)) * w2[0] + bb[0];
            a[1] = m0 * bf2f((u16)(a0.x >> 16)) * w0[1] + bf2f((u16)(a1.x >> 16)) * w1[1] + m2 * bf2f((u16)(a2.x >> 16)) * w2[1] + bb[1];
            a[2] = m0 * bf2f((u16)(a0.y & 0xffff)) * w0[2] + bf2f((u16)(a1.y & 0xffff)) * w1[2] + m2 * bf2f((u16)(a2.y & 0xffff)) * w2[2] + bb[2];
            a[3] = m0 * bf2f((u16)(a0.y >> 16)) * w0[3] + bf2f((u16)(a1.y >> 16)) * w1[3] + m2 * bf2f((u16)(a2.y >> 16)) * w2[3] + bb[3];
            const f32x4 v = acc[ai][bj][m][n];
            *(uint2*)(ACT + (size_t)r * DFF + c) = make_uint2(pack2(silu_f(a[0]) * v[0], silu_f(a[1]) * v[1]), pack2(silu_f(a[2]) * v[2], silu_f(a[3]) * v[3]));
          }
        }
      }
  }
};
template <class Epi>
__device__ __forceinline__ void run_gemm(const u16* A, const u16* Bt, int M, int N, int K, const Epi& E) {
  pg8::Gemm g; g.A = A; g.Bt = Bt; g.M = M; g.N = N; g.K = K;
  pg8::StaticOrder S; S.init(M, N, gridDim.x, BID());
  __syncthreads();
  pg8::gemm_phase<Epi, pg8::StaticOrder, false>((PG8_LAS unsigned char*)smem, g, S, E, nullptr);
  __syncthreads();
}

__device__ __forceinline__ int fidx(int p) { return p + ((p >> 6) << 2); }
__device__ __forceinline__ float2 cmulf(float2 a, float2 b) { return make_float2(a.x * b.x - a.y * b.y, a.x * b.y + a.y * b.x); }
__device__ __forceinline__ float2 cmulcf(float2 a, float2 b) { return make_float2(a.x * b.x + a.y * b.y, a.y * b.x - a.x * b.y); }
#define R16C(q) ((q) == 0 ? 1.f : (q) == 1 ? 0.9238795325f : (q) == 2 ? 0.7071067812f : (q) == 3 ? 0.3826834324f : (q) == 4 ? 0.f : (q) == 5 ? -0.3826834324f : (q) == 6 ? -0.7071067812f : -0.9238795325f)
#define R16S(q) ((q) == 0 ? 0.f : (q) == 1 ? -0.3826834324f : (q) == 2 ? -0.7071067812f : (q) == 3 ? -0.9238795325f : (q) == 4 ? -1.f : (q) == 5 ? -0.9238795325f : (q) == 6 ? -0.7071067812f : -0.3826834324f)
template <int N, int RS, bool INV>
__device__ __forceinline__ void fft_pass(float2* x, const float2* __restrict__ tw, const int S, const int tid) {
  constexpr int R = 1 << RS;
  const int E = S >> (RS - 1);
#pragma unroll 1
  for (int g = tid; g < N / R; g += NT) {
    const int blo = g & (E - 1);
    const int base = ((g - blo) << RS) + blo;
    float2 e[R];
#pragma unroll
    for (int k = 0; k < R; ++k) e[k] = x[fidx(base + k * E)];
    float2 wb[RS];
#pragma unroll
    for (int st = 0; st < RS; ++st) wb[st] = tw[blo * (8192 / (S >> st))];
#pragma unroll
    for (int sq = 0; sq < RS; ++sq) {
      const int st = INV ? (RS - 1 - sq) : sq;
      const int h = (R / 2) >> st;
#pragma unroll
      for (int k = 0; k < R; ++k) {
        if ((k & h) == 0) {
          const int m = k & (h - 1);
          const int q = m * (8 / h);
          float2 w = wb[st];
          if (q != 0) w = cmulf(w, make_float2(R16C(q), R16S(q)));
          if (!INV) {
            const float2 a = e[k], b = e[k + h];
            e[k] = make_float2(a.x + b.x, a.y + b.y);
            e[k + h] = cmulf(make_float2(a.x - b.x, a.y - b.y), w);
          } else {
            const float2 a = e[k], b = cmulcf(e[k + h], w);
            e[k] = make_float2(a.x + b.x, a.y + b.y);
            e[k + h] = make_float2(a.x - b.x, a.y - b.y);
          }
        }
      }
    }
#pragma unroll
    for (int k = 0; k < R; ++k) x[fidx(base + k * E)] = e[k];
  }
  __syncthreads();
}
template <int N>
__device__ __forceinline__ void fft_dif_t(float2* x, const float2* __restrict__ tw) {
  const int tid = TID();
  if (N == 16384) {
    fft_pass<N, 4, false>(x, tw, 8192, tid); fft_pass<N, 4, false>(x, tw, 512, tid);
    fft_pass<N, 4, false>(x, tw, 32, tid); fft_pass<N, 2, false>(x, tw, 2, tid);
  } else {
    fft_pass<N, 4, false>(x, tw, 2048, tid); fft_pass<N, 4, false>(x, tw, 128, tid); fft_pass<N, 4, false>(x, tw, 8, tid);
  }
}
template <int N>
__device__ __forceinline__ void ifft_dit_t(float2* x, const float2* __restrict__ tw) {
  const int tid = TID();
  if (N == 16384) {
    fft_pass<N, 2, true>(x, tw, 2, tid); fft_pass<N, 4, true>(x, tw, 32, tid);
    fft_pass<N, 4, true>(x, tw, 512, tid); fft_pass<N, 4, true>(x, tw, 8192, tid);
  } else {
    fft_pass<N, 4, true>(x, tw, 8, tid); fft_pass<N, 4, true>(x, tw, 128, tid); fft_pass<N, 4, true>(x, tw, 2048, tid);
  }
}
__device__ __forceinline__ void fft_dif(float2* x, int N, const float2* __restrict__ tw) {
  if (N == 16384) fft_dif_t<16384>(x, tw); else fft_dif_t<4096>(x, tw);
}
__device__ __forceinline__ void ifft_dit(float2* x, int N, const float2* __restrict__ tw) {
  if (N == 16384) ifft_dit_t<16384>(x, tw); else ifft_dit_t<4096>(x, tw);
}

__device__ void transpose_w(const float* __restrict__ W, u16* __restrict__ Wt, int K, int N) {
  float* smf = (float*)smem;
  const int tk = K / 64, tn = N / 64, tid = TID(), G = gridDim.x;
  const int kk0 = tid >> 4, n40 = tid & 15, kk1 = (tid + NT) >> 4, n41 = (tid + NT) & 15;
  int item = BID();
  float4 v0 = make_float4(0, 0, 0, 0), v1 = v0;
  if (item < tk * tn) {
    const int k0 = (item / tn) * 64, n0 = (item % tn) * 64;
    v0 = *(const float4*)(W + (long)(k0 + kk0) * N + n0 + n40 * 4);
    v1 = *(const float4*)(W + (long)(k0 + kk1) * N + n0 + n41 * 4);
  }
  for (; item < tk * tn; item += G) {
    const int k0 = (item / tn) * 64, n0 = (item % tn) * 64;
    float4 w0 = v0, w1 = v1;
    const int nx = item + G;
    if (nx < tk * tn) {
      const int k2 = (nx / tn) * 64, n2 = (nx % tn) * 64;
      w0 = *(const float4*)(W + (long)(k2 + kk0) * N + n2 + n40 * 4);
      w1 = *(const float4*)(W + (long)(k2 + kk1) * N + n2 + n41 * 4);
    }
    __syncthreads();
    { float* p = smf + kk0 * 65 + n40 * 4; p[0] = v0.x; p[1] = v0.y; p[2] = v0.z; p[3] = v0.w; }
    { float* p = smf + kk1 * 65 + n41 * 4; p[0] = v1.x; p[1] = v1.y; p[2] = v1.z; p[3] = v1.w; }
    __syncthreads();
    const int nn = tid >> 3, k8 = tid & 7;
    float f[8];
#pragma unroll
    for (int i = 0; i < 8; ++i) f[i] = smf[(k8 * 8 + i) * 65 + nn];
    *(uint4*)(Wt + (long)(n0 + nn) * K + k0 + k8 * 8) = pack8s(f, 1.f);
    v0 = w0; v1 = w1;
  }
  __syncthreads();
}

__device__ void phase_pre0(const Params& P) {
  const int tid = TID();
  const long gtid = (long)BID() * NT + tid, gsz = (long)gridDim.x * NT;
  transpose_w(P.in[7], (u16*)(WS(P) + O_WHYIN), 1024, 3072);
  transpose_w(P.in[18], (u16*)(WS(P) + O_WHYOUT), 1024, 1024);
  transpose_w(P.in[19], (u16*)(WS(P) + O_WRETIN), 1024, 6144);
  transpose_w(P.in[21], (u16*)(WS(P) + O_WRETOUT), 2048, 1024);
  transpose_w(P.in[22], (u16*)(WS(P) + O_WSWAIN), 1024, 1536);
  transpose_w(P.in[26], (u16*)(WS(P) + O_WSWAOUT), 1024, 1024);
  transpose_w(P.in[27], (u16*)(WS(P) + O_WHGIN), 1024, 5120);
  transpose_w(P.in[30], (u16*)(WS(P) + O_WHGOUT), 1024, 1024);
  for (int l = 0; l < 4; ++l) {
    transpose_w(P.in[31] + (long)l * 1024 * DFF, (u16*)(WS(P) + O_WFG) + (long)l * DFF * 1024, 1024, DFF);
    transpose_w(P.in[32] + (long)l * 1024 * DFF, (u16*)(WS(P) + O_WFV) + (long)l * DFF * 1024, 1024, DFF);
    transpose_w(P.in[35] + (long)l * DFF * 1024, (u16*)(WS(P) + O_WFD) + (long)l * 1024 * DFF, DFF, 1024);
  }
  {
    float* cs = (float*)smem;
    float* modp = (float*)(WS(P) + O_MODP);
    for (int item = BID(); item < 4 * 8 * 12; item += gridDim.x) {
      const int nb = item % 12, ks = (item / 12) % 8, l = item / 96;
      __syncthreads();
      for (int i = tid; i < 2048; i += NT) {
        int b = i >> 7, k = i & 127;
        float c = (b < 8) ? P.in[2][b * 1024 + ks * 128 + k] : P.in[3][(b - 8) * 1024 + ks * 128 + k];
        cs[i] = c / (1.f + expf(-c));
      }
      __syncthreads();
      const int n = nb * 512 + tid;
      float a[16];
#pragma unroll
      for (int b = 0; b < 16; ++b) a[b] = 0.f;
      const float* w = P.in[4] + ((long)l * 1024 + ks * 128) * 6144 + n;
      for (int k = 0; k < 128; ++k) {
        float wv = w[(long)k * 6144];
#pragma unroll
        for (int b = 0; b < 16; ++b) a[b] += cs[b * 128 + k] * wv;
      }
#pragma unroll
      for (int b = 0; b < 16; ++b) modp[(((long)ks * 4 + l) * 16 + b) * 6144 + n] = a[b];
    }
    __syncthreads();
  }
  {
    float2* tw = (float2*)(WS(P) + O_TW);
    for (long i = gtid; i < 8192; i += gsz) {
      float s, c;
      sincospif((float)i * (1.f / 8192.f), &s, &c);
      tw[i] = make_float2(c, -s);
    }
    float2* rr = (float2*)(WS(P) + O_ROPER);
    for (long i = gtid; i < (long)8192 * 128; i += gsz) {
      int pos = (int)(i >> 7), d = (int)(i & 127);
      float inv = exp2f(-(float)d * (13.287712379549449f / 128.f));
      float s, c;
      sincosf((float)pos * inv, &s, &c);
      rr[i] = make_float2(c, s);
    }
    float2* rs = (float2*)(WS(P) + O_ROPES);
    for (long i = gtid; i < (long)8192 * 32; i += gsz) {
      int pos = (int)(i >> 5), d = (int)(i & 31);
      float inv = exp2f(-(float)d * (13.287712379549449f / 32.f));
      float s, c;
      sincosf((float)pos * inv, &s, &c);
      rs[i] = make_float2(c, s);
    }
  }
  {
    float* zf = (float*)smem;
    float* h1 = zf + 8 * 36;
    const float* w1 = P.in[10]; const float* b1 = P.in[11]; const float* w2 = P.in[12]; const float* b2 = P.in[13];
    const float* fr = P.in[15];
    const int tl = tid >> 6, j = tid & 63;
    for (int item = BID(); item < 1280; item += gridDim.x) {
      const int sel = item >= 1024;
      const int L = sel ? 2048 : 8192;
      const int t = (sel ? item - 1024 : item) * 8 + tl;
      float* hid = (float*)(WS(P) + (sel ? O_HIDP : O_HIDS));
      __syncthreads();
      if (j < 33) {
        float v;
        if (j == 0) v = (float)t / (float)(L - 1);
        else {
          int i = (j - 1) & 15;
          float band = 1e-4f + (float)i * ((15.f - 1e-4f) / 15.f);
          float ang = (6.283185307179586f / (float)L) * (float)t;
          float a = band * ang;
          v = (j <= 16) ? cosf(a) : -sinf(a);
        }
        zf[tl * 36 + j] = v;
      }
      __syncthreads();
      float s = b1[j];
#pragma unroll 3
      for (int i = 0; i < 33; ++i) s += zf[tl * 36 + i] * w1[i * 64 + j];
      h1[tl * 64 + j] = sinf(fr[j] * s);
      __syncthreads();
      float s2 = b2[j];
#pragma unroll 4
      for (int i = 0; i < 64; ++i) s2 += h1[tl * 64 + i] * w2[i * 64 + j];
      hid[(long)t * 64 + j] = sinf(fr[j] * s2);
    }
    __syncthreads();
  }
}

__device__ void phase_pre1(const Params& P) {
  __shared__ float w3s[128];
  __shared__ float red[8];
  const int tid = TID(), lane = tid & 63, wid = tid >> 6;
  const long gtid = (long)BID() * NT + tid, gsz = (long)gridDim.x * NT;
  {
    const float* modp = (const float*)(WS(P) + O_MODP);
    float* mod = (float*)(WS(P) + O_MOD);
    for (long i = gtid; i < (long)4 * 16 * 6144; i += gsz) {
      int n = (int)(i % 6144);
      int l = (int)(i / (16 * 6144));
      float s = P.in[5][l * 6144 + n];
      for (int ks = 0; ks < 8; ++ks) s += modp[(long)ks * 4 * 16 * 6144 + i];
      mod[i] = s;
    }
  }
  float2* buf = (float2*)smem;
  const float2* tw = (const float2*)(WS(P) + O_TW);
  for (int item = BID(); item < 2048; item += gridDim.x) {
    const int sel = item >> 10, c = item & 1023;
    const int L = sel ? 2048 : 8192, N = 2 * L;
    const float* hid = (const float*)(WS(P) + (sel ? O_HIDP : O_HIDS));
    float2* hs = (float2*)(WS(P) + (sel ? O_HSPP : O_HSPS)) + (long)c * N;
    __syncthreads();
    if (tid < 128) {
      int dirn = tid >> 6, j = tid & 63;
      w3s[tid] = P.in[14][(long)j * 2048 + dirn * 1024 + c];
    }
    __syncthreads();
    const float dec0 = fabsf(P.in[16][c]), dec1 = fabsf(P.in[16][1024 + c]);
    const float invLm1 = 1.f / (float)(L - 1);
    float asum = 0.f;
    for (int n = tid; n < N; n += NT) {
      float val = 0.f;
      if (n != L) {
        const int dirn = n < L ? 0 : 1;
        const int t = n < L ? n : N - n;
        const float4* hr = (const float4*)(hid + (long)t * 64);
        const float* w = w3s + dirn * 64;
        float s = 0.f;
#pragma unroll
        for (int q = 0; q < 16; ++q) {
          float4 h4 = hr[q];
          s += h4.x * w[4 * q] + h4.y * w[4 * q + 1] + h4.z * w[4 * q + 2] + h4.w * w[4 * q + 3];
        }
        float tl = (float)t * invLm1;
        val = s * expf(-tl * (dirn ? dec1 : dec0));
      }
      buf[fidx(n)] = make_float2(val, 0.f);
      asum += fabsf(val);
    }
    asum = wave_sum(asum);
    if (lane == 0) red[wid] = asum;
    __syncthreads();
    float tot = 0.f;
#pragma unroll
    for (int w = 0; w < 8; ++w) tot += red[w];
    const float scale = 1.f / (tot * (float)N);
    fft_dif(buf, N, tw);
    for (int p = tid; p < N; p += NT) {
      float2 a = buf[fidx(p)];
      hs[p] = make_float2(a.x * scale, a.y * scale);
    }
  }
  __syncthreads();
}

__device__ void phase_norm(const Params& P, int layer, int sl, int which) {
  const int grow0 = which ? sl * FSLAB : sl * SLAB, nrows = which ? FSLAB : SLAB;
  const float* __restrict__ x = (layer == 0 && which == 0) ? xin_of(P, sl) : (const float*)(OUTP(P) + (long)grow0 * D);
  u16* __restrict__ h = (u16*)(WS(P) + (which ? O_FHBUF : O_HBUF));
  const float* gain = P.in[6] + (layer * 2 + which) * D;
  const float* mod = (const float*)(WS(P) + O_MOD) + (long)layer * 16 * 6144;
  const int shoff = which ? 3 * D : 0, scoff = which ? 4 * D : D;
  const int tid = TID(), lane = tid & 63, wid = tid >> 6;
  for (int item = BID(); item < nrows / 32; item += gridDim.x) {
    const int r0 = item * 32 + wid * 4;
    float4 v[4][4];
    float ss[4];
#pragma unroll
    for (int u = 0; u < 4; ++u) {
      const float* xr = x + (long)(r0 + u) * D;
      float a = 0.f;
#pragma unroll
      for (int i = 0; i < 4; ++i) {
        v[u][i] = *(const float4*)(xr + i * 256 + lane * 4);
        a += v[u][i].x * v[u][i].x + v[u][i].y * v[u][i].y + v[u][i].z * v[u][i].z + v[u][i].w * v[u][i].w;
      }
      ss[u] = a;
    }
    const float* m = mod + (long)gb_row(grow0 + r0) * 6144;
#pragma unroll
    for (int u = 0; u < 4; ++u) ss[u] = wave_sum(ss[u]);
#pragma unroll
    for (int i = 0; i < 4; ++i) {
      const int col = i * 256 + lane * 4;
      const float4 g = *(const float4*)(gain + col);
      const float4 sc = *(const float4*)(m + scoff + col);
      const float4 sh = *(const float4*)(m + shoff + col);
      const float a0 = g.x * (1.f + sc.x), a1 = g.y * (1.f + sc.y), a2 = g.z * (1.f + sc.z), a3 = g.w * (1.f + sc.w);
#pragma unroll
      for (int u = 0; u < 4; ++u) {
        const float rstd = rsqrtf(ss[u] * (1.f / 1024.f) + 1e-6f);
        const float y0 = v[u][i].x * rstd * a0 + sh.x, y1 = v[u][i].y * rstd * a1 + sh.y;
        const float y2 = v[u][i].z * rstd * a2 + sh.z, y3 = v[u][i].w * rstd * a3 + sh.w;
        *(uint2*)(h + (long)(r0 + u) * D + col) = make_uint2(pack2(y0, y1), pack2(y2, y3));
      }
    }
  }
}

__device__ void phase_proj(const Params& P, size_t woff, int N) {
  EpiStoreBf16 E; E.O = (u16*)(WS(P) + O_PROJ); E.ldc = N;
  run_gemm((const u16*)(WS(P) + O_HBUF), (const u16*)(WS(P) + woff), SLAB, N, D, E);
}
__device__ void phase_resid(const Params& P, int layer, int slab, const u16* A, int K, size_t woff, int goff) {
  EpiResid E; E.X = OUTP(P) + (long)slab * SLAB * D; E.XS = (layer == 0) ? xin_of(P, slab) : (const float*)E.X; E.mod = (const float*)(WS(P) + O_MOD) + (long)layer * 16 * 6144; E.goff = goff; E.grow0 = slab * SLAB;
  run_gemm(A, (const u16*)(WS(P) + woff), SLAB, D, K, E);
}

__device__ void phase_ffn_gate(const Params& P, int layer) {
  EpiStoreBf16 E; E.O = (u16*)(WS(P) + O_FGBUF); E.ldc = DFF;
  run_gemm((const u16*)(WS(P) + O_FHBUF), (const u16*)(WS(P) + O_WFG) + (long)layer * DFF * D, FSLAB, DFF, D, E);
}
__device__ void phase_ffn_val(const Params& P, int layer, int fs) {
  EpiFfnVal E; E.G = (const u16*)(WS(P) + O_FGBUF); E.ACT = (u16*)(WS(P) + O_FACT) + (long)fs * FSLAB * DFF;
  E.cw = P.in[33] + (long)layer * 3 * DFF; E.cb = P.in[34] + (long)layer * DFF; E.grow0 = fs * FSLAB;
  run_gemm((const u16*)(WS(P) + O_FHBUF), (const u16*)(WS(P) + O_WFV) + (long)layer * DFF * D, FSLAB, DFF, D, E);
}
__device__ void phase_ffn_down(const Params& P, int layer) {
  EpiResid E; E.X = OUTP(P); E.XS = E.X; E.mod = (const float*)(WS(P) + O_MOD) + (long)layer * 16 * 6144; E.goff = 5 * D; E.grow0 = 0;
  run_gemm((const u16*)(WS(P) + O_FACT), (const u16*)(WS(P) + O_WFD) + (long)layer * D * DFF, NTOK, D, DFF, E);
}

__device__ void phase_hy_conv(const Params& P, int slab) {
  const int L = Lof(slab), nseq = SLAB / L, tid = TID();
  const u16* __restrict__ z = (const u16*)(WS(P) + O_PROJ);
  float* __restrict__ uT = (float*)(WS(P) + O_UT);
  u16* __restrict__ x0c = (u16*)(WS(P) + O_X0C);
  const float* cw = P.in[8];
  const float* cb = P.in[9];
  float* tile = (float*)smem;
  const int ntt = L / 64;
  const int nitems = nseq * ntt * 16;
  const int tl = tid >> 3, cg = tid & 7;
  for (int item = BID(); item < nitems; item += gridDim.x) {
    const int ct = item % 16, tt = (item / 16) % ntt, seq = item / (16 * ntt);
    const int t = tt * 64 + tl, c0 = ct * 64 + cg * 8;
    const long row = (long)seq * L + t;
    const float mp = t > 0 ? 1.f : 0.f, mn = t < L - 1 ? 1.f : 0.f;
    const long rp = t > 0 ? row - 1 : row, rn = t < L - 1 ? row + 1 : row;
    float val[3][8];
#pragma unroll
    for (int q = 0; q < 3; ++q) {
      const int col = q * 1024 + c0;
      float a[8], b[8], c[8];
      unpack8(*(const uint4*)(z + rp * 3072 + col), a);
      unpack8(*(const uint4*)(z + row * 3072 + col), b);
      unpack8(*(const uint4*)(z + rn * 3072 + col), c);
      const float4 w0a = *(const float4*)(cw + col), w0b = *(const float4*)(cw + col + 4);
      const float4 w1a = *(const float4*)(cw + 3072 + col), w1b = *(const float4*)(cw + 3072 + col + 4);
      const float4 w2a = *(const float4*)(cw + 6144 + col), w2b = *(const float4*)(cw + 6144 + col + 4);
      const float4 ba = *(const float4*)(cb + col), bb = *(const float4*)(cb + col + 4);
      const float w0[8] = {w0a.x, w0a.y, w0a.z, w0a.w, w0b.x, w0b.y, w0b.z, w0b.w};
      const float w1[8] = {w1a.x, w1a.y, w1a.z, w1a.w, w1b.x, w1b.y, w1b.z, w1b.w};
      const float w2[8] = {w2a.x, w2a.y, w2a.z, w2a.w, w2b.x, w2b.y, w2b.z, w2b.w};
      const float bs[8] = {ba.x, ba.y, ba.z, ba.w, bb.x, bb.y, bb.z, bb.w};
#pragma unroll
      for (int i = 0; i < 8; ++i) val[q][i] = mp * a[i] * w0[i] + b[i] * w1[i] + mn * c[i] * w2[i] + bs[i];
    }
    *(uint4*)(x0c + row * 1024 + c0) = pack8s(val[0], 1.f);
    __syncthreads();
#pragma unroll
    for (int i = 0; i < 8; ++i) tile[tl * 65 + cg * 8 + i] = val[1][i] * val[2][i];
    __syncthreads();
    {
      const int cl = tid >> 3, tq = tid & 7;
      float* dst = uT + ((long)seq * 1024 + ct * 64 + cl) * L + tt * 64 + tq * 8;
      float4 o0, o1;
      o0.x = tile[(tq * 8 + 0) * 65 + cl]; o0.y = tile[(tq * 8 + 1) * 65 + cl]; o0.z = tile[(tq * 8 + 2) * 65 + cl]; o0.w = tile[(tq * 8 + 3) * 65 + cl];
      o1.x = tile[(tq * 8 + 4) * 65 + cl]; o1.y = tile[(tq * 8 + 5) * 65 + cl]; o1.z = tile[(tq * 8 + 6) * 65 + cl]; o1.w = tile[(tq * 8 + 7) * 65 + cl];
      *(float4*)dst = o0; *(float4*)(dst + 4) = o1;
    }
  }
  __syncthreads();
}

__device__ void phase_hy_fft(const Params& P, int slab, bool dry = false) {
  const int L = Lof(slab), N = 2 * L, nseq = SLAB / L, tid = TID();
  float* uT = (float*)(WS(P) + O_UT);
  const float2* hsb = (const float2*)(WS(P) + (slab == 0 ? O_HSPP : O_HSPS));
  const float2* tw = (const float2*)(WS(P) + O_TW);
  const float* skip = P.in[17];
  float2* buf = (float2*)smem;
  const int nitems = (nseq / 2) * 1024;
  for (int item = BID(); item < nitems; item += gridDim.x) {
    const int pr = item >> 10, c = item & 1023;
    float* u0 = uT + ((long)(pr * 2) * 1024 + c) * L;
    float* u1 = u0 + (long)1024 * L;
    __syncthreads();
    for (int t = tid; t < L; t += NT) {
      buf[fidx(t)] = make_float2(u0[t], u1[t]);
      buf[fidx(t + L)] = make_float2(0.f, 0.f);
    }
    __syncthreads();
    fft_dif(buf, N, tw);
    const float2* h = hsb + (long)c * N;
    for (int p = tid; p < N; p += NT) {
      float2 a = buf[fidx(p)], b = h[p];
      buf[fidx(p)] = make_float2(a.x * b.x - a.y * b.y, a.x * b.y + a.y * b.x);
    }
    __syncthreads();
    ifft_dit(buf, N, tw);
    const float sk = skip[c];
    for (int t = tid; t < L; t += NT) {
      float2 y = buf[fidx(t)];
      const long doff = dry ? (long)(END_HY - O_UT) / 4 : 0;
      u0[t + doff] = y.x + u0[t] * sk;
      u1[t + doff] = y.y + u1[t] * sk;
    }
  }
  __syncthreads();
}

__device__ void phase_hy_tr(const Params& P, int slab) {
  const int L = Lof(slab), nseq = SLAB / L, tid = TID();
  const float* __restrict__ yT = (const float*)(WS(P) + O_UT);
  const u16* __restrict__ x0c = (const u16*)(WS(P) + O_X0C);
  u16* __restrict__ a2 = (u16*)(WS(P) + O_A2);
  float* tile = (float*)smem;
  const int ntt = L / 64;
  const int nitems = nseq * ntt * 16;
  for (int item = BID(); item < nitems; item += gridDim.x) {
    const int ct = item % 16, tt = (item / 16) % ntt, seq = item / (16 * ntt);
    const int cl = tid >> 3, tq = tid & 7;
    const float* src = yT + ((long)seq * 1024 + ct * 64 + cl) * L + tt * 64 + tq * 8;
    const float4 i0 = *(const float4*)src, i1 = *(const float4*)(src + 4);
    const int tl = tid >> 3, cg = tid & 7;
    const long row = (long)seq * L + tt * 64 + tl;
    const int c0 = ct * 64 + cg * 8;
    float xg[8];
    unpack8(*(const uint4*)(x0c + row * 1024 + c0), xg);
    __syncthreads();
    float* p = tile + cl * 65 + tq * 8;
    p[0] = i0.x; p[1] = i0.y; p[2] = i0.z; p[3] = i0.w; p[4] = i1.x; p[5] = i1.y; p[6] = i1.z; p[7] = i1.w;
    __syncthreads();
    float o[8];
#pragma unroll
    for (int i = 0; i < 8; ++i) o[i] = tile[(cg * 8 + i) * 65 + tl] * xg[i];
    *(uint4*)(a2 + row * 1024 + c0) = pack8s(o, 1.f);
  }
  __syncthreads();
}

struct Rec {
  int H, DK, DV, C;
  int ldv, voff, goff;
};
__device__ __forceinline__ Rec rec_of(int kind) {
  Rec r;
  if (kind == 1) { r.H = 4; r.DK = 256; r.DV = 512; r.C = 256; r.ldv = 6144; r.voff = 2048; r.goff = 4096; }
  else { r.H = 8; r.DK = 128; r.DV = 128; r.C = 128; r.ldv = 5120; r.voff = 1024; r.goff = 4096; }
  return r;
}

__device__ void phase_ret_prep(const Params& P, int slab) {
  const int L = Lof(slab);
  const u16* __restrict__ pj = (const u16*)(WS(P) + O_PROJ);
  u16* __restrict__ qdf = (u16*)(WS(P) + O_QDF); u16* __restrict__ qdb = (u16*)(WS(P) + O_QDB);
  u16* __restrict__ kif = (u16*)(WS(P) + O_KIF); u16* __restrict__ kib = (u16*)(WS(P) + O_KIB);
  u16* __restrict__ kef = (u16*)(WS(P) + O_KEF); u16* __restrict__ keb = (u16*)(WS(P) + O_KEB);
  float* dlf = (float*)(WS(P) + O_DLF); float* dlb = (float*)(WS(P) + O_DLB);
  const float2* __restrict__ rope = (const float2*)(WS(P) + O_ROPER);
  const long gtid = (long)BID() * NT + TID(), gsz = (long)gridDim.x * NT;
  for (long idx = gtid; idx < (long)SLAB * 64; idx += gsz) {
    const int d0 = (int)(idx & 15) * 8, h = (int)((idx >> 4) & 3), t = (int)(idx >> 6);
    const int pos = t & (L - 1), r = t & 255;
    const float lgf = -expf(P.in[20][h]), lgb = -expf(P.in[20][4 + h]);
    const u16* row = pj + (long)t * 6144 + h * 256 + d0;
    const uint4 vq1 = *(const uint4*)row, vq2 = *(const uint4*)(row + 128);
    const uint4 vk1 = *(const uint4*)(row + 1024), vk2 = *(const uint4*)(row + 1024 + 128);
    const float4* rp = (const float4*)(rope + (long)pos * 128 + d0);
    const float4 c01 = rp[0], c23 = rp[1], c45 = rp[2], c67 = rp[3];
    float q1[8], q2[8], k1[8], k2[8];
    unpack8(vq1, q1); unpack8(vq2, q2); unpack8(vk1, k1); unpack8(vk2, k2);
    const float cs[8] = {c01.x, c01.z, c23.x, c23.z, c45.x, c45.z, c67.x, c67.z};
    const float sn[8] = {c01.y, c01.w, c23.y, c23.w, c45.y, c45.w, c67.y, c67.w};
    float qa[8], qb[8], ka[8], kb[8];
#pragma unroll
    for (int i = 0; i < 8; ++i) {
      qa[i] = q1[i] * cs[i] - q2[i] * sn[i]; qb[i] = q1[i] * sn[i] + q2[i] * cs[i];
      ka[i] = (k1[i] * cs[i] - k2[i] * sn[i]) * 0.0625f; kb[i] = (k1[i] * sn[i] + k2[i] * cs[i]) * 0.0625f;
    }
    const float bf = (float)(r + 1) * lgf, bb = (float)(256 - r) * lgb;
    const float ef = expf(bf), eif = expf(-bf), eef = expf((float)(255 - r) * lgf);
    const float eb = expf(bb), eib = expf(-bb), eeb = expf((float)r * lgb);
    const long o1 = (long)t * 1024 + h * 256 + d0, o2 = o1 + 128;
    *(uint4*)(qdf + o1) = pack8s(qa, ef); *(uint4*)(qdf + o2) = pack8s(qb, ef);
    *(uint4*)(qdb + o1) = pack8s(qa, eb); *(uint4*)(qdb + o2) = pack8s(qb, eb);
    *(uint4*)(kif + o1) = pack8s(ka, eif); *(uint4*)(kif + o2) = pack8s(kb, eif);
    *(uint4*)(kib + o1) = pack8s(ka, eib); *(uint4*)(kib + o2) = pack8s(kb, eib);
    *(uint4*)(kef + o1) = pack8s(ka, eef); *(uint4*)(kef + o2) = pack8s(kb, eef);
    *(uint4*)(keb + o1) = pack8s(ka, eeb); *(uint4*)(keb + o2) = pack8s(kb, eeb);
    if (r == 0) {
      const long cgi = (long)(t >> 8) * 1024 + h * 256 + d0;
      const float df = expf(256.f * lgf), db = expf(256.f * lgb);
#pragma unroll
      for (int i = 0; i < 8; ++i) { dlf[cgi + i] = df; dlf[cgi + 128 + i] = df; dlb[cgi + i] = db; dlb[cgi + 128 + i] = db; }
    }
  }
}

__device__ __forceinline__ float lb_of(const float* lbt, int dr, int ch) {
  const float a0 = lbt[(dr * 4 + 0) * 1024 + ch], a1 = lbt[(dr * 4 + 1) * 1024 + ch], a2 = lbt[(dr * 4 + 2) * 1024 + ch], a3 = lbt[(dr * 4 + 3) * 1024 + ch];
  const float m = fmaxf(fmaxf(a0, a1), fmaxf(a2, a3));
  const float e0 = expf(a0 - m), e1 = expf(a1 - m), e2 = expf(a2 - m), e3 = expf(a3 - m);
  return (e0 + e1 + e2) / (e0 + e1 + e2 + e3);
}
__device__ void phase_hg_prep(const Params& P) {
  const u16* __restrict__ pj = (const u16*)(WS(P) + O_PROJ);
  u16* __restrict__ qdf = (u16*)(WS(P) + O_QDF); u16* __restrict__ qdb = (u16*)(WS(P) + O_QDB);
  u16* __restrict__ kif = (u16*)(WS(P) + O_KIF); u16* __restrict__ kib = (u16*)(WS(P) + O_KIB);
  u16* __restrict__ kef = (u16*)(WS(P) + O_KEF); u16* __restrict__ keb = (u16*)(WS(P) + O_KEB);
  float* dlf = (float*)(WS(P) + O_DLF); float* dlb = (float*)(WS(P) + O_DLB);
  const float* lbt = P.in[28];
  float* totF = (float*)smem;
  float* totB = totF + 1024;
  const int tid = TID(), lane = tid & 63, rg = tid >> 6;
  constexpr int RPT = 16;
  for (int item = BID(); item < 1024; item += gridDim.x) {
    const int cgi = item >> 3, ch = (item & 7) * 128 + lane * 2;
    const long t0 = (long)cgi * 128 + rg * RPT;
    unsigned wq[RPT], wf[RPT], wb[RPT];
#pragma unroll
    for (int i = 0; i < RPT; ++i) {
      const u16* row = pj + (t0 + i) * 5120 + ch;
      wq[i] = *(const unsigned*)row; wf[i] = *(const unsigned*)(row + 2048); wb[i] = *(const unsigned*)(row + 3072);
    }
    float lb0[2], lb1[2];
    lb0[0] = lb_of(lbt, 0, ch); lb0[1] = lb_of(lbt, 0, ch + 1);
    lb1[0] = lb_of(lbt, 1, ch); lb1[1] = lb_of(lbt, 1, ch + 1);
    float pf[2][RPT], sb[2][RPT], accf[2], accb[2];
#pragma unroll
    for (int c = 0; c < 2; ++c) {
      float a = 0.f;
#pragma unroll
      for (int i = 0; i < RPT; ++i) {
        const float x = bf2f((u16)(c ? (wf[i] >> 16) : (wf[i] & 0xffff)));
        a += logf(lb0[c] + (1.f - lb0[c]) * sigm(x)); pf[c][i] = a;
      }
      accf[c] = a;
      a = 0.f;
#pragma unroll
      for (int i = RPT - 1; i >= 0; --i) {
        const float x = bf2f((u16)(c ? (wb[i] >> 16) : (wb[i] & 0xffff)));
        a += logf(lb1[c] + (1.f - lb1[c]) * sigm(x)); sb[c][i] = a;
      }
      accb[c] = a;
    }
    __syncthreads();
    *(float2*)(totF + rg * 128 + lane * 2) = make_float2(accf[0], accf[1]);
    *(float2*)(totB + rg * 128 + lane * 2) = make_float2(accb[0], accb[1]);
    __syncthreads();
    float offF[2] = {0.f, 0.f}, offB[2] = {0.f, 0.f}, totf[2] = {0.f, 0.f}, totb[2] = {0.f, 0.f};
#pragma unroll
    for (int g = 0; g < 8; ++g) {
      const float2 f = *(const float2*)(totF + g * 128 + lane * 2), bq = *(const float2*)(totB + g * 128 + lane * 2);
      totf[0] += f.x; totf[1] += f.y; totb[0] += bq.x; totb[1] += bq.y;
      if (g < rg) { offF[0] += f.x; offF[1] += f.y; }
      if (g > rg) { offB[0] += bq.x; offB[1] += bq.y; }
    }
#pragma unroll
    for (int i = 0; i < RPT; ++i) {
      float o[6][2];
#pragma unroll
      for (int c = 0; c < 2; ++c) {
        const float xq = bf2f((u16)(c ? (wq[i] >> 16) : (wq[i] & 0xffff)));
        const float xf = bf2f((u16)(c ? (wf[i] >> 16) : (wf[i] & 0xffff)));
        const float xb = bf2f((u16)(c ? (wb[i] >> 16) : (wb[i] & 0xffff)));
        const float q = silu_f(xq);
        const float bf = offF[c] + pf[c][i], bb = offB[c] + sb[c][i];
        const float kf = (1.f - lb0[c]) * sigm(-xf), kb = (1.f - lb1[c]) * sigm(-xb);
        o[0][c] = q * expf(bf); o[1][c] = kf * expf(-bf); o[2][c] = kf * expf(totf[c] - bf);
        o[3][c] = q * expf(bb); o[4][c] = kb * expf(-bb); o[5][c] = kb * expf(totb[c] - bb);
      }
      const long oo = (t0 + i) * 1024 + ch;
      *(unsigned*)(qdf + oo) = pack2(o[0][0], o[0][1]);
      *(unsigned*)(kif + oo) = pack2(o[1][0], o[1][1]);
      *(unsigned*)(kef + oo) = pack2(o[2][0], o[2][1]);
      *(unsigned*)(qdb + oo) = pack2(o[3][0], o[3][1]);
      *(unsigned*)(kib + oo) = pack2(o[4][0], o[4][1]);
      *(unsigned*)(keb + oo) = pack2(o[5][0], o[5][1]);
    }
    if (rg == 0) {
      *(float2*)(dlf + (long)cgi * 1024 + ch) = make_float2(expf(totf[0]), expf(totf[1]));
      *(float2*)(dlb + (long)cgi * 1024 + ch) = make_float2(expf(totb[0]), expf(totb[1]));
    }
  }
  __syncthreads();
}

template <int C, int DKT>
__device__ __forceinline__ void rec_scores_item(const Params& P, const Rec& R, int cgi, int h, int ti, int tj) {
  constexpr int T = C > 128 ? 128 : C, KTS = DKT;
  const u16* qdf = (const u16*)(WS(P) + O_QDF); const u16* qdb = (const u16*)(WS(P) + O_QDB);
  const u16* kif = (const u16*)(WS(P) + O_KIF); const u16* kib = (const u16*)(WS(P) + O_KIB);
  u16* sc = (u16*)(WS(P) + O_SC) + (((long)cgi * R.H + h) * C + ti * T) * C + tj * T;
  const long offA = ((long)cgi * C + ti * T) * 1024 + h * R.DK, offB = ((long)cgi * C + tj * T) * 1024 + h * R.DK;
  f32x4 af[T / 32][T / 64] = {}, ab[T / 32][T / 64] = {};
  if (ti >= tj) gemm_acc<T, T, true, true, true, KTS>(af, qdf + offA, 1024, kif + offB, 1024, (u16*)smem);
  if (ti <= tj) gemm_acc<T, T, true, true, true, KTS>(ab, qdb + offA, 1024, kib + offB, 1024, (u16*)smem);
  const int tid = TID(), lane = tid & 63, wid = tid >> 6;
  const int wm = wid >> 2, wn = wid & 3, fr = lane & 15, fq = lane >> 4;
#pragma unroll
  for (int mi = 0; mi < T / 32; ++mi)
#pragma unroll
    for (int ni = 0; ni < T / 64; ++ni) {
      const int r = wm * (T / 2) + mi * 16 + fr, c0 = wn * (T / 4) + ni * 16 + fq * 4;
      const int gr = ti * T + r;
      float v[4];
#pragma unroll
      for (int j = 0; j < 4; ++j) {
        const int gc = tj * T + c0 + j;
        v[j] = (gc <= gr ? af[mi][ni][j] : 0.f) + (gc >= gr ? ab[mi][ni][j] : 0.f);
      }
      *(uint2*)(sc + r * C + c0) = make_uint2(pack2(v[0], v[1]), pack2(v[2], v[3]));
    }
}

template <int C, int DKT>
__device__ void phase_rec_su(const Params& P, int kind) {
  const Rec R = rec_of(kind);
  constexpr int KTU = C / 64;
  const int nch = SLAB / C;
  constexpr int NT1 = (C > 128 ? C / 128 : 1), NTT = NT1 * NT1;
  const int n_sc = nch * R.H * NTT;
  const int mtn = R.DK / 128, ntn = R.DV / 128;
  const int n_u = nch * R.H * 2 * mtn * ntn, G = gridDim.x;
  const u16* pj = (const u16*)(WS(P) + O_PROJ);
  for (int item = BID(); item < n_sc; item += G) { const int tl = item % NTT, hh = (item / NTT) % R.H, cg = item / (NTT * R.H); rec_scores_item<C, DKT>(P, R, cg, hh, tl / NT1, tl % NT1); }
  const u16* kef = (const u16*)(WS(P) + O_KEF); const u16* keb = (const u16*)(WS(P) + O_KEB);
  u16* stfb = (u16*)(WS(P) + O_STF); u16* stbb = (u16*)(WS(P) + O_STB);
  Tiles<KTU> ta, tb;
#define U_DECODE(q_, nt_, mt_, dir_, h_, cgi_) int nt_, mt_, dir_, h_, cgi_; { int qq = (q_); nt_ = qq % ntn; qq /= ntn; mt_ = qq % mtn; qq /= mtn; dir_ = qq & 1; qq >>= 1; h_ = qq % R.H; cgi_ = qq / R.H; }
#define U_ISSUE(T_, nt_, mt_, dir_, h_, cgi_) tiles_issue<128, 128, false, false, KTU>(T_, (dir_ ? keb : kef) + (long)cgi_ * C * 1024 + h_ * R.DK + mt_ * 128, 1024, pj + (long)cgi_ * C * R.ldv + R.voff + h_ * R.DV + nt_ * 128, R.ldv)
#define U_RUN(T_, nt_, mt_, dir_, h_, cgi_) { f32x4 acc[4][2] = {}; gemm_run<128, 128, false, false, false, KTU>(acc, T_, (u16*)smem); \
    u16* st = (dir_ ? stbb : stfb) + (((long)cgi_ * R.H + h_) * R.DV + nt_ * 128) * R.DK + mt_ * 128; const int DK = R.DK; \
    epi_each<128, 128, false>(acc, [&](int r, int c, f32x4 val) { *(uint2*)(st + (long)c * DK + r) = make_uint2(pack2(val[0], val[1]), pack2(val[2], val[3])); }); }
  int q = BID();
  if (q < n_u) { U_DECODE(q, nt, mt, dir, h, cgi); U_ISSUE(ta, nt, mt, dir, h, cgi); }
  for (; q < n_u; q += 2 * G) {
    U_DECODE(q, nt, mt, dir, h, cgi);
    const int q2 = q + G;
    if (q2 < n_u) { U_DECODE(q2, nt2, mt2, dir2, h2, cgi2); U_ISSUE(tb, nt2, mt2, dir2, h2, cgi2); }
    U_RUN(ta, nt, mt, dir, h, cgi);
    const int q3 = q + 2 * G;
    if (q3 < n_u) { U_DECODE(q3, nt3, mt3, dir3, h3, cgi3); U_ISSUE(ta, nt3, mt3, dir3, h3, cgi3); }
    if (q2 < n_u) { U_DECODE(q2, nt2, mt2, dir2, h2, cgi2); U_RUN(tb, nt2, mt2, dir2, h2, cgi2); }
  }
#undef U_DECODE
#undef U_ISSUE
#undef U_RUN
  __syncthreads();
}

__device__ void phase_rec_scan(const Params& P, int kind, int slab, bool dry = false) {
  const Rec R = rec_of(kind);
  const int L = Lof(slab), nseq = SLAB / L, ncs = L / R.C;
  const int qdk = R.DK / 4;
  const long per = (long)R.H * R.DV * qdk;
  const long total = 2 * nseq * per;
  const long gtid = (long)BID() * NT + TID(), gsz = (long)gridDim.x * NT;
  for (long idx = gtid; idx < total; idx += gsz) {
    long q = idx;
    const int pd = (int)(q % qdk); q /= qdk;
    const int e = (int)(q % R.DV); q /= R.DV;
    const int h = (int)(q % R.H); q /= R.H;
    const int seq = (int)(q % nseq);
    const int dir = (int)(q / nseq);
    u16* st = (u16*)(WS(P) + (dir ? O_STB : O_STF));
    u16* stw = dry ? (u16*)(WS(P) + O_OBUF) : st;
    const float* dl = (const float*)(WS(P) + (dir ? O_DLB : O_DLF));
    float s0 = 0.f, s1 = 0.f, s2 = 0.f, s3 = 0.f;
    const long ebase = ((long)h * R.DV + e) * R.DK + pd * 4;
    const long cstride = (long)R.H * R.DV * R.DK;
    const int dbase = h * R.DK + pd * 4;
    for (int i0 = 0; i0 < ncs; i0 += 8) {
      uint2 u[8];
      float4 dd[8];
#pragma unroll
      for (int j = 0; j < 8; ++j) {
        const int n = dir ? (ncs - 1 - i0 - j) : (i0 + j);
        const long cgi = (long)seq * ncs + n;
        u[j] = *(const uint2*)(st + cgi * cstride + ebase);
        dd[j] = *(const float4*)(dl + cgi * 1024 + dbase);
      }
#pragma unroll
      for (int j = 0; j < 8; ++j) {
        const int n = dir ? (ncs - 1 - i0 - j) : (i0 + j);
        const long cgi = (long)seq * ncs + n;
        *(uint2*)(stw + cgi * cstride + ebase) = make_uint2(pack2(s0, s1), pack2(s2, s3));
        s0 = dd[j].x * s0 + bf2f((u16)(u[j].x & 0xffff));
        s1 = dd[j].y * s1 + bf2f((u16)(u[j].x >> 16));
        s2 = dd[j].z * s2 + bf2f((u16)(u[j].y & 0xffff));
        s3 = dd[j].w * s3 + bf2f((u16)(u[j].y >> 16));
      }
    }
  }
}

template <int C, int DKT>
__device__ void phase_rec_out(const Params& P, int kind) {
  const Rec R = rec_of(kind);
  constexpr int T = C > 128 ? 128 : C, NRT = C / T;
  constexpr int KT1 = C / 64, KT2 = DKT;
  const int nch = SLAB / C, ntn = R.DV / 128;
  const u16* pj = (const u16*)(WS(P) + O_PROJ);
  const u16* scb = (const u16*)(WS(P) + O_SC);
  const u16* qdf = (const u16*)(WS(P) + O_QDF); const u16* qdb = (const u16*)(WS(P) + O_QDB);
  const u16* stf = (const u16*)(WS(P) + O_STF); const u16* stb = (const u16*)(WS(P) + O_STB);
  u16* ob = (u16*)(WS(P) + O_OBUF);
  const int HDV = R.H * R.DV;
  const int nitems = nch * R.H * NRT * ntn, G = gridDim.x;
  Tiles<KT1> t1; Tiles<KT2> t2; Tiles<KT2> t3;
  int item = BID();
  if (item < nitems) {
    const int nt = item % ntn, rt = (item / ntn) % NRT, h = (item / (ntn * NRT)) % R.H, cgi = item / (ntn * NRT * R.H);
    tiles_issue<T, 128, true, false, KT1>(t1, scb + (((long)cgi * R.H + h) * C + rt * T) * C, C, pj + (long)cgi * C * R.ldv + R.voff + h * R.DV + nt * 128, R.ldv);
  }
  for (; item < nitems; item += G) {
    const int nt = item % ntn, rt = (item / ntn) % NRT, h = (item / (ntn * NRT)) % R.H, cgi = item / (ntn * NRT * R.H);
    const long qoff = ((long)cgi * C + rt * T) * 1024 + h * R.DK;
    const long soff = (((long)cgi * R.H + h) * R.DV + nt * 128) * R.DK;
    f32x4 acc[T / 32][2] = {};
    tiles_issue<T, 128, true, true, KT2>(t2, qdf + qoff, 1024, stf + soff, R.DK);
    gemm_run<T, 128, true, false, true, KT1>(acc, t1, (u16*)smem);
    tiles_issue<T, 128, true, true, KT2>(t3, qdb + qoff, 1024, stb + soff, R.DK);
    gemm_run<T, 128, true, true, true, KT2>(acc, t2, (u16*)smem);
    const int nx = item + G;
    if (nx < nitems) {
      const int nt2 = nx % ntn, rt2 = (nx / ntn) % NRT, h2 = (nx / (ntn * NRT)) % R.H, cg2 = nx / (ntn * NRT * R.H);
      tiles_issue<T, 128, true, false, KT1>(t1, scb + (((long)cg2 * R.H + h2) * C + rt2 * T) * C, C, pj + (long)cg2 * C * R.ldv + R.voff + h2 * R.DV + nt2 * 128, R.ldv);
    }
    gemm_run<T, 128, true, true, true, KT2>(acc, t3, (u16*)smem);
    u16* o = ob + ((long)cgi * C + rt * T) * HDV + h * R.DV + nt * 128;
    epi_each<T, 128, true>(acc, [&](int r, int c, f32x4 val) { *(uint2*)(o + (long)r * HDV + c) = make_uint2(pack2(val[0], val[1]), pack2(val[2], val[3])); });
  }
  __syncthreads();
}

template <int KIND>
__device__ void phase_rec_ng_t(const Params& P) {
  const Rec R = rec_of(KIND);
  constexpr int DV = (KIND == 1) ? 512 : 128, H = (KIND == 1) ? 4 : 8, PER = DV / 64, HDV = H * DV;
  const u16* __restrict__ ob = (const u16*)(WS(P) + O_OBUF);
  const u16* __restrict__ pj = (const u16*)(WS(P) + O_PROJ);
  u16* __restrict__ a2 = (u16*)(WS(P) + O_A2);
  const float* gain = P.in[29];
  const int tid = TID(), lane = tid & 63, wid = tid >> 6;
  constexpr int nrows = SLAB * H;
  for (int item = BID(); item < nrows / 32; item += gridDim.x) {
    float v[4][PER];
    float ss[4];
#pragma unroll
    for (int u = 0; u < 4; ++u) {
      const int rh = item * 32 + wid * 4 + u;
      const int t = rh / H, h = rh % H;
      const u16* o = ob + (long)t * HDV + h * DV + lane * PER;
      if (PER == 8) {
        float f8[8];
        unpack8(*(const uint4*)o, f8);
#pragma unroll
        for (int i = 0; i < 8; ++i) v[u][i % PER] = f8[i];
      } else {
        const unsigned w = *(const unsigned*)o;
        v[u][0] = bf2f((u16)(w & 0xffff)); v[u][1 % PER] = bf2f((u16)(w >> 16));
      }
      float a = 0.f;
#pragma unroll
      for (int i = 0; i < PER; ++i) a += v[u][i] * v[u][i];
      ss[u] = a;
    }
#pragma unroll
    for (int u = 0; u < 4; ++u) ss[u] = wave_sum(ss[u]);
#pragma unroll
    for (int u = 0; u < 4; ++u) {
      const int rh = item * 32 + wid * 4 + u;
      const int t = rh / H, h = rh % H;
      const float rstd = rsqrtf(ss[u] / (float)DV + 1e-6f);
      const u16* g = pj + (long)t * R.ldv + R.goff + h * DV + lane * PER;
      u16* out = a2 + (long)t * HDV + h * DV + lane * PER;
      float y[PER];
#pragma unroll
      for (int i = 0; i < PER; ++i) {
        y[i] = v[u][i] * rstd;
        if (KIND == 3) y[i] *= gain[lane * PER + i];
      }
      if (PER == 8) {
        const uint4 gw = *(const uint4*)g;
        float gf[8];
        unpack8(gw, gf);
        float r8[8];
#pragma unroll
        for (int i = 0; i < 8; ++i) r8[i] = y[i % PER] * silu_f(gf[i]);
        *(uint4*)out = pack8s(r8, 1.f);
      } else {
        const unsigned gw = *(const unsigned*)g;
        *(unsigned*)out = pack2(y[0] * silu_f(bf2f((u16)(gw & 0xffff))), y[1 % PER] * silu_f(bf2f((u16)(gw >> 16))));
      }
    }
  }
}
__device__ void phase_rec_ng(const Params& P, int kind) {
  if (kind == 1) phase_rec_ng_t<1>(P); else phase_rec_ng_t<3>(P);
}

__device__ void phase_swa_prep(const Params& P, int slab) {
  const int L = Lof(slab);
  const u16* __restrict__ pj = (const u16*)(WS(P) + O_PROJ);
  u16* __restrict__ qn = (u16*)(WS(P) + O_QN);
  u16* __restrict__ kn = (u16*)(WS(P) + O_KN);
  const float2* __restrict__ rope = (const float2*)(WS(P) + O_ROPES);
  const long gtid = (long)BID() * NT + TID(), gsz = (long)gridDim.x * NT;
  for (long idx = gtid; idx < (long)SLAB * 80; idx += gsz) {
    const int j = (int)(idx & 3);
    const int hd = (int)((idx >> 2) % 20);
    const int t = (int)(idx / 80);
    const int col = hd < 16 ? hd * 64 : 1024 + (hd - 16) * 64;
    const int d0 = j * 8;
    float x1[8], x2[8];
    unpack8(*(const uint4*)(pj + (long)t * 1536 + col + d0), x1);
    unpack8(*(const uint4*)(pj + (long)t * 1536 + col + d0 + 32), x2);
    const float4* rp = (const float4*)(rope + (long)(t & (L - 1)) * 32 + d0);
    const float4 c01 = rp[0], c23 = rp[1], c45 = rp[2], c67 = rp[3];
    float ss = 0.f;
#pragma unroll
    for (int i = 0; i < 8; ++i) ss += x1[i] * x1[i] + x2[i] * x2[i];
    ss += __shfl_xor(ss, 1); ss += __shfl_xor(ss, 2);
    const float rstd = rsqrtf(ss * (1.f / 64.f) + 1e-6f);
    const float* gn = hd < 16 ? P.in[23] : P.in[24];
    const float4 ga = *(const float4*)(gn + d0), gb = *(const float4*)(gn + d0 + 4), gc = *(const float4*)(gn + d0 + 32), gd = *(const float4*)(gn + d0 + 36);
    const float g1[8] = {ga.x, ga.y, ga.z, ga.w, gb.x, gb.y, gb.z, gb.w};
    const float g2[8] = {gc.x, gc.y, gc.z, gc.w, gd.x, gd.y, gd.z, gd.w};
    const float cs[8] = {c01.x, c01.z, c23.x, c23.z, c45.x, c45.z, c67.x, c67.z};
    const float sn[8] = {c01.y, c01.w, c23.y, c23.w, c45.y, c45.w, c67.y, c67.w};
    const float osc = hd < 16 ? 0.125f : 1.f;
    float o1[8], o2[8];
#pragma unroll
    for (int i = 0; i < 8; ++i) {
      const float y1 = x1[i] * rstd * g1[i], y2 = x2[i] * rstd * g2[i];
      o1[i] = (y1 * cs[i] - y2 * sn[i]) * osc;
      o2[i] = (y1 * sn[i] + y2 * cs[i]) * osc;
    }
    u16* dst = hd < 16 ? qn + (long)t * 1024 + hd * 64 + d0 : kn + (long)t * 256 + (hd - 16) * 64 + d0;
    *(uint4*)dst = pack8s(o1, 1.f);
    *(uint4*)(dst + 32) = pack8s(o2, 1.f);
  }
}

constexpr int SLD = 324;
__device__ void phase_swa_att(const Params& P, int slab) {
  const int L = Lof(slab), nqb = L / 64;
  const u16* qn = (const u16*)(WS(P) + O_QN);
  const u16* kn = (const u16*)(WS(P) + O_KN);
  const u16* pj = (const u16*)(WS(P) + O_PROJ);
  u16* a2 = (u16*)(WS(P) + O_A2);
  const float* sink = P.in[25];
  float* S = (float*)(smem + 40960);
  u16* Bs = (u16*)smem + 9216;
  const int tid = TID(), lane = tid & 63, wid = tid >> 6;
  const int wm = wid >> 2, wn = wid & 3, fr = lane & 15, fq = lane >> 4;
  const int nitems = (SLAB / 64) * 16;
  for (int item = BID(); item < nitems; item += gridDim.x) {
    const int hq = item & 15, qbg = item >> 4;
    const int seq = qbg / nqb, qb = qbg % nqb;
    const int q0 = qb * 64;
    const long tok0 = (long)seq * L;
    const int hkv = hq >> 2;
    uint4 vt[5];
#pragma unroll
    for (int kt = 0; kt < 5; ++kt) {
      const int kp0 = q0 - 128 + kt * 64;
      vt[kt] = make_uint4(0, 0, 0, 0);
      if (kp0 >= 0 && kp0 < L) vt[kt] = ld_chunk<64, false>(pj + (tok0 + kp0) * 1536 + 1280 + hkv * 64, 1536, 0, tid);
    }
    for (int kt = 0; kt < 5; ++kt) {
      const int kp0 = q0 - 128 + kt * 64;
      if (kp0 >= 0 && kp0 < L) {
        f32x4 acc[2][1] = {};
        gemm_acc<64, 64, true, true, true, 1>(acc, qn + (tok0 + q0) * 1024 + hq * 64, 1024, kn + (tok0 + kp0) * 256 + hkv * 64, 256, (u16*)smem);
        epi_each<64, 64, true>(acc, [&](int r, int c, f32x4 v) {
          f32x4 o;
#pragma unroll
          for (int j = 0; j < 4; ++j) {
            const int dlt = (q0 + r) - (kp0 + c + j);
            o[j] = (dlt <= 128 && dlt >= -128) ? v[j] : -1e30f;
          }
          *(f32x4*)(S + r * SLD + kt * 64 + c) = o;
        });
      } else {
        for (int i = tid; i < 4096; i += NT) S[(i >> 6) * SLD + kt * 64 + (i & 63)] = -1e30f;
      }
    }
    __syncthreads();
    {
      const int r = tid >> 3, sub = tid & 7;
      const float sk = sink[hq];
      float e[40];
      float m = sk;
#pragma unroll
      for (int i = 0; i < 40; ++i) { e[i] = S[r * SLD + sub + 8 * i]; m = fmaxf(m, e[i]); }
      m = fmaxf(m, __shfl_xor(m, 1)); m = fmaxf(m, __shfl_xor(m, 2)); m = fmaxf(m, __shfl_xor(m, 4));
      float den = 0.f;
#pragma unroll
      for (int i = 0; i < 40; ++i) { e[i] = __expf(e[i] - m); den += e[i]; }
      den += __shfl_xor(den, 1); den += __shfl_xor(den, 2); den += __shfl_xor(den, 4);
      den += __expf(sk - m);
      const float inv = 1.f / den;
      u16* prow = (u16*)(S + r * SLD);
#pragma unroll
      for (int i = 0; i < 40; ++i) prow[sub + 8 * i] = f2bf(e[i] * inv);
    }
    __syncthreads();
    f32x4 acc[2][1] = {};
#pragma unroll
    for (int kt = 0; kt < 5; ++kt) {
      const int kp0 = q0 - 128 + kt * 64;
      if (kp0 >= 0 && kp0 < L) {
        __syncthreads();
        st_chunk<64, false>(Bs, vt[kt], tid);
        __syncthreads();
#pragma unroll
        for (int ks = 0; ks < 2; ++ks) {
          bf16x8 af[2];
#pragma unroll
          for (int mi = 0; mi < 2; ++mi) af[mi] = *(const bf16x8*)((const u16*)(S + (wm * 32 + mi * 16 + fr) * SLD) + kt * 64 + ks * 32 + fq * 8);
          const bf16x8 bfr = ld_frag<64, false>(Bs, wn * 16, ks, fr, fq);
#pragma unroll
          for (int mi = 0; mi < 2; ++mi) acc[mi][0] = __builtin_amdgcn_mfma_f32_16x16x32_bf16(bfr, af[mi], acc[mi][0], 0, 0, 0);
        }
      }
    }
    u16* o = a2 + (tok0 + q0) * 1024 + hq * 64;
    epi_each<64, 64, true>(acc, [&](int r, int c, f32x4 v) { *(uint2*)(o + (long)r * 1024 + c) = make_uint2(pack2(v[0], v[1]), pack2(v[2], v[3])); });
    __syncthreads();
  }
}

#define XB_TMO      128
#define XB_XCNT(j)  (256  + 64 * (j))
#define XB_XSUB(j)  (1280 + 64 * (j))
#define XB_XGEN(j)  (2304 + 64 * (j))
#define XB_TOP      3328
#define XB_TOPGEN   3392
#define XCD_BAR_WORDS 3456
#define XB_SPIN_CAP (1u << 18)
__device__ __forceinline__ unsigned xb_ld(unsigned* p)              { return __hip_atomic_load(p, __ATOMIC_RELAXED, __HIP_MEMORY_SCOPE_AGENT); }
__device__ __forceinline__ unsigned xb_add(unsigned* p, unsigned v) { return __hip_atomic_fetch_add(p, v, __ATOMIC_RELAXED, __HIP_MEMORY_SCOPE_AGENT); }
__device__ __forceinline__ unsigned xb_xcc_id() { return (unsigned)__builtin_amdgcn_s_getreg((3 << 11) | 20) & 0xFu; }
#define XB_SPIN(cond, bar) do { unsigned _sp = 0; while (cond) { __builtin_amdgcn_s_sleep(1); \
    if ((++_sp & 255u) == 0u) { if (xb_ld(&(bar)[XB_TMO])) break; if (_sp > XB_SPIN_CAP) { atomicAdd(&(bar)[XB_TMO], 1u); break; } } } } while (0)
struct XcdBarrier { unsigned* bar; unsigned x; volatile LDS_AS unsigned* st; };
__device__ __forceinline__ XcdBarrier xcd_barrier_post(unsigned* bar, volatile LDS_AS unsigned* st) {
    XcdBarrier b; b.bar = bar; b.x = xb_xcc_id(); b.st = st;
    if (threadIdx.x == 0) (void)xb_add(&bar[XB_XCNT(b.x)], 1u);
    return b;
}
__device__ __forceinline__ void xcd_barrier_complete(unsigned* bar, unsigned x, unsigned& nloc, unsigned& nx) {
    const unsigned G = gridDim.x * gridDim.y * gridDim.z;
    unsigned sum, cnt, mine, sp = 0u;
    for (;;) {
        sum = 0u; cnt = 0u; mine = 0u;
#pragma unroll
        for (unsigned j = 0; j < 16; ++j) { const unsigned c = xb_ld(&bar[XB_XCNT(j)]); sum += c; cnt += (c > 0u) ? 1u : 0u; mine = (j == x) ? c : mine; }
        if (sum == G) break;
        __builtin_amdgcn_s_sleep(1);
        if ((++sp & 255u) == 0u) { if (xb_ld(&bar[XB_TMO])) break; if (sp > XB_SPIN_CAP) { atomicAdd(&bar[XB_TMO], 1u); break; } }
    }
    nloc = mine > 0u ? mine : 1u; nx = cnt > 0u ? cnt : 1u;
}
__device__ __forceinline__ void xcd_barrier(const XcdBarrier& b) {
    asm volatile("s_waitcnt vmcnt(0)" ::: "memory");
    __syncthreads();
    if (threadIdx.x == 0) {
        unsigned* bar = b.bar;
        __builtin_amdgcn_s_waitcnt(0);
        unsigned nloc = b.st[0], nx = b.st[1];
        if (nloc == 0u) { xcd_barrier_complete(bar, b.x, nloc, nx); b.st[0] = nloc; b.st[1] = nx; }
        const unsigned old = xb_add(&bar[XB_XSUB(b.x)], 1u);
        const unsigned gen = old / nloc;
        if (old + 1u == (gen + 1u) * nloc) {
            __builtin_amdgcn_fence(__ATOMIC_RELEASE, "agent");
            asm volatile("s_waitcnt vmcnt(0)" ::: "memory");
            const unsigned og = xb_add(&bar[XB_TOP], 1u);
            const unsigned tg = og / nx;
            if (og + 1u == (tg + 1u) * nx) xb_add(&bar[XB_TOPGEN], 1u);
            else XB_SPIN(xb_ld(&bar[XB_TOPGEN]) == tg, bar);
            __builtin_amdgcn_fence(__ATOMIC_ACQUIRE, "agent");
            xb_add(&bar[XB_XGEN(b.x)], 1u);
            asm volatile("s_waitcnt vmcnt(0)" ::: "memory");
        } else {
            XB_SPIN(xb_ld(&bar[XB_XGEN(b.x)]) == gen, bar);
            __builtin_amdgcn_fence(__ATOMIC_ACQUIRE, "agent");
            asm volatile("s_waitcnt vmcnt(0)" ::: "memory");
        }
    }
    __syncthreads();
}

__device__ __forceinline__ int nmix_of(int kind) { return (kind & 1) ? 8 : (kind == 2 ? 5 : 6); }

__device__ void ffn_step(const Params& P, int layer, int f) {
  if (f == 6) { phase_ffn_down(P, layer); return; }
  const int fs = f / 3, st = f % 3;
  if (st == 0) { REP(4) phase_norm(P, layer, fs, 1); }
  else if (st == 1) { REP(0) phase_ffn_gate(P, layer); }
  else { REP(0) phase_ffn_val(P, layer, fs); }
}
__device__ void layer_step(const Params& P, int layer, int slab, int step) {
  const int kind = layer;
  if (step == 0) { REP(4) phase_norm(P, layer, slab, 0); return; }
  if (kind == 0) {
    if (step == 1) { REP(0) phase_proj(P, O_WHYIN, 3072); }
    else if (step == 2) { REP(3) phase_hy_conv(P, slab); }
    else if (step == 3) { if ((PROBE_MASK >> 7) & 1) phase_hy_fft(P, slab, true); phase_hy_fft(P, slab); }
    else if (step == 4) { REP(3) phase_hy_tr(P, slab); }
    else phase_resid(P, layer, slab, (const u16*)(WS(P) + O_A2), 1024, O_WHYOUT, 2 * D);
  } else if (kind == 1) {
    if (step == 1) { REP(0) phase_proj(P, O_WRETIN, 6144); }
    else if (step == 2) { REP(1) REP(9) phase_ret_prep(P, slab); }
    else if (step == 3) { REP(1) REP(11) phase_rec_su<256, 4>(P, 1); }
    else if (step == 4) { if ((PROBE_MASK >> 6) & 1) phase_rec_scan(P, 1, slab, true); phase_rec_scan(P, 1, slab); }
    else if (step == 5) { REP(1) REP(12) phase_rec_out<256, 4>(P, 1); }
    else if (step == 6) { REP(1) REP(9) phase_rec_ng(P, 1); }
    else phase_resid(P, layer, slab, (const u16*)(WS(P) + O_A2), 2048, O_WRETOUT, 2 * D);
  } else if (kind == 2) {
    if (step == 1) { REP(0) phase_proj(P, O_WSWAIN, 1536); }
    else if (step == 2) { REP(2) REP(14) phase_swa_prep(P, slab); }
    else if (step == 3) { REP(2) REP(15) phase_swa_att(P, slab); }
    else phase_resid(P, layer, slab, (const u16*)(WS(P) + O_A2), 1024, O_WSWAOUT, 2 * D);
  } else {
    if (step == 1) { REP(0) phase_proj(P, O_WHGIN, 5120); }
    else if (step == 2) { REP(1) REP(9) phase_hg_prep(P); }
    else if (step == 3) { REP(1) REP(11) phase_rec_su<128, 2>(P, 3); }
    else if (step == 4) { if ((PROBE_MASK >> 6) & 1) phase_rec_scan(P, 3, slab, true); phase_rec_scan(P, 3, slab); }
    else if (step == 5) { REP(1) REP(12) phase_rec_out<128, 2>(P, 3); }
    else if (step == 6) { REP(1) REP(9) phase_rec_ng(P, 3); }
    else phase_resid(P, layer, slab, (const u16*)(WS(P) + O_A2), 1024, O_WHGOUT, 2 * D);
  }
}

__global__ void __launch_bounds__(NT) fwd_megakernel(Params P) {
  cg::grid_group grid = cg::this_grid();
  __shared__ uint4 xb_words;
  if (threadIdx.x == 0) xb_words = make_uint4(0u, 0u, 0u, 0u);
  __syncthreads();
  XcdBarrier xb = xcd_barrier_post((unsigned*)(P.ws + O_BAR), (volatile LDS_AS unsigned*)&xb_words);
  for (int pid = P.p0; pid < P.p1; ++pid) {
    if (pid == 0) { REP(5) phase_pre0(P); }
    else if (pid == 1) { REP(5) phase_pre1(P); }
    else {
      int q = pid - 2, layer = 0;
      while (q >= 5 * nmix_of(layer) + 7) { q -= 5 * nmix_of(layer) + 7; ++layer; }
      const int nm = nmix_of(layer);
      if (q < 5 * nm) layer_step(P, layer, q / nm, q % nm);
      else ffn_step(P, layer, q - 5 * nm);
    }
    if (pid + 1 < P.p1) {
      if (pid == 0) grid.sync();
      else xcd_barrier(xb);
      if ((PROBE_MASK >> 8) & 1) xcd_barrier(xb);
    }
  }
}

extern "C" void kernel_launch(void* const* d_in, const int* in_sizes, int n_in, void* d_out, int out_size, void* d_ws,
                              size_t ws_size, hipStream_t stream) {
  static int grid_blocks = 0;
  if (!grid_blocks) {
    int dev = 0, cus = 0, per_cu = 0;
    (void)hipGetDevice(&dev);
    (void)hipDeviceGetAttribute(&cus, hipDeviceAttributeMultiprocessorCount, dev);
    (void)hipFuncSetAttribute((const void*)fwd_megakernel, hipFuncAttributeMaxDynamicSharedMemorySize, LDSB);
    (void)hipOccupancyMaxActiveBlocksPerMultiprocessor(&per_cu, (const void*)fwd_megakernel, NT, LDSB);
    if (per_cu < 1) per_cu = 1;
    if (per_cu > 1) per_cu = 1;
    grid_blocks = cus * per_cu;
    if (ws_size < WS_END) fprintf(stderr, "kernel_launch: workspace too small: %zu < %zu\n", ws_size, (size_t)WS_END);
  }
  Params p;
  memset(&p, 0, sizeof(p));
  for (int i = 0; i < 36; ++i) p.in[i] = (const float*)d_in[i];
  p.out = (float*)d_out;
  p.ws = (unsigned char*)d_ws;
  (void)hipMemsetAsync((unsigned char*)d_ws + O_BAR, 0, XCD_BAR_WORDS * 4, stream);
#if ONE_LAUNCH
  p.p0 = 0; p.p1 = NPHASES;
  void* args[] = {&p};
  hipError_t e = hipLaunchCooperativeKernel((const void*)fwd_megakernel, dim3(grid_blocks), dim3(NT), args, LDSB, stream);
  if (e != hipSuccess) fprintf(stderr, "cooperative launch failed: %s (grid %d)\n", hipGetErrorString(e), grid_blocks);
#else
  for (int ph = 0; ph < NPHASES; ++ph) {
    p.p0 = ph; p.p1 = ph + 1;
    hipLaunchKernelGGL(fwd_megakernel, dim3(grid_blocks), dim3(NT), LDSB, stream, p);
  }
#endif
}
```

```cpp
#include <hip/hip_runtime.h>
#include <hip/hip_cooperative_groups.h>
#include <cstdio>
#include <cstdint>
#include <cstring>
namespace cg = cooperative_groups;

typedef unsigned short u16;
typedef __attribute__((ext_vector_type(8))) short bf16x8;
typedef __attribute__((ext_vector_type(4))) float f32x4;

#define NT 512
#ifndef ONE_LAUNCH
#define ONE_LAUNCH 1
#endif
#ifndef PROBE_MASK
#define PROBE_MASK 0
#endif
#define REP(cls) for (int rep_##cls = 0; rep_##cls < (((PROBE_MASK >> (cls)) & 1) ? 2 : 1); ++rep_##cls)

constexpr int D = 1024, SLAB = 16384, DFF = 2816;
constexpr int LDSB = 139264;
constexpr int FSLAB = 40960, NTOK = 81920;
constexpr int NPHASES = 2 + 5 * (6 + 8 + 5 + 8) + 4 * 7;

constexpr size_t SZW(size_t n, size_t k) { return n * k * 2; }
constexpr size_t O_WHYIN = 0;
constexpr size_t O_WHYOUT = O_WHYIN + SZW(3072, 1024);
constexpr size_t O_WRETIN = O_WHYOUT + SZW(1024, 1024);
constexpr size_t O_WRETOUT = O_WRETIN + SZW(6144, 1024);
constexpr size_t O_WSWAIN = O_WRETOUT + SZW(1024, 2048);
constexpr size_t O_WSWAOUT = O_WSWAIN + SZW(1536, 1024);
constexpr size_t O_WHGIN = O_WSWAOUT + SZW(1024, 1024);
constexpr size_t O_WHGOUT = O_WHGIN + SZW(5120, 1024);
constexpr size_t O_WFG = O_WHGOUT + SZW(1024, 1024);
constexpr size_t O_WFV = O_WFG + 4 * SZW(2816, 1024);
constexpr size_t O_WFD = O_WFV + 4 * SZW(2816, 1024);
constexpr size_t O_MOD = O_WFD + 4 * SZW(1024, 2816);
constexpr size_t O_TW = O_MOD + (size_t)4 * 16 * 6144 * 4;
constexpr size_t O_HIDS = O_TW + 8192 * 8;
constexpr size_t O_HIDP = O_HIDS + (size_t)8192 * 64 * 4;
constexpr size_t O_ROPER = O_HIDP + (size_t)2048 * 64 * 4;
constexpr size_t O_ROPES = O_ROPER + (size_t)8192 * 128 * 8;
constexpr size_t O_PROJ = O_ROPES + (size_t)8192 * 32 * 8;
constexpr size_t O_HBUF = O_PROJ + (size_t)SLAB * 6144 * 2;
constexpr size_t O_A2 = O_HBUF + (size_t)SLAB * 1024 * 2;
constexpr size_t O_C = O_A2 + (size_t)SLAB * 2048 * 2;
constexpr size_t O_FHBUF = O_PROJ;
constexpr size_t O_FGBUF = O_FHBUF + (size_t)FSLAB * 1024 * 2;
constexpr size_t O_FACT = O_FGBUF + (size_t)FSLAB * DFF * 2;
constexpr size_t END_F = O_FACT + (size_t)NTOK * DFF * 2;
constexpr size_t O_MODP = O_C;
constexpr size_t O_BAR = ((size_t)1 << 30) - 16384;
constexpr size_t O_HSPS = O_BAR - (size_t)1024 * 16384 * 8 - (size_t)1024 * 4096 * 8;
constexpr size_t O_HSPP = O_HSPS + (size_t)1024 * 16384 * 8;
constexpr size_t O_UT = O_C;
constexpr size_t O_X0C = O_UT + (size_t)SLAB * 1024 * 4;
constexpr size_t END_HY = O_X0C + (size_t)SLAB * 1024 * 2;
static_assert(END_F <= O_HSPS && END_HY <= O_HSPS, "layer-0 buffers overlap the filter spectra");
constexpr size_t SZP = (size_t)SLAB * 1024 * 2;
constexpr size_t O_QDF = O_C, O_QDB = O_QDF + SZP, O_KIF = O_QDB + SZP, O_KIB = O_KIF + SZP, O_KEF = O_KIB + SZP, O_KEB = O_KEF + SZP;
constexpr size_t O_DLF = O_KEB + SZP;
constexpr size_t O_DLB = O_DLF + (size_t)256 * 1024 * 4;
constexpr size_t O_SC = O_DLB + (size_t)256 * 1024 * 4;
constexpr size_t O_STF = O_SC + (size_t)SLAB * 1024 * 2;
constexpr size_t O_STB = O_STF + (size_t)134217728;
constexpr size_t O_OBUF = O_STB + (size_t)134217728;
constexpr size_t END_REC = O_OBUF + (size_t)SLAB * 2048 * 4;
constexpr size_t O_QN = O_C;
constexpr size_t O_KN = O_QN + SZP;
constexpr size_t O_PBUF = O_KN + (size_t)SLAB * 256 * 2;
constexpr size_t END_SWA = O_PBUF + (size_t)SLAB * 16 * 320 * 2;
constexpr size_t WS_END = END_REC > END_HY ? (END_REC > END_SWA ? END_REC : END_SWA) : (END_HY > END_SWA ? END_HY : END_SWA);
static_assert(WS_END <= O_BAR, "workspace exceeds 1 GiB");

struct Params {
  const float* in[36];
  float* out;
  unsigned char* ws;
  int p0, p1;
};

extern __shared__ __attribute__((aligned(16))) unsigned char smem[];

__device__ __forceinline__ int TID() { int t = threadIdx.x; asm volatile("" : "+v"(t)); return t; }
__device__ __forceinline__ int BID() { int b = blockIdx.x; asm volatile("" : "+s"(b)); return b; }
__device__ __forceinline__ long ZOFF() { long z = 0; asm volatile("" : "+s"(z)); return z; }
__device__ __forceinline__ unsigned char* WS(const Params& P) { return P.ws + ZOFF(); }
__device__ __forceinline__ float* OUTP(const Params& P) { return P.out + ZOFF(); }

namespace pg8 {
#define PG8_LAS __attribute__((address_space(3)))
typedef unsigned short bf16_t;
typedef short bf16x8 __attribute__((ext_vector_type(8)));
typedef float f32x4 __attribute__((ext_vector_type(4)));
typedef unsigned u32x4 __attribute__((ext_vector_type(4)));
constexpr int BM = 256, BK = 64, HALF = 128, HTB = HALF * BK * 2  , STAGE_BYTES = 8 * HTB, NXCD = 8, WGM = 8;

__host__ __device__ __forceinline__ int lds_byte(int r, int c) { const int st = (r >> 4) * 2 + (c >> 5), rr = r & 15, cc = c & 31, ob = rr * 64 + cc * 2; return st * 1024 + (ob ^ (((ob >> 9) & 1) << 5)); }
__host__ __device__ __forceinline__ void stage_rc(int b, int& R, int& C) { const int st = b / 1024, sb = b % 1024, swz = sb ^ (((sb >> 9) & 1) << 5); R = (st >> 1) * 16 + swz / 64; C = (st & 1) * 32 + (swz % 64) / 2; }
__host__ __device__ __forceinline__ int perm32(int rho) { const int n = rho >> 4, i = rho & 15; return 8 * (i >> 2) + 4 * n + (i & 3); }

struct Unit { int pm, pn; };
struct Gemm { const bf16_t* A; const bf16_t* Bt; int M, N, K; };

struct StaticOrder {
    int nM, nN, nwg, G, c;
    __host__ __device__ void init(int M, int N, int G_, int c_) { nM = M / BM; nN = N / BM; nwg = nM * nN; G = G_; c = c_; }
    __host__ __device__ bool next(int i, Unit& u) const {
        const long L = (long)i * G + c; if (L >= nwg) return false;
        int wgid = (int)L; { const int q = nwg / NXCD, r = nwg % NXCD, xcd = wgid % NXCD, off = wgid / NXCD; wgid = (xcd < r ? xcd * (q + 1) : r * (q + 1) + (xcd - r) * q) + off; }
        const int nig = WGM * nN, gid = wgid / nig, fm = gid * WGM, gsz = (nM - fm) < WGM ? (nM - fm) : WGM;
        u.pm = fm + ((wgid % nig) % gsz); u.pn = (wgid % nig) / gsz; return true;
    }
    __device__ __forceinline__ void a_ready(const Unit&) const {}
    __device__ __forceinline__ void done(const Unit&) const {}
};

template <class Epi, class Sched, bool STAMP = false>
__device__ __forceinline__ void gemm_phase(PG8_LAS unsigned char* lds, const Gemm g, const Sched& S, const Epi& E, unsigned long long* stamps) {
    const int tid = TID(), wid = __builtin_amdgcn_readfirstlane(tid >> 6), lane = tid & 63, wr = wid >> 2, wc = wid & 3, fr = lane & 15, fq = lane >> 4;
    const int K = g.K, nt = K / BK;
    int ts_lo = 0, ts_hi = 0, nts = 0; const unsigned long long rt_entry = STAMP ? (unsigned long long)wall_clock64() : 0ull;
#define PG8_STAMP() do { if (STAMP && wid == 0 && nts < 64) { const unsigned long long _c = (unsigned long long)clock64(); \
        ts_lo = (lane == nts) ? (int)(unsigned)_c : ts_lo; ts_hi = (lane == nts) ? (int)(unsigned)(_c >> 32) : ts_hi; ++nts; } } while (0)
    PG8_STAMP();
    unsigned voffA[2], voffB[2];
#pragma unroll
    for (int i = 0; i < 2; ++i) { int R, C; stage_rc(tid * 16 + i * 8192, R, C); const int Rb = Epi::PERM ? ((R & ~31) + perm32(R & 31)) : R;
        voffA[i] = (unsigned)(R * K + C) * 2u; voffB[i] = (unsigned)(Rb * K + C) * 2u; }
    const size_t kstep = (size_t)(BK * 2);
    const size_t hstep = (size_t)HALF * K * 2;
    const size_t tstep = 2 * hstep;
    const unsigned ldsw = (unsigned)wid * 1024u;
    const int aoff = lds_byte(wr * 64 + fr, fq * 8), boff = lds_byte(wc * 32 + fr, fq * 8);
#define PG8_SA(b, h) (((b) * 2 + (h)) * HTB)
#define PG8_SB(b, h) ((4 + (b) * 2 + (h)) * HTB)
#define PG8_STAGE(bufoff, gbase, voff) do { _Pragma("unroll") for (int _i = 0; _i < 2; ++_i) \
        __builtin_amdgcn_global_load_lds((const unsigned*)((const char*)(gbase) + (voff)[_i]), (PG8_LAS unsigned*)(lds + (bufoff) + ldsw + _i * 8192), 16, 0, 0); } while (0)
#define PG8_LDA(dst, b, h) do { _Pragma("unroll") for (int m = 0; m < 4; ++m) _Pragma("unroll") for (int k = 0; k < 2; ++k) dst[m][k] = *(const PG8_LAS bf16x8*)(lds + PG8_SA(b, h) + aoff + m * 2048 + k * 1024); } while (0)
#define PG8_LDB(dst, b, h) do { _Pragma("unroll") for (int n = 0; n < 2; ++n) _Pragma("unroll") for (int k = 0; k < 2; ++k) dst[n][k] = *(const PG8_LAS bf16x8*)(lds + PG8_SB(b, h) + boff + n * 2048 + k * 1024); } while (0)
#define PG8_MMA(ai, bj, At, Bt) do { __builtin_amdgcn_s_setprio(1); _Pragma("unroll") for (int m = 0; m < 4; ++m) _Pragma("unroll") for (int n = 0; n < 2; ++n) _Pragma("unroll") for (int k = 0; k < 2; ++k) \
        acc[ai][bj][m][n] = __builtin_amdgcn_mfma_f32_16x16x32_bf16(Bt[n][k], At[m][k], acc[ai][bj][m][n], 0, 0, 0); __builtin_amdgcn_s_setprio(0); } while (0)
#define PG8_WAIT_V(n) asm volatile("s_waitcnt vmcnt(" #n ")" ::: "memory")
#define PG8_WAIT_L(n) asm volatile("s_waitcnt lgkmcnt(" #n ")" ::: "memory")
#define PG8_BAR __builtin_amdgcn_s_barrier()
#define PG8_SCHED __builtin_amdgcn_sched_barrier(0)
    Unit cur, nxt; int ui = 0;
    if (!S.next(0, cur)) return;
    f32x4 acc[2][2][4][2];
#pragma unroll
    for (int a = 0; a < 2; ++a)
#pragma unroll
        for (int b = 0; b < 2; ++b)
#pragma unroll
            for (int m = 0; m < 4; ++m)
#pragma unroll
                for (int n = 0; n < 2; ++n) acc[a][b][m][n] = (f32x4){0.f, 0.f, 0.f, 0.f};
    bf16x8 At[4][2], B0[2][2], B1[2][2];
    const char* cA = (const char*)g.A + (size_t)cur.pm * tstep; const char* cB = (const char*)g.Bt + (size_t)cur.pn * tstep;
    S.a_ready(cur);
    PG8_STAGE(PG8_SB(0, 0), cB, voffB); PG8_STAGE(PG8_SA(0, 0), cA, voffA); PG8_STAGE(PG8_SB(0, 1), cB + hstep, voffB); PG8_STAGE(PG8_SA(0, 1), cA + hstep, voffA);
    if (wr == 1) PG8_BAR;
    PG8_WAIT_V(4); PG8_BAR;
    PG8_STAGE(PG8_SB(1, 0), cB + kstep, voffB); PG8_STAGE(PG8_SA(1, 0), cA + kstep, voffA); PG8_STAGE(PG8_SB(1, 1), cB + hstep + kstep, voffB);
    PG8_WAIT_V(6); PG8_BAR;
    PG8_STAMP();
    for (;;) {
        const bool has_next = S.next(ui + 1, nxt);
        const char* nA = has_next ? (const char*)g.A + (size_t)nxt.pm * tstep : cA; const char* nB = has_next ? (const char*)g.Bt + (size_t)nxt.pn * tstep : cB;
        for (int t = 0; t < nt; t += 2) {
            const bool last = (t == nt - 2);
            const char* a1 = cA + (size_t)(t + 1) * kstep;
            const char* a2 = last ? nA : cA + (size_t)(t + 2) * kstep; const char* b2 = last ? nB : cB + (size_t)(t + 2) * kstep;
            const char* a3 = a2 + kstep; const char* b3 = b2 + kstep;
            if (last && has_next) S.a_ready(nxt);
            PG8_LDB(B0, 0, 0); PG8_SCHED; PG8_LDA(At, 0, 0); PG8_STAGE(PG8_SA(1, 1), a1 + hstep, voffA);
            PG8_WAIT_L(8); PG8_BAR; PG8_WAIT_L(0); PG8_MMA(0, 0, At, B0); PG8_BAR; PG8_SCHED;
            PG8_LDB(B1, 0, 1); PG8_STAGE(PG8_SB(0, 0), b2, voffB);
            PG8_BAR; PG8_WAIT_L(0); PG8_MMA(0, 1, At, B1); PG8_BAR;
            PG8_LDA(At, 0, 1); PG8_STAGE(PG8_SA(0, 0), a2, voffA);
            PG8_BAR; PG8_WAIT_L(0); PG8_MMA(1, 0, At, B0); PG8_BAR; PG8_SCHED;
            PG8_STAGE(PG8_SB(0, 1), b2 + hstep, voffB);
            PG8_WAIT_V(6); PG8_BAR; PG8_MMA(1, 1, At, B1); PG8_BAR;
            PG8_LDB(B0, 1, 0); PG8_SCHED; PG8_LDA(At, 1, 0); PG8_STAGE(PG8_SA(0, 1), a2 + hstep, voffA);
            PG8_WAIT_L(8); PG8_BAR; PG8_WAIT_L(0); PG8_MMA(0, 0, At, B0); PG8_BAR; PG8_SCHED;
            PG8_LDB(B1, 1, 1); PG8_STAGE(PG8_SB(1, 0), b3, voffB);
            PG8_BAR; PG8_WAIT_L(0); PG8_MMA(0, 1, At, B1); PG8_BAR;
            PG8_LDA(At, 1, 1); PG8_STAGE(PG8_SA(1, 0), a3, voffA);
            PG8_BAR; PG8_WAIT_L(0); PG8_MMA(1, 0, At, B0); PG8_BAR; PG8_SCHED;
            PG8_STAGE(PG8_SB(1, 1), b3 + hstep, voffB);
            PG8_WAIT_V(6); PG8_BAR; PG8_MMA(1, 1, At, B1); PG8_BAR;
        }
        PG8_STAMP();
        if constexpr (!Epi::AFTER_DRAIN) { E(acc, cur, wr, wc, fr, fq); S.done(cur); }
        PG8_STAMP();
        if (!has_next) break;
#pragma unroll
        for (int a = 0; a < 2; ++a)
#pragma unroll
            for (int b = 0; b < 2; ++b)
#pragma unroll
                for (int m = 0; m < 4; ++m)
#pragma unroll
                    for (int n = 0; n < 2; ++n) acc[a][b][m][n] = (f32x4){0.f, 0.f, 0.f, 0.f};
        cur = nxt; cA = nA; cB = nB; ++ui;
    }
    PG8_WAIT_V(0);
    if (wr == 0) PG8_BAR;
    PG8_BAR;
    if constexpr (Epi::AFTER_DRAIN) { E.fused(acc, cur, wr, wc, fr, fq, lds, wid, lane); S.done(cur); }
    PG8_STAMP();
    if (STAMP && wid == 0) { stamps[lane] = lane < nts ? (((unsigned long long)(unsigned)ts_hi << 32) | (unsigned)ts_lo) : 0ull;
        if (lane == 62) stamps[62] = rt_entry; if (lane == 63) stamps[63] = (unsigned long long)wall_clock64(); }
#undef PG8_STAMP
#undef PG8_SA
#undef PG8_SB
#undef PG8_STAGE
#undef PG8_LDA
#undef PG8_LDB
#undef PG8_MMA
#undef PG8_WAIT_V
#undef PG8_WAIT_L
#undef PG8_BAR
#undef PG8_SCHED
}
}


__device__ __forceinline__ u16 f2bf(float f) {
  unsigned u = __float_as_uint(f);
  u += 0x7fffu + ((u >> 16) & 1u);
  return (u16)(u >> 16);
}
__device__ __forceinline__ float bf2f(u16 h) { return __uint_as_float(((unsigned)h) << 16); }
__device__ __forceinline__ unsigned pack2(float a, float b) { return (unsigned)f2bf(a) | ((unsigned)f2bf(b) << 16); }
__device__ __forceinline__ void unpack8(const uint4 v, float (&f)[8]) {
  f[0] = bf2f((u16)(v.x & 0xffff)); f[1] = bf2f((u16)(v.x >> 16)); f[2] = bf2f((u16)(v.y & 0xffff)); f[3] = bf2f((u16)(v.y >> 16));
  f[4] = bf2f((u16)(v.z & 0xffff)); f[5] = bf2f((u16)(v.z >> 16)); f[6] = bf2f((u16)(v.w & 0xffff)); f[7] = bf2f((u16)(v.w >> 16));
}
__device__ __forceinline__ uint4 pack8s(const float (&f)[8], float sc) {
  return make_uint4(pack2(f[0] * sc, f[1] * sc), pack2(f[2] * sc, f[3] * sc), pack2(f[4] * sc, f[5] * sc), pack2(f[6] * sc, f[7] * sc));
}
__device__ __forceinline__ float silu_f(float x) { return x / (1.f + __expf(-x)); }
__device__ __forceinline__ float sigm(float x) { return 1.f / (1.f + __expf(-x)); }
__device__ __forceinline__ float wave_sum(float v) {
#pragma unroll
  for (int o = 32; o; o >>= 1) v += __shfl_xor(v, o);
  return v;
}
__device__ __forceinline__ const float* xin_of(const Params& P, int slab) { return slab == 0 ? P.in[0] : P.in[1] + (long)(slab - 1) * SLAB * D; }
__device__ __forceinline__ int Lof(int slab) { return slab == 0 ? 2048 : 8192; }
__device__ __forceinline__ int gb_row(int gr) { return gr < 16384 ? (gr >> 11) : (8 + ((gr - 16384) >> 13)); }
__device__ __forceinline__ int gb_of(int slab, int r) { return slab == 0 ? (r >> 11) : (8 + (slab - 1) * 2 + (r >> 13)); }

typedef short v4s __attribute__((ext_vector_type(4)));
#define LBAR() asm volatile("s_waitcnt lgkmcnt(0)\n\ts_barrier" ::: "memory")
#define LDS_AS __attribute__((address_space(3)))
template <int R, bool KC>
__device__ __forceinline__ uint4 ld_chunk(const u16* __restrict__ base, long ld, int k0, int c) {
  if (KC) {
    const int r = c >> 3, kc = c & 7;
    return *(const uint4*)(base + (long)r * ld + k0 + kc * 8);
  } else {
    const int k = c / (R / 8), mc = c % (R / 8);
    return *(const uint4*)(base + (long)(k0 + k) * ld + mc * 8);
  }
}
template <int R, bool KC>
__device__ __forceinline__ void st_chunk(u16* s, uint4 v, int c) {
  if (KC) {
    const int r = c >> 3, kc = c & 7;
    *(uint4*)(s + r * 72 + kc * 8) = v;
  } else {
    const int k = c / (R / 8), mc = c % (R / 8);
    *(uint4*)(s + k * (R + 8) + mc * 8) = v;
  }
}
template <int R, bool KC>
__device__ __forceinline__ bf16x8 ld_frag(const u16* s, int x0, int ks, int fr, int fq) {
  if (KC) {
    return *(const bf16x8*)(s + (x0 + fr) * 72 + ks * 32 + fq * 8);
  } else {
    const int q4 = fr >> 2, p4 = fr & 3;
    const u16* p = s + (ks * 32 + 8 * fq + q4) * (R + 8) + x0 + 4 * p4;
    v4s lo = __builtin_amdgcn_ds_read_tr16_b64_v4i16((LDS_AS v4s*)p);
    v4s hi = __builtin_amdgcn_ds_read_tr16_b64_v4i16((LDS_AS v4s*)(p + 4 * (R + 8)));
    bf16x8 r;
    r[0] = lo[0]; r[1] = lo[1]; r[2] = lo[2]; r[3] = lo[3]; r[4] = hi[0]; r[5] = hi[1]; r[6] = hi[2]; r[7] = hi[3];
    return r;
  }
}

template <int TM, int TN, bool AKC, bool BKC, bool TR, int KT>
__device__ __forceinline__ void gemm_acc(f32x4 (&acc)[TM / 32][TN / 64], const u16* __restrict__ A, long lda,
                                         const u16* __restrict__ B, long ldb, u16* sm) {
  u16* As = sm;
  u16* Bs = sm + 9216;
  const int tid = TID(), lane = tid & 63, wid = tid >> 6;
  const int wm = wid >> 2, wn = wid & 3, fr = lane & 15, fq = lane >> 4;
  constexpr int MI = TM / 32, NI = TN / 64;
  uint4 ra0[KT], ra1[KT], rb0[KT], rb1[KT];
#pragma unroll
  for (int kt = 0; kt < KT; ++kt) {
    ra0[kt] = ld_chunk<TM, AKC>(A, lda, kt * 64, tid);
    ra1[kt] = ra0[kt];
    if (TM == 128) ra1[kt] = ld_chunk<TM, AKC>(A, lda, kt * 64, tid + NT);
    rb0[kt] = ld_chunk<TN, BKC>(B, ldb, kt * 64, tid);
    rb1[kt] = rb0[kt];
    if (TN == 128) rb1[kt] = ld_chunk<TN, BKC>(B, ldb, kt * 64, tid + NT);
  }
#pragma unroll
  for (int kt = 0; kt < KT; ++kt) {
    __syncthreads();
    st_chunk<TM, AKC>(As, ra0[kt], tid);
    if (TM == 128) st_chunk<TM, AKC>(As, ra1[kt], tid + NT);
    st_chunk<TN, BKC>(Bs, rb0[kt], tid);
    if (TN == 128) st_chunk<TN, BKC>(Bs, rb1[kt], tid + NT);
    __syncthreads();
#pragma unroll
    for (int ks = 0; ks < 2; ++ks) {
      bf16x8 af[MI], bfr[NI];
#pragma unroll
      for (int mi = 0; mi < MI; ++mi) af[mi] = ld_frag<TM, AKC>(As, wm * (TM / 2) + mi * 16, ks, fr, fq);
#pragma unroll
      for (int ni = 0; ni < NI; ++ni) bfr[ni] = ld_frag<TN, BKC>(Bs, wn * (TN / 4) + ni * 16, ks, fr, fq);
#pragma unroll
      for (int mi = 0; mi < MI; ++mi)
#pragma unroll
        for (int ni = 0; ni < NI; ++ni)
          acc[mi][ni] = TR ? __builtin_amdgcn_mfma_f32_16x16x32_bf16(bfr[ni], af[mi], acc[mi][ni], 0, 0, 0)
                           : __builtin_amdgcn_mfma_f32_16x16x32_bf16(af[mi], bfr[ni], acc[mi][ni], 0, 0, 0);
    }
  }
  __syncthreads();
}

template <int KT> struct Tiles { uint4 a0[KT], a1[KT], b0[KT], b1[KT]; };
template <int TM, int TN, bool AKC, bool BKC, int KT>
__device__ __forceinline__ void tiles_issue(Tiles<KT>& t, const u16* __restrict__ A, long lda, const u16* __restrict__ B, long ldb) {
  const int tid = TID();
#pragma unroll
  for (int kt = 0; kt < KT; ++kt) {
    t.a0[kt] = ld_chunk<TM, AKC>(A, lda, kt * 64, tid);
    t.a1[kt] = t.a0[kt];
    if (TM == 128) t.a1[kt] = ld_chunk<TM, AKC>(A, lda, kt * 64, tid + NT);
    t.b0[kt] = ld_chunk<TN, BKC>(B, ldb, kt * 64, tid);
    t.b1[kt] = t.b0[kt];
    if (TN == 128) t.b1[kt] = ld_chunk<TN, BKC>(B, ldb, kt * 64, tid + NT);
  }
}
template <int TM, int TN, bool AKC, bool BKC, bool TR, int KT>
__device__ __forceinline__ void gemm_run(f32x4 (&acc)[TM / 32][TN / 64], const Tiles<KT>& t, u16* sm) {
  u16* As = sm;
  u16* Bs = sm + 9216;
  const int tid = TID(), lane = tid & 63, wid = tid >> 6;
  const int wm = wid >> 2, wn = wid & 3, fr = lane & 15, fq = lane >> 4;
  constexpr int MI = TM / 32, NI = TN / 64;
#pragma unroll
  for (int kt = 0; kt < KT; ++kt) {
    __syncthreads();
    st_chunk<TM, AKC>(As, t.a0[kt], tid);
    if (TM == 128) st_chunk<TM, AKC>(As, t.a1[kt], tid + NT);
    st_chunk<TN, BKC>(Bs, t.b0[kt], tid);
    if (TN == 128) st_chunk<TN, BKC>(Bs, t.b1[kt], tid + NT);
    __syncthreads();
#pragma unroll
    for (int ks = 0; ks < 2; ++ks) {
      bf16x8 af[MI], bfr[NI];
#pragma unroll
      for (int mi = 0; mi < MI; ++mi) af[mi] = ld_frag<TM, AKC>(As, wm * (TM / 2) + mi * 16, ks, fr, fq);
#pragma unroll
      for (int ni = 0; ni < NI; ++ni) bfr[ni] = ld_frag<TN, BKC>(Bs, wn * (TN / 4) + ni * 16, ks, fr, fq);
#pragma unroll
      for (int mi = 0; mi < MI; ++mi)
#pragma unroll
        for (int ni = 0; ni < NI; ++ni)
          acc[mi][ni] = TR ? __builtin_amdgcn_mfma_f32_16x16x32_bf16(bfr[ni], af[mi], acc[mi][ni], 0, 0, 0)
                           : __builtin_amdgcn_mfma_f32_16x16x32_bf16(af[mi], bfr[ni], acc[mi][ni], 0, 0, 0);
    }
  }
}

template <int TM, int TN, bool TR, class F>
__device__ __forceinline__ void epi_each(f32x4 (&acc)[TM / 32][TN / 64], F f) {
  const int tid = TID(), lane = tid & 63, wid = tid >> 6;
  const int wm = wid >> 2, wn = wid & 3, fr = lane & 15, fq = lane >> 4;
#pragma unroll
  for (int mi = 0; mi < TM / 32; ++mi)
#pragma unroll
    for (int ni = 0; ni < TN / 64; ++ni) {
      const int r0 = wm * (TM / 2) + mi * 16, c0 = wn * (TN / 4) + ni * 16;
      if (TR) f(r0 + fr, c0 + fq * 4, acc[mi][ni]);
      else f(r0 + fq * 4, c0 + fr, acc[mi][ni]);
    }
}

struct EpiStoreBf16 {
  static constexpr bool PERM = true, AFTER_DRAIN = false;
  u16* O; int ldc;
  __device__ __forceinline__ void operator()(const f32x4 (&acc)[2][2][4][2], const pg8::Unit& u, int wr, int wc, int fr, int fq) const {
    const int row0 = u.pm * 256 + wr * 64 + fr, col0 = u.pn * 256 + wc * 32 + 8 * fq;
#pragma unroll
    for (int ai = 0; ai < 2; ++ai)
#pragma unroll
      for (int m = 0; m < 4; ++m) {
        u16* rowp = O + (size_t)(row0 + ai * 128 + m * 16) * ldc + col0;
#pragma unroll
        for (int bj = 0; bj < 2; ++bj) {
          const f32x4 v0 = acc[ai][bj][m][0], v1 = acc[ai][bj][m][1];
          *(uint4*)(rowp + bj * 128) = make_uint4(pack2(v0[0], v0[1]), pack2(v0[2], v0[3]), pack2(v1[0], v1[1]), pack2(v1[2], v1[3]));
        }
      }
  }
};
struct EpiResid {
  static constexpr bool PERM = false, AFTER_DRAIN = false;
  float* X; const float* XS; const float* mod; int goff; int grow0;
  __device__ __forceinline__ void operator()(const f32x4 (&acc)[2][2][4][2], const pg8::Unit& u, int wr, int wc, int fr, int fq) const {
    const int row0 = u.pm * 256 + wr * 64 + fr, col0 = u.pn * 256 + wc * 32 + 4 * fq;
    const float* g = mod + (size_t)gb_row(grow0 + u.pm * 256) * 6144 + goff + col0;
    f32x4 gv[2][2];
#pragma unroll
    for (int bj = 0; bj < 2; ++bj)
#pragma unroll
      for (int n = 0; n < 2; ++n) gv[bj][n] = *(const f32x4*)(g + bj * 128 + n * 16);
#pragma unroll
    for (int am = 0; am < 4; ++am) {
      f32x4 xv[2][2][2];
#pragma unroll
      for (int mm = 0; mm < 2; ++mm)
#pragma unroll
        for (int bj = 0; bj < 2; ++bj)
#pragma unroll
          for (int n = 0; n < 2; ++n) xv[mm][bj][n] = *(const f32x4*)(XS + (size_t)(row0 + (am >> 1) * 128 + ((am & 1) * 2 + mm) * 16) * D + col0 + bj * 128 + n * 16);
#pragma unroll
      for (int mm = 0; mm < 2; ++mm)
#pragma unroll
        for (int bj = 0; bj < 2; ++bj)
#pragma unroll
          for (int n = 0; n < 2; ++n)
            *(f32x4*)(X + (size_t)(row0 + (am >> 1) * 128 + ((am & 1) * 2 + mm) * 16) * D + col0 + bj * 128 + n * 16) = xv[mm][bj][n] + gv[bj][n] * acc[am >> 1][bj][(am & 1) * 2 + mm][n];
    }
  }
};
struct EpiFfnVal {
  static constexpr bool PERM = false, AFTER_DRAIN = false;
  const u16* G; u16* ACT; const float* cw; const float* cb; int grow0;
  __device__ __forceinline__ void operator()(const f32x4 (&acc)[2][2][4][2], const pg8::Unit& u, int wr, int wc, int fr, int fq) const {
    const int row0 = u.pm * 256 + wr * 64 + fr, col0 = u.pn * 256 + wc * 32 + 4 * fq;
#pragma unroll
    for (int bj = 0; bj < 2; ++bj)
#pragma unroll
      for (int n = 0; n < 2; ++n) {
        const int c = col0 + bj * 128 + n * 16;
        const f32x4 w0 = *(const f32x4*)(cw + c), w1 = *(const f32x4*)(cw + DFF + c), w2 = *(const f32x4*)(cw + 2 * DFF + c), bb = *(const f32x4*)(cb + c);
#pragma unroll
        for (int ai = 0; ai < 2; ++ai) {
          uint2 g0[4], g1[4], g2[4];
#pragma unroll
          for (int m = 0; m < 4; ++m) {
            const int r = row0 + ai * 128 + m * 16;
            const int L = (grow0 + r) < 16384 ? 2048 : 8192;
            const int pos = (grow0 + r) & (L - 1);
            const u16* gp = G + (size_t)r * DFF + c;
            g1[m] = *(const uint2*)gp;
            g0[m] = *(const uint2*)(gp - (pos > 0 ? DFF : 0));
            g2[m] = *(const uint2*)(gp + (pos < L - 1 ? DFF : 0));
          }
#pragma unroll
          for (int m = 0; m < 4; ++m) {
            const int r = row0 + ai * 128 + m * 16;
            const int L = (grow0 + r) < 16384 ? 2048 : 8192;
            const int pos = (grow0 + r) & (L - 1);
            const float m0 = pos > 0 ? 1.f : 0.f, m2 = pos < L - 1 ? 1.f : 0.f;
            const uint2 a0 = g0[m], a1 = g1[m], a2 = g2[m];
            f32x4 a;
            a[0] = m0 * bf2f((u16)(a0.x & 0xffff)) * w0[0] + bf2f((u16)(a1.x & 0xffff)) * w1[0] + m2 * bf2f((u16)(a2.x & 0xffff)) * w2[0] + bb[0];
            a[1] = m0 * bf2f((u16)(a0.x >> 16)) * w0[1] + bf2f((u16)(a1.x >> 16)) * w1[1] + m2 * bf2f((u16)(a2.x >> 16)) * w2[1] + bb[1];
            a[2] = m0 * bf2f((u16)(a0.y & 0xffff)) * w0[2] + bf2f((u16)(a1.y & 0xffff)) * w1[2] + m2 * bf2f((u16)(a2.y & 0xffff)) * w2[2] + bb[2];
            a[3] = m0 * bf2f((u16)(a0.y >> 16)) * w0[3] + bf2f((u16)(a1.y >> 16)) * w1[3] + m2 * bf2f((u16)(a2.y >> 16)) * w2[3] + bb[3];
            const f32x4 v = acc[ai][bj][m][n];
            *(uint2*)(ACT + (size_t)r * DFF + c) = make_uint2(pack2(silu_f(a[0]) * v[0], silu_f(a[1]) * v[1]), pack2(silu_f(a[2]) * v[2], silu_f(a[3]) * v[3]));
          }
        }
      }
  }
};
template <class Epi>
__device__ __forceinline__ void run_gemm(const u16* A, const u16* Bt, int M, int N, int K, const Epi& E) {
  pg8::Gemm g; g.A = A; g.Bt = Bt; g.M = M; g.N = N; g.K = K;
  pg8::StaticOrder S; S.init(M, N, gridDim.x, BID());
  __syncthreads();
  pg8::gemm_phase<Epi, pg8::StaticOrder, false>((PG8_LAS unsigned char*)smem, g, S, E, nullptr);
  __syncthreads();
}

__device__ __forceinline__ int fidx(int p) { return p + ((p >> 6) << 2); }
__device__ __forceinline__ float2 cmulf(float2 a, float2 b) { return make_float2(a.x * b.x - a.y * b.y, a.x * b.y + a.y * b.x); }
__device__ __forceinline__ float2 cmulcf(float2 a, float2 b) { return make_float2(a.x * b.x + a.y * b.y, a.y * b.x - a.x * b.y); }
#define R16C(q) ((q) == 0 ? 1.f : (q) == 1 ? 0.9238795325f : (q) == 2 ? 0.7071067812f : (q) == 3 ? 0.3826834324f : (q) == 4 ? 0.f : (q) == 5 ? -0.3826834324f : (q) == 6 ? -0.7071067812f : -0.9238795325f)
#define R16S(q) ((q) == 0 ? 0.f : (q) == 1 ? -0.3826834324f : (q) == 2 ? -0.7071067812f : (q) == 3 ? -0.9238795325f : (q) == 4 ? -1.f : (q) == 5 ? -0.9238795325f : (q) == 6 ? -0.7071067812f : -0.3826834324f)
template <int N, int RS, bool INV>
__device__ __forceinline__ void fft_pass(float2* x, const float2* __restrict__ tw, const int S, const int tid) {
  constexpr int R = 1 << RS;
  const int E = S >> (RS - 1);
#pragma unroll 1
  for (int g = tid; g < N / R; g += NT) {
    const int blo = g & (E - 1);
    const int base = ((g - blo) << RS) + blo;
    float2 e[R];
#pragma unroll
    for (int k = 0; k < R; ++k) e[k] = x[fidx(base + k * E)];
    float2 wb[RS];
#pragma unroll
    for (int st = 0; st < RS; ++st) wb[st] = tw[blo * (8192 / (S >> st))];
#pragma unroll
    for (int sq = 0; sq < RS; ++sq) {
      const int st = INV ? (RS - 1 - sq) : sq;
      const int h = (R / 2) >> st;
#pragma unroll
      for (int k = 0; k < R; ++k) {
        if ((k & h) == 0) {
          const int m = k & (h - 1);
          const int q = m * (8 / h);
          float2 w = wb[st];
          if (q != 0) w = cmulf(w, make_float2(R16C(q), R16S(q)));
          if (!INV) {
            const float2 a = e[k], b = e[k + h];
            e[k] = make_float2(a.x + b.x, a.y + b.y);
            e[k + h] = cmulf(make_float2(a.x - b.x, a.y - b.y), w);
          } else {
            const float2 a = e[k], b = cmulcf(e[k + h], w);
            e[k] = make_float2(a.x + b.x, a.y + b.y);
            e[k + h] = make_float2(a.x - b.x, a.y - b.y);
          }
        }
      }
    }
#pragma unroll
    for (int k = 0; k < R; ++k) x[fidx(base + k * E)] = e[k];
  }
  __syncthreads();
}
template <int N>
__device__ __forceinline__ void fft_dif_t(float2* x, const float2* __restrict__ tw) {
  const int tid = TID();
  if (N == 16384) {
    fft_pass<N, 4, false>(x, tw, 8192, tid); fft_pass<N, 4, false>(x, tw, 512, tid);
    fft_pass<N, 4, false>(x, tw, 32, tid); fft_pass<N, 2, false>(x, tw, 2, tid);
  } else {
    fft_pass<N, 4, false>(x, tw, 2048, tid); fft_pass<N, 4, false>(x, tw, 128, tid); fft_pass<N, 4, false>(x, tw, 8, tid);
  }
}
template <int N>
__device__ __forceinline__ void ifft_dit_t(float2* x, const float2* __restrict__ tw) {
  const int tid = TID();
  if (N == 16384) {
    fft_pass<N, 2, true>(x, tw, 2, tid); fft_pass<N, 4, true>(x, tw, 32, tid);
    fft_pass<N, 4, true>(x, tw, 512, tid); fft_pass<N, 4, true>(x, tw, 8192, tid);
  } else {
    fft_pass<N, 4, true>(x, tw, 8, tid); fft_pass<N, 4, true>(x, tw, 128, tid); fft_pass<N, 4, true>(x, tw, 2048, tid);
  }
}
__device__ __forceinline__ void fft_dif(float2* x, int N, const float2* __restrict__ tw) {
  if (N == 16384) fft_dif_t<16384>(x, tw); else fft_dif_t<4096>(x, tw);
}
__device__ __forceinline__ void ifft_dit(float2* x, int N, const float2* __restrict__ tw) {
  if (N == 16384) ifft_dit_t<16384>(x, tw); else ifft_dit_t<4096>(x, tw);
}

__device__ void transpose_w(const float* __restrict__ W, u16* __restrict__ Wt, int K, int N) {
  float* smf = (float*)smem;
  const int tk = K / 64, tn = N / 64, tid = TID(), G = gridDim.x;
  const int kk0 = tid >> 4, n40 = tid & 15, kk1 = (tid + NT) >> 4, n41 = (tid + NT) & 15;
  int item = BID();
  float4 v0 = make_float4(0, 0, 0, 0), v1 = v0;
  if (item < tk * tn) {
    const int k0 = (item / tn) * 64, n0 = (item % tn) * 64;
    v0 = *(const float4*)(W + (long)(k0 + kk0) * N + n0 + n40 * 4);
    v1 = *(const float4*)(W + (long)(k0 + kk1) * N + n0 + n41 * 4);
  }
  for (; item < tk * tn; item += G) {
    const int k0 = (item / tn) * 64, n0 = (item % tn) * 64;
    float4 w0 = v0, w1 = v1;
    const int nx = item + G;
    if (nx < tk * tn) {
      const int k2 = (nx / tn) * 64, n2 = (nx % tn) * 64;
      w0 = *(const float4*)(W + (long)(k2 + kk0) * N + n2 + n40 * 4);
      w1 = *(const float4*)(W + (long)(k2 + kk1) * N + n2 + n41 * 4);
    }
    __syncthreads();
    { float* p = smf + kk0 * 65 + n40 * 4; p[0] = v0.x; p[1] = v0.y; p[2] = v0.z; p[3] = v0.w; }
    { float* p = smf + kk1 * 65 + n41 * 4; p[0] = v1.x; p[1] = v1.y; p[2] = v1.z; p[3] = v1.w; }
    __syncthreads();
    const int nn = tid >> 3, k8 = tid & 7;
    float f[8];
#pragma unroll
    for (int i = 0; i < 8; ++i) f[i] = smf[(k8 * 8 + i) * 65 + nn];
    *(uint4*)(Wt + (long)(n0 + nn) * K + k0 + k8 * 8) = pack8s(f, 1.f);
    v0 = w0; v1 = w1;
  }
  __syncthreads();
}

__device__ void phase_pre0(const Params& P) {
  const int tid = TID();
  const long gtid = (long)BID() * NT + tid, gsz = (long)gridDim.x * NT;
  transpose_w(P.in[7], (u16*)(WS(P) + O_WHYIN), 1024, 3072);
  transpose_w(P.in[18], (u16*)(WS(P) + O_WHYOUT), 1024, 1024);
  transpose_w(P.in[19], (u16*)(WS(P) + O_WRETIN), 1024, 6144);
  transpose_w(P.in[21], (u16*)(WS(P) + O_WRETOUT), 2048, 1024);
  transpose_w(P.in[22], (u16*)(WS(P) + O_WSWAIN), 1024, 1536);
  transpose_w(P.in[26], (u16*)(WS(P) + O_WSWAOUT), 1024, 1024);
  transpose_w(P.in[27], (u16*)(WS(P) + O_WHGIN), 1024, 5120);
  transpose_w(P.in[30], (u16*)(WS(P) + O_WHGOUT), 1024, 1024);
  for (int l = 0; l < 4; ++l) {
    transpose_w(P.in[31] + (long)l * 1024 * DFF, (u16*)(WS(P) + O_WFG) + (long)l * DFF * 1024, 1024, DFF);
    transpose_w(P.in[32] + (long)l * 1024 * DFF, (u16*)(WS(P) + O_WFV) + (long)l * DFF * 1024, 1024, DFF);
    transpose_w(P.in[35] + (long)l * DFF * 1024, (u16*)(WS(P) + O_WFD) + (long)l * 1024 * DFF, DFF, 1024);
  }
  {
    float* cs = (float*)smem;
    float* modp = (float*)(WS(P) + O_MODP);
    for (int item = BID(); item < 4 * 8 * 12; item += gridDim.x) {
      const int nb = item % 12, ks = (item / 12) % 8, l = item / 96;
      __syncthreads();
      for (int i = tid; i < 2048; i += NT) {
        int b = i >> 7, k = i & 127;
        float c = (b < 8) ? P.in[2][b * 1024 + ks * 128 + k] : P.in[3][(b - 8) * 1024 + ks * 128 + k];
        cs[i] = c / (1.f + expf(-c));
      }
      __syncthreads();
      const int n = nb * 512 + tid;
      float a[16];
#pragma unroll
      for (int b = 0; b < 16; ++b) a[b] = 0.f;
      const float* w = P.in[4] + ((long)l * 1024 + ks * 128) * 6144 + n;
      for (int k = 0; k < 128; ++k) {
        float wv = w[(long)k * 6144];
#pragma unroll
        for (int b = 0; b < 16; ++b) a[b] += cs[b * 128 + k] * wv;
      }
#pragma unroll
      for (int b = 0; b < 16; ++b) modp[(((long)ks * 4 + l) * 16 + b) * 6144 + n] = a[b];
    }
    __syncthreads();
  }
  {
    float2* tw = (float2*)(WS(P) + O_TW);
    for (long i = gtid; i < 8192; i += gsz) {
      float s, c;
      sincospif((float)i * (1.f / 8192.f), &s, &c);
      tw[i] = make_float2(c, -s);
    }
    float2* rr = (float2*)(WS(P) + O_ROPER);
    for (long i = gtid; i < (long)8192 * 128; i += gsz) {
      int pos = (int)(i >> 7), d = (int)(i & 127);
      float inv = exp2f(-(float)d * (13.287712379549449f / 128.f));
      float s, c;
      sincosf((float)pos * inv, &s, &c);
      rr[i] = make_float2(c, s);
    }
    float2* rs = (float2*)(WS(P) + O_ROPES);
    for (long i = gtid; i < (long)8192 * 32; i += gsz) {
      int pos = (int)(i >> 5), d = (int)(i & 31);
      float inv = exp2f(-(float)d * (13.287712379549449f / 32.f));
      float s, c;
      sincosf((float)pos * inv, &s, &c);
      rs[i] = make_float2(c, s);
    }
  }
  {
    float* zf = (float*)smem;
    float* h1 = zf + 8 * 36;
    const float* w1 = P.in[10]; const float* b1 = P.in[11]; const float* w2 = P.in[12]; const float* b2 = P.in[13];
    const float* fr = P.in[15];
    const int tl = tid >> 6, j = tid & 63;
    for (int item = BID(); item < 1280; item += gridDim.x) {
      const int sel = item >= 1024;
      const int L = sel ? 2048 : 8192;
      const int t = (sel ? item - 1024 : item) * 8 + tl;
      float* hid = (float*)(WS(P) + (sel ? O_HIDP : O_HIDS));
      __syncthreads();
      if (j < 33) {
        float v;
        if (j == 0) v = (float)t / (float)(L - 1);
        else {
          int i = (j - 1) & 15;
          float band = 1e-4f + (float)i * ((15.f - 1e-4f) / 15.f);
          float ang = (6.283185307179586f / (float)L) * (float)t;
          float a = band * ang;
          v = (j <= 16) ? cosf(a) : -sinf(a);
        }
        zf[tl * 36 + j] = v;
      }
      __syncthreads();
      float s = b1[j];
#pragma unroll 3
      for (int i = 0; i < 33; ++i) s += zf[tl * 36 + i] * w1[i * 64 + j];
      h1[tl * 64 + j] = sinf(fr[j] * s);
      __syncthreads();
      float s2 = b2[j];
#pragma unroll 4
      for (int i = 0; i < 64; ++i) s2 += h1[tl * 64 + i] * w2[i * 64 + j];
      hid[(long)j * L + t] = sinf(fr[j] * s2);
    }
    __syncthreads();
  }
}

__device__ void phase_pre1(const Params& P) {
  __shared__ float w3s[128];
  __shared__ float red[8];
  const int tid = TID(), lane = tid & 63, wid = tid >> 6;
  const long gtid = (long)BID() * NT + tid, gsz = (long)gridDim.x * NT;
  {
    const float* modp = (const float*)(WS(P) + O_MODP);
    float* mod = (float*)(WS(P) + O_MOD);
    for (long i = gtid; i < (long)4 * 16 * 6144; i += gsz) {
      int n = (int)(i % 6144);
      int l = (int)(i / (16 * 6144));
      float s = P.in[5][l * 6144 + n];
      for (int ks = 0; ks < 8; ++ks) s += modp[(long)ks * 4 * 16 * 6144 + i];
      mod[i] = s;
    }
  }
  float2* buf = (float2*)smem;
  const float2* tw = (const float2*)(WS(P) + O_TW);
  for (int item = BID(); item < 2048; item += gridDim.x) {
    const int sel = item >> 10, c = item & 1023;
    const int L = sel ? 2048 : 8192, N = 2 * L;
    const float* hid = (const float*)(WS(P) + (sel ? O_HIDP : O_HIDS));
    float2* hs = (float2*)(WS(P) + (sel ? O_HSPP : O_HSPS)) + (long)c * N;
    __syncthreads();
    if (tid < 128) {
      int dirn = tid >> 6, j = tid & 63;
      w3s[tid] = P.in[14][(long)j * 2048 + dirn * 1024 + c];
    }
    __syncthreads();
    const float dec0 = fabsf(P.in[16][c]), dec1 = fabsf(P.in[16][1024 + c]);
    const float invLm1 = 1.f / (float)(L - 1);
    float asum = 0.f;
    for (int n = tid; n < N; n += NT) {
      float val = 0.f;
      if (n != L) {
        const int dirn = n < L ? 0 : 1;
        const int t = n < L ? n : N - n;
        const float* hp = hid + t;
        const float* w = w3s + dirn * 64;
        float s = 0.f;
#pragma unroll 16
        for (int j = 0; j < 64; ++j) s += hp[(long)j * L] * w[j];
        float tl = (float)t * invLm1;
        val = s * expf(-tl * (dirn ? dec1 : dec0));
      }
      buf[fidx(n)] = make_float2(val, 0.f);
      asum += fabsf(val);
    }
    asum = wave_sum(asum);
    if (lane == 0) red[wid] = asum;
    __syncthreads();
    float tot = 0.f;
#pragma unroll
    for (int w = 0; w < 8; ++w) tot += red[w];
    const float scale = 1.f / (tot * (float)N);
    fft_dif(buf, N, tw);
    for (int p = tid; p < N; p += NT) {
      float2 a = buf[fidx(p)];
      hs[p] = make_float2(a.x * scale, a.y * scale);
    }
  }
  __syncthreads();
}

__device__ void phase_norm(const Params& P, int layer, int sl, int which) {
  const int grow0 = which ? sl * FSLAB : sl * SLAB, nrows = which ? FSLAB : SLAB;
  const float* __restrict__ x = (layer == 0 && which == 0) ? xin_of(P, sl) : (const float*)(OUTP(P) + (long)grow0 * D);
  u16* __restrict__ h = (u16*)(WS(P) + (which ? O_FHBUF : O_HBUF));
  const float* gain = P.in[6] + (layer * 2 + which) * D;
  const float* mod = (const float*)(WS(P) + O_MOD) + (long)layer * 16 * 6144;
  const int shoff = which ? 3 * D : 0, scoff = which ? 4 * D : D;
  const int tid = TID(), lane = tid & 63, wid = tid >> 6;
  for (int item = BID(); item < nrows / 32; item += gridDim.x) {
    const int r0 = item * 32 + wid * 4;
    float4 v[4][4];
    float ss[4];
#pragma unroll
    for (int u = 0; u < 4; ++u) {
      const float* xr = x + (long)(r0 + u) * D;
      float a = 0.f;
#pragma unroll
      for (int i = 0; i < 4; ++i) {
        v[u][i] = *(const float4*)(xr + i * 256 + lane * 4);
        a += v[u][i].x * v[u][i].x + v[u][i].y * v[u][i].y + v[u][i].z * v[u][i].z + v[u][i].w * v[u][i].w;
      }
      ss[u] = a;
    }
    const float* m = mod + (long)gb_row(grow0 + r0) * 6144;
#pragma unroll
    for (int u = 0; u < 4; ++u) ss[u] = wave_sum(ss[u]);
#pragma unroll
    for (int i = 0; i < 4; ++i) {
      const int col = i * 256 + lane * 4;
      const float4 g = *(const float4*)(gain + col);
      const float4 sc = *(const float4*)(m + scoff + col);
      const float4 sh = *(const float4*)(m + shoff + col);
      const float a0 = g.x * (1.f + sc.x), a1 = g.y * (1.f + sc.y), a2 = g.z * (1.f + sc.z), a3 = g.w * (1.f + sc.w);
#pragma unroll
      for (int u = 0; u < 4; ++u) {
        const float rstd = rsqrtf(ss[u] * (1.f / 1024.f) + 1e-6f);
        const float y0 = v[u][i].x * rstd * a0 + sh.x, y1 = v[u][i].y * rstd * a1 + sh.y;
        const float y2 = v[u][i].z * rstd * a2 + sh.z, y3 = v[u][i].w * rstd * a3 + sh.w;
        *(uint2*)(h + (long)(r0 + u) * D + col) = make_uint2(pack2(y0, y1), pack2(y2, y3));
      }
    }
  }
}

__device__ void phase_proj(const Params& P, size_t woff, int N) {
  EpiStoreBf16 E; E.O = (u16*)(WS(P) + O_PROJ); E.ldc = N;
  run_gemm((const u16*)(WS(P) + O_HBUF), (const u16*)(WS(P) + woff), SLAB, N, D, E);
}
__device__ void phase_resid(const Params& P, int layer, int slab, const u16* A, int K, size_t woff, int goff) {
  EpiResid E; E.X = OUTP(P) + (long)slab * SLAB * D; E.XS = (layer == 0) ? xin_of(P, slab) : (const float*)E.X; E.mod = (const float*)(WS(P) + O_MOD) + (long)layer * 16 * 6144; E.goff = goff; E.grow0 = slab * SLAB;
  run_gemm(A, (const u16*)(WS(P) + woff), SLAB, D, K, E);
}

__device__ void phase_ffn_gate(const Params& P, int layer) {
  EpiStoreBf16 E; E.O = (u16*)(WS(P) + O_FGBUF); E.ldc = DFF;
  run_gemm((const u16*)(WS(P) + O_FHBUF), (const u16*)(WS(P) + O_WFG) + (long)layer * DFF * D, FSLAB, DFF, D, E);
}
__device__ void phase_ffn_val(const Params& P, int layer, int fs) {
  EpiFfnVal E; E.G = (const u16*)(WS(P) + O_FGBUF); E.ACT = (u16*)(WS(P) + O_FACT) + (long)fs * FSLAB * DFF;
  E.cw = P.in[33] + (long)layer * 3 * DFF; E.cb = P.in[34] + (long)layer * DFF; E.grow0 = fs * FSLAB;
  run_gemm((const u16*)(WS(P) + O_FHBUF), (const u16*)(WS(P) + O_WFV) + (long)layer * DFF * D, FSLAB, DFF, D, E);
}
__device__ void phase_ffn_down(const Params& P, int layer) {
  EpiResid E; E.X = OUTP(P); E.XS = E.X; E.mod = (const float*)(WS(P) + O_MOD) + (long)layer * 16 * 6144; E.goff = 5 * D; E.grow0 = 0;
  run_gemm((const u16*)(WS(P) + O_FACT), (const u16*)(WS(P) + O_WFD) + (long)layer * D * DFF, NTOK, D, DFF, E);
}

__device__ void phase_hy_conv(const Params& P, int slab) {
  const int L = Lof(slab), nseq = SLAB / L, tid = TID();
  const u16* __restrict__ z = (const u16*)(WS(P) + O_PROJ);
  float* __restrict__ uT = (float*)(WS(P) + O_UT);
  u16* __restrict__ x0c = (u16*)(WS(P) + O_X0C);
  const float* cw = P.in[8];
  const float* cb = P.in[9];
  float* tile = (float*)smem;
  const int ntt = L / 64;
  const int nitems = nseq * ntt * 16;
  const int tl = tid >> 3, cg = tid & 7;
  for (int item = BID(); item < nitems; item += gridDim.x) {
    const int ct = item % 16, tt = (item / 16) % ntt, seq = item / (16 * ntt);
    const int t = tt * 64 + tl, c0 = ct * 64 + cg * 8;
    const long row = (long)seq * L + t;
    const float mp = t > 0 ? 1.f : 0.f, mn = t < L - 1 ? 1.f : 0.f;
    const long rp = t > 0 ? row - 1 : row, rn = t < L - 1 ? row + 1 : row;
    float val[3][8];
#pragma unroll
    for (int q = 0; q < 3; ++q) {
      const int col = q * 1024 + c0;
      float a[8], b[8], c[8];
      unpack8(*(const uint4*)(z + rp * 3072 + col), a);
      unpack8(*(const uint4*)(z + row * 3072 + col), b);
      unpack8(*(const uint4*)(z + rn * 3072 + col), c);
      const float4 w0a = *(const float4*)(cw + col), w0b = *(const float4*)(cw + col + 4);
      const float4 w1a = *(const float4*)(cw + 3072 + col), w1b = *(const float4*)(cw + 3072 + col + 4);
      const float4 w2a = *(const float4*)(cw + 6144 + col), w2b = *(const float4*)(cw + 6144 + col + 4);
      const float4 ba = *(const float4*)(cb + col), bb = *(const float4*)(cb + col + 4);
      const float w0[8] = {w0a.x, w0a.y, w0a.z, w0a.w, w0b.x, w0b.y, w0b.z, w0b.w};
      const float w1[8] = {w1a.x, w1a.y, w1a.z, w1a.w, w1b.x, w1b.y, w1b.z, w1b.w};
      const float w2[8] = {w2a.x, w2a.y, w2a.z, w2a.w, w2b.x, w2b.y, w2b.z, w2b.w};
      const float bs[8] = {ba.x, ba.y, ba.z, ba.w, bb.x, bb.y, bb.z, bb.w};
#pragma unroll
      for (int i = 0; i < 8; ++i) val[q][i] = mp * a[i] * w0[i] + b[i] * w1[i] + mn * c[i] * w2[i] + bs[i];
    }
    *(uint4*)(x0c + row * 1024 + c0) = pack8s(val[0], 1.f);
    __syncthreads();
#pragma unroll
    for (int i = 0; i < 8; ++i) tile[tl * 65 + cg * 8 + i] = val[1][i] * val[2][i];
    __syncthreads();
    {
      const int cl = tid >> 3, tq = tid & 7;
      float* dst = uT + ((long)seq * 1024 + ct * 64 + cl) * L + tt * 64 + tq * 8;
      float4 o0, o1;
      o0.x = tile[(tq * 8 + 0) * 65 + cl]; o0.y = tile[(tq * 8 + 1) * 65 + cl]; o0.z = tile[(tq * 8 + 2) * 65 + cl]; o0.w = tile[(tq * 8 + 3) * 65 + cl];
      o1.x = tile[(tq * 8 + 4) * 65 + cl]; o1.y = tile[(tq * 8 + 5) * 65 + cl]; o1.z = tile[(tq * 8 + 6) * 65 + cl]; o1.w = tile[(tq * 8 + 7) * 65 + cl];
      *(float4*)dst = o0; *(float4*)(dst + 4) = o1;
    }
  }
  __syncthreads();
}

__device__ void phase_hy_fft(const Params& P, int slab, bool dry = false) {
  const int L = Lof(slab), N = 2 * L, nseq = SLAB / L, tid = TID();
  float* uT = (float*)(WS(P) + O_UT);
  const float2* hsb = (const float2*)(WS(P) + (slab == 0 ? O_HSPP : O_HSPS));
  const float2* tw = (const float2*)(WS(P) + O_TW);
  const float* skip = P.in[17];
  float2* buf = (float2*)smem;
  const int nitems = (nseq / 2) * 1024;
  for (int item = BID(); item < nitems; item += gridDim.x) {
    const int pr = item >> 10, c = item & 1023;
    float* u0 = uT + ((long)(pr * 2) * 1024 + c) * L;
    float* u1 = u0 + (long)1024 * L;
    __syncthreads();
    for (int t = tid; t < L; t += NT) {
      buf[fidx(t)] = make_float2(u0[t], u1[t]);
      buf[fidx(t + L)] = make_float2(0.f, 0.f);
    }
    __syncthreads();
    fft_dif(buf, N, tw);
    const float2* h = hsb + (long)c * N;
    for (int p = tid; p < N; p += NT) {
      float2 a = buf[fidx(p)], b = h[p];
      buf[fidx(p)] = make_float2(a.x * b.x - a.y * b.y, a.x * b.y + a.y * b.x);
    }
    __syncthreads();
    ifft_dit(buf, N, tw);
    const float sk = skip[c];
    for (int t = tid; t < L; t += NT) {
      float2 y = buf[fidx(t)];
      const long doff = dry ? (long)(END_HY - O_UT) / 4 : 0;
      u0[t + doff] = y.x + u0[t] * sk;
      u1[t + doff] = y.y + u1[t] * sk;
    }
  }
  __syncthreads();
}

__device__ void phase_hy_tr(const Params& P, int slab) {
  const int L = Lof(slab), nseq = SLAB / L, tid = TID();
  const float* __restrict__ yT = (const float*)(WS(P) + O_UT);
  const u16* __restrict__ x0c = (const u16*)(WS(P) + O_X0C);
  u16* __restrict__ a2 = (u16*)(WS(P) + O_A2);
  float* tile = (float*)smem;
  const int ntt = L / 64;
  const int nitems = nseq * ntt * 16;
  for (int item = BID(); item < nitems; item += gridDim.x) {
    const int ct = item % 16, tt = (item / 16) % ntt, seq = item / (16 * ntt);
    const int cl = tid >> 3, tq = tid & 7;
    const float* src = yT + ((long)seq * 1024 + ct * 64 + cl) * L + tt * 64 + tq * 8;
    const float4 i0 = *(const float4*)src, i1 = *(const float4*)(src + 4);
    const int tl = tid >> 3, cg = tid & 7;
    const long row = (long)seq * L + tt * 64 + tl;
    const int c0 = ct * 64 + cg * 8;
    float xg[8];
    unpack8(*(const uint4*)(x0c + row * 1024 + c0), xg);
    __syncthreads();
    float* p = tile + cl * 65 + tq * 8;
    p[0] = i0.x; p[1] = i0.y; p[2] = i0.z; p[3] = i0.w; p[4] = i1.x; p[5] = i1.y; p[6] = i1.z; p[7] = i1.w;
    __syncthreads();
    float o[8];
#pragma unroll
    for (int i = 0; i < 8; ++i) o[i] = tile[(cg * 8 + i) * 65 + tl] * xg[i];
    *(uint4*)(a2 + row * 1024 + c0) = pack8s(o, 1.f);
  }
  __syncthreads();
}

struct Rec {
  int H, DK, DV, C;
  int ldv, voff, goff;
};
__device__ __forceinline__ Rec rec_of(int kind) {
  Rec r;
  if (kind == 1) { r.H = 4; r.DK = 256; r.DV = 512; r.C = 256; r.ldv = 6144; r.voff = 2048; r.goff = 4096; }
  else { r.H = 8; r.DK = 128; r.DV = 128; r.C = 128; r.ldv = 5120; r.voff = 1024; r.goff = 4096; }
  return r;
}

__device__ void phase_ret_prep(const Params& P, int slab) {
  const int L = Lof(slab);
  const u16* __restrict__ pj = (const u16*)(WS(P) + O_PROJ);
  u16* __restrict__ qdf = (u16*)(WS(P) + O_QDF); u16* __restrict__ qdb = (u16*)(WS(P) + O_QDB);
  u16* __restrict__ kif = (u16*)(WS(P) + O_KIF); u16* __restrict__ kib = (u16*)(WS(P) + O_KIB);
  u16* __restrict__ kef = (u16*)(WS(P) + O_KEF); u16* __restrict__ keb = (u16*)(WS(P) + O_KEB);
  float* dlf = (float*)(WS(P) + O_DLF); float* dlb = (float*)(WS(P) + O_DLB);
  const float2* __restrict__ rope = (const float2*)(WS(P) + O_ROPER);
  const long gtid = (long)BID() * NT + TID(), gsz = (long)gridDim.x * NT;
  for (long idx = gtid; idx < (long)SLAB * 64; idx += gsz) {
    const int d0 = (int)(idx & 15) * 8, h = (int)((idx >> 4) & 3), t = (int)(idx >> 6);
    const int pos = t & (L - 1), r = t & 255;
    const float lgf = -expf(P.in[20][h]), lgb = -expf(P.in[20][4 + h]);
    const u16* row = pj + (long)t * 6144 + h * 256 + d0;
    const uint4 vq1 = *(const uint4*)row, vq2 = *(const uint4*)(row + 128);
    const uint4 vk1 = *(const uint4*)(row + 1024), vk2 = *(const uint4*)(row + 1024 + 128);
    const float4* rp = (const float4*)(rope + (long)pos * 128 + d0);
    const float4 c01 = rp[0], c23 = rp[1], c45 = rp[2], c67 = rp[3];
    float q1[8], q2[8], k1[8], k2[8];
    unpack8(vq1, q1); unpack8(vq2, q2); unpack8(vk1, k1); unpack8(vk2, k2);
    const float cs[8] = {c01.x, c01.z, c23.x, c23.z, c45.x, c45.z, c67.x, c67.z};
    const float sn[8] = {c01.y, c01.w, c23.y, c23.w, c45.y, c45.w, c67.y, c67.w};
    float qa[8], qb[8], ka[8], kb[8];
#pragma unroll
    for (int i = 0; i < 8; ++i) {
      qa[i] = q1[i] * cs[i] - q2[i] * sn[i]; qb[i] = q1[i] * sn[i] + q2[i] * cs[i];
      ka[i] = (k1[i] * cs[i] - k2[i] * sn[i]) * 0.0625f; kb[i] = (k1[i] * sn[i] + k2[i] * cs[i]) * 0.0625f;
    }
    const float bf = (float)(r + 1) * lgf, bb = (float)(256 - r) * lgb;
    const float ef = expf(bf), eif = expf(-bf), eef = expf((float)(255 - r) * lgf);
    const float eb = expf(bb), eib = expf(-bb), eeb = expf((float)r * lgb);
    const long o1 = (long)t * 1024 + h * 256 + d0, o2 = o1 + 128;
    *(uint4*)(qdf + o1) = pack8s(qa, ef); *(uint4*)(qdf + o2) = pack8s(qb, ef);
    *(uint4*)(qdb + o1) = pack8s(qa, eb); *(uint4*)(qdb + o2) = pack8s(qb, eb);
    *(uint4*)(kif + o1) = pack8s(ka, eif); *(uint4*)(kif + o2) = pack8s(kb, eif);
    *(uint4*)(kib + o1) = pack8s(ka, eib); *(uint4*)(kib + o2) = pack8s(kb, eib);
    *(uint4*)(kef + o1) = pack8s(ka, eef); *(uint4*)(kef + o2) = pack8s(kb, eef);
    *(uint4*)(keb + o1) = pack8s(ka, eeb); *(uint4*)(keb + o2) = pack8s(kb, eeb);
    if (r == 0) {
      const long cgi = (long)(t >> 8) * 1024 + h * 256 + d0;
      const float df = expf(256.f * lgf), db = expf(256.f * lgb);
#pragma unroll
      for (int i = 0; i < 8; ++i) { dlf[cgi + i] = df; dlf[cgi + 128 + i] = df; dlb[cgi + i] = db; dlb[cgi + 128 + i] = db; }
    }
  }
}

__device__ __forceinline__ float lb_of(const float* lbt, int dr, int ch) {
  const float a0 = lbt[(dr * 4 + 0) * 1024 + ch], a1 = lbt[(dr * 4 + 1) * 1024 + ch], a2 = lbt[(dr * 4 + 2) * 1024 + ch], a3 = lbt[(dr * 4 + 3) * 1024 + ch];
  const float m = fmaxf(fmaxf(a0, a1), fmaxf(a2, a3));
  const float e0 = expf(a0 - m), e1 = expf(a1 - m), e2 = expf(a2 - m), e3 = expf(a3 - m);
  return (e0 + e1 + e2) / (e0 + e1 + e2 + e3);
}
__device__ void phase_hg_prep(const Params& P) {
  const u16* __restrict__ pj = (const u16*)(WS(P) + O_PROJ);
  u16* __restrict__ qdf = (u16*)(WS(P) + O_QDF); u16* __restrict__ qdb = (u16*)(WS(P) + O_QDB);
  u16* __restrict__ kif = (u16*)(WS(P) + O_KIF); u16* __restrict__ kib = (u16*)(WS(P) + O_KIB);
  u16* __restrict__ kef = (u16*)(WS(P) + O_KEF); u16* __restrict__ keb = (u16*)(WS(P) + O_KEB);
  float* dlf = (float*)(WS(P) + O_DLF); float* dlb = (float*)(WS(P) + O_DLB);
  const float* lbt = P.in[28];
  float* totF = (float*)smem;
  float* totB = totF + 1024;
  const int tid = TID(), lane = tid & 63, rg = tid >> 6;
  constexpr int RPT = 16;
  for (int item = BID(); item < 1024; item += gridDim.x) {
    const int cgi = item >> 3, ch = (item & 7) * 128 + lane * 2;
    const long t0 = (long)cgi * 128 + rg * RPT;
    unsigned wq[RPT], wf[RPT], wb[RPT];
#pragma unroll
    for (int i = 0; i < RPT; ++i) {
      const u16* row = pj + (t0 + i) * 5120 + ch;
      wq[i] = *(const unsigned*)row; wf[i] = *(const unsigned*)(row + 2048); wb[i] = *(const unsigned*)(row + 3072);
    }
    float lb0[2], lb1[2];
    lb0[0] = lb_of(lbt, 0, ch); lb0[1] = lb_of(lbt, 0, ch + 1);
    lb1[0] = lb_of(lbt, 1, ch); lb1[1] = lb_of(lbt, 1, ch + 1);
    float pf[2][RPT], sb[2][RPT], accf[2], accb[2];
#pragma unroll
    for (int c = 0; c < 2; ++c) {
      float a = 0.f;
#pragma unroll
      for (int i = 0; i < RPT; ++i) {
        const float x = bf2f((u16)(c ? (wf[i] >> 16) : (wf[i] & 0xffff)));
        a += logf(lb0[c] + (1.f - lb0[c]) * sigm(x)); pf[c][i] = a;
      }
      accf[c] = a;
      a = 0.f;
#pragma unroll
      for (int i = RPT - 1; i >= 0; --i) {
        const float x = bf2f((u16)(c ? (wb[i] >> 16) : (wb[i] & 0xffff)));
        a += logf(lb1[c] + (1.f - lb1[c]) * sigm(x)); sb[c][i] = a;
      }
      accb[c] = a;
    }
    __syncthreads();
    *(float2*)(totF + rg * 128 + lane * 2) = make_float2(accf[0], accf[1]);
    *(float2*)(totB + rg * 128 + lane * 2) = make_float2(accb[0], accb[1]);
    __syncthreads();
    float offF[2] = {0.f, 0.f}, offB[2] = {0.f, 0.f}, totf[2] = {0.f, 0.f}, totb[2] = {0.f, 0.f};
#pragma unroll
    for (int g = 0; g < 8; ++g) {
      const float2 f = *(const float2*)(totF + g * 128 + lane * 2), bq = *(const float2*)(totB + g * 128 + lane * 2);
      totf[0] += f.x; totf[1] += f.y; totb[0] += bq.x; totb[1] += bq.y;
      if (g < rg) { offF[0] += f.x; offF[1] += f.y; }
      if (g > rg) { offB[0] += bq.x; offB[1] += bq.y; }
    }
#pragma unroll
    for (int i = 0; i < RPT; ++i) {
      float o[6][2];
#pragma unroll
      for (int c = 0; c < 2; ++c) {
        const float xq = bf2f((u16)(c ? (wq[i] >> 16) : (wq[i] & 0xffff)));
        const float xf = bf2f((u16)(c ? (wf[i] >> 16) : (wf[i] & 0xffff)));
        const float xb = bf2f((u16)(c ? (wb[i] >> 16) : (wb[i] & 0xffff)));
        const float q = silu_f(xq);
        const float bf = offF[c] + pf[c][i], bb = offB[c] + sb[c][i];
        const float kf = (1.f - lb0[c]) * sigm(-xf), kb = (1.f - lb1[c]) * sigm(-xb);
        o[0][c] = q * expf(bf); o[1][c] = kf * expf(-bf); o[2][c] = kf * expf(totf[c] - bf);
        o[3][c] = q * expf(bb); o[4][c] = kb * expf(-bb); o[5][c] = kb * expf(totb[c] - bb);
      }
      const long oo = (t0 + i) * 1024 + ch;
      *(unsigned*)(qdf + oo) = pack2(o[0][0], o[0][1]);
      *(unsigned*)(kif + oo) = pack2(o[1][0], o[1][1]);
      *(unsigned*)(kef + oo) = pack2(o[2][0], o[2][1]);
      *(unsigned*)(qdb + oo) = pack2(o[3][0], o[3][1]);
      *(unsigned*)(kib + oo) = pack2(o[4][0], o[4][1]);
      *(unsigned*)(keb + oo) = pack2(o[5][0], o[5][1]);
    }
    if (rg == 0) {
      *(float2*)(dlf + (long)cgi * 1024 + ch) = make_float2(expf(totf[0]), expf(totf[1]));
      *(float2*)(dlb + (long)cgi * 1024 + ch) = make_float2(expf(totb[0]), expf(totb[1]));
    }
  }
  __syncthreads();
}

template <int C, int DKT>
__device__ __forceinline__ void rec_scores_item(const Params& P, const Rec& R, int cgi, int h, int ti, int tj) {
  constexpr int T = C > 128 ? 128 : C, KTS = DKT;
  const u16* qdf = (const u16*)(WS(P) + O_QDF); const u16* qdb = (const u16*)(WS(P) + O_QDB);
  const u16* kif = (const u16*)(WS(P) + O_KIF); const u16* kib = (const u16*)(WS(P) + O_KIB);
  u16* sc = (u16*)(WS(P) + O_SC) + (((long)cgi * R.H + h) * C + ti * T) * C + tj * T;
  const long offA = ((long)cgi * C + ti * T) * 1024 + h * R.DK, offB = ((long)cgi * C + tj * T) * 1024 + h * R.DK;
  f32x4 af[T / 32][T / 64] = {}, ab[T / 32][T / 64] = {};
  if (ti >= tj) gemm_acc<T, T, true, true, true, KTS>(af, qdf + offA, 1024, kif + offB, 1024, (u16*)smem);
  if (ti <= tj) gemm_acc<T, T, true, true, true, KTS>(ab, qdb + offA, 1024, kib + offB, 1024, (u16*)smem);
  const int tid = TID(), lane = tid & 63, wid = tid >> 6;
  const int wm = wid >> 2, wn = wid & 3, fr = lane & 15, fq = lane >> 4;
#pragma unroll
  for (int mi = 0; mi < T / 32; ++mi)
#pragma unroll
    for (int ni = 0; ni < T / 64; ++ni) {
      const int r = wm * (T / 2) + mi * 16 + fr, c0 = wn * (T / 4) + ni * 16 + fq * 4;
      const int gr = ti * T + r;
      float v[4];
#pragma unroll
      for (int j = 0; j < 4; ++j) {
        const int gc = tj * T + c0 + j;
        v[j] = (gc <= gr ? af[mi][ni][j] : 0.f) + (gc >= gr ? ab[mi][ni][j] : 0.f);
      }
      *(uint2*)(sc + r * C + c0) = make_uint2(pack2(v[0], v[1]), pack2(v[2], v[3]));
    }
}

template <int C, int DKT>
__device__ void phase_rec_su(const Params& P, int kind) {
  const Rec R = rec_of(kind);
  constexpr int KTU = C / 64;
  const int nch = SLAB / C;
  constexpr int NT1 = (C > 128 ? C / 128 : 1), NTT = NT1 * NT1;
  const int n_sc = nch * R.H * NTT;
  const int mtn = R.DK / 128, ntn = R.DV / 128;
  const int n_u = nch * R.H * 2 * mtn * ntn, G = gridDim.x;
  const u16* pj = (const u16*)(WS(P) + O_PROJ);
  for (int item = BID(); item < n_sc; item += G) { const int tl = item % NTT, hh = (item / NTT) % R.H, cg = item / (NTT * R.H); rec_scores_item<C, DKT>(P, R, cg, hh, tl / NT1, tl % NT1); }
  const u16* kef = (const u16*)(WS(P) + O_KEF); const u16* keb = (const u16*)(WS(P) + O_KEB);
  u16* stfb = (u16*)(WS(P) + O_STF); u16* stbb = (u16*)(WS(P) + O_STB);
  Tiles<KTU> ta, tb;
#define U_DECODE(q_, nt_, mt_, dir_, h_, cgi_) int nt_, mt_, dir_, h_, cgi_; { int qq = (q_); nt_ = qq % ntn; qq /= ntn; mt_ = qq % mtn; qq /= mtn; dir_ = qq & 1; qq >>= 1; h_ = qq % R.H; cgi_ = qq / R.H; }
#define U_ISSUE(T_, nt_, mt_, dir_, h_, cgi_) tiles_issue<128, 128, false, false, KTU>(T_, (dir_ ? keb : kef) + (long)cgi_ * C * 1024 + h_ * R.DK + mt_ * 128, 1024, pj + (long)cgi_ * C * R.ldv + R.voff + h_ * R.DV + nt_ * 128, R.ldv)
#define U_RUN(T_, nt_, mt_, dir_, h_, cgi_) { f32x4 acc[4][2] = {}; gemm_run<128, 128, false, false, false, KTU>(acc, T_, (u16*)smem); \
    u16* st = (dir_ ? stbb : stfb) + (((long)cgi_ * R.H + h_) * R.DV + nt_ * 128) * R.DK + mt_ * 128; const int DK = R.DK; \
    epi_each<128, 128, false>(acc, [&](int r, int c, f32x4 val) { *(uint2*)(st + (long)c * DK + r) = make_uint2(pack2(val[0], val[1]), pack2(val[2], val[3])); }); }
  int q = BID();
  if (q < n_u) { U_DECODE(q, nt, mt, dir, h, cgi); U_ISSUE(ta, nt, mt, dir, h, cgi); }
  for (; q < n_u; q += 2 * G) {
    U_DECODE(q, nt, mt, dir, h, cgi);
    const int q2 = q + G;
    if (q2 < n_u) { U_DECODE(q2, nt2, mt2, dir2, h2, cgi2); U_ISSUE(tb, nt2, mt2, dir2, h2, cgi2); }
    U_RUN(ta, nt, mt, dir, h, cgi);
    const int q3 = q + 2 * G;
    if (q3 < n_u) { U_DECODE(q3, nt3, mt3, dir3, h3, cgi3); U_ISSUE(ta, nt3, mt3, dir3, h3, cgi3); }
    if (q2 < n_u) { U_DECODE(q2, nt2, mt2, dir2, h2, cgi2); U_RUN(tb, nt2, mt2, dir2, h2, cgi2); }
  }
#undef U_DECODE
#undef U_ISSUE
#undef U_RUN
  __syncthreads();
}

__device__ void phase_rec_scan(const Params& P, int kind, int slab, bool dry = false) {
  const Rec R = rec_of(kind);
  const int L = Lof(slab), nseq = SLAB / L, ncs = L / R.C;
  const int qdk = R.DK / 4;
  const long per = (long)R.H * R.DV * qdk;
  const long total = 2 * nseq * per;
  const long gtid = (long)BID() * NT + TID(), gsz = (long)gridDim.x * NT;
  for (long idx = gtid; idx < total; idx += gsz) {
    long q = idx;
    const int pd = (int)(q % qdk); q /= qdk;
    const int e = (int)(q % R.DV); q /= R.DV;
    const int h = (int)(q % R.H); q /= R.H;
    const int seq = (int)(q % nseq);
    const int dir = (int)(q / nseq);
    u16* st = (u16*)(WS(P) + (dir ? O_STB : O_STF));
    u16* stw = dry ? (u16*)(WS(P) + O_OBUF) : st;
    const float* dl = (const float*)(WS(P) + (dir ? O_DLB : O_DLF));
    float s0 = 0.f, s1 = 0.f, s2 = 0.f, s3 = 0.f;
    const long ebase = ((long)h * R.DV + e) * R.DK + pd * 4;
    const long cstride = (long)R.H * R.DV * R.DK;
    const int dbase = h * R.DK + pd * 4;
    for (int i0 = 0; i0 < ncs; i0 += 8) {
      uint2 u[8];
      float4 dd[8];
#pragma unroll
      for (int j = 0; j < 8; ++j) {
        const int n = dir ? (ncs - 1 - i0 - j) : (i0 + j);
        const long cgi = (long)seq * ncs + n;
        u[j] = *(const uint2*)(st + cgi * cstride + ebase);
        dd[j] = *(const float4*)(dl + cgi * 1024 + dbase);
      }
#pragma unroll
      for (int j = 0; j < 8; ++j) {
        const int n = dir ? (ncs - 1 - i0 - j) : (i0 + j);
        const long cgi = (long)seq * ncs + n;
        *(uint2*)(stw + cgi * cstride + ebase) = make_uint2(pack2(s0, s1), pack2(s2, s3));
        s0 = dd[j].x * s0 + bf2f((u16)(u[j].x & 0xffff));
        s1 = dd[j].y * s1 + bf2f((u16)(u[j].x >> 16));
        s2 = dd[j].z * s2 + bf2f((u16)(u[j].y & 0xffff));
        s3 = dd[j].w * s3 + bf2f((u16)(u[j].y >> 16));
      }
    }
  }
}

template <int C, int DKT>
__device__ void phase_rec_out(const Params& P, int kind) {
  const Rec R = rec_of(kind);
  constexpr int T = C > 128 ? 128 : C, NRT = C / T;
  constexpr int KT1 = C / 64, KT2 = DKT;
  const int nch = SLAB / C, ntn = R.DV / 128;
  const u16* pj = (const u16*)(WS(P) + O_PROJ);
  const u16* scb = (const u16*)(WS(P) + O_SC);
  const u16* qdf = (const u16*)(WS(P) + O_QDF); const u16* qdb = (const u16*)(WS(P) + O_QDB);
  const u16* stf = (const u16*)(WS(P) + O_STF); const u16* stb = (const u16*)(WS(P) + O_STB);
  u16* ob = (u16*)(WS(P) + O_OBUF);
  const int HDV = R.H * R.DV;
  const int nitems = nch * R.H * NRT * ntn, G = gridDim.x;
  Tiles<KT1> t1; Tiles<KT2> t2; Tiles<KT2> t3;
  int item = BID();
  if (item < nitems) {
    const int nt = item % ntn, rt = (item / ntn) % NRT, h = (item / (ntn * NRT)) % R.H, cgi = item / (ntn * NRT * R.H);
    tiles_issue<T, 128, true, false, KT1>(t1, scb + (((long)cgi * R.H + h) * C + rt * T) * C, C, pj + (long)cgi * C * R.ldv + R.voff + h * R.DV + nt * 128, R.ldv);
  }
  for (; item < nitems; item += G) {
    const int nt = item % ntn, rt = (item / ntn) % NRT, h = (item / (ntn * NRT)) % R.H, cgi = item / (ntn * NRT * R.H);
    const long qoff = ((long)cgi * C + rt * T) * 1024 + h * R.DK;
    const long soff = (((long)cgi * R.H + h) * R.DV + nt * 128) * R.DK;
    f32x4 acc[T / 32][2] = {};
    tiles_issue<T, 128, true, true, KT2>(t2, qdf + qoff, 1024, stf + soff, R.DK);
    gemm_run<T, 128, true, false, true, KT1>(acc, t1, (u16*)smem);
    tiles_issue<T, 128, true, true, KT2>(t3, qdb + qoff, 1024, stb + soff, R.DK);
    gemm_run<T, 128, true, true, true, KT2>(acc, t2, (u16*)smem);
    const int nx = item + G;
    if (nx < nitems) {
      const int nt2 = nx % ntn, rt2 = (nx / ntn) % NRT, h2 = (nx / (ntn * NRT)) % R.H, cg2 = nx / (ntn * NRT * R.H);
      tiles_issue<T, 128, true, false, KT1>(t1, scb + (((long)cg2 * R.H + h2) * C + rt2 * T) * C, C, pj + (long)cg2 * C * R.ldv + R.voff + h2 * R.DV + nt2 * 128, R.ldv);
    }
    gemm_run<T, 128, true, true, true, KT2>(acc, t3, (u16*)smem);
    u16* o = ob + ((long)cgi * C + rt * T) * HDV + h * R.DV + nt * 128;
    epi_each<T, 128, true>(acc, [&](int r, int c, f32x4 val) { *(uint2*)(o + (long)r * HDV + c) = make_uint2(pack2(val[0], val[1]), pack2(val[2], val[3])); });
  }
  __syncthreads();
}

template <int KIND>
__device__ void phase_rec_ng_t(const Params& P) {
  const Rec R = rec_of(KIND);
  constexpr int DV = (KIND == 1) ? 512 : 128, H = (KIND == 1) ? 4 : 8, PER = DV / 64, HDV = H * DV;
  const u16* __restrict__ ob = (const u16*)(WS(P) + O_OBUF);
  const u16* __restrict__ pj = (const u16*)(WS(P) + O_PROJ);
  u16* __restrict__ a2 = (u16*)(WS(P) + O_A2);
  const float* gain = P.in[29];
  const int tid = TID(), lane = tid & 63, wid = tid >> 6;
  constexpr int nrows = SLAB * H;
  for (int item = BID(); item < nrows / 32; item += gridDim.x) {
    float v[4][PER];
    float ss[4];
#pragma unroll
    for (int u = 0; u < 4; ++u) {
      const int rh = item * 32 + wid * 4 + u;
      const int t = rh / H, h = rh % H;
      const u16* o = ob + (long)t * HDV + h * DV + lane * PER;
      if (PER == 8) {
        float f8[8];
        unpack8(*(const uint4*)o, f8);
#pragma unroll
        for (int i = 0; i < 8; ++i) v[u][i % PER] = f8[i];
      } else {
        const unsigned w = *(const unsigned*)o;
        v[u][0] = bf2f((u16)(w & 0xffff)); v[u][1 % PER] = bf2f((u16)(w >> 16));
      }
      float a = 0.f;
#pragma unroll
      for (int i = 0; i < PER; ++i) a += v[u][i] * v[u][i];
      ss[u] = a;
    }
#pragma unroll
    for (int u = 0; u < 4; ++u) ss[u] = wave_sum(ss[u]);
#pragma unroll
    for (int u = 0; u < 4; ++u) {
      const int rh = item * 32 + wid * 4 + u;
      const int t = rh / H, h = rh % H;
      const float rstd = rsqrtf(ss[u] / (float)DV + 1e-6f);
      const u16* g = pj + (long)t * R.ldv + R.goff + h * DV + lane * PER;
      u16* out = a2 + (long)t * HDV + h * DV + lane * PER;
      float y[PER];
#pragma unroll
      for (int i = 0; i < PER; ++i) {
        y[i] = v[u][i] * rstd;
        if (KIND == 3) y[i] *= gain[lane * PER + i];
      }
      if (PER == 8) {
        const uint4 gw = *(const uint4*)g;
        float gf[8];
        unpack8(gw, gf);
        float r8[8];
#pragma unroll
        for (int i = 0; i < 8; ++i) r8[i] = y[i % PER] * silu_f(gf[i]);
        *(uint4*)out = pack8s(r8, 1.f);
      } else {
        const unsigned gw = *(const unsigned*)g;
        *(unsigned*)out = pack2(y[0] * silu_f(bf2f((u16)(gw & 0xffff))), y[1 % PER] * silu_f(bf2f((u16)(gw >> 16))));
      }
    }
  }
}
__device__ void phase_rec_ng(const Params& P, int kind) {
  if (kind == 1) phase_rec_ng_t<1>(P); else phase_rec_ng_t<3>(P);
}

__device__ void phase_swa_prep(const Params& P, int slab) {
  const int L = Lof(slab);
  const u16* __restrict__ pj = (const u16*)(WS(P) + O_PROJ);
  u16* __restrict__ qn = (u16*)(WS(P) + O_QN);
  u16* __restrict__ kn = (u16*)(WS(P) + O_KN);
  const float2* __restrict__ rope = (const float2*)(WS(P) + O_ROPES);
  const long gtid = (long)BID() * NT + TID(), gsz = (long)gridDim.x * NT;
  for (long idx = gtid; idx < (long)SLAB * 80; idx += gsz) {
    const int j = (int)(idx & 3);
    const int hd = (int)((idx >> 2) % 20);
    const int t = (int)(idx / 80);
    const int col = hd < 16 ? hd * 64 : 1024 + (hd - 16) * 64;
    const int d0 = j * 8;
    float x1[8], x2[8];
    unpack8(*(const uint4*)(pj + (long)t * 1536 + col + d0), x1);
    unpack8(*(const uint4*)(pj + (long)t * 1536 + col + d0 + 32), x2);
    const float4* rp = (const float4*)(rope + (long)(t & (L - 1)) * 32 + d0);
    const float4 c01 = rp[0], c23 = rp[1], c45 = rp[2], c67 = rp[3];
    float ss = 0.f;
#pragma unroll
    for (int i = 0; i < 8; ++i) ss += x1[i] * x1[i] + x2[i] * x2[i];
    ss += __shfl_xor(ss, 1); ss += __shfl_xor(ss, 2);
    const float rstd = rsqrtf(ss * (1.f / 64.f) + 1e-6f);
    const float* gn = hd < 16 ? P.in[23] : P.in[24];
    const float4 ga = *(const float4*)(gn + d0), gb = *(const float4*)(gn + d0 + 4), gc = *(const float4*)(gn + d0 + 32), gd = *(const float4*)(gn + d0 + 36);
    const float g1[8] = {ga.x, ga.y, ga.z, ga.w, gb.x, gb.y, gb.z, gb.w};
    const float g2[8] = {gc.x, gc.y, gc.z, gc.w, gd.x, gd.y, gd.z, gd.w};
    const float cs[8] = {c01.x, c01.z, c23.x, c23.z, c45.x, c45.z, c67.x, c67.z};
    const float sn[8] = {c01.y, c01.w, c23.y, c23.w, c45.y, c45.w, c67.y, c67.w};
    const float osc = hd < 16 ? 0.125f : 1.f;
    float o1[8], o2[8];
#pragma unroll
    for (int i = 0; i < 8; ++i) {
      const float y1 = x1[i] * rstd * g1[i], y2 = x2[i] * rstd * g2[i];
      o1[i] = (y1 * cs[i] - y2 * sn[i]) * osc;
      o2[i] = (y1 * sn[i] + y2 * cs[i]) * osc;
    }
    u16* dst = hd < 16 ? qn + (long)t * 1024 + hd * 64 + d0 : kn + (long)t * 256 + (hd - 16) * 64 + d0;
    *(uint4*)dst = pack8s(o1, 1.f);
    *(uint4*)(dst + 32) = pack8s(o2, 1.f);
  }
}

constexpr int SLD = 324;
__device__ void phase_swa_att(const Params& P, int slab) {
  const int L = Lof(slab), nqb = L / 64;
  const u16* qn = (const u16*)(WS(P) + O_QN);
  const u16* kn = (const u16*)(WS(P) + O_KN);
  const u16* pj = (const u16*)(WS(P) + O_PROJ);
  u16* a2 = (u16*)(WS(P) + O_A2);
  const float* sink = P.in[25];
  float* S = (float*)(smem + 40960);
  u16* Bs = (u16*)smem + 9216;
  const int tid = TID(), lane = tid & 63, wid = tid >> 6;
  const int wm = wid >> 2, wn = wid & 3, fr = lane & 15, fq = lane >> 4;
  const int nitems = (SLAB / 64) * 16;
  for (int item = BID(); item < nitems; item += gridDim.x) {
    const int hq = item & 15, qbg = item >> 4;
    const int seq = qbg / nqb, qb = qbg % nqb;
    const int q0 = qb * 64;
    const long tok0 = (long)seq * L;
    const int hkv = hq >> 2;
    uint4 vt[5];
#pragma unroll
    for (int kt = 0; kt < 5; ++kt) {
      const int kp0 = q0 - 128 + kt * 64;
      vt[kt] = make_uint4(0, 0, 0, 0);
      if (kp0 >= 0 && kp0 < L) vt[kt] = ld_chunk<64, false>(pj + (tok0 + kp0) * 1536 + 1280 + hkv * 64, 1536, 0, tid);
    }
    for (int kt = 0; kt < 5; ++kt) {
      const int kp0 = q0 - 128 + kt * 64;
      if (kp0 >= 0 && kp0 < L) {
        f32x4 acc[2][1] = {};
        gemm_acc<64, 64, true, true, true, 1>(acc, qn + (tok0 + q0) * 1024 + hq * 64, 1024, kn + (tok0 + kp0) * 256 + hkv * 64, 256, (u16*)smem);
        epi_each<64, 64, true>(acc, [&](int r, int c, f32x4 v) {
          f32x4 o;
#pragma unroll
          for (int j = 0; j < 4; ++j) {
            const int dlt = (q0 + r) - (kp0 + c + j);
            o[j] = (dlt <= 128 && dlt >= -128) ? v[j] : -1e30f;
          }
          *(f32x4*)(S + r * SLD + kt * 64 + c) = o;
        });
      } else {
        for (int i = tid; i < 4096; i += NT) S[(i >> 6) * SLD + kt * 64 + (i & 63)] = -1e30f;
      }
    }
    __syncthreads();
    {
      const int r = tid >> 3, sub = tid & 7;
      const float sk = sink[hq];
      float e[40];
      float m = sk;
#pragma unroll
      for (int i = 0; i < 40; ++i) { e[i] = S[r * SLD + sub + 8 * i]; m = fmaxf(m, e[i]); }
      m = fmaxf(m, __shfl_xor(m, 1)); m = fmaxf(m, __shfl_xor(m, 2)); m = fmaxf(m, __shfl_xor(m, 4));
      float den = 0.f;
#pragma unroll
      for (int i = 0; i < 40; ++i) { e[i] = __expf(e[i] - m); den += e[i]; }
      den += __shfl_xor(den, 1); den += __shfl_xor(den, 2); den += __shfl_xor(den, 4);
      den += __expf(sk - m);
      const float inv = 1.f / den;
      u16* prow = (u16*)(S + r * SLD);
#pragma unroll
      for (int i = 0; i < 40; ++i) prow[sub + 8 * i] = f2bf(e[i] * inv);
    }
    __syncthreads();
    f32x4 acc[2][1] = {};
#pragma unroll
    for (int kt = 0; kt < 5; ++kt) {
      const int kp0 = q0 - 128 + kt * 64;
      if (kp0 >= 0 && kp0 < L) {
        __syncthreads();
        st_chunk<64, false>(Bs, vt[kt], tid);
        __syncthreads();
#pragma unroll
        for (int ks = 0; ks < 2; ++ks) {
          bf16x8 af[2];
#pragma unroll
          for (int mi = 0; mi < 2; ++mi) af[mi] = *(const bf16x8*)((const u16*)(S + (wm * 32 + mi * 16 + fr) * SLD) + kt * 64 + ks * 32 + fq * 8);
          const bf16x8 bfr = ld_frag<64, false>(Bs, wn * 16, ks, fr, fq);
#pragma unroll
          for (int mi = 0; mi < 2; ++mi) acc[mi][0] = __builtin_amdgcn_mfma_f32_16x16x32_bf16(bfr, af[mi], acc[mi][0], 0, 0, 0);
        }
      }
    }
    u16* o = a2 + (tok0 + q0) * 1024 + hq * 64;
    epi_each<64, 64, true>(acc, [&](int r, int c, f32x4 v) { *(uint2*)(o + (long)r * 1024 + c) = make_uint2(pack2(v[0], v[1]), pack2(v[2], v[3])); });
    __syncthreads();
  }
}

#define XB_TMO      128
#define XB_XCNT(j)  (256  + 64 * (j))
#define XB_XSUB(j)  (1280 + 64 * (j))
#define XB_XGEN(j)  (2304 + 64 * (j))
#define XB_TOP      3328
#define XB_TOPGEN   3392
#define XCD_BAR_WORDS 3456
#define XB_SPIN_CAP (1u << 18)
__device__ __forceinline__ unsigned xb_ld(unsigned* p)              { return __hip_atomic_load(p, __ATOMIC_RELAXED, __HIP_MEMORY_SCOPE_AGENT); }
__device__ __forceinline__ unsigned xb_add(unsigned* p, unsigned v) { return __hip_atomic_fetch_add(p, v, __ATOMIC_RELAXED, __HIP_MEMORY_SCOPE_AGENT); }
__device__ __forceinline__ unsigned xb_xcc_id() { return (unsigned)__builtin_amdgcn_s_getreg((3 << 11) | 20) & 0xFu; }
#define XB_SPIN(cond, bar) do { unsigned _sp = 0; while (cond) { __builtin_amdgcn_s_sleep(1); \
    if ((++_sp & 255u) == 0u) { if (xb_ld(&(bar)[XB_TMO])) break; if (_sp > XB_SPIN_CAP) { atomicAdd(&(bar)[XB_TMO], 1u); break; } } } } while (0)
struct XcdBarrier { unsigned* bar; unsigned x; volatile LDS_AS unsigned* st; };
__device__ __forceinline__ XcdBarrier xcd_barrier_post(unsigned* bar, volatile LDS_AS unsigned* st) {
    XcdBarrier b; b.bar = bar; b.x = xb_xcc_id(); b.st = st;
    if (threadIdx.x == 0) (void)xb_add(&bar[XB_XCNT(b.x)], 1u);
    return b;
}
__device__ __forceinline__ void xcd_barrier_complete(unsigned* bar, unsigned x, unsigned& nloc, unsigned& nx) {
    const unsigned G = gridDim.x * gridDim.y * gridDim.z;
    unsigned sum, cnt, mine, sp = 0u;
    for (;;) {
        sum = 0u; cnt = 0u; mine = 0u;
#pragma unroll
        for (unsigned j = 0; j < 16; ++j) { const unsigned c = xb_ld(&bar[XB_XCNT(j)]); sum += c; cnt += (c > 0u) ? 1u : 0u; mine = (j == x) ? c : mine; }
        if (sum == G) break;
        __builtin_amdgcn_s_sleep(1);
        if ((++sp & 255u) == 0u) { if (xb_ld(&bar[XB_TMO])) break; if (sp > XB_SPIN_CAP) { atomicAdd(&bar[XB_TMO], 1u); break; } }
    }
    nloc = mine > 0u ? mine : 1u; nx = cnt > 0u ? cnt : 1u;
}
__device__ __forceinline__ void xcd_barrier(const XcdBarrier& b) {
    asm volatile("s_waitcnt vmcnt(0)" ::: "memory");
    __syncthreads();
    if (threadIdx.x == 0) {
        unsigned* bar = b.bar;
        __builtin_amdgcn_s_waitcnt(0);
        unsigned nloc = b.st[0], nx = b.st[1];
        if (nloc == 0u) { xcd_barrier_complete(bar, b.x, nloc, nx); b.st[0] = nloc; b.st[1] = nx; }
        const unsigned old = xb_add(&bar[XB_XSUB(b.x)], 1u);
        const unsigned gen = old / nloc;
        if (old + 1u == (gen + 1u) * nloc) {
            __builtin_amdgcn_fence(__ATOMIC_RELEASE, "agent");
            asm volatile("s_waitcnt vmcnt(0)" ::: "memory");
            const unsigned og = xb_add(&bar[XB_TOP], 1u);
            const unsigned tg = og / nx;
            if (og + 1u == (tg + 1u) * nx) xb_add(&bar[XB_TOPGEN], 1u);
            else XB_SPIN(xb_ld(&bar[XB_TOPGEN]) == tg, bar);
            __builtin_amdgcn_fence(__ATOMIC_ACQUIRE, "agent");
            xb_add(&bar[XB_XGEN(b.x)], 1u);
            asm volatile("s_waitcnt vmcnt(0)" ::: "memory");
        } else {
            XB_SPIN(xb_ld(&bar[XB_XGEN(b.x)]) == gen, bar);
            __builtin_amdgcn_fence(__ATOMIC_ACQUIRE, "agent");
            asm volatile("s_waitcnt vmcnt(0)" ::: "memory");
        }
    }
    __syncthreads();
}

__device__ __forceinline__ int nmix_of(int kind) { return (kind & 1) ? 8 : (kind == 2 ? 5 : 6); }

__device__ void ffn_step(const Params& P, int layer, int f) {
  if (f == 6) { phase_ffn_down(P, layer); return; }
  const int fs = f / 3, st = f % 3;
  if (st == 0) { REP(4) phase_norm(P, layer, fs, 1); }
  else if (st == 1) { REP(0) phase_ffn_gate(P, layer); }
  else { REP(0) phase_ffn_val(P, layer, fs); }
}
__device__ void layer_step(const Params& P, int layer, int slab, int step) {
  const int kind = layer;
  if (step == 0) { REP(4) phase_norm(P, layer, slab, 0); return; }
  if (kind == 0) {
    if (step == 1) { REP(0) phase_proj(P, O_WHYIN, 3072); }
    else if (step == 2) { REP(3) phase_hy_conv(P, slab); }
    else if (step == 3) { if ((PROBE_MASK >> 7) & 1) phase_hy_fft(P, slab, true); phase_hy_fft(P, slab); }
    else if (step == 4) { REP(3) phase_hy_tr(P, slab); }
    else phase_resid(P, layer, slab, (const u16*)(WS(P) + O_A2), 1024, O_WHYOUT, 2 * D);
  } else if (kind == 1) {
    if (step == 1) { REP(0) phase_proj(P, O_WRETIN, 6144); }
    else if (step == 2) { REP(1) REP(9) phase_ret_prep(P, slab); }
    else if (step == 3) { REP(1) REP(11) phase_rec_su<256, 4>(P, 1); }
    else if (step == 4) { if ((PROBE_MASK >> 6) & 1) phase_rec_scan(P, 1, slab, true); phase_rec_scan(P, 1, slab); }
    else if (step == 5) { REP(1) REP(12) phase_rec_out<256, 4>(P, 1); }
    else if (step == 6) { REP(1) REP(9) phase_rec_ng(P, 1); }
    else phase_resid(P, layer, slab, (const u16*)(WS(P) + O_A2), 2048, O_WRETOUT, 2 * D);
  } else if (kind == 2) {
    if (step == 1) { REP(0) phase_proj(P, O_WSWAIN, 1536); }
    else if (step == 2) { REP(2) REP(14) phase_swa_prep(P, slab); }
    else if (step == 3) { REP(2) REP(15) phase_swa_att(P, slab); }
    else phase_resid(P, layer, slab, (const u16*)(WS(P) + O_A2), 1024, O_WSWAOUT, 2 * D);
  } else {
    if (step == 1) { REP(0) phase_proj(P, O_WHGIN, 5120); }
    else if (step == 2) { REP(1) REP(9) phase_hg_prep(P); }
    else if (step == 3) { REP(1) REP(11) phase_rec_su<128, 2>(P, 3); }
    else if (step == 4) { if ((PROBE_MASK >> 6) & 1) phase_rec_scan(P, 3, slab, true); phase_rec_scan(P, 3, slab); }
    else if (step == 5) { REP(1) REP(12) phase_rec_out<128, 2>(P, 3); }
    else if (step == 6) { REP(1) REP(9) phase_rec_ng(P, 3); }
    else phase_resid(P, layer, slab, (const u16*)(WS(P) + O_A2), 1024, O_WHGOUT, 2 * D);
  }
}

__global__ void __launch_bounds__(NT) fwd_megakernel(Params P) {
  cg::grid_group grid = cg::this_grid();
  __shared__ uint4 xb_words;
  if (threadIdx.x == 0) xb_words = make_uint4(0u, 0u, 0u, 0u);
  __syncthreads();
  XcdBarrier xb = xcd_barrier_post((unsigned*)(P.ws + O_BAR), (volatile LDS_AS unsigned*)&xb_words);
  for (int pid = P.p0; pid < P.p1; ++pid) {
    if (pid == 0) { REP(5) phase_pre0(P); }
    else if (pid == 1) { REP(5) phase_pre1(P); }
    else {
      int q = pid - 2, layer = 0;
      while (q >= 5 * nmix_of(layer) + 7) { q -= 5 * nmix_of(layer) + 7; ++layer; }
      const int nm = nmix_of(layer);
      if (q < 5 * nm) layer_step(P, layer, q / nm, q % nm);
      else ffn_step(P, layer, q - 5 * nm);
    }
    if (pid + 1 < P.p1) {
      if (pid == 0) grid.sync();
      else xcd_barrier(xb);
      if ((PROBE_MASK >> 8) & 1) xcd_barrier(xb);
    }
  }
}

extern "C" void kernel_launch(void* const* d_in, const int* in_sizes, int n_in, void* d_out, int out_size, void* d_ws,
                              size_t ws_size, hipStream_t stream) {
  static int grid_blocks = 0;
  if (!grid_blocks) {
    int dev = 0, cus = 0, per_cu = 0;
    (void)hipGetDevice(&dev);
    (void)hipDeviceGetAttribute(&cus, hipDeviceAttributeMultiprocessorCount, dev);
    (void)hipFuncSetAttribute((const void*)fwd_megakernel, hipFuncAttributeMaxDynamicSharedMemorySize, LDSB);
    (void)hipOccupancyMaxActiveBlocksPerMultiprocessor(&per_cu, (const void*)fwd_megakernel, NT, LDSB);
    if (per_cu < 1) per_cu = 1;
    if (per_cu > 1) per_cu = 1;
    grid_blocks = cus * per_cu;
    if (ws_size < WS_END) fprintf(stderr, "kernel_launch: workspace too small: %zu < %zu\n", ws_size, (size_t)WS_END);
  }
  Params p;
  memset(&p, 0, sizeof(p));
  for (int i = 0; i < 36; ++i) p.in[i] = (const float*)d_in[i];
  p.out = (float*)d_out;
  p.ws = (unsigned char*)d_ws;
  (void)hipMemsetAsync((unsigned char*)d_ws + O_BAR, 0, XCD_BAR_WORDS * 4, stream);
#if ONE_LAUNCH
  p.p0 = 0; p.p1 = NPHASES;
  void* args[] = {&p};
  hipError_t e = hipLaunchCooperativeKernel((const void*)fwd_megakernel, dim3(grid_blocks), dim3(NT), args, LDSB, stream);
  if (e != hipSuccess) fprintf(stderr, "cooperative launch failed: %s (grid %d)\n", hipGetErrorString(e), grid_blocks);
#else
  for (int ph = 0; ph < NPHASES; ++ph) {
    p.p0 = ph; p.p1 = ph + 1;
    hipLaunchKernelGGL(fwd_megakernel, dim3(grid_blocks), dim3(NT), LDSB, stream, p);
  }
#endif
}
```

```cpp
#include <hip/hip_runtime.h>
#include <hip/hip_cooperative_groups.h>
#include <cstdio>
#include <cstdint>
#include <cstring>
namespace cg = cooperative_groups;

typedef unsigned short u16;
typedef __attribute__((ext_vector_type(8))) short bf16x8;
typedef __attribute__((ext_vector_type(4))) float f32x4;

#define NT 512
#ifndef ONE_LAUNCH
#define ONE_LAUNCH 1
#endif
#ifndef PROBE_MASK
#define PROBE_MASK 0
#endif
#define REP(cls) for (int rep_##cls = 0; rep_##cls < (((PROBE_MASK >> (cls)) & 1) ? 2 : 1); ++rep_##cls)

constexpr int D = 1024, SLAB = 16384, DFF = 2816;
constexpr int LDSB = 139264;
constexpr int FSLAB = 40960, NTOK = 81920;
constexpr int NPHASES = 2 + 5 * (6 + 8 + 8) + 5 + 4 * 7;

constexpr size_t SZW(size_t n, size_t k) { return n * k * 2; }
constexpr size_t O_WHYIN = 0;
constexpr size_t O_WHYOUT = O_WHYIN + SZW(3072, 1024);
constexpr size_t O_WRETIN = O_WHYOUT + SZW(1024, 1024);
constexpr size_t O_WRETOUT = O_WRETIN + SZW(6144, 1024);
constexpr size_t O_WSWAIN = O_WRETOUT + SZW(1024, 2048);
constexpr size_t O_WSWAOUT = O_WSWAIN + SZW(1536, 1024);
constexpr size_t O_WHGIN = O_WSWAOUT + SZW(1024, 1024);
constexpr size_t O_WHGOUT = O_WHGIN + SZW(5120, 1024);
constexpr size_t O_WFG = O_WHGOUT + SZW(1024, 1024);
constexpr size_t O_WFV = O_WFG + 4 * SZW(2816, 1024);
constexpr size_t O_WFD = O_WFV + 4 * SZW(2816, 1024);
constexpr size_t O_MOD = O_WFD + 4 * SZW(1024, 2816);
constexpr size_t O_TW = O_MOD + (size_t)4 * 16 * 6144 * 4;
constexpr size_t O_HIDS = O_TW + 8192 * 8;
constexpr size_t O_HIDP = O_HIDS + (size_t)8192 * 64 * 4;
constexpr size_t O_ROPER = O_HIDP + (size_t)2048 * 64 * 4;
constexpr size_t O_ROPES = O_ROPER + (size_t)8192 * 128 * 8;
constexpr size_t O_PROJ = O_ROPES + (size_t)8192 * 32 * 8;
constexpr size_t O_HBUF = O_PROJ + (size_t)SLAB * 6144 * 2;
constexpr size_t O_A2 = O_HBUF + (size_t)SLAB * 1024 * 2;
constexpr size_t O_C = O_A2 + (size_t)SLAB * 2048 * 2;
constexpr size_t O_FHBUF = O_PROJ;
constexpr size_t O_FGBUF = O_FHBUF + (size_t)FSLAB * 1024 * 2;
constexpr size_t O_FACT = O_FGBUF + (size_t)FSLAB * DFF * 2;
constexpr size_t END_F = O_FACT + (size_t)NTOK * DFF * 2;
constexpr size_t O_MODP = O_C;
constexpr size_t O_BAR = ((size_t)1 << 30) - 16384;
constexpr size_t O_HSPS = O_BAR - (size_t)1024 * 16384 * 8 - (size_t)1024 * 4096 * 8;
constexpr size_t O_HSPP = O_HSPS + (size_t)1024 * 16384 * 8;
constexpr size_t O_UT = O_C;
constexpr size_t O_X0C = O_UT + (size_t)SLAB * 1024 * 4;
constexpr size_t END_HY = O_X0C + (size_t)SLAB * 1024 * 2;
static_assert(END_F <= O_HSPS && END_HY <= O_HSPS, "layer-0 buffers overlap the filter spectra");
constexpr size_t SZP = (size_t)SLAB * 1024 * 2;
constexpr size_t O_QDF = O_C, O_QDB = O_QDF + SZP, O_KIF = O_QDB + SZP, O_KIB = O_KIF + SZP, O_KEF = O_KIB + SZP, O_KEB = O_KEF + SZP;
constexpr size_t O_DLF = O_KEB + SZP;
constexpr size_t O_DLB = O_DLF + (size_t)256 * 1024 * 4;
constexpr size_t O_SC = O_DLB + (size_t)256 * 1024 * 4;
constexpr size_t O_STF = O_SC + (size_t)SLAB * 1024 * 2;
constexpr size_t O_STB = O_STF + (size_t)134217728;
constexpr size_t O_OBUF = O_STB + (size_t)134217728;
constexpr size_t END_REC = O_OBUF + (size_t)SLAB * 2048 * 4;
constexpr size_t O_QN = O_C;
constexpr size_t O_KN = O_QN + SZP;
constexpr size_t O_PBUF = O_KN + (size_t)SLAB * 256 * 2;
constexpr size_t END_SWA0 = O_PBUF + (size_t)SLAB * 16 * 320 * 2;
constexpr size_t O_SA_H = O_PROJ;
constexpr size_t O_SA_P = O_SA_H + (size_t)81920 * 1024 * 2;
constexpr size_t O_SA_Q = O_SA_P + (size_t)81920 * 1536 * 2;
constexpr size_t O_SA_K = O_SA_Q + (size_t)81920 * 1024 * 2;
constexpr size_t O_SA_A = O_SA_K + (size_t)81920 * 256 * 2;
constexpr size_t END_SWA = O_SA_A + (size_t)81920 * 1024 * 2;
constexpr size_t WS_END = END_REC > END_HY ? (END_REC > END_SWA ? END_REC : END_SWA) : (END_HY > END_SWA ? END_HY : END_SWA);
static_assert(WS_END <= O_BAR, "workspace exceeds 1 GiB");

struct Params {
  const float* in[36];
  float* out;
  unsigned char* ws;
  int p0, p1;
};

extern __shared__ __attribute__((aligned(16))) unsigned char smem[];

__device__ __forceinline__ int TID() { int t = threadIdx.x; asm volatile("" : "+v"(t)); return t; }
__device__ __forceinline__ int BID() { int b = blockIdx.x; asm volatile("" : "+s"(b)); return b; }
__device__ __forceinline__ long ZOFF() { long z = 0; asm volatile("" : "+s"(z)); return z; }
__device__ __forceinline__ unsigned char* WS(const Params& P) { return P.ws + ZOFF(); }
__device__ __forceinline__ float* OUTP(const Params& P) { return P.out + ZOFF(); }

namespace pg8 {
#define PG8_LAS __attribute__((address_space(3)))
typedef unsigned short bf16_t;
typedef short bf16x8 __attribute__((ext_vector_type(8)));
typedef float f32x4 __attribute__((ext_vector_type(4)));
typedef unsigned u32x4 __attribute__((ext_vector_type(4)));
constexpr int BM = 256, BK = 64, HALF = 128, HTB = HALF * BK * 2  , STAGE_BYTES = 8 * HTB, NXCD = 8, WGM = 8;

__host__ __device__ __forceinline__ int lds_byte(int r, int c) { const int st = (r >> 4) * 2 + (c >> 5), rr = r & 15, cc = c & 31, ob = rr * 64 + cc * 2; return st * 1024 + (ob ^ (((ob >> 9) & 1) << 5)); }
__host__ __device__ __forceinline__ void stage_rc(int b, int& R, int& C) { const int st = b / 1024, sb = b % 1024, swz = sb ^ (((sb >> 9) & 1) << 5); R = (st >> 1) * 16 + swz / 64; C = (st & 1) * 32 + (swz % 64) / 2; }
__host__ __device__ __forceinline__ int perm32(int rho) { const int n = rho >> 4, i = rho & 15; return 8 * (i >> 2) + 4 * n + (i & 3); }

struct Unit { int pm, pn; };
struct Gemm { const bf16_t* A; const bf16_t* Bt; int M, N, K; };

struct StaticOrder {
    int nM, nN, nwg, G, c;
    __host__ __device__ void init(int M, int N, int G_, int c_) { nM = M / BM; nN = N / BM; nwg = nM * nN; G = G_; c = c_; }
    __host__ __device__ bool next(int i, Unit& u) const {
        const long L = (long)i * G + c; if (L >= nwg) return false;
        int wgid = (int)L; { const int q = nwg / NXCD, r = nwg % NXCD, xcd = wgid % NXCD, off = wgid / NXCD; wgid = (xcd < r ? xcd * (q + 1) : r * (q + 1) + (xcd - r) * q) + off; }
        const int nig = WGM * nN, gid = wgid / nig, fm = gid * WGM, gsz = (nM - fm) < WGM ? (nM - fm) : WGM;
        u.pm = fm + ((wgid % nig) % gsz); u.pn = (wgid % nig) / gsz; return true;
    }
    __device__ __forceinline__ void a_ready(const Unit&) const {}
    __device__ __forceinline__ void done(const Unit&) const {}
};

template <class Epi, class Sched, bool STAMP = false>
__device__ __forceinline__ void gemm_phase(PG8_LAS unsigned char* lds, const Gemm g, const Sched& S, const Epi& E, unsigned long long* stamps) {
    const int tid = TID(), wid = __builtin_amdgcn_readfirstlane(tid >> 6), lane = tid & 63, wr = wid >> 2, wc = wid & 3, fr = lane & 15, fq = lane >> 4;
    const int K = g.K, nt = K / BK;
    int ts_lo = 0, ts_hi = 0, nts = 0; const unsigned long long rt_entry = STAMP ? (unsigned long long)wall_clock64() : 0ull;
#define PG8_STAMP() do { if (STAMP && wid == 0 && nts < 64) { const unsigned long long _c = (unsigned long long)clock64(); \
        ts_lo = (lane == nts) ? (int)(unsigned)_c : ts_lo; ts_hi = (lane == nts) ? (int)(unsigned)(_c >> 32) : ts_hi; ++nts; } } while (0)
    PG8_STAMP();
    unsigned voffA[2], voffB[2];
#pragma unroll
    for (int i = 0; i < 2; ++i) { int R, C; stage_rc(tid * 16 + i * 8192, R, C); const int Rb = Epi::PERM ? ((R & ~31) + perm32(R & 31)) : R;
        voffA[i] = (unsigned)(R * K + C) * 2u; voffB[i] = (unsigned)(Rb * K + C) * 2u; }
    const size_t kstep = (size_t)(BK * 2);
    const size_t hstep = (size_t)HALF * K * 2;
    const size_t tstep = 2 * hstep;
    const unsigned ldsw = (unsigned)wid * 1024u;
    const int aoff = lds_byte(wr * 64 + fr, fq * 8), boff = lds_byte(wc * 32 + fr, fq * 8);
#define PG8_SA(b, h) (((b) * 2 + (h)) * HTB)
#define PG8_SB(b, h) ((4 + (b) * 2 + (h)) * HTB)
#define PG8_STAGE(bufoff, gbase, voff) do { _Pragma("unroll") for (int _i = 0; _i < 2; ++_i) \
        __builtin_amdgcn_global_load_lds((const unsigned*)((const char*)(gbase) + (voff)[_i]), (PG8_LAS unsigned*)(lds + (bufoff) + ldsw + _i * 8192), 16, 0, 0); } while (0)
#define PG8_LDA(dst, b, h) do { _Pragma("unroll") for (int m = 0; m < 4; ++m) _Pragma("unroll") for (int k = 0; k < 2; ++k) dst[m][k] = *(const PG8_LAS bf16x8*)(lds + PG8_SA(b, h) + aoff + m * 2048 + k * 1024); } while (0)
#define PG8_LDB(dst, b, h) do { _Pragma("unroll") for (int n = 0; n < 2; ++n) _Pragma("unroll") for (int k = 0; k < 2; ++k) dst[n][k] = *(const PG8_LAS bf16x8*)(lds + PG8_SB(b, h) + boff + n * 2048 + k * 1024); } while (0)
#define PG8_MMA(ai, bj, At, Bt) do { __builtin_amdgcn_s_setprio(1); _Pragma("unroll") for (int m = 0; m < 4; ++m) _Pragma("unroll") for (int n = 0; n < 2; ++n) _Pragma("unroll") for (int k = 0; k < 2; ++k) \
        acc[ai][bj][m][n] = __builtin_amdgcn_mfma_f32_16x16x32_bf16(Bt[n][k], At[m][k], acc[ai][bj][m][n], 0, 0, 0); __builtin_amdgcn_s_setprio(0); } while (0)
#define PG8_WAIT_V(n) asm volatile("s_waitcnt vmcnt(" #n ")" ::: "memory")
#define PG8_WAIT_L(n) asm volatile("s_waitcnt lgkmcnt(" #n ")" ::: "memory")
#define PG8_BAR __builtin_amdgcn_s_barrier()
#define PG8_SCHED __builtin_amdgcn_sched_barrier(0)
    Unit cur, nxt; int ui = 0;
    if (!S.next(0, cur)) return;
    f32x4 acc[2][2][4][2];
#pragma unroll
    for (int a = 0; a < 2; ++a)
#pragma unroll
        for (int b = 0; b < 2; ++b)
#pragma unroll
            for (int m = 0; m < 4; ++m)
#pragma unroll
                for (int n = 0; n < 2; ++n) acc[a][b][m][n] = (f32x4){0.f, 0.f, 0.f, 0.f};
    bf16x8 At[4][2], B0[2][2], B1[2][2];
    const char* cA = (const char*)g.A + (size_t)cur.pm * tstep; const char* cB = (const char*)g.Bt + (size_t)cur.pn * tstep;
    S.a_ready(cur);
    PG8_STAGE(PG8_SB(0, 0), cB, voffB); PG8_STAGE(PG8_SA(0, 0), cA, voffA); PG8_STAGE(PG8_SB(0, 1), cB + hstep, voffB); PG8_STAGE(PG8_SA(0, 1), cA + hstep, voffA);
    if (wr == 1) PG8_BAR;
    PG8_WAIT_V(4); PG8_BAR;
    PG8_STAGE(PG8_SB(1, 0), cB + kstep, voffB); PG8_STAGE(PG8_SA(1, 0), cA + kstep, voffA); PG8_STAGE(PG8_SB(1, 1), cB + hstep + kstep, voffB);
    PG8_WAIT_V(6); PG8_BAR;
    PG8_STAMP();
    for (;;) {
        const bool has_next = S.next(ui + 1, nxt);
        const char* nA = has_next ? (const char*)g.A + (size_t)nxt.pm * tstep : cA; const char* nB = has_next ? (const char*)g.Bt + (size_t)nxt.pn * tstep : cB;
        for (int t = 0; t < nt; t += 2) {
            const bool last = (t == nt - 2);
            const char* a1 = cA + (size_t)(t + 1) * kstep;
            const char* a2 = last ? nA : cA + (size_t)(t + 2) * kstep; const char* b2 = last ? nB : cB + (size_t)(t + 2) * kstep;
            const char* a3 = a2 + kstep; const char* b3 = b2 + kstep;
            if (last && has_next) S.a_ready(nxt);
            PG8_LDB(B0, 0, 0); PG8_SCHED; PG8_LDA(At, 0, 0); PG8_STAGE(PG8_SA(1, 1), a1 + hstep, voffA);
            PG8_WAIT_L(8); PG8_BAR; PG8_WAIT_L(0); PG8_MMA(0, 0, At, B0); PG8_BAR; PG8_SCHED;
            PG8_LDB(B1, 0, 1); PG8_STAGE(PG8_SB(0, 0), b2, voffB);
            PG8_BAR; PG8_WAIT_L(0); PG8_MMA(0, 1, At, B1); PG8_BAR;
            PG8_LDA(At, 0, 1); PG8_STAGE(PG8_SA(0, 0), a2, voffA);
            PG8_BAR; PG8_WAIT_L(0); PG8_MMA(1, 0, At, B0); PG8_BAR; PG8_SCHED;
            PG8_STAGE(PG8_SB(0, 1), b2 + hstep, voffB);
            PG8_WAIT_V(6); PG8_BAR; PG8_MMA(1, 1, At, B1); PG8_BAR;
            PG8_LDB(B0, 1, 0); PG8_SCHED; PG8_LDA(At, 1, 0); PG8_STAGE(PG8_SA(0, 1), a2 + hstep, voffA);
            PG8_WAIT_L(8); PG8_BAR; PG8_WAIT_L(0); PG8_MMA(0, 0, At, B0); PG8_BAR; PG8_SCHED;
            PG8_LDB(B1, 1, 1); PG8_STAGE(PG8_SB(1, 0), b3, voffB);
            PG8_BAR; PG8_WAIT_L(0); PG8_MMA(0, 1, At, B1); PG8_BAR;
            PG8_LDA(At, 1, 1); PG8_STAGE(PG8_SA(1, 0), a3, voffA);
            PG8_BAR; PG8_WAIT_L(0); PG8_MMA(1, 0, At, B0); PG8_BAR; PG8_SCHED;
            PG8_STAGE(PG8_SB(1, 1), b3 + hstep, voffB);
            PG8_WAIT_V(6); PG8_BAR; PG8_MMA(1, 1, At, B1); PG8_BAR;
        }
        PG8_STAMP();
        if constexpr (!Epi::AFTER_DRAIN) { E(acc, cur, wr, wc, fr, fq); S.done(cur); }
        PG8_STAMP();
        if (!has_next) break;
#pragma unroll
        for (int a = 0; a < 2; ++a)
#pragma unroll
            for (int b = 0; b < 2; ++b)
#pragma unroll
                for (int m = 0; m < 4; ++m)
#pragma unroll
                    for (int n = 0; n < 2; ++n) acc[a][b][m][n] = (f32x4){0.f, 0.f, 0.f, 0.f};
        cur = nxt; cA = nA; cB = nB; ++ui;
    }
    PG8_WAIT_V(0);
    if (wr == 0) PG8_BAR;
    PG8_BAR;
    if constexpr (Epi::AFTER_DRAIN) { E.fused(acc, cur, wr, wc, fr, fq, lds, wid, lane); S.done(cur); }
    PG8_STAMP();
    if (STAMP && wid == 0) { stamps[lane] = lane < nts ? (((unsigned long long)(unsigned)ts_hi << 32) | (unsigned)ts_lo) : 0ull;
        if (lane == 62) stamps[62] = rt_entry; if (lane == 63) stamps[63] = (unsigned long long)wall_clock64(); }
#undef PG8_STAMP
#undef PG8_SA
#undef PG8_SB
#undef PG8_STAGE
#undef PG8_LDA
#undef PG8_LDB
#undef PG8_MMA
#undef PG8_WAIT_V
#undef PG8_WAIT_L
#undef PG8_BAR
#undef PG8_SCHED
}
}


__device__ __forceinline__ u16 f2bf(float f) {
  unsigned u = __float_as_uint(f);
  u += 0x7fffu + ((u >> 16) & 1u);
  return (u16)(u >> 16);
}
__device__ __forceinline__ float bf2f(u16 h) { return __uint_as_float(((unsigned)h) << 16); }
__device__ __forceinline__ unsigned pack2(float a, float b) { return (unsigned)f2bf(a) | ((unsigned)f2bf(b) << 16); }
__device__ __forceinline__ void unpack8(const uint4 v, float (&f)[8]) {
  f[0] = bf2f((u16)(v.x & 0xffff)); f[1] = bf2f((u16)(v.x >> 16)); f[2] = bf2f((u16)(v.y & 0xffff)); f[3] = bf2f((u16)(v.y >> 16));
  f[4] = bf2f((u16)(v.z & 0xffff)); f[5] = bf2f((u16)(v.z >> 16)); f[6] = bf2f((u16)(v.w & 0xffff)); f[7] = bf2f((u16)(v.w >> 16));
}
__device__ __forceinline__ uint4 pack8s(const float (&f)[8], float sc) {
  return make_uint4(pack2(f[0] * sc, f[1] * sc), pack2(f[2] * sc, f[3] * sc), pack2(f[4] * sc, f[5] * sc), pack2(f[6] * sc, f[7] * sc));
}
__device__ __forceinline__ float silu_f(float x) { return x / (1.f + __expf(-x)); }
__device__ __forceinline__ float sigm(float x) { return 1.f / (1.f + __expf(-x)); }
__device__ __forceinline__ float wave_sum(float v) {
#pragma unroll
  for (int o = 32; o; o >>= 1) v += __shfl_xor(v, o);
  return v;
}
__device__ __forceinline__ const float* xin_of(const Params& P, int slab) { return slab == 0 ? P.in[0] : P.in[1] + (long)(slab - 1) * SLAB * D; }
__device__ __forceinline__ int Lof(int slab) { return slab == 0 ? 2048 : 8192; }
__device__ __forceinline__ int gb_row(int gr) { return gr < 16384 ? (gr >> 11) : (8 + ((gr - 16384) >> 13)); }
__device__ __forceinline__ int gb_of(int slab, int r) { return slab == 0 ? (r >> 11) : (8 + (slab - 1) * 2 + (r >> 13)); }

typedef short v4s __attribute__((ext_vector_type(4)));
#define LBAR() asm volatile("s_waitcnt lgkmcnt(0)\n\ts_barrier" ::: "memory")
#define LDS_AS __attribute__((address_space(3)))
template <int R, bool KC>
__device__ __forceinline__ uint4 ld_chunk(const u16* __restrict__ base, long ld, int k0, int c) {
  if (KC) {
    const int r = c >> 3, kc = c & 7;
    return *(const uint4*)(base + (long)r * ld + k0 + kc * 8);
  } else {
    const int k = c / (R / 8), mc = c % (R / 8);
    return *(const uint4*)(base + (long)(k0 + k) * ld + mc * 8);
  }
}
template <int R, bool KC>
__device__ __forceinline__ void st_chunk(u16* s, uint4 v, int c) {
  if (KC) {
    const int r = c >> 3, kc = c & 7;
    *(uint4*)(s + r * 72 + kc * 8) = v;
  } else {
    const int k = c / (R / 8), mc = c % (R / 8);
    *(uint4*)(s + k * (R + 8) + mc * 8) = v;
  }
}
template <int R, bool KC>
__device__ __forceinline__ bf16x8 ld_frag(const u16* s, int x0, int ks, int fr, int fq) {
  if (KC) {
    return *(const bf16x8*)(s + (x0 + fr) * 72 + ks * 32 + fq * 8);
  } else {
    const int q4 = fr >> 2, p4 = fr & 3;
    const u16* p = s + (ks * 32 + 8 * fq + q4) * (R + 8) + x0 + 4 * p4;
    v4s lo = __builtin_amdgcn_ds_read_tr16_b64_v4i16((LDS_AS v4s*)p);
    v4s hi = __builtin_amdgcn_ds_read_tr16_b64_v4i16((LDS_AS v4s*)(p + 4 * (R + 8)));
    bf16x8 r;
    r[0] = lo[0]; r[1] = lo[1]; r[2] = lo[2]; r[3] = lo[3]; r[4] = hi[0]; r[5] = hi[1]; r[6] = hi[2]; r[7] = hi[3];
    return r;
  }
}

template <int TM, int TN, bool AKC, bool BKC, bool TR, int KT>
__device__ __forceinline__ void gemm_acc(f32x4 (&acc)[TM / 32][TN / 64], const u16* __restrict__ A, long lda,
                                         const u16* __restrict__ B, long ldb, u16* sm) {
  u16* As = sm;
  u16* Bs = sm + 9216;
  const int tid = TID(), lane = tid & 63, wid = tid >> 6;
  const int wm = wid >> 2, wn = wid & 3, fr = lane & 15, fq = lane >> 4;
  constexpr int MI = TM / 32, NI = TN / 64;
  uint4 ra0[KT], ra1[KT], rb0[KT], rb1[KT];
#pragma unroll
  for (int kt = 0; kt < KT; ++kt) {
    ra0[kt] = ld_chunk<TM, AKC>(A, lda, kt * 64, tid);
    ra1[kt] = ra0[kt];
    if (TM == 128) ra1[kt] = ld_chunk<TM, AKC>(A, lda, kt * 64, tid + NT);
    rb0[kt] = ld_chunk<TN, BKC>(B, ldb, kt * 64, tid);
    rb1[kt] = rb0[kt];
    if (TN == 128) rb1[kt] = ld_chunk<TN, BKC>(B, ldb, kt * 64, tid + NT);
  }
#pragma unroll
  for (int kt = 0; kt < KT; ++kt) {
    __syncthreads();
    st_chunk<TM, AKC>(As, ra0[kt], tid);
    if (TM == 128) st_chunk<TM, AKC>(As, ra1[kt], tid + NT);
    st_chunk<TN, BKC>(Bs, rb0[kt], tid);
    if (TN == 128) st_chunk<TN, BKC>(Bs, rb1[kt], tid + NT);
    __syncthreads();
#pragma unroll
    for (int ks = 0; ks < 2; ++ks) {
      bf16x8 af[MI], bfr[NI];
#pragma unroll
      for (int mi = 0; mi < MI; ++mi) af[mi] = ld_frag<TM, AKC>(As, wm * (TM / 2) + mi * 16, ks, fr, fq);
#pragma unroll
      for (int ni = 0; ni < NI; ++ni) bfr[ni] = ld_frag<TN, BKC>(Bs, wn * (TN / 4) + ni * 16, ks, fr, fq);
#pragma unroll
      for (int mi = 0; mi < MI; ++mi)
#pragma unroll
        for (int ni = 0; ni < NI; ++ni)
          acc[mi][ni] = TR ? __builtin_amdgcn_mfma_f32_16x16x32_bf16(bfr[ni], af[mi], acc[mi][ni], 0, 0, 0)
                           : __builtin_amdgcn_mfma_f32_16x16x32_bf16(af[mi], bfr[ni], acc[mi][ni], 0, 0, 0);
    }
  }
  __syncthreads();
}

template <int KT> struct Tiles { uint4 a0[KT], a1[KT], b0[KT], b1[KT]; };
template <int TM, int TN, bool AKC, bool BKC, int KT>
__device__ __forceinline__ void tiles_issue(Tiles<KT>& t, const u16* __restrict__ A, long lda, const u16* __restrict__ B, long ldb) {
  const int tid = TID();
#pragma unroll
  for (int kt = 0; kt < KT; ++kt) {
    t.a0[kt] = ld_chunk<TM, AKC>(A, lda, kt * 64, tid);
    t.a1[kt] = t.a0[kt];
    if (TM == 128) t.a1[kt] = ld_chunk<TM, AKC>(A, lda, kt * 64, tid + NT);
    t.b0[kt] = ld_chunk<TN, BKC>(B, ldb, kt * 64, tid);
    t.b1[kt] = t.b0[kt];
    if (TN == 128) t.b1[kt] = ld_chunk<TN, BKC>(B, ldb, kt * 64, tid + NT);
  }
}
template <int TM, int TN, bool AKC, bool BKC, bool TR, int KT>
__device__ __forceinline__ void gemm_run(f32x4 (&acc)[TM / 32][TN / 64], const Tiles<KT>& t, u16* sm) {
  u16* As = sm;
  u16* Bs = sm + 9216;
  const int tid = TID(), lane = tid & 63, wid = tid >> 6;
  const int wm = wid >> 2, wn = wid & 3, fr = lane & 15, fq = lane >> 4;
  constexpr int MI = TM / 32, NI = TN / 64;
#pragma unroll
  for (int kt = 0; kt < KT; ++kt) {
    __syncthreads();
    st_chunk<TM, AKC>(As, t.a0[kt], tid);
    if (TM == 128) st_chunk<TM, AKC>(As, t.a1[kt], tid + NT);
    st_chunk<TN, BKC>(Bs, t.b0[kt], tid);
    if (TN == 128) st_chunk<TN, BKC>(Bs, t.b1[kt], tid + NT);
    __syncthreads();
#pragma unroll
    for (int ks = 0; ks < 2; ++ks) {
      bf16x8 af[MI], bfr[NI];
#pragma unroll
      for (int mi = 0; mi < MI; ++mi) af[mi] = ld_frag<TM, AKC>(As, wm * (TM / 2) + mi * 16, ks, fr, fq);
#pragma unroll
      for (int ni = 0; ni < NI; ++ni) bfr[ni] = ld_frag<TN, BKC>(Bs, wn * (TN / 4) + ni * 16, ks, fr, fq);
#pragma unroll
      for (int mi = 0; mi < MI; ++mi)
#pragma unroll
        for (int ni = 0; ni < NI; ++ni)
          acc[mi][ni] = TR ? __builtin_amdgcn_mfma_f32_16x16x32_bf16(bfr[ni], af[mi], acc[mi][ni], 0, 0, 0)
                           : __builtin_amdgcn_mfma_f32_16x16x32_bf16(af[mi], bfr[ni], acc[mi][ni], 0, 0, 0);
    }
  }
}

template <int TM, int TN, bool TR, class F>
__device__ __forceinline__ void epi_each(f32x4 (&acc)[TM / 32][TN / 64], F f) {
  const int tid = TID(), lane = tid & 63, wid = tid >> 6;
  const int wm = wid >> 2, wn = wid & 3, fr = lane & 15, fq = lane >> 4;
#pragma unroll
  for (int mi = 0; mi < TM / 32; ++mi)
#pragma unroll
    for (int ni = 0; ni < TN / 64; ++ni) {
      const int r0 = wm * (TM / 2) + mi * 16, c0 = wn * (TN / 4) + ni * 16;
      if (TR) f(r0 + fr, c0 + fq * 4, acc[mi][ni]);
      else f(r0 + fq * 4, c0 + fr, acc[mi][ni]);
    }
}

struct EpiStoreBf16 {
  static constexpr bool PERM = true, AFTER_DRAIN = false;
  u16* O; int ldc;
  __device__ __forceinline__ void operator()(const f32x4 (&acc)[2][2][4][2], const pg8::Unit& u, int wr, int wc, int fr, int fq) const {
    const int row0 = u.pm * 256 + wr * 64 + fr, col0 = u.pn * 256 + wc * 32 + 8 * fq;
#pragma unroll
    for (int ai = 0; ai < 2; ++ai)
#pragma unroll
      for (int m = 0; m < 4; ++m) {
        u16* rowp = O + (size_t)(row0 + ai * 128 + m * 16) * ldc + col0;
#pragma unroll
        for (int bj = 0; bj < 2; ++bj) {
          const f32x4 v0 = acc[ai][bj][m][0], v1 = acc[ai][bj][m][1];
          *(uint4*)(rowp + bj * 128) = make_uint4(pack2(v0[0], v0[1]), pack2(v0[2], v0[3]), pack2(v1[0], v1[1]), pack2(v1[2], v1[3]));
        }
      }
  }
};
struct EpiResid {
  static constexpr bool PERM = false, AFTER_DRAIN = false;
  float* X; const float* XS; const float* mod; int goff; int grow0;
  __device__ __forceinline__ void operator()(const f32x4 (&acc)[2][2][4][2], const pg8::Unit& u, int wr, int wc, int fr, int fq) const {
    const int row0 = u.pm * 256 + wr * 64 + fr, col0 = u.pn * 256 + wc * 32 + 4 * fq;
    const float* g = mod + (size_t)gb_row(grow0 + u.pm * 256) * 6144 + goff + col0;
    f32x4 gv[2][2];
#pragma unroll
    for (int bj = 0; bj < 2; ++bj)
#pragma unroll
      for (int n = 0; n < 2; ++n) gv[bj][n] = *(const f32x4*)(g + bj * 128 + n * 16);
#pragma unroll
    for (int am = 0; am < 4; ++am) {
      f32x4 xv[2][2][2];
#pragma unroll
      for (int mm = 0; mm < 2; ++mm)
#pragma unroll
        for (int bj = 0; bj < 2; ++bj)
#pragma unroll
          for (int n = 0; n < 2; ++n) xv[mm][bj][n] = *(const f32x4*)(XS + (size_t)(row0 + (am >> 1) * 128 + ((am & 1) * 2 + mm) * 16) * D + col0 + bj * 128 + n * 16);
#pragma unroll
      for (int mm = 0; mm < 2; ++mm)
#pragma unroll
        for (int bj = 0; bj < 2; ++bj)
#pragma unroll
          for (int n = 0; n < 2; ++n)
            *(f32x4*)(X + (size_t)(row0 + (am >> 1) * 128 + ((am & 1) * 2 + mm) * 16) * D + col0 + bj * 128 + n * 16) = xv[mm][bj][n] + gv[bj][n] * acc[am >> 1][bj][(am & 1) * 2 + mm][n];
    }
  }
};
struct EpiFfnVal {
  static constexpr bool PERM = false, AFTER_DRAIN = false;
  const u16* G; u16* ACT; const float* cw; const float* cb; int grow0;
  __device__ __forceinline__ void operator()(const f32x4 (&acc)[2][2][4][2], const pg8::Unit& u, int wr, int wc, int fr, int fq) const {
    const int row0 = u.pm * 256 + wr * 64 + fr, col0 = u.pn * 256 + wc * 32 + 4 * fq;
#pragma unroll
    for (int bj = 0; bj < 2; ++bj)
#pragma unroll
      for (int n = 0; n < 2; ++n) {
        const int c = col0 + bj * 128 + n * 16;
        const f32x4 w0 = *(const f32x4*)(cw + c), w1 = *(const f32x4*)(cw + DFF + c), w2 = *(const f32x4*)(cw + 2 * DFF + c), bb = *(const f32x4*)(cb + c);
#pragma unroll
        for (int ai = 0; ai < 2; ++ai) {
          uint2 g0[4], g1[4], g2[4];
#pragma unroll
          for (int m = 0; m < 4; ++m) {
            const int r = row0 + ai * 128 + m * 16;
            const int L = (grow0 + r) < 16384 ? 2048 : 8192;
            const int pos = (grow0 + r) & (L - 1);
            const u16* gp = G + (size_t)r * DFF + c;
            g1[m] = *(const uint2*)gp;
            g0[m] = *(const uint2*)(gp - (pos > 0 ? DFF : 0));
            g2[m] = *(const uint2*)(gp + (pos < L - 1 ? DFF : 0));
          }
#pragma unroll
          for (int m = 0; m < 4; ++m) {
            const int r = row0 + ai * 128 + m * 16;
            const int L = (grow0 + r) < 16384 ? 2048 : 8192;
            const int pos = (grow0 + r) & (L - 1);
            const float m0 = pos > 0 ? 1.f : 0.f, m2 = pos < L - 1 ? 1.f : 0.f;
            const uint2 a0 = g0[m], a1 = g1[m], a2 = g2[m];
            f32x4 a;
            a[0] = m0 * bf2f((u16)(a0.x & 0xffff)) * w0[0] + bf2f((u16)(a1.x & 0xffff)) * w1[0] + m2 * bf2f((u16)(a2.x & 0xffff)) * w2[0] + bb[0];
            a[1] = m0 * bf2f((u16)(a0.x >> 16)) * w0[1] + bf2f((u16)(a1.x >> 16)) * w1[1] + m2 * bf2f((u16)(a2.x >> 16)) * w2[1] + bb[1];
            a[2] = m0 * bf2f((u16)(a0.y & 0xffff)) * w0[2] + bf2f((u16)(a1.y & 0xffff)) * w1[2] + m2 * bf2f((u16)(a2.y & 0xffff)) * w2[2] + bb[2];
            a[3] = m0 * bf2f((u16)(a0.y >> 16)) * w0[3] + bf2f((u16)(a1.y >> 16)) * w1[3] + m2 * bf2f((u16)(a2.y >> 16)) * w2[3] + bb[3];
            const f32x4 v = acc[ai][bj][m][n];
            *(uint2*)(ACT + (size_t)r * DFF + c) = make_uint2(pack2(silu_f(a[0]) * v[0], silu_f(a[1]) * v[1]), pack2(silu_f(a[2]) * v[2], silu_f(a[3]) * v[3]));
          }
        }
      }
  }
};
template <class Epi>
__device__ __forceinline__ void run_gemm(const u16* A, const u16* Bt, int M, int N, int K, const Epi& E) {
  pg8::Gemm g; g.A = A; g.Bt = Bt; g.M = M; g.N = N; g.K = K;
  pg8::StaticOrder S; S.init(M, N, gridDim.x, BID());
  __syncthreads();
  pg8::gemm_phase<Epi, pg8::StaticOrder, false>((PG8_LAS unsigned char*)smem, g, S, E, nullptr);
  __syncthreads();
}

__device__ __forceinline__ int fidx(int p) { return p + ((p >> 6) << 2); }
__device__ __forceinline__ float2 cmulf(float2 a, float2 b) { return make_float2(a.x * b.x - a.y * b.y, a.x * b.y + a.y * b.x); }
__device__ __forceinline__ float2 cmulcf(float2 a, float2 b) { return make_float2(a.x * b.x + a.y * b.y, a.y * b.x - a.x * b.y); }
#define R16C(q) ((q) == 0 ? 1.f : (q) == 1 ? 0.9238795325f : (q) == 2 ? 0.7071067812f : (q) == 3 ? 0.3826834324f : (q) == 4 ? 0.f : (q) == 5 ? -0.3826834324f : (q) == 6 ? -0.7071067812f : -0.9238795325f)
#define R16S(q) ((q) == 0 ? 0.f : (q) == 1 ? -0.3826834324f : (q) == 2 ? -0.7071067812f : (q) == 3 ? -0.9238795325f : (q) == 4 ? -1.f : (q) == 5 ? -0.9238795325f : (q) == 6 ? -0.7071067812f : -0.3826834324f)
template <int N, int RS, bool INV>
__device__ __forceinline__ void fft_pass(float2* x, const float2* __restrict__ tw, const int S, const int tid) {
  constexpr int R = 1 << RS;
  const int E = S >> (RS - 1);
#pragma unroll 1
  for (int g = tid; g < N / R; g += NT) {
    const int blo = g & (E - 1);
    const int base = ((g - blo) << RS) + blo;
    float2 e[R];
#pragma unroll
    for (int k = 0; k < R; ++k) e[k] = x[fidx(base + k * E)];
    float2 wb[RS];
#pragma unroll
    for (int st = 0; st < RS; ++st) wb[st] = tw[blo * (8192 / (S >> st))];
#pragma unroll
    for (int sq = 0; sq < RS; ++sq) {
      const int st = INV ? (RS - 1 - sq) : sq;
      const int h = (R / 2) >> st;
#pragma unroll
      for (int k = 0; k < R; ++k) {
        if ((k & h) == 0) {
          const int m = k & (h - 1);
          const int q = m * (8 / h);
          float2 w = wb[st];
          if (q != 0) w = cmulf(w, make_float2(R16C(q), R16S(q)));
          if (!INV) {
            const float2 a = e[k], b = e[k + h];
            e[k] = make_float2(a.x + b.x, a.y + b.y);
            e[k + h] = cmulf(make_float2(a.x - b.x, a.y - b.y), w);
          } else {
            const float2 a = e[k], b = cmulcf(e[k + h], w);
            e[k] = make_float2(a.x + b.x, a.y + b.y);
            e[k + h] = make_float2(a.x - b.x, a.y - b.y);
          }
        }
      }
    }
#pragma unroll
    for (int k = 0; k < R; ++k) x[fidx(base + k * E)] = e[k];
  }
  __syncthreads();
}
template <int N>
__device__ __forceinline__ void fft_dif_t(float2* x, const float2* __restrict__ tw) {
  const int tid = TID();
  if (N == 16384) {
    fft_pass<N, 4, false>(x, tw, 8192, tid); fft_pass<N, 4, false>(x, tw, 512, tid);
    fft_pass<N, 4, false>(x, tw, 32, tid); fft_pass<N, 2, false>(x, tw, 2, tid);
  } else {
    fft_pass<N, 4, false>(x, tw, 2048, tid); fft_pass<N, 4, false>(x, tw, 128, tid); fft_pass<N, 4, false>(x, tw, 8, tid);
  }
}
template <int N>
__device__ __forceinline__ void ifft_dit_t(float2* x, const float2* __restrict__ tw) {
  const int tid = TID();
  if (N == 16384) {
    fft_pass<N, 2, true>(x, tw, 2, tid); fft_pass<N, 4, true>(x, tw, 32, tid);
    fft_pass<N, 4, true>(x, tw, 512, tid); fft_pass<N, 4, true>(x, tw, 8192, tid);
  } else {
    fft_pass<N, 4, true>(x, tw, 8, tid); fft_pass<N, 4, true>(x, tw, 128, tid); fft_pass<N, 4, true>(x, tw, 2048, tid);
  }
}
__device__ __forceinline__ void fft_dif(float2* x, int N, const float2* __restrict__ tw) {
  if (N == 16384) fft_dif_t<16384>(x, tw); else fft_dif_t<4096>(x, tw);
}
__device__ __forceinline__ void ifft_dit(float2* x, int N, const float2* __restrict__ tw) {
  if (N == 16384) ifft_dit_t<16384>(x, tw); else ifft_dit_t<4096>(x, tw);
}

__device__ void transpose_w(const float* __restrict__ W, u16* __restrict__ Wt, int K, int N) {
  float* smf = (float*)smem;
  const int tk = K / 64, tn = N / 64, tid = TID(), G = gridDim.x;
  const int kk0 = tid >> 4, n40 = tid & 15, kk1 = (tid + NT) >> 4, n41 = (tid + NT) & 15;
  int item = BID();
  float4 v0 = make_float4(0, 0, 0, 0), v1 = v0;
  if (item < tk * tn) {
    const int k0 = (item / tn) * 64, n0 = (item % tn) * 64;
    v0 = *(const float4*)(W + (long)(k0 + kk0) * N + n0 + n40 * 4);
    v1 = *(const float4*)(W + (long)(k0 + kk1) * N + n0 + n41 * 4);
  }
  for (; item < tk * tn; item += G) {
    const int k0 = (item / tn) * 64, n0 = (item % tn) * 64;
    float4 w0 = v0, w1 = v1;
    const int nx = item + G;
    if (nx < tk * tn) {
      const int k2 = (nx / tn) * 64, n2 = (nx % tn) * 64;
      w0 = *(const float4*)(W + (long)(k2 + kk0) * N + n2 + n40 * 4);
      w1 = *(const float4*)(W + (long)(k2 + kk1) * N + n2 + n41 * 4);
    }
    __syncthreads();
    { float* p = smf + kk0 * 65 + n40 * 4; p[0] = v0.x; p[1] = v0.y; p[2] = v0.z; p[3] = v0.w; }
    { float* p = smf + kk1 * 65 + n41 * 4; p[0] = v1.x; p[1] = v1.y; p[2] = v1.z; p[3] = v1.w; }
    __syncthreads();
    const int nn = tid >> 3, k8 = tid & 7;
    float f[8];
#pragma unroll
    for (int i = 0; i < 8; ++i) f[i] = smf[(k8 * 8 + i) * 65 + nn];
    *(uint4*)(Wt + (long)(n0 + nn) * K + k0 + k8 * 8) = pack8s(f, 1.f);
    v0 = w0; v1 = w1;
  }
  __syncthreads();
}

__device__ void phase_pre0(const Params& P) {
  const int tid = TID();
  const long gtid = (long)BID() * NT + tid, gsz = (long)gridDim.x * NT;
  transpose_w(P.in[7], (u16*)(WS(P) + O_WHYIN), 1024, 3072);
  transpose_w(P.in[18], (u16*)(WS(P) + O_WHYOUT), 1024, 1024);
  transpose_w(P.in[19], (u16*)(WS(P) + O_WRETIN), 1024, 6144);
  transpose_w(P.in[21], (u16*)(WS(P) + O_WRETOUT), 2048, 1024);
  transpose_w(P.in[22], (u16*)(WS(P) + O_WSWAIN), 1024, 1536);
  transpose_w(P.in[26], (u16*)(WS(P) + O_WSWAOUT), 1024, 1024);
  transpose_w(P.in[27], (u16*)(WS(P) + O_WHGIN), 1024, 5120);
  transpose_w(P.in[30], (u16*)(WS(P) + O_WHGOUT), 1024, 1024);
  for (int l = 0; l < 4; ++l) {
    transpose_w(P.in[31] + (long)l * 1024 * DFF, (u16*)(WS(P) + O_WFG) + (long)l * DFF * 1024, 1024, DFF);
    transpose_w(P.in[32] + (long)l * 1024 * DFF, (u16*)(WS(P) + O_WFV) + (long)l * DFF * 1024, 1024, DFF);
    transpose_w(P.in[35] + (long)l * DFF * 1024, (u16*)(WS(P) + O_WFD) + (long)l * 1024 * DFF, DFF, 1024);
  }
  {
    float* cs = (float*)smem;
    float* modp = (float*)(WS(P) + O_MODP);
    for (int item = BID(); item < 4 * 8 * 12; item += gridDim.x) {
      const int nb = item % 12, ks = (item / 12) % 8, l = item / 96;
      __syncthreads();
      for (int i = tid; i < 2048; i += NT) {
        int b = i >> 7, k = i & 127;
        float c = (b < 8) ? P.in[2][b * 1024 + ks * 128 + k] : P.in[3][(b - 8) * 1024 + ks * 128 + k];
        cs[i] = c / (1.f + expf(-c));
      }
      __syncthreads();
      const int n = nb * 512 + tid;
      float a[16];
#pragma unroll
      for (int b = 0; b < 16; ++b) a[b] = 0.f;
      const float* w = P.in[4] + ((long)l * 1024 + ks * 128) * 6144 + n;
      for (int k = 0; k < 128; ++k) {
        float wv = w[(long)k * 6144];
#pragma unroll
        for (int b = 0; b < 16; ++b) a[b] += cs[b * 128 + k] * wv;
      }
#pragma unroll
      for (int b = 0; b < 16; ++b) modp[(((long)ks * 4 + l) * 16 + b) * 6144 + n] = a[b];
    }
    __syncthreads();
  }
  {
    float2* tw = (float2*)(WS(P) + O_TW);
    for (long i = gtid; i < 8192; i += gsz) {
      float s, c;
      sincospif((float)i * (1.f / 8192.f), &s, &c);
      tw[i] = make_float2(c, -s);
    }
    float2* rr = (float2*)(WS(P) + O_ROPER);
    for (long i = gtid; i < (long)8192 * 128; i += gsz) {
      int pos = (int)(i >> 7), d = (int)(i & 127);
      float inv = exp2f(-(float)d * (13.287712379549449f / 128.f));
      float s, c;
      sincosf((float)pos * inv, &s, &c);
      rr[i] = make_float2(c, s);
    }
    float2* rs = (float2*)(WS(P) + O_ROPES);
    for (long i = gtid; i < (long)8192 * 32; i += gsz) {
      int pos = (int)(i >> 5), d = (int)(i & 31);
      float inv = exp2f(-(float)d * (13.287712379549449f / 32.f));
      float s, c;
      sincosf((float)pos * inv, &s, &c);
      rs[i] = make_float2(c, s);
    }
  }
  {
    float* zf = (float*)smem;
    float* h1 = zf + 8 * 36;
    const float* w1 = P.in[10]; const float* b1 = P.in[11]; const float* w2 = P.in[12]; const float* b2 = P.in[13];
    const float* fr = P.in[15];
    const int tl = tid >> 6, j = tid & 63;
    for (int item = BID(); item < 1280; item += gridDim.x) {
      const int sel = item >= 1024;
      const int L = sel ? 2048 : 8192;
      const int t = (sel ? item - 1024 : item) * 8 + tl;
      float* hid = (float*)(WS(P) + (sel ? O_HIDP : O_HIDS));
      __syncthreads();
      if (j < 33) {
        float v;
        if (j == 0) v = (float)t / (float)(L - 1);
        else {
          int i = (j - 1) & 15;
          float band = 1e-4f + (float)i * ((15.f - 1e-4f) / 15.f);
          float ang = (6.283185307179586f / (float)L) * (float)t;
          float a = band * ang;
          v = (j <= 16) ? cosf(a) : -sinf(a);
        }
        zf[tl * 36 + j] = v;
      }
      __syncthreads();
      float s = b1[j];
#pragma unroll 3
      for (int i = 0; i < 33; ++i) s += zf[tl * 36 + i] * w1[i * 64 + j];
      h1[tl * 64 + j] = sinf(fr[j] * s);
      __syncthreads();
      float s2 = b2[j];
#pragma unroll 4
      for (int i = 0; i < 64; ++i) s2 += h1[tl * 64 + i] * w2[i * 64 + j];
      hid[(long)j * L + t] = sinf(fr[j] * s2);
    }
    __syncthreads();
  }
}

__device__ void phase_pre1(const Params& P) {
  __shared__ float w3s[128];
  __shared__ float red[8];
  const int tid = TID(), lane = tid & 63, wid = tid >> 6;
  const long gtid = (long)BID() * NT + tid, gsz = (long)gridDim.x * NT;
  {
    const float* modp = (const float*)(WS(P) + O_MODP);
    float* mod = (float*)(WS(P) + O_MOD);
    for (long i = gtid; i < (long)4 * 16 * 6144; i += gsz) {
      int n = (int)(i % 6144);
      int l = (int)(i / (16 * 6144));
      float s = P.in[5][l * 6144 + n];
      for (int ks = 0; ks < 8; ++ks) s += modp[(long)ks * 4 * 16 * 6144 + i];
      mod[i] = s;
    }
  }
  float2* buf = (float2*)smem;
  const float2* tw = (const float2*)(WS(P) + O_TW);
  for (int item = BID(); item < 2048; item += gridDim.x) {
    const int sel = item >> 10, c = item & 1023;
    const int L = sel ? 2048 : 8192, N = 2 * L;
    const float* hid = (const float*)(WS(P) + (sel ? O_HIDP : O_HIDS));
    float2* hs = (float2*)(WS(P) + (sel ? O_HSPP : O_HSPS)) + (long)c * N;
    __syncthreads();
    if (tid < 128) {
      int dirn = tid >> 6, j = tid & 63;
      w3s[tid] = P.in[14][(long)j * 2048 + dirn * 1024 + c];
    }
    __syncthreads();
    const float dec0 = fabsf(P.in[16][c]), dec1 = fabsf(P.in[16][1024 + c]);
    const float invLm1 = 1.f / (float)(L - 1);
    float asum = 0.f;
    for (int n = tid; n < N; n += NT) {
      float val = 0.f;
      if (n != L) {
        const int dirn = n < L ? 0 : 1;
        const int t = n < L ? n : N - n;
        const float* hp = hid + t;
        const float* w = w3s + dirn * 64;
        float s = 0.f;
#pragma unroll 16
        for (int j = 0; j < 64; ++j) s += hp[(long)j * L] * w[j];
        float tl = (float)t * invLm1;
        val = s * expf(-tl * (dirn ? dec1 : dec0));
      }
      buf[fidx(n)] = make_float2(val, 0.f);
      asum += fabsf(val);
    }
    asum = wave_sum(asum);
    if (lane == 0) red[wid] = asum;
    __syncthreads();
    float tot = 0.f;
#pragma unroll
    for (int w = 0; w < 8; ++w) tot += red[w];
    const float scale = 1.f / (tot * (float)N);
    fft_dif(buf, N, tw);
    for (int p = tid; p < N; p += NT) {
      float2 a = buf[fidx(p)];
      hs[p] = make_float2(a.x * scale, a.y * scale);
    }
  }
  __syncthreads();
}

__device__ void phase_norm(const Params& P, int layer, int sl, int which) {
  const int grow0 = which == 1 ? sl * FSLAB : (which == 2 ? 0 : sl * SLAB), nrows = which == 1 ? FSLAB : (which == 2 ? NTOK : SLAB);
  const float* __restrict__ x = (layer == 0 && which == 0) ? xin_of(P, sl) : (const float*)(OUTP(P) + (long)grow0 * D);
  u16* __restrict__ h = (u16*)(WS(P) + (which == 1 ? O_FHBUF : (which == 2 ? O_SA_H : O_HBUF)));
  const float* gain = P.in[6] + (layer * 2 + (which == 1 ? 1 : 0)) * D;
  const float* mod = (const float*)(WS(P) + O_MOD) + (long)layer * 16 * 6144;
  const int shoff = which == 1 ? 3 * D : 0, scoff = which == 1 ? 4 * D : D;
  const int tid = TID(), lane = tid & 63, wid = tid >> 6;
  for (int item = BID(); item < nrows / 32; item += gridDim.x) {
    const int r0 = item * 32 + wid * 4;
    float4 v[4][4];
    float ss[4];
#pragma unroll
    for (int u = 0; u < 4; ++u) {
      const float* xr = x + (long)(r0 + u) * D;
      float a = 0.f;
#pragma unroll
      for (int i = 0; i < 4; ++i) {
        v[u][i] = *(const float4*)(xr + i * 256 + lane * 4);
        a += v[u][i].x * v[u][i].x + v[u][i].y * v[u][i].y + v[u][i].z * v[u][i].z + v[u][i].w * v[u][i].w;
      }
      ss[u] = a;
    }
    const float* m = mod + (long)gb_row(grow0 + r0) * 6144;
#pragma unroll
    for (int u = 0; u < 4; ++u) ss[u] = wave_sum(ss[u]);
#pragma unroll
    for (int i = 0; i < 4; ++i) {
      const int col = i * 256 + lane * 4;
      const float4 g = *(const float4*)(gain + col);
      const float4 sc = *(const float4*)(m + scoff + col);
      const float4 sh = *(const float4*)(m + shoff + col);
      const float a0 = g.x * (1.f + sc.x), a1 = g.y * (1.f + sc.y), a2 = g.z * (1.f + sc.z), a3 = g.w * (1.f + sc.w);
#pragma unroll
      for (int u = 0; u < 4; ++u) {
        const float rstd = rsqrtf(ss[u] * (1.f / 1024.f) + 1e-6f);
        const float y0 = v[u][i].x * rstd * a0 + sh.x, y1 = v[u][i].y * rstd * a1 + sh.y;
        const float y2 = v[u][i].z * rstd * a2 + sh.z, y3 = v[u][i].w * rstd * a3 + sh.w;
        *(uint2*)(h + (long)(r0 + u) * D + col) = make_uint2(pack2(y0, y1), pack2(y2, y3));
      }
    }
  }
}

__device__ void phase_proj(const Params& P, size_t woff, int N) {
  EpiStoreBf16 E; E.O = (u16*)(WS(P) + O_PROJ); E.ldc = N;
  run_gemm((const u16*)(WS(P) + O_HBUF), (const u16*)(WS(P) + woff), SLAB, N, D, E);
}
__device__ void phase_resid(const Params& P, int layer, int slab, const u16* A, int K, size_t woff, int goff) {
  EpiResid E; E.X = OUTP(P) + (long)slab * SLAB * D; E.XS = (layer == 0) ? xin_of(P, slab) : (const float*)E.X; E.mod = (const float*)(WS(P) + O_MOD) + (long)layer * 16 * 6144; E.goff = goff; E.grow0 = slab * SLAB;
  run_gemm(A, (const u16*)(WS(P) + woff), SLAB, D, K, E);
}

__device__ void phase_ffn_gate(const Params& P, int layer) {
  EpiStoreBf16 E; E.O = (u16*)(WS(P) + O_FGBUF); E.ldc = DFF;
  run_gemm((const u16*)(WS(P) + O_FHBUF), (const u16*)(WS(P) + O_WFG) + (long)layer * DFF * D, FSLAB, DFF, D, E);
}
__device__ void phase_ffn_val(const Params& P, int layer, int fs) {
  EpiFfnVal E; E.G = (const u16*)(WS(P) + O_FGBUF); E.ACT = (u16*)(WS(P) + O_FACT) + (long)fs * FSLAB * DFF;
  E.cw = P.in[33] + (long)layer * 3 * DFF; E.cb = P.in[34] + (long)layer * DFF; E.grow0 = fs * FSLAB;
  run_gemm((const u16*)(WS(P) + O_FHBUF), (const u16*)(WS(P) + O_WFV) + (long)layer * DFF * D, FSLAB, DFF, D, E);
}
__device__ void phase_ffn_down(const Params& P, int layer) {
  EpiResid E; E.X = OUTP(P); E.XS = E.X; E.mod = (const float*)(WS(P) + O_MOD) + (long)layer * 16 * 6144; E.goff = 5 * D; E.grow0 = 0;
  run_gemm((const u16*)(WS(P) + O_FACT), (const u16*)(WS(P) + O_WFD) + (long)layer * D * DFF, NTOK, D, DFF, E);
}

__device__ void phase_hy_conv(const Params& P, int slab) {
  const int L = Lof(slab), nseq = SLAB / L, tid = TID();
  const u16* __restrict__ z = (const u16*)(WS(P) + O_PROJ);
  float* __restrict__ uT = (float*)(WS(P) + O_UT);
  u16* __restrict__ x0c = (u16*)(WS(P) + O_X0C);
  const float* cw = P.in[8];
  const float* cb = P.in[9];
  float* tile = (float*)smem;
  const int ntt = L / 64;
  const int nitems = nseq * ntt * 16;
  const int tl = tid >> 3, cg = tid & 7;
  for (int item = BID(); item < nitems; item += gridDim.x) {
    const int ct = item % 16, tt = (item / 16) % ntt, seq = item / (16 * ntt);
    const int t = tt * 64 + tl, c0 = ct * 64 + cg * 8;
    const long row = (long)seq * L + t;
    const float mp = t > 0 ? 1.f : 0.f, mn = t < L - 1 ? 1.f : 0.f;
    const long rp = t > 0 ? row - 1 : row, rn = t < L - 1 ? row + 1 : row;
    float val[3][8];
#pragma unroll
    for (int q = 0; q < 3; ++q) {
      const int col = q * 1024 + c0;
      float a[8], b[8], c[8];
      unpack8(*(const uint4*)(z + rp * 3072 + col), a);
      unpack8(*(const uint4*)(z + row * 3072 + col), b);
      unpack8(*(const uint4*)(z + rn * 3072 + col), c);
      const float4 w0a = *(const float4*)(cw + col), w0b = *(const float4*)(cw + col + 4);
      const float4 w1a = *(const float4*)(cw + 3072 + col), w1b = *(const float4*)(cw + 3072 + col + 4);
      const float4 w2a = *(const float4*)(cw + 6144 + col), w2b = *(const float4*)(cw + 6144 + col + 4);
      const float4 ba = *(const float4*)(cb + col), bb = *(const float4*)(cb + col + 4);
      const float w0[8] = {w0a.x, w0a.y, w0a.z, w0a.w, w0b.x, w0b.y, w0b.z, w0b.w};
      const float w1[8] = {w1a.x, w1a.y, w1a.z, w1a.w, w1b.x, w1b.y, w1b.z, w1b.w};
      const float w2[8] = {w2a.x, w2a.y, w2a.z, w2a.w, w2b.x, w2b.y, w2b.z, w2b.w};
      const float bs[8] = {ba.x, ba.y, ba.z, ba.w, bb.x, bb.y, bb.z, bb.w};
#pragma unroll
      for (int i = 0; i < 8; ++i) val[q][i] = mp * a[i] * w0[i] + b[i] * w1[i] + mn * c[i] * w2[i] + bs[i];
    }
    *(uint4*)(x0c + row * 1024 + c0) = pack8s(val[0], 1.f);
    __syncthreads();
#pragma unroll
    for (int i = 0; i < 8; ++i) tile[tl * 65 + cg * 8 + i] = val[1][i] * val[2][i];
    __syncthreads();
    {
      const int cl = tid >> 3, tq = tid & 7;
      float* dst = uT + ((long)seq * 1024 + ct * 64 + cl) * L + tt * 64 + tq * 8;
      float4 o0, o1;
      o0.x = tile[(tq * 8 + 0) * 65 + cl]; o0.y = tile[(tq * 8 + 1) * 65 + cl]; o0.z = tile[(tq * 8 + 2) * 65 + cl]; o0.w = tile[(tq * 8 + 3) * 65 + cl];
      o1.x = tile[(tq * 8 + 4) * 65 + cl]; o1.y = tile[(tq * 8 + 5) * 65 + cl]; o1.z = tile[(tq * 8 + 6) * 65 + cl]; o1.w = tile[(tq * 8 + 7) * 65 + cl];
      *(float4*)dst = o0; *(float4*)(dst + 4) = o1;
    }
  }
  __syncthreads();
}

__device__ void phase_hy_fft(const Params& P, int slab, bool dry = false) {
  const int L = Lof(slab), N = 2 * L, nseq = SLAB / L, tid = TID();
  float* uT = (float*)(WS(P) + O_UT);
  const float2* hsb = (const float2*)(WS(P) + (slab == 0 ? O_HSPP : O_HSPS));
  const float2* tw = (const float2*)(WS(P) + O_TW);
  const float* skip = P.in[17];
  float2* buf = (float2*)smem;
  const int nitems = (nseq / 2) * 1024;
  for (int item = BID(); item < nitems; item += gridDim.x) {
    const int pr = item >> 10, c = item & 1023;
    float* u0 = uT + ((long)(pr * 2) * 1024 + c) * L;
    float* u1 = u0 + (long)1024 * L;
    __syncthreads();
    for (int t = tid; t < L; t += NT) {
      buf[fidx(t)] = make_float2(u0[t], u1[t]);
      buf[fidx(t + L)] = make_float2(0.f, 0.f);
    }
    __syncthreads();
    fft_dif(buf, N, tw);
    const float2* h = hsb + (long)c * N;
    for (int p = tid; p < N; p += NT) {
      float2 a = buf[fidx(p)], b = h[p];
      buf[fidx(p)] = make_float2(a.x * b.x - a.y * b.y, a.x * b.y + a.y * b.x);
    }
    __syncthreads();
    ifft_dit(buf, N, tw);
    const float sk = skip[c];
    for (int t = tid; t < L; t += NT) {
      float2 y = buf[fidx(t)];
      const long doff = dry ? (long)(END_HY - O_UT) / 4 : 0;
      u0[t + doff] = y.x + u0[t] * sk;
      u1[t + doff] = y.y + u1[t] * sk;
    }
  }
  __syncthreads();
}

__device__ void phase_hy_tr(const Params& P, int slab) {
  const int L = Lof(slab), nseq = SLAB / L, tid = TID();
  const float* __restrict__ yT = (const float*)(WS(P) + O_UT);
  const u16* __restrict__ x0c = (const u16*)(WS(P) + O_X0C);
  u16* __restrict__ a2 = (u16*)(WS(P) + O_A2);
  float* tile = (float*)smem;
  const int ntt = L / 64;
  const int nitems = nseq * ntt * 16;
  for (int item = BID(); item < nitems; item += gridDim.x) {
    const int ct = item % 16, tt = (item / 16) % ntt, seq = item / (16 * ntt);
    const int cl = tid >> 3, tq = tid & 7;
    const float* src = yT + ((long)seq * 1024 + ct * 64 + cl) * L + tt * 64 + tq * 8;
    const float4 i0 = *(const float4*)src, i1 = *(const float4*)(src + 4);
    const int tl = tid >> 3, cg = tid & 7;
    const long row = (long)seq * L + tt * 64 + tl;
    const int c0 = ct * 64 + cg * 8;
    float xg[8];
    unpack8(*(const uint4*)(x0c + row * 1024 + c0), xg);
    __syncthreads();
    float* p = tile + cl * 65 + tq * 8;
    p[0] = i0.x; p[1] = i0.y; p[2] = i0.z; p[3] = i0.w; p[4] = i1.x; p[5] = i1.y; p[6] = i1.z; p[7] = i1.w;
    __syncthreads();
    float o[8];
#pragma unroll
    for (int i = 0; i < 8; ++i) o[i] = tile[(cg * 8 + i) * 65 + tl] * xg[i];
    *(uint4*)(a2 + row * 1024 + c0) = pack8s(o, 1.f);
  }
  __syncthreads();
}

struct Rec {
  int H, DK, DV, C;
  int ldv, voff, goff;
};
__device__ __forceinline__ Rec rec_of(int kind) {
  Rec r;
  if (kind == 1) { r.H = 4; r.DK = 256; r.DV = 512; r.C = 256; r.ldv = 6144; r.voff = 2048; r.goff = 4096; }
  else { r.H = 8; r.DK = 128; r.DV = 128; r.C = 128; r.ldv = 5120; r.voff = 1024; r.goff = 4096; }
  return r;
}

__device__ void phase_ret_prep(const Params& P, int slab) {
  const int L = Lof(slab);
  const u16* __restrict__ pj = (const u16*)(WS(P) + O_PROJ);
  u16* __restrict__ qdf = (u16*)(WS(P) + O_QDF); u16* __restrict__ qdb = (u16*)(WS(P) + O_QDB);
  u16* __restrict__ kif = (u16*)(WS(P) + O_KIF); u16* __restrict__ kib = (u16*)(WS(P) + O_KIB);
  u16* __restrict__ kef = (u16*)(WS(P) + O_KEF); u16* __restrict__ keb = (u16*)(WS(P) + O_KEB);
  float* dlf = (float*)(WS(P) + O_DLF); float* dlb = (float*)(WS(P) + O_DLB);
  const float2* __restrict__ rope = (const float2*)(WS(P) + O_ROPER);
  const long gtid = (long)BID() * NT + TID(), gsz = (long)gridDim.x * NT;
  for (long idx = gtid; idx < (long)SLAB * 64; idx += gsz) {
    const int d0 = (int)(idx & 15) * 8, h = (int)((idx >> 4) & 3), t = (int)(idx >> 6);
    const int pos = t & (L - 1), r = t & 255;
    const float lgf = -expf(P.in[20][h]), lgb = -expf(P.in[20][4 + h]);
    const u16* row = pj + (long)t * 6144 + h * 256 + d0;
    const uint4 vq1 = *(const uint4*)row, vq2 = *(const uint4*)(row + 128);
    const uint4 vk1 = *(const uint4*)(row + 1024), vk2 = *(const uint4*)(row + 1024 + 128);
    const float4* rp = (const float4*)(rope + (long)pos * 128 + d0);
    const float4 c01 = rp[0], c23 = rp[1], c45 = rp[2], c67 = rp[3];
    float q1[8], q2[8], k1[8], k2[8];
    unpack8(vq1, q1); unpack8(vq2, q2); unpack8(vk1, k1); unpack8(vk2, k2);
    const float cs[8] = {c01.x, c01.z, c23.x, c23.z, c45.x, c45.z, c67.x, c67.z};
    const float sn[8] = {c01.y, c01.w, c23.y, c23.w, c45.y, c45.w, c67.y, c67.w};
    float qa[8], qb[8], ka[8], kb[8];
#pragma unroll
    for (int i = 0; i < 8; ++i) {
      qa[i] = q1[i] * cs[i] - q2[i] * sn[i]; qb[i] = q1[i] * sn[i] + q2[i] * cs[i];
      ka[i] = (k1[i] * cs[i] - k2[i] * sn[i]) * 0.0625f; kb[i] = (k1[i] * sn[i] + k2[i] * cs[i]) * 0.0625f;
    }
    const float bf = (float)(r + 1) * lgf, bb = (float)(256 - r) * lgb;
    const float ef = expf(bf), eif = expf(-bf), eef = expf((float)(255 - r) * lgf);
    const float eb = expf(bb), eib = expf(-bb), eeb = expf((float)r * lgb);
    const long o1 = (long)t * 1024 + h * 256 + d0, o2 = o1 + 128;
    *(uint4*)(qdf + o1) = pack8s(qa, ef); *(uint4*)(qdf + o2) = pack8s(qb, ef);
    *(uint4*)(qdb + o1) = pack8s(qa, eb); *(uint4*)(qdb + o2) = pack8s(qb, eb);
    *(uint4*)(kif + o1) = pack8s(ka, eif); *(uint4*)(kif + o2) = pack8s(kb, eif);
    *(uint4*)(kib + o1) = pack8s(ka, eib); *(uint4*)(kib + o2) = pack8s(kb, eib);
    *(uint4*)(kef + o1) = pack8s(ka, eef); *(uint4*)(kef + o2) = pack8s(kb, eef);
    *(uint4*)(keb + o1) = pack8s(ka, eeb); *(uint4*)(keb + o2) = pack8s(kb, eeb);
    if (r == 0) {
      const long cgi = (long)(t >> 8) * 1024 + h * 256 + d0;
      const float df = expf(256.f * lgf), db = expf(256.f * lgb);
#pragma unroll
      for (int i = 0; i < 8; ++i) { dlf[cgi + i] = df; dlf[cgi + 128 + i] = df; dlb[cgi + i] = db; dlb[cgi + 128 + i] = db; }
    }
  }
}

__device__ __forceinline__ float lb_of(const float* lbt, int dr, int ch) {
  const float a0 = lbt[(dr * 4 + 0) * 1024 + ch], a1 = lbt[(dr * 4 + 1) * 1024 + ch], a2 = lbt[(dr * 4 + 2) * 1024 + ch], a3 = lbt[(dr * 4 + 3) * 1024 + ch];
  const float m = fmaxf(fmaxf(a0, a1), fmaxf(a2, a3));
  const float e0 = expf(a0 - m), e1 = expf(a1 - m), e2 = expf(a2 - m), e3 = expf(a3 - m);
  return (e0 + e1 + e2) / (e0 + e1 + e2 + e3);
}
__device__ void phase_hg_prep(const Params& P) {
  const u16* __restrict__ pj = (const u16*)(WS(P) + O_PROJ);
  u16* __restrict__ qdf = (u16*)(WS(P) + O_QDF); u16* __restrict__ qdb = (u16*)(WS(P) + O_QDB);
  u16* __restrict__ kif = (u16*)(WS(P) + O_KIF); u16* __restrict__ kib = (u16*)(WS(P) + O_KIB);
  u16* __restrict__ kef = (u16*)(WS(P) + O_KEF); u16* __restrict__ keb = (u16*)(WS(P) + O_KEB);
  float* dlf = (float*)(WS(P) + O_DLF); float* dlb = (float*)(WS(P) + O_DLB);
  const float* lbt = P.in[28];
  float* totF = (float*)smem;
  float* totB = totF + 1024;
  const int tid = TID(), lane = tid & 63, rg = tid >> 6;
  constexpr int RPT = 16;
  for (int item = BID(); item < 1024; item += gridDim.x) {
    const int cgi = item >> 3, ch = (item & 7) * 128 + lane * 2;
    const long t0 = (long)cgi * 128 + rg * RPT;
    unsigned wq[RPT], wf[RPT], wb[RPT];
#pragma unroll
    for (int i = 0; i < RPT; ++i) {
      const u16* row = pj + (t0 + i) * 5120 + ch;
      wq[i] = *(const unsigned*)row; wf[i] = *(const unsigned*)(row + 2048); wb[i] = *(const unsigned*)(row + 3072);
    }
    float lb0[2], lb1[2];
    lb0[0] = lb_of(lbt, 0, ch); lb0[1] = lb_of(lbt, 0, ch + 1);
    lb1[0] = lb_of(lbt, 1, ch); lb1[1] = lb_of(lbt, 1, ch + 1);
    float pf[2][RPT], sb[2][RPT], accf[2], accb[2];
#pragma unroll
    for (int c = 0; c < 2; ++c) {
      float a = 0.f;
#pragma unroll
      for (int i = 0; i < RPT; ++i) {
        const float x = bf2f((u16)(c ? (wf[i] >> 16) : (wf[i] & 0xffff)));
        a += logf(lb0[c] + (1.f - lb0[c]) * sigm(x)); pf[c][i] = a;
      }
      accf[c] = a;
      a = 0.f;
#pragma unroll
      for (int i = RPT - 1; i >= 0; --i) {
        const float x = bf2f((u16)(c ? (wb[i] >> 16) : (wb[i] & 0xffff)));
        a += logf(lb1[c] + (1.f - lb1[c]) * sigm(x)); sb[c][i] = a;
      }
      accb[c] = a;
    }
    __syncthreads();
    *(float2*)(totF + rg * 128 + lane * 2) = make_float2(accf[0], accf[1]);
    *(float2*)(totB + rg * 128 + lane * 2) = make_float2(accb[0], accb[1]);
    __syncthreads();
    float offF[2] = {0.f, 0.f}, offB[2] = {0.f, 0.f}, totf[2] = {0.f, 0.f}, totb[2] = {0.f, 0.f};
#pragma unroll
    for (int g = 0; g < 8; ++g) {
      const float2 f = *(const float2*)(totF + g * 128 + lane * 2), bq = *(const float2*)(totB + g * 128 + lane * 2);
      totf[0] += f.x; totf[1] += f.y; totb[0] += bq.x; totb[1] += bq.y;
      if (g < rg) { offF[0] += f.x; offF[1] += f.y; }
      if (g > rg) { offB[0] += bq.x; offB[1] += bq.y; }
    }
#pragma unroll
    for (int i = 0; i < RPT; ++i) {
      float o[6][2];
#pragma unroll
      for (int c = 0; c < 2; ++c) {
        const float xq = bf2f((u16)(c ? (wq[i] >> 16) : (wq[i] & 0xffff)));
        const float xf = bf2f((u16)(c ? (wf[i] >> 16) : (wf[i] & 0xffff)));
        const float xb = bf2f((u16)(c ? (wb[i] >> 16) : (wb[i] & 0xffff)));
        const float q = silu_f(xq);
        const float bf = offF[c] + pf[c][i], bb = offB[c] + sb[c][i];
        const float kf = (1.f - lb0[c]) * sigm(-xf), kb = (1.f - lb1[c]) * sigm(-xb);
        o[0][c] = q * expf(bf); o[1][c] = kf * expf(-bf); o[2][c] = kf * expf(totf[c] - bf);
        o[3][c] = q * expf(bb); o[4][c] = kb * expf(-bb); o[5][c] = kb * expf(totb[c] - bb);
      }
      const long oo = (t0 + i) * 1024 + ch;
      *(unsigned*)(qdf + oo) = pack2(o[0][0], o[0][1]);
      *(unsigned*)(kif + oo) = pack2(o[1][0], o[1][1]);
      *(unsigned*)(kef + oo) = pack2(o[2][0], o[2][1]);
      *(unsigned*)(qdb + oo) = pack2(o[3][0], o[3][1]);
      *(unsigned*)(kib + oo) = pack2(o[4][0], o[4][1]);
      *(unsigned*)(keb + oo) = pack2(o[5][0], o[5][1]);
    }
    if (rg == 0) {
      *(float2*)(dlf + (long)cgi * 1024 + ch) = make_float2(expf(totf[0]), expf(totf[1]));
      *(float2*)(dlb + (long)cgi * 1024 + ch) = make_float2(expf(totb[0]), expf(totb[1]));
    }
  }
  __syncthreads();
}

template <int C, int DKT>
__device__ __forceinline__ void rec_scores_item(const Params& P, const Rec& R, int cgi, int h, int ti, int tj) {
  constexpr int T = C > 128 ? 128 : C, KTS = DKT;
  const u16* qdf = (const u16*)(WS(P) + O_QDF); const u16* qdb = (const u16*)(WS(P) + O_QDB);
  const u16* kif = (const u16*)(WS(P) + O_KIF); const u16* kib = (const u16*)(WS(P) + O_KIB);
  u16* sc = (u16*)(WS(P) + O_SC) + (((long)cgi * R.H + h) * C + ti * T) * C + tj * T;
  const long offA = ((long)cgi * C + ti * T) * 1024 + h * R.DK, offB = ((long)cgi * C + tj * T) * 1024 + h * R.DK;
  f32x4 af[T / 32][T / 64] = {}, ab[T / 32][T / 64] = {};
  if (ti >= tj) gemm_acc<T, T, true, true, true, KTS>(af, qdf + offA, 1024, kif + offB, 1024, (u16*)smem);
  if (ti <= tj) gemm_acc<T, T, true, true, true, KTS>(ab, qdb + offA, 1024, kib + offB, 1024, (u16*)smem);
  const int tid = TID(), lane = tid & 63, wid = tid >> 6;
  const int wm = wid >> 2, wn = wid & 3, fr = lane & 15, fq = lane >> 4;
#pragma unroll
  for (int mi = 0; mi < T / 32; ++mi)
#pragma unroll
    for (int ni = 0; ni < T / 64; ++ni) {
      const int r = wm * (T / 2) + mi * 16 + fr, c0 = wn * (T / 4) + ni * 16 + fq * 4;
      const int gr = ti * T + r;
      float v[4];
#pragma unroll
      for (int j = 0; j < 4; ++j) {
        const int gc = tj * T + c0 + j;
        v[j] = (gc <= gr ? af[mi][ni][j] : 0.f) + (gc >= gr ? ab[mi][ni][j] : 0.f);
      }
      *(uint2*)(sc + r * C + c0) = make_uint2(pack2(v[0], v[1]), pack2(v[2], v[3]));
    }
}

template <int C, int DKT>
__device__ void phase_rec_su(const Params& P, int kind) {
  const Rec R = rec_of(kind);
  constexpr int KTU = C / 64;
  const int nch = SLAB / C;
  constexpr int NT1 = (C > 128 ? C / 128 : 1), NTT = NT1 * NT1;
  const int n_sc = nch * R.H * NTT;
  const int mtn = R.DK / 128, ntn = R.DV / 128;
  const int n_u = nch * R.H * 2 * mtn * ntn, G = gridDim.x;
  const u16* pj = (const u16*)(WS(P) + O_PROJ);
  for (int item = BID(); item < n_sc; item += G) { const int tl = item % NTT, hh = (item / NTT) % R.H, cg = item / (NTT * R.H); rec_scores_item<C, DKT>(P, R, cg, hh, tl / NT1, tl % NT1); }
  const u16* kef = (const u16*)(WS(P) + O_KEF); const u16* keb = (const u16*)(WS(P) + O_KEB);
  u16* stfb = (u16*)(WS(P) + O_STF); u16* stbb = (u16*)(WS(P) + O_STB);
  Tiles<KTU> ta, tb;
#define U_DECODE(q_, nt_, mt_, dir_, h_, cgi_) int nt_, mt_, dir_, h_, cgi_; { int qq = (q_); nt_ = qq % ntn; qq /= ntn; mt_ = qq % mtn; qq /= mtn; dir_ = qq & 1; qq >>= 1; h_ = qq % R.H; cgi_ = qq / R.H; }
#define U_ISSUE(T_, nt_, mt_, dir_, h_, cgi_) tiles_issue<128, 128, false, false, KTU>(T_, (dir_ ? keb : kef) + (long)cgi_ * C * 1024 + h_ * R.DK + mt_ * 128, 1024, pj + (long)cgi_ * C * R.ldv + R.voff + h_ * R.DV + nt_ * 128, R.ldv)
#define U_RUN(T_, nt_, mt_, dir_, h_, cgi_) { f32x4 acc[4][2] = {}; gemm_run<128, 128, false, false, false, KTU>(acc, T_, (u16*)smem); \
    u16* st = (dir_ ? stbb : stfb) + (((long)cgi_ * R.H + h_) * R.DV + nt_ * 128) * R.DK + mt_ * 128; const int DK = R.DK; \
    epi_each<128, 128, false>(acc, [&](int r, int c, f32x4 val) { *(uint2*)(st + (long)c * DK + r) = make_uint2(pack2(val[0], val[1]), pack2(val[2], val[3])); }); }
  int q = BID();
  if (q < n_u) { U_DECODE(q, nt, mt, dir, h, cgi); U_ISSUE(ta, nt, mt, dir, h, cgi); }
  for (; q < n_u; q += 2 * G) {
    U_DECODE(q, nt, mt, dir, h, cgi);
    const int q2 = q + G;
    if (q2 < n_u) { U_DECODE(q2, nt2, mt2, dir2, h2, cgi2); U_ISSUE(tb, nt2, mt2, dir2, h2, cgi2); }
    U_RUN(ta, nt, mt, dir, h, cgi);
    const int q3 = q + 2 * G;
    if (q3 < n_u) { U_DECODE(q3, nt3, mt3, dir3, h3, cgi3); U_ISSUE(ta, nt3, mt3, dir3, h3, cgi3); }
    if (q2 < n_u) { U_DECODE(q2, nt2, mt2, dir2, h2, cgi2); U_RUN(tb, nt2, mt2, dir2, h2, cgi2); }
  }
#undef U_DECODE
#undef U_ISSUE
#undef U_RUN
  __syncthreads();
}

__device__ void phase_rec_scan(const Params& P, int kind, int slab, bool dry = false) {
  const Rec R = rec_of(kind);
  const int L = Lof(slab), nseq = SLAB / L, ncs = L / R.C;
  const int qdk = R.DK / 4;
  const long per = (long)R.H * R.DV * qdk;
  const long total = 2 * nseq * per;
  const long gtid = (long)BID() * NT + TID(), gsz = (long)gridDim.x * NT;
  for (long idx = gtid; idx < total; idx += gsz) {
    long q = idx;
    const int pd = (int)(q % qdk); q /= qdk;
    const int e = (int)(q % R.DV); q /= R.DV;
    const int h = (int)(q % R.H); q /= R.H;
    const int seq = (int)(q % nseq);
    const int dir = (int)(q / nseq);
    u16* st = (u16*)(WS(P) + (dir ? O_STB : O_STF));
    u16* stw = dry ? (u16*)(WS(P) + O_OBUF) : st;
    const float* dl = (const float*)(WS(P) + (dir ? O_DLB : O_DLF));
    float s0 = 0.f, s1 = 0.f, s2 = 0.f, s3 = 0.f;
    const long ebase = ((long)h * R.DV + e) * R.DK + pd * 4;
    const long cstride = (long)R.H * R.DV * R.DK;
    const int dbase = h * R.DK + pd * 4;
    for (int i0 = 0; i0 < ncs; i0 += 8) {
      uint2 u[8];
      float4 dd[8];
#pragma unroll
      for (int j = 0; j < 8; ++j) {
        const int n = dir ? (ncs - 1 - i0 - j) : (i0 + j);
        const long cgi = (long)seq * ncs + n;
        u[j] = *(const uint2*)(st + cgi * cstride + ebase);
        dd[j] = *(const float4*)(dl + cgi * 1024 + dbase);
      }
#pragma unroll
      for (int j = 0; j < 8; ++j) {
        const int n = dir ? (ncs - 1 - i0 - j) : (i0 + j);
        const long cgi = (long)seq * ncs + n;
        *(uint2*)(stw + cgi * cstride + ebase) = make_uint2(pack2(s0, s1), pack2(s2, s3));
        s0 = dd[j].x * s0 + bf2f((u16)(u[j].x & 0xffff));
        s1 = dd[j].y * s1 + bf2f((u16)(u[j].x >> 16));
        s2 = dd[j].z * s2 + bf2f((u16)(u[j].y & 0xffff));
        s3 = dd[j].w * s3 + bf2f((u16)(u[j].y >> 16));
      }
    }
  }
}

template <int C, int DKT>
__device__ void phase_rec_out(const Params& P, int kind) {
  const Rec R = rec_of(kind);
  constexpr int T = C > 128 ? 128 : C, NRT = C / T;
  constexpr int KT1 = C / 64, KT2 = DKT;
  const int nch = SLAB / C, ntn = R.DV / 128;
  const u16* pj = (const u16*)(WS(P) + O_PROJ);
  const u16* scb = (const u16*)(WS(P) + O_SC);
  const u16* qdf = (const u16*)(WS(P) + O_QDF); const u16* qdb = (const u16*)(WS(P) + O_QDB);
  const u16* stf = (const u16*)(WS(P) + O_STF); const u16* stb = (const u16*)(WS(P) + O_STB);
  u16* ob = (u16*)(WS(P) + O_OBUF);
  const int HDV = R.H * R.DV;
  const int nitems = nch * R.H * NRT * ntn, G = gridDim.x;
  Tiles<KT1> t1; Tiles<KT2> t2; Tiles<KT2> t3;
  int item = BID();
  if (item < nitems) {
    const int nt = item % ntn, rt = (item / ntn) % NRT, h = (item / (ntn * NRT)) % R.H, cgi = item / (ntn * NRT * R.H);
    tiles_issue<T, 128, true, false, KT1>(t1, scb + (((long)cgi * R.H + h) * C + rt * T) * C, C, pj + (long)cgi * C * R.ldv + R.voff + h * R.DV + nt * 128, R.ldv);
  }
  for (; item < nitems; item += G) {
    const int nt = item % ntn, rt = (item / ntn) % NRT, h = (item / (ntn * NRT)) % R.H, cgi = item / (ntn * NRT * R.H);
    const long qoff = ((long)cgi * C + rt * T) * 1024 + h * R.DK;
    const long soff = (((long)cgi * R.H + h) * R.DV + nt * 128) * R.DK;
    f32x4 acc[T / 32][2] = {};
    tiles_issue<T, 128, true, true, KT2>(t2, qdf + qoff, 1024, stf + soff, R.DK);
    gemm_run<T, 128, true, false, true, KT1>(acc, t1, (u16*)smem);
    tiles_issue<T, 128, true, true, KT2>(t3, qdb + qoff, 1024, stb + soff, R.DK);
    gemm_run<T, 128, true, true, true, KT2>(acc, t2, (u16*)smem);
    const int nx = item + G;
    if (nx < nitems) {
      const int nt2 = nx % ntn, rt2 = (nx / ntn) % NRT, h2 = (nx / (ntn * NRT)) % R.H, cg2 = nx / (ntn * NRT * R.H);
      tiles_issue<T, 128, true, false, KT1>(t1, scb + (((long)cg2 * R.H + h2) * C + rt2 * T) * C, C, pj + (long)cg2 * C * R.ldv + R.voff + h2 * R.DV + nt2 * 128, R.ldv);
    }
    gemm_run<T, 128, true, true, true, KT2>(acc, t3, (u16*)smem);
    u16* o = ob + ((long)cgi * C + rt * T) * HDV + h * R.DV + nt * 128;
    epi_each<T, 128, true>(acc, [&](int r, int c, f32x4 val) { *(uint2*)(o + (long)r * HDV + c) = make_uint2(pack2(val[0], val[1]), pack2(val[2], val[3])); });
  }
  __syncthreads();
}

template <int KIND>
__device__ void phase_rec_ng_t(const Params& P) {
  const Rec R = rec_of(KIND);
  constexpr int DV = (KIND == 1) ? 512 : 128, H = (KIND == 1) ? 4 : 8, PER = DV / 64, HDV = H * DV;
  const u16* __restrict__ ob = (const u16*)(WS(P) + O_OBUF);
  const u16* __restrict__ pj = (const u16*)(WS(P) + O_PROJ);
  u16* __restrict__ a2 = (u16*)(WS(P) + O_A2);
  const float* gain = P.in[29];
  const int tid = TID(), lane = tid & 63, wid = tid >> 6;
  constexpr int nrows = SLAB * H;
  for (int item = BID(); item < nrows / 32; item += gridDim.x) {
    float v[4][PER];
    float ss[4];
#pragma unroll
    for (int u = 0; u < 4; ++u) {
      const int rh = item * 32 + wid * 4 + u;
      const int t = rh / H, h = rh % H;
      const u16* o = ob + (long)t * HDV + h * DV + lane * PER;
      if (PER == 8) {
        float f8[8];
        unpack8(*(const uint4*)o, f8);
#pragma unroll
        for (int i = 0; i < 8; ++i) v[u][i % PER] = f8[i];
      } else {
        const unsigned w = *(const unsigned*)o;
        v[u][0] = bf2f((u16)(w & 0xffff)); v[u][1 % PER] = bf2f((u16)(w >> 16));
      }
      float a = 0.f;
#pragma unroll
      for (int i = 0; i < PER; ++i) a += v[u][i] * v[u][i];
      ss[u] = a;
    }
#pragma unroll
    for (int u = 0; u < 4; ++u) ss[u] = wave_sum(ss[u]);
#pragma unroll
    for (int u = 0; u < 4; ++u) {
      const int rh = item * 32 + wid * 4 + u;
      const int t = rh / H, h = rh % H;
      const float rstd = rsqrtf(ss[u] / (float)DV + 1e-6f);
      const u16* g = pj + (long)t * R.ldv + R.goff + h * DV + lane * PER;
      u16* out = a2 + (long)t * HDV + h * DV + lane * PER;
      float y[PER];
#pragma unroll
      for (int i = 0; i < PER; ++i) {
        y[i] = v[u][i] * rstd;
        if (KIND == 3) y[i] *= gain[lane * PER + i];
      }
      if (PER == 8) {
        const uint4 gw = *(const uint4*)g;
        float gf[8];
        unpack8(gw, gf);
        float r8[8];
#pragma unroll
        for (int i = 0; i < 8; ++i) r8[i] = y[i % PER] * silu_f(gf[i]);
        *(uint4*)out = pack8s(r8, 1.f);
      } else {
        const unsigned gw = *(const unsigned*)g;
        *(unsigned*)out = pack2(y[0] * silu_f(bf2f((u16)(gw & 0xffff))), y[1 % PER] * silu_f(bf2f((u16)(gw >> 16))));
      }
    }
  }
}
__device__ void phase_rec_ng(const Params& P, int kind) {
  if (kind == 1) phase_rec_ng_t<1>(P); else phase_rec_ng_t<3>(P);
}

__device__ void phase_swa_prep(const Params& P) {
  const u16* __restrict__ pj = (const u16*)(WS(P) + O_SA_P);
  u16* __restrict__ qn = (u16*)(WS(P) + O_SA_Q);
  u16* __restrict__ kn = (u16*)(WS(P) + O_SA_K);
  const float2* __restrict__ rope = (const float2*)(WS(P) + O_ROPES);
  const long gtid = (long)BID() * NT + TID(), gsz = (long)gridDim.x * NT;
  for (long idx = gtid; idx < (long)NTOK * 80; idx += gsz) {
    const int j = (int)(idx & 3);
    const int hd = (int)((idx >> 2) % 20);
    const int t = (int)(idx / 80);
    const int col = hd < 16 ? hd * 64 : 1024 + (hd - 16) * 64;
    const int d0 = j * 8;
    float x1[8], x2[8];
    unpack8(*(const uint4*)(pj + (long)t * 1536 + col + d0), x1);
    unpack8(*(const uint4*)(pj + (long)t * 1536 + col + d0 + 32), x2);
    const int L = t < 16384 ? 2048 : 8192;
    const float4* rp = (const float4*)(rope + (long)(t & (L - 1)) * 32 + d0);
    const float4 c01 = rp[0], c23 = rp[1], c45 = rp[2], c67 = rp[3];
    float ss = 0.f;
#pragma unroll
    for (int i = 0; i < 8; ++i) ss += x1[i] * x1[i] + x2[i] * x2[i];
    ss += __shfl_xor(ss, 1); ss += __shfl_xor(ss, 2);
    const float rstd = rsqrtf(ss * (1.f / 64.f) + 1e-6f);
    const float* gn = hd < 16 ? P.in[23] : P.in[24];
    const float4 ga = *(const float4*)(gn + d0), gb = *(const float4*)(gn + d0 + 4), gc = *(const float4*)(gn + d0 + 32), gd = *(const float4*)(gn + d0 + 36);
    const float g1[8] = {ga.x, ga.y, ga.z, ga.w, gb.x, gb.y, gb.z, gb.w};
    const float g2[8] = {gc.x, gc.y, gc.z, gc.w, gd.x, gd.y, gd.z, gd.w};
    const float cs[8] = {c01.x, c01.z, c23.x, c23.z, c45.x, c45.z, c67.x, c67.z};
    const float sn[8] = {c01.y, c01.w, c23.y, c23.w, c45.y, c45.w, c67.y, c67.w};
    const float osc = hd < 16 ? 0.125f : 1.f;
    float o1[8], o2[8];
#pragma unroll
    for (int i = 0; i < 8; ++i) {
      const float y1 = x1[i] * rstd * g1[i], y2 = x2[i] * rstd * g2[i];
      o1[i] = (y1 * cs[i] - y2 * sn[i]) * osc;
      o2[i] = (y1 * sn[i] + y2 * cs[i]) * osc;
    }
    u16* dst = hd < 16 ? qn + (long)t * 1024 + hd * 64 + d0 : kn + (long)t * 256 + (hd - 16) * 64 + d0;
    *(uint4*)dst = pack8s(o1, 1.f);
    *(uint4*)(dst + 32) = pack8s(o2, 1.f);
  }
}

constexpr int SLD = 324;
__device__ void phase_swa_att(const Params& P) {
  const u16* qn = (const u16*)(WS(P) + O_SA_Q);
  const u16* kn = (const u16*)(WS(P) + O_SA_K);
  const u16* pj = (const u16*)(WS(P) + O_SA_P);
  u16* a2 = (u16*)(WS(P) + O_SA_A);
  const float* sink = P.in[25];
  float* S = (float*)(smem + 40960);
  u16* Bs = (u16*)smem + 9216;
  const int tid = TID(), lane = tid & 63, wid = tid >> 6;
  const int wm = wid >> 2, wn = wid & 3, fr = lane & 15, fq = lane >> 4;
  const int nitems = (NTOK / 64) * 16;
  for (int item = BID(); item < nitems; item += gridDim.x) {
    const int hq = item & 15, qbg = item >> 4;
    const int L = qbg < 256 ? 2048 : 8192;
    const int q0 = qbg < 256 ? (qbg & 31) * 64 : ((qbg - 256) & 127) * 64;
    const long tok0 = qbg < 256 ? (long)(qbg >> 5) * 2048 : 16384 + (long)((qbg - 256) >> 7) * 8192;
    const int hkv = hq >> 2;
    uint4 vt[5];
#pragma unroll
    for (int kt = 0; kt < 5; ++kt) {
      const int kp0 = q0 - 128 + kt * 64;
      vt[kt] = make_uint4(0, 0, 0, 0);
      if (kp0 >= 0 && kp0 < L) vt[kt] = ld_chunk<64, false>(pj + (tok0 + kp0) * 1536 + 1280 + hkv * 64, 1536, 0, tid);
    }
    for (int kt = 0; kt < 5; ++kt) {
      const int kp0 = q0 - 128 + kt * 64;
      if (kp0 >= 0 && kp0 < L) {
        f32x4 acc[2][1] = {};
        gemm_acc<64, 64, true, true, true, 1>(acc, qn + (tok0 + q0) * 1024 + hq * 64, 1024, kn + (tok0 + kp0) * 256 + hkv * 64, 256, (u16*)smem);
        epi_each<64, 64, true>(acc, [&](int r, int c, f32x4 v) {
          f32x4 o;
#pragma unroll
          for (int j = 0; j < 4; ++j) {
            const int dlt = (q0 + r) - (kp0 + c + j);
            o[j] = (dlt <= 128 && dlt >= -128) ? v[j] : -1e30f;
          }
          *(f32x4*)(S + r * SLD + kt * 64 + c) = o;
        });
      } else {
        for (int i = tid; i < 4096; i += NT) S[(i >> 6) * SLD + kt * 64 + (i & 63)] = -1e30f;
      }
    }
    __syncthreads();
    {
      const int r = tid >> 3, sub = tid & 7;
      const float sk = sink[hq];
      float e[40];
      float m = sk;
#pragma unroll
      for (int i = 0; i < 40; ++i) { e[i] = S[r * SLD + sub + 8 * i]; m = fmaxf(m, e[i]); }
      m = fmaxf(m, __shfl_xor(m, 1)); m = fmaxf(m, __shfl_xor(m, 2)); m = fmaxf(m, __shfl_xor(m, 4));
      float den = 0.f;
#pragma unroll
      for (int i = 0; i < 40; ++i) { e[i] = __expf(e[i] - m); den += e[i]; }
      den += __shfl_xor(den, 1); den += __shfl_xor(den, 2); den += __shfl_xor(den, 4);
      den += __expf(sk - m);
      const float inv = 1.f / den;
      u16* prow = (u16*)(S + r * SLD);
#pragma unroll
      for (int i = 0; i < 40; ++i) prow[sub + 8 * i] = f2bf(e[i] * inv);
    }
    __syncthreads();
    f32x4 acc[2][1] = {};
#pragma unroll
    for (int kt = 0; kt < 5; ++kt) {
      const int kp0 = q0 - 128 + kt * 64;
      if (kp0 >= 0 && kp0 < L) {
        __syncthreads();
        st_chunk<64, false>(Bs, vt[kt], tid);
        __syncthreads();
#pragma unroll
        for (int ks = 0; ks < 2; ++ks) {
          bf16x8 af[2];
#pragma unroll
          for (int mi = 0; mi < 2; ++mi) af[mi] = *(const bf16x8*)((const u16*)(S + (wm * 32 + mi * 16 + fr) * SLD) + kt * 64 + ks * 32 + fq * 8);
          const bf16x8 bfr = ld_frag<64, false>(Bs, wn * 16, ks, fr, fq);
#pragma unroll
          for (int mi = 0; mi < 2; ++mi) acc[mi][0] = __builtin_amdgcn_mfma_f32_16x16x32_bf16(bfr, af[mi], acc[mi][0], 0, 0, 0);
        }
      }
    }
    u16* o = a2 + (tok0 + q0) * 1024 + hq * 64;
    epi_each<64, 64, true>(acc, [&](int r, int c, f32x4 v) { *(uint2*)(o + (long)r * 1024 + c) = make_uint2(pack2(v[0], v[1]), pack2(v[2], v[3])); });
    __syncthreads();
  }
}

#define XB_TMO      128
#define XB_XCNT(j)  (256  + 64 * (j))
#define XB_XSUB(j)  (1280 + 64 * (j))
#define XB_XGEN(j)  (2304 + 64 * (j))
#define XB_TOP      3328
#define XB_TOPGEN   3392
#define XCD_BAR_WORDS 3456
#define XB_SPIN_CAP (1u << 18)
__device__ __forceinline__ unsigned xb_ld(unsigned* p)              { return __hip_atomic_load(p, __ATOMIC_RELAXED, __HIP_MEMORY_SCOPE_AGENT); }
__device__ __forceinline__ unsigned xb_add(unsigned* p, unsigned v) { return __hip_atomic_fetch_add(p, v, __ATOMIC_RELAXED, __HIP_MEMORY_SCOPE_AGENT); }
__device__ __forceinline__ unsigned xb_xcc_id() { return (unsigned)__builtin_amdgcn_s_getreg((3 << 11) | 20) & 0xFu; }
#define XB_SPIN(cond, bar) do { unsigned _sp = 0; while (cond) { __builtin_amdgcn_s_sleep(1); \
    if ((++_sp & 255u) == 0u) { if (xb_ld(&(bar)[XB_TMO])) break; if (_sp > XB_SPIN_CAP) { atomicAdd(&(bar)[XB_TMO], 1u); break; } } } } while (0)
struct XcdBarrier { unsigned* bar; unsigned x; volatile LDS_AS unsigned* st; };
__device__ __forceinline__ XcdBarrier xcd_barrier_post(unsigned* bar, volatile LDS_AS unsigned* st) {
    XcdBarrier b; b.bar = bar; b.x = xb_xcc_id(); b.st = st;
    if (threadIdx.x == 0) (void)xb_add(&bar[XB_XCNT(b.x)], 1u);
    return b;
}
__device__ __forceinline__ void xcd_barrier_complete(unsigned* bar, unsigned x, unsigned& nloc, unsigned& nx) {
    const unsigned G = gridDim.x * gridDim.y * gridDim.z;
    unsigned sum, cnt, mine, sp = 0u;
    for (;;) {
        sum = 0u; cnt = 0u; mine = 0u;
#pragma unroll
        for (unsigned j = 0; j < 16; ++j) { const unsigned c = xb_ld(&bar[XB_XCNT(j)]); sum += c; cnt += (c > 0u) ? 1u : 0u; mine = (j == x) ? c : mine; }
        if (sum == G) break;
        __builtin_amdgcn_s_sleep(1);
        if ((++sp & 255u) == 0u) { if (xb_ld(&bar[XB_TMO])) break; if (sp > XB_SPIN_CAP) { atomicAdd(&bar[XB_TMO], 1u); break; } }
    }
    nloc = mine > 0u ? mine : 1u; nx = cnt > 0u ? cnt : 1u;
}
__device__ __forceinline__ void xcd_barrier(const XcdBarrier& b) {
    asm volatile("s_waitcnt vmcnt(0)" ::: "memory");
    __syncthreads();
    if (threadIdx.x == 0) {
        unsigned* bar = b.bar;
        __builtin_amdgcn_s_waitcnt(0);
        unsigned nloc = b.st[0], nx = b.st[1];
        if (nloc == 0u) { xcd_barrier_complete(bar, b.x, nloc, nx); b.st[0] = nloc; b.st[1] = nx; }
        const unsigned old = xb_add(&bar[XB_XSUB(b.x)], 1u);
        const unsigned gen = old / nloc;
        if (old + 1u == (gen + 1u) * nloc) {
            __builtin_amdgcn_fence(__ATOMIC_RELEASE, "agent");
            asm volatile("s_waitcnt vmcnt(0)" ::: "memory");
            const unsigned og = xb_add(&bar[XB_TOP], 1u);
            const unsigned tg = og / nx;
            if (og + 1u == (tg + 1u) * nx) xb_add(&bar[XB_TOPGEN], 1u);
            else XB_SPIN(xb_ld(&bar[XB_TOPGEN]) == tg, bar);
            __builtin_amdgcn_fence(__ATOMIC_ACQUIRE, "agent");
            xb_add(&bar[XB_XGEN(b.x)], 1u);
            asm volatile("s_waitcnt vmcnt(0)" ::: "memory");
        } else {
            XB_SPIN(xb_ld(&bar[XB_XGEN(b.x)]) == gen, bar);
            __builtin_amdgcn_fence(__ATOMIC_ACQUIRE, "agent");
            asm volatile("s_waitcnt vmcnt(0)" ::: "memory");
        }
    }
    __syncthreads();
}

__device__ __forceinline__ int nmix_of(int kind) { return (kind & 1) ? 8 : (kind == 2 ? 5 : 6); }
__device__ __forceinline__ int nsl_of(int kind) { return kind == 2 ? 1 : 5; }

__device__ void ffn_step(const Params& P, int layer, int f) {
  if (f == 6) { phase_ffn_down(P, layer); return; }
  const int fs = f / 3, st = f % 3;
  if (st == 0) { REP(4) phase_norm(P, layer, fs, 1); }
  else if (st == 1) { REP(0) phase_ffn_gate(P, layer); }
  else { REP(0) phase_ffn_val(P, layer, fs); }
}
__device__ void layer_step(const Params& P, int layer, int slab, int step) {
  const int kind = layer;
  if (step == 0) { REP(4) phase_norm(P, layer, slab, kind == 2 ? 2 : 0); return; }
  if (kind == 0) {
    if (step == 1) { REP(0) phase_proj(P, O_WHYIN, 3072); }
    else if (step == 2) { REP(3) phase_hy_conv(P, slab); }
    else if (step == 3) { if ((PROBE_MASK >> 7) & 1) phase_hy_fft(P, slab, true); phase_hy_fft(P, slab); }
    else if (step == 4) { REP(3) phase_hy_tr(P, slab); }
    else phase_resid(P, layer, slab, (const u16*)(WS(P) + O_A2), 1024, O_WHYOUT, 2 * D);
  } else if (kind == 1) {
    if (step == 1) { REP(0) phase_proj(P, O_WRETIN, 6144); }
    else if (step == 2) { REP(1) REP(9) phase_ret_prep(P, slab); }
    else if (step == 3) { REP(1) REP(11) phase_rec_su<256, 4>(P, 1); }
    else if (step == 4) { if ((PROBE_MASK >> 6) & 1) phase_rec_scan(P, 1, slab, true); phase_rec_scan(P, 1, slab); }
    else if (step == 5) { REP(1) REP(12) phase_rec_out<256, 4>(P, 1); }
    else if (step == 6) { REP(1) REP(9) phase_rec_ng(P, 1); }
    else phase_resid(P, layer, slab, (const u16*)(WS(P) + O_A2), 2048, O_WRETOUT, 2 * D);
  } else if (kind == 2) {
    if (step == 1) {
      EpiStoreBf16 E; E.O = (u16*)(WS(P) + O_SA_P); E.ldc = 1536;
      REP(0) run_gemm((const u16*)(WS(P) + O_SA_H), (const u16*)(WS(P) + O_WSWAIN), NTOK, 1536, D, E);
    }
    else if (step == 2) { REP(2) REP(14) phase_swa_prep(P); }
    else if (step == 3) { REP(2) REP(15) phase_swa_att(P); }
    else {
      EpiResid E; E.X = OUTP(P); E.XS = E.X; E.mod = (const float*)(WS(P) + O_MOD) + (long)layer * 16 * 6144; E.goff = 2 * D; E.grow0 = 0;
      run_gemm((const u16*)(WS(P) + O_SA_A), (const u16*)(WS(P) + O_WSWAOUT), NTOK, D, 1024, E);
    }
  } else {
    if (step == 1) { REP(0) phase_proj(P, O_WHGIN, 5120); }
    else if (step == 2) { REP(1) REP(9) phase_hg_prep(P); }
    else if (step == 3) { REP(1) REP(11) phase_rec_su<128, 2>(P, 3); }
    else if (step == 4) { if ((PROBE_MASK >> 6) & 1) phase_rec_scan(P, 3, slab, true); phase_rec_scan(P, 3, slab); }
    else if (step == 5) { REP(1) REP(12) phase_rec_out<128, 2>(P, 3); }
    else if (step == 6) { REP(1) REP(9) phase_rec_ng(P, 3); }
    else phase_resid(P, layer, slab, (const u16*)(WS(P) + O_A2), 1024, O_WHGOUT, 2 * D);
  }
}

__global__ void __launch_bounds__(NT) fwd_megakernel(Params P) {
  cg::grid_group grid = cg::this_grid();
  __shared__ uint4 xb_words;
  if (threadIdx.x == 0) xb_words = make_uint4(0u, 0u, 0u, 0u);
  __syncthreads();
  XcdBarrier xb = xcd_barrier_post((unsigned*)(P.ws + O_BAR), (volatile LDS_AS unsigned*)&xb_words);
  for (int pid = P.p0; pid < P.p1; ++pid) {
    if (pid == 0) { REP(5) phase_pre0(P); }
    else if (pid == 1) { REP(5) phase_pre1(P); }
    else {
      int q = pid - 2, layer = 0;
      while (q >= nsl_of(layer) * nmix_of(layer) + 7) { q -= nsl_of(layer) * nmix_of(layer) + 7; ++layer; }
      const int nm = nmix_of(layer), nsl = nsl_of(layer);
      if (q < nsl * nm) layer_step(P, layer, q / nm, q % nm);
      else ffn_step(P, layer, q - nsl * nm);
    }
    if (pid + 1 < P.p1) {
      if (pid == 0) grid.sync();
      else xcd_barrier(xb);
      if ((PROBE_MASK >> 8) & 1) xcd_barrier(xb);
    }
  }
}

extern "C" void kernel_launch(void* const* d_in, const int* in_sizes, int n_in, void* d_out, int out_size, void* d_ws,
                              size_t ws_size, hipStream_t stream) {
  static int grid_blocks = 0;
  if (!grid_blocks) {
    int dev = 0, cus = 0, per_cu = 0;
    (void)hipGetDevice(&dev);
    (void)hipDeviceGetAttribute(&cus, hipDeviceAttributeMultiprocessorCount, dev);
    (void)hipFuncSetAttribute((const void*)fwd_megakernel, hipFuncAttributeMaxDynamicSharedMemorySize, LDSB);
    (void)hipOccupancyMaxActiveBlocksPerMultiprocessor(&per_cu, (const void*)fwd_megakernel, NT, LDSB);
    if (per_cu < 1) per_cu = 1;
    if (per_cu > 1) per_cu = 1;
    grid_blocks = cus * per_cu;
    if (ws_size < WS_END) fprintf(stderr, "kernel_launch: workspace too small: %zu < %zu\n", ws_size, (size_t)WS_END);
  }
  Params p;
  memset(&p, 0, sizeof(p));
  for (int i = 0; i < 36; ++i) p.in[i] = (const float*)d_in[i];
  p.out = (float*)d_out;
  p.ws = (unsigned char*)d_ws;
  (void)hipMemsetAsync((unsigned char*)d_ws + O_BAR, 0, XCD_BAR_WORDS * 4, stream);
#if ONE_LAUNCH
  p.p0 = 0; p.p1 = NPHASES;
  void* args[] = {&p};
  hipError_t e = hipLaunchCooperativeKernel((const void*)fwd_megakernel, dim3(grid_blocks), dim3(NT), args, LDSB, stream);
  if (e != hipSuccess) fprintf(stderr, "cooperative launch failed: %s (grid %d)\n", hipGetErrorString(e), grid_blocks);
#else
  for (int ph = 0; ph < NPHASES; ++ph) {
    p.p0 = ph; p.p1 = ph + 1;
    hipLaunchKernelGGL(fwd_megakernel, dim3(grid_blocks), dim3(NT), LDSB, stream, p);
  }
#endif
}
```

```cpp
#include <hip/hip_runtime.h>
#include <hip/hip_cooperative_groups.h>
#include <cstdio>
#include <cstdint>
#include <cstring>
namespace cg = cooperative_groups;

typedef unsigned short u16;
typedef __attribute__((ext_vector_type(8))) short bf16x8;
typedef __attribute__((ext_vector_type(4))) float f32x4;

#define NT 512
#ifndef ONE_LAUNCH
#define ONE_LAUNCH 1
#endif
#ifndef PROBE_MASK
#define PROBE_MASK 0
#endif
#define REP(cls) for (int rep_##cls = 0; rep_##cls < (((PROBE_MASK >> (cls)) & 1) ? 2 : 1); ++rep_##cls)

constexpr int D = 1024, SLAB = 16384, DFF = 2816;
constexpr int LDSB = 139264;
constexpr int FSLAB = 40960, NTOK = 81920;
constexpr int NPHASES = 2 + 5 * (6 + 8 + 8) + 5 + 4 * 7;

constexpr size_t SZW(size_t n, size_t k) { return n * k * 2; }
constexpr size_t O_WHYIN = 0;
constexpr size_t O_WHYOUT = O_WHYIN + SZW(3072, 1024);
constexpr size_t O_WRETIN = O_WHYOUT + SZW(1024, 1024);
constexpr size_t O_WRETOUT = O_WRETIN + SZW(6144, 1024);
constexpr size_t O_WSWAIN = O_WRETOUT + SZW(1024, 2048);
constexpr size_t O_WSWAOUT = O_WSWAIN + SZW(1536, 1024);
constexpr size_t O_WHGIN = O_WSWAOUT + SZW(1024, 1024);
constexpr size_t O_WHGOUT = O_WHGIN + SZW(5120, 1024);
constexpr size_t O_WFG = O_WHGOUT + SZW(1024, 1024);
constexpr size_t O_WFV = O_WFG + 4 * SZW(2816, 1024);
constexpr size_t O_WFD = O_WFV + 4 * SZW(2816, 1024);
constexpr size_t O_MOD = O_WFD + 4 * SZW(1024, 2816);
constexpr size_t O_TW = O_MOD + (size_t)4 * 16 * 6144 * 4;
constexpr size_t O_HIDS = O_TW + 8192 * 8;
constexpr size_t O_HIDP = O_HIDS + (size_t)8192 * 64 * 4;
constexpr size_t O_ROPER = O_HIDP + (size_t)2048 * 64 * 4;
constexpr size_t O_ROPES = O_ROPER + (size_t)8192 * 128 * 8;
constexpr size_t O_PROJ = O_ROPES + (size_t)8192 * 32 * 8;
constexpr size_t O_HBUF = O_PROJ + (size_t)SLAB * 6144 * 2;
constexpr size_t O_A2 = O_HBUF + (size_t)SLAB * 1024 * 2;
constexpr size_t O_C = O_A2 + (size_t)SLAB * 2048 * 2;
constexpr size_t O_FHBUF = O_PROJ;
constexpr size_t O_FGBUF = O_FHBUF + (size_t)FSLAB * 1024 * 2;
constexpr size_t O_FACT = O_FGBUF + (size_t)FSLAB * DFF * 2;
constexpr size_t END_F = O_FACT + (size_t)NTOK * DFF * 2;
constexpr size_t O_MODP = O_C;
constexpr size_t O_BAR = ((size_t)1 << 30) - 16384;
constexpr size_t O_HSPS = O_BAR - (size_t)1024 * 16384 * 8 - (size_t)1024 * 4096 * 8;
constexpr size_t O_HSPP = O_HSPS + (size_t)1024 * 16384 * 8;
constexpr size_t O_UT = O_C;
constexpr size_t O_X0C = O_UT + (size_t)SLAB * 1024 * 4;
constexpr size_t END_HY = O_X0C + (size_t)SLAB * 1024 * 2;
static_assert(END_F <= O_HSPS && END_HY <= O_HSPS, "layer-0 buffers overlap the filter spectra");
constexpr size_t SZP = (size_t)SLAB * 1024 * 2;
constexpr size_t O_QDF = O_C, O_QDB = O_QDF + SZP, O_KIF = O_QDB + SZP, O_KIB = O_KIF + SZP, O_KEF = O_KIB + SZP, O_KEB = O_KEF + SZP;
constexpr size_t O_DLF = O_KEB + SZP;
constexpr size_t O_DLB = O_DLF + (size_t)256 * 1024 * 4;
constexpr size_t O_SC = O_DLB + (size_t)256 * 1024 * 4;
constexpr size_t O_STF = O_SC + (size_t)SLAB * 1024 * 2;
constexpr size_t O_STB = O_STF + (size_t)134217728;
constexpr size_t O_OBUF = O_STB + (size_t)134217728;
constexpr size_t END_REC = O_OBUF + (size_t)SLAB * 2048 * 4;
constexpr size_t O_QN = O_C;
constexpr size_t O_KN = O_QN + SZP;
constexpr size_t O_PBUF = O_KN + (size_t)SLAB * 256 * 2;
constexpr size_t END_SWA0 = O_PBUF + (size_t)SLAB * 16 * 320 * 2;
constexpr size_t O_SA_H = O_PROJ;
constexpr size_t O_SA_P = O_SA_H + (size_t)81920 * 1024 * 2;
constexpr size_t O_SA_Q = O_SA_P + (size_t)81920 * 1536 * 2;
constexpr size_t O_SA_K = O_SA_Q + (size_t)81920 * 1024 * 2;
constexpr size_t O_SA_A = O_SA_K + (size_t)81920 * 256 * 2;
constexpr size_t END_SWA = O_SA_A + (size_t)81920 * 1024 * 2;
constexpr size_t WS_END = END_REC > END_HY ? (END_REC > END_SWA ? END_REC : END_SWA) : (END_HY > END_SWA ? END_HY : END_SWA);
static_assert(WS_END <= O_BAR, "workspace exceeds 1 GiB");

struct Params {
  const float* in[36];
  float* out;
  unsigned char* ws;
  int p0, p1;
};

extern __shared__ __attribute__((aligned(16))) unsigned char smem[];

__device__ __forceinline__ int TID() { int t = threadIdx.x; asm volatile("" : "+v"(t)); return t; }
__device__ __forceinline__ int BID() { int b = blockIdx.x; asm volatile("" : "+s"(b)); return b; }
__device__ __forceinline__ long ZOFF() { long z = 0; asm volatile("" : "+s"(z)); return z; }
__device__ __forceinline__ unsigned char* WS(const Params& P) { return P.ws + ZOFF(); }
__device__ __forceinline__ float* OUTP(const Params& P) { return P.out + ZOFF(); }

namespace pg8 {
#define PG8_LAS __attribute__((address_space(3)))
typedef unsigned short bf16_t;
typedef short bf16x8 __attribute__((ext_vector_type(8)));
typedef float f32x4 __attribute__((ext_vector_type(4)));
typedef unsigned u32x4 __attribute__((ext_vector_type(4)));
constexpr int BM = 256, BK = 64, HALF = 128, HTB = HALF * BK * 2  , STAGE_BYTES = 8 * HTB, NXCD = 8, WGM = 8;

__host__ __device__ __forceinline__ int lds_byte(int r, int c) { const int st = (r >> 4) * 2 + (c >> 5), rr = r & 15, cc = c & 31, ob = rr * 64 + cc * 2; return st * 1024 + (ob ^ (((ob >> 9) & 1) << 5)); }
__host__ __device__ __forceinline__ void stage_rc(int b, int& R, int& C) { const int st = b / 1024, sb = b % 1024, swz = sb ^ (((sb >> 9) & 1) << 5); R = (st >> 1) * 16 + swz / 64; C = (st & 1) * 32 + (swz % 64) / 2; }
__host__ __device__ __forceinline__ int perm32(int rho) { const int n = rho >> 4, i = rho & 15; return 8 * (i >> 2) + 4 * n + (i & 3); }

struct Unit { int pm, pn; };
struct Gemm { const bf16_t* A; const bf16_t* Bt; int M, N, K; };

struct StaticOrder {
    int nM, nN, nwg, G, c;
    __host__ __device__ void init(int M, int N, int G_, int c_) { nM = M / BM; nN = N / BM; nwg = nM * nN; G = G_; c = c_; }
    __host__ __device__ bool next(int i, Unit& u) const {
        const long L = (long)i * G + c; if (L >= nwg) return false;
        int wgid = (int)L; { const int q = nwg / NXCD, r = nwg % NXCD, xcd = wgid % NXCD, off = wgid / NXCD; wgid = (xcd < r ? xcd * (q + 1) : r * (q + 1) + (xcd - r) * q) + off; }
        const int nig = WGM * nN, gid = wgid / nig, fm = gid * WGM, gsz = (nM - fm) < WGM ? (nM - fm) : WGM;
        u.pm = fm + ((wgid % nig) % gsz); u.pn = (wgid % nig) / gsz; return true;
    }
    __device__ __forceinline__ void a_ready(const Unit&) const {}
    __device__ __forceinline__ void done(const Unit&) const {}
};

template <class Epi, class Sched, bool STAMP = false>
__device__ __forceinline__ void gemm_phase(PG8_LAS unsigned char* lds, const Gemm g, const Sched& S, const Epi& E, unsigned long long* stamps) {
    const int tid = TID(), wid = __builtin_amdgcn_readfirstlane(tid >> 6), lane = tid & 63, wr = wid >> 2, wc = wid & 3, fr = lane & 15, fq = lane >> 4;
    const int K = g.K, nt = K / BK;
    int ts_lo = 0, ts_hi = 0, nts = 0; const unsigned long long rt_entry = STAMP ? (unsigned long long)wall_clock64() : 0ull;
#define PG8_STAMP() do { if (STAMP && wid == 0 && nts < 64) { const unsigned long long _c = (unsigned long long)clock64(); \
        ts_lo = (lane == nts) ? (int)(unsigned)_c : ts_lo; ts_hi = (lane == nts) ? (int)(unsigned)(_c >> 32) : ts_hi; ++nts; } } while (0)
    PG8_STAMP();
    unsigned voffA[2], voffB[2];
#pragma unroll
    for (int i = 0; i < 2; ++i) { int R, C; stage_rc(tid * 16 + i * 8192, R, C); const int Rb = Epi::PERM ? ((R & ~31) + perm32(R & 31)) : R;
        voffA[i] = (unsigned)(R * K + C) * 2u; voffB[i] = (unsigned)(Rb * K + C) * 2u; }
    const size_t kstep = (size_t)(BK * 2);
    const size_t hstep = (size_t)HALF * K * 2;
    const size_t tstep = 2 * hstep;
    const unsigned ldsw = (unsigned)wid * 1024u;
    const int aoff = lds_byte(wr * 64 + fr, fq * 8), boff = lds_byte(wc * 32 + fr, fq * 8);
#define PG8_SA(b, h) (((b) * 2 + (h)) * HTB)
#define PG8_SB(b, h) ((4 + (b) * 2 + (h)) * HTB)
#define PG8_STAGE(bufoff, gbase, voff) do { _Pragma("unroll") for (int _i = 0; _i < 2; ++_i) \
        __builtin_amdgcn_global_load_lds((const unsigned*)((const char*)(gbase) + (voff)[_i]), (PG8_LAS unsigned*)(lds + (bufoff) + ldsw + _i * 8192), 16, 0, 0); } while (0)
#define PG8_LDA(dst, b, h) do { _Pragma("unroll") for (int m = 0; m < 4; ++m) _Pragma("unroll") for (int k = 0; k < 2; ++k) dst[m][k] = *(const PG8_LAS bf16x8*)(lds + PG8_SA(b, h) + aoff + m * 2048 + k * 1024); } while (0)
#define PG8_LDB(dst, b, h) do { _Pragma("unroll") for (int n = 0; n < 2; ++n) _Pragma("unroll") for (int k = 0; k < 2; ++k) dst[n][k] = *(const PG8_LAS bf16x8*)(lds + PG8_SB(b, h) + boff + n * 2048 + k * 1024); } while (0)
#define PG8_MMA(ai, bj, At, Bt) do { __builtin_amdgcn_s_setprio(1); _Pragma("unroll") for (int m = 0; m < 4; ++m) _Pragma("unroll") for (int n = 0; n < 2; ++n) _Pragma("unroll") for (int k = 0; k < 2; ++k) \
        acc[ai][bj][m][n] = __builtin_amdgcn_mfma_f32_16x16x32_bf16(Bt[n][k], At[m][k], acc[ai][bj][m][n], 0, 0, 0); __builtin_amdgcn_s_setprio(0); } while (0)
#define PG8_WAIT_V(n) asm volatile("s_waitcnt vmcnt(" #n ")" ::: "memory")
#define PG8_WAIT_L(n) asm volatile("s_waitcnt lgkmcnt(" #n ")" ::: "memory")
#define PG8_BAR __builtin_amdgcn_s_barrier()
#define PG8_SCHED __builtin_amdgcn_sched_barrier(0)
    Unit cur, nxt; int ui = 0;
    if (!S.next(0, cur)) return;
    f32x4 acc[2][2][4][2];
#pragma unroll
    for (int a = 0; a < 2; ++a)
#pragma unroll
        for (int b = 0; b < 2; ++b)
#pragma unroll
            for (int m = 0; m < 4; ++m)
#pragma unroll
                for (int n = 0; n < 2; ++n) acc[a][b][m][n] = (f32x4){0.f, 0.f, 0.f, 0.f};
    bf16x8 At[4][2], B0[2][2], B1[2][2];
    const char* cA = (const char*)g.A + (size_t)cur.pm * tstep; const char* cB = (const char*)g.Bt + (size_t)cur.pn * tstep;
    S.a_ready(cur);
    PG8_STAGE(PG8_SB(0, 0), cB, voffB); PG8_STAGE(PG8_SA(0, 0), cA, voffA); PG8_STAGE(PG8_SB(0, 1), cB + hstep, voffB); PG8_STAGE(PG8_SA(0, 1), cA + hstep, voffA);
    if (wr == 1) PG8_BAR;
    PG8_WAIT_V(4); PG8_BAR;
    PG8_STAGE(PG8_SB(1, 0), cB + kstep, voffB); PG8_STAGE(PG8_SA(1, 0), cA + kstep, voffA); PG8_STAGE(PG8_SB(1, 1), cB + hstep + kstep, voffB);
    PG8_WAIT_V(6); PG8_BAR;
    PG8_STAMP();
    for (;;) {
        const bool has_next = S.next(ui + 1, nxt);
        const char* nA = has_next ? (const char*)g.A + (size_t)nxt.pm * tstep : cA; const char* nB = has_next ? (const char*)g.Bt + (size_t)nxt.pn * tstep : cB;
        for (int t = 0; t < nt; t += 2) {
            const bool last = (t == nt - 2);
            const char* a1 = cA + (size_t)(t + 1) * kstep;
            const char* a2 = last ? nA : cA + (size_t)(t + 2) * kstep; const char* b2 = last ? nB : cB + (size_t)(t + 2) * kstep;
            const char* a3 = a2 + kstep; const char* b3 = b2 + kstep;
            if (last && has_next) S.a_ready(nxt);
            PG8_LDB(B0, 0, 0); PG8_SCHED; PG8_LDA(At, 0, 0); PG8_STAGE(PG8_SA(1, 1), a1 + hstep, voffA);
            PG8_WAIT_L(8); PG8_BAR; PG8_WAIT_L(0); PG8_MMA(0, 0, At, B0); PG8_BAR; PG8_SCHED;
            PG8_LDB(B1, 0, 1); PG8_STAGE(PG8_SB(0, 0), b2, voffB);
            PG8_BAR; PG8_WAIT_L(0); PG8_MMA(0, 1, At, B1); PG8_BAR;
            PG8_LDA(At, 0, 1); PG8_STAGE(PG8_SA(0, 0), a2, voffA);
            PG8_BAR; PG8_WAIT_L(0); PG8_MMA(1, 0, At, B0); PG8_BAR; PG8_SCHED;
            PG8_STAGE(PG8_SB(0, 1), b2 + hstep, voffB);
            PG8_WAIT_V(6); PG8_BAR; PG8_MMA(1, 1, At, B1); PG8_BAR;
            PG8_LDB(B0, 1, 0); PG8_SCHED; PG8_LDA(At, 1, 0); PG8_STAGE(PG8_SA(0, 1), a2 + hstep, voffA);
            PG8_WAIT_L(8); PG8_BAR; PG8_WAIT_L(0); PG8_MMA(0, 0, At, B0); PG8_BAR; PG8_SCHED;
            PG8_LDB(B1, 1, 1); PG8_STAGE(PG8_SB(1, 0), b3, voffB);
            PG8_BAR; PG8_WAIT_L(0); PG8_MMA(0, 1, At, B1); PG8_BAR;
            PG8_LDA(At, 1, 1); PG8_STAGE(PG8_SA(1, 0), a3, voffA);
            PG8_BAR; PG8_WAIT_L(0); PG8_MMA(1, 0, At, B0); PG8_BAR; PG8_SCHED;
            PG8_STAGE(PG8_SB(1, 1), b3 + hstep, voffB);
            PG8_WAIT_V(6); PG8_BAR; PG8_MMA(1, 1, At, B1); PG8_BAR;
        }
        PG8_STAMP();
        if constexpr (!Epi::AFTER_DRAIN) { E(acc, cur, wr, wc, fr, fq); S.done(cur); }
        PG8_STAMP();
        if (!has_next) break;
#pragma unroll
        for (int a = 0; a < 2; ++a)
#pragma unroll
            for (int b = 0; b < 2; ++b)
#pragma unroll
                for (int m = 0; m < 4; ++m)
#pragma unroll
                    for (int n = 0; n < 2; ++n) acc[a][b][m][n] = (f32x4){0.f, 0.f, 0.f, 0.f};
        cur = nxt; cA = nA; cB = nB; ++ui;
    }
    PG8_WAIT_V(0);
    if (wr == 0) PG8_BAR;
    PG8_BAR;
    if constexpr (Epi::AFTER_DRAIN) { E.fused(acc, cur, wr, wc, fr, fq, lds, wid, lane); S.done(cur); }
    PG8_STAMP();
    if (STAMP && wid == 0) { stamps[lane] = lane < nts ? (((unsigned long long)(unsigned)ts_hi << 32) | (unsigned)ts_lo) : 0ull;
        if (lane == 62) stamps[62] = rt_entry; if (lane == 63) stamps[63] = (unsigned long long)wall_clock64(); }
#undef PG8_STAMP
#undef PG8_SA
#undef PG8_SB
#undef PG8_STAGE
#undef PG8_LDA
#undef PG8_LDB
#undef PG8_MMA
#undef PG8_WAIT_V
#undef PG8_WAIT_L
#undef PG8_BAR
#undef PG8_SCHED
}
}


__device__ __forceinline__ u16 f2bf(float f) {
  unsigned u = __float_as_uint(f);
  u += 0x7fffu + ((u >> 16) & 1u);
  return (u16)(u >> 16);
}
__device__ __forceinline__ float bf2f(u16 h) { return __uint_as_float(((unsigned)h) << 16); }
__device__ __forceinline__ unsigned pack2(float a, float b) { return (unsigned)f2bf(a) | ((unsigned)f2bf(b) << 16); }
__device__ __forceinline__ void unpack8(const uint4 v, float (&f)[8]) {
  f[0] = bf2f((u16)(v.x & 0xffff)); f[1] = bf2f((u16)(v.x >> 16)); f[2] = bf2f((u16)(v.y & 0xffff)); f[3] = bf2f((u16)(v.y >> 16));
  f[4] = bf2f((u16)(v.z & 0xffff)); f[5] = bf2f((u16)(v.z >> 16)); f[6] = bf2f((u16)(v.w & 0xffff)); f[7] = bf2f((u16)(v.w >> 16));
}
__device__ __forceinline__ uint4 pack8s(const float (&f)[8], float sc) {
  return make_uint4(pack2(f[0] * sc, f[1] * sc), pack2(f[2] * sc, f[3] * sc), pack2(f[4] * sc, f[5] * sc), pack2(f[6] * sc, f[7] * sc));
}
__device__ __forceinline__ float silu_f(float x) { return x / (1.f + __expf(-x)); }
__device__ __forceinline__ float sigm(float x) { return 1.f / (1.f + __expf(-x)); }
__device__ __forceinline__ float wave_sum(float v) {
#pragma unroll
  for (int o = 32; o; o >>= 1) v += __shfl_xor(v, o);
  return v;
}
__device__ __forceinline__ const float* xin_of(const Params& P, int slab) { return slab == 0 ? P.in[0] : P.in[1] + (long)(slab - 1) * SLAB * D; }
__device__ __forceinline__ int Lof(int slab) { return slab == 0 ? 2048 : 8192; }
__device__ __forceinline__ int gb_row(int gr) { return gr < 16384 ? (gr >> 11) : (8 + ((gr - 16384) >> 13)); }
__device__ __forceinline__ int gb_of(int slab, int r) { return slab == 0 ? (r >> 11) : (8 + (slab - 1) * 2 + (r >> 13)); }

typedef short v4s __attribute__((ext_vector_type(4)));
#define LBAR() asm volatile("s_waitcnt lgkmcnt(0)\n\ts_barrier" ::: "memory")
#define LDS_AS __attribute__((address_space(3)))
template <int R, bool KC>
__device__ __forceinline__ uint4 ld_chunk(const u16* __restrict__ base, long ld, int k0, int c) {
  if (KC) {
    const int r = c >> 3, kc = c & 7;
    return *(const uint4*)(base + (long)r * ld + k0 + kc * 8);
  } else {
    const int k = c / (R / 8), mc = c % (R / 8);
    return *(const uint4*)(base + (long)(k0 + k) * ld + mc * 8);
  }
}
template <int R, bool KC>
__device__ __forceinline__ void st_chunk(u16* s, uint4 v, int c) {
  if (KC) {
    const int r = c >> 3, kc = c & 7;
    *(uint4*)(s + r * 72 + kc * 8) = v;
  } else {
    const int k = c / (R / 8), mc = c % (R / 8);
    *(uint4*)(s + k * (R + 8) + mc * 8) = v;
  }
}
template <int R, bool KC>
__device__ __forceinline__ bf16x8 ld_frag(const u16* s, int x0, int ks, int fr, int fq) {
  if (KC) {
    return *(const bf16x8*)(s + (x0 + fr) * 72 + ks * 32 + fq * 8);
  } else {
    const int q4 = fr >> 2, p4 = fr & 3;
    const u16* p = s + (ks * 32 + 8 * fq + q4) * (R + 8) + x0 + 4 * p4;
    v4s lo = __builtin_amdgcn_ds_read_tr16_b64_v4i16((LDS_AS v4s*)p);
    v4s hi = __builtin_amdgcn_ds_read_tr16_b64_v4i16((LDS_AS v4s*)(p + 4 * (R + 8)));
    bf16x8 r;
    r[0] = lo[0]; r[1] = lo[1]; r[2] = lo[2]; r[3] = lo[3]; r[4] = hi[0]; r[5] = hi[1]; r[6] = hi[2]; r[7] = hi[3];
    return r;
  }
}

template <int TM, int TN, bool AKC, bool BKC, bool TR, int KT>
__device__ __forceinline__ void gemm_acc(f32x4 (&acc)[TM / 32][TN / 64], const u16* __restrict__ A, long lda,
                                         const u16* __restrict__ B, long ldb, u16* sm) {
  u16* As = sm;
  u16* Bs = sm + 9216;
  const int tid = TID(), lane = tid & 63, wid = tid >> 6;
  const int wm = wid >> 2, wn = wid & 3, fr = lane & 15, fq = lane >> 4;
  constexpr int MI = TM / 32, NI = TN / 64;
  uint4 ra0[KT], ra1[KT], rb0[KT], rb1[KT];
#pragma unroll
  for (int kt = 0; kt < KT; ++kt) {
    ra0[kt] = ld_chunk<TM, AKC>(A, lda, kt * 64, tid);
    ra1[kt] = ra0[kt];
    if (TM == 128) ra1[kt] = ld_chunk<TM, AKC>(A, lda, kt * 64, tid + NT);
    rb0[kt] = ld_chunk<TN, BKC>(B, ldb, kt * 64, tid);
    rb1[kt] = rb0[kt];
    if (TN == 128) rb1[kt] = ld_chunk<TN, BKC>(B, ldb, kt * 64, tid + NT);
  }
#pragma unroll
  for (int kt = 0; kt < KT; ++kt) {
    __syncthreads();
    st_chunk<TM, AKC>(As, ra0[kt], tid);
    if (TM == 128) st_chunk<TM, AKC>(As, ra1[kt], tid + NT);
    st_chunk<TN, BKC>(Bs, rb0[kt], tid);
    if (TN == 128) st_chunk<TN, BKC>(Bs, rb1[kt], tid + NT);
    __syncthreads();
#pragma unroll
    for (int ks = 0; ks < 2; ++ks) {
      bf16x8 af[MI], bfr[NI];
#pragma unroll
      for (int mi = 0; mi < MI; ++mi) af[mi] = ld_frag<TM, AKC>(As, wm * (TM / 2) + mi * 16, ks, fr, fq);
#pragma unroll
      for (int ni = 0; ni < NI; ++ni) bfr[ni] = ld_frag<TN, BKC>(Bs, wn * (TN / 4) + ni * 16, ks, fr, fq);
#pragma unroll
      for (int mi = 0; mi < MI; ++mi)
#pragma unroll
        for (int ni = 0; ni < NI; ++ni)
          acc[mi][ni] = TR ? __builtin_amdgcn_mfma_f32_16x16x32_bf16(bfr[ni], af[mi], acc[mi][ni], 0, 0, 0)
                           : __builtin_amdgcn_mfma_f32_16x16x32_bf16(af[mi], bfr[ni], acc[mi][ni], 0, 0, 0);
    }
  }
  __syncthreads();
}

template <int KT> struct Tiles { uint4 a0[KT], a1[KT], b0[KT], b1[KT]; };
template <int TM, int TN, bool AKC, bool BKC, int KT>
__device__ __forceinline__ void tiles_issue(Tiles<KT>& t, const u16* __restrict__ A, long lda, const u16* __restrict__ B, long ldb) {
  const int tid = TID();
#pragma unroll
  for (int kt = 0; kt < KT; ++kt) {
    t.a0[kt] = ld_chunk<TM, AKC>(A, lda, kt * 64, tid);
    t.a1[kt] = t.a0[kt];
    if (TM == 128) t.a1[kt] = ld_chunk<TM, AKC>(A, lda, kt * 64, tid + NT);
    t.b0[kt] = ld_chunk<TN, BKC>(B, ldb, kt * 64, tid);
    t.b1[kt] = t.b0[kt];
    if (TN == 128) t.b1[kt] = ld_chunk<TN, BKC>(B, ldb, kt * 64, tid + NT);
  }
}
template <int TM, int TN, bool AKC, bool BKC, bool TR, int KT>
__device__ __forceinline__ void gemm_run(f32x4 (&acc)[TM / 32][TN / 64], const Tiles<KT>& t, u16* sm) {
  u16* As = sm;
  u16* Bs = sm + 9216;
  const int tid = TID(), lane = tid & 63, wid = tid >> 6;
  const int wm = wid >> 2, wn = wid & 3, fr = lane & 15, fq = lane >> 4;
  constexpr int MI = TM / 32, NI = TN / 64;
#pragma unroll
  for (int kt = 0; kt < KT; ++kt) {
    __syncthreads();
    st_chunk<TM, AKC>(As, t.a0[kt], tid);
    if (TM == 128) st_chunk<TM, AKC>(As, t.a1[kt], tid + NT);
    st_chunk<TN, BKC>(Bs, t.b0[kt], tid);
    if (TN == 128) st_chunk<TN, BKC>(Bs, t.b1[kt], tid + NT);
    __syncthreads();
#pragma unroll
    for (int ks = 0; ks < 2; ++ks) {
      bf16x8 af[MI], bfr[NI];
#pragma unroll
      for (int mi = 0; mi < MI; ++mi) af[mi] = ld_frag<TM, AKC>(As, wm * (TM / 2) + mi * 16, ks, fr, fq);
#pragma unroll
      for (int ni = 0; ni < NI; ++ni) bfr[ni] = ld_frag<TN, BKC>(Bs, wn * (TN / 4) + ni * 16, ks, fr, fq);
#pragma unroll
      for (int mi = 0; mi < MI; ++mi)
#pragma unroll
        for (int ni = 0; ni < NI; ++ni)
          acc[mi][ni] = TR ? __builtin_amdgcn_mfma_f32_16x16x32_bf16(bfr[ni], af[mi], acc[mi][ni], 0, 0, 0)
                           : __builtin_amdgcn_mfma_f32_16x16x32_bf16(af[mi], bfr[ni], acc[mi][ni], 0, 0, 0);
    }
  }
}

template <int TM, int TN, bool TR, class F>
__device__ __forceinline__ void epi_each(f32x4 (&acc)[TM / 32][TN / 64], F f) {
  const int tid = TID(), lane = tid & 63, wid = tid >> 6;
  const int wm = wid >> 2, wn = wid & 3, fr = lane & 15, fq = lane >> 4;
#pragma unroll
  for (int mi = 0; mi < TM / 32; ++mi)
#pragma unroll
    for (int ni = 0; ni < TN / 64; ++ni) {
      const int r0 = wm * (TM / 2) + mi * 16, c0 = wn * (TN / 4) + ni * 16;
      if (TR) f(r0 + fr, c0 + fq * 4, acc[mi][ni]);
      else f(r0 + fq * 4, c0 + fr, acc[mi][ni]);
    }
}

struct EpiStoreBf16 {
  static constexpr bool PERM = true, AFTER_DRAIN = false;
  u16* O; int ldc;
  __device__ __forceinline__ void operator()(const f32x4 (&acc)[2][2][4][2], const pg8::Unit& u, int wr, int wc, int fr, int fq) const {
    const int row0 = u.pm * 256 + wr * 64 + fr, col0 = u.pn * 256 + wc * 32 + 8 * fq;
#pragma unroll
    for (int ai = 0; ai < 2; ++ai)
#pragma unroll
      for (int m = 0; m < 4; ++m) {
        u16* rowp = O + (size_t)(row0 + ai * 128 + m * 16) * ldc + col0;
#pragma unroll
        for (int bj = 0; bj < 2; ++bj) {
          const f32x4 v0 = acc[ai][bj][m][0], v1 = acc[ai][bj][m][1];
          *(uint4*)(rowp + bj * 128) = make_uint4(pack2(v0[0], v0[1]), pack2(v0[2], v0[3]), pack2(v1[0], v1[1]), pack2(v1[2], v1[3]));
        }
      }
  }
};
struct EpiResid {
  static constexpr bool PERM = false, AFTER_DRAIN = false;
  float* X; const float* XS; const float* mod; int goff; int grow0;
  __device__ __forceinline__ void operator()(const f32x4 (&acc)[2][2][4][2], const pg8::Unit& u, int wr, int wc, int fr, int fq) const {
    const int row0 = u.pm * 256 + wr * 64 + fr, col0 = u.pn * 256 + wc * 32 + 4 * fq;
    const float* g = mod + (size_t)gb_row(grow0 + u.pm * 256) * 6144 + goff + col0;
    f32x4 gv[2][2];
#pragma unroll
    for (int bj = 0; bj < 2; ++bj)
#pragma unroll
      for (int n = 0; n < 2; ++n) gv[bj][n] = *(const f32x4*)(g + bj * 128 + n * 16);
#pragma unroll
    for (int am = 0; am < 4; ++am) {
      f32x4 xv[2][2][2];
#pragma unroll
      for (int mm = 0; mm < 2; ++mm)
#pragma unroll
        for (int bj = 0; bj < 2; ++bj)
#pragma unroll
          for (int n = 0; n < 2; ++n) xv[mm][bj][n] = *(const f32x4*)(XS + (size_t)(row0 + (am >> 1) * 128 + ((am & 1) * 2 + mm) * 16) * D + col0 + bj * 128 + n * 16);
#pragma unroll
      for (int mm = 0; mm < 2; ++mm)
#pragma unroll
        for (int bj = 0; bj < 2; ++bj)
#pragma unroll
          for (int n = 0; n < 2; ++n)
            *(f32x4*)(X + (size_t)(row0 + (am >> 1) * 128 + ((am & 1) * 2 + mm) * 16) * D + col0 + bj * 128 + n * 16) = xv[mm][bj][n] + gv[bj][n] * acc[am >> 1][bj][(am & 1) * 2 + mm][n];
    }
  }
};
struct EpiFfnVal {
  static constexpr bool PERM = false, AFTER_DRAIN = false;
  const u16* G; u16* ACT; const float* cw; const float* cb; int grow0;
  __device__ __forceinline__ void operator()(const f32x4 (&acc)[2][2][4][2], const pg8::Unit& u, int wr, int wc, int fr, int fq) const {
    const int row0 = u.pm * 256 + wr * 64 + fr, col0 = u.pn * 256 + wc * 32 + 4 * fq;
#pragma unroll
    for (int bj = 0; bj < 2; ++bj)
#pragma unroll
      for (int n = 0; n < 2; ++n) {
        const int c = col0 + bj * 128 + n * 16;
        const f32x4 w0 = *(const f32x4*)(cw + c), w1 = *(const f32x4*)(cw + DFF + c), w2 = *(const f32x4*)(cw + 2 * DFF + c), bb = *(const f32x4*)(cb + c);
#pragma unroll
        for (int ai = 0; ai < 2; ++ai) {
          uint2 g0[4], g1[4], g2[4];
#pragma unroll
          for (int m = 0; m < 4; ++m) {
            const int r = row0 + ai * 128 + m * 16;
            const int L = (grow0 + r) < 16384 ? 2048 : 8192;
            const int pos = (grow0 + r) & (L - 1);
            const u16* gp = G + (size_t)r * DFF + c;
            g1[m] = *(const uint2*)gp;
            g0[m] = *(const uint2*)(gp - (pos > 0 ? DFF : 0));
            g2[m] = *(const uint2*)(gp + (pos < L - 1 ? DFF : 0));
          }
#pragma unroll
          for (int m = 0; m < 4; ++m) {
            const int r = row0 + ai * 128 + m * 16;
            const int L = (grow0 + r) < 16384 ? 2048 : 8192;
            const int pos = (grow0 + r) & (L - 1);
            const float m0 = pos > 0 ? 1.f : 0.f, m2 = pos < L - 1 ? 1.f : 0.f;
            const uint2 a0 = g0[m], a1 = g1[m], a2 = g2[m];
            f32x4 a;
            a[0] = m0 * bf2f((u16)(a0.x & 0xffff)) * w0[0] + bf2f((u16)(a1.x & 0xffff)) * w1[0] + m2 * bf2f((u16)(a2.x & 0xffff)) * w2[0] + bb[0];
            a[1] = m0 * bf2f((u16)(a0.x >> 16)) * w0[1] + bf2f((u16)(a1.x >> 16)) * w1[1] + m2 * bf2f((u16)(a2.x >> 16)) * w2[1] + bb[1];
            a[2] = m0 * bf2f((u16)(a0.y & 0xffff)) * w0[2] + bf2f((u16)(a1.y & 0xffff)) * w1[2] + m2 * bf2f((u16)(a2.y & 0xffff)) * w2[2] + bb[2];
            a[3] = m0 * bf2f((u16)(a0.y >> 16)) * w0[3] + bf2f((u16)(a1.y >> 16)) * w1[3] + m2 * bf2f((u16)(a2.y >> 16)) * w2[3] + bb[3];
            const f32x4 v = acc[ai][bj][m][n];
            *(uint2*)(ACT + (size_t)r * DFF + c) = make_uint2(pack2(silu_f(a[0]) * v[0], silu_f(a[1]) * v[1]), pack2(silu_f(a[2]) * v[2], silu_f(a[3]) * v[3]));
          }
        }
      }
  }
};
template <class Epi>
__device__ __forceinline__ void run_gemm(const u16* A, const u16* Bt, int M, int N, int K, const Epi& E) {
  pg8::Gemm g; g.A = A; g.Bt = Bt; g.M = M; g.N = N; g.K = K;
  pg8::StaticOrder S; S.init(M, N, gridDim.x, BID());
  __syncthreads();
  pg8::gemm_phase<Epi, pg8::StaticOrder, false>((PG8_LAS unsigned char*)smem, g, S, E, nullptr);
  __syncthreads();
}

__device__ __forceinline__ int fidx(int p) { return p + ((p >> 6) << 2); }
__device__ __forceinline__ float2 cmulf(float2 a, float2 b) { return make_float2(a.x * b.x - a.y * b.y, a.x * b.y + a.y * b.x); }
__device__ __forceinline__ float2 cmulcf(float2 a, float2 b) { return make_float2(a.x * b.x + a.y * b.y, a.y * b.x - a.x * b.y); }
#define R16C(q) ((q) == 0 ? 1.f : (q) == 1 ? 0.9238795325f : (q) == 2 ? 0.7071067812f : (q) == 3 ? 0.3826834324f : (q) == 4 ? 0.f : (q) == 5 ? -0.3826834324f : (q) == 6 ? -0.7071067812f : -0.9238795325f)
#define R16S(q) ((q) == 0 ? 0.f : (q) == 1 ? -0.3826834324f : (q) == 2 ? -0.7071067812f : (q) == 3 ? -0.9238795325f : (q) == 4 ? -1.f : (q) == 5 ? -0.9238795325f : (q) == 6 ? -0.7071067812f : -0.3826834324f)
template <int N, int RS, bool INV>
__device__ __forceinline__ void fft_pass(float2* x, const float2* __restrict__ tw, const int S, const int tid) {
  constexpr int R = 1 << RS;
  const int E = S >> (RS - 1);
#pragma unroll 1
  for (int g = tid; g < N / R; g += NT) {
    const int blo = g & (E - 1);
    const int base = ((g - blo) << RS) + blo;
    float2 e[R];
#pragma unroll
    for (int k = 0; k < R; ++k) e[k] = x[fidx(base + k * E)];
    float2 wb[RS];
#pragma unroll
    for (int st = 0; st < RS; ++st) wb[st] = tw[blo * (8192 / (S >> st))];
#pragma unroll
    for (int sq = 0; sq < RS; ++sq) {
      const int st = INV ? (RS - 1 - sq) : sq;
      const int h = (R / 2) >> st;
#pragma unroll
      for (int k = 0; k < R; ++k) {
        if ((k & h) == 0) {
          const int m = k & (h - 1);
          const int q = m * (8 / h);
          float2 w = wb[st];
          if (q != 0) w = cmulf(w, make_float2(R16C(q), R16S(q)));
          if (!INV) {
            const float2 a = e[k], b = e[k + h];
            e[k] = make_float2(a.x + b.x, a.y + b.y);
            e[k + h] = cmulf(make_float2(a.x - b.x, a.y - b.y), w);
          } else {
            const float2 a = e[k], b = cmulcf(e[k + h], w);
            e[k] = make_float2(a.x + b.x, a.y + b.y);
            e[k + h] = make_float2(a.x - b.x, a.y - b.y);
          }
        }
      }
    }
#pragma unroll
    for (int k = 0; k < R; ++k) x[fidx(base + k * E)] = e[k];
  }
  __syncthreads();
}
template <int N>
__device__ __forceinline__ void fft_dif_t(float2* x, const float2* __restrict__ tw) {
  const int tid = TID();
  if (N == 16384) {
    fft_pass<N, 4, false>(x, tw, 8192, tid); fft_pass<N, 4, false>(x, tw, 512, tid);
    fft_pass<N, 4, false>(x, tw, 32, tid); fft_pass<N, 2, false>(x, tw, 2, tid);
  } else {
    fft_pass<N, 4, false>(x, tw, 2048, tid); fft_pass<N, 4, false>(x, tw, 128, tid); fft_pass<N, 4, false>(x, tw, 8, tid);
  }
}
template <int N>
__device__ __forceinline__ void ifft_dit_t(float2* x, const float2* __restrict__ tw) {
  const int tid = TID();
  if (N == 16384) {
    fft_pass<N, 2, true>(x, tw, 2, tid); fft_pass<N, 4, true>(x, tw, 32, tid);
    fft_pass<N, 4, true>(x, tw, 512, tid); fft_pass<N, 4, true>(x, tw, 8192, tid);
  } else {
    fft_pass<N, 4, true>(x, tw, 8, tid); fft_pass<N, 4, true>(x, tw, 128, tid); fft_pass<N, 4, true>(x, tw, 2048, tid);
  }
}
__device__ __forceinline__ void fft_dif(float2* x, int N, const float2* __restrict__ tw) {
  if (N == 16384) fft_dif_t<16384>(x, tw); else fft_dif_t<4096>(x, tw);
}
__device__ __forceinline__ void ifft_dit(float2* x, int N, const float2* __restrict__ tw) {
  if (N == 16384) ifft_dit_t<16384>(x, tw); else ifft_dit_t<4096>(x, tw);
}

__device__ void transpose_w(const float* __restrict__ W, u16* __restrict__ Wt, int K, int N) {
  float* smf = (float*)smem;
  const int tk = K / 64, tn = N / 64, tid = TID(), G = gridDim.x;
  const int kk0 = tid >> 4, n40 = tid & 15, kk1 = (tid + NT) >> 4, n41 = (tid + NT) & 15;
  int item = BID();
  float4 v0 = make_float4(0, 0, 0, 0), v1 = v0;
  if (item < tk * tn) {
    const int k0 = (item / tn) * 64, n0 = (item % tn) * 64;
    v0 = *(const float4*)(W + (long)(k0 + kk0) * N + n0 + n40 * 4);
    v1 = *(const float4*)(W + (long)(k0 + kk1) * N + n0 + n41 * 4);
  }
  for (; item < tk * tn; item += G) {
    const int k0 = (item / tn) * 64, n0 = (item % tn) * 64;
    float4 w0 = v0, w1 = v1;
    const int nx = item + G;
    if (nx < tk * tn) {
      const int k2 = (nx / tn) * 64, n2 = (nx % tn) * 64;
      w0 = *(const float4*)(W + (long)(k2 + kk0) * N + n2 + n40 * 4);
      w1 = *(const float4*)(W + (long)(k2 + kk1) * N + n2 + n41 * 4);
    }
    __syncthreads();
    { float* p = smf + kk0 * 65 + n40 * 4; p[0] = v0.x; p[1] = v0.y; p[2] = v0.z; p[3] = v0.w; }
    { float* p = smf + kk1 * 65 + n41 * 4; p[0] = v1.x; p[1] = v1.y; p[2] = v1.z; p[3] = v1.w; }
    __syncthreads();
    const int nn = tid >> 3, k8 = tid & 7;
    float f[8];
#pragma unroll
    for (int i = 0; i < 8; ++i) f[i] = smf[(k8 * 8 + i) * 65 + nn];
    *(uint4*)(Wt + (long)(n0 + nn) * K + k0 + k8 * 8) = pack8s(f, 1.f);
    v0 = w0; v1 = w1;
  }
  __syncthreads();
}

__device__ void phase_pre0(const Params& P) {
  const int tid = TID();
  const long gtid = (long)BID() * NT + tid, gsz = (long)gridDim.x * NT;
  transpose_w(P.in[7], (u16*)(WS(P) + O_WHYIN), 1024, 3072);
  transpose_w(P.in[18], (u16*)(WS(P) + O_WHYOUT), 1024, 1024);
  transpose_w(P.in[19], (u16*)(WS(P) + O_WRETIN), 1024, 6144);
  transpose_w(P.in[21], (u16*)(WS(P) + O_WRETOUT), 2048, 1024);
  transpose_w(P.in[22], (u16*)(WS(P) + O_WSWAIN), 1024, 1536);
  transpose_w(P.in[26], (u16*)(WS(P) + O_WSWAOUT), 1024, 1024);
  transpose_w(P.in[27], (u16*)(WS(P) + O_WHGIN), 1024, 5120);
  transpose_w(P.in[30], (u16*)(WS(P) + O_WHGOUT), 1024, 1024);
  for (int l = 0; l < 4; ++l) {
    transpose_w(P.in[31] + (long)l * 1024 * DFF, (u16*)(WS(P) + O_WFG) + (long)l * DFF * 1024, 1024, DFF);
    transpose_w(P.in[32] + (long)l * 1024 * DFF, (u16*)(WS(P) + O_WFV) + (long)l * DFF * 1024, 1024, DFF);
    transpose_w(P.in[35] + (long)l * DFF * 1024, (u16*)(WS(P) + O_WFD) + (long)l * 1024 * DFF, DFF, 1024);
  }
  {
    float* cs = (float*)smem;
    float* modp = (float*)(WS(P) + O_MODP);
    for (int item = BID(); item < 4 * 8 * 12; item += gridDim.x) {
      const int nb = item % 12, ks = (item / 12) % 8, l = item / 96;
      __syncthreads();
      for (int i = tid; i < 2048; i += NT) {
        int b = i >> 7, k = i & 127;
        float c = (b < 8) ? P.in[2][b * 1024 + ks * 128 + k] : P.in[3][(b - 8) * 1024 + ks * 128 + k];
        cs[i] = c / (1.f + expf(-c));
      }
      __syncthreads();
      const int n = nb * 512 + tid;
      float a[16];
#pragma unroll
      for (int b = 0; b < 16; ++b) a[b] = 0.f;
      const float* w = P.in[4] + ((long)l * 1024 + ks * 128) * 6144 + n;
      for (int k = 0; k < 128; ++k) {
        float wv = w[(long)k * 6144];
#pragma unroll
        for (int b = 0; b < 16; ++b) a[b] += cs[b * 128 + k] * wv;
      }
#pragma unroll
      for (int b = 0; b < 16; ++b) modp[(((long)ks * 4 + l) * 16 + b) * 6144 + n] = a[b];
    }
    __syncthreads();
  }
  {
    float2* tw = (float2*)(WS(P) + O_TW);
    for (long i = gtid; i < 8192; i += gsz) {
      float s, c;
      sincospif((float)i * (1.f / 8192.f), &s, &c);
      tw[i] = make_float2(c, -s);
    }
    float2* rr = (float2*)(WS(P) + O_ROPER);
    for (long i = gtid; i < (long)8192 * 128; i += gsz) {
      int pos = (int)(i >> 7), d = (int)(i & 127);
      float inv = exp2f(-(float)d * (13.287712379549449f / 128.f));
      float s, c;
      sincosf((float)pos * inv, &s, &c);
      rr[i] = make_float2(c, s);
    }
    float2* rs = (float2*)(WS(P) + O_ROPES);
    for (long i = gtid; i < (long)8192 * 32; i += gsz) {
      int pos = (int)(i >> 5), d = (int)(i & 31);
      float inv = exp2f(-(float)d * (13.287712379549449f / 32.f));
      float s, c;
      sincosf((float)pos * inv, &s, &c);
      rs[i] = make_float2(c, s);
    }
  }
  {
    float* zf = (float*)smem;
    float* h1 = zf + 8 * 36;
    const float* w1 = P.in[10]; const float* b1 = P.in[11]; const float* w2 = P.in[12]; const float* b2 = P.in[13];
    const float* fr = P.in[15];
    const int tl = tid >> 6, j = tid & 63;
    for (int item = BID(); item < 1280; item += gridDim.x) {
      const int sel = item >= 1024;
      const int L = sel ? 2048 : 8192;
      const int t = (sel ? item - 1024 : item) * 8 + tl;
      float* hid = (float*)(WS(P) + (sel ? O_HIDP : O_HIDS));
      __syncthreads();
      if (j < 33) {
        float v;
        if (j == 0) v = (float)t / (float)(L - 1);
        else {
          int i = (j - 1) & 15;
          float band = 1e-4f + (float)i * ((15.f - 1e-4f) / 15.f);
          float ang = (6.283185307179586f / (float)L) * (float)t;
          float a = band * ang;
          v = (j <= 16) ? cosf(a) : -sinf(a);
        }
        zf[tl * 36 + j] = v;
      }
      __syncthreads();
      float s = b1[j];
#pragma unroll 3
      for (int i = 0; i < 33; ++i) s += zf[tl * 36 + i] * w1[i * 64 + j];
      h1[tl * 64 + j] = sinf(fr[j] * s);
      __syncthreads();
      float s2 = b2[j];
#pragma unroll 4
      for (int i = 0; i < 64; ++i) s2 += h1[tl * 64 + i] * w2[i * 64 + j];
      hid[(long)j * L + t] = sinf(fr[j] * s2);
    }
    __syncthreads();
  }
}

__device__ void phase_pre1(const Params& P) {
  __shared__ float w3s[128];
  __shared__ float red[8];
  const int tid = TID(), lane = tid & 63, wid = tid >> 6;
  const long gtid = (long)BID() * NT + tid, gsz = (long)gridDim.x * NT;
  {
    const float* modp = (const float*)(WS(P) + O_MODP);
    float* mod = (float*)(WS(P) + O_MOD);
    for (long i = gtid; i < (long)4 * 16 * 6144; i += gsz) {
      int n = (int)(i % 6144);
      int l = (int)(i / (16 * 6144));
      float s = P.in[5][l * 6144 + n];
      for (int ks = 0; ks < 8; ++ks) s += modp[(long)ks * 4 * 16 * 6144 + i];
      mod[i] = s;
    }
  }
  float2* buf = (float2*)smem;
  const float2* tw = (const float2*)(WS(P) + O_TW);
  for (int item = BID(); item < 2048; item += gridDim.x) {
    const int sel = item >> 10, c = item & 1023;
    const int L = sel ? 2048 : 8192, N = 2 * L;
    const float* hid = (const float*)(WS(P) + (sel ? O_HIDP : O_HIDS));
    float2* hs = (float2*)(WS(P) + (sel ? O_HSPP : O_HSPS)) + (long)c * N;
    __syncthreads();
    if (tid < 128) {
      int dirn = tid >> 6, j = tid & 63;
      w3s[tid] = P.in[14][(long)j * 2048 + dirn * 1024 + c];
    }
    __syncthreads();
    const float dec0 = fabsf(P.in[16][c]), dec1 = fabsf(P.in[16][1024 + c]);
    const float invLm1 = 1.f / (float)(L - 1);
    float asum = 0.f;
    for (int n = tid; n < N; n += NT) {
      float val = 0.f;
      if (n != L) {
        const int dirn = n < L ? 0 : 1;
        const int t = n < L ? n : N - n;
        const float* hp = hid + t;
        const float* w = w3s + dirn * 64;
        float s = 0.f;
#pragma unroll 16
        for (int j = 0; j < 64; ++j) s += hp[(long)j * L] * w[j];
        float tl = (float)t * invLm1;
        val = s * expf(-tl * (dirn ? dec1 : dec0));
      }
      buf[fidx(n)] = make_float2(val, 0.f);
      asum += fabsf(val);
    }
    asum = wave_sum(asum);
    if (lane == 0) red[wid] = asum;
    __syncthreads();
    float tot = 0.f;
#pragma unroll
    for (int w = 0; w < 8; ++w) tot += red[w];
    const float scale = 1.f / (tot * (float)N);
    fft_dif(buf, N, tw);
    for (int p = tid; p < N; p += NT) {
      float2 a = buf[fidx(p)];
      hs[p] = make_float2(a.x * scale, a.y * scale);
    }
  }
  __syncthreads();
}

__device__ void phase_norm(const Params& P, int layer, int sl, int which) {
  const int grow0 = which == 1 ? sl * FSLAB : (which == 2 ? 0 : sl * SLAB), nrows = which == 1 ? FSLAB : (which == 2 ? NTOK : SLAB);
  const float* __restrict__ x = (layer == 0 && which == 0) ? xin_of(P, sl) : (const float*)(OUTP(P) + (long)grow0 * D);
  u16* __restrict__ h = (u16*)(WS(P) + (which == 1 ? O_FHBUF : (which == 2 ? O_SA_H : O_HBUF)));
  const float* gain = P.in[6] + (layer * 2 + (which == 1 ? 1 : 0)) * D;
  const float* mod = (const float*)(WS(P) + O_MOD) + (long)layer * 16 * 6144;
  const int shoff = which == 1 ? 3 * D : 0, scoff = which == 1 ? 4 * D : D;
  const int tid = TID(), lane = tid & 63, wid = tid >> 6;
  for (int item = BID(); item < nrows / 32; item += gridDim.x) {
    const int r0 = item * 32 + wid * 4;
    float4 v[4][4];
    float ss[4];
#pragma unroll
    for (int u = 0; u < 4; ++u) {
      const float* xr = x + (long)(r0 + u) * D;
      float a = 0.f;
#pragma unroll
      for (int i = 0; i < 4; ++i) {
        v[u][i] = *(const float4*)(xr + i * 256 + lane * 4);
        a += v[u][i].x * v[u][i].x + v[u][i].y * v[u][i].y + v[u][i].z * v[u][i].z + v[u][i].w * v[u][i].w;
      }
      ss[u] = a;
    }
    const float* m = mod + (long)gb_row(grow0 + r0) * 6144;
#pragma unroll
    for (int u = 0; u < 4; ++u) ss[u] = wave_sum(ss[u]);
#pragma unroll
    for (int i = 0; i < 4; ++i) {
      const int col = i * 256 + lane * 4;
      const float4 g = *(const float4*)(gain + col);
      const float4 sc = *(const float4*)(m + scoff + col);
      const float4 sh = *(const float4*)(m + shoff + col);
      const float a0 = g.x * (1.f + sc.x), a1 = g.y * (1.f + sc.y), a2 = g.z * (1.f + sc.z), a3 = g.w * (1.f + sc.w);
#pragma unroll
      for (int u = 0; u < 4; ++u) {
        const float rstd = rsqrtf(ss[u] * (1.f / 1024.f) + 1e-6f);
        const float y0 = v[u][i].x * rstd * a0 + sh.x, y1 = v[u][i].y * rstd * a1 + sh.y;
        const float y2 = v[u][i].z * rstd * a2 + sh.z, y3 = v[u][i].w * rstd * a3 + sh.w;
        *(uint2*)(h + (long)(r0 + u) * D + col) = make_uint2(pack2(y0, y1), pack2(y2, y3));
      }
    }
  }
}

__device__ void phase_proj(const Params& P, size_t woff, int N) {
  EpiStoreBf16 E; E.O = (u16*)(WS(P) + O_PROJ); E.ldc = N;
  run_gemm((const u16*)(WS(P) + O_HBUF), (const u16*)(WS(P) + woff), SLAB, N, D, E);
}
__device__ void phase_resid(const Params& P, int layer, int slab, const u16* A, int K, size_t woff, int goff) {
  EpiResid E; E.X = OUTP(P) + (long)slab * SLAB * D; E.XS = (layer == 0) ? xin_of(P, slab) : (const float*)E.X; E.mod = (const float*)(WS(P) + O_MOD) + (long)layer * 16 * 6144; E.goff = goff; E.grow0 = slab * SLAB;
  run_gemm(A, (const u16*)(WS(P) + woff), SLAB, D, K, E);
}

__device__ void phase_ffn_gate(const Params& P, int layer) {
  EpiStoreBf16 E; E.O = (u16*)(WS(P) + O_FGBUF); E.ldc = DFF;
  run_gemm((const u16*)(WS(P) + O_FHBUF), (const u16*)(WS(P) + O_WFG) + (long)layer * DFF * D, FSLAB, DFF, D, E);
}
__device__ void phase_ffn_val(const Params& P, int layer, int fs) {
  EpiFfnVal E; E.G = (const u16*)(WS(P) + O_FGBUF); E.ACT = (u16*)(WS(P) + O_FACT) + (long)fs * FSLAB * DFF;
  E.cw = P.in[33] + (long)layer * 3 * DFF; E.cb = P.in[34] + (long)layer * DFF; E.grow0 = fs * FSLAB;
  run_gemm((const u16*)(WS(P) + O_FHBUF), (const u16*)(WS(P) + O_WFV) + (long)layer * DFF * D, FSLAB, DFF, D, E);
}
__device__ void phase_ffn_down(const Params& P, int layer) {
  EpiResid E; E.X = OUTP(P); E.XS = E.X; E.mod = (const float*)(WS(P) + O_MOD) + (long)layer * 16 * 6144; E.goff = 5 * D; E.grow0 = 0;
  run_gemm((const u16*)(WS(P) + O_FACT), (const u16*)(WS(P) + O_WFD) + (long)layer * D * DFF, NTOK, D, DFF, E);
}

__device__ void phase_hy_conv(const Params& P, int slab) {
  const int L = Lof(slab), nseq = SLAB / L, tid = TID();
  const u16* __restrict__ z = (const u16*)(WS(P) + O_PROJ);
  float* __restrict__ uT = (float*)(WS(P) + O_UT);
  u16* __restrict__ x0c = (u16*)(WS(P) + O_X0C);
  const float* cw = P.in[8];
  const float* cb = P.in[9];
  float* tile = (float*)smem;
  const int ntt = L / 64;
  const int nitems = nseq * ntt * 16;
  const int tl = tid >> 3, cg = tid & 7;
  for (int item = BID(); item < nitems; item += gridDim.x) {
    const int ct = item % 16, tt = (item / 16) % ntt, seq = item / (16 * ntt);
    const int t = tt * 64 + tl, c0 = ct * 64 + cg * 8;
    const long row = (long)seq * L + t;
    const float mp = t > 0 ? 1.f : 0.f, mn = t < L - 1 ? 1.f : 0.f;
    const long rp = t > 0 ? row - 1 : row, rn = t < L - 1 ? row + 1 : row;
    float val[3][8];
#pragma unroll
    for (int q = 0; q < 3; ++q) {
      const int col = q * 1024 + c0;
      float a[8], b[8], c[8];
      unpack8(*(const uint4*)(z + rp * 3072 + col), a);
      unpack8(*(const uint4*)(z + row * 3072 + col), b);
      unpack8(*(const uint4*)(z + rn * 3072 + col), c);
      const float4 w0a = *(const float4*)(cw + col), w0b = *(const float4*)(cw + col + 4);
      const float4 w1a = *(const float4*)(cw + 3072 + col), w1b = *(const float4*)(cw + 3072 + col + 4);
      const float4 w2a = *(const float4*)(cw + 6144 + col), w2b = *(const float4*)(cw + 6144 + col + 4);
      const float4 ba = *(const float4*)(cb + col), bb = *(const float4*)(cb + col + 4);
      const float w0[8] = {w0a.x, w0a.y, w0a.z, w0a.w, w0b.x, w0b.y, w0b.z, w0b.w};
      const float w1[8] = {w1a.x, w1a.y, w1a.z, w1a.w, w1b.x, w1b.y, w1b.z, w1b.w};
      const float w2[8] = {w2a.x, w2a.y, w2a.z, w2a.w, w2b.x, w2b.y, w2b.z, w2b.w};
      const float bs[8] = {ba.x, ba.y, ba.z, ba.w, bb.x, bb.y, bb.z, bb.w};
#pragma unroll
      for (int i = 0; i < 8; ++i) val[q][i] = mp * a[i] * w0[i] + b[i] * w1[i] + mn * c[i] * w2[i] + bs[i];
    }
    *(uint4*)(x0c + row * 1024 + c0) = pack8s(val[0], 1.f);
    __syncthreads();
#pragma unroll
    for (int i = 0; i < 8; ++i) tile[tl * 65 + cg * 8 + i] = val[1][i] * val[2][i];
    __syncthreads();
    {
      const int cl = tid >> 3, tq = tid & 7;
      float* dst = uT + ((long)seq * 1024 + ct * 64 + cl) * L + tt * 64 + tq * 8;
      float4 o0, o1;
      o0.x = tile[(tq * 8 + 0) * 65 + cl]; o0.y = tile[(tq * 8 + 1) * 65 + cl]; o0.z = tile[(tq * 8 + 2) * 65 + cl]; o0.w = tile[(tq * 8 + 3) * 65 + cl];
      o1.x = tile[(tq * 8 + 4) * 65 + cl]; o1.y = tile[(tq * 8 + 5) * 65 + cl]; o1.z = tile[(tq * 8 + 6) * 65 + cl]; o1.w = tile[(tq * 8 + 7) * 65 + cl];
      *(float4*)dst = o0; *(float4*)(dst + 4) = o1;
    }
  }
  __syncthreads();
}

__device__ void phase_hy_fft(const Params& P, int slab, bool dry = false) {
  const int L = Lof(slab), N = 2 * L, nseq = SLAB / L, tid = TID();
  float* uT = (float*)(WS(P) + O_UT);
  const float2* hsb = (const float2*)(WS(P) + (slab == 0 ? O_HSPP : O_HSPS));
  const float2* tw = (const float2*)(WS(P) + O_TW);
  const float* skip = P.in[17];
  float2* buf = (float2*)smem;
  const int nitems = (nseq / 2) * 1024;
  for (int item = BID(); item < nitems; item += gridDim.x) {
    const int pr = item >> 10, c = item & 1023;
    float* u0 = uT + ((long)(pr * 2) * 1024 + c) * L;
    float* u1 = u0 + (long)1024 * L;
    __syncthreads();
    for (int t = tid; t < L; t += NT) {
      buf[fidx(t)] = make_float2(u0[t], u1[t]);
      buf[fidx(t + L)] = make_float2(0.f, 0.f);
    }
    __syncthreads();
    fft_dif(buf, N, tw);
    const float2* h = hsb + (long)c * N;
    for (int p = tid; p < N; p += NT) {
      float2 a = buf[fidx(p)], b = h[p];
      buf[fidx(p)] = make_float2(a.x * b.x - a.y * b.y, a.x * b.y + a.y * b.x);
    }
    __syncthreads();
    ifft_dit(buf, N, tw);
    const float sk = skip[c];
    for (int t = tid; t < L; t += NT) {
      float2 y = buf[fidx(t)];
      const long doff = dry ? (long)(END_HY - O_UT) / 4 : 0;
      u0[t + doff] = y.x + u0[t] * sk;
      u1[t + doff] = y.y + u1[t] * sk;
    }
  }
  __syncthreads();
}

__device__ void phase_hy_tr(const Params& P, int slab) {
  const int L = Lof(slab), nseq = SLAB / L, tid = TID();
  const float* __restrict__ yT = (const float*)(WS(P) + O_UT);
  const u16* __restrict__ x0c = (const u16*)(WS(P) + O_X0C);
  u16* __restrict__ a2 = (u16*)(WS(P) + O_A2);
  float* tile = (float*)smem;
  const int ntt = L / 64;
  const int nitems = nseq * ntt * 16;
  for (int item = BID(); item < nitems; item += gridDim.x) {
    const int ct = item % 16, tt = (item / 16) % ntt, seq = item / (16 * ntt);
    const int cl = tid >> 3, tq = tid & 7;
    const float* src = yT + ((long)seq * 1024 + ct * 64 + cl) * L + tt * 64 + tq * 8;
    const float4 i0 = *(const float4*)src, i1 = *(const float4*)(src + 4);
    const int tl = tid >> 3, cg = tid & 7;
    const long row = (long)seq * L + tt * 64 + tl;
    const int c0 = ct * 64 + cg * 8;
    float xg[8];
    unpack8(*(const uint4*)(x0c + row * 1024 + c0), xg);
    __syncthreads();
    float* p = tile + cl * 65 + tq * 8;
    p[0] = i0.x; p[1] = i0.y; p[2] = i0.z; p[3] = i0.w; p[4] = i1.x; p[5] = i1.y; p[6] = i1.z; p[7] = i1.w;
    __syncthreads();
    float o[8];
#pragma unroll
    for (int i = 0; i < 8; ++i) o[i] = tile[(cg * 8 + i) * 65 + tl] * xg[i];
    *(uint4*)(a2 + row * 1024 + c0) = pack8s(o, 1.f);
  }
  __syncthreads();
}

struct Rec {
  int H, DK, DV, C;
  int ldv, voff, goff;
};
__device__ __forceinline__ Rec rec_of(int kind) {
  Rec r;
  if (kind == 1) { r.H = 4; r.DK = 256; r.DV = 512; r.C = 256; r.ldv = 6144; r.voff = 2048; r.goff = 4096; }
  else { r.H = 8; r.DK = 128; r.DV = 128; r.C = 128; r.ldv = 5120; r.voff = 1024; r.goff = 4096; }
  return r;
}

__device__ void phase_ret_prep(const Params& P, int slab) {
  const int L = Lof(slab);
  const u16* __restrict__ pj = (const u16*)(WS(P) + O_PROJ);
  u16* __restrict__ qdf = (u16*)(WS(P) + O_QDF); u16* __restrict__ qdb = (u16*)(WS(P) + O_QDB);
  u16* __restrict__ kif = (u16*)(WS(P) + O_KIF); u16* __restrict__ kib = (u16*)(WS(P) + O_KIB);
  u16* __restrict__ kef = (u16*)(WS(P) + O_KEF); u16* __restrict__ keb = (u16*)(WS(P) + O_KEB);
  float* dlf = (float*)(WS(P) + O_DLF); float* dlb = (float*)(WS(P) + O_DLB);
  const float2* __restrict__ rope = (const float2*)(WS(P) + O_ROPER);
  const long gtid = (long)BID() * NT + TID(), gsz = (long)gridDim.x * NT;
  for (long idx = gtid; idx < (long)SLAB * 64; idx += gsz) {
    const int d0 = (int)(idx & 15) * 8, h = (int)((idx >> 4) & 3), t = (int)(idx >> 6);
    const int pos = t & (L - 1), r = t & 255;
    const float lgf = -expf(P.in[20][h]), lgb = -expf(P.in[20][4 + h]);
    const u16* row = pj + (long)t * 6144 + h * 256 + d0;
    const uint4 vq1 = *(const uint4*)row, vq2 = *(const uint4*)(row + 128);
    const uint4 vk1 = *(const uint4*)(row + 1024), vk2 = *(const uint4*)(row + 1024 + 128);
    const float4* rp = (const float4*)(rope + (long)pos * 128 + d0);
    const float4 c01 = rp[0], c23 = rp[1], c45 = rp[2], c67 = rp[3];
    float q1[8], q2[8], k1[8], k2[8];
    unpack8(vq1, q1); unpack8(vq2, q2); unpack8(vk1, k1); unpack8(vk2, k2);
    const float cs[8] = {c01.x, c01.z, c23.x, c23.z, c45.x, c45.z, c67.x, c67.z};
    const float sn[8] = {c01.y, c01.w, c23.y, c23.w, c45.y, c45.w, c67.y, c67.w};
    float qa[8], qb[8], ka[8], kb[8];
#pragma unroll
    for (int i = 0; i < 8; ++i) {
      qa[i] = q1[i] * cs[i] - q2[i] * sn[i]; qb[i] = q1[i] * sn[i] + q2[i] * cs[i];
      ka[i] = (k1[i] * cs[i] - k2[i] * sn[i]) * 0.0625f; kb[i] = (k1[i] * sn[i] + k2[i] * cs[i]) * 0.0625f;
    }
    const float bf = (float)(r + 1) * lgf, bb = (float)(256 - r) * lgb;
    const float ef = expf(bf), eif = expf(-bf), eef = expf((float)(255 - r) * lgf);
    const float eb = expf(bb), eib = expf(-bb), eeb = expf((float)r * lgb);
    const long o1 = (long)t * 1024 + h * 256 + d0, o2 = o1 + 128;
    *(uint4*)(qdf + o1) = pack8s(qa, ef); *(uint4*)(qdf + o2) = pack8s(qb, ef);
    *(uint4*)(qdb + o1) = pack8s(qa, eb); *(uint4*)(qdb + o2) = pack8s(qb, eb);
    *(uint4*)(kef + o1) = pack8s(ka, eef); *(uint4*)(kef + o2) = pack8s(kb, eef);
    *(uint4*)(keb + o1) = pack8s(ka, eeb); *(uint4*)(keb + o2) = pack8s(kb, eeb);
    if (r == 0) {
      const long cgi = (long)(t >> 8) * 1024 + h * 256 + d0;
      const float df = expf(256.f * lgf), db = expf(256.f * lgb);
#pragma unroll
      for (int i = 0; i < 8; ++i) { dlf[cgi + i] = df; dlf[cgi + 128 + i] = df; dlb[cgi + i] = db; dlb[cgi + 128 + i] = db; }
    }
  }
}

__device__ __forceinline__ float lb_of(const float* lbt, int dr, int ch) {
  const float a0 = lbt[(dr * 4 + 0) * 1024 + ch], a1 = lbt[(dr * 4 + 1) * 1024 + ch], a2 = lbt[(dr * 4 + 2) * 1024 + ch], a3 = lbt[(dr * 4 + 3) * 1024 + ch];
  const float m = fmaxf(fmaxf(a0, a1), fmaxf(a2, a3));
  const float e0 = expf(a0 - m), e1 = expf(a1 - m), e2 = expf(a2 - m), e3 = expf(a3 - m);
  return (e0 + e1 + e2) / (e0 + e1 + e2 + e3);
}
__device__ void phase_hg_prep(const Params& P) {
  const u16* __restrict__ pj = (const u16*)(WS(P) + O_PROJ);
  u16* __restrict__ qdf = (u16*)(WS(P) + O_QDF); u16* __restrict__ qdb = (u16*)(WS(P) + O_QDB);
  u16* __restrict__ kif = (u16*)(WS(P) + O_KIF); u16* __restrict__ kib = (u16*)(WS(P) + O_KIB);
  u16* __restrict__ kef = (u16*)(WS(P) + O_KEF); u16* __restrict__ keb = (u16*)(WS(P) + O_KEB);
  float* dlf = (float*)(WS(P) + O_DLF); float* dlb = (float*)(WS(P) + O_DLB);
  const float* lbt = P.in[28];
  float* totF = (float*)smem;
  float* totB = totF + 1024;
  const int tid = TID(), lane = tid & 63, rg = tid >> 6;
  constexpr int RPT = 16;
  for (int item = BID(); item < 1024; item += gridDim.x) {
    const int cgi = item >> 3, ch = (item & 7) * 128 + lane * 2;
    const long t0 = (long)cgi * 128 + rg * RPT;
    unsigned wq[RPT], wf[RPT], wb[RPT];
#pragma unroll
    for (int i = 0; i < RPT; ++i) {
      const u16* row = pj + (t0 + i) * 5120 + ch;
      wq[i] = *(const unsigned*)row; wf[i] = *(const unsigned*)(row + 2048); wb[i] = *(const unsigned*)(row + 3072);
    }
    float lb0[2], lb1[2];
    lb0[0] = lb_of(lbt, 0, ch); lb0[1] = lb_of(lbt, 0, ch + 1);
    lb1[0] = lb_of(lbt, 1, ch); lb1[1] = lb_of(lbt, 1, ch + 1);
    float pf[2][RPT], sb[2][RPT], accf[2], accb[2];
#pragma unroll
    for (int c = 0; c < 2; ++c) {
      float a = 0.f;
#pragma unroll
      for (int i = 0; i < RPT; ++i) {
        const float x = bf2f((u16)(c ? (wf[i] >> 16) : (wf[i] & 0xffff)));
        a += logf(lb0[c] + (1.f - lb0[c]) * sigm(x)); pf[c][i] = a;
      }
      accf[c] = a;
      a = 0.f;
#pragma unroll
      for (int i = RPT - 1; i >= 0; --i) {
        const float x = bf2f((u16)(c ? (wb[i] >> 16) : (wb[i] & 0xffff)));
        a += logf(lb1[c] + (1.f - lb1[c]) * sigm(x)); sb[c][i] = a;
      }
      accb[c] = a;
    }
    __syncthreads();
    *(float2*)(totF + rg * 128 + lane * 2) = make_float2(accf[0], accf[1]);
    *(float2*)(totB + rg * 128 + lane * 2) = make_float2(accb[0], accb[1]);
    __syncthreads();
    float offF[2] = {0.f, 0.f}, offB[2] = {0.f, 0.f}, totf[2] = {0.f, 0.f}, totb[2] = {0.f, 0.f};
#pragma unroll
    for (int g = 0; g < 8; ++g) {
      const float2 f = *(const float2*)(totF + g * 128 + lane * 2), bq = *(const float2*)(totB + g * 128 + lane * 2);
      totf[0] += f.x; totf[1] += f.y; totb[0] += bq.x; totb[1] += bq.y;
      if (g < rg) { offF[0] += f.x; offF[1] += f.y; }
      if (g > rg) { offB[0] += bq.x; offB[1] += bq.y; }
    }
#pragma unroll
    for (int i = 0; i < RPT; ++i) {
      float o[6][2];
#pragma unroll
      for (int c = 0; c < 2; ++c) {
        const float xq = bf2f((u16)(c ? (wq[i] >> 16) : (wq[i] & 0xffff)));
        const float xf = bf2f((u16)(c ? (wf[i] >> 16) : (wf[i] & 0xffff)));
        const float xb = bf2f((u16)(c ? (wb[i] >> 16) : (wb[i] & 0xffff)));
        const float q = silu_f(xq);
        const float bf = offF[c] + pf[c][i], bb = offB[c] + sb[c][i];
        const float kf = (1.f - lb0[c]) * sigm(-xf), kb = (1.f - lb1[c]) * sigm(-xb);
        o[0][c] = q * expf(bf); o[1][c] = kf * expf(-bf); o[2][c] = kf * expf(totf[c] - bf);
        o[3][c] = q * expf(bb); o[4][c] = kb * expf(-bb); o[5][c] = kb * expf(totb[c] - bb);
      }
      const long oo = (t0 + i) * 1024 + ch;
      *(unsigned*)(qdf + oo) = pack2(o[0][0], o[0][1]);
      *(unsigned*)(kif + oo) = pack2(o[1][0], o[1][1]);
      *(unsigned*)(kef + oo) = pack2(o[2][0], o[2][1]);
      *(unsigned*)(qdb + oo) = pack2(o[3][0], o[3][1]);
      *(unsigned*)(kib + oo) = pack2(o[4][0], o[4][1]);
      *(unsigned*)(keb + oo) = pack2(o[5][0], o[5][1]);
    }
    if (rg == 0) {
      *(float2*)(dlf + (long)cgi * 1024 + ch) = make_float2(expf(totf[0]), expf(totf[1]));
      *(float2*)(dlb + (long)cgi * 1024 + ch) = make_float2(expf(totb[0]), expf(totb[1]));
    }
  }
  __syncthreads();
}

template <int C, int DKT>
__device__ __forceinline__ void rec_scores_item(const Params& P, const Rec& R, int cgi, int h, int ti, int tj) {
  constexpr int T = C > 128 ? 128 : C, KTS = DKT;
  const u16* qdf = (const u16*)(WS(P) + O_QDF); const u16* qdb = (const u16*)(WS(P) + O_QDB);
  const u16* kif = (const u16*)(WS(P) + O_KIF); const u16* kib = (const u16*)(WS(P) + O_KIB);
  u16* sc = (u16*)(WS(P) + O_SC) + (((long)cgi * R.H + h) * C + ti * T) * C + tj * T;
  const long offA = ((long)cgi * C + ti * T) * 1024 + h * R.DK, offB = ((long)cgi * C + tj * T) * 1024 + h * R.DK;
  f32x4 af[T / 32][T / 64] = {}, ab[T / 32][T / 64] = {};
  float sff = 1.f, sfb = 1.f;
  if (C == 256) {
    kif = (const u16*)(WS(P) + O_KEF); kib = (const u16*)(WS(P) + O_KEB);
    sff = expf((float)C * expf(P.in[20][h])); sfb = expf((float)C * expf(P.in[20][4 + h]));
  }
  if (ti >= tj) gemm_acc<T, T, true, true, true, KTS>(af, qdf + offA, 1024, kif + offB, 1024, (u16*)smem);
  if (ti <= tj) gemm_acc<T, T, true, true, true, KTS>(ab, qdb + offA, 1024, kib + offB, 1024, (u16*)smem);
  const int tid = TID(), lane = tid & 63, wid = tid >> 6;
  const int wm = wid >> 2, wn = wid & 3, fr = lane & 15, fq = lane >> 4;
#pragma unroll
  for (int mi = 0; mi < T / 32; ++mi)
#pragma unroll
    for (int ni = 0; ni < T / 64; ++ni) {
      const int r = wm * (T / 2) + mi * 16 + fr, c0 = wn * (T / 4) + ni * 16 + fq * 4;
      const int gr = ti * T + r;
      float v[4];
#pragma unroll
      for (int j = 0; j < 4; ++j) {
        const int gc = tj * T + c0 + j;
        v[j] = (gc <= gr ? af[mi][ni][j] * sff : 0.f) + (gc >= gr ? ab[mi][ni][j] * sfb : 0.f);
      }
      *(uint2*)(sc + r * C + c0) = make_uint2(pack2(v[0], v[1]), pack2(v[2], v[3]));
    }
}

template <int C, int DKT>
__device__ void phase_rec_su(const Params& P, int kind) {
  const Rec R = rec_of(kind);
  constexpr int KTU = C / 64;
  const int nch = SLAB / C;
  constexpr int NT1 = (C > 128 ? C / 128 : 1), NTT = NT1 * NT1;
  const int n_sc = nch * R.H * NTT;
  const int mtn = R.DK / 128, ntn = R.DV / 128;
  const int n_u = nch * R.H * 2 * mtn * ntn, G = gridDim.x;
  const u16* pj = (const u16*)(WS(P) + O_PROJ);
  for (int item = BID(); item < n_sc; item += G) { const int tl = item % NTT, hh = (item / NTT) % R.H, cg = item / (NTT * R.H); rec_scores_item<C, DKT>(P, R, cg, hh, tl / NT1, tl % NT1); }
  const u16* kef = (const u16*)(WS(P) + O_KEF); const u16* keb = (const u16*)(WS(P) + O_KEB);
  u16* stfb = (u16*)(WS(P) + O_STF); u16* stbb = (u16*)(WS(P) + O_STB);
  Tiles<KTU> ta, tb;
#define U_DECODE(q_, nt_, mt_, dir_, h_, cgi_) int nt_, mt_, dir_, h_, cgi_; { int qq = (q_); nt_ = qq % ntn; qq /= ntn; mt_ = qq % mtn; qq /= mtn; dir_ = qq & 1; qq >>= 1; h_ = qq % R.H; cgi_ = qq / R.H; }
#define U_ISSUE(T_, nt_, mt_, dir_, h_, cgi_) tiles_issue<128, 128, false, false, KTU>(T_, (dir_ ? keb : kef) + (long)cgi_ * C * 1024 + h_ * R.DK + mt_ * 128, 1024, pj + (long)cgi_ * C * R.ldv + R.voff + h_ * R.DV + nt_ * 128, R.ldv)
#define U_RUN(T_, nt_, mt_, dir_, h_, cgi_) { f32x4 acc[4][2] = {}; gemm_run<128, 128, false, false, false, KTU>(acc, T_, (u16*)smem); \
    u16* st = (dir_ ? stbb : stfb) + (((long)cgi_ * R.H + h_) * R.DV + nt_ * 128) * R.DK + mt_ * 128; const int DK = R.DK; \
    epi_each<128, 128, false>(acc, [&](int r, int c, f32x4 val) { *(uint2*)(st + (long)c * DK + r) = make_uint2(pack2(val[0], val[1]), pack2(val[2], val[3])); }); }
  int q = BID();
  if (q < n_u) { U_DECODE(q, nt, mt, dir, h, cgi); U_ISSUE(ta, nt, mt, dir, h, cgi); }
  for (; q < n_u; q += 2 * G) {
    U_DECODE(q, nt, mt, dir, h, cgi);
    const int q2 = q + G;
    if (q2 < n_u) { U_DECODE(q2, nt2, mt2, dir2, h2, cgi2); U_ISSUE(tb, nt2, mt2, dir2, h2, cgi2); }
    U_RUN(ta, nt, mt, dir, h, cgi);
    const int q3 = q + 2 * G;
    if (q3 < n_u) { U_DECODE(q3, nt3, mt3, dir3, h3, cgi3); U_ISSUE(ta, nt3, mt3, dir3, h3, cgi3); }
    if (q2 < n_u) { U_DECODE(q2, nt2, mt2, dir2, h2, cgi2); U_RUN(tb, nt2, mt2, dir2, h2, cgi2); }
  }
#undef U_DECODE
#undef U_ISSUE
#undef U_RUN
  __syncthreads();
}

__device__ void phase_rec_scan(const Params& P, int kind, int slab, bool dry = false) {
  const Rec R = rec_of(kind);
  const int L = Lof(slab), nseq = SLAB / L, ncs = L / R.C;
  const int qdk = R.DK / 4;
  const long per = (long)R.H * R.DV * qdk;
  const long total = 2 * nseq * per;
  const long gtid = (long)BID() * NT + TID(), gsz = (long)gridDim.x * NT;
  for (long idx = gtid; idx < total; idx += gsz) {
    long q = idx;
    const int pd = (int)(q % qdk); q /= qdk;
    const int e = (int)(q % R.DV); q /= R.DV;
    const int h = (int)(q % R.H); q /= R.H;
    const int seq = (int)(q % nseq);
    const int dir = (int)(q / nseq);
    u16* st = (u16*)(WS(P) + (dir ? O_STB : O_STF));
    u16* stw = dry ? (u16*)(WS(P) + O_OBUF) : st;
    const float* dl = (const float*)(WS(P) + (dir ? O_DLB : O_DLF));
    float s0 = 0.f, s1 = 0.f, s2 = 0.f, s3 = 0.f;
    const long ebase = ((long)h * R.DV + e) * R.DK + pd * 4;
    const long cstride = (long)R.H * R.DV * R.DK;
    const int dbase = h * R.DK + pd * 4;
    for (int i0 = 0; i0 < ncs; i0 += 8) {
      uint2 u[8];
      float4 dd[8];
#pragma unroll
      for (int j = 0; j < 8; ++j) {
        const int n = dir ? (ncs - 1 - i0 - j) : (i0 + j);
        const long cgi = (long)seq * ncs + n;
        u[j] = *(const uint2*)(st + cgi * cstride + ebase);
        dd[j] = *(const float4*)(dl + cgi * 1024 + dbase);
      }
#pragma unroll
      for (int j = 0; j < 8; ++j) {
        const int n = dir ? (ncs - 1 - i0 - j) : (i0 + j);
        const long cgi = (long)seq * ncs + n;
        *(uint2*)(stw + cgi * cstride + ebase) = make_uint2(pack2(s0, s1), pack2(s2, s3));
        s0 = dd[j].x * s0 + bf2f((u16)(u[j].x & 0xffff));
        s1 = dd[j].y * s1 + bf2f((u16)(u[j].x >> 16));
        s2 = dd[j].z * s2 + bf2f((u16)(u[j].y & 0xffff));
        s3 = dd[j].w * s3 + bf2f((u16)(u[j].y >> 16));
      }
    }
  }
}

template <int C, int DKT>
__device__ void phase_rec_out(const Params& P, int kind) {
  const Rec R = rec_of(kind);
  constexpr int T = C > 128 ? 128 : C, NRT = C / T;
  constexpr int KT1 = C / 64, KT2 = DKT;
  const int nch = SLAB / C, ntn = R.DV / 128;
  const u16* pj = (const u16*)(WS(P) + O_PROJ);
  const u16* scb = (const u16*)(WS(P) + O_SC);
  const u16* qdf = (const u16*)(WS(P) + O_QDF); const u16* qdb = (const u16*)(WS(P) + O_QDB);
  const u16* stf = (const u16*)(WS(P) + O_STF); const u16* stb = (const u16*)(WS(P) + O_STB);
  u16* ob = (u16*)(WS(P) + O_OBUF);
  const int HDV = R.H * R.DV;
  const int nitems = nch * R.H * NRT * ntn, G = gridDim.x;
  Tiles<KT1> t1; Tiles<KT2> t2; Tiles<KT2> t3;
  int item = BID();
  if (item < nitems) {
    const int nt = item % ntn, rt = (item / ntn) % NRT, h = (item / (ntn * NRT)) % R.H, cgi = item / (ntn * NRT * R.H);
    tiles_issue<T, 128, true, false, KT1>(t1, scb + (((long)cgi * R.H + h) * C + rt * T) * C, C, pj + (long)cgi * C * R.ldv + R.voff + h * R.DV + nt * 128, R.ldv);
  }
  for (; item < nitems; item += G) {
    const int nt = item % ntn, rt = (item / ntn) % NRT, h = (item / (ntn * NRT)) % R.H, cgi = item / (ntn * NRT * R.H);
    const long qoff = ((long)cgi * C + rt * T) * 1024 + h * R.DK;
    const long soff = (((long)cgi * R.H + h) * R.DV + nt * 128) * R.DK;
    f32x4 acc[T / 32][2] = {};
    tiles_issue<T, 128, true, true, KT2>(t2, qdf + qoff, 1024, stf + soff, R.DK);
    gemm_run<T, 128, true, false, true, KT1>(acc, t1, (u16*)smem);
    tiles_issue<T, 128, true, true, KT2>(t3, qdb + qoff, 1024, stb + soff, R.DK);
    gemm_run<T, 128, true, true, true, KT2>(acc, t2, (u16*)smem);
    const int nx = item + G;
    if (nx < nitems) {
      const int nt2 = nx % ntn, rt2 = (nx / ntn) % NRT, h2 = (nx / (ntn * NRT)) % R.H, cg2 = nx / (ntn * NRT * R.H);
      tiles_issue<T, 128, true, false, KT1>(t1, scb + (((long)cg2 * R.H + h2) * C + rt2 * T) * C, C, pj + (long)cg2 * C * R.ldv + R.voff + h2 * R.DV + nt2 * 128, R.ldv);
    }
    gemm_run<T, 128, true, true, true, KT2>(acc, t3, (u16*)smem);
    u16* o = ob + ((long)cgi * C + rt * T) * HDV + h * R.DV + nt * 128;
    epi_each<T, 128, true>(acc, [&](int r, int c, f32x4 val) { *(uint2*)(o + (long)r * HDV + c) = make_uint2(pack2(val[0], val[1]), pack2(val[2], val[3])); });
  }
  __syncthreads();
}

template <int KIND>
__device__ void phase_rec_ng_t(const Params& P) {
  const Rec R = rec_of(KIND);
  constexpr int DV = (KIND == 1) ? 512 : 128, H = (KIND == 1) ? 4 : 8, PER = DV / 64, HDV = H * DV;
  const u16* __restrict__ ob = (const u16*)(WS(P) + O_OBUF);
  const u16* __restrict__ pj = (const u16*)(WS(P) + O_PROJ);
  u16* __restrict__ a2 = (u16*)(WS(P) + O_A2);
  const float* gain = P.in[29];
  const int tid = TID(), lane = tid & 63, wid = tid >> 6;
  constexpr int nrows = SLAB * H;
  for (int item = BID(); item < nrows / 32; item += gridDim.x) {
    float v[4][PER];
    float ss[4];
#pragma unroll
    for (int u = 0; u < 4; ++u) {
      const int rh = item * 32 + wid * 4 + u;
      const int t = rh / H, h = rh % H;
      const u16* o = ob + (long)t * HDV + h * DV + lane * PER;
      if (PER == 8) {
        float f8[8];
        unpack8(*(const uint4*)o, f8);
#pragma unroll
        for (int i = 0; i < 8; ++i) v[u][i % PER] = f8[i];
      } else {
        const unsigned w = *(const unsigned*)o;
        v[u][0] = bf2f((u16)(w & 0xffff)); v[u][1 % PER] = bf2f((u16)(w >> 16));
      }
      float a = 0.f;
#pragma unroll
      for (int i = 0; i < PER; ++i) a += v[u][i] * v[u][i];
      ss[u] = a;
    }
#pragma unroll
    for (int u = 0; u < 4; ++u) ss[u] = wave_sum(ss[u]);
#pragma unroll
    for (int u = 0; u < 4; ++u) {
      const int rh = item * 32 + wid * 4 + u;
      const int t = rh / H, h = rh % H;
      const float rstd = rsqrtf(ss[u] / (float)DV + 1e-6f);
      const u16* g = pj + (long)t * R.ldv + R.goff + h * DV + lane * PER;
      u16* out = a2 + (long)t * HDV + h * DV + lane * PER;
      float y[PER];
#pragma unroll
      for (int i = 0; i < PER; ++i) {
        y[i] = v[u][i] * rstd;
        if (KIND == 3) y[i] *= gain[lane * PER + i];
      }
      if (PER == 8) {
        const uint4 gw = *(const uint4*)g;
        float gf[8];
        unpack8(gw, gf);
        float r8[8];
#pragma unroll
        for (int i = 0; i < 8; ++i) r8[i] = y[i % PER] * silu_f(gf[i]);
        *(uint4*)out = pack8s(r8, 1.f);
      } else {
        const unsigned gw = *(const unsigned*)g;
        *(unsigned*)out = pack2(y[0] * silu_f(bf2f((u16)(gw & 0xffff))), y[1 % PER] * silu_f(bf2f((u16)(gw >> 16))));
      }
    }
  }
}
__device__ void phase_rec_ng(const Params& P, int kind) {
  if (kind == 1) phase_rec_ng_t<1>(P); else phase_rec_ng_t<3>(P);
}

__device__ void phase_swa_prep(const Params& P) {
  const u16* __restrict__ pj = (const u16*)(WS(P) + O_SA_P);
  u16* __restrict__ qn = (u16*)(WS(P) + O_SA_Q);
  u16* __restrict__ kn = (u16*)(WS(P) + O_SA_K);
  const float2* __restrict__ rope = (const float2*)(WS(P) + O_ROPES);
  const long gtid = (long)BID() * NT + TID(), gsz = (long)gridDim.x * NT;
  for (long idx = gtid; idx < (long)NTOK * 80; idx += gsz) {
    const int j = (int)(idx & 3);
    const int hd = (int)((idx >> 2) % 20);
    const int t = (int)(idx / 80);
    const int col = hd < 16 ? hd * 64 : 1024 + (hd - 16) * 64;
    const int d0 = j * 8;
    float x1[8], x2[8];
    unpack8(*(const uint4*)(pj + (long)t * 1536 + col + d0), x1);
    unpack8(*(const uint4*)(pj + (long)t * 1536 + col + d0 + 32), x2);
    const int L = t < 16384 ? 2048 : 8192;
    const float4* rp = (const float4*)(rope + (long)(t & (L - 1)) * 32 + d0);
    const float4 c01 = rp[0], c23 = rp[1], c45 = rp[2], c67 = rp[3];
    float ss = 0.f;
#pragma unroll
    for (int i = 0; i < 8; ++i) ss += x1[i] * x1[i] + x2[i] * x2[i];
    ss += __shfl_xor(ss, 1); ss += __shfl_xor(ss, 2);
    const float rstd = rsqrtf(ss * (1.f / 64.f) + 1e-6f);
    const float* gn = hd < 16 ? P.in[23] : P.in[24];
    const float4 ga = *(const float4*)(gn + d0), gb = *(const float4*)(gn + d0 + 4), gc = *(const float4*)(gn + d0 + 32), gd = *(const float4*)(gn + d0 + 36);
    const float g1[8] = {ga.x, ga.y, ga.z, ga.w, gb.x, gb.y, gb.z, gb.w};
    const float g2[8] = {gc.x, gc.y, gc.z, gc.w, gd.x, gd.y, gd.z, gd.w};
    const float cs[8] = {c01.x, c01.z, c23.x, c23.z, c45.x, c45.z, c67.x, c67.z};
    const float sn[8] = {c01.y, c01.w, c23.y, c23.w, c45.y, c45.w, c67.y, c67.w};
    const float osc = hd < 16 ? 0.125f : 1.f;
    float o1[8], o2[8];
#pragma unroll
    for (int i = 0; i < 8; ++i) {
      const float y1 = x1[i] * rstd * g1[i], y2 = x2[i] * rstd * g2[i];
      o1[i] = (y1 * cs[i] - y2 * sn[i]) * osc;
      o2[i] = (y1 * sn[i] + y2 * cs[i]) * osc;
    }
    u16* dst = hd < 16 ? qn + (long)t * 1024 + hd * 64 + d0 : kn + (long)t * 256 + (hd - 16) * 64 + d0;
    *(uint4*)dst = pack8s(o1, 1.f);
    *(uint4*)(dst + 32) = pack8s(o2, 1.f);
  }
}

constexpr int SLD = 324;
__device__ void phase_swa_att(const Params& P) {
  const u16* qn = (const u16*)(WS(P) + O_SA_Q);
  const u16* kn = (const u16*)(WS(P) + O_SA_K);
  const u16* pj = (const u16*)(WS(P) + O_SA_P);
  u16* a2 = (u16*)(WS(P) + O_SA_A);
  const float* sink = P.in[25];
  float* S = (float*)(smem + 40960);
  u16* Bs = (u16*)smem + 9216;
  const int tid = TID(), lane = tid & 63, wid = tid >> 6;
  const int wm = wid >> 2, wn = wid & 3, fr = lane & 15, fq = lane >> 4;
  const int nitems = (NTOK / 64) * 16;
  for (int item = BID(); item < nitems; item += gridDim.x) {
    const int hq = item & 15, qbg = item >> 4;
    const int L = qbg < 256 ? 2048 : 8192;
    const int q0 = qbg < 256 ? (qbg & 31) * 64 : ((qbg - 256) & 127) * 64;
    const long tok0 = qbg < 256 ? (long)(qbg >> 5) * 2048 : 16384 + (long)((qbg - 256) >> 7) * 8192;
    const int hkv = hq >> 2;
    uint4 vt[5];
#pragma unroll
    for (int kt = 0; kt < 5; ++kt) {
      const int kp0 = q0 - 128 + kt * 64;
      vt[kt] = make_uint4(0, 0, 0, 0);
      if (kp0 >= 0 && kp0 < L) vt[kt] = ld_chunk<64, false>(pj + (tok0 + kp0) * 1536 + 1280 + hkv * 64, 1536, 0, tid);
    }
    for (int kt = 0; kt < 5; ++kt) {
      const int kp0 = q0 - 128 + kt * 64;
      if (kp0 >= 0 && kp0 < L) {
        f32x4 acc[2][1] = {};
        gemm_acc<64, 64, true, true, true, 1>(acc, qn + (tok0 + q0) * 1024 + hq * 64, 1024, kn + (tok0 + kp0) * 256 + hkv * 64, 256, (u16*)smem);
        epi_each<64, 64, true>(acc, [&](int r, int c, f32x4 v) {
          f32x4 o;
#pragma unroll
          for (int j = 0; j < 4; ++j) {
            const int dlt = (q0 + r) - (kp0 + c + j);
            o[j] = (dlt <= 128 && dlt >= -128) ? v[j] : -1e30f;
          }
          *(f32x4*)(S + r * SLD + kt * 64 + c) = o;
        });
      } else {
        for (int i = tid; i < 4096; i += NT) S[(i >> 6) * SLD + kt * 64 + (i & 63)] = -1e30f;
      }
    }
    __syncthreads();
    {
      const int r = tid >> 3, sub = tid & 7;
      const float sk = sink[hq];
      float e[40];
      float m = sk;
#pragma unroll
      for (int i = 0; i < 40; ++i) { e[i] = S[r * SLD + sub + 8 * i]; m = fmaxf(m, e[i]); }
      m = fmaxf(m, __shfl_xor(m, 1)); m = fmaxf(m, __shfl_xor(m, 2)); m = fmaxf(m, __shfl_xor(m, 4));
      float den = 0.f;
#pragma unroll
      for (int i = 0; i < 40; ++i) { e[i] = __expf(e[i] - m); den += e[i]; }
      den += __shfl_xor(den, 1); den += __shfl_xor(den, 2); den += __shfl_xor(den, 4);
      den += __expf(sk - m);
      const float inv = 1.f / den;
      u16* prow = (u16*)(S + r * SLD);
#pragma unroll
      for (int i = 0; i < 40; ++i) prow[sub + 8 * i] = f2bf(e[i] * inv);
    }
    __syncthreads();
    f32x4 acc[2][1] = {};
#pragma unroll
    for (int kt = 0; kt < 5; ++kt) {
      const int kp0 = q0 - 128 + kt * 64;
      if (kp0 >= 0 && kp0 < L) {
        __syncthreads();
        st_chunk<64, false>(Bs, vt[kt], tid);
        __syncthreads();
#pragma unroll
        for (int ks = 0; ks < 2; ++ks) {
          bf16x8 af[2];
#pragma unroll
          for (int mi = 0; mi < 2; ++mi) af[mi] = *(const bf16x8*)((const u16*)(S + (wm * 32 + mi * 16 + fr) * SLD) + kt * 64 + ks * 32 + fq * 8);
          const bf16x8 bfr = ld_frag<64, false>(Bs, wn * 16, ks, fr, fq);
#pragma unroll
          for (int mi = 0; mi < 2; ++mi) acc[mi][0] = __builtin_amdgcn_mfma_f32_16x16x32_bf16(bfr, af[mi], acc[mi][0], 0, 0, 0);
        }
      }
    }
    u16* o = a2 + (tok0 + q0) * 1024 + hq * 64;
    epi_each<64, 64, true>(acc, [&](int r, int c, f32x4 v) { *(uint2*)(o + (long)r * 1024 + c) = make_uint2(pack2(v[0], v[1]), pack2(v[2], v[3])); });
    __syncthreads();
  }
}

#define XB_TMO      128
#define XB_XCNT(j)  (256  + 64 * (j))
#define XB_XSUB(j)  (1280 + 64 * (j))
#define XB_XGEN(j)  (2304 + 64 * (j))
#define XB_TOP      3328
#define XB_TOPGEN   3392
#define XCD_BAR_WORDS 3456
#define XB_SPIN_CAP (1u << 18)
__device__ __forceinline__ unsigned xb_ld(unsigned* p)              { return __hip_atomic_load(p, __ATOMIC_RELAXED, __HIP_MEMORY_SCOPE_AGENT); }
__device__ __forceinline__ unsigned xb_add(unsigned* p, unsigned v) { return __hip_atomic_fetch_add(p, v, __ATOMIC_RELAXED, __HIP_MEMORY_SCOPE_AGENT); }
__device__ __forceinline__ unsigned xb_xcc_id() { return (unsigned)__builtin_amdgcn_s_getreg((3 << 11) | 20) & 0xFu; }
#define XB_SPIN(cond, bar) do { unsigned _sp = 0; while (cond) { __builtin_amdgcn_s_sleep(1); \
    if ((++_sp & 255u) == 0u) { if (xb_ld(&(bar)[XB_TMO])) break; if (_sp > XB_SPIN_CAP) { atomicAdd(&(bar)[XB_TMO], 1u); break; } } } } while (0)
struct XcdBarrier { unsigned* bar; unsigned x; volatile LDS_AS unsigned* st; };
__device__ __forceinline__ XcdBarrier xcd_barrier_post(unsigned* bar, volatile LDS_AS unsigned* st) {
    XcdBarrier b; b.bar = bar; b.x = xb_xcc_id(); b.st = st;
    if (threadIdx.x == 0) (void)xb_add(&bar[XB_XCNT(b.x)], 1u);
    return b;
}
__device__ __forceinline__ void xcd_barrier_complete(unsigned* bar, unsigned x, unsigned& nloc, unsigned& nx) {
    const unsigned G = gridDim.x * gridDim.y * gridDim.z;
    unsigned sum, cnt, mine, sp = 0u;
    for (;;) {
        sum = 0u; cnt = 0u; mine = 0u;
#pragma unroll
        for (unsigned j = 0; j < 16; ++j) { const unsigned c = xb_ld(&bar[XB_XCNT(j)]); sum += c; cnt += (c > 0u) ? 1u : 0u; mine = (j == x) ? c : mine; }
        if (sum == G) break;
        __builtin_amdgcn_s_sleep(1);
        if ((++sp & 255u) == 0u) { if (xb_ld(&bar[XB_TMO])) break; if (sp > XB_SPIN_CAP) { atomicAdd(&bar[XB_TMO], 1u); break; } }
    }
    nloc = mine > 0u ? mine : 1u; nx = cnt > 0u ? cnt : 1u;
}
__device__ __forceinline__ void xcd_barrier(const XcdBarrier& b) {
    asm volatile("s_waitcnt vmcnt(0)" ::: "memory");
    __syncthreads();
    if (threadIdx.x == 0) {
        unsigned* bar = b.bar;
        __builtin_amdgcn_s_waitcnt(0);
        unsigned nloc = b.st[0], nx = b.st[1];
        if (nloc == 0u) { xcd_barrier_complete(bar, b.x, nloc, nx); b.st[0] = nloc; b.st[1] = nx; }
        const unsigned old = xb_add(&bar[XB_XSUB(b.x)], 1u);
        const unsigned gen = old / nloc;
        if (old + 1u == (gen + 1u) * nloc) {
            __builtin_amdgcn_fence(__ATOMIC_RELEASE, "agent");
            asm volatile("s_waitcnt vmcnt(0)" ::: "memory");
            const unsigned og = xb_add(&bar[XB_TOP], 1u);
            const unsigned tg = og / nx;
            if (og + 1u == (tg + 1u) * nx) xb_add(&bar[XB_TOPGEN], 1u);
            else XB_SPIN(xb_ld(&bar[XB_TOPGEN]) == tg, bar);
            __builtin_amdgcn_fence(__ATOMIC_ACQUIRE, "agent");
            xb_add(&bar[XB_XGEN(b.x)], 1u);
            asm volatile("s_waitcnt vmcnt(0)" ::: "memory");
        } else {
            XB_SPIN(xb_ld(&bar[XB_XGEN(b.x)]) == gen, bar);
            __builtin_amdgcn_fence(__ATOMIC_ACQUIRE, "agent");
            asm volatile("s_waitcnt vmcnt(0)" ::: "memory");
        }
    }
    __syncthreads();
}

__device__ __forceinline__ int nmix_of(int kind) { return (kind & 1) ? 8 : (kind == 2 ? 5 : 6); }
__device__ __forceinline__ int nsl_of(int kind) { return kind == 2 ? 1 : 5; }

__device__ void ffn_step(const Params& P, int layer, int f) {
  if (f == 6) { phase_ffn_down(P, layer); return; }
  const int fs = f / 3, st = f % 3;
  if (st == 0) { REP(4) phase_norm(P, layer, fs, 1); }
  else if (st == 1) { REP(0) phase_ffn_gate(P, layer); }
  else { REP(0) phase_ffn_val(P, layer, fs); }
}
__device__ void layer_step(const Params& P, int layer, int slab, int step) {
  const int kind = layer;
  if (step == 0) { REP(4) phase_norm(P, layer, slab, kind == 2 ? 2 : 0); return; }
  if (kind == 0) {
    if (step == 1) { REP(0) phase_proj(P, O_WHYIN, 3072); }
    else if (step == 2) { REP(3) phase_hy_conv(P, slab); }
    else if (step == 3) { if ((PROBE_MASK >> 7) & 1) phase_hy_fft(P, slab, true); phase_hy_fft(P, slab); }
    else if (step == 4) { REP(3) phase_hy_tr(P, slab); }
    else phase_resid(P, layer, slab, (const u16*)(WS(P) + O_A2), 1024, O_WHYOUT, 2 * D);
  } else if (kind == 1) {
    if (step == 1) { REP(0) phase_proj(P, O_WRETIN, 6144); }
    else if (step == 2) { REP(1) REP(9) phase_ret_prep(P, slab); }
    else if (step == 3) { REP(1) REP(11) phase_rec_su<256, 4>(P, 1); }
    else if (step == 4) { if ((PROBE_MASK >> 6) & 1) phase_rec_scan(P, 1, slab, true); phase_rec_scan(P, 1, slab); }
    else if (step == 5) { REP(1) REP(12) phase_rec_out<256, 4>(P, 1); }
    else if (step == 6) { REP(1) REP(9) phase_rec_ng(P, 1); }
    else phase_resid(P, layer, slab, (const u16*)(WS(P) + O_A2), 2048, O_WRETOUT, 2 * D);
  } else if (kind == 2) {
    if (step == 1) {
      EpiStoreBf16 E; E.O = (u16*)(WS(P) + O_SA_P); E.ldc = 1536;
      REP(0) run_gemm((const u16*)(WS(P) + O_SA_H), (const u16*)(WS(P) + O_WSWAIN), NTOK, 1536, D, E);
    }
    else if (step == 2) { REP(2) REP(14) phase_swa_prep(P); }
    else if (step == 3) { REP(2) REP(15) phase_swa_att(P); }
    else {
      EpiResid E; E.X = OUTP(P); E.XS = E.X; E.mod = (const float*)(WS(P) + O_MOD) + (long)layer * 16 * 6144; E.goff = 2 * D; E.grow0 = 0;
      run_gemm((const u16*)(WS(P) + O_SA_A), (const u16*)(WS(P) + O_WSWAOUT), NTOK, D, 1024, E);
    }
  } else {
    if (step == 1) { REP(0) phase_proj(P, O_WHGIN, 5120); }
    else if (step == 2) { REP(1) REP(9) phase_hg_prep(P); }
    else if (step == 3) { REP(1) REP(11) phase_rec_su<128, 2>(P, 3); }
    else if (step == 4) { if ((PROBE_MASK >> 6) & 1) phase_rec_scan(P, 3, slab, true); phase_rec_scan(P, 3, slab); }
    else if (step == 5) { REP(1) REP(12) phase_rec_out<128, 2>(P, 3); }
    else if (step == 6) { REP(1) REP(9) phase_rec_ng(P, 3); }
    else phase_resid(P, layer, slab, (const u16*)(WS(P) + O_A2), 1024, O_WHGOUT, 2 * D);
  }
}

__global__ void __launch_bounds__(NT) fwd_megakernel(Params P) {
  cg::grid_group grid = cg::this_grid();
  __shared__ uint4 xb_words;
  if (threadIdx.x == 0) xb_words = make_uint4(0u, 0u, 0u, 0u);
  __syncthreads();
  XcdBarrier xb = xcd_barrier_post((unsigned*)(P.ws + O_BAR), (volatile LDS_AS unsigned*)&xb_words);
  for (int pid = P.p0; pid < P.p1; ++pid) {
    if (pid == 0) { REP(5) phase_pre0(P); }
    else if (pid == 1) { REP(5) phase_pre1(P); }
    else {
      int q = pid - 2, layer = 0;
      while (q >= nsl_of(layer) * nmix_of(layer) + 7) { q -= nsl_of(layer) * nmix_of(layer) + 7; ++layer; }
      const int nm = nmix_of(layer), nsl = nsl_of(layer);
      if (q < nsl * nm) layer_step(P, layer, q / nm, q % nm);
      else ffn_step(P, layer, q - nsl * nm);
    }
    if (pid + 1 < P.p1) {
      if (pid == 0) grid.sync();
      else xcd_barrier(xb);
      if ((PROBE_MASK >> 8) & 1) xcd_barrier(xb);
    }
  }
}

extern "C" void kernel_launch(void* const* d_in, const int* in_sizes, int n_in, void* d_out, int out_size, void* d_ws,
                              size_t ws_size, hipStream_t stream) {
  static int grid_blocks = 0;
  if (!grid_blocks) {
    int dev = 0, cus = 0, per_cu = 0;
    (void)hipGetDevice(&dev);
    (void)hipDeviceGetAttribute(&cus, hipDeviceAttributeMultiprocessorCount, dev);
    (void)hipFuncSetAttribute((const void*)fwd_megakernel, hipFuncAttributeMaxDynamicSharedMemorySize, LDSB);
    (void)hipOccupancyMaxActiveBlocksPerMultiprocessor(&per_cu, (const void*)fwd_megakernel, NT, LDSB);
    if (per_cu < 1) per_cu = 1;
    if (per_cu > 1) per_cu = 1;
    grid_blocks = cus * per_cu;
    if (ws_size < WS_END) fprintf(stderr, "kernel_launch: workspace too small: %zu < %zu\n", ws_size, (size_t)WS_END);
  }
  Params p;
  memset(&p, 0, sizeof(p));
  for (int i = 0; i < 36; ++i) p.in[i] = (const float*)d_in[i];
  p.out = (float*)d_out;
  p.ws = (unsigned char*)d_ws;
  (void)hipMemsetAsync((unsigned char*)d_ws + O_BAR, 0, XCD_BAR_WORDS * 4, stream);
#if ONE_LAUNCH
  p.p0 = 0; p.p1 = NPHASES;
  void* args[] = {&p};
  hipError_t e = hipLaunchCooperativeKernel((const void*)fwd_megakernel, dim3(grid_blocks), dim3(NT), args, LDSB, stream);
  if (e != hipSuccess) fprintf(stderr, "cooperative launch failed: %s (grid %d)\n", hipGetErrorString(e), grid_blocks);
#else
  for (int ph = 0; ph < NPHASES; ++ph) {
    p.p0 = ph; p.p1 = ph + 1;
    hipLaunchKernelGGL(fwd_megakernel, dim3(grid_blocks), dim3(NT), LDSB, stream, p);
  }
#endif
}
```

```cpp
#include <hip/hip_runtime.h>
#include <hip/hip_cooperative_groups.h>
#include <cstdio>
#include <cstdint>
#include <cstring>
namespace cg = cooperative_groups;

typedef unsigned short u16;
typedef __attribute__((ext_vector_type(8))) short bf16x8;
typedef __attribute__((ext_vector_type(4))) float f32x4;

#define NT 512
#ifndef ONE_LAUNCH
#define ONE_LAUNCH 1
#endif
#ifndef PROBE_MASK
#define PROBE_MASK 0
#endif
#define REP(cls) for (int rep_##cls = 0; rep_##cls < (((PROBE_MASK >> (cls)) & 1) ? 2 : 1); ++rep_##cls)

constexpr int D = 1024, SLAB = 16384, DFF = 2816;
constexpr int LDSB = 139264;
constexpr int FSLAB = 40960, NTOK = 81920;
constexpr int NPHASES = 2 + 5 * (6 + 8 + 8) + 5 + 4 * 7;

constexpr size_t SZW(size_t n, size_t k) { return n * k * 2; }
constexpr size_t O_WHYIN = 0;
constexpr size_t O_WHYOUT = O_WHYIN + SZW(3072, 1024);
constexpr size_t O_WRETIN = O_WHYOUT + SZW(1024, 1024);
constexpr size_t O_WRETOUT = O_WRETIN + SZW(6144, 1024);
constexpr size_t O_WSWAIN = O_WRETOUT + SZW(1024, 2048);
constexpr size_t O_WSWAOUT = O_WSWAIN + SZW(1536, 1024);
constexpr size_t O_WHGIN = O_WSWAOUT + SZW(1024, 1024);
constexpr size_t O_WHGOUT = O_WHGIN + SZW(5120, 1024);
constexpr size_t O_WFG = O_WHGOUT + SZW(1024, 1024);
constexpr size_t O_WFV = O_WFG + 4 * SZW(2816, 1024);
constexpr size_t O_WFD = O_WFV + 4 * SZW(2816, 1024);
constexpr size_t O_MOD = O_WFD + 4 * SZW(1024, 2816);
constexpr size_t O_TW = O_MOD + (size_t)4 * 16 * 6144 * 4;
constexpr size_t O_HIDS = O_TW + 8192 * 8;
constexpr size_t O_HIDP = O_HIDS + (size_t)8192 * 64 * 4;
constexpr size_t O_ROPER = O_HIDP + (size_t)2048 * 64 * 4;
constexpr size_t O_ROPES = O_ROPER + (size_t)8192 * 128 * 8;
constexpr size_t O_PROJ = O_ROPES + (size_t)8192 * 32 * 8;
constexpr size_t O_HBUF = O_PROJ + (size_t)SLAB * 6144 * 2;
constexpr size_t O_A2 = O_HBUF + (size_t)SLAB * 1024 * 2;
constexpr size_t O_C = O_A2 + (size_t)SLAB * 2048 * 2;
constexpr size_t O_FHBUF = O_PROJ;
constexpr size_t O_FGBUF = O_FHBUF + (size_t)FSLAB * 1024 * 2;
constexpr size_t O_FACT = O_FGBUF + (size_t)FSLAB * DFF * 2;
constexpr size_t END_F = O_FACT + (size_t)NTOK * DFF * 2;
constexpr size_t O_MODP = O_C;
constexpr size_t O_BAR = ((size_t)1 << 30) - 16384;
constexpr size_t O_HSPS = O_BAR - (size_t)1024 * 16384 * 8 - (size_t)1024 * 4096 * 8;
constexpr size_t O_HSPP = O_HSPS + (size_t)1024 * 16384 * 8;
constexpr size_t O_UT = O_C;
constexpr size_t O_X0C = O_UT + (size_t)SLAB * 1024 * 4;
constexpr size_t END_HY = O_X0C + (size_t)SLAB * 1024 * 2;
static_assert(END_F <= O_HSPS && END_HY <= O_HSPS, "layer-0 buffers overlap the filter spectra");
constexpr size_t SZP = (size_t)SLAB * 1024 * 2;
constexpr size_t O_QDF = O_C, O_QDB = O_QDF + SZP, O_KIF = O_QDB + SZP, O_KIB = O_KIF + SZP, O_KEF = O_KIB + SZP, O_KEB = O_KEF + SZP;
constexpr size_t O_DLF = O_KEB + SZP;
constexpr size_t O_DLB = O_DLF + (size_t)256 * 1024 * 4;
constexpr size_t O_SC = O_DLB + (size_t)256 * 1024 * 4;
constexpr size_t O_STF = O_SC + (size_t)SLAB * 1024 * 2;
constexpr size_t O_STB = O_STF + (size_t)134217728;
constexpr size_t O_OBUF = O_STB + (size_t)134217728;
constexpr size_t END_REC = O_OBUF + (size_t)SLAB * 2048 * 4;
constexpr size_t O_QN = O_C;
constexpr size_t O_KN = O_QN + SZP;
constexpr size_t O_PBUF = O_KN + (size_t)SLAB * 256 * 2;
constexpr size_t END_SWA0 = O_PBUF + (size_t)SLAB * 16 * 320 * 2;
constexpr size_t O_SA_H = O_PROJ;
constexpr size_t O_SA_P = O_SA_H + (size_t)81920 * 1024 * 2;
constexpr size_t O_SA_Q = O_SA_P + (size_t)81920 * 1536 * 2;
constexpr size_t O_SA_K = O_SA_Q + (size_t)81920 * 1024 * 2;
constexpr size_t O_SA_A = O_SA_K + (size_t)81920 * 256 * 2;
constexpr size_t END_SWA = O_SA_A + (size_t)81920 * 1024 * 2;
constexpr size_t WS_END = END_REC > END_HY ? (END_REC > END_SWA ? END_REC : END_SWA) : (END_HY > END_SWA ? END_HY : END_SWA);
static_assert(WS_END <= O_BAR, "workspace exceeds 1 GiB");

struct Params {
  const float* in[36];
  float* out;
  unsigned char* ws;
  int p0, p1;
};

extern __shared__ __attribute__((aligned(16))) unsigned char smem[];

__device__ __forceinline__ int TID() { int t = threadIdx.x; asm volatile("" : "+v"(t)); return t; }
__device__ __forceinline__ int BID() { int b = blockIdx.x; asm volatile("" : "+s"(b)); return b; }
__device__ __forceinline__ int VBID() { const int b = BID(), g = gridDim.x; return (g & 7) ? b : (b & 7) * (g >> 3) + (b >> 3); }
__device__ __forceinline__ long ZOFF() { long z = 0; asm volatile("" : "+s"(z)); return z; }
__device__ __forceinline__ unsigned char* WS(const Params& P) { return P.ws + ZOFF(); }
__device__ __forceinline__ float* OUTP(const Params& P) { return P.out + ZOFF(); }

namespace pg8 {
#define PG8_LAS __attribute__((address_space(3)))
typedef unsigned short bf16_t;
typedef short bf16x8 __attribute__((ext_vector_type(8)));
typedef float f32x4 __attribute__((ext_vector_type(4)));
typedef unsigned u32x4 __attribute__((ext_vector_type(4)));
constexpr int BM = 256, BK = 64, HALF = 128, HTB = HALF * BK * 2  , STAGE_BYTES = 8 * HTB, NXCD = 8, WGM = 8;

__host__ __device__ __forceinline__ int lds_byte(int r, int c) { const int st = (r >> 4) * 2 + (c >> 5), rr = r & 15, cc = c & 31, ob = rr * 64 + cc * 2; return st * 1024 + (ob ^ (((ob >> 9) & 1) << 5)); }
__host__ __device__ __forceinline__ void stage_rc(int b, int& R, int& C) { const int st = b / 1024, sb = b % 1024, swz = sb ^ (((sb >> 9) & 1) << 5); R = (st >> 1) * 16 + swz / 64; C = (st & 1) * 32 + (swz % 64) / 2; }
__host__ __device__ __forceinline__ int perm32(int rho) { const int n = rho >> 4, i = rho & 15; return 8 * (i >> 2) + 4 * n + (i & 3); }

struct Unit { int pm, pn; };
struct Gemm { const bf16_t* A; const bf16_t* Bt; int M, N, K; };

struct StaticOrder {
    int nM, nN, nwg, G, c;
    __host__ __device__ void init(int M, int N, int G_, int c_) { nM = M / BM; nN = N / BM; nwg = nM * nN; G = G_; c = c_; }
    __host__ __device__ bool next(int i, Unit& u) const {
        const long L = (long)i * G + c; if (L >= nwg) return false;
        int wgid = (int)L; { const int q = nwg / NXCD, r = nwg % NXCD, xcd = wgid % NXCD, off = wgid / NXCD; wgid = (xcd < r ? xcd * (q + 1) : r * (q + 1) + (xcd - r) * q) + off; }
        const int nig = WGM * nN, gid = wgid / nig, fm = gid * WGM, gsz = (nM - fm) < WGM ? (nM - fm) : WGM;
        u.pm = fm + ((wgid % nig) % gsz); u.pn = (wgid % nig) / gsz; return true;
    }
    __device__ __forceinline__ void a_ready(const Unit&) const {}
    __device__ __forceinline__ void done(const Unit&) const {}
};

template <class Epi, class Sched, bool STAMP = false>
__device__ __forceinline__ void gemm_phase(PG8_LAS unsigned char* lds, const Gemm g, const Sched& S, const Epi& E, unsigned long long* stamps) {
    const int tid = TID(), wid = __builtin_amdgcn_readfirstlane(tid >> 6), lane = tid & 63, wr = wid >> 2, wc = wid & 3, fr = lane & 15, fq = lane >> 4;
    const int K = g.K, nt = K / BK;
    int ts_lo = 0, ts_hi = 0, nts = 0; const unsigned long long rt_entry = STAMP ? (unsigned long long)wall_clock64() : 0ull;
#define PG8_STAMP() do { if (STAMP && wid == 0 && nts < 64) { const unsigned long long _c = (unsigned long long)clock64(); \
        ts_lo = (lane == nts) ? (int)(unsigned)_c : ts_lo; ts_hi = (lane == nts) ? (int)(unsigned)(_c >> 32) : ts_hi; ++nts; } } while (0)
    PG8_STAMP();
    unsigned voffA[2], voffB[2];
#pragma unroll
    for (int i = 0; i < 2; ++i) { int R, C; stage_rc(tid * 16 + i * 8192, R, C); const int Rb = Epi::PERM ? ((R & ~31) + perm32(R & 31)) : R;
        voffA[i] = (unsigned)(R * K + C) * 2u; voffB[i] = (unsigned)(Rb * K + C) * 2u; }
    const size_t kstep = (size_t)(BK * 2);
    const size_t hstep = (size_t)HALF * K * 2;
    const size_t tstep = 2 * hstep;
    const unsigned ldsw = (unsigned)wid * 1024u;
    const int aoff = lds_byte(wr * 64 + fr, fq * 8), boff = lds_byte(wc * 32 + fr, fq * 8);
#define PG8_SA(b, h) (((b) * 2 + (h)) * HTB)
#define PG8_SB(b, h) ((4 + (b) * 2 + (h)) * HTB)
#define PG8_STAGE(bufoff, gbase, voff) do { _Pragma("unroll") for (int _i = 0; _i < 2; ++_i) \
        __builtin_amdgcn_global_load_lds((const unsigned*)((const char*)(gbase) + (voff)[_i]), (PG8_LAS unsigned*)(lds + (bufoff) + ldsw + _i * 8192), 16, 0, 0); } while (0)
#define PG8_LDA(dst, b, h) do { _Pragma("unroll") for (int m = 0; m < 4; ++m) _Pragma("unroll") for (int k = 0; k < 2; ++k) dst[m][k] = *(const PG8_LAS bf16x8*)(lds + PG8_SA(b, h) + aoff + m * 2048 + k * 1024); } while (0)
#define PG8_LDB(dst, b, h) do { _Pragma("unroll") for (int n = 0; n < 2; ++n) _Pragma("unroll") for (int k = 0; k < 2; ++k) dst[n][k] = *(const PG8_LAS bf16x8*)(lds + PG8_SB(b, h) + boff + n * 2048 + k * 1024); } while (0)
#define PG8_MMA(ai, bj, At, Bt) do { __builtin_amdgcn_s_setprio(1); _Pragma("unroll") for (int m = 0; m < 4; ++m) _Pragma("unroll") for (int n = 0; n < 2; ++n) _Pragma("unroll") for (int k = 0; k < 2; ++k) \
        acc[ai][bj][m][n] = __builtin_amdgcn_mfma_f32_16x16x32_bf16(Bt[n][k], At[m][k], acc[ai][bj][m][n], 0, 0, 0); __builtin_amdgcn_s_setprio(0); } while (0)
#define PG8_WAIT_V(n) asm volatile("s_waitcnt vmcnt(" #n ")" ::: "memory")
#define PG8_WAIT_L(n) asm volatile("s_waitcnt lgkmcnt(" #n ")" ::: "memory")
#define PG8_BAR __builtin_amdgcn_s_barrier()
#define PG8_SCHED __builtin_amdgcn_sched_barrier(0)
    Unit cur, nxt; int ui = 0;
    if (!S.next(0, cur)) return;
    f32x4 acc[2][2][4][2];
#pragma unroll
    for (int a = 0; a < 2; ++a)
#pragma unroll
        for (int b = 0; b < 2; ++b)
#pragma unroll
            for (int m = 0; m < 4; ++m)
#pragma unroll
                for (int n = 0; n < 2; ++n) acc[a][b][m][n] = (f32x4){0.f, 0.f, 0.f, 0.f};
    bf16x8 At[4][2], B0[2][2], B1[2][2];
    const char* cA = (const char*)g.A + (size_t)cur.pm * tstep; const char* cB = (const char*)g.Bt + (size_t)cur.pn * tstep;
    S.a_ready(cur);
    PG8_STAGE(PG8_SB(0, 0), cB, voffB); PG8_STAGE(PG8_SA(0, 0), cA, voffA); PG8_STAGE(PG8_SB(0, 1), cB + hstep, voffB); PG8_STAGE(PG8_SA(0, 1), cA + hstep, voffA);
    if (wr == 1) PG8_BAR;
    PG8_WAIT_V(4); PG8_BAR;
    PG8_STAGE(PG8_SB(1, 0), cB + kstep, voffB); PG8_STAGE(PG8_SA(1, 0), cA + kstep, voffA); PG8_STAGE(PG8_SB(1, 1), cB + hstep + kstep, voffB);
    PG8_WAIT_V(6); PG8_BAR;
    PG8_STAMP();
    for (;;) {
        const bool has_next = S.next(ui + 1, nxt);
        const char* nA = has_next ? (const char*)g.A + (size_t)nxt.pm * tstep : cA; const char* nB = has_next ? (const char*)g.Bt + (size_t)nxt.pn * tstep : cB;
        for (int t = 0; t < nt; t += 2) {
            const bool last = (t == nt - 2);
            const char* a1 = cA + (size_t)(t + 1) * kstep;
            const char* a2 = last ? nA : cA + (size_t)(t + 2) * kstep; const char* b2 = last ? nB : cB + (size_t)(t + 2) * kstep;
            const char* a3 = a2 + kstep; const char* b3 = b2 + kstep;
            if (last && has_next) S.a_ready(nxt);
            PG8_LDB(B0, 0, 0); PG8_SCHED; PG8_LDA(At, 0, 0); PG8_STAGE(PG8_SA(1, 1), a1 + hstep, voffA);
            PG8_WAIT_L(8); PG8_BAR; PG8_WAIT_L(0); PG8_MMA(0, 0, At, B0); PG8_BAR; PG8_SCHED;
            PG8_LDB(B1, 0, 1); PG8_STAGE(PG8_SB(0, 0), b2, voffB);
            PG8_BAR; PG8_WAIT_L(0); PG8_MMA(0, 1, At, B1); PG8_BAR;
            PG8_LDA(At, 0, 1); PG8_STAGE(PG8_SA(0, 0), a2, voffA);
            PG8_BAR; PG8_WAIT_L(0); PG8_MMA(1, 0, At, B0); PG8_BAR; PG8_SCHED;
            PG8_STAGE(PG8_SB(0, 1), b2 + hstep, voffB);
            PG8_WAIT_V(6); PG8_BAR; PG8_MMA(1, 1, At, B1); PG8_BAR;
            PG8_LDB(B0, 1, 0); PG8_SCHED; PG8_LDA(At, 1, 0); PG8_STAGE(PG8_SA(0, 1), a2 + hstep, voffA);
            PG8_WAIT_L(8); PG8_BAR; PG8_WAIT_L(0); PG8_MMA(0, 0, At, B0); PG8_BAR; PG8_SCHED;
            PG8_LDB(B1, 1, 1); PG8_STAGE(PG8_SB(1, 0), b3, voffB);
            PG8_BAR; PG8_WAIT_L(0); PG8_MMA(0, 1, At, B1); PG8_BAR;
            PG8_LDA(At, 1, 1); PG8_STAGE(PG8_SA(1, 0), a3, voffA);
            PG8_BAR; PG8_WAIT_L(0); PG8_MMA(1, 0, At, B0); PG8_BAR; PG8_SCHED;
            PG8_STAGE(PG8_SB(1, 1), b3 + hstep, voffB);
            PG8_WAIT_V(6); PG8_BAR; PG8_MMA(1, 1, At, B1); PG8_BAR;
        }
        PG8_STAMP();
        if constexpr (!Epi::AFTER_DRAIN) { E(acc, cur, wr, wc, fr, fq); S.done(cur); }
        PG8_STAMP();
        if (!has_next) break;
#pragma unroll
        for (int a = 0; a < 2; ++a)
#pragma unroll
            for (int b = 0; b < 2; ++b)
#pragma unroll
                for (int m = 0; m < 4; ++m)
#pragma unroll
                    for (int n = 0; n < 2; ++n) acc[a][b][m][n] = (f32x4){0.f, 0.f, 0.f, 0.f};
        cur = nxt; cA = nA; cB = nB; ++ui;
    }
    PG8_WAIT_V(0);
    if (wr == 0) PG8_BAR;
    PG8_BAR;
    if constexpr (Epi::AFTER_DRAIN) { E.fused(acc, cur, wr, wc, fr, fq, lds, wid, lane); S.done(cur); }
    PG8_STAMP();
    if (STAMP && wid == 0) { stamps[lane] = lane < nts ? (((unsigned long long)(unsigned)ts_hi << 32) | (unsigned)ts_lo) : 0ull;
        if (lane == 62) stamps[62] = rt_entry; if (lane == 63) stamps[63] = (unsigned long long)wall_clock64(); }
#undef PG8_STAMP
#undef PG8_SA
#undef PG8_SB
#undef PG8_STAGE
#undef PG8_LDA
#undef PG8_LDB
#undef PG8_MMA
#undef PG8_WAIT_V
#undef PG8_WAIT_L
#undef PG8_BAR
#undef PG8_SCHED
}
}


__device__ __forceinline__ u16 f2bf(float f) {
  unsigned u = __float_as_uint(f);
  u += 0x7fffu + ((u >> 16) & 1u);
  return (u16)(u >> 16);
}
__device__ __forceinline__ float bf2f(u16 h) { return __uint_as_float(((unsigned)h) << 16); }
__device__ __forceinline__ unsigned pack2(float a, float b) { return (unsigned)f2bf(a) | ((unsigned)f2bf(b) << 16); }
__device__ __forceinline__ void unpack8(const uint4 v, float (&f)[8]) {
  f[0] = bf2f((u16)(v.x & 0xffff)); f[1] = bf2f((u16)(v.x >> 16)); f[2] = bf2f((u16)(v.y & 0xffff)); f[3] = bf2f((u16)(v.y >> 16));
  f[4] = bf2f((u16)(v.z & 0xffff)); f[5] = bf2f((u16)(v.z >> 16)); f[6] = bf2f((u16)(v.w & 0xffff)); f[7] = bf2f((u16)(v.w >> 16));
}
__device__ __forceinline__ uint4 pack8s(const float (&f)[8], float sc) {
  return make_uint4(pack2(f[0] * sc, f[1] * sc), pack2(f[2] * sc, f[3] * sc), pack2(f[4] * sc, f[5] * sc), pack2(f[6] * sc, f[7] * sc));
}
__device__ __forceinline__ float silu_f(float x) { return x / (1.f + __expf(-x)); }
__device__ __forceinline__ float sigm(float x) { return 1.f / (1.f + __expf(-x)); }
__device__ __forceinline__ float wave_sum(float v) {
#pragma unroll
  for (int o = 32; o; o >>= 1) v += __shfl_xor(v, o);
  return v;
}
__device__ __forceinline__ const float* xin_of(const Params& P, int slab) { return slab == 0 ? P.in[0] : P.in[1] + (long)(slab - 1) * SLAB * D; }
__device__ __forceinline__ int Lof(int slab) { return slab == 0 ? 2048 : 8192; }
__device__ __forceinline__ int gb_row(int gr) { return gr < 16384 ? (gr >> 11) : (8 + ((gr - 16384) >> 13)); }
__device__ __forceinline__ int gb_of(int slab, int r) { return slab == 0 ? (r >> 11) : (8 + (slab - 1) * 2 + (r >> 13)); }

typedef short v4s __attribute__((ext_vector_type(4)));
#define LBAR() asm volatile("s_waitcnt lgkmcnt(0)\n\ts_barrier" ::: "memory")
#define LDS_AS __attribute__((address_space(3)))
template <int R, bool KC>
__device__ __forceinline__ uint4 ld_chunk(const u16* __restrict__ base, long ld, int k0, int c) {
  if (KC) {
    const int r = c >> 3, kc = c & 7;
    return *(const uint4*)(base + (long)r * ld + k0 + kc * 8);
  } else {
    const int k = c / (R / 8), mc = c % (R / 8);
    return *(const uint4*)(base + (long)(k0 + k) * ld + mc * 8);
  }
}
template <int R, bool KC>
__device__ __forceinline__ void st_chunk(u16* s, uint4 v, int c) {
  if (KC) {
    const int r = c >> 3, kc = c & 7;
    *(uint4*)(s + r * 72 + kc * 8) = v;
  } else {
    const int k = c / (R / 8), mc = c % (R / 8);
    *(uint4*)(s + k * (R + 8) + mc * 8) = v;
  }
}
template <int R, bool KC>
__device__ __forceinline__ bf16x8 ld_frag(const u16* s, int x0, int ks, int fr, int fq) {
  if (KC) {
    return *(const bf16x8*)(s + (x0 + fr) * 72 + ks * 32 + fq * 8);
  } else {
    const int q4 = fr >> 2, p4 = fr & 3;
    const u16* p = s + (ks * 32 + 8 * fq + q4) * (R + 8) + x0 + 4 * p4;
    v4s lo = __builtin_amdgcn_ds_read_tr16_b64_v4i16((LDS_AS v4s*)p);
    v4s hi = __builtin_amdgcn_ds_read_tr16_b64_v4i16((LDS_AS v4s*)(p + 4 * (R + 8)));
    bf16x8 r;
    r[0] = lo[0]; r[1] = lo[1]; r[2] = lo[2]; r[3] = lo[3]; r[4] = hi[0]; r[5] = hi[1]; r[6] = hi[2]; r[7] = hi[3];
    return r;
  }
}

template <int TM, int TN, bool AKC, bool BKC, bool TR, int KT>
__device__ __forceinline__ void gemm_acc(f32x4 (&acc)[TM / 32][TN / 64], const u16* __restrict__ A, long lda,
                                         const u16* __restrict__ B, long ldb, u16* sm) {
  u16* As = sm;
  u16* Bs = sm + 9216;
  const int tid = TID(), lane = tid & 63, wid = tid >> 6;
  const int wm = wid >> 2, wn = wid & 3, fr = lane & 15, fq = lane >> 4;
  constexpr int MI = TM / 32, NI = TN / 64;
  uint4 ra0[KT], ra1[KT], rb0[KT], rb1[KT];
#pragma unroll
  for (int kt = 0; kt < KT; ++kt) {
    ra0[kt] = ld_chunk<TM, AKC>(A, lda, kt * 64, tid);
    ra1[kt] = ra0[kt];
    if (TM == 128) ra1[kt] = ld_chunk<TM, AKC>(A, lda, kt * 64, tid + NT);
    rb0[kt] = ld_chunk<TN, BKC>(B, ldb, kt * 64, tid);
    rb1[kt] = rb0[kt];
    if (TN == 128) rb1[kt] = ld_chunk<TN, BKC>(B, ldb, kt * 64, tid + NT);
  }
  __syncthreads();
  st_chunk<TM, AKC>(As, ra0[0], tid);
  if (TM == 128) st_chunk<TM, AKC>(As, ra1[0], tid + NT);
  st_chunk<TN, BKC>(Bs, rb0[0], tid);
  if (TN == 128) st_chunk<TN, BKC>(Bs, rb1[0], tid + NT);
  __syncthreads();
#pragma unroll
  for (int kt = 0; kt < KT; ++kt) {
    u16* Ac = As + (kt & 1) * 18432;
    u16* Bc = Bs + (kt & 1) * 18432;
    if (kt + 1 < KT) {
      u16* An = As + ((kt + 1) & 1) * 18432;
      u16* Bn = Bs + ((kt + 1) & 1) * 18432;
      st_chunk<TM, AKC>(An, ra0[kt + 1 < KT ? kt + 1 : 0], tid);
      if (TM == 128) st_chunk<TM, AKC>(An, ra1[kt + 1 < KT ? kt + 1 : 0], tid + NT);
      st_chunk<TN, BKC>(Bn, rb0[kt + 1 < KT ? kt + 1 : 0], tid);
      if (TN == 128) st_chunk<TN, BKC>(Bn, rb1[kt + 1 < KT ? kt + 1 : 0], tid + NT);
    }
#pragma unroll
    for (int ks = 0; ks < 2; ++ks) {
      bf16x8 af[MI], bfr[NI];
#pragma unroll
      for (int mi = 0; mi < MI; ++mi) af[mi] = ld_frag<TM, AKC>(Ac, wm * (TM / 2) + mi * 16, ks, fr, fq);
#pragma unroll
      for (int ni = 0; ni < NI; ++ni) bfr[ni] = ld_frag<TN, BKC>(Bc, wn * (TN / 4) + ni * 16, ks, fr, fq);
#pragma unroll
      for (int mi = 0; mi < MI; ++mi)
#pragma unroll
        for (int ni = 0; ni < NI; ++ni)
          acc[mi][ni] = TR ? __builtin_amdgcn_mfma_f32_16x16x32_bf16(bfr[ni], af[mi], acc[mi][ni], 0, 0, 0)
                           : __builtin_amdgcn_mfma_f32_16x16x32_bf16(af[mi], bfr[ni], acc[mi][ni], 0, 0, 0);
    }
    __syncthreads();
  }
}

template <int KT> struct Tiles { uint4 a0[KT], a1[KT], b0[KT], b1[KT]; };
template <int TM, int TN, bool AKC, bool BKC, int KT>
__device__ __forceinline__ void tiles_issue(Tiles<KT>& t, const u16* __restrict__ A, long lda, const u16* __restrict__ B, long ldb) {
  const int tid = TID();
#pragma unroll
  for (int kt = 0; kt < KT; ++kt) {
    t.a0[kt] = ld_chunk<TM, AKC>(A, lda, kt * 64, tid);
    t.a1[kt] = t.a0[kt];
    if (TM == 128) t.a1[kt] = ld_chunk<TM, AKC>(A, lda, kt * 64, tid + NT);
    t.b0[kt] = ld_chunk<TN, BKC>(B, ldb, kt * 64, tid);
    t.b1[kt] = t.b0[kt];
    if (TN == 128) t.b1[kt] = ld_chunk<TN, BKC>(B, ldb, kt * 64, tid + NT);
  }
}
template <int TM, int TN, bool AKC, bool BKC, bool TR, int KT>
__device__ __forceinline__ void gemm_run(f32x4 (&acc)[TM / 32][TN / 64], const Tiles<KT>& t, u16* sm) {
  u16* As = sm;
  u16* Bs = sm + 9216;
  const int tid = TID(), lane = tid & 63, wid = tid >> 6;
  const int wm = wid >> 2, wn = wid & 3, fr = lane & 15, fq = lane >> 4;
  constexpr int MI = TM / 32, NI = TN / 64;
  __syncthreads();
  st_chunk<TM, AKC>(As, t.a0[0], tid);
  if (TM == 128) st_chunk<TM, AKC>(As, t.a1[0], tid + NT);
  st_chunk<TN, BKC>(Bs, t.b0[0], tid);
  if (TN == 128) st_chunk<TN, BKC>(Bs, t.b1[0], tid + NT);
  __syncthreads();
#pragma unroll
  for (int kt = 0; kt < KT; ++kt) {
    u16* Ac = As + (kt & 1) * 18432;
    u16* Bc = Bs + (kt & 1) * 18432;
    if (kt + 1 < KT) {
      u16* An = As + ((kt + 1) & 1) * 18432;
      u16* Bn = Bs + ((kt + 1) & 1) * 18432;
      st_chunk<TM, AKC>(An, t.a0[kt + 1 < KT ? kt + 1 : 0], tid);
      if (TM == 128) st_chunk<TM, AKC>(An, t.a1[kt + 1 < KT ? kt + 1 : 0], tid + NT);
      st_chunk<TN, BKC>(Bn, t.b0[kt + 1 < KT ? kt + 1 : 0], tid);
      if (TN == 128) st_chunk<TN, BKC>(Bn, t.b1[kt + 1 < KT ? kt + 1 : 0], tid + NT);
    }
#pragma unroll
    for (int ks = 0; ks < 2; ++ks) {
      bf16x8 af[MI], bfr[NI];
#pragma unroll
      for (int mi = 0; mi < MI; ++mi) af[mi] = ld_frag<TM, AKC>(Ac, wm * (TM / 2) + mi * 16, ks, fr, fq);
#pragma unroll
      for (int ni = 0; ni < NI; ++ni) bfr[ni] = ld_frag<TN, BKC>(Bc, wn * (TN / 4) + ni * 16, ks, fr, fq);
#pragma unroll
      for (int mi = 0; mi < MI; ++mi)
#pragma unroll
        for (int ni = 0; ni < NI; ++ni)
          acc[mi][ni] = TR ? __builtin_amdgcn_mfma_f32_16x16x32_bf16(bfr[ni], af[mi], acc[mi][ni], 0, 0, 0)
                           : __builtin_amdgcn_mfma_f32_16x16x32_bf16(af[mi], bfr[ni], acc[mi][ni], 0, 0, 0);
    }
    __syncthreads();
  }
}

template <int TM, int TN, bool TR, class F>
__device__ __forceinline__ void epi_each(f32x4 (&acc)[TM / 32][TN / 64], F f) {
  const int tid = TID(), lane = tid & 63, wid = tid >> 6;
  const int wm = wid >> 2, wn = wid & 3, fr = lane & 15, fq = lane >> 4;
#pragma unroll
  for (int mi = 0; mi < TM / 32; ++mi)
#pragma unroll
    for (int ni = 0; ni < TN / 64; ++ni) {
      const int r0 = wm * (TM / 2) + mi * 16, c0 = wn * (TN / 4) + ni * 16;
      if (TR) f(r0 + fr, c0 + fq * 4, acc[mi][ni]);
      else f(r0 + fq * 4, c0 + fr, acc[mi][ni]);
    }
}

struct EpiStoreBf16 {
  static constexpr bool PERM = true, AFTER_DRAIN = false;
  u16* O; int ldc;
  __device__ __forceinline__ void operator()(const f32x4 (&acc)[2][2][4][2], const pg8::Unit& u, int wr, int wc, int fr, int fq) const {
    const int row0 = u.pm * 256 + wr * 64 + fr, col0 = u.pn * 256 + wc * 32 + 8 * fq;
#pragma unroll
    for (int ai = 0; ai < 2; ++ai)
#pragma unroll
      for (int m = 0; m < 4; ++m) {
        u16* rowp = O + (size_t)(row0 + ai * 128 + m * 16) * ldc + col0;
#pragma unroll
        for (int bj = 0; bj < 2; ++bj) {
          const f32x4 v0 = acc[ai][bj][m][0], v1 = acc[ai][bj][m][1];
          *(uint4*)(rowp + bj * 128) = make_uint4(pack2(v0[0], v0[1]), pack2(v0[2], v0[3]), pack2(v1[0], v1[1]), pack2(v1[2], v1[3]));
        }
      }
  }
};
struct EpiResid {
  static constexpr bool PERM = false, AFTER_DRAIN = false;
  float* X; const float* XS; const float* mod; int goff; int grow0;
  __device__ __forceinline__ void operator()(const f32x4 (&acc)[2][2][4][2], const pg8::Unit& u, int wr, int wc, int fr, int fq) const {
    const int row0 = u.pm * 256 + wr * 64 + fr, col0 = u.pn * 256 + wc * 32 + 4 * fq;
    const float* g = mod + (size_t)gb_row(grow0 + u.pm * 256) * 6144 + goff + col0;
    f32x4 gv[2][2];
#pragma unroll
    for (int bj = 0; bj < 2; ++bj)
#pragma unroll
      for (int n = 0; n < 2; ++n) gv[bj][n] = *(const f32x4*)(g + bj * 128 + n * 16);
#pragma unroll
    for (int am = 0; am < 4; ++am) {
      f32x4 xv[2][2][2];
#pragma unroll
      for (int mm = 0; mm < 2; ++mm)
#pragma unroll
        for (int bj = 0; bj < 2; ++bj)
#pragma unroll
          for (int n = 0; n < 2; ++n) xv[mm][bj][n] = *(const f32x4*)(XS + (size_t)(row0 + (am >> 1) * 128 + ((am & 1) * 2 + mm) * 16) * D + col0 + bj * 128 + n * 16);
#pragma unroll
      for (int mm = 0; mm < 2; ++mm)
#pragma unroll
        for (int bj = 0; bj < 2; ++bj)
#pragma unroll
          for (int n = 0; n < 2; ++n)
            *(f32x4*)(X + (size_t)(row0 + (am >> 1) * 128 + ((am & 1) * 2 + mm) * 16) * D + col0 + bj * 128 + n * 16) = xv[mm][bj][n] + gv[bj][n] * acc[am >> 1][bj][(am & 1) * 2 + mm][n];
    }
  }
};
struct EpiFfnVal {
  static constexpr bool PERM = false, AFTER_DRAIN = false;
  const u16* G; u16* ACT; const float* cw; const float* cb; int grow0;
  __device__ __forceinline__ void operator()(const f32x4 (&acc)[2][2][4][2], const pg8::Unit& u, int wr, int wc, int fr, int fq) const {
    const int row0 = u.pm * 256 + wr * 64 + fr, col0 = u.pn * 256 + wc * 32 + 4 * fq;
#pragma unroll
    for (int bj = 0; bj < 2; ++bj)
#pragma unroll
      for (int n = 0; n < 2; ++n) {
        const int c = col0 + bj * 128 + n * 16;
        const f32x4 w0 = *(const f32x4*)(cw + c), w1 = *(const f32x4*)(cw + DFF + c), w2 = *(const f32x4*)(cw + 2 * DFF + c), bb = *(const f32x4*)(cb + c);
#pragma unroll
        for (int ai = 0; ai < 2; ++ai) {
          uint2 g0[4], g1[4], g2[4];
#pragma unroll
          for (int m = 0; m < 4; ++m) {
            const int r = row0 + ai * 128 + m * 16;
            const int L = (grow0 + r) < 16384 ? 2048 : 8192;
            const int pos = (grow0 + r) & (L - 1);
            const u16* gp = G + (size_t)r * DFF + c;
            g1[m] = *(const uint2*)gp;
            g0[m] = *(const uint2*)(gp - (pos > 0 ? DFF : 0));
            g2[m] = *(const uint2*)(gp + (pos < L - 1 ? DFF : 0));
          }
#pragma unroll
          for (int m = 0; m < 4; ++m) {
            const int r = row0 + ai * 128 + m * 16;
            const int L = (grow0 + r) < 16384 ? 2048 : 8192;
            const int pos = (grow0 + r) & (L - 1);
            const float m0 = pos > 0 ? 1.f : 0.f, m2 = pos < L - 1 ? 1.f : 0.f;
            const uint2 a0 = g0[m], a1 = g1[m], a2 = g2[m];
            f32x4 a;
            a[0] = m0 * bf2f((u16)(a0.x & 0xffff)) * w0[0] + bf2f((u16)(a1.x & 0xffff)) * w1[0] + m2 * bf2f((u16)(a2.x & 0xffff)) * w2[0] + bb[0];
            a[1] = m0 * bf2f((u16)(a0.x >> 16)) * w0[1] + bf2f((u16)(a1.x >> 16)) * w1[1] + m2 * bf2f((u16)(a2.x >> 16)) * w2[1] + bb[1];
            a[2] = m0 * bf2f((u16)(a0.y & 0xffff)) * w0[2] + bf2f((u16)(a1.y & 0xffff)) * w1[2] + m2 * bf2f((u16)(a2.y & 0xffff)) * w2[2] + bb[2];
            a[3] = m0 * bf2f((u16)(a0.y >> 16)) * w0[3] + bf2f((u16)(a1.y >> 16)) * w1[3] + m2 * bf2f((u16)(a2.y >> 16)) * w2[3] + bb[3];
            const f32x4 v = acc[ai][bj][m][n];
            *(uint2*)(ACT + (size_t)r * DFF + c) = make_uint2(pack2(silu_f(a[0]) * v[0], silu_f(a[1]) * v[1]), pack2(silu_f(a[2]) * v[2], silu_f(a[3]) * v[3]));
          }
        }
      }
  }
};
template <class Epi>
__device__ __forceinline__ void run_gemm(const u16* A, const u16* Bt, int M, int N, int K, const Epi& E) {
  pg8::Gemm g; g.A = A; g.Bt = Bt; g.M = M; g.N = N; g.K = K;
  pg8::StaticOrder S; S.init(M, N, gridDim.x, BID());
  __syncthreads();
  pg8::gemm_phase<Epi, pg8::StaticOrder, false>((PG8_LAS unsigned char*)smem, g, S, E, nullptr);
  __syncthreads();
}

__device__ __forceinline__ int fidx(int p) { return p + ((p >> 6) << 2); }
__device__ __forceinline__ float2 cmulf(float2 a, float2 b) { return make_float2(a.x * b.x - a.y * b.y, a.x * b.y + a.y * b.x); }
__device__ __forceinline__ float2 cmulcf(float2 a, float2 b) { return make_float2(a.x * b.x + a.y * b.y, a.y * b.x - a.x * b.y); }
#define R16C(q) ((q) == 0 ? 1.f : (q) == 1 ? 0.9238795325f : (q) == 2 ? 0.7071067812f : (q) == 3 ? 0.3826834324f : (q) == 4 ? 0.f : (q) == 5 ? -0.3826834324f : (q) == 6 ? -0.7071067812f : -0.9238795325f)
#define R16S(q) ((q) == 0 ? 0.f : (q) == 1 ? -0.3826834324f : (q) == 2 ? -0.7071067812f : (q) == 3 ? -0.9238795325f : (q) == 4 ? -1.f : (q) == 5 ? -0.9238795325f : (q) == 6 ? -0.7071067812f : -0.3826834324f)
template <int N, int RS, bool INV>
__device__ __forceinline__ void fft_pass(float2* x, const float2* __restrict__ tw, const int S, const int tid) {
  constexpr int R = 1 << RS;
  const int E = S >> (RS - 1);
#pragma unroll 1
  for (int g = tid; g < N / R; g += NT) {
    const int blo = g & (E - 1);
    const int base = ((g - blo) << RS) + blo;
    float2 e[R];
#pragma unroll
    for (int k = 0; k < R; ++k) e[k] = x[fidx(base + k * E)];
    float2 wb[RS];
#pragma unroll
    for (int st = 0; st < RS; ++st) wb[st] = tw[blo * (8192 / (S >> st))];
#pragma unroll
    for (int sq = 0; sq < RS; ++sq) {
      const int st = INV ? (RS - 1 - sq) : sq;
      const int h = (R / 2) >> st;
#pragma unroll
      for (int k = 0; k < R; ++k) {
        if ((k & h) == 0) {
          const int m = k & (h - 1);
          const int q = m * (8 / h);
          float2 w = wb[st];
          if (q != 0) w = cmulf(w, make_float2(R16C(q), R16S(q)));
          if (!INV) {
            const float2 a = e[k], b = e[k + h];
            e[k] = make_float2(a.x + b.x, a.y + b.y);
            e[k + h] = cmulf(make_float2(a.x - b.x, a.y - b.y), w);
          } else {
            const float2 a = e[k], b = cmulcf(e[k + h], w);
            e[k] = make_float2(a.x + b.x, a.y + b.y);
            e[k + h] = make_float2(a.x - b.x, a.y - b.y);
          }
        }
      }
    }
#pragma unroll
    for (int k = 0; k < R; ++k) x[fidx(base + k * E)] = e[k];
  }
  __syncthreads();
}
template <int N>
__device__ __forceinline__ void fft_dif_t(float2* x, const float2* __restrict__ tw) {
  const int tid = TID();
  if (N == 16384) {
    fft_pass<N, 4, false>(x, tw, 8192, tid); fft_pass<N, 4, false>(x, tw, 512, tid);
    fft_pass<N, 4, false>(x, tw, 32, tid); fft_pass<N, 2, false>(x, tw, 2, tid);
  } else {
    fft_pass<N, 4, false>(x, tw, 2048, tid); fft_pass<N, 4, false>(x, tw, 128, tid); fft_pass<N, 4, false>(x, tw, 8, tid);
  }
}
template <int N>
__device__ __forceinline__ void ifft_dit_t(float2* x, const float2* __restrict__ tw) {
  const int tid = TID();
  if (N == 16384) {
    fft_pass<N, 2, true>(x, tw, 2, tid); fft_pass<N, 4, true>(x, tw, 32, tid);
    fft_pass<N, 4, true>(x, tw, 512, tid); fft_pass<N, 4, true>(x, tw, 8192, tid);
  } else {
    fft_pass<N, 4, true>(x, tw, 8, tid); fft_pass<N, 4, true>(x, tw, 128, tid); fft_pass<N, 4, true>(x, tw, 2048, tid);
  }
}
__device__ __forceinline__ void fft_dif(float2* x, int N, const float2* __restrict__ tw) {
  if (N == 16384) fft_dif_t<16384>(x, tw); else fft_dif_t<4096>(x, tw);
}
__device__ __forceinline__ void ifft_dit(float2* x, int N, const float2* __restrict__ tw) {
  if (N == 16384) ifft_dit_t<16384>(x, tw); else ifft_dit_t<4096>(x, tw);
}

__device__ void transpose_w(const float* __restrict__ W, u16* __restrict__ Wt, int K, int N) {
  float* smf = (float*)smem;
  const int tk = K / 64, tn = N / 64, tid = TID(), G = gridDim.x;
  const int kk0 = tid >> 4, n40 = tid & 15, kk1 = (tid + NT) >> 4, n41 = (tid + NT) & 15;
  int item = BID();
  float4 v0 = make_float4(0, 0, 0, 0), v1 = v0;
  if (item < tk * tn) {
    const int k0 = (item / tn) * 64, n0 = (item % tn) * 64;
    v0 = *(const float4*)(W + (long)(k0 + kk0) * N + n0 + n40 * 4);
    v1 = *(const float4*)(W + (long)(k0 + kk1) * N + n0 + n41 * 4);
  }
  for (; item < tk * tn; item += G) {
    const int k0 = (item / tn) * 64, n0 = (item % tn) * 64;
    float4 w0 = v0, w1 = v1;
    const int nx = item + G;
    if (nx < tk * tn) {
      const int k2 = (nx / tn) * 64, n2 = (nx % tn) * 64;
      w0 = *(const float4*)(W + (long)(k2 + kk0) * N + n2 + n40 * 4);
      w1 = *(const float4*)(W + (long)(k2 + kk1) * N + n2 + n41 * 4);
    }
    __syncthreads();
    { float* p = smf + kk0 * 65 + n40 * 4; p[0] = v0.x; p[1] = v0.y; p[2] = v0.z; p[3] = v0.w; }
    { float* p = smf + kk1 * 65 + n41 * 4; p[0] = v1.x; p[1] = v1.y; p[2] = v1.z; p[3] = v1.w; }
    __syncthreads();
    const int nn = tid >> 3, k8 = tid & 7;
    float f[8];
#pragma unroll
    for (int i = 0; i < 8; ++i) f[i] = smf[(k8 * 8 + i) * 65 + nn];
    *(uint4*)(Wt + (long)(n0 + nn) * K + k0 + k8 * 8) = pack8s(f, 1.f);
    v0 = w0; v1 = w1;
  }
  __syncthreads();
}

__device__ void phase_pre0(const Params& P) {
  const int tid = TID();
  const long gtid = (long)BID() * NT + tid, gsz = (long)gridDim.x * NT;
  transpose_w(P.in[7], (u16*)(WS(P) + O_WHYIN), 1024, 3072);
  transpose_w(P.in[18], (u16*)(WS(P) + O_WHYOUT), 1024, 1024);
  transpose_w(P.in[19], (u16*)(WS(P) + O_WRETIN), 1024, 6144);
  transpose_w(P.in[21], (u16*)(WS(P) + O_WRETOUT), 2048, 1024);
  transpose_w(P.in[22], (u16*)(WS(P) + O_WSWAIN), 1024, 1536);
  transpose_w(P.in[26], (u16*)(WS(P) + O_WSWAOUT), 1024, 1024);
  transpose_w(P.in[27], (u16*)(WS(P) + O_WHGIN), 1024, 5120);
  transpose_w(P.in[30], (u16*)(WS(P) + O_WHGOUT), 1024, 1024);
  for (int l = 0; l < 4; ++l) {
    transpose_w(P.in[31] + (long)l * 1024 * DFF, (u16*)(WS(P) + O_WFG) + (long)l * DFF * 1024, 1024, DFF);
    transpose_w(P.in[32] + (long)l * 1024 * DFF, (u16*)(WS(P) + O_WFV) + (long)l * DFF * 1024, 1024, DFF);
    transpose_w(P.in[35] + (long)l * DFF * 1024, (u16*)(WS(P) + O_WFD) + (long)l * 1024 * DFF, DFF, 1024);
  }
  {
    float* cs = (float*)smem;
    float* modp = (float*)(WS(P) + O_MODP);
    for (int item = BID(); item < 4 * 8 * 12; item += gridDim.x) {
      const int nb = item % 12, ks = (item / 12) % 8, l = item / 96;
      __syncthreads();
      for (int i = tid; i < 2048; i += NT) {
        int b = i >> 7, k = i & 127;
        float c = (b < 8) ? P.in[2][b * 1024 + ks * 128 + k] : P.in[3][(b - 8) * 1024 + ks * 128 + k];
        cs[i] = c / (1.f + expf(-c));
      }
      __syncthreads();
      const int n = nb * 512 + tid;
      float a[16];
#pragma unroll
      for (int b = 0; b < 16; ++b) a[b] = 0.f;
      const float* w = P.in[4] + ((long)l * 1024 + ks * 128) * 6144 + n;
      for (int k = 0; k < 128; ++k) {
        float wv = w[(long)k * 6144];
#pragma unroll
        for (int b = 0; b < 16; ++b) a[b] += cs[b * 128 + k] * wv;
      }
#pragma unroll
      for (int b = 0; b < 16; ++b) modp[(((long)ks * 4 + l) * 16 + b) * 6144 + n] = a[b];
    }
    __syncthreads();
  }
  {
    float2* tw = (float2*)(WS(P) + O_TW);
    for (long i = gtid; i < 8192; i += gsz) {
      float s, c;
      sincospif((float)i * (1.f / 8192.f), &s, &c);
      tw[i] = make_float2(c, -s);
    }
    float2* rr = (float2*)(WS(P) + O_ROPER);
    for (long i = gtid; i < (long)8192 * 128; i += gsz) {
      int pos = (int)(i >> 7), d = (int)(i & 127);
      float inv = exp2f(-(float)d * (13.287712379549449f / 128.f));
      float s, c;
      sincosf((float)pos * inv, &s, &c);
      rr[i] = make_float2(c, s);
    }
    float2* rs = (float2*)(WS(P) + O_ROPES);
    for (long i = gtid; i < (long)8192 * 32; i += gsz) {
      int pos = (int)(i >> 5), d = (int)(i & 31);
      float inv = exp2f(-(float)d * (13.287712379549449f / 32.f));
      float s, c;
      sincosf((float)pos * inv, &s, &c);
      rs[i] = make_float2(c, s);
    }
  }
  {
    float* zf = (float*)smem;
    float* h1 = zf + 8 * 36;
    const float* w1 = P.in[10]; const float* b1 = P.in[11]; const float* w2 = P.in[12]; const float* b2 = P.in[13];
    const float* fr = P.in[15];
    const int tl = tid >> 6, j = tid & 63;
    for (int item = BID(); item < 1280; item += gridDim.x) {
      const int sel = item >= 1024;
      const int L = sel ? 2048 : 8192;
      const int t = (sel ? item - 1024 : item) * 8 + tl;
      float* hid = (float*)(WS(P) + (sel ? O_HIDP : O_HIDS));
      __syncthreads();
      if (j < 33) {
        float v;
        if (j == 0) v = (float)t / (float)(L - 1);
        else {
          int i = (j - 1) & 15;
          float band = 1e-4f + (float)i * ((15.f - 1e-4f) / 15.f);
          float ang = (6.283185307179586f / (float)L) * (float)t;
          float a = band * ang;
          v = (j <= 16) ? cosf(a) : -sinf(a);
        }
        zf[tl * 36 + j] = v;
      }
      __syncthreads();
      float s = b1[j];
#pragma unroll 3
      for (int i = 0; i < 33; ++i) s += zf[tl * 36 + i] * w1[i * 64 + j];
      h1[tl * 64 + j] = sinf(fr[j] * s);
      __syncthreads();
      float s2 = b2[j];
#pragma unroll 4
      for (int i = 0; i < 64; ++i) s2 += h1[tl * 64 + i] * w2[i * 64 + j];
      hid[(long)j * L + t] = sinf(fr[j] * s2);
    }
    __syncthreads();
  }
}

__device__ void phase_pre1(const Params& P) {
  __shared__ float w3s[128];
  __shared__ float red[8];
  const int tid = TID(), lane = tid & 63, wid = tid >> 6;
  const long gtid = (long)BID() * NT + tid, gsz = (long)gridDim.x * NT;
  {
    const float* modp = (const float*)(WS(P) + O_MODP);
    float* mod = (float*)(WS(P) + O_MOD);
    for (long i = gtid; i < (long)4 * 16 * 6144; i += gsz) {
      int n = (int)(i % 6144);
      int l = (int)(i / (16 * 6144));
      float s = P.in[5][l * 6144 + n];
      for (int ks = 0; ks < 8; ++ks) s += modp[(long)ks * 4 * 16 * 6144 + i];
      mod[i] = s;
    }
  }
  float2* buf = (float2*)smem;
  const float2* tw = (const float2*)(WS(P) + O_TW);
  for (int item = BID(); item < 2048; item += gridDim.x) {
    const int sel = item >> 10, c = item & 1023;
    const int L = sel ? 2048 : 8192, N = 2 * L;
    const float* hid = (const float*)(WS(P) + (sel ? O_HIDP : O_HIDS));
    float2* hs = (float2*)(WS(P) + (sel ? O_HSPP : O_HSPS)) + (long)c * N;
    __syncthreads();
    if (tid < 128) {
      int dirn = tid >> 6, j = tid & 63;
      w3s[tid] = P.in[14][(long)j * 2048 + dirn * 1024 + c];
    }
    __syncthreads();
    const float dec0 = fabsf(P.in[16][c]), dec1 = fabsf(P.in[16][1024 + c]);
    const float invLm1 = 1.f / (float)(L - 1);
    float asum = 0.f;
    for (int n = tid; n < N; n += NT) {
      float val = 0.f;
      if (n != L) {
        const int dirn = n < L ? 0 : 1;
        const int t = n < L ? n : N - n;
        const float* hp = hid + t;
        const float* w = w3s + dirn * 64;
        float s = 0.f;
#pragma unroll 16
        for (int j = 0; j < 64; ++j) s += hp[(long)j * L] * w[j];
        float tl = (float)t * invLm1;
        val = s * expf(-tl * (dirn ? dec1 : dec0));
      }
      buf[fidx(n)] = make_float2(val, 0.f);
      asum += fabsf(val);
    }
    asum = wave_sum(asum);
    if (lane == 0) red[wid] = asum;
    __syncthreads();
    float tot = 0.f;
#pragma unroll
    for (int w = 0; w < 8; ++w) tot += red[w];
    const float scale = 1.f / (tot * (float)N);
    fft_dif(buf, N, tw);
    for (int p = tid; p < N; p += NT) {
      float2 a = buf[fidx(p)];
      hs[p] = make_float2(a.x * scale, a.y * scale);
    }
  }
  __syncthreads();
}

__device__ void phase_norm(const Params& P, int layer, int sl, int which) {
  const int grow0 = which == 1 ? sl * FSLAB : (which == 2 ? 0 : sl * SLAB), nrows = which == 1 ? FSLAB : (which == 2 ? NTOK : SLAB);
  const float* __restrict__ x = (layer == 0 && which == 0) ? xin_of(P, sl) : (const float*)(OUTP(P) + (long)grow0 * D);
  u16* __restrict__ h = (u16*)(WS(P) + (which == 1 ? O_FHBUF : (which == 2 ? O_SA_H : O_HBUF)));
  const float* gain = P.in[6] + (layer * 2 + (which == 1 ? 1 : 0)) * D;
  const float* mod = (const float*)(WS(P) + O_MOD) + (long)layer * 16 * 6144;
  const int shoff = which == 1 ? 3 * D : 0, scoff = which == 1 ? 4 * D : D;
  const int tid = TID(), lane = tid & 63, wid = tid >> 6;
  for (int item = BID(); item < nrows / 32; item += gridDim.x) {
    const int r0 = item * 32 + wid * 4;
    float4 v[4][4];
    float ss[4];
#pragma unroll
    for (int u = 0; u < 4; ++u) {
      const float* xr = x + (long)(r0 + u) * D;
      float a = 0.f;
#pragma unroll
      for (int i = 0; i < 4; ++i) {
        v[u][i] = *(const float4*)(xr + i * 256 + lane * 4);
        a += v[u][i].x * v[u][i].x + v[u][i].y * v[u][i].y + v[u][i].z * v[u][i].z + v[u][i].w * v[u][i].w;
      }
      ss[u] = a;
    }
    const float* m = mod + (long)gb_row(grow0 + r0) * 6144;
#pragma unroll
    for (int u = 0; u < 4; ++u) ss[u] = wave_sum(ss[u]);
#pragma unroll
    for (int i = 0; i < 4; ++i) {
      const int col = i * 256 + lane * 4;
      const float4 g = *(const float4*)(gain + col);
      const float4 sc = *(const float4*)(m + scoff + col);
      const float4 sh = *(const float4*)(m + shoff + col);
      const float a0 = g.x * (1.f + sc.x), a1 = g.y * (1.f + sc.y), a2 = g.z * (1.f + sc.z), a3 = g.w * (1.f + sc.w);
#pragma unroll
      for (int u = 0; u < 4; ++u) {
        const float rstd = rsqrtf(ss[u] * (1.f / 1024.f) + 1e-6f);
        const float y0 = v[u][i].x * rstd * a0 + sh.x, y1 = v[u][i].y * rstd * a1 + sh.y;
        const float y2 = v[u][i].z * rstd * a2 + sh.z, y3 = v[u][i].w * rstd * a3 + sh.w;
        *(uint2*)(h + (long)(r0 + u) * D + col) = make_uint2(pack2(y0, y1), pack2(y2, y3));
      }
    }
  }
}

__device__ void phase_proj(const Params& P, size_t woff, int N) {
  EpiStoreBf16 E; E.O = (u16*)(WS(P) + O_PROJ); E.ldc = N;
  run_gemm((const u16*)(WS(P) + O_HBUF), (const u16*)(WS(P) + woff), SLAB, N, D, E);
}
__device__ void phase_resid(const Params& P, int layer, int slab, const u16* A, int K, size_t woff, int goff) {
  EpiResid E; E.X = OUTP(P) + (long)slab * SLAB * D; E.XS = (layer == 0) ? xin_of(P, slab) : (const float*)E.X; E.mod = (const float*)(WS(P) + O_MOD) + (long)layer * 16 * 6144; E.goff = goff; E.grow0 = slab * SLAB;
  run_gemm(A, (const u16*)(WS(P) + woff), SLAB, D, K, E);
}

__device__ void phase_ffn_gate(const Params& P, int layer) {
  EpiStoreBf16 E; E.O = (u16*)(WS(P) + O_FGBUF); E.ldc = DFF;
  run_gemm((const u16*)(WS(P) + O_FHBUF), (const u16*)(WS(P) + O_WFG) + (long)layer * DFF * D, FSLAB, DFF, D, E);
}
__device__ void phase_ffn_val(const Params& P, int layer, int fs) {
  EpiFfnVal E; E.G = (const u16*)(WS(P) + O_FGBUF); E.ACT = (u16*)(WS(P) + O_FACT) + (long)fs * FSLAB * DFF;
  E.cw = P.in[33] + (long)layer * 3 * DFF; E.cb = P.in[34] + (long)layer * DFF; E.grow0 = fs * FSLAB;
  run_gemm((const u16*)(WS(P) + O_FHBUF), (const u16*)(WS(P) + O_WFV) + (long)layer * DFF * D, FSLAB, DFF, D, E);
}
__device__ void phase_ffn_down(const Params& P, int layer) {
  EpiResid E; E.X = OUTP(P); E.XS = E.X; E.mod = (const float*)(WS(P) + O_MOD) + (long)layer * 16 * 6144; E.goff = 5 * D; E.grow0 = 0;
  run_gemm((const u16*)(WS(P) + O_FACT), (const u16*)(WS(P) + O_WFD) + (long)layer * D * DFF, NTOK, D, DFF, E);
}

__device__ void phase_hy_conv(const Params& P, int slab) {
  const int L = Lof(slab), nseq = SLAB / L, tid = TID();
  const u16* __restrict__ z = (const u16*)(WS(P) + O_PROJ);
  float* __restrict__ uT = (float*)(WS(P) + O_UT);
  u16* __restrict__ x0c = (u16*)(WS(P) + O_X0C);
  const float* cw = P.in[8];
  const float* cb = P.in[9];
  float* tile = (float*)smem;
  const int ntt = L / 64;
  const int nitems = nseq * ntt * 16;
  const int tl = tid >> 3, cg = tid & 7;
  for (int item = BID(); item < nitems; item += gridDim.x) {
    const int ct = item % 16, tt = (item / 16) % ntt, seq = item / (16 * ntt);
    const int t = tt * 64 + tl, c0 = ct * 64 + cg * 8;
    const long row = (long)seq * L + t;
    const float mp = t > 0 ? 1.f : 0.f, mn = t < L - 1 ? 1.f : 0.f;
    const long rp = t > 0 ? row - 1 : row, rn = t < L - 1 ? row + 1 : row;
    float val[3][8];
#pragma unroll
    for (int q = 0; q < 3; ++q) {
      const int col = q * 1024 + c0;
      float a[8], b[8], c[8];
      unpack8(*(const uint4*)(z + rp * 3072 + col), a);
      unpack8(*(const uint4*)(z + row * 3072 + col), b);
      unpack8(*(const uint4*)(z + rn * 3072 + col), c);
      const float4 w0a = *(const float4*)(cw + col), w0b = *(const float4*)(cw + col + 4);
      const float4 w1a = *(const float4*)(cw + 3072 + col), w1b = *(const float4*)(cw + 3072 + col + 4);
      const float4 w2a = *(const float4*)(cw + 6144 + col), w2b = *(const float4*)(cw + 6144 + col + 4);
      const float4 ba = *(const float4*)(cb + col), bb = *(const float4*)(cb + col + 4);
      const float w0[8] = {w0a.x, w0a.y, w0a.z, w0a.w, w0b.x, w0b.y, w0b.z, w0b.w};
      const float w1[8] = {w1a.x, w1a.y, w1a.z, w1a.w, w1b.x, w1b.y, w1b.z, w1b.w};
      const float w2[8] = {w2a.x, w2a.y, w2a.z, w2a.w, w2b.x, w2b.y, w2b.z, w2b.w};
      const float bs[8] = {ba.x, ba.y, ba.z, ba.w, bb.x, bb.y, bb.z, bb.w};
#pragma unroll
      for (int i = 0; i < 8; ++i) val[q][i] = mp * a[i] * w0[i] + b[i] * w1[i] + mn * c[i] * w2[i] + bs[i];
    }
    *(uint4*)(x0c + row * 1024 + c0) = pack8s(val[0], 1.f);
    __syncthreads();
#pragma unroll
    for (int i = 0; i < 8; ++i) tile[tl * 65 + cg * 8 + i] = val[1][i] * val[2][i];
    __syncthreads();
    {
      const int cl = tid >> 3, tq = tid & 7;
      float* dst = uT + ((long)seq * 1024 + ct * 64 + cl) * L + tt * 64 + tq * 8;
      float4 o0, o1;
      o0.x = tile[(tq * 8 + 0) * 65 + cl]; o0.y = tile[(tq * 8 + 1) * 65 + cl]; o0.z = tile[(tq * 8 + 2) * 65 + cl]; o0.w = tile[(tq * 8 + 3) * 65 + cl];
      o1.x = tile[(tq * 8 + 4) * 65 + cl]; o1.y = tile[(tq * 8 + 5) * 65 + cl]; o1.z = tile[(tq * 8 + 6) * 65 + cl]; o1.w = tile[(tq * 8 + 7) * 65 + cl];
      *(float4*)dst = o0; *(float4*)(dst + 4) = o1;
    }
  }
  __syncthreads();
}

__device__ void phase_hy_fft(const Params& P, int slab, bool dry = false) {
  const int L = Lof(slab), N = 2 * L, nseq = SLAB / L, tid = TID();
  float* uT = (float*)(WS(P) + O_UT);
  const float2* hsb = (const float2*)(WS(P) + (slab == 0 ? O_HSPP : O_HSPS));
  const float2* tw = (const float2*)(WS(P) + O_TW);
  const float* skip = P.in[17];
  float2* buf = (float2*)smem;
  const int nitems = (nseq / 2) * 1024;
  for (int item = BID(); item < nitems; item += gridDim.x) {
    const int pr = item >> 10, c = item & 1023;
    float* u0 = uT + ((long)(pr * 2) * 1024 + c) * L;
    float* u1 = u0 + (long)1024 * L;
    __syncthreads();
    for (int t = tid; t < L; t += NT) {
      buf[fidx(t)] = make_float2(u0[t], u1[t]);
      buf[fidx(t + L)] = make_float2(0.f, 0.f);
    }
    __syncthreads();
    fft_dif(buf, N, tw);
    const float2* h = hsb + (long)c * N;
    for (int p = tid; p < N; p += NT) {
      float2 a = buf[fidx(p)], b = h[p];
      buf[fidx(p)] = make_float2(a.x * b.x - a.y * b.y, a.x * b.y + a.y * b.x);
    }
    __syncthreads();
    ifft_dit(buf, N, tw);
    const float sk = skip[c];
    for (int t = tid; t < L; t += NT) {
      float2 y = buf[fidx(t)];
      const long doff = dry ? (long)(END_HY - O_UT) / 4 : 0;
      u0[t + doff] = y.x + u0[t] * sk;
      u1[t + doff] = y.y + u1[t] * sk;
    }
  }
  __syncthreads();
}

__device__ void phase_hy_tr(const Params& P, int slab) {
  const int L = Lof(slab), nseq = SLAB / L, tid = TID();
  const float* __restrict__ yT = (const float*)(WS(P) + O_UT);
  const u16* __restrict__ x0c = (const u16*)(WS(P) + O_X0C);
  u16* __restrict__ a2 = (u16*)(WS(P) + O_A2);
  float* tile = (float*)smem;
  const int ntt = L / 64;
  const int nitems = nseq * ntt * 16;
  for (int item = BID(); item < nitems; item += gridDim.x) {
    const int ct = item % 16, tt = (item / 16) % ntt, seq = item / (16 * ntt);
    const int cl = tid >> 3, tq = tid & 7;
    const float* src = yT + ((long)seq * 1024 + ct * 64 + cl) * L + tt * 64 + tq * 8;
    const float4 i0 = *(const float4*)src, i1 = *(const float4*)(src + 4);
    const int tl = tid >> 3, cg = tid & 7;
    const long row = (long)seq * L + tt * 64 + tl;
    const int c0 = ct * 64 + cg * 8;
    float xg[8];
    unpack8(*(const uint4*)(x0c + row * 1024 + c0), xg);
    __syncthreads();
    float* p = tile + cl * 65 + tq * 8;
    p[0] = i0.x; p[1] = i0.y; p[2] = i0.z; p[3] = i0.w; p[4] = i1.x; p[5] = i1.y; p[6] = i1.z; p[7] = i1.w;
    __syncthreads();
    float o[8];
#pragma unroll
    for (int i = 0; i < 8; ++i) o[i] = tile[(cg * 8 + i) * 65 + tl] * xg[i];
    *(uint4*)(a2 + row * 1024 + c0) = pack8s(o, 1.f);
  }
  __syncthreads();
}

struct Rec {
  int H, DK, DV, C;
  int ldv, voff, goff;
};
__device__ __forceinline__ Rec rec_of(int kind) {
  Rec r;
  if (kind == 1) { r.H = 4; r.DK = 256; r.DV = 512; r.C = 256; r.ldv = 6144; r.voff = 2048; r.goff = 4096; }
  else { r.H = 8; r.DK = 128; r.DV = 128; r.C = 128; r.ldv = 5120; r.voff = 1024; r.goff = 4096; }
  return r;
}

__device__ void phase_ret_prep(const Params& P, int slab) {
  const int L = Lof(slab);
  const u16* __restrict__ pj = (const u16*)(WS(P) + O_PROJ);
  u16* __restrict__ qdf = (u16*)(WS(P) + O_QDF); u16* __restrict__ qdb = (u16*)(WS(P) + O_QDB);
  u16* __restrict__ kif = (u16*)(WS(P) + O_KIF); u16* __restrict__ kib = (u16*)(WS(P) + O_KIB);
  u16* __restrict__ kef = (u16*)(WS(P) + O_KEF); u16* __restrict__ keb = (u16*)(WS(P) + O_KEB);
  float* dlf = (float*)(WS(P) + O_DLF); float* dlb = (float*)(WS(P) + O_DLB);
  const float2* __restrict__ rope = (const float2*)(WS(P) + O_ROPER);
  const long gtid = (long)BID() * NT + TID(), gsz = (long)gridDim.x * NT;
  for (long idx = gtid; idx < (long)SLAB * 64; idx += gsz) {
    const int d0 = (int)(idx & 15) * 8, h = (int)((idx >> 4) & 3), t = (int)(idx >> 6);
    const int pos = t & (L - 1), r = t & 255;
    const float lgf = -expf(P.in[20][h]), lgb = -expf(P.in[20][4 + h]);
    const u16* row = pj + (long)t * 6144 + h * 256 + d0;
    const uint4 vq1 = *(const uint4*)row, vq2 = *(const uint4*)(row + 128);
    const uint4 vk1 = *(const uint4*)(row + 1024), vk2 = *(const uint4*)(row + 1024 + 128);
    const float4* rp = (const float4*)(rope + (long)pos * 128 + d0);
    const float4 c01 = rp[0], c23 = rp[1], c45 = rp[2], c67 = rp[3];
    float q1[8], q2[8], k1[8], k2[8];
    unpack8(vq1, q1); unpack8(vq2, q2); unpack8(vk1, k1); unpack8(vk2, k2);
    const float cs[8] = {c01.x, c01.z, c23.x, c23.z, c45.x, c45.z, c67.x, c67.z};
    const float sn[8] = {c01.y, c01.w, c23.y, c23.w, c45.y, c45.w, c67.y, c67.w};
    float qa[8], qb[8], ka[8], kb[8];
#pragma unroll
    for (int i = 0; i < 8; ++i) {
      qa[i] = q1[i] * cs[i] - q2[i] * sn[i]; qb[i] = q1[i] * sn[i] + q2[i] * cs[i];
      ka[i] = (k1[i] * cs[i] - k2[i] * sn[i]) * 0.0625f; kb[i] = (k1[i] * sn[i] + k2[i] * cs[i]) * 0.0625f;
    }
    const float bf = (float)(r + 1) * lgf, bb = (float)(256 - r) * lgb;
    const float ef = expf(bf), eif = expf(-bf), eef = expf((float)(255 - r) * lgf);
    const float eb = expf(bb), eib = expf(-bb), eeb = expf((float)r * lgb);
    const long o1 = (long)t * 1024 + h * 256 + d0, o2 = o1 + 128;
    *(uint4*)(qdf + o1) = pack8s(qa, ef); *(uint4*)(qdf + o2) = pack8s(qb, ef);
    *(uint4*)(qdb + o1) = pack8s(qa, eb); *(uint4*)(qdb + o2) = pack8s(qb, eb);
    *(uint4*)(kef + o1) = pack8s(ka, eef); *(uint4*)(kef + o2) = pack8s(kb, eef);
    *(uint4*)(keb + o1) = pack8s(ka, eeb); *(uint4*)(keb + o2) = pack8s(kb, eeb);
    if (r == 0) {
      const long cgi = (long)(t >> 8) * 1024 + h * 256 + d0;
      const float df = expf(256.f * lgf), db = expf(256.f * lgb);
#pragma unroll
      for (int i = 0; i < 8; ++i) { dlf[cgi + i] = df; dlf[cgi + 128 + i] = df; dlb[cgi + i] = db; dlb[cgi + 128 + i] = db; }
    }
  }
}

__device__ __forceinline__ float lb_of(const float* lbt, int dr, int ch) {
  const float a0 = lbt[(dr * 4 + 0) * 1024 + ch], a1 = lbt[(dr * 4 + 1) * 1024 + ch], a2 = lbt[(dr * 4 + 2) * 1024 + ch], a3 = lbt[(dr * 4 + 3) * 1024 + ch];
  const float m = fmaxf(fmaxf(a0, a1), fmaxf(a2, a3));
  const float e0 = expf(a0 - m), e1 = expf(a1 - m), e2 = expf(a2 - m), e3 = expf(a3 - m);
  return (e0 + e1 + e2) / (e0 + e1 + e2 + e3);
}
__device__ void phase_hg_prep(const Params& P) {
  const u16* __restrict__ pj = (const u16*)(WS(P) + O_PROJ);
  u16* __restrict__ qdf = (u16*)(WS(P) + O_QDF); u16* __restrict__ qdb = (u16*)(WS(P) + O_QDB);
  u16* __restrict__ kif = (u16*)(WS(P) + O_KIF); u16* __restrict__ kib = (u16*)(WS(P) + O_KIB);
  u16* __restrict__ kef = (u16*)(WS(P) + O_KEF); u16* __restrict__ keb = (u16*)(WS(P) + O_KEB);
  float* dlf = (float*)(WS(P) + O_DLF); float* dlb = (float*)(WS(P) + O_DLB);
  const float* lbt = P.in[28];
  float* totF = (float*)smem;
  float* totB = totF + 1024;
  const int tid = TID(), lane = tid & 63, rg = tid >> 6;
  constexpr int RPT = 16;
  for (int item = BID(); item < 1024; item += gridDim.x) {
    const int cgi = item >> 3, ch = (item & 7) * 128 + lane * 2;
    const long t0 = (long)cgi * 128 + rg * RPT;
    unsigned wq[RPT], wf[RPT], wb[RPT];
#pragma unroll
    for (int i = 0; i < RPT; ++i) {
      const u16* row = pj + (t0 + i) * 5120 + ch;
      wq[i] = *(const unsigned*)row; wf[i] = *(const unsigned*)(row + 2048); wb[i] = *(const unsigned*)(row + 3072);
    }
    float lb0[2], lb1[2];
    lb0[0] = lb_of(lbt, 0, ch); lb0[1] = lb_of(lbt, 0, ch + 1);
    lb1[0] = lb_of(lbt, 1, ch); lb1[1] = lb_of(lbt, 1, ch + 1);
    float pf[2][RPT], sb[2][RPT], accf[2], accb[2];
#pragma unroll
    for (int c = 0; c < 2; ++c) {
      float a = 0.f;
#pragma unroll
      for (int i = 0; i < RPT; ++i) {
        const float x = bf2f((u16)(c ? (wf[i] >> 16) : (wf[i] & 0xffff)));
        a += logf(lb0[c] + (1.f - lb0[c]) * sigm(x)); pf[c][i] = a;
      }
      accf[c] = a;
      a = 0.f;
#pragma unroll
      for (int i = RPT - 1; i >= 0; --i) {
        const float x = bf2f((u16)(c ? (wb[i] >> 16) : (wb[i] & 0xffff)));
        a += logf(lb1[c] + (1.f - lb1[c]) * sigm(x)); sb[c][i] = a;
      }
      accb[c] = a;
    }
    __syncthreads();
    *(float2*)(totF + rg * 128 + lane * 2) = make_float2(accf[0], accf[1]);
    *(float2*)(totB + rg * 128 + lane * 2) = make_float2(accb[0], accb[1]);
    __syncthreads();
    float offF[2] = {0.f, 0.f}, offB[2] = {0.f, 0.f}, totf[2] = {0.f, 0.f}, totb[2] = {0.f, 0.f};
#pragma unroll
    for (int g = 0; g < 8; ++g) {
      const float2 f = *(const float2*)(totF + g * 128 + lane * 2), bq = *(const float2*)(totB + g * 128 + lane * 2);
      totf[0] += f.x; totf[1] += f.y; totb[0] += bq.x; totb[1] += bq.y;
      if (g < rg) { offF[0] += f.x; offF[1] += f.y; }
      if (g > rg) { offB[0] += bq.x; offB[1] += bq.y; }
    }
#pragma unroll
    for (int i = 0; i < RPT; ++i) {
      float o[6][2];
#pragma unroll
      for (int c = 0; c < 2; ++c) {
        const float xq = bf2f((u16)(c ? (wq[i] >> 16) : (wq[i] & 0xffff)));
        const float xf = bf2f((u16)(c ? (wf[i] >> 16) : (wf[i] & 0xffff)));
        const float xb = bf2f((u16)(c ? (wb[i] >> 16) : (wb[i] & 0xffff)));
        const float q = silu_f(xq);
        const float bf = offF[c] + pf[c][i], bb = offB[c] + sb[c][i];
        const float kf = (1.f - lb0[c]) * sigm(-xf), kb = (1.f - lb1[c]) * sigm(-xb);
        o[0][c] = q * expf(bf); o[1][c] = kf * expf(-bf); o[2][c] = kf * expf(totf[c] - bf);
        o[3][c] = q * expf(bb); o[4][c] = kb * expf(-bb); o[5][c] = kb * expf(totb[c] - bb);
      }
      const long oo = (t0 + i) * 1024 + ch;
      *(unsigned*)(qdf + oo) = pack2(o[0][0], o[0][1]);
      *(unsigned*)(kif + oo) = pack2(o[1][0], o[1][1]);
      *(unsigned*)(kef + oo) = pack2(o[2][0], o[2][1]);
      *(unsigned*)(qdb + oo) = pack2(o[3][0], o[3][1]);
      *(unsigned*)(kib + oo) = pack2(o[4][0], o[4][1]);
      *(unsigned*)(keb + oo) = pack2(o[5][0], o[5][1]);
    }
    if (rg == 0) {
      *(float2*)(dlf + (long)cgi * 1024 + ch) = make_float2(expf(totf[0]), expf(totf[1]));
      *(float2*)(dlb + (long)cgi * 1024 + ch) = make_float2(expf(totb[0]), expf(totb[1]));
    }
  }
  __syncthreads();
}

template <int C, int DKT>
__device__ __forceinline__ void rec_scores_item(const Params& P, const Rec& R, int cgi, int h, int ti, int tj) {
  constexpr int T = C > 128 ? 128 : C, KTS = DKT;
  const u16* qdf = (const u16*)(WS(P) + O_QDF); const u16* qdb = (const u16*)(WS(P) + O_QDB);
  const u16* kif = (const u16*)(WS(P) + O_KIF); const u16* kib = (const u16*)(WS(P) + O_KIB);
  u16* sc = (u16*)(WS(P) + O_SC) + (((long)cgi * R.H + h) * C + ti * T) * C + tj * T;
  const long offA = ((long)cgi * C + ti * T) * 1024 + h * R.DK, offB = ((long)cgi * C + tj * T) * 1024 + h * R.DK;
  f32x4 af[T / 32][T / 64] = {}, ab[T / 32][T / 64] = {};
  float sff = 1.f, sfb = 1.f;
  if (C == 256) {
    kif = (const u16*)(WS(P) + O_KEF); kib = (const u16*)(WS(P) + O_KEB);
    sff = expf((float)C * expf(P.in[20][h])); sfb = expf((float)C * expf(P.in[20][4 + h]));
  }
  if (ti >= tj) gemm_acc<T, T, true, true, true, KTS>(af, qdf + offA, 1024, kif + offB, 1024, (u16*)smem);
  if (ti <= tj) gemm_acc<T, T, true, true, true, KTS>(ab, qdb + offA, 1024, kib + offB, 1024, (u16*)smem);
  const int tid = TID(), lane = tid & 63, wid = tid >> 6;
  const int wm = wid >> 2, wn = wid & 3, fr = lane & 15, fq = lane >> 4;
#pragma unroll
  for (int mi = 0; mi < T / 32; ++mi)
#pragma unroll
    for (int ni = 0; ni < T / 64; ++ni) {
      const int r = wm * (T / 2) + mi * 16 + fr, c0 = wn * (T / 4) + ni * 16 + fq * 4;
      const int gr = ti * T + r;
      float v[4];
#pragma unroll
      for (int j = 0; j < 4; ++j) {
        const int gc = tj * T + c0 + j;
        v[j] = (gc <= gr ? af[mi][ni][j] * sff : 0.f) + (gc >= gr ? ab[mi][ni][j] * sfb : 0.f);
      }
      *(uint2*)(sc + r * C + c0) = make_uint2(pack2(v[0], v[1]), pack2(v[2], v[3]));
    }
}

template <int C, int DKT>
__device__ void phase_rec_su(const Params& P, int kind) {
  const Rec R = rec_of(kind);
  constexpr int KTU = C / 64;
  const int nch = SLAB / C;
  constexpr int NT1 = (C > 128 ? C / 128 : 1), NTT = NT1 * NT1;
  const int n_sc = nch * R.H * NTT;
  const int mtn = R.DK / 128, ntn = R.DV / 128;
  const int n_u = nch * R.H * 2 * mtn * ntn, G = gridDim.x;
  const u16* pj = (const u16*)(WS(P) + O_PROJ);
  for (int item = VBID(); item < n_sc; item += G) { const int tl = item % NTT, hh = (item / NTT) % R.H, cg = item / (NTT * R.H); rec_scores_item<C, DKT>(P, R, cg, hh, tl / NT1, tl % NT1); }
  const u16* kef = (const u16*)(WS(P) + O_KEF); const u16* keb = (const u16*)(WS(P) + O_KEB);
  u16* stfb = (u16*)(WS(P) + O_STF); u16* stbb = (u16*)(WS(P) + O_STB);
  Tiles<KTU> ta, tb;
#define U_DECODE(q_, nt_, mt_, dir_, h_, cgi_) int nt_, mt_, dir_, h_, cgi_; { int qq = (q_); nt_ = qq % ntn; qq /= ntn; mt_ = qq % mtn; qq /= mtn; dir_ = qq & 1; qq >>= 1; h_ = qq % R.H; cgi_ = qq / R.H; }
#define U_ISSUE(T_, nt_, mt_, dir_, h_, cgi_) tiles_issue<128, 128, false, false, KTU>(T_, (dir_ ? keb : kef) + (long)cgi_ * C * 1024 + h_ * R.DK + mt_ * 128, 1024, pj + (long)cgi_ * C * R.ldv + R.voff + h_ * R.DV + nt_ * 128, R.ldv)
#define U_RUN(T_, nt_, mt_, dir_, h_, cgi_) { f32x4 acc[4][2] = {}; gemm_run<128, 128, false, false, false, KTU>(acc, T_, (u16*)smem); \
    u16* st = (dir_ ? stbb : stfb) + (((long)cgi_ * R.H + h_) * R.DV + nt_ * 128) * R.DK + mt_ * 128; const int DK = R.DK; \
    epi_each<128, 128, false>(acc, [&](int r, int c, f32x4 val) { *(uint2*)(st + (long)c * DK + r) = make_uint2(pack2(val[0], val[1]), pack2(val[2], val[3])); }); }
  int q = VBID();
  if (q < n_u) { U_DECODE(q, nt, mt, dir, h, cgi); U_ISSUE(ta, nt, mt, dir, h, cgi); }
  for (; q < n_u; q += 2 * G) {
    U_DECODE(q, nt, mt, dir, h, cgi);
    const int q2 = q + G;
    if (q2 < n_u) { U_DECODE(q2, nt2, mt2, dir2, h2, cgi2); U_ISSUE(tb, nt2, mt2, dir2, h2, cgi2); }
    U_RUN(ta, nt, mt, dir, h, cgi);
    const int q3 = q + 2 * G;
    if (q3 < n_u) { U_DECODE(q3, nt3, mt3, dir3, h3, cgi3); U_ISSUE(ta, nt3, mt3, dir3, h3, cgi3); }
    if (q2 < n_u) { U_DECODE(q2, nt2, mt2, dir2, h2, cgi2); U_RUN(tb, nt2, mt2, dir2, h2, cgi2); }
  }
#undef U_DECODE
#undef U_ISSUE
#undef U_RUN
  __syncthreads();
}

__device__ void phase_rec_scan(const Params& P, int kind, int slab, bool dry = false) {
  const Rec R = rec_of(kind);
  const int L = Lof(slab), nseq = SLAB / L, ncs = L / R.C;
  const int qdk = R.DK / 4;
  const long per = (long)R.H * R.DV * qdk;
  const long total = 2 * nseq * per;
  const long gtid = (long)BID() * NT + TID(), gsz = (long)gridDim.x * NT;
  for (long idx = gtid; idx < total; idx += gsz) {
    long q = idx;
    const int pd = (int)(q % qdk); q /= qdk;
    const int e = (int)(q % R.DV); q /= R.DV;
    const int h = (int)(q % R.H); q /= R.H;
    const int seq = (int)(q % nseq);
    const int dir = (int)(q / nseq);
    u16* st = (u16*)(WS(P) + (dir ? O_STB : O_STF));
    u16* stw = dry ? (u16*)(WS(P) + O_OBUF) : st;
    const float* dl = (const float*)(WS(P) + (dir ? O_DLB : O_DLF));
    float s0 = 0.f, s1 = 0.f, s2 = 0.f, s3 = 0.f;
    const long ebase = ((long)h * R.DV + e) * R.DK + pd * 4;
    const long cstride = (long)R.H * R.DV * R.DK;
    const int dbase = h * R.DK + pd * 4;
    for (int i0 = 0; i0 < ncs; i0 += 8) {
      uint2 u[8];
      float4 dd[8];
#pragma unroll
      for (int j = 0; j < 8; ++j) {
        const int n = dir ? (ncs - 1 - i0 - j) : (i0 + j);
        const long cgi = (long)seq * ncs + n;
        u[j] = *(const uint2*)(st + cgi * cstride + ebase);
        dd[j] = *(const float4*)(dl + cgi * 1024 + dbase);
      }
#pragma unroll
      for (int j = 0; j < 8; ++j) {
        const int n = dir ? (ncs - 1 - i0 - j) : (i0 + j);
        const long cgi = (long)seq * ncs + n;
        *(uint2*)(stw + cgi * cstride + ebase) = make_uint2(pack2(s0, s1), pack2(s2, s3));
        s0 = dd[j].x * s0 + bf2f((u16)(u[j].x & 0xffff));
        s1 = dd[j].y * s1 + bf2f((u16)(u[j].x >> 16));
        s2 = dd[j].z * s2 + bf2f((u16)(u[j].y & 0xffff));
        s3 = dd[j].w * s3 + bf2f((u16)(u[j].y >> 16));
      }
    }
  }
}

template <int C, int DKT>
__device__ void phase_rec_out(const Params& P, int kind) {
  const Rec R = rec_of(kind);
  constexpr int T = C > 128 ? 128 : C, NRT = C / T;
  constexpr int KT1 = C / 64, KT2 = DKT;
  const int nch = SLAB / C, ntn = R.DV / 128;
  const u16* pj = (const u16*)(WS(P) + O_PROJ);
  const u16* scb = (const u16*)(WS(P) + O_SC);
  const u16* qdf = (const u16*)(WS(P) + O_QDF); const u16* qdb = (const u16*)(WS(P) + O_QDB);
  const u16* stf = (const u16*)(WS(P) + O_STF); const u16* stb = (const u16*)(WS(P) + O_STB);
  u16* ob = (u16*)(WS(P) + O_OBUF);
  const int HDV = R.H * R.DV;
  const int nitems = nch * R.H * NRT * ntn, G = gridDim.x;
  Tiles<KT1> t1; Tiles<KT2> t2; Tiles<KT2> t3;
  int item = VBID();
  if (item < nitems) {
    const int nt = item % ntn, rt = (item / ntn) % NRT, h = (item / (ntn * NRT)) % R.H, cgi = item / (ntn * NRT * R.H);
    tiles_issue<T, 128, true, false, KT1>(t1, scb + (((long)cgi * R.H + h) * C + rt * T) * C, C, pj + (long)cgi * C * R.ldv + R.voff + h * R.DV + nt * 128, R.ldv);
  }
  for (; item < nitems; item += G) {
    const int nt = item % ntn, rt = (item / ntn) % NRT, h = (item / (ntn * NRT)) % R.H, cgi = item / (ntn * NRT * R.H);
    const long qoff = ((long)cgi * C + rt * T) * 1024 + h * R.DK;
    const long soff = (((long)cgi * R.H + h) * R.DV + nt * 128) * R.DK;
    f32x4 acc[T / 32][2] = {};
    tiles_issue<T, 128, true, true, KT2>(t2, qdf + qoff, 1024, stf + soff, R.DK);
    gemm_run<T, 128, true, false, true, KT1>(acc, t1, (u16*)smem);
    tiles_issue<T, 128, true, true, KT2>(t3, qdb + qoff, 1024, stb + soff, R.DK);
    gemm_run<T, 128, true, true, true, KT2>(acc, t2, (u16*)smem);
    const int nx = item + G;
    if (nx < nitems) {
      const int nt2 = nx % ntn, rt2 = (nx / ntn) % NRT, h2 = (nx / (ntn * NRT)) % R.H, cg2 = nx / (ntn * NRT * R.H);
      tiles_issue<T, 128, true, false, KT1>(t1, scb + (((long)cg2 * R.H + h2) * C + rt2 * T) * C, C, pj + (long)cg2 * C * R.ldv + R.voff + h2 * R.DV + nt2 * 128, R.ldv);
    }
    gemm_run<T, 128, true, true, true, KT2>(acc, t3, (u16*)smem);
    u16* o = ob + ((long)cgi * C + rt * T) * HDV + h * R.DV + nt * 128;
    epi_each<T, 128, true>(acc, [&](int r, int c, f32x4 val) { *(uint2*)(o + (long)r * HDV + c) = make_uint2(pack2(val[0], val[1]), pack2(val[2], val[3])); });
  }
  __syncthreads();
}

template <int KIND>
__device__ void phase_rec_ng_t(const Params& P) {
  const Rec R = rec_of(KIND);
  constexpr int DV = (KIND == 1) ? 512 : 128, H = (KIND == 1) ? 4 : 8, PER = DV / 64, HDV = H * DV;
  const u16* __restrict__ ob = (const u16*)(WS(P) + O_OBUF);
  const u16* __restrict__ pj = (const u16*)(WS(P) + O_PROJ);
  u16* __restrict__ a2 = (u16*)(WS(P) + O_A2);
  const float* gain = P.in[29];
  const int tid = TID(), lane = tid & 63, wid = tid >> 6;
  constexpr int nrows = SLAB * H;
  for (int item = BID(); item < nrows / 32; item += gridDim.x) {
    float v[4][PER];
    float ss[4];
#pragma unroll
    for (int u = 0; u < 4; ++u) {
      const int rh = item * 32 + wid * 4 + u;
      const int t = rh / H, h = rh % H;
      const u16* o = ob + (long)t * HDV + h * DV + lane * PER;
      if (PER == 8) {
        float f8[8];
        unpack8(*(const uint4*)o, f8);
#pragma unroll
        for (int i = 0; i < 8; ++i) v[u][i % PER] = f8[i];
      } else {
        const unsigned w = *(const unsigned*)o;
        v[u][0] = bf2f((u16)(w & 0xffff)); v[u][1 % PER] = bf2f((u16)(w >> 16));
      }
      float a = 0.f;
#pragma unroll
      for (int i = 0; i < PER; ++i) a += v[u][i] * v[u][i];
      ss[u] = a;
    }
#pragma unroll
    for (int u = 0; u < 4; ++u) ss[u] = wave_sum(ss[u]);
#pragma unroll
    for (int u = 0; u < 4; ++u) {
      const int rh = item * 32 + wid * 4 + u;
      const int t = rh / H, h = rh % H;
      const float rstd = rsqrtf(ss[u] / (float)DV + 1e-6f);
      const u16* g = pj + (long)t * R.ldv + R.goff + h * DV + lane * PER;
      u16* out = a2 + (long)t * HDV + h * DV + lane * PER;
      float y[PER];
#pragma unroll
      for (int i = 0; i < PER; ++i) {
        y[i] = v[u][i] * rstd;
        if (KIND == 3) y[i] *= gain[lane * PER + i];
      }
      if (PER == 8) {
        const uint4 gw = *(const uint4*)g;
        float gf[8];
        unpack8(gw, gf);
        float r8[8];
#pragma unroll
        for (int i = 0; i < 8; ++i) r8[i] = y[i % PER] * silu_f(gf[i]);
        *(uint4*)out = pack8s(r8, 1.f);
      } else {
        const unsigned gw = *(const unsigned*)g;
        *(unsigned*)out = pack2(y[0] * silu_f(bf2f((u16)(gw & 0xffff))), y[1 % PER] * silu_f(bf2f((u16)(gw >> 16))));
      }
    }
  }
}
__device__ void phase_rec_ng(const Params& P, int kind) {
  if (kind == 1) phase_rec_ng_t<1>(P); else phase_rec_ng_t<3>(P);
}

__device__ void phase_swa_prep(const Params& P) {
  const u16* __restrict__ pj = (const u16*)(WS(P) + O_SA_P);
  u16* __restrict__ qn = (u16*)(WS(P) + O_SA_Q);
  u16* __restrict__ kn = (u16*)(WS(P) + O_SA_K);
  const float2* __restrict__ rope = (const float2*)(WS(P) + O_ROPES);
  const long gtid = (long)BID() * NT + TID(), gsz = (long)gridDim.x * NT;
  for (long idx = gtid; idx < (long)NTOK * 80; idx += gsz) {
    const int j = (int)(idx & 3);
    const int hd = (int)((idx >> 2) % 20);
    const int t = (int)(idx / 80);
    const int col = hd < 16 ? hd * 64 : 1024 + (hd - 16) * 64;
    const int d0 = j * 8;
    float x1[8], x2[8];
    unpack8(*(const uint4*)(pj + (long)t * 1536 + col + d0), x1);
    unpack8(*(const uint4*)(pj + (long)t * 1536 + col + d0 + 32), x2);
    const int L = t < 16384 ? 2048 : 8192;
    const float4* rp = (const float4*)(rope + (long)(t & (L - 1)) * 32 + d0);
    const float4 c01 = rp[0], c23 = rp[1], c45 = rp[2], c67 = rp[3];
    float ss = 0.f;
#pragma unroll
    for (int i = 0; i < 8; ++i) ss += x1[i] * x1[i] + x2[i] * x2[i];
    ss += __shfl_xor(ss, 1); ss += __shfl_xor(ss, 2);
    const float rstd = rsqrtf(ss * (1.f / 64.f) + 1e-6f);
    const float* gn = hd < 16 ? P.in[23] : P.in[24];
    const float4 ga = *(const float4*)(gn + d0), gb = *(const float4*)(gn + d0 + 4), gc = *(const float4*)(gn + d0 + 32), gd = *(const float4*)(gn + d0 + 36);
    const float g1[8] = {ga.x, ga.y, ga.z, ga.w, gb.x, gb.y, gb.z, gb.w};
    const float g2[8] = {gc.x, gc.y, gc.z, gc.w, gd.x, gd.y, gd.z, gd.w};
    const float cs[8] = {c01.x, c01.z, c23.x, c23.z, c45.x, c45.z, c67.x, c67.z};
    const float sn[8] = {c01.y, c01.w, c23.y, c23.w, c45.y, c45.w, c67.y, c67.w};
    const float osc = hd < 16 ? 0.125f : 1.f;
    float o1[8], o2[8];
#pragma unroll
    for (int i = 0; i < 8; ++i) {
      const float y1 = x1[i] * rstd * g1[i], y2 = x2[i] * rstd * g2[i];
      o1[i] = (y1 * cs[i] - y2 * sn[i]) * osc;
      o2[i] = (y1 * sn[i] + y2 * cs[i]) * osc;
    }
    u16* dst = hd < 16 ? qn + (long)t * 1024 + hd * 64 + d0 : kn + (long)t * 256 + (hd - 16) * 64 + d0;
    *(uint4*)dst = pack8s(o1, 1.f);
    *(uint4*)(dst + 32) = pack8s(o2, 1.f);
  }
}

constexpr int SLD = 324;
__device__ void phase_swa_att(const Params& P) {
  const u16* qn = (const u16*)(WS(P) + O_SA_Q);
  const u16* kn = (const u16*)(WS(P) + O_SA_K);
  const u16* pj = (const u16*)(WS(P) + O_SA_P);
  u16* a2 = (u16*)(WS(P) + O_SA_A);
  const float* sink = P.in[25];
  float* S = (float*)(smem + 40960);
  u16* Bs = (u16*)smem + 9216;
  const int tid = TID(), lane = tid & 63, wid = tid >> 6;
  const int wm = wid >> 2, wn = wid & 3, fr = lane & 15, fq = lane >> 4;
  const int nitems = (NTOK / 64) * 16;
  for (int item = VBID(); item < nitems; item += gridDim.x) {
    const int hq = item & 15, qbg = item >> 4;
    const int L = qbg < 256 ? 2048 : 8192;
    const int q0 = qbg < 256 ? (qbg & 31) * 64 : ((qbg - 256) & 127) * 64;
    const long tok0 = qbg < 256 ? (long)(qbg >> 5) * 2048 : 16384 + (long)((qbg - 256) >> 7) * 8192;
    const int hkv = hq >> 2;
    uint4 vt[5];
#pragma unroll
    for (int kt = 0; kt < 5; ++kt) {
      const int kp0 = q0 - 128 + kt * 64;
      vt[kt] = make_uint4(0, 0, 0, 0);
      if (kp0 >= 0 && kp0 < L) vt[kt] = ld_chunk<64, false>(pj + (tok0 + kp0) * 1536 + 1280 + hkv * 64, 1536, 0, tid);
    }
    for (int kt = 0; kt < 5; ++kt) {
      const int kp0 = q0 - 128 + kt * 64;
      if (kp0 >= 0 && kp0 < L) {
        f32x4 acc[2][1] = {};
        gemm_acc<64, 64, true, true, true, 1>(acc, qn + (tok0 + q0) * 1024 + hq * 64, 1024, kn + (tok0 + kp0) * 256 + hkv * 64, 256, (u16*)smem);
        epi_each<64, 64, true>(acc, [&](int r, int c, f32x4 v) {
          f32x4 o;
#pragma unroll
          for (int j = 0; j < 4; ++j) {
            const int dlt = (q0 + r) - (kp0 + c + j);
            o[j] = (dlt <= 128 && dlt >= -128) ? v[j] : -1e30f;
          }
          *(f32x4*)(S + r * SLD + kt * 64 + c) = o;
        });
      } else {
        for (int i = tid; i < 4096; i += NT) S[(i >> 6) * SLD + kt * 64 + (i & 63)] = -1e30f;
      }
    }
    __syncthreads();
    {
      const int r = tid >> 3, sub = tid & 7;
      const float sk = sink[hq];
      float e[40];
      float m = sk;
#pragma unroll
      for (int i = 0; i < 40; ++i) { e[i] = S[r * SLD + sub + 8 * i]; m = fmaxf(m, e[i]); }
      m = fmaxf(m, __shfl_xor(m, 1)); m = fmaxf(m, __shfl_xor(m, 2)); m = fmaxf(m, __shfl_xor(m, 4));
      float den = 0.f;
#pragma unroll
      for (int i = 0; i < 40; ++i) { e[i] = __expf(e[i] - m); den += e[i]; }
      den += __shfl_xor(den, 1); den += __shfl_xor(den, 2); den += __shfl_xor(den, 4);
      den += __expf(sk - m);
      const float inv = 1.f / den;
      u16* prow = (u16*)(S + r * SLD);
#pragma unroll
      for (int i = 0; i < 40; ++i) prow[sub + 8 * i] = f2bf(e[i] * inv);
    }
    __syncthreads();
    f32x4 acc[2][1] = {};
#pragma unroll
    for (int kt = 0; kt < 5; ++kt) {
      const int kp0 = q0 - 128 + kt * 64;
      if (kp0 >= 0 && kp0 < L) {
        __syncthreads();
        st_chunk<64, false>(Bs, vt[kt], tid);
        __syncthreads();
#pragma unroll
        for (int ks = 0; ks < 2; ++ks) {
          bf16x8 af[2];
#pragma unroll
          for (int mi = 0; mi < 2; ++mi) af[mi] = *(const bf16x8*)((const u16*)(S + (wm * 32 + mi * 16 + fr) * SLD) + kt * 64 + ks * 32 + fq * 8);
          const bf16x8 bfr = ld_frag<64, false>(Bs, wn * 16, ks, fr, fq);
#pragma unroll
          for (int mi = 0; mi < 2; ++mi) acc[mi][0] = __builtin_amdgcn_mfma_f32_16x16x32_bf16(bfr, af[mi], acc[mi][0], 0, 0, 0);
        }
      }
    }
    u16* o = a2 + (tok0 + q0) * 1024 + hq * 64;
    epi_each<64, 64, true>(acc, [&](int r, int c, f32x4 v) { *(uint2*)(o + (long)r * 1024 + c) = make_uint2(pack2(v[0], v[1]), pack2(v[2], v[3])); });
    __syncthreads();
  }
}

#define XB_TMO      128
#define XB_XCNT(j)  (256  + 64 * (j))
#define XB_XSUB(j)  (1280 + 64 * (j))
#define XB_XGEN(j)  (2304 + 64 * (j))
#define XB_TOP      3328
#define XB_TOPGEN   3392
#define XCD_BAR_WORDS 3456
#define XB_SPIN_CAP (1u << 18)
__device__ __forceinline__ unsigned xb_ld(unsigned* p)              { return __hip_atomic_load(p, __ATOMIC_RELAXED, __HIP_MEMORY_SCOPE_AGENT); }
__device__ __forceinline__ unsigned xb_add(unsigned* p, unsigned v) { return __hip_atomic_fetch_add(p, v, __ATOMIC_RELAXED, __HIP_MEMORY_SCOPE_AGENT); }
__device__ __forceinline__ unsigned xb_xcc_id() { return (unsigned)__builtin_amdgcn_s_getreg((3 << 11) | 20) & 0xFu; }
#define XB_SPIN(cond, bar) do { unsigned _sp = 0; while (cond) { __builtin_amdgcn_s_sleep(1); \
    if ((++_sp & 255u) == 0u) { if (xb_ld(&(bar)[XB_TMO])) break; if (_sp > XB_SPIN_CAP) { atomicAdd(&(bar)[XB_TMO], 1u); break; } } } } while (0)
struct XcdBarrier { unsigned* bar; unsigned x; volatile LDS_AS unsigned* st; };
__device__ __forceinline__ XcdBarrier xcd_barrier_post(unsigned* bar, volatile LDS_AS unsigned* st) {
    XcdBarrier b; b.bar = bar; b.x = xb_xcc_id(); b.st = st;
    if (threadIdx.x == 0) (void)xb_add(&bar[XB_XCNT(b.x)], 1u);
    return b;
}
__device__ __forceinline__ void xcd_barrier_complete(unsigned* bar, unsigned x, unsigned& nloc, unsigned& nx) {
    const unsigned G = gridDim.x * gridDim.y * gridDim.z;
    unsigned sum, cnt, mine, sp = 0u;
    for (;;) {
        sum = 0u; cnt = 0u; mine = 0u;
#pragma unroll
        for (unsigned j = 0; j < 16; ++j) { const unsigned c = xb_ld(&bar[XB_XCNT(j)]); sum += c; cnt += (c > 0u) ? 1u : 0u; mine = (j == x) ? c : mine; }
        if (sum == G) break;
        __builtin_amdgcn_s_sleep(1);
        if ((++sp & 255u) == 0u) { if (xb_ld(&bar[XB_TMO])) break; if (sp > XB_SPIN_CAP) { atomicAdd(&bar[XB_TMO], 1u); break; } }
    }
    nloc = mine > 0u ? mine : 1u; nx = cnt > 0u ? cnt : 1u;
}
__device__ __forceinline__ void xcd_barrier(const XcdBarrier& b) {
    asm volatile("s_waitcnt vmcnt(0)" ::: "memory");
    __syncthreads();
    if (threadIdx.x == 0) {
        unsigned* bar = b.bar;
        __builtin_amdgcn_s_waitcnt(0);
        unsigned nloc = b.st[0], nx = b.st[1];
        if (nloc == 0u) { xcd_barrier_complete(bar, b.x, nloc, nx); b.st[0] = nloc; b.st[1] = nx; }
        const unsigned old = xb_add(&bar[XB_XSUB(b.x)], 1u);
        const unsigned gen = old / nloc;
        if (old + 1u == (gen + 1u) * nloc) {
            __builtin_amdgcn_fence(__ATOMIC_RELEASE, "agent");
            asm volatile("s_waitcnt vmcnt(0)" ::: "memory");
            const unsigned og = xb_add(&bar[XB_TOP], 1u);
            const unsigned tg = og / nx;
            if (og + 1u == (tg + 1u) * nx) xb_add(&bar[XB_TOPGEN], 1u);
            else XB_SPIN(xb_ld(&bar[XB_TOPGEN]) == tg, bar);
            __builtin_amdgcn_fence(__ATOMIC_ACQUIRE, "agent");
            xb_add(&bar[XB_XGEN(b.x)], 1u);
            asm volatile("s_waitcnt vmcnt(0)" ::: "memory");
        } else {
            XB_SPIN(xb_ld(&bar[XB_XGEN(b.x)]) == gen, bar);
            __builtin_amdgcn_fence(__ATOMIC_ACQUIRE, "agent");
            asm volatile("s_waitcnt vmcnt(0)" ::: "memory");
        }
    }
    __syncthreads();
}

__device__ __forceinline__ int nmix_of(int kind) { return (kind & 1) ? 8 : (kind == 2 ? 5 : 6); }
__device__ __forceinline__ int nsl_of(int kind) { return kind == 2 ? 1 : 5; }

__device__ void ffn_step(const Params& P, int layer, int f) {
  if (f == 6) { phase_ffn_down(P, layer); return; }
  const int fs = f / 3, st = f % 3;
  if (st == 0) { REP(4) phase_norm(P, layer, fs, 1); }
  else if (st == 1) { REP(0) phase_ffn_gate(P, layer); }
  else { REP(0) phase_ffn_val(P, layer, fs); }
}
__device__ void layer_step(const Params& P, int layer, int slab, int step) {
  const int kind = layer;
  if (step == 0) { REP(4) phase_norm(P, layer, slab, kind == 2 ? 2 : 0); return; }
  if (kind == 0) {
    if (step == 1) { REP(0) phase_proj(P, O_WHYIN, 3072); }
    else if (step == 2) { REP(3) phase_hy_conv(P, slab); }
    else if (step == 3) { if ((PROBE_MASK >> 7) & 1) phase_hy_fft(P, slab, true); phase_hy_fft(P, slab); }
    else if (step == 4) { REP(3) phase_hy_tr(P, slab); }
    else phase_resid(P, layer, slab, (const u16*)(WS(P) + O_A2), 1024, O_WHYOUT, 2 * D);
  } else if (kind == 1) {
    if (step == 1) { REP(0) phase_proj(P, O_WRETIN, 6144); }
    else if (step == 2) { REP(1) REP(9) phase_ret_prep(P, slab); }
    else if (step == 3) { REP(1) REP(11) phase_rec_su<256, 4>(P, 1); }
    else if (step == 4) { if ((PROBE_MASK >> 6) & 1) phase_rec_scan(P, 1, slab, true); phase_rec_scan(P, 1, slab); }
    else if (step == 5) { REP(1) REP(12) phase_rec_out<256, 4>(P, 1); }
    else if (step == 6) { REP(1) REP(9) phase_rec_ng(P, 1); }
    else phase_resid(P, layer, slab, (const u16*)(WS(P) + O_A2), 2048, O_WRETOUT, 2 * D);
  } else if (kind == 2) {
    if (step == 1) {
      EpiStoreBf16 E; E.O = (u16*)(WS(P) + O_SA_P); E.ldc = 1536;
      REP(0) run_gemm((const u16*)(WS(P) + O_SA_H), (const u16*)(WS(P) + O_WSWAIN), NTOK, 1536, D, E);
    }
    else if (step == 2) { REP(2) REP(14) phase_swa_prep(P); }
    else if (step == 3) { REP(2) REP(15) phase_swa_att(P); }
    else {
      EpiResid E; E.X = OUTP(P); E.XS = E.X; E.mod = (const float*)(WS(P) + O_MOD) + (long)layer * 16 * 6144; E.goff = 2 * D; E.grow0 = 0;
      run_gemm((const u16*)(WS(P) + O_SA_A), (const u16*)(WS(P) + O_WSWAOUT), NTOK, D, 1024, E);
    }
  } else {
    if (step == 1) { REP(0) phase_proj(P, O_WHGIN, 5120); }
    else if (step == 2) { REP(1) REP(9) phase_hg_prep(P); }
    else if (step == 3) { REP(1) REP(11) phase_rec_su<128, 2>(P, 3); }
    else if (step == 4) { if ((PROBE_MASK >> 6) & 1) phase_rec_scan(P, 3, slab, true); phase_rec_scan(P, 3, slab); }
    else if (step == 5) { REP(1) REP(12) phase_rec_out<128, 2>(P, 3); }
    else if (step == 6) { REP(1) REP(9) phase_rec_ng(P, 3); }
    else phase_resid(P, layer, slab, (const u16*)(WS(P) + O_A2), 1024, O_WHGOUT, 2 * D);
  }
}

__global__ void __launch_bounds__(NT) fwd_megakernel(Params P) {
  cg::grid_group grid = cg::this_grid();
  __shared__ uint4 xb_words;
  if (threadIdx.x == 0) xb_words = make_uint4(0u, 0u, 0u, 0u);
  __syncthreads();
  XcdBarrier xb = xcd_barrier_post((unsigned*)(P.ws + O_BAR), (volatile LDS_AS unsigned*)&xb_words);
  for (int pid = P.p0; pid < P.p1; ++pid) {
    if (pid == 0) { REP(5) phase_pre0(P); }
    else if (pid == 1) { REP(5) phase_pre1(P); }
    else {
      int q = pid - 2, layer = 0;
      while (q >= nsl_of(layer) * nmix_of(layer) + 7) { q -= nsl_of(layer) * nmix_of(layer) + 7; ++layer; }
      const int nm = nmix_of(layer), nsl = nsl_of(layer);
      if (q < nsl * nm) layer_step(P, layer, q / nm, q % nm);
      else ffn_step(P, layer, q - nsl * nm);
    }
    if (pid + 1 < P.p1) {
      if (pid == 0) grid.sync();
      else xcd_barrier(xb);
      if ((PROBE_MASK >> 8) & 1) xcd_barrier(xb);
    }
  }
}

extern "C" void kernel_launch(void* const* d_in, const int* in_sizes, int n_in, void* d_out, int out_size, void* d_ws,
                              size_t ws_size, hipStream_t stream) {
  static int grid_blocks = 0;
  if (!grid_blocks) {
    int dev = 0, cus = 0, per_cu = 0;
    (void)hipGetDevice(&dev);
    (void)hipDeviceGetAttribute(&cus, hipDeviceAttributeMultiprocessorCount, dev);
    (void)hipFuncSetAttribute((const void*)fwd_megakernel, hipFuncAttributeMaxDynamicSharedMemorySize, LDSB);
    (void)hipOccupancyMaxActiveBlocksPerMultiprocessor(&per_cu, (const void*)fwd_megakernel, NT, LDSB);
    if (per_cu < 1) per_cu = 1;
    if (per_cu > 1) per_cu = 1;
    grid_blocks = cus * per_cu;
    if (ws_size < WS_END) fprintf(stderr, "kernel_launch: workspace too small: %zu < %zu\n", ws_size, (size_t)WS_END);
  }
  Params p;
  memset(&p, 0, sizeof(p));
  for (int i = 0; i < 36; ++i) p.in[i] = (const float*)d_in[i];
  p.out = (float*)d_out;
  p.ws = (unsigned char*)d_ws;
  (void)hipMemsetAsync((unsigned char*)d_ws + O_BAR, 0, XCD_BAR_WORDS * 4, stream);
#if ONE_LAUNCH
  p.p0 = 0; p.p1 = NPHASES;
  void* args[] = {&p};
  hipError_t e = hipLaunchCooperativeKernel((const void*)fwd_megakernel, dim3(grid_blocks), dim3(NT), args, LDSB, stream);
  if (e != hipSuccess) fprintf(stderr, "cooperative launch failed: %s (grid %d)\n", hipGetErrorString(e), grid_blocks);
#else
  for (int ph = 0; ph < NPHASES; ++ph) {
    p.p0 = ph; p.p1 = ph + 1;
    hipLaunchKernelGGL(fwd_megakernel, dim3(grid_blocks), dim3(NT), LDSB, stream, p);
  }
#endif
}
```

```cpp
#include <hip/hip_runtime.h>
#include <hip/hip_cooperative_groups.h>
#include <cstdio>
#include <cstdint>
#include <cstring>
namespace cg = cooperative_groups;

typedef unsigned short u16;
typedef __attribute__((ext_vector_type(8))) short bf16x8;
typedef __attribute__((ext_vector_type(4))) float f32x4;

#define NT 512
#ifndef ONE_LAUNCH
#define ONE_LAUNCH 1
#endif
#ifndef PROBE_MASK
#define PROBE_MASK 0
#endif
#define REP(cls) for (int rep_##cls = 0; rep_##cls < (((PROBE_MASK >> (cls)) & 1) ? 2 : 1); ++rep_##cls)

constexpr int D = 1024, SLAB = 16384, DFF = 2816;
constexpr int LDSB = 139264;
constexpr int FSLAB = 40960, NTOK = 81920;
constexpr int NPHASES = 2 + 5 * (6 + 8 + 7) + 5 + 4 * 7;

constexpr size_t SZW(size_t n, size_t k) { return n * k * 2; }
constexpr size_t O_WHYIN = 0;
constexpr size_t O_WHYOUT = O_WHYIN + SZW(3072, 1024);
constexpr size_t O_WRETIN = O_WHYOUT + SZW(1024, 1024);
constexpr size_t O_WRETOUT = O_WRETIN + SZW(6144, 1024);
constexpr size_t O_WSWAIN = O_WRETOUT + SZW(1024, 2048);
constexpr size_t O_WSWAOUT = O_WSWAIN + SZW(1536, 1024);
constexpr size_t O_WHGIN = O_WSWAOUT + SZW(1024, 1024);
constexpr size_t O_WHGOUT = O_WHGIN + SZW(5120, 1024);
constexpr size_t O_WFG = O_WHGOUT + SZW(1024, 1024);
constexpr size_t O_WFV = O_WFG + 4 * SZW(2816, 1024);
constexpr size_t O_WFD = O_WFV + 4 * SZW(2816, 1024);
constexpr size_t O_MOD = O_WFD + 4 * SZW(1024, 2816);
constexpr size_t O_TW = O_MOD + (size_t)4 * 16 * 6144 * 4;
constexpr size_t O_HIDS = O_TW + 8192 * 8;
constexpr size_t O_HIDP = O_HIDS + (size_t)8192 * 64 * 4;
constexpr size_t O_ROPER = O_HIDP + (size_t)2048 * 64 * 4;
constexpr size_t O_ROPES = O_ROPER + (size_t)8192 * 128 * 8;
constexpr size_t O_PROJ = O_ROPES + (size_t)8192 * 32 * 8;
constexpr size_t O_HBUF = O_PROJ + (size_t)SLAB * 6144 * 2;
constexpr size_t O_A2 = O_HBUF + (size_t)SLAB * 1024 * 2;
constexpr size_t O_C = O_A2 + (size_t)SLAB * 2048 * 2;
constexpr size_t O_FHBUF = O_PROJ;
constexpr size_t O_FGBUF = O_FHBUF + (size_t)FSLAB * 1024 * 2;
constexpr size_t O_FACT = O_FGBUF + (size_t)FSLAB * DFF * 2;
constexpr size_t END_F = O_FACT + (size_t)NTOK * DFF * 2;
constexpr size_t O_MODP = O_C;
constexpr size_t O_BAR = ((size_t)1 << 30) - 16384;
constexpr size_t O_HSPS = O_BAR - (size_t)1024 * 16384 * 8 - (size_t)1024 * 4096 * 8;
constexpr size_t O_HSPP = O_HSPS + (size_t)1024 * 16384 * 8;
constexpr size_t O_UT = O_C;
constexpr size_t O_X0C = O_UT + (size_t)SLAB * 1024 * 4;
constexpr size_t END_HY = O_X0C + (size_t)SLAB * 1024 * 2;
static_assert(END_F <= O_HSPS && END_HY <= O_HSPS, "layer-0 buffers overlap the filter spectra");
constexpr size_t SZP = (size_t)SLAB * 1024 * 2;
constexpr size_t O_QDF = O_C, O_QDB = O_QDF + SZP, O_KIF = O_QDB + SZP, O_KIB = O_KIF + SZP, O_KEF = O_KIB + SZP, O_KEB = O_KEF + SZP;
constexpr size_t O_DLF = O_KEB + SZP;
constexpr size_t O_DLB = O_DLF + (size_t)256 * 1024 * 4;
constexpr size_t O_SC = O_DLB + (size_t)256 * 1024 * 4;
constexpr size_t O_STF = O_SC + (size_t)SLAB * 1024 * 2;
constexpr size_t O_STB = O_STF + (size_t)134217728;
constexpr size_t O_OBUF = O_STB + (size_t)134217728;
constexpr size_t END_REC = O_OBUF + (size_t)SLAB * 2048 * 4;
constexpr size_t O_QN = O_C;
constexpr size_t O_KN = O_QN + SZP;
constexpr size_t O_PBUF = O_KN + (size_t)SLAB * 256 * 2;
constexpr size_t END_SWA0 = O_PBUF + (size_t)SLAB * 16 * 320 * 2;
constexpr size_t O_SA_H = O_PROJ;
constexpr size_t O_SA_P = O_SA_H + (size_t)81920 * 1024 * 2;
constexpr size_t O_SA_Q = O_SA_P + (size_t)81920 * 1536 * 2;
constexpr size_t O_SA_K = O_SA_Q + (size_t)81920 * 1024 * 2;
constexpr size_t O_SA_A = O_SA_K + (size_t)81920 * 256 * 2;
constexpr size_t END_SWA = O_SA_A + (size_t)81920 * 1024 * 2;
constexpr size_t WS_END = END_REC > END_HY ? (END_REC > END_SWA ? END_REC : END_SWA) : (END_HY > END_SWA ? END_HY : END_SWA);
static_assert(WS_END <= O_BAR, "workspace exceeds 1 GiB");

struct Params {
  const float* in[36];
  float* out;
  unsigned char* ws;
  int p0, p1;
};

extern __shared__ __attribute__((aligned(16))) unsigned char smem[];

__device__ __forceinline__ int TID() { int t = threadIdx.x; asm volatile("" : "+v"(t)); return t; }
__device__ __forceinline__ int BID() { int b = blockIdx.x; asm volatile("" : "+s"(b)); return b; }
__device__ __forceinline__ int VBID() { const int b = BID(), g = gridDim.x; return (g & 7) ? b : (b & 7) * (g >> 3) + (b >> 3); }
__device__ __forceinline__ long ZOFF() { long z = 0; asm volatile("" : "+s"(z)); return z; }
__device__ __forceinline__ unsigned char* WS(const Params& P) { return P.ws + ZOFF(); }
__device__ __forceinline__ float* OUTP(const Params& P) { return P.out + ZOFF(); }

namespace pg8 {
#define PG8_LAS __attribute__((address_space(3)))
typedef unsigned short bf16_t;
typedef short bf16x8 __attribute__((ext_vector_type(8)));
typedef float f32x4 __attribute__((ext_vector_type(4)));
typedef unsigned u32x4 __attribute__((ext_vector_type(4)));
constexpr int BM = 256, BK = 64, HALF = 128, HTB = HALF * BK * 2  , STAGE_BYTES = 8 * HTB, NXCD = 8, WGM = 8;

__host__ __device__ __forceinline__ int lds_byte(int r, int c) { const int st = (r >> 4) * 2 + (c >> 5), rr = r & 15, cc = c & 31, ob = rr * 64 + cc * 2; return st * 1024 + (ob ^ (((ob >> 9) & 1) << 5)); }
__host__ __device__ __forceinline__ void stage_rc(int b, int& R, int& C) { const int st = b / 1024, sb = b % 1024, swz = sb ^ (((sb >> 9) & 1) << 5); R = (st >> 1) * 16 + swz / 64; C = (st & 1) * 32 + (swz % 64) / 2; }
__host__ __device__ __forceinline__ int perm32(int rho) { const int n = rho >> 4, i = rho & 15; return 8 * (i >> 2) + 4 * n + (i & 3); }

struct Unit { int pm, pn; };
struct Gemm { const bf16_t* A; const bf16_t* Bt; int M, N, K; };

struct StaticOrder {
    int nM, nN, nwg, G, c;
    __host__ __device__ void init(int M, int N, int G_, int c_) { nM = M / BM; nN = N / BM; nwg = nM * nN; G = G_; c = c_; }
    __host__ __device__ bool next(int i, Unit& u) const {
        const long L = (long)i * G + c; if (L >= nwg) return false;
        int wgid = (int)L; { const int q = nwg / NXCD, r = nwg % NXCD, xcd = wgid % NXCD, off = wgid / NXCD; wgid = (xcd < r ? xcd * (q + 1) : r * (q + 1) + (xcd - r) * q) + off; }
        const int nig = WGM * nN, gid = wgid / nig, fm = gid * WGM, gsz = (nM - fm) < WGM ? (nM - fm) : WGM;
        u.pm = fm + ((wgid % nig) % gsz); u.pn = (wgid % nig) / gsz; return true;
    }
    __device__ __forceinline__ void a_ready(const Unit&) const {}
    __device__ __forceinline__ void done(const Unit&) const {}
};

template <class Epi, class Sched, bool STAMP = false>
__device__ __forceinline__ void gemm_phase(PG8_LAS unsigned char* lds, const Gemm g, const Sched& S, const Epi& E, unsigned long long* stamps) {
    const int tid = TID(), wid = __builtin_amdgcn_readfirstlane(tid >> 6), lane = tid & 63, wr = wid >> 2, wc = wid & 3, fr = lane & 15, fq = lane >> 4;
    const int K = g.K, nt = K / BK;
    int ts_lo = 0, ts_hi = 0, nts = 0; const unsigned long long rt_entry = STAMP ? (unsigned long long)wall_clock64() : 0ull;
#define PG8_STAMP() do { if (STAMP && wid == 0 && nts < 64) { const unsigned long long _c = (unsigned long long)clock64(); \
        ts_lo = (lane == nts) ? (int)(unsigned)_c : ts_lo; ts_hi = (lane == nts) ? (int)(unsigned)(_c >> 32) : ts_hi; ++nts; } } while (0)
    PG8_STAMP();
    unsigned voffA[2], voffB[2];
#pragma unroll
    for (int i = 0; i < 2; ++i) { int R, C; stage_rc(tid * 16 + i * 8192, R, C); const int Rb = Epi::PERM ? ((R & ~31) + perm32(R & 31)) : R;
        voffA[i] = (unsigned)(R * K + C) * 2u; voffB[i] = (unsigned)(Rb * K + C) * 2u; }
    const size_t kstep = (size_t)(BK * 2);
    const size_t hstep = (size_t)HALF * K * 2;
    const size_t tstep = 2 * hstep;
    const unsigned ldsw = (unsigned)wid * 1024u;
    const int aoff = lds_byte(wr * 64 + fr, fq * 8), boff = lds_byte(wc * 32 + fr, fq * 8);
#define PG8_SA(b, h) (((b) * 2 + (h)) * HTB)
#define PG8_SB(b, h) ((4 + (b) * 2 + (h)) * HTB)
#define PG8_STAGE(bufoff, gbase, voff) do { _Pragma("unroll") for (int _i = 0; _i < 2; ++_i) \
        __builtin_amdgcn_global_load_lds((const unsigned*)((const char*)(gbase) + (voff)[_i]), (PG8_LAS unsigned*)(lds + (bufoff) + ldsw + _i * 8192), 16, 0, 0); } while (0)
#define PG8_LDA(dst, b, h) do { _Pragma("unroll") for (int m = 0; m < 4; ++m) _Pragma("unroll") for (int k = 0; k < 2; ++k) dst[m][k] = *(const PG8_LAS bf16x8*)(lds + PG8_SA(b, h) + aoff + m * 2048 + k * 1024); } while (0)
#define PG8_LDB(dst, b, h) do { _Pragma("unroll") for (int n = 0; n < 2; ++n) _Pragma("unroll") for (int k = 0; k < 2; ++k) dst[n][k] = *(const PG8_LAS bf16x8*)(lds + PG8_SB(b, h) + boff + n * 2048 + k * 1024); } while (0)
#define PG8_MMA(ai, bj, At, Bt) do { __builtin_amdgcn_s_setprio(1); _Pragma("unroll") for (int m = 0; m < 4; ++m) _Pragma("unroll") for (int n = 0; n < 2; ++n) _Pragma("unroll") for (int k = 0; k < 2; ++k) \
        acc[ai][bj][m][n] = __builtin_amdgcn_mfma_f32_16x16x32_bf16(Bt[n][k], At[m][k], acc[ai][bj][m][n], 0, 0, 0); __builtin_amdgcn_s_setprio(0); } while (0)
#define PG8_WAIT_V(n) asm volatile("s_waitcnt vmcnt(" #n ")" ::: "memory")
#define PG8_WAIT_L(n) asm volatile("s_waitcnt lgkmcnt(" #n ")" ::: "memory")
#define PG8_BAR __builtin_amdgcn_s_barrier()
#define PG8_SCHED __builtin_amdgcn_sched_barrier(0)
    Unit cur, nxt; int ui = 0;
    if (!S.next(0, cur)) return;
    f32x4 acc[2][2][4][2];
#pragma unroll
    for (int a = 0; a < 2; ++a)
#pragma unroll
        for (int b = 0; b < 2; ++b)
#pragma unroll
            for (int m = 0; m < 4; ++m)
#pragma unroll
                for (int n = 0; n < 2; ++n) acc[a][b][m][n] = (f32x4){0.f, 0.f, 0.f, 0.f};
    bf16x8 At[4][2], B0[2][2], B1[2][2];
    const char* cA = (const char*)g.A + (size_t)cur.pm * tstep; const char* cB = (const char*)g.Bt + (size_t)cur.pn * tstep;
    S.a_ready(cur);
    PG8_STAGE(PG8_SB(0, 0), cB, voffB); PG8_STAGE(PG8_SA(0, 0), cA, voffA); PG8_STAGE(PG8_SB(0, 1), cB + hstep, voffB); PG8_STAGE(PG8_SA(0, 1), cA + hstep, voffA);
    if (wr == 1) PG8_BAR;
    PG8_WAIT_V(4); PG8_BAR;
    PG8_STAGE(PG8_SB(1, 0), cB + kstep, voffB); PG8_STAGE(PG8_SA(1, 0), cA + kstep, voffA); PG8_STAGE(PG8_SB(1, 1), cB + hstep + kstep, voffB);
    PG8_WAIT_V(6); PG8_BAR;
    PG8_STAMP();
    for (;;) {
        const bool has_next = S.next(ui + 1, nxt);
        const char* nA = has_next ? (const char*)g.A + (size_t)nxt.pm * tstep : cA; const char* nB = has_next ? (const char*)g.Bt + (size_t)nxt.pn * tstep : cB;
        for (int t = 0; t < nt; t += 2) {
            const bool last = (t == nt - 2);
            const char* a1 = cA + (size_t)(t + 1) * kstep;
            const char* a2 = last ? nA : cA + (size_t)(t + 2) * kstep; const char* b2 = last ? nB : cB + (size_t)(t + 2) * kstep;
            const char* a3 = a2 + kstep; const char* b3 = b2 + kstep;
            if (last && has_next) S.a_ready(nxt);
            PG8_LDB(B0, 0, 0); PG8_SCHED; PG8_LDA(At, 0, 0); PG8_STAGE(PG8_SA(1, 1), a1 + hstep, voffA);
            PG8_WAIT_L(8); PG8_BAR; PG8_WAIT_L(0); PG8_MMA(0, 0, At, B0); PG8_BAR; PG8_SCHED;
            PG8_LDB(B1, 0, 1); PG8_STAGE(PG8_SB(0, 0), b2, voffB);
            PG8_BAR; PG8_WAIT_L(0); PG8_MMA(0, 1, At, B1); PG8_BAR;
            PG8_LDA(At, 0, 1); PG8_STAGE(PG8_SA(0, 0), a2, voffA);
            PG8_BAR; PG8_WAIT_L(0); PG8_MMA(1, 0, At, B0); PG8_BAR; PG8_SCHED;
            PG8_STAGE(PG8_SB(0, 1), b2 + hstep, voffB);
            PG8_WAIT_V(6); PG8_BAR; PG8_MMA(1, 1, At, B1); PG8_BAR;
            PG8_LDB(B0, 1, 0); PG8_SCHED; PG8_LDA(At, 1, 0); PG8_STAGE(PG8_SA(0, 1), a2 + hstep, voffA);
            PG8_WAIT_L(8); PG8_BAR; PG8_WAIT_L(0); PG8_MMA(0, 0, At, B0); PG8_BAR; PG8_SCHED;
            PG8_LDB(B1, 1, 1); PG8_STAGE(PG8_SB(1, 0), b3, voffB);
            PG8_BAR; PG8_WAIT_L(0); PG8_MMA(0, 1, At, B1); PG8_BAR;
            PG8_LDA(At, 1, 1); PG8_STAGE(PG8_SA(1, 0), a3, voffA);
            PG8_BAR; PG8_WAIT_L(0); PG8_MMA(1, 0, At, B0); PG8_BAR; PG8_SCHED;
            PG8_STAGE(PG8_SB(1, 1), b3 + hstep, voffB);
            PG8_WAIT_V(6); PG8_BAR; PG8_MMA(1, 1, At, B1); PG8_BAR;
        }
        PG8_STAMP();
        if constexpr (!Epi::AFTER_DRAIN) { E(acc, cur, wr, wc, fr, fq); S.done(cur); }
        PG8_STAMP();
        if (!has_next) break;
#pragma unroll
        for (int a = 0; a < 2; ++a)
#pragma unroll
            for (int b = 0; b < 2; ++b)
#pragma unroll
                for (int m = 0; m < 4; ++m)
#pragma unroll
                    for (int n = 0; n < 2; ++n) acc[a][b][m][n] = (f32x4){0.f, 0.f, 0.f, 0.f};
        cur = nxt; cA = nA; cB = nB; ++ui;
    }
    PG8_WAIT_V(0);
    if (wr == 0) PG8_BAR;
    PG8_BAR;
    if constexpr (Epi::AFTER_DRAIN) { E.fused(acc, cur, wr, wc, fr, fq, lds, wid, lane); S.done(cur); }
    PG8_STAMP();
    if (STAMP && wid == 0) { stamps[lane] = lane < nts ? (((unsigned long long)(unsigned)ts_hi << 32) | (unsigned)ts_lo) : 0ull;
        if (lane == 62) stamps[62] = rt_entry; if (lane == 63) stamps[63] = (unsigned long long)wall_clock64(); }
#undef PG8_STAMP
#undef PG8_SA
#undef PG8_SB
#undef PG8_STAGE
#undef PG8_LDA
#undef PG8_LDB
#undef PG8_MMA
#undef PG8_WAIT_V
#undef PG8_WAIT_L
#undef PG8_BAR
#undef PG8_SCHED
}
}


__device__ __forceinline__ u16 f2bf(float f) {
  unsigned u = __float_as_uint(f);
  u += 0x7fffu + ((u >> 16) & 1u);
  return (u16)(u >> 16);
}
__device__ __forceinline__ float bf2f(u16 h) { return __uint_as_float(((unsigned)h) << 16); }
__device__ __forceinline__ unsigned pack2(float a, float b) { return (unsigned)f2bf(a) | ((unsigned)f2bf(b) << 16); }
__device__ __forceinline__ void unpack8(const uint4 v, float (&f)[8]) {
  f[0] = bf2f((u16)(v.x & 0xffff)); f[1] = bf2f((u16)(v.x >> 16)); f[2] = bf2f((u16)(v.y & 0xffff)); f[3] = bf2f((u16)(v.y >> 16));
  f[4] = bf2f((u16)(v.z & 0xffff)); f[5] = bf2f((u16)(v.z >> 16)); f[6] = bf2f((u16)(v.w & 0xffff)); f[7] = bf2f((u16)(v.w >> 16));
}
__device__ __forceinline__ uint4 pack8s(const float (&f)[8], float sc) {
  return make_uint4(pack2(f[0] * sc, f[1] * sc), pack2(f[2] * sc, f[3] * sc), pack2(f[4] * sc, f[5] * sc), pack2(f[6] * sc, f[7] * sc));
}
__device__ __forceinline__ float silu_f(float x) { return x / (1.f + __expf(-x)); }
__device__ __forceinline__ float sigm(float x) { return 1.f / (1.f + __expf(-x)); }
__device__ __forceinline__ float wave_sum(float v) {
#pragma unroll
  for (int o = 32; o; o >>= 1) v += __shfl_xor(v, o);
  return v;
}
__device__ __forceinline__ const float* xin_of(const Params& P, int slab) { return slab == 0 ? P.in[0] : P.in[1] + (long)(slab - 1) * SLAB * D; }
__device__ __forceinline__ int Lof(int slab) { return slab == 0 ? 2048 : 8192; }
__device__ __forceinline__ int gb_row(int gr) { return gr < 16384 ? (gr >> 11) : (8 + ((gr - 16384) >> 13)); }
__device__ __forceinline__ int gb_of(int slab, int r) { return slab == 0 ? (r >> 11) : (8 + (slab - 1) * 2 + (r >> 13)); }

typedef short v4s __attribute__((ext_vector_type(4)));
#define LBAR() asm volatile("s_waitcnt lgkmcnt(0)\n\ts_barrier" ::: "memory")
#define LDS_AS __attribute__((address_space(3)))
template <int R, bool KC>
__device__ __forceinline__ uint4 ld_chunk(const u16* __restrict__ base, long ld, int k0, int c) {
  if (KC) {
    const int r = c >> 3, kc = c & 7;
    return *(const uint4*)(base + (long)r * ld + k0 + kc * 8);
  } else {
    const int k = c / (R / 8), mc = c % (R / 8);
    return *(const uint4*)(base + (long)(k0 + k) * ld + mc * 8);
  }
}
template <int R, bool KC>
__device__ __forceinline__ void st_chunk(u16* s, uint4 v, int c) {
  if (KC) {
    const int r = c >> 3, kc = c & 7;
    *(uint4*)(s + r * 72 + kc * 8) = v;
  } else {
    const int k = c / (R / 8), mc = c % (R / 8);
    *(uint4*)(s + k * (R + 8) + mc * 8) = v;
  }
}
template <int R, bool KC>
__device__ __forceinline__ bf16x8 ld_frag(const u16* s, int x0, int ks, int fr, int fq) {
  if (KC) {
    return *(const bf16x8*)(s + (x0 + fr) * 72 + ks * 32 + fq * 8);
  } else {
    const int q4 = fr >> 2, p4 = fr & 3;
    const u16* p = s + (ks * 32 + 8 * fq + q4) * (R + 8) + x0 + 4 * p4;
    v4s lo = __builtin_amdgcn_ds_read_tr16_b64_v4i16((LDS_AS v4s*)p);
    v4s hi = __builtin_amdgcn_ds_read_tr16_b64_v4i16((LDS_AS v4s*)(p + 4 * (R + 8)));
    bf16x8 r;
    r[0] = lo[0]; r[1] = lo[1]; r[2] = lo[2]; r[3] = lo[3]; r[4] = hi[0]; r[5] = hi[1]; r[6] = hi[2]; r[7] = hi[3];
    return r;
  }
}

template <int TM, int TN, bool AKC, bool BKC, bool TR, int KT>
__device__ __forceinline__ void gemm_acc(f32x4 (&acc)[TM / 32][TN / 64], const u16* __restrict__ A, long lda,
                                         const u16* __restrict__ B, long ldb, u16* sm) {
  u16* As = sm;
  u16* Bs = sm + 9216;
  const int tid = TID(), lane = tid & 63, wid = tid >> 6;
  const int wm = wid >> 2, wn = wid & 3, fr = lane & 15, fq = lane >> 4;
  constexpr int MI = TM / 32, NI = TN / 64;
  uint4 ra0[KT], ra1[KT], rb0[KT], rb1[KT];
#pragma unroll
  for (int kt = 0; kt < KT; ++kt) {
    ra0[kt] = ld_chunk<TM, AKC>(A, lda, kt * 64, tid);
    ra1[kt] = ra0[kt];
    if (TM == 128) ra1[kt] = ld_chunk<TM, AKC>(A, lda, kt * 64, tid + NT);
    rb0[kt] = ld_chunk<TN, BKC>(B, ldb, kt * 64, tid);
    rb1[kt] = rb0[kt];
    if (TN == 128) rb1[kt] = ld_chunk<TN, BKC>(B, ldb, kt * 64, tid + NT);
  }
  __syncthreads();
  st_chunk<TM, AKC>(As, ra0[0], tid);
  if (TM == 128) st_chunk<TM, AKC>(As, ra1[0], tid + NT);
  st_chunk<TN, BKC>(Bs, rb0[0], tid);
  if (TN == 128) st_chunk<TN, BKC>(Bs, rb1[0], tid + NT);
  __syncthreads();
#pragma unroll
  for (int kt = 0; kt < KT; ++kt) {
    u16* Ac = As + (kt & 1) * 18432;
    u16* Bc = Bs + (kt & 1) * 18432;
    if (kt + 1 < KT) {
      u16* An = As + ((kt + 1) & 1) * 18432;
      u16* Bn = Bs + ((kt + 1) & 1) * 18432;
      st_chunk<TM, AKC>(An, ra0[kt + 1 < KT ? kt + 1 : 0], tid);
      if (TM == 128) st_chunk<TM, AKC>(An, ra1[kt + 1 < KT ? kt + 1 : 0], tid + NT);
      st_chunk<TN, BKC>(Bn, rb0[kt + 1 < KT ? kt + 1 : 0], tid);
      if (TN == 128) st_chunk<TN, BKC>(Bn, rb1[kt + 1 < KT ? kt + 1 : 0], tid + NT);
    }
#pragma unroll
    for (int ks = 0; ks < 2; ++ks) {
      bf16x8 af[MI], bfr[NI];
#pragma unroll
      for (int mi = 0; mi < MI; ++mi) af[mi] = ld_frag<TM, AKC>(Ac, wm * (TM / 2) + mi * 16, ks, fr, fq);
#pragma unroll
      for (int ni = 0; ni < NI; ++ni) bfr[ni] = ld_frag<TN, BKC>(Bc, wn * (TN / 4) + ni * 16, ks, fr, fq);
#pragma unroll
      for (int mi = 0; mi < MI; ++mi)
#pragma unroll
        for (int ni = 0; ni < NI; ++ni)
          acc[mi][ni] = TR ? __builtin_amdgcn_mfma_f32_16x16x32_bf16(bfr[ni], af[mi], acc[mi][ni], 0, 0, 0)
                           : __builtin_amdgcn_mfma_f32_16x16x32_bf16(af[mi], bfr[ni], acc[mi][ni], 0, 0, 0);
    }
    __syncthreads();
  }
}

template <int KT> struct Tiles { uint4 a0[KT], a1[KT], b0[KT], b1[KT]; };
template <int TM, int TN, bool AKC, bool BKC, int KT>
__device__ __forceinline__ void tiles_issue(Tiles<KT>& t, const u16* __restrict__ A, long lda, const u16* __restrict__ B, long ldb) {
  const int tid = TID();
#pragma unroll
  for (int kt = 0; kt < KT; ++kt) {
    t.a0[kt] = ld_chunk<TM, AKC>(A, lda, kt * 64, tid);
    t.a1[kt] = t.a0[kt];
    if (TM == 128) t.a1[kt] = ld_chunk<TM, AKC>(A, lda, kt * 64, tid + NT);
    t.b0[kt] = ld_chunk<TN, BKC>(B, ldb, kt * 64, tid);
    t.b1[kt] = t.b0[kt];
    if (TN == 128) t.b1[kt] = ld_chunk<TN, BKC>(B, ldb, kt * 64, tid + NT);
  }
}
template <int TM, int TN, bool AKC, bool BKC, bool TR, int KT>
__device__ __forceinline__ void gemm_run(f32x4 (&acc)[TM / 32][TN / 64], const Tiles<KT>& t, u16* sm) {
  u16* As = sm;
  u16* Bs = sm + 9216;
  const int tid = TID(), lane = tid & 63, wid = tid >> 6;
  const int wm = wid >> 2, wn = wid & 3, fr = lane & 15, fq = lane >> 4;
  constexpr int MI = TM / 32, NI = TN / 64;
  __syncthreads();
  st_chunk<TM, AKC>(As, t.a0[0], tid);
  if (TM == 128) st_chunk<TM, AKC>(As, t.a1[0], tid + NT);
  st_chunk<TN, BKC>(Bs, t.b0[0], tid);
  if (TN == 128) st_chunk<TN, BKC>(Bs, t.b1[0], tid + NT);
  __syncthreads();
#pragma unroll
  for (int kt = 0; kt < KT; ++kt) {
    u16* Ac = As + (kt & 1) * 18432;
    u16* Bc = Bs + (kt & 1) * 18432;
    if (kt + 1 < KT) {
      u16* An = As + ((kt + 1) & 1) * 18432;
      u16* Bn = Bs + ((kt + 1) & 1) * 18432;
      st_chunk<TM, AKC>(An, t.a0[kt + 1 < KT ? kt + 1 : 0], tid);
      if (TM == 128) st_chunk<TM, AKC>(An, t.a1[kt + 1 < KT ? kt + 1 : 0], tid + NT);
      st_chunk<TN, BKC>(Bn, t.b0[kt + 1 < KT ? kt + 1 : 0], tid);
      if (TN == 128) st_chunk<TN, BKC>(Bn, t.b1[kt + 1 < KT ? kt + 1 : 0], tid + NT);
    }
#pragma unroll
    for (int ks = 0; ks < 2; ++ks) {
      bf16x8 af[MI], bfr[NI];
#pragma unroll
      for (int mi = 0; mi < MI; ++mi) af[mi] = ld_frag<TM, AKC>(Ac, wm * (TM / 2) + mi * 16, ks, fr, fq);
#pragma unroll
      for (int ni = 0; ni < NI; ++ni) bfr[ni] = ld_frag<TN, BKC>(Bc, wn * (TN / 4) + ni * 16, ks, fr, fq);
#pragma unroll
      for (int mi = 0; mi < MI; ++mi)
#pragma unroll
        for (int ni = 0; ni < NI; ++ni)
          acc[mi][ni] = TR ? __builtin_amdgcn_mfma_f32_16x16x32_bf16(bfr[ni], af[mi], acc[mi][ni], 0, 0, 0)
                           : __builtin_amdgcn_mfma_f32_16x16x32_bf16(af[mi], bfr[ni], acc[mi][ni], 0, 0, 0);
    }
    __syncthreads();
  }
}

template <int TM, int TN, bool TR, class F>
__device__ __forceinline__ void epi_each(f32x4 (&acc)[TM / 32][TN / 64], F f) {
  const int tid = TID(), lane = tid & 63, wid = tid >> 6;
  const int wm = wid >> 2, wn = wid & 3, fr = lane & 15, fq = lane >> 4;
#pragma unroll
  for (int mi = 0; mi < TM / 32; ++mi)
#pragma unroll
    for (int ni = 0; ni < TN / 64; ++ni) {
      const int r0 = wm * (TM / 2) + mi * 16, c0 = wn * (TN / 4) + ni * 16;
      if (TR) f(r0 + fr, c0 + fq * 4, acc[mi][ni]);
      else f(r0 + fq * 4, c0 + fr, acc[mi][ni]);
    }
}

struct EpiStoreBf16 {
  static constexpr bool PERM = true, AFTER_DRAIN = false;
  u16* O; int ldc;
  __device__ __forceinline__ void operator()(const f32x4 (&acc)[2][2][4][2], const pg8::Unit& u, int wr, int wc, int fr, int fq) const {
    const int row0 = u.pm * 256 + wr * 64 + fr, col0 = u.pn * 256 + wc * 32 + 8 * fq;
#pragma unroll
    for (int ai = 0; ai < 2; ++ai)
#pragma unroll
      for (int m = 0; m < 4; ++m) {
        u16* rowp = O + (size_t)(row0 + ai * 128 + m * 16) * ldc + col0;
#pragma unroll
        for (int bj = 0; bj < 2; ++bj) {
          const f32x4 v0 = acc[ai][bj][m][0], v1 = acc[ai][bj][m][1];
          *(uint4*)(rowp + bj * 128) = make_uint4(pack2(v0[0], v0[1]), pack2(v0[2], v0[3]), pack2(v1[0], v1[1]), pack2(v1[2], v1[3]));
        }
      }
  }
};
struct EpiResid {
  static constexpr bool PERM = false, AFTER_DRAIN = false;
  float* X; const float* XS; const float* mod; int goff; int grow0;
  __device__ __forceinline__ void operator()(const f32x4 (&acc)[2][2][4][2], const pg8::Unit& u, int wr, int wc, int fr, int fq) const {
    const int row0 = u.pm * 256 + wr * 64 + fr, col0 = u.pn * 256 + wc * 32 + 4 * fq;
    const float* g = mod + (size_t)gb_row(grow0 + u.pm * 256) * 6144 + goff + col0;
    f32x4 gv[2][2];
#pragma unroll
    for (int bj = 0; bj < 2; ++bj)
#pragma unroll
      for (int n = 0; n < 2; ++n) gv[bj][n] = *(const f32x4*)(g + bj * 128 + n * 16);
#pragma unroll
    for (int am = 0; am < 4; ++am) {
      f32x4 xv[2][2][2];
#pragma unroll
      for (int mm = 0; mm < 2; ++mm)
#pragma unroll
        for (int bj = 0; bj < 2; ++bj)
#pragma unroll
          for (int n = 0; n < 2; ++n) xv[mm][bj][n] = *(const f32x4*)(XS + (size_t)(row0 + (am >> 1) * 128 + ((am & 1) * 2 + mm) * 16) * D + col0 + bj * 128 + n * 16);
#pragma unroll
      for (int mm = 0; mm < 2; ++mm)
#pragma unroll
        for (int bj = 0; bj < 2; ++bj)
#pragma unroll
          for (int n = 0; n < 2; ++n)
            *(f32x4*)(X + (size_t)(row0 + (am >> 1) * 128 + ((am & 1) * 2 + mm) * 16) * D + col0 + bj * 128 + n * 16) = xv[mm][bj][n] + gv[bj][n] * acc[am >> 1][bj][(am & 1) * 2 + mm][n];
    }
  }
};
struct EpiFfnVal {
  static constexpr bool PERM = false, AFTER_DRAIN = false;
  const u16* G; u16* ACT; const float* cw; const float* cb; int grow0;
  __device__ __forceinline__ void operator()(const f32x4 (&acc)[2][2][4][2], const pg8::Unit& u, int wr, int wc, int fr, int fq) const {
    const int row0 = u.pm * 256 + wr * 64 + fr, col0 = u.pn * 256 + wc * 32 + 4 * fq;
#pragma unroll
    for (int bj = 0; bj < 2; ++bj)
#pragma unroll
      for (int n = 0; n < 2; ++n) {
        const int c = col0 + bj * 128 + n * 16;
        const f32x4 w0 = *(const f32x4*)(cw + c), w1 = *(const f32x4*)(cw + DFF + c), w2 = *(const f32x4*)(cw + 2 * DFF + c), bb = *(const f32x4*)(cb + c);
#pragma unroll
        for (int ai = 0; ai < 2; ++ai) {
          uint2 g0[4], g1[4], g2[4];
#pragma unroll
          for (int m = 0; m < 4; ++m) {
            const int r = row0 + ai * 128 + m * 16;
            const int L = (grow0 + r) < 16384 ? 2048 : 8192;
            const int pos = (grow0 + r) & (L - 1);
            const u16* gp = G + (size_t)r * DFF + c;
            g1[m] = *(const uint2*)gp;
            g0[m] = *(const uint2*)(gp - (pos > 0 ? DFF : 0));
            g2[m] = *(const uint2*)(gp + (pos < L - 1 ? DFF : 0));
          }
#pragma unroll
          for (int m = 0; m < 4; ++m) {
            const int r = row0 + ai * 128 + m * 16;
            const int L = (grow0 + r) < 16384 ? 2048 : 8192;
            const int pos = (grow0 + r) & (L - 1);
            const float m0 = pos > 0 ? 1.f : 0.f, m2 = pos < L - 1 ? 1.f : 0.f;
            const uint2 a0 = g0[m], a1 = g1[m], a2 = g2[m];
            f32x4 a;
            a[0] = m0 * bf2f((u16)(a0.x & 0xffff)) * w0[0] + bf2f((u16)(a1.x & 0xffff)) * w1[0] + m2 * bf2f((u16)(a2.x & 0xffff)) * w2[0] + bb[0];
            a[1] = m0 * bf2f((u16)(a0.x >> 16)) * w0[1] + bf2f((u16)(a1.x >> 16)) * w1[1] + m2 * bf2f((u16)(a2.x >> 16)) * w2[1] + bb[1];
            a[2] = m0 * bf2f((u16)(a0.y & 0xffff)) * w0[2] + bf2f((u16)(a1.y & 0xffff)) * w1[2] + m2 * bf2f((u16)(a2.y & 0xffff)) * w2[2] + bb[2];
            a[3] = m0 * bf2f((u16)(a0.y >> 16)) * w0[3] + bf2f((u16)(a1.y >> 16)) * w1[3] + m2 * bf2f((u16)(a2.y >> 16)) * w2[3] + bb[3];
            const f32x4 v = acc[ai][bj][m][n];
            *(uint2*)(ACT + (size_t)r * DFF + c) = make_uint2(pack2(silu_f(a[0]) * v[0], silu_f(a[1]) * v[1]), pack2(silu_f(a[2]) * v[2], silu_f(a[3]) * v[3]));
          }
        }
      }
  }
};
template <class Epi>
__device__ __forceinline__ void run_gemm(const u16* A, const u16* Bt, int M, int N, int K, const Epi& E) {
  pg8::Gemm g; g.A = A; g.Bt = Bt; g.M = M; g.N = N; g.K = K;
  pg8::StaticOrder S; S.init(M, N, gridDim.x, BID());
  __syncthreads();
  pg8::gemm_phase<Epi, pg8::StaticOrder, false>((PG8_LAS unsigned char*)smem, g, S, E, nullptr);
  __syncthreads();
}

__device__ __forceinline__ int fidx(int p) { return p + ((p >> 6) << 2); }
__device__ __forceinline__ float2 cmulf(float2 a, float2 b) { return make_float2(a.x * b.x - a.y * b.y, a.x * b.y + a.y * b.x); }
__device__ __forceinline__ float2 cmulcf(float2 a, float2 b) { return make_float2(a.x * b.x + a.y * b.y, a.y * b.x - a.x * b.y); }
#define R16C(q) ((q) == 0 ? 1.f : (q) == 1 ? 0.9238795325f : (q) == 2 ? 0.7071067812f : (q) == 3 ? 0.3826834324f : (q) == 4 ? 0.f : (q) == 5 ? -0.3826834324f : (q) == 6 ? -0.7071067812f : -0.9238795325f)
#define R16S(q) ((q) == 0 ? 0.f : (q) == 1 ? -0.3826834324f : (q) == 2 ? -0.7071067812f : (q) == 3 ? -0.9238795325f : (q) == 4 ? -1.f : (q) == 5 ? -0.9238795325f : (q) == 6 ? -0.7071067812f : -0.3826834324f)
template <int N, int RS, bool INV>
__device__ __forceinline__ void fft_pass(float2* x, const float2* __restrict__ tw, const int S, const int tid) {
  constexpr int R = 1 << RS;
  const int E = S >> (RS - 1);
#pragma unroll 1
  for (int g = tid; g < N / R; g += NT) {
    const int blo = g & (E - 1);
    const int base = ((g - blo) << RS) + blo;
    float2 e[R];
#pragma unroll
    for (int k = 0; k < R; ++k) e[k] = x[fidx(base + k * E)];
    float2 wb[RS];
#pragma unroll
    for (int st = 0; st < RS; ++st) wb[st] = tw[blo * (8192 / (S >> st))];
#pragma unroll
    for (int sq = 0; sq < RS; ++sq) {
      const int st = INV ? (RS - 1 - sq) : sq;
      const int h = (R / 2) >> st;
#pragma unroll
      for (int k = 0; k < R; ++k) {
        if ((k & h) == 0) {
          const int m = k & (h - 1);
          const int q = m * (8 / h);
          float2 w = wb[st];
          if (q != 0) w = cmulf(w, make_float2(R16C(q), R16S(q)));
          if (!INV) {
            const float2 a = e[k], b = e[k + h];
            e[k] = make_float2(a.x + b.x, a.y + b.y);
            e[k + h] = cmulf(make_float2(a.x - b.x, a.y - b.y), w);
          } else {
            const float2 a = e[k], b = cmulcf(e[k + h], w);
            e[k] = make_float2(a.x + b.x, a.y + b.y);
            e[k + h] = make_float2(a.x - b.x, a.y - b.y);
          }
        }
      }
    }
#pragma unroll
    for (int k = 0; k < R; ++k) x[fidx(base + k * E)] = e[k];
  }
  __syncthreads();
}
template <int N>
__device__ __forceinline__ void fft_dif_t(float2* x, const float2* __restrict__ tw) {
  const int tid = TID();
  if (N == 16384) {
    fft_pass<N, 4, false>(x, tw, 8192, tid); fft_pass<N, 4, false>(x, tw, 512, tid);
    fft_pass<N, 4, false>(x, tw, 32, tid); fft_pass<N, 2, false>(x, tw, 2, tid);
  } else {
    fft_pass<N, 4, false>(x, tw, 2048, tid); fft_pass<N, 4, false>(x, tw, 128, tid); fft_pass<N, 4, false>(x, tw, 8, tid);
  }
}
template <int N>
__device__ __forceinline__ void ifft_dit_t(float2* x, const float2* __restrict__ tw) {
  const int tid = TID();
  if (N == 16384) {
    fft_pass<N, 2, true>(x, tw, 2, tid); fft_pass<N, 4, true>(x, tw, 32, tid);
    fft_pass<N, 4, true>(x, tw, 512, tid); fft_pass<N, 4, true>(x, tw, 8192, tid);
  } else {
    fft_pass<N, 4, true>(x, tw, 8, tid); fft_pass<N, 4, true>(x, tw, 128, tid); fft_pass<N, 4, true>(x, tw, 2048, tid);
  }
}
__device__ __forceinline__ void fft_dif(float2* x, int N, const float2* __restrict__ tw) {
  if (N == 16384) fft_dif_t<16384>(x, tw); else fft_dif_t<4096>(x, tw);
}
__device__ __forceinline__ void ifft_dit(float2* x, int N, const float2* __restrict__ tw) {
  if (N == 16384) ifft_dit_t<16384>(x, tw); else ifft_dit_t<4096>(x, tw);
}

__device__ void transpose_w(const float* __restrict__ W, u16* __restrict__ Wt, int K, int N) {
  float* smf = (float*)smem;
  const int tk = K / 64, tn = N / 64, tid = TID(), G = gridDim.x;
  const int kk0 = tid >> 4, n40 = tid & 15, kk1 = (tid + NT) >> 4, n41 = (tid + NT) & 15;
  int item = BID();
  float4 v0 = make_float4(0, 0, 0, 0), v1 = v0;
  if (item < tk * tn) {
    const int k0 = (item / tn) * 64, n0 = (item % tn) * 64;
    v0 = *(const float4*)(W + (long)(k0 + kk0) * N + n0 + n40 * 4);
    v1 = *(const float4*)(W + (long)(k0 + kk1) * N + n0 + n41 * 4);
  }
  for (; item < tk * tn; item += G) {
    const int k0 = (item / tn) * 64, n0 = (item % tn) * 64;
    float4 w0 = v0, w1 = v1;
    const int nx = item + G;
    if (nx < tk * tn) {
      const int k2 = (nx / tn) * 64, n2 = (nx % tn) * 64;
      w0 = *(const float4*)(W + (long)(k2 + kk0) * N + n2 + n40 * 4);
      w1 = *(const float4*)(W + (long)(k2 + kk1) * N + n2 + n41 * 4);
    }
    __syncthreads();
    { float* p = smf + kk0 * 65 + n40 * 4; p[0] = v0.x; p[1] = v0.y; p[2] = v0.z; p[3] = v0.w; }
    { float* p = smf + kk1 * 65 + n41 * 4; p[0] = v1.x; p[1] = v1.y; p[2] = v1.z; p[3] = v1.w; }
    __syncthreads();
    const int nn = tid >> 3, k8 = tid & 7;
    float f[8];
#pragma unroll
    for (int i = 0; i < 8; ++i) f[i] = smf[(k8 * 8 + i) * 65 + nn];
    *(uint4*)(Wt + (long)(n0 + nn) * K + k0 + k8 * 8) = pack8s(f, 1.f);
    v0 = w0; v1 = w1;
  }
  __syncthreads();
}

__device__ void phase_pre0(const Params& P) {
  const int tid = TID();
  const long gtid = (long)BID() * NT + tid, gsz = (long)gridDim.x * NT;
  transpose_w(P.in[7], (u16*)(WS(P) + O_WHYIN), 1024, 3072);
  transpose_w(P.in[18], (u16*)(WS(P) + O_WHYOUT), 1024, 1024);
  transpose_w(P.in[19], (u16*)(WS(P) + O_WRETIN), 1024, 6144);
  transpose_w(P.in[21], (u16*)(WS(P) + O_WRETOUT), 2048, 1024);
  transpose_w(P.in[22], (u16*)(WS(P) + O_WSWAIN), 1024, 1536);
  transpose_w(P.in[26], (u16*)(WS(P) + O_WSWAOUT), 1024, 1024);
  transpose_w(P.in[27], (u16*)(WS(P) + O_WHGIN), 1024, 5120);
  transpose_w(P.in[30], (u16*)(WS(P) + O_WHGOUT), 1024, 1024);
  for (int l = 0; l < 4; ++l) {
    transpose_w(P.in[31] + (long)l * 1024 * DFF, (u16*)(WS(P) + O_WFG) + (long)l * DFF * 1024, 1024, DFF);
    transpose_w(P.in[32] + (long)l * 1024 * DFF, (u16*)(WS(P) + O_WFV) + (long)l * DFF * 1024, 1024, DFF);
    transpose_w(P.in[35] + (long)l * DFF * 1024, (u16*)(WS(P) + O_WFD) + (long)l * 1024 * DFF, DFF, 1024);
  }
  {
    float* cs = (float*)smem;
    float* modp = (float*)(WS(P) + O_MODP);
    for (int item = BID(); item < 4 * 8 * 12; item += gridDim.x) {
      const int nb = item % 12, ks = (item / 12) % 8, l = item / 96;
      __syncthreads();
      for (int i = tid; i < 2048; i += NT) {
        int b = i >> 7, k = i & 127;
        float c = (b < 8) ? P.in[2][b * 1024 + ks * 128 + k] : P.in[3][(b - 8) * 1024 + ks * 128 + k];
        cs[i] = c / (1.f + expf(-c));
      }
      __syncthreads();
      const int n = nb * 512 + tid;
      float a[16];
#pragma unroll
      for (int b = 0; b < 16; ++b) a[b] = 0.f;
      const float* w = P.in[4] + ((long)l * 1024 + ks * 128) * 6144 + n;
      for (int k = 0; k < 128; ++k) {
        float wv = w[(long)k * 6144];
#pragma unroll
        for (int b = 0; b < 16; ++b) a[b] += cs[b * 128 + k] * wv;
      }
#pragma unroll
      for (int b = 0; b < 16; ++b) modp[(((long)ks * 4 + l) * 16 + b) * 6144 + n] = a[b];
    }
    __syncthreads();
  }
  {
    float2* tw = (float2*)(WS(P) + O_TW);
    for (long i = gtid; i < 8192; i += gsz) {
      float s, c;
      sincospif((float)i * (1.f / 8192.f), &s, &c);
      tw[i] = make_float2(c, -s);
    }
    float2* rr = (float2*)(WS(P) + O_ROPER);
    for (long i = gtid; i < (long)8192 * 128; i += gsz) {
      int pos = (int)(i >> 7), d = (int)(i & 127);
      float inv = exp2f(-(float)d * (13.287712379549449f / 128.f));
      float s, c;
      sincosf((float)pos * inv, &s, &c);
      rr[i] = make_float2(c, s);
    }
    float2* rs = (float2*)(WS(P) + O_ROPES);
    for (long i = gtid; i < (long)8192 * 32; i += gsz) {
      int pos = (int)(i >> 5), d = (int)(i & 31);
      float inv = exp2f(-(float)d * (13.287712379549449f / 32.f));
      float s, c;
      sincosf((float)pos * inv, &s, &c);
      rs[i] = make_float2(c, s);
    }
  }
  {
    float* zf = (float*)smem;
    float* h1 = zf + 8 * 36;
    const float* w1 = P.in[10]; const float* b1 = P.in[11]; const float* w2 = P.in[12]; const float* b2 = P.in[13];
    const float* fr = P.in[15];
    const int tl = tid >> 6, j = tid & 63;
    for (int item = BID(); item < 1280; item += gridDim.x) {
      const int sel = item >= 1024;
      const int L = sel ? 2048 : 8192;
      const int t = (sel ? item - 1024 : item) * 8 + tl;
      float* hid = (float*)(WS(P) + (sel ? O_HIDP : O_HIDS));
      __syncthreads();
      if (j < 33) {
        float v;
        if (j == 0) v = (float)t / (float)(L - 1);
        else {
          int i = (j - 1) & 15;
          float band = 1e-4f + (float)i * ((15.f - 1e-4f) / 15.f);
          float ang = (6.283185307179586f / (float)L) * (float)t;
          float a = band * ang;
          v = (j <= 16) ? cosf(a) : -sinf(a);
        }
        zf[tl * 36 + j] = v;
      }
      __syncthreads();
      float s = b1[j];
#pragma unroll 3
      for (int i = 0; i < 33; ++i) s += zf[tl * 36 + i] * w1[i * 64 + j];
      h1[tl * 64 + j] = sinf(fr[j] * s);
      __syncthreads();
      float s2 = b2[j];
#pragma unroll 4
      for (int i = 0; i < 64; ++i) s2 += h1[tl * 64 + i] * w2[i * 64 + j];
      hid[(long)j * L + t] = sinf(fr[j] * s2);
    }
    __syncthreads();
  }
}

__device__ void phase_pre1(const Params& P) {
  __shared__ float w3s[128];
  __shared__ float red[8];
  const int tid = TID(), lane = tid & 63, wid = tid >> 6;
  const long gtid = (long)BID() * NT + tid, gsz = (long)gridDim.x * NT;
  {
    const float* modp = (const float*)(WS(P) + O_MODP);
    float* mod = (float*)(WS(P) + O_MOD);
    for (long i = gtid; i < (long)4 * 16 * 6144; i += gsz) {
      int n = (int)(i % 6144);
      int l = (int)(i / (16 * 6144));
      float s = P.in[5][l * 6144 + n];
      for (int ks = 0; ks < 8; ++ks) s += modp[(long)ks * 4 * 16 * 6144 + i];
      mod[i] = s;
    }
  }
  float2* buf = (float2*)smem;
  const float2* tw = (const float2*)(WS(P) + O_TW);
  for (int item = BID(); item < 2048; item += gridDim.x) {
    const int sel = item >> 10, c = item & 1023;
    const int L = sel ? 2048 : 8192, N = 2 * L;
    const float* hid = (const float*)(WS(P) + (sel ? O_HIDP : O_HIDS));
    float2* hs = (float2*)(WS(P) + (sel ? O_HSPP : O_HSPS)) + (long)c * N;
    __syncthreads();
    if (tid < 128) {
      int dirn = tid >> 6, j = tid & 63;
      w3s[tid] = P.in[14][(long)j * 2048 + dirn * 1024 + c];
    }
    __syncthreads();
    const float dec0 = fabsf(P.in[16][c]), dec1 = fabsf(P.in[16][1024 + c]);
    const float invLm1 = 1.f / (float)(L - 1);
    float asum = 0.f;
    for (int n = tid; n < N; n += NT) {
      float val = 0.f;
      if (n != L) {
        const int dirn = n < L ? 0 : 1;
        const int t = n < L ? n : N - n;
        const float* hp = hid + t;
        const float* w = w3s + dirn * 64;
        float s = 0.f;
#pragma unroll 16
        for (int j = 0; j < 64; ++j) s += hp[(long)j * L] * w[j];
        float tl = (float)t * invLm1;
        val = s * expf(-tl * (dirn ? dec1 : dec0));
      }
      buf[fidx(n)] = make_float2(val, 0.f);
      asum += fabsf(val);
    }
    asum = wave_sum(asum);
    if (lane == 0) red[wid] = asum;
    __syncthreads();
    float tot = 0.f;
#pragma unroll
    for (int w = 0; w < 8; ++w) tot += red[w];
    const float scale = 1.f / (tot * (float)N);
    fft_dif(buf, N, tw);
    for (int p = tid; p < N; p += NT) {
      float2 a = buf[fidx(p)];
      hs[p] = make_float2(a.x * scale, a.y * scale);
    }
  }
  __syncthreads();
}

__device__ void phase_norm(const Params& P, int layer, int sl, int which) {
  const int grow0 = which == 1 ? sl * FSLAB : (which == 2 ? 0 : sl * SLAB), nrows = which == 1 ? FSLAB : (which == 2 ? NTOK : SLAB);
  const float* __restrict__ x = (layer == 0 && which == 0) ? xin_of(P, sl) : (const float*)(OUTP(P) + (long)grow0 * D);
  u16* __restrict__ h = (u16*)(WS(P) + (which == 1 ? O_FHBUF : (which == 2 ? O_SA_H : O_HBUF)));
  const float* gain = P.in[6] + (layer * 2 + (which == 1 ? 1 : 0)) * D;
  const float* mod = (const float*)(WS(P) + O_MOD) + (long)layer * 16 * 6144;
  const int shoff = which == 1 ? 3 * D : 0, scoff = which == 1 ? 4 * D : D;
  const int tid = TID(), lane = tid & 63, wid = tid >> 6;
  for (int item = BID(); item < nrows / 32; item += gridDim.x) {
    const int r0 = item * 32 + wid * 4;
    float4 v[4][4];
    float ss[4];
#pragma unroll
    for (int u = 0; u < 4; ++u) {
      const float* xr = x + (long)(r0 + u) * D;
      float a = 0.f;
#pragma unroll
      for (int i = 0; i < 4; ++i) {
        v[u][i] = *(const float4*)(xr + i * 256 + lane * 4);
        a += v[u][i].x * v[u][i].x + v[u][i].y * v[u][i].y + v[u][i].z * v[u][i].z + v[u][i].w * v[u][i].w;
      }
      ss[u] = a;
    }
    const float* m = mod + (long)gb_row(grow0 + r0) * 6144;
#pragma unroll
    for (int u = 0; u < 4; ++u) ss[u] = wave_sum(ss[u]);
#pragma unroll
    for (int i = 0; i < 4; ++i) {
      const int col = i * 256 + lane * 4;
      const float4 g = *(const float4*)(gain + col);
      const float4 sc = *(const float4*)(m + scoff + col);
      const float4 sh = *(const float4*)(m + shoff + col);
      const float a0 = g.x * (1.f + sc.x), a1 = g.y * (1.f + sc.y), a2 = g.z * (1.f + sc.z), a3 = g.w * (1.f + sc.w);
#pragma unroll
      for (int u = 0; u < 4; ++u) {
        const float rstd = rsqrtf(ss[u] * (1.f / 1024.f) + 1e-6f);
        const float y0 = v[u][i].x * rstd * a0 + sh.x, y1 = v[u][i].y * rstd * a1 + sh.y;
        const float y2 = v[u][i].z * rstd * a2 + sh.z, y3 = v[u][i].w * rstd * a3 + sh.w;
        *(uint2*)(h + (long)(r0 + u) * D + col) = make_uint2(pack2(y0, y1), pack2(y2, y3));
      }
    }
  }
}

__device__ void phase_proj(const Params& P, size_t woff, int N) {
  EpiStoreBf16 E; E.O = (u16*)(WS(P) + O_PROJ); E.ldc = N;
  run_gemm((const u16*)(WS(P) + O_HBUF), (const u16*)(WS(P) + woff), SLAB, N, D, E);
}
__device__ void phase_resid(const Params& P, int layer, int slab, const u16* A, int K, size_t woff, int goff) {
  EpiResid E; E.X = OUTP(P) + (long)slab * SLAB * D; E.XS = (layer == 0) ? xin_of(P, slab) : (const float*)E.X; E.mod = (const float*)(WS(P) + O_MOD) + (long)layer * 16 * 6144; E.goff = goff; E.grow0 = slab * SLAB;
  run_gemm(A, (const u16*)(WS(P) + woff), SLAB, D, K, E);
}

__device__ void phase_ffn_gate(const Params& P, int layer) {
  EpiStoreBf16 E; E.O = (u16*)(WS(P) + O_FGBUF); E.ldc = DFF;
  run_gemm((const u16*)(WS(P) + O_FHBUF), (const u16*)(WS(P) + O_WFG) + (long)layer * DFF * D, FSLAB, DFF, D, E);
}
__device__ void phase_ffn_val(const Params& P, int layer, int fs) {
  EpiFfnVal E; E.G = (const u16*)(WS(P) + O_FGBUF); E.ACT = (u16*)(WS(P) + O_FACT) + (long)fs * FSLAB * DFF;
  E.cw = P.in[33] + (long)layer * 3 * DFF; E.cb = P.in[34] + (long)layer * DFF; E.grow0 = fs * FSLAB;
  run_gemm((const u16*)(WS(P) + O_FHBUF), (const u16*)(WS(P) + O_WFV) + (long)layer * DFF * D, FSLAB, DFF, D, E);
}
__device__ void phase_ffn_down(const Params& P, int layer) {
  EpiResid E; E.X = OUTP(P); E.XS = E.X; E.mod = (const float*)(WS(P) + O_MOD) + (long)layer * 16 * 6144; E.goff = 5 * D; E.grow0 = 0;
  run_gemm((const u16*)(WS(P) + O_FACT), (const u16*)(WS(P) + O_WFD) + (long)layer * D * DFF, NTOK, D, DFF, E);
}

__device__ void phase_hy_conv(const Params& P, int slab) {
  const int L = Lof(slab), nseq = SLAB / L, tid = TID();
  const u16* __restrict__ z = (const u16*)(WS(P) + O_PROJ);
  float* __restrict__ uT = (float*)(WS(P) + O_UT);
  u16* __restrict__ x0c = (u16*)(WS(P) + O_X0C);
  const float* cw = P.in[8];
  const float* cb = P.in[9];
  float* tile = (float*)smem;
  const int ntt = L / 64;
  const int nitems = nseq * ntt * 16;
  const int tl = tid >> 3, cg = tid & 7;
  for (int item = BID(); item < nitems; item += gridDim.x) {
    const int ct = item % 16, tt = (item / 16) % ntt, seq = item / (16 * ntt);
    const int t = tt * 64 + tl, c0 = ct * 64 + cg * 8;
    const long row = (long)seq * L + t;
    const float mp = t > 0 ? 1.f : 0.f, mn = t < L - 1 ? 1.f : 0.f;
    const long rp = t > 0 ? row - 1 : row, rn = t < L - 1 ? row + 1 : row;
    float val[3][8];
#pragma unroll
    for (int q = 0; q < 3; ++q) {
      const int col = q * 1024 + c0;
      float a[8], b[8], c[8];
      unpack8(*(const uint4*)(z + rp * 3072 + col), a);
      unpack8(*(const uint4*)(z + row * 3072 + col), b);
      unpack8(*(const uint4*)(z + rn * 3072 + col), c);
      const float4 w0a = *(const float4*)(cw + col), w0b = *(const float4*)(cw + col + 4);
      const float4 w1a = *(const float4*)(cw + 3072 + col), w1b = *(const float4*)(cw + 3072 + col + 4);
      const float4 w2a = *(const float4*)(cw + 6144 + col), w2b = *(const float4*)(cw + 6144 + col + 4);
      const float4 ba = *(const float4*)(cb + col), bb = *(const float4*)(cb + col + 4);
      const float w0[8] = {w0a.x, w0a.y, w0a.z, w0a.w, w0b.x, w0b.y, w0b.z, w0b.w};
      const float w1[8] = {w1a.x, w1a.y, w1a.z, w1a.w, w1b.x, w1b.y, w1b.z, w1b.w};
      const float w2[8] = {w2a.x, w2a.y, w2a.z, w2a.w, w2b.x, w2b.y, w2b.z, w2b.w};
      const float bs[8] = {ba.x, ba.y, ba.z, ba.w, bb.x, bb.y, bb.z, bb.w};
#pragma unroll
      for (int i = 0; i < 8; ++i) val[q][i] = mp * a[i] * w0[i] + b[i] * w1[i] + mn * c[i] * w2[i] + bs[i];
    }
    *(uint4*)(x0c + row * 1024 + c0) = pack8s(val[0], 1.f);
    __syncthreads();
#pragma unroll
    for (int i = 0; i < 8; ++i) tile[tl * 65 + cg * 8 + i] = val[1][i] * val[2][i];
    __syncthreads();
    {
      const int cl = tid >> 3, tq = tid & 7;
      float* dst = uT + ((long)seq * 1024 + ct * 64 + cl) * L + tt * 64 + tq * 8;
      float4 o0, o1;
      o0.x = tile[(tq * 8 + 0) * 65 + cl]; o0.y = tile[(tq * 8 + 1) * 65 + cl]; o0.z = tile[(tq * 8 + 2) * 65 + cl]; o0.w = tile[(tq * 8 + 3) * 65 + cl];
      o1.x = tile[(tq * 8 + 4) * 65 + cl]; o1.y = tile[(tq * 8 + 5) * 65 + cl]; o1.z = tile[(tq * 8 + 6) * 65 + cl]; o1.w = tile[(tq * 8 + 7) * 65 + cl];
      *(float4*)dst = o0; *(float4*)(dst + 4) = o1;
    }
  }
  __syncthreads();
}

__device__ void phase_hy_fft(const Params& P, int slab, bool dry = false) {
  const int L = Lof(slab), N = 2 * L, nseq = SLAB / L, tid = TID();
  float* uT = (float*)(WS(P) + O_UT);
  const float2* hsb = (const float2*)(WS(P) + (slab == 0 ? O_HSPP : O_HSPS));
  const float2* tw = (const float2*)(WS(P) + O_TW);
  const float* skip = P.in[17];
  float2* buf = (float2*)smem;
  const int nitems = (nseq / 2) * 1024;
  for (int item = BID(); item < nitems; item += gridDim.x) {
    const int pr = item >> 10, c = item & 1023;
    float* u0 = uT + ((long)(pr * 2) * 1024 + c) * L;
    float* u1 = u0 + (long)1024 * L;
    __syncthreads();
    for (int t = tid; t < L; t += NT) {
      buf[fidx(t)] = make_float2(u0[t], u1[t]);
      buf[fidx(t + L)] = make_float2(0.f, 0.f);
    }
    __syncthreads();
    fft_dif(buf, N, tw);
    const float2* h = hsb + (long)c * N;
    for (int p = tid; p < N; p += NT) {
      float2 a = buf[fidx(p)], b = h[p];
      buf[fidx(p)] = make_float2(a.x * b.x - a.y * b.y, a.x * b.y + a.y * b.x);
    }
    __syncthreads();
    ifft_dit(buf, N, tw);
    const float sk = skip[c];
    for (int t = tid; t < L; t += NT) {
      float2 y = buf[fidx(t)];
      const long doff = dry ? (long)(END_HY - O_UT) / 4 : 0;
      u0[t + doff] = y.x + u0[t] * sk;
      u1[t + doff] = y.y + u1[t] * sk;
    }
  }
  __syncthreads();
}

__device__ void phase_hy_tr(const Params& P, int slab) {
  const int L = Lof(slab), nseq = SLAB / L, tid = TID();
  const float* __restrict__ yT = (const float*)(WS(P) + O_UT);
  const u16* __restrict__ x0c = (const u16*)(WS(P) + O_X0C);
  u16* __restrict__ a2 = (u16*)(WS(P) + O_A2);
  float* tile = (float*)smem;
  const int ntt = L / 64;
  const int nitems = nseq * ntt * 16;
  for (int item = BID(); item < nitems; item += gridDim.x) {
    const int ct = item % 16, tt = (item / 16) % ntt, seq = item / (16 * ntt);
    const int cl = tid >> 3, tq = tid & 7;
    const float* src = yT + ((long)seq * 1024 + ct * 64 + cl) * L + tt * 64 + tq * 8;
    const float4 i0 = *(const float4*)src, i1 = *(const float4*)(src + 4);
    const int tl = tid >> 3, cg = tid & 7;
    const long row = (long)seq * L + tt * 64 + tl;
    const int c0 = ct * 64 + cg * 8;
    float xg[8];
    unpack8(*(const uint4*)(x0c + row * 1024 + c0), xg);
    __syncthreads();
    float* p = tile + cl * 65 + tq * 8;
    p[0] = i0.x; p[1] = i0.y; p[2] = i0.z; p[3] = i0.w; p[4] = i1.x; p[5] = i1.y; p[6] = i1.z; p[7] = i1.w;
    __syncthreads();
    float o[8];
#pragma unroll
    for (int i = 0; i < 8; ++i) o[i] = tile[(cg * 8 + i) * 65 + tl] * xg[i];
    *(uint4*)(a2 + row * 1024 + c0) = pack8s(o, 1.f);
  }
  __syncthreads();
}

struct Rec {
  int H, DK, DV, C;
  int ldv, voff, goff;
};
__device__ __forceinline__ Rec rec_of(int kind) {
  Rec r;
  if (kind == 1) { r.H = 4; r.DK = 256; r.DV = 512; r.C = 256; r.ldv = 6144; r.voff = 2048; r.goff = 4096; }
  else { r.H = 8; r.DK = 128; r.DV = 128; r.C = 128; r.ldv = 5120; r.voff = 1024; r.goff = 4096; }
  return r;
}

__device__ void phase_ret_prep(const Params& P, int slab) {
  const int L = Lof(slab);
  const u16* __restrict__ pj = (const u16*)(WS(P) + O_PROJ);
  u16* __restrict__ qdf = (u16*)(WS(P) + O_QDF); u16* __restrict__ qdb = (u16*)(WS(P) + O_QDB);
  u16* __restrict__ kif = (u16*)(WS(P) + O_KIF); u16* __restrict__ kib = (u16*)(WS(P) + O_KIB);
  u16* __restrict__ kef = (u16*)(WS(P) + O_KEF); u16* __restrict__ keb = (u16*)(WS(P) + O_KEB);
  float* dlf = (float*)(WS(P) + O_DLF); float* dlb = (float*)(WS(P) + O_DLB);
  const float2* __restrict__ rope = (const float2*)(WS(P) + O_ROPER);
  const long gtid = (long)BID() * NT + TID(), gsz = (long)gridDim.x * NT;
  for (long idx = gtid; idx < (long)SLAB * 64; idx += gsz) {
    const int d0 = (int)(idx & 15) * 8, h = (int)((idx >> 4) & 3), t = (int)(idx >> 6);
    const int pos = t & (L - 1), r = t & 255;
    const float lgf = -expf(P.in[20][h]), lgb = -expf(P.in[20][4 + h]);
    const u16* row = pj + (long)t * 6144 + h * 256 + d0;
    const uint4 vq1 = *(const uint4*)row, vq2 = *(const uint4*)(row + 128);
    const uint4 vk1 = *(const uint4*)(row + 1024), vk2 = *(const uint4*)(row + 1024 + 128);
    const float4* rp = (const float4*)(rope + (long)pos * 128 + d0);
    const float4 c01 = rp[0], c23 = rp[1], c45 = rp[2], c67 = rp[3];
    float q1[8], q2[8], k1[8], k2[8];
    unpack8(vq1, q1); unpack8(vq2, q2); unpack8(vk1, k1); unpack8(vk2, k2);
    const float cs[8] = {c01.x, c01.z, c23.x, c23.z, c45.x, c45.z, c67.x, c67.z};
    const float sn[8] = {c01.y, c01.w, c23.y, c23.w, c45.y, c45.w, c67.y, c67.w};
    float qa[8], qb[8], ka[8], kb[8];
#pragma unroll
    for (int i = 0; i < 8; ++i) {
      qa[i] = q1[i] * cs[i] - q2[i] * sn[i]; qb[i] = q1[i] * sn[i] + q2[i] * cs[i];
      ka[i] = (k1[i] * cs[i] - k2[i] * sn[i]) * 0.0625f; kb[i] = (k1[i] * sn[i] + k2[i] * cs[i]) * 0.0625f;
    }
    const float bf = (float)(r + 1) * lgf, bb = (float)(256 - r) * lgb;
    const float ef = expf(bf), eif = expf(-bf), eef = expf((float)(255 - r) * lgf);
    const float eb = expf(bb), eib = expf(-bb), eeb = expf((float)r * lgb);
    const long o1 = (long)t * 1024 + h * 256 + d0, o2 = o1 + 128;
    *(uint4*)(qdf + o1) = pack8s(qa, ef); *(uint4*)(qdf + o2) = pack8s(qb, ef);
    *(uint4*)(qdb + o1) = pack8s(qa, eb); *(uint4*)(qdb + o2) = pack8s(qb, eb);
    *(uint4*)(kef + o1) = pack8s(ka, eef); *(uint4*)(kef + o2) = pack8s(kb, eef);
    *(uint4*)(keb + o1) = pack8s(ka, eeb); *(uint4*)(keb + o2) = pack8s(kb, eeb);
    if (r == 0) {
      const long cgi = (long)(t >> 8) * 1024 + h * 256 + d0;
      const float df = expf(256.f * lgf), db = expf(256.f * lgb);
#pragma unroll
      for (int i = 0; i < 8; ++i) { dlf[cgi + i] = df; dlf[cgi + 128 + i] = df; dlb[cgi + i] = db; dlb[cgi + 128 + i] = db; }
    }
  }
}

__device__ __forceinline__ float lb_of(const float* lbt, int dr, int ch) {
  const float a0 = lbt[(dr * 4 + 0) * 1024 + ch], a1 = lbt[(dr * 4 + 1) * 1024 + ch], a2 = lbt[(dr * 4 + 2) * 1024 + ch], a3 = lbt[(dr * 4 + 3) * 1024 + ch];
  const float m = fmaxf(fmaxf(a0, a1), fmaxf(a2, a3));
  const float e0 = expf(a0 - m), e1 = expf(a1 - m), e2 = expf(a2 - m), e3 = expf(a3 - m);
  return (e0 + e1 + e2) / (e0 + e1 + e2 + e3);
}
__device__ void phase_hg_prep(const Params& P) {
  const u16* __restrict__ pj = (const u16*)(WS(P) + O_PROJ);
  u16* __restrict__ qdf = (u16*)(WS(P) + O_QDF); u16* __restrict__ qdb = (u16*)(WS(P) + O_QDB);
  u16* __restrict__ kif = (u16*)(WS(P) + O_KIF); u16* __restrict__ kib = (u16*)(WS(P) + O_KIB);
  u16* __restrict__ kef = (u16*)(WS(P) + O_KEF); u16* __restrict__ keb = (u16*)(WS(P) + O_KEB);
  float* dlf = (float*)(WS(P) + O_DLF); float* dlb = (float*)(WS(P) + O_DLB);
  const float* lbt = P.in[28];
  float* totF = (float*)smem;
  float* totB = totF + 1024;
  const int tid = TID(), lane = tid & 63, rg = tid >> 6;
  constexpr int RPT = 16;
  for (int item = BID(); item < 1024; item += gridDim.x) {
    const int cgi = item >> 3, ch = (item & 7) * 128 + lane * 2;
    const long t0 = (long)cgi * 128 + rg * RPT;
    unsigned wq[RPT], wf[RPT], wb[RPT];
#pragma unroll
    for (int i = 0; i < RPT; ++i) {
      const u16* row = pj + (t0 + i) * 5120 + ch;
      wq[i] = *(const unsigned*)row; wf[i] = *(const unsigned*)(row + 2048); wb[i] = *(const unsigned*)(row + 3072);
    }
    float lb0[2], lb1[2];
    lb0[0] = lb_of(lbt, 0, ch); lb0[1] = lb_of(lbt, 0, ch + 1);
    lb1[0] = lb_of(lbt, 1, ch); lb1[1] = lb_of(lbt, 1, ch + 1);
    float pf[2][RPT], sb[2][RPT], accf[2], accb[2];
#pragma unroll
    for (int c = 0; c < 2; ++c) {
      float a = 0.f;
#pragma unroll
      for (int i = 0; i < RPT; ++i) {
        const float x = bf2f((u16)(c ? (wf[i] >> 16) : (wf[i] & 0xffff)));
        a += logf(lb0[c] + (1.f - lb0[c]) * sigm(x)); pf[c][i] = a;
      }
      accf[c] = a;
      a = 0.f;
#pragma unroll
      for (int i = RPT - 1; i >= 0; --i) {
        const float x = bf2f((u16)(c ? (wb[i] >> 16) : (wb[i] & 0xffff)));
        a += logf(lb1[c] + (1.f - lb1[c]) * sigm(x)); sb[c][i] = a;
      }
      accb[c] = a;
    }
    __syncthreads();
    *(float2*)(totF + rg * 128 + lane * 2) = make_float2(accf[0], accf[1]);
    *(float2*)(totB + rg * 128 + lane * 2) = make_float2(accb[0], accb[1]);
    __syncthreads();
    float offF[2] = {0.f, 0.f}, offB[2] = {0.f, 0.f}, totf[2] = {0.f, 0.f}, totb[2] = {0.f, 0.f};
#pragma unroll
    for (int g = 0; g < 8; ++g) {
      const float2 f = *(const float2*)(totF + g * 128 + lane * 2), bq = *(const float2*)(totB + g * 128 + lane * 2);
      totf[0] += f.x; totf[1] += f.y; totb[0] += bq.x; totb[1] += bq.y;
      if (g < rg) { offF[0] += f.x; offF[1] += f.y; }
      if (g > rg) { offB[0] += bq.x; offB[1] += bq.y; }
    }
#pragma unroll
    for (int i = 0; i < RPT; ++i) {
      float o[6][2];
#pragma unroll
      for (int c = 0; c < 2; ++c) {
        const float xq = bf2f((u16)(c ? (wq[i] >> 16) : (wq[i] & 0xffff)));
        const float xf = bf2f((u16)(c ? (wf[i] >> 16) : (wf[i] & 0xffff)));
        const float xb = bf2f((u16)(c ? (wb[i] >> 16) : (wb[i] & 0xffff)));
        const float q = silu_f(xq);
        const float bf = offF[c] + pf[c][i], bb = offB[c] + sb[c][i];
        const float kf = (1.f - lb0[c]) * sigm(-xf), kb = (1.f - lb1[c]) * sigm(-xb);
        o[0][c] = q * expf(bf); o[1][c] = kf * expf(-bf); o[2][c] = kf * expf(totf[c] - bf);
        o[3][c] = q * expf(bb); o[4][c] = kb * expf(-bb); o[5][c] = kb * expf(totb[c] - bb);
      }
      const long oo = (t0 + i) * 1024 + ch;
      *(unsigned*)(qdf + oo) = pack2(o[0][0], o[0][1]);
      *(unsigned*)(kif + oo) = pack2(o[1][0], o[1][1]);
      *(unsigned*)(kef + oo) = pack2(o[2][0], o[2][1]);
      *(unsigned*)(qdb + oo) = pack2(o[3][0], o[3][1]);
      *(unsigned*)(kib + oo) = pack2(o[4][0], o[4][1]);
      *(unsigned*)(keb + oo) = pack2(o[5][0], o[5][1]);
    }
    if (rg == 0) {
      *(float2*)(dlf + (long)cgi * 1024 + ch) = make_float2(expf(totf[0]), expf(totf[1]));
      *(float2*)(dlb + (long)cgi * 1024 + ch) = make_float2(expf(totb[0]), expf(totb[1]));
    }
  }
  __syncthreads();
}

template <int C, int DKT>
__device__ __forceinline__ void rec_scores_item(const Params& P, const Rec& R, int cgi, int h, int ti, int tj) {
  constexpr int T = C > 128 ? 128 : C, KTS = DKT;
  const u16* qdf = (const u16*)(WS(P) + O_QDF); const u16* qdb = (const u16*)(WS(P) + O_QDB);
  const u16* kif = (const u16*)(WS(P) + O_KIF); const u16* kib = (const u16*)(WS(P) + O_KIB);
  u16* sc = (u16*)(WS(P) + O_SC) + (((long)cgi * R.H + h) * C + ti * T) * C + tj * T;
  const long offA = ((long)cgi * C + ti * T) * 1024 + h * R.DK, offB = ((long)cgi * C + tj * T) * 1024 + h * R.DK;
  f32x4 af[T / 32][T / 64] = {}, ab[T / 32][T / 64] = {};
  float sff = 1.f, sfb = 1.f;
  if (C == 256) {
    kif = (const u16*)(WS(P) + O_KEF); kib = (const u16*)(WS(P) + O_KEB);
    sff = expf((float)C * expf(P.in[20][h])); sfb = expf((float)C * expf(P.in[20][4 + h]));
  }
  if (ti >= tj) gemm_acc<T, T, true, true, true, KTS>(af, qdf + offA, 1024, kif + offB, 1024, (u16*)smem);
  if (ti <= tj) gemm_acc<T, T, true, true, true, KTS>(ab, qdb + offA, 1024, kib + offB, 1024, (u16*)smem);
  const int tid = TID(), lane = tid & 63, wid = tid >> 6;
  const int wm = wid >> 2, wn = wid & 3, fr = lane & 15, fq = lane >> 4;
#pragma unroll
  for (int mi = 0; mi < T / 32; ++mi)
#pragma unroll
    for (int ni = 0; ni < T / 64; ++ni) {
      const int r = wm * (T / 2) + mi * 16 + fr, c0 = wn * (T / 4) + ni * 16 + fq * 4;
      const int gr = ti * T + r;
      float v[4];
#pragma unroll
      for (int j = 0; j < 4; ++j) {
        const int gc = tj * T + c0 + j;
        v[j] = (gc <= gr ? af[mi][ni][j] * sff : 0.f) + (gc >= gr ? ab[mi][ni][j] * sfb : 0.f);
      }
      *(uint2*)(sc + r * C + c0) = make_uint2(pack2(v[0], v[1]), pack2(v[2], v[3]));
    }
}

template <int C, int DKT>
__device__ void phase_rec_su(const Params& P, int kind) {
  const Rec R = rec_of(kind);
  constexpr int KTU = C / 64;
  const int nch = SLAB / C;
  constexpr int NT1 = (C > 128 ? C / 128 : 1), NTT = NT1 * NT1;
  const int n_sc = nch * R.H * NTT;
  const int mtn = R.DK / 128, ntn = R.DV / 128;
  const int n_u = nch * R.H * 2 * mtn * ntn, G = gridDim.x;
  const u16* pj = (const u16*)(WS(P) + O_PROJ);
  for (int item = VBID(); item < n_sc; item += G) { const int tl = item % NTT, hh = (item / NTT) % R.H, cg = item / (NTT * R.H); rec_scores_item<C, DKT>(P, R, cg, hh, tl / NT1, tl % NT1); }
  const u16* kef = (const u16*)(WS(P) + O_KEF); const u16* keb = (const u16*)(WS(P) + O_KEB);
  u16* stfb = (u16*)(WS(P) + O_STF); u16* stbb = (u16*)(WS(P) + O_STB);
  Tiles<KTU> ta, tb;
#define U_DECODE(q_, nt_, mt_, dir_, h_, cgi_) int nt_, mt_, dir_, h_, cgi_; { int qq = (q_); nt_ = qq % ntn; qq /= ntn; mt_ = qq % mtn; qq /= mtn; dir_ = qq & 1; qq >>= 1; h_ = qq % R.H; cgi_ = qq / R.H; }
#define U_ISSUE(T_, nt_, mt_, dir_, h_, cgi_) tiles_issue<128, 128, false, false, KTU>(T_, (dir_ ? keb : kef) + (long)cgi_ * C * 1024 + h_ * R.DK + mt_ * 128, 1024, pj + (long)cgi_ * C * R.ldv + R.voff + h_ * R.DV + nt_ * 128, R.ldv)
#define U_RUN(T_, nt_, mt_, dir_, h_, cgi_) { f32x4 acc[4][2] = {}; gemm_run<128, 128, false, false, false, KTU>(acc, T_, (u16*)smem); \
    u16* st = (dir_ ? stbb : stfb) + (((long)cgi_ * R.H + h_) * R.DV + nt_ * 128) * R.DK + mt_ * 128; const int DK = R.DK; \
    epi_each<128, 128, false>(acc, [&](int r, int c, f32x4 val) { *(uint2*)(st + (long)c * DK + r) = make_uint2(pack2(val[0], val[1]), pack2(val[2], val[3])); }); }
  int q = VBID();
  if (q < n_u) { U_DECODE(q, nt, mt, dir, h, cgi); U_ISSUE(ta, nt, mt, dir, h, cgi); }
  for (; q < n_u; q += 2 * G) {
    U_DECODE(q, nt, mt, dir, h, cgi);
    const int q2 = q + G;
    if (q2 < n_u) { U_DECODE(q2, nt2, mt2, dir2, h2, cgi2); U_ISSUE(tb, nt2, mt2, dir2, h2, cgi2); }
    U_RUN(ta, nt, mt, dir, h, cgi);
    const int q3 = q + 2 * G;
    if (q3 < n_u) { U_DECODE(q3, nt3, mt3, dir3, h3, cgi3); U_ISSUE(ta, nt3, mt3, dir3, h3, cgi3); }
    if (q2 < n_u) { U_DECODE(q2, nt2, mt2, dir2, h2, cgi2); U_RUN(tb, nt2, mt2, dir2, h2, cgi2); }
  }
#undef U_DECODE
#undef U_ISSUE
#undef U_RUN
  __syncthreads();
}

__device__ void phase_rec_scan(const Params& P, int kind, int slab, bool dry = false) {
  const Rec R = rec_of(kind);
  const int L = Lof(slab), nseq = SLAB / L, ncs = L / R.C;
  const int qdk = R.DK / 4;
  const long per = (long)R.H * R.DV * qdk;
  const long total = 2 * nseq * per;
  const long gtid = (long)BID() * NT + TID(), gsz = (long)gridDim.x * NT;
  for (long idx = gtid; idx < total; idx += gsz) {
    long q = idx;
    const int pd = (int)(q % qdk); q /= qdk;
    const int e = (int)(q % R.DV); q /= R.DV;
    const int h = (int)(q % R.H); q /= R.H;
    const int seq = (int)(q % nseq);
    const int dir = (int)(q / nseq);
    u16* st = (u16*)(WS(P) + (dir ? O_STB : O_STF));
    u16* stw = dry ? (u16*)(WS(P) + O_OBUF) : st;
    const float* dl = (const float*)(WS(P) + (dir ? O_DLB : O_DLF));
    float s0 = 0.f, s1 = 0.f, s2 = 0.f, s3 = 0.f;
    const long ebase = ((long)h * R.DV + e) * R.DK + pd * 4;
    const long cstride = (long)R.H * R.DV * R.DK;
    const int dbase = h * R.DK + pd * 4;
    for (int i0 = 0; i0 < ncs; i0 += 8) {
      uint2 u[8];
      float4 dd[8];
#pragma unroll
      for (int j = 0; j < 8; ++j) {
        const int n = dir ? (ncs - 1 - i0 - j) : (i0 + j);
        const long cgi = (long)seq * ncs + n;
        u[j] = *(const uint2*)(st + cgi * cstride + ebase);
        dd[j] = *(const float4*)(dl + cgi * 1024 + dbase);
      }
#pragma unroll
      for (int j = 0; j < 8; ++j) {
        const int n = dir ? (ncs - 1 - i0 - j) : (i0 + j);
        const long cgi = (long)seq * ncs + n;
        *(uint2*)(stw + cgi * cstride + ebase) = make_uint2(pack2(s0, s1), pack2(s2, s3));
        s0 = dd[j].x * s0 + bf2f((u16)(u[j].x & 0xffff));
        s1 = dd[j].y * s1 + bf2f((u16)(u[j].x >> 16));
        s2 = dd[j].z * s2 + bf2f((u16)(u[j].y & 0xffff));
        s3 = dd[j].w * s3 + bf2f((u16)(u[j].y >> 16));
      }
    }
  }
}

template <int C, int DKT>
__device__ void phase_rec_out(const Params& P, int kind) {
  const Rec R = rec_of(kind);
  constexpr int T = C > 128 ? 128 : C, NRT = C / T;
  constexpr int KT1 = C / 64, KT2 = DKT;
  const int nch = SLAB / C, ntn = R.DV / 128;
  const u16* pj = (const u16*)(WS(P) + O_PROJ);
  const u16* scb = (const u16*)(WS(P) + O_SC);
  const u16* qdf = (const u16*)(WS(P) + O_QDF); const u16* qdb = (const u16*)(WS(P) + O_QDB);
  const u16* stf = (const u16*)(WS(P) + O_STF); const u16* stb = (const u16*)(WS(P) + O_STB);
  u16* ob = (u16*)(WS(P) + O_OBUF);
  const int HDV = R.H * R.DV;
  const int nitems = nch * R.H * NRT * ntn, G = gridDim.x;
  Tiles<KT1> t1; Tiles<KT2> t2; Tiles<KT2> t3;
  int item = VBID();
  if (item < nitems) {
    const int nt = item % ntn, rt = (item / ntn) % NRT, h = (item / (ntn * NRT)) % R.H, cgi = item / (ntn * NRT * R.H);
    tiles_issue<T, 128, true, false, KT1>(t1, scb + (((long)cgi * R.H + h) * C + rt * T) * C, C, pj + (long)cgi * C * R.ldv + R.voff + h * R.DV + nt * 128, R.ldv);
  }
  for (; item < nitems; item += G) {
    const int nt = item % ntn, rt = (item / ntn) % NRT, h = (item / (ntn * NRT)) % R.H, cgi = item / (ntn * NRT * R.H);
    const long qoff = ((long)cgi * C + rt * T) * 1024 + h * R.DK;
    const long soff = (((long)cgi * R.H + h) * R.DV + nt * 128) * R.DK;
    f32x4 acc[T / 32][2] = {};
    tiles_issue<T, 128, true, true, KT2>(t2, qdf + qoff, 1024, stf + soff, R.DK);
    gemm_run<T, 128, true, false, true, KT1>(acc, t1, (u16*)smem);
    tiles_issue<T, 128, true, true, KT2>(t3, qdb + qoff, 1024, stb + soff, R.DK);
    gemm_run<T, 128, true, true, true, KT2>(acc, t2, (u16*)smem);
    const int nx = item + G;
    if (nx < nitems) {
      const int nt2 = nx % ntn, rt2 = (nx / ntn) % NRT, h2 = (nx / (ntn * NRT)) % R.H, cg2 = nx / (ntn * NRT * R.H);
      tiles_issue<T, 128, true, false, KT1>(t1, scb + (((long)cg2 * R.H + h2) * C + rt2 * T) * C, C, pj + (long)cg2 * C * R.ldv + R.voff + h2 * R.DV + nt2 * 128, R.ldv);
    }
    gemm_run<T, 128, true, true, true, KT2>(acc, t3, (u16*)smem);
    if (DKT == 2) {
      float* part = (float*)(smem + 81920);
      const int tid = TID(), lane = tid & 63, wid = tid >> 6;
      const int wm = wid >> 2, wn = wid & 3, fr = lane & 15, fq = lane >> 4;
#pragma unroll
      for (int mi = 0; mi < T / 32; ++mi) {
        float sq = 0.f;
#pragma unroll
        for (int ni = 0; ni < 2; ++ni)
#pragma unroll
          for (int j = 0; j < 4; ++j) sq += acc[mi][ni][j] * acc[mi][ni][j];
        sq += __shfl_xor(sq, 16); sq += __shfl_xor(sq, 32);
        if (fq == 0) part[wn * 128 + wm * (T / 2) + mi * 16 + fr] = sq;
      }
      __syncthreads();
      const float* gain = P.in[29];
      u16* a2 = (u16*)(WS(P) + O_A2);
#pragma unroll
      for (int mi = 0; mi < T / 32; ++mi) {
        const int row = wm * (T / 2) + mi * 16 + fr;
        const float tot = part[row] + part[128 + row] + part[256 + row] + part[384 + row];
        const float rstd = rsqrtf(tot * (1.f / 128.f) + 1e-6f);
        const long t = (long)cgi * C + rt * T + row;
#pragma unroll
        for (int ni = 0; ni < 2; ++ni) {
          const int c = wn * 32 + ni * 16 + fq * 4;
          const float4 g4 = *(const float4*)(gain + c);
          const uint2 gw = *(const uint2*)(pj + t * R.ldv + R.goff + h * 128 + c);
          const f32x4 v = acc[mi][ni];
          const float y0 = v[0] * rstd * g4.x * silu_f(bf2f((u16)(gw.x & 0xffff)));
          const float y1 = v[1] * rstd * g4.y * silu_f(bf2f((u16)(gw.x >> 16)));
          const float y2 = v[2] * rstd * g4.z * silu_f(bf2f((u16)(gw.y & 0xffff)));
          const float y3 = v[3] * rstd * g4.w * silu_f(bf2f((u16)(gw.y >> 16)));
          *(uint2*)(a2 + t * 1024 + h * 128 + c) = make_uint2(pack2(y0, y1), pack2(y2, y3));
        }
      }
    } else {
      u16* o = ob + ((long)cgi * C + rt * T) * HDV + h * R.DV + nt * 128;
      epi_each<T, 128, true>(acc, [&](int r, int c, f32x4 val) { *(uint2*)(o + (long)r * HDV + c) = make_uint2(pack2(val[0], val[1]), pack2(val[2], val[3])); });
    }
  }
  __syncthreads();
}

template <int KIND>
__device__ void phase_rec_ng_t(const Params& P) {
  const Rec R = rec_of(KIND);
  constexpr int DV = (KIND == 1) ? 512 : 128, H = (KIND == 1) ? 4 : 8, PER = DV / 64, HDV = H * DV;
  const u16* __restrict__ ob = (const u16*)(WS(P) + O_OBUF);
  const u16* __restrict__ pj = (const u16*)(WS(P) + O_PROJ);
  u16* __restrict__ a2 = (u16*)(WS(P) + O_A2);
  const float* gain = P.in[29];
  const int tid = TID(), lane = tid & 63, wid = tid >> 6;
  constexpr int nrows = SLAB * H;
  for (int item = BID(); item < nrows / 32; item += gridDim.x) {
    float v[4][PER];
    float ss[4];
#pragma unroll
    for (int u = 0; u < 4; ++u) {
      const int rh = item * 32 + wid * 4 + u;
      const int t = rh / H, h = rh % H;
      const u16* o = ob + (long)t * HDV + h * DV + lane * PER;
      if (PER == 8) {
        float f8[8];
        unpack8(*(const uint4*)o, f8);
#pragma unroll
        for (int i = 0; i < 8; ++i) v[u][i % PER] = f8[i];
      } else {
        const unsigned w = *(const unsigned*)o;
        v[u][0] = bf2f((u16)(w & 0xffff)); v[u][1 % PER] = bf2f((u16)(w >> 16));
      }
      float a = 0.f;
#pragma unroll
      for (int i = 0; i < PER; ++i) a += v[u][i] * v[u][i];
      ss[u] = a;
    }
#pragma unroll
    for (int u = 0; u < 4; ++u) ss[u] = wave_sum(ss[u]);
#pragma unroll
    for (int u = 0; u < 4; ++u) {
      const int rh = item * 32 + wid * 4 + u;
      const int t = rh / H, h = rh % H;
      const float rstd = rsqrtf(ss[u] / (float)DV + 1e-6f);
      const u16* g = pj + (long)t * R.ldv + R.goff + h * DV + lane * PER;
      u16* out = a2 + (long)t * HDV + h * DV + lane * PER;
      float y[PER];
#pragma unroll
      for (int i = 0; i < PER; ++i) {
        y[i] = v[u][i] * rstd;
        if (KIND == 3) y[i] *= gain[lane * PER + i];
      }
      if (PER == 8) {
        const uint4 gw = *(const uint4*)g;
        float gf[8];
        unpack8(gw, gf);
        float r8[8];
#pragma unroll
        for (int i = 0; i < 8; ++i) r8[i] = y[i % PER] * silu_f(gf[i]);
        *(uint4*)out = pack8s(r8, 1.f);
      } else {
        const unsigned gw = *(const unsigned*)g;
        *(unsigned*)out = pack2(y[0] * silu_f(bf2f((u16)(gw & 0xffff))), y[1 % PER] * silu_f(bf2f((u16)(gw >> 16))));
      }
    }
  }
}
__device__ void phase_rec_ng(const Params& P, int kind) {
  if (kind == 1) phase_rec_ng_t<1>(P); else phase_rec_ng_t<3>(P);
}

__device__ void phase_swa_prep(const Params& P) {
  const u16* __restrict__ pj = (const u16*)(WS(P) + O_SA_P);
  u16* __restrict__ qn = (u16*)(WS(P) + O_SA_Q);
  u16* __restrict__ kn = (u16*)(WS(P) + O_SA_K);
  const float2* __restrict__ rope = (const float2*)(WS(P) + O_ROPES);
  const long gtid = (long)BID() * NT + TID(), gsz = (long)gridDim.x * NT;
  for (long idx = gtid; idx < (long)NTOK * 80; idx += gsz) {
    const int j = (int)(idx & 3);
    const int hd = (int)((idx >> 2) % 20);
    const int t = (int)(idx / 80);
    const int col = hd < 16 ? hd * 64 : 1024 + (hd - 16) * 64;
    const int d0 = j * 8;
    float x1[8], x2[8];
    unpack8(*(const uint4*)(pj + (long)t * 1536 + col + d0), x1);
    unpack8(*(const uint4*)(pj + (long)t * 1536 + col + d0 + 32), x2);
    const int L = t < 16384 ? 2048 : 8192;
    const float4* rp = (const float4*)(rope + (long)(t & (L - 1)) * 32 + d0);
    const float4 c01 = rp[0], c23 = rp[1], c45 = rp[2], c67 = rp[3];
    float ss = 0.f;
#pragma unroll
    for (int i = 0; i < 8; ++i) ss += x1[i] * x1[i] + x2[i] * x2[i];
    ss += __shfl_xor(ss, 1); ss += __shfl_xor(ss, 2);
    const float rstd = rsqrtf(ss * (1.f / 64.f) + 1e-6f);
    const float* gn = hd < 16 ? P.in[23] : P.in[24];
    const float4 ga = *(const float4*)(gn + d0), gb = *(const float4*)(gn + d0 + 4), gc = *(const float4*)(gn + d0 + 32), gd = *(const float4*)(gn + d0 + 36);
    const float g1[8] = {ga.x, ga.y, ga.z, ga.w, gb.x, gb.y, gb.z, gb.w};
    const float g2[8] = {gc.x, gc.y, gc.z, gc.w, gd.x, gd.y, gd.z, gd.w};
    const float cs[8] = {c01.x, c01.z, c23.x, c23.z, c45.x, c45.z, c67.x, c67.z};
    const float sn[8] = {c01.y, c01.w, c23.y, c23.w, c45.y, c45.w, c67.y, c67.w};
    const float osc = hd < 16 ? 0.125f : 1.f;
    float o1[8], o2[8];
#pragma unroll
    for (int i = 0; i < 8; ++i) {
      const float y1 = x1[i] * rstd * g1[i], y2 = x2[i] * rstd * g2[i];
      o1[i] = (y1 * cs[i] - y2 * sn[i]) * osc;
      o2[i] = (y1 * sn[i] + y2 * cs[i]) * osc;
    }
    u16* dst = hd < 16 ? qn + (long)t * 1024 + hd * 64 + d0 : kn + (long)t * 256 + (hd - 16) * 64 + d0;
    *(uint4*)dst = pack8s(o1, 1.f);
    *(uint4*)(dst + 32) = pack8s(o2, 1.f);
  }
}

constexpr int SLD = 324;
__device__ void phase_swa_att(const Params& P) {
  const u16* qn = (const u16*)(WS(P) + O_SA_Q);
  const u16* kn = (const u16*)(WS(P) + O_SA_K);
  const u16* pj = (const u16*)(WS(P) + O_SA_P);
  u16* a2 = (u16*)(WS(P) + O_SA_A);
  const float* sink = P.in[25];
  float* S = (float*)(smem + 40960);
  u16* Bs = (u16*)smem + 9216;
  const int tid = TID(), lane = tid & 63, wid = tid >> 6;
  const int wm = wid >> 2, wn = wid & 3, fr = lane & 15, fq = lane >> 4;
  const int nitems = (NTOK / 64) * 16;
  for (int item = VBID(); item < nitems; item += gridDim.x) {
    const int hq = item & 15, qbg = item >> 4;
    const int L = qbg < 256 ? 2048 : 8192;
    const int q0 = qbg < 256 ? (qbg & 31) * 64 : ((qbg - 256) & 127) * 64;
    const long tok0 = qbg < 256 ? (long)(qbg >> 5) * 2048 : 16384 + (long)((qbg - 256) >> 7) * 8192;
    const int hkv = hq >> 2;
    uint4 vt[5];
#pragma unroll
    for (int kt = 0; kt < 5; ++kt) {
      const int kp0 = q0 - 128 + kt * 64;
      vt[kt] = make_uint4(0, 0, 0, 0);
      if (kp0 >= 0 && kp0 < L) vt[kt] = ld_chunk<64, false>(pj + (tok0 + kp0) * 1536 + 1280 + hkv * 64, 1536, 0, tid);
    }
    for (int kt = 0; kt < 5; ++kt) {
      const int kp0 = q0 - 128 + kt * 64;
      if (kp0 >= 0 && kp0 < L) {
        f32x4 acc[2][1] = {};
        gemm_acc<64, 64, true, true, true, 1>(acc, qn + (tok0 + q0) * 1024 + hq * 64, 1024, kn + (tok0 + kp0) * 256 + hkv * 64, 256, (u16*)smem);
        epi_each<64, 64, true>(acc, [&](int r, int c, f32x4 v) {
          f32x4 o;
#pragma unroll
          for (int j = 0; j < 4; ++j) {
            const int dlt = (q0 + r) - (kp0 + c + j);
            o[j] = (dlt <= 128 && dlt >= -128) ? v[j] : -1e30f;
          }
          *(f32x4*)(S + r * SLD + kt * 64 + c) = o;
        });
      } else {
        for (int i = tid; i < 4096; i += NT) S[(i >> 6) * SLD + kt * 64 + (i & 63)] = -1e30f;
      }
    }
    __syncthreads();
    {
      const int r = tid >> 3, sub = tid & 7;
      const float sk = sink[hq];
      float e[40];
      float m = sk;
#pragma unroll
      for (int i = 0; i < 40; ++i) { e[i] = S[r * SLD + sub + 8 * i]; m = fmaxf(m, e[i]); }
      m = fmaxf(m, __shfl_xor(m, 1)); m = fmaxf(m, __shfl_xor(m, 2)); m = fmaxf(m, __shfl_xor(m, 4));
      float den = 0.f;
#pragma unroll
      for (int i = 0; i < 40; ++i) { e[i] = __expf(e[i] - m); den += e[i]; }
      den += __shfl_xor(den, 1); den += __shfl_xor(den, 2); den += __shfl_xor(den, 4);
      den += __expf(sk - m);
      const float inv = 1.f / den;
      u16* prow = (u16*)(S + r * SLD);
#pragma unroll
      for (int i = 0; i < 40; ++i) prow[sub + 8 * i] = f2bf(e[i] * inv);
    }
    __syncthreads();
    f32x4 acc[2][1] = {};
#pragma unroll
    for (int kt = 0; kt < 5; ++kt) {
      const int kp0 = q0 - 128 + kt * 64;
      if (kp0 >= 0 && kp0 < L) {
        __syncthreads();
        st_chunk<64, false>(Bs, vt[kt], tid);
        __syncthreads();
#pragma unroll
        for (int ks = 0; ks < 2; ++ks) {
          bf16x8 af[2];
#pragma unroll
          for (int mi = 0; mi < 2; ++mi) af[mi] = *(const bf16x8*)((const u16*)(S + (wm * 32 + mi * 16 + fr) * SLD) + kt * 64 + ks * 32 + fq * 8);
          const bf16x8 bfr = ld_frag<64, false>(Bs, wn * 16, ks, fr, fq);
#pragma unroll
          for (int mi = 0; mi < 2; ++mi) acc[mi][0] = __builtin_amdgcn_mfma_f32_16x16x32_bf16(bfr, af[mi], acc[mi][0], 0, 0, 0);
        }
      }
    }
    u16* o = a2 + (tok0 + q0) * 1024 + hq * 64;
    epi_each<64, 64, true>(acc, [&](int r, int c, f32x4 v) { *(uint2*)(o + (long)r * 1024 + c) = make_uint2(pack2(v[0], v[1]), pack2(v[2], v[3])); });
    __syncthreads();
  }
}

#define XB_TMO      128
#define XB_XCNT(j)  (256  + 64 * (j))
#define XB_XSUB(j)  (1280 + 64 * (j))
#define XB_XGEN(j)  (2304 + 64 * (j))
#define XB_TOP      3328
#define XB_TOPGEN   3392
#define XCD_BAR_WORDS 3456
#define XB_SPIN_CAP (1u << 18)
__device__ __forceinline__ unsigned xb_ld(unsigned* p)              { return __hip_atomic_load(p, __ATOMIC_RELAXED, __HIP_MEMORY_SCOPE_AGENT); }
__device__ __forceinline__ unsigned xb_add(unsigned* p, unsigned v) { return __hip_atomic_fetch_add(p, v, __ATOMIC_RELAXED, __HIP_MEMORY_SCOPE_AGENT); }
__device__ __forceinline__ unsigned xb_xcc_id() { return (unsigned)__builtin_amdgcn_s_getreg((3 << 11) | 20) & 0xFu; }
#define XB_SPIN(cond, bar) do { unsigned _sp = 0; while (cond) { __builtin_amdgcn_s_sleep(1); \
    if ((++_sp & 255u) == 0u) { if (xb_ld(&(bar)[XB_TMO])) break; if (_sp > XB_SPIN_CAP) { atomicAdd(&(bar)[XB_TMO], 1u); break; } } } } while (0)
struct XcdBarrier { unsigned* bar; unsigned x; volatile LDS_AS unsigned* st; };
__device__ __forceinline__ XcdBarrier xcd_barrier_post(unsigned* bar, volatile LDS_AS unsigned* st) {
    XcdBarrier b; b.bar = bar; b.x = xb_xcc_id(); b.st = st;
    if (threadIdx.x == 0) (void)xb_add(&bar[XB_XCNT(b.x)], 1u);
    return b;
}
__device__ __forceinline__ void xcd_barrier_complete(unsigned* bar, unsigned x, unsigned& nloc, unsigned& nx) {
    const unsigned G = gridDim.x * gridDim.y * gridDim.z;
    unsigned sum, cnt, mine, sp = 0u;
    for (;;) {
        sum = 0u; cnt = 0u; mine = 0u;
#pragma unroll
        for (unsigned j = 0; j < 16; ++j) { const unsigned c = xb_ld(&bar[XB_XCNT(j)]); sum += c; cnt += (c > 0u) ? 1u : 0u; mine = (j == x) ? c : mine; }
        if (sum == G) break;
        __builtin_amdgcn_s_sleep(1);
        if ((++sp & 255u) == 0u) { if (xb_ld(&bar[XB_TMO])) break; if (sp > XB_SPIN_CAP) { atomicAdd(&bar[XB_TMO], 1u); break; } }
    }
    nloc = mine > 0u ? mine : 1u; nx = cnt > 0u ? cnt : 1u;
}
__device__ __forceinline__ void xcd_barrier(const XcdBarrier& b) {
    asm volatile("s_waitcnt vmcnt(0)" ::: "memory");
    __syncthreads();
    if (threadIdx.x == 0) {
        unsigned* bar = b.bar;
        __builtin_amdgcn_s_waitcnt(0);
        unsigned nloc = b.st[0], nx = b.st[1];
        if (nloc == 0u) { xcd_barrier_complete(bar, b.x, nloc, nx); b.st[0] = nloc; b.st[1] = nx; }
        const unsigned old = xb_add(&bar[XB_XSUB(b.x)], 1u);
        const unsigned gen = old / nloc;
        if (old + 1u == (gen + 1u) * nloc) {
            __builtin_amdgcn_fence(__ATOMIC_RELEASE, "agent");
            asm volatile("s_waitcnt vmcnt(0)" ::: "memory");
            const unsigned og = xb_add(&bar[XB_TOP], 1u);
            const unsigned tg = og / nx;
            if (og + 1u == (tg + 1u) * nx) xb_add(&bar[XB_TOPGEN], 1u);
            else XB_SPIN(xb_ld(&bar[XB_TOPGEN]) == tg, bar);
            __builtin_amdgcn_fence(__ATOMIC_ACQUIRE, "agent");
            xb_add(&bar[XB_XGEN(b.x)], 1u);
            asm volatile("s_waitcnt vmcnt(0)" ::: "memory");
        } else {
            XB_SPIN(xb_ld(&bar[XB_XGEN(b.x)]) == gen, bar);
            __builtin_amdgcn_fence(__ATOMIC_ACQUIRE, "agent");
            asm volatile("s_waitcnt vmcnt(0)" ::: "memory");
        }
    }
    __syncthreads();
}

__device__ __forceinline__ int nmix_of(int kind) { return kind == 1 ? 8 : (kind == 3 ? 7 : (kind == 2 ? 5 : 6)); }
__device__ __forceinline__ int nsl_of(int kind) { return kind == 2 ? 1 : 5; }

__device__ void ffn_step(const Params& P, int layer, int f) {
  if (f == 6) { phase_ffn_down(P, layer); return; }
  const int fs = f / 3, st = f % 3;
  if (st == 0) { REP(4) phase_norm(P, layer, fs, 1); }
  else if (st == 1) { REP(0) phase_ffn_gate(P, layer); }
  else { REP(0) phase_ffn_val(P, layer, fs); }
}
__device__ void layer_step(const Params& P, int layer, int slab, int step) {
  const int kind = layer;
  if (step == 0) { REP(4) phase_norm(P, layer, slab, kind == 2 ? 2 : 0); return; }
  if (kind == 0) {
    if (step == 1) { REP(0) phase_proj(P, O_WHYIN, 3072); }
    else if (step == 2) { REP(3) phase_hy_conv(P, slab); }
    else if (step == 3) { if ((PROBE_MASK >> 7) & 1) phase_hy_fft(P, slab, true); phase_hy_fft(P, slab); }
    else if (step == 4) { REP(3) phase_hy_tr(P, slab); }
    else phase_resid(P, layer, slab, (const u16*)(WS(P) + O_A2), 1024, O_WHYOUT, 2 * D);
  } else if (kind == 1) {
    if (step == 1) { REP(0) phase_proj(P, O_WRETIN, 6144); }
    else if (step == 2) { REP(1) REP(9) phase_ret_prep(P, slab); }
    else if (step == 3) { REP(1) REP(11) phase_rec_su<256, 4>(P, 1); }
    else if (step == 4) { if ((PROBE_MASK >> 6) & 1) phase_rec_scan(P, 1, slab, true); phase_rec_scan(P, 1, slab); }
    else if (step == 5) { REP(1) REP(12) phase_rec_out<256, 4>(P, 1); }
    else if (step == 6) { REP(1) REP(9) phase_rec_ng(P, 1); }
    else phase_resid(P, layer, slab, (const u16*)(WS(P) + O_A2), 2048, O_WRETOUT, 2 * D);
  } else if (kind == 2) {
    if (step == 1) {
      EpiStoreBf16 E; E.O = (u16*)(WS(P) + O_SA_P); E.ldc = 1536;
      REP(0) run_gemm((const u16*)(WS(P) + O_SA_H), (const u16*)(WS(P) + O_WSWAIN), NTOK, 1536, D, E);
    }
    else if (step == 2) { REP(2) REP(14) phase_swa_prep(P); }
    else if (step == 3) { REP(2) REP(15) phase_swa_att(P); }
    else {
      EpiResid E; E.X = OUTP(P); E.XS = E.X; E.mod = (const float*)(WS(P) + O_MOD) + (long)layer * 16 * 6144; E.goff = 2 * D; E.grow0 = 0;
      run_gemm((const u16*)(WS(P) + O_SA_A), (const u16*)(WS(P) + O_WSWAOUT), NTOK, D, 1024, E);
    }
  } else {
    if (step == 1) { REP(0) phase_proj(P, O_WHGIN, 5120); }
    else if (step == 2) { REP(1) REP(9) phase_hg_prep(P); }
    else if (step == 3) { REP(1) REP(11) phase_rec_su<128, 2>(P, 3); }
    else if (step == 4) { if ((PROBE_MASK >> 6) & 1) phase_rec_scan(P, 3, slab, true); phase_rec_scan(P, 3, slab); }
    else if (step == 5) { REP(1) REP(12) phase_rec_out<128, 2>(P, 3); }
    else phase_resid(P, layer, slab, (const u16*)(WS(P) + O_A2), 1024, O_WHGOUT, 2 * D);
  }
}

__global__ void __launch_bounds__(NT) fwd_megakernel(Params P) {
  cg::grid_group grid = cg::this_grid();
  __shared__ uint4 xb_words;
  if (threadIdx.x == 0) xb_words = make_uint4(0u, 0u, 0u, 0u);
  __syncthreads();
  XcdBarrier xb = xcd_barrier_post((unsigned*)(P.ws + O_BAR), (volatile LDS_AS unsigned*)&xb_words);
  for (int pid = P.p0; pid < P.p1; ++pid) {
    if (pid == 0) { REP(5) phase_pre0(P); }
    else if (pid == 1) { REP(5) phase_pre1(P); }
    else {
      int q = pid - 2, layer = 0;
      while (q >= nsl_of(layer) * nmix_of(layer) + 7) { q -= nsl_of(layer) * nmix_of(layer) + 7; ++layer; }
      const int nm = nmix_of(layer), nsl = nsl_of(layer);
      if (q < nsl * nm) layer_step(P, layer, q / nm, q % nm);
      else ffn_step(P, layer, q - nsl * nm);
    }
    if (pid + 1 < P.p1) {
      if (pid == 0) grid.sync();
      else xcd_barrier(xb);
      if ((PROBE_MASK >> 8) & 1) xcd_barrier(xb);
    }
  }
}

extern "C" void kernel_launch(void* const* d_in, const int* in_sizes, int n_in, void* d_out, int out_size, void* d_ws,
                              size_t ws_size, hipStream_t stream) {
  static int grid_blocks = 0;
  if (!grid_blocks) {
    int dev = 0, cus = 0, per_cu = 0;
    (void)hipGetDevice(&dev);
    (void)hipDeviceGetAttribute(&cus, hipDeviceAttributeMultiprocessorCount, dev);
    (void)hipFuncSetAttribute((const void*)fwd_megakernel, hipFuncAttributeMaxDynamicSharedMemorySize, LDSB);
    (void)hipOccupancyMaxActiveBlocksPerMultiprocessor(&per_cu, (const void*)fwd_megakernel, NT, LDSB);
    if (per_cu < 1) per_cu = 1;
    if (per_cu > 1) per_cu = 1;
    grid_blocks = cus * per_cu;
    if (ws_size < WS_END) fprintf(stderr, "kernel_launch: workspace too small: %zu < %zu\n", ws_size, (size_t)WS_END);
  }
  Params p;
  memset(&p, 0, sizeof(p));
  for (int i = 0; i < 36; ++i) p.in[i] = (const float*)d_in[i];
  p.out = (float*)d_out;
  p.ws = (unsigned char*)d_ws;
  (void)hipMemsetAsync((unsigned char*)d_ws + O_BAR, 0, XCD_BAR_WORDS * 4, stream);
#if ONE_LAUNCH
  p.p0 = 0; p.p1 = NPHASES;
  void* args[] = {&p};
  hipError_t e = hipLaunchCooperativeKernel((const void*)fwd_megakernel, dim3(grid_blocks), dim3(NT), args, LDSB, stream);
  if (e != hipSuccess) fprintf(stderr, "cooperative launch failed: %s (grid %d)\n", hipGetErrorString(e), grid_blocks);
#else
  for (int ph = 0; ph < NPHASES; ++ph) {
    p.p0 = ph; p.p1 = ph + 1;
    hipLaunchKernelGGL(fwd_megakernel, dim3(grid_blocks), dim3(NT), LDSB, stream, p);
  }
#endif
}
```

```cpp
#include <hip/hip_runtime.h>
#include <hip/hip_cooperative_groups.h>
#include <cstdio>
#include <cstdint>
#include <cstring>
namespace cg = cooperative_groups;

typedef unsigned short u16;
typedef __attribute__((ext_vector_type(8))) short bf16x8;
typedef __attribute__((ext_vector_type(4))) float f32x4;

#define NT 512
#ifndef ONE_LAUNCH
#define ONE_LAUNCH 1
#endif
#ifndef PROBE_MASK
#define PROBE_MASK 0
#endif
#define REP(cls) for (int rep_##cls = 0; rep_##cls < (((PROBE_MASK >> (cls)) & 1) ? 2 : 1); ++rep_##cls)

constexpr int D = 1024, SLAB = 16384, DFF = 2816;
constexpr int LDSB = 139264;
constexpr int FSLAB = 40960, NTOK = 81920;
constexpr int NPHASES = 2 + 5 * (6 + 8 + 7) + 5 + 4 * 7;

constexpr size_t SZW(size_t n, size_t k) { return n * k * 2; }
constexpr size_t O_WHYIN = 0;
constexpr size_t O_WHYOUT = O_WHYIN + SZW(3072, 1024);
constexpr size_t O_WRETIN = O_WHYOUT + SZW(1024, 1024);
constexpr size_t O_WRETOUT = O_WRETIN + SZW(6144, 1024);
constexpr size_t O_WSWAIN = O_WRETOUT + SZW(1024, 2048);
constexpr size_t O_WSWAOUT = O_WSWAIN + SZW(1536, 1024);
constexpr size_t O_WHGIN = O_WSWAOUT + SZW(1024, 1024);
constexpr size_t O_WHGOUT = O_WHGIN + SZW(5120, 1024);
constexpr size_t O_WFG = O_WHGOUT + SZW(1024, 1024);
constexpr size_t O_WFV = O_WFG + 4 * SZW(2816, 1024);
constexpr size_t O_WFD = O_WFV + 4 * SZW(2816, 1024);
constexpr size_t O_MOD = O_WFD + 4 * SZW(1024, 2816);
constexpr size_t O_TW = O_MOD + (size_t)4 * 16 * 6144 * 4;
constexpr size_t O_HIDS = O_TW + 8192 * 8;
constexpr size_t O_HIDP = O_HIDS + (size_t)8192 * 64 * 4;
constexpr size_t O_ROPER = O_HIDP + (size_t)2048 * 64 * 4;
constexpr size_t O_ROPES = O_ROPER + (size_t)8192 * 128 * 8;
constexpr size_t O_PROJ = O_ROPES + (size_t)8192 * 32 * 8;
constexpr size_t O_HBUF = O_PROJ + (size_t)SLAB * 6144 * 2;
constexpr size_t O_A2 = O_HBUF + (size_t)SLAB * 1024 * 2;
constexpr size_t O_C = O_A2 + (size_t)SLAB * 2048 * 2;
constexpr size_t O_FHBUF = O_PROJ;
constexpr size_t O_FGBUF = O_FHBUF + (size_t)FSLAB * 1024 * 2;
constexpr size_t O_FACT = O_FGBUF + (size_t)FSLAB * DFF * 2;
constexpr size_t END_F = O_FACT + (size_t)NTOK * DFF * 2;
constexpr size_t O_MODP = O_C;
constexpr size_t O_BAR = ((size_t)1 << 30) - 16384;
constexpr size_t O_HSPS = O_BAR - (size_t)1024 * 16384 * 8 - (size_t)1024 * 4096 * 8;
constexpr size_t O_HSPP = O_HSPS + (size_t)1024 * 16384 * 8;
constexpr size_t O_UT = O_C;
constexpr size_t O_X0C = O_UT + (size_t)SLAB * 1024 * 4;
constexpr size_t END_HY = O_X0C + (size_t)SLAB * 1024 * 2;
static_assert(END_F <= O_HSPS && END_HY <= O_HSPS, "layer-0 buffers overlap the filter spectra");
constexpr size_t SZP = (size_t)SLAB * 1024 * 2;
constexpr size_t O_QDF = O_C, O_QDB = O_QDF + SZP, O_KIF = O_QDB + SZP, O_KIB = O_KIF + SZP, O_KEF = O_KIB + SZP, O_KEB = O_KEF + SZP;
constexpr size_t O_DLF = O_KEB + SZP;
constexpr size_t O_DLB = O_DLF + (size_t)256 * 1024 * 4;
constexpr size_t O_SC = O_DLB + (size_t)256 * 1024 * 4;
constexpr size_t O_STF = O_SC + (size_t)SLAB * 1024 * 2;
constexpr size_t O_STB = O_STF + (size_t)134217728;
constexpr size_t O_OBUF = O_STB + (size_t)134217728;
constexpr size_t END_REC = O_OBUF + (size_t)SLAB * 2048 * 4;
constexpr size_t O_QN = O_C;
constexpr size_t O_KN = O_QN + SZP;
constexpr size_t O_PBUF = O_KN + (size_t)SLAB * 256 * 2;
constexpr size_t END_SWA0 = O_PBUF + (size_t)SLAB * 16 * 320 * 2;
constexpr size_t O_SA_H = O_PROJ;
constexpr size_t O_SA_P = O_SA_H + (size_t)81920 * 1024 * 2;
constexpr size_t O_SA_Q = O_SA_P + (size_t)81920 * 1536 * 2;
constexpr size_t O_SA_K = O_SA_Q + (size_t)81920 * 1024 * 2;
constexpr size_t O_SA_A = O_SA_K + (size_t)81920 * 256 * 2;
constexpr size_t END_SWA = O_SA_A + (size_t)81920 * 1024 * 2;
constexpr size_t WS_END = END_REC > END_HY ? (END_REC > END_SWA ? END_REC : END_SWA) : (END_HY > END_SWA ? END_HY : END_SWA);
static_assert(WS_END <= O_BAR, "workspace exceeds 1 GiB");

struct Params {
  const float* in[36];
  float* out;
  unsigned char* ws;
  int p0, p1;
};

extern __shared__ __attribute__((aligned(16))) unsigned char smem[];

__device__ __forceinline__ int TID() { int t = threadIdx.x; asm volatile("" : "+v"(t)); return t; }
__device__ __forceinline__ int BID() { int b = blockIdx.x; asm volatile("" : "+s"(b)); return b; }
__device__ __forceinline__ int VBID() { const int b = BID(), g = gridDim.x; return (g & 7) ? b : (b & 7) * (g >> 3) + (b >> 3); }
__device__ __forceinline__ long ZOFF() { long z = 0; asm volatile("" : "+s"(z)); return z; }
__device__ __forceinline__ unsigned char* WS(const Params& P) { return P.ws + ZOFF(); }
__device__ __forceinline__ float* OUTP(const Params& P) { return P.out + ZOFF(); }

namespace pg8 {
#define PG8_LAS __attribute__((address_space(3)))
typedef unsigned short bf16_t;
typedef short bf16x8 __attribute__((ext_vector_type(8)));
typedef float f32x4 __attribute__((ext_vector_type(4)));
typedef unsigned u32x4 __attribute__((ext_vector_type(4)));
constexpr int BM = 256, BK = 64, HALF = 128, HTB = HALF * BK * 2  , STAGE_BYTES = 8 * HTB, NXCD = 8, WGM = 8;

__host__ __device__ __forceinline__ int lds_byte(int r, int c) { const int st = (r >> 4) * 2 + (c >> 5), rr = r & 15, cc = c & 31, ob = rr * 64 + cc * 2; return st * 1024 + (ob ^ (((ob >> 9) & 1) << 5)); }
__host__ __device__ __forceinline__ void stage_rc(int b, int& R, int& C) { const int st = b / 1024, sb = b % 1024, swz = sb ^ (((sb >> 9) & 1) << 5); R = (st >> 1) * 16 + swz / 64; C = (st & 1) * 32 + (swz % 64) / 2; }
__host__ __device__ __forceinline__ int perm32(int rho) { const int n = rho >> 4, i = rho & 15; return 8 * (i >> 2) + 4 * n + (i & 3); }

struct Unit { int pm, pn; };
struct Gemm { const bf16_t* A; const bf16_t* Bt; int M, N, K; };

struct StaticOrder {
    int nM, nN, nwg, G, c;
    __host__ __device__ void init(int M, int N, int G_, int c_) { nM = M / BM; nN = N / BM; nwg = nM * nN; G = G_; c = c_; }
    __host__ __device__ bool next(int i, Unit& u) const {
        const long L = (long)i * G + c; if (L >= nwg) return false;
        int wgid = (int)L; { const int q = nwg / NXCD, r = nwg % NXCD, xcd = wgid % NXCD, off = wgid / NXCD; wgid = (xcd < r ? xcd * (q + 1) : r * (q + 1) + (xcd - r) * q) + off; }
        const int nig = WGM * nN, gid = wgid / nig, fm = gid * WGM, gsz = (nM - fm) < WGM ? (nM - fm) : WGM;
        u.pm = fm + ((wgid % nig) % gsz); u.pn = (wgid % nig) / gsz; return true;
    }
    __device__ __forceinline__ void a_ready(const Unit&) const {}
    __device__ __forceinline__ void done(const Unit&) const {}
};

template <class Epi, class Sched, bool STAMP = false>
__device__ __forceinline__ void gemm_phase(PG8_LAS unsigned char* lds, const Gemm g, const Sched& S, const Epi& E, unsigned long long* stamps) {
    const int tid = TID(), wid = __builtin_amdgcn_readfirstlane(tid >> 6), lane = tid & 63, wr = wid >> 2, wc = wid & 3, fr = lane & 15, fq = lane >> 4;
    const int K = g.K, nt = K / BK;
    int ts_lo = 0, ts_hi = 0, nts = 0; const unsigned long long rt_entry = STAMP ? (unsigned long long)wall_clock64() : 0ull;
#define PG8_STAMP() do { if (STAMP && wid == 0 && nts < 64) { const unsigned long long _c = (unsigned long long)clock64(); \
        ts_lo = (lane == nts) ? (int)(unsigned)_c : ts_lo; ts_hi = (lane == nts) ? (int)(unsigned)(_c >> 32) : ts_hi; ++nts; } } while (0)
    PG8_STAMP();
    unsigned voffA[2], voffB[2];
#pragma unroll
    for (int i = 0; i < 2; ++i) { int R, C; stage_rc(tid * 16 + i * 8192, R, C); const int Rb = Epi::PERM ? ((R & ~31) + perm32(R & 31)) : R;
        voffA[i] = (unsigned)(R * K + C) * 2u; voffB[i] = (unsigned)(Rb * K + C) * 2u; }
    const size_t kstep = (size_t)(BK * 2);
    const size_t hstep = (size_t)HALF * K * 2;
    const size_t tstep = 2 * hstep;
    const unsigned ldsw = (unsigned)wid * 1024u;
    const int aoff = lds_byte(wr * 64 + fr, fq * 8), boff = lds_byte(wc * 32 + fr, fq * 8);
#define PG8_SA(b, h) (((b) * 2 + (h)) * HTB)
#define PG8_SB(b, h) ((4 + (b) * 2 + (h)) * HTB)
#define PG8_STAGE(bufoff, gbase, voff) do { _Pragma("unroll") for (int _i = 0; _i < 2; ++_i) \
        __builtin_amdgcn_global_load_lds((const unsigned*)((const char*)(gbase) + (voff)[_i]), (PG8_LAS unsigned*)(lds + (bufoff) + ldsw + _i * 8192), 16, 0, 0); } while (0)
#define PG8_LDA(dst, b, h) do { _Pragma("unroll") for (int m = 0; m < 4; ++m) _Pragma("unroll") for (int k = 0; k < 2; ++k) dst[m][k] = *(const PG8_LAS bf16x8*)(lds + PG8_SA(b, h) + aoff + m * 2048 + k * 1024); } while (0)
#define PG8_LDB(dst, b, h) do { _Pragma("unroll") for (int n = 0; n < 2; ++n) _Pragma("unroll") for (int k = 0; k < 2; ++k) dst[n][k] = *(const PG8_LAS bf16x8*)(lds + PG8_SB(b, h) + boff + n * 2048 + k * 1024); } while (0)
#define PG8_MMA(ai, bj, At, Bt) do { __builtin_amdgcn_s_setprio(1); _Pragma("unroll") for (int m = 0; m < 4; ++m) _Pragma("unroll") for (int n = 0; n < 2; ++n) _Pragma("unroll") for (int k = 0; k < 2; ++k) \
        acc[ai][bj][m][n] = __builtin_amdgcn_mfma_f32_16x16x32_bf16(Bt[n][k], At[m][k], acc[ai][bj][m][n], 0, 0, 0); __builtin_amdgcn_s_setprio(0); } while (0)
#define PG8_WAIT_V(n) asm volatile("s_waitcnt vmcnt(" #n ")" ::: "memory")
#define PG8_WAIT_L(n) asm volatile("s_waitcnt lgkmcnt(" #n ")" ::: "memory")
#define PG8_BAR __builtin_amdgcn_s_barrier()
#define PG8_SCHED __builtin_amdgcn_sched_barrier(0)
    Unit cur, nxt; int ui = 0;
    if (!S.next(0, cur)) return;
    f32x4 acc[2][2][4][2];
#pragma unroll
    for (int a = 0; a < 2; ++a)
#pragma unroll
        for (int b = 0; b < 2; ++b)
#pragma unroll
            for (int m = 0; m < 4; ++m)
#pragma unroll
                for (int n = 0; n < 2; ++n) acc[a][b][m][n] = (f32x4){0.f, 0.f, 0.f, 0.f};
    bf16x8 At[4][2], B0[2][2], B1[2][2];
    const char* cA = (const char*)g.A + (size_t)cur.pm * tstep; const char* cB = (const char*)g.Bt + (size_t)cur.pn * tstep;
    S.a_ready(cur);
    PG8_STAGE(PG8_SB(0, 0), cB, voffB); PG8_STAGE(PG8_SA(0, 0), cA, voffA); PG8_STAGE(PG8_SB(0, 1), cB + hstep, voffB); PG8_STAGE(PG8_SA(0, 1), cA + hstep, voffA);
    if (wr == 1) PG8_BAR;
    PG8_WAIT_V(4); PG8_BAR;
    PG8_STAGE(PG8_SB(1, 0), cB + kstep, voffB); PG8_STAGE(PG8_SA(1, 0), cA + kstep, voffA); PG8_STAGE(PG8_SB(1, 1), cB + hstep + kstep, voffB);
    PG8_WAIT_V(6); PG8_BAR;
    PG8_STAMP();
    for (;;) {
        const bool has_next = S.next(ui + 1, nxt);
        const char* nA = has_next ? (const char*)g.A + (size_t)nxt.pm * tstep : cA; const char* nB = has_next ? (const char*)g.Bt + (size_t)nxt.pn * tstep : cB;
        for (int t = 0; t < nt; t += 2) {
            const bool last = (t == nt - 2);
            const char* a1 = cA + (size_t)(t + 1) * kstep;
            const char* a2 = last ? nA : cA + (size_t)(t + 2) * kstep; const char* b2 = last ? nB : cB + (size_t)(t + 2) * kstep;
            const char* a3 = a2 + kstep; const char* b3 = b2 + kstep;
            if (last && has_next) S.a_ready(nxt);
            PG8_LDB(B0, 0, 0); PG8_SCHED; PG8_LDA(At, 0, 0); PG8_STAGE(PG8_SA(1, 1), a1 + hstep, voffA);
            PG8_WAIT_L(8); PG8_BAR; PG8_WAIT_L(0); PG8_MMA(0, 0, At, B0); PG8_BAR; PG8_SCHED;
            PG8_LDB(B1, 0, 1); PG8_STAGE(PG8_SB(0, 0), b2, voffB);
            PG8_BAR; PG8_WAIT_L(0); PG8_MMA(0, 1, At, B1); PG8_BAR;
            PG8_LDA(At, 0, 1); PG8_STAGE(PG8_SA(0, 0), a2, voffA);
            PG8_BAR; PG8_WAIT_L(0); PG8_MMA(1, 0, At, B0); PG8_BAR; PG8_SCHED;
            PG8_STAGE(PG8_SB(0, 1), b2 + hstep, voffB);
            PG8_WAIT_V(6); PG8_BAR; PG8_MMA(1, 1, At, B1); PG8_BAR;
            PG8_LDB(B0, 1, 0); PG8_SCHED; PG8_LDA(At, 1, 0); PG8_STAGE(PG8_SA(0, 1), a2 + hstep, voffA);
            PG8_WAIT_L(8); PG8_BAR; PG8_WAIT_L(0); PG8_MMA(0, 0, At, B0); PG8_BAR; PG8_SCHED;
            PG8_LDB(B1, 1, 1); PG8_STAGE(PG8_SB(1, 0), b3, voffB);
            PG8_BAR; PG8_WAIT_L(0); PG8_MMA(0, 1, At, B1); PG8_BAR;
            PG8_LDA(At, 1, 1); PG8_STAGE(PG8_SA(1, 0), a3, voffA);
            PG8_BAR; PG8_WAIT_L(0); PG8_MMA(1, 0, At, B0); PG8_BAR; PG8_SCHED;
            PG8_STAGE(PG8_SB(1, 1), b3 + hstep, voffB);
            PG8_WAIT_V(6); PG8_BAR; PG8_MMA(1, 1, At, B1); PG8_BAR;
        }
        PG8_STAMP();
        if constexpr (!Epi::AFTER_DRAIN) { E(acc, cur, wr, wc, fr, fq); S.done(cur); }
        PG8_STAMP();
        if (!has_next) break;
#pragma unroll
        for (int a = 0; a < 2; ++a)
#pragma unroll
            for (int b = 0; b < 2; ++b)
#pragma unroll
                for (int m = 0; m < 4; ++m)
#pragma unroll
                    for (int n = 0; n < 2; ++n) acc[a][b][m][n] = (f32x4){0.f, 0.f, 0.f, 0.f};
        cur = nxt; cA = nA; cB = nB; ++ui;
    }
    PG8_WAIT_V(0);
    if (wr == 0) PG8_BAR;
    PG8_BAR;
    if constexpr (Epi::AFTER_DRAIN) { E.fused(acc, cur, wr, wc, fr, fq, lds, wid, lane); S.done(cur); }
    PG8_STAMP();
    if (STAMP && wid == 0) { stamps[lane] = lane < nts ? (((unsigned long long)(unsigned)ts_hi << 32) | (unsigned)ts_lo) : 0ull;
        if (lane == 62) stamps[62] = rt_entry; if (lane == 63) stamps[63] = (unsigned long long)wall_clock64(); }
#undef PG8_STAMP
#undef PG8_SA
#undef PG8_SB
#undef PG8_STAGE
#undef PG8_LDA
#undef PG8_LDB
#undef PG8_MMA
#undef PG8_WAIT_V
#undef PG8_WAIT_L
#undef PG8_BAR
#undef PG8_SCHED
}
}


__device__ __forceinline__ u16 f2bf(float f) {
  unsigned u = __float_as_uint(f);
  u += 0x7fffu + ((u >> 16) & 1u);
  return (u16)(u >> 16);
}
__device__ __forceinline__ float bf2f(u16 h) { return __uint_as_float(((unsigned)h) << 16); }
__device__ __forceinline__ unsigned pack2(float a, float b) { return (unsigned)f2bf(a) | ((unsigned)f2bf(b) << 16); }
__device__ __forceinline__ void unpack8(const uint4 v, float (&f)[8]) {
  f[0] = bf2f((u16)(v.x & 0xffff)); f[1] = bf2f((u16)(v.x >> 16)); f[2] = bf2f((u16)(v.y & 0xffff)); f[3] = bf2f((u16)(v.y >> 16));
  f[4] = bf2f((u16)(v.z & 0xffff)); f[5] = bf2f((u16)(v.z >> 16)); f[6] = bf2f((u16)(v.w & 0xffff)); f[7] = bf2f((u16)(v.w >> 16));
}
__device__ __forceinline__ uint4 pack8s(const float (&f)[8], float sc) {
  return make_uint4(pack2(f[0] * sc, f[1] * sc), pack2(f[2] * sc, f[3] * sc), pack2(f[4] * sc, f[5] * sc), pack2(f[6] * sc, f[7] * sc));
}
__device__ __forceinline__ float silu_f(float x) { return x / (1.f + __expf(-x)); }
__device__ __forceinline__ float sigm(float x) { return 1.f / (1.f + __expf(-x)); }
__device__ __forceinline__ float wave_sum(float v) {
#pragma unroll
  for (int o = 32; o; o >>= 1) v += __shfl_xor(v, o);
  return v;
}
__device__ __forceinline__ const float* xin_of(const Params& P, int slab) { return slab == 0 ? P.in[0] : P.in[1] + (long)(slab - 1) * SLAB * D; }
__device__ __forceinline__ int Lof(int slab) { return slab == 0 ? 2048 : 8192; }
__device__ __forceinline__ int gb_row(int gr) { return gr < 16384 ? (gr >> 11) : (8 + ((gr - 16384) >> 13)); }
__device__ __forceinline__ int gb_of(int slab, int r) { return slab == 0 ? (r >> 11) : (8 + (slab - 1) * 2 + (r >> 13)); }

typedef short v4s __attribute__((ext_vector_type(4)));
#define LBAR() asm volatile("s_waitcnt lgkmcnt(0)\n\ts_barrier" ::: "memory")
#define LDS_AS __attribute__((address_space(3)))
template <int R, bool KC>
__device__ __forceinline__ uint4 ld_chunk(const u16* __restrict__ base, long ld, int k0, int c) {
  if (KC) {
    const int r = c >> 3, kc = c & 7;
    return *(const uint4*)(base + (long)r * ld + k0 + kc * 8);
  } else {
    const int k = c / (R / 8), mc = c % (R / 8);
    return *(const uint4*)(base + (long)(k0 + k) * ld + mc * 8);
  }
}
template <int R, bool KC>
__device__ __forceinline__ void st_chunk(u16* s, uint4 v, int c) {
  if (KC) {
    const int r = c >> 3, kc = c & 7;
    *(uint4*)(s + r * 72 + kc * 8) = v;
  } else {
    const int k = c / (R / 8), mc = c % (R / 8);
    *(uint4*)(s + k * (R + 8) + mc * 8) = v;
  }
}
template <int R, bool KC>
__device__ __forceinline__ bf16x8 ld_frag(const u16* s, int x0, int ks, int fr, int fq) {
  if (KC) {
    return *(const bf16x8*)(s + (x0 + fr) * 72 + ks * 32 + fq * 8);
  } else {
    const int q4 = fr >> 2, p4 = fr & 3;
    const u16* p = s + (ks * 32 + 8 * fq + q4) * (R + 8) + x0 + 4 * p4;
    v4s lo = __builtin_amdgcn_ds_read_tr16_b64_v4i16((LDS_AS v4s*)p);
    v4s hi = __builtin_amdgcn_ds_read_tr16_b64_v4i16((LDS_AS v4s*)(p + 4 * (R + 8)));
    bf16x8 r;
    r[0] = lo[0]; r[1] = lo[1]; r[2] = lo[2]; r[3] = lo[3]; r[4] = hi[0]; r[5] = hi[1]; r[6] = hi[2]; r[7] = hi[3];
    return r;
  }
}

template <int TM, int TN, bool AKC, bool BKC, bool TR, int KT>
__device__ __forceinline__ void gemm_acc(f32x4 (&acc)[TM / 32][TN / 64], const u16* __restrict__ A, long lda,
                                         const u16* __restrict__ B, long ldb, u16* sm) {
  u16* As = sm;
  u16* Bs = sm + 9216;
  const int tid = TID(), lane = tid & 63, wid = tid >> 6;
  const int wm = wid >> 2, wn = wid & 3, fr = lane & 15, fq = lane >> 4;
  constexpr int MI = TM / 32, NI = TN / 64;
  uint4 ra0[KT], ra1[KT], rb0[KT], rb1[KT];
#pragma unroll
  for (int kt = 0; kt < KT; ++kt) {
    ra0[kt] = ld_chunk<TM, AKC>(A, lda, kt * 64, tid);
    ra1[kt] = ra0[kt];
    if (TM == 128) ra1[kt] = ld_chunk<TM, AKC>(A, lda, kt * 64, tid + NT);
    rb0[kt] = ld_chunk<TN, BKC>(B, ldb, kt * 64, tid);
    rb1[kt] = rb0[kt];
    if (TN == 128) rb1[kt] = ld_chunk<TN, BKC>(B, ldb, kt * 64, tid + NT);
  }
  __syncthreads();
  st_chunk<TM, AKC>(As, ra0[0], tid);
  if (TM == 128) st_chunk<TM, AKC>(As, ra1[0], tid + NT);
  st_chunk<TN, BKC>(Bs, rb0[0], tid);
  if (TN == 128) st_chunk<TN, BKC>(Bs, rb1[0], tid + NT);
  __syncthreads();
#pragma unroll
  for (int kt = 0; kt < KT; ++kt) {
    u16* Ac = As + (kt & 1) * 18432;
    u16* Bc = Bs + (kt & 1) * 18432;
    if (kt + 1 < KT) {
      u16* An = As + ((kt + 1) & 1) * 18432;
      u16* Bn = Bs + ((kt + 1) & 1) * 18432;
      st_chunk<TM, AKC>(An, ra0[kt + 1 < KT ? kt + 1 : 0], tid);
      if (TM == 128) st_chunk<TM, AKC>(An, ra1[kt + 1 < KT ? kt + 1 : 0], tid + NT);
      st_chunk<TN, BKC>(Bn, rb0[kt + 1 < KT ? kt + 1 : 0], tid);
      if (TN == 128) st_chunk<TN, BKC>(Bn, rb1[kt + 1 < KT ? kt + 1 : 0], tid + NT);
    }
#pragma unroll
    for (int ks = 0; ks < 2; ++ks) {
      bf16x8 af[MI], bfr[NI];
#pragma unroll
      for (int mi = 0; mi < MI; ++mi) af[mi] = ld_frag<TM, AKC>(Ac, wm * (TM / 2) + mi * 16, ks, fr, fq);
#pragma unroll
      for (int ni = 0; ni < NI; ++ni) bfr[ni] = ld_frag<TN, BKC>(Bc, wn * (TN / 4) + ni * 16, ks, fr, fq);
#pragma unroll
      for (int mi = 0; mi < MI; ++mi)
#pragma unroll
        for (int ni = 0; ni < NI; ++ni)
          acc[mi][ni] = TR ? __builtin_amdgcn_mfma_f32_16x16x32_bf16(bfr[ni], af[mi], acc[mi][ni], 0, 0, 0)
                           : __builtin_amdgcn_mfma_f32_16x16x32_bf16(af[mi], bfr[ni], acc[mi][ni], 0, 0, 0);
    }
    __syncthreads();
  }
}

template <int KT> struct Tiles { uint4 a0[KT], a1[KT], b0[KT], b1[KT]; };
template <int TM, int TN, bool AKC, bool BKC, int KT>
__device__ __forceinline__ void tiles_issue(Tiles<KT>& t, const u16* __restrict__ A, long lda, const u16* __restrict__ B, long ldb) {
  const int tid = TID();
#pragma unroll
  for (int kt = 0; kt < KT; ++kt) {
    t.a0[kt] = ld_chunk<TM, AKC>(A, lda, kt * 64, tid);
    t.a1[kt] = t.a0[kt];
    if (TM == 128) t.a1[kt] = ld_chunk<TM, AKC>(A, lda, kt * 64, tid + NT);
    t.b0[kt] = ld_chunk<TN, BKC>(B, ldb, kt * 64, tid);
    t.b1[kt] = t.b0[kt];
    if (TN == 128) t.b1[kt] = ld_chunk<TN, BKC>(B, ldb, kt * 64, tid + NT);
  }
}
template <int TM, int TN, bool AKC, bool BKC, bool TR, int KT>
__device__ __forceinline__ void gemm_run(f32x4 (&acc)[TM / 32][TN / 64], const Tiles<KT>& t, u16* sm) {
  u16* As = sm;
  u16* Bs = sm + 9216;
  const int tid = TID(), lane = tid & 63, wid = tid >> 6;
  const int wm = wid >> 2, wn = wid & 3, fr = lane & 15, fq = lane >> 4;
  constexpr int MI = TM / 32, NI = TN / 64;
  __syncthreads();
  st_chunk<TM, AKC>(As, t.a0[0], tid);
  if (TM == 128) st_chunk<TM, AKC>(As, t.a1[0], tid + NT);
  st_chunk<TN, BKC>(Bs, t.b0[0], tid);
  if (TN == 128) st_chunk<TN, BKC>(Bs, t.b1[0], tid + NT);
  __syncthreads();
#pragma unroll
  for (int kt = 0; kt < KT; ++kt) {
    u16* Ac = As + (kt & 1) * 18432;
    u16* Bc = Bs + (kt & 1) * 18432;
    if (kt + 1 < KT) {
      u16* An = As + ((kt + 1) & 1) * 18432;
      u16* Bn = Bs + ((kt + 1) & 1) * 18432;
      st_chunk<TM, AKC>(An, t.a0[kt + 1 < KT ? kt + 1 : 0], tid);
      if (TM == 128) st_chunk<TM, AKC>(An, t.a1[kt + 1 < KT ? kt + 1 : 0], tid + NT);
      st_chunk<TN, BKC>(Bn, t.b0[kt + 1 < KT ? kt + 1 : 0], tid);
      if (TN == 128) st_chunk<TN, BKC>(Bn, t.b1[kt + 1 < KT ? kt + 1 : 0], tid + NT);
    }
#pragma unroll
    for (int ks = 0; ks < 2; ++ks) {
      bf16x8 af[MI], bfr[NI];
#pragma unroll
      for (int mi = 0; mi < MI; ++mi) af[mi] = ld_frag<TM, AKC>(Ac, wm * (TM / 2) + mi * 16, ks, fr, fq);
#pragma unroll
      for (int ni = 0; ni < NI; ++ni) bfr[ni] = ld_frag<TN, BKC>(Bc, wn * (TN / 4) + ni * 16, ks, fr, fq);
#pragma unroll
      for (int mi = 0; mi < MI; ++mi)
#pragma unroll
        for (int ni = 0; ni < NI; ++ni)
          acc[mi][ni] = TR ? __builtin_amdgcn_mfma_f32_16x16x32_bf16(bfr[ni], af[mi], acc[mi][ni], 0, 0, 0)
                           : __builtin_amdgcn_mfma_f32_16x16x32_bf16(af[mi], bfr[ni], acc[mi][ni], 0, 0, 0);
    }
    __syncthreads();
  }
}

template <int TM, int TN, bool TR, class F>
__device__ __forceinline__ void epi_each(f32x4 (&acc)[TM / 32][TN / 64], F f) {
  const int tid = TID(), lane = tid & 63, wid = tid >> 6;
  const int wm = wid >> 2, wn = wid & 3, fr = lane & 15, fq = lane >> 4;
#pragma unroll
  for (int mi = 0; mi < TM / 32; ++mi)
#pragma unroll
    for (int ni = 0; ni < TN / 64; ++ni) {
      const int r0 = wm * (TM / 2) + mi * 16, c0 = wn * (TN / 4) + ni * 16;
      if (TR) f(r0 + fr, c0 + fq * 4, acc[mi][ni]);
      else f(r0 + fq * 4, c0 + fr, acc[mi][ni]);
    }
}

struct EpiStoreBf16 {
  static constexpr bool PERM = true, AFTER_DRAIN = false;
  u16* O; int ldc;
  __device__ __forceinline__ void operator()(const f32x4 (&acc)[2][2][4][2], const pg8::Unit& u, int wr, int wc, int fr, int fq) const {
    const int row0 = u.pm * 256 + wr * 64 + fr, col0 = u.pn * 256 + wc * 32 + 8 * fq;
#pragma unroll
    for (int ai = 0; ai < 2; ++ai)
#pragma unroll
      for (int m = 0; m < 4; ++m) {
        u16* rowp = O + (size_t)(row0 + ai * 128 + m * 16) * ldc + col0;
#pragma unroll
        for (int bj = 0; bj < 2; ++bj) {
          const f32x4 v0 = acc[ai][bj][m][0], v1 = acc[ai][bj][m][1];
          *(uint4*)(rowp + bj * 128) = make_uint4(pack2(v0[0], v0[1]), pack2(v0[2], v0[3]), pack2(v1[0], v1[1]), pack2(v1[2], v1[3]));
        }
      }
  }
};
struct EpiResid {
  static constexpr bool PERM = false, AFTER_DRAIN = false;
  float* X; const float* XS; const float* mod; int goff; int grow0;
  __device__ __forceinline__ void operator()(const f32x4 (&acc)[2][2][4][2], const pg8::Unit& u, int wr, int wc, int fr, int fq) const {
    const int row0 = u.pm * 256 + wr * 64 + fr, col0 = u.pn * 256 + wc * 32 + 4 * fq;
    const float* g = mod + (size_t)gb_row(grow0 + u.pm * 256) * 6144 + goff + col0;
    f32x4 gv[2][2];
#pragma unroll
    for (int bj = 0; bj < 2; ++bj)
#pragma unroll
      for (int n = 0; n < 2; ++n) gv[bj][n] = *(const f32x4*)(g + bj * 128 + n * 16);
#pragma unroll
    for (int am = 0; am < 4; ++am) {
      f32x4 xv[2][2][2];
#pragma unroll
      for (int mm = 0; mm < 2; ++mm)
#pragma unroll
        for (int bj = 0; bj < 2; ++bj)
#pragma unroll
          for (int n = 0; n < 2; ++n) xv[mm][bj][n] = *(const f32x4*)(XS + (size_t)(row0 + (am >> 1) * 128 + ((am & 1) * 2 + mm) * 16) * D + col0 + bj * 128 + n * 16);
#pragma unroll
      for (int mm = 0; mm < 2; ++mm)
#pragma unroll
        for (int bj = 0; bj < 2; ++bj)
#pragma unroll
          for (int n = 0; n < 2; ++n)
            *(f32x4*)(X + (size_t)(row0 + (am >> 1) * 128 + ((am & 1) * 2 + mm) * 16) * D + col0 + bj * 128 + n * 16) = xv[mm][bj][n] + gv[bj][n] * acc[am >> 1][bj][(am & 1) * 2 + mm][n];
    }
  }
};
struct EpiFfnVal {
  static constexpr bool PERM = false, AFTER_DRAIN = false;
  const u16* G; u16* ACT; const float* cw; const float* cb; int grow0;
  __device__ __forceinline__ void operator()(const f32x4 (&acc)[2][2][4][2], const pg8::Unit& u, int wr, int wc, int fr, int fq) const {
    const int row0 = u.pm * 256 + wr * 64 + fr, col0 = u.pn * 256 + wc * 32 + 4 * fq;
#pragma unroll
    for (int bj = 0; bj < 2; ++bj)
#pragma unroll
      for (int n = 0; n < 2; ++n) {
        const int c = col0 + bj * 128 + n * 16;
        const f32x4 w0 = *(const f32x4*)(cw + c), w1 = *(const f32x4*)(cw + DFF + c), w2 = *(const f32x4*)(cw + 2 * DFF + c), bb = *(const f32x4*)(cb + c);
#pragma unroll
        for (int ai = 0; ai < 2; ++ai) {
          uint2 g0[4], g1[4], g2[4];
#pragma unroll
          for (int m = 0; m < 4; ++m) {
            const int r = row0 + ai * 128 + m * 16;
            const int L = (grow0 + r) < 16384 ? 2048 : 8192;
            const int pos = (grow0 + r) & (L - 1);
            const u16* gp = G + (size_t)r * DFF + c;
            g1[m] = *(const uint2*)gp;
            g0[m] = *(const uint2*)(gp - (pos > 0 ? DFF : 0));
            g2[m] = *(const uint2*)(gp + (pos < L - 1 ? DFF : 0));
          }
#pragma unroll
          for (int m = 0; m < 4; ++m) {
            const int r = row0 + ai * 128 + m * 16;
            const int L = (grow0 + r) < 16384 ? 2048 : 8192;
            const int pos = (grow0 + r) & (L - 1);
            const float m0 = pos > 0 ? 1.f : 0.f, m2 = pos < L - 1 ? 1.f : 0.f;
            const uint2 a0 = g0[m], a1 = g1[m], a2 = g2[m];
            f32x4 a;
            a[0] = m0 * bf2f((u16)(a0.x & 0xffff)) * w0[0] + bf2f((u16)(a1.x & 0xffff)) * w1[0] + m2 * bf2f((u16)(a2.x & 0xffff)) * w2[0] + bb[0];
            a[1] = m0 * bf2f((u16)(a0.x >> 16)) * w0[1] + bf2f((u16)(a1.x >> 16)) * w1[1] + m2 * bf2f((u16)(a2.x >> 16)) * w2[1] + bb[1];
            a[2] = m0 * bf2f((u16)(a0.y & 0xffff)) * w0[2] + bf2f((u16)(a1.y & 0xffff)) * w1[2] + m2 * bf2f((u16)(a2.y & 0xffff)) * w2[2] + bb[2];
            a[3] = m0 * bf2f((u16)(a0.y >> 16)) * w0[3] + bf2f((u16)(a1.y >> 16)) * w1[3] + m2 * bf2f((u16)(a2.y >> 16)) * w2[3] + bb[3];
            const f32x4 v = acc[ai][bj][m][n];
            *(uint2*)(ACT + (size_t)r * DFF + c) = make_uint2(pack2(silu_f(a[0]) * v[0], silu_f(a[1]) * v[1]), pack2(silu_f(a[2]) * v[2], silu_f(a[3]) * v[3]));
          }
        }
      }
  }
};
template <class Epi>
__device__ __forceinline__ void run_gemm(const u16* A, const u16* Bt, int M, int N, int K, const Epi& E) {
  pg8::Gemm g; g.A = A; g.Bt = Bt; g.M = M; g.N = N; g.K = K;
  pg8::StaticOrder S; S.init(M, N, gridDim.x, BID());
  __syncthreads();
  pg8::gemm_phase<Epi, pg8::StaticOrder, false>((PG8_LAS unsigned char*)smem, g, S, E, nullptr);
  __syncthreads();
}

__device__ __forceinline__ int fidx(int p) { return p + ((p >> 6) << 2); }
__device__ __forceinline__ float2 cmulf(float2 a, float2 b) { return make_float2(a.x * b.x - a.y * b.y, a.x * b.y + a.y * b.x); }
__device__ __forceinline__ float2 cmulcf(float2 a, float2 b) { return make_float2(a.x * b.x + a.y * b.y, a.y * b.x - a.x * b.y); }
#define R16C(q) ((q) == 0 ? 1.f : (q) == 1 ? 0.9238795325f : (q) == 2 ? 0.7071067812f : (q) == 3 ? 0.3826834324f : (q) == 4 ? 0.f : (q) == 5 ? -0.3826834324f : (q) == 6 ? -0.7071067812f : -0.9238795325f)
#define R16S(q) ((q) == 0 ? 0.f : (q) == 1 ? -0.3826834324f : (q) == 2 ? -0.7071067812f : (q) == 3 ? -0.9238795325f : (q) == 4 ? -1.f : (q) == 5 ? -0.9238795325f : (q) == 6 ? -0.7071067812f : -0.3826834324f)
template <int N, int RS, bool INV>
__device__ __forceinline__ void fft_pass(float2* x, const float2* __restrict__ tw, const int S, const int tid) {
  constexpr int R = 1 << RS;
  const int E = S >> (RS - 1);
#pragma unroll 1
  for (int g = tid; g < N / R; g += NT) {
    const int blo = g & (E - 1);
    const int base = ((g - blo) << RS) + blo;
    float2 e[R];
#pragma unroll
    for (int k = 0; k < R; ++k) e[k] = x[fidx(base + k * E)];
    float2 wb[RS];
#pragma unroll
    for (int st = 0; st < RS; ++st) wb[st] = tw[blo * (8192 / (S >> st))];
#pragma unroll
    for (int sq = 0; sq < RS; ++sq) {
      const int st = INV ? (RS - 1 - sq) : sq;
      const int h = (R / 2) >> st;
#pragma unroll
      for (int k = 0; k < R; ++k) {
        if ((k & h) == 0) {
          const int m = k & (h - 1);
          const int q = m * (8 / h);
          float2 w = wb[st];
          if (q != 0) w = cmulf(w, make_float2(R16C(q), R16S(q)));
          if (!INV) {
            const float2 a = e[k], b = e[k + h];
            e[k] = make_float2(a.x + b.x, a.y + b.y);
            e[k + h] = cmulf(make_float2(a.x - b.x, a.y - b.y), w);
          } else {
            const float2 a = e[k], b = cmulcf(e[k + h], w);
            e[k] = make_float2(a.x + b.x, a.y + b.y);
            e[k + h] = make_float2(a.x - b.x, a.y - b.y);
          }
        }
      }
    }
#pragma unroll
    for (int k = 0; k < R; ++k) x[fidx(base + k * E)] = e[k];
  }
  __syncthreads();
}
template <int N>
__device__ __forceinline__ void fft_dif_t(float2* x, const float2* __restrict__ tw) {
  const int tid = TID();
  if (N == 16384) {
    fft_pass<N, 4, false>(x, tw, 8192, tid); fft_pass<N, 4, false>(x, tw, 512, tid);
    fft_pass<N, 4, false>(x, tw, 32, tid); fft_pass<N, 2, false>(x, tw, 2, tid);
  } else {
    fft_pass<N, 4, false>(x, tw, 2048, tid); fft_pass<N, 4, false>(x, tw, 128, tid); fft_pass<N, 4, false>(x, tw, 8, tid);
  }
}
template <int N>
__device__ __forceinline__ void ifft_dit_t(float2* x, const float2* __restrict__ tw) {
  const int tid = TID();
  if (N == 16384) {
    fft_pass<N, 2, true>(x, tw, 2, tid); fft_pass<N, 4, true>(x, tw, 32, tid);
    fft_pass<N, 4, true>(x, tw, 512, tid); fft_pass<N, 4, true>(x, tw, 8192, tid);
  } else {
    fft_pass<N, 4, true>(x, tw, 8, tid); fft_pass<N, 4, true>(x, tw, 128, tid); fft_pass<N, 4, true>(x, tw, 2048, tid);
  }
}
__device__ __forceinline__ void fft_dif(float2* x, int N, const float2* __restrict__ tw) {
  if (N == 16384) fft_dif_t<16384>(x, tw); else fft_dif_t<4096>(x, tw);
}
__device__ __forceinline__ void ifft_dit(float2* x, int N, const float2* __restrict__ tw) {
  if (N == 16384) ifft_dit_t<16384>(x, tw); else ifft_dit_t<4096>(x, tw);
}

__device__ void transpose_w(const float* __restrict__ W, u16* __restrict__ Wt, int K, int N) {
  float* smf = (float*)smem;
  const int tk = K / 64, tn = N / 64, tid = TID(), G = gridDim.x;
  const int kk0 = tid >> 4, n40 = tid & 15, kk1 = (tid + NT) >> 4, n41 = (tid + NT) & 15;
  int item = BID();
  float4 v0 = make_float4(0, 0, 0, 0), v1 = v0;
  if (item < tk * tn) {
    const int k0 = (item / tn) * 64, n0 = (item % tn) * 64;
    v0 = *(const float4*)(W + (long)(k0 + kk0) * N + n0 + n40 * 4);
    v1 = *(const float4*)(W + (long)(k0 + kk1) * N + n0 + n41 * 4);
  }
  for (; item < tk * tn; item += G) {
    const int k0 = (item / tn) * 64, n0 = (item % tn) * 64;
    float4 w0 = v0, w1 = v1;
    const int nx = item + G;
    if (nx < tk * tn) {
      const int k2 = (nx / tn) * 64, n2 = (nx % tn) * 64;
      w0 = *(const float4*)(W + (long)(k2 + kk0) * N + n2 + n40 * 4);
      w1 = *(const float4*)(W + (long)(k2 + kk1) * N + n2 + n41 * 4);
    }
    __syncthreads();
    { float* p = smf + kk0 * 65 + n40 * 4; p[0] = v0.x; p[1] = v0.y; p[2] = v0.z; p[3] = v0.w; }
    { float* p = smf + kk1 * 65 + n41 * 4; p[0] = v1.x; p[1] = v1.y; p[2] = v1.z; p[3] = v1.w; }
    __syncthreads();
    const int nn = tid >> 3, k8 = tid & 7;
    float f[8];
#pragma unroll
    for (int i = 0; i < 8; ++i) f[i] = smf[(k8 * 8 + i) * 65 + nn];
    *(uint4*)(Wt + (long)(n0 + nn) * K + k0 + k8 * 8) = pack8s(f, 1.f);
    v0 = w0; v1 = w1;
  }
  __syncthreads();
}

__device__ void phase_pre0(const Params& P) {
  const int tid = TID();
  const long gtid = (long)BID() * NT + tid, gsz = (long)gridDim.x * NT;
  transpose_w(P.in[7], (u16*)(WS(P) + O_WHYIN), 1024, 3072);
  transpose_w(P.in[18], (u16*)(WS(P) + O_WHYOUT), 1024, 1024);
  transpose_w(P.in[19], (u16*)(WS(P) + O_WRETIN), 1024, 6144);
  transpose_w(P.in[21], (u16*)(WS(P) + O_WRETOUT), 2048, 1024);
  transpose_w(P.in[22], (u16*)(WS(P) + O_WSWAIN), 1024, 1536);
  transpose_w(P.in[26], (u16*)(WS(P) + O_WSWAOUT), 1024, 1024);
  transpose_w(P.in[27], (u16*)(WS(P) + O_WHGIN), 1024, 5120);
  transpose_w(P.in[30], (u16*)(WS(P) + O_WHGOUT), 1024, 1024);
  for (int l = 0; l < 4; ++l) {
    transpose_w(P.in[31] + (long)l * 1024 * DFF, (u16*)(WS(P) + O_WFG) + (long)l * DFF * 1024, 1024, DFF);
    transpose_w(P.in[32] + (long)l * 1024 * DFF, (u16*)(WS(P) + O_WFV) + (long)l * DFF * 1024, 1024, DFF);
    transpose_w(P.in[35] + (long)l * DFF * 1024, (u16*)(WS(P) + O_WFD) + (long)l * 1024 * DFF, DFF, 1024);
  }
  {
    float* cs = (float*)smem;
    float* modp = (float*)(WS(P) + O_MODP);
    for (int item = BID(); item < 4 * 8 * 12; item += gridDim.x) {
      const int nb = item % 12, ks = (item / 12) % 8, l = item / 96;
      __syncthreads();
      for (int i = tid; i < 2048; i += NT) {
        int b = i >> 7, k = i & 127;
        float c = (b < 8) ? P.in[2][b * 1024 + ks * 128 + k] : P.in[3][(b - 8) * 1024 + ks * 128 + k];
        cs[i] = c / (1.f + expf(-c));
      }
      __syncthreads();
      const int n = nb * 512 + tid;
      float a[16];
#pragma unroll
      for (int b = 0; b < 16; ++b) a[b] = 0.f;
      const float* w = P.in[4] + ((long)l * 1024 + ks * 128) * 6144 + n;
      for (int k = 0; k < 128; ++k) {
        float wv = w[(long)k * 6144];
#pragma unroll
        for (int b = 0; b < 16; ++b) a[b] += cs[b * 128 + k] * wv;
      }
#pragma unroll
      for (int b = 0; b < 16; ++b) modp[(((long)ks * 4 + l) * 16 + b) * 6144 + n] = a[b];
    }
    __syncthreads();
  }
  {
    float2* tw = (float2*)(WS(P) + O_TW);
    for (long i = gtid; i < 8192; i += gsz) {
      float s, c;
      sincospif((float)i * (1.f / 8192.f), &s, &c);
      tw[i] = make_float2(c, -s);
    }
    float2* rr = (float2*)(WS(P) + O_ROPER);
    for (long i = gtid; i < (long)8192 * 128; i += gsz) {
      int pos = (int)(i >> 7), d = (int)(i & 127);
      float inv = exp2f(-(float)d * (13.287712379549449f / 128.f));
      float s, c;
      sincosf((float)pos * inv, &s, &c);
      rr[i] = make_float2(c, s);
    }
    float2* rs = (float2*)(WS(P) + O_ROPES);
    for (long i = gtid; i < (long)8192 * 32; i += gsz) {
      int pos = (int)(i >> 5), d = (int)(i & 31);
      float inv = exp2f(-(float)d * (13.287712379549449f / 32.f));
      float s, c;
      sincosf((float)pos * inv, &s, &c);
      rs[i] = make_float2(c, s);
    }
  }
  {
    float* zf = (float*)smem;
    float* h1 = zf + 8 * 36;
    const float* w1 = P.in[10]; const float* b1 = P.in[11]; const float* w2 = P.in[12]; const float* b2 = P.in[13];
    const float* fr = P.in[15];
    const int tl = tid >> 6, j = tid & 63;
    for (int item = BID(); item < 1280; item += gridDim.x) {
      const int sel = item >= 1024;
      const int L = sel ? 2048 : 8192;
      const int t = (sel ? item - 1024 : item) * 8 + tl;
      float* hid = (float*)(WS(P) + (sel ? O_HIDP : O_HIDS));
      __syncthreads();
      if (j < 33) {
        float v;
        if (j == 0) v = (float)t / (float)(L - 1);
        else {
          int i = (j - 1) & 15;
          float band = 1e-4f + (float)i * ((15.f - 1e-4f) / 15.f);
          float ang = (6.283185307179586f / (float)L) * (float)t;
          float a = band * ang;
          v = (j <= 16) ? cosf(a) : -sinf(a);
        }
        zf[tl * 36 + j] = v;
      }
      __syncthreads();
      float s = b1[j];
#pragma unroll 3
      for (int i = 0; i < 33; ++i) s += zf[tl * 36 + i] * w1[i * 64 + j];
      h1[tl * 64 + j] = sinf(fr[j] * s);
      __syncthreads();
      float s2 = b2[j];
#pragma unroll 4
      for (int i = 0; i < 64; ++i) s2 += h1[tl * 64 + i] * w2[i * 64 + j];
      hid[(long)j * L + t] = sinf(fr[j] * s2);
    }
    __syncthreads();
  }
}

__device__ void phase_pre1(const Params& P) {
  __shared__ float w3s[128];
  __shared__ float red[8];
  const int tid = TID(), lane = tid & 63, wid = tid >> 6;
  const long gtid = (long)BID() * NT + tid, gsz = (long)gridDim.x * NT;
  {
    const float* modp = (const float*)(WS(P) + O_MODP);
    float* mod = (float*)(WS(P) + O_MOD);
    for (long i = gtid; i < (long)4 * 16 * 6144; i += gsz) {
      int n = (int)(i % 6144);
      int l = (int)(i / (16 * 6144));
      float s = P.in[5][l * 6144 + n];
      for (int ks = 0; ks < 8; ++ks) s += modp[(long)ks * 4 * 16 * 6144 + i];
      mod[i] = s;
    }
  }
  float2* buf = (float2*)smem;
  const float2* tw = (const float2*)(WS(P) + O_TW);
  for (int item = BID(); item < 2048; item += gridDim.x) {
    const int sel = item >> 10, c = item & 1023;
    const int L = sel ? 2048 : 8192, N = 2 * L;
    const float* hid = (const float*)(WS(P) + (sel ? O_HIDP : O_HIDS));
    float2* hs = (float2*)(WS(P) + (sel ? O_HSPP : O_HSPS)) + (long)c * N;
    __syncthreads();
    if (tid < 128) {
      int dirn = tid >> 6, j = tid & 63;
      w3s[tid] = P.in[14][(long)j * 2048 + dirn * 1024 + c];
    }
    __syncthreads();
    const float dec0 = fabsf(P.in[16][c]), dec1 = fabsf(P.in[16][1024 + c]);
    const float invLm1 = 1.f / (float)(L - 1);
    float asum = 0.f;
    for (int n = tid; n < N; n += NT) {
      float val = 0.f;
      if (n != L) {
        const int dirn = n < L ? 0 : 1;
        const int t = n < L ? n : N - n;
        const float* hp = hid + t;
        const float* w = w3s + dirn * 64;
        float s = 0.f;
#pragma unroll 16
        for (int j = 0; j < 64; ++j) s += hp[(long)j * L] * w[j];
        float tl = (float)t * invLm1;
        val = s * expf(-tl * (dirn ? dec1 : dec0));
      }
      buf[fidx(n)] = make_float2(val, 0.f);
      asum += fabsf(val);
    }
    asum = wave_sum(asum);
    if (lane == 0) red[wid] = asum;
    __syncthreads();
    float tot = 0.f;
#pragma unroll
    for (int w = 0; w < 8; ++w) tot += red[w];
    const float scale = 1.f / (tot * (float)N);
    fft_dif(buf, N, tw);
    for (int p = tid; p < N; p += NT) {
      float2 a = buf[fidx(p)];
      hs[p] = make_float2(a.x * scale, a.y * scale);
    }
  }
  __syncthreads();
}

__device__ void phase_norm(const Params& P, int layer, int sl, int which) {
  const int grow0 = which == 1 ? sl * FSLAB : (which == 2 ? 0 : sl * SLAB), nrows = which == 1 ? FSLAB : (which == 2 ? NTOK : SLAB);
  const float* __restrict__ x = (layer == 0 && which == 0) ? xin_of(P, sl) : (const float*)(OUTP(P) + (long)grow0 * D);
  u16* __restrict__ h = (u16*)(WS(P) + (which == 1 ? O_FHBUF : (which == 2 ? O_SA_H : O_HBUF)));
  const float* gain = P.in[6] + (layer * 2 + (which == 1 ? 1 : 0)) * D;
  const float* mod = (const float*)(WS(P) + O_MOD) + (long)layer * 16 * 6144;
  const int shoff = which == 1 ? 3 * D : 0, scoff = which == 1 ? 4 * D : D;
  const int tid = TID(), lane = tid & 63, wid = tid >> 6;
  for (int item = BID(); item < nrows / 32; item += gridDim.x) {
    const int r0 = item * 32 + wid * 4;
    float4 v[4][4];
    float ss[4];
#pragma unroll
    for (int u = 0; u < 4; ++u) {
      const float* xr = x + (long)(r0 + u) * D;
      float a = 0.f;
#pragma unroll
      for (int i = 0; i < 4; ++i) {
        v[u][i] = *(const float4*)(xr + i * 256 + lane * 4);
        a += v[u][i].x * v[u][i].x + v[u][i].y * v[u][i].y + v[u][i].z * v[u][i].z + v[u][i].w * v[u][i].w;
      }
      ss[u] = a;
    }
    const float* m = mod + (long)gb_row(grow0 + r0) * 6144;
#pragma unroll
    for (int u = 0; u < 4; ++u) ss[u] = wave_sum(ss[u]);
#pragma unroll
    for (int i = 0; i < 4; ++i) {
      const int col = i * 256 + lane * 4;
      const float4 g = *(const float4*)(gain + col);
      const float4 sc = *(const float4*)(m + scoff + col);
      const float4 sh = *(const float4*)(m + shoff + col);
      const float a0 = g.x * (1.f + sc.x), a1 = g.y * (1.f + sc.y), a2 = g.z * (1.f + sc.z), a3 = g.w * (1.f + sc.w);
#pragma unroll
      for (int u = 0; u < 4; ++u) {
        const float rstd = rsqrtf(ss[u] * (1.f / 1024.f) + 1e-6f);
        const float y0 = v[u][i].x * rstd * a0 + sh.x, y1 = v[u][i].y * rstd * a1 + sh.y;
        const float y2 = v[u][i].z * rstd * a2 + sh.z, y3 = v[u][i].w * rstd * a3 + sh.w;
        *(uint2*)(h + (long)(r0 + u) * D + col) = make_uint2(pack2(y0, y1), pack2(y2, y3));
      }
    }
  }
}

__device__ void phase_proj(const Params& P, size_t woff, int N) {
  EpiStoreBf16 E; E.O = (u16*)(WS(P) + O_PROJ); E.ldc = N;
  run_gemm((const u16*)(WS(P) + O_HBUF), (const u16*)(WS(P) + woff), SLAB, N, D, E);
}
__device__ void phase_resid(const Params& P, int layer, int slab, const u16* A, int K, size_t woff, int goff) {
  EpiResid E; E.X = OUTP(P) + (long)slab * SLAB * D; E.XS = (layer == 0) ? xin_of(P, slab) : (const float*)E.X; E.mod = (const float*)(WS(P) + O_MOD) + (long)layer * 16 * 6144; E.goff = goff; E.grow0 = slab * SLAB;
  run_gemm(A, (const u16*)(WS(P) + woff), SLAB, D, K, E);
}

__device__ void phase_ffn_gate(const Params& P, int layer) {
  EpiStoreBf16 E; E.O = (u16*)(WS(P) + O_FGBUF); E.ldc = DFF;
  run_gemm((const u16*)(WS(P) + O_FHBUF), (const u16*)(WS(P) + O_WFG) + (long)layer * DFF * D, FSLAB, DFF, D, E);
}
__device__ void phase_ffn_val(const Params& P, int layer, int fs) {
  EpiFfnVal E; E.G = (const u16*)(WS(P) + O_FGBUF); E.ACT = (u16*)(WS(P) + O_FACT) + (long)fs * FSLAB * DFF;
  E.cw = P.in[33] + (long)layer * 3 * DFF; E.cb = P.in[34] + (long)layer * DFF; E.grow0 = fs * FSLAB;
  run_gemm((const u16*)(WS(P) + O_FHBUF), (const u16*)(WS(P) + O_WFV) + (long)layer * DFF * D, FSLAB, DFF, D, E);
}
__device__ void phase_ffn_down(const Params& P, int layer) {
  EpiResid E; E.X = OUTP(P); E.XS = E.X; E.mod = (const float*)(WS(P) + O_MOD) + (long)layer * 16 * 6144; E.goff = 5 * D; E.grow0 = 0;
  run_gemm((const u16*)(WS(P) + O_FACT), (const u16*)(WS(P) + O_WFD) + (long)layer * D * DFF, NTOK, D, DFF, E);
}

__device__ void phase_hy_conv(const Params& P, int slab) {
  const int L = Lof(slab), nseq = SLAB / L, tid = TID();
  const u16* __restrict__ z = (const u16*)(WS(P) + O_PROJ);
  float* __restrict__ uT = (float*)(WS(P) + O_UT);
  u16* __restrict__ x0c = (u16*)(WS(P) + O_X0C);
  const float* cw = P.in[8];
  const float* cb = P.in[9];
  float* tile = (float*)smem;
  const int ntt = L / 64;
  const int nitems = nseq * ntt * 16;
  const int tl = tid >> 3, cg = tid & 7;
  for (int item = BID(); item < nitems; item += gridDim.x) {
    const int ct = item % 16, tt = (item / 16) % ntt, seq = item / (16 * ntt);
    const int t = tt * 64 + tl, c0 = ct * 64 + cg * 8;
    const long row = (long)seq * L + t;
    const float mp = t > 0 ? 1.f : 0.f, mn = t < L - 1 ? 1.f : 0.f;
    const long rp = t > 0 ? row - 1 : row, rn = t < L - 1 ? row + 1 : row;
    float val[3][8];
#pragma unroll
    for (int q = 0; q < 3; ++q) {
      const int col = q * 1024 + c0;
      float a[8], b[8], c[8];
      unpack8(*(const uint4*)(z + rp * 3072 + col), a);
      unpack8(*(const uint4*)(z + row * 3072 + col), b);
      unpack8(*(const uint4*)(z + rn * 3072 + col), c);
      const float4 w0a = *(const float4*)(cw + col), w0b = *(const float4*)(cw + col + 4);
      const float4 w1a = *(const float4*)(cw + 3072 + col), w1b = *(const float4*)(cw + 3072 + col + 4);
      const float4 w2a = *(const float4*)(cw + 6144 + col), w2b = *(const float4*)(cw + 6144 + col + 4);
      const float4 ba = *(const float4*)(cb + col), bb = *(const float4*)(cb + col + 4);
      const float w0[8] = {w0a.x, w0a.y, w0a.z, w0a.w, w0b.x, w0b.y, w0b.z, w0b.w};
      const float w1[8] = {w1a.x, w1a.y, w1a.z, w1a.w, w1b.x, w1b.y, w1b.z, w1b.w};
      const float w2[8] = {w2a.x, w2a.y, w2a.z, w2a.w, w2b.x, w2b.y, w2b.z, w2b.w};
      const float bs[8] = {ba.x, ba.y, ba.z, ba.w, bb.x, bb.y, bb.z, bb.w};
#pragma unroll
      for (int i = 0; i < 8; ++i) val[q][i] = mp * a[i] * w0[i] + b[i] * w1[i] + mn * c[i] * w2[i] + bs[i];
    }
    *(uint4*)(x0c + row * 1024 + c0) = pack8s(val[0], 1.f);
    __syncthreads();
#pragma unroll
    for (int i = 0; i < 8; ++i) tile[tl * 65 + cg * 8 + i] = val[1][i] * val[2][i];
    __syncthreads();
    {
      const int cl = tid >> 3, tq = tid & 7;
      float* dst = uT + ((long)seq * 1024 + ct * 64 + cl) * L + tt * 64 + tq * 8;
      float4 o0, o1;
      o0.x = tile[(tq * 8 + 0) * 65 + cl]; o0.y = tile[(tq * 8 + 1) * 65 + cl]; o0.z = tile[(tq * 8 + 2) * 65 + cl]; o0.w = tile[(tq * 8 + 3) * 65 + cl];
      o1.x = tile[(tq * 8 + 4) * 65 + cl]; o1.y = tile[(tq * 8 + 5) * 65 + cl]; o1.z = tile[(tq * 8 + 6) * 65 + cl]; o1.w = tile[(tq * 8 + 7) * 65 + cl];
      *(float4*)dst = o0; *(float4*)(dst + 4) = o1;
    }
  }
  __syncthreads();
}

__device__ void phase_hy_fft(const Params& P, int slab, bool dry = false) {
  const int L = Lof(slab), N = 2 * L, nseq = SLAB / L, tid = TID();
  float* uT = (float*)(WS(P) + O_UT);
  const float2* hsb = (const float2*)(WS(P) + (slab == 0 ? O_HSPP : O_HSPS));
  const float2* tw = (const float2*)(WS(P) + O_TW);
  const float* skip = P.in[17];
  float2* buf = (float2*)smem;
  const int nitems = (nseq / 2) * 1024;
  for (int item = BID(); item < nitems; item += gridDim.x) {
    const int pr = item >> 10, c = item & 1023;
    float* u0 = uT + ((long)(pr * 2) * 1024 + c) * L;
    float* u1 = u0 + (long)1024 * L;
    __syncthreads();
    for (int t = tid; t < L; t += NT) {
      buf[fidx(t)] = make_float2(u0[t], u1[t]);
      buf[fidx(t + L)] = make_float2(0.f, 0.f);
    }
    __syncthreads();
    fft_dif(buf, N, tw);
    const float2* h = hsb + (long)c * N;
    for (int p = tid; p < N; p += NT) {
      float2 a = buf[fidx(p)], b = h[p];
      buf[fidx(p)] = make_float2(a.x * b.x - a.y * b.y, a.x * b.y + a.y * b.x);
    }
    __syncthreads();
    ifft_dit(buf, N, tw);
    const float sk = skip[c];
    for (int t = tid; t < L; t += NT) {
      float2 y = buf[fidx(t)];
      const long doff = dry ? (long)(END_HY - O_UT) / 4 : 0;
      u0[t + doff] = y.x + u0[t] * sk;
      u1[t + doff] = y.y + u1[t] * sk;
    }
  }
  __syncthreads();
}

__device__ void phase_hy_tr(const Params& P, int slab) {
  const int L = Lof(slab), nseq = SLAB / L, tid = TID();
  const float* __restrict__ yT = (const float*)(WS(P) + O_UT);
  const u16* __restrict__ x0c = (const u16*)(WS(P) + O_X0C);
  u16* __restrict__ a2 = (u16*)(WS(P) + O_A2);
  float* tile = (float*)smem;
  const int ntt = L / 64;
  const int nitems = nseq * ntt * 16;
  for (int item = BID(); item < nitems; item += gridDim.x) {
    const int ct = item % 16, tt = (item / 16) % ntt, seq = item / (16 * ntt);
    const int cl = tid >> 3, tq = tid & 7;
    const float* src = yT + ((long)seq * 1024 + ct * 64 + cl) * L + tt * 64 + tq * 8;
    const float4 i0 = *(const float4*)src, i1 = *(const float4*)(src + 4);
    const int tl = tid >> 3, cg = tid & 7;
    const long row = (long)seq * L + tt * 64 + tl;
    const int c0 = ct * 64 + cg * 8;
    float xg[8];
    unpack8(*(const uint4*)(x0c + row * 1024 + c0), xg);
    __syncthreads();
    float* p = tile + cl * 65 + tq * 8;
    p[0] = i0.x; p[1] = i0.y; p[2] = i0.z; p[3] = i0.w; p[4] = i1.x; p[5] = i1.y; p[6] = i1.z; p[7] = i1.w;
    __syncthreads();
    float o[8];
#pragma unroll
    for (int i = 0; i < 8; ++i) o[i] = tile[(cg * 8 + i) * 65 + tl] * xg[i];
    *(uint4*)(a2 + row * 1024 + c0) = pack8s(o, 1.f);
  }
  __syncthreads();
}

struct Rec {
  int H, DK, DV, C;
  int ldv, voff, goff;
};
__device__ __forceinline__ Rec rec_of(int kind) {
  Rec r;
  if (kind == 1) { r.H = 4; r.DK = 256; r.DV = 512; r.C = 256; r.ldv = 6144; r.voff = 2048; r.goff = 4096; }
  else { r.H = 8; r.DK = 128; r.DV = 128; r.C = 128; r.ldv = 5120; r.voff = 1024; r.goff = 4096; }
  return r;
}

__device__ void phase_ret_prep(const Params& P, int slab) {
  const int L = Lof(slab);
  const u16* __restrict__ pj = (const u16*)(WS(P) + O_PROJ);
  u16* __restrict__ qdf = (u16*)(WS(P) + O_QDF); u16* __restrict__ qdb = (u16*)(WS(P) + O_QDB);
  u16* __restrict__ kif = (u16*)(WS(P) + O_KIF); u16* __restrict__ kib = (u16*)(WS(P) + O_KIB);
  u16* __restrict__ kef = (u16*)(WS(P) + O_KEF); u16* __restrict__ keb = (u16*)(WS(P) + O_KEB);
  float* dlf = (float*)(WS(P) + O_DLF); float* dlb = (float*)(WS(P) + O_DLB);
  const float2* __restrict__ rope = (const float2*)(WS(P) + O_ROPER);
  const long gtid = (long)BID() * NT + TID(), gsz = (long)gridDim.x * NT;
  for (long idx = gtid; idx < (long)SLAB * 64; idx += gsz) {
    const int d0 = (int)(idx & 15) * 8, h = (int)((idx >> 4) & 3), t = (int)(idx >> 6);
    const int pos = t & (L - 1), r = t & 255;
    const float lgf = -expf(P.in[20][h]), lgb = -expf(P.in[20][4 + h]);
    const u16* row = pj + (long)t * 6144 + h * 256 + d0;
    const uint4 vq1 = *(const uint4*)row, vq2 = *(const uint4*)(row + 128);
    const uint4 vk1 = *(const uint4*)(row + 1024), vk2 = *(const uint4*)(row + 1024 + 128);
    const float4* rp = (const float4*)(rope + (long)pos * 128 + d0);
    const float4 c01 = rp[0], c23 = rp[1], c45 = rp[2], c67 = rp[3];
    float q1[8], q2[8], k1[8], k2[8];
    unpack8(vq1, q1); unpack8(vq2, q2); unpack8(vk1, k1); unpack8(vk2, k2);
    const float cs[8] = {c01.x, c01.z, c23.x, c23.z, c45.x, c45.z, c67.x, c67.z};
    const float sn[8] = {c01.y, c01.w, c23.y, c23.w, c45.y, c45.w, c67.y, c67.w};
    float qa[8], qb[8], ka[8], kb[8];
#pragma unroll
    for (int i = 0; i < 8; ++i) {
      qa[i] = q1[i] * cs[i] - q2[i] * sn[i]; qb[i] = q1[i] * sn[i] + q2[i] * cs[i];
      ka[i] = (k1[i] * cs[i] - k2[i] * sn[i]) * 0.0625f; kb[i] = (k1[i] * sn[i] + k2[i] * cs[i]) * 0.0625f;
    }
    const float bf = (float)(r + 1) * lgf, bb = (float)(256 - r) * lgb;
    const float ef = expf(bf), eif = expf(-bf), eef = expf((float)(255 - r) * lgf);
    const float eb = expf(bb), eib = expf(-bb), eeb = expf((float)r * lgb);
    const long o1 = (long)t * 1024 + h * 256 + d0, o2 = o1 + 128;
    *(uint4*)(qdf + o1) = pack8s(qa, ef); *(uint4*)(qdf + o2) = pack8s(qb, ef);
    *(uint4*)(qdb + o1) = pack8s(qa, eb); *(uint4*)(qdb + o2) = pack8s(qb, eb);
    *(uint4*)(kef + o1) = pack8s(ka, eef); *(uint4*)(kef + o2) = pack8s(kb, eef);
    *(uint4*)(keb + o1) = pack8s(ka, eeb); *(uint4*)(keb + o2) = pack8s(kb, eeb);
    if (r == 0) {
      const long cgi = (long)(t >> 8) * 1024 + h * 256 + d0;
      const float df = expf(256.f * lgf), db = expf(256.f * lgb);
#pragma unroll
      for (int i = 0; i < 8; ++i) { dlf[cgi + i] = df; dlf[cgi + 128 + i] = df; dlb[cgi + i] = db; dlb[cgi + 128 + i] = db; }
    }
  }
}

__device__ __forceinline__ float lb_of(const float* lbt, int dr, int ch) {
  const float a0 = lbt[(dr * 4 + 0) * 1024 + ch], a1 = lbt[(dr * 4 + 1) * 1024 + ch], a2 = lbt[(dr * 4 + 2) * 1024 + ch], a3 = lbt[(dr * 4 + 3) * 1024 + ch];
  const float m = fmaxf(fmaxf(a0, a1), fmaxf(a2, a3));
  const float e0 = expf(a0 - m), e1 = expf(a1 - m), e2 = expf(a2 - m), e3 = expf(a3 - m);
  return (e0 + e1 + e2) / (e0 + e1 + e2 + e3);
}
__device__ void phase_hg_prep(const Params& P) {
  const u16* __restrict__ pj = (const u16*)(WS(P) + O_PROJ);
  u16* __restrict__ qdf = (u16*)(WS(P) + O_QDF); u16* __restrict__ qdb = (u16*)(WS(P) + O_QDB);
  u16* __restrict__ kif = (u16*)(WS(P) + O_KIF); u16* __restrict__ kib = (u16*)(WS(P) + O_KIB);
  u16* __restrict__ kef = (u16*)(WS(P) + O_KEF); u16* __restrict__ keb = (u16*)(WS(P) + O_KEB);
  float* dlf = (float*)(WS(P) + O_DLF); float* dlb = (float*)(WS(P) + O_DLB);
  const float* lbt = P.in[28];
  float* totF = (float*)smem;
  float* totB = totF + 1024;
  const int tid = TID(), lane = tid & 63, rg = tid >> 6;
  constexpr int RPT = 16;
  for (int item = BID(); item < 1024; item += gridDim.x) {
    const int cgi = item >> 3, ch = (item & 7) * 128 + lane * 2;
    const long t0 = (long)cgi * 128 + rg * RPT;
    unsigned wq[RPT], wf[RPT], wb[RPT];
#pragma unroll
    for (int i = 0; i < RPT; ++i) {
      const u16* row = pj + (t0 + i) * 5120 + ch;
      wq[i] = *(const unsigned*)row; wf[i] = *(const unsigned*)(row + 2048); wb[i] = *(const unsigned*)(row + 3072);
    }
    float lb0[2], lb1[2];
    lb0[0] = lb_of(lbt, 0, ch); lb0[1] = lb_of(lbt, 0, ch + 1);
    lb1[0] = lb_of(lbt, 1, ch); lb1[1] = lb_of(lbt, 1, ch + 1);
    float pf[2][RPT], sb[2][RPT], accf[2], accb[2];
#pragma unroll
    for (int c = 0; c < 2; ++c) {
      float a = 0.f;
#pragma unroll
      for (int i = 0; i < RPT; ++i) {
        const float x = bf2f((u16)(c ? (wf[i] >> 16) : (wf[i] & 0xffff)));
        a += logf(lb0[c] + (1.f - lb0[c]) * sigm(x)); pf[c][i] = a;
      }
      accf[c] = a;
      a = 0.f;
#pragma unroll
      for (int i = RPT - 1; i >= 0; --i) {
        const float x = bf2f((u16)(c ? (wb[i] >> 16) : (wb[i] & 0xffff)));
        a += logf(lb1[c] + (1.f - lb1[c]) * sigm(x)); sb[c][i] = a;
      }
      accb[c] = a;
    }
    __syncthreads();
    *(float2*)(totF + rg * 128 + lane * 2) = make_float2(accf[0], accf[1]);
    *(float2*)(totB + rg * 128 + lane * 2) = make_float2(accb[0], accb[1]);
    __syncthreads();
    float offF[2] = {0.f, 0.f}, offB[2] = {0.f, 0.f}, totf[2] = {0.f, 0.f}, totb[2] = {0.f, 0.f};
#pragma unroll
    for (int g = 0; g < 8; ++g) {
      const float2 f = *(const float2*)(totF + g * 128 + lane * 2), bq = *(const float2*)(totB + g * 128 + lane * 2);
      totf[0] += f.x; totf[1] += f.y; totb[0] += bq.x; totb[1] += bq.y;
      if (g < rg) { offF[0] += f.x; offF[1] += f.y; }
      if (g > rg) { offB[0] += bq.x; offB[1] += bq.y; }
    }
#pragma unroll
    for (int i = 0; i < RPT; ++i) {
      float o[6][2];
#pragma unroll
      for (int c = 0; c < 2; ++c) {
        const float xq = bf2f((u16)(c ? (wq[i] >> 16) : (wq[i] & 0xffff)));
        const float xf = bf2f((u16)(c ? (wf[i] >> 16) : (wf[i] & 0xffff)));
        const float xb = bf2f((u16)(c ? (wb[i] >> 16) : (wb[i] & 0xffff)));
        const float q = silu_f(xq);
        const float bf = offF[c] + pf[c][i], bb = offB[c] + sb[c][i];
        const float kf = (1.f - lb0[c]) * sigm(-xf), kb = (1.f - lb1[c]) * sigm(-xb);
        o[0][c] = q * expf(bf); o[1][c] = kf * expf(-bf); o[2][c] = kf * expf(totf[c] - bf);
        o[3][c] = q * expf(bb); o[4][c] = kb * expf(-bb); o[5][c] = kb * expf(totb[c] - bb);
      }
      const long oo = (t0 + i) * 1024 + ch;
      *(unsigned*)(qdf + oo) = pack2(o[0][0], o[0][1]);
      *(unsigned*)(kif + oo) = pack2(o[1][0], o[1][1]);
      *(unsigned*)(kef + oo) = pack2(o[2][0], o[2][1]);
      *(unsigned*)(qdb + oo) = pack2(o[3][0], o[3][1]);
      *(unsigned*)(kib + oo) = pack2(o[4][0], o[4][1]);
      *(unsigned*)(keb + oo) = pack2(o[5][0], o[5][1]);
    }
    if (rg == 0) {
      *(float2*)(dlf + (long)cgi * 1024 + ch) = make_float2(expf(totf[0]), expf(totf[1]));
      *(float2*)(dlb + (long)cgi * 1024 + ch) = make_float2(expf(totb[0]), expf(totb[1]));
    }
  }
  __syncthreads();
}

template <int C, int DKT>
__device__ __forceinline__ void rec_scores_item(const Params& P, const Rec& R, int cgi, int h, int ti, int tj) {
  constexpr int T = C > 128 ? 128 : C, KTS = DKT;
  const u16* qdf = (const u16*)(WS(P) + O_QDF); const u16* qdb = (const u16*)(WS(P) + O_QDB);
  const u16* kif = (const u16*)(WS(P) + O_KIF); const u16* kib = (const u16*)(WS(P) + O_KIB);
  u16* sc = (u16*)(WS(P) + O_SC) + (((long)cgi * R.H + h) * C + ti * T) * C + tj * T;
  const long offA = ((long)cgi * C + ti * T) * 1024 + h * R.DK, offB = ((long)cgi * C + tj * T) * 1024 + h * R.DK;
  f32x4 af[T / 32][T / 64] = {}, ab[T / 32][T / 64] = {};
  float sff = 1.f, sfb = 1.f;
  if (C == 256) {
    kif = (const u16*)(WS(P) + O_KEF); kib = (const u16*)(WS(P) + O_KEB);
    sff = expf((float)C * expf(P.in[20][h])); sfb = expf((float)C * expf(P.in[20][4 + h]));
  }
  if (ti >= tj) gemm_acc<T, T, true, true, true, KTS>(af, qdf + offA, 1024, kif + offB, 1024, (u16*)smem);
  if (ti <= tj) gemm_acc<T, T, true, true, true, KTS>(ab, qdb + offA, 1024, kib + offB, 1024, (u16*)smem);
  const int tid = TID(), lane = tid & 63, wid = tid >> 6;
  const int wm = wid >> 2, wn = wid & 3, fr = lane & 15, fq = lane >> 4;
#pragma unroll
  for (int mi = 0; mi < T / 32; ++mi)
#pragma unroll
    for (int ni = 0; ni < T / 64; ++ni) {
      const int r = wm * (T / 2) + mi * 16 + fr, c0 = wn * (T / 4) + ni * 16 + fq * 4;
      const int gr = ti * T + r;
      float v[4];
#pragma unroll
      for (int j = 0; j < 4; ++j) {
        const int gc = tj * T + c0 + j;
        v[j] = (gc <= gr ? af[mi][ni][j] * sff : 0.f) + (gc >= gr ? ab[mi][ni][j] * sfb : 0.f);
      }
      *(uint2*)(sc + r * C + c0) = make_uint2(pack2(v[0], v[1]), pack2(v[2], v[3]));
    }
}

template <int C, int DKT>
__device__ void phase_rec_su(const Params& P, int kind) {
  const Rec R = rec_of(kind);
  constexpr int KTU = C / 64;
  const int nch = SLAB / C;
  constexpr int NT1 = (C > 128 ? C / 128 : 1), NTT = NT1 * NT1;
  const int n_sc = nch * R.H * NTT;
  const int mtn = R.DK / 128, ntn = R.DV / 128;
  const int n_u = nch * R.H * 2 * mtn * ntn, G = gridDim.x;
  const u16* pj = (const u16*)(WS(P) + O_PROJ);
  for (int item = VBID(); item < n_sc; item += G) { const int tl = item % NTT, hh = (item / NTT) % R.H, cg = item / (NTT * R.H); rec_scores_item<C, DKT>(P, R, cg, hh, tl / NT1, tl % NT1); }
  const u16* kef = (const u16*)(WS(P) + O_KEF); const u16* keb = (const u16*)(WS(P) + O_KEB);
  u16* stfb = (u16*)(WS(P) + O_STF); u16* stbb = (u16*)(WS(P) + O_STB);
  Tiles<KTU> ta, tb;
#define U_DECODE(q_, nt_, mt_, dir_, h_, cgi_) int nt_, mt_, dir_, h_, cgi_; { int qq = (q_); nt_ = qq % ntn; qq /= ntn; mt_ = qq % mtn; qq /= mtn; dir_ = qq & 1; qq >>= 1; h_ = qq % R.H; cgi_ = qq / R.H; }
#define U_ISSUE(T_, nt_, mt_, dir_, h_, cgi_) tiles_issue<128, 128, false, false, KTU>(T_, (dir_ ? keb : kef) + (long)cgi_ * C * 1024 + h_ * R.DK + mt_ * 128, 1024, pj + (long)cgi_ * C * R.ldv + R.voff + h_ * R.DV + nt_ * 128, R.ldv)
#define U_RUN(T_, nt_, mt_, dir_, h_, cgi_) { f32x4 acc[4][2] = {}; gemm_run<128, 128, false, false, false, KTU>(acc, T_, (u16*)smem); \
    u16* st = (dir_ ? stbb : stfb) + (((long)cgi_ * R.H + h_) * R.DV + nt_ * 128) * R.DK + mt_ * 128; const int DK = R.DK; \
    epi_each<128, 128, false>(acc, [&](int r, int c, f32x4 val) { *(uint2*)(st + (long)c * DK + r) = make_uint2(pack2(val[0], val[1]), pack2(val[2], val[3])); }); }
  int q = VBID();
  if (q < n_u) { U_DECODE(q, nt, mt, dir, h, cgi); U_ISSUE(ta, nt, mt, dir, h, cgi); }
  for (; q < n_u; q += 2 * G) {
    U_DECODE(q, nt, mt, dir, h, cgi);
    const int q2 = q + G;
    if (q2 < n_u) { U_DECODE(q2, nt2, mt2, dir2, h2, cgi2); U_ISSUE(tb, nt2, mt2, dir2, h2, cgi2); }
    U_RUN(ta, nt, mt, dir, h, cgi);
    const int q3 = q + 2 * G;
    if (q3 < n_u) { U_DECODE(q3, nt3, mt3, dir3, h3, cgi3); U_ISSUE(ta, nt3, mt3, dir3, h3, cgi3); }
    if (q2 < n_u) { U_DECODE(q2, nt2, mt2, dir2, h2, cgi2); U_RUN(tb, nt2, mt2, dir2, h2, cgi2); }
  }
#undef U_DECODE
#undef U_ISSUE
#undef U_RUN
  __syncthreads();
}

__device__ void phase_rec_scan(const Params& P, int kind, int slab, bool dry = false) {
  const Rec R = rec_of(kind);
  const int L = Lof(slab), nseq = SLAB / L, ncs = L / R.C;
  const int qdk = R.DK / 4;
  const long per = (long)R.H * R.DV * qdk;
  const long total = 2 * nseq * per;
  const long gtid = (long)BID() * NT + TID(), gsz = (long)gridDim.x * NT;
  for (long idx = gtid; idx < total; idx += gsz) {
    long q = idx;
    const int pd = (int)(q % qdk); q /= qdk;
    const int e = (int)(q % R.DV); q /= R.DV;
    const int h = (int)(q % R.H); q /= R.H;
    const int seq = (int)(q % nseq);
    const int dir = (int)(q / nseq);
    u16* st = (u16*)(WS(P) + (dir ? O_STB : O_STF));
    u16* stw = dry ? (u16*)(WS(P) + O_OBUF) : st;
    const float* dl = (const float*)(WS(P) + (dir ? O_DLB : O_DLF));
    float s0 = 0.f, s1 = 0.f, s2 = 0.f, s3 = 0.f;
    const long ebase = ((long)h * R.DV + e) * R.DK + pd * 4;
    const long cstride = (long)R.H * R.DV * R.DK;
    const int dbase = h * R.DK + pd * 4;
    for (int i0 = 0; i0 < ncs; i0 += 8) {
      uint2 u[8];
      float4 dd[8];
#pragma unroll
      for (int j = 0; j < 8; ++j) {
        const int n = dir ? (ncs - 1 - i0 - j) : (i0 + j);
        const long cgi = (long)seq * ncs + n;
        { const unsigned long long w = __builtin_nontemporal_load((const unsigned long long*)(st + cgi * cstride + ebase)); u[j] = make_uint2((unsigned)w, (unsigned)(w >> 32)); }
        dd[j] = *(const float4*)(dl + cgi * 1024 + dbase);
      }
#pragma unroll
      for (int j = 0; j < 8; ++j) {
        const int n = dir ? (ncs - 1 - i0 - j) : (i0 + j);
        const long cgi = (long)seq * ncs + n;
        __builtin_nontemporal_store((unsigned long long)pack2(s0, s1) | ((unsigned long long)pack2(s2, s3) << 32), (unsigned long long*)(stw + cgi * cstride + ebase));
        s0 = dd[j].x * s0 + bf2f((u16)(u[j].x & 0xffff));
        s1 = dd[j].y * s1 + bf2f((u16)(u[j].x >> 16));
        s2 = dd[j].z * s2 + bf2f((u16)(u[j].y & 0xffff));
        s3 = dd[j].w * s3 + bf2f((u16)(u[j].y >> 16));
      }
    }
  }
}

template <int C, int DKT>
__device__ void phase_rec_out(const Params& P, int kind) {
  const Rec R = rec_of(kind);
  constexpr int T = C > 128 ? 128 : C, NRT = C / T;
  constexpr int KT1 = C / 64, KT2 = DKT;
  const int nch = SLAB / C, ntn = R.DV / 128;
  const u16* pj = (const u16*)(WS(P) + O_PROJ);
  const u16* scb = (const u16*)(WS(P) + O_SC);
  const u16* qdf = (const u16*)(WS(P) + O_QDF); const u16* qdb = (const u16*)(WS(P) + O_QDB);
  const u16* stf = (const u16*)(WS(P) + O_STF); const u16* stb = (const u16*)(WS(P) + O_STB);
  u16* ob = (u16*)(WS(P) + O_OBUF);
  const int HDV = R.H * R.DV;
  const int nitems = nch * R.H * NRT * ntn, G = gridDim.x;
  Tiles<KT1> t1; Tiles<KT2> t2; Tiles<KT2> t3;
  int item = VBID();
  if (item < nitems) {
    const int nt = item % ntn, rt = (item / ntn) % NRT, h = (item / (ntn * NRT)) % R.H, cgi = item / (ntn * NRT * R.H);
    tiles_issue<T, 128, true, false, KT1>(t1, scb + (((long)cgi * R.H + h) * C + rt * T) * C, C, pj + (long)cgi * C * R.ldv + R.voff + h * R.DV + nt * 128, R.ldv);
  }
  for (; item < nitems; item += G) {
    const int nt = item % ntn, rt = (item / ntn) % NRT, h = (item / (ntn * NRT)) % R.H, cgi = item / (ntn * NRT * R.H);
    const long qoff = ((long)cgi * C + rt * T) * 1024 + h * R.DK;
    const long soff = (((long)cgi * R.H + h) * R.DV + nt * 128) * R.DK;
    f32x4 acc[T / 32][2] = {};
    tiles_issue<T, 128, true, true, KT2>(t2, qdf + qoff, 1024, stf + soff, R.DK);
    gemm_run<T, 128, true, false, true, KT1>(acc, t1, (u16*)smem);
    tiles_issue<T, 128, true, true, KT2>(t3, qdb + qoff, 1024, stb + soff, R.DK);
    gemm_run<T, 128, true, true, true, KT2>(acc, t2, (u16*)smem);
    const int nx = item + G;
    if (nx < nitems) {
      const int nt2 = nx % ntn, rt2 = (nx / ntn) % NRT, h2 = (nx / (ntn * NRT)) % R.H, cg2 = nx / (ntn * NRT * R.H);
      tiles_issue<T, 128, true, false, KT1>(t1, scb + (((long)cg2 * R.H + h2) * C + rt2 * T) * C, C, pj + (long)cg2 * C * R.ldv + R.voff + h2 * R.DV + nt2 * 128, R.ldv);
    }
    gemm_run<T, 128, true, true, true, KT2>(acc, t3, (u16*)smem);
    if (DKT == 2) {
      float* part = (float*)(smem + 81920);
      const int tid = TID(), lane = tid & 63, wid = tid >> 6;
      const int wm = wid >> 2, wn = wid & 3, fr = lane & 15, fq = lane >> 4;
#pragma unroll
      for (int mi = 0; mi < T / 32; ++mi) {
        float sq = 0.f;
#pragma unroll
        for (int ni = 0; ni < 2; ++ni)
#pragma unroll
          for (int j = 0; j < 4; ++j) sq += acc[mi][ni][j] * acc[mi][ni][j];
        sq += __shfl_xor(sq, 16); sq += __shfl_xor(sq, 32);
        if (fq == 0) part[wn * 128 + wm * (T / 2) + mi * 16 + fr] = sq;
      }
      __syncthreads();
      const float* gain = P.in[29];
      u16* a2 = (u16*)(WS(P) + O_A2);
#pragma unroll
      for (int mi = 0; mi < T / 32; ++mi) {
        const int row = wm * (T / 2) + mi * 16 + fr;
        const float tot = part[row] + part[128 + row] + part[256 + row] + part[384 + row];
        const float rstd = rsqrtf(tot * (1.f / 128.f) + 1e-6f);
        const long t = (long)cgi * C + rt * T + row;
#pragma unroll
        for (int ni = 0; ni < 2; ++ni) {
          const int c = wn * 32 + ni * 16 + fq * 4;
          const float4 g4 = *(const float4*)(gain + c);
          const uint2 gw = *(const uint2*)(pj + t * R.ldv + R.goff + h * 128 + c);
          const f32x4 v = acc[mi][ni];
          const float y0 = v[0] * rstd * g4.x * silu_f(bf2f((u16)(gw.x & 0xffff)));
          const float y1 = v[1] * rstd * g4.y * silu_f(bf2f((u16)(gw.x >> 16)));
          const float y2 = v[2] * rstd * g4.z * silu_f(bf2f((u16)(gw.y & 0xffff)));
          const float y3 = v[3] * rstd * g4.w * silu_f(bf2f((u16)(gw.y >> 16)));
          *(uint2*)(a2 + t * 1024 + h * 128 + c) = make_uint2(pack2(y0, y1), pack2(y2, y3));
        }
      }
    } else {
      u16* o = ob + ((long)cgi * C + rt * T) * HDV + h * R.DV + nt * 128;
      epi_each<T, 128, true>(acc, [&](int r, int c, f32x4 val) { *(uint2*)(o + (long)r * HDV + c) = make_uint2(pack2(val[0], val[1]), pack2(val[2], val[3])); });
    }
  }
  __syncthreads();
}

template <int KIND>
__device__ void phase_rec_ng_t(const Params& P) {
  const Rec R = rec_of(KIND);
  constexpr int DV = (KIND == 1) ? 512 : 128, H = (KIND == 1) ? 4 : 8, PER = DV / 64, HDV = H * DV;
  const u16* __restrict__ ob = (const u16*)(WS(P) + O_OBUF);
  const u16* __restrict__ pj = (const u16*)(WS(P) + O_PROJ);
  u16* __restrict__ a2 = (u16*)(WS(P) + O_A2);
  const float* gain = P.in[29];
  const int tid = TID(), lane = tid & 63, wid = tid >> 6;
  constexpr int nrows = SLAB * H;
  for (int item = BID(); item < nrows / 32; item += gridDim.x) {
    float v[4][PER];
    float ss[4];
#pragma unroll
    for (int u = 0; u < 4; ++u) {
      const int rh = item * 32 + wid * 4 + u;
      const int t = rh / H, h = rh % H;
      const u16* o = ob + (long)t * HDV + h * DV + lane * PER;
      if (PER == 8) {
        float f8[8];
        unpack8(*(const uint4*)o, f8);
#pragma unroll
        for (int i = 0; i < 8; ++i) v[u][i % PER] = f8[i];
      } else {
        const unsigned w = *(const unsigned*)o;
        v[u][0] = bf2f((u16)(w & 0xffff)); v[u][1 % PER] = bf2f((u16)(w >> 16));
      }
      float a = 0.f;
#pragma unroll
      for (int i = 0; i < PER; ++i) a += v[u][i] * v[u][i];
      ss[u] = a;
    }
#pragma unroll
    for (int u = 0; u < 4; ++u) ss[u] = wave_sum(ss[u]);
#pragma unroll
    for (int u = 0; u < 4; ++u) {
      const int rh = item * 32 + wid * 4 + u;
      const int t = rh / H, h = rh % H;
      const float rstd = rsqrtf(ss[u] / (float)DV + 1e-6f);
      const u16* g = pj + (long)t * R.ldv + R.goff + h * DV + lane * PER;
      u16* out = a2 + (long)t * HDV + h * DV + lane * PER;
      float y[PER];
#pragma unroll
      for (int i = 0; i < PER; ++i) {
        y[i] = v[u][i] * rstd;
        if (KIND == 3) y[i] *= gain[lane * PER + i];
      }
      if (PER == 8) {
        const uint4 gw = *(const uint4*)g;
        float gf[8];
        unpack8(gw, gf);
        float r8[8];
#pragma unroll
        for (int i = 0; i < 8; ++i) r8[i] = y[i % PER] * silu_f(gf[i]);
        *(uint4*)out = pack8s(r8, 1.f);
      } else {
        const unsigned gw = *(const unsigned*)g;
        *(unsigned*)out = pack2(y[0] * silu_f(bf2f((u16)(gw & 0xffff))), y[1 % PER] * silu_f(bf2f((u16)(gw >> 16))));
      }
    }
  }
}
__device__ void phase_rec_ng(const Params& P, int kind) {
  if (kind == 1) phase_rec_ng_t<1>(P); else phase_rec_ng_t<3>(P);
}

__device__ void phase_swa_prep(const Params& P) {
  const u16* __restrict__ pj = (const u16*)(WS(P) + O_SA_P);
  u16* __restrict__ qn = (u16*)(WS(P) + O_SA_Q);
  u16* __restrict__ kn = (u16*)(WS(P) + O_SA_K);
  const float2* __restrict__ rope = (const float2*)(WS(P) + O_ROPES);
  const long gtid = (long)BID() * NT + TID(), gsz = (long)gridDim.x * NT;
  for (long idx = gtid; idx < (long)NTOK * 80; idx += gsz) {
    const int j = (int)(idx & 3);
    const int hd = (int)((idx >> 2) % 20);
    const int t = (int)(idx / 80);
    const int col = hd < 16 ? hd * 64 : 1024 + (hd - 16) * 64;
    const int d0 = j * 8;
    float x1[8], x2[8];
    unpack8(*(const uint4*)(pj + (long)t * 1536 + col + d0), x1);
    unpack8(*(const uint4*)(pj + (long)t * 1536 + col + d0 + 32), x2);
    const int L = t < 16384 ? 2048 : 8192;
    const float4* rp = (const float4*)(rope + (long)(t & (L - 1)) * 32 + d0);
    const float4 c01 = rp[0], c23 = rp[1], c45 = rp[2], c67 = rp[3];
    float ss = 0.f;
#pragma unroll
    for (int i = 0; i < 8; ++i) ss += x1[i] * x1[i] + x2[i] * x2[i];
    ss += __shfl_xor(ss, 1); ss += __shfl_xor(ss, 2);
    const float rstd = rsqrtf(ss * (1.f / 64.f) + 1e-6f);
    const float* gn = hd < 16 ? P.in[23] : P.in[24];
    const float4 ga = *(const float4*)(gn + d0), gb = *(const float4*)(gn + d0 + 4), gc = *(const float4*)(gn + d0 + 32), gd = *(const float4*)(gn + d0 + 36);
    const float g1[8] = {ga.x, ga.y, ga.z, ga.w, gb.x, gb.y, gb.z, gb.w};
    const float g2[8] = {gc.x, gc.y, gc.z, gc.w, gd.x, gd.y, gd.z, gd.w};
    const float cs[8] = {c01.x, c01.z, c23.x, c23.z, c45.x, c45.z, c67.x, c67.z};
    const float sn[8] = {c01.y, c01.w, c23.y, c23.w, c45.y, c45.w, c67.y, c67.w};
    const float osc = hd < 16 ? 0.125f : 1.f;
    float o1[8], o2[8];
#pragma unroll
    for (int i = 0; i < 8; ++i) {
      const float y1 = x1[i] * rstd * g1[i], y2 = x2[i] * rstd * g2[i];
      o1[i] = (y1 * cs[i] - y2 * sn[i]) * osc;
      o2[i] = (y1 * sn[i] + y2 * cs[i]) * osc;
    }
    u16* dst = hd < 16 ? qn + (long)t * 1024 + hd * 64 + d0 : kn + (long)t * 256 + (hd - 16) * 64 + d0;
    *(uint4*)dst = pack8s(o1, 1.f);
    *(uint4*)(dst + 32) = pack8s(o2, 1.f);
  }
}

constexpr int SLD = 324;
__device__ void phase_swa_att(const Params& P) {
  const u16* qn = (const u16*)(WS(P) + O_SA_Q);
  const u16* kn = (const u16*)(WS(P) + O_SA_K);
  const u16* pj = (const u16*)(WS(P) + O_SA_P);
  u16* a2 = (u16*)(WS(P) + O_SA_A);
  const float* sink = P.in[25];
  float* S = (float*)(smem + 40960);
  u16* Bs = (u16*)smem + 9216;
  const int tid = TID(), lane = tid & 63, wid = tid >> 6;
  const int wm = wid >> 2, wn = wid & 3, fr = lane & 15, fq = lane >> 4;
  const int nitems = (NTOK / 64) * 16;
  for (int item = VBID(); item < nitems; item += gridDim.x) {
    const int hq = item & 15, qbg = item >> 4;
    const int L = qbg < 256 ? 2048 : 8192;
    const int q0 = qbg < 256 ? (qbg & 31) * 64 : ((qbg - 256) & 127) * 64;
    const long tok0 = qbg < 256 ? (long)(qbg >> 5) * 2048 : 16384 + (long)((qbg - 256) >> 7) * 8192;
    const int hkv = hq >> 2;
    uint4 vt[5];
#pragma unroll
    for (int kt = 0; kt < 5; ++kt) {
      const int kp0 = q0 - 128 + kt * 64;
      vt[kt] = make_uint4(0, 0, 0, 0);
      if (kp0 >= 0 && kp0 < L) vt[kt] = ld_chunk<64, false>(pj + (tok0 + kp0) * 1536 + 1280 + hkv * 64, 1536, 0, tid);
    }
    for (int kt = 0; kt < 5; ++kt) {
      const int kp0 = q0 - 128 + kt * 64;
      if (kp0 >= 0 && kp0 < L) {
        f32x4 acc[2][1] = {};
        gemm_acc<64, 64, true, true, true, 1>(acc, qn + (tok0 + q0) * 1024 + hq * 64, 1024, kn + (tok0 + kp0) * 256 + hkv * 64, 256, (u16*)smem);
        epi_each<64, 64, true>(acc, [&](int r, int c, f32x4 v) {
          f32x4 o;
#pragma unroll
          for (int j = 0; j < 4; ++j) {
            const int dlt = (q0 + r) - (kp0 + c + j);
            o[j] = (dlt <= 128 && dlt >= -128) ? v[j] : -1e30f;
          }
          *(f32x4*)(S + r * SLD + kt * 64 + c) = o;
        });
      } else {
        for (int i = tid; i < 4096; i += NT) S[(i >> 6) * SLD + kt * 64 + (i & 63)] = -1e30f;
      }
    }
    __syncthreads();
    {
      const int r = tid >> 3, sub = tid & 7;
      const float sk = sink[hq];
      float e[40];
      float m = sk;
#pragma unroll
      for (int i = 0; i < 40; ++i) { e[i] = S[r * SLD + sub + 8 * i]; m = fmaxf(m, e[i]); }
      m = fmaxf(m, __shfl_xor(m, 1)); m = fmaxf(m, __shfl_xor(m, 2)); m = fmaxf(m, __shfl_xor(m, 4));
      float den = 0.f;
#pragma unroll
      for (int i = 0; i < 40; ++i) { e[i] = __expf(e[i] - m); den += e[i]; }
      den += __shfl_xor(den, 1); den += __shfl_xor(den, 2); den += __shfl_xor(den, 4);
      den += __expf(sk - m);
      const float inv = 1.f / den;
      u16* prow = (u16*)(S + r * SLD);
#pragma unroll
      for (int i = 0; i < 40; ++i) prow[sub + 8 * i] = f2bf(e[i] * inv);
    }
    __syncthreads();
    f32x4 acc[2][1] = {};
#pragma unroll
    for (int kt = 0; kt < 5; ++kt) {
      const int kp0 = q0 - 128 + kt * 64;
      if (kp0 >= 0 && kp0 < L) {
        __syncthreads();
        st_chunk<64, false>(Bs, vt[kt], tid);
        __syncthreads();
#pragma unroll
        for (int ks = 0; ks < 2; ++ks) {
          bf16x8 af[2];
#pragma unroll
          for (int mi = 0; mi < 2; ++mi) af[mi] = *(const bf16x8*)((const u16*)(S + (wm * 32 + mi * 16 + fr) * SLD) + kt * 64 + ks * 32 + fq * 8);
          const bf16x8 bfr = ld_frag<64, false>(Bs, wn * 16, ks, fr, fq);
#pragma unroll
          for (int mi = 0; mi < 2; ++mi) acc[mi][0] = __builtin_amdgcn_mfma_f32_16x16x32_bf16(bfr, af[mi], acc[mi][0], 0, 0, 0);
        }
      }
    }
    u16* o = a2 + (tok0 + q0) * 1024 + hq * 64;
    epi_each<64, 64, true>(acc, [&](int r, int c, f32x4 v) { *(uint2*)(o + (long)r * 1024 + c) = make_uint2(pack2(v[0], v[1]), pack2(v[2], v[3])); });
    __syncthreads();
  }
}

#define XB_TMO      128
#define XB_XCNT(j)  (256  + 64 * (j))
#define XB_XSUB(j)  (1280 + 64 * (j))
#define XB_XGEN(j)  (2304 + 64 * (j))
#define XB_TOP      3328
#define XB_TOPGEN   3392
#define XCD_BAR_WORDS 3456
#define XB_SPIN_CAP (1u << 18)
__device__ __forceinline__ unsigned xb_ld(unsigned* p)              { return __hip_atomic_load(p, __ATOMIC_RELAXED, __HIP_MEMORY_SCOPE_AGENT); }
__device__ __forceinline__ unsigned xb_add(unsigned* p, unsigned v) { return __hip_atomic_fetch_add(p, v, __ATOMIC_RELAXED, __HIP_MEMORY_SCOPE_AGENT); }
__device__ __forceinline__ unsigned xb_xcc_id() { return (unsigned)__builtin_amdgcn_s_getreg((3 << 11) | 20) & 0xFu; }
#define XB_SPIN(cond, bar) do { unsigned _sp = 0; while (cond) { __builtin_amdgcn_s_sleep(1); \
    if ((++_sp & 255u) == 0u) { if (xb_ld(&(bar)[XB_TMO])) break; if (_sp > XB_SPIN_CAP) { atomicAdd(&(bar)[XB_TMO], 1u); break; } } } } while (0)
struct XcdBarrier { unsigned* bar; unsigned x; volatile LDS_AS unsigned* st; };
__device__ __forceinline__ XcdBarrier xcd_barrier_post(unsigned* bar, volatile LDS_AS unsigned* st) {
    XcdBarrier b; b.bar = bar; b.x = xb_xcc_id(); b.st = st;
    if (threadIdx.x == 0) (void)xb_add(&bar[XB_XCNT(b.x)], 1u);
    return b;
}
__device__ __forceinline__ void xcd_barrier_complete(unsigned* bar, unsigned x, unsigned& nloc, unsigned& nx) {
    const unsigned G = gridDim.x * gridDim.y * gridDim.z;
    unsigned sum, cnt, mine, sp = 0u;
    for (;;) {
        sum = 0u; cnt = 0u; mine = 0u;
#pragma unroll
        for (unsigned j = 0; j < 16; ++j) { const unsigned c = xb_ld(&bar[XB_XCNT(j)]); sum += c; cnt += (c > 0u) ? 1u : 0u; mine = (j == x) ? c : mine; }
        if (sum == G) break;
        __builtin_amdgcn_s_sleep(1);
        if ((++sp & 255u) == 0u) { if (xb_ld(&bar[XB_TMO])) break; if (sp > XB_SPIN_CAP) { atomicAdd(&bar[XB_TMO], 1u); break; } }
    }
    nloc = mine > 0u ? mine : 1u; nx = cnt > 0u ? cnt : 1u;
}
__device__ __forceinline__ void xcd_barrier(const XcdBarrier& b) {
    asm volatile("s_waitcnt vmcnt(0)" ::: "memory");
    __syncthreads();
    if (threadIdx.x == 0) {
        unsigned* bar = b.bar;
        __builtin_amdgcn_s_waitcnt(0);
        unsigned nloc = b.st[0], nx = b.st[1];
        if (nloc == 0u) { xcd_barrier_complete(bar, b.x, nloc, nx); b.st[0] = nloc; b.st[1] = nx; }
        const unsigned old = xb_add(&bar[XB_XSUB(b.x)], 1u);
        const unsigned gen = old / nloc;
        if (old + 1u == (gen + 1u) * nloc) {
            __builtin_amdgcn_fence(__ATOMIC_RELEASE, "agent");
            asm volatile("s_waitcnt vmcnt(0)" ::: "memory");
            const unsigned og = xb_add(&bar[XB_TOP], 1u);
            const unsigned tg = og / nx;
            if (og + 1u == (tg + 1u) * nx) xb_add(&bar[XB_TOPGEN], 1u);
            else XB_SPIN(xb_ld(&bar[XB_TOPGEN]) == tg, bar);
            __builtin_amdgcn_fence(__ATOMIC_ACQUIRE, "agent");
            xb_add(&bar[XB_XGEN(b.x)], 1u);
            asm volatile("s_waitcnt vmcnt(0)" ::: "memory");
        } else {
            XB_SPIN(xb_ld(&bar[XB_XGEN(b.x)]) == gen, bar);
            __builtin_amdgcn_fence(__ATOMIC_ACQUIRE, "agent");
            asm volatile("s_waitcnt vmcnt(0)" ::: "memory");
        }
    }
    __syncthreads();
}

__device__ __forceinline__ int nmix_of(int kind) { return kind == 1 ? 8 : (kind == 3 ? 7 : (kind == 2 ? 5 : 6)); }
__device__ __forceinline__ int nsl_of(int kind) { return kind == 2 ? 1 : 5; }

__device__ void ffn_step(const Params& P, int layer, int f) {
  if (f == 6) { phase_ffn_down(P, layer); return; }
  const int fs = f / 3, st = f % 3;
  if (st == 0) { REP(4) phase_norm(P, layer, fs, 1); }
  else if (st == 1) { REP(0) phase_ffn_gate(P, layer); }
  else { REP(0) phase_ffn_val(P, layer, fs); }
}
__device__ void layer_step(const Params& P, int layer, int slab, int step) {
  const int kind = layer;
  if (step == 0) { REP(4) phase_norm(P, layer, slab, kind == 2 ? 2 : 0); return; }
  if (kind == 0) {
    if (step == 1) { REP(0) phase_proj(P, O_WHYIN, 3072); }
    else if (step == 2) { REP(3) phase_hy_conv(P, slab); }
    else if (step == 3) { if ((PROBE_MASK >> 7) & 1) phase_hy_fft(P, slab, true); phase_hy_fft(P, slab); }
    else if (step == 4) { REP(3) phase_hy_tr(P, slab); }
    else phase_resid(P, layer, slab, (const u16*)(WS(P) + O_A2), 1024, O_WHYOUT, 2 * D);
  } else if (kind == 1) {
    if (step == 1) { REP(0) phase_proj(P, O_WRETIN, 6144); }
    else if (step == 2) { REP(1) REP(9) phase_ret_prep(P, slab); }
    else if (step == 3) { REP(1) REP(11) phase_rec_su<256, 4>(P, 1); }
    else if (step == 4) { if ((PROBE_MASK >> 6) & 1) phase_rec_scan(P, 1, slab, true); phase_rec_scan(P, 1, slab); }
    else if (step == 5) { REP(1) REP(12) phase_rec_out<256, 4>(P, 1); }
    else if (step == 6) { REP(1) REP(9) phase_rec_ng(P, 1); }
    else phase_resid(P, layer, slab, (const u16*)(WS(P) + O_A2), 2048, O_WRETOUT, 2 * D);
  } else if (kind == 2) {
    if (step == 1) {
      EpiStoreBf16 E; E.O = (u16*)(WS(P) + O_SA_P); E.ldc = 1536;
      REP(0) run_gemm((const u16*)(WS(P) + O_SA_H), (const u16*)(WS(P) + O_WSWAIN), NTOK, 1536, D, E);
    }
    else if (step == 2) { REP(2) REP(14) phase_swa_prep(P); }
    else if (step == 3) { REP(2) REP(15) phase_swa_att(P); }
    else {
      EpiResid E; E.X = OUTP(P); E.XS = E.X; E.mod = (const float*)(WS(P) + O_MOD) + (long)layer * 16 * 6144; E.goff = 2 * D; E.grow0 = 0;
      run_gemm((const u16*)(WS(P) + O_SA_A), (const u16*)(WS(P) + O_WSWAOUT), NTOK, D, 1024, E);
    }
  } else {
    if (step == 1) { REP(0) phase_proj(P, O_WHGIN, 5120); }
    else if (step == 2) { REP(1) REP(9) phase_hg_prep(P); }
    else if (step == 3) { REP(1) REP(11) phase_rec_su<128, 2>(P, 3); }
    else if (step == 4) { if ((PROBE_MASK >> 6) & 1) phase_rec_scan(P, 3, slab, true); phase_rec_scan(P, 3, slab); }
    else if (step == 5) { REP(1) REP(12) phase_rec_out<128, 2>(P, 3); }
    else phase_resid(P, layer, slab, (const u16*)(WS(P) + O_A2), 1024, O_WHGOUT, 2 * D);
  }
}

__global__ void __launch_bounds__(NT) fwd_megakernel(Params P) {
  cg::grid_group grid = cg::this_grid();
  __shared__ uint4 xb_words;
  if (threadIdx.x == 0) xb_words = make_uint4(0u, 0u, 0u, 0u);
  __syncthreads();
  XcdBarrier xb = xcd_barrier_post((unsigned*)(P.ws + O_BAR), (volatile LDS_AS unsigned*)&xb_words);
  for (int pid = P.p0; pid < P.p1; ++pid) {
    if (pid == 0) { REP(5) phase_pre0(P); }
    else if (pid == 1) { REP(5) phase_pre1(P); }
    else {
      int q = pid - 2, layer = 0;
      while (q >= nsl_of(layer) * nmix_of(layer) + 7) { q -= nsl_of(layer) * nmix_of(layer) + 7; ++layer; }
      const int nm = nmix_of(layer), nsl = nsl_of(layer);
      if (q < nsl * nm) layer_step(P, layer, q / nm, q % nm);
      else ffn_step(P, layer, q - nsl * nm);
    }
    if (pid + 1 < P.p1) {
      if (pid == 0) grid.sync();
      else xcd_barrier(xb);
      if ((PROBE_MASK >> 8) & 1) xcd_barrier(xb);
    }
  }
}

extern "C" void kernel_launch(void* const* d_in, const int* in_sizes, int n_in, void* d_out, int out_size, void* d_ws,
                              size_t ws_size, hipStream_t stream) {
  static int grid_blocks = 0;
  if (!grid_blocks) {
    int dev = 0, cus = 0, per_cu = 0;
    (void)hipGetDevice(&dev);
    (void)hipDeviceGetAttribute(&cus, hipDeviceAttributeMultiprocessorCount, dev);
    (void)hipFuncSetAttribute((const void*)fwd_megakernel, hipFuncAttributeMaxDynamicSharedMemorySize, LDSB);
    (void)hipOccupancyMaxActiveBlocksPerMultiprocessor(&per_cu, (const void*)fwd_megakernel, NT, LDSB);
    if (per_cu < 1) per_cu = 1;
    if (per_cu > 1) per_cu = 1;
    grid_blocks = cus * per_cu;
    if (ws_size < WS_END) fprintf(stderr, "kernel_launch: workspace too small: %zu < %zu\n", ws_size, (size_t)WS_END);
  }
  Params p;
  memset(&p, 0, sizeof(p));
  for (int i = 0; i < 36; ++i) p.in[i] = (const float*)d_in[i];
  p.out = (float*)d_out;
  p.ws = (unsigned char*)d_ws;
  (void)hipMemsetAsync((unsigned char*)d_ws + O_BAR, 0, XCD_BAR_WORDS * 4, stream);
#if ONE_LAUNCH
  p.p0 = 0; p.p1 = NPHASES;
  void* args[] = {&p};
  hipError_t e = hipLaunchCooperativeKernel((const void*)fwd_megakernel, dim3(grid_blocks), dim3(NT), args, LDSB, stream);
  if (e != hipSuccess) fprintf(stderr, "cooperative launch failed: %s (grid %d)\n", hipGetErrorString(e), grid_blocks);
#else
  for (int ph = 0; ph < NPHASES; ++ph) {
    p.p0 = ph; p.p1 = ph + 1;
    hipLaunchKernelGGL(fwd_megakernel, dim3(grid_blocks), dim3(NT), LDSB, stream, p);
  }
#endif
}
```

```cpp
#include <hip/hip_runtime.h>
#include <hip/hip_cooperative_groups.h>
#include <cstdio>
#include <cstdint>
#include <cstring>
namespace cg = cooperative_groups;

typedef unsigned short u16;
typedef __attribute__((ext_vector_type(8))) short bf16x8;
typedef __attribute__((ext_vector_type(4))) float f32x4;

#define NT 512
#ifndef ONE_LAUNCH
#define ONE_LAUNCH 1
#endif
#ifndef PROBE_MASK
#define PROBE_MASK 0
#endif
#define REP(cls) for (int rep_##cls = 0; rep_##cls < (((PROBE_MASK >> (cls)) & 1) ? 2 : 1); ++rep_##cls)

constexpr int D = 1024, SLAB = 16384, DFF = 2816;
constexpr int LDSB = 139264;
constexpr int FSLAB = 40960, NTOK = 81920;
constexpr int NPHASES = 2 + 5 * (6 + 8 + 7) + 5 + 4 * 7;

constexpr size_t SZW(size_t n, size_t k) { return n * k * 2; }
constexpr size_t O_WHYIN = 0;
constexpr size_t O_WHYOUT = O_WHYIN + SZW(3072, 1024);
constexpr size_t O_WRETIN = O_WHYOUT + SZW(1024, 1024);
constexpr size_t O_WRETOUT = O_WRETIN + SZW(6144, 1024);
constexpr size_t O_WSWAIN = O_WRETOUT + SZW(1024, 2048);
constexpr size_t O_WSWAOUT = O_WSWAIN + SZW(1536, 1024);
constexpr size_t O_WHGIN = O_WSWAOUT + SZW(1024, 1024);
constexpr size_t O_WHGOUT = O_WHGIN + SZW(5120, 1024);
constexpr size_t O_WFG = O_WHGOUT + SZW(1024, 1024);
constexpr size_t O_WFV = O_WFG + 4 * SZW(2816, 1024);
constexpr size_t O_WFD = O_WFV + 4 * SZW(2816, 1024);
constexpr size_t O_MOD = O_WFD + 4 * SZW(1024, 2816);
constexpr size_t O_TW = O_MOD + (size_t)4 * 16 * 6144 * 4;
constexpr size_t O_HIDS = O_TW + 8192 * 8;
constexpr size_t O_HIDP = O_HIDS + (size_t)8192 * 64 * 4;
constexpr size_t O_ROPER = O_HIDP + (size_t)2048 * 64 * 4;
constexpr size_t O_ROPES = O_ROPER + (size_t)8192 * 128 * 8;
constexpr size_t O_PROJ = O_ROPES + (size_t)8192 * 32 * 8;
constexpr size_t O_HBUF = O_PROJ + (size_t)SLAB * 6144 * 2;
constexpr size_t O_A2 = O_HBUF + (size_t)SLAB * 1024 * 2;
constexpr size_t O_C = O_A2 + (size_t)SLAB * 2048 * 2;
constexpr size_t O_FHBUF = O_PROJ;
constexpr size_t O_FGBUF = O_FHBUF + (size_t)FSLAB * 1024 * 2;
constexpr size_t O_FACT = O_FGBUF + (size_t)FSLAB * DFF * 2;
constexpr size_t END_F = O_FACT + (size_t)NTOK * DFF * 2;
constexpr size_t O_MODP = O_C;
constexpr size_t O_BAR = ((size_t)1 << 30) - 16384;
constexpr size_t O_HSPS = O_BAR - (size_t)1024 * 16384 * 8 - (size_t)1024 * 4096 * 8;
constexpr size_t O_HSPP = O_HSPS + (size_t)1024 * 16384 * 8;
constexpr size_t O_UT = O_C;
constexpr size_t O_X0C = O_UT + (size_t)SLAB * 1024 * 4;
constexpr size_t END_HY = O_X0C + (size_t)SLAB * 1024 * 2;
static_assert(END_F <= O_HSPS && END_HY <= O_HSPS, "layer-0 buffers overlap the filter spectra");
constexpr size_t SZP = (size_t)SLAB * 1024 * 2;
constexpr size_t O_QDF = O_C, O_QDB = O_QDF + SZP, O_KIF = O_QDB + SZP, O_KIB = O_KIF + SZP, O_KEF = O_KIB + SZP, O_KEB = O_KEF + SZP;
constexpr size_t O_DLF = O_KEB + SZP;
constexpr size_t O_DLB = O_DLF + (size_t)256 * 1024 * 4;
constexpr size_t O_SC = O_DLB + (size_t)256 * 1024 * 4;
constexpr size_t O_STF = O_SC + (size_t)SLAB * 1024 * 2;
constexpr size_t O_STB = O_STF + (size_t)134217728;
constexpr size_t O_OBUF = O_STB + (size_t)134217728;
constexpr size_t END_REC = O_OBUF + (size_t)SLAB * 2048 * 4;
constexpr size_t O_QN = O_C;
constexpr size_t O_KN = O_QN + SZP;
constexpr size_t O_PBUF = O_KN + (size_t)SLAB * 256 * 2;
constexpr size_t END_SWA0 = O_PBUF + (size_t)SLAB * 16 * 320 * 2;
constexpr size_t O_SA_H = O_PROJ;
constexpr size_t O_SA_P = O_SA_H + (size_t)81920 * 1024 * 2;
constexpr size_t O_SA_Q = O_SA_P + (size_t)81920 * 1536 * 2;
constexpr size_t O_SA_K = O_SA_Q + (size_t)81920 * 1024 * 2;
constexpr size_t O_SA_A = O_SA_K + (size_t)81920 * 256 * 2;
constexpr size_t END_SWA = O_SA_A + (size_t)81920 * 1024 * 2;
constexpr size_t WS_END = END_REC > END_HY ? (END_REC > END_SWA ? END_REC : END_SWA) : (END_HY > END_SWA ? END_HY : END_SWA);
static_assert(WS_END <= O_BAR, "workspace exceeds 1 GiB");

struct Params {
  const float* in[36];
  float* out;
  unsigned char* ws;
  int p0, p1;
};

extern __shared__ __attribute__((aligned(16))) unsigned char smem[];

__device__ __forceinline__ int TID() { int t = threadIdx.x; asm volatile("" : "+v"(t)); return t; }
__device__ __forceinline__ int BID() { int b = blockIdx.x; asm volatile("" : "+s"(b)); return b; }
__device__ __forceinline__ int VBID() { const int b = BID(), g = gridDim.x; return (g & 7) ? b : (b & 7) * (g >> 3) + (b >> 3); }
__device__ __forceinline__ long ZOFF() { long z = 0; asm volatile("" : "+s"(z)); return z; }
__device__ __forceinline__ unsigned char* WS(const Params& P) { return P.ws + ZOFF(); }
__device__ __forceinline__ float* OUTP(const Params& P) { return P.out + ZOFF(); }

namespace pg8 {
#define PG8_LAS __attribute__((address_space(3)))
typedef unsigned short bf16_t;
typedef short bf16x8 __attribute__((ext_vector_type(8)));
typedef float f32x4 __attribute__((ext_vector_type(4)));
typedef unsigned u32x4 __attribute__((ext_vector_type(4)));
constexpr int BM = 256, BK = 64, HALF = 128, HTB = HALF * BK * 2  , STAGE_BYTES = 8 * HTB, NXCD = 8, WGM = 8;

__host__ __device__ __forceinline__ int lds_byte(int r, int c) { const int st = (r >> 4) * 2 + (c >> 5), rr = r & 15, cc = c & 31, ob = rr * 64 + cc * 2; return st * 1024 + (ob ^ (((ob >> 9) & 1) << 5)); }
__host__ __device__ __forceinline__ void stage_rc(int b, int& R, int& C) { const int st = b / 1024, sb = b % 1024, swz = sb ^ (((sb >> 9) & 1) << 5); R = (st >> 1) * 16 + swz / 64; C = (st & 1) * 32 + (swz % 64) / 2; }
__host__ __device__ __forceinline__ int perm32(int rho) { const int n = rho >> 4, i = rho & 15; return 8 * (i >> 2) + 4 * n + (i & 3); }

struct Unit { int pm, pn; };
struct Gemm { const bf16_t* A; const bf16_t* Bt; int M, N, K; };

struct StaticOrder {
    int nM, nN, nwg, G, c;
    __host__ __device__ void init(int M, int N, int G_, int c_) { nM = M / BM; nN = N / BM; nwg = nM * nN; G = G_; c = c_; }
    __host__ __device__ bool next(int i, Unit& u) const {
        const long L = (long)i * G + c; if (L >= nwg) return false;
        int wgid = (int)L; { const int q = nwg / NXCD, r = nwg % NXCD, xcd = wgid % NXCD, off = wgid / NXCD; wgid = (xcd < r ? xcd * (q + 1) : r * (q + 1) + (xcd - r) * q) + off; }
        const int nig = WGM * nN, gid = wgid / nig, fm = gid * WGM, gsz = (nM - fm) < WGM ? (nM - fm) : WGM;
        u.pm = fm + ((wgid % nig) % gsz); u.pn = (wgid % nig) / gsz; return true;
    }
    __device__ __forceinline__ void a_ready(const Unit&) const {}
    __device__ __forceinline__ void done(const Unit&) const {}
};

template <class Epi, class Sched, bool STAMP = false>
__device__ __forceinline__ void gemm_phase(PG8_LAS unsigned char* lds, const Gemm g, const Sched& S, const Epi& E, unsigned long long* stamps) {
    const int tid = TID(), wid = __builtin_amdgcn_readfirstlane(tid >> 6), lane = tid & 63, wr = wid >> 2, wc = wid & 3, fr = lane & 15, fq = lane >> 4;
    const int K = g.K, nt = K / BK;
    int ts_lo = 0, ts_hi = 0, nts = 0; const unsigned long long rt_entry = STAMP ? (unsigned long long)wall_clock64() : 0ull;
#define PG8_STAMP() do { if (STAMP && wid == 0 && nts < 64) { const unsigned long long _c = (unsigned long long)clock64(); \
        ts_lo = (lane == nts) ? (int)(unsigned)_c : ts_lo; ts_hi = (lane == nts) ? (int)(unsigned)(_c >> 32) : ts_hi; ++nts; } } while (0)
    PG8_STAMP();
    unsigned voffA[2], voffB[2];
#pragma unroll
    for (int i = 0; i < 2; ++i) { int R, C; stage_rc(tid * 16 + i * 8192, R, C); const int Rb = Epi::PERM ? ((R & ~31) + perm32(R & 31)) : R;
        voffA[i] = (unsigned)(R * K + C) * 2u; voffB[i] = (unsigned)(Rb * K + C) * 2u; }
    const size_t kstep = (size_t)(BK * 2);
    const size_t hstep = (size_t)HALF * K * 2;
    const size_t tstep = 2 * hstep;
    const unsigned ldsw = (unsigned)wid * 1024u;
    const int aoff = lds_byte(wr * 64 + fr, fq * 8), boff = lds_byte(wc * 32 + fr, fq * 8);
#define PG8_SA(b, h) (((b) * 2 + (h)) * HTB)
#define PG8_SB(b, h) ((4 + (b) * 2 + (h)) * HTB)
#define PG8_STAGE(bufoff, gbase, voff) do { _Pragma("unroll") for (int _i = 0; _i < 2; ++_i) \
        __builtin_amdgcn_global_load_lds((const unsigned*)((const char*)(gbase) + (voff)[_i]), (PG8_LAS unsigned*)(lds + (bufoff) + ldsw + _i * 8192), 16, 0, 0); } while (0)
#define PG8_LDA(dst, b, h) do { _Pragma("unroll") for (int m = 0; m < 4; ++m) _Pragma("unroll") for (int k = 0; k < 2; ++k) dst[m][k] = *(const PG8_LAS bf16x8*)(lds + PG8_SA(b, h) + aoff + m * 2048 + k * 1024); } while (0)
#define PG8_LDB(dst, b, h) do { _Pragma("unroll") for (int n = 0; n < 2; ++n) _Pragma("unroll") for (int k = 0; k < 2; ++k) dst[n][k] = *(const PG8_LAS bf16x8*)(lds + PG8_SB(b, h) + boff + n * 2048 + k * 1024); } while (0)
#define PG8_MMA(ai, bj, At, Bt) do { __builtin_amdgcn_s_setprio(1); _Pragma("unroll") for (int m = 0; m < 4; ++m) _Pragma("unroll") for (int n = 0; n < 2; ++n) _Pragma("unroll") for (int k = 0; k < 2; ++k) \
        acc[ai][bj][m][n] = __builtin_amdgcn_mfma_f32_16x16x32_bf16(Bt[n][k], At[m][k], acc[ai][bj][m][n], 0, 0, 0); __builtin_amdgcn_s_setprio(0); } while (0)
#define PG8_WAIT_V(n) asm volatile("s_waitcnt vmcnt(" #n ")" ::: "memory")
#define PG8_WAIT_L(n) asm volatile("s_waitcnt lgkmcnt(" #n ")" ::: "memory")
#define PG8_BAR __builtin_amdgcn_s_barrier()
#define PG8_SCHED __builtin_amdgcn_sched_barrier(0)
    Unit cur, nxt; int ui = 0;
    if (!S.next(0, cur)) return;
    f32x4 acc[2][2][4][2];
#pragma unroll
    for (int a = 0; a < 2; ++a)
#pragma unroll
        for (int b = 0; b < 2; ++b)
#pragma unroll
            for (int m = 0; m < 4; ++m)
#pragma unroll
                for (int n = 0; n < 2; ++n) acc[a][b][m][n] = (f32x4){0.f, 0.f, 0.f, 0.f};
    bf16x8 At[4][2], B0[2][2], B1[2][2];
    const char* cA = (const char*)g.A + (size_t)cur.pm * tstep; const char* cB = (const char*)g.Bt + (size_t)cur.pn * tstep;
    S.a_ready(cur);
    PG8_STAGE(PG8_SB(0, 0), cB, voffB); PG8_STAGE(PG8_SA(0, 0), cA, voffA); PG8_STAGE(PG8_SB(0, 1), cB + hstep, voffB); PG8_STAGE(PG8_SA(0, 1), cA + hstep, voffA);
    if (wr == 1) PG8_BAR;
    PG8_WAIT_V(4); PG8_BAR;
    PG8_STAGE(PG8_SB(1, 0), cB + kstep, voffB); PG8_STAGE(PG8_SA(1, 0), cA + kstep, voffA); PG8_STAGE(PG8_SB(1, 1), cB + hstep + kstep, voffB);
    PG8_WAIT_V(6); PG8_BAR;
    PG8_STAMP();
    for (;;) {
        const bool has_next = S.next(ui + 1, nxt);
        const char* nA = has_next ? (const char*)g.A + (size_t)nxt.pm * tstep : cA; const char* nB = has_next ? (const char*)g.Bt + (size_t)nxt.pn * tstep : cB;
        for (int t = 0; t < nt; t += 2) {
            const bool last = (t == nt - 2);
            const char* a1 = cA + (size_t)(t + 1) * kstep;
            const char* a2 = last ? nA : cA + (size_t)(t + 2) * kstep; const char* b2 = last ? nB : cB + (size_t)(t + 2) * kstep;
            const char* a3 = a2 + kstep; const char* b3 = b2 + kstep;
            if (last && has_next) S.a_ready(nxt);
            PG8_LDB(B0, 0, 0); PG8_SCHED; PG8_LDA(At, 0, 0); PG8_STAGE(PG8_SA(1, 1), a1 + hstep, voffA);
            PG8_WAIT_L(8); PG8_BAR; PG8_WAIT_L(0); PG8_MMA(0, 0, At, B0); PG8_BAR; PG8_SCHED;
            PG8_LDB(B1, 0, 1); PG8_STAGE(PG8_SB(0, 0), b2, voffB);
            PG8_BAR; PG8_WAIT_L(0); PG8_MMA(0, 1, At, B1); PG8_BAR;
            PG8_LDA(At, 0, 1); PG8_STAGE(PG8_SA(0, 0), a2, voffA);
            PG8_BAR; PG8_WAIT_L(0); PG8_MMA(1, 0, At, B0); PG8_BAR; PG8_SCHED;
            PG8_STAGE(PG8_SB(0, 1), b2 + hstep, voffB);
            PG8_WAIT_V(6); PG8_BAR; PG8_MMA(1, 1, At, B1); PG8_BAR;
            PG8_LDB(B0, 1, 0); PG8_SCHED; PG8_LDA(At, 1, 0); PG8_STAGE(PG8_SA(0, 1), a2 + hstep, voffA);
            PG8_WAIT_L(8); PG8_BAR; PG8_WAIT_L(0); PG8_MMA(0, 0, At, B0); PG8_BAR; PG8_SCHED;
            PG8_LDB(B1, 1, 1); PG8_STAGE(PG8_SB(1, 0), b3, voffB);
            PG8_BAR; PG8_WAIT_L(0); PG8_MMA(0, 1, At, B1); PG8_BAR;
            PG8_LDA(At, 1, 1); PG8_STAGE(PG8_SA(1, 0), a3, voffA);
            PG8_BAR; PG8_WAIT_L(0); PG8_MMA(1, 0, At, B0); PG8_BAR; PG8_SCHED;
            PG8_STAGE(PG8_SB(1, 1), b3 + hstep, voffB);
            PG8_WAIT_V(6); PG8_BAR; PG8_MMA(1, 1, At, B1); PG8_BAR;
        }
        PG8_STAMP();
        if constexpr (!Epi::AFTER_DRAIN) { E(acc, cur, wr, wc, fr, fq); S.done(cur); }
        PG8_STAMP();
        if (!has_next) break;
#pragma unroll
        for (int a = 0; a < 2; ++a)
#pragma unroll
            for (int b = 0; b < 2; ++b)
#pragma unroll
                for (int m = 0; m < 4; ++m)
#pragma unroll
                    for (int n = 0; n < 2; ++n) acc[a][b][m][n] = (f32x4){0.f, 0.f, 0.f, 0.f};
        cur = nxt; cA = nA; cB = nB; ++ui;
    }
    PG8_WAIT_V(0);
    if (wr == 0) PG8_BAR;
    PG8_BAR;
    if constexpr (Epi::AFTER_DRAIN) { E.fused(acc, cur, wr, wc, fr, fq, lds, wid, lane); S.done(cur); }
    PG8_STAMP();
    if (STAMP && wid == 0) { stamps[lane] = lane < nts ? (((unsigned long long)(unsigned)ts_hi << 32) | (unsigned)ts_lo) : 0ull;
        if (lane == 62) stamps[62] = rt_entry; if (lane == 63) stamps[63] = (unsigned long long)wall_clock64(); }
#undef PG8_STAMP
#undef PG8_SA
#undef PG8_SB
#undef PG8_STAGE
#undef PG8_LDA
#undef PG8_LDB
#undef PG8_MMA
#undef PG8_WAIT_V
#undef PG8_WAIT_L
#undef PG8_BAR
#undef PG8_SCHED
}
}


__device__ __forceinline__ u16 f2bf(float f) {
  unsigned u = __float_as_uint(f);
  u += 0x7fffu + ((u >> 16) & 1u);
  return (u16)(u >> 16);
}
__device__ __forceinline__ float bf2f(u16 h) { return __uint_as_float(((unsigned)h) << 16); }
__device__ __forceinline__ unsigned pack2(float a, float b) { return (unsigned)f2bf(a) | ((unsigned)f2bf(b) << 16); }
__device__ __forceinline__ void unpack8(const uint4 v, float (&f)[8]) {
  f[0] = bf2f((u16)(v.x & 0xffff)); f[1] = bf2f((u16)(v.x >> 16)); f[2] = bf2f((u16)(v.y & 0xffff)); f[3] = bf2f((u16)(v.y >> 16));
  f[4] = bf2f((u16)(v.z & 0xffff)); f[5] = bf2f((u16)(v.z >> 16)); f[6] = bf2f((u16)(v.w & 0xffff)); f[7] = bf2f((u16)(v.w >> 16));
}
__device__ __forceinline__ uint4 pack8s(const float (&f)[8], float sc) {
  return make_uint4(pack2(f[0] * sc, f[1] * sc), pack2(f[2] * sc, f[3] * sc), pack2(f[4] * sc, f[5] * sc), pack2(f[6] * sc, f[7] * sc));
}
__device__ __forceinline__ float silu_f(float x) { return x / (1.f + __expf(-x)); }
__device__ __forceinline__ float sigm(float x) { return 1.f / (1.f + __expf(-x)); }
__device__ __forceinline__ float wave_sum(float v) {
#pragma unroll
  for (int o = 32; o; o >>= 1) v += __shfl_xor(v, o);
  return v;
}
__device__ __forceinline__ const float* xin_of(const Params& P, int slab) { return slab == 0 ? P.in[0] : P.in[1] + (long)(slab - 1) * SLAB * D; }
__device__ __forceinline__ int Lof(int slab) { return slab == 0 ? 2048 : 8192; }
__device__ __forceinline__ int gb_row(int gr) { return gr < 16384 ? (gr >> 11) : (8 + ((gr - 16384) >> 13)); }
__device__ __forceinline__ int gb_of(int slab, int r) { return slab == 0 ? (r >> 11) : (8 + (slab - 1) * 2 + (r >> 13)); }

typedef short v4s __attribute__((ext_vector_type(4)));
#define LBAR() asm volatile("s_waitcnt lgkmcnt(0)\n\ts_barrier" ::: "memory")
#define LDS_AS __attribute__((address_space(3)))
template <int R, bool KC>
__device__ __forceinline__ uint4 ld_chunk(const u16* __restrict__ base, long ld, int k0, int c) {
  if (KC) {
    const int r = c >> 3, kc = c & 7;
    return *(const uint4*)(base + (long)r * ld + k0 + kc * 8);
  } else {
    const int k = c / (R / 8), mc = c % (R / 8);
    return *(const uint4*)(base + (long)(k0 + k) * ld + mc * 8);
  }
}
template <int R, bool KC>
__device__ __forceinline__ void st_chunk(u16* s, uint4 v, int c) {
  if (KC) {
    const int r = c >> 3, kc = c & 7;
    *(uint4*)(s + r * 72 + kc * 8) = v;
  } else {
    const int k = c / (R / 8), mc = c % (R / 8);
    *(uint4*)(s + k * (R + 8) + mc * 8) = v;
  }
}
template <int R, bool KC>
__device__ __forceinline__ bf16x8 ld_frag(const u16* s, int x0, int ks, int fr, int fq) {
  if (KC) {
    return *(const bf16x8*)(s + (x0 + fr) * 72 + ks * 32 + fq * 8);
  } else {
    const int q4 = fr >> 2, p4 = fr & 3;
    const u16* p = s + (ks * 32 + 8 * fq + q4) * (R + 8) + x0 + 4 * p4;
    v4s lo = __builtin_amdgcn_ds_read_tr16_b64_v4i16((LDS_AS v4s*)p);
    v4s hi = __builtin_amdgcn_ds_read_tr16_b64_v4i16((LDS_AS v4s*)(p + 4 * (R + 8)));
    bf16x8 r;
    r[0] = lo[0]; r[1] = lo[1]; r[2] = lo[2]; r[3] = lo[3]; r[4] = hi[0]; r[5] = hi[1]; r[6] = hi[2]; r[7] = hi[3];
    return r;
  }
}

template <int TM, int TN, bool AKC, bool BKC, bool TR, int KT>
__device__ __forceinline__ void gemm_acc(f32x4 (&acc)[TM / 32][TN / 64], const u16* __restrict__ A, long lda,
                                         const u16* __restrict__ B, long ldb, u16* sm) {
  u16* As = sm;
  u16* Bs = sm + 9216;
  const int tid = TID(), lane = tid & 63, wid = tid >> 6;
  const int wm = wid >> 2, wn = wid & 3, fr = lane & 15, fq = lane >> 4;
  constexpr int MI = TM / 32, NI = TN / 64;
  uint4 ra0[KT], ra1[KT], rb0[KT], rb1[KT];
#pragma unroll
  for (int kt = 0; kt < KT; ++kt) {
    ra0[kt] = ld_chunk<TM, AKC>(A, lda, kt * 64, tid);
    ra1[kt] = ra0[kt];
    if (TM == 128) ra1[kt] = ld_chunk<TM, AKC>(A, lda, kt * 64, tid + NT);
    rb0[kt] = ld_chunk<TN, BKC>(B, ldb, kt * 64, tid);
    rb1[kt] = rb0[kt];
    if (TN == 128) rb1[kt] = ld_chunk<TN, BKC>(B, ldb, kt * 64, tid + NT);
  }
  __syncthreads();
  st_chunk<TM, AKC>(As, ra0[0], tid);
  if (TM == 128) st_chunk<TM, AKC>(As, ra1[0], tid + NT);
  st_chunk<TN, BKC>(Bs, rb0[0], tid);
  if (TN == 128) st_chunk<TN, BKC>(Bs, rb1[0], tid + NT);
  __syncthreads();
#pragma unroll
  for (int kt = 0; kt < KT; ++kt) {
    u16* Ac = As + (kt & 1) * 18432;
    u16* Bc = Bs + (kt & 1) * 18432;
    if (kt + 1 < KT) {
      u16* An = As + ((kt + 1) & 1) * 18432;
      u16* Bn = Bs + ((kt + 1) & 1) * 18432;
      st_chunk<TM, AKC>(An, ra0[kt + 1 < KT ? kt + 1 : 0], tid);
      if (TM == 128) st_chunk<TM, AKC>(An, ra1[kt + 1 < KT ? kt + 1 : 0], tid + NT);
      st_chunk<TN, BKC>(Bn, rb0[kt + 1 < KT ? kt + 1 : 0], tid);
      if (TN == 128) st_chunk<TN, BKC>(Bn, rb1[kt + 1 < KT ? kt + 1 : 0], tid + NT);
    }
#pragma unroll
    for (int ks = 0; ks < 2; ++ks) {
      bf16x8 af[MI], bfr[NI];
#pragma unroll
      for (int mi = 0; mi < MI; ++mi) af[mi] = ld_frag<TM, AKC>(Ac, wm * (TM / 2) + mi * 16, ks, fr, fq);
#pragma unroll
      for (int ni = 0; ni < NI; ++ni) bfr[ni] = ld_frag<TN, BKC>(Bc, wn * (TN / 4) + ni * 16, ks, fr, fq);
#pragma unroll
      for (int mi = 0; mi < MI; ++mi)
#pragma unroll
        for (int ni = 0; ni < NI; ++ni)
          acc[mi][ni] = TR ? __builtin_amdgcn_mfma_f32_16x16x32_bf16(bfr[ni], af[mi], acc[mi][ni], 0, 0, 0)
                           : __builtin_amdgcn_mfma_f32_16x16x32_bf16(af[mi], bfr[ni], acc[mi][ni], 0, 0, 0);
    }
    __syncthreads();
  }
}

template <int KT> struct Tiles { uint4 a0[KT], a1[KT], b0[KT], b1[KT]; };
template <int TM, int TN, bool AKC, bool BKC, int KT>
__device__ __forceinline__ void tiles_issue(Tiles<KT>& t, const u16* __restrict__ A, long lda, const u16* __restrict__ B, long ldb) {
  const int tid = TID();
#pragma unroll
  for (int kt = 0; kt < KT; ++kt) {
    t.a0[kt] = ld_chunk<TM, AKC>(A, lda, kt * 64, tid);
    t.a1[kt] = t.a0[kt];
    if (TM == 128) t.a1[kt] = ld_chunk<TM, AKC>(A, lda, kt * 64, tid + NT);
    t.b0[kt] = ld_chunk<TN, BKC>(B, ldb, kt * 64, tid);
    t.b1[kt] = t.b0[kt];
    if (TN == 128) t.b1[kt] = ld_chunk<TN, BKC>(B, ldb, kt * 64, tid + NT);
  }
}
template <int TM, int TN, bool AKC, bool BKC, bool TR, int KT>
__device__ __forceinline__ void gemm_run(f32x4 (&acc)[TM / 32][TN / 64], const Tiles<KT>& t, u16* sm) {
  u16* As = sm;
  u16* Bs = sm + 9216;
  const int tid = TID(), lane = tid & 63, wid = tid >> 6;
  const int wm = wid >> 2, wn = wid & 3, fr = lane & 15, fq = lane >> 4;
  constexpr int MI = TM / 32, NI = TN / 64;
  __syncthreads();
  st_chunk<TM, AKC>(As, t.a0[0], tid);
  if (TM == 128) st_chunk<TM, AKC>(As, t.a1[0], tid + NT);
  st_chunk<TN, BKC>(Bs, t.b0[0], tid);
  if (TN == 128) st_chunk<TN, BKC>(Bs, t.b1[0], tid + NT);
  __syncthreads();
#pragma unroll
  for (int kt = 0; kt < KT; ++kt) {
    u16* Ac = As + (kt & 1) * 18432;
    u16* Bc = Bs + (kt & 1) * 18432;
    if (kt + 1 < KT) {
      u16* An = As + ((kt + 1) & 1) * 18432;
      u16* Bn = Bs + ((kt + 1) & 1) * 18432;
      st_chunk<TM, AKC>(An, t.a0[kt + 1 < KT ? kt + 1 : 0], tid);
      if (TM == 128) st_chunk<TM, AKC>(An, t.a1[kt + 1 < KT ? kt + 1 : 0], tid + NT);
      st_chunk<TN, BKC>(Bn, t.b0[kt + 1 < KT ? kt + 1 : 0], tid);
      if (TN == 128) st_chunk<TN, BKC>(Bn, t.b1[kt + 1 < KT ? kt + 1 : 0], tid + NT);
    }
#pragma unroll
    for (int ks = 0; ks < 2; ++ks) {
      bf16x8 af[MI], bfr[NI];
#pragma unroll
      for (int mi = 0; mi < MI; ++mi) af[mi] = ld_frag<TM, AKC>(Ac, wm * (TM / 2) + mi * 16, ks, fr, fq);
#pragma unroll
      for (int ni = 0; ni < NI; ++ni) bfr[ni] = ld_frag<TN, BKC>(Bc, wn * (TN / 4) + ni * 16, ks, fr, fq);
#pragma unroll
      for (int mi = 0; mi < MI; ++mi)
#pragma unroll
        for (int ni = 0; ni < NI; ++ni)
          acc[mi][ni] = TR ? __builtin_amdgcn_mfma_f32_16x16x32_bf16(bfr[ni], af[mi], acc[mi][ni], 0, 0, 0)
                           : __builtin_amdgcn_mfma_f32_16x16x32_bf16(af[mi], bfr[ni], acc[mi][ni], 0, 0, 0);
    }
    __syncthreads();
  }
}

template <int TM, int TN, bool TR, class F>
__device__ __forceinline__ void epi_each(f32x4 (&acc)[TM / 32][TN / 64], F f) {
  const int tid = TID(), lane = tid & 63, wid = tid >> 6;
  const int wm = wid >> 2, wn = wid & 3, fr = lane & 15, fq = lane >> 4;
#pragma unroll
  for (int mi = 0; mi < TM / 32; ++mi)
#pragma unroll
    for (int ni = 0; ni < TN / 64; ++ni) {
      const int r0 = wm * (TM / 2) + mi * 16, c0 = wn * (TN / 4) + ni * 16;
      if (TR) f(r0 + fr, c0 + fq * 4, acc[mi][ni]);
      else f(r0 + fq * 4, c0 + fr, acc[mi][ni]);
    }
}

struct EpiStoreBf16 {
  static constexpr bool PERM = true, AFTER_DRAIN = false;
  u16* O; int ldc;
  __device__ __forceinline__ void operator()(const f32x4 (&acc)[2][2][4][2], const pg8::Unit& u, int wr, int wc, int fr, int fq) const {
    const int row0 = u.pm * 256 + wr * 64 + fr, col0 = u.pn * 256 + wc * 32 + 8 * fq;
#pragma unroll
    for (int ai = 0; ai < 2; ++ai)
#pragma unroll
      for (int m = 0; m < 4; ++m) {
        u16* rowp = O + (size_t)(row0 + ai * 128 + m * 16) * ldc + col0;
#pragma unroll
        for (int bj = 0; bj < 2; ++bj) {
          const f32x4 v0 = acc[ai][bj][m][0], v1 = acc[ai][bj][m][1];
          *(uint4*)(rowp + bj * 128) = make_uint4(pack2(v0[0], v0[1]), pack2(v0[2], v0[3]), pack2(v1[0], v1[1]), pack2(v1[2], v1[3]));
        }
      }
  }
};
struct EpiResid {
  static constexpr bool PERM = false, AFTER_DRAIN = false;
  float* X; const float* XS; const float* mod; int goff; int grow0;
  __device__ __forceinline__ void operator()(const f32x4 (&acc)[2][2][4][2], const pg8::Unit& u, int wr, int wc, int fr, int fq) const {
    const int row0 = u.pm * 256 + wr * 64 + fr, col0 = u.pn * 256 + wc * 32 + 4 * fq;
    const float* g = mod + (size_t)gb_row(grow0 + u.pm * 256) * 6144 + goff + col0;
    f32x4 gv[2][2];
#pragma unroll
    for (int bj = 0; bj < 2; ++bj)
#pragma unroll
      for (int n = 0; n < 2; ++n) gv[bj][n] = *(const f32x4*)(g + bj * 128 + n * 16);
#pragma unroll
    for (int am = 0; am < 4; ++am) {
      f32x4 xv[2][2][2];
#pragma unroll
      for (int mm = 0; mm < 2; ++mm)
#pragma unroll
        for (int bj = 0; bj < 2; ++bj)
#pragma unroll
          for (int n = 0; n < 2; ++n) xv[mm][bj][n] = *(const f32x4*)(XS + (size_t)(row0 + (am >> 1) * 128 + ((am & 1) * 2 + mm) * 16) * D + col0 + bj * 128 + n * 16);
#pragma unroll
      for (int mm = 0; mm < 2; ++mm)
#pragma unroll
        for (int bj = 0; bj < 2; ++bj)
#pragma unroll
          for (int n = 0; n < 2; ++n)
            *(f32x4*)(X + (size_t)(row0 + (am >> 1) * 128 + ((am & 1) * 2 + mm) * 16) * D + col0 + bj * 128 + n * 16) = xv[mm][bj][n] + gv[bj][n] * acc[am >> 1][bj][(am & 1) * 2 + mm][n];
    }
  }
};
struct EpiFfnVal {
  static constexpr bool PERM = false, AFTER_DRAIN = false;
  const u16* G; u16* ACT; const float* cw; const float* cb; int grow0;
  __device__ __forceinline__ void operator()(const f32x4 (&acc)[2][2][4][2], const pg8::Unit& u, int wr, int wc, int fr, int fq) const {
    const int row0 = u.pm * 256 + wr * 64 + fr, col0 = u.pn * 256 + wc * 32 + 4 * fq;
#pragma unroll
    for (int bj = 0; bj < 2; ++bj)
#pragma unroll
      for (int n = 0; n < 2; ++n) {
        const int c = col0 + bj * 128 + n * 16;
        const f32x4 w0 = *(const f32x4*)(cw + c), w1 = *(const f32x4*)(cw + DFF + c), w2 = *(const f32x4*)(cw + 2 * DFF + c), bb = *(const f32x4*)(cb + c);
#pragma unroll
        for (int ai = 0; ai < 2; ++ai) {
          uint2 g0[4], g1[4], g2[4];
#pragma unroll
          for (int m = 0; m < 4; ++m) {
            const int r = row0 + ai * 128 + m * 16;
            const int L = (grow0 + r) < 16384 ? 2048 : 8192;
            const int pos = (grow0 + r) & (L - 1);
            const u16* gp = G + (size_t)r * DFF + c;
            g1[m] = *(const uint2*)gp;
            g0[m] = *(const uint2*)(gp - (pos > 0 ? DFF : 0));
            g2[m] = *(const uint2*)(gp + (pos < L - 1 ? DFF : 0));
          }
#pragma unroll
          for (int m = 0; m < 4; ++m) {
            const int r = row0 + ai * 128 + m * 16;
            const int L = (grow0 + r) < 16384 ? 2048 : 8192;
            const int pos = (grow0 + r) & (L - 1);
            const float m0 = pos > 0 ? 1.f : 0.f, m2 = pos < L - 1 ? 1.f : 0.f;
            const uint2 a0 = g0[m], a1 = g1[m], a2 = g2[m];
            f32x4 a;
            a[0] = m0 * bf2f((u16)(a0.x & 0xffff)) * w0[0] + bf2f((u16)(a1.x & 0xffff)) * w1[0] + m2 * bf2f((u16)(a2.x & 0xffff)) * w2[0] + bb[0];
            a[1] = m0 * bf2f((u16)(a0.x >> 16)) * w0[1] + bf2f((u16)(a1.x >> 16)) * w1[1] + m2 * bf2f((u16)(a2.x >> 16)) * w2[1] + bb[1];
            a[2] = m0 * bf2f((u16)(a0.y & 0xffff)) * w0[2] + bf2f((u16)(a1.y & 0xffff)) * w1[2] + m2 * bf2f((u16)(a2.y & 0xffff)) * w2[2] + bb[2];
            a[3] = m0 * bf2f((u16)(a0.y >> 16)) * w0[3] + bf2f((u16)(a1.y >> 16)) * w1[3] + m2 * bf2f((u16)(a2.y >> 16)) * w2[3] + bb[3];
            const f32x4 v = acc[ai][bj][m][n];
            *(uint2*)(ACT + (size_t)r * DFF + c) = make_uint2(pack2(silu_f(a[0]) * v[0], silu_f(a[1]) * v[1]), pack2(silu_f(a[2]) * v[2], silu_f(a[3]) * v[3]));
          }
        }
      }
  }
};
template <class Epi>
__device__ __forceinline__ void run_gemm(const u16* A, const u16* Bt, int M, int N, int K, const Epi& E) {
  pg8::Gemm g; g.A = A; g.Bt = Bt; g.M = M; g.N = N; g.K = K;
  pg8::StaticOrder S; S.init(M, N, gridDim.x, BID());
  __syncthreads();
  pg8::gemm_phase<Epi, pg8::StaticOrder, false>((PG8_LAS unsigned char*)smem, g, S, E, nullptr);
  __syncthreads();
}

__device__ __forceinline__ int fidx(int p) { return p + ((p >> 6) << 2); }
__device__ __forceinline__ float2 cmulf(float2 a, float2 b) { return make_float2(a.x * b.x - a.y * b.y, a.x * b.y + a.y * b.x); }
__device__ __forceinline__ float2 cmulcf(float2 a, float2 b) { return make_float2(a.x * b.x + a.y * b.y, a.y * b.x - a.x * b.y); }
#define R16C(q) ((q) == 0 ? 1.f : (q) == 1 ? 0.9238795325f : (q) == 2 ? 0.7071067812f : (q) == 3 ? 0.3826834324f : (q) == 4 ? 0.f : (q) == 5 ? -0.3826834324f : (q) == 6 ? -0.7071067812f : -0.9238795325f)
#define R16S(q) ((q) == 0 ? 0.f : (q) == 1 ? -0.3826834324f : (q) == 2 ? -0.7071067812f : (q) == 3 ? -0.9238795325f : (q) == 4 ? -1.f : (q) == 5 ? -0.9238795325f : (q) == 6 ? -0.7071067812f : -0.3826834324f)
template <int N, int RS, bool INV>
__device__ __forceinline__ void fft_pass(float2* x, const float2* __restrict__ tw, const int S, const int tid) {
  constexpr int R = 1 << RS;
  const int E = S >> (RS - 1);
#pragma unroll 1
  for (int g = tid; g < N / R; g += NT) {
    const int blo = g & (E - 1);
    const int base = ((g - blo) << RS) + blo;
    float2 e[R];
#pragma unroll
    for (int k = 0; k < R; ++k) e[k] = x[fidx(base + k * E)];
    float2 wb[RS];
#pragma unroll
    for (int st = 0; st < RS; ++st) wb[st] = tw[blo * (8192 / (S >> st))];
#pragma unroll
    for (int sq = 0; sq < RS; ++sq) {
      const int st = INV ? (RS - 1 - sq) : sq;
      const int h = (R / 2) >> st;
#pragma unroll
      for (int k = 0; k < R; ++k) {
        if ((k & h) == 0) {
          const int m = k & (h - 1);
          const int q = m * (8 / h);
          float2 w = wb[st];
          if (q != 0) w = cmulf(w, make_float2(R16C(q), R16S(q)));
          if (!INV) {
            const float2 a = e[k], b = e[k + h];
            e[k] = make_float2(a.x + b.x, a.y + b.y);
            e[k + h] = cmulf(make_float2(a.x - b.x, a.y - b.y), w);
          } else {
            const float2 a = e[k], b = cmulcf(e[k + h], w);
            e[k] = make_float2(a.x + b.x, a.y + b.y);
            e[k + h] = make_float2(a.x - b.x, a.y - b.y);
          }
        }
      }
    }
#pragma unroll
    for (int k = 0; k < R; ++k) x[fidx(base + k * E)] = e[k];
  }
  __syncthreads();
}
template <int N>
__device__ __forceinline__ void fft_dif_t(float2* x, const float2* __restrict__ tw) {
  const int tid = TID();
  if (N == 16384) {
    fft_pass<N, 4, false>(x, tw, 8192, tid); fft_pass<N, 4, false>(x, tw, 512, tid);
    fft_pass<N, 4, false>(x, tw, 32, tid); fft_pass<N, 2, false>(x, tw, 2, tid);
  } else {
    fft_pass<N, 4, false>(x, tw, 2048, tid); fft_pass<N, 4, false>(x, tw, 128, tid); fft_pass<N, 4, false>(x, tw, 8, tid);
  }
}
template <int N>
__device__ __forceinline__ void ifft_dit_t(float2* x, const float2* __restrict__ tw) {
  const int tid = TID();
  if (N == 16384) {
    fft_pass<N, 2, true>(x, tw, 2, tid); fft_pass<N, 4, true>(x, tw, 32, tid);
    fft_pass<N, 4, true>(x, tw, 512, tid); fft_pass<N, 4, true>(x, tw, 8192, tid);
  } else {
    fft_pass<N, 4, true>(x, tw, 8, tid); fft_pass<N, 4, true>(x, tw, 128, tid); fft_pass<N, 4, true>(x, tw, 2048, tid);
  }
}
template <int N, int RS>
__device__ __forceinline__ void fft_pass_mid(float2* x, const float2* __restrict__ tw, const float2* __restrict__ hs, const int S, const int tid) {
  constexpr int R = 1 << RS;
  const int E = S >> (RS - 1);
#pragma unroll 1
  for (int g = tid; g < N / R; g += NT) {
    const int blo = g & (E - 1);
    const int base = ((g - blo) << RS) + blo;
    float2 e[R];
#pragma unroll
    for (int k = 0; k < R; ++k) e[k] = x[fidx(base + k * E)];
    float2 hv[R];
#pragma unroll
    for (int k = 0; k < R; ++k) hv[k] = hs[base + k * E];
    float2 wb[RS];
#pragma unroll
    for (int st = 0; st < RS; ++st) wb[st] = tw[blo * (8192 / (S >> st))];
#pragma unroll
    for (int st = 0; st < RS; ++st) {
      const int h = (R / 2) >> st;
#pragma unroll
      for (int k = 0; k < R; ++k) {
        if ((k & h) == 0) {
          const int q = (k & (h - 1)) * (8 / h);
          float2 w = wb[st];
          if (q != 0) w = cmulf(w, make_float2(R16C(q), R16S(q)));
          const float2 a = e[k], b = e[k + h];
          e[k] = make_float2(a.x + b.x, a.y + b.y);
          e[k + h] = cmulf(make_float2(a.x - b.x, a.y - b.y), w);
        }
      }
    }
#pragma unroll
    for (int k = 0; k < R; ++k) e[k] = cmulf(e[k], hv[k]);
#pragma unroll
    for (int sq = 0; sq < RS; ++sq) {
      const int st = RS - 1 - sq;
      const int h = (R / 2) >> st;
#pragma unroll
      for (int k = 0; k < R; ++k) {
        if ((k & h) == 0) {
          const int q = (k & (h - 1)) * (8 / h);
          float2 w = wb[st];
          if (q != 0) w = cmulf(w, make_float2(R16C(q), R16S(q)));
          const float2 a = e[k], b = cmulcf(e[k + h], w);
          e[k] = make_float2(a.x + b.x, a.y + b.y);
          e[k + h] = make_float2(a.x - b.x, a.y - b.y);
        }
      }
    }
#pragma unroll
    for (int k = 0; k < R; ++k) x[fidx(base + k * E)] = e[k];
  }
  __syncthreads();
}
__device__ __forceinline__ void fft_conv(float2* x, int N, const float2* __restrict__ tw, const float2* __restrict__ hs) {
  const int tid = TID();
  if (N == 16384) {
    fft_pass<16384, 4, false>(x, tw, 8192, tid); fft_pass<16384, 4, false>(x, tw, 512, tid); fft_pass<16384, 4, false>(x, tw, 32, tid);
    fft_pass_mid<16384, 2>(x, tw, hs, 2, tid);
    fft_pass<16384, 4, true>(x, tw, 32, tid); fft_pass<16384, 4, true>(x, tw, 512, tid); fft_pass<16384, 4, true>(x, tw, 8192, tid);
  } else {
    fft_pass<4096, 4, false>(x, tw, 2048, tid); fft_pass<4096, 4, false>(x, tw, 128, tid);
    fft_pass_mid<4096, 4>(x, tw, hs, 8, tid);
    fft_pass<4096, 4, true>(x, tw, 128, tid); fft_pass<4096, 4, true>(x, tw, 2048, tid);
  }
}
__device__ __forceinline__ void fft_dif(float2* x, int N, const float2* __restrict__ tw) {
  if (N == 16384) fft_dif_t<16384>(x, tw); else fft_dif_t<4096>(x, tw);
}
__device__ __forceinline__ void ifft_dit(float2* x, int N, const float2* __restrict__ tw) {
  if (N == 16384) ifft_dit_t<16384>(x, tw); else ifft_dit_t<4096>(x, tw);
}

__device__ void transpose_w(const float* __restrict__ W, u16* __restrict__ Wt, int K, int N) {
  float* smf = (float*)smem;
  const int tk = K / 64, tn = N / 64, tid = TID(), G = gridDim.x;
  const int kk0 = tid >> 4, n40 = tid & 15, kk1 = (tid + NT) >> 4, n41 = (tid + NT) & 15;
  int item = BID();
  float4 v0 = make_float4(0, 0, 0, 0), v1 = v0;
  if (item < tk * tn) {
    const int k0 = (item / tn) * 64, n0 = (item % tn) * 64;
    v0 = *(const float4*)(W + (long)(k0 + kk0) * N + n0 + n40 * 4);
    v1 = *(const float4*)(W + (long)(k0 + kk1) * N + n0 + n41 * 4);
  }
  for (; item < tk * tn; item += G) {
    const int k0 = (item / tn) * 64, n0 = (item % tn) * 64;
    float4 w0 = v0, w1 = v1;
    const int nx = item + G;
    if (nx < tk * tn) {
      const int k2 = (nx / tn) * 64, n2 = (nx % tn) * 64;
      w0 = *(const float4*)(W + (long)(k2 + kk0) * N + n2 + n40 * 4);
      w1 = *(const float4*)(W + (long)(k2 + kk1) * N + n2 + n41 * 4);
    }
    __syncthreads();
    { float* p = smf + kk0 * 65 + n40 * 4; p[0] = v0.x; p[1] = v0.y; p[2] = v0.z; p[3] = v0.w; }
    { float* p = smf + kk1 * 65 + n41 * 4; p[0] = v1.x; p[1] = v1.y; p[2] = v1.z; p[3] = v1.w; }
    __syncthreads();
    const int nn = tid >> 3, k8 = tid & 7;
    float f[8];
#pragma unroll
    for (int i = 0; i < 8; ++i) f[i] = smf[(k8 * 8 + i) * 65 + nn];
    *(uint4*)(Wt + (long)(n0 + nn) * K + k0 + k8 * 8) = pack8s(f, 1.f);
    v0 = w0; v1 = w1;
  }
  __syncthreads();
}

__device__ void phase_pre0(const Params& P) {
  const int tid = TID();
  const long gtid = (long)BID() * NT + tid, gsz = (long)gridDim.x * NT;
  transpose_w(P.in[7], (u16*)(WS(P) + O_WHYIN), 1024, 3072);
  transpose_w(P.in[18], (u16*)(WS(P) + O_WHYOUT), 1024, 1024);
  transpose_w(P.in[19], (u16*)(WS(P) + O_WRETIN), 1024, 6144);
  transpose_w(P.in[21], (u16*)(WS(P) + O_WRETOUT), 2048, 1024);
  transpose_w(P.in[22], (u16*)(WS(P) + O_WSWAIN), 1024, 1536);
  transpose_w(P.in[26], (u16*)(WS(P) + O_WSWAOUT), 1024, 1024);
  transpose_w(P.in[27], (u16*)(WS(P) + O_WHGIN), 1024, 5120);
  transpose_w(P.in[30], (u16*)(WS(P) + O_WHGOUT), 1024, 1024);
  for (int l = 0; l < 4; ++l) {
    transpose_w(P.in[31] + (long)l * 1024 * DFF, (u16*)(WS(P) + O_WFG) + (long)l * DFF * 1024, 1024, DFF);
    transpose_w(P.in[32] + (long)l * 1024 * DFF, (u16*)(WS(P) + O_WFV) + (long)l * DFF * 1024, 1024, DFF);
    transpose_w(P.in[35] + (long)l * DFF * 1024, (u16*)(WS(P) + O_WFD) + (long)l * 1024 * DFF, DFF, 1024);
  }
  {
    float* cs = (float*)smem;
    float* modp = (float*)(WS(P) + O_MODP);
    for (int item = BID(); item < 4 * 8 * 12; item += gridDim.x) {
      const int nb = item % 12, ks = (item / 12) % 8, l = item / 96;
      __syncthreads();
      for (int i = tid; i < 2048; i += NT) {
        int b = i >> 7, k = i & 127;
        float c = (b < 8) ? P.in[2][b * 1024 + ks * 128 + k] : P.in[3][(b - 8) * 1024 + ks * 128 + k];
        cs[i] = c / (1.f + expf(-c));
      }
      __syncthreads();
      const int n = nb * 512 + tid;
      float a[16];
#pragma unroll
      for (int b = 0; b < 16; ++b) a[b] = 0.f;
      const float* w = P.in[4] + ((long)l * 1024 + ks * 128) * 6144 + n;
      for (int k = 0; k < 128; ++k) {
        float wv = w[(long)k * 6144];
#pragma unroll
        for (int b = 0; b < 16; ++b) a[b] += cs[b * 128 + k] * wv;
      }
#pragma unroll
      for (int b = 0; b < 16; ++b) modp[(((long)ks * 4 + l) * 16 + b) * 6144 + n] = a[b];
    }
    __syncthreads();
  }
  {
    float2* tw = (float2*)(WS(P) + O_TW);
    for (long i = gtid; i < 8192; i += gsz) {
      float s, c;
      sincospif((float)i * (1.f / 8192.f), &s, &c);
      tw[i] = make_float2(c, -s);
    }
    float2* rr = (float2*)(WS(P) + O_ROPER);
    for (long i = gtid; i < (long)8192 * 128; i += gsz) {
      int pos = (int)(i >> 7), d = (int)(i & 127);
      float inv = exp2f(-(float)d * (13.287712379549449f / 128.f));
      float s, c;
      sincosf((float)pos * inv, &s, &c);
      rr[i] = make_float2(c, s);
    }
    float2* rs = (float2*)(WS(P) + O_ROPES);
    for (long i = gtid; i < (long)8192 * 32; i += gsz) {
      int pos = (int)(i >> 5), d = (int)(i & 31);
      float inv = exp2f(-(float)d * (13.287712379549449f / 32.f));
      float s, c;
      sincosf((float)pos * inv, &s, &c);
      rs[i] = make_float2(c, s);
    }
  }
  {
    float* zf = (float*)smem;
    float* h1 = zf + 8 * 36;
    const float* w1 = P.in[10]; const float* b1 = P.in[11]; const float* w2 = P.in[12]; const float* b2 = P.in[13];
    const float* fr = P.in[15];
    const int tl = tid >> 6, j = tid & 63;
    for (int item = BID(); item < 1280; item += gridDim.x) {
      const int sel = item >= 1024;
      const int L = sel ? 2048 : 8192;
      const int t = (sel ? item - 1024 : item) * 8 + tl;
      float* hid = (float*)(WS(P) + (sel ? O_HIDP : O_HIDS));
      __syncthreads();
      if (j < 33) {
        float v;
        if (j == 0) v = (float)t / (float)(L - 1);
        else {
          int i = (j - 1) & 15;
          float band = 1e-4f + (float)i * ((15.f - 1e-4f) / 15.f);
          float ang = (6.283185307179586f / (float)L) * (float)t;
          float a = band * ang;
          v = (j <= 16) ? cosf(a) : -sinf(a);
        }
        zf[tl * 36 + j] = v;
      }
      __syncthreads();
      float s = b1[j];
#pragma unroll 3
      for (int i = 0; i < 33; ++i) s += zf[tl * 36 + i] * w1[i * 64 + j];
      h1[tl * 64 + j] = sinf(fr[j] * s);
      __syncthreads();
      float s2 = b2[j];
#pragma unroll 4
      for (int i = 0; i < 64; ++i) s2 += h1[tl * 64 + i] * w2[i * 64 + j];
      hid[(long)j * L + t] = sinf(fr[j] * s2);
    }
    __syncthreads();
  }
}

__device__ void phase_pre1(const Params& P) {
  __shared__ float w3s[128];
  __shared__ float red[8];
  const int tid = TID(), lane = tid & 63, wid = tid >> 6;
  const long gtid = (long)BID() * NT + tid, gsz = (long)gridDim.x * NT;
  {
    const float* modp = (const float*)(WS(P) + O_MODP);
    float* mod = (float*)(WS(P) + O_MOD);
    for (long i = gtid; i < (long)4 * 16 * 6144; i += gsz) {
      int n = (int)(i % 6144);
      int l = (int)(i / (16 * 6144));
      float s = P.in[5][l * 6144 + n];
      for (int ks = 0; ks < 8; ++ks) s += modp[(long)ks * 4 * 16 * 6144 + i];
      mod[i] = s;
    }
  }
  float2* buf = (float2*)smem;
  const float2* tw = (const float2*)(WS(P) + O_TW);
  for (int item = BID(); item < 2048; item += gridDim.x) {
    const int sel = item >> 10, c = item & 1023;
    const int L = sel ? 2048 : 8192, N = 2 * L;
    const float* hid = (const float*)(WS(P) + (sel ? O_HIDP : O_HIDS));
    float2* hs = (float2*)(WS(P) + (sel ? O_HSPP : O_HSPS)) + (long)c * N;
    __syncthreads();
    if (tid < 128) {
      int dirn = tid >> 6, j = tid & 63;
      w3s[tid] = P.in[14][(long)j * 2048 + dirn * 1024 + c];
    }
    __syncthreads();
    const float dec0 = fabsf(P.in[16][c]), dec1 = fabsf(P.in[16][1024 + c]);
    const float invLm1 = 1.f / (float)(L - 1);
    float asum = 0.f;
    for (int n = tid; n < N; n += NT) {
      float val = 0.f;
      if (n != L) {
        const int dirn = n < L ? 0 : 1;
        const int t = n < L ? n : N - n;
        const float* hp = hid + t;
        const float* w = w3s + dirn * 64;
        float s = 0.f;
#pragma unroll 16
        for (int j = 0; j < 64; ++j) s += hp[(long)j * L] * w[j];
        float tl = (float)t * invLm1;
        val = s * expf(-tl * (dirn ? dec1 : dec0));
      }
      buf[fidx(n)] = make_float2(val, 0.f);
      asum += fabsf(val);
    }
    asum = wave_sum(asum);
    if (lane == 0) red[wid] = asum;
    __syncthreads();
    float tot = 0.f;
#pragma unroll
    for (int w = 0; w < 8; ++w) tot += red[w];
    const float scale = 1.f / (tot * (float)N);
    fft_dif(buf, N, tw);
    for (int p = tid; p < N; p += NT) {
      float2 a = buf[fidx(p)];
      hs[p] = make_float2(a.x * scale, a.y * scale);
    }
  }
  __syncthreads();
}

__device__ void phase_norm(const Params& P, int layer, int sl, int which) {
  const int grow0 = which == 1 ? sl * FSLAB : (which == 2 ? 0 : sl * SLAB), nrows = which == 1 ? FSLAB : (which == 2 ? NTOK : SLAB);
  const float* __restrict__ x = (layer == 0 && which == 0) ? xin_of(P, sl) : (const float*)(OUTP(P) + (long)grow0 * D);
  u16* __restrict__ h = (u16*)(WS(P) + (which == 1 ? O_FHBUF : (which == 2 ? O_SA_H : O_HBUF)));
  const float* gain = P.in[6] + (layer * 2 + (which == 1 ? 1 : 0)) * D;
  const float* mod = (const float*)(WS(P) + O_MOD) + (long)layer * 16 * 6144;
  const int shoff = which == 1 ? 3 * D : 0, scoff = which == 1 ? 4 * D : D;
  const int tid = TID(), lane = tid & 63, wid = tid >> 6;
  for (int item = BID(); item < nrows / 32; item += gridDim.x) {
    const int r0 = item * 32 + wid * 4;
    float4 v[4][4];
    float ss[4];
#pragma unroll
    for (int u = 0; u < 4; ++u) {
      const float* xr = x + (long)(r0 + u) * D;
      float a = 0.f;
#pragma unroll
      for (int i = 0; i < 4; ++i) {
        v[u][i] = *(const float4*)(xr + i * 256 + lane * 4);
        a += v[u][i].x * v[u][i].x + v[u][i].y * v[u][i].y + v[u][i].z * v[u][i].z + v[u][i].w * v[u][i].w;
      }
      ss[u] = a;
    }
    const float* m = mod + (long)gb_row(grow0 + r0) * 6144;
#pragma unroll
    for (int u = 0; u < 4; ++u) ss[u] = wave_sum(ss[u]);
#pragma unroll
    for (int i = 0; i < 4; ++i) {
      const int col = i * 256 + lane * 4;
      const float4 g = *(const float4*)(gain + col);
      const float4 sc = *(const float4*)(m + scoff + col);
      const float4 sh = *(const float4*)(m + shoff + col);
      const float a0 = g.x * (1.f + sc.x), a1 = g.y * (1.f + sc.y), a2 = g.z * (1.f + sc.z), a3 = g.w * (1.f + sc.w);
#pragma unroll
      for (int u = 0; u < 4; ++u) {
        const float rstd = rsqrtf(ss[u] * (1.f / 1024.f) + 1e-6f);
        const float y0 = v[u][i].x * rstd * a0 + sh.x, y1 = v[u][i].y * rstd * a1 + sh.y;
        const float y2 = v[u][i].z * rstd * a2 + sh.z, y3 = v[u][i].w * rstd * a3 + sh.w;
        *(uint2*)(h + (long)(r0 + u) * D + col) = make_uint2(pack2(y0, y1), pack2(y2, y3));
      }
    }
  }
}

__device__ void phase_proj(const Params& P, size_t woff, int N) {
  EpiStoreBf16 E; E.O = (u16*)(WS(P) + O_PROJ); E.ldc = N;
  run_gemm((const u16*)(WS(P) + O_HBUF), (const u16*)(WS(P) + woff), SLAB, N, D, E);
}
__device__ void phase_resid(const Params& P, int layer, int slab, const u16* A, int K, size_t woff, int goff) {
  EpiResid E; E.X = OUTP(P) + (long)slab * SLAB * D; E.XS = (layer == 0) ? xin_of(P, slab) : (const float*)E.X; E.mod = (const float*)(WS(P) + O_MOD) + (long)layer * 16 * 6144; E.goff = goff; E.grow0 = slab * SLAB;
  run_gemm(A, (const u16*)(WS(P) + woff), SLAB, D, K, E);
}

__device__ void phase_ffn_gate(const Params& P, int layer) {
  EpiStoreBf16 E; E.O = (u16*)(WS(P) + O_FGBUF); E.ldc = DFF;
  run_gemm((const u16*)(WS(P) + O_FHBUF), (const u16*)(WS(P) + O_WFG) + (long)layer * DFF * D, FSLAB, DFF, D, E);
}
__device__ void phase_ffn_val(const Params& P, int layer, int fs) {
  EpiFfnVal E; E.G = (const u16*)(WS(P) + O_FGBUF); E.ACT = (u16*)(WS(P) + O_FACT) + (long)fs * FSLAB * DFF;
  E.cw = P.in[33] + (long)layer * 3 * DFF; E.cb = P.in[34] + (long)layer * DFF; E.grow0 = fs * FSLAB;
  run_gemm((const u16*)(WS(P) + O_FHBUF), (const u16*)(WS(P) + O_WFV) + (long)layer * DFF * D, FSLAB, DFF, D, E);
}
__device__ void phase_ffn_down(const Params& P, int layer) {
  EpiResid E; E.X = OUTP(P); E.XS = E.X; E.mod = (const float*)(WS(P) + O_MOD) + (long)layer * 16 * 6144; E.goff = 5 * D; E.grow0 = 0;
  run_gemm((const u16*)(WS(P) + O_FACT), (const u16*)(WS(P) + O_WFD) + (long)layer * D * DFF, NTOK, D, DFF, E);
}

__device__ void phase_hy_conv(const Params& P, int slab) {
  const int L = Lof(slab), nseq = SLAB / L, tid = TID();
  const u16* __restrict__ z = (const u16*)(WS(P) + O_PROJ);
  float* __restrict__ uT = (float*)(WS(P) + O_UT);
  u16* __restrict__ x0c = (u16*)(WS(P) + O_X0C);
  const float* cw = P.in[8];
  const float* cb = P.in[9];
  float* tile = (float*)smem;
  const int ntt = L / 64;
  const int nitems = nseq * ntt * 16;
  const int tl = tid >> 3, cg = tid & 7;
  for (int item = BID(); item < nitems; item += gridDim.x) {
    const int ct = item % 16, tt = (item / 16) % ntt, seq = item / (16 * ntt);
    const int t = tt * 64 + tl, c0 = ct * 64 + cg * 8;
    const long row = (long)seq * L + t;
    const float mp = t > 0 ? 1.f : 0.f, mn = t < L - 1 ? 1.f : 0.f;
    const long rp = t > 0 ? row - 1 : row, rn = t < L - 1 ? row + 1 : row;
    float val[3][8];
#pragma unroll
    for (int q = 0; q < 3; ++q) {
      const int col = q * 1024 + c0;
      float a[8], b[8], c[8];
      unpack8(*(const uint4*)(z + rp * 3072 + col), a);
      unpack8(*(const uint4*)(z + row * 3072 + col), b);
      unpack8(*(const uint4*)(z + rn * 3072 + col), c);
      const float4 w0a = *(const float4*)(cw + col), w0b = *(const float4*)(cw + col + 4);
      const float4 w1a = *(const float4*)(cw + 3072 + col), w1b = *(const float4*)(cw + 3072 + col + 4);
      const float4 w2a = *(const float4*)(cw + 6144 + col), w2b = *(const float4*)(cw + 6144 + col + 4);
      const float4 ba = *(const float4*)(cb + col), bb = *(const float4*)(cb + col + 4);
      const float w0[8] = {w0a.x, w0a.y, w0a.z, w0a.w, w0b.x, w0b.y, w0b.z, w0b.w};
      const float w1[8] = {w1a.x, w1a.y, w1a.z, w1a.w, w1b.x, w1b.y, w1b.z, w1b.w};
      const float w2[8] = {w2a.x, w2a.y, w2a.z, w2a.w, w2b.x, w2b.y, w2b.z, w2b.w};
      const float bs[8] = {ba.x, ba.y, ba.z, ba.w, bb.x, bb.y, bb.z, bb.w};
#pragma unroll
      for (int i = 0; i < 8; ++i) val[q][i] = mp * a[i] * w0[i] + b[i] * w1[i] + mn * c[i] * w2[i] + bs[i];
    }
    *(uint4*)(x0c + row * 1024 + c0) = pack8s(val[0], 1.f);
    __syncthreads();
#pragma unroll
    for (int i = 0; i < 8; ++i) tile[tl * 65 + cg * 8 + i] = val[1][i] * val[2][i];
    __syncthreads();
    {
      const int cl = tid >> 3, tq = tid & 7;
      float* dst = uT + ((long)seq * 1024 + ct * 64 + cl) * L + tt * 64 + tq * 8;
      float4 o0, o1;
      o0.x = tile[(tq * 8 + 0) * 65 + cl]; o0.y = tile[(tq * 8 + 1) * 65 + cl]; o0.z = tile[(tq * 8 + 2) * 65 + cl]; o0.w = tile[(tq * 8 + 3) * 65 + cl];
      o1.x = tile[(tq * 8 + 4) * 65 + cl]; o1.y = tile[(tq * 8 + 5) * 65 + cl]; o1.z = tile[(tq * 8 + 6) * 65 + cl]; o1.w = tile[(tq * 8 + 7) * 65 + cl];
      *(float4*)dst = o0; *(float4*)(dst + 4) = o1;
    }
  }
  __syncthreads();
}

__device__ void phase_hy_fft(const Params& P, int slab, bool dry = false) {
  const int L = Lof(slab), N = 2 * L, nseq = SLAB / L, tid = TID();
  float* uT = (float*)(WS(P) + O_UT);
  const float2* hsb = (const float2*)(WS(P) + (slab == 0 ? O_HSPP : O_HSPS));
  const float2* tw = (const float2*)(WS(P) + O_TW);
  const float* skip = P.in[17];
  float2* buf = (float2*)smem;
  const int nitems = (nseq / 2) * 1024;
  for (int item = BID(); item < nitems; item += gridDim.x) {
    const int pr = item >> 10, c = item & 1023;
    float* u0 = uT + ((long)(pr * 2) * 1024 + c) * L;
    float* u1 = u0 + (long)1024 * L;
    __syncthreads();
    for (int t = tid; t < L; t += NT) {
      buf[fidx(t)] = make_float2(u0[t], u1[t]);
      buf[fidx(t + L)] = make_float2(0.f, 0.f);
    }
    __syncthreads();
    fft_conv(buf, N, tw, hsb + (long)c * N);
    const float sk = skip[c];
    for (int t = tid; t < L; t += NT) {
      float2 y = buf[fidx(t)];
      const long doff = dry ? (long)(END_HY - O_UT) / 4 : 0;
      u0[t + doff] = y.x + u0[t] * sk;
      u1[t + doff] = y.y + u1[t] * sk;
    }
  }
  __syncthreads();
}

__device__ void phase_hy_tr(const Params& P, int slab) {
  const int L = Lof(slab), nseq = SLAB / L, tid = TID();
  const float* __restrict__ yT = (const float*)(WS(P) + O_UT);
  const u16* __restrict__ x0c = (const u16*)(WS(P) + O_X0C);
  u16* __restrict__ a2 = (u16*)(WS(P) + O_A2);
  float* tile = (float*)smem;
  const int ntt = L / 64;
  const int nitems = nseq * ntt * 16;
  for (int item = BID(); item < nitems; item += gridDim.x) {
    const int ct = item % 16, tt = (item / 16) % ntt, seq = item / (16 * ntt);
    const int cl = tid >> 3, tq = tid & 7;
    const float* src = yT + ((long)seq * 1024 + ct * 64 + cl) * L + tt * 64 + tq * 8;
    const float4 i0 = *(const float4*)src, i1 = *(const float4*)(src + 4);
    const int tl = tid >> 3, cg = tid & 7;
    const long row = (long)seq * L + tt * 64 + tl;
    const int c0 = ct * 64 + cg * 8;
    float xg[8];
    unpack8(*(const uint4*)(x0c + row * 1024 + c0), xg);
    __syncthreads();
    float* p = tile + cl * 65 + tq * 8;
    p[0] = i0.x; p[1] = i0.y; p[2] = i0.z; p[3] = i0.w; p[4] = i1.x; p[5] = i1.y; p[6] = i1.z; p[7] = i1.w;
    __syncthreads();
    float o[8];
#pragma unroll
    for (int i = 0; i < 8; ++i) o[i] = tile[(cg * 8 + i) * 65 + tl] * xg[i];
    *(uint4*)(a2 + row * 1024 + c0) = pack8s(o, 1.f);
  }
  __syncthreads();
}

struct Rec {
  int H, DK, DV, C;
  int ldv, voff, goff;
};
__device__ __forceinline__ Rec rec_of(int kind) {
  Rec r;
  if (kind == 1) { r.H = 4; r.DK = 256; r.DV = 512; r.C = 256; r.ldv = 6144; r.voff = 2048; r.goff = 4096; }
  else { r.H = 8; r.DK = 128; r.DV = 128; r.C = 128; r.ldv = 5120; r.voff = 1024; r.goff = 4096; }
  return r;
}

__device__ void phase_ret_prep(const Params& P, int slab) {
  const int L = Lof(slab);
  const u16* __restrict__ pj = (const u16*)(WS(P) + O_PROJ);
  u16* __restrict__ qdf = (u16*)(WS(P) + O_QDF); u16* __restrict__ qdb = (u16*)(WS(P) + O_QDB);
  u16* __restrict__ kif = (u16*)(WS(P) + O_KIF); u16* __restrict__ kib = (u16*)(WS(P) + O_KIB);
  u16* __restrict__ kef = (u16*)(WS(P) + O_KEF); u16* __restrict__ keb = (u16*)(WS(P) + O_KEB);
  float* dlf = (float*)(WS(P) + O_DLF); float* dlb = (float*)(WS(P) + O_DLB);
  const float2* __restrict__ rope = (const float2*)(WS(P) + O_ROPER);
  const long gtid = (long)BID() * NT + TID(), gsz = (long)gridDim.x * NT;
  for (long idx = gtid; idx < (long)SLAB * 64; idx += gsz) {
    const int d0 = (int)(idx & 15) * 8, h = (int)((idx >> 4) & 3), t = (int)(idx >> 6);
    const int pos = t & (L - 1), r = t & 255;
    const float lgf = -expf(P.in[20][h]), lgb = -expf(P.in[20][4 + h]);
    const u16* row = pj + (long)t * 6144 + h * 256 + d0;
    const uint4 vq1 = *(const uint4*)row, vq2 = *(const uint4*)(row + 128);
    const uint4 vk1 = *(const uint4*)(row + 1024), vk2 = *(const uint4*)(row + 1024 + 128);
    const float4* rp = (const float4*)(rope + (long)pos * 128 + d0);
    const float4 c01 = rp[0], c23 = rp[1], c45 = rp[2], c67 = rp[3];
    float q1[8], q2[8], k1[8], k2[8];
    unpack8(vq1, q1); unpack8(vq2, q2); unpack8(vk1, k1); unpack8(vk2, k2);
    const float cs[8] = {c01.x, c01.z, c23.x, c23.z, c45.x, c45.z, c67.x, c67.z};
    const float sn[8] = {c01.y, c01.w, c23.y, c23.w, c45.y, c45.w, c67.y, c67.w};
    float qa[8], qb[8], ka[8], kb[8];
#pragma unroll
    for (int i = 0; i < 8; ++i) {
      qa[i] = q1[i] * cs[i] - q2[i] * sn[i]; qb[i] = q1[i] * sn[i] + q2[i] * cs[i];
      ka[i] = (k1[i] * cs[i] - k2[i] * sn[i]) * 0.0625f; kb[i] = (k1[i] * sn[i] + k2[i] * cs[i]) * 0.0625f;
    }
    const float bf = (float)(r + 1) * lgf, bb = (float)(256 - r) * lgb;
    const float ef = expf(bf), eif = expf(-bf), eef = expf((float)(255 - r) * lgf);
    const float eb = expf(bb), eib = expf(-bb), eeb = expf((float)r * lgb);
    const long o1 = (long)t * 1024 + h * 256 + d0, o2 = o1 + 128;
    *(uint4*)(qdf + o1) = pack8s(qa, ef); *(uint4*)(qdf + o2) = pack8s(qb, ef);
    *(uint4*)(qdb + o1) = pack8s(qa, eb); *(uint4*)(qdb + o2) = pack8s(qb, eb);
    *(uint4*)(kef + o1) = pack8s(ka, eef); *(uint4*)(kef + o2) = pack8s(kb, eef);
    *(uint4*)(keb + o1) = pack8s(ka, eeb); *(uint4*)(keb + o2) = pack8s(kb, eeb);
    if (r == 0) {
      const long cgi = (long)(t >> 8) * 1024 + h * 256 + d0;
      const float df = expf(256.f * lgf), db = expf(256.f * lgb);
#pragma unroll
      for (int i = 0; i < 8; ++i) { dlf[cgi + i] = df; dlf[cgi + 128 + i] = df; dlb[cgi + i] = db; dlb[cgi + 128 + i] = db; }
    }
  }
}

__device__ __forceinline__ float lb_of(const float* lbt, int dr, int ch) {
  const float a0 = lbt[(dr * 4 + 0) * 1024 + ch], a1 = lbt[(dr * 4 + 1) * 1024 + ch], a2 = lbt[(dr * 4 + 2) * 1024 + ch], a3 = lbt[(dr * 4 + 3) * 1024 + ch];
  const float m = fmaxf(fmaxf(a0, a1), fmaxf(a2, a3));
  const float e0 = expf(a0 - m), e1 = expf(a1 - m), e2 = expf(a2 - m), e3 = expf(a3 - m);
  return (e0 + e1 + e2) / (e0 + e1 + e2 + e3);
}
__device__ void phase_hg_prep(const Params& P) {
  const u16* __restrict__ pj = (const u16*)(WS(P) + O_PROJ);
  u16* __restrict__ qdf = (u16*)(WS(P) + O_QDF); u16* __restrict__ qdb = (u16*)(WS(P) + O_QDB);
  u16* __restrict__ kif = (u16*)(WS(P) + O_KIF); u16* __restrict__ kib = (u16*)(WS(P) + O_KIB);
  u16* __restrict__ kef = (u16*)(WS(P) + O_KEF); u16* __restrict__ keb = (u16*)(WS(P) + O_KEB);
  float* dlf = (float*)(WS(P) + O_DLF); float* dlb = (float*)(WS(P) + O_DLB);
  const float* lbt = P.in[28];
  float* totF = (float*)smem;
  float* totB = totF + 1024;
  const int tid = TID(), lane = tid & 63, rg = tid >> 6;
  constexpr int RPT = 16;
  for (int item = BID(); item < 1024; item += gridDim.x) {
    const int cgi = item >> 3, ch = (item & 7) * 128 + lane * 2;
    const long t0 = (long)cgi * 128 + rg * RPT;
    unsigned wq[RPT], wf[RPT], wb[RPT];
#pragma unroll
    for (int i = 0; i < RPT; ++i) {
      const u16* row = pj + (t0 + i) * 5120 + ch;
      wq[i] = *(const unsigned*)row; wf[i] = *(const unsigned*)(row + 2048); wb[i] = *(const unsigned*)(row + 3072);
    }
    float lb0[2], lb1[2];
    lb0[0] = lb_of(lbt, 0, ch); lb0[1] = lb_of(lbt, 0, ch + 1);
    lb1[0] = lb_of(lbt, 1, ch); lb1[1] = lb_of(lbt, 1, ch + 1);
    float pf[2][RPT], sb[2][RPT], accf[2], accb[2];
#pragma unroll
    for (int c = 0; c < 2; ++c) {
      float a = 0.f;
#pragma unroll
      for (int i = 0; i < RPT; ++i) {
        const float x = bf2f((u16)(c ? (wf[i] >> 16) : (wf[i] & 0xffff)));
        a += logf(lb0[c] + (1.f - lb0[c]) * sigm(x)); pf[c][i] = a;
      }
      accf[c] = a;
      a = 0.f;
#pragma unroll
      for (int i = RPT - 1; i >= 0; --i) {
        const float x = bf2f((u16)(c ? (wb[i] >> 16) : (wb[i] & 0xffff)));
        a += logf(lb1[c] + (1.f - lb1[c]) * sigm(x)); sb[c][i] = a;
      }
      accb[c] = a;
    }
    __syncthreads();
    *(float2*)(totF + rg * 128 + lane * 2) = make_float2(accf[0], accf[1]);
    *(float2*)(totB + rg * 128 + lane * 2) = make_float2(accb[0], accb[1]);
    __syncthreads();
    float offF[2] = {0.f, 0.f}, offB[2] = {0.f, 0.f}, totf[2] = {0.f, 0.f}, totb[2] = {0.f, 0.f};
#pragma unroll
    for (int g = 0; g < 8; ++g) {
      const float2 f = *(const float2*)(totF + g * 128 + lane * 2), bq = *(const float2*)(totB + g * 128 + lane * 2);
      totf[0] += f.x; totf[1] += f.y; totb[0] += bq.x; totb[1] += bq.y;
      if (g < rg) { offF[0] += f.x; offF[1] += f.y; }
      if (g > rg) { offB[0] += bq.x; offB[1] += bq.y; }
    }
#pragma unroll
    for (int i = 0; i < RPT; ++i) {
      float o[6][2];
#pragma unroll
      for (int c = 0; c < 2; ++c) {
        const float xq = bf2f((u16)(c ? (wq[i] >> 16) : (wq[i] & 0xffff)));
        const float xf = bf2f((u16)(c ? (wf[i] >> 16) : (wf[i] & 0xffff)));
        const float xb = bf2f((u16)(c ? (wb[i] >> 16) : (wb[i] & 0xffff)));
        const float q = silu_f(xq);
        const float bf = offF[c] + pf[c][i], bb = offB[c] + sb[c][i];
        const float kf = (1.f - lb0[c]) * sigm(-xf), kb = (1.f - lb1[c]) * sigm(-xb);
        o[0][c] = q * expf(bf); o[1][c] = kf * expf(-bf); o[2][c] = kf * expf(totf[c] - bf);
        o[3][c] = q * expf(bb); o[4][c] = kb * expf(-bb); o[5][c] = kb * expf(totb[c] - bb);
      }
      const long oo = (t0 + i) * 1024 + ch;
      *(unsigned*)(qdf + oo) = pack2(o[0][0], o[0][1]);
      *(unsigned*)(kif + oo) = pack2(o[1][0], o[1][1]);
      *(unsigned*)(kef + oo) = pack2(o[2][0], o[2][1]);
      *(unsigned*)(qdb + oo) = pack2(o[3][0], o[3][1]);
      *(unsigned*)(kib + oo) = pack2(o[4][0], o[4][1]);
      *(unsigned*)(keb + oo) = pack2(o[5][0], o[5][1]);
    }
    if (rg == 0) {
      *(float2*)(dlf + (long)cgi * 1024 + ch) = make_float2(expf(totf[0]), expf(totf[1]));
      *(float2*)(dlb + (long)cgi * 1024 + ch) = make_float2(expf(totb[0]), expf(totb[1]));
    }
  }
  __syncthreads();
}

template <int C, int DKT>
__device__ __forceinline__ void rec_scores_item(const Params& P, const Rec& R, int cgi, int h, int ti, int tj) {
  constexpr int T = C > 128 ? 128 : C, KTS = DKT;
  const u16* qdf = (const u16*)(WS(P) + O_QDF); const u16* qdb = (const u16*)(WS(P) + O_QDB);
  const u16* kif = (const u16*)(WS(P) + O_KIF); const u16* kib = (const u16*)(WS(P) + O_KIB);
  u16* sc = (u16*)(WS(P) + O_SC) + (((long)cgi * R.H + h) * C + ti * T) * C + tj * T;
  const long offA = ((long)cgi * C + ti * T) * 1024 + h * R.DK, offB = ((long)cgi * C + tj * T) * 1024 + h * R.DK;
  f32x4 af[T / 32][T / 64] = {}, ab[T / 32][T / 64] = {};
  float sff = 1.f, sfb = 1.f;
  if (C == 256) {
    kif = (const u16*)(WS(P) + O_KEF); kib = (const u16*)(WS(P) + O_KEB);
    sff = expf((float)C * expf(P.in[20][h])); sfb = expf((float)C * expf(P.in[20][4 + h]));
  }
  if (ti >= tj) gemm_acc<T, T, true, true, true, KTS>(af, qdf + offA, 1024, kif + offB, 1024, (u16*)smem);
  if (ti <= tj) gemm_acc<T, T, true, true, true, KTS>(ab, qdb + offA, 1024, kib + offB, 1024, (u16*)smem);
  const int tid = TID(), lane = tid & 63, wid = tid >> 6;
  const int wm = wid >> 2, wn = wid & 3, fr = lane & 15, fq = lane >> 4;
#pragma unroll
  for (int mi = 0; mi < T / 32; ++mi)
#pragma unroll
    for (int ni = 0; ni < T / 64; ++ni) {
      const int r = wm * (T / 2) + mi * 16 + fr, c0 = wn * (T / 4) + ni * 16 + fq * 4;
      const int gr = ti * T + r;
      float v[4];
#pragma unroll
      for (int j = 0; j < 4; ++j) {
        const int gc = tj * T + c0 + j;
        v[j] = (gc <= gr ? af[mi][ni][j] * sff : 0.f) + (gc >= gr ? ab[mi][ni][j] * sfb : 0.f);
      }
      *(uint2*)(sc + r * C + c0) = make_uint2(pack2(v[0], v[1]), pack2(v[2], v[3]));
    }
}

template <int C, int DKT>
__device__ void phase_rec_su(const Params& P, int kind) {
  const Rec R = rec_of(kind);
  constexpr int KTU = C / 64;
  const int nch = SLAB / C;
  constexpr int NT1 = (C > 128 ? C / 128 : 1), NTT = NT1 * NT1;
  const int n_sc = nch * R.H * NTT;
  const int mtn = R.DK / 128, ntn = R.DV / 128;
  const int n_u = nch * R.H * 2 * mtn * ntn, G = gridDim.x;
  const u16* pj = (const u16*)(WS(P) + O_PROJ);
  for (int item = VBID(); item < n_sc; item += G) { const int tl = item % NTT, hh = (item / NTT) % R.H, cg = item / (NTT * R.H); rec_scores_item<C, DKT>(P, R, cg, hh, tl / NT1, tl % NT1); }
  const u16* kef = (const u16*)(WS(P) + O_KEF); const u16* keb = (const u16*)(WS(P) + O_KEB);
  u16* stfb = (u16*)(WS(P) + O_STF); u16* stbb = (u16*)(WS(P) + O_STB);
  Tiles<KTU> ta, tb;
#define U_DECODE(q_, nt_, mt_, dir_, h_, cgi_) int nt_, mt_, dir_, h_, cgi_; { int qq = (q_); nt_ = qq % ntn; qq /= ntn; mt_ = qq % mtn; qq /= mtn; dir_ = qq & 1; qq >>= 1; h_ = qq % R.H; cgi_ = qq / R.H; }
#define U_ISSUE(T_, nt_, mt_, dir_, h_, cgi_) tiles_issue<128, 128, false, false, KTU>(T_, (dir_ ? keb : kef) + (long)cgi_ * C * 1024 + h_ * R.DK + mt_ * 128, 1024, pj + (long)cgi_ * C * R.ldv + R.voff + h_ * R.DV + nt_ * 128, R.ldv)
#define U_RUN(T_, nt_, mt_, dir_, h_, cgi_) { f32x4 acc[4][2] = {}; gemm_run<128, 128, false, false, false, KTU>(acc, T_, (u16*)smem); \
    u16* st = (dir_ ? stbb : stfb) + (((long)cgi_ * R.H + h_) * R.DV + nt_ * 128) * R.DK + mt_ * 128; const int DK = R.DK; \
    epi_each<128, 128, false>(acc, [&](int r, int c, f32x4 val) { *(uint2*)(st + (long)c * DK + r) = make_uint2(pack2(val[0], val[1]), pack2(val[2], val[3])); }); }
  int q = VBID();
  if (q < n_u) { U_DECODE(q, nt, mt, dir, h, cgi); U_ISSUE(ta, nt, mt, dir, h, cgi); }
  for (; q < n_u; q += 2 * G) {
    U_DECODE(q, nt, mt, dir, h, cgi);
    const int q2 = q + G;
    if (q2 < n_u) { U_DECODE(q2, nt2, mt2, dir2, h2, cgi2); U_ISSUE(tb, nt2, mt2, dir2, h2, cgi2); }
    U_RUN(ta, nt, mt, dir, h, cgi);
    const int q3 = q + 2 * G;
    if (q3 < n_u) { U_DECODE(q3, nt3, mt3, dir3, h3, cgi3); U_ISSUE(ta, nt3, mt3, dir3, h3, cgi3); }
    if (q2 < n_u) { U_DECODE(q2, nt2, mt2, dir2, h2, cgi2); U_RUN(tb, nt2, mt2, dir2, h2, cgi2); }
  }
#undef U_DECODE
#undef U_ISSUE
#undef U_RUN
  __syncthreads();
}

__device__ void phase_rec_scan(const Params& P, int kind, int slab, bool dry = false) {
  const Rec R = rec_of(kind);
  const int L = Lof(slab), nseq = SLAB / L, ncs = L / R.C;
  const int qdk = R.DK / 4;
  const long per = (long)R.H * R.DV * qdk;
  const long total = 2 * nseq * per;
  const long gtid = (long)BID() * NT + TID(), gsz = (long)gridDim.x * NT;
  for (long idx = gtid; idx < total; idx += gsz) {
    long q = idx;
    const int pd = (int)(q % qdk); q /= qdk;
    const int e = (int)(q % R.DV); q /= R.DV;
    const int h = (int)(q % R.H); q /= R.H;
    const int seq = (int)(q % nseq);
    const int dir = (int)(q / nseq);
    u16* st = (u16*)(WS(P) + (dir ? O_STB : O_STF));
    u16* stw = dry ? (u16*)(WS(P) + O_OBUF) : st;
    const float* dl = (const float*)(WS(P) + (dir ? O_DLB : O_DLF));
    float s0 = 0.f, s1 = 0.f, s2 = 0.f, s3 = 0.f;
    const long ebase = ((long)h * R.DV + e) * R.DK + pd * 4;
    const long cstride = (long)R.H * R.DV * R.DK;
    const int dbase = h * R.DK + pd * 4;
    for (int i0 = 0; i0 < ncs; i0 += 8) {
      uint2 u[8];
      float4 dd[8];
#pragma unroll
      for (int j = 0; j < 8; ++j) {
        const int n = dir ? (ncs - 1 - i0 - j) : (i0 + j);
        const long cgi = (long)seq * ncs + n;
        { const unsigned long long w = __builtin_nontemporal_load((const unsigned long long*)(st + cgi * cstride + ebase)); u[j] = make_uint2((unsigned)w, (unsigned)(w >> 32)); }
        dd[j] = *(const float4*)(dl + cgi * 1024 + dbase);
      }
#pragma unroll
      for (int j = 0; j < 8; ++j) {
        const int n = dir ? (ncs - 1 - i0 - j) : (i0 + j);
        const long cgi = (long)seq * ncs + n;
        __builtin_nontemporal_store((unsigned long long)pack2(s0, s1) | ((unsigned long long)pack2(s2, s3) << 32), (unsigned long long*)(stw + cgi * cstride + ebase));
        s0 = dd[j].x * s0 + bf2f((u16)(u[j].x & 0xffff));
        s1 = dd[j].y * s1 + bf2f((u16)(u[j].x >> 16));
        s2 = dd[j].z * s2 + bf2f((u16)(u[j].y & 0xffff));
        s3 = dd[j].w * s3 + bf2f((u16)(u[j].y >> 16));
      }
    }
  }
}

template <int C, int DKT>
__device__ void phase_rec_out(const Params& P, int kind) {
  const Rec R = rec_of(kind);
  constexpr int T = C > 128 ? 128 : C, NRT = C / T;
  constexpr int KT1 = C / 64, KT2 = DKT;
  const int nch = SLAB / C, ntn = R.DV / 128;
  const u16* pj = (const u16*)(WS(P) + O_PROJ);
  const u16* scb = (const u16*)(WS(P) + O_SC);
  const u16* qdf = (const u16*)(WS(P) + O_QDF); const u16* qdb = (const u16*)(WS(P) + O_QDB);
  const u16* stf = (const u16*)(WS(P) + O_STF); const u16* stb = (const u16*)(WS(P) + O_STB);
  u16* ob = (u16*)(WS(P) + O_OBUF);
  const int HDV = R.H * R.DV;
  const int nitems = nch * R.H * NRT * ntn, G = gridDim.x;
  Tiles<KT1> t1; Tiles<KT2> t2; Tiles<KT2> t3;
  int item = VBID();
  if (item < nitems) {
    const int nt = item % ntn, rt = (item / ntn) % NRT, h = (item / (ntn * NRT)) % R.H, cgi = item / (ntn * NRT * R.H);
    tiles_issue<T, 128, true, false, KT1>(t1, scb + (((long)cgi * R.H + h) * C + rt * T) * C, C, pj + (long)cgi * C * R.ldv + R.voff + h * R.DV + nt * 128, R.ldv);
  }
  for (; item < nitems; item += G) {
    const int nt = item % ntn, rt = (item / ntn) % NRT, h = (item / (ntn * NRT)) % R.H, cgi = item / (ntn * NRT * R.H);
    const long qoff = ((long)cgi * C + rt * T) * 1024 + h * R.DK;
    const long soff = (((long)cgi * R.H + h) * R.DV + nt * 128) * R.DK;
    f32x4 acc[T / 32][2] = {};
    tiles_issue<T, 128, true, true, KT2>(t2, qdf + qoff, 1024, stf + soff, R.DK);
    gemm_run<T, 128, true, false, true, KT1>(acc, t1, (u16*)smem);
    tiles_issue<T, 128, true, true, KT2>(t3, qdb + qoff, 1024, stb + soff, R.DK);
    gemm_run<T, 128, true, true, true, KT2>(acc, t2, (u16*)smem);
    const int nx = item + G;
    if (nx < nitems) {
      const int nt2 = nx % ntn, rt2 = (nx / ntn) % NRT, h2 = (nx / (ntn * NRT)) % R.H, cg2 = nx / (ntn * NRT * R.H);
      tiles_issue<T, 128, true, false, KT1>(t1, scb + (((long)cg2 * R.H + h2) * C + rt2 * T) * C, C, pj + (long)cg2 * C * R.ldv + R.voff + h2 * R.DV + nt2 * 128, R.ldv);
    }
    gemm_run<T, 128, true, true, true, KT2>(acc, t3, (u16*)smem);
    if (DKT == 2) {
      float* part = (float*)(smem + 81920);
      const int tid = TID(), lane = tid & 63, wid = tid >> 6;
      const int wm = wid >> 2, wn = wid & 3, fr = lane & 15, fq = lane >> 4;
#pragma unroll
      for (int mi = 0; mi < T / 32; ++mi) {
        float sq = 0.f;
#pragma unroll
        for (int ni = 0; ni < 2; ++ni)
#pragma unroll
          for (int j = 0; j < 4; ++j) sq += acc[mi][ni][j] * acc[mi][ni][j];
        sq += __shfl_xor(sq, 16); sq += __shfl_xor(sq, 32);
        if (fq == 0) part[wn * 128 + wm * (T / 2) + mi * 16 + fr] = sq;
      }
      __syncthreads();
      const float* gain = P.in[29];
      u16* a2 = (u16*)(WS(P) + O_A2);
#pragma unroll
      for (int mi = 0; mi < T / 32; ++mi) {
        const int row = wm * (T / 2) + mi * 16 + fr;
        const float tot = part[row] + part[128 + row] + part[256 + row] + part[384 + row];
        const float rstd = rsqrtf(tot * (1.f / 128.f) + 1e-6f);
        const long t = (long)cgi * C + rt * T + row;
#pragma unroll
        for (int ni = 0; ni < 2; ++ni) {
          const int c = wn * 32 + ni * 16 + fq * 4;
          const float4 g4 = *(const float4*)(gain + c);
          const uint2 gw = *(const uint2*)(pj + t * R.ldv + R.goff + h * 128 + c);
          const f32x4 v = acc[mi][ni];
          const float y0 = v[0] * rstd * g4.x * silu_f(bf2f((u16)(gw.x & 0xffff)));
          const float y1 = v[1] * rstd * g4.y * silu_f(bf2f((u16)(gw.x >> 16)));
          const float y2 = v[2] * rstd * g4.z * silu_f(bf2f((u16)(gw.y & 0xffff)));
          const float y3 = v[3] * rstd * g4.w * silu_f(bf2f((u16)(gw.y >> 16)));
          *(uint2*)(a2 + t * 1024 + h * 128 + c) = make_uint2(pack2(y0, y1), pack2(y2, y3));
        }
      }
    } else {
      u16* o = ob + ((long)cgi * C + rt * T) * HDV + h * R.DV + nt * 128;
      epi_each<T, 128, true>(acc, [&](int r, int c, f32x4 val) { *(uint2*)(o + (long)r * HDV + c) = make_uint2(pack2(val[0], val[1]), pack2(val[2], val[3])); });
    }
  }
  __syncthreads();
}

template <int KIND>
__device__ void phase_rec_ng_t(const Params& P) {
  const Rec R = rec_of(KIND);
  constexpr int DV = (KIND == 1) ? 512 : 128, H = (KIND == 1) ? 4 : 8, PER = DV / 64, HDV = H * DV;
  const u16* __restrict__ ob = (const u16*)(WS(P) + O_OBUF);
  const u16* __restrict__ pj = (const u16*)(WS(P) + O_PROJ);
  u16* __restrict__ a2 = (u16*)(WS(P) + O_A2);
  const float* gain = P.in[29];
  const int tid = TID(), lane = tid & 63, wid = tid >> 6;
  constexpr int nrows = SLAB * H;
  for (int item = BID(); item < nrows / 32; item += gridDim.x) {
    float v[4][PER];
    float ss[4];
#pragma unroll
    for (int u = 0; u < 4; ++u) {
      const int rh = item * 32 + wid * 4 + u;
      const int t = rh / H, h = rh % H;
      const u16* o = ob + (long)t * HDV + h * DV + lane * PER;
      if (PER == 8) {
        float f8[8];
        unpack8(*(const uint4*)o, f8);
#pragma unroll
        for (int i = 0; i < 8; ++i) v[u][i % PER] = f8[i];
      } else {
        const unsigned w = *(const unsigned*)o;
        v[u][0] = bf2f((u16)(w & 0xffff)); v[u][1 % PER] = bf2f((u16)(w >> 16));
      }
      float a = 0.f;
#pragma unroll
      for (int i = 0; i < PER; ++i) a += v[u][i] * v[u][i];
      ss[u] = a;
    }
#pragma unroll
    for (int u = 0; u < 4; ++u) ss[u] = wave_sum(ss[u]);
#pragma unroll
    for (int u = 0; u < 4; ++u) {
      const int rh = item * 32 + wid * 4 + u;
      const int t = rh / H, h = rh % H;
      const float rstd = rsqrtf(ss[u] / (float)DV + 1e-6f);
      const u16* g = pj + (long)t * R.ldv + R.goff + h * DV + lane * PER;
      u16* out = a2 + (long)t * HDV + h * DV + lane * PER;
      float y[PER];
#pragma unroll
      for (int i = 0; i < PER; ++i) {
        y[i] = v[u][i] * rstd;
        if (KIND == 3) y[i] *= gain[lane * PER + i];
      }
      if (PER == 8) {
        const uint4 gw = *(const uint4*)g;
        float gf[8];
        unpack8(gw, gf);
        float r8[8];
#pragma unroll
        for (int i = 0; i < 8; ++i) r8[i] = y[i % PER] * silu_f(gf[i]);
        *(uint4*)out = pack8s(r8, 1.f);
      } else {
        const unsigned gw = *(const unsigned*)g;
        *(unsigned*)out = pack2(y[0] * silu_f(bf2f((u16)(gw & 0xffff))), y[1 % PER] * silu_f(bf2f((u16)(gw >> 16))));
      }
    }
  }
}
__device__ void phase_rec_ng(const Params& P, int kind) {
  if (kind == 1) phase_rec_ng_t<1>(P); else phase_rec_ng_t<3>(P);
}

__device__ void phase_swa_prep(const Params& P) {
  const u16* __restrict__ pj = (const u16*)(WS(P) + O_SA_P);
  u16* __restrict__ qn = (u16*)(WS(P) + O_SA_Q);
  u16* __restrict__ kn = (u16*)(WS(P) + O_SA_K);
  const float2* __restrict__ rope = (const float2*)(WS(P) + O_ROPES);
  const long gtid = (long)BID() * NT + TID(), gsz = (long)gridDim.x * NT;
  for (long idx = gtid; idx < (long)NTOK * 80; idx += gsz) {
    const int j = (int)(idx & 3);
    const int hd = (int)((idx >> 2) % 20);
    const int t = (int)(idx / 80);
    const int col = hd < 16 ? hd * 64 : 1024 + (hd - 16) * 64;
    const int d0 = j * 8;
    float x1[8], x2[8];
    unpack8(*(const uint4*)(pj + (long)t * 1536 + col + d0), x1);
    unpack8(*(const uint4*)(pj + (long)t * 1536 + col + d0 + 32), x2);
    const int L = t < 16384 ? 2048 : 8192;
    const float4* rp = (const float4*)(rope + (long)(t & (L - 1)) * 32 + d0);
    const float4 c01 = rp[0], c23 = rp[1], c45 = rp[2], c67 = rp[3];
    float ss = 0.f;
#pragma unroll
    for (int i = 0; i < 8; ++i) ss += x1[i] * x1[i] + x2[i] * x2[i];
    ss += __shfl_xor(ss, 1); ss += __shfl_xor(ss, 2);
    const float rstd = rsqrtf(ss * (1.f / 64.f) + 1e-6f);
    const float* gn = hd < 16 ? P.in[23] : P.in[24];
    const float4 ga = *(const float4*)(gn + d0), gb = *(const float4*)(gn + d0 + 4), gc = *(const float4*)(gn + d0 + 32), gd = *(const float4*)(gn + d0 + 36);
    const float g1[8] = {ga.x, ga.y, ga.z, ga.w, gb.x, gb.y, gb.z, gb.w};
    const float g2[8] = {gc.x, gc.y, gc.z, gc.w, gd.x, gd.y, gd.z, gd.w};
    const float cs[8] = {c01.x, c01.z, c23.x, c23.z, c45.x, c45.z, c67.x, c67.z};
    const float sn[8] = {c01.y, c01.w, c23.y, c23.w, c45.y, c45.w, c67.y, c67.w};
    const float osc = hd < 16 ? 0.125f : 1.f;
    float o1[8], o2[8];
#pragma unroll
    for (int i = 0; i < 8; ++i) {
      const float y1 = x1[i] * rstd * g1[i], y2 = x2[i] * rstd * g2[i];
      o1[i] = (y1 * cs[i] - y2 * sn[i]) * osc;
      o2[i] = (y1 * sn[i] + y2 * cs[i]) * osc;
    }
    u16* dst = hd < 16 ? qn + (long)t * 1024 + hd * 64 + d0 : kn + (long)t * 256 + (hd - 16) * 64 + d0;
    *(uint4*)dst = pack8s(o1, 1.f);
    *(uint4*)(dst + 32) = pack8s(o2, 1.f);
  }
}

constexpr int SLD = 324;
__device__ void phase_swa_att(const Params& P) {
  const u16* qn = (const u16*)(WS(P) + O_SA_Q);
  const u16* kn = (const u16*)(WS(P) + O_SA_K);
  const u16* pj = (const u16*)(WS(P) + O_SA_P);
  u16* a2 = (u16*)(WS(P) + O_SA_A);
  const float* sink = P.in[25];
  float* S = (float*)(smem + 40960);
  u16* Bs = (u16*)smem + 9216;
  const int tid = TID(), lane = tid & 63, wid = tid >> 6;
  const int wm = wid >> 2, wn = wid & 3, fr = lane & 15, fq = lane >> 4;
  const int nitems = (NTOK / 64) * 16;
  for (int item = VBID(); item < nitems; item += gridDim.x) {
    const int hq = item & 15, qbg = item >> 4;
    const int L = qbg < 256 ? 2048 : 8192;
    const int q0 = qbg < 256 ? (qbg & 31) * 64 : ((qbg - 256) & 127) * 64;
    const long tok0 = qbg < 256 ? (long)(qbg >> 5) * 2048 : 16384 + (long)((qbg - 256) >> 7) * 8192;
    const int hkv = hq >> 2;
    uint4 vt[5];
#pragma unroll
    for (int kt = 0; kt < 5; ++kt) {
      const int kp0 = q0 - 128 + kt * 64;
      vt[kt] = make_uint4(0, 0, 0, 0);
      if (kp0 >= 0 && kp0 < L) vt[kt] = ld_chunk<64, false>(pj + (tok0 + kp0) * 1536 + 1280 + hkv * 64, 1536, 0, tid);
    }
    for (int kt = 0; kt < 5; ++kt) {
      const int kp0 = q0 - 128 + kt * 64;
      if (kp0 >= 0 && kp0 < L) {
        f32x4 acc[2][1] = {};
        gemm_acc<64, 64, true, true, true, 1>(acc, qn + (tok0 + q0) * 1024 + hq * 64, 1024, kn + (tok0 + kp0) * 256 + hkv * 64, 256, (u16*)smem);
        epi_each<64, 64, true>(acc, [&](int r, int c, f32x4 v) {
          f32x4 o;
#pragma unroll
          for (int j = 0; j < 4; ++j) {
            const int dlt = (q0 + r) - (kp0 + c + j);
            o[j] = (dlt <= 128 && dlt >= -128) ? v[j] : -1e30f;
          }
          *(f32x4*)(S + r * SLD + kt * 64 + c) = o;
        });
      } else {
        for (int i = tid; i < 4096; i += NT) S[(i >> 6) * SLD + kt * 64 + (i & 63)] = -1e30f;
      }
    }
    __syncthreads();
    {
      const int r = tid >> 3, sub = tid & 7;
      const float sk = sink[hq];
      float e[40];
      float m = sk;
#pragma unroll
      for (int i = 0; i < 40; ++i) { e[i] = S[r * SLD + sub + 8 * i]; m = fmaxf(m, e[i]); }
      m = fmaxf(m, __shfl_xor(m, 1)); m = fmaxf(m, __shfl_xor(m, 2)); m = fmaxf(m, __shfl_xor(m, 4));
      float den = 0.f;
#pragma unroll
      for (int i = 0; i < 40; ++i) { e[i] = __expf(e[i] - m); den += e[i]; }
      den += __shfl_xor(den, 1); den += __shfl_xor(den, 2); den += __shfl_xor(den, 4);
      den += __expf(sk - m);
      const float inv = 1.f / den;
      u16* prow = (u16*)(S + r * SLD);
#pragma unroll
      for (int i = 0; i < 40; ++i) prow[sub + 8 * i] = f2bf(e[i] * inv);
    }
    __syncthreads();
    f32x4 acc[2][1] = {};
#pragma unroll
    for (int kt = 0; kt < 5; ++kt) {
      const int kp0 = q0 - 128 + kt * 64;
      if (kp0 >= 0 && kp0 < L) {
        __syncthreads();
        st_chunk<64, false>(Bs, vt[kt], tid);
        __syncthreads();
#pragma unroll
        for (int ks = 0; ks < 2; ++ks) {
          bf16x8 af[2];
#pragma unroll
          for (int mi = 0; mi < 2; ++mi) af[mi] = *(const bf16x8*)((const u16*)(S + (wm * 32 + mi * 16 + fr) * SLD) + kt * 64 + ks * 32 + fq * 8);
          const bf16x8 bfr = ld_frag<64, false>(Bs, wn * 16, ks, fr, fq);
#pragma unroll
          for (int mi = 0; mi < 2; ++mi) acc[mi][0] = __builtin_amdgcn_mfma_f32_16x16x32_bf16(bfr, af[mi], acc[mi][0], 0, 0, 0);
        }
      }
    }
    u16* o = a2 + (tok0 + q0) * 1024 + hq * 64;
    epi_each<64, 64, true>(acc, [&](int r, int c, f32x4 v) { *(uint2*)(o + (long)r * 1024 + c) = make_uint2(pack2(v[0], v[1]), pack2(v[2], v[3])); });
    __syncthreads();
  }
}

#define XB_TMO      128
#define XB_XCNT(j)  (256  + 64 * (j))
#define XB_XSUB(j)  (1280 + 64 * (j))
#define XB_XGEN(j)  (2304 + 64 * (j))
#define XB_TOP      3328
#define XB_TOPGEN   3392
#define XCD_BAR_WORDS 3456
#define XB_SPIN_CAP (1u << 18)
__device__ __forceinline__ unsigned xb_ld(unsigned* p)              { return __hip_atomic_load(p, __ATOMIC_RELAXED, __HIP_MEMORY_SCOPE_AGENT); }
__device__ __forceinline__ unsigned xb_add(unsigned* p, unsigned v) { return __hip_atomic_fetch_add(p, v, __ATOMIC_RELAXED, __HIP_MEMORY_SCOPE_AGENT); }
__device__ __forceinline__ unsigned xb_xcc_id() { return (unsigned)__builtin_amdgcn_s_getreg((3 << 11) | 20) & 0xFu; }
#define XB_SPIN(cond, bar) do { unsigned _sp = 0; while (cond) { __builtin_amdgcn_s_sleep(1); \
    if ((++_sp & 255u) == 0u) { if (xb_ld(&(bar)[XB_TMO])) break; if (_sp > XB_SPIN_CAP) { atomicAdd(&(bar)[XB_TMO], 1u); break; } } } } while (0)
struct XcdBarrier { unsigned* bar; unsigned x; volatile LDS_AS unsigned* st; };
__device__ __forceinline__ XcdBarrier xcd_barrier_post(unsigned* bar, volatile LDS_AS unsigned* st) {
    XcdBarrier b; b.bar = bar; b.x = xb_xcc_id(); b.st = st;
    if (threadIdx.x == 0) (void)xb_add(&bar[XB_XCNT(b.x)], 1u);
    return b;
}
__device__ __forceinline__ void xcd_barrier_complete(unsigned* bar, unsigned x, unsigned& nloc, unsigned& nx) {
    const unsigned G = gridDim.x * gridDim.y * gridDim.z;
    unsigned sum, cnt, mine, sp = 0u;
    for (;;) {
        sum = 0u; cnt = 0u; mine = 0u;
#pragma unroll
        for (unsigned j = 0; j < 16; ++j) { const unsigned c = xb_ld(&bar[XB_XCNT(j)]); sum += c; cnt += (c > 0u) ? 1u : 0u; mine = (j == x) ? c : mine; }
        if (sum == G) break;
        __builtin_amdgcn_s_sleep(1);
        if ((++sp & 255u) == 0u) { if (xb_ld(&bar[XB_TMO])) break; if (sp > XB_SPIN_CAP) { atomicAdd(&bar[XB_TMO], 1u); break; } }
    }
    nloc = mine > 0u ? mine : 1u; nx = cnt > 0u ? cnt : 1u;
}
__device__ __forceinline__ void xcd_barrier(const XcdBarrier& b) {
    asm volatile("s_waitcnt vmcnt(0)" ::: "memory");
    __syncthreads();
    if (threadIdx.x == 0) {
        unsigned* bar = b.bar;
        __builtin_amdgcn_s_waitcnt(0);
        unsigned nloc = b.st[0], nx = b.st[1];
        if (nloc == 0u) { xcd_barrier_complete(bar, b.x, nloc, nx); b.st[0] = nloc; b.st[1] = nx; }
        const unsigned old = xb_add(&bar[XB_XSUB(b.x)], 1u);
        const unsigned gen = old / nloc;
        if (old + 1u == (gen + 1u) * nloc) {
            __builtin_amdgcn_fence(__ATOMIC_RELEASE, "agent");
            asm volatile("s_waitcnt vmcnt(0)" ::: "memory");
            const unsigned og = xb_add(&bar[XB_TOP], 1u);
            const unsigned tg = og / nx;
            if (og + 1u == (tg + 1u) * nx) xb_add(&bar[XB_TOPGEN], 1u);
            else XB_SPIN(xb_ld(&bar[XB_TOPGEN]) == tg, bar);
            __builtin_amdgcn_fence(__ATOMIC_ACQUIRE, "agent");
            xb_add(&bar[XB_XGEN(b.x)], 1u);
            asm volatile("s_waitcnt vmcnt(0)" ::: "memory");
        } else {
            XB_SPIN(xb_ld(&bar[XB_XGEN(b.x)]) == gen, bar);
            __builtin_amdgcn_fence(__ATOMIC_ACQUIRE, "agent");
            asm volatile("s_waitcnt vmcnt(0)" ::: "memory");
        }
    }
    __syncthreads();
}

__device__ __forceinline__ int nmix_of(int kind) { return kind == 1 ? 8 : (kind == 3 ? 7 : (kind == 2 ? 5 : 6)); }
__device__ __forceinline__ int nsl_of(int kind) { return kind == 2 ? 1 : 5; }

__device__ void ffn_step(const Params& P, int layer, int f) {
  if (f == 6) { phase_ffn_down(P, layer); return; }
  const int fs = f / 3, st = f % 3;
  if (st == 0) { REP(4) phase_norm(P, layer, fs, 1); }
  else if (st == 1) { REP(0) phase_ffn_gate(P, layer); }
  else { REP(0) phase_ffn_val(P, layer, fs); }
}
__device__ void layer_step(const Params& P, int layer, int slab, int step) {
  const int kind = layer;
  if (step == 0) { REP(4) phase_norm(P, layer, slab, kind == 2 ? 2 : 0); return; }
  if (kind == 0) {
    if (step == 1) { REP(0) phase_proj(P, O_WHYIN, 3072); }
    else if (step == 2) { REP(3) phase_hy_conv(P, slab); }
    else if (step == 3) { if ((PROBE_MASK >> 7) & 1) phase_hy_fft(P, slab, true); phase_hy_fft(P, slab); }
    else if (step == 4) { REP(3) phase_hy_tr(P, slab); }
    else phase_resid(P, layer, slab, (const u16*)(WS(P) + O_A2), 1024, O_WHYOUT, 2 * D);
  } else if (kind == 1) {
    if (step == 1) { REP(0) phase_proj(P, O_WRETIN, 6144); }
    else if (step == 2) { REP(1) REP(9) phase_ret_prep(P, slab); }
    else if (step == 3) { REP(1) REP(11) phase_rec_su<256, 4>(P, 1); }
    else if (step == 4) { if ((PROBE_MASK >> 6) & 1) phase_rec_scan(P, 1, slab, true); phase_rec_scan(P, 1, slab); }
    else if (step == 5) { REP(1) REP(12) phase_rec_out<256, 4>(P, 1); }
    else if (step == 6) { REP(1) REP(9) phase_rec_ng(P, 1); }
    else phase_resid(P, layer, slab, (const u16*)(WS(P) + O_A2), 2048, O_WRETOUT, 2 * D);
  } else if (kind == 2) {
    if (step == 1) {
      EpiStoreBf16 E; E.O = (u16*)(WS(P) + O_SA_P); E.ldc = 1536;
      REP(0) run_gemm((const u16*)(WS(P) + O_SA_H), (const u16*)(WS(P) + O_WSWAIN), NTOK, 1536, D, E);
    }
    else if (step == 2) { REP(2) REP(14) phase_swa_prep(P); }
    else if (step == 3) { REP(2) REP(15) phase_swa_att(P); }
    else {
      EpiResid E; E.X = OUTP(P); E.XS = E.X; E.mod = (const float*)(WS(P) + O_MOD) + (long)layer * 16 * 6144; E.goff = 2 * D; E.grow0 = 0;
      run_gemm((const u16*)(WS(P) + O_SA_A), (const u16*)(WS(P) + O_WSWAOUT), NTOK, D, 1024, E);
    }
  } else {
    if (step == 1) { REP(0) phase_proj(P, O_WHGIN, 5120); }
    else if (step == 2) { REP(1) REP(9) phase_hg_prep(P); }
    else if (step == 3) { REP(1) REP(11) phase_rec_su<128, 2>(P, 3); }
    else if (step == 4) { if ((PROBE_MASK >> 6) & 1) phase_rec_scan(P, 3, slab, true); phase_rec_scan(P, 3, slab); }
    else if (step == 5) { REP(1) REP(12) phase_rec_out<128, 2>(P, 3); }
    else phase_resid(P, layer, slab, (const u16*)(WS(P) + O_A2), 1024, O_WHGOUT, 2 * D);
  }
}

__global__ void __launch_bounds__(NT) fwd_megakernel(Params P) {
  cg::grid_group grid = cg::this_grid();
  __shared__ uint4 xb_words;
  if (threadIdx.x == 0) xb_words = make_uint4(0u, 0u, 0u, 0u);
  __syncthreads();
  XcdBarrier xb = xcd_barrier_post((unsigned*)(P.ws + O_BAR), (volatile LDS_AS unsigned*)&xb_words);
  for (int pid = P.p0; pid < P.p1; ++pid) {
    if (pid == 0) { REP(5) phase_pre0(P); }
    else if (pid == 1) { REP(5) phase_pre1(P); }
    else {
      int q = pid - 2, layer = 0;
      while (q >= nsl_of(layer) * nmix_of(layer) + 7) { q -= nsl_of(layer) * nmix_of(layer) + 7; ++layer; }
      const int nm = nmix_of(layer), nsl = nsl_of(layer);
      if (q < nsl * nm) layer_step(P, layer, q / nm, q % nm);
      else ffn_step(P, layer, q - nsl * nm);
    }
    if (pid + 1 < P.p1) {
      if (pid == 0) grid.sync();
      else xcd_barrier(xb);
      if ((PROBE_MASK >> 8) & 1) xcd_barrier(xb);
    }
  }
}

extern "C" void kernel_launch(void* const* d_in, const int* in_sizes, int n_in, void* d_out, int out_size, void* d_ws,
                              size_t ws_size, hipStream_t stream) {
  static int grid_blocks = 0;
  if (!grid_blocks) {
    int dev = 0, cus = 0, per_cu = 0;
    (void)hipGetDevice(&dev);
    (void)hipDeviceGetAttribute(&cus, hipDeviceAttributeMultiprocessorCount, dev);
    (void)hipFuncSetAttribute((const void*)fwd_megakernel, hipFuncAttributeMaxDynamicSharedMemorySize, LDSB);
    (void)hipOccupancyMaxActiveBlocksPerMultiprocessor(&per_cu, (const void*)fwd_megakernel, NT, LDSB);
    if (per_cu < 1) per_cu = 1;
    if (per_cu > 1) per_cu = 1;
    grid_blocks = cus * per_cu;
    if (ws_size < WS_END) fprintf(stderr, "kernel_launch: workspace too small: %zu < %zu\n", ws_size, (size_t)WS_END);
  }
  Params p;
  memset(&p, 0, sizeof(p));
  for (int i = 0; i < 36; ++i) p.in[i] = (const float*)d_in[i];
  p.out = (float*)d_out;
  p.ws = (unsigned char*)d_ws;
  (void)hipMemsetAsync((unsigned char*)d_ws + O_BAR, 0, XCD_BAR_WORDS * 4, stream);
#if ONE_LAUNCH
  p.p0 = 0; p.p1 = NPHASES;
  void* args[] = {&p};
  hipError_t e = hipLaunchCooperativeKernel((const void*)fwd_megakernel, dim3(grid_blocks), dim3(NT), args, LDSB, stream);
  if (e != hipSuccess) fprintf(stderr, "cooperative launch failed: %s (grid %d)\n", hipGetErrorString(e), grid_blocks);
#else
  for (int ph = 0; ph < NPHASES; ++ph) {
    p.p0 = ph; p.p1 = ph + 1;
    hipLaunchKernelGGL(fwd_megakernel, dim3(grid_blocks), dim3(NT), LDSB, stream, p);
  }
#endif
}
```

```cpp
#include <hip/hip_runtime.h>
#include <hip/hip_cooperative_groups.h>
#include <cstdio>
#include <cstdint>
#include <cstring>
namespace cg = cooperative_groups;

typedef unsigned short u16;
typedef __attribute__((ext_vector_type(8))) short bf16x8;
typedef __attribute__((ext_vector_type(4))) float f32x4;

#define NT 512
#ifndef ONE_LAUNCH
#define ONE_LAUNCH 1
#endif
#ifndef PROBE_MASK
#define PROBE_MASK 0
#endif
#define REP(cls) for (int rep_##cls = 0; rep_##cls < (((PROBE_MASK >> (cls)) & 1) ? 2 : 1); ++rep_##cls)

constexpr int D = 1024, SLAB = 16384, DFF = 2816;
constexpr int LDSB = 139264;
constexpr int FSLAB = 40960, NTOK = 81920;
constexpr int NPHASES = 2 + 5 * (6 + 8 + 7) + 5 + 4 * 7;

constexpr size_t SZW(size_t n, size_t k) { return n * k * 2; }
constexpr size_t O_WHYIN = 0;
constexpr size_t O_WHYOUT = O_WHYIN + SZW(3072, 1024);
constexpr size_t O_WRETIN = O_WHYOUT + SZW(1024, 1024);
constexpr size_t O_WRETOUT = O_WRETIN + SZW(6144, 1024);
constexpr size_t O_WSWAIN = O_WRETOUT + SZW(1024, 2048);
constexpr size_t O_WSWAOUT = O_WSWAIN + SZW(1536, 1024);
constexpr size_t O_WHGIN = O_WSWAOUT + SZW(1024, 1024);
constexpr size_t O_WHGOUT = O_WHGIN + SZW(5120, 1024);
constexpr size_t O_WFG = O_WHGOUT + SZW(1024, 1024);
constexpr size_t O_WFV = O_WFG + 4 * SZW(2816, 1024);
constexpr size_t O_WFD = O_WFV + 4 * SZW(2816, 1024);
constexpr size_t O_MOD = O_WFD + 4 * SZW(1024, 2816);
constexpr size_t O_TW = O_MOD + (size_t)4 * 16 * 6144 * 4;
constexpr size_t O_HIDS = O_TW + 8192 * 8;
constexpr size_t O_HIDP = O_HIDS + (size_t)8192 * 64 * 4;
constexpr size_t O_ROPER = O_HIDP + (size_t)2048 * 64 * 4;
constexpr size_t O_ROPES = O_ROPER + (size_t)8192 * 128 * 8;
constexpr size_t O_PROJ = O_ROPES + (size_t)8192 * 32 * 8;
constexpr size_t O_HBUF = O_PROJ + (size_t)SLAB * 6144 * 2;
constexpr size_t O_A2 = O_HBUF + (size_t)SLAB * 1024 * 2;
constexpr size_t O_C = O_A2 + (size_t)SLAB * 2048 * 2;
constexpr size_t O_FHBUF = O_PROJ;
constexpr size_t O_FGBUF = O_FHBUF + (size_t)FSLAB * 1024 * 2;
constexpr size_t O_FACT = O_FGBUF + (size_t)FSLAB * DFF * 2;
constexpr size_t END_F = O_FACT + (size_t)NTOK * DFF * 2;
constexpr size_t O_MODP = O_C;
constexpr size_t O_BAR = ((size_t)1 << 30) - 16384;
constexpr size_t O_HSPS = O_BAR - (size_t)1024 * 16384 * 8 - (size_t)1024 * 4096 * 8;
constexpr size_t O_HSPP = O_HSPS + (size_t)1024 * 16384 * 8;
constexpr size_t O_UT = O_C;
constexpr size_t O_X0C = O_UT + (size_t)SLAB * 1024 * 4;
constexpr size_t END_HY = O_X0C + (size_t)SLAB * 1024 * 2;
static_assert(END_F <= O_HSPS && END_HY <= O_HSPS, "layer-0 buffers overlap the filter spectra");
constexpr size_t SZP = (size_t)SLAB * 1024 * 2;
constexpr size_t O_QDF = O_C, O_QDB = O_QDF + SZP, O_KIF = O_QDB + SZP, O_KIB = O_KIF + SZP, O_KEF = O_KIB + SZP, O_KEB = O_KEF + SZP;
constexpr size_t O_DLF = O_KEB + SZP;
constexpr size_t O_DLB = O_DLF + (size_t)256 * 1024 * 4;
constexpr size_t O_SC = O_DLB + (size_t)256 * 1024 * 4;
constexpr size_t O_STF = O_SC + (size_t)SLAB * 1024 * 2;
constexpr size_t O_STB = O_STF + (size_t)134217728;
constexpr size_t O_OBUF = O_STB + (size_t)134217728;
constexpr size_t END_REC = O_OBUF + (size_t)SLAB * 2048 * 4;
constexpr size_t O_QN = O_C;
constexpr size_t O_KN = O_QN + SZP;
constexpr size_t O_PBUF = O_KN + (size_t)SLAB * 256 * 2;
constexpr size_t END_SWA0 = O_PBUF + (size_t)SLAB * 16 * 320 * 2;
constexpr size_t O_SA_H = O_PROJ;
constexpr size_t O_SA_P = O_SA_H + (size_t)81920 * 1024 * 2;
constexpr size_t O_SA_Q = O_SA_P + (size_t)81920 * 1536 * 2;
constexpr size_t O_SA_K = O_SA_Q + (size_t)81920 * 1024 * 2;
constexpr size_t O_SA_A = O_SA_K + (size_t)81920 * 256 * 2;
constexpr size_t END_SWA = O_SA_A + (size_t)81920 * 1024 * 2;
constexpr size_t WS_END = END_REC > END_HY ? (END_REC > END_SWA ? END_REC : END_SWA) : (END_HY > END_SWA ? END_HY : END_SWA);
static_assert(WS_END <= O_BAR, "workspace exceeds 1 GiB");

struct Params {
  const float* in[36];
  float* out;
  unsigned char* ws;
  int p0, p1;
};

extern __shared__ __attribute__((aligned(16))) unsigned char smem[];

__device__ __forceinline__ int TID() { int t = threadIdx.x; asm volatile("" : "+v"(t)); return t; }
__device__ __forceinline__ int BID() { int b = blockIdx.x; asm volatile("" : "+s"(b)); return b; }
__device__ __forceinline__ int VBID() { const int b = BID(), g = gridDim.x; return (g & 7) ? b : (b & 7) * (g >> 3) + (b >> 3); }
__device__ __forceinline__ long ZOFF() { long z = 0; asm volatile("" : "+s"(z)); return z; }
__device__ __forceinline__ unsigned char* WS(const Params& P) { return P.ws + ZOFF(); }
__device__ __forceinline__ float* OUTP(const Params& P) { return P.out + ZOFF(); }

namespace pg8 {
#define PG8_LAS __attribute__((address_space(3)))
typedef unsigned short bf16_t;
typedef short bf16x8 __attribute__((ext_vector_type(8)));
typedef float f32x4 __attribute__((ext_vector_type(4)));
typedef unsigned u32x4 __attribute__((ext_vector_type(4)));
constexpr int BM = 256, BK = 64, HALF = 128, HTB = HALF * BK * 2  , STAGE_BYTES = 8 * HTB, NXCD = 8, WGM = 8;

__host__ __device__ __forceinline__ int lds_byte(int r, int c) { const int st = (r >> 4) * 2 + (c >> 5), rr = r & 15, cc = c & 31, ob = rr * 64 + cc * 2; return st * 1024 + (ob ^ (((ob >> 9) & 1) << 5)); }
__host__ __device__ __forceinline__ void stage_rc(int b, int& R, int& C) { const int st = b / 1024, sb = b % 1024, swz = sb ^ (((sb >> 9) & 1) << 5); R = (st >> 1) * 16 + swz / 64; C = (st & 1) * 32 + (swz % 64) / 2; }
__host__ __device__ __forceinline__ int perm32(int rho) { const int n = rho >> 4, i = rho & 15; return 8 * (i >> 2) + 4 * n + (i & 3); }

struct Unit { int pm, pn; };
struct Gemm { const bf16_t* A; const bf16_t* Bt; int M, N, K; };

struct StaticOrder {
    int nM, nN, nwg, G, c;
    __host__ __device__ void init(int M, int N, int G_, int c_) { nM = M / BM; nN = N / BM; nwg = nM * nN; G = G_; c = c_; }
    __host__ __device__ bool next(int i, Unit& u) const {
        const long L = (long)i * G + c; if (L >= nwg) return false;
        int wgid = (int)L; { const int q = nwg / NXCD, r = nwg % NXCD, xcd = wgid % NXCD, off = wgid / NXCD; wgid = (xcd < r ? xcd * (q + 1) : r * (q + 1) + (xcd - r) * q) + off; }
        const int nig = WGM * nN, gid = wgid / nig, fm = gid * WGM, gsz = (nM - fm) < WGM ? (nM - fm) : WGM;
        u.pm = fm + ((wgid % nig) % gsz); u.pn = (wgid % nig) / gsz; return true;
    }
    __device__ __forceinline__ void a_ready(const Unit&) const {}
    __device__ __forceinline__ void done(const Unit&) const {}
};

template <class Epi, class Sched, bool STAMP = false>
__device__ __forceinline__ void gemm_phase(PG8_LAS unsigned char* lds, const Gemm g, const Sched& S, const Epi& E, unsigned long long* stamps) {
    const int tid = TID(), wid = __builtin_amdgcn_readfirstlane(tid >> 6), lane = tid & 63, wr = wid >> 2, wc = wid & 3, fr = lane & 15, fq = lane >> 4;
    const int K = g.K, nt = K / BK;
    int ts_lo = 0, ts_hi = 0, nts = 0; const unsigned long long rt_entry = STAMP ? (unsigned long long)wall_clock64() : 0ull;
#define PG8_STAMP() do { if (STAMP && wid == 0 && nts < 64) { const unsigned long long _c = (unsigned long long)clock64(); \
        ts_lo = (lane == nts) ? (int)(unsigned)_c : ts_lo; ts_hi = (lane == nts) ? (int)(unsigned)(_c >> 32) : ts_hi; ++nts; } } while (0)
    PG8_STAMP();
    unsigned voffA[2], voffB[2];
#pragma unroll
    for (int i = 0; i < 2; ++i) { int R, C; stage_rc(tid * 16 + i * 8192, R, C); const int Rb = Epi::PERM ? ((R & ~31) + perm32(R & 31)) : R;
        voffA[i] = (unsigned)(R * K + C) * 2u; voffB[i] = (unsigned)(Rb * K + C) * 2u; }
    const size_t kstep = (size_t)(BK * 2);
    const size_t hstep = (size_t)HALF * K * 2;
    const size_t tstep = 2 * hstep;
    const unsigned ldsw = (unsigned)wid * 1024u;
    const int aoff = lds_byte(wr * 64 + fr, fq * 8), boff = lds_byte(wc * 32 + fr, fq * 8);
#define PG8_SA(b, h) (((b) * 2 + (h)) * HTB)
#define PG8_SB(b, h) ((4 + (b) * 2 + (h)) * HTB)
#define PG8_STAGE(bufoff, gbase, voff) do { _Pragma("unroll") for (int _i = 0; _i < 2; ++_i) \
        __builtin_amdgcn_global_load_lds((const unsigned*)((const char*)(gbase) + (voff)[_i]), (PG8_LAS unsigned*)(lds + (bufoff) + ldsw + _i * 8192), 16, 0, 0); } while (0)
#define PG8_LDA(dst, b, h) do { _Pragma("unroll") for (int m = 0; m < 4; ++m) _Pragma("unroll") for (int k = 0; k < 2; ++k) dst[m][k] = *(const PG8_LAS bf16x8*)(lds + PG8_SA(b, h) + aoff + m * 2048 + k * 1024); } while (0)
#define PG8_LDB(dst, b, h) do { _Pragma("unroll") for (int n = 0; n < 2; ++n) _Pragma("unroll") for (int k = 0; k < 2; ++k) dst[n][k] = *(const PG8_LAS bf16x8*)(lds + PG8_SB(b, h) + boff + n * 2048 + k * 1024); } while (0)
#define PG8_MMA(ai, bj, At, Bt) do { __builtin_amdgcn_s_setprio(1); _Pragma("unroll") for (int m = 0; m < 4; ++m) _Pragma("unroll") for (int n = 0; n < 2; ++n) _Pragma("unroll") for (int k = 0; k < 2; ++k) \
        acc[ai][bj][m][n] = __builtin_amdgcn_mfma_f32_16x16x32_bf16(Bt[n][k], At[m][k], acc[ai][bj][m][n], 0, 0, 0); __builtin_amdgcn_s_setprio(0); } while (0)
#define PG8_WAIT_V(n) asm volatile("s_waitcnt vmcnt(" #n ")" ::: "memory")
#define PG8_WAIT_L(n) asm volatile("s_waitcnt lgkmcnt(" #n ")" ::: "memory")
#define PG8_BAR __builtin_amdgcn_s_barrier()
#define PG8_SCHED __builtin_amdgcn_sched_barrier(0)
    Unit cur, nxt; int ui = 0;
    if (!S.next(0, cur)) return;
    f32x4 acc[2][2][4][2];
#pragma unroll
    for (int a = 0; a < 2; ++a)
#pragma unroll
        for (int b = 0; b < 2; ++b)
#pragma unroll
            for (int m = 0; m < 4; ++m)
#pragma unroll
                for (int n = 0; n < 2; ++n) acc[a][b][m][n] = (f32x4){0.f, 0.f, 0.f, 0.f};
    bf16x8 At[4][2], B0[2][2], B1[2][2];
    const char* cA = (const char*)g.A + (size_t)cur.pm * tstep; const char* cB = (const char*)g.Bt + (size_t)cur.pn * tstep;
    S.a_ready(cur);
    PG8_STAGE(PG8_SB(0, 0), cB, voffB); PG8_STAGE(PG8_SA(0, 0), cA, voffA); PG8_STAGE(PG8_SB(0, 1), cB + hstep, voffB); PG8_STAGE(PG8_SA(0, 1), cA + hstep, voffA);
    if (wr == 1) PG8_BAR;
    PG8_WAIT_V(4); PG8_BAR;
    PG8_STAGE(PG8_SB(1, 0), cB + kstep, voffB); PG8_STAGE(PG8_SA(1, 0), cA + kstep, voffA); PG8_STAGE(PG8_SB(1, 1), cB + hstep + kstep, voffB);
    PG8_WAIT_V(6); PG8_BAR;
    PG8_STAMP();
    for (;;) {
        const bool has_next = S.next(ui + 1, nxt);
        const char* nA = has_next ? (const char*)g.A + (size_t)nxt.pm * tstep : cA; const char* nB = has_next ? (const char*)g.Bt + (size_t)nxt.pn * tstep : cB;
        for (int t = 0; t < nt; t += 2) {
            const bool last = (t == nt - 2);
            const char* a1 = cA + (size_t)(t + 1) * kstep;
            const char* a2 = last ? nA : cA + (size_t)(t + 2) * kstep; const char* b2 = last ? nB : cB + (size_t)(t + 2) * kstep;
            const char* a3 = a2 + kstep; const char* b3 = b2 + kstep;
            if (last && has_next) S.a_ready(nxt);
            PG8_LDB(B0, 0, 0); PG8_SCHED; PG8_LDA(At, 0, 0); PG8_STAGE(PG8_SA(1, 1), a1 + hstep, voffA);
            PG8_WAIT_L(8); PG8_BAR; PG8_WAIT_L(0); PG8_MMA(0, 0, At, B0); PG8_BAR; PG8_SCHED;
            PG8_LDB(B1, 0, 1); PG8_STAGE(PG8_SB(0, 0), b2, voffB);
            PG8_BAR; PG8_WAIT_L(0); PG8_MMA(0, 1, At, B1); PG8_BAR;
            PG8_LDA(At, 0, 1); PG8_STAGE(PG8_SA(0, 0), a2, voffA);
            PG8_BAR; PG8_WAIT_L(0); PG8_MMA(1, 0, At, B0); PG8_BAR; PG8_SCHED;
            PG8_STAGE(PG8_SB(0, 1), b2 + hstep, voffB);
            PG8_WAIT_V(6); PG8_BAR; PG8_MMA(1, 1, At, B1); PG8_BAR;
            PG8_LDB(B0, 1, 0); PG8_SCHED; PG8_LDA(At, 1, 0); PG8_STAGE(PG8_SA(0, 1), a2 + hstep, voffA);
            PG8_WAIT_L(8); PG8_BAR; PG8_WAIT_L(0); PG8_MMA(0, 0, At, B0); PG8_BAR; PG8_SCHED;
            PG8_LDB(B1, 1, 1); PG8_STAGE(PG8_SB(1, 0), b3, voffB);
            PG8_BAR; PG8_WAIT_L(0); PG8_MMA(0, 1, At, B1); PG8_BAR;
            PG8_LDA(At, 1, 1); PG8_STAGE(PG8_SA(1, 0), a3, voffA);
            PG8_BAR; PG8_WAIT_L(0); PG8_MMA(1, 0, At, B0); PG8_BAR; PG8_SCHED;
            PG8_STAGE(PG8_SB(1, 1), b3 + hstep, voffB);
            PG8_WAIT_V(6); PG8_BAR; PG8_MMA(1, 1, At, B1); PG8_BAR;
        }
        PG8_STAMP();
        if constexpr (!Epi::AFTER_DRAIN) { E(acc, cur, wr, wc, fr, fq); S.done(cur); }
        PG8_STAMP();
        if (!has_next) break;
#pragma unroll
        for (int a = 0; a < 2; ++a)
#pragma unroll
            for (int b = 0; b < 2; ++b)
#pragma unroll
                for (int m = 0; m < 4; ++m)
#pragma unroll
                    for (int n = 0; n < 2; ++n) acc[a][b][m][n] = (f32x4){0.f, 0.f, 0.f, 0.f};
        cur = nxt; cA = nA; cB = nB; ++ui;
    }
    PG8_WAIT_V(0);
    if (wr == 0) PG8_BAR;
    PG8_BAR;
    if constexpr (Epi::AFTER_DRAIN) { E.fused(acc, cur, wr, wc, fr, fq, lds, wid, lane); S.done(cur); }
    PG8_STAMP();
    if (STAMP && wid == 0) { stamps[lane] = lane < nts ? (((unsigned long long)(unsigned)ts_hi << 32) | (unsigned)ts_lo) : 0ull;
        if (lane == 62) stamps[62] = rt_entry; if (lane == 63) stamps[63] = (unsigned long long)wall_clock64(); }
#undef PG8_STAMP
#undef PG8_SA
#undef PG8_SB
#undef PG8_STAGE
#undef PG8_LDA
#undef PG8_LDB
#undef PG8_MMA
#undef PG8_WAIT_V
#undef PG8_WAIT_L
#undef PG8_BAR
#undef PG8_SCHED
}
}


__device__ __forceinline__ u16 f2bf(float f) {
  unsigned u = __float_as_uint(f);
  u += 0x7fffu + ((u >> 16) & 1u);
  return (u16)(u >> 16);
}
__device__ __forceinline__ float bf2f(u16 h) { return __uint_as_float(((unsigned)h) << 16); }
__device__ __forceinline__ unsigned pack2(float a, float b) { return (unsigned)f2bf(a) | ((unsigned)f2bf(b) << 16); }
__device__ __forceinline__ void unpack8(const uint4 v, float (&f)[8]) {
  f[0] = bf2f((u16)(v.x & 0xffff)); f[1] = bf2f((u16)(v.x >> 16)); f[2] = bf2f((u16)(v.y & 0xffff)); f[3] = bf2f((u16)(v.y >> 16));
  f[4] = bf2f((u16)(v.z & 0xffff)); f[5] = bf2f((u16)(v.z >> 16)); f[6] = bf2f((u16)(v.w & 0xffff)); f[7] = bf2f((u16)(v.w >> 16));
}
__device__ __forceinline__ uint4 pack8s(const float (&f)[8], float sc) {
  return make_uint4(pack2(f[0] * sc, f[1] * sc), pack2(f[2] * sc, f[3] * sc), pack2(f[4] * sc, f[5] * sc), pack2(f[6] * sc, f[7] * sc));
}
__device__ __forceinline__ float silu_f(float x) { return x / (1.f + __expf(-x)); }
__device__ __forceinline__ float sigm(float x) { return 1.f / (1.f + __expf(-x)); }
__device__ __forceinline__ float wave_sum(float v) {
#pragma unroll
  for (int o = 32; o; o >>= 1) v += __shfl_xor(v, o);
  return v;
}
__device__ __forceinline__ const float* xin_of(const Params& P, int slab) { return slab == 0 ? P.in[0] : P.in[1] + (long)(slab - 1) * SLAB * D; }
__device__ __forceinline__ int Lof(int slab) { return slab == 0 ? 2048 : 8192; }
__device__ __forceinline__ int gb_row(int gr) { return gr < 16384 ? (gr >> 11) : (8 + ((gr - 16384) >> 13)); }
__device__ __forceinline__ int gb_of(int slab, int r) { return slab == 0 ? (r >> 11) : (8 + (slab - 1) * 2 + (r >> 13)); }

typedef short v4s __attribute__((ext_vector_type(4)));
#define LBAR() asm volatile("s_waitcnt lgkmcnt(0)\n\ts_barrier" ::: "memory")
#define LDS_AS __attribute__((address_space(3)))
template <int R, bool KC>
__device__ __forceinline__ uint4 ld_chunk(const u16* __restrict__ base, long ld, int k0, int c) {
  if (KC) {
    const int r = c >> 3, kc = c & 7;
    return *(const uint4*)(base + (long)r * ld + k0 + kc * 8);
  } else {
    const int k = c / (R / 8), mc = c % (R / 8);
    return *(const uint4*)(base + (long)(k0 + k) * ld + mc * 8);
  }
}
template <int R, bool KC>
__device__ __forceinline__ void st_chunk(u16* s, uint4 v, int c) {
  if (KC) {
    const int r = c >> 3, kc = c & 7;
    *(uint4*)(s + r * 72 + kc * 8) = v;
  } else {
    const int k = c / (R / 8), mc = c % (R / 8);
    *(uint4*)(s + k * (R + 8) + mc * 8) = v;
  }
}
template <int R, bool KC>
__device__ __forceinline__ bf16x8 ld_frag(const u16* s, int x0, int ks, int fr, int fq) {
  if (KC) {
    return *(const bf16x8*)(s + (x0 + fr) * 72 + ks * 32 + fq * 8);
  } else {
    const int q4 = fr >> 2, p4 = fr & 3;
    const u16* p = s + (ks * 32 + 8 * fq + q4) * (R + 8) + x0 + 4 * p4;
    v4s lo = __builtin_amdgcn_ds_read_tr16_b64_v4i16((LDS_AS v4s*)p);
    v4s hi = __builtin_amdgcn_ds_read_tr16_b64_v4i16((LDS_AS v4s*)(p + 4 * (R + 8)));
    bf16x8 r;
    r[0] = lo[0]; r[1] = lo[1]; r[2] = lo[2]; r[3] = lo[3]; r[4] = hi[0]; r[5] = hi[1]; r[6] = hi[2]; r[7] = hi[3];
    return r;
  }
}

template <int TM, int TN, bool AKC, bool BKC, bool TR, int KT>
__device__ __forceinline__ void gemm_acc(f32x4 (&acc)[TM / 32][TN / 64], const u16* __restrict__ A, long lda,
                                         const u16* __restrict__ B, long ldb, u16* sm) {
  u16* As = sm;
  u16* Bs = sm + 9216;
  const int tid = TID(), lane = tid & 63, wid = tid >> 6;
  const int wm = wid >> 2, wn = wid & 3, fr = lane & 15, fq = lane >> 4;
  constexpr int MI = TM / 32, NI = TN / 64;
  uint4 ra0[KT], ra1[KT], rb0[KT], rb1[KT];
#pragma unroll
  for (int kt = 0; kt < KT; ++kt) {
    ra0[kt] = ld_chunk<TM, AKC>(A, lda, kt * 64, tid);
    ra1[kt] = ra0[kt];
    if (TM == 128) ra1[kt] = ld_chunk<TM, AKC>(A, lda, kt * 64, tid + NT);
    rb0[kt] = ld_chunk<TN, BKC>(B, ldb, kt * 64, tid);
    rb1[kt] = rb0[kt];
    if (TN == 128) rb1[kt] = ld_chunk<TN, BKC>(B, ldb, kt * 64, tid + NT);
  }
  __syncthreads();
  st_chunk<TM, AKC>(As, ra0[0], tid);
  if (TM == 128) st_chunk<TM, AKC>(As, ra1[0], tid + NT);
  st_chunk<TN, BKC>(Bs, rb0[0], tid);
  if (TN == 128) st_chunk<TN, BKC>(Bs, rb1[0], tid + NT);
  __syncthreads();
#pragma unroll
  for (int kt = 0; kt < KT; ++kt) {
    u16* Ac = As + (kt & 1) * 18432;
    u16* Bc = Bs + (kt & 1) * 18432;
    if (kt + 1 < KT) {
      u16* An = As + ((kt + 1) & 1) * 18432;
      u16* Bn = Bs + ((kt + 1) & 1) * 18432;
      st_chunk<TM, AKC>(An, ra0[kt + 1 < KT ? kt + 1 : 0], tid);
      if (TM == 128) st_chunk<TM, AKC>(An, ra1[kt + 1 < KT ? kt + 1 : 0], tid + NT);
      st_chunk<TN, BKC>(Bn, rb0[kt + 1 < KT ? kt + 1 : 0], tid);
      if (TN == 128) st_chunk<TN, BKC>(Bn, rb1[kt + 1 < KT ? kt + 1 : 0], tid + NT);
    }
#pragma unroll
    for (int ks = 0; ks < 2; ++ks) {
      bf16x8 af[MI], bfr[NI];
#pragma unroll
      for (int mi = 0; mi < MI; ++mi) af[mi] = ld_frag<TM, AKC>(Ac, wm * (TM / 2) + mi * 16, ks, fr, fq);
#pragma unroll
      for (int ni = 0; ni < NI; ++ni) bfr[ni] = ld_frag<TN, BKC>(Bc, wn * (TN / 4) + ni * 16, ks, fr, fq);
#pragma unroll
      for (int mi = 0; mi < MI; ++mi)
#pragma unroll
        for (int ni = 0; ni < NI; ++ni)
          acc[mi][ni] = TR ? __builtin_amdgcn_mfma_f32_16x16x32_bf16(bfr[ni], af[mi], acc[mi][ni], 0, 0, 0)
                           : __builtin_amdgcn_mfma_f32_16x16x32_bf16(af[mi], bfr[ni], acc[mi][ni], 0, 0, 0);
    }
    __syncthreads();
  }
}

template <int KT> struct Tiles { uint4 a0[KT], a1[KT], b0[KT], b1[KT]; };
template <int TM, int TN, bool AKC, bool BKC, int KT>
__device__ __forceinline__ void tiles_issue(Tiles<KT>& t, const u16* __restrict__ A, long lda, const u16* __restrict__ B, long ldb) {
  const int tid = TID();
#pragma unroll
  for (int kt = 0; kt < KT; ++kt) {
    t.a0[kt] = ld_chunk<TM, AKC>(A, lda, kt * 64, tid);
    t.a1[kt] = t.a0[kt];
    if (TM == 128) t.a1[kt] = ld_chunk<TM, AKC>(A, lda, kt * 64, tid + NT);
    t.b0[kt] = ld_chunk<TN, BKC>(B, ldb, kt * 64, tid);
    t.b1[kt] = t.b0[kt];
    if (TN == 128) t.b1[kt] = ld_chunk<TN, BKC>(B, ldb, kt * 64, tid + NT);
  }
}
template <int TM, int TN, bool AKC, bool BKC, bool TR, int KT>
__device__ __forceinline__ void gemm_run(f32x4 (&acc)[TM / 32][TN / 64], const Tiles<KT>& t, u16* sm) {
  u16* As = sm;
  u16* Bs = sm + 9216;
  const int tid = TID(), lane = tid & 63, wid = tid >> 6;
  const int wm = wid >> 2, wn = wid & 3, fr = lane & 15, fq = lane >> 4;
  constexpr int MI = TM / 32, NI = TN / 64;
  __syncthreads();
  st_chunk<TM, AKC>(As, t.a0[0], tid);
  if (TM == 128) st_chunk<TM, AKC>(As, t.a1[0], tid + NT);
  st_chunk<TN, BKC>(Bs, t.b0[0], tid);
  if (TN == 128) st_chunk<TN, BKC>(Bs, t.b1[0], tid + NT);
  __syncthreads();
#pragma unroll
  for (int kt = 0; kt < KT; ++kt) {
    u16* Ac = As + (kt & 1) * 18432;
    u16* Bc = Bs + (kt & 1) * 18432;
    if (kt + 1 < KT) {
      u16* An = As + ((kt + 1) & 1) * 18432;
      u16* Bn = Bs + ((kt + 1) & 1) * 18432;
      st_chunk<TM, AKC>(An, t.a0[kt + 1 < KT ? kt + 1 : 0], tid);
      if (TM == 128) st_chunk<TM, AKC>(An, t.a1[kt + 1 < KT ? kt + 1 : 0], tid + NT);
      st_chunk<TN, BKC>(Bn, t.b0[kt + 1 < KT ? kt + 1 : 0], tid);
      if (TN == 128) st_chunk<TN, BKC>(Bn, t.b1[kt + 1 < KT ? kt + 1 : 0], tid + NT);
    }
#pragma unroll
    for (int ks = 0; ks < 2; ++ks) {
      bf16x8 af[MI], bfr[NI];
#pragma unroll
      for (int mi = 0; mi < MI; ++mi) af[mi] = ld_frag<TM, AKC>(Ac, wm * (TM / 2) + mi * 16, ks, fr, fq);
#pragma unroll
      for (int ni = 0; ni < NI; ++ni) bfr[ni] = ld_frag<TN, BKC>(Bc, wn * (TN / 4) + ni * 16, ks, fr, fq);
#pragma unroll
      for (int mi = 0; mi < MI; ++mi)
#pragma unroll
        for (int ni = 0; ni < NI; ++ni)
          acc[mi][ni] = TR ? __builtin_amdgcn_mfma_f32_16x16x32_bf16(bfr[ni], af[mi], acc[mi][ni], 0, 0, 0)
                           : __builtin_amdgcn_mfma_f32_16x16x32_bf16(af[mi], bfr[ni], acc[mi][ni], 0, 0, 0);
    }
    __syncthreads();
  }
}

template <int TM, int TN, bool TR, class F>
__device__ __forceinline__ void epi_each(f32x4 (&acc)[TM / 32][TN / 64], F f) {
  const int tid = TID(), lane = tid & 63, wid = tid >> 6;
  const int wm = wid >> 2, wn = wid & 3, fr = lane & 15, fq = lane >> 4;
#pragma unroll
  for (int mi = 0; mi < TM / 32; ++mi)
#pragma unroll
    for (int ni = 0; ni < TN / 64; ++ni) {
      const int r0 = wm * (TM / 2) + mi * 16, c0 = wn * (TN / 4) + ni * 16;
      if (TR) f(r0 + fr, c0 + fq * 4, acc[mi][ni]);
      else f(r0 + fq * 4, c0 + fr, acc[mi][ni]);
    }
}

struct EpiStoreBf16 {
  static constexpr bool PERM = true, AFTER_DRAIN = false;
  u16* O; int ldc;
  __device__ __forceinline__ void operator()(const f32x4 (&acc)[2][2][4][2], const pg8::Unit& u, int wr, int wc, int fr, int fq) const {
    const int row0 = u.pm * 256 + wr * 64 + fr, col0 = u.pn * 256 + wc * 32 + 8 * fq;
#pragma unroll
    for (int ai = 0; ai < 2; ++ai)
#pragma unroll
      for (int m = 0; m < 4; ++m) {
        u16* rowp = O + (size_t)(row0 + ai * 128 + m * 16) * ldc + col0;
#pragma unroll
        for (int bj = 0; bj < 2; ++bj) {
          const f32x4 v0 = acc[ai][bj][m][0], v1 = acc[ai][bj][m][1];
          *(uint4*)(rowp + bj * 128) = make_uint4(pack2(v0[0], v0[1]), pack2(v0[2], v0[3]), pack2(v1[0], v1[1]), pack2(v1[2], v1[3]));
        }
      }
  }
};
struct EpiResid {
  static constexpr bool PERM = false, AFTER_DRAIN = false;
  float* X; const float* XS; const float* mod; int goff; int grow0;
  __device__ __forceinline__ void operator()(const f32x4 (&acc)[2][2][4][2], const pg8::Unit& u, int wr, int wc, int fr, int fq) const {
    const int row0 = u.pm * 256 + wr * 64 + fr, col0 = u.pn * 256 + wc * 32 + 4 * fq;
    const float* g = mod + (size_t)gb_row(grow0 + u.pm * 256) * 6144 + goff + col0;
    f32x4 gv[2][2];
#pragma unroll
    for (int bj = 0; bj < 2; ++bj)
#pragma unroll
      for (int n = 0; n < 2; ++n) gv[bj][n] = *(const f32x4*)(g + bj * 128 + n * 16);
#pragma unroll
    for (int am = 0; am < 4; ++am) {
      f32x4 xv[2][2][2];
#pragma unroll
      for (int mm = 0; mm < 2; ++mm)
#pragma unroll
        for (int bj = 0; bj < 2; ++bj)
#pragma unroll
          for (int n = 0; n < 2; ++n) xv[mm][bj][n] = *(const f32x4*)(XS + (size_t)(row0 + (am >> 1) * 128 + ((am & 1) * 2 + mm) * 16) * D + col0 + bj * 128 + n * 16);
#pragma unroll
      for (int mm = 0; mm < 2; ++mm)
#pragma unroll
        for (int bj = 0; bj < 2; ++bj)
#pragma unroll
          for (int n = 0; n < 2; ++n)
            *(f32x4*)(X + (size_t)(row0 + (am >> 1) * 128 + ((am & 1) * 2 + mm) * 16) * D + col0 + bj * 128 + n * 16) = xv[mm][bj][n] + gv[bj][n] * acc[am >> 1][bj][(am & 1) * 2 + mm][n];
    }
  }
};
struct EpiFfnVal {
  static constexpr bool PERM = false, AFTER_DRAIN = false;
  const u16* G; u16* ACT; const float* cw; const float* cb; int grow0;
  __device__ __forceinline__ void operator()(const f32x4 (&acc)[2][2][4][2], const pg8::Unit& u, int wr, int wc, int fr, int fq) const {
    const int row0 = u.pm * 256 + wr * 64 + fr, col0 = u.pn * 256 + wc * 32 + 4 * fq;
#pragma unroll
    for (int bj = 0; bj < 2; ++bj)
#pragma unroll
      for (int n = 0; n < 2; ++n) {
        const int c = col0 + bj * 128 + n * 16;
        const f32x4 w0 = *(const f32x4*)(cw + c), w1 = *(const f32x4*)(cw + DFF + c), w2 = *(const f32x4*)(cw + 2 * DFF + c), bb = *(const f32x4*)(cb + c);
#pragma unroll
        for (int ai = 0; ai < 2; ++ai) {
          uint2 g0[4], g1[4], g2[4];
#pragma unroll
          for (int m = 0; m < 4; ++m) {
            const int r = row0 + ai * 128 + m * 16;
            const int L = (grow0 + r) < 16384 ? 2048 : 8192;
            const int pos = (grow0 + r) & (L - 1);
            const u16* gp = G + (size_t)r * DFF + c;
            g1[m] = *(const uint2*)gp;
            g0[m] = *(const uint2*)(gp - (pos > 0 ? DFF : 0));
            g2[m] = *(const uint2*)(gp + (pos < L - 1 ? DFF : 0));
          }
#pragma unroll
          for (int m = 0; m < 4; ++m) {
            const int r = row0 + ai * 128 + m * 16;
            const int L = (grow0 + r) < 16384 ? 2048 : 8192;
            const int pos = (grow0 + r) & (L - 1);
            const float m0 = pos > 0 ? 1.f : 0.f, m2 = pos < L - 1 ? 1.f : 0.f;
            const uint2 a0 = g0[m], a1 = g1[m], a2 = g2[m];
            f32x4 a;
            a[0] = m0 * bf2f((u16)(a0.x & 0xffff)) * w0[0] + bf2f((u16)(a1.x & 0xffff)) * w1[0] + m2 * bf2f((u16)(a2.x & 0xffff)) * w2[0] + bb[0];
            a[1] = m0 * bf2f((u16)(a0.x >> 16)) * w0[1] + bf2f((u16)(a1.x >> 16)) * w1[1] + m2 * bf2f((u16)(a2.x >> 16)) * w2[1] + bb[1];
            a[2] = m0 * bf2f((u16)(a0.y & 0xffff)) * w0[2] + bf2f((u16)(a1.y & 0xffff)) * w1[2] + m2 * bf2f((u16)(a2.y & 0xffff)) * w2[2] + bb[2];
            a[3] = m0 * bf2f((u16)(a0.y >> 16)) * w0[3] + bf2f((u16)(a1.y >> 16)) * w1[3] + m2 * bf2f((u16)(a2.y >> 16)) * w2[3] + bb[3];
            const f32x4 v = acc[ai][bj][m][n];
            *(uint2*)(ACT + (size_t)r * DFF + c) = make_uint2(pack2(silu_f(a[0]) * v[0], silu_f(a[1]) * v[1]), pack2(silu_f(a[2]) * v[2], silu_f(a[3]) * v[3]));
          }
        }
      }
  }
};
template <class Epi>
__device__ __forceinline__ void run_gemm(const u16* A, const u16* Bt, int M, int N, int K, const Epi& E) {
  pg8::Gemm g; g.A = A; g.Bt = Bt; g.M = M; g.N = N; g.K = K;
  pg8::StaticOrder S; S.init(M, N, gridDim.x, BID());
  __syncthreads();
  pg8::gemm_phase<Epi, pg8::StaticOrder, false>((PG8_LAS unsigned char*)smem, g, S, E, nullptr);
  __syncthreads();
}

__device__ __forceinline__ int fidx(int p) { return p + ((p >> 6) << 2); }
__device__ __forceinline__ float2 cmulf(float2 a, float2 b) { return make_float2(a.x * b.x - a.y * b.y, a.x * b.y + a.y * b.x); }
__device__ __forceinline__ float2 cmulcf(float2 a, float2 b) { return make_float2(a.x * b.x + a.y * b.y, a.y * b.x - a.x * b.y); }
#define R16C(q) ((q) == 0 ? 1.f : (q) == 1 ? 0.9238795325f : (q) == 2 ? 0.7071067812f : (q) == 3 ? 0.3826834324f : (q) == 4 ? 0.f : (q) == 5 ? -0.3826834324f : (q) == 6 ? -0.7071067812f : -0.9238795325f)
#define R16S(q) ((q) == 0 ? 0.f : (q) == 1 ? -0.3826834324f : (q) == 2 ? -0.7071067812f : (q) == 3 ? -0.9238795325f : (q) == 4 ? -1.f : (q) == 5 ? -0.9238795325f : (q) == 6 ? -0.7071067812f : -0.3826834324f)
template <int N, int RS, bool INV>
__device__ __forceinline__ void fft_pass(float2* x, const float2* __restrict__ tw, const int S, const int tid) {
  constexpr int R = 1 << RS;
  const int E = S >> (RS - 1);
#pragma unroll 1
  for (int g = tid; g < N / R; g += NT) {
    const int blo = g & (E - 1);
    const int base = ((g - blo) << RS) + blo;
    float2 e[R];
#pragma unroll
    for (int k = 0; k < R; ++k) e[k] = x[fidx(base + k * E)];
    float2 wb[RS];
#pragma unroll
    for (int st = 0; st < RS; ++st) wb[st] = tw[blo * (8192 / (S >> st))];
#pragma unroll
    for (int sq = 0; sq < RS; ++sq) {
      const int st = INV ? (RS - 1 - sq) : sq;
      const int h = (R / 2) >> st;
#pragma unroll
      for (int k = 0; k < R; ++k) {
        if ((k & h) == 0) {
          const int m = k & (h - 1);
          const int q = m * (8 / h);
          float2 w = wb[st];
          if (q != 0) w = cmulf(w, make_float2(R16C(q), R16S(q)));
          if (!INV) {
            const float2 a = e[k], b = e[k + h];
            e[k] = make_float2(a.x + b.x, a.y + b.y);
            e[k + h] = cmulf(make_float2(a.x - b.x, a.y - b.y), w);
          } else {
            const float2 a = e[k], b = cmulcf(e[k + h], w);
            e[k] = make_float2(a.x + b.x, a.y + b.y);
            e[k + h] = make_float2(a.x - b.x, a.y - b.y);
          }
        }
      }
    }
#pragma unroll
    for (int k = 0; k < R; ++k) x[fidx(base + k * E)] = e[k];
  }
  __syncthreads();
}
template <int N>
__device__ __forceinline__ void fft_dif_t(float2* x, const float2* __restrict__ tw) {
  const int tid = TID();
  if (N == 16384) {
    fft_pass<N, 4, false>(x, tw, 8192, tid); fft_pass<N, 4, false>(x, tw, 512, tid);
    fft_pass<N, 4, false>(x, tw, 32, tid); fft_pass<N, 2, false>(x, tw, 2, tid);
  } else {
    fft_pass<N, 4, false>(x, tw, 2048, tid); fft_pass<N, 4, false>(x, tw, 128, tid); fft_pass<N, 4, false>(x, tw, 8, tid);
  }
}
template <int N>
__device__ __forceinline__ void ifft_dit_t(float2* x, const float2* __restrict__ tw) {
  const int tid = TID();
  if (N == 16384) {
    fft_pass<N, 2, true>(x, tw, 2, tid); fft_pass<N, 4, true>(x, tw, 32, tid);
    fft_pass<N, 4, true>(x, tw, 512, tid); fft_pass<N, 4, true>(x, tw, 8192, tid);
  } else {
    fft_pass<N, 4, true>(x, tw, 8, tid); fft_pass<N, 4, true>(x, tw, 128, tid); fft_pass<N, 4, true>(x, tw, 2048, tid);
  }
}
template <int N, int RS>
__device__ __forceinline__ void fft_pass_mid(float2* x, const float2* __restrict__ tw, const float2* __restrict__ hs, const int S, const int tid) {
  constexpr int R = 1 << RS;
  const int E = S >> (RS - 1);
#pragma unroll 1
  for (int g = tid; g < N / R; g += NT) {
    const int blo = g & (E - 1);
    const int base = ((g - blo) << RS) + blo;
    float2 e[R];
#pragma unroll
    for (int k = 0; k < R; ++k) e[k] = x[fidx(base + k * E)];
    float2 hv[R];
#pragma unroll
    for (int k = 0; k < R; ++k) hv[k] = hs[base + k * E];
    float2 wb[RS];
#pragma unroll
    for (int st = 0; st < RS; ++st) wb[st] = tw[blo * (8192 / (S >> st))];
#pragma unroll
    for (int st = 0; st < RS; ++st) {
      const int h = (R / 2) >> st;
#pragma unroll
      for (int k = 0; k < R; ++k) {
        if ((k & h) == 0) {
          const int q = (k & (h - 1)) * (8 / h);
          float2 w = wb[st];
          if (q != 0) w = cmulf(w, make_float2(R16C(q), R16S(q)));
          const float2 a = e[k], b = e[k + h];
          e[k] = make_float2(a.x + b.x, a.y + b.y);
          e[k + h] = cmulf(make_float2(a.x - b.x, a.y - b.y), w);
        }
      }
    }
#pragma unroll
    for (int k = 0; k < R; ++k) e[k] = cmulf(e[k], hv[k]);
#pragma unroll
    for (int sq = 0; sq < RS; ++sq) {
      const int st = RS - 1 - sq;
      const int h = (R / 2) >> st;
#pragma unroll
      for (int k = 0; k < R; ++k) {
        if ((k & h) == 0) {
          const int q = (k & (h - 1)) * (8 / h);
          float2 w = wb[st];
          if (q != 0) w = cmulf(w, make_float2(R16C(q), R16S(q)));
          const float2 a = e[k], b = cmulcf(e[k + h], w);
          e[k] = make_float2(a.x + b.x, a.y + b.y);
          e[k + h] = make_float2(a.x - b.x, a.y - b.y);
        }
      }
    }
#pragma unroll
    for (int k = 0; k < R; ++k) x[fidx(base + k * E)] = e[k];
  }
  __syncthreads();
}
template <int N>
__device__ __forceinline__ void fft_pass_first(float2* x, const float2* __restrict__ tw, const float* __restrict__ u0, const float* __restrict__ u1, const int tid) {
  constexpr int RS = 4, R = 16, S = N / 2, E = N / 16;
#pragma unroll 1
  for (int g = tid; g < N / R; g += NT) {
    float2 e[R];
#pragma unroll
    for (int k = 0; k < R; ++k) e[k] = (k < 8) ? make_float2(u0[g + k * E], u1[g + k * E]) : make_float2(0.f, 0.f);
    float2 wb[RS];
#pragma unroll
    for (int st = 0; st < RS; ++st) wb[st] = tw[g * (8192 / (S >> st))];
#pragma unroll
    for (int st = 0; st < RS; ++st) {
      const int h = (R / 2) >> st;
#pragma unroll
      for (int k = 0; k < R; ++k) {
        if ((k & h) == 0) {
          const int q = (k & (h - 1)) * (8 / h);
          float2 w = wb[st];
          if (q != 0) w = cmulf(w, make_float2(R16C(q), R16S(q)));
          const float2 a = e[k], b = e[k + h];
          e[k] = make_float2(a.x + b.x, a.y + b.y);
          e[k + h] = cmulf(make_float2(a.x - b.x, a.y - b.y), w);
        }
      }
    }
#pragma unroll
    for (int k = 0; k < R; ++k) x[fidx(g + k * E)] = e[k];
  }
  __syncthreads();
}
template <int N>
__device__ __forceinline__ void fft_pass_last(float2* x, const float2* __restrict__ tw, float* __restrict__ u0, float* __restrict__ u1, const float sk, const int tid) {
  constexpr int RS = 4, R = 16, S = N / 2, E = N / 16;
#pragma unroll 1
  for (int g = tid; g < N / R; g += NT) {
    float2 e[R];
#pragma unroll
    for (int k = 0; k < R; ++k) e[k] = x[fidx(g + k * E)];
    float2 wb[RS];
#pragma unroll
    for (int st = 0; st < RS; ++st) wb[st] = tw[g * (8192 / (S >> st))];
#pragma unroll
    for (int sq = 0; sq < RS; ++sq) {
      const int st = RS - 1 - sq;
      const int h = (R / 2) >> st;
#pragma unroll
      for (int k = 0; k < R; ++k) {
        if ((k & h) == 0) {
          const int q = (k & (h - 1)) * (8 / h);
          float2 w = wb[st];
          if (q != 0) w = cmulf(w, make_float2(R16C(q), R16S(q)));
          const float2 a = e[k], b = cmulcf(e[k + h], w);
          e[k] = make_float2(a.x + b.x, a.y + b.y);
          e[k + h] = make_float2(a.x - b.x, a.y - b.y);
        }
      }
    }
#pragma unroll
    for (int k = 0; k < 8; ++k) {
      const int t = g + k * E;
      u0[t] = e[k].x + u0[t] * sk;
      u1[t] = e[k].y + u1[t] * sk;
    }
  }
  __syncthreads();
}
__device__ __forceinline__ void fft_conv(float2* x, int N, const float2* __restrict__ tw, const float2* __restrict__ hs, float* __restrict__ u0, float* __restrict__ u1, const float sk) {
  const int tid = TID();
  if (N == 16384) {
    fft_pass_first<16384>(x, tw, u0, u1, tid); fft_pass<16384, 4, false>(x, tw, 512, tid); fft_pass<16384, 4, false>(x, tw, 32, tid);
    fft_pass_mid<16384, 2>(x, tw, hs, 2, tid);
    fft_pass<16384, 4, true>(x, tw, 32, tid); fft_pass<16384, 4, true>(x, tw, 512, tid); fft_pass_last<16384>(x, tw, u0, u1, sk, tid);
  } else {
    fft_pass_first<4096>(x, tw, u0, u1, tid); fft_pass<4096, 4, false>(x, tw, 128, tid);
    fft_pass_mid<4096, 4>(x, tw, hs, 8, tid);
    fft_pass<4096, 4, true>(x, tw, 128, tid); fft_pass_last<4096>(x, tw, u0, u1, sk, tid);
  }
}
__device__ __forceinline__ void fft_dif(float2* x, int N, const float2* __restrict__ tw) {
  if (N == 16384) fft_dif_t<16384>(x, tw); else fft_dif_t<4096>(x, tw);
}
__device__ __forceinline__ void ifft_dit(float2* x, int N, const float2* __restrict__ tw) {
  if (N == 16384) ifft_dit_t<16384>(x, tw); else ifft_dit_t<4096>(x, tw);
}

__device__ void transpose_w(const float* __restrict__ W, u16* __restrict__ Wt, int K, int N) {
  float* smf = (float*)smem;
  const int tk = K / 64, tn = N / 64, tid = TID(), G = gridDim.x;
  const int kk0 = tid >> 4, n40 = tid & 15, kk1 = (tid + NT) >> 4, n41 = (tid + NT) & 15;
  int item = BID();
  float4 v0 = make_float4(0, 0, 0, 0), v1 = v0;
  if (item < tk * tn) {
    const int k0 = (item / tn) * 64, n0 = (item % tn) * 64;
    v0 = *(const float4*)(W + (long)(k0 + kk0) * N + n0 + n40 * 4);
    v1 = *(const float4*)(W + (long)(k0 + kk1) * N + n0 + n41 * 4);
  }
  for (; item < tk * tn; item += G) {
    const int k0 = (item / tn) * 64, n0 = (item % tn) * 64;
    float4 w0 = v0, w1 = v1;
    const int nx = item + G;
    if (nx < tk * tn) {
      const int k2 = (nx / tn) * 64, n2 = (nx % tn) * 64;
      w0 = *(const float4*)(W + (long)(k2 + kk0) * N + n2 + n40 * 4);
      w1 = *(const float4*)(W + (long)(k2 + kk1) * N + n2 + n41 * 4);
    }
    __syncthreads();
    { float* p = smf + kk0 * 65 + n40 * 4; p[0] = v0.x; p[1] = v0.y; p[2] = v0.z; p[3] = v0.w; }
    { float* p = smf + kk1 * 65 + n41 * 4; p[0] = v1.x; p[1] = v1.y; p[2] = v1.z; p[3] = v1.w; }
    __syncthreads();
    const int nn = tid >> 3, k8 = tid & 7;
    float f[8];
#pragma unroll
    for (int i = 0; i < 8; ++i) f[i] = smf[(k8 * 8 + i) * 65 + nn];
    *(uint4*)(Wt + (long)(n0 + nn) * K + k0 + k8 * 8) = pack8s(f, 1.f);
    v0 = w0; v1 = w1;
  }
  __syncthreads();
}

__device__ void phase_pre0(const Params& P) {
  const int tid = TID();
  const long gtid = (long)BID() * NT + tid, gsz = (long)gridDim.x * NT;
  transpose_w(P.in[7], (u16*)(WS(P) + O_WHYIN), 1024, 3072);
  transpose_w(P.in[18], (u16*)(WS(P) + O_WHYOUT), 1024, 1024);
  transpose_w(P.in[19], (u16*)(WS(P) + O_WRETIN), 1024, 6144);
  transpose_w(P.in[21], (u16*)(WS(P) + O_WRETOUT), 2048, 1024);
  transpose_w(P.in[22], (u16*)(WS(P) + O_WSWAIN), 1024, 1536);
  transpose_w(P.in[26], (u16*)(WS(P) + O_WSWAOUT), 1024, 1024);
  transpose_w(P.in[27], (u16*)(WS(P) + O_WHGIN), 1024, 5120);
  transpose_w(P.in[30], (u16*)(WS(P) + O_WHGOUT), 1024, 1024);
  for (int l = 0; l < 4; ++l) {
    transpose_w(P.in[31] + (long)l * 1024 * DFF, (u16*)(WS(P) + O_WFG) + (long)l * DFF * 1024, 1024, DFF);
    transpose_w(P.in[32] + (long)l * 1024 * DFF, (u16*)(WS(P) + O_WFV) + (long)l * DFF * 1024, 1024, DFF);
    transpose_w(P.in[35] + (long)l * DFF * 1024, (u16*)(WS(P) + O_WFD) + (long)l * 1024 * DFF, DFF, 1024);
  }
  {
    float* cs = (float*)smem;
    float* modp = (float*)(WS(P) + O_MODP);
    for (int item = BID(); item < 4 * 8 * 12; item += gridDim.x) {
      const int nb = item % 12, ks = (item / 12) % 8, l = item / 96;
      __syncthreads();
      for (int i = tid; i < 2048; i += NT) {
        int b = i >> 7, k = i & 127;
        float c = (b < 8) ? P.in[2][b * 1024 + ks * 128 + k] : P.in[3][(b - 8) * 1024 + ks * 128 + k];
        cs[i] = c / (1.f + expf(-c));
      }
      __syncthreads();
      const int n = nb * 512 + tid;
      float a[16];
#pragma unroll
      for (int b = 0; b < 16; ++b) a[b] = 0.f;
      const float* w = P.in[4] + ((long)l * 1024 + ks * 128) * 6144 + n;
      for (int k = 0; k < 128; ++k) {
        float wv = w[(long)k * 6144];
#pragma unroll
        for (int b = 0; b < 16; ++b) a[b] += cs[b * 128 + k] * wv;
      }
#pragma unroll
      for (int b = 0; b < 16; ++b) modp[(((long)ks * 4 + l) * 16 + b) * 6144 + n] = a[b];
    }
    __syncthreads();
  }
  {
    float2* tw = (float2*)(WS(P) + O_TW);
    for (long i = gtid; i < 8192; i += gsz) {
      float s, c;
      sincospif((float)i * (1.f / 8192.f), &s, &c);
      tw[i] = make_float2(c, -s);
    }
    float2* rr = (float2*)(WS(P) + O_ROPER);
    for (long i = gtid; i < (long)8192 * 128; i += gsz) {
      int pos = (int)(i >> 7), d = (int)(i & 127);
      float inv = exp2f(-(float)d * (13.287712379549449f / 128.f));
      float s, c;
      sincosf((float)pos * inv, &s, &c);
      rr[i] = make_float2(c, s);
    }
    float2* rs = (float2*)(WS(P) + O_ROPES);
    for (long i = gtid; i < (long)8192 * 32; i += gsz) {
      int pos = (int)(i >> 5), d = (int)(i & 31);
      float inv = exp2f(-(float)d * (13.287712379549449f / 32.f));
      float s, c;
      sincosf((float)pos * inv, &s, &c);
      rs[i] = make_float2(c, s);
    }
  }
  {
    float* zf = (float*)smem;
    float* h1 = zf + 8 * 36;
    const float* w1 = P.in[10]; const float* b1 = P.in[11]; const float* w2 = P.in[12]; const float* b2 = P.in[13];
    const float* fr = P.in[15];
    const int tl = tid >> 6, j = tid & 63;
    for (int item = BID(); item < 1280; item += gridDim.x) {
      const int sel = item >= 1024;
      const int L = sel ? 2048 : 8192;
      const int t = (sel ? item - 1024 : item) * 8 + tl;
      float* hid = (float*)(WS(P) + (sel ? O_HIDP : O_HIDS));
      __syncthreads();
      if (j < 33) {
        float v;
        if (j == 0) v = (float)t / (float)(L - 1);
        else {
          int i = (j - 1) & 15;
          float band = 1e-4f + (float)i * ((15.f - 1e-4f) / 15.f);
          float ang = (6.283185307179586f / (float)L) * (float)t;
          float a = band * ang;
          v = (j <= 16) ? cosf(a) : -sinf(a);
        }
        zf[tl * 36 + j] = v;
      }
      __syncthreads();
      float s = b1[j];
#pragma unroll 3
      for (int i = 0; i < 33; ++i) s += zf[tl * 36 + i] * w1[i * 64 + j];
      h1[tl * 64 + j] = sinf(fr[j] * s);
      __syncthreads();
      float s2 = b2[j];
#pragma unroll 4
      for (int i = 0; i < 64; ++i) s2 += h1[tl * 64 + i] * w2[i * 64 + j];
      hid[(long)j * L + t] = sinf(fr[j] * s2);
    }
    __syncthreads();
  }
}

__device__ void phase_pre1(const Params& P) {
  __shared__ float w3s[128];
  __shared__ float red[8];
  const int tid = TID(), lane = tid & 63, wid = tid >> 6;
  const long gtid = (long)BID() * NT + tid, gsz = (long)gridDim.x * NT;
  {
    const float* modp = (const float*)(WS(P) + O_MODP);
    float* mod = (float*)(WS(P) + O_MOD);
    for (long i = gtid; i < (long)4 * 16 * 6144; i += gsz) {
      int n = (int)(i % 6144);
      int l = (int)(i / (16 * 6144));
      float s = P.in[5][l * 6144 + n];
      for (int ks = 0; ks < 8; ++ks) s += modp[(long)ks * 4 * 16 * 6144 + i];
      mod[i] = s;
    }
  }
  float2* buf = (float2*)smem;
  const float2* tw = (const float2*)(WS(P) + O_TW);
  for (int item = BID(); item < 2048; item += gridDim.x) {
    const int sel = item >> 10, c = item & 1023;
    const int L = sel ? 2048 : 8192, N = 2 * L;
    const float* hid = (const float*)(WS(P) + (sel ? O_HIDP : O_HIDS));
    float2* hs = (float2*)(WS(P) + (sel ? O_HSPP : O_HSPS)) + (long)c * N;
    __syncthreads();
    if (tid < 128) {
      int dirn = tid >> 6, j = tid & 63;
      w3s[tid] = P.in[14][(long)j * 2048 + dirn * 1024 + c];
    }
    __syncthreads();
    const float dec0 = fabsf(P.in[16][c]), dec1 = fabsf(P.in[16][1024 + c]);
    const float invLm1 = 1.f / (float)(L - 1);
    float asum = 0.f;
    for (int n = tid; n < N; n += NT) {
      float val = 0.f;
      if (n != L) {
        const int dirn = n < L ? 0 : 1;
        const int t = n < L ? n : N - n;
        const float* hp = hid + t;
        const float* w = w3s + dirn * 64;
        float s = 0.f;
#pragma unroll 16
        for (int j = 0; j < 64; ++j) s += hp[(long)j * L] * w[j];
        float tl = (float)t * invLm1;
        val = s * expf(-tl * (dirn ? dec1 : dec0));
      }
      buf[fidx(n)] = make_float2(val, 0.f);
      asum += fabsf(val);
    }
    asum = wave_sum(asum);
    if (lane == 0) red[wid] = asum;
    __syncthreads();
    float tot = 0.f;
#pragma unroll
    for (int w = 0; w < 8; ++w) tot += red[w];
    const float scale = 1.f / (tot * (float)N);
    fft_dif(buf, N, tw);
    for (int p = tid; p < N; p += NT) {
      float2 a = buf[fidx(p)];
      hs[p] = make_float2(a.x * scale, a.y * scale);
    }
  }
  __syncthreads();
}

__device__ void phase_norm(const Params& P, int layer, int sl, int which) {
  const int grow0 = which == 1 ? sl * FSLAB : (which == 2 ? 0 : sl * SLAB), nrows = which == 1 ? FSLAB : (which == 2 ? NTOK : SLAB);
  const float* __restrict__ x = (layer == 0 && which == 0) ? xin_of(P, sl) : (const float*)(OUTP(P) + (long)grow0 * D);
  u16* __restrict__ h = (u16*)(WS(P) + (which == 1 ? O_FHBUF : (which == 2 ? O_SA_H : O_HBUF)));
  const float* gain = P.in[6] + (layer * 2 + (which == 1 ? 1 : 0)) * D;
  const float* mod = (const float*)(WS(P) + O_MOD) + (long)layer * 16 * 6144;
  const int shoff = which == 1 ? 3 * D : 0, scoff = which == 1 ? 4 * D : D;
  const int tid = TID(), lane = tid & 63, wid = tid >> 6;
  for (int item = BID(); item < nrows / 32; item += gridDim.x) {
    const int r0 = item * 32 + wid * 4;
    float4 v[4][4];
    float ss[4];
#pragma unroll
    for (int u = 0; u < 4; ++u) {
      const float* xr = x + (long)(r0 + u) * D;
      float a = 0.f;
#pragma unroll
      for (int i = 0; i < 4; ++i) {
        v[u][i] = *(const float4*)(xr + i * 256 + lane * 4);
        a += v[u][i].x * v[u][i].x + v[u][i].y * v[u][i].y + v[u][i].z * v[u][i].z + v[u][i].w * v[u][i].w;
      }
      ss[u] = a;
    }
    const float* m = mod + (long)gb_row(grow0 + r0) * 6144;
#pragma unroll
    for (int u = 0; u < 4; ++u) ss[u] = wave_sum(ss[u]);
#pragma unroll
    for (int i = 0; i < 4; ++i) {
      const int col = i * 256 + lane * 4;
      const float4 g = *(const float4*)(gain + col);
      const float4 sc = *(const float4*)(m + scoff + col);
      const float4 sh = *(const float4*)(m + shoff + col);
      const float a0 = g.x * (1.f + sc.x), a1 = g.y * (1.f + sc.y), a2 = g.z * (1.f + sc.z), a3 = g.w * (1.f + sc.w);
#pragma unroll
      for (int u = 0; u < 4; ++u) {
        const float rstd = rsqrtf(ss[u] * (1.f / 1024.f) + 1e-6f);
        const float y0 = v[u][i].x * rstd * a0 + sh.x, y1 = v[u][i].y * rstd * a1 + sh.y;
        const float y2 = v[u][i].z * rstd * a2 + sh.z, y3 = v[u][i].w * rstd * a3 + sh.w;
        *(uint2*)(h + (long)(r0 + u) * D + col) = make_uint2(pack2(y0, y1), pack2(y2, y3));
      }
    }
  }
}

__device__ void phase_proj(const Params& P, size_t woff, int N) {
  EpiStoreBf16 E; E.O = (u16*)(WS(P) + O_PROJ); E.ldc = N;
  run_gemm((const u16*)(WS(P) + O_HBUF), (const u16*)(WS(P) + woff), SLAB, N, D, E);
}
__device__ void phase_resid(const Params& P, int layer, int slab, const u16* A, int K, size_t woff, int goff) {
  EpiResid E; E.X = OUTP(P) + (long)slab * SLAB * D; E.XS = (layer == 0) ? xin_of(P, slab) : (const float*)E.X; E.mod = (const float*)(WS(P) + O_MOD) + (long)layer * 16 * 6144; E.goff = goff; E.grow0 = slab * SLAB;
  run_gemm(A, (const u16*)(WS(P) + woff), SLAB, D, K, E);
}

__device__ void phase_ffn_gate(const Params& P, int layer) {
  EpiStoreBf16 E; E.O = (u16*)(WS(P) + O_FGBUF); E.ldc = DFF;
  run_gemm((const u16*)(WS(P) + O_FHBUF), (const u16*)(WS(P) + O_WFG) + (long)layer * DFF * D, FSLAB, DFF, D, E);
}
__device__ void phase_ffn_val(const Params& P, int layer, int fs) {
  EpiFfnVal E; E.G = (const u16*)(WS(P) + O_FGBUF); E.ACT = (u16*)(WS(P) + O_FACT) + (long)fs * FSLAB * DFF;
  E.cw = P.in[33] + (long)layer * 3 * DFF; E.cb = P.in[34] + (long)layer * DFF; E.grow0 = fs * FSLAB;
  run_gemm((const u16*)(WS(P) + O_FHBUF), (const u16*)(WS(P) + O_WFV) + (long)layer * DFF * D, FSLAB, DFF, D, E);
}
__device__ void phase_ffn_down(const Params& P, int layer) {
  EpiResid E; E.X = OUTP(P); E.XS = E.X; E.mod = (const float*)(WS(P) + O_MOD) + (long)layer * 16 * 6144; E.goff = 5 * D; E.grow0 = 0;
  run_gemm((const u16*)(WS(P) + O_FACT), (const u16*)(WS(P) + O_WFD) + (long)layer * D * DFF, NTOK, D, DFF, E);
}

__device__ void phase_hy_conv(const Params& P, int slab) {
  const int L = Lof(slab), nseq = SLAB / L, tid = TID();
  const u16* __restrict__ z = (const u16*)(WS(P) + O_PROJ);
  float* __restrict__ uT = (float*)(WS(P) + O_UT);
  u16* __restrict__ x0c = (u16*)(WS(P) + O_X0C);
  const float* cw = P.in[8];
  const float* cb = P.in[9];
  float* tile = (float*)smem;
  const int ntt = L / 64;
  const int nitems = nseq * ntt * 16;
  const int tl = tid >> 3, cg = tid & 7;
  for (int item = BID(); item < nitems; item += gridDim.x) {
    const int ct = item % 16, tt = (item / 16) % ntt, seq = item / (16 * ntt);
    const int t = tt * 64 + tl, c0 = ct * 64 + cg * 8;
    const long row = (long)seq * L + t;
    const float mp = t > 0 ? 1.f : 0.f, mn = t < L - 1 ? 1.f : 0.f;
    const long rp = t > 0 ? row - 1 : row, rn = t < L - 1 ? row + 1 : row;
    float val[3][8];
#pragma unroll
    for (int q = 0; q < 3; ++q) {
      const int col = q * 1024 + c0;
      float a[8], b[8], c[8];
      unpack8(*(const uint4*)(z + rp * 3072 + col), a);
      unpack8(*(const uint4*)(z + row * 3072 + col), b);
      unpack8(*(const uint4*)(z + rn * 3072 + col), c);
      const float4 w0a = *(const float4*)(cw + col), w0b = *(const float4*)(cw + col + 4);
      const float4 w1a = *(const float4*)(cw + 3072 + col), w1b = *(const float4*)(cw + 3072 + col + 4);
      const float4 w2a = *(const float4*)(cw + 6144 + col), w2b = *(const float4*)(cw + 6144 + col + 4);
      const float4 ba = *(const float4*)(cb + col), bb = *(const float4*)(cb + col + 4);
      const float w0[8] = {w0a.x, w0a.y, w0a.z, w0a.w, w0b.x, w0b.y, w0b.z, w0b.w};
      const float w1[8] = {w1a.x, w1a.y, w1a.z, w1a.w, w1b.x, w1b.y, w1b.z, w1b.w};
      const float w2[8] = {w2a.x, w2a.y, w2a.z, w2a.w, w2b.x, w2b.y, w2b.z, w2b.w};
      const float bs[8] = {ba.x, ba.y, ba.z, ba.w, bb.x, bb.y, bb.z, bb.w};
#pragma unroll
      for (int i = 0; i < 8; ++i) val[q][i] = mp * a[i] * w0[i] + b[i] * w1[i] + mn * c[i] * w2[i] + bs[i];
    }
    *(uint4*)(x0c + row * 1024 + c0) = pack8s(val[0], 1.f);
    __syncthreads();
#pragma unroll
    for (int i = 0; i < 8; ++i) tile[tl * 65 + cg * 8 + i] = val[1][i] * val[2][i];
    __syncthreads();
    {
      const int cl = tid >> 3, tq = tid & 7;
      float* dst = uT + ((long)seq * 1024 + ct * 64 + cl) * L + tt * 64 + tq * 8;
      float4 o0, o1;
      o0.x = tile[(tq * 8 + 0) * 65 + cl]; o0.y = tile[(tq * 8 + 1) * 65 + cl]; o0.z = tile[(tq * 8 + 2) * 65 + cl]; o0.w = tile[(tq * 8 + 3) * 65 + cl];
      o1.x = tile[(tq * 8 + 4) * 65 + cl]; o1.y = tile[(tq * 8 + 5) * 65 + cl]; o1.z = tile[(tq * 8 + 6) * 65 + cl]; o1.w = tile[(tq * 8 + 7) * 65 + cl];
      *(float4*)dst = o0; *(float4*)(dst + 4) = o1;
    }
  }
  __syncthreads();
}

__device__ void phase_hy_fft(const Params& P, int slab, bool dry = false) {
  const int L = Lof(slab), N = 2 * L, nseq = SLAB / L, tid = TID();
  float* uT = (float*)(WS(P) + O_UT);
  const float2* hsb = (const float2*)(WS(P) + (slab == 0 ? O_HSPP : O_HSPS));
  const float2* tw = (const float2*)(WS(P) + O_TW);
  const float* skip = P.in[17];
  float2* buf = (float2*)smem;
  const int nitems = (nseq / 2) * 1024;
  for (int item = BID(); item < nitems; item += gridDim.x) {
    const int pr = item >> 10, c = item & 1023;
    float* u0 = uT + ((long)(pr * 2) * 1024 + c) * L;
    float* u1 = u0 + (long)1024 * L;
    fft_conv(buf, N, tw, hsb + (long)c * N, u0, u1, skip[c]);
  }
  __syncthreads();
}

__device__ void phase_hy_tr(const Params& P, int slab) {
  const int L = Lof(slab), nseq = SLAB / L, tid = TID();
  const float* __restrict__ yT = (const float*)(WS(P) + O_UT);
  const u16* __restrict__ x0c = (const u16*)(WS(P) + O_X0C);
  u16* __restrict__ a2 = (u16*)(WS(P) + O_A2);
  float* tile = (float*)smem;
  const int ntt = L / 64;
  const int nitems = nseq * ntt * 16;
  for (int item = BID(); item < nitems; item += gridDim.x) {
    const int ct = item % 16, tt = (item / 16) % ntt, seq = item / (16 * ntt);
    const int cl = tid >> 3, tq = tid & 7;
    const float* src = yT + ((long)seq * 1024 + ct * 64 + cl) * L + tt * 64 + tq * 8;
    const float4 i0 = *(const float4*)src, i1 = *(const float4*)(src + 4);
    const int tl = tid >> 3, cg = tid & 7;
    const long row = (long)seq * L + tt * 64 + tl;
    const int c0 = ct * 64 + cg * 8;
    float xg[8];
    unpack8(*(const uint4*)(x0c + row * 1024 + c0), xg);
    __syncthreads();
    float* p = tile + cl * 65 + tq * 8;
    p[0] = i0.x; p[1] = i0.y; p[2] = i0.z; p[3] = i0.w; p[4] = i1.x; p[5] = i1.y; p[6] = i1.z; p[7] = i1.w;
    __syncthreads();
    float o[8];
#pragma unroll
    for (int i = 0; i < 8; ++i) o[i] = tile[(cg * 8 + i) * 65 + tl] * xg[i];
    *(uint4*)(a2 + row * 1024 + c0) = pack8s(o, 1.f);
  }
  __syncthreads();
}

struct Rec {
  int H, DK, DV, C;
  int ldv, voff, goff;
};
__device__ __forceinline__ Rec rec_of(int kind) {
  Rec r;
  if (kind == 1) { r.H = 4; r.DK = 256; r.DV = 512; r.C = 256; r.ldv = 6144; r.voff = 2048; r.goff = 4096; }
  else { r.H = 8; r.DK = 128; r.DV = 128; r.C = 128; r.ldv = 5120; r.voff = 1024; r.goff = 4096; }
  return r;
}

__device__ void phase_ret_prep(const Params& P, int slab) {
  const int L = Lof(slab);
  const u16* __restrict__ pj = (const u16*)(WS(P) + O_PROJ);
  u16* __restrict__ qdf = (u16*)(WS(P) + O_QDF); u16* __restrict__ qdb = (u16*)(WS(P) + O_QDB);
  u16* __restrict__ kif = (u16*)(WS(P) + O_KIF); u16* __restrict__ kib = (u16*)(WS(P) + O_KIB);
  u16* __restrict__ kef = (u16*)(WS(P) + O_KEF); u16* __restrict__ keb = (u16*)(WS(P) + O_KEB);
  float* dlf = (float*)(WS(P) + O_DLF); float* dlb = (float*)(WS(P) + O_DLB);
  const float2* __restrict__ rope = (const float2*)(WS(P) + O_ROPER);
  const long gtid = (long)BID() * NT + TID(), gsz = (long)gridDim.x * NT;
  for (long idx = gtid; idx < (long)SLAB * 64; idx += gsz) {
    const int d0 = (int)(idx & 15) * 8, h = (int)((idx >> 4) & 3), t = (int)(idx >> 6);
    const int pos = t & (L - 1), r = t & 255;
    const float lgf = -expf(P.in[20][h]), lgb = -expf(P.in[20][4 + h]);
    const u16* row = pj + (long)t * 6144 + h * 256 + d0;
    const uint4 vq1 = *(const uint4*)row, vq2 = *(const uint4*)(row + 128);
    const uint4 vk1 = *(const uint4*)(row + 1024), vk2 = *(const uint4*)(row + 1024 + 128);
    const float4* rp = (const float4*)(rope + (long)pos * 128 + d0);
    const float4 c01 = rp[0], c23 = rp[1], c45 = rp[2], c67 = rp[3];
    float q1[8], q2[8], k1[8], k2[8];
    unpack8(vq1, q1); unpack8(vq2, q2); unpack8(vk1, k1); unpack8(vk2, k2);
    const float cs[8] = {c01.x, c01.z, c23.x, c23.z, c45.x, c45.z, c67.x, c67.z};
    const float sn[8] = {c01.y, c01.w, c23.y, c23.w, c45.y, c45.w, c67.y, c67.w};
    float qa[8], qb[8], ka[8], kb[8];
#pragma unroll
    for (int i = 0; i < 8; ++i) {
      qa[i] = q1[i] * cs[i] - q2[i] * sn[i]; qb[i] = q1[i] * sn[i] + q2[i] * cs[i];
      ka[i] = (k1[i] * cs[i] - k2[i] * sn[i]) * 0.0625f; kb[i] = (k1[i] * sn[i] + k2[i] * cs[i]) * 0.0625f;
    }
    const float bf = (float)(r + 1) * lgf, bb = (float)(256 - r) * lgb;
    const float ef = expf(bf), eif = expf(-bf), eef = expf((float)(255 - r) * lgf);
    const float eb = expf(bb), eib = expf(-bb), eeb = expf((float)r * lgb);
    const long o1 = (long)t * 1024 + h * 256 + d0, o2 = o1 + 128;
    *(uint4*)(qdf + o1) = pack8s(qa, ef); *(uint4*)(qdf + o2) = pack8s(qb, ef);
    *(uint4*)(qdb + o1) = pack8s(qa, eb); *(uint4*)(qdb + o2) = pack8s(qb, eb);
    *(uint4*)(kef + o1) = pack8s(ka, eef); *(uint4*)(kef + o2) = pack8s(kb, eef);
    *(uint4*)(keb + o1) = pack8s(ka, eeb); *(uint4*)(keb + o2) = pack8s(kb, eeb);
    if (r == 0) {
      const long cgi = (long)(t >> 8) * 1024 + h * 256 + d0;
      const float df = expf(256.f * lgf), db = expf(256.f * lgb);
#pragma unroll
      for (int i = 0; i < 8; ++i) { dlf[cgi + i] = df; dlf[cgi + 128 + i] = df; dlb[cgi + i] = db; dlb[cgi + 128 + i] = db; }
    }
  }
}

__device__ __forceinline__ float lb_of(const float* lbt, int dr, int ch) {
  const float a0 = lbt[(dr * 4 + 0) * 1024 + ch], a1 = lbt[(dr * 4 + 1) * 1024 + ch], a2 = lbt[(dr * 4 + 2) * 1024 + ch], a3 = lbt[(dr * 4 + 3) * 1024 + ch];
  const float m = fmaxf(fmaxf(a0, a1), fmaxf(a2, a3));
  const float e0 = expf(a0 - m), e1 = expf(a1 - m), e2 = expf(a2 - m), e3 = expf(a3 - m);
  return (e0 + e1 + e2) / (e0 + e1 + e2 + e3);
}
__device__ void phase_hg_prep(const Params& P) {
  const u16* __restrict__ pj = (const u16*)(WS(P) + O_PROJ);
  u16* __restrict__ qdf = (u16*)(WS(P) + O_QDF); u16* __restrict__ qdb = (u16*)(WS(P) + O_QDB);
  u16* __restrict__ kif = (u16*)(WS(P) + O_KIF); u16* __restrict__ kib = (u16*)(WS(P) + O_KIB);
  u16* __restrict__ kef = (u16*)(WS(P) + O_KEF); u16* __restrict__ keb = (u16*)(WS(P) + O_KEB);
  float* dlf = (float*)(WS(P) + O_DLF); float* dlb = (float*)(WS(P) + O_DLB);
  const float* lbt = P.in[28];
  float* totF = (float*)smem;
  float* totB = totF + 1024;
  const int tid = TID(), lane = tid & 63, rg = tid >> 6;
  constexpr int RPT = 16;
  for (int item = BID(); item < 1024; item += gridDim.x) {
    const int cgi = item >> 3, ch = (item & 7) * 128 + lane * 2;
    const long t0 = (long)cgi * 128 + rg * RPT;
    unsigned wq[RPT], wf[RPT], wb[RPT];
#pragma unroll
    for (int i = 0; i < RPT; ++i) {
      const u16* row = pj + (t0 + i) * 5120 + ch;
      wq[i] = *(const unsigned*)row; wf[i] = *(const unsigned*)(row + 2048); wb[i] = *(const unsigned*)(row + 3072);
    }
    float lb0[2], lb1[2];
    lb0[0] = lb_of(lbt, 0, ch); lb0[1] = lb_of(lbt, 0, ch + 1);
    lb1[0] = lb_of(lbt, 1, ch); lb1[1] = lb_of(lbt, 1, ch + 1);
    float pf[2][RPT], sb[2][RPT], accf[2], accb[2];
#pragma unroll
    for (int c = 0; c < 2; ++c) {
      float a = 0.f;
#pragma unroll
      for (int i = 0; i < RPT; ++i) {
        const float x = bf2f((u16)(c ? (wf[i] >> 16) : (wf[i] & 0xffff)));
        a += logf(lb0[c] + (1.f - lb0[c]) * sigm(x)); pf[c][i] = a;
      }
      accf[c] = a;
      a = 0.f;
#pragma unroll
      for (int i = RPT - 1; i >= 0; --i) {
        const float x = bf2f((u16)(c ? (wb[i] >> 16) : (wb[i] & 0xffff)));
        a += logf(lb1[c] + (1.f - lb1[c]) * sigm(x)); sb[c][i] = a;
      }
      accb[c] = a;
    }
    __syncthreads();
    *(float2*)(totF + rg * 128 + lane * 2) = make_float2(accf[0], accf[1]);
    *(float2*)(totB + rg * 128 + lane * 2) = make_float2(accb[0], accb[1]);
    __syncthreads();
    float offF[2] = {0.f, 0.f}, offB[2] = {0.f, 0.f}, totf[2] = {0.f, 0.f}, totb[2] = {0.f, 0.f};
#pragma unroll
    for (int g = 0; g < 8; ++g) {
      const float2 f = *(const float2*)(totF + g * 128 + lane * 2), bq = *(const float2*)(totB + g * 128 + lane * 2);
      totf[0] += f.x; totf[1] += f.y; totb[0] += bq.x; totb[1] += bq.y;
      if (g < rg) { offF[0] += f.x; offF[1] += f.y; }
      if (g > rg) { offB[0] += bq.x; offB[1] += bq.y; }
    }
#pragma unroll
    for (int i = 0; i < RPT; ++i) {
      float o[6][2];
#pragma unroll
      for (int c = 0; c < 2; ++c) {
        const float xq = bf2f((u16)(c ? (wq[i] >> 16) : (wq[i] & 0xffff)));
        const float xf = bf2f((u16)(c ? (wf[i] >> 16) : (wf[i] & 0xffff)));
        const float xb = bf2f((u16)(c ? (wb[i] >> 16) : (wb[i] & 0xffff)));
        const float q = silu_f(xq);
        const float bf = offF[c] + pf[c][i], bb = offB[c] + sb[c][i];
        const float kf = (1.f - lb0[c]) * sigm(-xf), kb = (1.f - lb1[c]) * sigm(-xb);
        o[0][c] = q * expf(bf); o[1][c] = kf * expf(-bf); o[2][c] = kf * expf(totf[c] - bf);
        o[3][c] = q * expf(bb); o[4][c] = kb * expf(-bb); o[5][c] = kb * expf(totb[c] - bb);
      }
      const long oo = (t0 + i) * 1024 + ch;
      *(unsigned*)(qdf + oo) = pack2(o[0][0], o[0][1]);
      *(unsigned*)(kif + oo) = pack2(o[1][0], o[1][1]);
      *(unsigned*)(kef + oo) = pack2(o[2][0], o[2][1]);
      *(unsigned*)(qdb + oo) = pack2(o[3][0], o[3][1]);
      *(unsigned*)(kib + oo) = pack2(o[4][0], o[4][1]);
      *(unsigned*)(keb + oo) = pack2(o[5][0], o[5][1]);
    }
    if (rg == 0) {
      *(float2*)(dlf + (long)cgi * 1024 + ch) = make_float2(expf(totf[0]), expf(totf[1]));
      *(float2*)(dlb + (long)cgi * 1024 + ch) = make_float2(expf(totb[0]), expf(totb[1]));
    }
  }
  __syncthreads();
}

template <int C, int DKT>
__device__ __forceinline__ void rec_scores_item(const Params& P, const Rec& R, int cgi, int h, int ti, int tj) {
  constexpr int T = C > 128 ? 128 : C, KTS = DKT;
  const u16* qdf = (const u16*)(WS(P) + O_QDF); const u16* qdb = (const u16*)(WS(P) + O_QDB);
  const u16* kif = (const u16*)(WS(P) + O_KIF); const u16* kib = (const u16*)(WS(P) + O_KIB);
  u16* sc = (u16*)(WS(P) + O_SC) + (((long)cgi * R.H + h) * C + ti * T) * C + tj * T;
  const long offA = ((long)cgi * C + ti * T) * 1024 + h * R.DK, offB = ((long)cgi * C + tj * T) * 1024 + h * R.DK;
  f32x4 af[T / 32][T / 64] = {}, ab[T / 32][T / 64] = {};
  float sff = 1.f, sfb = 1.f;
  if (C == 256) {
    kif = (const u16*)(WS(P) + O_KEF); kib = (const u16*)(WS(P) + O_KEB);
    sff = expf((float)C * expf(P.in[20][h])); sfb = expf((float)C * expf(P.in[20][4 + h]));
  }
  if (ti >= tj) gemm_acc<T, T, true, true, true, KTS>(af, qdf + offA, 1024, kif + offB, 1024, (u16*)smem);
  if (ti <= tj) gemm_acc<T, T, true, true, true, KTS>(ab, qdb + offA, 1024, kib + offB, 1024, (u16*)smem);
  const int tid = TID(), lane = tid & 63, wid = tid >> 6;
  const int wm = wid >> 2, wn = wid & 3, fr = lane & 15, fq = lane >> 4;
#pragma unroll
  for (int mi = 0; mi < T / 32; ++mi)
#pragma unroll
    for (int ni = 0; ni < T / 64; ++ni) {
      const int r = wm * (T / 2) + mi * 16 + fr, c0 = wn * (T / 4) + ni * 16 + fq * 4;
      const int gr = ti * T + r;
      float v[4];
#pragma unroll
      for (int j = 0; j < 4; ++j) {
        const int gc = tj * T + c0 + j;
        v[j] = (gc <= gr ? af[mi][ni][j] * sff : 0.f) + (gc >= gr ? ab[mi][ni][j] * sfb : 0.f);
      }
      *(uint2*)(sc + r * C + c0) = make_uint2(pack2(v[0], v[1]), pack2(v[2], v[3]));
    }
}

template <int C, int DKT>
__device__ void phase_rec_su(const Params& P, int kind) {
  const Rec R = rec_of(kind);
  constexpr int KTU = C / 64;
  const int nch = SLAB / C;
  constexpr int NT1 = (C > 128 ? C / 128 : 1), NTT = NT1 * NT1;
  const int n_sc = nch * R.H * NTT;
  const int mtn = R.DK / 128, ntn = R.DV / 128;
  const int n_u = nch * R.H * 2 * mtn * ntn, G = gridDim.x;
  const u16* pj = (const u16*)(WS(P) + O_PROJ);
  for (int item = VBID(); item < n_sc; item += G) { const int tl = item % NTT, hh = (item / NTT) % R.H, cg = item / (NTT * R.H); rec_scores_item<C, DKT>(P, R, cg, hh, tl / NT1, tl % NT1); }
  const u16* kef = (const u16*)(WS(P) + O_KEF); const u16* keb = (const u16*)(WS(P) + O_KEB);
  u16* stfb = (u16*)(WS(P) + O_STF); u16* stbb = (u16*)(WS(P) + O_STB);
  Tiles<KTU> ta, tb;
#define U_DECODE(q_, nt_, mt_, dir_, h_, cgi_) int nt_, mt_, dir_, h_, cgi_; { int qq = (q_); nt_ = qq % ntn; qq /= ntn; mt_ = qq % mtn; qq /= mtn; dir_ = qq & 1; qq >>= 1; h_ = qq % R.H; cgi_ = qq / R.H; }
#define U_ISSUE(T_, nt_, mt_, dir_, h_, cgi_) tiles_issue<128, 128, false, false, KTU>(T_, (dir_ ? keb : kef) + (long)cgi_ * C * 1024 + h_ * R.DK + mt_ * 128, 1024, pj + (long)cgi_ * C * R.ldv + R.voff + h_ * R.DV + nt_ * 128, R.ldv)
#define U_RUN(T_, nt_, mt_, dir_, h_, cgi_) { f32x4 acc[4][2] = {}; gemm_run<128, 128, false, false, false, KTU>(acc, T_, (u16*)smem); \
    u16* st = (dir_ ? stbb : stfb) + (((long)cgi_ * R.H + h_) * R.DV + nt_ * 128) * R.DK + mt_ * 128; const int DK = R.DK; \
    epi_each<128, 128, false>(acc, [&](int r, int c, f32x4 val) { *(uint2*)(st + (long)c * DK + r) = make_uint2(pack2(val[0], val[1]), pack2(val[2], val[3])); }); }
  int q = VBID();
  if (q < n_u) { U_DECODE(q, nt, mt, dir, h, cgi); U_ISSUE(ta, nt, mt, dir, h, cgi); }
  for (; q < n_u; q += 2 * G) {
    U_DECODE(q, nt, mt, dir, h, cgi);
    const int q2 = q + G;
    if (q2 < n_u) { U_DECODE(q2, nt2, mt2, dir2, h2, cgi2); U_ISSUE(tb, nt2, mt2, dir2, h2, cgi2); }
    U_RUN(ta, nt, mt, dir, h, cgi);
    const int q3 = q + 2 * G;
    if (q3 < n_u) { U_DECODE(q3, nt3, mt3, dir3, h3, cgi3); U_ISSUE(ta, nt3, mt3, dir3, h3, cgi3); }
    if (q2 < n_u) { U_DECODE(q2, nt2, mt2, dir2, h2, cgi2); U_RUN(tb, nt2, mt2, dir2, h2, cgi2); }
  }
#undef U_DECODE
#undef U_ISSUE
#undef U_RUN
  __syncthreads();
}

__device__ void phase_rec_scan(const Params& P, int kind, int slab, bool dry = false) {
  const Rec R = rec_of(kind);
  const int L = Lof(slab), nseq = SLAB / L, ncs = L / R.C;
  const int qdk = R.DK / 4;
  const long per = (long)R.H * R.DV * qdk;
  const long total = 2 * nseq * per;
  const long gtid = (long)BID() * NT + TID(), gsz = (long)gridDim.x * NT;
  for (long idx = gtid; idx < total; idx += gsz) {
    long q = idx;
    const int pd = (int)(q % qdk); q /= qdk;
    const int e = (int)(q % R.DV); q /= R.DV;
    const int h = (int)(q % R.H); q /= R.H;
    const int seq = (int)(q % nseq);
    const int dir = (int)(q / nseq);
    u16* st = (u16*)(WS(P) + (dir ? O_STB : O_STF));
    u16* stw = dry ? (u16*)(WS(P) + O_OBUF) : st;
    const float* dl = (const float*)(WS(P) + (dir ? O_DLB : O_DLF));
    float s0 = 0.f, s1 = 0.f, s2 = 0.f, s3 = 0.f;
    const long ebase = ((long)h * R.DV + e) * R.DK + pd * 4;
    const long cstride = (long)R.H * R.DV * R.DK;
    const int dbase = h * R.DK + pd * 4;
    for (int i0 = 0; i0 < ncs; i0 += 8) {
      uint2 u[8];
      float4 dd[8];
#pragma unroll
      for (int j = 0; j < 8; ++j) {
        const int n = dir ? (ncs - 1 - i0 - j) : (i0 + j);
        const long cgi = (long)seq * ncs + n;
        { const unsigned long long w = __builtin_nontemporal_load((const unsigned long long*)(st + cgi * cstride + ebase)); u[j] = make_uint2((unsigned)w, (unsigned)(w >> 32)); }
        dd[j] = *(const float4*)(dl + cgi * 1024 + dbase);
      }
#pragma unroll
      for (int j = 0; j < 8; ++j) {
        const int n = dir ? (ncs - 1 - i0 - j) : (i0 + j);
        const long cgi = (long)seq * ncs + n;
        __builtin_nontemporal_store((unsigned long long)pack2(s0, s1) | ((unsigned long long)pack2(s2, s3) << 32), (unsigned long long*)(stw + cgi * cstride + ebase));
        s0 = dd[j].x * s0 + bf2f((u16)(u[j].x & 0xffff));
        s1 = dd[j].y * s1 + bf2f((u16)(u[j].x >> 16));
        s2 = dd[j].z * s2 + bf2f((u16)(u[j].y & 0xffff));
        s3 = dd[j].w * s3 + bf2f((u16)(u[j].y >> 16));
      }
    }
  }
}

template <int C, int DKT>
__device__ void phase_rec_out(const Params& P, int kind) {
  const Rec R = rec_of(kind);
  constexpr int T = C > 128 ? 128 : C, NRT = C / T;
  constexpr int KT1 = C / 64, KT2 = DKT;
  const int nch = SLAB / C, ntn = R.DV / 128;
  const u16* pj = (const u16*)(WS(P) + O_PROJ);
  const u16* scb = (const u16*)(WS(P) + O_SC);
  const u16* qdf = (const u16*)(WS(P) + O_QDF); const u16* qdb = (const u16*)(WS(P) + O_QDB);
  const u16* stf = (const u16*)(WS(P) + O_STF); const u16* stb = (const u16*)(WS(P) + O_STB);
  u16* ob = (u16*)(WS(P) + O_OBUF);
  const int HDV = R.H * R.DV;
  const int nitems = nch * R.H * NRT * ntn, G = gridDim.x;
  Tiles<KT1> t1; Tiles<KT2> t2; Tiles<KT2> t3;
  int item = VBID();
  if (item < nitems) {
    const int nt = item % ntn, rt = (item / ntn) % NRT, h = (item / (ntn * NRT)) % R.H, cgi = item / (ntn * NRT * R.H);
    tiles_issue<T, 128, true, false, KT1>(t1, scb + (((long)cgi * R.H + h) * C + rt * T) * C, C, pj + (long)cgi * C * R.ldv + R.voff + h * R.DV + nt * 128, R.ldv);
  }
  for (; item < nitems; item += G) {
    const int nt = item % ntn, rt = (item / ntn) % NRT, h = (item / (ntn * NRT)) % R.H, cgi = item / (ntn * NRT * R.H);
    const long qoff = ((long)cgi * C + rt * T) * 1024 + h * R.DK;
    const long soff = (((long)cgi * R.H + h) * R.DV + nt * 128) * R.DK;
    f32x4 acc[T / 32][2] = {};
    tiles_issue<T, 128, true, true, KT2>(t2, qdf + qoff, 1024, stf + soff, R.DK);
    gemm_run<T, 128, true, false, true, KT1>(acc, t1, (u16*)smem);
    tiles_issue<T, 128, true, true, KT2>(t3, qdb + qoff, 1024, stb + soff, R.DK);
    gemm_run<T, 128, true, true, true, KT2>(acc, t2, (u16*)smem);
    const int nx = item + G;
    if (nx < nitems) {
      const int nt2 = nx % ntn, rt2 = (nx / ntn) % NRT, h2 = (nx / (ntn * NRT)) % R.H, cg2 = nx / (ntn * NRT * R.H);
      tiles_issue<T, 128, true, false, KT1>(t1, scb + (((long)cg2 * R.H + h2) * C + rt2 * T) * C, C, pj + (long)cg2 * C * R.ldv + R.voff + h2 * R.DV + nt2 * 128, R.ldv);
    }
    gemm_run<T, 128, true, true, true, KT2>(acc, t3, (u16*)smem);
    if (DKT == 2) {
      float* part = (float*)(smem + 81920);
      const int tid = TID(), lane = tid & 63, wid = tid >> 6;
      const int wm = wid >> 2, wn = wid & 3, fr = lane & 15, fq = lane >> 4;
#pragma unroll
      for (int mi = 0; mi < T / 32; ++mi) {
        float sq = 0.f;
#pragma unroll
        for (int ni = 0; ni < 2; ++ni)
#pragma unroll
          for (int j = 0; j < 4; ++j) sq += acc[mi][ni][j] * acc[mi][ni][j];
        sq += __shfl_xor(sq, 16); sq += __shfl_xor(sq, 32);
        if (fq == 0) part[wn * 128 + wm * (T / 2) + mi * 16 + fr] = sq;
      }
      __syncthreads();
      const float* gain = P.in[29];
      u16* a2 = (u16*)(WS(P) + O_A2);
#pragma unroll
      for (int mi = 0; mi < T / 32; ++mi) {
        const int row = wm * (T / 2) + mi * 16 + fr;
        const float tot = part[row] + part[128 + row] + part[256 + row] + part[384 + row];
        const float rstd = rsqrtf(tot * (1.f / 128.f) + 1e-6f);
        const long t = (long)cgi * C + rt * T + row;
#pragma unroll
        for (int ni = 0; ni < 2; ++ni) {
          const int c = wn * 32 + ni * 16 + fq * 4;
          const float4 g4 = *(const float4*)(gain + c);
          const uint2 gw = *(const uint2*)(pj + t * R.ldv + R.goff + h * 128 + c);
          const f32x4 v = acc[mi][ni];
          const float y0 = v[0] * rstd * g4.x * silu_f(bf2f((u16)(gw.x & 0xffff)));
          const float y1 = v[1] * rstd * g4.y * silu_f(bf2f((u16)(gw.x >> 16)));
          const float y2 = v[2] * rstd * g4.z * silu_f(bf2f((u16)(gw.y & 0xffff)));
          const float y3 = v[3] * rstd * g4.w * silu_f(bf2f((u16)(gw.y >> 16)));
          *(uint2*)(a2 + t * 1024 + h * 128 + c) = make_uint2(pack2(y0, y1), pack2(y2, y3));
        }
      }
    } else {
      u16* o = ob + ((long)cgi * C + rt * T) * HDV + h * R.DV + nt * 128;
      epi_each<T, 128, true>(acc, [&](int r, int c, f32x4 val) { *(uint2*)(o + (long)r * HDV + c) = make_uint2(pack2(val[0], val[1]), pack2(val[2], val[3])); });
    }
  }
  __syncthreads();
}

template <int KIND>
__device__ void phase_rec_ng_t(const Params& P) {
  const Rec R = rec_of(KIND);
  constexpr int DV = (KIND == 1) ? 512 : 128, H = (KIND == 1) ? 4 : 8, PER = DV / 64, HDV = H * DV;
  const u16* __restrict__ ob = (const u16*)(WS(P) + O_OBUF);
  const u16* __restrict__ pj = (const u16*)(WS(P) + O_PROJ);
  u16* __restrict__ a2 = (u16*)(WS(P) + O_A2);
  const float* gain = P.in[29];
  const int tid = TID(), lane = tid & 63, wid = tid >> 6;
  constexpr int nrows = SLAB * H;
  for (int item = BID(); item < nrows / 32; item += gridDim.x) {
    float v[4][PER];
    float ss[4];
#pragma unroll
    for (int u = 0; u < 4; ++u) {
      const int rh = item * 32 + wid * 4 + u;
      const int t = rh / H, h = rh % H;
      const u16* o = ob + (long)t * HDV + h * DV + lane * PER;
      if (PER == 8) {
        float f8[8];
        unpack8(*(const uint4*)o, f8);
#pragma unroll
        for (int i = 0; i < 8; ++i) v[u][i % PER] = f8[i];
      } else {
        const unsigned w = *(const unsigned*)o;
        v[u][0] = bf2f((u16)(w & 0xffff)); v[u][1 % PER] = bf2f((u16)(w >> 16));
      }
      float a = 0.f;
#pragma unroll
      for (int i = 0; i < PER; ++i) a += v[u][i] * v[u][i];
      ss[u] = a;
    }
#pragma unroll
    for (int u = 0; u < 4; ++u) ss[u] = wave_sum(ss[u]);
#pragma unroll
    for (int u = 0; u < 4; ++u) {
      const int rh = item * 32 + wid * 4 + u;
      const int t = rh / H, h = rh % H;
      const float rstd = rsqrtf(ss[u] / (float)DV + 1e-6f);
      const u16* g = pj + (long)t * R.ldv + R.goff + h * DV + lane * PER;
      u16* out = a2 + (long)t * HDV + h * DV + lane * PER;
      float y[PER];
#pragma unroll
      for (int i = 0; i < PER; ++i) {
        y[i] = v[u][i] * rstd;
        if (KIND == 3) y[i] *= gain[lane * PER + i];
      }
      if (PER == 8) {
        const uint4 gw = *(const uint4*)g;
        float gf[8];
        unpack8(gw, gf);
        float r8[8];
#pragma unroll
        for (int i = 0; i < 8; ++i) r8[i] = y[i % PER] * silu_f(gf[i]);
        *(uint4*)out = pack8s(r8, 1.f);
      } else {
        const unsigned gw = *(const unsigned*)g;
        *(unsigned*)out = pack2(y[0] * silu_f(bf2f((u16)(gw & 0xffff))), y[1 % PER] * silu_f(bf2f((u16)(gw >> 16))));
      }
    }
  }
}
__device__ void phase_rec_ng(const Params& P, int kind) {
  if (kind == 1) phase_rec_ng_t<1>(P); else phase_rec_ng_t<3>(P);
}

__device__ void phase_swa_prep(const Params& P) {
  const u16* __restrict__ pj = (const u16*)(WS(P) + O_SA_P);
  u16* __restrict__ qn = (u16*)(WS(P) + O_SA_Q);
  u16* __restrict__ kn = (u16*)(WS(P) + O_SA_K);
  const float2* __restrict__ rope = (const float2*)(WS(P) + O_ROPES);
  const long gtid = (long)BID() * NT + TID(), gsz = (long)gridDim.x * NT;
  for (long idx = gtid; idx < (long)NTOK * 80; idx += gsz) {
    const int j = (int)(idx & 3);
    const int hd = (int)((idx >> 2) % 20);
    const int t = (int)(idx / 80);
    const int col = hd < 16 ? hd * 64 : 1024 + (hd - 16) * 64;
    const int d0 = j * 8;
    float x1[8], x2[8];
    unpack8(*(const uint4*)(pj + (long)t * 1536 + col + d0), x1);
    unpack8(*(const uint4*)(pj + (long)t * 1536 + col + d0 + 32), x2);
    const int L = t < 16384 ? 2048 : 8192;
    const float4* rp = (const float4*)(rope + (long)(t & (L - 1)) * 32 + d0);
    const float4 c01 = rp[0], c23 = rp[1], c45 = rp[2], c67 = rp[3];
    float ss = 0.f;
#pragma unroll
    for (int i = 0; i < 8; ++i) ss += x1[i] * x1[i] + x2[i] * x2[i];
    ss += __shfl_xor(ss, 1); ss += __shfl_xor(ss, 2);
    const float rstd = rsqrtf(ss * (1.f / 64.f) + 1e-6f);
    const float* gn = hd < 16 ? P.in[23] : P.in[24];
    const float4 ga = *(const float4*)(gn + d0), gb = *(const float4*)(gn + d0 + 4), gc = *(const float4*)(gn + d0 + 32), gd = *(const float4*)(gn + d0 + 36);
    const float g1[8] = {ga.x, ga.y, ga.z, ga.w, gb.x, gb.y, gb.z, gb.w};
    const float g2[8] = {gc.x, gc.y, gc.z, gc.w, gd.x, gd.y, gd.z, gd.w};
    const float cs[8] = {c01.x, c01.z, c23.x, c23.z, c45.x, c45.z, c67.x, c67.z};
    const float sn[8] = {c01.y, c01.w, c23.y, c23.w, c45.y, c45.w, c67.y, c67.w};
    const float osc = hd < 16 ? 0.125f : 1.f;
    float o1[8], o2[8];
#pragma unroll
    for (int i = 0; i < 8; ++i) {
      const float y1 = x1[i] * rstd * g1[i], y2 = x2[i] * rstd * g2[i];
      o1[i] = (y1 * cs[i] - y2 * sn[i]) * osc;
      o2[i] = (y1 * sn[i] + y2 * cs[i]) * osc;
    }
    u16* dst = hd < 16 ? qn + (long)t * 1024 + hd * 64 + d0 : kn + (long)t * 256 + (hd - 16) * 64 + d0;
    *(uint4*)dst = pack8s(o1, 1.f);
    *(uint4*)(dst + 32) = pack8s(o2, 1.f);
  }
}

constexpr int SLD = 324;
__device__ void phase_swa_att(const Params& P) {
  const u16* qn = (const u16*)(WS(P) + O_SA_Q);
  const u16* kn = (const u16*)(WS(P) + O_SA_K);
  const u16* pj = (const u16*)(WS(P) + O_SA_P);
  u16* a2 = (u16*)(WS(P) + O_SA_A);
  const float* sink = P.in[25];
  float* S = (float*)(smem + 40960);
  u16* Bs = (u16*)smem + 9216;
  const int tid = TID(), lane = tid & 63, wid = tid >> 6;
  const int wm = wid >> 2, wn = wid & 3, fr = lane & 15, fq = lane >> 4;
  const int nitems = (NTOK / 64) * 16;
  for (int item = VBID(); item < nitems; item += gridDim.x) {
    const int hq = item & 15, qbg = item >> 4;
    const int L = qbg < 256 ? 2048 : 8192;
    const int q0 = qbg < 256 ? (qbg & 31) * 64 : ((qbg - 256) & 127) * 64;
    const long tok0 = qbg < 256 ? (long)(qbg >> 5) * 2048 : 16384 + (long)((qbg - 256) >> 7) * 8192;
    const int hkv = hq >> 2;
    uint4 vt[5];
#pragma unroll
    for (int kt = 0; kt < 5; ++kt) {
      const int kp0 = q0 - 128 + kt * 64;
      vt[kt] = make_uint4(0, 0, 0, 0);
      if (kp0 >= 0 && kp0 < L) vt[kt] = ld_chunk<64, false>(pj + (tok0 + kp0) * 1536 + 1280 + hkv * 64, 1536, 0, tid);
    }
    for (int kt = 0; kt < 5; ++kt) {
      const int kp0 = q0 - 128 + kt * 64;
      if (kp0 >= 0 && kp0 < L) {
        f32x4 acc[2][1] = {};
        gemm_acc<64, 64, true, true, true, 1>(acc, qn + (tok0 + q0) * 1024 + hq * 64, 1024, kn + (tok0 + kp0) * 256 + hkv * 64, 256, (u16*)smem);
        epi_each<64, 64, true>(acc, [&](int r, int c, f32x4 v) {
          f32x4 o;
#pragma unroll
          for (int j = 0; j < 4; ++j) {
            const int dlt = (q0 + r) - (kp0 + c + j);
            o[j] = (dlt <= 128 && dlt >= -128) ? v[j] : -1e30f;
          }
          *(f32x4*)(S + r * SLD + kt * 64 + c) = o;
        });
      } else {
        for (int i = tid; i < 4096; i += NT) S[(i >> 6) * SLD + kt * 64 + (i & 63)] = -1e30f;
      }
    }
    __syncthreads();
    {
      const int r = tid >> 3, sub = tid & 7;
      const float sk = sink[hq];
      float e[40];
      float m = sk;
#pragma unroll
      for (int i = 0; i < 40; ++i) { e[i] = S[r * SLD + sub + 8 * i]; m = fmaxf(m, e[i]); }
      m = fmaxf(m, __shfl_xor(m, 1)); m = fmaxf(m, __shfl_xor(m, 2)); m = fmaxf(m, __shfl_xor(m, 4));
      float den = 0.f;
#pragma unroll
      for (int i = 0; i < 40; ++i) { e[i] = __expf(e[i] - m); den += e[i]; }
      den += __shfl_xor(den, 1); den += __shfl_xor(den, 2); den += __shfl_xor(den, 4);
      den += __expf(sk - m);
      const float inv = 1.f / den;
      u16* prow = (u16*)(S + r * SLD);
#pragma unroll
      for (int i = 0; i < 40; ++i) prow[sub + 8 * i] = f2bf(e[i] * inv);
    }
    __syncthreads();
    f32x4 acc[2][1] = {};
#pragma unroll
    for (int kt = 0; kt < 5; ++kt) {
      const int kp0 = q0 - 128 + kt * 64;
      if (kp0 >= 0 && kp0 < L) {
        __syncthreads();
        st_chunk<64, false>(Bs, vt[kt], tid);
        __syncthreads();
#pragma unroll
        for (int ks = 0; ks < 2; ++ks) {
          bf16x8 af[2];
#pragma unroll
          for (int mi = 0; mi < 2; ++mi) af[mi] = *(const bf16x8*)((const u16*)(S + (wm * 32 + mi * 16 + fr) * SLD) + kt * 64 + ks * 32 + fq * 8);
          const bf16x8 bfr = ld_frag<64, false>(Bs, wn * 16, ks, fr, fq);
#pragma unroll
          for (int mi = 0; mi < 2; ++mi) acc[mi][0] = __builtin_amdgcn_mfma_f32_16x16x32_bf16(bfr, af[mi], acc[mi][0], 0, 0, 0);
        }
      }
    }
    u16* o = a2 + (tok0 + q0) * 1024 + hq * 64;
    epi_each<64, 64, true>(acc, [&](int r, int c, f32x4 v) { *(uint2*)(o + (long)r * 1024 + c) = make_uint2(pack2(v[0], v[1]), pack2(v[2], v[3])); });
    __syncthreads();
  }
}

#define XB_TMO      128
#define XB_XCNT(j)  (256  + 64 * (j))
#define XB_XSUB(j)  (1280 + 64 * (j))
#define XB_XGEN(j)  (2304 + 64 * (j))
#define XB_TOP      3328
#define XB_TOPGEN   3392
#define XCD_BAR_WORDS 3456
#define XB_SPIN_CAP (1u << 18)
__device__ __forceinline__ unsigned xb_ld(unsigned* p)              { return __hip_atomic_load(p, __ATOMIC_RELAXED, __HIP_MEMORY_SCOPE_AGENT); }
__device__ __forceinline__ unsigned xb_add(unsigned* p, unsigned v) { return __hip_atomic_fetch_add(p, v, __ATOMIC_RELAXED, __HIP_MEMORY_SCOPE_AGENT); }
__device__ __forceinline__ unsigned xb_xcc_id() { return (unsigned)__builtin_amdgcn_s_getreg((3 << 11) | 20) & 0xFu; }
#define XB_SPIN(cond, bar) do { unsigned _sp = 0; while (cond) { __builtin_amdgcn_s_sleep(1); \
    if ((++_sp & 255u) == 0u) { if (xb_ld(&(bar)[XB_TMO])) break; if (_sp > XB_SPIN_CAP) { atomicAdd(&(bar)[XB_TMO], 1u); break; } } } } while (0)
struct XcdBarrier { unsigned* bar; unsigned x; volatile LDS_AS unsigned* st; };
__device__ __forceinline__ XcdBarrier xcd_barrier_post(unsigned* bar, volatile LDS_AS unsigned* st) {
    XcdBarrier b; b.bar = bar; b.x = xb_xcc_id(); b.st = st;
    if (threadIdx.x == 0) (void)xb_add(&bar[XB_XCNT(b.x)], 1u);
    return b;
}
__device__ __forceinline__ void xcd_barrier_complete(unsigned* bar, unsigned x, unsigned& nloc, unsigned& nx) {
    const unsigned G = gridDim.x * gridDim.y * gridDim.z;
    unsigned sum, cnt, mine, sp = 0u;
    for (;;) {
        sum = 0u; cnt = 0u; mine = 0u;
#pragma unroll
        for (unsigned j = 0; j < 16; ++j) { const unsigned c = xb_ld(&bar[XB_XCNT(j)]); sum += c; cnt += (c > 0u) ? 1u : 0u; mine = (j == x) ? c : mine; }
        if (sum == G) break;
        __builtin_amdgcn_s_sleep(1);
        if ((++sp & 255u) == 0u) { if (xb_ld(&bar[XB_TMO])) break; if (sp > XB_SPIN_CAP) { atomicAdd(&bar[XB_TMO], 1u); break; } }
    }
    nloc = mine > 0u ? mine : 1u; nx = cnt > 0u ? cnt : 1u;
}
__device__ __forceinline__ void xcd_barrier(const XcdBarrier& b) {
    asm volatile("s_waitcnt vmcnt(0)" ::: "memory");
    __syncthreads();
    if (threadIdx.x == 0) {
        unsigned* bar = b.bar;
        __builtin_amdgcn_s_waitcnt(0);
        unsigned nloc = b.st[0], nx = b.st[1];
        if (nloc == 0u) { xcd_barrier_complete(bar, b.x, nloc, nx); b.st[0] = nloc; b.st[1] = nx; }
        const unsigned old = xb_add(&bar[XB_XSUB(b.x)], 1u);
        const unsigned gen = old / nloc;
        if (old + 1u == (gen + 1u) * nloc) {
            __builtin_amdgcn_fence(__ATOMIC_RELEASE, "agent");
            asm volatile("s_waitcnt vmcnt(0)" ::: "memory");
            const unsigned og = xb_add(&bar[XB_TOP], 1u);
            const unsigned tg = og / nx;
            if (og + 1u == (tg + 1u) * nx) xb_add(&bar[XB_TOPGEN], 1u);
            else XB_SPIN(xb_ld(&bar[XB_TOPGEN]) == tg, bar);
            __builtin_amdgcn_fence(__ATOMIC_ACQUIRE, "agent");
            xb_add(&bar[XB_XGEN(b.x)], 1u);
            asm volatile("s_waitcnt vmcnt(0)" ::: "memory");
        } else {
            XB_SPIN(xb_ld(&bar[XB_XGEN(b.x)]) == gen, bar);
            __builtin_amdgcn_fence(__ATOMIC_ACQUIRE, "agent");
            asm volatile("s_waitcnt vmcnt(0)" ::: "memory");
        }
    }
    __syncthreads();
}

__device__ __forceinline__ int nmix_of(int kind) { return kind == 1 ? 8 : (kind == 3 ? 7 : (kind == 2 ? 5 : 6)); }
__device__ __forceinline__ int nsl_of(int kind) { return kind == 2 ? 1 : 5; }

__device__ void ffn_step(const Params& P, int layer, int f) {
  if (f == 6) { phase_ffn_down(P, layer); return; }
  const int fs = f / 3, st = f % 3;
  if (st == 0) { REP(4) phase_norm(P, layer, fs, 1); }
  else if (st == 1) { REP(0) phase_ffn_gate(P, layer); }
  else { REP(0) phase_ffn_val(P, layer, fs); }
}
__device__ void layer_step(const Params& P, int layer, int slab, int step) {
  const int kind = layer;
  if (step == 0) { REP(4) phase_norm(P, layer, slab, kind == 2 ? 2 : 0); return; }
  if (kind == 0) {
    if (step == 1) { REP(0) phase_proj(P, O_WHYIN, 3072); }
    else if (step == 2) { REP(3) phase_hy_conv(P, slab); }
    else if (step == 3) { if ((PROBE_MASK >> 7) & 1) phase_hy_fft(P, slab, true); phase_hy_fft(P, slab); }
    else if (step == 4) { REP(3) phase_hy_tr(P, slab); }
    else phase_resid(P, layer, slab, (const u16*)(WS(P) + O_A2), 1024, O_WHYOUT, 2 * D);
  } else if (kind == 1) {
    if (step == 1) { REP(0) phase_proj(P, O_WRETIN, 6144); }
    else if (step == 2) { REP(1) REP(9) phase_ret_prep(P, slab); }
    else if (step == 3) { REP(1) REP(11) phase_rec_su<256, 4>(P, 1); }
    else if (step == 4) { if ((PROBE_MASK >> 6) & 1) phase_rec_scan(P, 1, slab, true); phase_rec_scan(P, 1, slab); }
    else if (step == 5) { REP(1) REP(12) phase_rec_out<256, 4>(P, 1); }
    else if (step == 6) { REP(1) REP(9) phase_rec_ng(P, 1); }
    else phase_resid(P, layer, slab, (const u16*)(WS(P) + O_A2), 2048, O_WRETOUT, 2 * D);
  } else if (kind == 2) {
    if (step == 1) {
      EpiStoreBf16 E; E.O = (u16*)(WS(P) + O_SA_P); E.ldc = 1536;
      REP(0) run_gemm((const u16*)(WS(P) + O_SA_H), (const u16*)(WS(P) + O_WSWAIN), NTOK, 1536, D, E);
    }
    else if (step == 2) { REP(2) REP(14) phase_swa_prep(P); }
    else if (step == 3) { REP(2) REP(15) phase_swa_att(P); }
    else {
      EpiResid E; E.X = OUTP(P); E.XS = E.X; E.mod = (const float*)(WS(P) + O_MOD) + (long)layer * 16 * 6144; E.goff = 2 * D; E.grow0 = 0;
      run_gemm((const u16*)(WS(P) + O_SA_A), (const u16*)(WS(P) + O_WSWAOUT), NTOK, D, 1024, E);
    }
  } else {
    if (step == 1) { REP(0) phase_proj(P, O_WHGIN, 5120); }
    else if (step == 2) { REP(1) REP(9) phase_hg_prep(P); }
    else if (step == 3) { REP(1) REP(11) phase_rec_su<128, 2>(P, 3); }
    else if (step == 4) { if ((PROBE_MASK >> 6) & 1) phase_rec_scan(P, 3, slab, true); phase_rec_scan(P, 3, slab); }
    else if (step == 5) { REP(1) REP(12) phase_rec_out<128, 2>(P, 3); }
    else phase_resid(P, layer, slab, (const u16*)(WS(P) + O_A2), 1024, O_WHGOUT, 2 * D);
  }
}

__global__ void __launch_bounds__(NT) fwd_megakernel(Params P) {
  cg::grid_group grid = cg::this_grid();
  __shared__ uint4 xb_words;
  if (threadIdx.x == 0) xb_words = make_uint4(0u, 0u, 0u, 0u);
  __syncthreads();
  XcdBarrier xb = xcd_barrier_post((unsigned*)(P.ws + O_BAR), (volatile LDS_AS unsigned*)&xb_words);
  for (int pid = P.p0; pid < P.p1; ++pid) {
    if (pid == 0) { REP(5) phase_pre0(P); }
    else if (pid == 1) { REP(5) phase_pre1(P); }
    else {
      int q = pid - 2, layer = 0;
      while (q >= nsl_of(layer) * nmix_of(layer) + 7) { q -= nsl_of(layer) * nmix_of(layer) + 7; ++layer; }
      const int nm = nmix_of(layer), nsl = nsl_of(layer);
      if (q < nsl * nm) layer_step(P, layer, q / nm, q % nm);
      else ffn_step(P, layer, q - nsl * nm);
    }
    if (pid + 1 < P.p1) {
      if (pid == 0) grid.sync();
      else xcd_barrier(xb);
      if ((PROBE_MASK >> 8) & 1) xcd_barrier(xb);
    }
  }
}

extern "C" void kernel_launch(void* const* d_in, const int* in_sizes, int n_in, void* d_out, int out_size, void* d_ws,
                              size_t ws_size, hipStream_t stream) {
  static int grid_blocks = 0;
  if (!grid_blocks) {
    int dev = 0, cus = 0, per_cu = 0;
    (void)hipGetDevice(&dev);
    (void)hipDeviceGetAttribute(&cus, hipDeviceAttributeMultiprocessorCount, dev);
    (void)hipFuncSetAttribute((const void*)fwd_megakernel, hipFuncAttributeMaxDynamicSharedMemorySize, LDSB);
    (void)hipOccupancyMaxActiveBlocksPerMultiprocessor(&per_cu, (const void*)fwd_megakernel, NT, LDSB);
    if (per_cu < 1) per_cu = 1;
    if (per_cu > 1) per_cu = 1;
    grid_blocks = cus * per_cu;
    if (ws_size < WS_END) fprintf(stderr, "kernel_launch: workspace too small: %zu < %zu\n", ws_size, (size_t)WS_END);
  }
  Params p;
  memset(&p, 0, sizeof(p));
  for (int i = 0; i < 36; ++i) p.in[i] = (const float*)d_in[i];
  p.out = (float*)d_out;
  p.ws = (unsigned char*)d_ws;
  (void)hipMemsetAsync((unsigned char*)d_ws + O_BAR, 0, XCD_BAR_WORDS * 4, stream);
#if ONE_LAUNCH
  p.p0 = 0; p.p1 = NPHASES;
  void* args[] = {&p};
  hipError_t e = hipLaunchCooperativeKernel((const void*)fwd_megakernel, dim3(grid_blocks), dim3(NT), args, LDSB, stream);
  if (e != hipSuccess) fprintf(stderr, "cooperative launch failed: %s (grid %d)\n", hipGetErrorString(e), grid_blocks);
#else
  for (int ph = 0; ph < NPHASES; ++ph) {
    p.p0 = ph; p.p1 = ph + 1;
    hipLaunchKernelGGL(fwd_megakernel, dim3(grid_blocks), dim3(NT), LDSB, stream, p);
  }
#endif
}
```
